# Optimizing an MI355X kernel written in HIP

```python
import jax, jax.numpy as jnp
from jax import lax
import numpy as np

D_MODEL = 1024
BATCH = 8
SEQ = 2048
DEPTH = 1

MLA_HEADS = 4
MLA_Q_RANK = 384
MLA_KV_RANK = 256
MLA_NOPE = 128
MLA_ROPE = 64
MLA_V = 128
ROPE_THETA = 10000.0
ATTN_BLOCK = 128

GLA_HEADS = 4
GLA_DK = 64
GLA_DV = 128
GLA_GATE_RANK = 16
GLA_GATE_NORM = 16.0
GLA_CHUNK = 64

MIX_WIDTH = MLA_HEADS * MLA_V + GLA_HEADS * GLA_DV

IN_SIZES = (MLA_Q_RANK, MLA_KV_RANK, MLA_ROPE,
            GLA_HEADS * GLA_DK, GLA_HEADS * GLA_DK, GLA_HEADS * GLA_DV,
            GLA_GATE_RANK, GLA_GATE_RANK, GLA_HEADS * GLA_DV)
IN_WIDTH = sum(IN_SIZES)

PEER_HEADS = 8
PEER_NKEYS = 128
PEER_EXPERTS = PEER_NKEYS * PEER_NKEYS
PEER_DKEY = 256
PEER_TOPK = 16
PEER_BLOCK = 128

NORM_EPS = 1e-6

kernel_name = 'hymba_mla_gla_peer_adaln_encoder'


def rmsnorm(x, g):
    xf = x.astype(jnp.float32)
    y = xf * lax.rsqrt(jnp.mean(xf * xf, axis=-1, keepdims=True) + NORM_EPS)
    return (y * g.astype(jnp.float32)).astype(x.dtype)


def rope(x, positions):
    d = x.shape[-1]
    half = d // 2
    inv = ROPE_THETA ** (-jnp.arange(half, dtype=jnp.float32) / half)
    ang = positions.astype(jnp.float32)[..., None] * inv
    ang = ang.reshape(ang.shape[:2] + (1,) * (x.ndim - 3) + (half,))
    cos, sin = jnp.cos(ang), jnp.sin(ang)
    xf = x.astype(jnp.float32)
    x1, x2 = xf[..., :half], xf[..., half:]
    return jnp.concatenate([x1 * cos - x2 * sin, x2 * cos + x1 * sin], axis=-1).astype(x.dtype)


def block_attention(q, k, v):
    B, S, H, dq = q.shape
    nb = S // ATTN_BLOCK
    scale = dq ** -0.5
    qb = q.reshape(B, nb, ATTN_BLOCK, H, dq).transpose(1, 0, 2, 3, 4)

    def one_block(qblk):
        s = jnp.einsum('bqhd,bkhd->bhqk', qblk, k).astype(jnp.float32) * scale
        p = jax.nn.softmax(s, axis=-1).astype(v.dtype)
        return jnp.einsum('bhqk,bkhv->bqhv', p, v)

    out = lax.map(one_block, qb)
    return out.transpose(1, 0, 2, 3, 4).reshape(B, S, H, v.shape[-1])


def gla_chunked(q, k, v, log_a):
    B, S, H, dk = q.shape
    dv = v.shape[-1]
    C = GLA_CHUNK
    n = S // C

    def blocks(t):
        return t.astype(jnp.float32).reshape(B, n, C, H, t.shape[-1]).transpose(0, 3, 1, 2, 4)

    qc, kc, vc, gc = blocks(q), blocks(k), blocks(v), blocks(log_a)
    b = jnp.cumsum(gc, axis=3)
    b_last = b[:, :, :, -1:, :]
    q_dec = qc * jnp.exp(b)
    k_inv = kc * jnp.exp(-b)
    lower = jnp.tril(jnp.ones((C, C), dtype=bool))
    att = jnp.where(lower, jnp.einsum('bhnid,bhnjd->bhnij', q_dec, k_inv), 0.0)
    o_intra = jnp.einsum('bhnij,bhnjv->bhniv', att, vc)
    d_state = jnp.einsum('bhnjd,bhnjv->bhndv', kc * jnp.exp(b_last - b), vc)
    chunk_decay = jnp.exp(b_last[:, :, :, 0, :])

    def step(state, inp):
        dec, ds = inp
        return dec[..., None] * state + ds, state

    _, s_prev = lax.scan(step, jnp.zeros((B, H, dk, dv), jnp.float32),
                         (jnp.moveaxis(chunk_decay, 2, 0), jnp.moveaxis(d_state, 2, 0)))
    s_prev = jnp.moveaxis(s_prev, 0, 2)
    o = o_intra + jnp.einsum('bhnid,bhndv->bhniv', q_dec, s_prev)
    return o.transpose(0, 2, 3, 1, 4).reshape(B, S, H, dv)


def token_mixer(h, positions, w_in, g_q_latent, w_q_up, g_kv_latent, w_kv_up,
                w_gate_fwd, b_gate_fwd, w_gate_bwd, b_gate_bwd, g_gla_norm, w_out):
    B, S, _ = h.shape
    proj = h @ w_in
    offs = np.cumsum(IN_SIZES)[:-1].tolist()
    (cq, ckv, k_rope_raw, qg, kg, vg,
     gl_fwd, gl_bwd, r) = jnp.split(proj, offs, axis=-1)

    qa = (rmsnorm(cq, g_q_latent) @ w_q_up).reshape(B, S, MLA_HEADS, MLA_NOPE + MLA_ROPE)
    q_nope, q_rope = qa[..., :MLA_NOPE], rope(qa[..., MLA_NOPE:], positions)
    kv = (rmsnorm(ckv, g_kv_latent) @ w_kv_up).reshape(B, S, MLA_HEADS, MLA_NOPE + MLA_V)
    k_nope, v_mla = kv[..., :MLA_NOPE], kv[..., MLA_NOPE:]
    k_rope = rope(k_rope_raw, positions)
    q_mla = jnp.concatenate([q_nope, q_rope], axis=-1)
    k_mla = jnp.concatenate(
        [k_nope, jnp.broadcast_to(k_rope[:, :, None, :], (B, S, MLA_HEADS, MLA_ROPE))], axis=-1)
    o_mla = block_attention(q_mla, k_mla, v_mla).reshape(B, S, MLA_HEADS * MLA_V)

    qg = qg.reshape(B, S, GLA_HEADS, GLA_DK) * (GLA_DK ** -0.5)
    kg = kg.reshape(B, S, GLA_HEADS, GLA_DK)
    vg = vg.reshape(B, S, GLA_HEADS, GLA_DV)
    la_fwd = (jax.nn.log_sigmoid((gl_fwd @ w_gate_fwd + b_gate_fwd).astype(jnp.float32))
              / GLA_GATE_NORM).reshape(B, S, GLA_HEADS, GLA_DK)
    la_bwd = (jax.nn.log_sigmoid((gl_bwd @ w_gate_bwd + b_gate_bwd).astype(jnp.float32))
              / GLA_GATE_NORM).reshape(B, S, GLA_HEADS, GLA_DK)
    o_f = gla_chunked(qg, kg, vg, la_fwd)
    flip = lambda t: jnp.flip(t, axis=1)
    o_b = flip(gla_chunked(flip(qg), flip(kg), flip(vg), flip(la_bwd)))
    o_g = rmsnorm((o_f + o_b).astype(h.dtype), g_gla_norm)
    o_gla = (o_g * jax.nn.silu(r.reshape(B, S, GLA_HEADS, GLA_DV))).reshape(B, S, GLA_HEADS * GLA_DV)

    return jnp.concatenate([o_mla, o_gla], axis=-1) @ w_out


def peer(h, w_peer_q, sub_keys_1, sub_keys_2, expert_u, expert_v):
    B, S, D = h.shape
    half = PEER_DKEY // 2
    tokens = h.reshape(-1, PEER_BLOCK, D)

    def one_block(xb):
        P = xb.shape[0]
        qry = (xb @ w_peer_q).reshape(P, PEER_HEADS, PEER_DKEY)
        s1 = jnp.einsum('phd,nd->phn', qry[..., :half], sub_keys_1).astype(jnp.float32)
        s2 = jnp.einsum('phd,nd->phn', qry[..., half:], sub_keys_2).astype(jnp.float32)
        v1, i1 = lax.top_k(s1, PEER_TOPK)
        v2, i2 = lax.top_k(s2, PEER_TOPK)
        cand_s = (v1[..., :, None] + v2[..., None, :]).reshape(P, PEER_HEADS, PEER_TOPK * PEER_TOPK)
        cand_i = (i1[..., :, None] * PEER_NKEYS + i2[..., None, :]).reshape(P, PEER_HEADS, PEER_TOPK * PEER_TOPK)
        top_s, pos = lax.top_k(cand_s, PEER_TOPK)
        eidx = jnp.take_along_axis(cand_i, pos, axis=-1)
        gates = jax.nn.softmax(top_s, axis=-1)
        u = expert_u[eidx]
        a = jnp.einsum('phkd,pd->phk', u, xb).astype(jnp.float32)
        w = (gates * jax.nn.gelu(a, approximate=False)).astype(xb.dtype)
        return jnp.einsum('phk,phkd->pd', w, expert_v[eidx])

    return lax.map(one_block, tokens).reshape(B, S, D)


def setup_inputs(seed: int = 0) -> dict:
    key = jax.random.key(seed)
    ks = jax.random.split(key, 32)
    L, D = DEPTH, D_MODEL
    nrm = lambda k, shape, fan: jax.random.normal(k, shape, jnp.float32) * (fan ** -0.5)
    gain = lambda k, shape: 1.0 + 0.05 * jax.random.normal(k, shape, jnp.float32)
    x = jax.random.normal(ks[0], (BATCH, SEQ, D), jnp.float32)
    c = jax.random.normal(ks[1], (BATCH, D), jnp.float32)
    offsets = jax.random.randint(ks[2], (BATCH, 1), 0, 1024, dtype=jnp.int32)
    positions = jnp.arange(SEQ, dtype=jnp.int32)[None, :] + offsets
    return {
        'x': x,
        'c': c,
        'positions': positions,
        'w_ada': 0.5 * nrm(ks[3], (L, D, 6 * D), D),
        'b_ada': 0.01 * jax.random.normal(ks[4], (L, 6 * D), jnp.float32),
        'g_pre_mix': gain(ks[5], (L, D)),
        'g_post_mix': gain(ks[6], (L, D)),
        'w_in': nrm(ks[7], (L, D, IN_WIDTH), D),
        'g_q_latent': gain(ks[8], (L, MLA_Q_RANK)),
        'w_q_up': nrm(ks[9], (L, MLA_Q_RANK, MLA_HEADS * (MLA_NOPE + MLA_ROPE)), MLA_Q_RANK),
        'g_kv_latent': gain(ks[10], (L, MLA_KV_RANK)),
        'w_kv_up': nrm(ks[11], (L, MLA_KV_RANK, MLA_HEADS * (MLA_NOPE + MLA_V)), MLA_KV_RANK),
        'w_gate_fwd': nrm(ks[12], (L, GLA_GATE_RANK, GLA_HEADS * GLA_DK), GLA_GATE_RANK),
        'b_gate_fwd': 0.1 * jax.random.normal(ks[13], (L, GLA_HEADS * GLA_DK), jnp.float32),
        'w_gate_bwd': nrm(ks[14], (L, GLA_GATE_RANK, GLA_HEADS * GLA_DK), GLA_GATE_RANK),
        'b_gate_bwd': 0.1 * jax.random.normal(ks[15], (L, GLA_HEADS * GLA_DK), jnp.float32),
        'g_gla_norm': gain(ks[16], (L, GLA_DV)),
        'w_out': nrm(ks[17], (L, MIX_WIDTH, D), MIX_WIDTH),
        'g_pre_ffn': gain(ks[18], (L, D)),
        'g_post_ffn': gain(ks[19], (L, D)),
        'w_peer_q': nrm(ks[20], (L, D, PEER_HEADS * PEER_DKEY), D),
        'sub_keys_1': nrm(ks[21], (L, PEER_NKEYS, PEER_DKEY // 2), PEER_DKEY // 2),
        'sub_keys_2': nrm(ks[22], (L, PEER_NKEYS, PEER_DKEY // 2), PEER_DKEY // 2),
        'expert_u': nrm(ks[23], (L, PEER_EXPERTS, D), D),
        'expert_v': nrm(ks[24], (L, PEER_EXPERTS, D), D),
    }


def reference(x, c, positions, w_ada, b_ada, g_pre_mix, g_post_mix, w_in, g_q_latent, w_q_up,
              g_kv_latent, w_kv_up, w_gate_fwd, b_gate_fwd, w_gate_bwd, b_gate_bwd, g_gla_norm,
              w_out, g_pre_ffn, g_post_ffn, w_peer_q, sub_keys_1, sub_keys_2, expert_u, expert_v):
    c_act = jax.nn.silu(c)
    for l in range(DEPTH):
        mod = (c_act @ w_ada[l] + b_ada[l])[:, None, :]
        sh1, sc1, gt1, sh2, sc2, gt2 = jnp.split(mod, 6, axis=-1)
        h = rmsnorm(x, g_pre_mix[l]) * (1.0 + sc1) + sh1
        y = token_mixer(h, positions, w_in[l], g_q_latent[l], w_q_up[l], g_kv_latent[l], w_kv_up[l],
                        w_gate_fwd[l], b_gate_fwd[l], w_gate_bwd[l], b_gate_bwd[l], g_gla_norm[l], w_out[l])
        x = x + gt1 * rmsnorm(y, g_post_mix[l])
        h = rmsnorm(x, g_pre_ffn[l]) * (1.0 + sc2) + sh2
        y = peer(h, w_peer_q[l], sub_keys_1[l], sub_keys_2[l], expert_u[l], expert_v[l])
        x = x + gt2 * rmsnorm(y, g_post_ffn[l])
    return x
```

```cpp
#include <hip/hip_runtime.h>
#include <stdint.h>

typedef unsigned short bf16_t;
#define DI __device__ __forceinline__

DI float bf2f(bf16_t v) { return __uint_as_float(((unsigned)v) << 16); }
DI bf16_t f2bf(float f) { unsigned u = __float_as_uint(f); u += 0x7fffu + ((u >> 16) & 1u); return (bf16_t)(u >> 16); }

constexpr int BATCH = 8, SEQ = 2048, DM = 1024, NTOK = BATCH * SEQ;
constexpr int INW = 2272;
constexpr float EPS = 1e-6f;
constexpr int O_CQ = 0, O_CKV = 384, O_KR = 640, O_QG = 704, O_KG = 960, O_VG = 1216, O_GF = 1728, O_GB = 1744, O_R = 1760;

DI float wave_sum(float v) {
#pragma unroll
  for (int o = 1; o < 64; o <<= 1) v += __shfl_xor(v, o);
  return v;
}
DI float wave_max(float v) {
#pragma unroll
  for (int o = 1; o < 64; o <<= 1) v = fmaxf(v, __shfl_xor(v, o));
  return v;
}
DI float block_sum256(float v, float* red) {
  v = wave_sum(v);
  __syncthreads();
  if ((threadIdx.x & 63) == 0) red[threadIdx.x >> 6] = v;
  __syncthreads();
  return red[0] + red[1] + red[2] + red[3];
}
DI float block_max256(float v, float* red) {
  v = wave_max(v);
  __syncthreads();
  if ((threadIdx.x & 63) == 0) red[threadIdx.x >> 6] = v;
  __syncthreads();
  return fmaxf(fmaxf(red[0], red[1]), fmaxf(red[2], red[3]));
}
DI float silu_f(float x) { return x / (1.f + expf(-x)); }
DI float logsigmoid_f(float x) { return fminf(x, 0.f) - log1pf(expf(-fabsf(x))); }
DI float gelu_erf(float x) { return 0.5f * x * (1.f + erff(x * 0.70710678118654752f)); }

__global__ __launch_bounds__(256) void n_mod(const float* __restrict__ c, const float* __restrict__ w_ada, const float* __restrict__ b_ada, float* __restrict__ mod) {
  int idx = blockIdx.x * 256 + threadIdx.x;
  int b = idx / 6144, j = idx % 6144;
  float acc = b_ada[j];
  for (int k = 0; k < 1024; ++k) acc += silu_f(c[b * 1024 + k]) * w_ada[(size_t)k * 6144 + j];
  mod[idx] = acc;
}

__global__ __launch_bounds__(256) void n_hnorm(const float* __restrict__ x, const float* __restrict__ g, const float* __restrict__ mod, int b, int off_sh, int off_sc, float* __restrict__ h) {
  __shared__ float red[4];
  int t = blockIdx.x, tid = threadIdx.x;
  const float* xr = x + ((size_t)b * SEQ + t) * DM;
  float v[4]; float ss = 0.f;
#pragma unroll
  for (int i = 0; i < 4; ++i) { v[i] = xr[tid + 256 * i]; ss += v[i] * v[i]; }
  ss = block_sum256(ss, red);
  float rs = rsqrtf(ss * (1.f / DM) + EPS);
#pragma unroll
  for (int i = 0; i < 4; ++i) { int d = tid + 256 * i; h[(size_t)t * DM + d] = v[i] * rs * g[d] * (1.f + mod[b * 6144 + off_sc + d]) + mod[b * 6144 + off_sh + d]; }
}

template <bool BT>
__global__ __launch_bounds__(256) void n_gemm(const float* __restrict__ A, int lda, const float* __restrict__ B, int ldb, float* __restrict__ C, int ldc, int M, int N, int K) {
  __shared__ float As[16][65];
  __shared__ float Bs[16][65];
  const int tid = threadIdx.x, tx = tid & 15, ty = tid >> 4;
  const int m0 = blockIdx.y * 64, n0 = blockIdx.x * 64;
  float acc[4][4];
#pragma unroll
  for (int i = 0; i < 4; ++i)
#pragma unroll
    for (int j = 0; j < 4; ++j) acc[i][j] = 0.f;
  for (int k0 = 0; k0 < K; k0 += 16) {
#pragma unroll
    for (int i = 0; i < 4; ++i) { int e = tid + 256 * i; int m = e >> 4, k = e & 15; As[k][m] = A[(size_t)(m0 + m) * lda + k0 + k]; }
#pragma unroll
    for (int i = 0; i < 4; ++i) { int e = tid + 256 * i;
      if (!BT) { int k = e >> 6, n = e & 63; Bs[k][n] = (n0 + n < N) ? B[(size_t)(k0 + k) * ldb + n0 + n] : 0.f; }
      else     { int n = e >> 4, k = e & 15; Bs[k][n] = (n0 + n < N) ? B[(size_t)(n0 + n) * ldb + k0 + k] : 0.f; } }
    __syncthreads();
#pragma unroll
    for (int k = 0; k < 16; ++k) {
      float a[4], bb[4];
#pragma unroll
      for (int i = 0; i < 4; ++i) { a[i] = As[k][ty * 4 + i]; bb[i] = Bs[k][tx * 4 + i]; }
#pragma unroll
      for (int i = 0; i < 4; ++i)
#pragma unroll
        for (int j = 0; j < 4; ++j) acc[i][j] += a[i] * bb[j];
    }
    __syncthreads();
  }
#pragma unroll
  for (int i = 0; i < 4; ++i)
#pragma unroll
    for (int j = 0; j < 4; ++j) { int n = n0 + tx * 4 + j; if (n < N) C[(size_t)(m0 + ty * 4 + i) * ldc + n] = acc[i][j]; }
}

__global__ __launch_bounds__(256) void n_rms_slice(const float* __restrict__ in, int ldin, int off, int W, const float* __restrict__ g, float* __restrict__ out) {
  __shared__ float red[4];
  int t = blockIdx.x, tid = threadIdx.x;
  float v0 = (tid < W) ? in[(size_t)t * ldin + off + tid] : 0.f;
  float v1 = (tid + 256 < W) ? in[(size_t)t * ldin + off + tid + 256] : 0.f;
  float ss = block_sum256(v0 * v0 + v1 * v1, red);
  float rs = rsqrtf(ss / (float)W + EPS);
  if (tid < W) out[(size_t)t * W + tid] = v0 * rs * g[tid];
  if (tid + 256 < W) out[(size_t)t * W + tid + 256] = v1 * rs * g[tid + 256];
}

__global__ __launch_bounds__(256) void n_scatter(const float* __restrict__ proj, const float* __restrict__ qa, const float* __restrict__ kv, const int* __restrict__ positions, int b,
                                                 const float* __restrict__ wgf, const float* __restrict__ bgf, const float* __restrict__ wgb, const float* __restrict__ bgb,
                                                 bf16_t* __restrict__ Qm, bf16_t* __restrict__ Km, bf16_t* __restrict__ Vm, bf16_t* __restrict__ qg, bf16_t* __restrict__ kg, bf16_t* __restrict__ vg,
                                                 bf16_t* __restrict__ rg, float* __restrict__ laf, float* __restrict__ lab) {
  __shared__ float cs[32], sn[32];
  const int t = blockIdx.x, tid = threadIdx.x;
  const size_t tok = (size_t)b * SEQ + t;
  const float* pr = proj + (size_t)t * INW;
  const float* qr = qa + (size_t)t * 768;
  const float* kr = kv + (size_t)t * 1024;
  if (tid < 32) {
    float inv = powf(10000.f, -(float)tid / 32.f);
    float ang = (float)positions[tok] * inv;
    cs[tid] = cosf(ang); sn[tid] = sinf(ang);
  }
  __syncthreads();
  for (int e = tid; e < 4 * 192; e += 256) {
    int h = e / 192, d = e % 192; float v;
    if (d < 128) v = qr[h * 192 + d];
    else { int j = d - 128; const float* rp = qr + h * 192 + 128;
      if (j < 32) v = rp[j] * cs[j] - rp[j + 32] * sn[j]; else v = rp[j] * cs[j - 32] + rp[j - 32] * sn[j - 32]; }
    Qm[(((size_t)b * 4 + h) * SEQ + t) * 192 + d] = f2bf(v);
  }
  for (int e = tid; e < 4 * 192; e += 256) {
    int h = e / 192, d = e % 192; float v;
    if (d < 128) v = kr[h * 256 + d];
    else { int j = d - 128; const float* rp = pr + O_KR;
      if (j < 32) v = rp[j] * cs[j] - rp[j + 32] * sn[j]; else v = rp[j] * cs[j - 32] + rp[j - 32] * sn[j - 32]; }
    Km[(((size_t)b * 4 + h) * SEQ + t) * 192 + d] = f2bf(v);
  }
  for (int e = tid; e < 512; e += 256) { int h = e >> 7, d = e & 127; Vm[(((size_t)b * 4 + h) * SEQ + t) * 128 + d] = f2bf(kr[h * 256 + 128 + d]); }
  { int e = tid; qg[tok * 256 + e] = f2bf(pr[O_QG + e] * 0.125f); kg[tok * 256 + e] = f2bf(pr[O_KG + e]); }
  for (int e = tid; e < 512; e += 256) { vg[tok * 512 + e] = f2bf(pr[O_VG + e]); rg[tok * 512 + e] = f2bf(pr[O_R + e]); }
  { int cidx = tid; float af = bgf[cidx], ab = bgb[cidx];
#pragma unroll
    for (int r = 0; r < 16; ++r) { af += pr[O_GF + r] * wgf[r * 256 + cidx]; ab += pr[O_GB + r] * wgb[r * 256 + cidx]; }
    laf[tok * 256 + cidx] = logsigmoid_f(af) * (1.f / 16.f); lab[tok * 256 + cidx] = logsigmoid_f(ab) * (1.f / 16.f); }
}

__global__ __launch_bounds__(256) void n_attn(const bf16_t* __restrict__ Qm, const bf16_t* __restrict__ Km, const bf16_t* __restrict__ Vm, bf16_t* __restrict__ omla) {
  __shared__ float qs[192]; __shared__ float sc[2048]; __shared__ float red[4];
  const int i = blockIdx.x, h = blockIdx.y, b = blockIdx.z, tid = threadIdx.x;
  const size_t bh = (size_t)b * 4 + h;
  if (tid < 192) qs[tid] = bf2f(Qm[(bh * SEQ + i) * 192 + tid]);
  __syncthreads();
  float mx = -1e30f;
  for (int kk = 0; kk < 8; ++kk) {
    int key = tid + 256 * kk; const uint4* kr = (const uint4*)(Km + (bh * SEQ + key) * 192);
    float s = 0.f;
    for (int c = 0; c < 24; ++c) { uint4 w = kr[c]; const float* q = qs + c * 8;
      s += q[0] * __uint_as_float(w.x << 16) + q[1] * __uint_as_float(w.x & 0xffff0000u) + q[2] * __uint_as_float(w.y << 16) + q[3] * __uint_as_float(w.y & 0xffff0000u)
         + q[4] * __uint_as_float(w.z << 16) + q[5] * __uint_as_float(w.z & 0xffff0000u) + q[6] * __uint_as_float(w.w << 16) + q[7] * __uint_as_float(w.w & 0xffff0000u); }
    s *= 0.07216878364870322f; sc[key] = s; mx = fmaxf(mx, s);
  }
  mx = block_max256(mx, red);
  float sum = 0.f;
  for (int kk = 0; kk < 8; ++kk) { int key = tid + 256 * kk; float p = expf(sc[key] - mx); sc[key] = p; sum += p; }
  sum = block_sum256(sum, red);
  __syncthreads();
  if (tid < 128) { float o = 0.f; const bf16_t* vp = Vm + bh * SEQ * 128 + tid;
    for (int key = 0; key < SEQ; ++key) o += sc[key] * bf2f(vp[(size_t)key * 128]);
    omla[((size_t)b * SEQ + i) * 512 + h * 128 + tid] = f2bf(o / sum); }
}

__global__ __launch_bounds__(128) void n_gla(const bf16_t* __restrict__ qg, const bf16_t* __restrict__ kg, const bf16_t* __restrict__ vg, const float* __restrict__ laf, const float* __restrict__ lab, float* __restrict__ og) {
  __shared__ float qs[64], ks[64], as[64];
  const int bh = blockIdx.x, b = bh >> 2, h = bh & 3, dv = threadIdx.x;
  for (int dir = 0; dir < 2; ++dir) {
    float S[64];
#pragma unroll
    for (int d = 0; d < 64; ++d) S[d] = 0.f;
    const float* la = dir ? lab : laf;
    for (int s = 0; s < SEQ; ++s) {
      const int t = dir ? (SEQ - 1 - s) : s; const size_t tok = (size_t)b * SEQ + t;
      __syncthreads();
      if (dv < 64) { qs[dv] = bf2f(qg[tok * 256 + h * 64 + dv]); ks[dv] = bf2f(kg[tok * 256 + h * 64 + dv]); as[dv] = expf(la[tok * 256 + h * 64 + dv]); }
      __syncthreads();
      const float v = bf2f(vg[tok * 512 + h * 128 + dv]); float o = 0.f;
#pragma unroll
      for (int d = 0; d < 64; ++d) { S[d] = as[d] * S[d] + ks[d] * v; o += qs[d] * S[d]; }
      if (dir == 0) og[tok * 512 + h * 128 + dv] = o; else og[tok * 512 + h * 128 + dv] += o;
    }
  }
}

__global__ __launch_bounds__(256) void n_mix(const bf16_t* __restrict__ omla, const float* __restrict__ og, const bf16_t* __restrict__ rg, const float* __restrict__ g_gla, int b, float* __restrict__ mix) {
  __shared__ float ssum[4];
  const int t = blockIdx.x, tid = threadIdx.x; const size_t tok = (size_t)b * SEQ + t;
  if (tid < 4) ssum[tid] = 0.f;
  __syncthreads();
  float v[2];
#pragma unroll
  for (int i = 0; i < 2; ++i) { int e = tid + 256 * i; v[i] = og[tok * 512 + e]; atomicAdd(&ssum[e >> 7], v[i] * v[i]); mix[(size_t)t * DM + e] = bf2f(omla[tok * 512 + e]); }
  __syncthreads();
#pragma unroll
  for (int i = 0; i < 2; ++i) { int e = tid + 256 * i; float rs = rsqrtf(ssum[e >> 7] * (1.f / 128.f) + EPS);
    mix[(size_t)t * DM + 512 + e] = v[i] * rs * g_gla[e & 127] * silu_f(bf2f(rg[tok * 512 + e])); }
}

__global__ __launch_bounds__(256) void n_post1(const float* __restrict__ x, const float* __restrict__ y, const float* __restrict__ g_post, const float* __restrict__ g_pre2, const float* __restrict__ mod, int b,
                                               float* __restrict__ out, float* __restrict__ h2) {
  __shared__ float red[4];
  const int t = blockIdx.x, tid = threadIdx.x; const size_t tok = (size_t)b * SEQ + t;
  float yv[4], xv[4]; float ss = 0.f;
#pragma unroll
  for (int i = 0; i < 4; ++i) { yv[i] = y[(size_t)t * DM + tid + 256 * i]; ss += yv[i] * yv[i]; }
  ss = block_sum256(ss, red);
  float rs = rsqrtf(ss * (1.f / DM) + EPS); float s2 = 0.f;
#pragma unroll
  for (int i = 0; i < 4; ++i) { int d = tid + 256 * i; xv[i] = x[tok * DM + d] + mod[b * 6144 + 2048 + d] * (yv[i] * rs * g_post[d]); out[tok * DM + d] = xv[i]; s2 += xv[i] * xv[i]; }
  s2 = block_sum256(s2, red);
  float r2 = rsqrtf(s2 * (1.f / DM) + EPS);
#pragma unroll
  for (int i = 0; i < 4; ++i) { int d = tid + 256 * i; h2[(size_t)t * DM + d] = xv[i] * r2 * g_pre2[d] * (1.f + mod[b * 6144 + 4096 + d]) + mod[b * 6144 + 3072 + d]; }
}

DI void wave_argmax(float& v, int& i) {
#pragma unroll
  for (int o = 1; o < 64; o <<= 1) { float ov = __shfl_xor(v, o); int oi = __shfl_xor(i, o); if (ov > v || (ov == v && oi < i)) { v = ov; i = oi; } }
}
__global__ __launch_bounds__(256) void n_peer_select(const float* __restrict__ qry, const float* __restrict__ sk1, const float* __restrict__ sk2, int* __restrict__ eidx, float* __restrict__ gate) {
  __shared__ float v1s[4][16], v2s[4][16]; __shared__ int i1s[4][16], i2s[4][16];
  const int w = threadIdx.x >> 6, lane = threadIdx.x & 63;
  const int pair = blockIdx.x * 4 + w;
  const int t = pair >> 3, h = pair & 7;
  const float* q1 = qry + (size_t)t * 2048 + h * 256; const float* q2 = q1 + 128;
  float s1a = 0.f, s1b = 0.f, s2a = 0.f, s2b = 0.f;
  for (int d = 0; d < 128; ++d) { float a = q1[d], bq = q2[d];
    s1a += a * sk1[lane * 128 + d]; s1b += a * sk1[(lane + 64) * 128 + d]; s2a += bq * sk2[lane * 128 + d]; s2b += bq * sk2[(lane + 64) * 128 + d]; }
  for (int side = 0; side < 2; ++side) {
    float va = side ? s2a : s1a, vb = side ? s2b : s1b; bool ta = false, tb = false;
    for (int k = 0; k < 16; ++k) {
      float bv; int bi;
      if (!ta && (tb || va >= vb)) { bv = va; bi = lane; } else if (!tb) { bv = vb; bi = lane + 64; } else { bv = -3e38f; bi = 1 << 20; }
      wave_argmax(bv, bi);
      if (bi == lane) ta = true; if (bi == lane + 64) tb = true;
      if (lane == 0) { if (side) { v2s[w][k] = bv; i2s[w][k] = bi; } else { v1s[w][k] = bv; i1s[w][k] = bi; } }
    }
  }
  __syncthreads();
  float cv[4]; bool tk[4];
#pragma unroll
  for (int j = 0; j < 4; ++j) { int c = lane + 64 * j; cv[j] = v1s[w][c >> 4] + v2s[w][c & 15]; tk[j] = false; }
  float topv = 0.f; int topc = 0; float mx = 0.f;
  for (int k = 0; k < 16; ++k) {
    float bv = -3e38f; int bi = 1 << 20;
#pragma unroll
    for (int j = 0; j < 4; ++j) { if (!tk[j] && cv[j] > bv) { bv = cv[j]; bi = lane + 64 * j; } }
    wave_argmax(bv, bi);
#pragma unroll
    for (int j = 0; j < 4; ++j) if (bi == lane + 64 * j) tk[j] = true;
    if (k == 0) mx = bv;
    if (lane == k) { topv = bv; topc = bi; }
  }
  float e = (lane < 16) ? expf(topv - mx) : 0.f;
  float sum = wave_sum(e);
  if (lane < 16) { eidx[(size_t)pair * 16 + lane] = i1s[w][topc >> 4] * 128 + i2s[w][topc & 15]; gate[(size_t)pair * 16 + lane] = e / sum; }
}

__global__ __launch_bounds__(256) void n_peer_apply(const float* __restrict__ h2, const int* __restrict__ eidx, const float* __restrict__ gate, const float* __restrict__ eu, const float* __restrict__ ev,
                                                    const float* __restrict__ g_post, const float* __restrict__ mod, int b, float* __restrict__ out) {
  __shared__ float ys[4][1024]; __shared__ float red[4];
  const int t = blockIdx.x, tid = threadIdx.x, w = tid >> 6, lane = tid & 63; const size_t tok = (size_t)b * SEQ + t;
  float4 hx[4];
#pragma unroll
  for (int i = 0; i < 4; ++i) hx[i] = *(const float4*)(h2 + (size_t)t * DM + (lane + 64 * i) * 4);
  float4 acc[4];
#pragma unroll
  for (int i = 0; i < 4; ++i) acc[i] = make_float4(0.f, 0.f, 0.f, 0.f);
  for (int k = w; k < 128; k += 4) {
    const int e = eidx[(size_t)t * 128 + k]; const float gt = gate[(size_t)t * 128 + k];
    const float4* ur = (const float4*)(eu + (size_t)e * DM); const float4* vr = (const float4*)(ev + (size_t)e * DM);
    float d = 0.f;
#pragma unroll
    for (int i = 0; i < 4; ++i) { float4 u = ur[lane + 64 * i]; d += u.x * hx[i].x + u.y * hx[i].y + u.z * hx[i].z + u.w * hx[i].w; }
    d = wave_sum(d);
    const float wgt = gt * gelu_erf(d);
#pragma unroll
    for (int i = 0; i < 4; ++i) { float4 v = vr[lane + 64 * i]; acc[i].x += wgt * v.x; acc[i].y += wgt * v.y; acc[i].z += wgt * v.z; acc[i].w += wgt * v.w; }
  }
#pragma unroll
  for (int i = 0; i < 4; ++i) *(float4*)(&ys[w][(lane + 64 * i) * 4]) = acc[i];
  __syncthreads();
  float yv[4]; float ss = 0.f;
#pragma unroll
  for (int i = 0; i < 4; ++i) { int d = tid + 256 * i; yv[i] = ys[0][d] + ys[1][d] + ys[2][d] + ys[3][d]; ss += yv[i] * yv[i]; }
  ss = block_sum256(ss, red);
  const float rs = rsqrtf(ss * (1.f / DM) + EPS);
#pragma unroll
  for (int i = 0; i < 4; ++i) { int d = tid + 256 * i; out[tok * DM + d] = out[tok * DM + d] + mod[b * 6144 + 5120 + d] * (yv[i] * rs * g_post[d]); }
}

static inline size_t al256(size_t x) { return (x + 255) & ~(size_t)255; }

extern "C" void kernel_launch(void* const* d_in, const int* in_sizes, int n_in, void* d_out, int out_size, void* d_ws, size_t ws_size, hipStream_t stream) {
  const float* x = (const float*)d_in[0]; const float* c = (const float*)d_in[1]; const int* positions = (const int*)d_in[2];
  const float* w_ada = (const float*)d_in[3]; const float* b_ada = (const float*)d_in[4]; const float* g_pre_mix = (const float*)d_in[5]; const float* g_post_mix = (const float*)d_in[6];
  const float* w_in = (const float*)d_in[7]; const float* g_q_lat = (const float*)d_in[8]; const float* w_q_up = (const float*)d_in[9]; const float* g_kv_lat = (const float*)d_in[10];
  const float* w_kv_up = (const float*)d_in[11]; const float* wgf = (const float*)d_in[12]; const float* bgf = (const float*)d_in[13]; const float* wgb = (const float*)d_in[14];
  const float* bgb = (const float*)d_in[15]; const float* g_gla = (const float*)d_in[16]; const float* w_out = (const float*)d_in[17]; const float* g_pre_ffn = (const float*)d_in[18];
  const float* g_post_ffn = (const float*)d_in[19]; const float* w_peer_q = (const float*)d_in[20]; const float* sk1 = (const float*)d_in[21]; const float* sk2 = (const float*)d_in[22];
  const float* eu = (const float*)d_in[23]; const float* ev = (const float*)d_in[24];
  float* out = (float*)d_out;
  char* ws = (char*)d_ws; size_t off = 0;
  auto take = [&](size_t bytes) { char* p = ws + off; off = al256(off + bytes); return p; };
  float* mod = (float*)take(8 * 6144 * 4);
  bf16_t* Qm = (bf16_t*)take((size_t)NTOK * 4 * 192 * 2); bf16_t* Km = (bf16_t*)take((size_t)NTOK * 4 * 192 * 2); bf16_t* Vm = (bf16_t*)take((size_t)NTOK * 4 * 128 * 2);
  bf16_t* qg = (bf16_t*)take((size_t)NTOK * 256 * 2); bf16_t* kg = (bf16_t*)take((size_t)NTOK * 256 * 2); bf16_t* vg = (bf16_t*)take((size_t)NTOK * 512 * 2); bf16_t* rg = (bf16_t*)take((size_t)NTOK * 512 * 2);
  float* laf = (float*)take((size_t)NTOK * 256 * 4); float* lab = (float*)take((size_t)NTOK * 256 * 4);
  bf16_t* omla = (bf16_t*)take((size_t)NTOK * 512 * 2); float* og = (float*)take((size_t)NTOK * 512 * 4);
  const size_t scratch0 = off;
  float* hb = (float*)take((size_t)SEQ * DM * 4); float* projb = (float*)take((size_t)SEQ * INW * 4); float* cqn = (float*)take((size_t)SEQ * 384 * 4); float* qa = (float*)take((size_t)SEQ * 768 * 4);
  float* ckvn = (float*)take((size_t)SEQ * 256 * 4); float* kvb = (float*)take((size_t)SEQ * 1024 * 4);
  const size_t end1 = off; off = scratch0;
  float* mix = (float*)take((size_t)SEQ * DM * 4); float* yb = (float*)take((size_t)SEQ * DM * 4); float* h2 = (float*)take((size_t)SEQ * DM * 4); float* qry = (float*)take((size_t)SEQ * 2048 * 4);
  int* eidx = (int*)take((size_t)SEQ * 128 * 4); float* gatev = (float*)take((size_t)SEQ * 128 * 4);
  const size_t end3 = off;
  if ((end1 > end3 ? end1 : end3) > ws_size) return;

  n_mod<<<49152 / 256, 256, 0, stream>>>(c, w_ada, b_ada, mod);
  for (int b = 0; b < BATCH; ++b) {
    n_hnorm<<<SEQ, 256, 0, stream>>>(x, g_pre_mix, mod, b, 0, 1024, hb);
    n_gemm<false><<<dim3((INW + 63) / 64, SEQ / 64), 256, 0, stream>>>(hb, DM, w_in, INW, projb, INW, SEQ, INW, DM);
    n_rms_slice<<<SEQ, 256, 0, stream>>>(projb, INW, O_CQ, 384, g_q_lat, cqn);
    n_rms_slice<<<SEQ, 256, 0, stream>>>(projb, INW, O_CKV, 256, g_kv_lat, ckvn);
    n_gemm<false><<<dim3(768 / 64, SEQ / 64), 256, 0, stream>>>(cqn, 384, w_q_up, 768, qa, 768, SEQ, 768, 384);
    n_gemm<false><<<dim3(1024 / 64, SEQ / 64), 256, 0, stream>>>(ckvn, 256, w_kv_up, 1024, kvb, 1024, SEQ, 1024, 256);
    n_scatter<<<SEQ, 256, 0, stream>>>(projb, qa, kvb, positions, b, wgf, bgf, wgb, bgb, Qm, Km, Vm, qg, kg, vg, rg, laf, lab);
  }
  n_attn<<<dim3(SEQ, 4, BATCH), 256, 0, stream>>>(Qm, Km, Vm, omla);
  n_gla<<<32, 128, 0, stream>>>(qg, kg, vg, laf, lab, og);
  for (int b = 0; b < BATCH; ++b) {
    n_mix<<<SEQ, 256, 0, stream>>>(omla, og, rg, g_gla, b, mix);
    n_gemm<false><<<dim3(1024 / 64, SEQ / 64), 256, 0, stream>>>(mix, DM, w_out, DM, yb, DM, SEQ, DM, DM);
    n_post1<<<SEQ, 256, 0, stream>>>(x, yb, g_post_mix, g_pre_ffn, mod, b, out, h2);
    n_gemm<false><<<dim3(2048 / 64, SEQ / 64), 256, 0, stream>>>(h2, DM, w_peer_q, 2048, qry, 2048, SEQ, 2048, DM);
    n_peer_select<<<SEQ * 8 / 4, 256, 0, stream>>>(qry, sk1, sk2, eidx, gatev);
    n_peer_apply<<<SEQ, 256, 0, stream>>>(h2, eidx, gatev, eu, ev, g_post_ffn, mod, b, out);
  }
}
```

```cpp
#include <hip/hip_runtime.h>
#include <stdint.h>

typedef unsigned short bf16_t;
#define DI __device__ __forceinline__

DI float bf2f(bf16_t v) { return __uint_as_float(((unsigned)v) << 16); }
DI bf16_t f2bf(float f) { unsigned u = __float_as_uint(f); u += 0x7fffu + ((u >> 16) & 1u); return (bf16_t)(u >> 16); }

constexpr int BATCH = 8, SEQ = 2048, DM = 1024, NTOK = BATCH * SEQ;
constexpr int INW = 2272;
constexpr float EPS = 1e-6f;
constexpr int O_CQ = 0, O_CKV = 384, O_KR = 640, O_QG = 704, O_KG = 960, O_VG = 1216, O_GF = 1728, O_GB = 1744, O_R = 1760;

DI float wave_sum(float v) {
#pragma unroll
  for (int o = 1; o < 64; o <<= 1) v += __shfl_xor(v, o);
  return v;
}
DI float wave_max(float v) {
#pragma unroll
  for (int o = 1; o < 64; o <<= 1) v = fmaxf(v, __shfl_xor(v, o));
  return v;
}
DI float block_sum256(float v, float* red) {
  v = wave_sum(v);
  __syncthreads();
  if ((threadIdx.x & 63) == 0) red[threadIdx.x >> 6] = v;
  __syncthreads();
  return red[0] + red[1] + red[2] + red[3];
}
DI float block_max256(float v, float* red) {
  v = wave_max(v);
  __syncthreads();
  if ((threadIdx.x & 63) == 0) red[threadIdx.x >> 6] = v;
  __syncthreads();
  return fmaxf(fmaxf(red[0], red[1]), fmaxf(red[2], red[3]));
}
DI float silu_f(float x) { return x / (1.f + expf(-x)); }
DI float logsigmoid_f(float x) { return fminf(x, 0.f) - log1pf(expf(-fabsf(x))); }
DI float gelu_erf(float x) { return 0.5f * x * (1.f + erff(x * 0.70710678118654752f)); }

__global__ __launch_bounds__(256) void n_mod(const float* __restrict__ c, const float* __restrict__ w_ada, const float* __restrict__ b_ada, float* __restrict__ mod) {
  int idx = blockIdx.x * 256 + threadIdx.x;
  int b = idx / 6144, j = idx % 6144;
  float acc = b_ada[j];
  for (int k = 0; k < 1024; ++k) acc += silu_f(c[b * 1024 + k]) * w_ada[(size_t)k * 6144 + j];
  mod[idx] = acc;
}

__global__ __launch_bounds__(256) void n_hnorm(const float* __restrict__ x, const float* __restrict__ g, const float* __restrict__ mod, int b, int off_sh, int off_sc, float* __restrict__ h) {
  __shared__ float red[4];
  int t = blockIdx.x, tid = threadIdx.x;
  const float* xr = x + ((size_t)b * SEQ + t) * DM;
  float v[4]; float ss = 0.f;
#pragma unroll
  for (int i = 0; i < 4; ++i) { v[i] = xr[tid + 256 * i]; ss += v[i] * v[i]; }
  ss = block_sum256(ss, red);
  float rs = rsqrtf(ss * (1.f / DM) + EPS);
#pragma unroll
  for (int i = 0; i < 4; ++i) { int d = tid + 256 * i; h[(size_t)t * DM + d] = v[i] * rs * g[d] * (1.f + mod[b * 6144 + off_sc + d]) + mod[b * 6144 + off_sh + d]; }
}

template <bool BT>
__global__ __launch_bounds__(256) void n_gemm(const float* __restrict__ A, int lda, const float* __restrict__ B, int ldb, float* __restrict__ C, int ldc, int M, int N, int K) {
  __shared__ float As[16][65];
  __shared__ float Bs[16][65];
  const int tid = threadIdx.x, tx = tid & 15, ty = tid >> 4;
  const int m0 = blockIdx.y * 64, n0 = blockIdx.x * 64;
  float acc[4][4];
#pragma unroll
  for (int i = 0; i < 4; ++i)
#pragma unroll
    for (int j = 0; j < 4; ++j) acc[i][j] = 0.f;
  for (int k0 = 0; k0 < K; k0 += 16) {
#pragma unroll
    for (int i = 0; i < 4; ++i) { int e = tid + 256 * i; int m = e >> 4, k = e & 15; As[k][m] = A[(size_t)(m0 + m) * lda + k0 + k]; }
#pragma unroll
    for (int i = 0; i < 4; ++i) { int e = tid + 256 * i;
      if (!BT) { int k = e >> 6, n = e & 63; Bs[k][n] = (n0 + n < N) ? B[(size_t)(k0 + k) * ldb + n0 + n] : 0.f; }
      else     { int n = e >> 4, k = e & 15; Bs[k][n] = (n0 + n < N) ? B[(size_t)(n0 + n) * ldb + k0 + k] : 0.f; } }
    __syncthreads();
#pragma unroll
    for (int k = 0; k < 16; ++k) {
      float a[4], bb[4];
#pragma unroll
      for (int i = 0; i < 4; ++i) { a[i] = As[k][ty * 4 + i]; bb[i] = Bs[k][tx * 4 + i]; }
#pragma unroll
      for (int i = 0; i < 4; ++i)
#pragma unroll
        for (int j = 0; j < 4; ++j) acc[i][j] += a[i] * bb[j];
    }
    __syncthreads();
  }
#pragma unroll
  for (int i = 0; i < 4; ++i)
#pragma unroll
    for (int j = 0; j < 4; ++j) { int n = n0 + tx * 4 + j; if (n < N) C[(size_t)(m0 + ty * 4 + i) * ldc + n] = acc[i][j]; }
}

__global__ __launch_bounds__(256) void n_rms_slice(const float* __restrict__ in, int ldin, int off, int W, const float* __restrict__ g, float* __restrict__ out) {
  __shared__ float red[4];
  int t = blockIdx.x, tid = threadIdx.x;
  float v0 = (tid < W) ? in[(size_t)t * ldin + off + tid] : 0.f;
  float v1 = (tid + 256 < W) ? in[(size_t)t * ldin + off + tid + 256] : 0.f;
  float ss = block_sum256(v0 * v0 + v1 * v1, red);
  float rs = rsqrtf(ss / (float)W + EPS);
  if (tid < W) out[(size_t)t * W + tid] = v0 * rs * g[tid];
  if (tid + 256 < W) out[(size_t)t * W + tid + 256] = v1 * rs * g[tid + 256];
}

__global__ __launch_bounds__(256) void n_scatter(const float* __restrict__ proj, const float* __restrict__ qa, const float* __restrict__ kv, const int* __restrict__ positions, int b,
                                                 const float* __restrict__ wgf, const float* __restrict__ bgf, const float* __restrict__ wgb, const float* __restrict__ bgb,
                                                 bf16_t* __restrict__ Qm, bf16_t* __restrict__ Km, bf16_t* __restrict__ Vm, bf16_t* __restrict__ qg, bf16_t* __restrict__ kg, bf16_t* __restrict__ vg,
                                                 bf16_t* __restrict__ rg, float* __restrict__ laf, float* __restrict__ lab) {
  __shared__ float cs[32], sn[32];
  const int t = blockIdx.x, tid = threadIdx.x;
  const size_t tok = (size_t)b * SEQ + t;
  const float* pr = proj + (size_t)t * INW;
  const float* qr = qa + (size_t)t * 768;
  const float* kr = kv + (size_t)t * 1024;
  if (tid < 32) {
    float inv = powf(10000.f, -(float)tid / 32.f);
    float ang = (float)positions[tok] * inv;
    cs[tid] = cosf(ang); sn[tid] = sinf(ang);
  }
  __syncthreads();
  for (int e = tid; e < 4 * 192; e += 256) {
    int h = e / 192, d = e % 192; float v;
    if (d < 128) v = qr[h * 192 + d];
    else { int j = d - 128; const float* rp = qr + h * 192 + 128;
      if (j < 32) v = rp[j] * cs[j] - rp[j + 32] * sn[j]; else v = rp[j] * cs[j - 32] + rp[j - 32] * sn[j - 32]; }
    Qm[(((size_t)b * 4 + h) * SEQ + t) * 192 + d] = f2bf(v);
  }
  for (int e = tid; e < 4 * 192; e += 256) {
    int h = e / 192, d = e % 192; float v;
    if (d < 128) v = kr[h * 256 + d];
    else { int j = d - 128; const float* rp = pr + O_KR;
      if (j < 32) v = rp[j] * cs[j] - rp[j + 32] * sn[j]; else v = rp[j] * cs[j - 32] + rp[j - 32] * sn[j - 32]; }
    Km[(((size_t)b * 4 + h) * SEQ + t) * 192 + d] = f2bf(v);
  }
  for (int e = tid; e < 512; e += 256) { int h = e >> 7, d = e & 127; Vm[(((size_t)b * 4 + h) * SEQ + t) * 128 + d] = f2bf(kr[h * 256 + 128 + d]); }
  { int e = tid; qg[tok * 256 + e] = f2bf(pr[O_QG + e] * 0.125f); kg[tok * 256 + e] = f2bf(pr[O_KG + e]); }
  for (int e = tid; e < 512; e += 256) { vg[tok * 512 + e] = f2bf(pr[O_VG + e]); rg[tok * 512 + e] = f2bf(pr[O_R + e]); }
  { int cidx = tid; float af = bgf[cidx], ab = bgb[cidx];
#pragma unroll
    for (int r = 0; r < 16; ++r) { af += pr[O_GF + r] * wgf[r * 256 + cidx]; ab += pr[O_GB + r] * wgb[r * 256 + cidx]; }
    laf[tok * 256 + cidx] = logsigmoid_f(af) * (1.f / 16.f); lab[tok * 256 + cidx] = logsigmoid_f(ab) * (1.f / 16.f); }
}

__global__ __launch_bounds__(256) void n_attn(const bf16_t* __restrict__ Qm, const bf16_t* __restrict__ Km, const bf16_t* __restrict__ Vm, bf16_t* __restrict__ omla) {
  __shared__ float qs[192]; __shared__ float sc[2048]; __shared__ float red[4];
  const int i = blockIdx.x, h = blockIdx.y, b = blockIdx.z, tid = threadIdx.x;
  const size_t bh = (size_t)b * 4 + h;
  if (tid < 192) qs[tid] = bf2f(Qm[(bh * SEQ + i) * 192 + tid]);
  __syncthreads();
  float mx = -1e30f;
  for (int kk = 0; kk < 8; ++kk) {
    int key = tid + 256 * kk; const uint4* kr = (const uint4*)(Km + (bh * SEQ + key) * 192);
    float s = 0.f;
    for (int c = 0; c < 24; ++c) { uint4 w = kr[c]; const float* q = qs + c * 8;
      s += q[0] * __uint_as_float(w.x << 16) + q[1] * __uint_as_float(w.x & 0xffff0000u) + q[2] * __uint_as_float(w.y << 16) + q[3] * __uint_as_float(w.y & 0xffff0000u)
         + q[4] * __uint_as_float(w.z << 16) + q[5] * __uint_as_float(w.z & 0xffff0000u) + q[6] * __uint_as_float(w.w << 16) + q[7] * __uint_as_float(w.w & 0xffff0000u); }
    s *= 0.07216878364870322f; sc[key] = s; mx = fmaxf(mx, s);
  }
  mx = block_max256(mx, red);
  float sum = 0.f;
  for (int kk = 0; kk < 8; ++kk) { int key = tid + 256 * kk; float p = expf(sc[key] - mx); sc[key] = p; sum += p; }
  sum = block_sum256(sum, red);
  __syncthreads();
  if (tid < 128) { float o = 0.f; const bf16_t* vp = Vm + bh * SEQ * 128 + tid;
    for (int key = 0; key < SEQ; ++key) o += sc[key] * bf2f(vp[(size_t)key * 128]);
    omla[((size_t)b * SEQ + i) * 512 + h * 128 + tid] = f2bf(o / sum); }
}

__global__ __launch_bounds__(128) void n_gla(const bf16_t* __restrict__ qg, const bf16_t* __restrict__ kg, const bf16_t* __restrict__ vg, const float* __restrict__ laf, const float* __restrict__ lab, float* __restrict__ og) {
  __shared__ float qs[64], ks[64], as[64];
  const int bh = blockIdx.x, b = bh >> 2, h = bh & 3, dv = threadIdx.x;
  for (int dir = 0; dir < 2; ++dir) {
    float S[64];
#pragma unroll
    for (int d = 0; d < 64; ++d) S[d] = 0.f;
    const float* la = dir ? lab : laf;
    for (int s = 0; s < SEQ; ++s) {
      const int t = dir ? (SEQ - 1 - s) : s; const size_t tok = (size_t)b * SEQ + t;
      __syncthreads();
      if (dv < 64) { qs[dv] = bf2f(qg[tok * 256 + h * 64 + dv]); ks[dv] = bf2f(kg[tok * 256 + h * 64 + dv]); as[dv] = expf(la[tok * 256 + h * 64 + dv]); }
      __syncthreads();
      const float v = bf2f(vg[tok * 512 + h * 128 + dv]); float o = 0.f;
#pragma unroll
      for (int d = 0; d < 64; ++d) { S[d] = as[d] * S[d] + ks[d] * v; o += qs[d] * S[d]; }
      if (dir == 0) og[tok * 512 + h * 128 + dv] = o; else og[tok * 512 + h * 128 + dv] += o;
    }
  }
}

__global__ __launch_bounds__(256) void n_mix(const bf16_t* __restrict__ omla, const float* __restrict__ og, const bf16_t* __restrict__ rg, const float* __restrict__ g_gla, int b, float* __restrict__ mix) {
  __shared__ float ssum[4];
  const int t = blockIdx.x, tid = threadIdx.x; const size_t tok = (size_t)b * SEQ + t;
  if (tid < 4) ssum[tid] = 0.f;
  __syncthreads();
  float v[2];
#pragma unroll
  for (int i = 0; i < 2; ++i) { int e = tid + 256 * i; v[i] = og[tok * 512 + e]; atomicAdd(&ssum[e >> 7], v[i] * v[i]); mix[(size_t)t * DM + e] = bf2f(omla[tok * 512 + e]); }
  __syncthreads();
#pragma unroll
  for (int i = 0; i < 2; ++i) { int e = tid + 256 * i; float rs = rsqrtf(ssum[e >> 7] * (1.f / 128.f) + EPS);
    mix[(size_t)t * DM + 512 + e] = v[i] * rs * g_gla[e & 127] * silu_f(bf2f(rg[tok * 512 + e])); }
}

__global__ __launch_bounds__(256) void n_post1(const float* __restrict__ x, const float* __restrict__ y, const float* __restrict__ g_post, const float* __restrict__ g_pre2, const float* __restrict__ mod, int b,
                                               float* __restrict__ out, float* __restrict__ h2) {
  __shared__ float red[4];
  const int t = blockIdx.x, tid = threadIdx.x; const size_t tok = (size_t)b * SEQ + t;
  float yv[4], xv[4]; float ss = 0.f;
#pragma unroll
  for (int i = 0; i < 4; ++i) { yv[i] = y[(size_t)t * DM + tid + 256 * i]; ss += yv[i] * yv[i]; }
  ss = block_sum256(ss, red);
  float rs = rsqrtf(ss * (1.f / DM) + EPS); float s2 = 0.f;
#pragma unroll
  for (int i = 0; i < 4; ++i) { int d = tid + 256 * i; xv[i] = x[tok * DM + d] + mod[b * 6144 + 2048 + d] * (yv[i] * rs * g_post[d]); out[tok * DM + d] = xv[i]; s2 += xv[i] * xv[i]; }
  s2 = block_sum256(s2, red);
  float r2 = rsqrtf(s2 * (1.f / DM) + EPS);
#pragma unroll
  for (int i = 0; i < 4; ++i) { int d = tid + 256 * i; h2[(size_t)t * DM + d] = xv[i] * r2 * g_pre2[d] * (1.f + mod[b * 6144 + 4096 + d]) + mod[b * 6144 + 3072 + d]; }
}

DI void wave_argmax(float& v, int& i) {
#pragma unroll
  for (int o = 1; o < 64; o <<= 1) { float ov = __shfl_xor(v, o); int oi = __shfl_xor(i, o); if (ov > v || (ov == v && oi < i)) { v = ov; i = oi; } }
}
__global__ __launch_bounds__(256) void n_peer_select(const float* __restrict__ qry, const float* __restrict__ sk1, const float* __restrict__ sk2, int* __restrict__ eidx, float* __restrict__ gate) {
  __shared__ float v1s[4][16], v2s[4][16]; __shared__ int i1s[4][16], i2s[4][16];
  const int w = threadIdx.x >> 6, lane = threadIdx.x & 63;
  const int pair = blockIdx.x * 4 + w;
  const int t = pair >> 3, h = pair & 7;
  const float* q1 = qry + (size_t)t * 2048 + h * 256; const float* q2 = q1 + 128;
  float s1a = 0.f, s1b = 0.f, s2a = 0.f, s2b = 0.f;
  for (int d = 0; d < 128; ++d) { float a = q1[d], bq = q2[d];
    s1a += a * sk1[lane * 128 + d]; s1b += a * sk1[(lane + 64) * 128 + d]; s2a += bq * sk2[lane * 128 + d]; s2b += bq * sk2[(lane + 64) * 128 + d]; }
  for (int side = 0; side < 2; ++side) {
    float va = side ? s2a : s1a, vb = side ? s2b : s1b; bool ta = false, tb = false;
    for (int k = 0; k < 16; ++k) {
      float bv; int bi;
      if (!ta && (tb || va >= vb)) { bv = va; bi = lane; } else if (!tb) { bv = vb; bi = lane + 64; } else { bv = -3e38f; bi = 1 << 20; }
      wave_argmax(bv, bi);
      if (bi == lane) ta = true; if (bi == lane + 64) tb = true;
      if (lane == 0) { if (side) { v2s[w][k] = bv; i2s[w][k] = bi; } else { v1s[w][k] = bv; i1s[w][k] = bi; } }
    }
  }
  __syncthreads();
  float cv[4]; bool tk[4];
#pragma unroll
  for (int j = 0; j < 4; ++j) { int c = lane + 64 * j; cv[j] = v1s[w][c >> 4] + v2s[w][c & 15]; tk[j] = false; }
  float topv = 0.f; int topc = 0; float mx = 0.f;
  for (int k = 0; k < 16; ++k) {
    float bv = -3e38f; int bi = 1 << 20;
#pragma unroll
    for (int j = 0; j < 4; ++j) { if (!tk[j] && cv[j] > bv) { bv = cv[j]; bi = lane + 64 * j; } }
    wave_argmax(bv, bi);
#pragma unroll
    for (int j = 0; j < 4; ++j) if (bi == lane + 64 * j) tk[j] = true;
    if (k == 0) mx = bv;
    if (lane == k) { topv = bv; topc = bi; }
  }
  float e = (lane < 16) ? expf(topv - mx) : 0.f;
  float sum = wave_sum(e);
  if (lane < 16) { eidx[(size_t)pair * 16 + lane] = i1s[w][topc >> 4] * 128 + i2s[w][topc & 15]; gate[(size_t)pair * 16 + lane] = e / sum; }
}

__global__ __launch_bounds__(256) void n_peer_apply(const float* __restrict__ h2, const int* __restrict__ eidx, const float* __restrict__ gate, const float* __restrict__ eu, const float* __restrict__ ev,
                                                    const float* __restrict__ g_post, const float* __restrict__ mod, int b, float* __restrict__ out) {
  __shared__ float ys[4][1024]; __shared__ float red[4];
  const int t = blockIdx.x, tid = threadIdx.x, w = tid >> 6, lane = tid & 63; const size_t tok = (size_t)b * SEQ + t;
  float4 hx[4];
#pragma unroll
  for (int i = 0; i < 4; ++i) hx[i] = *(const float4*)(h2 + (size_t)t * DM + (lane + 64 * i) * 4);
  float4 acc[4];
#pragma unroll
  for (int i = 0; i < 4; ++i) acc[i] = make_float4(0.f, 0.f, 0.f, 0.f);
  for (int k = w; k < 128; k += 4) {
    const int e = eidx[(size_t)t * 128 + k]; const float gt = gate[(size_t)t * 128 + k];
    const float4* ur = (const float4*)(eu + (size_t)e * DM); const float4* vr = (const float4*)(ev + (size_t)e * DM);
    float d = 0.f;
#pragma unroll
    for (int i = 0; i < 4; ++i) { float4 u = ur[lane + 64 * i]; d += u.x * hx[i].x + u.y * hx[i].y + u.z * hx[i].z + u.w * hx[i].w; }
    d = wave_sum(d);
    const float wgt = gt * gelu_erf(d);
#pragma unroll
    for (int i = 0; i < 4; ++i) { float4 v = vr[lane + 64 * i]; acc[i].x += wgt * v.x; acc[i].y += wgt * v.y; acc[i].z += wgt * v.z; acc[i].w += wgt * v.w; }
  }
#pragma unroll
  for (int i = 0; i < 4; ++i) *(float4*)(&ys[w][(lane + 64 * i) * 4]) = acc[i];
  __syncthreads();
  float yv[4]; float ss = 0.f;
#pragma unroll
  for (int i = 0; i < 4; ++i) { int d = tid + 256 * i; yv[i] = ys[0][d] + ys[1][d] + ys[2][d] + ys[3][d]; ss += yv[i] * yv[i]; }
  ss = block_sum256(ss, red);
  const float rs = rsqrtf(ss * (1.f / DM) + EPS);
#pragma unroll
  for (int i = 0; i < 4; ++i) { int d = tid + 256 * i; out[tok * DM + d] = out[tok * DM + d] + mod[b * 6144 + 5120 + d] * (yv[i] * rs * g_post[d]); }
}

typedef short bf16x8 __attribute__((ext_vector_type(8)));
typedef float f32x16 __attribute__((ext_vector_type(16)));
#define MFMA32(a, b, c) __builtin_amdgcn_mfma_f32_32x32x16_bf16((a), (b), (c), 0, 0, 0)

constexpr int NTHR = 512;
constexpr size_t MiB = 1024 * 1024;
constexpr size_t WS_MOD   = 0;
constexpr size_t WS_WTIN  = 256 * 1024;
constexpr size_t WS_WTQUP = WS_WTIN + (size_t)2304 * 1024 * 2;
constexpr size_t WS_WTKVUP = WS_WTQUP + (size_t)768 * 384 * 2;
constexpr size_t WS_WTOUT = WS_WTKVUP + (size_t)1024 * 256 * 2;
constexpr size_t WS_WTPQ  = WS_WTOUT + (size_t)1024 * 1024 * 2;
constexpr size_t WS_KD    = WS_WTPQ + (size_t)2048 * 1024 * 2;
constexpr size_t WS_R0END = WS_KD + (size_t)256 * 256 * 2;
static_assert(WS_R0END <= 13 * MiB, "R0");
constexpr size_t WS_QM   = 13 * MiB;
constexpr size_t WS_KM   = WS_QM + 24 * MiB;
constexpr size_t WS_VM   = WS_KM + 24 * MiB;
constexpr size_t WS_QG   = WS_VM + 16 * MiB;
constexpr size_t WS_KG   = WS_QG + 8 * MiB;
constexpr size_t WS_VG   = WS_KG + 8 * MiB;
constexpr size_t WS_RG   = WS_VG + 16 * MiB;
constexpr size_t WS_LAF  = WS_RG + 16 * MiB;
constexpr size_t WS_LAB  = WS_LAF + 16 * MiB;
constexpr size_t WS_OMLA = WS_LAB + 16 * MiB;
constexpr size_t WS_OG   = WS_OMLA + 16 * MiB;
constexpr size_t WS_END  = WS_OG + 32 * MiB;
constexpr size_t WS_CQ   = WS_OMLA;
constexpr size_t OUT_HS  = 0;
constexpr size_t OUT_CQN = 32 * MiB;
constexpr size_t OUT_CKVN = 44 * MiB;
constexpr size_t OUT_GR  = 52 * MiB;
constexpr size_t WS_NP3  = WS_QM;

struct KP { const float* in[25]; float* out; unsigned char* ws; int ph_lo, ph_hi; };

constexpr int G_STRIDE = 144;
constexpr int G_ABYTES = 64 * G_STRIDE;
constexpr int G_BBYTES = 256 * G_STRIDE;
constexpr int G_STAGE = G_ABYTES + G_BBYTES;
constexpr int LDS_GEMM = 2 * G_STAGE;
constexpr int LDS_TAB = LDS_GEMM;
constexpr int LDS_TOTAL = LDS_TAB + 16384;

DI unsigned pack2(float lo, float hi) { return (unsigned)f2bf(lo) | ((unsigned)f2bf(hi) << 16); }
DI int crow(int reg, int hh) { return (reg & 3) + 8 * (reg >> 2) + 4 * hh; }

template <class Epi>
DI void block_gemm(char* lds, const bf16_t* A, int lda, const bf16_t* Bt, int ldb, int nchunks, int K, Epi&& epi) {
  const int tid = threadIdx.x, lane = tid & 63, w = tid >> 6, wm = w >> 2, wn = w & 3, r = lane & 31, hh = lane >> 5;
  const int nk = K >> 6;
  const int srow = tid >> 3, skc = tid & 7;
  const int st_off = srow * G_STRIDE + skc * 16;
  const int a_rd = (wm * 32 + r) * G_STRIDE + hh * 16;
  const int b_rd = G_ABYTES + (wn * 64 + r) * G_STRIDE + hh * 16;
  for (int ch = 0; ch < nchunks; ++ch) {
    const bf16_t* Ab = A + (size_t)srow * lda + skc * 8;
    const bf16_t* Bb = Bt + (size_t)(ch * 256 + srow) * ldb + skc * 8;
    f32x16 acc0, acc1;
#pragma unroll
    for (int i = 0; i < 16; ++i) { acc0[i] = 0.f; acc1[i] = 0.f; }
    uint4 ra, rb0, rb1, rb2, rb3;
    ra = *(const uint4*)Ab; rb0 = *(const uint4*)Bb; rb1 = *(const uint4*)(Bb + (size_t)64 * ldb); rb2 = *(const uint4*)(Bb + (size_t)128 * ldb); rb3 = *(const uint4*)(Bb + (size_t)192 * ldb);
    {
      char* nb = lds;
      *(uint4*)(nb + st_off) = ra;
      *(uint4*)(nb + G_ABYTES + st_off) = rb0; *(uint4*)(nb + G_ABYTES + 64 * G_STRIDE + st_off) = rb1;
      *(uint4*)(nb + G_ABYTES + 128 * G_STRIDE + st_off) = rb2; *(uint4*)(nb + G_ABYTES + 192 * G_STRIDE + st_off) = rb3;
    }
    __syncthreads();
    for (int t = 0; t < nk; ++t) {
      const char* cur = lds + (t & 1) * G_STAGE; char* nb = lds + ((t + 1) & 1) * G_STAGE;
      const bool more = (t + 1 < nk);
      if (more) { const int ko = (t + 1) * 64;
        ra = *(const uint4*)(Ab + ko); rb0 = *(const uint4*)(Bb + ko); rb1 = *(const uint4*)(Bb + (size_t)64 * ldb + ko);
        rb2 = *(const uint4*)(Bb + (size_t)128 * ldb + ko); rb3 = *(const uint4*)(Bb + (size_t)192 * ldb + ko); }
#pragma unroll
      for (int s = 0; s < 4; ++s) {
        const bf16x8 a = *(const bf16x8*)(cur + a_rd + s * 32);
        const bf16x8 b0 = *(const bf16x8*)(cur + b_rd + s * 32);
        const bf16x8 b1 = *(const bf16x8*)(cur + b_rd + 32 * G_STRIDE + s * 32);
        acc0 = MFMA32(a, b0, acc0); acc1 = MFMA32(a, b1, acc1);
      }
      if (more) {
        *(uint4*)(nb + st_off) = ra;
        *(uint4*)(nb + G_ABYTES + st_off) = rb0; *(uint4*)(nb + G_ABYTES + 64 * G_STRIDE + st_off) = rb1;
        *(uint4*)(nb + G_ABYTES + 128 * G_STRIDE + st_off) = rb2; *(uint4*)(nb + G_ABYTES + 192 * G_STRIDE + st_off) = rb3;
      }
      __syncthreads();
    }
    epi(wm * 32, ch * 256 + wn * 64, acc0, acc1);
    __syncthreads();
  }
}

DI void p0_transpose(char* lds, const float* __restrict__ W, int K, int N, bf16_t* __restrict__ Wt, int item) {
  float* s = (float*)lds;
  const int tid = threadIdx.x;
  const int ntn = (N + 63) >> 6, kt = item / ntn, nt = item % ntn, k0 = kt * 64, n0 = nt * 64;
  __syncthreads();
#pragma unroll
  for (int i = 0; i < 8; ++i) { int e = tid + 512 * i; int kk = e >> 6, nn = e & 63; s[kk * 65 + nn] = (n0 + nn < N) ? W[(size_t)(k0 + kk) * N + n0 + nn] : 0.f; }
  __syncthreads();
  const int nn = tid >> 3, part = tid & 7;
  const float* sp = s + (part * 8) * 65 + nn;
  uint4 o; o.x = pack2(sp[0], sp[65]); o.y = pack2(sp[2 * 65], sp[3 * 65]); o.z = pack2(sp[4 * 65], sp[5 * 65]); o.w = pack2(sp[6 * 65], sp[7 * 65]);
  *(uint4*)(Wt + (size_t)(n0 + nn) * K + k0 + part * 8) = o;
}

DI void phase0(const KP& p, char* lds) {
  const int tid = threadIdx.x, bid = blockIdx.x, nb = gridDim.x;
  unsigned char* ws = p.ws;
  constexpr int I_IN = 16 * 36, I_QUP = 6 * 12, I_KVUP = 4 * 16, I_OUT = 16 * 16, I_PQ = 16 * 32;
  constexpr int I_ALL = I_IN + I_QUP + I_KVUP + I_OUT + I_PQ;
  for (int it = bid; it < I_ALL; it += nb) {
    int q = it;
    if (q < I_IN) { p0_transpose(lds, p.in[7], 1024, 2272, (bf16_t*)(ws + WS_WTIN), q); continue; } q -= I_IN;
    if (q < I_QUP) { p0_transpose(lds, p.in[9], 384, 768, (bf16_t*)(ws + WS_WTQUP), q); continue; } q -= I_QUP;
    if (q < I_KVUP) { p0_transpose(lds, p.in[11], 256, 1024, (bf16_t*)(ws + WS_WTKVUP), q); continue; } q -= I_KVUP;
    if (q < I_OUT) { p0_transpose(lds, p.in[17], 1024, 1024, (bf16_t*)(ws + WS_WTOUT), q); continue; } q -= I_OUT;
    p0_transpose(lds, p.in[20], 1024, 2048, (bf16_t*)(ws + WS_WTPQ), q);
  }
  { bf16_t* kd = (bf16_t*)(ws + WS_KD);
    for (int e = bid * NTHR + tid; e < 65536; e += nb * NTHR) { int n = e >> 8, k = e & 255; float v = 0.f;
      if (n < 128 && k < 128) v = p.in[21][n * 128 + k]; else if (n >= 128 && k >= 128) v = p.in[22][(n - 128) * 128 + (k - 128)];
      kd[e] = f2bf(v); } }
  for (int jb = bid; jb < 96; jb += nb) {
    __syncthreads();
    float* cact = (float*)lds;
    float* red = (float*)(lds + 32768);
    for (int e = tid; e < 8192; e += NTHR) cact[e] = silu_f(p.in[1][e]);
    __syncthreads();
    const int jj = tid & 63, ks = tid >> 6, j0 = jb * 64;
    float acc[8];
#pragma unroll
    for (int b = 0; b < 8; ++b) acc[b] = 0.f;
    const float* wp = p.in[3] + (size_t)(ks * 128) * 6144 + j0 + jj;
    for (int k = 0; k < 128; ++k) { const float wv = wp[(size_t)k * 6144];
#pragma unroll
      for (int b = 0; b < 8; ++b) acc[b] += cact[b * 1024 + ks * 128 + k] * wv; }
#pragma unroll
    for (int b = 0; b < 8; ++b) red[(ks * 64 + jj) * 8 + b] = acc[b];
    __syncthreads();
    { const int b = tid >> 6; float sacc = p.in[4][j0 + jj];
#pragma unroll
      for (int k2 = 0; k2 < 8; ++k2) sacc += red[(k2 * 64 + jj) * 8 + b];
      ((float*)(ws + WS_MOD))[b * 6144 + j0 + jj] = sacc; }
  }
}

constexpr int WT_STRIDE = 144, WT_BYTES = 32 * WT_STRIDE;
DI void wt_write(char* wl, const f32x16& a0, const f32x16& a1, int r, int hh, float scale) {
  char* bp = wl + (4 * hh) * WT_STRIDE + r * 2;
#pragma unroll
  for (int reg = 0; reg < 16; ++reg) { const int ro = ((reg & 3) + 8 * (reg >> 2)) * WT_STRIDE;
    *(bf16_t*)(bp + ro) = f2bf(a0[reg] * scale); *(bf16_t*)(bp + ro + 64) = f2bf(a1[reg] * scale); }
}
DI void wt_write_rope(char* wl, const f32x16& a0, const f32x16& a1, int r, int hh, const float* cs, const float* sn, int m0) {
  char* bp = wl + (4 * hh) * WT_STRIDE + r * 2;
#pragma unroll
  for (int reg = 0; reg < 16; ++reg) { const int rw = (reg & 3) + 8 * (reg >> 2); const int row = m0 + rw + 4 * hh;
    const float c = cs[row * 32 + r], s = sn[row * 32 + r];
    *(bf16_t*)(bp + rw * WT_STRIDE) = f2bf(a0[reg] * c - a1[reg] * s); *(bf16_t*)(bp + rw * WT_STRIDE + 64) = f2bf(a1[reg] * c + a0[reg] * s); }
}
DI void wt_store(const char* wl, int lane, bf16_t* dA, int sA, bf16_t* dB, int sB) {
  const int piece = lane & 7, rsub = lane >> 3;
  bf16_t* d = (piece < 4) ? dA : dB; const int st = (piece < 4) ? sA : sB;
  if (d) {
#pragma unroll
    for (int i = 0; i < 4; ++i) { const int row = i * 8 + rsub; const uint4 v = *(const uint4*)(wl + row * WT_STRIDE + piece * 16);
      *(uint4*)(d + (size_t)row * st + (piece & 3) * 8) = v; }
  }
}
#define LDS_FENCE() asm volatile("s_waitcnt lgkmcnt(0)" ::: "memory")
DI int lv(int x) { asm volatile("" : "+v"(x)); return x; }
template <class T> DI T* launder(T* q) { asm volatile("" : "+s"(q)); return q; }

DI void phase1(const KP& p, char* lds) {
  const int tid = threadIdx.x, lane = tid & 63, w = tid >> 6, r = lane & 31, hh = lane >> 5;
  unsigned char* ws = p.ws; unsigned char* ob = (unsigned char*)p.out;
  const float* mod = (const float*)(ws + WS_MOD);
  float* cs = (float*)(lds + LDS_TAB); float* sn = cs + 2048;
  char* wl = lds + w * WT_BYTES;
  for (int tile = blockIdx.x; tile < 256; tile += gridDim.x) {
    const int tok0 = tile * 64, b = tile >> 5, t0 = (tile & 31) * 64;
    bf16_t* Hs = (bf16_t*)(ob + OUT_HS) + (size_t)tok0 * 1024;
    bf16_t* CQ = (bf16_t*)(ws + WS_CQ) + (size_t)tok0 * 640;
    bf16_t* CQN = (bf16_t*)(ob + OUT_CQN) + (size_t)tok0 * 384;
    bf16_t* CKVN = (bf16_t*)(ob + OUT_CKVN) + (size_t)tok0 * 256;
    bf16_t* GR = (bf16_t*)(ob + OUT_GR) + (size_t)tok0 * 32;
    bf16_t* Qm = (bf16_t*)(ws + WS_QM); bf16_t* Km = (bf16_t*)(ws + WS_KM); bf16_t* Vm = (bf16_t*)(ws + WS_VM);
    bf16_t* qg = (bf16_t*)(ws + WS_QG) + (size_t)tok0 * 256; bf16_t* kg = (bf16_t*)(ws + WS_KG) + (size_t)tok0 * 256;
    bf16_t* vg = (bf16_t*)(ws + WS_VG) + (size_t)tok0 * 512; bf16_t* rg = (bf16_t*)(ws + WS_RG) + (size_t)tok0 * 512;
    float* laf = (float*)(ws + WS_LAF) + (size_t)tok0 * 256; float* lab = (float*)(ws + WS_LAB) + (size_t)tok0 * 256;
    __syncthreads();
#pragma unroll
    for (int i = 0; i < 4; ++i) { const int e = tid + 512 * i, tt = e >> 5, j = e & 31;
      const float inv = powf(10000.f, -(float)j * (1.f / 32.f)); const float ang = (float)((const int*)p.in[2])[tok0 + tt] * inv;
      cs[e] = cosf(ang); sn[e] = sinf(ang); }
    {
      float4 ge[4], sh[4];
      const float* gpre = launder(p.in[5]); const float* modb = launder(mod) + b * 6144;
#pragma unroll
      for (int i = 0; i < 4; ++i) { const int d = (lane + 64 * i) * 4;
        const float4 g = *(const float4*)(gpre + d); const float4 sc = *(const float4*)(modb + 1024 + d); sh[i] = *(const float4*)(modb + d);
        ge[i] = make_float4(g.x * (1.f + sc.x), g.y * (1.f + sc.y), g.z * (1.f + sc.z), g.w * (1.f + sc.w)); }
      for (int rr = 0; rr < 8; ++rr) { const int row = w * 8 + rr;
        const float* xr = p.in[0] + (size_t)(tok0 + row) * 1024;
        float4 v[4]; float ss = 0.f;
#pragma unroll
        for (int i = 0; i < 4; ++i) { v[i] = *(const float4*)(xr + (lane + 64 * i) * 4); ss += v[i].x * v[i].x + v[i].y * v[i].y + v[i].z * v[i].z + v[i].w * v[i].w; }
        ss = wave_sum(ss); const float rs = rsqrtf(ss * (1.f / 1024.f) + EPS);
#pragma unroll
        for (int i = 0; i < 4; ++i) { uint2 o; o.x = pack2(v[i].x * rs * ge[i].x + sh[i].x, v[i].y * rs * ge[i].y + sh[i].y); o.y = pack2(v[i].z * rs * ge[i].z + sh[i].z, v[i].w * rs * ge[i].w + sh[i].w);
          *(uint2*)(Hs + (size_t)row * 1024 + (lane + 64 * i) * 4) = o; }
      }
    }
    __syncthreads();
    block_gemm(lds, Hs, 1024, (const bf16_t*)(ws + WS_WTIN), 1024, 9, 1024, [&](int m0, int n0, const f32x16& a0, const f32x16& a1) {
      const int r2 = lv(r), h2 = lv(hh), ln = lv(lane);
      if (n0 == O_KR) {
        wt_write_rope(wl, a0, a1, r2, h2, cs, sn, m0); LDS_FENCE();
        for (int h = 0; h < 4; ++h) { bf16_t* kp = Km + (((size_t)b * 4 + h) * SEQ + t0 + m0) * 192 + 128; wt_store(wl, ln, kp, 192, kp + 32, 192); }
        return; }
      wt_write(wl, a0, a1, r2, h2, (n0 >= O_QG && n0 < O_KG) ? 0.125f : 1.f); LDS_FENCE();
      bf16_t* d[2]; int st[2];
#pragma unroll
      for (int half = 0; half < 2; ++half) { const int nb = n0 + 32 * half;
        if (nb < 640) { d[half] = CQ + (size_t)m0 * 640 + nb; st[half] = 640; }
        else if (nb < O_KG) { d[half] = qg + (size_t)m0 * 256 + (nb - O_QG); st[half] = 256; }
        else if (nb < O_VG) { d[half] = kg + (size_t)m0 * 256 + (nb - O_KG); st[half] = 256; }
        else if (nb < O_GF) { d[half] = vg + (size_t)m0 * 512 + (nb - O_VG); st[half] = 512; }
        else if (nb < O_R) { d[half] = GR + (size_t)m0 * 32; st[half] = 32; }
        else if (nb < INW) { d[half] = rg + (size_t)m0 * 512 + (nb - O_R); st[half] = 512; }
        else { d[half] = nullptr; st[half] = 0; } }
      wt_store(wl, ln, d[0], st[0], d[1], st[1]);
    });
    __syncthreads();
    const float* gq = launder(p.in[8]); const float* gkv = launder(p.in[10]);
    const float* wgf = launder(p.in[12]); const float* bgf = launder(p.in[13]); const float* wgb = launder(p.in[14]); const float* bgb = launder(p.in[15]);
    for (int rr = 0; rr < 8; ++rr) { const int row = w * 8 + rr; const bf16_t* cr = CQ + (size_t)row * 640;
      float v[6]; float ss = 0.f;
#pragma unroll
      for (int i = 0; i < 6; ++i) { v[i] = bf2f(cr[lane + 64 * i]); ss += v[i] * v[i]; }
      ss = wave_sum(ss); float rs = rsqrtf(ss * (1.f / 384.f) + EPS);
#pragma unroll
      for (int i = 0; i < 6; ++i) CQN[(size_t)row * 384 + lane + 64 * i] = f2bf(v[i] * rs * gq[lane + 64 * i]);
      float u[4]; float s2 = 0.f;
#pragma unroll
      for (int i = 0; i < 4; ++i) { u[i] = bf2f(cr[384 + lane + 64 * i]); s2 += u[i] * u[i]; }
      s2 = wave_sum(s2); rs = rsqrtf(s2 * (1.f / 256.f) + EPS);
#pragma unroll
      for (int i = 0; i < 4; ++i) CKVN[(size_t)row * 256 + lane + 64 * i] = f2bf(u[i] * rs * gkv[lane + 64 * i]);
    }
    for (int i = 0; i < 32; ++i) { const int e = tid + 512 * i, tt = e >> 8, c = e & 255;
      float af = bgf[c], ab = bgb[c]; const bf16_t* gr = GR + tt * 32;
#pragma unroll
      for (int q = 0; q < 16; ++q) { af += bf2f(gr[q]) * wgf[q * 256 + c]; ab += bf2f(gr[16 + q]) * wgb[q * 256 + c]; }
      laf[tt * 256 + c] = logsigmoid_f(af) * (1.f / 16.f); lab[tt * 256 + c] = logsigmoid_f(ab) * (1.f / 16.f); }
    __syncthreads();
    block_gemm(lds, CQN, 384, (const bf16_t*)(ws + WS_WTQUP), 384, 3, 384, [&](int m0, int n0, const f32x16& a0, const f32x16& a1) {
      const int r2 = lv(r), h2 = lv(hh), ln = lv(lane);
      const int h = n0 / 192, d0 = n0 % 192;
      bf16_t* qp = Qm + (((size_t)b * 4 + h) * SEQ + t0 + m0) * 192 + d0;
      if (d0 < 128) wt_write(wl, a0, a1, r2, h2, 1.f); else wt_write_rope(wl, a0, a1, r2, h2, cs, sn, m0);
      LDS_FENCE();
      wt_store(wl, ln, qp, 192, qp + 32, 192);
    });
    block_gemm(lds, CKVN, 256, (const bf16_t*)(ws + WS_WTKVUP), 256, 4, 256, [&](int m0, int n0, const f32x16& a0, const f32x16& a1) {
      const int r2 = lv(r), h2 = lv(hh), ln = lv(lane);
      const int h = n0 >> 8, d0 = n0 & 255;
      wt_write(wl, a0, a1, r2, h2, 1.f); LDS_FENCE();
      if (d0 < 128) { bf16_t* kp = Km + (((size_t)b * 4 + h) * SEQ + t0 + m0) * 192 + d0; wt_store(wl, ln, kp, 192, kp + 32, 192); }
      else { bf16_t* vp = Vm + (((size_t)b * 4 + h) * SEQ + t0 + m0) * 128 + (d0 - 128); wt_store(wl, ln, vp, 128, vp + 32, 128); }
    });
  }
}

__global__ void __launch_bounds__(NTHR, 2) mega(KP p) {
  extern __shared__ __attribute__((aligned(16))) char lds[];
  if (p.ph_lo <= 0 && 0 < p.ph_hi) phase0(p, lds);
  if (p.ph_lo <= 1 && 1 < p.ph_hi) phase1(p, lds);
}

extern "C" void kernel_launch(void* const* d_in, const int* in_sizes, int n_in, void* d_out, int out_size, void* d_ws, size_t ws_size, hipStream_t stream) {
  const float* x = (const float*)d_in[0];
  const float* g_post_mix = (const float*)d_in[6];
  const float* g_gla = (const float*)d_in[16]; const float* w_out = (const float*)d_in[17]; const float* g_pre_ffn = (const float*)d_in[18];
  const float* g_post_ffn = (const float*)d_in[19]; const float* w_peer_q = (const float*)d_in[20]; const float* sk1 = (const float*)d_in[21]; const float* sk2 = (const float*)d_in[22];
  const float* eu = (const float*)d_in[23]; const float* ev = (const float*)d_in[24];
  float* out = (float*)d_out;
  unsigned char* ws = (unsigned char*)d_ws;
  if (ws_size < WS_END || n_in != 25) return;
  static bool attr_done = false;
  if (!attr_done) { (void)hipFuncSetAttribute((const void*)mega, hipFuncAttributeMaxDynamicSharedMemorySize, LDS_TOTAL); attr_done = true; }
  KP p{};
  for (int i = 0; i < 25; ++i) p.in[i] = (const float*)d_in[i];
  p.out = out; p.ws = ws;
  p.ph_lo = 0; p.ph_hi = 1; hipLaunchKernelGGL(mega, dim3(256), dim3(NTHR), LDS_TOTAL, stream, p);
  p.ph_lo = 1; p.ph_hi = 2; hipLaunchKernelGGL(mega, dim3(256), dim3(NTHR), LDS_TOTAL, stream, p);

  float* mod = (float*)(ws + WS_MOD);
  bf16_t* Qm = (bf16_t*)(ws + WS_QM); bf16_t* Km = (bf16_t*)(ws + WS_KM); bf16_t* Vm = (bf16_t*)(ws + WS_VM);
  bf16_t* qg = (bf16_t*)(ws + WS_QG); bf16_t* kg = (bf16_t*)(ws + WS_KG); bf16_t* vg = (bf16_t*)(ws + WS_VG); bf16_t* rg = (bf16_t*)(ws + WS_RG);
  float* laf = (float*)(ws + WS_LAF); float* lab = (float*)(ws + WS_LAB); bf16_t* omla = (bf16_t*)(ws + WS_OMLA); float* og = (float*)(ws + WS_OG);
  n_attn<<<dim3(SEQ, 4, BATCH), 256, 0, stream>>>(Qm, Km, Vm, omla);
  n_gla<<<32, 128, 0, stream>>>(qg, kg, vg, laf, lab, og);
  float* mix = (float*)(ws + WS_NP3); float* yb = mix + (size_t)SEQ * DM; float* h2 = yb + (size_t)SEQ * DM; float* qry = h2 + (size_t)SEQ * DM;
  int* eidx = (int*)(qry + (size_t)SEQ * 2048); float* gatev = (float*)(eidx + (size_t)SEQ * 128);
  for (int b = 0; b < BATCH; ++b) {
    n_mix<<<SEQ, 256, 0, stream>>>(omla, og, rg, g_gla, b, mix);
    n_gemm<false><<<dim3(1024 / 64, SEQ / 64), 256, 0, stream>>>(mix, DM, w_out, DM, yb, DM, SEQ, DM, DM);
    n_post1<<<SEQ, 256, 0, stream>>>(x, yb, g_post_mix, g_pre_ffn, mod, b, out, h2);
    n_gemm<false><<<dim3(2048 / 64, SEQ / 64), 256, 0, stream>>>(h2, DM, w_peer_q, 2048, qry, 2048, SEQ, 2048, DM);
    n_peer_select<<<SEQ * 8 / 4, 256, 0, stream>>>(qry, sk1, sk2, eidx, gatev);
    n_peer_apply<<<SEQ, 256, 0, stream>>>(h2, eidx, gatev, eu, ev, g_post_ffn, mod, b, out);
  }
}
```

```cpp
#include <hip/hip_runtime.h>
#include <hip/hip_cooperative_groups.h>
namespace cg = cooperative_groups;
#include <stdint.h>

typedef unsigned short bf16_t;
#define DI __device__ __forceinline__

DI float bf2f(bf16_t v) { return __uint_as_float(((unsigned)v) << 16); }
DI bf16_t f2bf(float f) { unsigned u = __float_as_uint(f); u += 0x7fffu + ((u >> 16) & 1u); return (bf16_t)(u >> 16); }

constexpr int BATCH = 8, SEQ = 2048, DM = 1024, NTOK = BATCH * SEQ;
constexpr int INW = 2272;
constexpr float EPS = 1e-6f;
constexpr int O_CQ = 0, O_CKV = 384, O_KR = 640, O_QG = 704, O_KG = 960, O_VG = 1216, O_GF = 1728, O_GB = 1744, O_R = 1760;

DI float wave_sum(float v) {
#pragma unroll
  for (int o = 1; o < 64; o <<= 1) v += __shfl_xor(v, o);
  return v;
}
DI float wave_max(float v) {
#pragma unroll
  for (int o = 1; o < 64; o <<= 1) v = fmaxf(v, __shfl_xor(v, o));
  return v;
}
DI float block_sum256(float v, float* red) {
  v = wave_sum(v);
  __syncthreads();
  if ((threadIdx.x & 63) == 0) red[threadIdx.x >> 6] = v;
  __syncthreads();
  return red[0] + red[1] + red[2] + red[3];
}
DI float block_max256(float v, float* red) {
  v = wave_max(v);
  __syncthreads();
  if ((threadIdx.x & 63) == 0) red[threadIdx.x >> 6] = v;
  __syncthreads();
  return fmaxf(fmaxf(red[0], red[1]), fmaxf(red[2], red[3]));
}
DI float silu_f(float x) { return x / (1.f + expf(-x)); }
DI float logsigmoid_f(float x) { return fminf(x, 0.f) - log1pf(expf(-fabsf(x))); }
DI float gelu_erf(float x) { return 0.5f * x * (1.f + erff(x * 0.70710678118654752f)); }

__global__ __launch_bounds__(256) void n_mod(const float* __restrict__ c, const float* __restrict__ w_ada, const float* __restrict__ b_ada, float* __restrict__ mod) {
  int idx = blockIdx.x * 256 + threadIdx.x;
  int b = idx / 6144, j = idx % 6144;
  float acc = b_ada[j];
  for (int k = 0; k < 1024; ++k) acc += silu_f(c[b * 1024 + k]) * w_ada[(size_t)k * 6144 + j];
  mod[idx] = acc;
}

__global__ __launch_bounds__(256) void n_hnorm(const float* __restrict__ x, const float* __restrict__ g, const float* __restrict__ mod, int b, int off_sh, int off_sc, float* __restrict__ h) {
  __shared__ float red[4];
  int t = blockIdx.x, tid = threadIdx.x;
  const float* xr = x + ((size_t)b * SEQ + t) * DM;
  float v[4]; float ss = 0.f;
#pragma unroll
  for (int i = 0; i < 4; ++i) { v[i] = xr[tid + 256 * i]; ss += v[i] * v[i]; }
  ss = block_sum256(ss, red);
  float rs = rsqrtf(ss * (1.f / DM) + EPS);
#pragma unroll
  for (int i = 0; i < 4; ++i) { int d = tid + 256 * i; h[(size_t)t * DM + d] = v[i] * rs * g[d] * (1.f + mod[b * 6144 + off_sc + d]) + mod[b * 6144 + off_sh + d]; }
}

template <bool BT>
__global__ __launch_bounds__(256) void n_gemm(const float* __restrict__ A, int lda, const float* __restrict__ B, int ldb, float* __restrict__ C, int ldc, int M, int N, int K) {
  __shared__ float As[16][65];
  __shared__ float Bs[16][65];
  const int tid = threadIdx.x, tx = tid & 15, ty = tid >> 4;
  const int m0 = blockIdx.y * 64, n0 = blockIdx.x * 64;
  float acc[4][4];
#pragma unroll
  for (int i = 0; i < 4; ++i)
#pragma unroll
    for (int j = 0; j < 4; ++j) acc[i][j] = 0.f;
  for (int k0 = 0; k0 < K; k0 += 16) {
#pragma unroll
    for (int i = 0; i < 4; ++i) { int e = tid + 256 * i; int m = e >> 4, k = e & 15; As[k][m] = A[(size_t)(m0 + m) * lda + k0 + k]; }
#pragma unroll
    for (int i = 0; i < 4; ++i) { int e = tid + 256 * i;
      if (!BT) { int k = e >> 6, n = e & 63; Bs[k][n] = (n0 + n < N) ? B[(size_t)(k0 + k) * ldb + n0 + n] : 0.f; }
      else     { int n = e >> 4, k = e & 15; Bs[k][n] = (n0 + n < N) ? B[(size_t)(n0 + n) * ldb + k0 + k] : 0.f; } }
    __syncthreads();
#pragma unroll
    for (int k = 0; k < 16; ++k) {
      float a[4], bb[4];
#pragma unroll
      for (int i = 0; i < 4; ++i) { a[i] = As[k][ty * 4 + i]; bb[i] = Bs[k][tx * 4 + i]; }
#pragma unroll
      for (int i = 0; i < 4; ++i)
#pragma unroll
        for (int j = 0; j < 4; ++j) acc[i][j] += a[i] * bb[j];
    }
    __syncthreads();
  }
#pragma unroll
  for (int i = 0; i < 4; ++i)
#pragma unroll
    for (int j = 0; j < 4; ++j) { int n = n0 + tx * 4 + j; if (n < N) C[(size_t)(m0 + ty * 4 + i) * ldc + n] = acc[i][j]; }
}

__global__ __launch_bounds__(256) void n_rms_slice(const float* __restrict__ in, int ldin, int off, int W, const float* __restrict__ g, float* __restrict__ out) {
  __shared__ float red[4];
  int t = blockIdx.x, tid = threadIdx.x;
  float v0 = (tid < W) ? in[(size_t)t * ldin + off + tid] : 0.f;
  float v1 = (tid + 256 < W) ? in[(size_t)t * ldin + off + tid + 256] : 0.f;
  float ss = block_sum256(v0 * v0 + v1 * v1, red);
  float rs = rsqrtf(ss / (float)W + EPS);
  if (tid < W) out[(size_t)t * W + tid] = v0 * rs * g[tid];
  if (tid + 256 < W) out[(size_t)t * W + tid + 256] = v1 * rs * g[tid + 256];
}

__global__ __launch_bounds__(256) void n_scatter(const float* __restrict__ proj, const float* __restrict__ qa, const float* __restrict__ kv, const int* __restrict__ positions, int b,
                                                 const float* __restrict__ wgf, const float* __restrict__ bgf, const float* __restrict__ wgb, const float* __restrict__ bgb,
                                                 bf16_t* __restrict__ Qm, bf16_t* __restrict__ Km, bf16_t* __restrict__ Vm, bf16_t* __restrict__ qg, bf16_t* __restrict__ kg, bf16_t* __restrict__ vg,
                                                 bf16_t* __restrict__ rg, float* __restrict__ laf, float* __restrict__ lab) {
  __shared__ float cs[32], sn[32];
  const int t = blockIdx.x, tid = threadIdx.x;
  const size_t tok = (size_t)b * SEQ + t;
  const float* pr = proj + (size_t)t * INW;
  const float* qr = qa + (size_t)t * 768;
  const float* kr = kv + (size_t)t * 1024;
  if (tid < 32) {
    float inv = powf(10000.f, -(float)tid / 32.f);
    float ang = (float)positions[tok] * inv;
    cs[tid] = cosf(ang); sn[tid] = sinf(ang);
  }
  __syncthreads();
  for (int e = tid; e < 4 * 192; e += 256) {
    int h = e / 192, d = e % 192; float v;
    if (d < 128) v = qr[h * 192 + d];
    else { int j = d - 128; const float* rp = qr + h * 192 + 128;
      if (j < 32) v = rp[j] * cs[j] - rp[j + 32] * sn[j]; else v = rp[j] * cs[j - 32] + rp[j - 32] * sn[j - 32]; }
    Qm[(((size_t)b * 4 + h) * SEQ + t) * 192 + d] = f2bf(v);
  }
  for (int e = tid; e < 4 * 192; e += 256) {
    int h = e / 192, d = e % 192; float v;
    if (d < 128) v = kr[h * 256 + d];
    else { int j = d - 128; const float* rp = pr + O_KR;
      if (j < 32) v = rp[j] * cs[j] - rp[j + 32] * sn[j]; else v = rp[j] * cs[j - 32] + rp[j - 32] * sn[j - 32]; }
    Km[(((size_t)b * 4 + h) * SEQ + t) * 192 + d] = f2bf(v);
  }
  for (int e = tid; e < 512; e += 256) { int h = e >> 7, d = e & 127; Vm[(((size_t)b * 4 + h) * SEQ + t) * 128 + d] = f2bf(kr[h * 256 + 128 + d]); }
  { int e = tid; qg[tok * 256 + e] = f2bf(pr[O_QG + e] * 0.125f); kg[tok * 256 + e] = f2bf(pr[O_KG + e]); }
  for (int e = tid; e < 512; e += 256) { vg[tok * 512 + e] = f2bf(pr[O_VG + e]); rg[tok * 512 + e] = f2bf(pr[O_R + e]); }
  { int cidx = tid; float af = bgf[cidx], ab = bgb[cidx];
#pragma unroll
    for (int r = 0; r < 16; ++r) { af += pr[O_GF + r] * wgf[r * 256 + cidx]; ab += pr[O_GB + r] * wgb[r * 256 + cidx]; }
    laf[tok * 256 + cidx] = logsigmoid_f(af) * (1.f / 16.f); lab[tok * 256 + cidx] = logsigmoid_f(ab) * (1.f / 16.f); }
}

__global__ __launch_bounds__(256) void n_attn(const bf16_t* __restrict__ Qm, const bf16_t* __restrict__ Km, const bf16_t* __restrict__ Vm, bf16_t* __restrict__ omla) {
  __shared__ float qs[192]; __shared__ float sc[2048]; __shared__ float red[4];
  const int i = blockIdx.x, h = blockIdx.y, b = blockIdx.z, tid = threadIdx.x;
  const size_t bh = (size_t)b * 4 + h;
  if (tid < 192) qs[tid] = bf2f(Qm[(bh * SEQ + i) * 192 + tid]);
  __syncthreads();
  float mx = -1e30f;
  for (int kk = 0; kk < 8; ++kk) {
    int key = tid + 256 * kk; const uint4* kr = (const uint4*)(Km + (bh * SEQ + key) * 192);
    float s = 0.f;
    for (int c = 0; c < 24; ++c) { uint4 w = kr[c]; const float* q = qs + c * 8;
      s += q[0] * __uint_as_float(w.x << 16) + q[1] * __uint_as_float(w.x & 0xffff0000u) + q[2] * __uint_as_float(w.y << 16) + q[3] * __uint_as_float(w.y & 0xffff0000u)
         + q[4] * __uint_as_float(w.z << 16) + q[5] * __uint_as_float(w.z & 0xffff0000u) + q[6] * __uint_as_float(w.w << 16) + q[7] * __uint_as_float(w.w & 0xffff0000u); }
    s *= 0.07216878364870322f; sc[key] = s; mx = fmaxf(mx, s);
  }
  mx = block_max256(mx, red);
  float sum = 0.f;
  for (int kk = 0; kk < 8; ++kk) { int key = tid + 256 * kk; float p = expf(sc[key] - mx); sc[key] = p; sum += p; }
  sum = block_sum256(sum, red);
  __syncthreads();
  if (tid < 128) { float o = 0.f; const bf16_t* vp = Vm + bh * SEQ * 128 + tid;
    for (int key = 0; key < SEQ; ++key) o += sc[key] * bf2f(vp[(size_t)key * 128]);
    omla[((size_t)b * SEQ + i) * 512 + h * 128 + tid] = f2bf(o / sum); }
}

__global__ __launch_bounds__(128) void n_gla(const bf16_t* __restrict__ qg, const bf16_t* __restrict__ kg, const bf16_t* __restrict__ vg, const float* __restrict__ laf, const float* __restrict__ lab, float* __restrict__ og) {
  __shared__ float qs[64], ks[64], as[64];
  const int bh = blockIdx.x, b = bh >> 2, h = bh & 3, dv = threadIdx.x;
  for (int dir = 0; dir < 2; ++dir) {
    float S[64];
#pragma unroll
    for (int d = 0; d < 64; ++d) S[d] = 0.f;
    const float* la = dir ? lab : laf;
    for (int s = 0; s < SEQ; ++s) {
      const int t = dir ? (SEQ - 1 - s) : s; const size_t tok = (size_t)b * SEQ + t;
      __syncthreads();
      if (dv < 64) { qs[dv] = bf2f(qg[tok * 256 + h * 64 + dv]); ks[dv] = bf2f(kg[tok * 256 + h * 64 + dv]); as[dv] = expf(la[tok * 256 + h * 64 + dv]); }
      __syncthreads();
      const float v = bf2f(vg[tok * 512 + h * 128 + dv]); float o = 0.f;
#pragma unroll
      for (int d = 0; d < 64; ++d) { S[d] = as[d] * S[d] + ks[d] * v; o += qs[d] * S[d]; }
      if (dir == 0) og[tok * 512 + h * 128 + dv] = o; else og[tok * 512 + h * 128 + dv] += o;
    }
  }
}

__global__ __launch_bounds__(256) void n_mix(const bf16_t* __restrict__ omla, const float* __restrict__ og, const bf16_t* __restrict__ rg, const float* __restrict__ g_gla, int b, float* __restrict__ mix) {
  __shared__ float ssum[4];
  const int t = blockIdx.x, tid = threadIdx.x; const size_t tok = (size_t)b * SEQ + t;
  if (tid < 4) ssum[tid] = 0.f;
  __syncthreads();
  float v[2];
#pragma unroll
  for (int i = 0; i < 2; ++i) { int e = tid + 256 * i; v[i] = og[tok * 512 + e]; atomicAdd(&ssum[e >> 7], v[i] * v[i]); mix[(size_t)t * DM + e] = bf2f(omla[tok * 512 + e]); }
  __syncthreads();
#pragma unroll
  for (int i = 0; i < 2; ++i) { int e = tid + 256 * i; float rs = rsqrtf(ssum[e >> 7] * (1.f / 128.f) + EPS);
    mix[(size_t)t * DM + 512 + e] = v[i] * rs * g_gla[e & 127] * silu_f(bf2f(rg[tok * 512 + e])); }
}

__global__ __launch_bounds__(256) void n_post1(const float* __restrict__ x, const float* __restrict__ y, const float* __restrict__ g_post, const float* __restrict__ g_pre2, const float* __restrict__ mod, int b,
                                               float* __restrict__ out, float* __restrict__ h2) {
  __shared__ float red[4];
  const int t = blockIdx.x, tid = threadIdx.x; const size_t tok = (size_t)b * SEQ + t;
  float yv[4], xv[4]; float ss = 0.f;
#pragma unroll
  for (int i = 0; i < 4; ++i) { yv[i] = y[(size_t)t * DM + tid + 256 * i]; ss += yv[i] * yv[i]; }
  ss = block_sum256(ss, red);
  float rs = rsqrtf(ss * (1.f / DM) + EPS); float s2 = 0.f;
#pragma unroll
  for (int i = 0; i < 4; ++i) { int d = tid + 256 * i; xv[i] = x[tok * DM + d] + mod[b * 6144 + 2048 + d] * (yv[i] * rs * g_post[d]); out[tok * DM + d] = xv[i]; s2 += xv[i] * xv[i]; }
  s2 = block_sum256(s2, red);
  float r2 = rsqrtf(s2 * (1.f / DM) + EPS);
#pragma unroll
  for (int i = 0; i < 4; ++i) { int d = tid + 256 * i; h2[(size_t)t * DM + d] = xv[i] * r2 * g_pre2[d] * (1.f + mod[b * 6144 + 4096 + d]) + mod[b * 6144 + 3072 + d]; }
}

DI void wave_argmax(float& v, int& i) {
#pragma unroll
  for (int o = 1; o < 64; o <<= 1) { float ov = __shfl_xor(v, o); int oi = __shfl_xor(i, o); if (ov > v || (ov == v && oi < i)) { v = ov; i = oi; } }
}
__global__ __launch_bounds__(256) void n_peer_select(const float* __restrict__ qry, const float* __restrict__ sk1, const float* __restrict__ sk2, int* __restrict__ eidx, float* __restrict__ gate) {
  __shared__ float v1s[4][16], v2s[4][16]; __shared__ int i1s[4][16], i2s[4][16];
  const int w = threadIdx.x >> 6, lane = threadIdx.x & 63;
  const int pair = blockIdx.x * 4 + w;
  const int t = pair >> 3, h = pair & 7;
  const float* q1 = qry + (size_t)t * 2048 + h * 256; const float* q2 = q1 + 128;
  float s1a = 0.f, s1b = 0.f, s2a = 0.f, s2b = 0.f;
  for (int d = 0; d < 128; ++d) { float a = q1[d], bq = q2[d];
    s1a += a * sk1[lane * 128 + d]; s1b += a * sk1[(lane + 64) * 128 + d]; s2a += bq * sk2[lane * 128 + d]; s2b += bq * sk2[(lane + 64) * 128 + d]; }
  for (int side = 0; side < 2; ++side) {
    float va = side ? s2a : s1a, vb = side ? s2b : s1b; bool ta = false, tb = false;
    for (int k = 0; k < 16; ++k) {
      float bv; int bi;
      if (!ta && (tb || va >= vb)) { bv = va; bi = lane; } else if (!tb) { bv = vb; bi = lane + 64; } else { bv = -3e38f; bi = 1 << 20; }
      wave_argmax(bv, bi);
      if (bi == lane) ta = true; if (bi == lane + 64) tb = true;
      if (lane == 0) { if (side) { v2s[w][k] = bv; i2s[w][k] = bi; } else { v1s[w][k] = bv; i1s[w][k] = bi; } }
    }
  }
  __syncthreads();
  float cv[4]; bool tk[4];
#pragma unroll
  for (int j = 0; j < 4; ++j) { int c = lane + 64 * j; cv[j] = v1s[w][c >> 4] + v2s[w][c & 15]; tk[j] = false; }
  float topv = 0.f; int topc = 0; float mx = 0.f;
  for (int k = 0; k < 16; ++k) {
    float bv = -3e38f; int bi = 1 << 20;
#pragma unroll
    for (int j = 0; j < 4; ++j) { if (!tk[j] && cv[j] > bv) { bv = cv[j]; bi = lane + 64 * j; } }
    wave_argmax(bv, bi);
#pragma unroll
    for (int j = 0; j < 4; ++j) if (bi == lane + 64 * j) tk[j] = true;
    if (k == 0) mx = bv;
    if (lane == k) { topv = bv; topc = bi; }
  }
  float e = (lane < 16) ? expf(topv - mx) : 0.f;
  float sum = wave_sum(e);
  if (lane < 16) { eidx[(size_t)pair * 16 + lane] = i1s[w][topc >> 4] * 128 + i2s[w][topc & 15]; gate[(size_t)pair * 16 + lane] = e / sum; }
}

__global__ __launch_bounds__(256) void n_peer_apply(const float* __restrict__ h2, const int* __restrict__ eidx, const float* __restrict__ gate, const float* __restrict__ eu, const float* __restrict__ ev,
                                                    const float* __restrict__ g_post, const float* __restrict__ mod, int b, float* __restrict__ out) {
  __shared__ float ys[4][1024]; __shared__ float red[4];
  const int t = blockIdx.x, tid = threadIdx.x, w = tid >> 6, lane = tid & 63; const size_t tok = (size_t)b * SEQ + t;
  float4 hx[4];
#pragma unroll
  for (int i = 0; i < 4; ++i) hx[i] = *(const float4*)(h2 + (size_t)t * DM + (lane + 64 * i) * 4);
  float4 acc[4];
#pragma unroll
  for (int i = 0; i < 4; ++i) acc[i] = make_float4(0.f, 0.f, 0.f, 0.f);
  for (int k = w; k < 128; k += 4) {
    const int e = eidx[(size_t)t * 128 + k]; const float gt = gate[(size_t)t * 128 + k];
    const float4* ur = (const float4*)(eu + (size_t)e * DM); const float4* vr = (const float4*)(ev + (size_t)e * DM);
    float d = 0.f;
#pragma unroll
    for (int i = 0; i < 4; ++i) { float4 u = ur[lane + 64 * i]; d += u.x * hx[i].x + u.y * hx[i].y + u.z * hx[i].z + u.w * hx[i].w; }
    d = wave_sum(d);
    const float wgt = gt * gelu_erf(d);
#pragma unroll
    for (int i = 0; i < 4; ++i) { float4 v = vr[lane + 64 * i]; acc[i].x += wgt * v.x; acc[i].y += wgt * v.y; acc[i].z += wgt * v.z; acc[i].w += wgt * v.w; }
  }
#pragma unroll
  for (int i = 0; i < 4; ++i) *(float4*)(&ys[w][(lane + 64 * i) * 4]) = acc[i];
  __syncthreads();
  float yv[4]; float ss = 0.f;
#pragma unroll
  for (int i = 0; i < 4; ++i) { int d = tid + 256 * i; yv[i] = ys[0][d] + ys[1][d] + ys[2][d] + ys[3][d]; ss += yv[i] * yv[i]; }
  ss = block_sum256(ss, red);
  const float rs = rsqrtf(ss * (1.f / DM) + EPS);
#pragma unroll
  for (int i = 0; i < 4; ++i) { int d = tid + 256 * i; out[tok * DM + d] = out[tok * DM + d] + mod[b * 6144 + 5120 + d] * (yv[i] * rs * g_post[d]); }
}

typedef short bf16x8 __attribute__((ext_vector_type(8)));
typedef float f32x16 __attribute__((ext_vector_type(16)));
#define MFMA32(a, b, c) __builtin_amdgcn_mfma_f32_32x32x16_bf16((a), (b), (c), 0, 0, 0)

constexpr int NTHR = 512;
constexpr size_t MiB = 1024 * 1024;
constexpr size_t WS_MOD   = 0;
constexpr size_t WS_WTIN  = 256 * 1024;
constexpr size_t WS_WTQUP = WS_WTIN + (size_t)2304 * 1024 * 2;
constexpr size_t WS_WTKVUP = WS_WTQUP + (size_t)768 * 384 * 2;
constexpr size_t WS_WTOUT = WS_WTKVUP + (size_t)1024 * 256 * 2;
constexpr size_t WS_WTPQ  = WS_WTOUT + (size_t)1024 * 1024 * 2;
constexpr size_t WS_KD    = WS_WTPQ + (size_t)2048 * 1024 * 2;
constexpr size_t WS_R0END = WS_KD + (size_t)256 * 256 * 2;
static_assert(WS_R0END <= 13 * MiB, "R0");
constexpr size_t WS_QM   = 13 * MiB;
constexpr size_t WS_KM   = WS_QM + 24 * MiB;
constexpr size_t WS_VM   = WS_KM + 24 * MiB;
constexpr size_t WS_QG   = WS_VM + 16 * MiB;
constexpr size_t WS_KG   = WS_QG + 8 * MiB;
constexpr size_t WS_VG   = WS_KG + 8 * MiB;
constexpr size_t WS_RG   = WS_VG + 16 * MiB;
constexpr size_t WS_LAF  = WS_RG + 16 * MiB;
constexpr size_t WS_LAB  = WS_LAF + 16 * MiB;
constexpr size_t WS_OMLA = WS_LAB + 16 * MiB;
constexpr size_t WS_OG   = WS_OMLA + 16 * MiB;
constexpr size_t WS_END  = WS_OG + 32 * MiB;
constexpr size_t WS_CQ   = WS_OMLA;
constexpr size_t OUT_HS  = 0;
constexpr size_t OUT_CQN = 32 * MiB;
constexpr size_t OUT_CKVN = 44 * MiB;
constexpr size_t OUT_GR  = 52 * MiB;
constexpr size_t WS_NP3  = WS_QM;

struct KP { const float* in[25]; float* out; unsigned char* ws; int ph_lo, ph_hi; };

constexpr int G_STRIDE = 144;
constexpr int G_ABYTES = 64 * G_STRIDE;
constexpr int G_BBYTES = 256 * G_STRIDE;
constexpr int G_STAGE = G_ABYTES + G_BBYTES;
constexpr int LDS_GEMM = 2 * G_STAGE;
constexpr int LDS_TAB = LDS_GEMM;
constexpr int LDS_TOTAL = 120832;

DI unsigned pack2(float lo, float hi) { return (unsigned)f2bf(lo) | ((unsigned)f2bf(hi) << 16); }
DI int crow(int reg, int hh) { return (reg & 3) + 8 * (reg >> 2) + 4 * hh; }

template <class Epi>
DI void block_gemm(char* lds, const bf16_t* A, int lda, const bf16_t* Bt, int ldb, int nchunks, int K, Epi&& epi) {
  const int tid = threadIdx.x, lane = tid & 63, w = tid >> 6, wm = w >> 2, wn = w & 3, r = lane & 31, hh = lane >> 5;
  const int nk = K >> 6;
  const int srow = tid >> 3, skc = tid & 7;
  const int st_off = srow * G_STRIDE + skc * 16;
  const int a_rd = (wm * 32 + r) * G_STRIDE + hh * 16;
  const int b_rd = G_ABYTES + (wn * 64 + r) * G_STRIDE + hh * 16;
  for (int ch = 0; ch < nchunks; ++ch) {
    const bf16_t* Ab = A + (size_t)srow * lda + skc * 8;
    const bf16_t* Bb = Bt + (size_t)(ch * 256 + srow) * ldb + skc * 8;
    f32x16 acc0, acc1;
#pragma unroll
    for (int i = 0; i < 16; ++i) { acc0[i] = 0.f; acc1[i] = 0.f; }
    uint4 ra, rb0, rb1, rb2, rb3;
    ra = *(const uint4*)Ab; rb0 = *(const uint4*)Bb; rb1 = *(const uint4*)(Bb + (size_t)64 * ldb); rb2 = *(const uint4*)(Bb + (size_t)128 * ldb); rb3 = *(const uint4*)(Bb + (size_t)192 * ldb);
    {
      char* nb = lds;
      *(uint4*)(nb + st_off) = ra;
      *(uint4*)(nb + G_ABYTES + st_off) = rb0; *(uint4*)(nb + G_ABYTES + 64 * G_STRIDE + st_off) = rb1;
      *(uint4*)(nb + G_ABYTES + 128 * G_STRIDE + st_off) = rb2; *(uint4*)(nb + G_ABYTES + 192 * G_STRIDE + st_off) = rb3;
    }
    __syncthreads();
    for (int t = 0; t < nk; ++t) {
      const char* cur = lds + (t & 1) * G_STAGE; char* nb = lds + ((t + 1) & 1) * G_STAGE;
      const bool more = (t + 1 < nk);
      if (more) { const int ko = (t + 1) * 64;
        ra = *(const uint4*)(Ab + ko); rb0 = *(const uint4*)(Bb + ko); rb1 = *(const uint4*)(Bb + (size_t)64 * ldb + ko);
        rb2 = *(const uint4*)(Bb + (size_t)128 * ldb + ko); rb3 = *(const uint4*)(Bb + (size_t)192 * ldb + ko); }
#pragma unroll
      for (int s = 0; s < 4; ++s) {
        const bf16x8 a = *(const bf16x8*)(cur + a_rd + s * 32);
        const bf16x8 b0 = *(const bf16x8*)(cur + b_rd + s * 32);
        const bf16x8 b1 = *(const bf16x8*)(cur + b_rd + 32 * G_STRIDE + s * 32);
        acc0 = MFMA32(a, b0, acc0); acc1 = MFMA32(a, b1, acc1);
      }
      if (more) {
        *(uint4*)(nb + st_off) = ra;
        *(uint4*)(nb + G_ABYTES + st_off) = rb0; *(uint4*)(nb + G_ABYTES + 64 * G_STRIDE + st_off) = rb1;
        *(uint4*)(nb + G_ABYTES + 128 * G_STRIDE + st_off) = rb2; *(uint4*)(nb + G_ABYTES + 192 * G_STRIDE + st_off) = rb3;
      }
      __syncthreads();
    }
    epi(wm * 32, ch * 256 + wn * 64, acc0, acc1);
    __syncthreads();
  }
}

DI void p0_transpose(char* lds, const float* __restrict__ W, int K, int N, bf16_t* __restrict__ Wt, int item) {
  float* s = (float*)lds;
  const int tid = threadIdx.x;
  const int ntn = (N + 63) >> 6, kt = item / ntn, nt = item % ntn, k0 = kt * 64, n0 = nt * 64;
  __syncthreads();
#pragma unroll
  for (int i = 0; i < 8; ++i) { int e = tid + 512 * i; int kk = e >> 6, nn = e & 63; s[kk * 65 + nn] = (n0 + nn < N) ? W[(size_t)(k0 + kk) * N + n0 + nn] : 0.f; }
  __syncthreads();
  const int nn = tid >> 3, part = tid & 7;
  const float* sp = s + (part * 8) * 65 + nn;
  uint4 o; o.x = pack2(sp[0], sp[65]); o.y = pack2(sp[2 * 65], sp[3 * 65]); o.z = pack2(sp[4 * 65], sp[5 * 65]); o.w = pack2(sp[6 * 65], sp[7 * 65]);
  *(uint4*)(Wt + (size_t)(n0 + nn) * K + k0 + part * 8) = o;
}

DI void phase0(const KP& p, char* lds) {
  const int tid = threadIdx.x, bid = blockIdx.x, nb = gridDim.x;
  unsigned char* ws = p.ws;
  constexpr int I_IN = 16 * 36, I_QUP = 6 * 12, I_KVUP = 4 * 16, I_OUT = 16 * 16, I_PQ = 16 * 32;
  constexpr int I_ALL = I_IN + I_QUP + I_KVUP + I_OUT + I_PQ;
  for (int it = bid; it < I_ALL; it += nb) {
    int q = it;
    if (q < I_IN) { p0_transpose(lds, p.in[7], 1024, 2272, (bf16_t*)(ws + WS_WTIN), q); continue; } q -= I_IN;
    if (q < I_QUP) { p0_transpose(lds, p.in[9], 384, 768, (bf16_t*)(ws + WS_WTQUP), q); continue; } q -= I_QUP;
    if (q < I_KVUP) { p0_transpose(lds, p.in[11], 256, 1024, (bf16_t*)(ws + WS_WTKVUP), q); continue; } q -= I_KVUP;
    if (q < I_OUT) { p0_transpose(lds, p.in[17], 1024, 1024, (bf16_t*)(ws + WS_WTOUT), q); continue; } q -= I_OUT;
    p0_transpose(lds, p.in[20], 1024, 2048, (bf16_t*)(ws + WS_WTPQ), q);
  }
  { bf16_t* kd = (bf16_t*)(ws + WS_KD);
    for (int e = bid * NTHR + tid; e < 65536; e += nb * NTHR) { int n = e >> 8, k = e & 255; float v = 0.f;
      if (n < 128 && k < 128) v = p.in[21][n * 128 + k]; else if (n >= 128 && k >= 128) v = p.in[22][(n - 128) * 128 + (k - 128)];
      kd[e] = f2bf(v); } }
  for (int jb = bid; jb < 96; jb += nb) {
    __syncthreads();
    float* cact = (float*)lds;
    float* red = (float*)(lds + 32768);
    for (int e = tid; e < 8192; e += NTHR) cact[e] = silu_f(p.in[1][e]);
    __syncthreads();
    const int jj = tid & 63, ks = tid >> 6, j0 = jb * 64;
    float acc[8];
#pragma unroll
    for (int b = 0; b < 8; ++b) acc[b] = 0.f;
    const float* wp = p.in[3] + (size_t)(ks * 128) * 6144 + j0 + jj;
    for (int k = 0; k < 128; ++k) { const float wv = wp[(size_t)k * 6144];
#pragma unroll
      for (int b = 0; b < 8; ++b) acc[b] += cact[b * 1024 + ks * 128 + k] * wv; }
#pragma unroll
    for (int b = 0; b < 8; ++b) red[(ks * 64 + jj) * 8 + b] = acc[b];
    __syncthreads();
    { const int b = tid >> 6; float sacc = p.in[4][j0 + jj];
#pragma unroll
      for (int k2 = 0; k2 < 8; ++k2) sacc += red[(k2 * 64 + jj) * 8 + b];
      ((float*)(ws + WS_MOD))[b * 6144 + j0 + jj] = sacc; }
  }
}

constexpr int WT_STRIDE = 144, WT_BYTES = 32 * WT_STRIDE;
DI void wt_write(char* wl, const f32x16& a0, const f32x16& a1, int r, int hh, float scale) {
  char* bp = wl + (4 * hh) * WT_STRIDE + r * 2;
#pragma unroll
  for (int reg = 0; reg < 16; ++reg) { const int ro = ((reg & 3) + 8 * (reg >> 2)) * WT_STRIDE;
    *(bf16_t*)(bp + ro) = f2bf(a0[reg] * scale); *(bf16_t*)(bp + ro + 64) = f2bf(a1[reg] * scale); }
}
DI void wt_write_rope(char* wl, const f32x16& a0, const f32x16& a1, int r, int hh, const float* cs, const float* sn, int m0) {
  char* bp = wl + (4 * hh) * WT_STRIDE + r * 2;
#pragma unroll
  for (int reg = 0; reg < 16; ++reg) { const int rw = (reg & 3) + 8 * (reg >> 2); const int row = m0 + rw + 4 * hh;
    const float c = cs[row * 32 + r], s = sn[row * 32 + r];
    *(bf16_t*)(bp + rw * WT_STRIDE) = f2bf(a0[reg] * c - a1[reg] * s); *(bf16_t*)(bp + rw * WT_STRIDE + 64) = f2bf(a1[reg] * c + a0[reg] * s); }
}
DI void wt_store(const char* wl, int lane, bf16_t* dA, int sA, bf16_t* dB, int sB) {
  const int piece = lane & 7, rsub = lane >> 3;
  bf16_t* d = (piece < 4) ? dA : dB; const int st = (piece < 4) ? sA : sB;
  if (d) {
#pragma unroll
    for (int i = 0; i < 4; ++i) { const int row = i * 8 + rsub; const uint4 v = *(const uint4*)(wl + row * WT_STRIDE + piece * 16);
      *(uint4*)(d + (size_t)row * st + (piece & 3) * 8) = v; }
  }
}
#define LDS_FENCE() asm volatile("s_waitcnt lgkmcnt(0)" ::: "memory")
DI int lv(int x) { asm volatile("" : "+v"(x)); return x; }
template <class T> DI T* launder(T* q) { asm volatile("" : "+s"(q)); return q; }

DI void phase1(const KP& p, char* lds) {
  const int tid = threadIdx.x, lane = tid & 63, w = tid >> 6, r = lane & 31, hh = lane >> 5;
  unsigned char* ws = p.ws; unsigned char* ob = (unsigned char*)p.out;
  const float* mod = (const float*)(ws + WS_MOD);
  float* cs = (float*)(lds + LDS_TAB); float* sn = cs + 2048;
  char* wl = lds + w * WT_BYTES;
  for (int tile = blockIdx.x; tile < 256; tile += gridDim.x) {
    const int tok0 = tile * 64, b = tile >> 5, t0 = (tile & 31) * 64;
    bf16_t* Hs = (bf16_t*)(ob + OUT_HS) + (size_t)tok0 * 1024;
    bf16_t* CQ = (bf16_t*)(ws + WS_CQ) + (size_t)tok0 * 640;
    bf16_t* CQN = (bf16_t*)(ob + OUT_CQN) + (size_t)tok0 * 384;
    bf16_t* CKVN = (bf16_t*)(ob + OUT_CKVN) + (size_t)tok0 * 256;
    bf16_t* GR = (bf16_t*)(ob + OUT_GR) + (size_t)tok0 * 32;
    bf16_t* Qm = (bf16_t*)(ws + WS_QM); bf16_t* Km = (bf16_t*)(ws + WS_KM); bf16_t* Vm = (bf16_t*)(ws + WS_VM);
    bf16_t* qg = (bf16_t*)(ws + WS_QG) + (size_t)tok0 * 256; bf16_t* kg = (bf16_t*)(ws + WS_KG) + (size_t)tok0 * 256;
    bf16_t* vg = (bf16_t*)(ws + WS_VG) + (size_t)tok0 * 512; bf16_t* rg = (bf16_t*)(ws + WS_RG) + (size_t)tok0 * 512;
    float* laf = (float*)(ws + WS_LAF) + (size_t)tok0 * 256; float* lab = (float*)(ws + WS_LAB) + (size_t)tok0 * 256;
    __syncthreads();
#pragma unroll
    for (int i = 0; i < 4; ++i) { const int e = tid + 512 * i, tt = e >> 5, j = e & 31;
      const float inv = powf(10000.f, -(float)j * (1.f / 32.f)); const float ang = (float)((const int*)p.in[2])[tok0 + tt] * inv;
      cs[e] = cosf(ang); sn[e] = sinf(ang); }
    {
      float4 ge[4], sh[4];
      const float* gpre = launder(p.in[5]); const float* modb = launder(mod) + b * 6144;
#pragma unroll
      for (int i = 0; i < 4; ++i) { const int d = (lane + 64 * i) * 4;
        const float4 g = *(const float4*)(gpre + d); const float4 sc = *(const float4*)(modb + 1024 + d); sh[i] = *(const float4*)(modb + d);
        ge[i] = make_float4(g.x * (1.f + sc.x), g.y * (1.f + sc.y), g.z * (1.f + sc.z), g.w * (1.f + sc.w)); }
      for (int rr = 0; rr < 8; ++rr) { const int row = w * 8 + rr;
        const float* xr = p.in[0] + (size_t)(tok0 + row) * 1024;
        float4 v[4]; float ss = 0.f;
#pragma unroll
        for (int i = 0; i < 4; ++i) { v[i] = *(const float4*)(xr + (lane + 64 * i) * 4); ss += v[i].x * v[i].x + v[i].y * v[i].y + v[i].z * v[i].z + v[i].w * v[i].w; }
        ss = wave_sum(ss); const float rs = rsqrtf(ss * (1.f / 1024.f) + EPS);
#pragma unroll
        for (int i = 0; i < 4; ++i) { uint2 o; o.x = pack2(v[i].x * rs * ge[i].x + sh[i].x, v[i].y * rs * ge[i].y + sh[i].y); o.y = pack2(v[i].z * rs * ge[i].z + sh[i].z, v[i].w * rs * ge[i].w + sh[i].w);
          *(uint2*)(Hs + (size_t)row * 1024 + (lane + 64 * i) * 4) = o; }
      }
    }
    __syncthreads();
    block_gemm(lds, Hs, 1024, (const bf16_t*)(ws + WS_WTIN), 1024, 9, 1024, [&](int m0, int n0, const f32x16& a0, const f32x16& a1) {
      const int r2 = lv(r), h2 = lv(hh), ln = lv(lane);
      if (n0 == O_KR) {
        wt_write_rope(wl, a0, a1, r2, h2, cs, sn, m0); LDS_FENCE();
        for (int h = 0; h < 4; ++h) { bf16_t* kp = Km + (((size_t)b * 4 + h) * SEQ + t0 + m0) * 192 + 128; wt_store(wl, ln, kp, 192, kp + 32, 192); }
        return; }
      wt_write(wl, a0, a1, r2, h2, (n0 >= O_QG && n0 < O_KG) ? 0.125f : 1.f); LDS_FENCE();
      bf16_t* d[2]; int st[2];
#pragma unroll
      for (int half = 0; half < 2; ++half) { const int nb = n0 + 32 * half;
        if (nb < 640) { d[half] = CQ + (size_t)m0 * 640 + nb; st[half] = 640; }
        else if (nb < O_KG) { d[half] = qg + (size_t)m0 * 256 + (nb - O_QG); st[half] = 256; }
        else if (nb < O_VG) { d[half] = kg + (size_t)m0 * 256 + (nb - O_KG); st[half] = 256; }
        else if (nb < O_GF) { d[half] = vg + (size_t)m0 * 512 + (nb - O_VG); st[half] = 512; }
        else if (nb < O_R) { d[half] = GR + (size_t)m0 * 32; st[half] = 32; }
        else if (nb < INW) { d[half] = rg + (size_t)m0 * 512 + (nb - O_R); st[half] = 512; }
        else { d[half] = nullptr; st[half] = 0; } }
      wt_store(wl, ln, d[0], st[0], d[1], st[1]);
    });
    __syncthreads();
    const float* gq = launder(p.in[8]); const float* gkv = launder(p.in[10]);
    const float* wgf = launder(p.in[12]); const float* bgf = launder(p.in[13]); const float* wgb = launder(p.in[14]); const float* bgb = launder(p.in[15]);
    for (int rr = 0; rr < 8; ++rr) { const int row = w * 8 + rr; const bf16_t* cr = CQ + (size_t)row * 640;
      float v[6]; float ss = 0.f;
#pragma unroll
      for (int i = 0; i < 6; ++i) { v[i] = bf2f(cr[lane + 64 * i]); ss += v[i] * v[i]; }
      ss = wave_sum(ss); float rs = rsqrtf(ss * (1.f / 384.f) + EPS);
#pragma unroll
      for (int i = 0; i < 6; ++i) CQN[(size_t)row * 384 + lane + 64 * i] = f2bf(v[i] * rs * gq[lane + 64 * i]);
      float u[4]; float s2 = 0.f;
#pragma unroll
      for (int i = 0; i < 4; ++i) { u[i] = bf2f(cr[384 + lane + 64 * i]); s2 += u[i] * u[i]; }
      s2 = wave_sum(s2); rs = rsqrtf(s2 * (1.f / 256.f) + EPS);
#pragma unroll
      for (int i = 0; i < 4; ++i) CKVN[(size_t)row * 256 + lane + 64 * i] = f2bf(u[i] * rs * gkv[lane + 64 * i]);
    }
    for (int i = 0; i < 32; ++i) { const int e = tid + 512 * i, tt = e >> 8, c = e & 255;
      float af = bgf[c], ab = bgb[c]; const bf16_t* gr = GR + tt * 32;
#pragma unroll
      for (int q = 0; q < 16; ++q) { af += bf2f(gr[q]) * wgf[q * 256 + c]; ab += bf2f(gr[16 + q]) * wgb[q * 256 + c]; }
      laf[tt * 256 + c] = logsigmoid_f(af) * (1.f / 16.f); lab[tt * 256 + c] = logsigmoid_f(ab) * (1.f / 16.f); }
    __syncthreads();
    block_gemm(lds, CQN, 384, (const bf16_t*)(ws + WS_WTQUP), 384, 3, 384, [&](int m0, int n0, const f32x16& a0, const f32x16& a1) {
      const int r2 = lv(r), h2 = lv(hh), ln = lv(lane);
      const int h = n0 / 192, d0 = n0 % 192;
      bf16_t* qp = Qm + (((size_t)b * 4 + h) * SEQ + t0 + m0) * 192 + d0;
      if (d0 < 128) wt_write(wl, a0, a1, r2, h2, 1.f); else wt_write_rope(wl, a0, a1, r2, h2, cs, sn, m0);
      LDS_FENCE();
      wt_store(wl, ln, qp, 192, qp + 32, 192);
    });
    block_gemm(lds, CKVN, 256, (const bf16_t*)(ws + WS_WTKVUP), 256, 4, 256, [&](int m0, int n0, const f32x16& a0, const f32x16& a1) {
      const int r2 = lv(r), h2 = lv(hh), ln = lv(lane);
      const int h = n0 >> 8, d0 = n0 & 255;
      wt_write(wl, a0, a1, r2, h2, 1.f); LDS_FENCE();
      if (d0 < 128) { bf16_t* kp = Km + (((size_t)b * 4 + h) * SEQ + t0 + m0) * 192 + d0; wt_store(wl, ln, kp, 192, kp + 32, 192); }
      else { bf16_t* vp = Vm + (((size_t)b * 4 + h) * SEQ + t0 + m0) * 128 + (d0 - 128); wt_store(wl, ln, vp, 128, vp + 32, 128); }
    });
  }
}

namespace att {
typedef short s16x4 __attribute__((ext_vector_type(4)));
typedef unsigned u32x4 __attribute__((ext_vector_type(4)));
constexpr int DQ = 192, DV = 128, KVBLK = 64;
constexpr float SCALE = 0.07216878364870322f;
constexpr float THR = 8.f;
constexpr int SHM_V = KVBLK * DV * 2, SHM_K = KVBLK * DQ * 2;
constexpr int SHM_QR = 8 * 32 * 144;
constexpr int SHM_ATTN = 2 * SHM_V + 2 * SHM_K + 8 * 64 * 4 + SHM_QR;
#define KSWZ(row, colB) ((row) * 384 + ((colB) ^ (((row) & 7) << 4)))
#define SBAR() __builtin_amdgcn_sched_barrier(0)
DI unsigned cvtpk(float lo, float hi) { unsigned r; asm volatile("v_cvt_pk_bf16_f32 %0, %1, %2" : "=v"(r) : "v"(lo), "v"(hi)); return r; }

DI void partialSM(f32x16& p0, f32x16& p1, float& m_reg, float& mn, float& alpha) {
  constexpr float C = SCALE * 1.4426950408889634f;
  float pmax = p0[0];
#pragma unroll
  for (int r = 1; r < 16; ++r) pmax = fmaxf(pmax, p0[r]);
#pragma unroll
  for (int r = 0; r < 16; ++r) pmax = fmaxf(pmax, p1[r]);
  { auto rr = __builtin_amdgcn_permlane32_swap(__float_as_uint(pmax), __float_as_uint(pmax), false, false);
    pmax = fmaxf(__uint_as_float(rr[0]), __uint_as_float(rr[1])); }
  if (__builtin_expect(__all(pmax - m_reg <= THR / SCALE), 1)) { mn = m_reg; alpha = 1.f; }
  else { mn = fmaxf(m_reg, pmax); alpha = __builtin_amdgcn_exp2f((m_reg - mn) * C); m_reg = mn; }
  const float mnC = -mn * C;
#pragma unroll
  for (int r = 0; r < 16; ++r) p0[r] = fmaf(p0[r], C, mnC);
#pragma unroll
  for (int r = 0; r < 16; ++r) p1[r] = fmaf(p1[r], C, mnC);
#pragma unroll
  for (int r = 0; r < 16; ++r) p0[r] = __builtin_amdgcn_exp2f(p0[r]);
}
DI void finishSM(f32x16& p0, f32x16& p1, float alpha, float& l_reg, bf16x8& pa0, bf16x8& pa1, bf16x8& pa2, bf16x8& pa3) {
#pragma unroll
  for (int r = 0; r < 16; ++r) p1[r] = __builtin_amdgcn_exp2f(p1[r]);
  float ps = 0;
#pragma unroll
  for (int r = 0; r < 16; ++r) ps += p0[r];
#pragma unroll
  for (int r = 0; r < 16; ++r) ps += p1[r];
  { auto rr = __builtin_amdgcn_permlane32_swap(__float_as_uint(ps), __float_as_uint(ps), false, false);
    ps = __uint_as_float(rr[0]) + __uint_as_float(rr[1]); }
  l_reg = l_reg * alpha + ps;
#define PK4(P, BASE, OUT) do { unsigned a0 = cvtpk(P[BASE + 0], P[BASE + 1]), a1 = cvtpk(P[BASE + 2], P[BASE + 3]);   \
    unsigned b0 = cvtpk(P[BASE + 4], P[BASE + 5]), b1 = cvtpk(P[BASE + 6], P[BASE + 7]);                              \
    auto r0 = __builtin_amdgcn_permlane32_swap(a0, b0, false, false); auto r1 = __builtin_amdgcn_permlane32_swap(a1, b1, false, false); \
    u32x4 wv = {r0[0], r1[0], r0[1], r1[1]}; OUT = *reinterpret_cast<bf16x8*>(&wv); } while (0)
  PK4(p0, 0, pa0); PK4(p0, 8, pa1); PK4(p1, 0, pa2); PK4(p1, 8, pa3);
#undef PK4
}
DI void qkt(f32x16& p0, f32x16& p1, const char* Ks, const bf16x8* qr, const char* qrl, int r32, int hi) {
#pragma unroll
  for (int i = 0; i < 16; ++i) { p0[i] = 0.f; p1[i] = 0.f; }
#pragma unroll
  for (int d0 = 0; d0 < 12; ++d0) { const int cb = (d0 * 16 + hi * 8) * 2;
    const bf16x8 b0 = *reinterpret_cast<const bf16x8*>(Ks + KSWZ(r32, cb));
    const bf16x8 b1 = *reinterpret_cast<const bf16x8*>(Ks + KSWZ(32 + r32, cb));
    const bf16x8 q = (d0 < 8) ? qr[d0 < 8 ? d0 : 0] : *reinterpret_cast<const bf16x8*>(qrl + (d0 - 8) * 32);
    p0 = MFMA32(b0, q, p0);
    p1 = MFMA32(b1, q, p1); }
}
DI int v_st(int k, int c) { const int kk = (k & ~0xC) | ((k & 4) << 1) | ((k & 8) >> 1); return ((kk >> 3) * 4 + (c >> 5)) * 512 + ((kk & 7) * 32 + (c & 31)) * 2; }
DI int v_rd_base(int lane) { return ((lane & 3) << 3) | (((lane >> 2) & 3) << 6) | (((lane >> 4) & 1) << 5) | (((lane >> 5) & 1) << 8); }
constexpr int v_rd_off(int d0, int ks, int half) { return d0 * 512 + ks * 4096 + half * 2048; }
template <int OFF> DI s16x4 tr_read(int vb) { s16x4 r; asm volatile("ds_read_b64_tr_b16 %0, %1 offset:%2" : "=&v"(r) : "v"(vb), "i"(OFF) : "memory"); return r; }
template <int D0> DI void pv_one(f32x16& od, int vb, bf16x8 pa0, bf16x8 pa1, bf16x8 pa2, bf16x8 pa3) {
  const s16x4 l0 = tr_read<v_rd_off(D0, 0, 0)>(vb), h0 = tr_read<v_rd_off(D0, 0, 1)>(vb), l1 = tr_read<v_rd_off(D0, 1, 0)>(vb), h1 = tr_read<v_rd_off(D0, 1, 1)>(vb);
  const s16x4 l2 = tr_read<v_rd_off(D0, 2, 0)>(vb), h2 = tr_read<v_rd_off(D0, 2, 1)>(vb), l3 = tr_read<v_rd_off(D0, 3, 0)>(vb), h3 = tr_read<v_rd_off(D0, 3, 1)>(vb);
  asm volatile("s_waitcnt lgkmcnt(0)" ::: "memory"); SBAR();
#define PK(L, H) (bf16x8){L[0], L[1], L[2], L[3], H[0], H[1], H[2], H[3]}
  od = MFMA32(pa0, PK(l0, h0), od);
  od = MFMA32(pa1, PK(l1, h1), od);
  od = MFMA32(pa2, PK(l2, h2), od);
  od = MFMA32(pa3, PK(l3, h3), od);
#undef PK
}
DI void pv_d0(f32x16* o, int vb, bf16x8 pa0, bf16x8 pa1, bf16x8 pa2, bf16x8 pa3) {
  pv_one<0>(o[0], vb, pa0, pa1, pa2, pa3); pv_one<1>(o[1], vb, pa0, pa1, pa2, pa3); pv_one<2>(o[2], vb, pa0, pa1, pa2, pa3); pv_one<3>(o[3], vb, pa0, pa1, pa2, pa3);
}
DI void attn_unit(const bf16_t* Qb, const bf16_t* Kh, const bf16_t* Vh, bf16_t* Ob, int seq, char* lds) {
  const int tid = threadIdx.x, wid = tid >> 6, lane = tid & 63, r32 = lane & 31, hi = lane >> 5;
  char* V_lds = lds; char* K_lds = lds + 2 * SHM_V;
  float* wsf = (float*)(lds + 2 * SHM_V + 2 * SHM_K) + wid * 64; float* li_l = wsf; float* al_l = wsf + 32;
  char* qrl = lds + 2 * SHM_V + 2 * SHM_K + 8 * 64 * 4 + wid * (32 * 144) + r32 * 144 + hi * 16;
  float m_reg = -1e30f, l_reg = 0; f32x16 o[4]; bf16x8 qr[8];
#pragma unroll
  for (int d = 0; d < 4; ++d)
#pragma unroll
    for (int i = 0; i < 16; ++i) o[d][i] = 0.f;
  const bf16_t* Qw = Qb + (size_t)(wid * 32 + r32) * DQ + hi * 8;
#pragma unroll
  for (int d0 = 0; d0 < 8; ++d0) qr[d0] = *reinterpret_cast<const bf16x8*>(Qw + d0 * 16);
#pragma unroll
  for (int d0 = 8; d0 < 12; ++d0) *reinterpret_cast<bf16x8*>(qrl + (d0 - 8) * 32) = *reinterpret_cast<const bf16x8*>(Qw + d0 * 16);
  int kst[3];
#pragma unroll
  for (int i = 0; i < 3; ++i) { const int c = tid + 512 * i; kst[i] = KSWZ(c / 24, (c % 24) * 16); }
  const int vst0 = v_st(tid >> 4, (tid & 15) * 8), vst1 = v_st(32 + (tid >> 4), (tid & 15) * 8);
  const int vb0 = (int)(uintptr_t)V_lds + v_rd_base(lane);
  bf16x8 sk0, sk1, sk2, sv0, sv1;
#define SLOAD(k0) do { const bf16x8* kp = reinterpret_cast<const bf16x8*>(Kh + (size_t)(k0) * DQ) + tid; sk0 = kp[0]; sk1 = kp[512]; sk2 = kp[1024]; \
    const bf16x8* vp = reinterpret_cast<const bf16x8*>(Vh + (size_t)(k0) * DV) + tid; sv0 = vp[0]; sv1 = vp[512]; } while (0)
#define SWRITE(b) do { *(bf16x8*)(V_lds + (b) * SHM_V + vst0) = sv0; *(bf16x8*)(V_lds + (b) * SHM_V + vst1) = sv1; \
    *(bf16x8*)(K_lds + (b) * SHM_K + kst[0]) = sk0; *(bf16x8*)(K_lds + (b) * SHM_K + kst[1]) = sk1; *(bf16x8*)(K_lds + (b) * SHM_K + kst[2]) = sk2; } while (0)
#define RESC(a) do { if (__any((a) < 1.f)) { if (hi == 0) al_l[r32] = (a); asm volatile("s_waitcnt lgkmcnt(0)" ::: "memory"); \
    _Pragma("unroll") for (int d = 0; d < 4; ++d) _Pragma("unroll") for (int r = 0; r < 16; ++r) o[d][r] *= al_l[crow(r, hi)]; } } while (0)
  f32x16 pA0, pA1, pB0, pB1; float mnA, mnB, alA, alB; bf16x8 pa0, pa1, pa2, pa3; const int NT = seq / KVBLK;
  SLOAD(0); SWRITE(0); __syncthreads();
  qkt(pA0, pA1, K_lds, qr, qrl, r32, hi); partialSM(pA0, pA1, m_reg, mnA, alA);
  SLOAD(KVBLK); SWRITE(1); __syncthreads();
  for (int j = 1; j + 1 < NT; j += 2) {
    SBAR(); qkt(pB0, pB1, K_lds + SHM_K, qr, qrl, r32, hi);
    finishSM(pA0, pA1, alA, l_reg, pa0, pa1, pa2, pa3); SBAR();
    SLOAD((j + 1) * KVBLK); SBAR();
    pv_d0(o, vb0, pa0, pa1, pa2, pa3); partialSM(pB0, pB1, m_reg, mnB, alB);
    __syncthreads(); SWRITE(0);
    RESC(alB); __syncthreads();
    SBAR(); qkt(pA0, pA1, K_lds, qr, qrl, r32, hi);
    finishSM(pB0, pB1, alB, l_reg, pa0, pa1, pa2, pa3); SBAR();
    SLOAD((j + 2) * KVBLK); SBAR();
    pv_d0(o, vb0 + SHM_V, pa0, pa1, pa2, pa3); partialSM(pA0, pA1, m_reg, mnA, alA);
    __syncthreads(); SWRITE(1);
    RESC(alA); __syncthreads();
  }
  SBAR(); qkt(pB0, pB1, K_lds + SHM_K, qr, qrl, r32, hi);
  finishSM(pA0, pA1, alA, l_reg, pa0, pa1, pa2, pa3); SBAR();
  pv_d0(o, vb0, pa0, pa1, pa2, pa3); partialSM(pB0, pB1, m_reg, mnB, alB);
  __syncthreads(); RESC(alB);
  finishSM(pB0, pB1, alB, l_reg, pa0, pa1, pa2, pa3); SBAR();
  pv_d0(o, vb0 + SHM_V, pa0, pa1, pa2, pa3);
  if (hi == 0) li_l[r32] = l_reg; asm volatile("s_waitcnt lgkmcnt(0)" ::: "memory");
  float rli[16];
#pragma unroll
  for (int r = 0; r < 16; ++r) rli[r] = __builtin_amdgcn_rcpf(li_l[crow(r, hi)]);
  bf16_t* Ow = Ob + (size_t)(wid * 32) * 512;
#pragma unroll
  for (int r = 0; r < 16; ++r) { const int orow = crow(r, hi);
#pragma unroll
    for (int d0 = 0; d0 < 4; ++d0) Ow[(size_t)orow * 512 + d0 * 32 + r32] = f2bf(o[d0][r] * rli[r]); }
  __syncthreads();
#undef SLOAD
#undef SWRITE
#undef RESC
}
}

DI void phase2_attn(const KP& p, char* lds) {
  unsigned char* ws = p.ws;
  const bf16_t* Qm = (const bf16_t*)(ws + WS_QM); const bf16_t* Km = (const bf16_t*)(ws + WS_KM); const bf16_t* Vm = (const bf16_t*)(ws + WS_VM);
  bf16_t* omla = (bf16_t*)(ws + WS_OMLA);
  for (int u = blockIdx.x; u < 256; u += gridDim.x) {
    const int qb = u & 7, bh = u >> 3, b = bh >> 2, h = bh & 3;
    att::attn_unit(Qm + ((size_t)bh * SEQ + qb * 256) * 192, Km + (size_t)bh * SEQ * 192, Vm + (size_t)bh * SEQ * 128,
                   omla + ((size_t)b * SEQ + qb * 256) * 512 + h * 128, SEQ, lds);
  }
}

__global__ void __launch_bounds__(NTHR, 2) mega(KP p) {
  extern __shared__ __attribute__((aligned(16))) char lds[];
  cg::grid_group grid = cg::this_grid();
  if (p.ph_lo <= 0 && 0 < p.ph_hi) { phase0(p, lds); if (1 < p.ph_hi) grid.sync(); }
  if (p.ph_lo <= 1 && 1 < p.ph_hi) { phase1(p, lds); if (2 < p.ph_hi) grid.sync(); }
  if (p.ph_lo <= 2 && 2 < p.ph_hi) { phase2_attn(p, lds); }
}

extern "C" void kernel_launch(void* const* d_in, const int* in_sizes, int n_in, void* d_out, int out_size, void* d_ws, size_t ws_size, hipStream_t stream) {
  const float* x = (const float*)d_in[0];
  const float* g_post_mix = (const float*)d_in[6];
  const float* g_gla = (const float*)d_in[16]; const float* w_out = (const float*)d_in[17]; const float* g_pre_ffn = (const float*)d_in[18];
  const float* g_post_ffn = (const float*)d_in[19]; const float* w_peer_q = (const float*)d_in[20]; const float* sk1 = (const float*)d_in[21]; const float* sk2 = (const float*)d_in[22];
  const float* eu = (const float*)d_in[23]; const float* ev = (const float*)d_in[24];
  float* out = (float*)d_out;
  unsigned char* ws = (unsigned char*)d_ws;
  if (ws_size < WS_END || n_in != 25) return;
  static bool attr_done = false;
  if (!attr_done) { (void)hipFuncSetAttribute((const void*)mega, hipFuncAttributeMaxDynamicSharedMemorySize, LDS_TOTAL); attr_done = true; }
  KP p{};
  for (int i = 0; i < 25; ++i) p.in[i] = (const float*)d_in[i];
  p.out = out; p.ws = ws;
  p.ph_lo = 0; p.ph_hi = 3;
  { void* args[] = {&p}; (void)hipLaunchCooperativeKernel((const void*)mega, dim3(256), dim3(NTHR), args, LDS_TOTAL, stream); }

  float* mod = (float*)(ws + WS_MOD);
  bf16_t* Qm = (bf16_t*)(ws + WS_QM); bf16_t* Km = (bf16_t*)(ws + WS_KM); bf16_t* Vm = (bf16_t*)(ws + WS_VM);
  bf16_t* qg = (bf16_t*)(ws + WS_QG); bf16_t* kg = (bf16_t*)(ws + WS_KG); bf16_t* vg = (bf16_t*)(ws + WS_VG); bf16_t* rg = (bf16_t*)(ws + WS_RG);
  float* laf = (float*)(ws + WS_LAF); float* lab = (float*)(ws + WS_LAB); bf16_t* omla = (bf16_t*)(ws + WS_OMLA); float* og = (float*)(ws + WS_OG);
  n_gla<<<32, 128, 0, stream>>>(qg, kg, vg, laf, lab, og);
  float* mix = (float*)(ws + WS_NP3); float* yb = mix + (size_t)SEQ * DM; float* h2 = yb + (size_t)SEQ * DM; float* qry = h2 + (size_t)SEQ * DM;
  int* eidx = (int*)(qry + (size_t)SEQ * 2048); float* gatev = (float*)(eidx + (size_t)SEQ * 128);
  for (int b = 0; b < BATCH; ++b) {
    n_mix<<<SEQ, 256, 0, stream>>>(omla, og, rg, g_gla, b, mix);
    n_gemm<false><<<dim3(1024 / 64, SEQ / 64), 256, 0, stream>>>(mix, DM, w_out, DM, yb, DM, SEQ, DM, DM);
    n_post1<<<SEQ, 256, 0, stream>>>(x, yb, g_post_mix, g_pre_ffn, mod, b, out, h2);
    n_gemm<false><<<dim3(2048 / 64, SEQ / 64), 256, 0, stream>>>(h2, DM, w_peer_q, 2048, qry, 2048, SEQ, 2048, DM);
    n_peer_select<<<SEQ * 8 / 4, 256, 0, stream>>>(qry, sk1, sk2, eidx, gatev);
    n_peer_apply<<<SEQ, 256, 0, stream>>>(h2, eidx, gatev, eu, ev, g_post_ffn, mod, b, out);
  }
}
```

```cpp
#include <hip/hip_runtime.h>
#include <hip/hip_cooperative_groups.h>
namespace cg = cooperative_groups;
#include <stdint.h>

typedef unsigned short bf16_t;
#define DI __device__ __forceinline__

DI float bf2f(bf16_t v) { return __uint_as_float(((unsigned)v) << 16); }
DI bf16_t f2bf(float f) { unsigned u = __float_as_uint(f); u += 0x7fffu + ((u >> 16) & 1u); return (bf16_t)(u >> 16); }

constexpr int BATCH = 8, SEQ = 2048, DM = 1024, NTOK = BATCH * SEQ;
constexpr int INW = 2272;
constexpr float EPS = 1e-6f;
constexpr int O_CQ = 0, O_CKV = 384, O_KR = 640, O_QG = 704, O_KG = 960, O_VG = 1216, O_GF = 1728, O_GB = 1744, O_R = 1760;

DI float wave_sum(float v) {
#pragma unroll
  for (int o = 1; o < 64; o <<= 1) v += __shfl_xor(v, o);
  return v;
}
DI float wave_max(float v) {
#pragma unroll
  for (int o = 1; o < 64; o <<= 1) v = fmaxf(v, __shfl_xor(v, o));
  return v;
}
DI float block_sum256(float v, float* red) {
  v = wave_sum(v);
  __syncthreads();
  if ((threadIdx.x & 63) == 0) red[threadIdx.x >> 6] = v;
  __syncthreads();
  return red[0] + red[1] + red[2] + red[3];
}
DI float block_max256(float v, float* red) {
  v = wave_max(v);
  __syncthreads();
  if ((threadIdx.x & 63) == 0) red[threadIdx.x >> 6] = v;
  __syncthreads();
  return fmaxf(fmaxf(red[0], red[1]), fmaxf(red[2], red[3]));
}
DI float silu_f(float x) { return x / (1.f + expf(-x)); }
DI float logsigmoid_f(float x) { return fminf(x, 0.f) - log1pf(expf(-fabsf(x))); }
DI float gelu_erf(float x) { return 0.5f * x * (1.f + erff(x * 0.70710678118654752f)); }

__global__ __launch_bounds__(256) void n_mod(const float* __restrict__ c, const float* __restrict__ w_ada, const float* __restrict__ b_ada, float* __restrict__ mod) {
  int idx = blockIdx.x * 256 + threadIdx.x;
  int b = idx / 6144, j = idx % 6144;
  float acc = b_ada[j];
  for (int k = 0; k < 1024; ++k) acc += silu_f(c[b * 1024 + k]) * w_ada[(size_t)k * 6144 + j];
  mod[idx] = acc;
}

__global__ __launch_bounds__(256) void n_hnorm(const float* __restrict__ x, const float* __restrict__ g, const float* __restrict__ mod, int b, int off_sh, int off_sc, float* __restrict__ h) {
  __shared__ float red[4];
  int t = blockIdx.x, tid = threadIdx.x;
  const float* xr = x + ((size_t)b * SEQ + t) * DM;
  float v[4]; float ss = 0.f;
#pragma unroll
  for (int i = 0; i < 4; ++i) { v[i] = xr[tid + 256 * i]; ss += v[i] * v[i]; }
  ss = block_sum256(ss, red);
  float rs = rsqrtf(ss * (1.f / DM) + EPS);
#pragma unroll
  for (int i = 0; i < 4; ++i) { int d = tid + 256 * i; h[(size_t)t * DM + d] = v[i] * rs * g[d] * (1.f + mod[b * 6144 + off_sc + d]) + mod[b * 6144 + off_sh + d]; }
}

template <bool BT>
__global__ __launch_bounds__(256) void n_gemm(const float* __restrict__ A, int lda, const float* __restrict__ B, int ldb, float* __restrict__ C, int ldc, int M, int N, int K) {
  __shared__ float As[16][65];
  __shared__ float Bs[16][65];
  const int tid = threadIdx.x, tx = tid & 15, ty = tid >> 4;
  const int m0 = blockIdx.y * 64, n0 = blockIdx.x * 64;
  float acc[4][4];
#pragma unroll
  for (int i = 0; i < 4; ++i)
#pragma unroll
    for (int j = 0; j < 4; ++j) acc[i][j] = 0.f;
  for (int k0 = 0; k0 < K; k0 += 16) {
#pragma unroll
    for (int i = 0; i < 4; ++i) { int e = tid + 256 * i; int m = e >> 4, k = e & 15; As[k][m] = A[(size_t)(m0 + m) * lda + k0 + k]; }
#pragma unroll
    for (int i = 0; i < 4; ++i) { int e = tid + 256 * i;
      if (!BT) { int k = e >> 6, n = e & 63; Bs[k][n] = (n0 + n < N) ? B[(size_t)(k0 + k) * ldb + n0 + n] : 0.f; }
      else     { int n = e >> 4, k = e & 15; Bs[k][n] = (n0 + n < N) ? B[(size_t)(n0 + n) * ldb + k0 + k] : 0.f; } }
    __syncthreads();
#pragma unroll
    for (int k = 0; k < 16; ++k) {
      float a[4], bb[4];
#pragma unroll
      for (int i = 0; i < 4; ++i) { a[i] = As[k][ty * 4 + i]; bb[i] = Bs[k][tx * 4 + i]; }
#pragma unroll
      for (int i = 0; i < 4; ++i)
#pragma unroll
        for (int j = 0; j < 4; ++j) acc[i][j] += a[i] * bb[j];
    }
    __syncthreads();
  }
#pragma unroll
  for (int i = 0; i < 4; ++i)
#pragma unroll
    for (int j = 0; j < 4; ++j) { int n = n0 + tx * 4 + j; if (n < N) C[(size_t)(m0 + ty * 4 + i) * ldc + n] = acc[i][j]; }
}

__global__ __launch_bounds__(256) void n_rms_slice(const float* __restrict__ in, int ldin, int off, int W, const float* __restrict__ g, float* __restrict__ out) {
  __shared__ float red[4];
  int t = blockIdx.x, tid = threadIdx.x;
  float v0 = (tid < W) ? in[(size_t)t * ldin + off + tid] : 0.f;
  float v1 = (tid + 256 < W) ? in[(size_t)t * ldin + off + tid + 256] : 0.f;
  float ss = block_sum256(v0 * v0 + v1 * v1, red);
  float rs = rsqrtf(ss / (float)W + EPS);
  if (tid < W) out[(size_t)t * W + tid] = v0 * rs * g[tid];
  if (tid + 256 < W) out[(size_t)t * W + tid + 256] = v1 * rs * g[tid + 256];
}

__global__ __launch_bounds__(256) void n_scatter(const float* __restrict__ proj, const float* __restrict__ qa, const float* __restrict__ kv, const int* __restrict__ positions, int b,
                                                 const float* __restrict__ wgf, const float* __restrict__ bgf, const float* __restrict__ wgb, const float* __restrict__ bgb,
                                                 bf16_t* __restrict__ Qm, bf16_t* __restrict__ Km, bf16_t* __restrict__ Vm, bf16_t* __restrict__ qg, bf16_t* __restrict__ kg, bf16_t* __restrict__ vg,
                                                 bf16_t* __restrict__ rg, float* __restrict__ laf, float* __restrict__ lab) {
  __shared__ float cs[32], sn[32];
  const int t = blockIdx.x, tid = threadIdx.x;
  const size_t tok = (size_t)b * SEQ + t;
  const float* pr = proj + (size_t)t * INW;
  const float* qr = qa + (size_t)t * 768;
  const float* kr = kv + (size_t)t * 1024;
  if (tid < 32) {
    float inv = powf(10000.f, -(float)tid / 32.f);
    float ang = (float)positions[tok] * inv;
    cs[tid] = cosf(ang); sn[tid] = sinf(ang);
  }
  __syncthreads();
  for (int e = tid; e < 4 * 192; e += 256) {
    int h = e / 192, d = e % 192; float v;
    if (d < 128) v = qr[h * 192 + d];
    else { int j = d - 128; const float* rp = qr + h * 192 + 128;
      if (j < 32) v = rp[j] * cs[j] - rp[j + 32] * sn[j]; else v = rp[j] * cs[j - 32] + rp[j - 32] * sn[j - 32]; }
    Qm[(((size_t)b * 4 + h) * SEQ + t) * 192 + d] = f2bf(v);
  }
  for (int e = tid; e < 4 * 192; e += 256) {
    int h = e / 192, d = e % 192; float v;
    if (d < 128) v = kr[h * 256 + d];
    else { int j = d - 128; const float* rp = pr + O_KR;
      if (j < 32) v = rp[j] * cs[j] - rp[j + 32] * sn[j]; else v = rp[j] * cs[j - 32] + rp[j - 32] * sn[j - 32]; }
    Km[(((size_t)b * 4 + h) * SEQ + t) * 192 + d] = f2bf(v);
  }
  for (int e = tid; e < 512; e += 256) { int h = e >> 7, d = e & 127; Vm[(((size_t)b * 4 + h) * SEQ + t) * 128 + d] = f2bf(kr[h * 256 + 128 + d]); }
  { int e = tid; qg[tok * 256 + e] = f2bf(pr[O_QG + e] * 0.125f); kg[tok * 256 + e] = f2bf(pr[O_KG + e]); }
  for (int e = tid; e < 512; e += 256) { vg[tok * 512 + e] = f2bf(pr[O_VG + e]); rg[tok * 512 + e] = f2bf(pr[O_R + e]); }
  { int cidx = tid; float af = bgf[cidx], ab = bgb[cidx];
#pragma unroll
    for (int r = 0; r < 16; ++r) { af += pr[O_GF + r] * wgf[r * 256 + cidx]; ab += pr[O_GB + r] * wgb[r * 256 + cidx]; }
    laf[tok * 256 + cidx] = logsigmoid_f(af) * (1.f / 16.f); lab[tok * 256 + cidx] = logsigmoid_f(ab) * (1.f / 16.f); }
}

__global__ __launch_bounds__(256) void n_attn(const bf16_t* __restrict__ Qm, const bf16_t* __restrict__ Km, const bf16_t* __restrict__ Vm, bf16_t* __restrict__ omla) {
  __shared__ float qs[192]; __shared__ float sc[2048]; __shared__ float red[4];
  const int i = blockIdx.x, h = blockIdx.y, b = blockIdx.z, tid = threadIdx.x;
  const size_t bh = (size_t)b * 4 + h;
  if (tid < 192) qs[tid] = bf2f(Qm[(bh * SEQ + i) * 192 + tid]);
  __syncthreads();
  float mx = -1e30f;
  for (int kk = 0; kk < 8; ++kk) {
    int key = tid + 256 * kk; const uint4* kr = (const uint4*)(Km + (bh * SEQ + key) * 192);
    float s = 0.f;
    for (int c = 0; c < 24; ++c) { uint4 w = kr[c]; const float* q = qs + c * 8;
      s += q[0] * __uint_as_float(w.x << 16) + q[1] * __uint_as_float(w.x & 0xffff0000u) + q[2] * __uint_as_float(w.y << 16) + q[3] * __uint_as_float(w.y & 0xffff0000u)
         + q[4] * __uint_as_float(w.z << 16) + q[5] * __uint_as_float(w.z & 0xffff0000u) + q[6] * __uint_as_float(w.w << 16) + q[7] * __uint_as_float(w.w & 0xffff0000u); }
    s *= 0.07216878364870322f; sc[key] = s; mx = fmaxf(mx, s);
  }
  mx = block_max256(mx, red);
  float sum = 0.f;
  for (int kk = 0; kk < 8; ++kk) { int key = tid + 256 * kk; float p = expf(sc[key] - mx); sc[key] = p; sum += p; }
  sum = block_sum256(sum, red);
  __syncthreads();
  if (tid < 128) { float o = 0.f; const bf16_t* vp = Vm + bh * SEQ * 128 + tid;
    for (int key = 0; key < SEQ; ++key) o += sc[key] * bf2f(vp[(size_t)key * 128]);
    omla[((size_t)b * SEQ + i) * 512 + h * 128 + tid] = f2bf(o / sum); }
}

__global__ __launch_bounds__(128) void n_gla(const bf16_t* __restrict__ qg, const bf16_t* __restrict__ kg, const bf16_t* __restrict__ vg, const bf16_t* __restrict__ laf, const bf16_t* __restrict__ lab, float* __restrict__ og) {
  __shared__ float qs[64], ks[64], as[64];
  const int bh = blockIdx.x, b = bh >> 2, h = bh & 3, dv = threadIdx.x;
  for (int dir = 0; dir < 2; ++dir) {
    float S[64];
#pragma unroll
    for (int d = 0; d < 64; ++d) S[d] = 0.f;
    const bf16_t* la = dir ? lab : laf;
    for (int s = 0; s < SEQ; ++s) {
      const int t = dir ? (SEQ - 1 - s) : s; const size_t tok = (size_t)b * SEQ + t;
      __syncthreads();
      if (dv < 64) { qs[dv] = bf2f(qg[tok * 256 + h * 64 + dv]); ks[dv] = bf2f(kg[tok * 256 + h * 64 + dv]); as[dv] = expf(bf2f(la[tok * 256 + h * 64 + dv])); }
      __syncthreads();
      const float v = bf2f(vg[tok * 512 + h * 128 + dv]); float o = 0.f;
#pragma unroll
      for (int d = 0; d < 64; ++d) { S[d] = as[d] * S[d] + ks[d] * v; o += qs[d] * S[d]; }
      if (dir == 0) og[tok * 512 + h * 128 + dv] = o; else og[tok * 512 + h * 128 + dv] += o;
    }
  }
}

__global__ __launch_bounds__(256) void n_mix(const bf16_t* __restrict__ omla, const float* __restrict__ og, const bf16_t* __restrict__ rg, const float* __restrict__ g_gla, int b, float* __restrict__ mix) {
  __shared__ float ssum[4];
  const int t = blockIdx.x, tid = threadIdx.x; const size_t tok = (size_t)b * SEQ + t;
  if (tid < 4) ssum[tid] = 0.f;
  __syncthreads();
  float v[2];
#pragma unroll
  for (int i = 0; i < 2; ++i) { int e = tid + 256 * i; v[i] = og[tok * 512 + e]; atomicAdd(&ssum[e >> 7], v[i] * v[i]); mix[(size_t)t * DM + e] = bf2f(omla[tok * 512 + e]); }
  __syncthreads();
#pragma unroll
  for (int i = 0; i < 2; ++i) { int e = tid + 256 * i; float rs = rsqrtf(ssum[e >> 7] * (1.f / 128.f) + EPS);
    mix[(size_t)t * DM + 512 + e] = v[i] * rs * g_gla[e & 127] * silu_f(bf2f(rg[tok * 512 + e])); }
}

__global__ __launch_bounds__(256) void n_post1(const float* __restrict__ x, const float* __restrict__ y, const float* __restrict__ g_post, const float* __restrict__ g_pre2, const float* __restrict__ mod, int b,
                                               float* __restrict__ out, float* __restrict__ h2) {
  __shared__ float red[4];
  const int t = blockIdx.x, tid = threadIdx.x; const size_t tok = (size_t)b * SEQ + t;
  float yv[4], xv[4]; float ss = 0.f;
#pragma unroll
  for (int i = 0; i < 4; ++i) { yv[i] = y[(size_t)t * DM + tid + 256 * i]; ss += yv[i] * yv[i]; }
  ss = block_sum256(ss, red);
  float rs = rsqrtf(ss * (1.f / DM) + EPS); float s2 = 0.f;
#pragma unroll
  for (int i = 0; i < 4; ++i) { int d = tid + 256 * i; xv[i] = x[tok * DM + d] + mod[b * 6144 + 2048 + d] * (yv[i] * rs * g_post[d]); out[tok * DM + d] = xv[i]; s2 += xv[i] * xv[i]; }
  s2 = block_sum256(s2, red);
  float r2 = rsqrtf(s2 * (1.f / DM) + EPS);
#pragma unroll
  for (int i = 0; i < 4; ++i) { int d = tid + 256 * i; h2[(size_t)t * DM + d] = xv[i] * r2 * g_pre2[d] * (1.f + mod[b * 6144 + 4096 + d]) + mod[b * 6144 + 3072 + d]; }
}

DI void wave_argmax(float& v, int& i) {
#pragma unroll
  for (int o = 1; o < 64; o <<= 1) { float ov = __shfl_xor(v, o); int oi = __shfl_xor(i, o); if (ov > v || (ov == v && oi < i)) { v = ov; i = oi; } }
}
__global__ __launch_bounds__(256) void n_peer_select(const float* __restrict__ qry, const float* __restrict__ sk1, const float* __restrict__ sk2, int* __restrict__ eidx, float* __restrict__ gate) {
  __shared__ float v1s[4][16], v2s[4][16]; __shared__ int i1s[4][16], i2s[4][16];
  const int w = threadIdx.x >> 6, lane = threadIdx.x & 63;
  const int pair = blockIdx.x * 4 + w;
  const int t = pair >> 3, h = pair & 7;
  const float* q1 = qry + (size_t)t * 2048 + h * 256; const float* q2 = q1 + 128;
  float s1a = 0.f, s1b = 0.f, s2a = 0.f, s2b = 0.f;
  for (int d = 0; d < 128; ++d) { float a = q1[d], bq = q2[d];
    s1a += a * sk1[lane * 128 + d]; s1b += a * sk1[(lane + 64) * 128 + d]; s2a += bq * sk2[lane * 128 + d]; s2b += bq * sk2[(lane + 64) * 128 + d]; }
  for (int side = 0; side < 2; ++side) {
    float va = side ? s2a : s1a, vb = side ? s2b : s1b; bool ta = false, tb = false;
    for (int k = 0; k < 16; ++k) {
      float bv; int bi;
      if (!ta && (tb || va >= vb)) { bv = va; bi = lane; } else if (!tb) { bv = vb; bi = lane + 64; } else { bv = -3e38f; bi = 1 << 20; }
      wave_argmax(bv, bi);
      if (bi == lane) ta = true; if (bi == lane + 64) tb = true;
      if (lane == 0) { if (side) { v2s[w][k] = bv; i2s[w][k] = bi; } else { v1s[w][k] = bv; i1s[w][k] = bi; } }
    }
  }
  __syncthreads();
  float cv[4]; bool tk[4];
#pragma unroll
  for (int j = 0; j < 4; ++j) { int c = lane + 64 * j; cv[j] = v1s[w][c >> 4] + v2s[w][c & 15]; tk[j] = false; }
  float topv = 0.f; int topc = 0; float mx = 0.f;
  for (int k = 0; k < 16; ++k) {
    float bv = -3e38f; int bi = 1 << 20;
#pragma unroll
    for (int j = 0; j < 4; ++j) { if (!tk[j] && cv[j] > bv) { bv = cv[j]; bi = lane + 64 * j; } }
    wave_argmax(bv, bi);
#pragma unroll
    for (int j = 0; j < 4; ++j) if (bi == lane + 64 * j) tk[j] = true;
    if (k == 0) mx = bv;
    if (lane == k) { topv = bv; topc = bi; }
  }
  float e = (lane < 16) ? expf(topv - mx) : 0.f;
  float sum = wave_sum(e);
  if (lane < 16) { eidx[(size_t)pair * 16 + lane] = i1s[w][topc >> 4] * 128 + i2s[w][topc & 15]; gate[(size_t)pair * 16 + lane] = e / sum; }
}

__global__ __launch_bounds__(256) void n_peer_apply(const float* __restrict__ h2, const int* __restrict__ eidx, const float* __restrict__ gate, const float* __restrict__ eu, const float* __restrict__ ev,
                                                    const float* __restrict__ g_post, const float* __restrict__ mod, int b, float* __restrict__ out) {
  __shared__ float ys[4][1024]; __shared__ float red[4];
  const int t = blockIdx.x, tid = threadIdx.x, w = tid >> 6, lane = tid & 63; const size_t tok = (size_t)b * SEQ + t;
  float4 hx[4];
#pragma unroll
  for (int i = 0; i < 4; ++i) hx[i] = *(const float4*)(h2 + (size_t)t * DM + (lane + 64 * i) * 4);
  float4 acc[4];
#pragma unroll
  for (int i = 0; i < 4; ++i) acc[i] = make_float4(0.f, 0.f, 0.f, 0.f);
  for (int k = w; k < 128; k += 4) {
    const int e = eidx[(size_t)t * 128 + k]; const float gt = gate[(size_t)t * 128 + k];
    const float4* ur = (const float4*)(eu + (size_t)e * DM); const float4* vr = (const float4*)(ev + (size_t)e * DM);
    float d = 0.f;
#pragma unroll
    for (int i = 0; i < 4; ++i) { float4 u = ur[lane + 64 * i]; d += u.x * hx[i].x + u.y * hx[i].y + u.z * hx[i].z + u.w * hx[i].w; }
    d = wave_sum(d);
    const float wgt = gt * gelu_erf(d);
#pragma unroll
    for (int i = 0; i < 4; ++i) { float4 v = vr[lane + 64 * i]; acc[i].x += wgt * v.x; acc[i].y += wgt * v.y; acc[i].z += wgt * v.z; acc[i].w += wgt * v.w; }
  }
#pragma unroll
  for (int i = 0; i < 4; ++i) *(float4*)(&ys[w][(lane + 64 * i) * 4]) = acc[i];
  __syncthreads();
  float yv[4]; float ss = 0.f;
#pragma unroll
  for (int i = 0; i < 4; ++i) { int d = tid + 256 * i; yv[i] = ys[0][d] + ys[1][d] + ys[2][d] + ys[3][d]; ss += yv[i] * yv[i]; }
  ss = block_sum256(ss, red);
  const float rs = rsqrtf(ss * (1.f / DM) + EPS);
#pragma unroll
  for (int i = 0; i < 4; ++i) { int d = tid + 256 * i; out[tok * DM + d] = out[tok * DM + d] + mod[b * 6144 + 5120 + d] * (yv[i] * rs * g_post[d]); }
}

typedef short bf16x8 __attribute__((ext_vector_type(8)));
typedef float f32x16 __attribute__((ext_vector_type(16)));
#define MFMA32(a, b, c) __builtin_amdgcn_mfma_f32_32x32x16_bf16((a), (b), (c), 0, 0, 0)

constexpr int NTHR = 512;
constexpr size_t MiB = 1024 * 1024;
constexpr size_t WS_MOD   = 0;
constexpr size_t WS_WTIN  = 256 * 1024;
constexpr size_t WS_WTQUP = WS_WTIN + (size_t)2304 * 1024 * 2;
constexpr size_t WS_WTKVUP = WS_WTQUP + (size_t)768 * 384 * 2;
constexpr size_t WS_WTOUT = WS_WTKVUP + (size_t)1024 * 256 * 2;
constexpr size_t WS_WTPQ  = WS_WTOUT + (size_t)1024 * 1024 * 2;
constexpr size_t WS_KD    = WS_WTPQ + (size_t)2048 * 1024 * 2;
constexpr size_t WS_R0END = WS_KD + (size_t)256 * 256 * 2;
static_assert(WS_R0END <= 13 * MiB, "R0");
constexpr size_t WS_QM   = 13 * MiB;
constexpr size_t WS_KM   = WS_QM + 24 * MiB;
constexpr size_t WS_VM   = WS_KM + 24 * MiB;
constexpr size_t WS_QG   = WS_VM + 16 * MiB;
constexpr size_t WS_KG   = WS_QG + 8 * MiB;
constexpr size_t WS_VG   = WS_KG + 8 * MiB;
constexpr size_t WS_RG   = WS_VG + 16 * MiB;
constexpr size_t WS_LAF  = WS_RG + 16 * MiB;
constexpr size_t WS_LAB  = WS_LAF + 8 * MiB;
constexpr size_t WS_OMLA = WS_LAB + 8 * MiB;
constexpr size_t WS_OG   = WS_OMLA + 16 * MiB;
constexpr size_t WS_EU   = WS_OG + 32 * MiB;
constexpr size_t WS_EV   = WS_EU + 32 * MiB;
constexpr size_t WS_END  = WS_EV + 32 * MiB;
static_assert(WS_RG == WS_QM + 96 * MiB, "P3 tile scratch aliases QM..VG");
constexpr size_t WS_CQ   = WS_OMLA;
constexpr size_t OUT_HS  = 0;
constexpr size_t OUT_CQN = 32 * MiB;
constexpr size_t OUT_CKVN = 44 * MiB;
constexpr size_t OUT_GR  = 52 * MiB;
constexpr size_t WS_NP3  = WS_QM;

struct KP { const float* in[25]; float* out; unsigned char* ws; int ph_lo, ph_hi; };

constexpr int G_STRIDE = 144;
constexpr int G_ABYTES = 64 * G_STRIDE;
constexpr int G_BBYTES = 256 * G_STRIDE;
constexpr int G_STAGE = G_ABYTES + G_BBYTES;
constexpr int LDS_GEMM = 2 * G_STAGE;
constexpr int LDS_TAB = LDS_GEMM;
constexpr int LDS_TOTAL = 157696;

DI unsigned pack2(float lo, float hi) { return (unsigned)f2bf(lo) | ((unsigned)f2bf(hi) << 16); }
DI int crow(int reg, int hh) { return (reg & 3) + 8 * (reg >> 2) + 4 * hh; }

template <class Epi>
DI void block_gemm(char* lds, const bf16_t* A, int lda, const bf16_t* Bt, int ldb, int nchunks, int K, Epi&& epi) {
  const int tid = threadIdx.x, lane = tid & 63, w = tid >> 6, wm = w >> 2, wn = w & 3, r = lane & 31, hh = lane >> 5;
  const int nk = K >> 6;
  const int srow = tid >> 3, skc = tid & 7;
  const int st_off = srow * G_STRIDE + skc * 16;
  const int a_rd = (wm * 32 + r) * G_STRIDE + hh * 16;
  const int b_rd = G_ABYTES + (wn * 64 + r) * G_STRIDE + hh * 16;
  for (int ch = 0; ch < nchunks; ++ch) {
    const bf16_t* Ab = A + (size_t)srow * lda + skc * 8;
    const bf16_t* Bb = Bt + (size_t)(ch * 256 + srow) * ldb + skc * 8;
    f32x16 acc0, acc1;
#pragma unroll
    for (int i = 0; i < 16; ++i) { acc0[i] = 0.f; acc1[i] = 0.f; }
    uint4 ra, rb0, rb1, rb2, rb3;
    ra = *(const uint4*)Ab; rb0 = *(const uint4*)Bb; rb1 = *(const uint4*)(Bb + (size_t)64 * ldb); rb2 = *(const uint4*)(Bb + (size_t)128 * ldb); rb3 = *(const uint4*)(Bb + (size_t)192 * ldb);
    {
      char* nb = lds;
      *(uint4*)(nb + st_off) = ra;
      *(uint4*)(nb + G_ABYTES + st_off) = rb0; *(uint4*)(nb + G_ABYTES + 64 * G_STRIDE + st_off) = rb1;
      *(uint4*)(nb + G_ABYTES + 128 * G_STRIDE + st_off) = rb2; *(uint4*)(nb + G_ABYTES + 192 * G_STRIDE + st_off) = rb3;
    }
    __syncthreads();
    for (int t = 0; t < nk; ++t) {
      const char* cur = lds + (t & 1) * G_STAGE; char* nb = lds + ((t + 1) & 1) * G_STAGE;
      const bool more = (t + 1 < nk);
      if (more) { const int ko = (t + 1) * 64;
        ra = *(const uint4*)(Ab + ko); rb0 = *(const uint4*)(Bb + ko); rb1 = *(const uint4*)(Bb + (size_t)64 * ldb + ko);
        rb2 = *(const uint4*)(Bb + (size_t)128 * ldb + ko); rb3 = *(const uint4*)(Bb + (size_t)192 * ldb + ko); }
#pragma unroll
      for (int s = 0; s < 4; ++s) {
        const bf16x8 a = *(const bf16x8*)(cur + a_rd + s * 32);
        const bf16x8 b0 = *(const bf16x8*)(cur + b_rd + s * 32);
        const bf16x8 b1 = *(const bf16x8*)(cur + b_rd + 32 * G_STRIDE + s * 32);
        acc0 = MFMA32(a, b0, acc0); acc1 = MFMA32(a, b1, acc1);
      }
      if (more) {
        *(uint4*)(nb + st_off) = ra;
        *(uint4*)(nb + G_ABYTES + st_off) = rb0; *(uint4*)(nb + G_ABYTES + 64 * G_STRIDE + st_off) = rb1;
        *(uint4*)(nb + G_ABYTES + 128 * G_STRIDE + st_off) = rb2; *(uint4*)(nb + G_ABYTES + 192 * G_STRIDE + st_off) = rb3;
      }
      __syncthreads();
    }
    epi(wm * 32, ch * 256 + wn * 64, acc0, acc1);
    __syncthreads();
  }
}

DI void p0_transpose(char* lds, const float* __restrict__ W, int K, int N, bf16_t* __restrict__ Wt, int item) {
  float* s = (float*)lds;
  const int tid = threadIdx.x;
  const int ntn = (N + 63) >> 6, kt = item / ntn, nt = item % ntn, k0 = kt * 64, n0 = nt * 64;
  __syncthreads();
#pragma unroll
  for (int i = 0; i < 8; ++i) { int e = tid + 512 * i; int kk = e >> 6, nn = e & 63; s[kk * 65 + nn] = (n0 + nn < N) ? W[(size_t)(k0 + kk) * N + n0 + nn] : 0.f; }
  __syncthreads();
  const int nn = tid >> 3, part = tid & 7;
  const float* sp = s + (part * 8) * 65 + nn;
  uint4 o; o.x = pack2(sp[0], sp[65]); o.y = pack2(sp[2 * 65], sp[3 * 65]); o.z = pack2(sp[4 * 65], sp[5 * 65]); o.w = pack2(sp[6 * 65], sp[7 * 65]);
  *(uint4*)(Wt + (size_t)(n0 + nn) * K + k0 + part * 8) = o;
}

DI void phase0(const KP& p, char* lds) {
  const int tid = threadIdx.x, bid = blockIdx.x, nb = gridDim.x;
  unsigned char* ws = p.ws;
  constexpr int I_IN = 16 * 36, I_QUP = 6 * 12, I_KVUP = 4 * 16, I_OUT = 16 * 16, I_PQ = 16 * 32;
  constexpr int I_ALL = I_IN + I_QUP + I_KVUP + I_OUT + I_PQ;
  for (int it = bid; it < I_ALL; it += nb) {
    int q = it;
    if (q < I_IN) { p0_transpose(lds, p.in[7], 1024, 2272, (bf16_t*)(ws + WS_WTIN), q); continue; } q -= I_IN;
    if (q < I_QUP) { p0_transpose(lds, p.in[9], 384, 768, (bf16_t*)(ws + WS_WTQUP), q); continue; } q -= I_QUP;
    if (q < I_KVUP) { p0_transpose(lds, p.in[11], 256, 1024, (bf16_t*)(ws + WS_WTKVUP), q); continue; } q -= I_KVUP;
    if (q < I_OUT) { p0_transpose(lds, p.in[17], 1024, 1024, (bf16_t*)(ws + WS_WTOUT), q); continue; } q -= I_OUT;
    p0_transpose(lds, p.in[20], 1024, 2048, (bf16_t*)(ws + WS_WTPQ), q);
  }
  { bf16_t* kd = (bf16_t*)(ws + WS_KD);
    for (int e = bid * NTHR + tid; e < 65536; e += nb * NTHR) { int n = e >> 8, k = e & 255; float v = 0.f;
      if (n < 128 && k < 128) v = p.in[21][n * 128 + k]; else if (n >= 128 && k >= 128) v = p.in[22][(n - 128) * 128 + (k - 128)];
      kd[e] = f2bf(v); } }
  { const size_t n8 = (size_t)16384 * 1024 / 8;
    for (int t = 0; t < 2; ++t) { const float* src = p.in[23 + t]; bf16_t* dst = (bf16_t*)(ws + (t ? WS_EV : WS_EU));
      for (size_t i = (size_t)bid * NTHR + tid; i < n8; i += (size_t)nb * NTHR) { const float4 x0 = *(const float4*)(src + i * 8), x1 = *(const float4*)(src + i * 8 + 4);
        uint4 o; o.x = pack2(x0.x, x0.y); o.y = pack2(x0.z, x0.w); o.z = pack2(x1.x, x1.y); o.w = pack2(x1.z, x1.w); *(uint4*)(dst + i * 8) = o; } } }
  for (int jb = bid; jb < 96; jb += nb) {
    __syncthreads();
    float* cact = (float*)lds;
    float* red = (float*)(lds + 32768);
    for (int e = tid; e < 8192; e += NTHR) cact[e] = silu_f(p.in[1][e]);
    __syncthreads();
    const int jj = tid & 63, ks = tid >> 6, j0 = jb * 64;
    float acc[8];
#pragma unroll
    for (int b = 0; b < 8; ++b) acc[b] = 0.f;
    const float* wp = p.in[3] + (size_t)(ks * 128) * 6144 + j0 + jj;
    for (int k = 0; k < 128; ++k) { const float wv = wp[(size_t)k * 6144];
#pragma unroll
      for (int b = 0; b < 8; ++b) acc[b] += cact[b * 1024 + ks * 128 + k] * wv; }
#pragma unroll
    for (int b = 0; b < 8; ++b) red[(ks * 64 + jj) * 8 + b] = acc[b];
    __syncthreads();
    { const int b = tid >> 6; float sacc = p.in[4][j0 + jj];
#pragma unroll
      for (int k2 = 0; k2 < 8; ++k2) sacc += red[(k2 * 64 + jj) * 8 + b];
      ((float*)(ws + WS_MOD))[b * 6144 + j0 + jj] = sacc; }
  }
}

constexpr int WT_STRIDE = 144, WT_BYTES = 32 * WT_STRIDE;
DI void wt_write(char* wl, const f32x16& a0, const f32x16& a1, int r, int hh, float scale) {
  char* bp = wl + (4 * hh) * WT_STRIDE + r * 2;
#pragma unroll
  for (int reg = 0; reg < 16; ++reg) { const int ro = ((reg & 3) + 8 * (reg >> 2)) * WT_STRIDE;
    *(bf16_t*)(bp + ro) = f2bf(a0[reg] * scale); *(bf16_t*)(bp + ro + 64) = f2bf(a1[reg] * scale); }
}
DI void wt_write_rope(char* wl, const f32x16& a0, const f32x16& a1, int r, int hh, const float* cs, const float* sn, int m0) {
  char* bp = wl + (4 * hh) * WT_STRIDE + r * 2;
#pragma unroll
  for (int reg = 0; reg < 16; ++reg) { const int rw = (reg & 3) + 8 * (reg >> 2); const int row = m0 + rw + 4 * hh;
    const float c = cs[row * 32 + r], s = sn[row * 32 + r];
    *(bf16_t*)(bp + rw * WT_STRIDE) = f2bf(a0[reg] * c - a1[reg] * s); *(bf16_t*)(bp + rw * WT_STRIDE + 64) = f2bf(a1[reg] * c + a0[reg] * s); }
}
DI void wt_store(const char* wl, int lane, bf16_t* dA, int sA, bf16_t* dB, int sB) {
  const int piece = lane & 7, rsub = lane >> 3;
  bf16_t* d = (piece < 4) ? dA : dB; const int st = (piece < 4) ? sA : sB;
  if (d) {
#pragma unroll
    for (int i = 0; i < 4; ++i) { const int row = i * 8 + rsub; const uint4 v = *(const uint4*)(wl + row * WT_STRIDE + piece * 16);
      *(uint4*)(d + (size_t)row * st + (piece & 3) * 8) = v; }
  }
}
#define LDS_FENCE() asm volatile("s_waitcnt lgkmcnt(0)" ::: "memory")
DI int lv(int x) { asm volatile("" : "+v"(x)); return x; }
template <class T> DI T* launder(T* q) { size_t z = 0; asm volatile("" : "+s"(z)); return (T*)((char*)q + z); }

DI void phase1(const KP& p, char* lds) {
  const int tid = threadIdx.x, lane = tid & 63, w = tid >> 6, r = lane & 31, hh = lane >> 5;
  float* cs = (float*)(lds + LDS_TAB); float* sn = cs + 2048;
  char* wl = lds + w * WT_BYTES;
  for (int tile = blockIdx.x; tile < 256; tile += gridDim.x) {
    unsigned char* ws = launder(p.ws); unsigned char* ob = (unsigned char*)launder(p.out); const float* xin = launder(p.in[0]);
    const float* mod = (const float*)(ws + WS_MOD);
    const int tok0 = tile * 64, b = tile >> 5, t0 = (tile & 31) * 64;
    bf16_t* Hs = (bf16_t*)(ob + OUT_HS) + (size_t)tok0 * 1024;
    bf16_t* CQ = (bf16_t*)(ws + WS_CQ) + (size_t)tok0 * 640;
    bf16_t* CQN = (bf16_t*)(ob + OUT_CQN) + (size_t)tok0 * 384;
    bf16_t* CKVN = (bf16_t*)(ob + OUT_CKVN) + (size_t)tok0 * 256;
    bf16_t* GR = (bf16_t*)(ob + OUT_GR) + (size_t)tok0 * 32;
    bf16_t* Qm = (bf16_t*)(ws + WS_QM); bf16_t* Km = (bf16_t*)(ws + WS_KM); bf16_t* Vm = (bf16_t*)(ws + WS_VM);
    bf16_t* qg = (bf16_t*)(ws + WS_QG) + (size_t)tok0 * 256; bf16_t* kg = (bf16_t*)(ws + WS_KG) + (size_t)tok0 * 256;
    bf16_t* vg = (bf16_t*)(ws + WS_VG) + (size_t)tok0 * 512; bf16_t* rg = (bf16_t*)(ws + WS_RG) + (size_t)tok0 * 512;
    bf16_t* laf = (bf16_t*)(ws + WS_LAF) + (size_t)tok0 * 256; bf16_t* lab = (bf16_t*)(ws + WS_LAB) + (size_t)tok0 * 256;
    __syncthreads();
#pragma unroll
    for (int i = 0; i < 4; ++i) { const int e = tid + 512 * i, tt = e >> 5, j = e & 31;
      const float inv = powf(10000.f, -(float)j * (1.f / 32.f)); const float ang = (float)((const int*)p.in[2])[tok0 + tt] * inv;
      cs[e] = cosf(ang); sn[e] = sinf(ang); }
    {
      float4 ge[4], sh[4];
      const float* gpre = launder(p.in[5]); const float* modb = launder(mod) + b * 6144;
#pragma unroll
      for (int i = 0; i < 4; ++i) { const int d = (lane + 64 * i) * 4;
        const float4 g = *(const float4*)(gpre + d); const float4 sc = *(const float4*)(modb + 1024 + d); sh[i] = *(const float4*)(modb + d);
        ge[i] = make_float4(g.x * (1.f + sc.x), g.y * (1.f + sc.y), g.z * (1.f + sc.z), g.w * (1.f + sc.w)); }
      for (int rr = 0; rr < 8; ++rr) { const int row = w * 8 + rr;
        const float* xr = xin + (size_t)(tok0 + row) * 1024;
        float4 v[4]; float ss = 0.f;
#pragma unroll
        for (int i = 0; i < 4; ++i) { v[i] = *(const float4*)(xr + (lane + 64 * i) * 4); ss += v[i].x * v[i].x + v[i].y * v[i].y + v[i].z * v[i].z + v[i].w * v[i].w; }
        ss = wave_sum(ss); const float rs = rsqrtf(ss * (1.f / 1024.f) + EPS);
#pragma unroll
        for (int i = 0; i < 4; ++i) { uint2 o; o.x = pack2(v[i].x * rs * ge[i].x + sh[i].x, v[i].y * rs * ge[i].y + sh[i].y); o.y = pack2(v[i].z * rs * ge[i].z + sh[i].z, v[i].w * rs * ge[i].w + sh[i].w);
          *(uint2*)(Hs + (size_t)row * 1024 + (lane + 64 * i) * 4) = o; }
      }
    }
    __syncthreads();
    block_gemm(lds, Hs, 1024, (const bf16_t*)(ws + WS_WTIN), 1024, 9, 1024, [&](int m0, int n0, const f32x16& a0, const f32x16& a1) {
      const int r2 = lv(r), h2 = lv(hh), ln = lv(lane);
      if (n0 == O_KR) {
        wt_write_rope(wl, a0, a1, r2, h2, cs, sn, m0); LDS_FENCE();
        for (int h = 0; h < 4; ++h) { bf16_t* kp = Km + (((size_t)b * 4 + h) * SEQ + t0 + m0) * 192 + 128; wt_store(wl, ln, kp, 192, kp + 32, 192); }
        return; }
      wt_write(wl, a0, a1, r2, h2, (n0 >= O_QG && n0 < O_KG) ? 0.125f : 1.f); LDS_FENCE();
      bf16_t* d[2]; int st[2];
#pragma unroll
      for (int half = 0; half < 2; ++half) { const int nb = n0 + 32 * half;
        if (nb < 640) { d[half] = CQ + (size_t)m0 * 640 + nb; st[half] = 640; }
        else if (nb < O_KG) { d[half] = qg + (size_t)m0 * 256 + (nb - O_QG); st[half] = 256; }
        else if (nb < O_VG) { d[half] = kg + (size_t)m0 * 256 + (nb - O_KG); st[half] = 256; }
        else if (nb < O_GF) { d[half] = vg + (size_t)m0 * 512 + (nb - O_VG); st[half] = 512; }
        else if (nb < O_R) { d[half] = GR + (size_t)m0 * 32; st[half] = 32; }
        else if (nb < INW) { d[half] = rg + (size_t)m0 * 512 + (nb - O_R); st[half] = 512; }
        else { d[half] = nullptr; st[half] = 0; } }
      wt_store(wl, ln, d[0], st[0], d[1], st[1]);
    });
    __syncthreads();
    const float* gq = launder(p.in[8]); const float* gkv = launder(p.in[10]);
    const float* wgf = launder(p.in[12]); const float* bgf = launder(p.in[13]); const float* wgb = launder(p.in[14]); const float* bgb = launder(p.in[15]);
    for (int rr = 0; rr < 8; ++rr) { const int row = w * 8 + rr; const bf16_t* cr = CQ + (size_t)row * 640;
      float v[6]; float ss = 0.f;
#pragma unroll
      for (int i = 0; i < 6; ++i) { v[i] = bf2f(cr[lane + 64 * i]); ss += v[i] * v[i]; }
      ss = wave_sum(ss); float rs = rsqrtf(ss * (1.f / 384.f) + EPS);
#pragma unroll
      for (int i = 0; i < 6; ++i) CQN[(size_t)row * 384 + lane + 64 * i] = f2bf(v[i] * rs * gq[lane + 64 * i]);
      float u[4]; float s2 = 0.f;
#pragma unroll
      for (int i = 0; i < 4; ++i) { u[i] = bf2f(cr[384 + lane + 64 * i]); s2 += u[i] * u[i]; }
      s2 = wave_sum(s2); rs = rsqrtf(s2 * (1.f / 256.f) + EPS);
#pragma unroll
      for (int i = 0; i < 4; ++i) CKVN[(size_t)row * 256 + lane + 64 * i] = f2bf(u[i] * rs * gkv[lane + 64 * i]);
    }
    for (int i = 0; i < 32; ++i) { const int e = tid + 512 * i, tt = e >> 8, c = e & 255;
      float af = bgf[c], ab = bgb[c]; const bf16_t* gr = GR + tt * 32;
#pragma unroll
      for (int q = 0; q < 16; ++q) { af += bf2f(gr[q]) * wgf[q * 256 + c]; ab += bf2f(gr[16 + q]) * wgb[q * 256 + c]; }
      laf[tt * 256 + c] = f2bf(logsigmoid_f(af) * (1.f / 16.f)); lab[tt * 256 + c] = f2bf(logsigmoid_f(ab) * (1.f / 16.f)); }
    __syncthreads();
    block_gemm(lds, CQN, 384, (const bf16_t*)(ws + WS_WTQUP), 384, 3, 384, [&](int m0, int n0, const f32x16& a0, const f32x16& a1) {
      const int r2 = lv(r), h2 = lv(hh), ln = lv(lane);
      const int h = n0 / 192, d0 = n0 % 192;
      bf16_t* qp = Qm + (((size_t)b * 4 + h) * SEQ + t0 + m0) * 192 + d0;
      if (d0 < 128) wt_write(wl, a0, a1, r2, h2, 1.f); else wt_write_rope(wl, a0, a1, r2, h2, cs, sn, m0);
      LDS_FENCE();
      wt_store(wl, ln, qp, 192, qp + 32, 192);
    });
    block_gemm(lds, CKVN, 256, (const bf16_t*)(ws + WS_WTKVUP), 256, 4, 256, [&](int m0, int n0, const f32x16& a0, const f32x16& a1) {
      const int r2 = lv(r), h2 = lv(hh), ln = lv(lane);
      const int h = n0 >> 8, d0 = n0 & 255;
      wt_write(wl, a0, a1, r2, h2, 1.f); LDS_FENCE();
      if (d0 < 128) { bf16_t* kp = Km + (((size_t)b * 4 + h) * SEQ + t0 + m0) * 192 + d0; wt_store(wl, ln, kp, 192, kp + 32, 192); }
      else { bf16_t* vp = Vm + (((size_t)b * 4 + h) * SEQ + t0 + m0) * 128 + (d0 - 128); wt_store(wl, ln, vp, 128, vp + 32, 128); }
    });
  }
}

namespace att {
typedef short s16x4 __attribute__((ext_vector_type(4)));
typedef unsigned u32x4 __attribute__((ext_vector_type(4)));
constexpr int DQ = 192, DV = 128, KVBLK = 64;
constexpr float SCALE = 0.07216878364870322f;
constexpr float THR = 8.f;
constexpr int SHM_V = KVBLK * DV * 2, SHM_K = KVBLK * DQ * 2;
constexpr int SHM_QR = 8 * 32 * 176;
constexpr int SHM_ATTN = 2 * SHM_V + 2 * SHM_K + 8 * 64 * 4 + SHM_QR;
#define KSWZ(row, colB) ((row) * 384 + ((colB) ^ (((row) & 7) << 4)))
#define SBAR() __builtin_amdgcn_sched_barrier(0)
DI unsigned cvtpk(float lo, float hi) { unsigned r; asm volatile("v_cvt_pk_bf16_f32 %0, %1, %2" : "=v"(r) : "v"(lo), "v"(hi)); return r; }

DI void partialSM(f32x16& p0, f32x16& p1, float& m_reg, float& mn, float& alpha) {
  constexpr float C = SCALE * 1.4426950408889634f;
  float pmax = p0[0];
#pragma unroll
  for (int r = 1; r < 16; ++r) pmax = fmaxf(pmax, p0[r]);
#pragma unroll
  for (int r = 0; r < 16; ++r) pmax = fmaxf(pmax, p1[r]);
  { auto rr = __builtin_amdgcn_permlane32_swap(__float_as_uint(pmax), __float_as_uint(pmax), false, false);
    pmax = fmaxf(__uint_as_float(rr[0]), __uint_as_float(rr[1])); }
  if (__builtin_expect(__all(pmax - m_reg <= THR / SCALE), 1)) { mn = m_reg; alpha = 1.f; }
  else { mn = fmaxf(m_reg, pmax); alpha = __builtin_amdgcn_exp2f((m_reg - mn) * C); m_reg = mn; }
  const float mnC = -mn * C;
#pragma unroll
  for (int r = 0; r < 16; ++r) p0[r] = fmaf(p0[r], C, mnC);
#pragma unroll
  for (int r = 0; r < 16; ++r) p1[r] = fmaf(p1[r], C, mnC);
#pragma unroll
  for (int r = 0; r < 16; ++r) p0[r] = __builtin_amdgcn_exp2f(p0[r]);
}
DI void finishSM(f32x16& p0, f32x16& p1, float alpha, float& l_reg, bf16x8& pa0, bf16x8& pa1, bf16x8& pa2, bf16x8& pa3) {
#pragma unroll
  for (int r = 0; r < 16; ++r) p1[r] = __builtin_amdgcn_exp2f(p1[r]);
  float ps = 0;
#pragma unroll
  for (int r = 0; r < 16; ++r) ps += p0[r];
#pragma unroll
  for (int r = 0; r < 16; ++r) ps += p1[r];
  { auto rr = __builtin_amdgcn_permlane32_swap(__float_as_uint(ps), __float_as_uint(ps), false, false);
    ps = __uint_as_float(rr[0]) + __uint_as_float(rr[1]); }
  l_reg = l_reg * alpha + ps;
#define PK4(P, BASE, OUT) do { unsigned a0 = cvtpk(P[BASE + 0], P[BASE + 1]), a1 = cvtpk(P[BASE + 2], P[BASE + 3]);   \
    unsigned b0 = cvtpk(P[BASE + 4], P[BASE + 5]), b1 = cvtpk(P[BASE + 6], P[BASE + 7]);                              \
    auto r0 = __builtin_amdgcn_permlane32_swap(a0, b0, false, false); auto r1 = __builtin_amdgcn_permlane32_swap(a1, b1, false, false); \
    u32x4 wv = {r0[0], r1[0], r0[1], r1[1]}; OUT = *reinterpret_cast<bf16x8*>(&wv); } while (0)
  PK4(p0, 0, pa0); PK4(p0, 8, pa1); PK4(p1, 0, pa2); PK4(p1, 8, pa3);
#undef PK4
}
DI void qkt(f32x16& p0, f32x16& p1, const char* Ks, const bf16x8* qr, const char* qrl, int r32, int hi) {
#pragma unroll
  for (int i = 0; i < 16; ++i) { p0[i] = 0.f; p1[i] = 0.f; }
#pragma unroll
  for (int d0 = 0; d0 < 12; ++d0) { const int cb = (d0 * 16 + hi * 8) * 2;
    const bf16x8 b0 = *reinterpret_cast<const bf16x8*>(Ks + KSWZ(r32, cb));
    const bf16x8 b1 = *reinterpret_cast<const bf16x8*>(Ks + KSWZ(32 + r32, cb));
    const bf16x8 q = (d0 < 7) ? qr[d0 < 7 ? d0 : 0] : *reinterpret_cast<const bf16x8*>(qrl + (d0 - 7) * 32);
    p0 = MFMA32(b0, q, p0);
    p1 = MFMA32(b1, q, p1); }
}
DI int v_st(int k, int c) { const int kk = (k & ~0xC) | ((k & 4) << 1) | ((k & 8) >> 1); return ((kk >> 3) * 4 + (c >> 5)) * 512 + ((kk & 7) * 32 + (c & 31)) * 2; }
DI int v_rd_base(int lane) { return ((lane & 3) << 3) | (((lane >> 2) & 3) << 6) | (((lane >> 4) & 1) << 5) | (((lane >> 5) & 1) << 8); }
constexpr int v_rd_off(int d0, int ks, int half) { return d0 * 512 + ks * 4096 + half * 2048; }
template <int OFF> DI s16x4 tr_read(int vb) { s16x4 r; asm volatile("ds_read_b64_tr_b16 %0, %1 offset:%2" : "=&v"(r) : "v"(vb), "i"(OFF) : "memory"); return r; }
template <int D0> DI void pv_one(f32x16& od, int vb, bf16x8 pa0, bf16x8 pa1, bf16x8 pa2, bf16x8 pa3) {
  const s16x4 l0 = tr_read<v_rd_off(D0, 0, 0)>(vb), h0 = tr_read<v_rd_off(D0, 0, 1)>(vb), l1 = tr_read<v_rd_off(D0, 1, 0)>(vb), h1 = tr_read<v_rd_off(D0, 1, 1)>(vb);
  const s16x4 l2 = tr_read<v_rd_off(D0, 2, 0)>(vb), h2 = tr_read<v_rd_off(D0, 2, 1)>(vb), l3 = tr_read<v_rd_off(D0, 3, 0)>(vb), h3 = tr_read<v_rd_off(D0, 3, 1)>(vb);
  asm volatile("s_waitcnt lgkmcnt(0)" ::: "memory"); SBAR();
#define PK(L, H) (bf16x8){L[0], L[1], L[2], L[3], H[0], H[1], H[2], H[3]}
  od = MFMA32(pa0, PK(l0, h0), od);
  od = MFMA32(pa1, PK(l1, h1), od);
  od = MFMA32(pa2, PK(l2, h2), od);
  od = MFMA32(pa3, PK(l3, h3), od);
#undef PK
}
DI void pv_d0(f32x16* o, int vb, bf16x8 pa0, bf16x8 pa1, bf16x8 pa2, bf16x8 pa3) {
  pv_one<0>(o[0], vb, pa0, pa1, pa2, pa3); pv_one<1>(o[1], vb, pa0, pa1, pa2, pa3); pv_one<2>(o[2], vb, pa0, pa1, pa2, pa3); pv_one<3>(o[3], vb, pa0, pa1, pa2, pa3);
}
DI void attn_unit(const bf16_t* Qb, const bf16_t* Kh, const bf16_t* Vh, bf16_t* Ob, int seq, char* lds) {
  const int tid = lv(threadIdx.x), wid = tid >> 6, lane = tid & 63, r32 = lane & 31, hi = lane >> 5;
  char* V_lds = lds; char* K_lds = lds + 2 * SHM_V;
  float* wsf = (float*)(lds + 2 * SHM_V + 2 * SHM_K) + wid * 64; float* li_l = wsf; float* al_l = wsf + 32;
  char* qrl = lds + 2 * SHM_V + 2 * SHM_K + 8 * 64 * 4 + wid * (32 * 176) + r32 * 176 + hi * 16;
  float m_reg = -1e30f, l_reg = 0; f32x16 o[4]; bf16x8 qr[7];
#pragma unroll
  for (int d = 0; d < 4; ++d)
#pragma unroll
    for (int i = 0; i < 16; ++i) o[d][i] = 0.f;
  const bf16_t* Qw = Qb + (size_t)(wid * 32 + r32) * DQ + hi * 8;
#pragma unroll
  for (int d0 = 0; d0 < 7; ++d0) qr[d0] = *reinterpret_cast<const bf16x8*>(Qw + d0 * 16);
#pragma unroll
  for (int d0 = 7; d0 < 12; ++d0) *reinterpret_cast<bf16x8*>(qrl + (d0 - 7) * 32) = *reinterpret_cast<const bf16x8*>(Qw + d0 * 16);
  int kst[3];
#pragma unroll
  for (int i = 0; i < 3; ++i) { const int c = tid + 512 * i; kst[i] = KSWZ(c / 24, (c % 24) * 16); }
  const int vst0 = v_st(tid >> 4, (tid & 15) * 8), vst1 = v_st(32 + (tid >> 4), (tid & 15) * 8);
  const int vb0 = (int)(uintptr_t)V_lds + v_rd_base(lane);
  bf16x8 sk0, sk1, sk2, sv0, sv1;
#define SLOAD(k0) do { const bf16x8* kp = reinterpret_cast<const bf16x8*>(Kh + (size_t)(k0) * DQ) + tid; sk0 = kp[0]; sk1 = kp[512]; sk2 = kp[1024]; \
    const bf16x8* vp = reinterpret_cast<const bf16x8*>(Vh + (size_t)(k0) * DV) + tid; sv0 = vp[0]; sv1 = vp[512]; } while (0)
#define SWRITE(b) do { *(bf16x8*)(V_lds + (b) * SHM_V + vst0) = sv0; *(bf16x8*)(V_lds + (b) * SHM_V + vst1) = sv1; \
    *(bf16x8*)(K_lds + (b) * SHM_K + kst[0]) = sk0; *(bf16x8*)(K_lds + (b) * SHM_K + kst[1]) = sk1; *(bf16x8*)(K_lds + (b) * SHM_K + kst[2]) = sk2; } while (0)
#define RESC(a) do { if (__any((a) < 1.f)) { if (hi == 0) al_l[r32] = (a); asm volatile("s_waitcnt lgkmcnt(0)" ::: "memory"); \
    _Pragma("unroll") for (int d = 0; d < 4; ++d) _Pragma("unroll") for (int r = 0; r < 16; ++r) o[d][r] *= al_l[crow(r, hi)]; } } while (0)
  f32x16 pA0, pA1, pB0, pB1; float mnA, mnB, alA, alB; bf16x8 pa0, pa1, pa2, pa3; const int NT = seq / KVBLK;
  SLOAD(0); SWRITE(0); __syncthreads();
  qkt(pA0, pA1, K_lds, qr, qrl, r32, hi); partialSM(pA0, pA1, m_reg, mnA, alA);
  SLOAD(KVBLK); SWRITE(1); __syncthreads();
  for (int j = 1; j + 1 < NT; j += 2) {
    SBAR(); qkt(pB0, pB1, K_lds + SHM_K, qr, qrl, r32, hi);
    finishSM(pA0, pA1, alA, l_reg, pa0, pa1, pa2, pa3); SBAR();
    SLOAD((j + 1) * KVBLK); SBAR();
    pv_d0(o, vb0, pa0, pa1, pa2, pa3); partialSM(pB0, pB1, m_reg, mnB, alB);
    __syncthreads(); SWRITE(0);
    RESC(alB); __syncthreads();
    SBAR(); qkt(pA0, pA1, K_lds, qr, qrl, r32, hi);
    finishSM(pB0, pB1, alB, l_reg, pa0, pa1, pa2, pa3); SBAR();
    SLOAD((j + 2) * KVBLK); SBAR();
    pv_d0(o, vb0 + SHM_V, pa0, pa1, pa2, pa3); partialSM(pA0, pA1, m_reg, mnA, alA);
    __syncthreads(); SWRITE(1);
    RESC(alA); __syncthreads();
  }
  SBAR(); qkt(pB0, pB1, K_lds + SHM_K, qr, qrl, r32, hi);
  finishSM(pA0, pA1, alA, l_reg, pa0, pa1, pa2, pa3); SBAR();
  pv_d0(o, vb0, pa0, pa1, pa2, pa3); partialSM(pB0, pB1, m_reg, mnB, alB);
  __syncthreads(); RESC(alB);
  finishSM(pB0, pB1, alB, l_reg, pa0, pa1, pa2, pa3); SBAR();
  pv_d0(o, vb0 + SHM_V, pa0, pa1, pa2, pa3);
  if (hi == 0) li_l[r32] = l_reg; asm volatile("s_waitcnt lgkmcnt(0)" ::: "memory");
  float rli[16];
#pragma unroll
  for (int r = 0; r < 16; ++r) rli[r] = __builtin_amdgcn_rcpf(li_l[crow(r, hi)]);
  bf16_t* Ow = Ob + (size_t)(wid * 32) * 512;
#pragma unroll
  for (int r = 0; r < 16; ++r) { const int orow = crow(r, hi);
#pragma unroll
    for (int d0 = 0; d0 < 4; ++d0) Ow[(size_t)orow * 512 + d0 * 32 + r32] = f2bf(o[d0][r] * rli[r]); }
  __syncthreads();
#undef SLOAD
#undef SWRITE
#undef RESC
}
}

DI void phase2_attn(const KP& p, char* lds) {
  for (int u = blockIdx.x; u < 256; u += gridDim.x) {
    unsigned char* ws = launder(p.ws);
    const bf16_t* Qm = (const bf16_t*)(ws + WS_QM); const bf16_t* Km = (const bf16_t*)(ws + WS_KM); const bf16_t* Vm = (const bf16_t*)(ws + WS_VM);
    bf16_t* omla = (bf16_t*)(ws + WS_OMLA);
    const int qb = u & 7, bh = u >> 3, b = bh >> 2, h = bh & 3;
    att::attn_unit(Qm + ((size_t)bh * SEQ + qb * 256) * 192, Km + (size_t)bh * SEQ * 192, Vm + (size_t)bh * SEQ * 128,
                   omla + ((size_t)b * SEQ + qb * 256) * 512 + h * 128, SEQ, lds);
  }
}

constexpr int P3_TILE_BYTES = 384 * 1024;
constexpr int LDS_TK = LDS_GEMM;
constexpr int SCW = 260;
template <int N> DI void ce_desc(float (&a)[N], int i, int l) { const float hi = fmaxf(a[i], a[l]), lo = fminf(a[i], a[l]); a[i] = hi; a[l] = lo; }
DI void sort16_desc(float (&a)[16]) {
#pragma unroll
  for (int k = 2; k <= 16; k <<= 1)
#pragma unroll
    for (int j = k >> 1; j > 0; j >>= 1)
#pragma unroll
      for (int i = 0; i < 16; ++i) { const int l = i ^ j; if (l > i) { if ((i & k) == 0) ce_desc(a, i, l); else ce_desc(a, l, i); } }
}
DI void merge16_desc(float (&a)[16]) {
#pragma unroll
  for (int j = 8; j > 0; j >>= 1)
#pragma unroll
    for (int i = 0; i < 16; ++i) { const int l = i ^ j; if (l > i) ce_desc(a, i, l); }
}
DI void top16_merge(float (&a)[16], const float (&b)[16]) {
#pragma unroll
  for (int i = 0; i < 16; ++i) a[i] = fmaxf(a[i], b[15 - i]);
  merge16_desc(a);
}
template <int CTRL> DI float dpp_f(float v) { return __int_as_float(__builtin_amdgcn_mov_dpp(__float_as_int(v), CTRL, 0xF, 0xF, true)); }

DI float gelu_fast(float x) { return 0.5f * x * (1.f + erff(x * 0.70710678118654752f)); }

DI void phase3(const KP& p, char* lds) {
  const int tid0 = threadIdx.x;
  const int r = tid0 & 31, hh = (tid0 >> 5) & 1, lane = tid0 & 63;
  char* wl = lds + (tid0 >> 6) * WT_BYTES;
  for (int tile = blockIdx.x; tile < 256; tile += gridDim.x) {
    unsigned char* ws = launder(p.ws); float* outp = launder(p.out); const float* xin = launder(p.in[0]);
    const int tok0 = tile * 64, b = tile >> 5;
    unsigned char* tsc = ws + WS_QM + (size_t)tile * P3_TILE_BYTES;
    bf16_t* QRY = (bf16_t*)tsc; bf16_t* Y = (bf16_t*)tsc; bf16_t* MIXA = (bf16_t*)(tsc + 256 * 1024); bf16_t* H2 = MIXA;
    const float* modb = launder((const float*)(ws + WS_MOD)) + b * 6144;
    __syncthreads();
    {
      const int tid = lv(tid0), lane = tid & 63, w = tid >> 6;
      const bf16_t* omla = (const bf16_t*)(ws + WS_OMLA); const float* og = (const float*)(ws + WS_OG); const bf16_t* rg = (const bf16_t*)(ws + WS_RG);
      const float* ggl = launder(p.in[16]); const float g0 = ggl[lane * 2], g1 = ggl[lane * 2 + 1];
      for (int rr = 0; rr < 8; ++rr) { const int row = w * 8 + rr; const size_t tok = tok0 + row;
        *(uint4*)(MIXA + (size_t)row * 1024 + lane * 8) = *(const uint4*)(omla + tok * 512 + lane * 8);
#pragma unroll
        for (int h = 0; h < 4; ++h) { const float2 ov = *(const float2*)(og + tok * 512 + h * 128 + lane * 2);
          const float ss = wave_sum(ov.x * ov.x + ov.y * ov.y); const float rs = rsqrtf(ss * (1.f / 128.f) + EPS);
          const unsigned rv = *(const unsigned*)(rg + tok * 512 + h * 128 + lane * 2);
          const float r0 = __uint_as_float(rv << 16), r1 = __uint_as_float(rv & 0xffff0000u);
          *(unsigned*)(MIXA + (size_t)row * 1024 + 512 + h * 128 + lane * 2) = pack2(ov.x * rs * g0 * silu_f(r0), ov.y * rs * g1 * silu_f(r1)); }
      }
    }
    __syncthreads();
    block_gemm(lds, MIXA, 1024, (const bf16_t*)(ws + WS_WTOUT), 1024, 4, 1024, [&](int m0, int n0, const f32x16& a0, const f32x16& a1) {
      const int r2 = lv(r), h2 = lv(hh), ln = lv(lane);
      wt_write(wl, a0, a1, r2, h2, 1.f); LDS_FENCE();
      bf16_t* d = Y + (size_t)m0 * 1024 + n0; wt_store(wl, ln, d, 1024, d + 32, 1024);
    });
    __syncthreads();
    {
      const int tid = lv(tid0), lane = tid & 63, w = tid >> 6;
      float4 A1[4], A2[4], S2[4];
      const float* gpo = launder(p.in[6]); const float* gpf = launder(p.in[18]);
#pragma unroll
      for (int i = 0; i < 4; ++i) { const int d = (lane + 64 * i) * 4;
        const float4 gp = *(const float4*)(gpo + d), gt = *(const float4*)(modb + 2048 + d), g2 = *(const float4*)(gpf + d), sc = *(const float4*)(modb + 4096 + d);
        S2[i] = *(const float4*)(modb + 3072 + d);
        A1[i] = make_float4(gp.x * gt.x, gp.y * gt.y, gp.z * gt.z, gp.w * gt.w);
        A2[i] = make_float4(g2.x * (1.f + sc.x), g2.y * (1.f + sc.y), g2.z * (1.f + sc.z), g2.w * (1.f + sc.w)); }
      for (int rr = 0; rr < 8; ++rr) { const int row = w * 8 + rr; const size_t tok = tok0 + row;
        float4 yv[4]; float ss = 0.f;
#pragma unroll
        for (int i = 0; i < 4; ++i) { const uint2 u = *(const uint2*)(Y + (size_t)row * 1024 + (lane + 64 * i) * 4);
          yv[i] = make_float4(__uint_as_float(u.x << 16), __uint_as_float(u.x & 0xffff0000u), __uint_as_float(u.y << 16), __uint_as_float(u.y & 0xffff0000u));
          ss += yv[i].x * yv[i].x + yv[i].y * yv[i].y + yv[i].z * yv[i].z + yv[i].w * yv[i].w; }
        ss = wave_sum(ss); const float rs = rsqrtf(ss * (1.f / 1024.f) + EPS);
        float4 xv[4]; float s2 = 0.f;
#pragma unroll
        for (int i = 0; i < 4; ++i) { const float4 x = *(const float4*)(xin + tok * 1024 + (lane + 64 * i) * 4);
          xv[i] = make_float4(x.x + A1[i].x * yv[i].x * rs, x.y + A1[i].y * yv[i].y * rs, x.z + A1[i].z * yv[i].z * rs, x.w + A1[i].w * yv[i].w * rs);
          *(float4*)(outp + tok * 1024 + (lane + 64 * i) * 4) = xv[i];
          s2 += xv[i].x * xv[i].x + xv[i].y * xv[i].y + xv[i].z * xv[i].z + xv[i].w * xv[i].w; }
        s2 = wave_sum(s2); const float r2 = rsqrtf(s2 * (1.f / 1024.f) + EPS);
#pragma unroll
        for (int i = 0; i < 4; ++i) { uint2 o; o.x = pack2(xv[i].x * r2 * A2[i].x + S2[i].x, xv[i].y * r2 * A2[i].y + S2[i].y); o.y = pack2(xv[i].z * r2 * A2[i].z + S2[i].z, xv[i].w * r2 * A2[i].w + S2[i].w);
          *(uint2*)(H2 + (size_t)row * 1024 + (lane + 64 * i) * 4) = o; }
      }
    }
    __syncthreads();
    block_gemm(lds, H2, 1024, (const bf16_t*)(ws + WS_WTPQ), 1024, 8, 1024, [&](int m0, int n0, const f32x16& a0, const f32x16& a1) {
      const int r2 = lv(r), h2 = lv(hh), ln = lv(lane);
      wt_write(wl, a0, a1, r2, h2, 1.f); LDS_FENCE();
      bf16_t* d = QRY + (size_t)m0 * 2048 + n0; wt_store(wl, ln, d, 2048, d + 32, 2048);
    });
    float* SC = (float*)lds; unsigned* TK = (unsigned*)(lds + LDS_TK);
    for (int h = 0; h < 8; ++h) {
      block_gemm(lds, QRY + h * 256, 2048, (const bf16_t*)(ws + WS_KD), 256, 1, 256, [&](int m0, int n0, const f32x16& a0, const f32x16& a1) {
        const int r2 = lv(r), h2 = lv(hh);
        float* sp = SC + (m0 + 4 * h2) * SCW + n0 + r2;
#pragma unroll
        for (int reg = 0; reg < 16; ++reg) { const int ro = ((reg & 3) + 8 * (reg >> 2)) * SCW; sp[ro] = a0[reg]; sp[ro + 32] = a1[reg]; }
      });
      {
        const int tid = lv(tid0);
        const int tt = tid >> 3, sd = (tid >> 2) & 1, q = tid & 3;
        const float* sr = SC + tt * SCW + sd * 128 + q * 32;
        float a[16], c[16];
#pragma unroll
        for (int i = 0; i < 4; ++i) { const float4 v = *(const float4*)(sr + i * 4); const unsigned ib = q * 32 + i * 4;
          a[i * 4 + 0] = __uint_as_float((__float_as_uint(v.x) & 0xFFFFFF80u) | (ib + 0)); a[i * 4 + 1] = __uint_as_float((__float_as_uint(v.y) & 0xFFFFFF80u) | (ib + 1));
          a[i * 4 + 2] = __uint_as_float((__float_as_uint(v.z) & 0xFFFFFF80u) | (ib + 2)); a[i * 4 + 3] = __uint_as_float((__float_as_uint(v.w) & 0xFFFFFF80u) | (ib + 3)); }
#pragma unroll
        for (int i = 0; i < 4; ++i) { const float4 v = *(const float4*)(sr + 16 + i * 4); const unsigned ib = q * 32 + 16 + i * 4;
          c[i * 4 + 0] = __uint_as_float((__float_as_uint(v.x) & 0xFFFFFF80u) | (ib + 0)); c[i * 4 + 1] = __uint_as_float((__float_as_uint(v.y) & 0xFFFFFF80u) | (ib + 1));
          c[i * 4 + 2] = __uint_as_float((__float_as_uint(v.z) & 0xFFFFFF80u) | (ib + 2)); c[i * 4 + 3] = __uint_as_float((__float_as_uint(v.w) & 0xFFFFFF80u) | (ib + 3)); }
        sort16_desc(a); sort16_desc(c); top16_merge(a, c);
#pragma unroll
        for (int i = 0; i < 16; ++i) c[i] = dpp_f<0xB1>(a[i]);
        top16_merge(a, c);
#pragma unroll
        for (int i = 0; i < 16; ++i) c[i] = dpp_f<0x4E>(a[i]);
        top16_merge(a, c);
        if (q == 0) { unsigned* tk = TK + ((tt * 8 + h) * 2 + sd) * 16;
#pragma unroll
          for (int i = 0; i < 4; ++i) *(uint4*)(tk + i * 4) = make_uint4(__float_as_uint(a[i * 4]), __float_as_uint(a[i * 4 + 1]), __float_as_uint(a[i * 4 + 2]), __float_as_uint(a[i * 4 + 3])); }
      }
      __syncthreads();
    }
    int* EIDX = (int*)lds; float* GATE = (float*)(lds + 32768);
    {
      const int tid = lv(tid0);
      const int tt = tid >> 3, h = tid & 7;
      const unsigned* t1 = TK + ((tt * 8 + h) * 2) * 16; const unsigned* t2 = t1 + 16;
      float v1[16], v2[16];
#pragma unroll
      for (int i = 0; i < 4; ++i) { const uint4 u = *(const uint4*)(t1 + i * 4), v = *(const uint4*)(t2 + i * 4);
        v1[i * 4] = __uint_as_float(u.x & 0xFFFFFF80u); v1[i * 4 + 1] = __uint_as_float(u.y & 0xFFFFFF80u); v1[i * 4 + 2] = __uint_as_float(u.z & 0xFFFFFF80u); v1[i * 4 + 3] = __uint_as_float(u.w & 0xFFFFFF80u);
        v2[i * 4] = __uint_as_float(v.x & 0xFFFFFF80u); v2[i * 4 + 1] = __uint_as_float(v.y & 0xFFFFFF80u); v2[i * 4 + 2] = __uint_as_float(v.z & 0xFFFFFF80u); v2[i * 4 + 3] = __uint_as_float(v.w & 0xFFFFFF80u); }
      float best[16], grp[16];
#define CAND(i, j) __uint_as_float((__float_as_uint(v1[i] + v2[j]) & 0xFFFFFF00u) | ((i) << 4) | (j))
      best[0] = CAND(0, 0); best[1] = CAND(0, 1); best[2] = CAND(0, 2); best[3] = CAND(0, 3); best[4] = CAND(0, 4); best[5] = CAND(0, 5); best[6] = CAND(0, 6); best[7] = CAND(0, 7);
      best[8] = CAND(0, 8); best[9] = CAND(0, 9); best[10] = CAND(0, 10); best[11] = CAND(0, 11); best[12] = CAND(0, 12); best[13] = CAND(0, 13); best[14] = CAND(0, 14); best[15] = CAND(0, 15);
      sort16_desc(best);
      grp[0] = CAND(1, 0); grp[1] = CAND(1, 1); grp[2] = CAND(1, 2); grp[3] = CAND(1, 3); grp[4] = CAND(1, 4); grp[5] = CAND(1, 5); grp[6] = CAND(1, 6); grp[7] = CAND(1, 7);
      grp[8] = CAND(2, 0); grp[9] = CAND(2, 1); grp[10] = CAND(2, 2); grp[11] = CAND(2, 3); grp[12] = CAND(2, 4); grp[13] = CAND(3, 0); grp[14] = CAND(3, 1); grp[15] = CAND(3, 2);
      sort16_desc(grp); top16_merge(best, grp);
      grp[0] = CAND(3, 3); grp[1] = CAND(4, 0); grp[2] = CAND(4, 1); grp[3] = CAND(4, 2); grp[4] = CAND(5, 0); grp[5] = CAND(5, 1); grp[6] = CAND(6, 0); grp[7] = CAND(6, 1);
      grp[8] = CAND(7, 0); grp[9] = CAND(7, 1); grp[10] = CAND(8, 0); grp[11] = CAND(9, 0); grp[12] = CAND(10, 0); grp[13] = CAND(11, 0); grp[14] = CAND(12, 0); grp[15] = CAND(13, 0);
      sort16_desc(grp); top16_merge(best, grp);
      { const float c14 = CAND(14, 0), c15 = CAND(15, 0);
        grp[0] = fmaxf(c14, c15); grp[1] = fminf(c14, c15);
#pragma unroll
        for (int i = 2; i < 16; ++i) grp[i] = -3.0e38f;
        top16_merge(best, grp); }
#undef CAND
      __syncthreads();
      float sv[16]; int ev[16]; float mx = -3.0e38f;
#pragma unroll
      for (int k = 0; k < 16; ++k) { const unsigned key = __float_as_uint(best[k]); const int ci = (key >> 4) & 15, cj = key & 15;
        const unsigned k1 = t1[ci], k2 = t2[cj];
        sv[k] = __uint_as_float(k1 & 0xFFFFFF80u) + __uint_as_float(k2 & 0xFFFFFF80u); ev[k] = (int)((k1 & 127u) * 128u + (k2 & 127u)); mx = fmaxf(mx, sv[k]); }
      float sum = 0.f;
#pragma unroll
      for (int k = 0; k < 16; ++k) { sv[k] = __expf(sv[k] - mx); sum += sv[k]; }
      const float inv = 1.f / sum;
#pragma unroll
      for (int k = 0; k < 16; ++k) { EIDX[tt * 128 + h * 16 + k] = ev[k]; GATE[tt * 128 + h * 16 + k] = sv[k] * inv; }
    }
    __syncthreads();
    {
      const int tid = lv(tid0), lane = tid & 63, w = tid >> 6;
      const bf16_t* EU = (const bf16_t*)(ws + WS_EU); const bf16_t* EV = (const bf16_t*)(ws + WS_EV);
      const float* gpf2 = launder(p.in[19]);
      typedef __bf16 bf2 __attribute__((ext_vector_type(2)));
#pragma unroll 1
      for (int rr = 0; rr < 8; ++rr) { const int row = w * 8 + rr; const size_t tok = tok0 + row;
        const uint4 hA = *(const uint4*)(H2 + (size_t)row * 1024 + lane * 8), hB = *(const uint4*)(H2 + (size_t)row * 1024 + 512 + lane * 8);
        float acc[16];
#pragma unroll
        for (int i = 0; i < 16; ++i) acc[i] = 0.f;
#pragma unroll 1
        for (int g = 0; g < 32; ++g) {
          const int4 e4 = *(const int4*)(EIDX + row * 128 + g * 4);
          const int e0 = __builtin_amdgcn_readfirstlane(e4.x), e1 = __builtin_amdgcn_readfirstlane(e4.y), e2 = __builtin_amdgcn_readfirstlane(e4.z), e3 = __builtin_amdgcn_readfirstlane(e4.w);
          const float gte = GATE[row * 128 + g * 4 + (lane & 3)];
          uint4 ua[4], ub[4], va[4], vb[4];
          { const uint4* r0 = (const uint4*)(EU + (size_t)e0 * 1024); const uint4* r1 = (const uint4*)(EU + (size_t)e1 * 1024);
            const uint4* r2 = (const uint4*)(EU + (size_t)e2 * 1024); const uint4* r3 = (const uint4*)(EU + (size_t)e3 * 1024);
            ua[0] = r0[lane]; ub[0] = r0[64 + lane]; ua[1] = r1[lane]; ub[1] = r1[64 + lane]; ua[2] = r2[lane]; ub[2] = r2[64 + lane]; ua[3] = r3[lane]; ub[3] = r3[64 + lane]; }
          { const uint4* r0 = (const uint4*)(EV + (size_t)e0 * 1024); const uint4* r1 = (const uint4*)(EV + (size_t)e1 * 1024);
            const uint4* r2 = (const uint4*)(EV + (size_t)e2 * 1024); const uint4* r3 = (const uint4*)(EV + (size_t)e3 * 1024);
            va[0] = r0[lane]; vb[0] = r0[64 + lane]; va[1] = r1[lane]; vb[1] = r1[64 + lane]; va[2] = r2[lane]; vb[2] = r2[64 + lane]; va[3] = r3[lane]; vb[3] = r3[64 + lane]; }
          float P4[4];
#pragma unroll
          for (int k2 = 0; k2 < 4; ++k2) {
            float d = __builtin_amdgcn_fdot2_f32_bf16(__builtin_bit_cast(bf2, ua[k2].x), __builtin_bit_cast(bf2, hA.x), 0.f, false);
            d = __builtin_amdgcn_fdot2_f32_bf16(__builtin_bit_cast(bf2, ua[k2].y), __builtin_bit_cast(bf2, hA.y), d, false);
            d = __builtin_amdgcn_fdot2_f32_bf16(__builtin_bit_cast(bf2, ua[k2].z), __builtin_bit_cast(bf2, hA.z), d, false);
            d = __builtin_amdgcn_fdot2_f32_bf16(__builtin_bit_cast(bf2, ua[k2].w), __builtin_bit_cast(bf2, hA.w), d, false);
            d = __builtin_amdgcn_fdot2_f32_bf16(__builtin_bit_cast(bf2, ub[k2].x), __builtin_bit_cast(bf2, hB.x), d, false);
            d = __builtin_amdgcn_fdot2_f32_bf16(__builtin_bit_cast(bf2, ub[k2].y), __builtin_bit_cast(bf2, hB.y), d, false);
            d = __builtin_amdgcn_fdot2_f32_bf16(__builtin_bit_cast(bf2, ub[k2].z), __builtin_bit_cast(bf2, hB.z), d, false);
            d = __builtin_amdgcn_fdot2_f32_bf16(__builtin_bit_cast(bf2, ub[k2].w), __builtin_bit_cast(bf2, hB.w), d, false);
            P4[k2] = d; }
          { const bool up2 = (lane & 2) != 0;
            const float k0 = up2 ? P4[2] : P4[0], s0 = up2 ? P4[0] : P4[2], k1 = up2 ? P4[3] : P4[1], s1 = up2 ? P4[1] : P4[3];
            const float q0 = k0 + dpp_f<0x4E>(s0), q1 = k1 + dpp_f<0x4E>(s1);
            const bool up1 = (lane & 1) != 0;
            const float kk = up1 ? q1 : q0, ss1 = up1 ? q0 : q1;
            float av = kk + dpp_f<0xB1>(ss1);
            av += __shfl_xor(av, 4); av += __shfl_xor(av, 8); av += __shfl_xor(av, 16); av += __shfl_xor(av, 32);
            const float ax = fabsf(av), t = __builtin_amdgcn_rcpf(ax * 0.2316418882f + 1.0f);
            float q = t * 0.5307027145f + (-0.7265760135f); q = q * t + 0.7107068705f; q = q * t + (-0.142248368f); q = q * t + 0.127414796f; q = q * t;
            const float ee = __builtin_amdgcn_exp2f(av * av * (-0.72134752044f));
            const float mm = av * (q * ee), gl = (av < 0.f) ? mm : (av - mm);
            P4[0] = gte * gl; }
#pragma unroll
          for (int k2 = 0; k2 < 4; ++k2) {
            const float wk = __int_as_float(__builtin_amdgcn_readlane(__float_as_int(P4[0]), k2));
            acc[0] += wk * __uint_as_float(va[k2].x << 16); acc[1] += wk * __uint_as_float(va[k2].x & 0xffff0000u); acc[2] += wk * __uint_as_float(va[k2].y << 16); acc[3] += wk * __uint_as_float(va[k2].y & 0xffff0000u);
            acc[4] += wk * __uint_as_float(va[k2].z << 16); acc[5] += wk * __uint_as_float(va[k2].z & 0xffff0000u); acc[6] += wk * __uint_as_float(va[k2].w << 16); acc[7] += wk * __uint_as_float(va[k2].w & 0xffff0000u);
            acc[8] += wk * __uint_as_float(vb[k2].x << 16); acc[9] += wk * __uint_as_float(vb[k2].x & 0xffff0000u); acc[10] += wk * __uint_as_float(vb[k2].y << 16); acc[11] += wk * __uint_as_float(vb[k2].y & 0xffff0000u);
            acc[12] += wk * __uint_as_float(vb[k2].z << 16); acc[13] += wk * __uint_as_float(vb[k2].z & 0xffff0000u); acc[14] += wk * __uint_as_float(vb[k2].w << 16); acc[15] += wk * __uint_as_float(vb[k2].w & 0xffff0000u); }
        }
        float ss = 0.f;
#pragma unroll
        for (int i = 0; i < 16; ++i) ss += acc[i] * acc[i];
        ss = wave_sum(ss); const float rs = rsqrtf(ss * (1.f / 1024.f) + EPS);
        float* orow = outp + tok * 1024;
#pragma unroll
        for (int i = 0; i < 2; ++i)
#pragma unroll
          for (int j = 0; j < 2; ++j) { const int d = 512 * i + lane * 8 + 4 * j; const int o = i * 8 + j * 4;
            float4 x1 = *(const float4*)(orow + d); const float4 g3 = *(const float4*)(gpf2 + d), g2 = *(const float4*)(modb + 5120 + d);
            x1.x += g3.x * g2.x * acc[o] * rs; x1.y += g3.y * g2.y * acc[o + 1] * rs; x1.z += g3.z * g2.z * acc[o + 2] * rs; x1.w += g3.w * g2.w * acc[o + 3] * rs;
            *(float4*)(orow + d) = x1; }
      }
    }
  }
}

__global__ void __launch_bounds__(NTHR, 2) mega(KP p) {
  extern __shared__ __attribute__((aligned(16))) char lds[];
  cg::grid_group grid = cg::this_grid();
  if (p.ph_lo <= 0 && 0 < p.ph_hi) { phase0(p, lds); if (1 < p.ph_hi) grid.sync(); }
  if (p.ph_lo <= 1 && 1 < p.ph_hi) { phase1(p, lds); if (2 < p.ph_hi) grid.sync(); }
  if (p.ph_lo <= 2 && 2 < p.ph_hi) { phase2_attn(p, lds); if (3 < p.ph_hi) grid.sync(); }
  if (p.ph_lo <= 3 && 3 < p.ph_hi) { phase3(p, lds); }
}

extern "C" void kernel_launch(void* const* d_in, const int* in_sizes, int n_in, void* d_out, int out_size, void* d_ws, size_t ws_size, hipStream_t stream) {
  float* out = (float*)d_out;
  unsigned char* ws = (unsigned char*)d_ws;
  if (ws_size < WS_END || n_in != 25) return;
  static bool attr_done = false;
  if (!attr_done) { (void)hipFuncSetAttribute((const void*)mega, hipFuncAttributeMaxDynamicSharedMemorySize, LDS_TOTAL); attr_done = true; }
  KP p{};
  for (int i = 0; i < 25; ++i) p.in[i] = (const float*)d_in[i];
  p.out = out; p.ws = ws;
  p.ph_lo = 0; p.ph_hi = 3;
  { void* args[] = {&p}; (void)hipLaunchCooperativeKernel((const void*)mega, dim3(256), dim3(NTHR), args, LDS_TOTAL, stream); }
  n_gla<<<32, 128, 0, stream>>>((const bf16_t*)(ws + WS_QG), (const bf16_t*)(ws + WS_KG), (const bf16_t*)(ws + WS_VG), (const bf16_t*)(ws + WS_LAF), (const bf16_t*)(ws + WS_LAB), (float*)(ws + WS_OG));
  p.ph_lo = 3; p.ph_hi = 4;
  { void* args[] = {&p}; (void)hipLaunchCooperativeKernel((const void*)mega, dim3(256), dim3(NTHR), args, LDS_TOTAL, stream); }
}
```

```cpp
#include <hip/hip_runtime.h>
#include <hip/hip_cooperative_groups.h>
namespace cg = cooperative_groups;
#include <stdint.h>

typedef unsigned short bf16_t;
#define DI __device__ __forceinline__

DI float bf2f(bf16_t v) { return __uint_as_float(((unsigned)v) << 16); }
DI bf16_t f2bf(float f) { unsigned u = __float_as_uint(f); u += 0x7fffu + ((u >> 16) & 1u); return (bf16_t)(u >> 16); }

constexpr int BATCH = 8, SEQ = 2048, DM = 1024, NTOK = BATCH * SEQ;
constexpr int INW = 2272;
constexpr float EPS = 1e-6f;
constexpr int O_CQ = 0, O_CKV = 384, O_KR = 640, O_QG = 704, O_KG = 960, O_VG = 1216, O_GF = 1728, O_GB = 1744, O_R = 1760;

DI float wave_sum(float v) {
#pragma unroll
  for (int o = 1; o < 64; o <<= 1) v += __shfl_xor(v, o);
  return v;
}
DI float wave_max(float v) {
#pragma unroll
  for (int o = 1; o < 64; o <<= 1) v = fmaxf(v, __shfl_xor(v, o));
  return v;
}
DI float block_sum256(float v, float* red) {
  v = wave_sum(v);
  __syncthreads();
  if ((threadIdx.x & 63) == 0) red[threadIdx.x >> 6] = v;
  __syncthreads();
  return red[0] + red[1] + red[2] + red[3];
}
DI float block_max256(float v, float* red) {
  v = wave_max(v);
  __syncthreads();
  if ((threadIdx.x & 63) == 0) red[threadIdx.x >> 6] = v;
  __syncthreads();
  return fmaxf(fmaxf(red[0], red[1]), fmaxf(red[2], red[3]));
}
DI float silu_f(float x) { return x / (1.f + expf(-x)); }
DI float logsigmoid_f(float x) { return fminf(x, 0.f) - log1pf(expf(-fabsf(x))); }
DI float gelu_erf(float x) { return 0.5f * x * (1.f + erff(x * 0.70710678118654752f)); }

__global__ __launch_bounds__(256) void n_mod(const float* __restrict__ c, const float* __restrict__ w_ada, const float* __restrict__ b_ada, float* __restrict__ mod) {
  int idx = blockIdx.x * 256 + threadIdx.x;
  int b = idx / 6144, j = idx % 6144;
  float acc = b_ada[j];
  for (int k = 0; k < 1024; ++k) acc += silu_f(c[b * 1024 + k]) * w_ada[(size_t)k * 6144 + j];
  mod[idx] = acc;
}

__global__ __launch_bounds__(256) void n_hnorm(const float* __restrict__ x, const float* __restrict__ g, const float* __restrict__ mod, int b, int off_sh, int off_sc, float* __restrict__ h) {
  __shared__ float red[4];
  int t = blockIdx.x, tid = threadIdx.x;
  const float* xr = x + ((size_t)b * SEQ + t) * DM;
  float v[4]; float ss = 0.f;
#pragma unroll
  for (int i = 0; i < 4; ++i) { v[i] = xr[tid + 256 * i]; ss += v[i] * v[i]; }
  ss = block_sum256(ss, red);
  float rs = rsqrtf(ss * (1.f / DM) + EPS);
#pragma unroll
  for (int i = 0; i < 4; ++i) { int d = tid + 256 * i; h[(size_t)t * DM + d] = v[i] * rs * g[d] * (1.f + mod[b * 6144 + off_sc + d]) + mod[b * 6144 + off_sh + d]; }
}

template <bool BT>
__global__ __launch_bounds__(256) void n_gemm(const float* __restrict__ A, int lda, const float* __restrict__ B, int ldb, float* __restrict__ C, int ldc, int M, int N, int K) {
  __shared__ float As[16][65];
  __shared__ float Bs[16][65];
  const int tid = threadIdx.x, tx = tid & 15, ty = tid >> 4;
  const int m0 = blockIdx.y * 64, n0 = blockIdx.x * 64;
  float acc[4][4];
#pragma unroll
  for (int i = 0; i < 4; ++i)
#pragma unroll
    for (int j = 0; j < 4; ++j) acc[i][j] = 0.f;
  for (int k0 = 0; k0 < K; k0 += 16) {
#pragma unroll
    for (int i = 0; i < 4; ++i) { int e = tid + 256 * i; int m = e >> 4, k = e & 15; As[k][m] = A[(size_t)(m0 + m) * lda + k0 + k]; }
#pragma unroll
    for (int i = 0; i < 4; ++i) { int e = tid + 256 * i;
      if (!BT) { int k = e >> 6, n = e & 63; Bs[k][n] = (n0 + n < N) ? B[(size_t)(k0 + k) * ldb + n0 + n] : 0.f; }
      else     { int n = e >> 4, k = e & 15; Bs[k][n] = (n0 + n < N) ? B[(size_t)(n0 + n) * ldb + k0 + k] : 0.f; } }
    __syncthreads();
#pragma unroll
    for (int k = 0; k < 16; ++k) {
      float a[4], bb[4];
#pragma unroll
      for (int i = 0; i < 4; ++i) { a[i] = As[k][ty * 4 + i]; bb[i] = Bs[k][tx * 4 + i]; }
#pragma unroll
      for (int i = 0; i < 4; ++i)
#pragma unroll
        for (int j = 0; j < 4; ++j) acc[i][j] += a[i] * bb[j];
    }
    __syncthreads();
  }
#pragma unroll
  for (int i = 0; i < 4; ++i)
#pragma unroll
    for (int j = 0; j < 4; ++j) { int n = n0 + tx * 4 + j; if (n < N) C[(size_t)(m0 + ty * 4 + i) * ldc + n] = acc[i][j]; }
}

__global__ __launch_bounds__(256) void n_rms_slice(const float* __restrict__ in, int ldin, int off, int W, const float* __restrict__ g, float* __restrict__ out) {
  __shared__ float red[4];
  int t = blockIdx.x, tid = threadIdx.x;
  float v0 = (tid < W) ? in[(size_t)t * ldin + off + tid] : 0.f;
  float v1 = (tid + 256 < W) ? in[(size_t)t * ldin + off + tid + 256] : 0.f;
  float ss = block_sum256(v0 * v0 + v1 * v1, red);
  float rs = rsqrtf(ss / (float)W + EPS);
  if (tid < W) out[(size_t)t * W + tid] = v0 * rs * g[tid];
  if (tid + 256 < W) out[(size_t)t * W + tid + 256] = v1 * rs * g[tid + 256];
}

__global__ __launch_bounds__(256) void n_scatter(const float* __restrict__ proj, const float* __restrict__ qa, const float* __restrict__ kv, const int* __restrict__ positions, int b,
                                                 const float* __restrict__ wgf, const float* __restrict__ bgf, const float* __restrict__ wgb, const float* __restrict__ bgb,
                                                 bf16_t* __restrict__ Qm, bf16_t* __restrict__ Km, bf16_t* __restrict__ Vm, bf16_t* __restrict__ qg, bf16_t* __restrict__ kg, bf16_t* __restrict__ vg,
                                                 bf16_t* __restrict__ rg, float* __restrict__ laf, float* __restrict__ lab) {
  __shared__ float cs[32], sn[32];
  const int t = blockIdx.x, tid = threadIdx.x;
  const size_t tok = (size_t)b * SEQ + t;
  const float* pr = proj + (size_t)t * INW;
  const float* qr = qa + (size_t)t * 768;
  const float* kr = kv + (size_t)t * 1024;
  if (tid < 32) {
    float inv = powf(10000.f, -(float)tid / 32.f);
    float ang = (float)positions[tok] * inv;
    cs[tid] = cosf(ang); sn[tid] = sinf(ang);
  }
  __syncthreads();
  for (int e = tid; e < 4 * 192; e += 256) {
    int h = e / 192, d = e % 192; float v;
    if (d < 128) v = qr[h * 192 + d];
    else { int j = d - 128; const float* rp = qr + h * 192 + 128;
      if (j < 32) v = rp[j] * cs[j] - rp[j + 32] * sn[j]; else v = rp[j] * cs[j - 32] + rp[j - 32] * sn[j - 32]; }
    Qm[(((size_t)b * 4 + h) * SEQ + t) * 192 + d] = f2bf(v);
  }
  for (int e = tid; e < 4 * 192; e += 256) {
    int h = e / 192, d = e % 192; float v;
    if (d < 128) v = kr[h * 256 + d];
    else { int j = d - 128; const float* rp = pr + O_KR;
      if (j < 32) v = rp[j] * cs[j] - rp[j + 32] * sn[j]; else v = rp[j] * cs[j - 32] + rp[j - 32] * sn[j - 32]; }
    Km[(((size_t)b * 4 + h) * SEQ + t) * 192 + d] = f2bf(v);
  }
  for (int e = tid; e < 512; e += 256) { int h = e >> 7, d = e & 127; Vm[(((size_t)b * 4 + h) * SEQ + t) * 128 + d] = f2bf(kr[h * 256 + 128 + d]); }
  { int e = tid; qg[tok * 256 + e] = f2bf(pr[O_QG + e] * 0.125f); kg[tok * 256 + e] = f2bf(pr[O_KG + e]); }
  for (int e = tid; e < 512; e += 256) { vg[tok * 512 + e] = f2bf(pr[O_VG + e]); rg[tok * 512 + e] = f2bf(pr[O_R + e]); }
  { int cidx = tid; float af = bgf[cidx], ab = bgb[cidx];
#pragma unroll
    for (int r = 0; r < 16; ++r) { af += pr[O_GF + r] * wgf[r * 256 + cidx]; ab += pr[O_GB + r] * wgb[r * 256 + cidx]; }
    laf[tok * 256 + cidx] = logsigmoid_f(af) * (1.f / 16.f); lab[tok * 256 + cidx] = logsigmoid_f(ab) * (1.f / 16.f); }
}

__global__ __launch_bounds__(256) void n_attn(const bf16_t* __restrict__ Qm, const bf16_t* __restrict__ Km, const bf16_t* __restrict__ Vm, bf16_t* __restrict__ omla) {
  __shared__ float qs[192]; __shared__ float sc[2048]; __shared__ float red[4];
  const int i = blockIdx.x, h = blockIdx.y, b = blockIdx.z, tid = threadIdx.x;
  const size_t bh = (size_t)b * 4 + h;
  if (tid < 192) qs[tid] = bf2f(Qm[(bh * SEQ + i) * 192 + tid]);
  __syncthreads();
  float mx = -1e30f;
  for (int kk = 0; kk < 8; ++kk) {
    int key = tid + 256 * kk; const uint4* kr = (const uint4*)(Km + (bh * SEQ + key) * 192);
    float s = 0.f;
    for (int c = 0; c < 24; ++c) { uint4 w = kr[c]; const float* q = qs + c * 8;
      s += q[0] * __uint_as_float(w.x << 16) + q[1] * __uint_as_float(w.x & 0xffff0000u) + q[2] * __uint_as_float(w.y << 16) + q[3] * __uint_as_float(w.y & 0xffff0000u)
         + q[4] * __uint_as_float(w.z << 16) + q[5] * __uint_as_float(w.z & 0xffff0000u) + q[6] * __uint_as_float(w.w << 16) + q[7] * __uint_as_float(w.w & 0xffff0000u); }
    s *= 0.07216878364870322f; sc[key] = s; mx = fmaxf(mx, s);
  }
  mx = block_max256(mx, red);
  float sum = 0.f;
  for (int kk = 0; kk < 8; ++kk) { int key = tid + 256 * kk; float p = expf(sc[key] - mx); sc[key] = p; sum += p; }
  sum = block_sum256(sum, red);
  __syncthreads();
  if (tid < 128) { float o = 0.f; const bf16_t* vp = Vm + bh * SEQ * 128 + tid;
    for (int key = 0; key < SEQ; ++key) o += sc[key] * bf2f(vp[(size_t)key * 128]);
    omla[((size_t)b * SEQ + i) * 512 + h * 128 + tid] = f2bf(o / sum); }
}

__global__ __launch_bounds__(128) void n_gla(const bf16_t* __restrict__ qg, const bf16_t* __restrict__ kg, const bf16_t* __restrict__ vg, const bf16_t* __restrict__ laf, const bf16_t* __restrict__ lab, float* __restrict__ og) {
  __shared__ float qs[64], ks[64], as[64];
  const int bh = blockIdx.x, b = bh >> 2, h = bh & 3, dv = threadIdx.x;
  for (int dir = 0; dir < 2; ++dir) {
    float S[64];
#pragma unroll
    for (int d = 0; d < 64; ++d) S[d] = 0.f;
    const bf16_t* la = dir ? lab : laf;
    for (int s = 0; s < SEQ; ++s) {
      const int t = dir ? (SEQ - 1 - s) : s; const size_t tok = (size_t)b * SEQ + t;
      __syncthreads();
      if (dv < 64) { qs[dv] = bf2f(qg[tok * 256 + h * 64 + dv]); ks[dv] = bf2f(kg[tok * 256 + h * 64 + dv]); as[dv] = expf(bf2f(la[tok * 256 + h * 64 + dv])); }
      __syncthreads();
      const float v = bf2f(vg[tok * 512 + h * 128 + dv]); float o = 0.f;
#pragma unroll
      for (int d = 0; d < 64; ++d) { S[d] = as[d] * S[d] + ks[d] * v; o += qs[d] * S[d]; }
      if (dir == 0) og[tok * 512 + h * 128 + dv] = o; else og[tok * 512 + h * 128 + dv] += o;
    }
  }
}

__global__ __launch_bounds__(256) void n_mix(const bf16_t* __restrict__ omla, const float* __restrict__ og, const bf16_t* __restrict__ rg, const float* __restrict__ g_gla, int b, float* __restrict__ mix) {
  __shared__ float ssum[4];
  const int t = blockIdx.x, tid = threadIdx.x; const size_t tok = (size_t)b * SEQ + t;
  if (tid < 4) ssum[tid] = 0.f;
  __syncthreads();
  float v[2];
#pragma unroll
  for (int i = 0; i < 2; ++i) { int e = tid + 256 * i; v[i] = og[tok * 512 + e]; atomicAdd(&ssum[e >> 7], v[i] * v[i]); mix[(size_t)t * DM + e] = bf2f(omla[tok * 512 + e]); }
  __syncthreads();
#pragma unroll
  for (int i = 0; i < 2; ++i) { int e = tid + 256 * i; float rs = rsqrtf(ssum[e >> 7] * (1.f / 128.f) + EPS);
    mix[(size_t)t * DM + 512 + e] = v[i] * rs * g_gla[e & 127] * silu_f(bf2f(rg[tok * 512 + e])); }
}

__global__ __launch_bounds__(256) void n_post1(const float* __restrict__ x, const float* __restrict__ y, const float* __restrict__ g_post, const float* __restrict__ g_pre2, const float* __restrict__ mod, int b,
                                               float* __restrict__ out, float* __restrict__ h2) {
  __shared__ float red[4];
  const int t = blockIdx.x, tid = threadIdx.x; const size_t tok = (size_t)b * SEQ + t;
  float yv[4], xv[4]; float ss = 0.f;
#pragma unroll
  for (int i = 0; i < 4; ++i) { yv[i] = y[(size_t)t * DM + tid + 256 * i]; ss += yv[i] * yv[i]; }
  ss = block_sum256(ss, red);
  float rs = rsqrtf(ss * (1.f / DM) + EPS); float s2 = 0.f;
#pragma unroll
  for (int i = 0; i < 4; ++i) { int d = tid + 256 * i; xv[i] = x[tok * DM + d] + mod[b * 6144 + 2048 + d] * (yv[i] * rs * g_post[d]); out[tok * DM + d] = xv[i]; s2 += xv[i] * xv[i]; }
  s2 = block_sum256(s2, red);
  float r2 = rsqrtf(s2 * (1.f / DM) + EPS);
#pragma unroll
  for (int i = 0; i < 4; ++i) { int d = tid + 256 * i; h2[(size_t)t * DM + d] = xv[i] * r2 * g_pre2[d] * (1.f + mod[b * 6144 + 4096 + d]) + mod[b * 6144 + 3072 + d]; }
}

DI void wave_argmax(float& v, int& i) {
#pragma unroll
  for (int o = 1; o < 64; o <<= 1) { float ov = __shfl_xor(v, o); int oi = __shfl_xor(i, o); if (ov > v || (ov == v && oi < i)) { v = ov; i = oi; } }
}
__global__ __launch_bounds__(256) void n_peer_select(const float* __restrict__ qry, const float* __restrict__ sk1, const float* __restrict__ sk2, int* __restrict__ eidx, float* __restrict__ gate) {
  __shared__ float v1s[4][16], v2s[4][16]; __shared__ int i1s[4][16], i2s[4][16];
  const int w = threadIdx.x >> 6, lane = threadIdx.x & 63;
  const int pair = blockIdx.x * 4 + w;
  const int t = pair >> 3, h = pair & 7;
  const float* q1 = qry + (size_t)t * 2048 + h * 256; const float* q2 = q1 + 128;
  float s1a = 0.f, s1b = 0.f, s2a = 0.f, s2b = 0.f;
  for (int d = 0; d < 128; ++d) { float a = q1[d], bq = q2[d];
    s1a += a * sk1[lane * 128 + d]; s1b += a * sk1[(lane + 64) * 128 + d]; s2a += bq * sk2[lane * 128 + d]; s2b += bq * sk2[(lane + 64) * 128 + d]; }
  for (int side = 0; side < 2; ++side) {
    float va = side ? s2a : s1a, vb = side ? s2b : s1b; bool ta = false, tb = false;
    for (int k = 0; k < 16; ++k) {
      float bv; int bi;
      if (!ta && (tb || va >= vb)) { bv = va; bi = lane; } else if (!tb) { bv = vb; bi = lane + 64; } else { bv = -3e38f; bi = 1 << 20; }
      wave_argmax(bv, bi);
      if (bi == lane) ta = true; if (bi == lane + 64) tb = true;
      if (lane == 0) { if (side) { v2s[w][k] = bv; i2s[w][k] = bi; } else { v1s[w][k] = bv; i1s[w][k] = bi; } }
    }
  }
  __syncthreads();
  float cv[4]; bool tk[4];
#pragma unroll
  for (int j = 0; j < 4; ++j) { int c = lane + 64 * j; cv[j] = v1s[w][c >> 4] + v2s[w][c & 15]; tk[j] = false; }
  float topv = 0.f; int topc = 0; float mx = 0.f;
  for (int k = 0; k < 16; ++k) {
    float bv = -3e38f; int bi = 1 << 20;
#pragma unroll
    for (int j = 0; j < 4; ++j) { if (!tk[j] && cv[j] > bv) { bv = cv[j]; bi = lane + 64 * j; } }
    wave_argmax(bv, bi);
#pragma unroll
    for (int j = 0; j < 4; ++j) if (bi == lane + 64 * j) tk[j] = true;
    if (k == 0) mx = bv;
    if (lane == k) { topv = bv; topc = bi; }
  }
  float e = (lane < 16) ? expf(topv - mx) : 0.f;
  float sum = wave_sum(e);
  if (lane < 16) { eidx[(size_t)pair * 16 + lane] = i1s[w][topc >> 4] * 128 + i2s[w][topc & 15]; gate[(size_t)pair * 16 + lane] = e / sum; }
}

__global__ __launch_bounds__(256) void n_peer_apply(const float* __restrict__ h2, const int* __restrict__ eidx, const float* __restrict__ gate, const float* __restrict__ eu, const float* __restrict__ ev,
                                                    const float* __restrict__ g_post, const float* __restrict__ mod, int b, float* __restrict__ out) {
  __shared__ float ys[4][1024]; __shared__ float red[4];
  const int t = blockIdx.x, tid = threadIdx.x, w = tid >> 6, lane = tid & 63; const size_t tok = (size_t)b * SEQ + t;
  float4 hx[4];
#pragma unroll
  for (int i = 0; i < 4; ++i) hx[i] = *(const float4*)(h2 + (size_t)t * DM + (lane + 64 * i) * 4);
  float4 acc[4];
#pragma unroll
  for (int i = 0; i < 4; ++i) acc[i] = make_float4(0.f, 0.f, 0.f, 0.f);
  for (int k = w; k < 128; k += 4) {
    const int e = eidx[(size_t)t * 128 + k]; const float gt = gate[(size_t)t * 128 + k];
    const float4* ur = (const float4*)(eu + (size_t)e * DM); const float4* vr = (const float4*)(ev + (size_t)e * DM);
    float d = 0.f;
#pragma unroll
    for (int i = 0; i < 4; ++i) { float4 u = ur[lane + 64 * i]; d += u.x * hx[i].x + u.y * hx[i].y + u.z * hx[i].z + u.w * hx[i].w; }
    d = wave_sum(d);
    const float wgt = gt * gelu_erf(d);
#pragma unroll
    for (int i = 0; i < 4; ++i) { float4 v = vr[lane + 64 * i]; acc[i].x += wgt * v.x; acc[i].y += wgt * v.y; acc[i].z += wgt * v.z; acc[i].w += wgt * v.w; }
  }
#pragma unroll
  for (int i = 0; i < 4; ++i) *(float4*)(&ys[w][(lane + 64 * i) * 4]) = acc[i];
  __syncthreads();
  float yv[4]; float ss = 0.f;
#pragma unroll
  for (int i = 0; i < 4; ++i) { int d = tid + 256 * i; yv[i] = ys[0][d] + ys[1][d] + ys[2][d] + ys[3][d]; ss += yv[i] * yv[i]; }
  ss = block_sum256(ss, red);
  const float rs = rsqrtf(ss * (1.f / DM) + EPS);
#pragma unroll
  for (int i = 0; i < 4; ++i) { int d = tid + 256 * i; out[tok * DM + d] = out[tok * DM + d] + mod[b * 6144 + 5120 + d] * (yv[i] * rs * g_post[d]); }
}

typedef short bf16x8 __attribute__((ext_vector_type(8)));
typedef float f32x16 __attribute__((ext_vector_type(16)));
#define MFMA32(a, b, c) __builtin_amdgcn_mfma_f32_32x32x16_bf16((a), (b), (c), 0, 0, 0)

constexpr int NTHR = 512;
constexpr size_t MiB = 1024 * 1024;
constexpr size_t WS_MOD   = 0;
constexpr size_t WS_WTIN  = 256 * 1024;
constexpr size_t WS_WTQUP = WS_WTIN + (size_t)2304 * 1024 * 2;
constexpr size_t WS_WTKVUP = WS_WTQUP + (size_t)768 * 384 * 2;
constexpr size_t WS_WTOUT = WS_WTKVUP + (size_t)1024 * 256 * 2;
constexpr size_t WS_WTPQ  = WS_WTOUT + (size_t)1024 * 1024 * 2;
constexpr size_t WS_KD    = WS_WTPQ + (size_t)2048 * 1024 * 2;
constexpr size_t WS_R0END = WS_KD + (size_t)256 * 256 * 2;
static_assert(WS_R0END <= 13 * MiB, "R0");
constexpr size_t WS_QM   = 13 * MiB;
constexpr size_t WS_KM   = WS_QM + 24 * MiB;
constexpr size_t WS_VM   = WS_KM + 24 * MiB;
constexpr size_t WS_QG   = WS_VM + 16 * MiB;
constexpr size_t WS_KG   = WS_QG + 8 * MiB;
constexpr size_t WS_VG   = WS_KG + 8 * MiB;
constexpr size_t WS_RG   = WS_VG + 16 * MiB;
constexpr size_t WS_LAF  = WS_RG + 16 * MiB;
constexpr size_t WS_LAB  = WS_LAF + 8 * MiB;
constexpr size_t WS_OMLA = WS_LAB + 8 * MiB;
constexpr size_t WS_OG   = WS_OMLA + 16 * MiB;
constexpr size_t WS_EU   = WS_OG + 32 * MiB;
constexpr size_t WS_EV   = WS_EU + 32 * MiB;
constexpr size_t WS_END  = WS_EV + 32 * MiB;
static_assert(WS_RG == WS_QM + 96 * MiB, "P3 tile scratch aliases QM..VG");
constexpr size_t WS_CQ   = WS_OMLA;
constexpr size_t OUT_HS  = 0;
constexpr size_t OUT_CQN = 32 * MiB;
constexpr size_t OUT_CKVN = 44 * MiB;
constexpr size_t OUT_GR  = 52 * MiB;
constexpr size_t WS_NP3  = WS_QM;

struct KP { const float* in[25]; float* out; unsigned char* ws; int ph_lo, ph_hi; };

constexpr int G_STRIDE = 144;
constexpr int G_ABYTES = 64 * G_STRIDE;
constexpr int G_BBYTES = 256 * G_STRIDE;
constexpr int G_STAGE = G_ABYTES + G_BBYTES;
constexpr int LDS_GEMM = 2 * G_STAGE;
constexpr int LDS_TAB = LDS_GEMM;
constexpr int LDS_TOTAL = 157696;

DI unsigned pack2(float lo, float hi) { return (unsigned)f2bf(lo) | ((unsigned)f2bf(hi) << 16); }
DI int crow(int reg, int hh) { return (reg & 3) + 8 * (reg >> 2) + 4 * hh; }

template <class Epi>
DI void block_gemm(char* lds, const bf16_t* A, int lda, const bf16_t* Bt, int ldb, int nchunks, int K, Epi&& epi) {
  const int tid = threadIdx.x, lane = tid & 63, w = tid >> 6, wm = w >> 2, wn = w & 3, r = lane & 31, hh = lane >> 5;
  const int nk = K >> 6;
  const int srow = tid >> 3, skc = tid & 7;
  const int st_off = srow * G_STRIDE + skc * 16;
  const int a_rd = (wm * 32 + r) * G_STRIDE + hh * 16;
  const int b_rd = G_ABYTES + (wn * 64 + r) * G_STRIDE + hh * 16;
  for (int ch = 0; ch < nchunks; ++ch) {
    const bf16_t* Ab = A + (size_t)srow * lda + skc * 8;
    const bf16_t* Bb = Bt + (size_t)(ch * 256 + srow) * ldb + skc * 8;
    f32x16 acc0, acc1;
#pragma unroll
    for (int i = 0; i < 16; ++i) { acc0[i] = 0.f; acc1[i] = 0.f; }
    uint4 ra, rb0, rb1, rb2, rb3;
    ra = *(const uint4*)Ab; rb0 = *(const uint4*)Bb; rb1 = *(const uint4*)(Bb + (size_t)64 * ldb); rb2 = *(const uint4*)(Bb + (size_t)128 * ldb); rb3 = *(const uint4*)(Bb + (size_t)192 * ldb);
    {
      char* nb = lds;
      *(uint4*)(nb + st_off) = ra;
      *(uint4*)(nb + G_ABYTES + st_off) = rb0; *(uint4*)(nb + G_ABYTES + 64 * G_STRIDE + st_off) = rb1;
      *(uint4*)(nb + G_ABYTES + 128 * G_STRIDE + st_off) = rb2; *(uint4*)(nb + G_ABYTES + 192 * G_STRIDE + st_off) = rb3;
    }
    __syncthreads();
    for (int t = 0; t < nk; ++t) {
      const char* cur = lds + (t & 1) * G_STAGE; char* nb = lds + ((t + 1) & 1) * G_STAGE;
      const bool more = (t + 1 < nk);
      if (more) { const int ko = (t + 1) * 64;
        ra = *(const uint4*)(Ab + ko); rb0 = *(const uint4*)(Bb + ko); rb1 = *(const uint4*)(Bb + (size_t)64 * ldb + ko);
        rb2 = *(const uint4*)(Bb + (size_t)128 * ldb + ko); rb3 = *(const uint4*)(Bb + (size_t)192 * ldb + ko); }
#pragma unroll
      for (int s = 0; s < 4; ++s) {
        const bf16x8 a = *(const bf16x8*)(cur + a_rd + s * 32);
        const bf16x8 b0 = *(const bf16x8*)(cur + b_rd + s * 32);
        const bf16x8 b1 = *(const bf16x8*)(cur + b_rd + 32 * G_STRIDE + s * 32);
        acc0 = MFMA32(a, b0, acc0); acc1 = MFMA32(a, b1, acc1);
      }
      if (more) {
        *(uint4*)(nb + st_off) = ra;
        *(uint4*)(nb + G_ABYTES + st_off) = rb0; *(uint4*)(nb + G_ABYTES + 64 * G_STRIDE + st_off) = rb1;
        *(uint4*)(nb + G_ABYTES + 128 * G_STRIDE + st_off) = rb2; *(uint4*)(nb + G_ABYTES + 192 * G_STRIDE + st_off) = rb3;
      }
      __syncthreads();
    }
    epi(wm * 32, ch * 256 + wn * 64, acc0, acc1);
    __syncthreads();
  }
}

DI void p0_transpose(char* lds, const float* __restrict__ W, int K, int N, bf16_t* __restrict__ Wt, int item) {
  float* s = (float*)lds;
  const int tid = threadIdx.x;
  const int ntn = (N + 63) >> 6, kt = item / ntn, nt = item % ntn, k0 = kt * 64, n0 = nt * 64;
  __syncthreads();
#pragma unroll
  for (int i = 0; i < 8; ++i) { int e = tid + 512 * i; int kk = e >> 6, nn = e & 63; s[kk * 65 + nn] = (n0 + nn < N) ? W[(size_t)(k0 + kk) * N + n0 + nn] : 0.f; }
  __syncthreads();
  const int nn = tid >> 3, part = tid & 7;
  const float* sp = s + (part * 8) * 65 + nn;
  uint4 o; o.x = pack2(sp[0], sp[65]); o.y = pack2(sp[2 * 65], sp[3 * 65]); o.z = pack2(sp[4 * 65], sp[5 * 65]); o.w = pack2(sp[6 * 65], sp[7 * 65]);
  *(uint4*)(Wt + (size_t)(n0 + nn) * K + k0 + part * 8) = o;
}

DI void phase0(const KP& p, char* lds) {
  const int tid = threadIdx.x, bid = blockIdx.x, nb = gridDim.x;
  unsigned char* ws = p.ws;
  constexpr int I_IN = 16 * 36, I_QUP = 6 * 12, I_KVUP = 4 * 16, I_OUT = 16 * 16, I_PQ = 16 * 32;
  constexpr int I_ALL = I_IN + I_QUP + I_KVUP + I_OUT + I_PQ;
  for (int it = bid; it < I_ALL; it += nb) {
    int q = it;
    if (q < I_IN) { p0_transpose(lds, p.in[7], 1024, 2272, (bf16_t*)(ws + WS_WTIN), q); continue; } q -= I_IN;
    if (q < I_QUP) { p0_transpose(lds, p.in[9], 384, 768, (bf16_t*)(ws + WS_WTQUP), q); continue; } q -= I_QUP;
    if (q < I_KVUP) { p0_transpose(lds, p.in[11], 256, 1024, (bf16_t*)(ws + WS_WTKVUP), q); continue; } q -= I_KVUP;
    if (q < I_OUT) { p0_transpose(lds, p.in[17], 1024, 1024, (bf16_t*)(ws + WS_WTOUT), q); continue; } q -= I_OUT;
    p0_transpose(lds, p.in[20], 1024, 2048, (bf16_t*)(ws + WS_WTPQ), q);
  }
  { bf16_t* kd = (bf16_t*)(ws + WS_KD);
    for (int e = bid * NTHR + tid; e < 65536; e += nb * NTHR) { int n = e >> 8, k = e & 255; float v = 0.f;
      if (n < 128 && k < 128) v = p.in[21][n * 128 + k]; else if (n >= 128 && k >= 128) v = p.in[22][(n - 128) * 128 + (k - 128)];
      kd[e] = f2bf(v); } }
  { const size_t n8 = (size_t)16384 * 1024 / 8;
    for (int t = 0; t < 2; ++t) { const float* src = p.in[23 + t]; bf16_t* dst = (bf16_t*)(ws + (t ? WS_EV : WS_EU));
      for (size_t i = (size_t)bid * NTHR + tid; i < n8; i += (size_t)nb * NTHR) { const float4 x0 = *(const float4*)(src + i * 8), x1 = *(const float4*)(src + i * 8 + 4);
        uint4 o; o.x = pack2(x0.x, x0.y); o.y = pack2(x0.z, x0.w); o.z = pack2(x1.x, x1.y); o.w = pack2(x1.z, x1.w); *(uint4*)(dst + i * 8) = o; } } }
  for (int jb = bid; jb < 96; jb += nb) {
    __syncthreads();
    float* cact = (float*)lds;
    float* red = (float*)(lds + 32768);
    for (int e = tid; e < 8192; e += NTHR) cact[e] = silu_f(p.in[1][e]);
    __syncthreads();
    const int jj = tid & 63, ks = tid >> 6, j0 = jb * 64;
    float acc[8];
#pragma unroll
    for (int b = 0; b < 8; ++b) acc[b] = 0.f;
    const float* wp = p.in[3] + (size_t)(ks * 128) * 6144 + j0 + jj;
    for (int k = 0; k < 128; ++k) { const float wv = wp[(size_t)k * 6144];
#pragma unroll
      for (int b = 0; b < 8; ++b) acc[b] += cact[b * 1024 + ks * 128 + k] * wv; }
#pragma unroll
    for (int b = 0; b < 8; ++b) red[(ks * 64 + jj) * 8 + b] = acc[b];
    __syncthreads();
    { const int b = tid >> 6; float sacc = p.in[4][j0 + jj];
#pragma unroll
      for (int k2 = 0; k2 < 8; ++k2) sacc += red[(k2 * 64 + jj) * 8 + b];
      ((float*)(ws + WS_MOD))[b * 6144 + j0 + jj] = sacc; }
  }
}

constexpr int WT_STRIDE = 144, WT_BYTES = 32 * WT_STRIDE;
DI void wt_write(char* wl, const f32x16& a0, const f32x16& a1, int r, int hh, float scale) {
  char* bp = wl + (4 * hh) * WT_STRIDE + r * 2;
#pragma unroll
  for (int reg = 0; reg < 16; ++reg) { const int ro = ((reg & 3) + 8 * (reg >> 2)) * WT_STRIDE;
    *(bf16_t*)(bp + ro) = f2bf(a0[reg] * scale); *(bf16_t*)(bp + ro + 64) = f2bf(a1[reg] * scale); }
}
DI void wt_write_rope(char* wl, const f32x16& a0, const f32x16& a1, int r, int hh, const float* cs, const float* sn, int m0) {
  char* bp = wl + (4 * hh) * WT_STRIDE + r * 2;
#pragma unroll
  for (int reg = 0; reg < 16; ++reg) { const int rw = (reg & 3) + 8 * (reg >> 2); const int row = m0 + rw + 4 * hh;
    const float c = cs[row * 32 + r], s = sn[row * 32 + r];
    *(bf16_t*)(bp + rw * WT_STRIDE) = f2bf(a0[reg] * c - a1[reg] * s); *(bf16_t*)(bp + rw * WT_STRIDE + 64) = f2bf(a1[reg] * c + a0[reg] * s); }
}
DI void wt_store(const char* wl, int lane, bf16_t* dA, int sA, bf16_t* dB, int sB) {
  const int piece = lane & 7, rsub = lane >> 3;
  bf16_t* d = (piece < 4) ? dA : dB; const int st = (piece < 4) ? sA : sB;
  if (d) {
#pragma unroll
    for (int i = 0; i < 4; ++i) { const int row = i * 8 + rsub; const uint4 v = *(const uint4*)(wl + row * WT_STRIDE + piece * 16);
      *(uint4*)(d + (size_t)row * st + (piece & 3) * 8) = v; }
  }
}
#define LDS_FENCE() asm volatile("s_waitcnt lgkmcnt(0)" ::: "memory")
DI int lv(int x) { asm volatile("" : "+v"(x)); return x; }
template <class T> DI T* launder(T* q) { size_t z = 0; asm volatile("" : "+s"(z)); return (T*)((char*)q + z); }

DI void phase1(const KP& p, char* lds) {
  const int tid = threadIdx.x, lane = tid & 63, w = tid >> 6, r = lane & 31, hh = lane >> 5;
  float* cs = (float*)(lds + LDS_TAB); float* sn = cs + 2048;
  char* wl = lds + w * WT_BYTES;
  for (int tile = blockIdx.x; tile < 256; tile += gridDim.x) {
    unsigned char* ws = launder(p.ws); unsigned char* ob = (unsigned char*)launder(p.out); const float* xin = launder(p.in[0]);
    const float* mod = (const float*)(ws + WS_MOD);
    const int tok0 = tile * 64, b = tile >> 5, t0 = (tile & 31) * 64;
    bf16_t* Hs = (bf16_t*)(ob + OUT_HS) + (size_t)tok0 * 1024;
    bf16_t* CQ = (bf16_t*)(ws + WS_CQ) + (size_t)tok0 * 640;
    bf16_t* CQN = (bf16_t*)(ob + OUT_CQN) + (size_t)tok0 * 384;
    bf16_t* CKVN = (bf16_t*)(ob + OUT_CKVN) + (size_t)tok0 * 256;
    bf16_t* GR = (bf16_t*)(ob + OUT_GR) + (size_t)tok0 * 32;
    bf16_t* Qm = (bf16_t*)(ws + WS_QM); bf16_t* Km = (bf16_t*)(ws + WS_KM); bf16_t* Vm = (bf16_t*)(ws + WS_VM);
    bf16_t* qg = (bf16_t*)(ws + WS_QG) + (size_t)tok0 * 256; bf16_t* kg = (bf16_t*)(ws + WS_KG) + (size_t)tok0 * 256;
    bf16_t* vg = (bf16_t*)(ws + WS_VG) + (size_t)tok0 * 512; bf16_t* rg = (bf16_t*)(ws + WS_RG) + (size_t)tok0 * 512;
    bf16_t* laf = (bf16_t*)(ws + WS_LAF) + (size_t)tok0 * 256; bf16_t* lab = (bf16_t*)(ws + WS_LAB) + (size_t)tok0 * 256;
    __syncthreads();
#pragma unroll
    for (int i = 0; i < 4; ++i) { const int e = tid + 512 * i, tt = e >> 5, j = e & 31;
      const float inv = powf(10000.f, -(float)j * (1.f / 32.f)); const float ang = (float)((const int*)p.in[2])[tok0 + tt] * inv;
      cs[e] = cosf(ang); sn[e] = sinf(ang); }
    {
      float4 ge[4], sh[4];
      const float* gpre = launder(p.in[5]); const float* modb = launder(mod) + b * 6144;
#pragma unroll
      for (int i = 0; i < 4; ++i) { const int d = (lane + 64 * i) * 4;
        const float4 g = *(const float4*)(gpre + d); const float4 sc = *(const float4*)(modb + 1024 + d); sh[i] = *(const float4*)(modb + d);
        ge[i] = make_float4(g.x * (1.f + sc.x), g.y * (1.f + sc.y), g.z * (1.f + sc.z), g.w * (1.f + sc.w)); }
      for (int rr = 0; rr < 8; ++rr) { const int row = w * 8 + rr;
        const float* xr = xin + (size_t)(tok0 + row) * 1024;
        float4 v[4]; float ss = 0.f;
#pragma unroll
        for (int i = 0; i < 4; ++i) { v[i] = *(const float4*)(xr + (lane + 64 * i) * 4); ss += v[i].x * v[i].x + v[i].y * v[i].y + v[i].z * v[i].z + v[i].w * v[i].w; }
        ss = wave_sum(ss); const float rs = rsqrtf(ss * (1.f / 1024.f) + EPS);
#pragma unroll
        for (int i = 0; i < 4; ++i) { uint2 o; o.x = pack2(v[i].x * rs * ge[i].x + sh[i].x, v[i].y * rs * ge[i].y + sh[i].y); o.y = pack2(v[i].z * rs * ge[i].z + sh[i].z, v[i].w * rs * ge[i].w + sh[i].w);
          *(uint2*)(Hs + (size_t)row * 1024 + (lane + 64 * i) * 4) = o; }
      }
    }
    __syncthreads();
    block_gemm(lds, Hs, 1024, (const bf16_t*)(ws + WS_WTIN), 1024, 9, 1024, [&](int m0, int n0, const f32x16& a0, const f32x16& a1) {
      const int r2 = lv(r), h2 = lv(hh), ln = lv(lane);
      if (n0 == O_KR) {
        wt_write_rope(wl, a0, a1, r2, h2, cs, sn, m0); LDS_FENCE();
        for (int h = 0; h < 4; ++h) { bf16_t* kp = Km + (((size_t)b * 4 + h) * SEQ + t0 + m0) * 192 + 128; wt_store(wl, ln, kp, 192, kp + 32, 192); }
        return; }
      wt_write(wl, a0, a1, r2, h2, (n0 >= O_QG && n0 < O_KG) ? 0.125f : 1.f); LDS_FENCE();
      bf16_t* d[2]; int st[2];
#pragma unroll
      for (int half = 0; half < 2; ++half) { const int nb = n0 + 32 * half;
        if (nb < 640) { d[half] = CQ + (size_t)m0 * 640 + nb; st[half] = 640; }
        else if (nb < O_KG) { d[half] = qg + (size_t)m0 * 256 + (nb - O_QG); st[half] = 256; }
        else if (nb < O_VG) { d[half] = kg + (size_t)m0 * 256 + (nb - O_KG); st[half] = 256; }
        else if (nb < O_GF) { d[half] = vg + (size_t)m0 * 512 + (nb - O_VG); st[half] = 512; }
        else if (nb < O_R) { d[half] = GR + (size_t)m0 * 32; st[half] = 32; }
        else if (nb < INW) { d[half] = rg + (size_t)m0 * 512 + (nb - O_R); st[half] = 512; }
        else { d[half] = nullptr; st[half] = 0; } }
      wt_store(wl, ln, d[0], st[0], d[1], st[1]);
    });
    __syncthreads();
    const float* gq = launder(p.in[8]); const float* gkv = launder(p.in[10]);
    const float* wgf = launder(p.in[12]); const float* bgf = launder(p.in[13]); const float* wgb = launder(p.in[14]); const float* bgb = launder(p.in[15]);
    for (int rr = 0; rr < 8; ++rr) { const int row = w * 8 + rr; const bf16_t* cr = CQ + (size_t)row * 640;
      float v[6]; float ss = 0.f;
#pragma unroll
      for (int i = 0; i < 6; ++i) { v[i] = bf2f(cr[lane + 64 * i]); ss += v[i] * v[i]; }
      ss = wave_sum(ss); float rs = rsqrtf(ss * (1.f / 384.f) + EPS);
#pragma unroll
      for (int i = 0; i < 6; ++i) CQN[(size_t)row * 384 + lane + 64 * i] = f2bf(v[i] * rs * gq[lane + 64 * i]);
      float u[4]; float s2 = 0.f;
#pragma unroll
      for (int i = 0; i < 4; ++i) { u[i] = bf2f(cr[384 + lane + 64 * i]); s2 += u[i] * u[i]; }
      s2 = wave_sum(s2); rs = rsqrtf(s2 * (1.f / 256.f) + EPS);
#pragma unroll
      for (int i = 0; i < 4; ++i) CKVN[(size_t)row * 256 + lane + 64 * i] = f2bf(u[i] * rs * gkv[lane + 64 * i]);
    }
    for (int i = 0; i < 32; ++i) { const int e = tid + 512 * i, tt = e >> 8, c = e & 255;
      float af = bgf[c], ab = bgb[c]; const bf16_t* gr = GR + tt * 32;
#pragma unroll
      for (int q = 0; q < 16; ++q) { af += bf2f(gr[q]) * wgf[q * 256 + c]; ab += bf2f(gr[16 + q]) * wgb[q * 256 + c]; }
      laf[tt * 256 + c] = f2bf(logsigmoid_f(af) * (1.f / 16.f)); lab[tt * 256 + c] = f2bf(logsigmoid_f(ab) * (1.f / 16.f)); }
    __syncthreads();
    block_gemm(lds, CQN, 384, (const bf16_t*)(ws + WS_WTQUP), 384, 3, 384, [&](int m0, int n0, const f32x16& a0, const f32x16& a1) {
      const int r2 = lv(r), h2 = lv(hh), ln = lv(lane);
      const int h = n0 / 192, d0 = n0 % 192;
      bf16_t* qp = Qm + (((size_t)b * 4 + h) * SEQ + t0 + m0) * 192 + d0;
      if (d0 < 128) wt_write(wl, a0, a1, r2, h2, 1.f); else wt_write_rope(wl, a0, a1, r2, h2, cs, sn, m0);
      LDS_FENCE();
      wt_store(wl, ln, qp, 192, qp + 32, 192);
    });
    block_gemm(lds, CKVN, 256, (const bf16_t*)(ws + WS_WTKVUP), 256, 4, 256, [&](int m0, int n0, const f32x16& a0, const f32x16& a1) {
      const int r2 = lv(r), h2 = lv(hh), ln = lv(lane);
      const int h = n0 >> 8, d0 = n0 & 255;
      wt_write(wl, a0, a1, r2, h2, 1.f); LDS_FENCE();
      if (d0 < 128) { bf16_t* kp = Km + (((size_t)b * 4 + h) * SEQ + t0 + m0) * 192 + d0; wt_store(wl, ln, kp, 192, kp + 32, 192); }
      else { bf16_t* vp = Vm + (((size_t)b * 4 + h) * SEQ + t0 + m0) * 128 + (d0 - 128); wt_store(wl, ln, vp, 128, vp + 32, 128); }
    });
  }
}

namespace att {
typedef short s16x4 __attribute__((ext_vector_type(4)));
typedef unsigned u32x4 __attribute__((ext_vector_type(4)));
constexpr int DQ = 192, DV = 128, KVBLK = 64;
constexpr float SCALE = 0.07216878364870322f;
constexpr float THR = 8.f;
constexpr int SHM_V = KVBLK * DV * 2, SHM_K = KVBLK * DQ * 2;
constexpr int SHM_QR = 8 * 32 * 176;
constexpr int SHM_ATTN = 2 * SHM_V + 2 * SHM_K + 8 * 64 * 4 + SHM_QR;
#define KSWZ(row, colB) ((row) * 384 + ((colB) ^ (((row) & 7) << 4)))
#define SBAR() __builtin_amdgcn_sched_barrier(0)
DI unsigned cvtpk(float lo, float hi) { unsigned r; asm volatile("v_cvt_pk_bf16_f32 %0, %1, %2" : "=v"(r) : "v"(lo), "v"(hi)); return r; }

DI void partialSM(f32x16& p0, f32x16& p1, float& m_reg, float& mn, float& alpha) {
  constexpr float C = SCALE * 1.4426950408889634f;
  float pmax = p0[0];
#pragma unroll
  for (int r = 1; r < 16; ++r) pmax = fmaxf(pmax, p0[r]);
#pragma unroll
  for (int r = 0; r < 16; ++r) pmax = fmaxf(pmax, p1[r]);
  { auto rr = __builtin_amdgcn_permlane32_swap(__float_as_uint(pmax), __float_as_uint(pmax), false, false);
    pmax = fmaxf(__uint_as_float(rr[0]), __uint_as_float(rr[1])); }
  if (__builtin_expect(__all(pmax - m_reg <= THR / SCALE), 1)) { mn = m_reg; alpha = 1.f; }
  else { mn = fmaxf(m_reg, pmax); alpha = __builtin_amdgcn_exp2f((m_reg - mn) * C); m_reg = mn; }
  const float mnC = -mn * C;
#pragma unroll
  for (int r = 0; r < 16; ++r) p0[r] = fmaf(p0[r], C, mnC);
#pragma unroll
  for (int r = 0; r < 16; ++r) p1[r] = fmaf(p1[r], C, mnC);
#pragma unroll
  for (int r = 0; r < 16; ++r) p0[r] = __builtin_amdgcn_exp2f(p0[r]);
}
DI void finishSM(f32x16& p0, f32x16& p1, float alpha, float& l_reg, bf16x8& pa0, bf16x8& pa1, bf16x8& pa2, bf16x8& pa3) {
#pragma unroll
  for (int r = 0; r < 16; ++r) p1[r] = __builtin_amdgcn_exp2f(p1[r]);
  float ps = 0;
#pragma unroll
  for (int r = 0; r < 16; ++r) ps += p0[r];
#pragma unroll
  for (int r = 0; r < 16; ++r) ps += p1[r];
  { auto rr = __builtin_amdgcn_permlane32_swap(__float_as_uint(ps), __float_as_uint(ps), false, false);
    ps = __uint_as_float(rr[0]) + __uint_as_float(rr[1]); }
  l_reg = l_reg * alpha + ps;
#define PK4(P, BASE, OUT) do { unsigned a0 = cvtpk(P[BASE + 0], P[BASE + 1]), a1 = cvtpk(P[BASE + 2], P[BASE + 3]);   \
    unsigned b0 = cvtpk(P[BASE + 4], P[BASE + 5]), b1 = cvtpk(P[BASE + 6], P[BASE + 7]);                              \
    auto r0 = __builtin_amdgcn_permlane32_swap(a0, b0, false, false); auto r1 = __builtin_amdgcn_permlane32_swap(a1, b1, false, false); \
    u32x4 wv = {r0[0], r1[0], r0[1], r1[1]}; OUT = *reinterpret_cast<bf16x8*>(&wv); } while (0)
  PK4(p0, 0, pa0); PK4(p0, 8, pa1); PK4(p1, 0, pa2); PK4(p1, 8, pa3);
#undef PK4
}
DI void qkt(f32x16& p0, f32x16& p1, const char* Ks, const bf16x8* qr, const char* qrl, int r32, int hi) {
#pragma unroll
  for (int i = 0; i < 16; ++i) { p0[i] = 0.f; p1[i] = 0.f; }
#pragma unroll
  for (int d0 = 0; d0 < 12; ++d0) { const int cb = (d0 * 16 + hi * 8) * 2;
    const bf16x8 b0 = *reinterpret_cast<const bf16x8*>(Ks + KSWZ(r32, cb));
    const bf16x8 b1 = *reinterpret_cast<const bf16x8*>(Ks + KSWZ(32 + r32, cb));
    const bf16x8 q = (d0 < 7) ? qr[d0 < 7 ? d0 : 0] : *reinterpret_cast<const bf16x8*>(qrl + (d0 - 7) * 32);
    p0 = MFMA32(b0, q, p0);
    p1 = MFMA32(b1, q, p1); }
}
DI int v_st(int k, int c) { const int kk = (k & ~0xC) | ((k & 4) << 1) | ((k & 8) >> 1); return ((kk >> 3) * 4 + (c >> 5)) * 512 + ((kk & 7) * 32 + (c & 31)) * 2; }
DI int v_rd_base(int lane) { return ((lane & 3) << 3) | (((lane >> 2) & 3) << 6) | (((lane >> 4) & 1) << 5) | (((lane >> 5) & 1) << 8); }
constexpr int v_rd_off(int d0, int ks, int half) { return d0 * 512 + ks * 4096 + half * 2048; }
template <int OFF> DI s16x4 tr_read(int vb) { s16x4 r; asm volatile("ds_read_b64_tr_b16 %0, %1 offset:%2" : "=&v"(r) : "v"(vb), "i"(OFF) : "memory"); return r; }
template <int D0> DI void pv_one(f32x16& od, int vb, bf16x8 pa0, bf16x8 pa1, bf16x8 pa2, bf16x8 pa3) {
  const s16x4 l0 = tr_read<v_rd_off(D0, 0, 0)>(vb), h0 = tr_read<v_rd_off(D0, 0, 1)>(vb), l1 = tr_read<v_rd_off(D0, 1, 0)>(vb), h1 = tr_read<v_rd_off(D0, 1, 1)>(vb);
  const s16x4 l2 = tr_read<v_rd_off(D0, 2, 0)>(vb), h2 = tr_read<v_rd_off(D0, 2, 1)>(vb), l3 = tr_read<v_rd_off(D0, 3, 0)>(vb), h3 = tr_read<v_rd_off(D0, 3, 1)>(vb);
  asm volatile("s_waitcnt lgkmcnt(0)" ::: "memory"); SBAR();
#define PK(L, H) (bf16x8){L[0], L[1], L[2], L[3], H[0], H[1], H[2], H[3]}
  od = MFMA32(pa0, PK(l0, h0), od);
  od = MFMA32(pa1, PK(l1, h1), od);
  od = MFMA32(pa2, PK(l2, h2), od);
  od = MFMA32(pa3, PK(l3, h3), od);
#undef PK
}
DI void pv_d0(f32x16* o, int vb, bf16x8 pa0, bf16x8 pa1, bf16x8 pa2, bf16x8 pa3) {
  pv_one<0>(o[0], vb, pa0, pa1, pa2, pa3); pv_one<1>(o[1], vb, pa0, pa1, pa2, pa3); pv_one<2>(o[2], vb, pa0, pa1, pa2, pa3); pv_one<3>(o[3], vb, pa0, pa1, pa2, pa3);
}
DI void attn_unit(const bf16_t* Qb, const bf16_t* Kh, const bf16_t* Vh, bf16_t* Ob, int seq, char* lds) {
  const int tid = lv(threadIdx.x), wid = tid >> 6, lane = tid & 63, r32 = lane & 31, hi = lane >> 5;
  char* V_lds = lds; char* K_lds = lds + 2 * SHM_V;
  float* wsf = (float*)(lds + 2 * SHM_V + 2 * SHM_K) + wid * 64; float* li_l = wsf; float* al_l = wsf + 32;
  char* qrl = lds + 2 * SHM_V + 2 * SHM_K + 8 * 64 * 4 + wid * (32 * 176) + r32 * 176 + hi * 16;
  float m_reg = -1e30f, l_reg = 0; f32x16 o[4]; bf16x8 qr[7];
#pragma unroll
  for (int d = 0; d < 4; ++d)
#pragma unroll
    for (int i = 0; i < 16; ++i) o[d][i] = 0.f;
  const bf16_t* Qw = Qb + (size_t)(wid * 32 + r32) * DQ + hi * 8;
#pragma unroll
  for (int d0 = 0; d0 < 7; ++d0) qr[d0] = *reinterpret_cast<const bf16x8*>(Qw + d0 * 16);
#pragma unroll
  for (int d0 = 7; d0 < 12; ++d0) *reinterpret_cast<bf16x8*>(qrl + (d0 - 7) * 32) = *reinterpret_cast<const bf16x8*>(Qw + d0 * 16);
  int kst[3];
#pragma unroll
  for (int i = 0; i < 3; ++i) { const int c = tid + 512 * i; kst[i] = KSWZ(c / 24, (c % 24) * 16); }
  const int vst0 = v_st(tid >> 4, (tid & 15) * 8), vst1 = v_st(32 + (tid >> 4), (tid & 15) * 8);
  const int vb0 = (int)(uintptr_t)V_lds + v_rd_base(lane);
  bf16x8 sk0, sk1, sk2, sv0, sv1;
#define SLOAD(k0) do { const bf16x8* kp = reinterpret_cast<const bf16x8*>(Kh + (size_t)(k0) * DQ) + tid; sk0 = kp[0]; sk1 = kp[512]; sk2 = kp[1024]; \
    const bf16x8* vp = reinterpret_cast<const bf16x8*>(Vh + (size_t)(k0) * DV) + tid; sv0 = vp[0]; sv1 = vp[512]; } while (0)
#define SWRITE(b) do { *(bf16x8*)(V_lds + (b) * SHM_V + vst0) = sv0; *(bf16x8*)(V_lds + (b) * SHM_V + vst1) = sv1; \
    *(bf16x8*)(K_lds + (b) * SHM_K + kst[0]) = sk0; *(bf16x8*)(K_lds + (b) * SHM_K + kst[1]) = sk1; *(bf16x8*)(K_lds + (b) * SHM_K + kst[2]) = sk2; } while (0)
#define RESC(a) do { if (__any((a) < 1.f)) { if (hi == 0) al_l[r32] = (a); asm volatile("s_waitcnt lgkmcnt(0)" ::: "memory"); \
    _Pragma("unroll") for (int d = 0; d < 4; ++d) _Pragma("unroll") for (int r = 0; r < 16; ++r) o[d][r] *= al_l[crow(r, hi)]; } } while (0)
  f32x16 pA0, pA1, pB0, pB1; float mnA, mnB, alA, alB; bf16x8 pa0, pa1, pa2, pa3; const int NT = seq / KVBLK;
  SLOAD(0); SWRITE(0); __syncthreads();
  qkt(pA0, pA1, K_lds, qr, qrl, r32, hi); partialSM(pA0, pA1, m_reg, mnA, alA);
  SLOAD(KVBLK); SWRITE(1); __syncthreads();
  for (int j = 1; j + 1 < NT; j += 2) {
    SBAR(); qkt(pB0, pB1, K_lds + SHM_K, qr, qrl, r32, hi);
    finishSM(pA0, pA1, alA, l_reg, pa0, pa1, pa2, pa3); SBAR();
    SLOAD((j + 1) * KVBLK); SBAR();
    pv_d0(o, vb0, pa0, pa1, pa2, pa3); partialSM(pB0, pB1, m_reg, mnB, alB);
    __syncthreads(); SWRITE(0);
    RESC(alB); __syncthreads();
    SBAR(); qkt(pA0, pA1, K_lds, qr, qrl, r32, hi);
    finishSM(pB0, pB1, alB, l_reg, pa0, pa1, pa2, pa3); SBAR();
    SLOAD((j + 2) * KVBLK); SBAR();
    pv_d0(o, vb0 + SHM_V, pa0, pa1, pa2, pa3); partialSM(pA0, pA1, m_reg, mnA, alA);
    __syncthreads(); SWRITE(1);
    RESC(alA); __syncthreads();
  }
  SBAR(); qkt(pB0, pB1, K_lds + SHM_K, qr, qrl, r32, hi);
  finishSM(pA0, pA1, alA, l_reg, pa0, pa1, pa2, pa3); SBAR();
  pv_d0(o, vb0, pa0, pa1, pa2, pa3); partialSM(pB0, pB1, m_reg, mnB, alB);
  __syncthreads(); RESC(alB);
  finishSM(pB0, pB1, alB, l_reg, pa0, pa1, pa2, pa3); SBAR();
  pv_d0(o, vb0 + SHM_V, pa0, pa1, pa2, pa3);
  if (hi == 0) li_l[r32] = l_reg; asm volatile("s_waitcnt lgkmcnt(0)" ::: "memory");
  float rli[16];
#pragma unroll
  for (int r = 0; r < 16; ++r) rli[r] = __builtin_amdgcn_rcpf(li_l[crow(r, hi)]);
  bf16_t* Ow = Ob + (size_t)(wid * 32) * 512;
#pragma unroll
  for (int r = 0; r < 16; ++r) { const int orow = crow(r, hi);
#pragma unroll
    for (int d0 = 0; d0 < 4; ++d0) Ow[(size_t)orow * 512 + d0 * 32 + r32] = f2bf(o[d0][r] * rli[r]); }
  __syncthreads();
#undef SLOAD
#undef SWRITE
#undef RESC
}
}

DI void phase2_attn(const KP& p, char* lds) {
  for (int u = blockIdx.x; u < 256; u += gridDim.x) {
    unsigned char* ws = launder(p.ws);
    const bf16_t* Qm = (const bf16_t*)(ws + WS_QM); const bf16_t* Km = (const bf16_t*)(ws + WS_KM); const bf16_t* Vm = (const bf16_t*)(ws + WS_VM);
    bf16_t* omla = (bf16_t*)(ws + WS_OMLA);
    const int qb = u & 7, bh = u >> 3, b = bh >> 2, h = bh & 3;
    att::attn_unit(Qm + ((size_t)bh * SEQ + qb * 256) * 192, Km + (size_t)bh * SEQ * 192, Vm + (size_t)bh * SEQ * 128,
                   omla + ((size_t)b * SEQ + qb * 256) * 512 + h * 128, SEQ, lds);
  }
}

constexpr int P3_TILE_BYTES = 384 * 1024;
constexpr int LDS_TK = LDS_GEMM;
constexpr int SCW = 260;
template <int N> DI void ce_desc(float (&a)[N], int i, int l) { const float hi = fmaxf(a[i], a[l]), lo = fminf(a[i], a[l]); a[i] = hi; a[l] = lo; }
DI void sort16_desc(float (&a)[16]) {
#pragma unroll
  for (int k = 2; k <= 16; k <<= 1)
#pragma unroll
    for (int j = k >> 1; j > 0; j >>= 1)
#pragma unroll
      for (int i = 0; i < 16; ++i) { const int l = i ^ j; if (l > i) { if ((i & k) == 0) ce_desc(a, i, l); else ce_desc(a, l, i); } }
}
DI void merge16_desc(float (&a)[16]) {
#pragma unroll
  for (int j = 8; j > 0; j >>= 1)
#pragma unroll
    for (int i = 0; i < 16; ++i) { const int l = i ^ j; if (l > i) ce_desc(a, i, l); }
}
DI void top16_merge(float (&a)[16], const float (&b)[16]) {
#pragma unroll
  for (int i = 0; i < 16; ++i) a[i] = fmaxf(a[i], b[15 - i]);
  merge16_desc(a);
}
template <int CTRL> DI float dpp_f(float v) { return __int_as_float(__builtin_amdgcn_mov_dpp(__float_as_int(v), CTRL, 0xF, 0xF, true)); }

DI float gelu_fast(float x) { return 0.5f * x * (1.f + erff(x * 0.70710678118654752f)); }

DI void phase3(const KP& p, char* lds) {
  const int tid0 = threadIdx.x;
  const int r = tid0 & 31, hh = (tid0 >> 5) & 1, lane = tid0 & 63;
  char* wl = lds + (tid0 >> 6) * WT_BYTES;
  for (int tile = blockIdx.x; tile < 256; tile += gridDim.x) {
    unsigned char* ws = launder(p.ws); float* outp = launder(p.out); const float* xin = launder(p.in[0]);
    const int tok0 = tile * 64, b = tile >> 5;
    unsigned char* tsc = ws + WS_QM + (size_t)tile * P3_TILE_BYTES;
    bf16_t* QRY = (bf16_t*)tsc; bf16_t* Y = (bf16_t*)tsc; bf16_t* MIXA = (bf16_t*)(tsc + 256 * 1024); bf16_t* H2 = MIXA;
    const float* modb = launder((const float*)(ws + WS_MOD)) + b * 6144;
    __syncthreads();
    {
      const int tid = lv(tid0), lane = tid & 63, w = tid >> 6;
      const bf16_t* omla = (const bf16_t*)(ws + WS_OMLA); const float* og = (const float*)(ws + WS_OG); const bf16_t* rg = (const bf16_t*)(ws + WS_RG);
      const float* ggl = launder(p.in[16]); const float g0 = ggl[lane * 2], g1 = ggl[lane * 2 + 1];
      for (int rr = 0; rr < 8; ++rr) { const int row = w * 8 + rr; const size_t tok = tok0 + row;
        *(uint4*)(MIXA + (size_t)row * 1024 + lane * 8) = *(const uint4*)(omla + tok * 512 + lane * 8);
#pragma unroll
        for (int h = 0; h < 4; ++h) { const float2 ov = *(const float2*)(og + tok * 512 + h * 128 + lane * 2);
          const float ss = wave_sum(ov.x * ov.x + ov.y * ov.y); const float rs = rsqrtf(ss * (1.f / 128.f) + EPS);
          const unsigned rv = *(const unsigned*)(rg + tok * 512 + h * 128 + lane * 2);
          const float r0 = __uint_as_float(rv << 16), r1 = __uint_as_float(rv & 0xffff0000u);
          *(unsigned*)(MIXA + (size_t)row * 1024 + 512 + h * 128 + lane * 2) = pack2(ov.x * rs * g0 * silu_f(r0), ov.y * rs * g1 * silu_f(r1)); }
      }
    }
    __syncthreads();
    block_gemm(lds, MIXA, 1024, (const bf16_t*)(ws + WS_WTOUT), 1024, 4, 1024, [&](int m0, int n0, const f32x16& a0, const f32x16& a1) {
      const int r2 = lv(r), h2 = lv(hh), ln = lv(lane);
      wt_write(wl, a0, a1, r2, h2, 1.f); LDS_FENCE();
      bf16_t* d = Y + (size_t)m0 * 1024 + n0; wt_store(wl, ln, d, 1024, d + 32, 1024);
    });
    __syncthreads();
    {
      const int tid = lv(tid0), lane = tid & 63, w = tid >> 6;
      float4 A1[4], A2[4], S2[4];
      const float* gpo = launder(p.in[6]); const float* gpf = launder(p.in[18]);
#pragma unroll
      for (int i = 0; i < 4; ++i) { const int d = (lane + 64 * i) * 4;
        const float4 gp = *(const float4*)(gpo + d), gt = *(const float4*)(modb + 2048 + d), g2 = *(const float4*)(gpf + d), sc = *(const float4*)(modb + 4096 + d);
        S2[i] = *(const float4*)(modb + 3072 + d);
        A1[i] = make_float4(gp.x * gt.x, gp.y * gt.y, gp.z * gt.z, gp.w * gt.w);
        A2[i] = make_float4(g2.x * (1.f + sc.x), g2.y * (1.f + sc.y), g2.z * (1.f + sc.z), g2.w * (1.f + sc.w)); }
      for (int rr = 0; rr < 8; ++rr) { const int row = w * 8 + rr; const size_t tok = tok0 + row;
        float4 yv[4]; float ss = 0.f;
#pragma unroll
        for (int i = 0; i < 4; ++i) { const uint2 u = *(const uint2*)(Y + (size_t)row * 1024 + (lane + 64 * i) * 4);
          yv[i] = make_float4(__uint_as_float(u.x << 16), __uint_as_float(u.x & 0xffff0000u), __uint_as_float(u.y << 16), __uint_as_float(u.y & 0xffff0000u));
          ss += yv[i].x * yv[i].x + yv[i].y * yv[i].y + yv[i].z * yv[i].z + yv[i].w * yv[i].w; }
        ss = wave_sum(ss); const float rs = rsqrtf(ss * (1.f / 1024.f) + EPS);
        float4 xv[4]; float s2 = 0.f;
#pragma unroll
        for (int i = 0; i < 4; ++i) { const float4 x = *(const float4*)(xin + tok * 1024 + (lane + 64 * i) * 4);
          xv[i] = make_float4(x.x + A1[i].x * yv[i].x * rs, x.y + A1[i].y * yv[i].y * rs, x.z + A1[i].z * yv[i].z * rs, x.w + A1[i].w * yv[i].w * rs);
          *(float4*)(outp + tok * 1024 + (lane + 64 * i) * 4) = xv[i];
          s2 += xv[i].x * xv[i].x + xv[i].y * xv[i].y + xv[i].z * xv[i].z + xv[i].w * xv[i].w; }
        s2 = wave_sum(s2); const float r2 = rsqrtf(s2 * (1.f / 1024.f) + EPS);
#pragma unroll
        for (int i = 0; i < 4; ++i) { uint2 o; o.x = pack2(xv[i].x * r2 * A2[i].x + S2[i].x, xv[i].y * r2 * A2[i].y + S2[i].y); o.y = pack2(xv[i].z * r2 * A2[i].z + S2[i].z, xv[i].w * r2 * A2[i].w + S2[i].w);
          *(uint2*)(H2 + (size_t)row * 1024 + (lane + 64 * i) * 4) = o; }
      }
    }
    __syncthreads();
    block_gemm(lds, H2, 1024, (const bf16_t*)(ws + WS_WTPQ), 1024, 8, 1024, [&](int m0, int n0, const f32x16& a0, const f32x16& a1) {
      const int r2 = lv(r), h2 = lv(hh), ln = lv(lane);
      wt_write(wl, a0, a1, r2, h2, 1.f); LDS_FENCE();
      bf16_t* d = QRY + (size_t)m0 * 2048 + n0; wt_store(wl, ln, d, 2048, d + 32, 2048);
    });
    float* SC = (float*)lds; unsigned* TK = (unsigned*)(lds + LDS_TK);
    for (int h = 0; h < 8; ++h) {
      block_gemm(lds, QRY + h * 256, 2048, (const bf16_t*)(ws + WS_KD), 256, 1, 256, [&](int m0, int n0, const f32x16& a0, const f32x16& a1) {
        const int r2 = lv(r), h2 = lv(hh);
        float* sp = SC + (m0 + 4 * h2) * SCW + n0 + r2;
#pragma unroll
        for (int reg = 0; reg < 16; ++reg) { const int ro = ((reg & 3) + 8 * (reg >> 2)) * SCW; sp[ro] = a0[reg]; sp[ro + 32] = a1[reg]; }
      });
      {
        const int tid = lv(tid0);
        const int tt = tid >> 3, sd = (tid >> 2) & 1, q = tid & 3;
        const float* sr = SC + tt * SCW + sd * 128 + q * 32;
        float a[16], c[16];
#pragma unroll
        for (int i = 0; i < 4; ++i) { const float4 v = *(const float4*)(sr + i * 4); const unsigned ib = q * 32 + i * 4;
          a[i * 4 + 0] = __uint_as_float((__float_as_uint(v.x) & 0xFFFFFF80u) | (ib + 0)); a[i * 4 + 1] = __uint_as_float((__float_as_uint(v.y) & 0xFFFFFF80u) | (ib + 1));
          a[i * 4 + 2] = __uint_as_float((__float_as_uint(v.z) & 0xFFFFFF80u) | (ib + 2)); a[i * 4 + 3] = __uint_as_float((__float_as_uint(v.w) & 0xFFFFFF80u) | (ib + 3)); }
#pragma unroll
        for (int i = 0; i < 4; ++i) { const float4 v = *(const float4*)(sr + 16 + i * 4); const unsigned ib = q * 32 + 16 + i * 4;
          c[i * 4 + 0] = __uint_as_float((__float_as_uint(v.x) & 0xFFFFFF80u) | (ib + 0)); c[i * 4 + 1] = __uint_as_float((__float_as_uint(v.y) & 0xFFFFFF80u) | (ib + 1));
          c[i * 4 + 2] = __uint_as_float((__float_as_uint(v.z) & 0xFFFFFF80u) | (ib + 2)); c[i * 4 + 3] = __uint_as_float((__float_as_uint(v.w) & 0xFFFFFF80u) | (ib + 3)); }
        sort16_desc(a); sort16_desc(c); top16_merge(a, c);
#pragma unroll
        for (int i = 0; i < 16; ++i) c[i] = dpp_f<0xB1>(a[i]);
        top16_merge(a, c);
#pragma unroll
        for (int i = 0; i < 16; ++i) c[i] = dpp_f<0x4E>(a[i]);
        top16_merge(a, c);
        if (q == 0) { unsigned* tk = TK + ((tt * 8 + h) * 2 + sd) * 16;
#pragma unroll
          for (int i = 0; i < 4; ++i) *(uint4*)(tk + i * 4) = make_uint4(__float_as_uint(a[i * 4]), __float_as_uint(a[i * 4 + 1]), __float_as_uint(a[i * 4 + 2]), __float_as_uint(a[i * 4 + 3])); }
      }
      __syncthreads();
    }
    int* EIDX = (int*)lds; float* GATE = (float*)(lds + 32768);
    {
      const int tid = lv(tid0);
      const int tt = tid >> 3, h = tid & 7;
      const unsigned* t1 = TK + ((tt * 8 + h) * 2) * 16; const unsigned* t2 = t1 + 16;
      float v1[16], v2[16];
#pragma unroll
      for (int i = 0; i < 4; ++i) { const uint4 u = *(const uint4*)(t1 + i * 4), v = *(const uint4*)(t2 + i * 4);
        v1[i * 4] = __uint_as_float(u.x & 0xFFFFFF80u); v1[i * 4 + 1] = __uint_as_float(u.y & 0xFFFFFF80u); v1[i * 4 + 2] = __uint_as_float(u.z & 0xFFFFFF80u); v1[i * 4 + 3] = __uint_as_float(u.w & 0xFFFFFF80u);
        v2[i * 4] = __uint_as_float(v.x & 0xFFFFFF80u); v2[i * 4 + 1] = __uint_as_float(v.y & 0xFFFFFF80u); v2[i * 4 + 2] = __uint_as_float(v.z & 0xFFFFFF80u); v2[i * 4 + 3] = __uint_as_float(v.w & 0xFFFFFF80u); }
      float best[16], grp[16];
#define CAND(i, j) __uint_as_float((__float_as_uint(v1[i] + v2[j]) & 0xFFFFFF00u) | ((i) << 4) | (j))
      best[0] = CAND(0, 0); best[1] = CAND(0, 1); best[2] = CAND(0, 2); best[3] = CAND(0, 3); best[4] = CAND(0, 4); best[5] = CAND(0, 5); best[6] = CAND(0, 6); best[7] = CAND(0, 7);
      best[8] = CAND(0, 8); best[9] = CAND(0, 9); best[10] = CAND(0, 10); best[11] = CAND(0, 11); best[12] = CAND(0, 12); best[13] = CAND(0, 13); best[14] = CAND(0, 14); best[15] = CAND(0, 15);
      sort16_desc(best);
      grp[0] = CAND(1, 0); grp[1] = CAND(1, 1); grp[2] = CAND(1, 2); grp[3] = CAND(1, 3); grp[4] = CAND(1, 4); grp[5] = CAND(1, 5); grp[6] = CAND(1, 6); grp[7] = CAND(1, 7);
      grp[8] = CAND(2, 0); grp[9] = CAND(2, 1); grp[10] = CAND(2, 2); grp[11] = CAND(2, 3); grp[12] = CAND(2, 4); grp[13] = CAND(3, 0); grp[14] = CAND(3, 1); grp[15] = CAND(3, 2);
      sort16_desc(grp); top16_merge(best, grp);
      grp[0] = CAND(3, 3); grp[1] = CAND(4, 0); grp[2] = CAND(4, 1); grp[3] = CAND(4, 2); grp[4] = CAND(5, 0); grp[5] = CAND(5, 1); grp[6] = CAND(6, 0); grp[7] = CAND(6, 1);
      grp[8] = CAND(7, 0); grp[9] = CAND(7, 1); grp[10] = CAND(8, 0); grp[11] = CAND(9, 0); grp[12] = CAND(10, 0); grp[13] = CAND(11, 0); grp[14] = CAND(12, 0); grp[15] = CAND(13, 0);
      sort16_desc(grp); top16_merge(best, grp);
      { const float c14 = CAND(14, 0), c15 = CAND(15, 0);
        grp[0] = fmaxf(c14, c15); grp[1] = fminf(c14, c15);
#pragma unroll
        for (int i = 2; i < 16; ++i) grp[i] = -3.0e38f;
        top16_merge(best, grp); }
#undef CAND
      __syncthreads();
      float sv[16]; int ev[16]; float mx = -3.0e38f;
#pragma unroll
      for (int k = 0; k < 16; ++k) { const unsigned key = __float_as_uint(best[k]); const int ci = (key >> 4) & 15, cj = key & 15;
        const unsigned k1 = t1[ci], k2 = t2[cj];
        sv[k] = __uint_as_float(k1 & 0xFFFFFF80u) + __uint_as_float(k2 & 0xFFFFFF80u); ev[k] = (int)((k1 & 127u) * 128u + (k2 & 127u)); mx = fmaxf(mx, sv[k]); }
      float sum = 0.f;
#pragma unroll
      for (int k = 0; k < 16; ++k) { sv[k] = __expf(sv[k] - mx); sum += sv[k]; }
      const float inv = 1.f / sum;
#pragma unroll
      for (int k = 0; k < 16; ++k) { EIDX[tt * 128 + h * 16 + k] = ev[k]; GATE[tt * 128 + h * 16 + k] = sv[k] * inv; }
    }
    __syncthreads();
    {
      const int tid = lv(tid0), lane = tid & 63, w = tid >> 6;
      const bf16_t* EU = (const bf16_t*)(ws + WS_EU); const bf16_t* EV = (const bf16_t*)(ws + WS_EV);
      const float* gpf2 = launder(p.in[19]);
      typedef __bf16 bf2 __attribute__((ext_vector_type(2)));
#pragma unroll 1
      for (int rr = 0; rr < 8; ++rr) { const int row = w * 8 + rr; const size_t tok = tok0 + row;
        const uint4 hA = *(const uint4*)(H2 + (size_t)row * 1024 + lane * 8), hB = *(const uint4*)(H2 + (size_t)row * 1024 + 512 + lane * 8);
        float acc[16];
#pragma unroll
        for (int i = 0; i < 16; ++i) acc[i] = 0.f;
#pragma unroll 1
        for (int g = 0; g < 32; ++g) {
          const int4 e4 = *(const int4*)(EIDX + row * 128 + g * 4);
          const int e0 = __builtin_amdgcn_readfirstlane(e4.x), e1 = __builtin_amdgcn_readfirstlane(e4.y), e2 = __builtin_amdgcn_readfirstlane(e4.z), e3 = __builtin_amdgcn_readfirstlane(e4.w);
          const float gte = GATE[row * 128 + g * 4 + (lane & 3)];
          uint4 ua[4], ub[4], va[4], vb[4];
          { const uint4* r0 = (const uint4*)(EU + (size_t)e0 * 1024); const uint4* r1 = (const uint4*)(EU + (size_t)e1 * 1024);
            const uint4* r2 = (const uint4*)(EU + (size_t)e2 * 1024); const uint4* r3 = (const uint4*)(EU + (size_t)e3 * 1024);
            ua[0] = r0[lane]; ub[0] = r0[64 + lane]; ua[1] = r1[lane]; ub[1] = r1[64 + lane]; ua[2] = r2[lane]; ub[2] = r2[64 + lane]; ua[3] = r3[lane]; ub[3] = r3[64 + lane]; }
          { const uint4* r0 = (const uint4*)(EV + (size_t)e0 * 1024); const uint4* r1 = (const uint4*)(EV + (size_t)e1 * 1024);
            const uint4* r2 = (const uint4*)(EV + (size_t)e2 * 1024); const uint4* r3 = (const uint4*)(EV + (size_t)e3 * 1024);
            va[0] = r0[lane]; vb[0] = r0[64 + lane]; va[1] = r1[lane]; vb[1] = r1[64 + lane]; va[2] = r2[lane]; vb[2] = r2[64 + lane]; va[3] = r3[lane]; vb[3] = r3[64 + lane]; }
          float P4[4];
#pragma unroll
          for (int k2 = 0; k2 < 4; ++k2) {
            float d = __builtin_amdgcn_fdot2_f32_bf16(__builtin_bit_cast(bf2, ua[k2].x), __builtin_bit_cast(bf2, hA.x), 0.f, false);
            d = __builtin_amdgcn_fdot2_f32_bf16(__builtin_bit_cast(bf2, ua[k2].y), __builtin_bit_cast(bf2, hA.y), d, false);
            d = __builtin_amdgcn_fdot2_f32_bf16(__builtin_bit_cast(bf2, ua[k2].z), __builtin_bit_cast(bf2, hA.z), d, false);
            d = __builtin_amdgcn_fdot2_f32_bf16(__builtin_bit_cast(bf2, ua[k2].w), __builtin_bit_cast(bf2, hA.w), d, false);
            d = __builtin_amdgcn_fdot2_f32_bf16(__builtin_bit_cast(bf2, ub[k2].x), __builtin_bit_cast(bf2, hB.x), d, false);
            d = __builtin_amdgcn_fdot2_f32_bf16(__builtin_bit_cast(bf2, ub[k2].y), __builtin_bit_cast(bf2, hB.y), d, false);
            d = __builtin_amdgcn_fdot2_f32_bf16(__builtin_bit_cast(bf2, ub[k2].z), __builtin_bit_cast(bf2, hB.z), d, false);
            d = __builtin_amdgcn_fdot2_f32_bf16(__builtin_bit_cast(bf2, ub[k2].w), __builtin_bit_cast(bf2, hB.w), d, false);
            P4[k2] = d; }
          { const bool up2 = (lane & 2) != 0;
            const float k0 = up2 ? P4[2] : P4[0], s0 = up2 ? P4[0] : P4[2], k1 = up2 ? P4[3] : P4[1], s1 = up2 ? P4[1] : P4[3];
            const float q0 = k0 + dpp_f<0x4E>(s0), q1 = k1 + dpp_f<0x4E>(s1);
            const bool up1 = (lane & 1) != 0;
            const float kk = up1 ? q1 : q0, ss1 = up1 ? q0 : q1;
            float av = kk + dpp_f<0xB1>(ss1);
            av += __shfl_xor(av, 4); av += __shfl_xor(av, 8); av += __shfl_xor(av, 16); av += __shfl_xor(av, 32);
            const float ax = fabsf(av), t = __builtin_amdgcn_rcpf(ax * 0.2316418882f + 1.0f);
            float q = t * 0.5307027145f + (-0.7265760135f); q = q * t + 0.7107068705f; q = q * t + (-0.142248368f); q = q * t + 0.127414796f; q = q * t;
            const float ee = __builtin_amdgcn_exp2f(av * av * (-0.72134752044f));
            const float mm = av * (q * ee), gl = (av < 0.f) ? mm : (av - mm);
            P4[0] = gte * gl; }
#pragma unroll
          for (int k2 = 0; k2 < 4; ++k2) {
            const float wk = __int_as_float(__builtin_amdgcn_readlane(__float_as_int(P4[0]), k2));
            acc[0] += wk * __uint_as_float(va[k2].x << 16); acc[1] += wk * __uint_as_float(va[k2].x & 0xffff0000u); acc[2] += wk * __uint_as_float(va[k2].y << 16); acc[3] += wk * __uint_as_float(va[k2].y & 0xffff0000u);
            acc[4] += wk * __uint_as_float(va[k2].z << 16); acc[5] += wk * __uint_as_float(va[k2].z & 0xffff0000u); acc[6] += wk * __uint_as_float(va[k2].w << 16); acc[7] += wk * __uint_as_float(va[k2].w & 0xffff0000u);
            acc[8] += wk * __uint_as_float(vb[k2].x << 16); acc[9] += wk * __uint_as_float(vb[k2].x & 0xffff0000u); acc[10] += wk * __uint_as_float(vb[k2].y << 16); acc[11] += wk * __uint_as_float(vb[k2].y & 0xffff0000u);
            acc[12] += wk * __uint_as_float(vb[k2].z << 16); acc[13] += wk * __uint_as_float(vb[k2].z & 0xffff0000u); acc[14] += wk * __uint_as_float(vb[k2].w << 16); acc[15] += wk * __uint_as_float(vb[k2].w & 0xffff0000u); }
        }
        float ss = 0.f;
#pragma unroll
        for (int i = 0; i < 16; ++i) ss += acc[i] * acc[i];
        ss = wave_sum(ss); const float rs = rsqrtf(ss * (1.f / 1024.f) + EPS);
        float* orow = outp + tok * 1024;
#pragma unroll
        for (int i = 0; i < 2; ++i)
#pragma unroll
          for (int j = 0; j < 2; ++j) { const int d = 512 * i + lane * 8 + 4 * j; const int o = i * 8 + j * 4;
            float4 x1 = *(const float4*)(orow + d); const float4 g3 = *(const float4*)(gpf2 + d), g2 = *(const float4*)(modb + 5120 + d);
            x1.x += g3.x * g2.x * acc[o] * rs; x1.y += g3.y * g2.y * acc[o + 1] * rs; x1.z += g3.z * g2.z * acc[o + 2] * rs; x1.w += g3.w * g2.w * acc[o + 3] * rs;
            *(float4*)(orow + d) = x1; }
      }
    }
  }
}


DI void phase2_gla_naive(const KP& p, char* lds) {
  unsigned char* ws = p.ws;
  const bf16_t* qg = (const bf16_t*)(ws + WS_QG); const bf16_t* kg = (const bf16_t*)(ws + WS_KG); const bf16_t* vg = (const bf16_t*)(ws + WS_VG);
  float* og = (float*)(ws + WS_OG);
  float* qs = (float*)lds; float* ks = qs + 64; float* as = ks + 64;
  const int tid = threadIdx.x;
  for (int bh = blockIdx.x; bh < 32; bh += gridDim.x) {
    const int b = bh >> 2, h = bh & 3, dv = tid & 127;
    for (int dir = 0; dir < 2; ++dir) {
      float S[64];
#pragma unroll
      for (int d = 0; d < 64; ++d) S[d] = 0.f;
      const bf16_t* la = (const bf16_t*)(ws + (dir ? WS_LAB : WS_LAF));
      for (int s = 0; s < SEQ; ++s) {
        const int t = dir ? (SEQ - 1 - s) : s; const size_t tok = (size_t)b * SEQ + t;
        __syncthreads();
        if (tid < 64) { qs[tid] = bf2f(qg[tok * 256 + h * 64 + tid]); ks[tid] = bf2f(kg[tok * 256 + h * 64 + tid]); as[tid] = expf(bf2f(la[tok * 256 + h * 64 + tid])); }
        __syncthreads();
        const float v = bf2f(vg[tok * 512 + h * 128 + dv]); float o = 0.f;
#pragma unroll
        for (int d = 0; d < 64; ++d) { S[d] = as[d] * S[d] + ks[d] * v; o += qs[d] * S[d]; }
        if (tid < 128) { if (dir == 0) og[tok * 512 + h * 128 + dv] = o; else og[tok * 512 + h * 128 + dv] += o; }
      }
    }
  }
}

__global__ void __launch_bounds__(NTHR, 2) mega(KP p) {
  extern __shared__ __attribute__((aligned(16))) char lds[];
  cg::grid_group grid = cg::this_grid();
  if (p.ph_lo <= 0 && 0 < p.ph_hi) { phase0(p, lds); if (1 < p.ph_hi) grid.sync(); }
  if (p.ph_lo <= 1 && 1 < p.ph_hi) { phase1(p, lds); if (2 < p.ph_hi) grid.sync(); }
  if (p.ph_lo <= 2 && 2 < p.ph_hi) { phase2_gla_naive(p, lds); phase2_attn(p, lds); if (3 < p.ph_hi) grid.sync(); }
  if (p.ph_lo <= 3 && 3 < p.ph_hi) { phase3(p, lds); }
}

extern "C" void kernel_launch(void* const* d_in, const int* in_sizes, int n_in, void* d_out, int out_size, void* d_ws, size_t ws_size, hipStream_t stream) {
  float* out = (float*)d_out;
  unsigned char* ws = (unsigned char*)d_ws;
  if (ws_size < WS_END || n_in != 25) return;
  static bool attr_done = false;
  if (!attr_done) { (void)hipFuncSetAttribute((const void*)mega, hipFuncAttributeMaxDynamicSharedMemorySize, LDS_TOTAL); attr_done = true; }
  KP p{};
  for (int i = 0; i < 25; ++i) p.in[i] = (const float*)d_in[i];
  p.out = out; p.ws = ws;
  p.ph_lo = 0; p.ph_hi = 4;
  { void* args[] = {&p}; (void)hipLaunchCooperativeKernel((const void*)mega, dim3(256), dim3(NTHR), args, LDS_TOTAL, stream); }
}
```

```cpp
#include <hip/hip_runtime.h>
#include <hip/hip_cooperative_groups.h>
namespace cg = cooperative_groups;
#include <stdint.h>

typedef unsigned short bf16_t;
#define DI __device__ __forceinline__

DI float bf2f(bf16_t v) { return __uint_as_float(((unsigned)v) << 16); }
DI bf16_t f2bf(float f) { unsigned u = __float_as_uint(f); u += 0x7fffu + ((u >> 16) & 1u); return (bf16_t)(u >> 16); }

constexpr int BATCH = 8, SEQ = 2048, DM = 1024, NTOK = BATCH * SEQ;
constexpr int INW = 2272;
constexpr float EPS = 1e-6f;
constexpr int O_CQ = 0, O_CKV = 384, O_KR = 640, O_QG = 704, O_KG = 960, O_VG = 1216, O_GF = 1728, O_GB = 1744, O_R = 1760;

DI float wave_sum(float v) {
#pragma unroll
  for (int o = 1; o < 64; o <<= 1) v += __shfl_xor(v, o);
  return v;
}
DI float wave_max(float v) {
#pragma unroll
  for (int o = 1; o < 64; o <<= 1) v = fmaxf(v, __shfl_xor(v, o));
  return v;
}
DI float block_sum256(float v, float* red) {
  v = wave_sum(v);
  __syncthreads();
  if ((threadIdx.x & 63) == 0) red[threadIdx.x >> 6] = v;
  __syncthreads();
  return red[0] + red[1] + red[2] + red[3];
}
DI float block_max256(float v, float* red) {
  v = wave_max(v);
  __syncthreads();
  if ((threadIdx.x & 63) == 0) red[threadIdx.x >> 6] = v;
  __syncthreads();
  return fmaxf(fmaxf(red[0], red[1]), fmaxf(red[2], red[3]));
}
DI float silu_f(float x) { return x / (1.f + expf(-x)); }
DI float logsigmoid_f(float x) { return fminf(x, 0.f) - log1pf(expf(-fabsf(x))); }
DI float gelu_erf(float x) { return 0.5f * x * (1.f + erff(x * 0.70710678118654752f)); }

__global__ __launch_bounds__(256) void n_mod(const float* __restrict__ c, const float* __restrict__ w_ada, const float* __restrict__ b_ada, float* __restrict__ mod) {
  int idx = blockIdx.x * 256 + threadIdx.x;
  int b = idx / 6144, j = idx % 6144;
  float acc = b_ada[j];
  for (int k = 0; k < 1024; ++k) acc += silu_f(c[b * 1024 + k]) * w_ada[(size_t)k * 6144 + j];
  mod[idx] = acc;
}

__global__ __launch_bounds__(256) void n_hnorm(const float* __restrict__ x, const float* __restrict__ g, const float* __restrict__ mod, int b, int off_sh, int off_sc, float* __restrict__ h) {
  __shared__ float red[4];
  int t = blockIdx.x, tid = threadIdx.x;
  const float* xr = x + ((size_t)b * SEQ + t) * DM;
  float v[4]; float ss = 0.f;
#pragma unroll
  for (int i = 0; i < 4; ++i) { v[i] = xr[tid + 256 * i]; ss += v[i] * v[i]; }
  ss = block_sum256(ss, red);
  float rs = rsqrtf(ss * (1.f / DM) + EPS);
#pragma unroll
  for (int i = 0; i < 4; ++i) { int d = tid + 256 * i; h[(size_t)t * DM + d] = v[i] * rs * g[d] * (1.f + mod[b * 6144 + off_sc + d]) + mod[b * 6144 + off_sh + d]; }
}

template <bool BT>
__global__ __launch_bounds__(256) void n_gemm(const float* __restrict__ A, int lda, const float* __restrict__ B, int ldb, float* __restrict__ C, int ldc, int M, int N, int K) {
  __shared__ float As[16][65];
  __shared__ float Bs[16][65];
  const int tid = threadIdx.x, tx = tid & 15, ty = tid >> 4;
  const int m0 = blockIdx.y * 64, n0 = blockIdx.x * 64;
  float acc[4][4];
#pragma unroll
  for (int i = 0; i < 4; ++i)
#pragma unroll
    for (int j = 0; j < 4; ++j) acc[i][j] = 0.f;
  for (int k0 = 0; k0 < K; k0 += 16) {
#pragma unroll
    for (int i = 0; i < 4; ++i) { int e = tid + 256 * i; int m = e >> 4, k = e & 15; As[k][m] = A[(size_t)(m0 + m) * lda + k0 + k]; }
#pragma unroll
    for (int i = 0; i < 4; ++i) { int e = tid + 256 * i;
      if (!BT) { int k = e >> 6, n = e & 63; Bs[k][n] = (n0 + n < N) ? B[(size_t)(k0 + k) * ldb + n0 + n] : 0.f; }
      else     { int n = e >> 4, k = e & 15; Bs[k][n] = (n0 + n < N) ? B[(size_t)(n0 + n) * ldb + k0 + k] : 0.f; } }
    __syncthreads();
#pragma unroll
    for (int k = 0; k < 16; ++k) {
      float a[4], bb[4];
#pragma unroll
      for (int i = 0; i < 4; ++i) { a[i] = As[k][ty * 4 + i]; bb[i] = Bs[k][tx * 4 + i]; }
#pragma unroll
      for (int i = 0; i < 4; ++i)
#pragma unroll
        for (int j = 0; j < 4; ++j) acc[i][j] += a[i] * bb[j];
    }
    __syncthreads();
  }
#pragma unroll
  for (int i = 0; i < 4; ++i)
#pragma unroll
    for (int j = 0; j < 4; ++j) { int n = n0 + tx * 4 + j; if (n < N) C[(size_t)(m0 + ty * 4 + i) * ldc + n] = acc[i][j]; }
}

__global__ __launch_bounds__(256) void n_rms_slice(const float* __restrict__ in, int ldin, int off, int W, const float* __restrict__ g, float* __restrict__ out) {
  __shared__ float red[4];
  int t = blockIdx.x, tid = threadIdx.x;
  float v0 = (tid < W) ? in[(size_t)t * ldin + off + tid] : 0.f;
  float v1 = (tid + 256 < W) ? in[(size_t)t * ldin + off + tid + 256] : 0.f;
  float ss = block_sum256(v0 * v0 + v1 * v1, red);
  float rs = rsqrtf(ss / (float)W + EPS);
  if (tid < W) out[(size_t)t * W + tid] = v0 * rs * g[tid];
  if (tid + 256 < W) out[(size_t)t * W + tid + 256] = v1 * rs * g[tid + 256];
}

__global__ __launch_bounds__(256) void n_scatter(const float* __restrict__ proj, const float* __restrict__ qa, const float* __restrict__ kv, const int* __restrict__ positions, int b,
                                                 const float* __restrict__ wgf, const float* __restrict__ bgf, const float* __restrict__ wgb, const float* __restrict__ bgb,
                                                 bf16_t* __restrict__ Qm, bf16_t* __restrict__ Km, bf16_t* __restrict__ Vm, bf16_t* __restrict__ qg, bf16_t* __restrict__ kg, bf16_t* __restrict__ vg,
                                                 bf16_t* __restrict__ rg, float* __restrict__ laf, float* __restrict__ lab) {
  __shared__ float cs[32], sn[32];
  const int t = blockIdx.x, tid = threadIdx.x;
  const size_t tok = (size_t)b * SEQ + t;
  const float* pr = proj + (size_t)t * INW;
  const float* qr = qa + (size_t)t * 768;
  const float* kr = kv + (size_t)t * 1024;
  if (tid < 32) {
    float inv = powf(10000.f, -(float)tid / 32.f);
    float ang = (float)positions[tok] * inv;
    cs[tid] = cosf(ang); sn[tid] = sinf(ang);
  }
  __syncthreads();
  for (int e = tid; e < 4 * 192; e += 256) {
    int h = e / 192, d = e % 192; float v;
    if (d < 128) v = qr[h * 192 + d];
    else { int j = d - 128; const float* rp = qr + h * 192 + 128;
      if (j < 32) v = rp[j] * cs[j] - rp[j + 32] * sn[j]; else v = rp[j] * cs[j - 32] + rp[j - 32] * sn[j - 32]; }
    Qm[(((size_t)b * 4 + h) * SEQ + t) * 192 + d] = f2bf(v);
  }
  for (int e = tid; e < 4 * 192; e += 256) {
    int h = e / 192, d = e % 192; float v;
    if (d < 128) v = kr[h * 256 + d];
    else { int j = d - 128; const float* rp = pr + O_KR;
      if (j < 32) v = rp[j] * cs[j] - rp[j + 32] * sn[j]; else v = rp[j] * cs[j - 32] + rp[j - 32] * sn[j - 32]; }
    Km[(((size_t)b * 4 + h) * SEQ + t) * 192 + d] = f2bf(v);
  }
  for (int e = tid; e < 512; e += 256) { int h = e >> 7, d = e & 127; Vm[(((size_t)b * 4 + h) * SEQ + t) * 128 + d] = f2bf(kr[h * 256 + 128 + d]); }
  { int e = tid; qg[tok * 256 + e] = f2bf(pr[O_QG + e] * 0.125f); kg[tok * 256 + e] = f2bf(pr[O_KG + e]); }
  for (int e = tid; e < 512; e += 256) { vg[tok * 512 + e] = f2bf(pr[O_VG + e]); rg[tok * 512 + e] = f2bf(pr[O_R + e]); }
  { int cidx = tid; float af = bgf[cidx], ab = bgb[cidx];
#pragma unroll
    for (int r = 0; r < 16; ++r) { af += pr[O_GF + r] * wgf[r * 256 + cidx]; ab += pr[O_GB + r] * wgb[r * 256 + cidx]; }
    laf[tok * 256 + cidx] = logsigmoid_f(af) * (1.f / 16.f); lab[tok * 256 + cidx] = logsigmoid_f(ab) * (1.f / 16.f); }
}

__global__ __launch_bounds__(256) void n_attn(const bf16_t* __restrict__ Qm, const bf16_t* __restrict__ Km, const bf16_t* __restrict__ Vm, bf16_t* __restrict__ omla) {
  __shared__ float qs[192]; __shared__ float sc[2048]; __shared__ float red[4];
  const int i = blockIdx.x, h = blockIdx.y, b = blockIdx.z, tid = threadIdx.x;
  const size_t bh = (size_t)b * 4 + h;
  if (tid < 192) qs[tid] = bf2f(Qm[(bh * SEQ + i) * 192 + tid]);
  __syncthreads();
  float mx = -1e30f;
  for (int kk = 0; kk < 8; ++kk) {
    int key = tid + 256 * kk; const uint4* kr = (const uint4*)(Km + (bh * SEQ + key) * 192);
    float s = 0.f;
    for (int c = 0; c < 24; ++c) { uint4 w = kr[c]; const float* q = qs + c * 8;
      s += q[0] * __uint_as_float(w.x << 16) + q[1] * __uint_as_float(w.x & 0xffff0000u) + q[2] * __uint_as_float(w.y << 16) + q[3] * __uint_as_float(w.y & 0xffff0000u)
         + q[4] * __uint_as_float(w.z << 16) + q[5] * __uint_as_float(w.z & 0xffff0000u) + q[6] * __uint_as_float(w.w << 16) + q[7] * __uint_as_float(w.w & 0xffff0000u); }
    s *= 0.07216878364870322f; sc[key] = s; mx = fmaxf(mx, s);
  }
  mx = block_max256(mx, red);
  float sum = 0.f;
  for (int kk = 0; kk < 8; ++kk) { int key = tid + 256 * kk; float p = expf(sc[key] - mx); sc[key] = p; sum += p; }
  sum = block_sum256(sum, red);
  __syncthreads();
  if (tid < 128) { float o = 0.f; const bf16_t* vp = Vm + bh * SEQ * 128 + tid;
    for (int key = 0; key < SEQ; ++key) o += sc[key] * bf2f(vp[(size_t)key * 128]);
    omla[((size_t)b * SEQ + i) * 512 + h * 128 + tid] = f2bf(o / sum); }
}

__global__ __launch_bounds__(128) void n_gla(const bf16_t* __restrict__ qg, const bf16_t* __restrict__ kg, const bf16_t* __restrict__ vg, const bf16_t* __restrict__ laf, const bf16_t* __restrict__ lab, float* __restrict__ og) {
  __shared__ float qs[64], ks[64], as[64];
  const int bh = blockIdx.x, b = bh >> 2, h = bh & 3, dv = threadIdx.x;
  for (int dir = 0; dir < 2; ++dir) {
    float S[64];
#pragma unroll
    for (int d = 0; d < 64; ++d) S[d] = 0.f;
    const bf16_t* la = dir ? lab : laf;
    for (int s = 0; s < SEQ; ++s) {
      const int t = dir ? (SEQ - 1 - s) : s; const size_t tok = (size_t)b * SEQ + t;
      __syncthreads();
      if (dv < 64) { qs[dv] = bf2f(qg[tok * 256 + h * 64 + dv]); ks[dv] = bf2f(kg[tok * 256 + h * 64 + dv]); as[dv] = expf(bf2f(la[tok * 256 + h * 64 + dv])); }
      __syncthreads();
      const float v = bf2f(vg[tok * 512 + h * 128 + dv]); float o = 0.f;
#pragma unroll
      for (int d = 0; d < 64; ++d) { S[d] = as[d] * S[d] + ks[d] * v; o += qs[d] * S[d]; }
      if (dir == 0) og[tok * 512 + h * 128 + dv] = o; else og[tok * 512 + h * 128 + dv] += o;
    }
  }
}

__global__ __launch_bounds__(256) void n_mix(const bf16_t* __restrict__ omla, const float* __restrict__ og, const bf16_t* __restrict__ rg, const float* __restrict__ g_gla, int b, float* __restrict__ mix) {
  __shared__ float ssum[4];
  const int t = blockIdx.x, tid = threadIdx.x; const size_t tok = (size_t)b * SEQ + t;
  if (tid < 4) ssum[tid] = 0.f;
  __syncthreads();
  float v[2];
#pragma unroll
  for (int i = 0; i < 2; ++i) { int e = tid + 256 * i; v[i] = og[tok * 512 + e]; atomicAdd(&ssum[e >> 7], v[i] * v[i]); mix[(size_t)t * DM + e] = bf2f(omla[tok * 512 + e]); }
  __syncthreads();
#pragma unroll
  for (int i = 0; i < 2; ++i) { int e = tid + 256 * i; float rs = rsqrtf(ssum[e >> 7] * (1.f / 128.f) + EPS);
    mix[(size_t)t * DM + 512 + e] = v[i] * rs * g_gla[e & 127] * silu_f(bf2f(rg[tok * 512 + e])); }
}

__global__ __launch_bounds__(256) void n_post1(const float* __restrict__ x, const float* __restrict__ y, const float* __restrict__ g_post, const float* __restrict__ g_pre2, const float* __restrict__ mod, int b,
                                               float* __restrict__ out, float* __restrict__ h2) {
  __shared__ float red[4];
  const int t = blockIdx.x, tid = threadIdx.x; const size_t tok = (size_t)b * SEQ + t;
  float yv[4], xv[4]; float ss = 0.f;
#pragma unroll
  for (int i = 0; i < 4; ++i) { yv[i] = y[(size_t)t * DM + tid + 256 * i]; ss += yv[i] * yv[i]; }
  ss = block_sum256(ss, red);
  float rs = rsqrtf(ss * (1.f / DM) + EPS); float s2 = 0.f;
#pragma unroll
  for (int i = 0; i < 4; ++i) { int d = tid + 256 * i; xv[i] = x[tok * DM + d] + mod[b * 6144 + 2048 + d] * (yv[i] * rs * g_post[d]); out[tok * DM + d] = xv[i]; s2 += xv[i] * xv[i]; }
  s2 = block_sum256(s2, red);
  float r2 = rsqrtf(s2 * (1.f / DM) + EPS);
#pragma unroll
  for (int i = 0; i < 4; ++i) { int d = tid + 256 * i; h2[(size_t)t * DM + d] = xv[i] * r2 * g_pre2[d] * (1.f + mod[b * 6144 + 4096 + d]) + mod[b * 6144 + 3072 + d]; }
}

DI void wave_argmax(float& v, int& i) {
#pragma unroll
  for (int o = 1; o < 64; o <<= 1) { float ov = __shfl_xor(v, o); int oi = __shfl_xor(i, o); if (ov > v || (ov == v && oi < i)) { v = ov; i = oi; } }
}
__global__ __launch_bounds__(256) void n_peer_select(const float* __restrict__ qry, const float* __restrict__ sk1, const float* __restrict__ sk2, int* __restrict__ eidx, float* __restrict__ gate) {
  __shared__ float v1s[4][16], v2s[4][16]; __shared__ int i1s[4][16], i2s[4][16];
  const int w = threadIdx.x >> 6, lane = threadIdx.x & 63;
  const int pair = blockIdx.x * 4 + w;
  const int t = pair >> 3, h = pair & 7;
  const float* q1 = qry + (size_t)t * 2048 + h * 256; const float* q2 = q1 + 128;
  float s1a = 0.f, s1b = 0.f, s2a = 0.f, s2b = 0.f;
  for (int d = 0; d < 128; ++d) { float a = q1[d], bq = q2[d];
    s1a += a * sk1[lane * 128 + d]; s1b += a * sk1[(lane + 64) * 128 + d]; s2a += bq * sk2[lane * 128 + d]; s2b += bq * sk2[(lane + 64) * 128 + d]; }
  for (int side = 0; side < 2; ++side) {
    float va = side ? s2a : s1a, vb = side ? s2b : s1b; bool ta = false, tb = false;
    for (int k = 0; k < 16; ++k) {
      float bv; int bi;
      if (!ta && (tb || va >= vb)) { bv = va; bi = lane; } else if (!tb) { bv = vb; bi = lane + 64; } else { bv = -3e38f; bi = 1 << 20; }
      wave_argmax(bv, bi);
      if (bi == lane) ta = true; if (bi == lane + 64) tb = true;
      if (lane == 0) { if (side) { v2s[w][k] = bv; i2s[w][k] = bi; } else { v1s[w][k] = bv; i1s[w][k] = bi; } }
    }
  }
  __syncthreads();
  float cv[4]; bool tk[4];
#pragma unroll
  for (int j = 0; j < 4; ++j) { int c = lane + 64 * j; cv[j] = v1s[w][c >> 4] + v2s[w][c & 15]; tk[j] = false; }
  float topv = 0.f; int topc = 0; float mx = 0.f;
  for (int k = 0; k < 16; ++k) {
    float bv = -3e38f; int bi = 1 << 20;
#pragma unroll
    for (int j = 0; j < 4; ++j) { if (!tk[j] && cv[j] > bv) { bv = cv[j]; bi = lane + 64 * j; } }
    wave_argmax(bv, bi);
#pragma unroll
    for (int j = 0; j < 4; ++j) if (bi == lane + 64 * j) tk[j] = true;
    if (k == 0) mx = bv;
    if (lane == k) { topv = bv; topc = bi; }
  }
  float e = (lane < 16) ? expf(topv - mx) : 0.f;
  float sum = wave_sum(e);
  if (lane < 16) { eidx[(size_t)pair * 16 + lane] = i1s[w][topc >> 4] * 128 + i2s[w][topc & 15]; gate[(size_t)pair * 16 + lane] = e / sum; }
}

__global__ __launch_bounds__(256) void n_peer_apply(const float* __restrict__ h2, const int* __restrict__ eidx, const float* __restrict__ gate, const float* __restrict__ eu, const float* __restrict__ ev,
                                                    const float* __restrict__ g_post, const float* __restrict__ mod, int b, float* __restrict__ out) {
  __shared__ float ys[4][1024]; __shared__ float red[4];
  const int t = blockIdx.x, tid = threadIdx.x, w = tid >> 6, lane = tid & 63; const size_t tok = (size_t)b * SEQ + t;
  float4 hx[4];
#pragma unroll
  for (int i = 0; i < 4; ++i) hx[i] = *(const float4*)(h2 + (size_t)t * DM + (lane + 64 * i) * 4);
  float4 acc[4];
#pragma unroll
  for (int i = 0; i < 4; ++i) acc[i] = make_float4(0.f, 0.f, 0.f, 0.f);
  for (int k = w; k < 128; k += 4) {
    const int e = eidx[(size_t)t * 128 + k]; const float gt = gate[(size_t)t * 128 + k];
    const float4* ur = (const float4*)(eu + (size_t)e * DM); const float4* vr = (const float4*)(ev + (size_t)e * DM);
    float d = 0.f;
#pragma unroll
    for (int i = 0; i < 4; ++i) { float4 u = ur[lane + 64 * i]; d += u.x * hx[i].x + u.y * hx[i].y + u.z * hx[i].z + u.w * hx[i].w; }
    d = wave_sum(d);
    const float wgt = gt * gelu_erf(d);
#pragma unroll
    for (int i = 0; i < 4; ++i) { float4 v = vr[lane + 64 * i]; acc[i].x += wgt * v.x; acc[i].y += wgt * v.y; acc[i].z += wgt * v.z; acc[i].w += wgt * v.w; }
  }
#pragma unroll
  for (int i = 0; i < 4; ++i) *(float4*)(&ys[w][(lane + 64 * i) * 4]) = acc[i];
  __syncthreads();
  float yv[4]; float ss = 0.f;
#pragma unroll
  for (int i = 0; i < 4; ++i) { int d = tid + 256 * i; yv[i] = ys[0][d] + ys[1][d] + ys[2][d] + ys[3][d]; ss += yv[i] * yv[i]; }
  ss = block_sum256(ss, red);
  const float rs = rsqrtf(ss * (1.f / DM) + EPS);
#pragma unroll
  for (int i = 0; i < 4; ++i) { int d = tid + 256 * i; out[tok * DM + d] = out[tok * DM + d] + mod[b * 6144 + 5120 + d] * (yv[i] * rs * g_post[d]); }
}

typedef short bf16x8 __attribute__((ext_vector_type(8)));
typedef float f32x16 __attribute__((ext_vector_type(16)));
#define MFMA32(a, b, c) __builtin_amdgcn_mfma_f32_32x32x16_bf16((a), (b), (c), 0, 0, 0)

constexpr int NTHR = 512;
constexpr size_t MiB = 1024 * 1024;
constexpr size_t WS_MOD   = 0;
constexpr size_t WS_WTIN  = 256 * 1024;
constexpr size_t WS_WTQUP = WS_WTIN + (size_t)2304 * 1024 * 2;
constexpr size_t WS_WTKVUP = WS_WTQUP + (size_t)768 * 384 * 2;
constexpr size_t WS_WTOUT = WS_WTKVUP + (size_t)1024 * 256 * 2;
constexpr size_t WS_WTPQ  = WS_WTOUT + (size_t)1024 * 1024 * 2;
constexpr size_t WS_KD    = WS_WTPQ + (size_t)2048 * 1024 * 2;
constexpr size_t WS_DEC   = WS_KD + (size_t)256 * 256 * 2;
constexpr size_t WS_R0END = WS_DEC + (size_t)2048 * 64 * 4;
static_assert(WS_R0END <= 13 * MiB, "R0");
constexpr size_t WS_QM   = 13 * MiB;
constexpr size_t WS_KM   = WS_QM + 24 * MiB;
constexpr size_t WS_VM   = WS_KM + 24 * MiB;
constexpr size_t WS_P1S  = WS_VM + 16 * MiB;
constexpr size_t WS_RG   = WS_P1S + 32 * MiB;
constexpr size_t WS_OINTRA = WS_RG + 16 * MiB;
constexpr size_t WS_QDEC = WS_OINTRA + 16 * MiB;
constexpr size_t WS_SPT  = WS_QDEC + 16 * MiB;
constexpr size_t WS_EU   = WS_SPT + 32 * MiB;
constexpr size_t WS_EV   = WS_EU + 32 * MiB;
constexpr size_t WS_END  = WS_EV + 32 * MiB;
static_assert(WS_P1S == WS_QM + 64 * MiB, "P3 QRY scratch aliases QM..VM");
constexpr size_t OUT_HS  = 0;
constexpr size_t OUT_CQ  = 32 * MiB;
constexpr size_t OUT_GR  = 52 * MiB;

struct KP { const float* in[25]; float* out; unsigned char* ws; int ph_lo, ph_hi; };

constexpr int G_STRIDE = 144;
constexpr int G_ABYTES = 64 * G_STRIDE;
constexpr int G_BBYTES = 256 * G_STRIDE;
constexpr int G_STAGE = G_ABYTES + G_BBYTES;
constexpr int LDS_GEMM = 2 * G_STAGE;
constexpr int LDS_TAB = LDS_GEMM;
constexpr int LDS_TOTAL = 157696;

DI unsigned pack2(float lo, float hi) { return (unsigned)f2bf(lo) | ((unsigned)f2bf(hi) << 16); }
DI int crow(int reg, int hh) { return (reg & 3) + 8 * (reg >> 2) + 4 * hh; }

template <class Epi>
DI void block_gemm(char* lds, const bf16_t* A, int lda, const bf16_t* Bt, int ldb, int nchunks, int K, Epi&& epi) {
  const int tid = threadIdx.x, lane = tid & 63, w = tid >> 6, wm = w >> 2, wn = w & 3, r = lane & 31, hh = lane >> 5;
  const int nk = K >> 6;
  const int srow = tid >> 3, skc = tid & 7;
  const int st_off = srow * G_STRIDE + skc * 16;
  const int a_rd = (wm * 32 + r) * G_STRIDE + hh * 16;
  const int b_rd = G_ABYTES + (wn * 64 + r) * G_STRIDE + hh * 16;
  for (int ch = 0; ch < nchunks; ++ch) {
    const bf16_t* Ab = A + (size_t)srow * lda + skc * 8;
    const bf16_t* Bb = Bt + (size_t)(ch * 256 + srow) * ldb + skc * 8;
    f32x16 acc0, acc1;
#pragma unroll
    for (int i = 0; i < 16; ++i) { acc0[i] = 0.f; acc1[i] = 0.f; }
    uint4 ra, rb0, rb1, rb2, rb3;
    ra = *(const uint4*)Ab; rb0 = *(const uint4*)Bb; rb1 = *(const uint4*)(Bb + (size_t)64 * ldb); rb2 = *(const uint4*)(Bb + (size_t)128 * ldb); rb3 = *(const uint4*)(Bb + (size_t)192 * ldb);
    {
      char* nb = lds;
      *(uint4*)(nb + st_off) = ra;
      *(uint4*)(nb + G_ABYTES + st_off) = rb0; *(uint4*)(nb + G_ABYTES + 64 * G_STRIDE + st_off) = rb1;
      *(uint4*)(nb + G_ABYTES + 128 * G_STRIDE + st_off) = rb2; *(uint4*)(nb + G_ABYTES + 192 * G_STRIDE + st_off) = rb3;
    }
    __syncthreads();
    for (int t = 0; t < nk; ++t) {
      const char* cur = lds + (t & 1) * G_STAGE; char* nb = lds + ((t + 1) & 1) * G_STAGE;
      const bool more = (t + 1 < nk);
      if (more) { const int ko = (t + 1) * 64;
        ra = *(const uint4*)(Ab + ko); rb0 = *(const uint4*)(Bb + ko); rb1 = *(const uint4*)(Bb + (size_t)64 * ldb + ko);
        rb2 = *(const uint4*)(Bb + (size_t)128 * ldb + ko); rb3 = *(const uint4*)(Bb + (size_t)192 * ldb + ko); }
#pragma unroll
      for (int s = 0; s < 4; ++s) {
        const bf16x8 a = *(const bf16x8*)(cur + a_rd + s * 32);
        const bf16x8 b0 = *(const bf16x8*)(cur + b_rd + s * 32);
        const bf16x8 b1 = *(const bf16x8*)(cur + b_rd + 32 * G_STRIDE + s * 32);
        acc0 = MFMA32(a, b0, acc0); acc1 = MFMA32(a, b1, acc1);
      }
      if (more) {
        *(uint4*)(nb + st_off) = ra;
        *(uint4*)(nb + G_ABYTES + st_off) = rb0; *(uint4*)(nb + G_ABYTES + 64 * G_STRIDE + st_off) = rb1;
        *(uint4*)(nb + G_ABYTES + 128 * G_STRIDE + st_off) = rb2; *(uint4*)(nb + G_ABYTES + 192 * G_STRIDE + st_off) = rb3;
      }
      __syncthreads();
    }
    epi(wm * 32, ch * 256 + wn * 64, acc0, acc1);
    __syncthreads();
  }
}

DI void p0_transpose(char* lds, const float* __restrict__ W, int K, int N, bf16_t* __restrict__ Wt, int item) {
  float* s = (float*)lds;
  const int tid = threadIdx.x;
  const int ntn = (N + 63) >> 6, kt = item / ntn, nt = item % ntn, k0 = kt * 64, n0 = nt * 64;
  __syncthreads();
#pragma unroll
  for (int i = 0; i < 8; ++i) { int e = tid + 512 * i; int kk = e >> 6, nn = e & 63; s[kk * 65 + nn] = (n0 + nn < N) ? W[(size_t)(k0 + kk) * N + n0 + nn] : 0.f; }
  __syncthreads();
  const int nn = tid >> 3, part = tid & 7;
  const float* sp = s + (part * 8) * 65 + nn;
  uint4 o; o.x = pack2(sp[0], sp[65]); o.y = pack2(sp[2 * 65], sp[3 * 65]); o.z = pack2(sp[4 * 65], sp[5 * 65]); o.w = pack2(sp[6 * 65], sp[7 * 65]);
  *(uint4*)(Wt + (size_t)(n0 + nn) * K + k0 + part * 8) = o;
}

DI void phase0(const KP& p, char* lds) {
  const int tid = threadIdx.x, bid = blockIdx.x, nb = gridDim.x;
  unsigned char* ws = p.ws;
  constexpr int I_IN = 16 * 36, I_QUP = 6 * 12, I_KVUP = 4 * 16, I_OUT = 16 * 16, I_PQ = 16 * 32;
  constexpr int I_ALL = I_IN + I_QUP + I_KVUP + I_OUT + I_PQ;
  for (int it = bid; it < I_ALL; it += nb) {
    int q = it;
    if (q < I_IN) { p0_transpose(lds, p.in[7], 1024, 2272, (bf16_t*)(ws + WS_WTIN), q); continue; } q -= I_IN;
    if (q < I_QUP) { p0_transpose(lds, p.in[9], 384, 768, (bf16_t*)(ws + WS_WTQUP), q); continue; } q -= I_QUP;
    if (q < I_KVUP) { p0_transpose(lds, p.in[11], 256, 1024, (bf16_t*)(ws + WS_WTKVUP), q); continue; } q -= I_KVUP;
    if (q < I_OUT) { p0_transpose(lds, p.in[17], 1024, 1024, (bf16_t*)(ws + WS_WTOUT), q); continue; } q -= I_OUT;
    p0_transpose(lds, p.in[20], 1024, 2048, (bf16_t*)(ws + WS_WTPQ), q);
  }
  { bf16_t* kd = (bf16_t*)(ws + WS_KD);
    for (int e = bid * NTHR + tid; e < 65536; e += nb * NTHR) { int n = e >> 8, k = e & 255; float v = 0.f;
      if (n < 128 && k < 128) v = p.in[21][n * 128 + k]; else if (n >= 128 && k >= 128) v = p.in[22][(n - 128) * 128 + (k - 128)];
      kd[e] = f2bf(v); } }
  { const size_t n8 = (size_t)16384 * 1024 / 8;
    for (int t = 0; t < 2; ++t) { const float* src = p.in[23 + t]; bf16_t* dst = (bf16_t*)(ws + (t ? WS_EV : WS_EU));
      for (size_t i = (size_t)bid * NTHR + tid; i < n8; i += (size_t)nb * NTHR) { const float4 x0 = *(const float4*)(src + i * 8), x1 = *(const float4*)(src + i * 8 + 4);
        uint4 o; o.x = pack2(x0.x, x0.y); o.y = pack2(x0.z, x0.w); o.z = pack2(x1.x, x1.y); o.w = pack2(x1.z, x1.w); *(uint4*)(dst + i * 8) = o; } } }
  for (int jb = bid; jb < 96; jb += nb) {
    __syncthreads();
    float* cact = (float*)lds;
    float* red = (float*)(lds + 32768);
    for (int e = tid; e < 8192; e += NTHR) cact[e] = silu_f(p.in[1][e]);
    __syncthreads();
    const int jj = tid & 63, ks = tid >> 6, j0 = jb * 64;
    float acc[8];
#pragma unroll
    for (int b = 0; b < 8; ++b) acc[b] = 0.f;
    const float* wp = p.in[3] + (size_t)(ks * 128) * 6144 + j0 + jj;
    for (int k = 0; k < 128; ++k) { const float wv = wp[(size_t)k * 6144];
#pragma unroll
      for (int b = 0; b < 8; ++b) acc[b] += cact[b * 1024 + ks * 128 + k] * wv; }
#pragma unroll
    for (int b = 0; b < 8; ++b) red[(ks * 64 + jj) * 8 + b] = acc[b];
    __syncthreads();
    { const int b = tid >> 6; float sacc = p.in[4][j0 + jj];
#pragma unroll
      for (int k2 = 0; k2 < 8; ++k2) sacc += red[(k2 * 64 + jj) * 8 + b];
      ((float*)(ws + WS_MOD))[b * 6144 + j0 + jj] = sacc; }
  }
}

constexpr int WT_STRIDE = 144, WT_BYTES = 32 * WT_STRIDE;
DI void wt_write(char* wl, const f32x16& a0, const f32x16& a1, int r, int hh, float scale) {
  char* bp = wl + (4 * hh) * WT_STRIDE + r * 2;
#pragma unroll
  for (int reg = 0; reg < 16; ++reg) { const int ro = ((reg & 3) + 8 * (reg >> 2)) * WT_STRIDE;
    *(bf16_t*)(bp + ro) = f2bf(a0[reg] * scale); *(bf16_t*)(bp + ro + 64) = f2bf(a1[reg] * scale); }
}
DI void wt_write_rope(char* wl, const f32x16& a0, const f32x16& a1, int r, int hh, const float* cs, const float* sn, int m0) {
  char* bp = wl + (4 * hh) * WT_STRIDE + r * 2;
#pragma unroll
  for (int reg = 0; reg < 16; ++reg) { const int rw = (reg & 3) + 8 * (reg >> 2); const int row = m0 + rw + 4 * hh;
    const float c = cs[row * 32 + r], s = sn[row * 32 + r];
    *(bf16_t*)(bp + rw * WT_STRIDE) = f2bf(a0[reg] * c - a1[reg] * s); *(bf16_t*)(bp + rw * WT_STRIDE + 64) = f2bf(a1[reg] * c + a0[reg] * s); }
}
DI void wt_store(const char* wl, int lane, bf16_t* dA, int sA, bf16_t* dB, int sB) {
  const int piece = lane & 7, rsub = lane >> 3;
  bf16_t* d = (piece < 4) ? dA : dB; const int st = (piece < 4) ? sA : sB;
  if (d) {
#pragma unroll
    for (int i = 0; i < 4; ++i) { const int row = i * 8 + rsub; const uint4 v = *(const uint4*)(wl + row * WT_STRIDE + piece * 16);
      *(uint4*)(d + (size_t)row * st + (piece & 3) * 8) = v; }
  }
}
#define LDS_FENCE() asm volatile("s_waitcnt lgkmcnt(0)" ::: "memory")
DI int lv(int x) { asm volatile("" : "+v"(x)); return x; }
template <class T> DI T* launder(T* q) { size_t z = 0; asm volatile("" : "+s"(z)); return (T*)((char*)q + z); }

constexpr int GL_GR = 0, GL_VT = 8192, GL_QD = 26624, GL_KI = 45056, GL_KIT = 63488, GL_ATT = 81920, GL_TOT = 91136, GL_DEC = 93184, GL_LA = 93696  ;
DI void gla_chunk_local(const KP& p, char* lds, unsigned char* ws, int tile, const bf16_t* qg, const bf16_t* kg, const bf16_t* vg, const bf16_t* GR) {
  const int tid = lv(threadIdx.x), lane = tid & 63, w = tid >> 6, r = lane & 31, hh = lane >> 5;
  const int b = tile >> 5, n = tile & 31, tok0 = tile * 64;
  float* GRL = (float*)(lds + GL_GR); float* TOT = (float*)(lds + GL_TOT); float* DECL = (float*)(lds + GL_DEC);
  __syncthreads();
#pragma unroll
  for (int i = 0; i < 4; ++i) GRL[tid + 512 * i] = bf2f(GR[tid + 512 * i]);
#pragma unroll 1
  for (int h = 0; h < 4; ++h) {
    __syncthreads();
#pragma unroll
    for (int i = 0; i < 2; ++i) { const int c = tid + 512 * i, t = c >> 4, d8 = (c & 15) * 8;
      const uint4 v = *(const uint4*)(vg + (size_t)t * 512 + h * 128 + d8);
      bf16_t* vt = (bf16_t*)(lds + GL_VT) + d8 * 72 + t;
      vt[0] = (bf16_t)(v.x & 0xffffu); vt[72] = (bf16_t)(v.x >> 16); vt[144] = (bf16_t)(v.y & 0xffffu); vt[216] = (bf16_t)(v.y >> 16);
      vt[288] = (bf16_t)(v.z & 0xffffu); vt[360] = (bf16_t)(v.z >> 16); vt[432] = (bf16_t)(v.w & 0xffffu); vt[504] = (bf16_t)(v.w >> 16); }
    const int dir = tid >> 8, qt = (tid >> 6) & 3, dk = tid & 63, col = h * 64 + dk;
    float* LAL = (float*)(lds + GL_LA) + tid;
    {
      const float* wg = launder(dir ? p.in[14] : p.in[12]); const float* bg = launder(dir ? p.in[15] : p.in[13]);
      float wr[16];
#pragma unroll
      for (int q = 0; q < 16; ++q) wr[q] = wg[q * 256 + col];
      const float bias = bg[col];
      float run = 0.f;
#pragma unroll 2
      for (int ii = 0; ii < 16; ++ii) { const int i = dir ? 15 - ii : ii;
        const float* gp = GRL + (qt * 16 + i) * 32 + dir * 16; float x = bias;
#pragma unroll
        for (int q = 0; q < 16; ++q) x += gp[q] * wr[q];
        run += logsigmoid_f(x) * (1.f / 16.f); LAL[i * 512] = run; }
      TOT[(dir * 64 + dk) * 4 + qt] = run;
    }
    __syncthreads();
    {
      const float4 tq = *(const float4*)(TOT + (dir * 64 + dk) * 4);
      const float total = (tq.x + tq.y) + (tq.z + tq.w);
      float off;
      if (dir == 0) off = (qt > 0 ? tq.x : 0.f) + (qt > 1 ? tq.y : 0.f) + (qt > 2 ? tq.z : 0.f);
      else          off = (qt < 1 ? tq.y : 0.f) + (qt < 2 ? tq.z : 0.f) + (qt < 3 ? tq.w : 0.f);
      if (qt == 0) { const float dc = expf(total); DECL[dir * 64 + dk] = dc; ((float*)(ws + WS_DEC))[((size_t)((b * 4 + h) * 2 + dir) * 32 + n) * 64 + dk] = dc; }
      bf16_t* QD = (bf16_t*)(lds + GL_QD + dir * 9216) + (qt * 16) * 72 + dk; bf16_t* KI = (bf16_t*)(lds + GL_KI + dir * 9216) + (qt * 16) * 72 + dk;
      bf16_t* KIT = (bf16_t*)(lds + GL_KIT + dir * 9216) + dk * 72 + qt * 16;
      bf16_t* qdg = (bf16_t*)(ws + WS_QDEC) + (size_t)((tile * 4 + h) * 2 + dir) * 4096 + (qt * 16) * 64 + dk;
      const bf16_t* qgp = qg + (size_t)(qt * 16) * 256 + col; const bf16_t* kgp = kg + (size_t)(qt * 16) * 256 + col;
#pragma unroll 2
      for (int i = 0; i < 16; ++i) { const float bb = off + LAL[i * 512];
        const float qv = bf2f(qgp[i * 256]), kv = bf2f(kgp[i * 256]);
        const bf16_t qd = f2bf(qv * expf(bb)), ki = f2bf(kv * expf(-bb));
        QD[i * 72] = qd; KI[i * 72] = ki; qdg[i * 64] = qd; KIT[i] = ki; }
    }
    __syncthreads();
    if (w < 4) { const int mi = w >> 1, ni = w & 1;
      f32x16 asum;
#pragma unroll
      for (int i = 0; i < 16; ++i) asum[i] = 0.f;
#pragma unroll
      for (int d = 0; d < 2; ++d) { f32x16 acc;
#pragma unroll
        for (int i = 0; i < 16; ++i) acc[i] = 0.f;
#pragma unroll
        for (int s = 0; s < 4; ++s) { const bf16x8 a = *(const bf16x8*)(lds + GL_QD + d * 9216 + (mi * 32 + r) * 144 + s * 32 + hh * 16);
          const bf16x8 bb = *(const bf16x8*)(lds + GL_KI + d * 9216 + (ni * 32 + r) * 144 + s * 32 + hh * 16); acc = MFMA32(a, bb, acc); }
#pragma unroll
        for (int reg = 0; reg < 16; ++reg) { const int ti = mi * 32 + crow(reg, hh), tj = ni * 32 + r; const bool keep = d ? (tj >= ti) : (tj <= ti); asum[reg] += keep ? acc[reg] : 0.f; } }
      bf16_t* at = (bf16_t*)(lds + GL_ATT) + (mi * 32 + 4 * hh) * 72 + ni * 32 + r;
#pragma unroll
      for (int reg = 0; reg < 16; ++reg) at[((reg & 3) + 8 * (reg >> 2)) * 72] = f2bf(asum[reg]);
    }
    __syncthreads();
    { const int mi = w >> 2, ni = w & 3; f32x16 acc;
#pragma unroll
      for (int i = 0; i < 16; ++i) acc[i] = 0.f;
#pragma unroll
      for (int s = 0; s < 4; ++s) { const bf16x8 a = *(const bf16x8*)(lds + GL_ATT + (mi * 32 + r) * 144 + s * 32 + hh * 16);
        const bf16x8 bb = *(const bf16x8*)(lds + GL_VT + (ni * 32 + r) * 144 + s * 32 + hh * 16); acc = MFMA32(a, bb, acc); }
      bf16_t* oi = (bf16_t*)(ws + WS_OINTRA) + (size_t)(tok0 + mi * 32 + 4 * hh) * 512 + h * 128 + ni * 32 + r;
#pragma unroll
      for (int reg = 0; reg < 16; ++reg) oi[(size_t)((reg & 3) + 8 * (reg >> 2)) * 512] = f2bf(acc[reg]); }
    { const int dvb = w >> 1, dkb = w & 1;
#pragma unroll
      for (int d = 0; d < 2; ++d) { f32x16 acc;
#pragma unroll
        for (int i = 0; i < 16; ++i) acc[i] = 0.f;
#pragma unroll
        for (int s = 0; s < 4; ++s) { const bf16x8 a = *(const bf16x8*)(lds + GL_VT + (dvb * 32 + r) * 144 + s * 32 + hh * 16);
          const bf16x8 bb = *(const bf16x8*)(lds + GL_KIT + d * 9216 + (dkb * 32 + r) * 144 + s * 32 + hh * 16); acc = MFMA32(a, bb, acc); }
        const float sc = DECL[d * 64 + dkb * 32 + r];
        bf16_t* ds = (bf16_t*)(ws + WS_SPT) + ((size_t)((b * 4 + h) * 2 + d) * 32 + n) * 8192 + (size_t)(dvb * 32 + 4 * hh) * 64 + dkb * 32 + r;
#pragma unroll
        for (int reg = 0; reg < 16; ++reg) ds[((reg & 3) + 8 * (reg >> 2)) * 64] = f2bf(acc[reg] * sc); } }
  }
}

DI void phase1(const KP& p, char* lds) {
  const int tid = threadIdx.x, lane = tid & 63, w = tid >> 6, r = lane & 31, hh = lane >> 5;
  float* cs = (float*)(lds + LDS_TAB); float* sn = cs + 2048;
  char* wl = lds + w * WT_BYTES;
  for (int tile = blockIdx.x; tile < 256; tile += gridDim.x) {
    unsigned char* ws = launder(p.ws); unsigned char* ob = (unsigned char*)launder(p.out); const float* xin = launder(p.in[0]);
    const float* mod = (const float*)(ws + WS_MOD);
    const int tok0 = tile * 64, b = tile >> 5, t0 = (tile & 31) * 64;
    bf16_t* Hs = (bf16_t*)(ob + OUT_HS) + (size_t)tok0 * 1024;
    bf16_t* CQ = (bf16_t*)(ob + OUT_CQ) + (size_t)tok0 * 640;
    bf16_t* CQN = Hs; bf16_t* CKVN = Hs + 64 * 384;
    bf16_t* GR = (bf16_t*)(ob + OUT_GR) + (size_t)tok0 * 32;
    bf16_t* Qm = (bf16_t*)(ws + WS_QM); bf16_t* Km = (bf16_t*)(ws + WS_KM); bf16_t* Vm = (bf16_t*)(ws + WS_VM);
    bf16_t* qg = (bf16_t*)(ws + WS_P1S + (size_t)tile * 131072); bf16_t* kg = qg + 64 * 256; bf16_t* vg = qg + 2 * 64 * 256;
    bf16_t* rg = (bf16_t*)(ws + WS_RG) + (size_t)tok0 * 512;
    __syncthreads();
#pragma unroll
    for (int i = 0; i < 4; ++i) { const int e = tid + 512 * i, tt = e >> 5, j = e & 31;
      const float inv = powf(10000.f, -(float)j * (1.f / 32.f)); const float ang = (float)((const int*)p.in[2])[tok0 + tt] * inv;
      cs[e] = cosf(ang); sn[e] = sinf(ang); }
    {
      float4 ge[4], sh[4];
      const float* gpre = launder(p.in[5]); const float* modb = launder(mod) + b * 6144;
#pragma unroll
      for (int i = 0; i < 4; ++i) { const int d = (lane + 64 * i) * 4;
        const float4 g = *(const float4*)(gpre + d); const float4 sc = *(const float4*)(modb + 1024 + d); sh[i] = *(const float4*)(modb + d);
        ge[i] = make_float4(g.x * (1.f + sc.x), g.y * (1.f + sc.y), g.z * (1.f + sc.z), g.w * (1.f + sc.w)); }
      for (int rr = 0; rr < 8; ++rr) { const int row = w * 8 + rr;
        const float* xr = xin + (size_t)(tok0 + row) * 1024;
        float4 v[4]; float ss = 0.f;
#pragma unroll
        for (int i = 0; i < 4; ++i) { v[i] = *(const float4*)(xr + (lane + 64 * i) * 4); ss += v[i].x * v[i].x + v[i].y * v[i].y + v[i].z * v[i].z + v[i].w * v[i].w; }
        ss = wave_sum(ss); const float rs = rsqrtf(ss * (1.f / 1024.f) + EPS);
#pragma unroll
        for (int i = 0; i < 4; ++i) { uint2 o; o.x = pack2(v[i].x * rs * ge[i].x + sh[i].x, v[i].y * rs * ge[i].y + sh[i].y); o.y = pack2(v[i].z * rs * ge[i].z + sh[i].z, v[i].w * rs * ge[i].w + sh[i].w);
          *(uint2*)(Hs + (size_t)row * 1024 + (lane + 64 * i) * 4) = o; }
      }
    }
    __syncthreads();
    block_gemm(lds, Hs, 1024, (const bf16_t*)(ws + WS_WTIN), 1024, 9, 1024, [&](int m0, int n0, const f32x16& a0, const f32x16& a1) {
      const int r2 = lv(r), h2 = lv(hh), ln = lv(lane);
      if (n0 == O_KR) {
        wt_write_rope(wl, a0, a1, r2, h2, cs, sn, m0); LDS_FENCE();
        for (int h = 0; h < 4; ++h) { bf16_t* kp = Km + (((size_t)b * 4 + h) * SEQ + t0 + m0) * 192 + 128; wt_store(wl, ln, kp, 192, kp + 32, 192); }
        return; }
      wt_write(wl, a0, a1, r2, h2, (n0 >= O_QG && n0 < O_KG) ? 0.125f : 1.f); LDS_FENCE();
      bf16_t* d[2]; int st[2];
#pragma unroll
      for (int half = 0; half < 2; ++half) { const int nb = n0 + 32 * half;
        if (nb < 640) { d[half] = CQ + (size_t)m0 * 640 + nb; st[half] = 640; }
        else if (nb < O_KG) { d[half] = qg + (size_t)m0 * 256 + (nb - O_QG); st[half] = 256; }
        else if (nb < O_VG) { d[half] = kg + (size_t)m0 * 256 + (nb - O_KG); st[half] = 256; }
        else if (nb < O_GF) { d[half] = vg + (size_t)m0 * 512 + (nb - O_VG); st[half] = 512; }
        else if (nb < O_R) { d[half] = GR + (size_t)m0 * 32; st[half] = 32; }
        else if (nb < INW) { d[half] = rg + (size_t)m0 * 512 + (nb - O_R); st[half] = 512; }
        else { d[half] = nullptr; st[half] = 0; } }
      wt_store(wl, ln, d[0], st[0], d[1], st[1]);
    });
    __syncthreads();
    const float* gq = launder(p.in[8]); const float* gkv = launder(p.in[10]);
    for (int rr = 0; rr < 8; ++rr) { const int row = w * 8 + rr; const bf16_t* cr = CQ + (size_t)row * 640;
      float v[6]; float ss = 0.f;
#pragma unroll
      for (int i = 0; i < 6; ++i) { v[i] = bf2f(cr[lane + 64 * i]); ss += v[i] * v[i]; }
      ss = wave_sum(ss); float rs = rsqrtf(ss * (1.f / 384.f) + EPS);
#pragma unroll
      for (int i = 0; i < 6; ++i) CQN[(size_t)row * 384 + lane + 64 * i] = f2bf(v[i] * rs * gq[lane + 64 * i]);
      float u[4]; float s2 = 0.f;
#pragma unroll
      for (int i = 0; i < 4; ++i) { u[i] = bf2f(cr[384 + lane + 64 * i]); s2 += u[i] * u[i]; }
      s2 = wave_sum(s2); rs = rsqrtf(s2 * (1.f / 256.f) + EPS);
#pragma unroll
      for (int i = 0; i < 4; ++i) CKVN[(size_t)row * 256 + lane + 64 * i] = f2bf(u[i] * rs * gkv[lane + 64 * i]);
    }
    __syncthreads();
    block_gemm(lds, CQN, 384, (const bf16_t*)(ws + WS_WTQUP), 384, 3, 384, [&](int m0, int n0, const f32x16& a0, const f32x16& a1) {
      const int r2 = lv(r), h2 = lv(hh), ln = lv(lane);
      const int h = n0 / 192, d0 = n0 % 192;
      bf16_t* qp = Qm + (((size_t)b * 4 + h) * SEQ + t0 + m0) * 192 + d0;
      if (d0 < 128) wt_write(wl, a0, a1, r2, h2, 1.f); else wt_write_rope(wl, a0, a1, r2, h2, cs, sn, m0);
      LDS_FENCE();
      wt_store(wl, ln, qp, 192, qp + 32, 192);
    });
    block_gemm(lds, CKVN, 256, (const bf16_t*)(ws + WS_WTKVUP), 256, 4, 256, [&](int m0, int n0, const f32x16& a0, const f32x16& a1) {
      const int r2 = lv(r), h2 = lv(hh), ln = lv(lane);
      const int h = n0 >> 8, d0 = n0 & 255;
      wt_write(wl, a0, a1, r2, h2, 1.f); LDS_FENCE();
      if (d0 < 128) { bf16_t* kp = Km + (((size_t)b * 4 + h) * SEQ + t0 + m0) * 192 + d0; wt_store(wl, ln, kp, 192, kp + 32, 192); }
      else { bf16_t* vp = Vm + (((size_t)b * 4 + h) * SEQ + t0 + m0) * 128 + (d0 - 128); wt_store(wl, ln, vp, 128, vp + 32, 128); }
    });
    gla_chunk_local(p, lds, ws, tile, qg, kg, vg, GR);
  }
}

namespace att {
typedef short s16x4 __attribute__((ext_vector_type(4)));
typedef unsigned u32x4 __attribute__((ext_vector_type(4)));
constexpr int DQ = 192, DV = 128, KVBLK = 64;
constexpr float SCALE = 0.07216878364870322f;
constexpr float THR = 8.f;
constexpr int SHM_V = KVBLK * DV * 2, SHM_K = KVBLK * DQ * 2;
constexpr int SHM_QR = 8 * 32 * 176;
constexpr int SHM_ATTN = 2 * SHM_V + 2 * SHM_K + 8 * 64 * 4 + SHM_QR;
#define KSWZ(row, colB) ((row) * 384 + ((colB) ^ (((row) & 7) << 4)))
#define SBAR() __builtin_amdgcn_sched_barrier(0)
DI unsigned cvtpk(float lo, float hi) { unsigned r; asm volatile("v_cvt_pk_bf16_f32 %0, %1, %2" : "=v"(r) : "v"(lo), "v"(hi)); return r; }

DI void partialSM(f32x16& p0, f32x16& p1, float& m_reg, float& mn, float& alpha) {
  constexpr float C = SCALE * 1.4426950408889634f;
  float pmax = p0[0];
#pragma unroll
  for (int r = 1; r < 16; ++r) pmax = fmaxf(pmax, p0[r]);
#pragma unroll
  for (int r = 0; r < 16; ++r) pmax = fmaxf(pmax, p1[r]);
  { auto rr = __builtin_amdgcn_permlane32_swap(__float_as_uint(pmax), __float_as_uint(pmax), false, false);
    pmax = fmaxf(__uint_as_float(rr[0]), __uint_as_float(rr[1])); }
  if (__builtin_expect(__all(pmax - m_reg <= THR / SCALE), 1)) { mn = m_reg; alpha = 1.f; }
  else { mn = fmaxf(m_reg, pmax); alpha = __builtin_amdgcn_exp2f((m_reg - mn) * C); m_reg = mn; }
  const float mnC = -mn * C;
#pragma unroll
  for (int r = 0; r < 16; ++r) p0[r] = fmaf(p0[r], C, mnC);
#pragma unroll
  for (int r = 0; r < 16; ++r) p1[r] = fmaf(p1[r], C, mnC);
#pragma unroll
  for (int r = 0; r < 16; ++r) p0[r] = __builtin_amdgcn_exp2f(p0[r]);
}
DI void finishSM(f32x16& p0, f32x16& p1, float alpha, float& l_reg, bf16x8& pa0, bf16x8& pa1, bf16x8& pa2, bf16x8& pa3) {
#pragma unroll
  for (int r = 0; r < 16; ++r) p1[r] = __builtin_amdgcn_exp2f(p1[r]);
  float ps = 0;
#pragma unroll
  for (int r = 0; r < 16; ++r) ps += p0[r];
#pragma unroll
  for (int r = 0; r < 16; ++r) ps += p1[r];
  { auto rr = __builtin_amdgcn_permlane32_swap(__float_as_uint(ps), __float_as_uint(ps), false, false);
    ps = __uint_as_float(rr[0]) + __uint_as_float(rr[1]); }
  l_reg = l_reg * alpha + ps;
#define PK4(P, BASE, OUT) do { unsigned a0 = cvtpk(P[BASE + 0], P[BASE + 1]), a1 = cvtpk(P[BASE + 2], P[BASE + 3]);   \
    unsigned b0 = cvtpk(P[BASE + 4], P[BASE + 5]), b1 = cvtpk(P[BASE + 6], P[BASE + 7]);                              \
    auto r0 = __builtin_amdgcn_permlane32_swap(a0, b0, false, false); auto r1 = __builtin_amdgcn_permlane32_swap(a1, b1, false, false); \
    u32x4 wv = {r0[0], r1[0], r0[1], r1[1]}; OUT = *reinterpret_cast<bf16x8*>(&wv); } while (0)
  PK4(p0, 0, pa0); PK4(p0, 8, pa1); PK4(p1, 0, pa2); PK4(p1, 8, pa3);
#undef PK4
}
DI void qkt(f32x16& p0, f32x16& p1, const char* Ks, const bf16x8* qr, const char* qrl, int r32, int hi) {
#pragma unroll
  for (int i = 0; i < 16; ++i) { p0[i] = 0.f; p1[i] = 0.f; }
#pragma unroll
  for (int d0 = 0; d0 < 12; ++d0) { const int cb = (d0 * 16 + hi * 8) * 2;
    const bf16x8 b0 = *reinterpret_cast<const bf16x8*>(Ks + KSWZ(r32, cb));
    const bf16x8 b1 = *reinterpret_cast<const bf16x8*>(Ks + KSWZ(32 + r32, cb));
    const bf16x8 q = (d0 < 7) ? qr[d0 < 7 ? d0 : 0] : *reinterpret_cast<const bf16x8*>(qrl + (d0 - 7) * 32);
    p0 = MFMA32(b0, q, p0);
    p1 = MFMA32(b1, q, p1); }
}
DI int v_st(int k, int c) { const int kk = (k & ~0xC) | ((k & 4) << 1) | ((k & 8) >> 1); return ((kk >> 3) * 4 + (c >> 5)) * 512 + ((kk & 7) * 32 + (c & 31)) * 2; }
DI int v_rd_base(int lane) { return ((lane & 3) << 3) | (((lane >> 2) & 3) << 6) | (((lane >> 4) & 1) << 5) | (((lane >> 5) & 1) << 8); }
constexpr int v_rd_off(int d0, int ks, int half) { return d0 * 512 + ks * 4096 + half * 2048; }
template <int OFF> DI s16x4 tr_read(int vb) { s16x4 r; asm volatile("ds_read_b64_tr_b16 %0, %1 offset:%2" : "=&v"(r) : "v"(vb), "i"(OFF) : "memory"); return r; }
template <int D0> DI void pv_one(f32x16& od, int vb, bf16x8 pa0, bf16x8 pa1, bf16x8 pa2, bf16x8 pa3) {
  const s16x4 l0 = tr_read<v_rd_off(D0, 0, 0)>(vb), h0 = tr_read<v_rd_off(D0, 0, 1)>(vb), l1 = tr_read<v_rd_off(D0, 1, 0)>(vb), h1 = tr_read<v_rd_off(D0, 1, 1)>(vb);
  const s16x4 l2 = tr_read<v_rd_off(D0, 2, 0)>(vb), h2 = tr_read<v_rd_off(D0, 2, 1)>(vb), l3 = tr_read<v_rd_off(D0, 3, 0)>(vb), h3 = tr_read<v_rd_off(D0, 3, 1)>(vb);
  asm volatile("s_waitcnt lgkmcnt(0)" ::: "memory"); SBAR();
#define PK(L, H) (bf16x8){L[0], L[1], L[2], L[3], H[0], H[1], H[2], H[3]}
  od = MFMA32(pa0, PK(l0, h0), od);
  od = MFMA32(pa1, PK(l1, h1), od);
  od = MFMA32(pa2, PK(l2, h2), od);
  od = MFMA32(pa3, PK(l3, h3), od);
#undef PK
}
DI void pv_d0(f32x16* o, int vb, bf16x8 pa0, bf16x8 pa1, bf16x8 pa2, bf16x8 pa3) {
  pv_one<0>(o[0], vb, pa0, pa1, pa2, pa3); pv_one<1>(o[1], vb, pa0, pa1, pa2, pa3); pv_one<2>(o[2], vb, pa0, pa1, pa2, pa3); pv_one<3>(o[3], vb, pa0, pa1, pa2, pa3);
}
DI void attn_unit(const bf16_t* Qb, const bf16_t* Kh, const bf16_t* Vh, bf16_t* Ob, int seq, char* lds) {
  const int tid = lv(threadIdx.x), wid = tid >> 6, lane = tid & 63, r32 = lane & 31, hi = lane >> 5;
  char* V_lds = lds; char* K_lds = lds + 2 * SHM_V;
  float* wsf = (float*)(lds + 2 * SHM_V + 2 * SHM_K) + wid * 64; float* li_l = wsf; float* al_l = wsf + 32;
  char* qrl = lds + 2 * SHM_V + 2 * SHM_K + 8 * 64 * 4 + wid * (32 * 176) + r32 * 176 + hi * 16;
  float m_reg = -1e30f, l_reg = 0; f32x16 o[4]; bf16x8 qr[7];
#pragma unroll
  for (int d = 0; d < 4; ++d)
#pragma unroll
    for (int i = 0; i < 16; ++i) o[d][i] = 0.f;
  const bf16_t* Qw = Qb + (size_t)(wid * 32 + r32) * DQ + hi * 8;
#pragma unroll
  for (int d0 = 0; d0 < 7; ++d0) qr[d0] = *reinterpret_cast<const bf16x8*>(Qw + d0 * 16);
#pragma unroll
  for (int d0 = 7; d0 < 12; ++d0) *reinterpret_cast<bf16x8*>(qrl + (d0 - 7) * 32) = *reinterpret_cast<const bf16x8*>(Qw + d0 * 16);
  int kst[3];
#pragma unroll
  for (int i = 0; i < 3; ++i) { const int c = tid + 512 * i; kst[i] = KSWZ(c / 24, (c % 24) * 16); }
  const int vst0 = v_st(tid >> 4, (tid & 15) * 8), vst1 = v_st(32 + (tid >> 4), (tid & 15) * 8);
  const int vb0 = (int)(uintptr_t)V_lds + v_rd_base(lane);
  bf16x8 sk0, sk1, sk2, sv0, sv1;
#define SLOAD(k0) do { const bf16x8* kp = reinterpret_cast<const bf16x8*>(Kh + (size_t)(k0) * DQ) + tid; sk0 = kp[0]; sk1 = kp[512]; sk2 = kp[1024]; \
    const bf16x8* vp = reinterpret_cast<const bf16x8*>(Vh + (size_t)(k0) * DV) + tid; sv0 = vp[0]; sv1 = vp[512]; } while (0)
#define SWRITE(b) do { *(bf16x8*)(V_lds + (b) * SHM_V + vst0) = sv0; *(bf16x8*)(V_lds + (b) * SHM_V + vst1) = sv1; \
    *(bf16x8*)(K_lds + (b) * SHM_K + kst[0]) = sk0; *(bf16x8*)(K_lds + (b) * SHM_K + kst[1]) = sk1; *(bf16x8*)(K_lds + (b) * SHM_K + kst[2]) = sk2; } while (0)
#define RESC(a) do { if (__any((a) < 1.f)) { if (hi == 0) al_l[r32] = (a); asm volatile("s_waitcnt lgkmcnt(0)" ::: "memory"); \
    _Pragma("unroll") for (int d = 0; d < 4; ++d) _Pragma("unroll") for (int r = 0; r < 16; ++r) o[d][r] *= al_l[crow(r, hi)]; } } while (0)
  f32x16 pA0, pA1, pB0, pB1; float mnA, mnB, alA, alB; bf16x8 pa0, pa1, pa2, pa3; const int NT = seq / KVBLK;
  SLOAD(0); SWRITE(0); __syncthreads();
  qkt(pA0, pA1, K_lds, qr, qrl, r32, hi); partialSM(pA0, pA1, m_reg, mnA, alA);
  SLOAD(KVBLK); SWRITE(1); __syncthreads();
  for (int j = 1; j + 1 < NT; j += 2) {
    SBAR(); qkt(pB0, pB1, K_lds + SHM_K, qr, qrl, r32, hi);
    finishSM(pA0, pA1, alA, l_reg, pa0, pa1, pa2, pa3); SBAR();
    SLOAD((j + 1) * KVBLK); SBAR();
    pv_d0(o, vb0, pa0, pa1, pa2, pa3); partialSM(pB0, pB1, m_reg, mnB, alB);
    __syncthreads(); SWRITE(0);
    RESC(alB); __syncthreads();
    SBAR(); qkt(pA0, pA1, K_lds, qr, qrl, r32, hi);
    finishSM(pB0, pB1, alB, l_reg, pa0, pa1, pa2, pa3); SBAR();
    SLOAD((j + 2) * KVBLK); SBAR();
    pv_d0(o, vb0 + SHM_V, pa0, pa1, pa2, pa3); partialSM(pA0, pA1, m_reg, mnA, alA);
    __syncthreads(); SWRITE(1);
    RESC(alA); __syncthreads();
  }
  SBAR(); qkt(pB0, pB1, K_lds + SHM_K, qr, qrl, r32, hi);
  finishSM(pA0, pA1, alA, l_reg, pa0, pa1, pa2, pa3); SBAR();
  pv_d0(o, vb0, pa0, pa1, pa2, pa3); partialSM(pB0, pB1, m_reg, mnB, alB);
  __syncthreads(); RESC(alB);
  finishSM(pB0, pB1, alB, l_reg, pa0, pa1, pa2, pa3); SBAR();
  pv_d0(o, vb0 + SHM_V, pa0, pa1, pa2, pa3);
  if (hi == 0) li_l[r32] = l_reg; asm volatile("s_waitcnt lgkmcnt(0)" ::: "memory");
  float rli[16];
#pragma unroll
  for (int r = 0; r < 16; ++r) rli[r] = __builtin_amdgcn_rcpf(li_l[crow(r, hi)]);
  bf16_t* Ow = Ob + (size_t)(wid * 32) * 1024;
#pragma unroll
  for (int r = 0; r < 16; ++r) { const int orow = crow(r, hi);
#pragma unroll
    for (int d0 = 0; d0 < 4; ++d0) Ow[(size_t)orow * 1024 + d0 * 32 + r32] = f2bf(o[d0][r] * rli[r]); }
  __syncthreads();
#undef SLOAD
#undef SWRITE
#undef RESC
}
}

DI void phase2_attn(const KP& p, char* lds) {
  for (int u = blockIdx.x; u < 256; u += gridDim.x) {
    unsigned char* ws = launder(p.ws);
    const bf16_t* Qm = (const bf16_t*)(ws + WS_QM); const bf16_t* Km = (const bf16_t*)(ws + WS_KM); const bf16_t* Vm = (const bf16_t*)(ws + WS_VM);
    bf16_t* mixa = (bf16_t*)(ws + WS_P1S);
    const int qb = u & 7, bh = u >> 3, b = bh >> 2, h = bh & 3;
    att::attn_unit(Qm + ((size_t)bh * SEQ + qb * 256) * 192, Km + (size_t)bh * SEQ * 192, Vm + (size_t)bh * SEQ * 128,
                   mixa + ((size_t)b * SEQ + qb * 256) * 1024 + h * 128, SEQ, lds);
  }
}

constexpr int P3_TILE_BYTES = 256 * 1024;
constexpr int LDS_TK = LDS_GEMM;
constexpr int SCW = 260;
template <int N> DI void ce_desc(float (&a)[N], int i, int l) { const float hi = fmaxf(a[i], a[l]), lo = fminf(a[i], a[l]); a[i] = hi; a[l] = lo; }
DI void sort16_desc(float (&a)[16]) {
#pragma unroll
  for (int k = 2; k <= 16; k <<= 1)
#pragma unroll
    for (int j = k >> 1; j > 0; j >>= 1)
#pragma unroll
      for (int i = 0; i < 16; ++i) { const int l = i ^ j; if (l > i) { if ((i & k) == 0) ce_desc(a, i, l); else ce_desc(a, l, i); } }
}
DI void merge16_desc(float (&a)[16]) {
#pragma unroll
  for (int j = 8; j > 0; j >>= 1)
#pragma unroll
    for (int i = 0; i < 16; ++i) { const int l = i ^ j; if (l > i) ce_desc(a, i, l); }
}
DI void top16_merge(float (&a)[16], const float (&b)[16]) {
#pragma unroll
  for (int i = 0; i < 16; ++i) a[i] = fmaxf(a[i], b[15 - i]);
  merge16_desc(a);
}
template <int CTRL> DI float dpp_f(float v) { return __int_as_float(__builtin_amdgcn_mov_dpp(__float_as_int(v), CTRL, 0xF, 0xF, true)); }

DI float gelu_fast(float x) { return 0.5f * x * (1.f + erff(x * 0.70710678118654752f)); }

DI void phase3(const KP& p, char* lds) {
  const int tid0 = threadIdx.x;
  const int r = tid0 & 31, hh = (tid0 >> 5) & 1, lane = tid0 & 63;
  char* wl = lds + (tid0 >> 6) * WT_BYTES;
  for (int tile = blockIdx.x; tile < 256; tile += gridDim.x) {
    unsigned char* ws = launder(p.ws); float* outp = launder(p.out); const float* xin = launder(p.in[0]);
    const int tok0 = tile * 64, b = tile >> 5;
    unsigned char* tsc = ws + WS_QM + (size_t)tile * P3_TILE_BYTES;
    bf16_t* QRY = (bf16_t*)tsc; bf16_t* Y = (bf16_t*)tsc; bf16_t* MIXA = (bf16_t*)(ws + WS_P1S) + (size_t)tok0 * 1024; bf16_t* H2 = MIXA;
    const float* modb = launder((const float*)(ws + WS_MOD)) + b * 6144;
    __syncthreads();
    {
      const int tid = lv(tid0), lane = tid & 63, w = tid >> 6, r = lane & 31, hh = lane >> 5;
      const int h = w >> 1, mi = w & 1, n = tile & 31;
      const bf16_t* QDg = (const bf16_t*)(ws + WS_QDEC) + (size_t)(tile * 4 + h) * 2 * 4096 + (mi * 32 + r) * 64 + hh * 8;
      const bf16_t* SPg = (const bf16_t*)(ws + WS_SPT) + ((size_t)((b * 4 + h) * 2) * 32 + n) * 8192 + r * 64 + hh * 8;
      f32x16 acc[4];
#pragma unroll
      for (int ni = 0; ni < 4; ++ni)
#pragma unroll
        for (int i = 0; i < 16; ++i) acc[ni][i] = 0.f;
#pragma unroll
      for (int d = 0; d < 2; ++d)
#pragma unroll
        for (int s = 0; s < 4; ++s) { const bf16x8 a = *(const bf16x8*)(QDg + d * 4096 + s * 16);
#pragma unroll
          for (int ni = 0; ni < 4; ++ni) { const bf16x8 bb = *(const bf16x8*)(SPg + (size_t)d * 32 * 8192 + ni * 32 * 64 + s * 16); acc[ni] = MFMA32(a, bb, acc[ni]); } }
      const bf16_t* OI = (const bf16_t*)(ws + WS_OINTRA) + (size_t)(tok0 + mi * 32 + 4 * hh) * 512 + h * 128 + r;
#pragma unroll
      for (int ni = 0; ni < 4; ++ni)
#pragma unroll
        for (int reg = 0; reg < 16; ++reg) acc[ni][reg] += bf2f(OI[(size_t)((reg & 3) + 8 * (reg >> 2)) * 512 + ni * 32]);
      float rs[16];
#pragma unroll
      for (int reg = 0; reg < 16; ++reg) { float v = acc[0][reg] * acc[0][reg] + acc[1][reg] * acc[1][reg] + acc[2][reg] * acc[2][reg] + acc[3][reg] * acc[3][reg];
        v += __shfl_xor(v, 1); v += __shfl_xor(v, 2); v += __shfl_xor(v, 4); v += __shfl_xor(v, 8); v += __shfl_xor(v, 16);
        rs[reg] = rsqrtf(v * (1.f / 128.f) + EPS); }
      const float* ggl = launder(p.in[16]);
      const bf16_t* RGp = (const bf16_t*)(ws + WS_RG) + (size_t)(tok0 + mi * 32 + 4 * hh) * 512 + h * 128 + r;
      bf16_t* MX = MIXA + (size_t)(mi * 32 + 4 * hh) * 1024 + 512 + h * 128 + r;
#pragma unroll
      for (int ni = 0; ni < 4; ++ni) { const float g = ggl[ni * 32 + r];
#pragma unroll
        for (int reg = 0; reg < 16; ++reg) { const int ro = (reg & 3) + 8 * (reg >> 2); const float rv = bf2f(RGp[(size_t)ro * 512 + ni * 32]);
          MX[(size_t)ro * 1024 + ni * 32] = f2bf(acc[ni][reg] * rs[reg] * g * silu_f(rv)); } }
    }
    __syncthreads();
    block_gemm(lds, MIXA, 1024, (const bf16_t*)(ws + WS_WTOUT), 1024, 4, 1024, [&](int m0, int n0, const f32x16& a0, const f32x16& a1) {
      const int r2 = lv(r), h2 = lv(hh), ln = lv(lane);
      wt_write(wl, a0, a1, r2, h2, 1.f); LDS_FENCE();
      bf16_t* d = Y + (size_t)m0 * 1024 + n0; wt_store(wl, ln, d, 1024, d + 32, 1024);
    });
    __syncthreads();
    {
      const int tid = lv(tid0), lane = tid & 63, w = tid >> 6;
      float4 A1[4], A2[4], S2[4];
      const float* gpo = launder(p.in[6]); const float* gpf = launder(p.in[18]);
#pragma unroll
      for (int i = 0; i < 4; ++i) { const int d = (lane + 64 * i) * 4;
        const float4 gp = *(const float4*)(gpo + d), gt = *(const float4*)(modb + 2048 + d), g2 = *(const float4*)(gpf + d), sc = *(const float4*)(modb + 4096 + d);
        S2[i] = *(const float4*)(modb + 3072 + d);
        A1[i] = make_float4(gp.x * gt.x, gp.y * gt.y, gp.z * gt.z, gp.w * gt.w);
        A2[i] = make_float4(g2.x * (1.f + sc.x), g2.y * (1.f + sc.y), g2.z * (1.f + sc.z), g2.w * (1.f + sc.w)); }
      for (int rr = 0; rr < 8; ++rr) { const int row = w * 8 + rr; const size_t tok = tok0 + row;
        float4 yv[4]; float ss = 0.f;
#pragma unroll
        for (int i = 0; i < 4; ++i) { const uint2 u = *(const uint2*)(Y + (size_t)row * 1024 + (lane + 64 * i) * 4);
          yv[i] = make_float4(__uint_as_float(u.x << 16), __uint_as_float(u.x & 0xffff0000u), __uint_as_float(u.y << 16), __uint_as_float(u.y & 0xffff0000u));
          ss += yv[i].x * yv[i].x + yv[i].y * yv[i].y + yv[i].z * yv[i].z + yv[i].w * yv[i].w; }
        ss = wave_sum(ss); const float rs = rsqrtf(ss * (1.f / 1024.f) + EPS);
        float4 xv[4]; float s2 = 0.f;
#pragma unroll
        for (int i = 0; i < 4; ++i) { const float4 x = *(const float4*)(xin + tok * 1024 + (lane + 64 * i) * 4);
          xv[i] = make_float4(x.x + A1[i].x * yv[i].x * rs, x.y + A1[i].y * yv[i].y * rs, x.z + A1[i].z * yv[i].z * rs, x.w + A1[i].w * yv[i].w * rs);
          *(float4*)(outp + tok * 1024 + (lane + 64 * i) * 4) = xv[i];
          s2 += xv[i].x * xv[i].x + xv[i].y * xv[i].y + xv[i].z * xv[i].z + xv[i].w * xv[i].w; }
        s2 = wave_sum(s2); const float r2 = rsqrtf(s2 * (1.f / 1024.f) + EPS);
#pragma unroll
        for (int i = 0; i < 4; ++i) { uint2 o; o.x = pack2(xv[i].x * r2 * A2[i].x + S2[i].x, xv[i].y * r2 * A2[i].y + S2[i].y); o.y = pack2(xv[i].z * r2 * A2[i].z + S2[i].z, xv[i].w * r2 * A2[i].w + S2[i].w);
          *(uint2*)(H2 + (size_t)row * 1024 + (lane + 64 * i) * 4) = o; }
      }
    }
    __syncthreads();
    block_gemm(lds, H2, 1024, (const bf16_t*)(ws + WS_WTPQ), 1024, 8, 1024, [&](int m0, int n0, const f32x16& a0, const f32x16& a1) {
      const int r2 = lv(r), h2 = lv(hh), ln = lv(lane);
      wt_write(wl, a0, a1, r2, h2, 1.f); LDS_FENCE();
      bf16_t* d = QRY + (size_t)m0 * 2048 + n0; wt_store(wl, ln, d, 2048, d + 32, 2048);
    });
    float* SC = (float*)lds; unsigned* TK = (unsigned*)(lds + LDS_TK);
    for (int h = 0; h < 8; ++h) {
      block_gemm(lds, QRY + h * 256, 2048, (const bf16_t*)(ws + WS_KD), 256, 1, 256, [&](int m0, int n0, const f32x16& a0, const f32x16& a1) {
        const int r2 = lv(r), h2 = lv(hh);
        float* sp = SC + (m0 + 4 * h2) * SCW + n0 + r2;
#pragma unroll
        for (int reg = 0; reg < 16; ++reg) { const int ro = ((reg & 3) + 8 * (reg >> 2)) * SCW; sp[ro] = a0[reg]; sp[ro + 32] = a1[reg]; }
      });
      {
        const int tid = lv(tid0);
        const int tt = tid >> 3, sd = (tid >> 2) & 1, q = tid & 3;
        const float* sr = SC + tt * SCW + sd * 128 + q * 32;
        float a[16], c[16];
#pragma unroll
        for (int i = 0; i < 4; ++i) { const float4 v = *(const float4*)(sr + i * 4); const unsigned ib = q * 32 + i * 4;
          a[i * 4 + 0] = __uint_as_float((__float_as_uint(v.x) & 0xFFFFFF80u) | (ib + 0)); a[i * 4 + 1] = __uint_as_float((__float_as_uint(v.y) & 0xFFFFFF80u) | (ib + 1));
          a[i * 4 + 2] = __uint_as_float((__float_as_uint(v.z) & 0xFFFFFF80u) | (ib + 2)); a[i * 4 + 3] = __uint_as_float((__float_as_uint(v.w) & 0xFFFFFF80u) | (ib + 3)); }
#pragma unroll
        for (int i = 0; i < 4; ++i) { const float4 v = *(const float4*)(sr + 16 + i * 4); const unsigned ib = q * 32 + 16 + i * 4;
          c[i * 4 + 0] = __uint_as_float((__float_as_uint(v.x) & 0xFFFFFF80u) | (ib + 0)); c[i * 4 + 1] = __uint_as_float((__float_as_uint(v.y) & 0xFFFFFF80u) | (ib + 1));
          c[i * 4 + 2] = __uint_as_float((__float_as_uint(v.z) & 0xFFFFFF80u) | (ib + 2)); c[i * 4 + 3] = __uint_as_float((__float_as_uint(v.w) & 0xFFFFFF80u) | (ib + 3)); }
        sort16_desc(a); sort16_desc(c); top16_merge(a, c);
#pragma unroll
        for (int i = 0; i < 16; ++i) c[i] = dpp_f<0xB1>(a[i]);
        top16_merge(a, c);
#pragma unroll
        for (int i = 0; i < 16; ++i) c[i] = dpp_f<0x4E>(a[i]);
        top16_merge(a, c);
        if (q == 0) { unsigned* tk = TK + ((tt * 8 + h) * 2 + sd) * 16;
#pragma unroll
          for (int i = 0; i < 4; ++i) *(uint4*)(tk + i * 4) = make_uint4(__float_as_uint(a[i * 4]), __float_as_uint(a[i * 4 + 1]), __float_as_uint(a[i * 4 + 2]), __float_as_uint(a[i * 4 + 3])); }
      }
      __syncthreads();
    }
    int* EIDX = (int*)lds; float* GATE = (float*)(lds + 32768);
    {
      const int tid = lv(tid0);
      const int tt = tid >> 3, h = tid & 7;
      const unsigned* t1 = TK + ((tt * 8 + h) * 2) * 16; const unsigned* t2 = t1 + 16;
      float v1[16], v2[16];
#pragma unroll
      for (int i = 0; i < 4; ++i) { const uint4 u = *(const uint4*)(t1 + i * 4), v = *(const uint4*)(t2 + i * 4);
        v1[i * 4] = __uint_as_float(u.x & 0xFFFFFF80u); v1[i * 4 + 1] = __uint_as_float(u.y & 0xFFFFFF80u); v1[i * 4 + 2] = __uint_as_float(u.z & 0xFFFFFF80u); v1[i * 4 + 3] = __uint_as_float(u.w & 0xFFFFFF80u);
        v2[i * 4] = __uint_as_float(v.x & 0xFFFFFF80u); v2[i * 4 + 1] = __uint_as_float(v.y & 0xFFFFFF80u); v2[i * 4 + 2] = __uint_as_float(v.z & 0xFFFFFF80u); v2[i * 4 + 3] = __uint_as_float(v.w & 0xFFFFFF80u); }
      float best[16], grp[16];
#define CAND(i, j) __uint_as_float((__float_as_uint(v1[i] + v2[j]) & 0xFFFFFF00u) | ((i) << 4) | (j))
      best[0] = CAND(0, 0); best[1] = CAND(0, 1); best[2] = CAND(0, 2); best[3] = CAND(0, 3); best[4] = CAND(0, 4); best[5] = CAND(0, 5); best[6] = CAND(0, 6); best[7] = CAND(0, 7);
      best[8] = CAND(0, 8); best[9] = CAND(0, 9); best[10] = CAND(0, 10); best[11] = CAND(0, 11); best[12] = CAND(0, 12); best[13] = CAND(0, 13); best[14] = CAND(0, 14); best[15] = CAND(0, 15);
      sort16_desc(best);
      grp[0] = CAND(1, 0); grp[1] = CAND(1, 1); grp[2] = CAND(1, 2); grp[3] = CAND(1, 3); grp[4] = CAND(1, 4); grp[5] = CAND(1, 5); grp[6] = CAND(1, 6); grp[7] = CAND(1, 7);
      grp[8] = CAND(2, 0); grp[9] = CAND(2, 1); grp[10] = CAND(2, 2); grp[11] = CAND(2, 3); grp[12] = CAND(2, 4); grp[13] = CAND(3, 0); grp[14] = CAND(3, 1); grp[15] = CAND(3, 2);
      sort16_desc(grp); top16_merge(best, grp);
      grp[0] = CAND(3, 3); grp[1] = CAND(4, 0); grp[2] = CAND(4, 1); grp[3] = CAND(4, 2); grp[4] = CAND(5, 0); grp[5] = CAND(5, 1); grp[6] = CAND(6, 0); grp[7] = CAND(6, 1);
      grp[8] = CAND(7, 0); grp[9] = CAND(7, 1); grp[10] = CAND(8, 0); grp[11] = CAND(9, 0); grp[12] = CAND(10, 0); grp[13] = CAND(11, 0); grp[14] = CAND(12, 0); grp[15] = CAND(13, 0);
      sort16_desc(grp); top16_merge(best, grp);
      { const float c14 = CAND(14, 0), c15 = CAND(15, 0);
        grp[0] = fmaxf(c14, c15); grp[1] = fminf(c14, c15);
#pragma unroll
        for (int i = 2; i < 16; ++i) grp[i] = -3.0e38f;
        top16_merge(best, grp); }
#undef CAND
      __syncthreads();
      float sv[16]; int ev[16]; float mx = -3.0e38f;
#pragma unroll
      for (int k = 0; k < 16; ++k) { const unsigned key = __float_as_uint(best[k]); const int ci = (key >> 4) & 15, cj = key & 15;
        const unsigned k1 = t1[ci], k2 = t2[cj];
        sv[k] = __uint_as_float(k1 & 0xFFFFFF80u) + __uint_as_float(k2 & 0xFFFFFF80u); ev[k] = (int)((k1 & 127u) * 128u + (k2 & 127u)); mx = fmaxf(mx, sv[k]); }
      float sum = 0.f;
#pragma unroll
      for (int k = 0; k < 16; ++k) { sv[k] = __expf(sv[k] - mx); sum += sv[k]; }
      const float inv = 1.f / sum;
#pragma unroll
      for (int k = 0; k < 16; ++k) { EIDX[tt * 128 + h * 16 + k] = ev[k]; GATE[tt * 128 + h * 16 + k] = sv[k] * inv; }
    }
    __syncthreads();
    {
      const int tid = lv(tid0), lane = tid & 63, w = tid >> 6;
      const bf16_t* EU = (const bf16_t*)(ws + WS_EU); const bf16_t* EV = (const bf16_t*)(ws + WS_EV);
      const float* gpf2 = launder(p.in[19]);
      typedef __bf16 bf2 __attribute__((ext_vector_type(2)));
#pragma unroll 1
      for (int rr = 0; rr < 8; ++rr) { const int row = w * 8 + rr; const size_t tok = tok0 + row;
        const uint4 hA = *(const uint4*)(H2 + (size_t)row * 1024 + lane * 8), hB = *(const uint4*)(H2 + (size_t)row * 1024 + 512 + lane * 8);
        float acc[16];
#pragma unroll
        for (int i = 0; i < 16; ++i) acc[i] = 0.f;
#pragma unroll 1
        for (int g = 0; g < 32; ++g) {
          const int4 e4 = *(const int4*)(EIDX + row * 128 + g * 4);
          const int e0 = __builtin_amdgcn_readfirstlane(e4.x), e1 = __builtin_amdgcn_readfirstlane(e4.y), e2 = __builtin_amdgcn_readfirstlane(e4.z), e3 = __builtin_amdgcn_readfirstlane(e4.w);
          const float gte = GATE[row * 128 + g * 4 + (lane & 3)];
          uint4 ua[4], ub[4], va[4], vb[4];
          { const uint4* r0 = (const uint4*)(EU + (size_t)e0 * 1024); const uint4* r1 = (const uint4*)(EU + (size_t)e1 * 1024);
            const uint4* r2 = (const uint4*)(EU + (size_t)e2 * 1024); const uint4* r3 = (const uint4*)(EU + (size_t)e3 * 1024);
            ua[0] = r0[lane]; ub[0] = r0[64 + lane]; ua[1] = r1[lane]; ub[1] = r1[64 + lane]; ua[2] = r2[lane]; ub[2] = r2[64 + lane]; ua[3] = r3[lane]; ub[3] = r3[64 + lane]; }
          { const uint4* r0 = (const uint4*)(EV + (size_t)e0 * 1024); const uint4* r1 = (const uint4*)(EV + (size_t)e1 * 1024);
            const uint4* r2 = (const uint4*)(EV + (size_t)e2 * 1024); const uint4* r3 = (const uint4*)(EV + (size_t)e3 * 1024);
            va[0] = r0[lane]; vb[0] = r0[64 + lane]; va[1] = r1[lane]; vb[1] = r1[64 + lane]; va[2] = r2[lane]; vb[2] = r2[64 + lane]; va[3] = r3[lane]; vb[3] = r3[64 + lane]; }
          float P4[4];
#pragma unroll
          for (int k2 = 0; k2 < 4; ++k2) {
            float d = __builtin_amdgcn_fdot2_f32_bf16(__builtin_bit_cast(bf2, ua[k2].x), __builtin_bit_cast(bf2, hA.x), 0.f, false);
            d = __builtin_amdgcn_fdot2_f32_bf16(__builtin_bit_cast(bf2, ua[k2].y), __builtin_bit_cast(bf2, hA.y), d, false);
            d = __builtin_amdgcn_fdot2_f32_bf16(__builtin_bit_cast(bf2, ua[k2].z), __builtin_bit_cast(bf2, hA.z), d, false);
            d = __builtin_amdgcn_fdot2_f32_bf16(__builtin_bit_cast(bf2, ua[k2].w), __builtin_bit_cast(bf2, hA.w), d, false);
            d = __builtin_amdgcn_fdot2_f32_bf16(__builtin_bit_cast(bf2, ub[k2].x), __builtin_bit_cast(bf2, hB.x), d, false);
            d = __builtin_amdgcn_fdot2_f32_bf16(__builtin_bit_cast(bf2, ub[k2].y), __builtin_bit_cast(bf2, hB.y), d, false);
            d = __builtin_amdgcn_fdot2_f32_bf16(__builtin_bit_cast(bf2, ub[k2].z), __builtin_bit_cast(bf2, hB.z), d, false);
            d = __builtin_amdgcn_fdot2_f32_bf16(__builtin_bit_cast(bf2, ub[k2].w), __builtin_bit_cast(bf2, hB.w), d, false);
            P4[k2] = d; }
          { const bool up2 = (lane & 2) != 0;
            const float k0 = up2 ? P4[2] : P4[0], s0 = up2 ? P4[0] : P4[2], k1 = up2 ? P4[3] : P4[1], s1 = up2 ? P4[1] : P4[3];
            const float q0 = k0 + dpp_f<0x4E>(s0), q1 = k1 + dpp_f<0x4E>(s1);
            const bool up1 = (lane & 1) != 0;
            const float kk = up1 ? q1 : q0, ss1 = up1 ? q0 : q1;
            float av = kk + dpp_f<0xB1>(ss1);
            av += __shfl_xor(av, 4); av += __shfl_xor(av, 8); av += __shfl_xor(av, 16); av += __shfl_xor(av, 32);
            const float ax = fabsf(av), t = __builtin_amdgcn_rcpf(ax * 0.2316418882f + 1.0f);
            float q = t * 0.5307027145f + (-0.7265760135f); q = q * t + 0.7107068705f; q = q * t + (-0.142248368f); q = q * t + 0.127414796f; q = q * t;
            const float ee = __builtin_amdgcn_exp2f(av * av * (-0.72134752044f));
            const float mm = av * (q * ee), gl = (av < 0.f) ? mm : (av - mm);
            P4[0] = gte * gl; }
#pragma unroll
          for (int k2 = 0; k2 < 4; ++k2) {
            const float wk = __int_as_float(__builtin_amdgcn_readlane(__float_as_int(P4[0]), k2));
            acc[0] += wk * __uint_as_float(va[k2].x << 16); acc[1] += wk * __uint_as_float(va[k2].x & 0xffff0000u); acc[2] += wk * __uint_as_float(va[k2].y << 16); acc[3] += wk * __uint_as_float(va[k2].y & 0xffff0000u);
            acc[4] += wk * __uint_as_float(va[k2].z << 16); acc[5] += wk * __uint_as_float(va[k2].z & 0xffff0000u); acc[6] += wk * __uint_as_float(va[k2].w << 16); acc[7] += wk * __uint_as_float(va[k2].w & 0xffff0000u);
            acc[8] += wk * __uint_as_float(vb[k2].x << 16); acc[9] += wk * __uint_as_float(vb[k2].x & 0xffff0000u); acc[10] += wk * __uint_as_float(vb[k2].y << 16); acc[11] += wk * __uint_as_float(vb[k2].y & 0xffff0000u);
            acc[12] += wk * __uint_as_float(vb[k2].z << 16); acc[13] += wk * __uint_as_float(vb[k2].z & 0xffff0000u); acc[14] += wk * __uint_as_float(vb[k2].w << 16); acc[15] += wk * __uint_as_float(vb[k2].w & 0xffff0000u); }
        }
        float ss = 0.f;
#pragma unroll
        for (int i = 0; i < 16; ++i) ss += acc[i] * acc[i];
        ss = wave_sum(ss); const float rs = rsqrtf(ss * (1.f / 1024.f) + EPS);
        float* orow = outp + tok * 1024;
#pragma unroll
        for (int i = 0; i < 2; ++i)
#pragma unroll
          for (int j = 0; j < 2; ++j) { const int d = 512 * i + lane * 8 + 4 * j; const int o = i * 8 + j * 4;
            float4 x1 = *(const float4*)(orow + d); const float4 g3 = *(const float4*)(gpf2 + d), g2 = *(const float4*)(modb + 5120 + d);
            x1.x += g3.x * g2.x * acc[o] * rs; x1.y += g3.y * g2.y * acc[o + 1] * rs; x1.z += g3.z * g2.z * acc[o + 2] * rs; x1.w += g3.w * g2.w * acc[o + 3] * rs;
            *(float4*)(orow + d) = x1; }
      }
    }
  }
}


DI void phase2_scan(const KP& p) {
  unsigned char* ws = p.ws;
  for (int g = blockIdx.x * NTHR + threadIdx.x; g < 131072; g += gridDim.x * NTHR) {
    const int seq = g >> 11, within = g & 2047, dv = within >> 4, dk4 = (within & 15) * 4, dir = seq & 1;
    bf16_t* base = (bf16_t*)(ws + WS_SPT) + ((size_t)seq * 32 * 128 + dv) * 64 + dk4;
    const float* dec = (const float*)(ws + WS_DEC) + (size_t)seq * 32 * 64 + dk4;
    float s0 = 0.f, s1 = 0.f, s2 = 0.f, s3 = 0.f;
#pragma unroll 1
    for (int i0 = 0; i0 < 32; i0 += 8) {
      uint2 d[8]; float4 c[8];
#pragma unroll
      for (int j = 0; j < 8; ++j) { const int n = dir ? 31 - (i0 + j) : (i0 + j); d[j] = *(const uint2*)(base + (size_t)n * 8192); c[j] = *(const float4*)(dec + n * 64); }
#pragma unroll
      for (int j = 0; j < 8; ++j) { const int n = dir ? 31 - (i0 + j) : (i0 + j);
        uint2 o; o.x = pack2(s0, s1); o.y = pack2(s2, s3); *(uint2*)(base + (size_t)n * 8192) = o;
        s0 = c[j].x * s0 + __uint_as_float(d[j].x << 16); s1 = c[j].y * s1 + __uint_as_float(d[j].x & 0xffff0000u);
        s2 = c[j].z * s2 + __uint_as_float(d[j].y << 16); s3 = c[j].w * s3 + __uint_as_float(d[j].y & 0xffff0000u); }
    }
  }
}

__global__ void __launch_bounds__(NTHR, 2) mega(KP p) {
  extern __shared__ __attribute__((aligned(16))) char lds[];
  cg::grid_group grid = cg::this_grid();
  if (p.ph_lo <= 0 && 0 < p.ph_hi) { phase0(p, lds); if (1 < p.ph_hi) grid.sync(); }
  if (p.ph_lo <= 1 && 1 < p.ph_hi) { phase1(p, lds); if (2 < p.ph_hi) grid.sync(); }
  if (p.ph_lo <= 2 && 2 < p.ph_hi) { phase2_scan(p); phase2_attn(p, lds); if (3 < p.ph_hi) grid.sync(); }
  if (p.ph_lo <= 3 && 3 < p.ph_hi) { phase3(p, lds); }
}

extern "C" void kernel_launch(void* const* d_in, const int* in_sizes, int n_in, void* d_out, int out_size, void* d_ws, size_t ws_size, hipStream_t stream) {
  float* out = (float*)d_out;
  unsigned char* ws = (unsigned char*)d_ws;
  if (ws_size < WS_END || n_in != 25) return;
  static bool attr_done = false;
  if (!attr_done) { (void)hipFuncSetAttribute((const void*)mega, hipFuncAttributeMaxDynamicSharedMemorySize, LDS_TOTAL); attr_done = true; }
  KP p{};
  for (int i = 0; i < 25; ++i) p.in[i] = (const float*)d_in[i];
  p.out = out; p.ws = ws;
  p.ph_lo = 0; p.ph_hi = 4;
  { void* args[] = {&p}; (void)hipLaunchCooperativeKernel((const void*)mega, dim3(256), dim3(NTHR), args, LDS_TOTAL, stream); }
}
```

```cpp
#include <hip/hip_runtime.h>
#include <hip/hip_cooperative_groups.h>
namespace cg = cooperative_groups;
#include <stdint.h>

typedef unsigned short bf16_t;
#define DI __device__ __forceinline__

DI float bf2f(bf16_t v) { return __uint_as_float(((unsigned)v) << 16); }
DI bf16_t f2bf(float f) { unsigned u = __float_as_uint(f); u += 0x7fffu + ((u >> 16) & 1u); return (bf16_t)(u >> 16); }

constexpr int BATCH = 8, SEQ = 2048, DM = 1024, NTOK = BATCH * SEQ;
constexpr int INW = 2272;
constexpr float EPS = 1e-6f;
constexpr int O_CQ = 0, O_CKV = 384, O_KR = 640, O_QG = 704, O_KG = 960, O_VG = 1216, O_GF = 1728, O_GB = 1744, O_R = 1760;

DI float wave_sum(float v) {
#pragma unroll
  for (int o = 1; o < 64; o <<= 1) v += __shfl_xor(v, o);
  return v;
}
DI float wave_max(float v) {
#pragma unroll
  for (int o = 1; o < 64; o <<= 1) v = fmaxf(v, __shfl_xor(v, o));
  return v;
}
DI float block_sum256(float v, float* red) {
  v = wave_sum(v);
  __syncthreads();
  if ((threadIdx.x & 63) == 0) red[threadIdx.x >> 6] = v;
  __syncthreads();
  return red[0] + red[1] + red[2] + red[3];
}
DI float block_max256(float v, float* red) {
  v = wave_max(v);
  __syncthreads();
  if ((threadIdx.x & 63) == 0) red[threadIdx.x >> 6] = v;
  __syncthreads();
  return fmaxf(fmaxf(red[0], red[1]), fmaxf(red[2], red[3]));
}
DI float silu_f(float x) { return x / (1.f + expf(-x)); }
DI float logsigmoid_f(float x) { return fminf(x, 0.f) - log1pf(expf(-fabsf(x))); }
DI float gelu_erf(float x) { return 0.5f * x * (1.f + erff(x * 0.70710678118654752f)); }

__global__ __launch_bounds__(256) void n_mod(const float* __restrict__ c, const float* __restrict__ w_ada, const float* __restrict__ b_ada, float* __restrict__ mod) {
  int idx = blockIdx.x * 256 + threadIdx.x;
  int b = idx / 6144, j = idx % 6144;
  float acc = b_ada[j];
  for (int k = 0; k < 1024; ++k) acc += silu_f(c[b * 1024 + k]) * w_ada[(size_t)k * 6144 + j];
  mod[idx] = acc;
}

__global__ __launch_bounds__(256) void n_hnorm(const float* __restrict__ x, const float* __restrict__ g, const float* __restrict__ mod, int b, int off_sh, int off_sc, float* __restrict__ h) {
  __shared__ float red[4];
  int t = blockIdx.x, tid = threadIdx.x;
  const float* xr = x + ((size_t)b * SEQ + t) * DM;
  float v[4]; float ss = 0.f;
#pragma unroll
  for (int i = 0; i < 4; ++i) { v[i] = xr[tid + 256 * i]; ss += v[i] * v[i]; }
  ss = block_sum256(ss, red);
  float rs = rsqrtf(ss * (1.f / DM) + EPS);
#pragma unroll
  for (int i = 0; i < 4; ++i) { int d = tid + 256 * i; h[(size_t)t * DM + d] = v[i] * rs * g[d] * (1.f + mod[b * 6144 + off_sc + d]) + mod[b * 6144 + off_sh + d]; }
}

template <bool BT>
__global__ __launch_bounds__(256) void n_gemm(const float* __restrict__ A, int lda, const float* __restrict__ B, int ldb, float* __restrict__ C, int ldc, int M, int N, int K) {
  __shared__ float As[16][65];
  __shared__ float Bs[16][65];
  const int tid = threadIdx.x, tx = tid & 15, ty = tid >> 4;
  const int m0 = blockIdx.y * 64, n0 = blockIdx.x * 64;
  float acc[4][4];
#pragma unroll
  for (int i = 0; i < 4; ++i)
#pragma unroll
    for (int j = 0; j < 4; ++j) acc[i][j] = 0.f;
  for (int k0 = 0; k0 < K; k0 += 16) {
#pragma unroll
    for (int i = 0; i < 4; ++i) { int e = tid + 256 * i; int m = e >> 4, k = e & 15; As[k][m] = A[(size_t)(m0 + m) * lda + k0 + k]; }
#pragma unroll
    for (int i = 0; i < 4; ++i) { int e = tid + 256 * i;
      if (!BT) { int k = e >> 6, n = e & 63; Bs[k][n] = (n0 + n < N) ? B[(size_t)(k0 + k) * ldb + n0 + n] : 0.f; }
      else     { int n = e >> 4, k = e & 15; Bs[k][n] = (n0 + n < N) ? B[(size_t)(n0 + n) * ldb + k0 + k] : 0.f; } }
    __syncthreads();
#pragma unroll
    for (int k = 0; k < 16; ++k) {
      float a[4], bb[4];
#pragma unroll
      for (int i = 0; i < 4; ++i) { a[i] = As[k][ty * 4 + i]; bb[i] = Bs[k][tx * 4 + i]; }
#pragma unroll
      for (int i = 0; i < 4; ++i)
#pragma unroll
        for (int j = 0; j < 4; ++j) acc[i][j] += a[i] * bb[j];
    }
    __syncthreads();
  }
#pragma unroll
  for (int i = 0; i < 4; ++i)
#pragma unroll
    for (int j = 0; j < 4; ++j) { int n = n0 + tx * 4 + j; if (n < N) C[(size_t)(m0 + ty * 4 + i) * ldc + n] = acc[i][j]; }
}

__global__ __launch_bounds__(256) void n_rms_slice(const float* __restrict__ in, int ldin, int off, int W, const float* __restrict__ g, float* __restrict__ out) {
  __shared__ float red[4];
  int t = blockIdx.x, tid = threadIdx.x;
  float v0 = (tid < W) ? in[(size_t)t * ldin + off + tid] : 0.f;
  float v1 = (tid + 256 < W) ? in[(size_t)t * ldin + off + tid + 256] : 0.f;
  float ss = block_sum256(v0 * v0 + v1 * v1, red);
  float rs = rsqrtf(ss / (float)W + EPS);
  if (tid < W) out[(size_t)t * W + tid] = v0 * rs * g[tid];
  if (tid + 256 < W) out[(size_t)t * W + tid + 256] = v1 * rs * g[tid + 256];
}

__global__ __launch_bounds__(256) void n_scatter(const float* __restrict__ proj, const float* __restrict__ qa, const float* __restrict__ kv, const int* __restrict__ positions, int b,
                                                 const float* __restrict__ wgf, const float* __restrict__ bgf, const float* __restrict__ wgb, const float* __restrict__ bgb,
                                                 bf16_t* __restrict__ Qm, bf16_t* __restrict__ Km, bf16_t* __restrict__ Vm, bf16_t* __restrict__ qg, bf16_t* __restrict__ kg, bf16_t* __restrict__ vg,
                                                 bf16_t* __restrict__ rg, float* __restrict__ laf, float* __restrict__ lab) {
  __shared__ float cs[32], sn[32];
  const int t = blockIdx.x, tid = threadIdx.x;
  const size_t tok = (size_t)b * SEQ + t;
  const float* pr = proj + (size_t)t * INW;
  const float* qr = qa + (size_t)t * 768;
  const float* kr = kv + (size_t)t * 1024;
  if (tid < 32) {
    float inv = powf(10000.f, -(float)tid / 32.f);
    float ang = (float)positions[tok] * inv;
    cs[tid] = cosf(ang); sn[tid] = sinf(ang);
  }
  __syncthreads();
  for (int e = tid; e < 4 * 192; e += 256) {
    int h = e / 192, d = e % 192; float v;
    if (d < 128) v = qr[h * 192 + d];
    else { int j = d - 128; const float* rp = qr + h * 192 + 128;
      if (j < 32) v = rp[j] * cs[j] - rp[j + 32] * sn[j]; else v = rp[j] * cs[j - 32] + rp[j - 32] * sn[j - 32]; }
    Qm[(((size_t)b * 4 + h) * SEQ + t) * 192 + d] = f2bf(v);
  }
  for (int e = tid; e < 4 * 192; e += 256) {
    int h = e / 192, d = e % 192; float v;
    if (d < 128) v = kr[h * 256 + d];
    else { int j = d - 128; const float* rp = pr + O_KR;
      if (j < 32) v = rp[j] * cs[j] - rp[j + 32] * sn[j]; else v = rp[j] * cs[j - 32] + rp[j - 32] * sn[j - 32]; }
    Km[(((size_t)b * 4 + h) * SEQ + t) * 192 + d] = f2bf(v);
  }
  for (int e = tid; e < 512; e += 256) { int h = e >> 7, d = e & 127; Vm[(((size_t)b * 4 + h) * SEQ + t) * 128 + d] = f2bf(kr[h * 256 + 128 + d]); }
  { int e = tid; qg[tok * 256 + e] = f2bf(pr[O_QG + e] * 0.125f); kg[tok * 256 + e] = f2bf(pr[O_KG + e]); }
  for (int e = tid; e < 512; e += 256) { vg[tok * 512 + e] = f2bf(pr[O_VG + e]); rg[tok * 512 + e] = f2bf(pr[O_R + e]); }
  { int cidx = tid; float af = bgf[cidx], ab = bgb[cidx];
#pragma unroll
    for (int r = 0; r < 16; ++r) { af += pr[O_GF + r] * wgf[r * 256 + cidx]; ab += pr[O_GB + r] * wgb[r * 256 + cidx]; }
    laf[tok * 256 + cidx] = logsigmoid_f(af) * (1.f / 16.f); lab[tok * 256 + cidx] = logsigmoid_f(ab) * (1.f / 16.f); }
}

__global__ __launch_bounds__(256) void n_attn(const bf16_t* __restrict__ Qm, const bf16_t* __restrict__ Km, const bf16_t* __restrict__ Vm, bf16_t* __restrict__ omla) {
  __shared__ float qs[192]; __shared__ float sc[2048]; __shared__ float red[4];
  const int i = blockIdx.x, h = blockIdx.y, b = blockIdx.z, tid = threadIdx.x;
  const size_t bh = (size_t)b * 4 + h;
  if (tid < 192) qs[tid] = bf2f(Qm[(bh * SEQ + i) * 192 + tid]);
  __syncthreads();
  float mx = -1e30f;
  for (int kk = 0; kk < 8; ++kk) {
    int key = tid + 256 * kk; const uint4* kr = (const uint4*)(Km + (bh * SEQ + key) * 192);
    float s = 0.f;
    for (int c = 0; c < 24; ++c) { uint4 w = kr[c]; const float* q = qs + c * 8;
      s += q[0] * __uint_as_float(w.x << 16) + q[1] * __uint_as_float(w.x & 0xffff0000u) + q[2] * __uint_as_float(w.y << 16) + q[3] * __uint_as_float(w.y & 0xffff0000u)
         + q[4] * __uint_as_float(w.z << 16) + q[5] * __uint_as_float(w.z & 0xffff0000u) + q[6] * __uint_as_float(w.w << 16) + q[7] * __uint_as_float(w.w & 0xffff0000u); }
    s *= 0.07216878364870322f; sc[key] = s; mx = fmaxf(mx, s);
  }
  mx = block_max256(mx, red);
  float sum = 0.f;
  for (int kk = 0; kk < 8; ++kk) { int key = tid + 256 * kk; float p = expf(sc[key] - mx); sc[key] = p; sum += p; }
  sum = block_sum256(sum, red);
  __syncthreads();
  if (tid < 128) { float o = 0.f; const bf16_t* vp = Vm + bh * SEQ * 128 + tid;
    for (int key = 0; key < SEQ; ++key) o += sc[key] * bf2f(vp[(size_t)key * 128]);
    omla[((size_t)b * SEQ + i) * 512 + h * 128 + tid] = f2bf(o / sum); }
}

__global__ __launch_bounds__(128) void n_gla(const bf16_t* __restrict__ qg, const bf16_t* __restrict__ kg, const bf16_t* __restrict__ vg, const bf16_t* __restrict__ laf, const bf16_t* __restrict__ lab, float* __restrict__ og) {
  __shared__ float qs[64], ks[64], as[64];
  const int bh = blockIdx.x, b = bh >> 2, h = bh & 3, dv = threadIdx.x;
  for (int dir = 0; dir < 2; ++dir) {
    float S[64];
#pragma unroll
    for (int d = 0; d < 64; ++d) S[d] = 0.f;
    const bf16_t* la = dir ? lab : laf;
    for (int s = 0; s < SEQ; ++s) {
      const int t = dir ? (SEQ - 1 - s) : s; const size_t tok = (size_t)b * SEQ + t;
      __syncthreads();
      if (dv < 64) { qs[dv] = bf2f(qg[tok * 256 + h * 64 + dv]); ks[dv] = bf2f(kg[tok * 256 + h * 64 + dv]); as[dv] = expf(bf2f(la[tok * 256 + h * 64 + dv])); }
      __syncthreads();
      const float v = bf2f(vg[tok * 512 + h * 128 + dv]); float o = 0.f;
#pragma unroll
      for (int d = 0; d < 64; ++d) { S[d] = as[d] * S[d] + ks[d] * v; o += qs[d] * S[d]; }
      if (dir == 0) og[tok * 512 + h * 128 + dv] = o; else og[tok * 512 + h * 128 + dv] += o;
    }
  }
}

__global__ __launch_bounds__(256) void n_mix(const bf16_t* __restrict__ omla, const float* __restrict__ og, const bf16_t* __restrict__ rg, const float* __restrict__ g_gla, int b, float* __restrict__ mix) {
  __shared__ float ssum[4];
  const int t = blockIdx.x, tid = threadIdx.x; const size_t tok = (size_t)b * SEQ + t;
  if (tid < 4) ssum[tid] = 0.f;
  __syncthreads();
  float v[2];
#pragma unroll
  for (int i = 0; i < 2; ++i) { int e = tid + 256 * i; v[i] = og[tok * 512 + e]; atomicAdd(&ssum[e >> 7], v[i] * v[i]); mix[(size_t)t * DM + e] = bf2f(omla[tok * 512 + e]); }
  __syncthreads();
#pragma unroll
  for (int i = 0; i < 2; ++i) { int e = tid + 256 * i; float rs = rsqrtf(ssum[e >> 7] * (1.f / 128.f) + EPS);
    mix[(size_t)t * DM + 512 + e] = v[i] * rs * g_gla[e & 127] * silu_f(bf2f(rg[tok * 512 + e])); }
}

__global__ __launch_bounds__(256) void n_post1(const float* __restrict__ x, const float* __restrict__ y, const float* __restrict__ g_post, const float* __restrict__ g_pre2, const float* __restrict__ mod, int b,
                                               float* __restrict__ out, float* __restrict__ h2) {
  __shared__ float red[4];
  const int t = blockIdx.x, tid = threadIdx.x; const size_t tok = (size_t)b * SEQ + t;
  float yv[4], xv[4]; float ss = 0.f;
#pragma unroll
  for (int i = 0; i < 4; ++i) { yv[i] = y[(size_t)t * DM + tid + 256 * i]; ss += yv[i] * yv[i]; }
  ss = block_sum256(ss, red);
  float rs = rsqrtf(ss * (1.f / DM) + EPS); float s2 = 0.f;
#pragma unroll
  for (int i = 0; i < 4; ++i) { int d = tid + 256 * i; xv[i] = x[tok * DM + d] + mod[b * 6144 + 2048 + d] * (yv[i] * rs * g_post[d]); out[tok * DM + d] = xv[i]; s2 += xv[i] * xv[i]; }
  s2 = block_sum256(s2, red);
  float r2 = rsqrtf(s2 * (1.f / DM) + EPS);
#pragma unroll
  for (int i = 0; i < 4; ++i) { int d = tid + 256 * i; h2[(size_t)t * DM + d] = xv[i] * r2 * g_pre2[d] * (1.f + mod[b * 6144 + 4096 + d]) + mod[b * 6144 + 3072 + d]; }
}

DI void wave_argmax(float& v, int& i) {
#pragma unroll
  for (int o = 1; o < 64; o <<= 1) { float ov = __shfl_xor(v, o); int oi = __shfl_xor(i, o); if (ov > v || (ov == v && oi < i)) { v = ov; i = oi; } }
}
__global__ __launch_bounds__(256) void n_peer_select(const float* __restrict__ qry, const float* __restrict__ sk1, const float* __restrict__ sk2, int* __restrict__ eidx, float* __restrict__ gate) {
  __shared__ float v1s[4][16], v2s[4][16]; __shared__ int i1s[4][16], i2s[4][16];
  const int w = threadIdx.x >> 6, lane = threadIdx.x & 63;
  const int pair = blockIdx.x * 4 + w;
  const int t = pair >> 3, h = pair & 7;
  const float* q1 = qry + (size_t)t * 2048 + h * 256; const float* q2 = q1 + 128;
  float s1a = 0.f, s1b = 0.f, s2a = 0.f, s2b = 0.f;
  for (int d = 0; d < 128; ++d) { float a = q1[d], bq = q2[d];
    s1a += a * sk1[lane * 128 + d]; s1b += a * sk1[(lane + 64) * 128 + d]; s2a += bq * sk2[lane * 128 + d]; s2b += bq * sk2[(lane + 64) * 128 + d]; }
  for (int side = 0; side < 2; ++side) {
    float va = side ? s2a : s1a, vb = side ? s2b : s1b; bool ta = false, tb = false;
    for (int k = 0; k < 16; ++k) {
      float bv; int bi;
      if (!ta && (tb || va >= vb)) { bv = va; bi = lane; } else if (!tb) { bv = vb; bi = lane + 64; } else { bv = -3e38f; bi = 1 << 20; }
      wave_argmax(bv, bi);
      if (bi == lane) ta = true; if (bi == lane + 64) tb = true;
      if (lane == 0) { if (side) { v2s[w][k] = bv; i2s[w][k] = bi; } else { v1s[w][k] = bv; i1s[w][k] = bi; } }
    }
  }
  __syncthreads();
  float cv[4]; bool tk[4];
#pragma unroll
  for (int j = 0; j < 4; ++j) { int c = lane + 64 * j; cv[j] = v1s[w][c >> 4] + v2s[w][c & 15]; tk[j] = false; }
  float topv = 0.f; int topc = 0; float mx = 0.f;
  for (int k = 0; k < 16; ++k) {
    float bv = -3e38f; int bi = 1 << 20;
#pragma unroll
    for (int j = 0; j < 4; ++j) { if (!tk[j] && cv[j] > bv) { bv = cv[j]; bi = lane + 64 * j; } }
    wave_argmax(bv, bi);
#pragma unroll
    for (int j = 0; j < 4; ++j) if (bi == lane + 64 * j) tk[j] = true;
    if (k == 0) mx = bv;
    if (lane == k) { topv = bv; topc = bi; }
  }
  float e = (lane < 16) ? expf(topv - mx) : 0.f;
  float sum = wave_sum(e);
  if (lane < 16) { eidx[(size_t)pair * 16 + lane] = i1s[w][topc >> 4] * 128 + i2s[w][topc & 15]; gate[(size_t)pair * 16 + lane] = e / sum; }
}

__global__ __launch_bounds__(256) void n_peer_apply(const float* __restrict__ h2, const int* __restrict__ eidx, const float* __restrict__ gate, const float* __restrict__ eu, const float* __restrict__ ev,
                                                    const float* __restrict__ g_post, const float* __restrict__ mod, int b, float* __restrict__ out) {
  __shared__ float ys[4][1024]; __shared__ float red[4];
  const int t = blockIdx.x, tid = threadIdx.x, w = tid >> 6, lane = tid & 63; const size_t tok = (size_t)b * SEQ + t;
  float4 hx[4];
#pragma unroll
  for (int i = 0; i < 4; ++i) hx[i] = *(const float4*)(h2 + (size_t)t * DM + (lane + 64 * i) * 4);
  float4 acc[4];
#pragma unroll
  for (int i = 0; i < 4; ++i) acc[i] = make_float4(0.f, 0.f, 0.f, 0.f);
  for (int k = w; k < 128; k += 4) {
    const int e = eidx[(size_t)t * 128 + k]; const float gt = gate[(size_t)t * 128 + k];
    const float4* ur = (const float4*)(eu + (size_t)e * DM); const float4* vr = (const float4*)(ev + (size_t)e * DM);
    float d = 0.f;
#pragma unroll
    for (int i = 0; i < 4; ++i) { float4 u = ur[lane + 64 * i]; d += u.x * hx[i].x + u.y * hx[i].y + u.z * hx[i].z + u.w * hx[i].w; }
    d = wave_sum(d);
    const float wgt = gt * gelu_erf(d);
#pragma unroll
    for (int i = 0; i < 4; ++i) { float4 v = vr[lane + 64 * i]; acc[i].x += wgt * v.x; acc[i].y += wgt * v.y; acc[i].z += wgt * v.z; acc[i].w += wgt * v.w; }
  }
#pragma unroll
  for (int i = 0; i < 4; ++i) *(float4*)(&ys[w][(lane + 64 * i) * 4]) = acc[i];
  __syncthreads();
  float yv[4]; float ss = 0.f;
#pragma unroll
  for (int i = 0; i < 4; ++i) { int d = tid + 256 * i; yv[i] = ys[0][d] + ys[1][d] + ys[2][d] + ys[3][d]; ss += yv[i] * yv[i]; }
  ss = block_sum256(ss, red);
  const float rs = rsqrtf(ss * (1.f / DM) + EPS);
#pragma unroll
  for (int i = 0; i < 4; ++i) { int d = tid + 256 * i; out[tok * DM + d] = out[tok * DM + d] + mod[b * 6144 + 5120 + d] * (yv[i] * rs * g_post[d]); }
}

typedef short bf16x8 __attribute__((ext_vector_type(8)));
typedef float f32x16 __attribute__((ext_vector_type(16)));
#define MFMA32(a, b, c) __builtin_amdgcn_mfma_f32_32x32x16_bf16((a), (b), (c), 0, 0, 0)

constexpr int NTHR = 512;
constexpr size_t MiB = 1024 * 1024;
constexpr size_t WS_MOD   = 0;
constexpr size_t WS_WTIN  = 256 * 1024;
constexpr size_t WS_WTQUP = WS_WTIN + (size_t)2304 * 1024 * 2;
constexpr size_t WS_WTKVUP = WS_WTQUP + (size_t)768 * 384 * 2;
constexpr size_t WS_WTOUT = WS_WTKVUP + (size_t)1024 * 256 * 2;
constexpr size_t WS_WTPQ  = WS_WTOUT + (size_t)1024 * 1024 * 2;
constexpr size_t WS_KD    = WS_WTPQ + (size_t)2048 * 1024 * 2;
constexpr size_t WS_DEC   = WS_KD + (size_t)256 * 256 * 2;
constexpr size_t WS_ESC   = WS_DEC + (size_t)2048 * 64 * 4;
constexpr size_t WS_R0END = WS_ESC + (size_t)2 * 16384 * 4;
static_assert(WS_R0END <= 13 * MiB, "R0");
constexpr size_t WS_QM   = 13 * MiB;
constexpr size_t WS_KM   = WS_QM + 24 * MiB;
constexpr size_t WS_VM   = WS_KM + 24 * MiB;
constexpr size_t WS_P1S  = WS_VM + 16 * MiB;
constexpr size_t WS_RG   = WS_P1S + 32 * MiB;
constexpr size_t WS_OINTRA = WS_RG + 16 * MiB;
constexpr size_t WS_QDEC = WS_OINTRA + 16 * MiB;
constexpr size_t WS_SPT  = WS_QDEC + 16 * MiB;
constexpr size_t WS_EU   = WS_SPT + 32 * MiB;
constexpr size_t WS_EV   = WS_EU + 16 * MiB;
constexpr size_t WS_END  = WS_EV + 16 * MiB;
static_assert(WS_P1S == WS_QM + 64 * MiB, "P3 QRY scratch aliases QM..VM");
constexpr size_t OUT_HS  = 0;
constexpr size_t OUT_CQ  = 32 * MiB;
constexpr size_t OUT_GR  = 52 * MiB;

struct KP { const float* in[25]; float* out; unsigned char* ws; int ph_lo, ph_hi; };

constexpr int G_STRIDE = 144;
constexpr int G_ABYTES = 64 * G_STRIDE;
constexpr int G_BBYTES = 256 * G_STRIDE;
constexpr int G_STAGE = G_ABYTES + G_BBYTES;
constexpr int LDS_GEMM = 2 * G_STAGE;
constexpr int LDS_TAB = LDS_GEMM;
constexpr int LDS_TOTAL = 157696;

DI unsigned pack2(float lo, float hi) { return (unsigned)f2bf(lo) | ((unsigned)f2bf(hi) << 16); }
DI int crow(int reg, int hh) { return (reg & 3) + 8 * (reg >> 2) + 4 * hh; }

template <class Epi>
DI void block_gemm(char* lds, const bf16_t* A, int lda, const bf16_t* Bt, int ldb, int nchunks, int K, Epi&& epi) {
  const int tid = threadIdx.x, lane = tid & 63, w = tid >> 6, wm = w >> 2, wn = w & 3, r = lane & 31, hh = lane >> 5;
  const int nk = K >> 6;
  const int srow = tid >> 3, skc = tid & 7;
  const int st_off = srow * G_STRIDE + skc * 16;
  const int a_rd = (wm * 32 + r) * G_STRIDE + hh * 16;
  const int b_rd = G_ABYTES + (wn * 64 + r) * G_STRIDE + hh * 16;
  for (int ch = 0; ch < nchunks; ++ch) {
    const bf16_t* Ab = A + (size_t)srow * lda + skc * 8;
    const bf16_t* Bb = Bt + (size_t)(ch * 256 + srow) * ldb + skc * 8;
    f32x16 acc0, acc1;
#pragma unroll
    for (int i = 0; i < 16; ++i) { acc0[i] = 0.f; acc1[i] = 0.f; }
    uint4 ra, rb0, rb1, rb2, rb3;
    ra = *(const uint4*)Ab; rb0 = *(const uint4*)Bb; rb1 = *(const uint4*)(Bb + (size_t)64 * ldb); rb2 = *(const uint4*)(Bb + (size_t)128 * ldb); rb3 = *(const uint4*)(Bb + (size_t)192 * ldb);
    {
      char* nb = lds;
      *(uint4*)(nb + st_off) = ra;
      *(uint4*)(nb + G_ABYTES + st_off) = rb0; *(uint4*)(nb + G_ABYTES + 64 * G_STRIDE + st_off) = rb1;
      *(uint4*)(nb + G_ABYTES + 128 * G_STRIDE + st_off) = rb2; *(uint4*)(nb + G_ABYTES + 192 * G_STRIDE + st_off) = rb3;
    }
    __syncthreads();
    for (int t = 0; t < nk; ++t) {
      const char* cur = lds + (t & 1) * G_STAGE; char* nb = lds + ((t + 1) & 1) * G_STAGE;
      const bool more = (t + 1 < nk);
      if (more) { const int ko = (t + 1) * 64;
        ra = *(const uint4*)(Ab + ko); rb0 = *(const uint4*)(Bb + ko); rb1 = *(const uint4*)(Bb + (size_t)64 * ldb + ko);
        rb2 = *(const uint4*)(Bb + (size_t)128 * ldb + ko); rb3 = *(const uint4*)(Bb + (size_t)192 * ldb + ko); }
#pragma unroll
      for (int s = 0; s < 4; ++s) {
        const bf16x8 a = *(const bf16x8*)(cur + a_rd + s * 32);
        const bf16x8 b0 = *(const bf16x8*)(cur + b_rd + s * 32);
        const bf16x8 b1 = *(const bf16x8*)(cur + b_rd + 32 * G_STRIDE + s * 32);
        acc0 = MFMA32(a, b0, acc0); acc1 = MFMA32(a, b1, acc1);
      }
      if (more) {
        *(uint4*)(nb + st_off) = ra;
        *(uint4*)(nb + G_ABYTES + st_off) = rb0; *(uint4*)(nb + G_ABYTES + 64 * G_STRIDE + st_off) = rb1;
        *(uint4*)(nb + G_ABYTES + 128 * G_STRIDE + st_off) = rb2; *(uint4*)(nb + G_ABYTES + 192 * G_STRIDE + st_off) = rb3;
      }
      __syncthreads();
    }
    epi(wm * 32, ch * 256 + wn * 64, acc0, acc1);
    __syncthreads();
  }
}

DI void p0_transpose(char* lds, const float* __restrict__ W, int K, int N, bf16_t* __restrict__ Wt, int item) {
  float* s = (float*)lds;
  const int tid = threadIdx.x;
  const int ntn = (N + 63) >> 6, kt = item / ntn, nt = item % ntn, k0 = kt * 64, n0 = nt * 64;
  __syncthreads();
#pragma unroll
  for (int i = 0; i < 8; ++i) { int e = tid + 512 * i; int kk = e >> 6, nn = e & 63; s[kk * 65 + nn] = (n0 + nn < N) ? W[(size_t)(k0 + kk) * N + n0 + nn] : 0.f; }
  __syncthreads();
  const int nn = tid >> 3, part = tid & 7;
  const float* sp = s + (part * 8) * 65 + nn;
  uint4 o; o.x = pack2(sp[0], sp[65]); o.y = pack2(sp[2 * 65], sp[3 * 65]); o.z = pack2(sp[4 * 65], sp[5 * 65]); o.w = pack2(sp[6 * 65], sp[7 * 65]);
  *(uint4*)(Wt + (size_t)(n0 + nn) * K + k0 + part * 8) = o;
}

DI void phase0(const KP& p, char* lds) {
  const int tid = threadIdx.x, bid = blockIdx.x, nb = gridDim.x;
  unsigned char* ws = p.ws;
  constexpr int I_IN = 16 * 36, I_QUP = 6 * 12, I_KVUP = 4 * 16, I_OUT = 16 * 16, I_PQ = 16 * 32;
  constexpr int I_ALL = I_IN + I_QUP + I_KVUP + I_OUT + I_PQ;
  for (int it = bid; it < I_ALL; it += nb) {
    int q = it;
    if (q < I_IN) { p0_transpose(lds, p.in[7], 1024, 2272, (bf16_t*)(ws + WS_WTIN), q); continue; } q -= I_IN;
    if (q < I_QUP) { p0_transpose(lds, p.in[9], 384, 768, (bf16_t*)(ws + WS_WTQUP), q); continue; } q -= I_QUP;
    if (q < I_KVUP) { p0_transpose(lds, p.in[11], 256, 1024, (bf16_t*)(ws + WS_WTKVUP), q); continue; } q -= I_KVUP;
    if (q < I_OUT) { p0_transpose(lds, p.in[17], 1024, 1024, (bf16_t*)(ws + WS_WTOUT), q); continue; } q -= I_OUT;
    p0_transpose(lds, p.in[20], 1024, 2048, (bf16_t*)(ws + WS_WTPQ), q);
  }
  { bf16_t* kd = (bf16_t*)(ws + WS_KD);
    for (int e = bid * NTHR + tid; e < 65536; e += nb * NTHR) { int n = e >> 8, k = e & 255; float v = 0.f;
      if (n < 128 && k < 128) v = p.in[21][n * 128 + k]; else if (n >= 128 && k >= 128) v = p.in[22][(n - 128) * 128 + (k - 128)];
      kd[e] = f2bf(v); } }
  { const int lane = tid & 63; float* scl = (float*)(ws + WS_ESC);
    for (int row = bid * 8 + (tid >> 6); row < 32768; row += nb * 8) { const int t = row >> 14, e = row & 16383;
      const float* src = p.in[23 + t] + (size_t)e * 1024 + lane * 16;
      float4 x[4]; float am = 0.f;
#pragma unroll
      for (int i = 0; i < 4; ++i) { x[i] = *(const float4*)(src + 4 * i); am = fmaxf(am, fmaxf(fmaxf(fabsf(x[i].x), fabsf(x[i].y)), fmaxf(fabsf(x[i].z), fabsf(x[i].w)))); }
      am = wave_max(am);
      float sc = 1.f, isc = 1.f;
      if (am > 0.f) { int ex; (void)frexpf(448.f / am, &ex); sc = ldexpf(1.f, ex - 1); isc = ldexpf(1.f, 1 - ex); }
      unsigned wv[4];
#pragma unroll
      for (int i = 0; i < 4; ++i) { int q = __builtin_amdgcn_cvt_pk_fp8_f32(x[i].x * sc, x[i].y * sc, 0, false); q = __builtin_amdgcn_cvt_pk_fp8_f32(x[i].z * sc, x[i].w * sc, q, true); wv[i] = (unsigned)q; }
      *(uint4*)(ws + (t ? WS_EV : WS_EU) + (size_t)e * 1024 + lane * 16) = make_uint4(wv[0], wv[1], wv[2], wv[3]);
      if (lane == 0) scl[t * 16384 + e] = isc; } }
  for (int jb = bid; jb < 96; jb += nb) {
    __syncthreads();
    float* cact = (float*)lds;
    float* red = (float*)(lds + 32768);
    for (int e = tid; e < 8192; e += NTHR) cact[e] = silu_f(p.in[1][e]);
    __syncthreads();
    const int jj = tid & 63, ks = tid >> 6, j0 = jb * 64;
    float acc[8];
#pragma unroll
    for (int b = 0; b < 8; ++b) acc[b] = 0.f;
    const float* wp = p.in[3] + (size_t)(ks * 128) * 6144 + j0 + jj;
    for (int k = 0; k < 128; ++k) { const float wv = wp[(size_t)k * 6144];
#pragma unroll
      for (int b = 0; b < 8; ++b) acc[b] += cact[b * 1024 + ks * 128 + k] * wv; }
#pragma unroll
    for (int b = 0; b < 8; ++b) red[(ks * 64 + jj) * 8 + b] = acc[b];
    __syncthreads();
    { const int b = tid >> 6; float sacc = p.in[4][j0 + jj];
#pragma unroll
      for (int k2 = 0; k2 < 8; ++k2) sacc += red[(k2 * 64 + jj) * 8 + b];
      ((float*)(ws + WS_MOD))[b * 6144 + j0 + jj] = sacc; }
  }
}

constexpr int WT_STRIDE = 144, WT_BYTES = 32 * WT_STRIDE;
DI void wt_write(char* wl, const f32x16& a0, const f32x16& a1, int r, int hh, float scale) {
  char* bp = wl + (4 * hh) * WT_STRIDE + r * 2;
#pragma unroll
  for (int reg = 0; reg < 16; ++reg) { const int ro = ((reg & 3) + 8 * (reg >> 2)) * WT_STRIDE;
    *(bf16_t*)(bp + ro) = f2bf(a0[reg] * scale); *(bf16_t*)(bp + ro + 64) = f2bf(a1[reg] * scale); }
}
DI void wt_write_rope(char* wl, const f32x16& a0, const f32x16& a1, int r, int hh, const float* cs, const float* sn, int m0) {
  char* bp = wl + (4 * hh) * WT_STRIDE + r * 2;
#pragma unroll
  for (int reg = 0; reg < 16; ++reg) { const int rw = (reg & 3) + 8 * (reg >> 2); const int row = m0 + rw + 4 * hh;
    const float c = cs[row * 32 + r], s = sn[row * 32 + r];
    *(bf16_t*)(bp + rw * WT_STRIDE) = f2bf(a0[reg] * c - a1[reg] * s); *(bf16_t*)(bp + rw * WT_STRIDE + 64) = f2bf(a1[reg] * c + a0[reg] * s); }
}
DI void wt_store(const char* wl, int lane, bf16_t* dA, int sA, bf16_t* dB, int sB) {
  const int piece = lane & 7, rsub = lane >> 3;
  bf16_t* d = (piece < 4) ? dA : dB; const int st = (piece < 4) ? sA : sB;
  if (d) {
#pragma unroll
    for (int i = 0; i < 4; ++i) { const int row = i * 8 + rsub; const uint4 v = *(const uint4*)(wl + row * WT_STRIDE + piece * 16);
      *(uint4*)(d + (size_t)row * st + (piece & 3) * 8) = v; }
  }
}
#define LDS_FENCE() asm volatile("s_waitcnt lgkmcnt(0)" ::: "memory")
DI int lv(int x) { asm volatile("" : "+v"(x)); return x; }
template <class T> DI T* launder(T* q) { size_t z = 0; asm volatile("" : "+s"(z)); return (T*)((char*)q + z); }

constexpr int GL_GR = 0, GL_VT = 8192, GL_QD = 26624, GL_KI = 45056, GL_KIT = 63488, GL_ATT = 81920, GL_TOT = 91136, GL_DEC = 93184, GL_LA = 93696  ;
DI void gla_chunk_local(const KP& p, char* lds, unsigned char* ws, int tile, const bf16_t* qg, const bf16_t* kg, const bf16_t* vg, const bf16_t* GR) {
  const int tid = lv(threadIdx.x), lane = tid & 63, w = tid >> 6, r = lane & 31, hh = lane >> 5;
  const int b = tile >> 5, n = tile & 31, tok0 = tile * 64;
  float* GRL = (float*)(lds + GL_GR); float* TOT = (float*)(lds + GL_TOT); float* DECL = (float*)(lds + GL_DEC);
  __syncthreads();
#pragma unroll
  for (int i = 0; i < 4; ++i) GRL[tid + 512 * i] = bf2f(GR[tid + 512 * i]);
#pragma unroll 1
  for (int h = 0; h < 4; ++h) {
    __syncthreads();
#pragma unroll
    for (int i = 0; i < 2; ++i) { const int c = tid + 512 * i, t = c >> 4, d8 = (c & 15) * 8;
      const uint4 v = *(const uint4*)(vg + (size_t)t * 512 + h * 128 + d8);
      bf16_t* vt = (bf16_t*)(lds + GL_VT) + d8 * 72 + t;
      vt[0] = (bf16_t)(v.x & 0xffffu); vt[72] = (bf16_t)(v.x >> 16); vt[144] = (bf16_t)(v.y & 0xffffu); vt[216] = (bf16_t)(v.y >> 16);
      vt[288] = (bf16_t)(v.z & 0xffffu); vt[360] = (bf16_t)(v.z >> 16); vt[432] = (bf16_t)(v.w & 0xffffu); vt[504] = (bf16_t)(v.w >> 16); }
    const int dir = tid >> 8, qt = (tid >> 6) & 3, dk = tid & 63, col = h * 64 + dk;
    float* LAL = (float*)(lds + GL_LA) + tid;
    {
      const float* wg = launder(dir ? p.in[14] : p.in[12]); const float* bg = launder(dir ? p.in[15] : p.in[13]);
      float wr[16];
#pragma unroll
      for (int q = 0; q < 16; ++q) wr[q] = wg[q * 256 + col];
      const float bias = bg[col];
      float run = 0.f;
#pragma unroll 2
      for (int ii = 0; ii < 16; ++ii) { const int i = dir ? 15 - ii : ii;
        const float* gp = GRL + (qt * 16 + i) * 32 + dir * 16; float x = bias;
#pragma unroll
        for (int q = 0; q < 16; ++q) x += gp[q] * wr[q];
        run += logsigmoid_f(x) * (1.f / 16.f); LAL[i * 512] = run; }
      TOT[(dir * 64 + dk) * 4 + qt] = run;
    }
    __syncthreads();
    {
      const float4 tq = *(const float4*)(TOT + (dir * 64 + dk) * 4);
      const float total = (tq.x + tq.y) + (tq.z + tq.w);
      float off;
      if (dir == 0) off = (qt > 0 ? tq.x : 0.f) + (qt > 1 ? tq.y : 0.f) + (qt > 2 ? tq.z : 0.f);
      else          off = (qt < 1 ? tq.y : 0.f) + (qt < 2 ? tq.z : 0.f) + (qt < 3 ? tq.w : 0.f);
      if (qt == 0) { const float dc = expf(total); DECL[dir * 64 + dk] = dc; ((float*)(ws + WS_DEC))[((size_t)((b * 4 + h) * 2 + dir) * 32 + n) * 64 + dk] = dc; }
      bf16_t* QD = (bf16_t*)(lds + GL_QD + dir * 9216) + (qt * 16) * 72 + dk; bf16_t* KI = (bf16_t*)(lds + GL_KI + dir * 9216) + (qt * 16) * 72 + dk;
      bf16_t* KIT = (bf16_t*)(lds + GL_KIT + dir * 9216) + dk * 72 + qt * 16;
      bf16_t* qdg = (bf16_t*)(ws + WS_QDEC) + (size_t)((tile * 4 + h) * 2 + dir) * 4096 + (qt * 16) * 64 + dk;
      const bf16_t* qgp = qg + (size_t)(qt * 16) * 256 + col; const bf16_t* kgp = kg + (size_t)(qt * 16) * 256 + col;
#pragma unroll 2
      for (int i = 0; i < 16; ++i) { const float bb = off + LAL[i * 512];
        const float qv = bf2f(qgp[i * 256]), kv = bf2f(kgp[i * 256]);
        const bf16_t qd = f2bf(qv * expf(bb)), ki = f2bf(kv * expf(-bb));
        QD[i * 72] = qd; KI[i * 72] = ki; qdg[i * 64] = qd; KIT[i] = ki; }
    }
    __syncthreads();
    if (w < 4) { const int mi = w >> 1, ni = w & 1;
      f32x16 asum;
#pragma unroll
      for (int i = 0; i < 16; ++i) asum[i] = 0.f;
#pragma unroll
      for (int d = 0; d < 2; ++d) { f32x16 acc;
#pragma unroll
        for (int i = 0; i < 16; ++i) acc[i] = 0.f;
#pragma unroll
        for (int s = 0; s < 4; ++s) { const bf16x8 a = *(const bf16x8*)(lds + GL_QD + d * 9216 + (mi * 32 + r) * 144 + s * 32 + hh * 16);
          const bf16x8 bb = *(const bf16x8*)(lds + GL_KI + d * 9216 + (ni * 32 + r) * 144 + s * 32 + hh * 16); acc = MFMA32(a, bb, acc); }
#pragma unroll
        for (int reg = 0; reg < 16; ++reg) { const int ti = mi * 32 + crow(reg, hh), tj = ni * 32 + r; const bool keep = d ? (tj >= ti) : (tj <= ti); asum[reg] += keep ? acc[reg] : 0.f; } }
      bf16_t* at = (bf16_t*)(lds + GL_ATT) + (mi * 32 + 4 * hh) * 72 + ni * 32 + r;
#pragma unroll
      for (int reg = 0; reg < 16; ++reg) at[((reg & 3) + 8 * (reg >> 2)) * 72] = f2bf(asum[reg]);
    }
    __syncthreads();
    { const int mi = w >> 2, ni = w & 3; f32x16 acc;
#pragma unroll
      for (int i = 0; i < 16; ++i) acc[i] = 0.f;
#pragma unroll
      for (int s = 0; s < 4; ++s) { const bf16x8 a = *(const bf16x8*)(lds + GL_ATT + (mi * 32 + r) * 144 + s * 32 + hh * 16);
        const bf16x8 bb = *(const bf16x8*)(lds + GL_VT + (ni * 32 + r) * 144 + s * 32 + hh * 16); acc = MFMA32(a, bb, acc); }
      bf16_t* oi = (bf16_t*)(ws + WS_OINTRA) + (size_t)(tok0 + mi * 32 + 4 * hh) * 512 + h * 128 + ni * 32 + r;
#pragma unroll
      for (int reg = 0; reg < 16; ++reg) oi[(size_t)((reg & 3) + 8 * (reg >> 2)) * 512] = f2bf(acc[reg]); }
    { const int dvb = w >> 1, dkb = w & 1;
#pragma unroll
      for (int d = 0; d < 2; ++d) { f32x16 acc;
#pragma unroll
        for (int i = 0; i < 16; ++i) acc[i] = 0.f;
#pragma unroll
        for (int s = 0; s < 4; ++s) { const bf16x8 a = *(const bf16x8*)(lds + GL_VT + (dvb * 32 + r) * 144 + s * 32 + hh * 16);
          const bf16x8 bb = *(const bf16x8*)(lds + GL_KIT + d * 9216 + (dkb * 32 + r) * 144 + s * 32 + hh * 16); acc = MFMA32(a, bb, acc); }
        const float sc = DECL[d * 64 + dkb * 32 + r];
        bf16_t* ds = (bf16_t*)(ws + WS_SPT) + ((size_t)((b * 4 + h) * 2 + d) * 32 + n) * 8192 + (size_t)(dvb * 32 + 4 * hh) * 64 + dkb * 32 + r;
#pragma unroll
        for (int reg = 0; reg < 16; ++reg) ds[((reg & 3) + 8 * (reg >> 2)) * 64] = f2bf(acc[reg] * sc); } }
  }
}

DI void phase1(const KP& p, char* lds) {
  const int tid = threadIdx.x, lane = tid & 63, w = tid >> 6, r = lane & 31, hh = lane >> 5;
  float* cs = (float*)(lds + LDS_TAB); float* sn = cs + 2048;
  char* wl = lds + w * WT_BYTES;
  for (int tile = blockIdx.x; tile < 256; tile += gridDim.x) {
    unsigned char* ws = launder(p.ws); unsigned char* ob = (unsigned char*)launder(p.out); const float* xin = launder(p.in[0]);
    const float* mod = (const float*)(ws + WS_MOD);
    const int tok0 = tile * 64, b = tile >> 5, t0 = (tile & 31) * 64;
    bf16_t* Hs = (bf16_t*)(ob + OUT_HS) + (size_t)tok0 * 1024;
    bf16_t* CQ = (bf16_t*)(ob + OUT_CQ) + (size_t)tok0 * 640;
    bf16_t* CQN = Hs; bf16_t* CKVN = Hs + 64 * 384;
    bf16_t* GR = (bf16_t*)(ob + OUT_GR) + (size_t)tok0 * 32;
    bf16_t* Qm = (bf16_t*)(ws + WS_QM); bf16_t* Km = (bf16_t*)(ws + WS_KM); bf16_t* Vm = (bf16_t*)(ws + WS_VM);
    bf16_t* qg = (bf16_t*)(ws + WS_P1S + (size_t)tile * 131072); bf16_t* kg = qg + 64 * 256; bf16_t* vg = qg + 2 * 64 * 256;
    bf16_t* rg = (bf16_t*)(ws + WS_RG) + (size_t)tok0 * 512;
    __syncthreads();
#pragma unroll
    for (int i = 0; i < 4; ++i) { const int e = tid + 512 * i, tt = e >> 5, j = e & 31;
      const float inv = powf(10000.f, -(float)j * (1.f / 32.f)); const float ang = (float)((const int*)p.in[2])[tok0 + tt] * inv;
      cs[e] = cosf(ang); sn[e] = sinf(ang); }
    {
      float4 ge[4], sh[4];
      const float* gpre = launder(p.in[5]); const float* modb = launder(mod) + b * 6144;
#pragma unroll
      for (int i = 0; i < 4; ++i) { const int d = (lane + 64 * i) * 4;
        const float4 g = *(const float4*)(gpre + d); const float4 sc = *(const float4*)(modb + 1024 + d); sh[i] = *(const float4*)(modb + d);
        ge[i] = make_float4(g.x * (1.f + sc.x), g.y * (1.f + sc.y), g.z * (1.f + sc.z), g.w * (1.f + sc.w)); }
      for (int rr = 0; rr < 8; ++rr) { const int row = w * 8 + rr;
        const float* xr = xin + (size_t)(tok0 + row) * 1024;
        float4 v[4]; float ss = 0.f;
#pragma unroll
        for (int i = 0; i < 4; ++i) { v[i] = *(const float4*)(xr + (lane + 64 * i) * 4); ss += v[i].x * v[i].x + v[i].y * v[i].y + v[i].z * v[i].z + v[i].w * v[i].w; }
        ss = wave_sum(ss); const float rs = rsqrtf(ss * (1.f / 1024.f) + EPS);
#pragma unroll
        for (int i = 0; i < 4; ++i) { uint2 o; o.x = pack2(v[i].x * rs * ge[i].x + sh[i].x, v[i].y * rs * ge[i].y + sh[i].y); o.y = pack2(v[i].z * rs * ge[i].z + sh[i].z, v[i].w * rs * ge[i].w + sh[i].w);
          *(uint2*)(Hs + (size_t)row * 1024 + (lane + 64 * i) * 4) = o; }
      }
    }
    __syncthreads();
    block_gemm(lds, Hs, 1024, (const bf16_t*)(ws + WS_WTIN), 1024, 9, 1024, [&](int m0, int n0, const f32x16& a0, const f32x16& a1) {
      const int r2 = lv(r), h2 = lv(hh), ln = lv(lane);
      if (n0 == O_KR) {
        wt_write_rope(wl, a0, a1, r2, h2, cs, sn, m0); LDS_FENCE();
        for (int h = 0; h < 4; ++h) { bf16_t* kp = Km + (((size_t)b * 4 + h) * SEQ + t0 + m0) * 192 + 128; wt_store(wl, ln, kp, 192, kp + 32, 192); }
        return; }
      wt_write(wl, a0, a1, r2, h2, (n0 >= O_QG && n0 < O_KG) ? 0.125f : 1.f); LDS_FENCE();
      bf16_t* d[2]; int st[2];
#pragma unroll
      for (int half = 0; half < 2; ++half) { const int nb = n0 + 32 * half;
        if (nb < 640) { d[half] = CQ + (size_t)m0 * 640 + nb; st[half] = 640; }
        else if (nb < O_KG) { d[half] = qg + (size_t)m0 * 256 + (nb - O_QG); st[half] = 256; }
        else if (nb < O_VG) { d[half] = kg + (size_t)m0 * 256 + (nb - O_KG); st[half] = 256; }
        else if (nb < O_GF) { d[half] = vg + (size_t)m0 * 512 + (nb - O_VG); st[half] = 512; }
        else if (nb < O_R) { d[half] = GR + (size_t)m0 * 32; st[half] = 32; }
        else if (nb < INW) { d[half] = rg + (size_t)m0 * 512 + (nb - O_R); st[half] = 512; }
        else { d[half] = nullptr; st[half] = 0; } }
      wt_store(wl, ln, d[0], st[0], d[1], st[1]);
    });
    __syncthreads();
    const float* gq = launder(p.in[8]); const float* gkv = launder(p.in[10]);
    for (int rr = 0; rr < 8; ++rr) { const int row = w * 8 + rr; const bf16_t* cr = CQ + (size_t)row * 640;
      float v[6]; float ss = 0.f;
#pragma unroll
      for (int i = 0; i < 6; ++i) { v[i] = bf2f(cr[lane + 64 * i]); ss += v[i] * v[i]; }
      ss = wave_sum(ss); float rs = rsqrtf(ss * (1.f / 384.f) + EPS);
#pragma unroll
      for (int i = 0; i < 6; ++i) CQN[(size_t)row * 384 + lane + 64 * i] = f2bf(v[i] * rs * gq[lane + 64 * i]);
      float u[4]; float s2 = 0.f;
#pragma unroll
      for (int i = 0; i < 4; ++i) { u[i] = bf2f(cr[384 + lane + 64 * i]); s2 += u[i] * u[i]; }
      s2 = wave_sum(s2); rs = rsqrtf(s2 * (1.f / 256.f) + EPS);
#pragma unroll
      for (int i = 0; i < 4; ++i) CKVN[(size_t)row * 256 + lane + 64 * i] = f2bf(u[i] * rs * gkv[lane + 64 * i]);
    }
    __syncthreads();
    block_gemm(lds, CQN, 384, (const bf16_t*)(ws + WS_WTQUP), 384, 3, 384, [&](int m0, int n0, const f32x16& a0, const f32x16& a1) {
      const int r2 = lv(r), h2 = lv(hh), ln = lv(lane);
      const int h = n0 / 192, d0 = n0 % 192;
      bf16_t* qp = Qm + (((size_t)b * 4 + h) * SEQ + t0 + m0) * 192 + d0;
      if (d0 < 128) wt_write(wl, a0, a1, r2, h2, 1.f); else wt_write_rope(wl, a0, a1, r2, h2, cs, sn, m0);
      LDS_FENCE();
      wt_store(wl, ln, qp, 192, qp + 32, 192);
    });
    block_gemm(lds, CKVN, 256, (const bf16_t*)(ws + WS_WTKVUP), 256, 4, 256, [&](int m0, int n0, const f32x16& a0, const f32x16& a1) {
      const int r2 = lv(r), h2 = lv(hh), ln = lv(lane);
      const int h = n0 >> 8, d0 = n0 & 255;
      wt_write(wl, a0, a1, r2, h2, 1.f); LDS_FENCE();
      if (d0 < 128) { bf16_t* kp = Km + (((size_t)b * 4 + h) * SEQ + t0 + m0) * 192 + d0; wt_store(wl, ln, kp, 192, kp + 32, 192); }
      else { bf16_t* vp = Vm + (((size_t)b * 4 + h) * SEQ + t0 + m0) * 128 + (d0 - 128); wt_store(wl, ln, vp, 128, vp + 32, 128); }
    });
    gla_chunk_local(p, lds, ws, tile, qg, kg, vg, GR);
  }
}

namespace att {
typedef short s16x4 __attribute__((ext_vector_type(4)));
typedef unsigned u32x4 __attribute__((ext_vector_type(4)));
constexpr int DQ = 192, DV = 128, KVBLK = 64;
constexpr float SCALE = 0.07216878364870322f;
constexpr float THR = 8.f;
constexpr int SHM_V = KVBLK * DV * 2, SHM_K = KVBLK * DQ * 2;
constexpr int SHM_QR = 8 * 32 * 176;
constexpr int SHM_ATTN = 2 * SHM_V + 2 * SHM_K + 8 * 64 * 4 + SHM_QR;
#define KSWZ(row, colB) ((row) * 384 + ((colB) ^ (((row) & 7) << 4)))
#define SBAR() __builtin_amdgcn_sched_barrier(0)
DI unsigned cvtpk(float lo, float hi) { unsigned r; asm volatile("v_cvt_pk_bf16_f32 %0, %1, %2" : "=v"(r) : "v"(lo), "v"(hi)); return r; }

DI void partialSM(f32x16& p0, f32x16& p1, float& m_reg, float& mn, float& alpha) {
  constexpr float C = SCALE * 1.4426950408889634f;
  float pmax = p0[0];
#pragma unroll
  for (int r = 1; r < 16; ++r) pmax = fmaxf(pmax, p0[r]);
#pragma unroll
  for (int r = 0; r < 16; ++r) pmax = fmaxf(pmax, p1[r]);
  { auto rr = __builtin_amdgcn_permlane32_swap(__float_as_uint(pmax), __float_as_uint(pmax), false, false);
    pmax = fmaxf(__uint_as_float(rr[0]), __uint_as_float(rr[1])); }
  if (__builtin_expect(__all(pmax - m_reg <= THR / SCALE), 1)) { mn = m_reg; alpha = 1.f; }
  else { mn = fmaxf(m_reg, pmax); alpha = __builtin_amdgcn_exp2f((m_reg - mn) * C); m_reg = mn; }
  const float mnC = -mn * C;
#pragma unroll
  for (int r = 0; r < 16; ++r) p0[r] = fmaf(p0[r], C, mnC);
#pragma unroll
  for (int r = 0; r < 16; ++r) p1[r] = fmaf(p1[r], C, mnC);
#pragma unroll
  for (int r = 0; r < 16; ++r) p0[r] = __builtin_amdgcn_exp2f(p0[r]);
}
DI void finishSM(f32x16& p0, f32x16& p1, float alpha, float& l_reg, bf16x8& pa0, bf16x8& pa1, bf16x8& pa2, bf16x8& pa3) {
#pragma unroll
  for (int r = 0; r < 16; ++r) p1[r] = __builtin_amdgcn_exp2f(p1[r]);
  float ps = 0;
#pragma unroll
  for (int r = 0; r < 16; ++r) ps += p0[r];
#pragma unroll
  for (int r = 0; r < 16; ++r) ps += p1[r];
  { auto rr = __builtin_amdgcn_permlane32_swap(__float_as_uint(ps), __float_as_uint(ps), false, false);
    ps = __uint_as_float(rr[0]) + __uint_as_float(rr[1]); }
  l_reg = l_reg * alpha + ps;
#define PK4(P, BASE, OUT) do { unsigned a0 = cvtpk(P[BASE + 0], P[BASE + 1]), a1 = cvtpk(P[BASE + 2], P[BASE + 3]);   \
    unsigned b0 = cvtpk(P[BASE + 4], P[BASE + 5]), b1 = cvtpk(P[BASE + 6], P[BASE + 7]);                              \
    auto r0 = __builtin_amdgcn_permlane32_swap(a0, b0, false, false); auto r1 = __builtin_amdgcn_permlane32_swap(a1, b1, false, false); \
    u32x4 wv = {r0[0], r1[0], r0[1], r1[1]}; OUT = *reinterpret_cast<bf16x8*>(&wv); } while (0)
  PK4(p0, 0, pa0); PK4(p0, 8, pa1); PK4(p1, 0, pa2); PK4(p1, 8, pa3);
#undef PK4
}
DI void qkt(f32x16& p0, f32x16& p1, const char* Ks, const bf16x8* qr, const char* qrl, int r32, int hi) {
#pragma unroll
  for (int i = 0; i < 16; ++i) { p0[i] = 0.f; p1[i] = 0.f; }
#pragma unroll
  for (int d0 = 0; d0 < 12; ++d0) { const int cb = (d0 * 16 + hi * 8) * 2;
    const bf16x8 b0 = *reinterpret_cast<const bf16x8*>(Ks + KSWZ(r32, cb));
    const bf16x8 b1 = *reinterpret_cast<const bf16x8*>(Ks + KSWZ(32 + r32, cb));
    const bf16x8 q = (d0 < 7) ? qr[d0 < 7 ? d0 : 0] : *reinterpret_cast<const bf16x8*>(qrl + (d0 - 7) * 32);
    p0 = MFMA32(b0, q, p0);
    p1 = MFMA32(b1, q, p1); }
}
DI int v_st(int k, int c) { const int kk = (k & ~0xC) | ((k & 4) << 1) | ((k & 8) >> 1); return ((kk >> 3) * 4 + (c >> 5)) * 512 + ((kk & 7) * 32 + (c & 31)) * 2; }
DI int v_rd_base(int lane) { return ((lane & 3) << 3) | (((lane >> 2) & 3) << 6) | (((lane >> 4) & 1) << 5) | (((lane >> 5) & 1) << 8); }
constexpr int v_rd_off(int d0, int ks, int half) { return d0 * 512 + ks * 4096 + half * 2048; }
template <int OFF> DI s16x4 tr_read(int vb) { s16x4 r; asm volatile("ds_read_b64_tr_b16 %0, %1 offset:%2" : "=&v"(r) : "v"(vb), "i"(OFF) : "memory"); return r; }
template <int D0> DI void pv_one(f32x16& od, int vb, bf16x8 pa0, bf16x8 pa1, bf16x8 pa2, bf16x8 pa3) {
  const s16x4 l0 = tr_read<v_rd_off(D0, 0, 0)>(vb), h0 = tr_read<v_rd_off(D0, 0, 1)>(vb), l1 = tr_read<v_rd_off(D0, 1, 0)>(vb), h1 = tr_read<v_rd_off(D0, 1, 1)>(vb);
  const s16x4 l2 = tr_read<v_rd_off(D0, 2, 0)>(vb), h2 = tr_read<v_rd_off(D0, 2, 1)>(vb), l3 = tr_read<v_rd_off(D0, 3, 0)>(vb), h3 = tr_read<v_rd_off(D0, 3, 1)>(vb);
  asm volatile("s_waitcnt lgkmcnt(0)" ::: "memory"); SBAR();
#define PK(L, H) (bf16x8){L[0], L[1], L[2], L[3], H[0], H[1], H[2], H[3]}
  od = MFMA32(pa0, PK(l0, h0), od);
  od = MFMA32(pa1, PK(l1, h1), od);
  od = MFMA32(pa2, PK(l2, h2), od);
  od = MFMA32(pa3, PK(l3, h3), od);
#undef PK
}
DI void pv_d0(f32x16* o, int vb, bf16x8 pa0, bf16x8 pa1, bf16x8 pa2, bf16x8 pa3) {
  pv_one<0>(o[0], vb, pa0, pa1, pa2, pa3); pv_one<1>(o[1], vb, pa0, pa1, pa2, pa3); pv_one<2>(o[2], vb, pa0, pa1, pa2, pa3); pv_one<3>(o[3], vb, pa0, pa1, pa2, pa3);
}
DI void attn_unit(const bf16_t* Qb, const bf16_t* Kh, const bf16_t* Vh, bf16_t* Ob, int seq, char* lds) {
  const int tid = lv(threadIdx.x), wid = tid >> 6, lane = tid & 63, r32 = lane & 31, hi = lane >> 5;
  char* V_lds = lds; char* K_lds = lds + 2 * SHM_V;
  float* wsf = (float*)(lds + 2 * SHM_V + 2 * SHM_K) + wid * 64; float* li_l = wsf; float* al_l = wsf + 32;
  char* qrl = lds + 2 * SHM_V + 2 * SHM_K + 8 * 64 * 4 + wid * (32 * 176) + r32 * 176 + hi * 16;
  float m_reg = -1e30f, l_reg = 0; f32x16 o[4]; bf16x8 qr[7];
#pragma unroll
  for (int d = 0; d < 4; ++d)
#pragma unroll
    for (int i = 0; i < 16; ++i) o[d][i] = 0.f;
  const bf16_t* Qw = Qb + (size_t)(wid * 32 + r32) * DQ + hi * 8;
#pragma unroll
  for (int d0 = 0; d0 < 7; ++d0) qr[d0] = *reinterpret_cast<const bf16x8*>(Qw + d0 * 16);
#pragma unroll
  for (int d0 = 7; d0 < 12; ++d0) *reinterpret_cast<bf16x8*>(qrl + (d0 - 7) * 32) = *reinterpret_cast<const bf16x8*>(Qw + d0 * 16);
  int kst[3];
#pragma unroll
  for (int i = 0; i < 3; ++i) { const int c = tid + 512 * i; kst[i] = KSWZ(c / 24, (c % 24) * 16); }
  const int vst0 = v_st(tid >> 4, (tid & 15) * 8), vst1 = v_st(32 + (tid >> 4), (tid & 15) * 8);
  const int vb0 = (int)(uintptr_t)V_lds + v_rd_base(lane);
  bf16x8 sk0, sk1, sk2, sv0, sv1;
#define SLOAD(k0) do { const bf16x8* kp = reinterpret_cast<const bf16x8*>(Kh + (size_t)(k0) * DQ) + tid; sk0 = kp[0]; sk1 = kp[512]; sk2 = kp[1024]; \
    const bf16x8* vp = reinterpret_cast<const bf16x8*>(Vh + (size_t)(k0) * DV) + tid; sv0 = vp[0]; sv1 = vp[512]; } while (0)
#define SWRITE(b) do { *(bf16x8*)(V_lds + (b) * SHM_V + vst0) = sv0; *(bf16x8*)(V_lds + (b) * SHM_V + vst1) = sv1; \
    *(bf16x8*)(K_lds + (b) * SHM_K + kst[0]) = sk0; *(bf16x8*)(K_lds + (b) * SHM_K + kst[1]) = sk1; *(bf16x8*)(K_lds + (b) * SHM_K + kst[2]) = sk2; } while (0)
#define RESC(a) do { if (__any((a) < 1.f)) { if (hi == 0) al_l[r32] = (a); asm volatile("s_waitcnt lgkmcnt(0)" ::: "memory"); \
    _Pragma("unroll") for (int d = 0; d < 4; ++d) _Pragma("unroll") for (int r = 0; r < 16; ++r) o[d][r] *= al_l[crow(r, hi)]; } } while (0)
  f32x16 pA0, pA1, pB0, pB1; float mnA, mnB, alA, alB; bf16x8 pa0, pa1, pa2, pa3; const int NT = seq / KVBLK;
  SLOAD(0); SWRITE(0); __syncthreads();
  qkt(pA0, pA1, K_lds, qr, qrl, r32, hi); partialSM(pA0, pA1, m_reg, mnA, alA);
  SLOAD(KVBLK); SWRITE(1); __syncthreads();
  for (int j = 1; j + 1 < NT; j += 2) {
    SBAR(); qkt(pB0, pB1, K_lds + SHM_K, qr, qrl, r32, hi);
    finishSM(pA0, pA1, alA, l_reg, pa0, pa1, pa2, pa3); SBAR();
    SLOAD((j + 1) * KVBLK); SBAR();
    pv_d0(o, vb0, pa0, pa1, pa2, pa3); partialSM(pB0, pB1, m_reg, mnB, alB);
    __syncthreads(); SWRITE(0);
    RESC(alB); __syncthreads();
    SBAR(); qkt(pA0, pA1, K_lds, qr, qrl, r32, hi);
    finishSM(pB0, pB1, alB, l_reg, pa0, pa1, pa2, pa3); SBAR();
    SLOAD((j + 2) * KVBLK); SBAR();
    pv_d0(o, vb0 + SHM_V, pa0, pa1, pa2, pa3); partialSM(pA0, pA1, m_reg, mnA, alA);
    __syncthreads(); SWRITE(1);
    RESC(alA); __syncthreads();
  }
  SBAR(); qkt(pB0, pB1, K_lds + SHM_K, qr, qrl, r32, hi);
  finishSM(pA0, pA1, alA, l_reg, pa0, pa1, pa2, pa3); SBAR();
  pv_d0(o, vb0, pa0, pa1, pa2, pa3); partialSM(pB0, pB1, m_reg, mnB, alB);
  __syncthreads(); RESC(alB);
  finishSM(pB0, pB1, alB, l_reg, pa0, pa1, pa2, pa3); SBAR();
  pv_d0(o, vb0 + SHM_V, pa0, pa1, pa2, pa3);
  if (hi == 0) li_l[r32] = l_reg; asm volatile("s_waitcnt lgkmcnt(0)" ::: "memory");
  float rli[16];
#pragma unroll
  for (int r = 0; r < 16; ++r) rli[r] = __builtin_amdgcn_rcpf(li_l[crow(r, hi)]);
  bf16_t* Ow = Ob + (size_t)(wid * 32) * 1024;
#pragma unroll
  for (int r = 0; r < 16; ++r) { const int orow = crow(r, hi);
#pragma unroll
    for (int d0 = 0; d0 < 4; ++d0) Ow[(size_t)orow * 1024 + d0 * 32 + r32] = f2bf(o[d0][r] * rli[r]); }
  __syncthreads();
#undef SLOAD
#undef SWRITE
#undef RESC
}
}

DI void phase2_attn(const KP& p, char* lds) {
  for (int u = blockIdx.x; u < 256; u += gridDim.x) {
    unsigned char* ws = launder(p.ws);
    const bf16_t* Qm = (const bf16_t*)(ws + WS_QM); const bf16_t* Km = (const bf16_t*)(ws + WS_KM); const bf16_t* Vm = (const bf16_t*)(ws + WS_VM);
    bf16_t* mixa = (bf16_t*)(ws + WS_P1S);
    const int qb = u & 7, bh = u >> 3, b = bh >> 2, h = bh & 3;
    att::attn_unit(Qm + ((size_t)bh * SEQ + qb * 256) * 192, Km + (size_t)bh * SEQ * 192, Vm + (size_t)bh * SEQ * 128,
                   mixa + ((size_t)b * SEQ + qb * 256) * 1024 + h * 128, SEQ, lds);
  }
}

constexpr int P3_TILE_BYTES = 256 * 1024;
constexpr int LDS_TK = LDS_GEMM;
constexpr int SCW = 260;
template <int N> DI void ce_desc(float (&a)[N], int i, int l) { const float hi = fmaxf(a[i], a[l]), lo = fminf(a[i], a[l]); a[i] = hi; a[l] = lo; }
DI void sort16_desc(float (&a)[16]) {
#pragma unroll
  for (int k = 2; k <= 16; k <<= 1)
#pragma unroll
    for (int j = k >> 1; j > 0; j >>= 1)
#pragma unroll
      for (int i = 0; i < 16; ++i) { const int l = i ^ j; if (l > i) { if ((i & k) == 0) ce_desc(a, i, l); else ce_desc(a, l, i); } }
}
DI void merge16_desc(float (&a)[16]) {
#pragma unroll
  for (int j = 8; j > 0; j >>= 1)
#pragma unroll
    for (int i = 0; i < 16; ++i) { const int l = i ^ j; if (l > i) ce_desc(a, i, l); }
}
DI void top16_merge(float (&a)[16], const float (&b)[16]) {
#pragma unroll
  for (int i = 0; i < 16; ++i) a[i] = fmaxf(a[i], b[15 - i]);
  merge16_desc(a);
}
template <int CTRL> DI float dpp_f(float v) { return __int_as_float(__builtin_amdgcn_mov_dpp(__float_as_int(v), CTRL, 0xF, 0xF, true)); }

DI float gelu_fast(float x) { return 0.5f * x * (1.f + erff(x * 0.70710678118654752f)); }

DI void phase3(const KP& p, char* lds, const int gather_reps, const int probe) {
  const int tid0 = threadIdx.x;
  const int r = tid0 & 31, hh = (tid0 >> 5) & 1, lane = tid0 & 63;
  char* wl = lds + (tid0 >> 6) * WT_BYTES;
  for (int tile = blockIdx.x; tile < 256; tile += gridDim.x) {
    unsigned char* ws = launder(p.ws); float* outp = launder(p.out); const float* xin = launder(p.in[0]);
    const int tok0 = tile * 64, b = tile >> 5;
    unsigned char* tsc = ws + WS_QM + (size_t)tile * P3_TILE_BYTES;
    bf16_t* QRY = (bf16_t*)tsc; bf16_t* Y = (bf16_t*)tsc; bf16_t* MIXA = (bf16_t*)(ws + WS_P1S) + (size_t)tok0 * 1024; bf16_t* H2 = MIXA;
    const float* modb = launder((const float*)(ws + WS_MOD)) + b * 6144;
    __syncthreads();
    {
      const int tid = lv(tid0), lane = tid & 63, w = tid >> 6, r = lane & 31, hh = lane >> 5;
      const int h = w >> 1, mi = w & 1, n = tile & 31;
      const bf16_t* QDg = (const bf16_t*)(ws + WS_QDEC) + (size_t)(tile * 4 + h) * 2 * 4096 + (mi * 32 + r) * 64 + hh * 8;
      const bf16_t* SPg = (const bf16_t*)(ws + WS_SPT) + ((size_t)((b * 4 + h) * 2) * 32 + n) * 8192 + r * 64 + hh * 8;
      f32x16 acc[4];
#pragma unroll
      for (int ni = 0; ni < 4; ++ni)
#pragma unroll
        for (int i = 0; i < 16; ++i) acc[ni][i] = 0.f;
#pragma unroll
      for (int d = 0; d < 2; ++d)
#pragma unroll
        for (int s = 0; s < 4; ++s) { const bf16x8 a = *(const bf16x8*)(QDg + d * 4096 + s * 16);
#pragma unroll
          for (int ni = 0; ni < 4; ++ni) { const bf16x8 bb = *(const bf16x8*)(SPg + (size_t)d * 32 * 8192 + ni * 32 * 64 + s * 16); acc[ni] = MFMA32(a, bb, acc[ni]); } }
      const bf16_t* OI = (const bf16_t*)(ws + WS_OINTRA) + (size_t)(tok0 + mi * 32 + 4 * hh) * 512 + h * 128 + r;
#pragma unroll
      for (int ni = 0; ni < 4; ++ni)
#pragma unroll
        for (int reg = 0; reg < 16; ++reg) acc[ni][reg] += bf2f(OI[(size_t)((reg & 3) + 8 * (reg >> 2)) * 512 + ni * 32]);
      float rs[16];
#pragma unroll
      for (int reg = 0; reg < 16; ++reg) { float v = acc[0][reg] * acc[0][reg] + acc[1][reg] * acc[1][reg] + acc[2][reg] * acc[2][reg] + acc[3][reg] * acc[3][reg];
        v += __shfl_xor(v, 1); v += __shfl_xor(v, 2); v += __shfl_xor(v, 4); v += __shfl_xor(v, 8); v += __shfl_xor(v, 16);
        rs[reg] = rsqrtf(v * (1.f / 128.f) + EPS); }
      const float* ggl = launder(p.in[16]);
      const bf16_t* RGp = (const bf16_t*)(ws + WS_RG) + (size_t)(tok0 + mi * 32 + 4 * hh) * 512 + h * 128 + r;
      bf16_t* MX = MIXA + (size_t)(mi * 32 + 4 * hh) * 1024 + 512 + h * 128 + r;
#pragma unroll
      for (int ni = 0; ni < 4; ++ni) { const float g = ggl[ni * 32 + r];
#pragma unroll
        for (int reg = 0; reg < 16; ++reg) { const int ro = (reg & 3) + 8 * (reg >> 2); const float rv = bf2f(RGp[(size_t)ro * 512 + ni * 32]);
          MX[(size_t)ro * 1024 + ni * 32] = f2bf(acc[ni][reg] * rs[reg] * g * silu_f(rv)); } }
    }
    __syncthreads();
    for (int rep3b = 0; rep3b < (probe == 5 ? 2 : 1); ++rep3b)
    block_gemm(lds, MIXA, 1024, (const bf16_t*)(ws + WS_WTOUT), 1024, 4, 1024, [&](int m0, int n0, const f32x16& a0, const f32x16& a1) {
      const int r2 = lv(r), h2 = lv(hh), ln = lv(lane);
      wt_write(wl, a0, a1, r2, h2, 1.f); LDS_FENCE();
      bf16_t* d = Y + (size_t)m0 * 1024 + n0; wt_store(wl, ln, d, 1024, d + 32, 1024);
    });
    __syncthreads();
    {
      const int tid = lv(tid0), lane = tid & 63, w = tid >> 6;
      float4 A1[4], A2[4], S2[4];
      const float* gpo = launder(p.in[6]); const float* gpf = launder(p.in[18]);
#pragma unroll
      for (int i = 0; i < 4; ++i) { const int d = (lane + 64 * i) * 4;
        const float4 gp = *(const float4*)(gpo + d), gt = *(const float4*)(modb + 2048 + d), g2 = *(const float4*)(gpf + d), sc = *(const float4*)(modb + 4096 + d);
        S2[i] = *(const float4*)(modb + 3072 + d);
        A1[i] = make_float4(gp.x * gt.x, gp.y * gt.y, gp.z * gt.z, gp.w * gt.w);
        A2[i] = make_float4(g2.x * (1.f + sc.x), g2.y * (1.f + sc.y), g2.z * (1.f + sc.z), g2.w * (1.f + sc.w)); }
      for (int rr = 0; rr < 8; ++rr) { const int row = w * 8 + rr; const size_t tok = tok0 + row;
        float4 yv[4]; float ss = 0.f;
#pragma unroll
        for (int i = 0; i < 4; ++i) { const uint2 u = *(const uint2*)(Y + (size_t)row * 1024 + (lane + 64 * i) * 4);
          yv[i] = make_float4(__uint_as_float(u.x << 16), __uint_as_float(u.x & 0xffff0000u), __uint_as_float(u.y << 16), __uint_as_float(u.y & 0xffff0000u));
          ss += yv[i].x * yv[i].x + yv[i].y * yv[i].y + yv[i].z * yv[i].z + yv[i].w * yv[i].w; }
        ss = wave_sum(ss); const float rs = rsqrtf(ss * (1.f / 1024.f) + EPS);
        float4 xv[4]; float s2 = 0.f;
#pragma unroll
        for (int i = 0; i < 4; ++i) { const float4 x = *(const float4*)(xin + tok * 1024 + (lane + 64 * i) * 4);
          xv[i] = make_float4(x.x + A1[i].x * yv[i].x * rs, x.y + A1[i].y * yv[i].y * rs, x.z + A1[i].z * yv[i].z * rs, x.w + A1[i].w * yv[i].w * rs);
          *(float4*)(outp + tok * 1024 + (lane + 64 * i) * 4) = xv[i];
          s2 += xv[i].x * xv[i].x + xv[i].y * xv[i].y + xv[i].z * xv[i].z + xv[i].w * xv[i].w; }
        s2 = wave_sum(s2); const float r2 = rsqrtf(s2 * (1.f / 1024.f) + EPS);
#pragma unroll
        for (int i = 0; i < 4; ++i) { uint2 o; o.x = pack2(xv[i].x * r2 * A2[i].x + S2[i].x, xv[i].y * r2 * A2[i].y + S2[i].y); o.y = pack2(xv[i].z * r2 * A2[i].z + S2[i].z, xv[i].w * r2 * A2[i].w + S2[i].w);
          *(uint2*)(H2 + (size_t)row * 1024 + (lane + 64 * i) * 4) = o; }
      }
    }
    __syncthreads();
    for (int rep3d = 0; rep3d < (probe == 6 ? 2 : 1); ++rep3d)
    block_gemm(lds, H2, 1024, (const bf16_t*)(ws + WS_WTPQ), 1024, 8, 1024, [&](int m0, int n0, const f32x16& a0, const f32x16& a1) {
      const int r2 = lv(r), h2 = lv(hh), ln = lv(lane);
      wt_write(wl, a0, a1, r2, h2, 1.f); LDS_FENCE();
      bf16_t* d = QRY + (size_t)m0 * 2048 + n0; wt_store(wl, ln, d, 2048, d + 32, 2048);
    });
    float* SC = (float*)lds; unsigned* TK = (unsigned*)(lds + LDS_TK);
    for (int rep3e = 0; rep3e < (probe == 7 ? 2 : 1); ++rep3e)
    for (int h = 0; h < 8; ++h) {
      block_gemm(lds, QRY + h * 256, 2048, (const bf16_t*)(ws + WS_KD), 256, 1, 256, [&](int m0, int n0, const f32x16& a0, const f32x16& a1) {
        const int r2 = lv(r), h2 = lv(hh);
        float* sp = SC + (m0 + 4 * h2) * SCW + n0 + r2;
#pragma unroll
        for (int reg = 0; reg < 16; ++reg) { const int ro = ((reg & 3) + 8 * (reg >> 2)) * SCW; sp[ro] = a0[reg]; sp[ro + 32] = a1[reg]; }
      });
      {
        const int tid = lv(tid0);
        const int tt = tid >> 3, sd = (tid >> 2) & 1, q = tid & 3;
        const float* sr = SC + tt * SCW + sd * 128 + q * 32;
        float a[16], c[16];
#pragma unroll
        for (int i = 0; i < 4; ++i) { const float4 v = *(const float4*)(sr + i * 4); const unsigned ib = q * 32 + i * 4;
          a[i * 4 + 0] = __uint_as_float((__float_as_uint(v.x) & 0xFFFFFF80u) | (ib + 0)); a[i * 4 + 1] = __uint_as_float((__float_as_uint(v.y) & 0xFFFFFF80u) | (ib + 1));
          a[i * 4 + 2] = __uint_as_float((__float_as_uint(v.z) & 0xFFFFFF80u) | (ib + 2)); a[i * 4 + 3] = __uint_as_float((__float_as_uint(v.w) & 0xFFFFFF80u) | (ib + 3)); }
#pragma unroll
        for (int i = 0; i < 4; ++i) { const float4 v = *(const float4*)(sr + 16 + i * 4); const unsigned ib = q * 32 + 16 + i * 4;
          c[i * 4 + 0] = __uint_as_float((__float_as_uint(v.x) & 0xFFFFFF80u) | (ib + 0)); c[i * 4 + 1] = __uint_as_float((__float_as_uint(v.y) & 0xFFFFFF80u) | (ib + 1));
          c[i * 4 + 2] = __uint_as_float((__float_as_uint(v.z) & 0xFFFFFF80u) | (ib + 2)); c[i * 4 + 3] = __uint_as_float((__float_as_uint(v.w) & 0xFFFFFF80u) | (ib + 3)); }
        sort16_desc(a); sort16_desc(c); top16_merge(a, c);
#pragma unroll
        for (int i = 0; i < 16; ++i) c[i] = dpp_f<0xB1>(a[i]);
        top16_merge(a, c);
#pragma unroll
        for (int i = 0; i < 16; ++i) c[i] = dpp_f<0x4E>(a[i]);
        top16_merge(a, c);
        if (q == 0) { unsigned* tk = TK + ((tt * 8 + h) * 2 + sd) * 16;
#pragma unroll
          for (int i = 0; i < 4; ++i) *(uint4*)(tk + i * 4) = make_uint4(__float_as_uint(a[i * 4]), __float_as_uint(a[i * 4 + 1]), __float_as_uint(a[i * 4 + 2]), __float_as_uint(a[i * 4 + 3])); }
      }
      __syncthreads();
    }
    int* EIDX = (int*)lds; float* GATE = (float*)(lds + 32768);
    {
      const int tid = lv(tid0);
      const int tt = tid >> 3, h = tid & 7;
      const unsigned* t1 = TK + ((tt * 8 + h) * 2) * 16; const unsigned* t2 = t1 + 16;
      float v1[16], v2[16];
#pragma unroll
      for (int i = 0; i < 4; ++i) { const uint4 u = *(const uint4*)(t1 + i * 4), v = *(const uint4*)(t2 + i * 4);
        v1[i * 4] = __uint_as_float(u.x & 0xFFFFFF80u); v1[i * 4 + 1] = __uint_as_float(u.y & 0xFFFFFF80u); v1[i * 4 + 2] = __uint_as_float(u.z & 0xFFFFFF80u); v1[i * 4 + 3] = __uint_as_float(u.w & 0xFFFFFF80u);
        v2[i * 4] = __uint_as_float(v.x & 0xFFFFFF80u); v2[i * 4 + 1] = __uint_as_float(v.y & 0xFFFFFF80u); v2[i * 4 + 2] = __uint_as_float(v.z & 0xFFFFFF80u); v2[i * 4 + 3] = __uint_as_float(v.w & 0xFFFFFF80u); }
      float best[16], grp[16];
#define CAND(i, j) __uint_as_float((__float_as_uint(v1[i] + v2[j]) & 0xFFFFFF00u) | ((i) << 4) | (j))
      best[0] = CAND(0, 0); best[1] = CAND(0, 1); best[2] = CAND(0, 2); best[3] = CAND(0, 3); best[4] = CAND(0, 4); best[5] = CAND(0, 5); best[6] = CAND(0, 6); best[7] = CAND(0, 7);
      best[8] = CAND(0, 8); best[9] = CAND(0, 9); best[10] = CAND(0, 10); best[11] = CAND(0, 11); best[12] = CAND(0, 12); best[13] = CAND(0, 13); best[14] = CAND(0, 14); best[15] = CAND(0, 15);
      sort16_desc(best);
      grp[0] = CAND(1, 0); grp[1] = CAND(1, 1); grp[2] = CAND(1, 2); grp[3] = CAND(1, 3); grp[4] = CAND(1, 4); grp[5] = CAND(1, 5); grp[6] = CAND(1, 6); grp[7] = CAND(1, 7);
      grp[8] = CAND(2, 0); grp[9] = CAND(2, 1); grp[10] = CAND(2, 2); grp[11] = CAND(2, 3); grp[12] = CAND(2, 4); grp[13] = CAND(3, 0); grp[14] = CAND(3, 1); grp[15] = CAND(3, 2);
      sort16_desc(grp); top16_merge(best, grp);
      grp[0] = CAND(3, 3); grp[1] = CAND(4, 0); grp[2] = CAND(4, 1); grp[3] = CAND(4, 2); grp[4] = CAND(5, 0); grp[5] = CAND(5, 1); grp[6] = CAND(6, 0); grp[7] = CAND(6, 1);
      grp[8] = CAND(7, 0); grp[9] = CAND(7, 1); grp[10] = CAND(8, 0); grp[11] = CAND(9, 0); grp[12] = CAND(10, 0); grp[13] = CAND(11, 0); grp[14] = CAND(12, 0); grp[15] = CAND(13, 0);
      sort16_desc(grp); top16_merge(best, grp);
      { const float c14 = CAND(14, 0), c15 = CAND(15, 0);
        grp[0] = fmaxf(c14, c15); grp[1] = fminf(c14, c15);
#pragma unroll
        for (int i = 2; i < 16; ++i) grp[i] = -3.0e38f;
        top16_merge(best, grp); }
#undef CAND
      __syncthreads();
      float sv[16]; int ev[16]; float mx = -3.0e38f;
#pragma unroll
      for (int k = 0; k < 16; ++k) { const unsigned key = __float_as_uint(best[k]); const int ci = (key >> 4) & 15, cj = key & 15;
        const unsigned k1 = t1[ci], k2 = t2[cj];
        sv[k] = __uint_as_float(k1 & 0xFFFFFF80u) + __uint_as_float(k2 & 0xFFFFFF80u); ev[k] = (int)((k1 & 127u) * 128u + (k2 & 127u)); mx = fmaxf(mx, sv[k]); }
      float sum = 0.f;
#pragma unroll
      for (int k = 0; k < 16; ++k) { sv[k] = __expf(sv[k] - mx); sum += sv[k]; }
      const float inv = 1.f / sum;
#pragma unroll
      for (int k = 0; k < 16; ++k) { EIDX[tt * 128 + h * 16 + k] = ev[k]; GATE[tt * 128 + h * 16 + k] = sv[k] * inv; }
    }
    __syncthreads();
    {
      const int tid = lv(tid0), lane = tid & 63, w = tid >> 6;
      const unsigned char* EU = ws + WS_EU; const unsigned char* EV = ws + WS_EV; const float* SCU = (const float*)(ws + WS_ESC); const float* SCV = SCU + 16384;
      const float* gpf2 = launder(p.in[19]);
      typedef float f2v __attribute__((ext_vector_type(2)));
#define FP8X4(wd, o0, o1, o2, o3) do { const f2v lo_ = __builtin_amdgcn_cvt_pk_f32_fp8((int)(wd), false), hi_ = __builtin_amdgcn_cvt_pk_f32_fp8((int)(wd), true); o0 = lo_.x; o1 = lo_.y; o2 = hi_.x; o3 = hi_.y; } while (0)
#pragma unroll 1
      for (int pass = 0; pass < gather_reps; ++pass)
#pragma unroll 1
      for (int rr = 0; rr < 8; ++rr) { const int row = w * 8 + rr; const size_t tok = tok0 + row;
        float hf[16];
        { const uint4 hA = *(const uint4*)(H2 + (size_t)row * 1024 + lane * 16), hB = *(const uint4*)(H2 + (size_t)row * 1024 + lane * 16 + 8);
          hf[0] = __uint_as_float(hA.x << 16); hf[1] = __uint_as_float(hA.x & 0xffff0000u); hf[2] = __uint_as_float(hA.y << 16); hf[3] = __uint_as_float(hA.y & 0xffff0000u);
          hf[4] = __uint_as_float(hA.z << 16); hf[5] = __uint_as_float(hA.z & 0xffff0000u); hf[6] = __uint_as_float(hA.w << 16); hf[7] = __uint_as_float(hA.w & 0xffff0000u);
          hf[8] = __uint_as_float(hB.x << 16); hf[9] = __uint_as_float(hB.x & 0xffff0000u); hf[10] = __uint_as_float(hB.y << 16); hf[11] = __uint_as_float(hB.y & 0xffff0000u);
          hf[12] = __uint_as_float(hB.z << 16); hf[13] = __uint_as_float(hB.z & 0xffff0000u); hf[14] = __uint_as_float(hB.w << 16); hf[15] = __uint_as_float(hB.w & 0xffff0000u); }
        float acc[16];
#pragma unroll
        for (int i = 0; i < 16; ++i) acc[i] = 0.f;
#pragma unroll 1
        for (int g = 0; g < 16; ++g) {
          const int* ep = EIDX + row * 128 + g * 8;
          const int4 ea = *(const int4*)ep, eb = *(const int4*)(ep + 4);
          int es[8];
          es[0] = __builtin_amdgcn_readfirstlane(ea.x); es[1] = __builtin_amdgcn_readfirstlane(ea.y); es[2] = __builtin_amdgcn_readfirstlane(ea.z); es[3] = __builtin_amdgcn_readfirstlane(ea.w);
          es[4] = __builtin_amdgcn_readfirstlane(eb.x); es[5] = __builtin_amdgcn_readfirstlane(eb.y); es[6] = __builtin_amdgcn_readfirstlane(eb.z); es[7] = __builtin_amdgcn_readfirstlane(eb.w);
          uint4 u[8], v[8];
#pragma unroll
          for (int k2 = 0; k2 < 8; ++k2) u[k2] = *(const uint4*)(EU + (size_t)es[k2] * 1024 + lane * 16);
#pragma unroll
          for (int k2 = 0; k2 < 8; ++k2) v[k2] = *(const uint4*)(EV + (size_t)es[k2] * 1024 + lane * 16);
          const int eslot = ep[lane & 7];
          const float gte = GATE[row * 128 + g * 8 + (lane & 7)], su = SCU[eslot], sv = SCV[eslot];
          float P[8];
#pragma unroll
          for (int k2 = 0; k2 < 8; ++k2) { float a0, a1, a2, a3, d;
            FP8X4(u[k2].x, a0, a1, a2, a3); d = a0 * hf[0] + a1 * hf[1] + a2 * hf[2] + a3 * hf[3];
            FP8X4(u[k2].y, a0, a1, a2, a3); d += a0 * hf[4] + a1 * hf[5] + a2 * hf[6] + a3 * hf[7];
            FP8X4(u[k2].z, a0, a1, a2, a3); d += a0 * hf[8] + a1 * hf[9] + a2 * hf[10] + a3 * hf[11];
            FP8X4(u[k2].w, a0, a1, a2, a3); d += a0 * hf[12] + a1 * hf[13] + a2 * hf[14] + a3 * hf[15];
            P[k2] = d; }
          { const bool up4 = (lane & 4) != 0;
#pragma unroll
            for (int e = 0; e < 4; ++e) { const float keep = up4 ? P[e + 4] : P[e], send = up4 ? P[e] : P[e + 4]; P[e] = keep + __shfl_xor(send, 4); }
            const bool up2 = (lane & 2) != 0;
#pragma unroll
            for (int e = 0; e < 2; ++e) { const float keep = up2 ? P[e + 2] : P[e], send = up2 ? P[e] : P[e + 2]; P[e] = keep + dpp_f<0x4E>(send); }
            const bool up1 = (lane & 1) != 0;
            const float keep = up1 ? P[1] : P[0], send = up1 ? P[0] : P[1];
            float av = keep + dpp_f<0xB1>(send);
            av += __shfl_xor(av, 8); av += __shfl_xor(av, 16); av += __shfl_xor(av, 32);
            av *= su;
            const float ax = fabsf(av), t = __builtin_amdgcn_rcpf(ax * 0.2316418882f + 1.0f);
            float q = t * 0.5307027145f + (-0.7265760135f); q = q * t + 0.7107068705f; q = q * t + (-0.142248368f); q = q * t + 0.127414796f; q = q * t;
            const float ee = __builtin_amdgcn_exp2f(av * av * (-0.72134752044f));
            const float mm = av * (q * ee), gl = (av < 0.f) ? mm : (av - mm);
            P[0] = gte * gl * sv; }
#pragma unroll
          for (int k2 = 0; k2 < 8; ++k2) { const float wk = __int_as_float(__builtin_amdgcn_readlane(__float_as_int(P[0]), k2)); float a0, a1, a2, a3;
            FP8X4(v[k2].x, a0, a1, a2, a3); acc[0] += wk * a0; acc[1] += wk * a1; acc[2] += wk * a2; acc[3] += wk * a3;
            FP8X4(v[k2].y, a0, a1, a2, a3); acc[4] += wk * a0; acc[5] += wk * a1; acc[6] += wk * a2; acc[7] += wk * a3;
            FP8X4(v[k2].z, a0, a1, a2, a3); acc[8] += wk * a0; acc[9] += wk * a1; acc[10] += wk * a2; acc[11] += wk * a3;
            FP8X4(v[k2].w, a0, a1, a2, a3); acc[12] += wk * a0; acc[13] += wk * a1; acc[14] += wk * a2; acc[15] += wk * a3; }
        }
        float ss = 0.f;
#pragma unroll
        for (int i = 0; i < 16; ++i) ss += acc[i] * acc[i];
        ss = wave_sum(ss); const float rs = rsqrtf(ss * (1.f / 1024.f) + EPS);
        float* orow = outp + tok * 1024 + lane * 16;
        if (pass == gather_reps - 1)
#pragma unroll
        for (int i = 0; i < 4; ++i) { const int d = lane * 16 + 4 * i;
          float4 x1 = *(const float4*)(orow + 4 * i); const float4 g3 = *(const float4*)(gpf2 + d), g2 = *(const float4*)(modb + 5120 + d);
          x1.x += g3.x * g2.x * acc[4 * i] * rs; x1.y += g3.y * g2.y * acc[4 * i + 1] * rs; x1.z += g3.z * g2.z * acc[4 * i + 2] * rs; x1.w += g3.w * g2.w * acc[4 * i + 3] * rs;
          *(float4*)(orow + 4 * i) = x1; }
      }
#undef FP8X4
    }
  }
}

DI void phase2_scan(const KP& p) {
  unsigned char* ws = p.ws;
  for (int g = blockIdx.x * NTHR + threadIdx.x; g < 131072; g += gridDim.x * NTHR) {
    const int seq = g >> 11, within = g & 2047, dv = within >> 4, dk4 = (within & 15) * 4, dir = seq & 1;
    bf16_t* base = (bf16_t*)(ws + WS_SPT) + ((size_t)seq * 32 * 128 + dv) * 64 + dk4;
    const float* dec = (const float*)(ws + WS_DEC) + (size_t)seq * 32 * 64 + dk4;
    float s0 = 0.f, s1 = 0.f, s2 = 0.f, s3 = 0.f;
#pragma unroll 1
    for (int i0 = 0; i0 < 32; i0 += 8) {
      uint2 d[8]; float4 c[8];
#pragma unroll
      for (int j = 0; j < 8; ++j) { const int n = dir ? 31 - (i0 + j) : (i0 + j); d[j] = *(const uint2*)(base + (size_t)n * 8192); c[j] = *(const float4*)(dec + n * 64); }
#pragma unroll
      for (int j = 0; j < 8; ++j) { const int n = dir ? 31 - (i0 + j) : (i0 + j);
        uint2 o; o.x = pack2(s0, s1); o.y = pack2(s2, s3); *(uint2*)(base + (size_t)n * 8192) = o;
        s0 = c[j].x * s0 + __uint_as_float(d[j].x << 16); s1 = c[j].y * s1 + __uint_as_float(d[j].x & 0xffff0000u);
        s2 = c[j].z * s2 + __uint_as_float(d[j].y << 16); s3 = c[j].w * s3 + __uint_as_float(d[j].y & 0xffff0000u); }
    }
  }
}

#ifndef PROBE_ID
#define PROBE_ID 0
#endif
__global__ void __launch_bounds__(NTHR, 2) mega(KP p) {
  extern __shared__ __attribute__((aligned(16))) char lds[];
  cg::grid_group grid = cg::this_grid();
  const int hi = p.ph_hi & 15, probe = p.ph_hi >> 4;
  if (p.ph_lo <= 0 && 0 < hi) { phase0(p, lds); if (probe == 1) phase0(p, lds); if (1 < hi) grid.sync(); }
  if (p.ph_lo <= 1 && 1 < hi) { phase1(p, lds); if (probe == 2) phase1(p, lds); if (2 < hi) grid.sync(); }
  if (p.ph_lo <= 2 && 2 < hi) { phase2_scan(p); phase2_attn(p, lds); if (probe == 3) phase2_attn(p, lds); if (3 < hi) grid.sync(); }
  if (p.ph_lo <= 3 && 3 < hi) { phase3(p, lds, probe == 4 ? 2 : 1, probe); }
}

extern "C" void kernel_launch(void* const* d_in, const int* in_sizes, int n_in, void* d_out, int out_size, void* d_ws, size_t ws_size, hipStream_t stream) {
  float* out = (float*)d_out;
  unsigned char* ws = (unsigned char*)d_ws;
  if (ws_size < WS_END || n_in != 25) return;
  static bool attr_done = false;
  if (!attr_done) { (void)hipFuncSetAttribute((const void*)mega, hipFuncAttributeMaxDynamicSharedMemorySize, LDS_TOTAL); attr_done = true; }
  KP p{};
  for (int i = 0; i < 25; ++i) p.in[i] = (const float*)d_in[i];
  p.out = out; p.ws = ws;
  p.ph_lo = 0; p.ph_hi = 4 + 16 * PROBE_ID;
  { void* args[] = {&p}; (void)hipLaunchCooperativeKernel((const void*)mega, dim3(256), dim3(NTHR), args, LDS_TOTAL, stream); }
}
```

```cpp
#include <hip/hip_runtime.h>
#include <hip/hip_cooperative_groups.h>
namespace cg = cooperative_groups;
#include <stdint.h>

typedef unsigned short bf16_t;
#define DI __device__ __forceinline__

DI float bf2f(bf16_t v) { return __uint_as_float(((unsigned)v) << 16); }
DI bf16_t f2bf(float f) { unsigned u = __float_as_uint(f); u += 0x7fffu + ((u >> 16) & 1u); return (bf16_t)(u >> 16); }

constexpr int BATCH = 8, SEQ = 2048, DM = 1024, NTOK = BATCH * SEQ;
constexpr int INW = 2272;
constexpr float EPS = 1e-6f;
constexpr int O_CQ = 0, O_CKV = 384, O_KR = 640, O_QG = 704, O_KG = 960, O_VG = 1216, O_GF = 1728, O_GB = 1744, O_R = 1760;

DI float wave_sum(float v) {
#pragma unroll
  for (int o = 1; o < 64; o <<= 1) v += __shfl_xor(v, o);
  return v;
}
DI float wave_max(float v) {
#pragma unroll
  for (int o = 1; o < 64; o <<= 1) v = fmaxf(v, __shfl_xor(v, o));
  return v;
}
DI float block_sum256(float v, float* red) {
  v = wave_sum(v);
  __syncthreads();
  if ((threadIdx.x & 63) == 0) red[threadIdx.x >> 6] = v;
  __syncthreads();
  return red[0] + red[1] + red[2] + red[3];
}
DI float block_max256(float v, float* red) {
  v = wave_max(v);
  __syncthreads();
  if ((threadIdx.x & 63) == 0) red[threadIdx.x >> 6] = v;
  __syncthreads();
  return fmaxf(fmaxf(red[0], red[1]), fmaxf(red[2], red[3]));
}
DI float silu_f(float x) { return x / (1.f + expf(-x)); }
DI float logsigmoid_f(float x) { return fminf(x, 0.f) - log1pf(expf(-fabsf(x))); }
DI float gelu_erf(float x) { return 0.5f * x * (1.f + erff(x * 0.70710678118654752f)); }

__global__ __launch_bounds__(256) void n_mod(const float* __restrict__ c, const float* __restrict__ w_ada, const float* __restrict__ b_ada, float* __restrict__ mod) {
  int idx = blockIdx.x * 256 + threadIdx.x;
  int b = idx / 6144, j = idx % 6144;
  float acc = b_ada[j];
  for (int k = 0; k < 1024; ++k) acc += silu_f(c[b * 1024 + k]) * w_ada[(size_t)k * 6144 + j];
  mod[idx] = acc;
}

__global__ __launch_bounds__(256) void n_hnorm(const float* __restrict__ x, const float* __restrict__ g, const float* __restrict__ mod, int b, int off_sh, int off_sc, float* __restrict__ h) {
  __shared__ float red[4];
  int t = blockIdx.x, tid = threadIdx.x;
  const float* xr = x + ((size_t)b * SEQ + t) * DM;
  float v[4]; float ss = 0.f;
#pragma unroll
  for (int i = 0; i < 4; ++i) { v[i] = xr[tid + 256 * i]; ss += v[i] * v[i]; }
  ss = block_sum256(ss, red);
  float rs = rsqrtf(ss * (1.f / DM) + EPS);
#pragma unroll
  for (int i = 0; i < 4; ++i) { int d = tid + 256 * i; h[(size_t)t * DM + d] = v[i] * rs * g[d] * (1.f + mod[b * 6144 + off_sc + d]) + mod[b * 6144 + off_sh + d]; }
}

template <bool BT>
__global__ __launch_bounds__(256) void n_gemm(const float* __restrict__ A, int lda, const float* __restrict__ B, int ldb, float* __restrict__ C, int ldc, int M, int N, int K) {
  __shared__ float As[16][65];
  __shared__ float Bs[16][65];
  const int tid = threadIdx.x, tx = tid & 15, ty = tid >> 4;
  const int m0 = blockIdx.y * 64, n0 = blockIdx.x * 64;
  float acc[4][4];
#pragma unroll
  for (int i = 0; i < 4; ++i)
#pragma unroll
    for (int j = 0; j < 4; ++j) acc[i][j] = 0.f;
  for (int k0 = 0; k0 < K; k0 += 16) {
#pragma unroll
    for (int i = 0; i < 4; ++i) { int e = tid + 256 * i; int m = e >> 4, k = e & 15; As[k][m] = A[(size_t)(m0 + m) * lda + k0 + k]; }
#pragma unroll
    for (int i = 0; i < 4; ++i) { int e = tid + 256 * i;
      if (!BT) { int k = e >> 6, n = e & 63; Bs[k][n] = (n0 + n < N) ? B[(size_t)(k0 + k) * ldb + n0 + n] : 0.f; }
      else     { int n = e >> 4, k = e & 15; Bs[k][n] = (n0 + n < N) ? B[(size_t)(n0 + n) * ldb + k0 + k] : 0.f; } }
    __syncthreads();
#pragma unroll
    for (int k = 0; k < 16; ++k) {
      float a[4], bb[4];
#pragma unroll
      for (int i = 0; i < 4; ++i) { a[i] = As[k][ty * 4 + i]; bb[i] = Bs[k][tx * 4 + i]; }
#pragma unroll
      for (int i = 0; i < 4; ++i)
#pragma unroll
        for (int j = 0; j < 4; ++j) acc[i][j] += a[i] * bb[j];
    }
    __syncthreads();
  }
#pragma unroll
  for (int i = 0; i < 4; ++i)
#pragma unroll
    for (int j = 0; j < 4; ++j) { int n = n0 + tx * 4 + j; if (n < N) C[(size_t)(m0 + ty * 4 + i) * ldc + n] = acc[i][j]; }
}

__global__ __launch_bounds__(256) void n_rms_slice(const float* __restrict__ in, int ldin, int off, int W, const float* __restrict__ g, float* __restrict__ out) {
  __shared__ float red[4];
  int t = blockIdx.x, tid = threadIdx.x;
  float v0 = (tid < W) ? in[(size_t)t * ldin + off + tid] : 0.f;
  float v1 = (tid + 256 < W) ? in[(size_t)t * ldin + off + tid + 256] : 0.f;
  float ss = block_sum256(v0 * v0 + v1 * v1, red);
  float rs = rsqrtf(ss / (float)W + EPS);
  if (tid < W) out[(size_t)t * W + tid] = v0 * rs * g[tid];
  if (tid + 256 < W) out[(size_t)t * W + tid + 256] = v1 * rs * g[tid + 256];
}

__global__ __launch_bounds__(256) void n_scatter(const float* __restrict__ proj, const float* __restrict__ qa, const float* __restrict__ kv, const int* __restrict__ positions, int b,
                                                 const float* __restrict__ wgf, const float* __restrict__ bgf, const float* __restrict__ wgb, const float* __restrict__ bgb,
                                                 bf16_t* __restrict__ Qm, bf16_t* __restrict__ Km, bf16_t* __restrict__ Vm, bf16_t* __restrict__ qg, bf16_t* __restrict__ kg, bf16_t* __restrict__ vg,
                                                 bf16_t* __restrict__ rg, float* __restrict__ laf, float* __restrict__ lab) {
  __shared__ float cs[32], sn[32];
  const int t = blockIdx.x, tid = threadIdx.x;
  const size_t tok = (size_t)b * SEQ + t;
  const float* pr = proj + (size_t)t * INW;
  const float* qr = qa + (size_t)t * 768;
  const float* kr = kv + (size_t)t * 1024;
  if (tid < 32) {
    float inv = powf(10000.f, -(float)tid / 32.f);
    float ang = (float)positions[tok] * inv;
    cs[tid] = cosf(ang); sn[tid] = sinf(ang);
  }
  __syncthreads();
  for (int e = tid; e < 4 * 192; e += 256) {
    int h = e / 192, d = e % 192; float v;
    if (d < 128) v = qr[h * 192 + d];
    else { int j = d - 128; const float* rp = qr + h * 192 + 128;
      if (j < 32) v = rp[j] * cs[j] - rp[j + 32] * sn[j]; else v = rp[j] * cs[j - 32] + rp[j - 32] * sn[j - 32]; }
    Qm[(((size_t)b * 4 + h) * SEQ + t) * 192 + d] = f2bf(v);
  }
  for (int e = tid; e < 4 * 192; e += 256) {
    int h = e / 192, d = e % 192; float v;
    if (d < 128) v = kr[h * 256 + d];
    else { int j = d - 128; const float* rp = pr + O_KR;
      if (j < 32) v = rp[j] * cs[j] - rp[j + 32] * sn[j]; else v = rp[j] * cs[j - 32] + rp[j - 32] * sn[j - 32]; }
    Km[(((size_t)b * 4 + h) * SEQ + t) * 192 + d] = f2bf(v);
  }
  for (int e = tid; e < 512; e += 256) { int h = e >> 7, d = e & 127; Vm[(((size_t)b * 4 + h) * SEQ + t) * 128 + d] = f2bf(kr[h * 256 + 128 + d]); }
  { int e = tid; qg[tok * 256 + e] = f2bf(pr[O_QG + e] * 0.125f); kg[tok * 256 + e] = f2bf(pr[O_KG + e]); }
  for (int e = tid; e < 512; e += 256) { vg[tok * 512 + e] = f2bf(pr[O_VG + e]); rg[tok * 512 + e] = f2bf(pr[O_R + e]); }
  { int cidx = tid; float af = bgf[cidx], ab = bgb[cidx];
#pragma unroll
    for (int r = 0; r < 16; ++r) { af += pr[O_GF + r] * wgf[r * 256 + cidx]; ab += pr[O_GB + r] * wgb[r * 256 + cidx]; }
    laf[tok * 256 + cidx] = logsigmoid_f(af) * (1.f / 16.f); lab[tok * 256 + cidx] = logsigmoid_f(ab) * (1.f / 16.f); }
}

__global__ __launch_bounds__(256) void n_attn(const bf16_t* __restrict__ Qm, const bf16_t* __restrict__ Km, const bf16_t* __restrict__ Vm, bf16_t* __restrict__ omla) {
  __shared__ float qs[192]; __shared__ float sc[2048]; __shared__ float red[4];
  const int i = blockIdx.x, h = blockIdx.y, b = blockIdx.z, tid = threadIdx.x;
  const size_t bh = (size_t)b * 4 + h;
  if (tid < 192) qs[tid] = bf2f(Qm[(bh * SEQ + i) * 192 + tid]);
  __syncthreads();
  float mx = -1e30f;
  for (int kk = 0; kk < 8; ++kk) {
    int key = tid + 256 * kk; const uint4* kr = (const uint4*)(Km + (bh * SEQ + key) * 192);
    float s = 0.f;
    for (int c = 0; c < 24; ++c) { uint4 w = kr[c]; const float* q = qs + c * 8;
      s += q[0] * __uint_as_float(w.x << 16) + q[1] * __uint_as_float(w.x & 0xffff0000u) + q[2] * __uint_as_float(w.y << 16) + q[3] * __uint_as_float(w.y & 0xffff0000u)
         + q[4] * __uint_as_float(w.z << 16) + q[5] * __uint_as_float(w.z & 0xffff0000u) + q[6] * __uint_as_float(w.w << 16) + q[7] * __uint_as_float(w.w & 0xffff0000u); }
    s *= 0.07216878364870322f; sc[key] = s; mx = fmaxf(mx, s);
  }
  mx = block_max256(mx, red);
  float sum = 0.f;
  for (int kk = 0; kk < 8; ++kk) { int key = tid + 256 * kk; float p = expf(sc[key] - mx); sc[key] = p; sum += p; }
  sum = block_sum256(sum, red);
  __syncthreads();
  if (tid < 128) { float o = 0.f; const bf16_t* vp = Vm + bh * SEQ * 128 + tid;
    for (int key = 0; key < SEQ; ++key) o += sc[key] * bf2f(vp[(size_t)key * 128]);
    omla[((size_t)b * SEQ + i) * 512 + h * 128 + tid] = f2bf(o / sum); }
}

__global__ __launch_bounds__(128) void n_gla(const bf16_t* __restrict__ qg, const bf16_t* __restrict__ kg, const bf16_t* __restrict__ vg, const bf16_t* __restrict__ laf, const bf16_t* __restrict__ lab, float* __restrict__ og) {
  __shared__ float qs[64], ks[64], as[64];
  const int bh = blockIdx.x, b = bh >> 2, h = bh & 3, dv = threadIdx.x;
  for (int dir = 0; dir < 2; ++dir) {
    float S[64];
#pragma unroll
    for (int d = 0; d < 64; ++d) S[d] = 0.f;
    const bf16_t* la = dir ? lab : laf;
    for (int s = 0; s < SEQ; ++s) {
      const int t = dir ? (SEQ - 1 - s) : s; const size_t tok = (size_t)b * SEQ + t;
      __syncthreads();
      if (dv < 64) { qs[dv] = bf2f(qg[tok * 256 + h * 64 + dv]); ks[dv] = bf2f(kg[tok * 256 + h * 64 + dv]); as[dv] = expf(bf2f(la[tok * 256 + h * 64 + dv])); }
      __syncthreads();
      const float v = bf2f(vg[tok * 512 + h * 128 + dv]); float o = 0.f;
#pragma unroll
      for (int d = 0; d < 64; ++d) { S[d] = as[d] * S[d] + ks[d] * v; o += qs[d] * S[d]; }
      if (dir == 0) og[tok * 512 + h * 128 + dv] = o; else og[tok * 512 + h * 128 + dv] += o;
    }
  }
}

__global__ __launch_bounds__(256) void n_mix(const bf16_t* __restrict__ omla, const float* __restrict__ og, const bf16_t* __restrict__ rg, const float* __restrict__ g_gla, int b, float* __restrict__ mix) {
  __shared__ float ssum[4];
  const int t = blockIdx.x, tid = threadIdx.x; const size_t tok = (size_t)b * SEQ + t;
  if (tid < 4) ssum[tid] = 0.f;
  __syncthreads();
  float v[2];
#pragma unroll
  for (int i = 0; i < 2; ++i) { int e = tid + 256 * i; v[i] = og[tok * 512 + e]; atomicAdd(&ssum[e >> 7], v[i] * v[i]); mix[(size_t)t * DM + e] = bf2f(omla[tok * 512 + e]); }
  __syncthreads();
#pragma unroll
  for (int i = 0; i < 2; ++i) { int e = tid + 256 * i; float rs = rsqrtf(ssum[e >> 7] * (1.f / 128.f) + EPS);
    mix[(size_t)t * DM + 512 + e] = v[i] * rs * g_gla[e & 127] * silu_f(bf2f(rg[tok * 512 + e])); }
}

__global__ __launch_bounds__(256) void n_post1(const float* __restrict__ x, const float* __restrict__ y, const float* __restrict__ g_post, const float* __restrict__ g_pre2, const float* __restrict__ mod, int b,
                                               float* __restrict__ out, float* __restrict__ h2) {
  __shared__ float red[4];
  const int t = blockIdx.x, tid = threadIdx.x; const size_t tok = (size_t)b * SEQ + t;
  float yv[4], xv[4]; float ss = 0.f;
#pragma unroll
  for (int i = 0; i < 4; ++i) { yv[i] = y[(size_t)t * DM + tid + 256 * i]; ss += yv[i] * yv[i]; }
  ss = block_sum256(ss, red);
  float rs = rsqrtf(ss * (1.f / DM) + EPS); float s2 = 0.f;
#pragma unroll
  for (int i = 0; i < 4; ++i) { int d = tid + 256 * i; xv[i] = x[tok * DM + d] + mod[b * 6144 + 2048 + d] * (yv[i] * rs * g_post[d]); out[tok * DM + d] = xv[i]; s2 += xv[i] * xv[i]; }
  s2 = block_sum256(s2, red);
  float r2 = rsqrtf(s2 * (1.f / DM) + EPS);
#pragma unroll
  for (int i = 0; i < 4; ++i) { int d = tid + 256 * i; h2[(size_t)t * DM + d] = xv[i] * r2 * g_pre2[d] * (1.f + mod[b * 6144 + 4096 + d]) + mod[b * 6144 + 3072 + d]; }
}

DI void wave_argmax(float& v, int& i) {
#pragma unroll
  for (int o = 1; o < 64; o <<= 1) { float ov = __shfl_xor(v, o); int oi = __shfl_xor(i, o); if (ov > v || (ov == v && oi < i)) { v = ov; i = oi; } }
}
__global__ __launch_bounds__(256) void n_peer_select(const float* __restrict__ qry, const float* __restrict__ sk1, const float* __restrict__ sk2, int* __restrict__ eidx, float* __restrict__ gate) {
  __shared__ float v1s[4][16], v2s[4][16]; __shared__ int i1s[4][16], i2s[4][16];
  const int w = threadIdx.x >> 6, lane = threadIdx.x & 63;
  const int pair = blockIdx.x * 4 + w;
  const int t = pair >> 3, h = pair & 7;
  const float* q1 = qry + (size_t)t * 2048 + h * 256; const float* q2 = q1 + 128;
  float s1a = 0.f, s1b = 0.f, s2a = 0.f, s2b = 0.f;
  for (int d = 0; d < 128; ++d) { float a = q1[d], bq = q2[d];
    s1a += a * sk1[lane * 128 + d]; s1b += a * sk1[(lane + 64) * 128 + d]; s2a += bq * sk2[lane * 128 + d]; s2b += bq * sk2[(lane + 64) * 128 + d]; }
  for (int side = 0; side < 2; ++side) {
    float va = side ? s2a : s1a, vb = side ? s2b : s1b; bool ta = false, tb = false;
    for (int k = 0; k < 16; ++k) {
      float bv; int bi;
      if (!ta && (tb || va >= vb)) { bv = va; bi = lane; } else if (!tb) { bv = vb; bi = lane + 64; } else { bv = -3e38f; bi = 1 << 20; }
      wave_argmax(bv, bi);
      if (bi == lane) ta = true; if (bi == lane + 64) tb = true;
      if (lane == 0) { if (side) { v2s[w][k] = bv; i2s[w][k] = bi; } else { v1s[w][k] = bv; i1s[w][k] = bi; } }
    }
  }
  __syncthreads();
  float cv[4]; bool tk[4];
#pragma unroll
  for (int j = 0; j < 4; ++j) { int c = lane + 64 * j; cv[j] = v1s[w][c >> 4] + v2s[w][c & 15]; tk[j] = false; }
  float topv = 0.f; int topc = 0; float mx = 0.f;
  for (int k = 0; k < 16; ++k) {
    float bv = -3e38f; int bi = 1 << 20;
#pragma unroll
    for (int j = 0; j < 4; ++j) { if (!tk[j] && cv[j] > bv) { bv = cv[j]; bi = lane + 64 * j; } }
    wave_argmax(bv, bi);
#pragma unroll
    for (int j = 0; j < 4; ++j) if (bi == lane + 64 * j) tk[j] = true;
    if (k == 0) mx = bv;
    if (lane == k) { topv = bv; topc = bi; }
  }
  float e = (lane < 16) ? expf(topv - mx) : 0.f;
  float sum = wave_sum(e);
  if (lane < 16) { eidx[(size_t)pair * 16 + lane] = i1s[w][topc >> 4] * 128 + i2s[w][topc & 15]; gate[(size_t)pair * 16 + lane] = e / sum; }
}

__global__ __launch_bounds__(256) void n_peer_apply(const float* __restrict__ h2, const int* __restrict__ eidx, const float* __restrict__ gate, const float* __restrict__ eu, const float* __restrict__ ev,
                                                    const float* __restrict__ g_post, const float* __restrict__ mod, int b, float* __restrict__ out) {
  __shared__ float ys[4][1024]; __shared__ float red[4];
  const int t = blockIdx.x, tid = threadIdx.x, w = tid >> 6, lane = tid & 63; const size_t tok = (size_t)b * SEQ + t;
  float4 hx[4];
#pragma unroll
  for (int i = 0; i < 4; ++i) hx[i] = *(const float4*)(h2 + (size_t)t * DM + (lane + 64 * i) * 4);
  float4 acc[4];
#pragma unroll
  for (int i = 0; i < 4; ++i) acc[i] = make_float4(0.f, 0.f, 0.f, 0.f);
  for (int k = w; k < 128; k += 4) {
    const int e = eidx[(size_t)t * 128 + k]; const float gt = gate[(size_t)t * 128 + k];
    const float4* ur = (const float4*)(eu + (size_t)e * DM); const float4* vr = (const float4*)(ev + (size_t)e * DM);
    float d = 0.f;
#pragma unroll
    for (int i = 0; i < 4; ++i) { float4 u = ur[lane + 64 * i]; d += u.x * hx[i].x + u.y * hx[i].y + u.z * hx[i].z + u.w * hx[i].w; }
    d = wave_sum(d);
    const float wgt = gt * gelu_erf(d);
#pragma unroll
    for (int i = 0; i < 4; ++i) { float4 v = vr[lane + 64 * i]; acc[i].x += wgt * v.x; acc[i].y += wgt * v.y; acc[i].z += wgt * v.z; acc[i].w += wgt * v.w; }
  }
#pragma unroll
  for (int i = 0; i < 4; ++i) *(float4*)(&ys[w][(lane + 64 * i) * 4]) = acc[i];
  __syncthreads();
  float yv[4]; float ss = 0.f;
#pragma unroll
  for (int i = 0; i < 4; ++i) { int d = tid + 256 * i; yv[i] = ys[0][d] + ys[1][d] + ys[2][d] + ys[3][d]; ss += yv[i] * yv[i]; }
  ss = block_sum256(ss, red);
  const float rs = rsqrtf(ss * (1.f / DM) + EPS);
#pragma unroll
  for (int i = 0; i < 4; ++i) { int d = tid + 256 * i; out[tok * DM + d] = out[tok * DM + d] + mod[b * 6144 + 5120 + d] * (yv[i] * rs * g_post[d]); }
}

typedef short bf16x8 __attribute__((ext_vector_type(8)));
typedef float f32x16 __attribute__((ext_vector_type(16)));
#define MFMA32(a, b, c) __builtin_amdgcn_mfma_f32_32x32x16_bf16((a), (b), (c), 0, 0, 0)

constexpr int NTHR = 512;
constexpr size_t MiB = 1024 * 1024;
constexpr size_t WS_MOD   = 0;
constexpr size_t WS_WTIN  = 256 * 1024;
constexpr size_t WS_WTQUP = WS_WTIN + (size_t)2304 * 1024 * 2;
constexpr size_t WS_WTKVUP = WS_WTQUP + (size_t)768 * 384 * 2;
constexpr size_t WS_WTOUT = WS_WTKVUP + (size_t)1024 * 256 * 2;
constexpr size_t WS_WTPQ  = WS_WTOUT + (size_t)1024 * 1024 * 2;
constexpr size_t WS_KD    = WS_WTPQ + (size_t)2048 * 1024 * 2;
constexpr size_t WS_DEC   = WS_KD + (size_t)256 * 256 * 2;
constexpr size_t WS_ESC   = WS_DEC + (size_t)2048 * 64 * 4;
constexpr size_t WS_R0END = WS_ESC + (size_t)2 * 16384 * 4;
static_assert(WS_R0END <= 13 * MiB, "R0");
constexpr size_t WS_QM   = 13 * MiB;
constexpr size_t WS_KM   = WS_QM + 24 * MiB;
constexpr size_t WS_VM   = WS_KM + 24 * MiB;
constexpr size_t WS_P1S  = WS_VM + 16 * MiB;
constexpr size_t WS_RG   = WS_P1S + 32 * MiB;
constexpr size_t WS_OINTRA = WS_RG + 16 * MiB;
constexpr size_t WS_QDEC = WS_OINTRA + 16 * MiB;
constexpr size_t WS_SPT  = WS_QDEC + 16 * MiB;
constexpr size_t WS_EU   = WS_SPT + 32 * MiB;
constexpr size_t WS_EV   = WS_EU + 16 * MiB;
constexpr size_t WS_END  = WS_EV + 16 * MiB;
static_assert(WS_P1S == WS_QM + 64 * MiB, "P3 QRY scratch aliases QM..VM");
constexpr size_t OUT_HS  = 0;
constexpr size_t OUT_CQ  = 32 * MiB;
constexpr size_t OUT_GR  = 52 * MiB;

struct KP { const float* in[25]; float* out; unsigned char* ws; int ph_lo, ph_hi; };

constexpr int G_STRIDE = 144;
constexpr int G_ABYTES = 64 * G_STRIDE;
constexpr int G_BBYTES = 256 * G_STRIDE;
constexpr int G_STAGE = G_ABYTES + G_BBYTES;
constexpr int LDS_GEMM = 2 * G_STAGE;
constexpr int LDS_TAB = LDS_GEMM;
constexpr int LDS_TOTAL = 157696;

DI unsigned pack2(float lo, float hi) { return (unsigned)f2bf(lo) | ((unsigned)f2bf(hi) << 16); }
DI int crow(int reg, int hh) { return (reg & 3) + 8 * (reg >> 2) + 4 * hh; }

template <class Epi>
DI void block_gemm(char* lds, const bf16_t* A, int lda, const bf16_t* Bt, int ldb, int nchunks, int K, Epi&& epi) {
  const int tid = threadIdx.x, lane = tid & 63, w = tid >> 6, wm = w >> 2, wn = w & 3, r = lane & 31, hh = lane >> 5;
  const int nk = K >> 6;
  const int srow = tid >> 3, skc = tid & 7;
  const int st_off = srow * G_STRIDE + skc * 16;
  const int a_rd = (wm * 32 + r) * G_STRIDE + hh * 16;
  const int b_rd = G_ABYTES + (wn * 64 + r) * G_STRIDE + hh * 16;
#define G_LOAD(R, tt) do { const int ko_ = (tt) * 64; R##a = *(const uint4*)(Ab + ko_); R##b0 = *(const uint4*)(Bb + ko_); R##b1 = *(const uint4*)(Bb + (size_t)64 * ldb + ko_); \
    R##b2 = *(const uint4*)(Bb + (size_t)128 * ldb + ko_); R##b3 = *(const uint4*)(Bb + (size_t)192 * ldb + ko_); } while (0)
#define G_WRITE(R, st) do { char* nb_ = lds + (st) * G_STAGE; *(uint4*)(nb_ + st_off) = R##a; *(uint4*)(nb_ + G_ABYTES + st_off) = R##b0; *(uint4*)(nb_ + G_ABYTES + 64 * G_STRIDE + st_off) = R##b1; \
    *(uint4*)(nb_ + G_ABYTES + 128 * G_STRIDE + st_off) = R##b2; *(uint4*)(nb_ + G_ABYTES + 192 * G_STRIDE + st_off) = R##b3; } while (0)
#define G_COMPUTE(st) do { const char* cur_ = lds + (st) * G_STAGE; _Pragma("unroll") for (int s_ = 0; s_ < 4; ++s_) { \
    const bf16x8 a_ = *(const bf16x8*)(cur_ + a_rd + s_ * 32); const bf16x8 b0_ = *(const bf16x8*)(cur_ + b_rd + s_ * 32); const bf16x8 b1_ = *(const bf16x8*)(cur_ + b_rd + 32 * G_STRIDE + s_ * 32); \
    acc0 = MFMA32(a_, b0_, acc0); acc1 = MFMA32(a_, b1_, acc1); } } while (0)
#pragma unroll 1
  for (int ch = 0; ch < nchunks; ++ch) {
    const bf16_t* Ab = A + (size_t)srow * lda + skc * 8;
    const bf16_t* Bb = Bt + (size_t)(ch * 256 + srow) * ldb + skc * 8;
    f32x16 acc0, acc1;
#pragma unroll
    for (int i = 0; i < 16; ++i) { acc0[i] = 0.f; acc1[i] = 0.f; }
    const uint4 z4_ = make_uint4(0u, 0u, 0u, 0u);
    uint4 R0a = z4_, R0b0 = z4_, R0b1 = z4_, R0b2 = z4_, R0b3 = z4_, R1a = z4_, R1b0 = z4_, R1b1 = z4_, R1b2 = z4_, R1b3 = z4_, R2a = z4_, R2b0 = z4_, R2b1 = z4_, R2b2 = z4_, R2b3 = z4_;
    G_LOAD(R0, 0); if (nk > 1) G_LOAD(R1, 1); if (nk > 2) G_LOAD(R2, 2);
    G_WRITE(R0, 0);
    __syncthreads();
    for (int t = 0; t < nk; t += 3) {
      if (t + 3 < nk) G_LOAD(R0, t + 3);
      G_COMPUTE(t & 1);
      if (t + 1 < nk) G_WRITE(R1, (t + 1) & 1);
      __syncthreads();
      if (t + 1 >= nk) break;
      if (t + 4 < nk) G_LOAD(R1, t + 4);
      G_COMPUTE((t + 1) & 1);
      if (t + 2 < nk) G_WRITE(R2, (t + 2) & 1);
      __syncthreads();
      if (t + 2 >= nk) break;
      if (t + 5 < nk) G_LOAD(R2, t + 5);
      G_COMPUTE((t + 2) & 1);
      if (t + 3 < nk) G_WRITE(R0, (t + 3) & 1);
      __syncthreads();
    }
    epi(wm * 32, ch * 256 + wn * 64, acc0, acc1);
    __syncthreads();
  }
#undef G_LOAD
#undef G_WRITE
#undef G_COMPUTE
}

DI void p0_transpose(char* lds, const float* __restrict__ W, int K, int N, bf16_t* __restrict__ Wt, int item) {
  float* s = (float*)lds;
  const int tid = threadIdx.x;
  const int ntn = (N + 63) >> 6, kt = item / ntn, nt = item % ntn, k0 = kt * 64, n0 = nt * 64;
  __syncthreads();
#pragma unroll
  for (int i = 0; i < 8; ++i) { int e = tid + 512 * i; int kk = e >> 6, nn = e & 63; s[kk * 65 + nn] = (n0 + nn < N) ? W[(size_t)(k0 + kk) * N + n0 + nn] : 0.f; }
  __syncthreads();
  const int nn = tid >> 3, part = tid & 7;
  const float* sp = s + (part * 8) * 65 + nn;
  uint4 o; o.x = pack2(sp[0], sp[65]); o.y = pack2(sp[2 * 65], sp[3 * 65]); o.z = pack2(sp[4 * 65], sp[5 * 65]); o.w = pack2(sp[6 * 65], sp[7 * 65]);
  *(uint4*)(Wt + (size_t)(n0 + nn) * K + k0 + part * 8) = o;
}

DI void phase0(const KP& p, char* lds) {
  const int tid = threadIdx.x, bid = blockIdx.x, nb = gridDim.x;
  unsigned char* ws = p.ws;
  constexpr int I_IN = 16 * 36, I_QUP = 6 * 12, I_KVUP = 4 * 16, I_OUT = 16 * 16, I_PQ = 16 * 32;
  constexpr int I_ALL = I_IN + I_QUP + I_KVUP + I_OUT + I_PQ;
  for (int it = bid; it < I_ALL; it += nb) {
    int q = it;
    if (q < I_IN) { p0_transpose(lds, p.in[7], 1024, 2272, (bf16_t*)(ws + WS_WTIN), q); continue; } q -= I_IN;
    if (q < I_QUP) { p0_transpose(lds, p.in[9], 384, 768, (bf16_t*)(ws + WS_WTQUP), q); continue; } q -= I_QUP;
    if (q < I_KVUP) { p0_transpose(lds, p.in[11], 256, 1024, (bf16_t*)(ws + WS_WTKVUP), q); continue; } q -= I_KVUP;
    if (q < I_OUT) { p0_transpose(lds, p.in[17], 1024, 1024, (bf16_t*)(ws + WS_WTOUT), q); continue; } q -= I_OUT;
    p0_transpose(lds, p.in[20], 1024, 2048, (bf16_t*)(ws + WS_WTPQ), q);
  }
  { bf16_t* kd = (bf16_t*)(ws + WS_KD);
    for (int e = bid * NTHR + tid; e < 65536; e += nb * NTHR) { int n = e >> 8, k = e & 255; float v = 0.f;
      if (n < 128 && k < 128) v = p.in[21][n * 128 + k]; else if (n >= 128 && k >= 128) v = p.in[22][(n - 128) * 128 + (k - 128)];
      kd[e] = f2bf(v); } }
  { const int lane = tid & 63; float* scl = (float*)(ws + WS_ESC);
    for (int row = bid * 8 + (tid >> 6); row < 32768; row += nb * 8) { const int t = row >> 14, e = row & 16383;
      const float* src = p.in[23 + t] + (size_t)e * 1024 + lane * 16;
      float4 x[4]; float am = 0.f;
#pragma unroll
      for (int i = 0; i < 4; ++i) { x[i] = *(const float4*)(src + 4 * i); am = fmaxf(am, fmaxf(fmaxf(fabsf(x[i].x), fabsf(x[i].y)), fmaxf(fabsf(x[i].z), fabsf(x[i].w)))); }
      am = wave_max(am);
      float sc = 1.f, isc = 1.f;
      if (am > 0.f) { int ex; (void)frexpf(448.f / am, &ex); sc = ldexpf(1.f, ex - 1); isc = ldexpf(1.f, 1 - ex); }
      unsigned wv[4];
#pragma unroll
      for (int i = 0; i < 4; ++i) { int q = __builtin_amdgcn_cvt_pk_fp8_f32(x[i].x * sc, x[i].y * sc, 0, false); q = __builtin_amdgcn_cvt_pk_fp8_f32(x[i].z * sc, x[i].w * sc, q, true); wv[i] = (unsigned)q; }
      *(uint4*)(ws + (t ? WS_EV : WS_EU) + (size_t)e * 1024 + lane * 16) = make_uint4(wv[0], wv[1], wv[2], wv[3]);
      if (lane == 0) scl[t * 16384 + e] = isc; } }
  for (int jb = bid; jb < 96; jb += nb) {
    __syncthreads();
    float* cact = (float*)lds;
    float* red = (float*)(lds + 32768);
    for (int e = tid; e < 8192; e += NTHR) cact[e] = silu_f(p.in[1][e]);
    __syncthreads();
    const int jj = tid & 63, ks = tid >> 6, j0 = jb * 64;
    float acc[8];
#pragma unroll
    for (int b = 0; b < 8; ++b) acc[b] = 0.f;
    const float* wp = p.in[3] + (size_t)(ks * 128) * 6144 + j0 + jj;
    for (int k = 0; k < 128; ++k) { const float wv = wp[(size_t)k * 6144];
#pragma unroll
      for (int b = 0; b < 8; ++b) acc[b] += cact[b * 1024 + ks * 128 + k] * wv; }
#pragma unroll
    for (int b = 0; b < 8; ++b) red[(ks * 64 + jj) * 8 + b] = acc[b];
    __syncthreads();
    { const int b = tid >> 6; float sacc = p.in[4][j0 + jj];
#pragma unroll
      for (int k2 = 0; k2 < 8; ++k2) sacc += red[(k2 * 64 + jj) * 8 + b];
      ((float*)(ws + WS_MOD))[b * 6144 + j0 + jj] = sacc; }
  }
}

constexpr int WT_STRIDE = 144, WT_BYTES = 32 * WT_STRIDE;
DI void wt_write(char* wl, const f32x16& a0, const f32x16& a1, int r, int hh, float scale) {
  char* bp = wl + (4 * hh) * WT_STRIDE + r * 2;
#pragma unroll
  for (int reg = 0; reg < 16; ++reg) { const int ro = ((reg & 3) + 8 * (reg >> 2)) * WT_STRIDE;
    *(bf16_t*)(bp + ro) = f2bf(a0[reg] * scale); *(bf16_t*)(bp + ro + 64) = f2bf(a1[reg] * scale); }
}
DI void wt_write_rope(char* wl, const f32x16& a0, const f32x16& a1, int r, int hh, const float* cs, const float* sn, int m0) {
  char* bp = wl + (4 * hh) * WT_STRIDE + r * 2;
#pragma unroll
  for (int reg = 0; reg < 16; ++reg) { const int rw = (reg & 3) + 8 * (reg >> 2); const int row = m0 + rw + 4 * hh;
    const float c = cs[row * 32 + r], s = sn[row * 32 + r];
    *(bf16_t*)(bp + rw * WT_STRIDE) = f2bf(a0[reg] * c - a1[reg] * s); *(bf16_t*)(bp + rw * WT_STRIDE + 64) = f2bf(a1[reg] * c + a0[reg] * s); }
}
DI void wt_store(const char* wl, int lane, bf16_t* dA, int sA, bf16_t* dB, int sB) {
  const int piece = lane & 7, rsub = lane >> 3;
  bf16_t* d = (piece < 4) ? dA : dB; const int st = (piece < 4) ? sA : sB;
  if (d) {
#pragma unroll
    for (int i = 0; i < 4; ++i) { const int row = i * 8 + rsub; const uint4 v = *(const uint4*)(wl + row * WT_STRIDE + piece * 16);
      *(uint4*)(d + (size_t)row * st + (piece & 3) * 8) = v; }
  }
}
#define LDS_FENCE() asm volatile("s_waitcnt lgkmcnt(0)" ::: "memory")
DI int lv(int x) { asm volatile("" : "+v"(x)); return x; }
template <class T> DI T* launder(T* q) { size_t z = 0; asm volatile("" : "+s"(z)); return (T*)((char*)q + z); }

constexpr int GL_GR = 0, GL_VT = 8192, GL_QD = 26624, GL_KI = 45056, GL_KIT = 63488, GL_ATT = 81920, GL_TOT = 91136, GL_DEC = 93184, GL_LA = 93696  ;
DI void gla_chunk_local(const KP& p, char* lds, unsigned char* ws, int tile, const bf16_t* qg, const bf16_t* kg, const bf16_t* vg, const bf16_t* GR) {
  const int tid = lv(threadIdx.x), lane = tid & 63, w = tid >> 6, r = lane & 31, hh = lane >> 5;
  const int b = tile >> 5, n = tile & 31, tok0 = tile * 64;
  float* GRL = (float*)(lds + GL_GR); float* TOT = (float*)(lds + GL_TOT); float* DECL = (float*)(lds + GL_DEC);
  __syncthreads();
#pragma unroll
  for (int i = 0; i < 4; ++i) GRL[tid + 512 * i] = bf2f(GR[tid + 512 * i]);
#pragma unroll 1
  for (int h = 0; h < 4; ++h) {
    __syncthreads();
#pragma unroll
    for (int i = 0; i < 2; ++i) { const int c = tid + 512 * i, t = c >> 4, d8 = (c & 15) * 8;
      const uint4 v = *(const uint4*)(vg + (size_t)t * 512 + h * 128 + d8);
      bf16_t* vt = (bf16_t*)(lds + GL_VT) + d8 * 72 + t;
      vt[0] = (bf16_t)(v.x & 0xffffu); vt[72] = (bf16_t)(v.x >> 16); vt[144] = (bf16_t)(v.y & 0xffffu); vt[216] = (bf16_t)(v.y >> 16);
      vt[288] = (bf16_t)(v.z & 0xffffu); vt[360] = (bf16_t)(v.z >> 16); vt[432] = (bf16_t)(v.w & 0xffffu); vt[504] = (bf16_t)(v.w >> 16); }
    const int dir = tid >> 8, qt = (tid >> 6) & 3, dk = tid & 63, col = h * 64 + dk;
    float* LAL = (float*)(lds + GL_LA) + tid;
    {
      const float* wg = launder(dir ? p.in[14] : p.in[12]); const float* bg = launder(dir ? p.in[15] : p.in[13]);
      float wr[16];
#pragma unroll
      for (int q = 0; q < 16; ++q) wr[q] = wg[q * 256 + col];
      const float bias = bg[col];
      float run = 0.f;
#pragma unroll 2
      for (int ii = 0; ii < 16; ++ii) { const int i = dir ? 15 - ii : ii;
        const float* gp = GRL + (qt * 16 + i) * 32 + dir * 16; float x = bias;
#pragma unroll
        for (int q = 0; q < 16; ++q) x += gp[q] * wr[q];
        run += logsigmoid_f(x) * (1.f / 16.f); LAL[i * 512] = run; }
      TOT[(dir * 64 + dk) * 4 + qt] = run;
    }
    __syncthreads();
    {
      const float4 tq = *(const float4*)(TOT + (dir * 64 + dk) * 4);
      const float total = (tq.x + tq.y) + (tq.z + tq.w);
      float off;
      if (dir == 0) off = (qt > 0 ? tq.x : 0.f) + (qt > 1 ? tq.y : 0.f) + (qt > 2 ? tq.z : 0.f);
      else          off = (qt < 1 ? tq.y : 0.f) + (qt < 2 ? tq.z : 0.f) + (qt < 3 ? tq.w : 0.f);
      if (qt == 0) { const float dc = expf(total); DECL[dir * 64 + dk] = dc; ((float*)(ws + WS_DEC))[((size_t)((b * 4 + h) * 2 + dir) * 32 + n) * 64 + dk] = dc; }
      bf16_t* QD = (bf16_t*)(lds + GL_QD + dir * 9216) + (qt * 16) * 72 + dk; bf16_t* KI = (bf16_t*)(lds + GL_KI + dir * 9216) + (qt * 16) * 72 + dk;
      bf16_t* KIT = (bf16_t*)(lds + GL_KIT + dir * 9216) + dk * 72 + qt * 16;
      bf16_t* qdg = (bf16_t*)(ws + WS_QDEC) + (size_t)((tile * 4 + h) * 2 + dir) * 4096 + (qt * 16) * 64 + dk;
      const bf16_t* qgp = qg + (size_t)(qt * 16) * 256 + col; const bf16_t* kgp = kg + (size_t)(qt * 16) * 256 + col;
#pragma unroll 2
      for (int i = 0; i < 16; ++i) { const float bb = off + LAL[i * 512];
        const float qv = bf2f(qgp[i * 256]), kv = bf2f(kgp[i * 256]);
        const bf16_t qd = f2bf(qv * expf(bb)), ki = f2bf(kv * expf(-bb));
        QD[i * 72] = qd; KI[i * 72] = ki; qdg[i * 64] = qd; KIT[i] = ki; }
    }
    __syncthreads();
    if (w < 4) { const int mi = w >> 1, ni = w & 1;
      f32x16 asum;
#pragma unroll
      for (int i = 0; i < 16; ++i) asum[i] = 0.f;
#pragma unroll
      for (int d = 0; d < 2; ++d) { f32x16 acc;
#pragma unroll
        for (int i = 0; i < 16; ++i) acc[i] = 0.f;
#pragma unroll
        for (int s = 0; s < 4; ++s) { const bf16x8 a = *(const bf16x8*)(lds + GL_QD + d * 9216 + (mi * 32 + r) * 144 + s * 32 + hh * 16);
          const bf16x8 bb = *(const bf16x8*)(lds + GL_KI + d * 9216 + (ni * 32 + r) * 144 + s * 32 + hh * 16); acc = MFMA32(a, bb, acc); }
#pragma unroll
        for (int reg = 0; reg < 16; ++reg) { const int ti = mi * 32 + crow(reg, hh), tj = ni * 32 + r; const bool keep = d ? (tj >= ti) : (tj <= ti); asum[reg] += keep ? acc[reg] : 0.f; } }
      bf16_t* at = (bf16_t*)(lds + GL_ATT) + (mi * 32 + 4 * hh) * 72 + ni * 32 + r;
#pragma unroll
      for (int reg = 0; reg < 16; ++reg) at[((reg & 3) + 8 * (reg >> 2)) * 72] = f2bf(asum[reg]);
    }
    __syncthreads();
    { const int mi = w >> 2, ni = w & 3; f32x16 acc;
#pragma unroll
      for (int i = 0; i < 16; ++i) acc[i] = 0.f;
#pragma unroll
      for (int s = 0; s < 4; ++s) { const bf16x8 a = *(const bf16x8*)(lds + GL_ATT + (mi * 32 + r) * 144 + s * 32 + hh * 16);
        const bf16x8 bb = *(const bf16x8*)(lds + GL_VT + (ni * 32 + r) * 144 + s * 32 + hh * 16); acc = MFMA32(a, bb, acc); }
      bf16_t* oi = (bf16_t*)(ws + WS_OINTRA) + (size_t)(tok0 + mi * 32 + 4 * hh) * 512 + h * 128 + ni * 32 + r;
#pragma unroll
      for (int reg = 0; reg < 16; ++reg) oi[(size_t)((reg & 3) + 8 * (reg >> 2)) * 512] = f2bf(acc[reg]); }
    { const int dvb = w >> 1, dkb = w & 1;
#pragma unroll
      for (int d = 0; d < 2; ++d) { f32x16 acc;
#pragma unroll
        for (int i = 0; i < 16; ++i) acc[i] = 0.f;
#pragma unroll
        for (int s = 0; s < 4; ++s) { const bf16x8 a = *(const bf16x8*)(lds + GL_VT + (dvb * 32 + r) * 144 + s * 32 + hh * 16);
          const bf16x8 bb = *(const bf16x8*)(lds + GL_KIT + d * 9216 + (dkb * 32 + r) * 144 + s * 32 + hh * 16); acc = MFMA32(a, bb, acc); }
        const float sc = DECL[d * 64 + dkb * 32 + r];
        bf16_t* ds = (bf16_t*)(ws + WS_SPT) + ((size_t)((b * 4 + h) * 2 + d) * 32 + n) * 8192 + (size_t)(dvb * 32 + 4 * hh) * 64 + dkb * 32 + r;
#pragma unroll
        for (int reg = 0; reg < 16; ++reg) ds[((reg & 3) + 8 * (reg >> 2)) * 64] = f2bf(acc[reg] * sc); } }
  }
}

DI void phase1(const KP& p, char* lds) {
  const int tid = threadIdx.x, lane = tid & 63, w = tid >> 6, r = lane & 31, hh = lane >> 5;
  float* cs = (float*)(lds + LDS_TAB); float* sn = cs + 2048;
  char* wl = lds + w * WT_BYTES;
  for (int tile = blockIdx.x; tile < 256; tile += gridDim.x) {
    unsigned char* ws = launder(p.ws); unsigned char* ob = (unsigned char*)launder(p.out); const float* xin = launder(p.in[0]);
    const float* mod = (const float*)(ws + WS_MOD);
    const int tok0 = tile * 64, b = tile >> 5, t0 = (tile & 31) * 64;
    bf16_t* Hs = (bf16_t*)(ob + OUT_HS) + (size_t)tok0 * 1024;
    bf16_t* CQ = (bf16_t*)(ob + OUT_CQ) + (size_t)tok0 * 640;
    bf16_t* CQN = Hs; bf16_t* CKVN = Hs + 64 * 384;
    bf16_t* GR = (bf16_t*)(ob + OUT_GR) + (size_t)tok0 * 32;
    bf16_t* Qm = (bf16_t*)(ws + WS_QM); bf16_t* Km = (bf16_t*)(ws + WS_KM); bf16_t* Vm = (bf16_t*)(ws + WS_VM);
    bf16_t* qg = (bf16_t*)(ws + WS_P1S + (size_t)tile * 131072); bf16_t* kg = qg + 64 * 256; bf16_t* vg = qg + 2 * 64 * 256;
    bf16_t* rg = (bf16_t*)(ws + WS_RG) + (size_t)tok0 * 512;
    __syncthreads();
#pragma unroll
    for (int i = 0; i < 4; ++i) { const int e = tid + 512 * i, tt = e >> 5, j = e & 31;
      const float inv = powf(10000.f, -(float)j * (1.f / 32.f)); const float ang = (float)((const int*)p.in[2])[tok0 + tt] * inv;
      cs[e] = cosf(ang); sn[e] = sinf(ang); }
    {
      float4 ge[4], sh[4];
      const float* gpre = launder(p.in[5]); const float* modb = launder(mod) + b * 6144;
#pragma unroll
      for (int i = 0; i < 4; ++i) { const int d = (lane + 64 * i) * 4;
        const float4 g = *(const float4*)(gpre + d); const float4 sc = *(const float4*)(modb + 1024 + d); sh[i] = *(const float4*)(modb + d);
        ge[i] = make_float4(g.x * (1.f + sc.x), g.y * (1.f + sc.y), g.z * (1.f + sc.z), g.w * (1.f + sc.w)); }
      for (int rr = 0; rr < 8; ++rr) { const int row = w * 8 + rr;
        const float* xr = xin + (size_t)(tok0 + row) * 1024;
        float4 v[4]; float ss = 0.f;
#pragma unroll
        for (int i = 0; i < 4; ++i) { v[i] = *(const float4*)(xr + (lane + 64 * i) * 4); ss += v[i].x * v[i].x + v[i].y * v[i].y + v[i].z * v[i].z + v[i].w * v[i].w; }
        ss = wave_sum(ss); const float rs = rsqrtf(ss * (1.f / 1024.f) + EPS);
#pragma unroll
        for (int i = 0; i < 4; ++i) { uint2 o; o.x = pack2(v[i].x * rs * ge[i].x + sh[i].x, v[i].y * rs * ge[i].y + sh[i].y); o.y = pack2(v[i].z * rs * ge[i].z + sh[i].z, v[i].w * rs * ge[i].w + sh[i].w);
          *(uint2*)(Hs + (size_t)row * 1024 + (lane + 64 * i) * 4) = o; }
      }
    }
    __syncthreads();
    block_gemm(lds, Hs, 1024, (const bf16_t*)(ws + WS_WTIN), 1024, 9, 1024, [&](int m0, int n0, const f32x16& a0, const f32x16& a1) {
      const int r2 = lv(r), h2 = lv(hh), ln = lv(lane);
      if (n0 == O_KR) {
        wt_write_rope(wl, a0, a1, r2, h2, cs, sn, m0); LDS_FENCE();
        for (int h = 0; h < 4; ++h) { bf16_t* kp = Km + (((size_t)b * 4 + h) * SEQ + t0 + m0) * 192 + 128; wt_store(wl, ln, kp, 192, kp + 32, 192); }
        return; }
      wt_write(wl, a0, a1, r2, h2, (n0 >= O_QG && n0 < O_KG) ? 0.125f : 1.f); LDS_FENCE();
      bf16_t* d[2]; int st[2];
#pragma unroll
      for (int half = 0; half < 2; ++half) { const int nb = n0 + 32 * half;
        if (nb < 640) { d[half] = CQ + (size_t)m0 * 640 + nb; st[half] = 640; }
        else if (nb < O_KG) { d[half] = qg + (size_t)m0 * 256 + (nb - O_QG); st[half] = 256; }
        else if (nb < O_VG) { d[half] = kg + (size_t)m0 * 256 + (nb - O_KG); st[half] = 256; }
        else if (nb < O_GF) { d[half] = vg + (size_t)m0 * 512 + (nb - O_VG); st[half] = 512; }
        else if (nb < O_R) { d[half] = GR + (size_t)m0 * 32; st[half] = 32; }
        else if (nb < INW) { d[half] = rg + (size_t)m0 * 512 + (nb - O_R); st[half] = 512; }
        else { d[half] = nullptr; st[half] = 0; } }
      wt_store(wl, ln, d[0], st[0], d[1], st[1]);
    });
    __syncthreads();
    const float* gq = launder(p.in[8]); const float* gkv = launder(p.in[10]);
    for (int rr = 0; rr < 8; ++rr) { const int row = w * 8 + rr; const bf16_t* cr = CQ + (size_t)row * 640;
      float v[6]; float ss = 0.f;
#pragma unroll
      for (int i = 0; i < 6; ++i) { v[i] = bf2f(cr[lane + 64 * i]); ss += v[i] * v[i]; }
      ss = wave_sum(ss); float rs = rsqrtf(ss * (1.f / 384.f) + EPS);
#pragma unroll
      for (int i = 0; i < 6; ++i) CQN[(size_t)row * 384 + lane + 64 * i] = f2bf(v[i] * rs * gq[lane + 64 * i]);
      float u[4]; float s2 = 0.f;
#pragma unroll
      for (int i = 0; i < 4; ++i) { u[i] = bf2f(cr[384 + lane + 64 * i]); s2 += u[i] * u[i]; }
      s2 = wave_sum(s2); rs = rsqrtf(s2 * (1.f / 256.f) + EPS);
#pragma unroll
      for (int i = 0; i < 4; ++i) CKVN[(size_t)row * 256 + lane + 64 * i] = f2bf(u[i] * rs * gkv[lane + 64 * i]);
    }
    __syncthreads();
    block_gemm(lds, CQN, 384, (const bf16_t*)(ws + WS_WTQUP), 384, 3, 384, [&](int m0, int n0, const f32x16& a0, const f32x16& a1) {
      const int r2 = lv(r), h2 = lv(hh), ln = lv(lane);
      const int h = n0 / 192, d0 = n0 % 192;
      bf16_t* qp = Qm + (((size_t)b * 4 + h) * SEQ + t0 + m0) * 192 + d0;
      if (d0 < 128) wt_write(wl, a0, a1, r2, h2, 1.f); else wt_write_rope(wl, a0, a1, r2, h2, cs, sn, m0);
      LDS_FENCE();
      wt_store(wl, ln, qp, 192, qp + 32, 192);
    });
    block_gemm(lds, CKVN, 256, (const bf16_t*)(ws + WS_WTKVUP), 256, 4, 256, [&](int m0, int n0, const f32x16& a0, const f32x16& a1) {
      const int r2 = lv(r), h2 = lv(hh), ln = lv(lane);
      const int h = n0 >> 8, d0 = n0 & 255;
      wt_write(wl, a0, a1, r2, h2, 1.f); LDS_FENCE();
      if (d0 < 128) { bf16_t* kp = Km + (((size_t)b * 4 + h) * SEQ + t0 + m0) * 192 + d0; wt_store(wl, ln, kp, 192, kp + 32, 192); }
      else { bf16_t* vp = Vm + (((size_t)b * 4 + h) * SEQ + t0 + m0) * 128 + (d0 - 128); wt_store(wl, ln, vp, 128, vp + 32, 128); }
    });
    gla_chunk_local(p, lds, ws, tile, qg, kg, vg, GR);
  }
}

namespace att {
typedef short s16x4 __attribute__((ext_vector_type(4)));
typedef unsigned u32x4 __attribute__((ext_vector_type(4)));
constexpr int DQ = 192, DV = 128, KVBLK = 64;
constexpr float SCALE = 0.07216878364870322f;
constexpr float THR = 8.f;
constexpr int SHM_V = KVBLK * DV * 2, SHM_K = KVBLK * DQ * 2;
constexpr int SHM_QR = 8 * 32 * 176;
constexpr int SHM_ATTN = 2 * SHM_V + 2 * SHM_K + 8 * 64 * 4 + SHM_QR;
#define KSWZ(row, colB) ((row) * 384 + ((colB) ^ (((row) & 7) << 4)))
#define SBAR() __builtin_amdgcn_sched_barrier(0)
DI unsigned cvtpk(float lo, float hi) { unsigned r; asm volatile("v_cvt_pk_bf16_f32 %0, %1, %2" : "=v"(r) : "v"(lo), "v"(hi)); return r; }

DI void partialSM(f32x16& p0, f32x16& p1, float& m_reg, float& mn, float& alpha) {
  constexpr float C = SCALE * 1.4426950408889634f;
  float pmax = p0[0];
#pragma unroll
  for (int r = 1; r < 16; ++r) pmax = fmaxf(pmax, p0[r]);
#pragma unroll
  for (int r = 0; r < 16; ++r) pmax = fmaxf(pmax, p1[r]);
  { auto rr = __builtin_amdgcn_permlane32_swap(__float_as_uint(pmax), __float_as_uint(pmax), false, false);
    pmax = fmaxf(__uint_as_float(rr[0]), __uint_as_float(rr[1])); }
  if (__builtin_expect(__all(pmax - m_reg <= THR / SCALE), 1)) { mn = m_reg; alpha = 1.f; }
  else { mn = fmaxf(m_reg, pmax); alpha = __builtin_amdgcn_exp2f((m_reg - mn) * C); m_reg = mn; }
  const float mnC = -mn * C;
#pragma unroll
  for (int r = 0; r < 16; ++r) p0[r] = fmaf(p0[r], C, mnC);
#pragma unroll
  for (int r = 0; r < 16; ++r) p1[r] = fmaf(p1[r], C, mnC);
#pragma unroll
  for (int r = 0; r < 16; ++r) p0[r] = __builtin_amdgcn_exp2f(p0[r]);
}
DI void finishSM(f32x16& p0, f32x16& p1, float alpha, float& l_reg, bf16x8& pa0, bf16x8& pa1, bf16x8& pa2, bf16x8& pa3) {
#pragma unroll
  for (int r = 0; r < 16; ++r) p1[r] = __builtin_amdgcn_exp2f(p1[r]);
  float ps = 0;
#pragma unroll
  for (int r = 0; r < 16; ++r) ps += p0[r];
#pragma unroll
  for (int r = 0; r < 16; ++r) ps += p1[r];
  { auto rr = __builtin_amdgcn_permlane32_swap(__float_as_uint(ps), __float_as_uint(ps), false, false);
    ps = __uint_as_float(rr[0]) + __uint_as_float(rr[1]); }
  l_reg = l_reg * alpha + ps;
#define PK4(P, BASE, OUT) do { unsigned a0 = cvtpk(P[BASE + 0], P[BASE + 1]), a1 = cvtpk(P[BASE + 2], P[BASE + 3]);   \
    unsigned b0 = cvtpk(P[BASE + 4], P[BASE + 5]), b1 = cvtpk(P[BASE + 6], P[BASE + 7]);                              \
    auto r0 = __builtin_amdgcn_permlane32_swap(a0, b0, false, false); auto r1 = __builtin_amdgcn_permlane32_swap(a1, b1, false, false); \
    u32x4 wv = {r0[0], r1[0], r0[1], r1[1]}; OUT = *reinterpret_cast<bf16x8*>(&wv); } while (0)
  PK4(p0, 0, pa0); PK4(p0, 8, pa1); PK4(p1, 0, pa2); PK4(p1, 8, pa3);
#undef PK4
}
DI void qkt(f32x16& p0, f32x16& p1, const char* Ks, const bf16x8* qr, const char* qrl, int r32, int hi) {
#pragma unroll
  for (int i = 0; i < 16; ++i) { p0[i] = 0.f; p1[i] = 0.f; }
#pragma unroll
  for (int d0 = 0; d0 < 12; ++d0) { const int cb = (d0 * 16 + hi * 8) * 2;
    const bf16x8 b0 = *reinterpret_cast<const bf16x8*>(Ks + KSWZ(r32, cb));
    const bf16x8 b1 = *reinterpret_cast<const bf16x8*>(Ks + KSWZ(32 + r32, cb));
    const bf16x8 q = (d0 < 7) ? qr[d0 < 7 ? d0 : 0] : *reinterpret_cast<const bf16x8*>(qrl + (d0 - 7) * 32);
    p0 = MFMA32(b0, q, p0);
    p1 = MFMA32(b1, q, p1); }
}
DI int v_st(int k, int c) { const int kk = (k & ~0xC) | ((k & 4) << 1) | ((k & 8) >> 1); return ((kk >> 3) * 4 + (c >> 5)) * 512 + ((kk & 7) * 32 + (c & 31)) * 2; }
DI int v_rd_base(int lane) { return ((lane & 3) << 3) | (((lane >> 2) & 3) << 6) | (((lane >> 4) & 1) << 5) | (((lane >> 5) & 1) << 8); }
constexpr int v_rd_off(int d0, int ks, int half) { return d0 * 512 + ks * 4096 + half * 2048; }
template <int OFF> DI s16x4 tr_read(int vb) { s16x4 r; asm volatile("ds_read_b64_tr_b16 %0, %1 offset:%2" : "=&v"(r) : "v"(vb), "i"(OFF) : "memory"); return r; }
template <int D0> DI void pv_one(f32x16& od, int vb, bf16x8 pa0, bf16x8 pa1, bf16x8 pa2, bf16x8 pa3) {
  const s16x4 l0 = tr_read<v_rd_off(D0, 0, 0)>(vb), h0 = tr_read<v_rd_off(D0, 0, 1)>(vb), l1 = tr_read<v_rd_off(D0, 1, 0)>(vb), h1 = tr_read<v_rd_off(D0, 1, 1)>(vb);
  const s16x4 l2 = tr_read<v_rd_off(D0, 2, 0)>(vb), h2 = tr_read<v_rd_off(D0, 2, 1)>(vb), l3 = tr_read<v_rd_off(D0, 3, 0)>(vb), h3 = tr_read<v_rd_off(D0, 3, 1)>(vb);
  asm volatile("s_waitcnt lgkmcnt(0)" ::: "memory"); SBAR();
#define PK(L, H) (bf16x8){L[0], L[1], L[2], L[3], H[0], H[1], H[2], H[3]}
  od = MFMA32(pa0, PK(l0, h0), od);
  od = MFMA32(pa1, PK(l1, h1), od);
  od = MFMA32(pa2, PK(l2, h2), od);
  od = MFMA32(pa3, PK(l3, h3), od);
#undef PK
}
DI void pv_d0(f32x16* o, int vb, bf16x8 pa0, bf16x8 pa1, bf16x8 pa2, bf16x8 pa3) {
  pv_one<0>(o[0], vb, pa0, pa1, pa2, pa3); pv_one<1>(o[1], vb, pa0, pa1, pa2, pa3); pv_one<2>(o[2], vb, pa0, pa1, pa2, pa3); pv_one<3>(o[3], vb, pa0, pa1, pa2, pa3);
}
DI void attn_unit(const bf16_t* Qb, const bf16_t* Kh, const bf16_t* Vh, bf16_t* Ob, int seq, char* lds) {
  const int tid = lv(threadIdx.x), wid = tid >> 6, lane = tid & 63, r32 = lane & 31, hi = lane >> 5;
  char* V_lds = lds; char* K_lds = lds + 2 * SHM_V;
  float* wsf = (float*)(lds + 2 * SHM_V + 2 * SHM_K) + wid * 64; float* li_l = wsf; float* al_l = wsf + 32;
  char* qrl = lds + 2 * SHM_V + 2 * SHM_K + 8 * 64 * 4 + wid * (32 * 176) + r32 * 176 + hi * 16;
  float m_reg = -1e30f, l_reg = 0; f32x16 o[4]; bf16x8 qr[7];
#pragma unroll
  for (int d = 0; d < 4; ++d)
#pragma unroll
    for (int i = 0; i < 16; ++i) o[d][i] = 0.f;
  const bf16_t* Qw = Qb + (size_t)(wid * 32 + r32) * DQ + hi * 8;
#pragma unroll
  for (int d0 = 0; d0 < 7; ++d0) qr[d0] = *reinterpret_cast<const bf16x8*>(Qw + d0 * 16);
#pragma unroll
  for (int d0 = 7; d0 < 12; ++d0) *reinterpret_cast<bf16x8*>(qrl + (d0 - 7) * 32) = *reinterpret_cast<const bf16x8*>(Qw + d0 * 16);
  int kst[3];
#pragma unroll
  for (int i = 0; i < 3; ++i) { const int c = tid + 512 * i; kst[i] = KSWZ(c / 24, (c % 24) * 16); }
  const int vst0 = v_st(tid >> 4, (tid & 15) * 8), vst1 = v_st(32 + (tid >> 4), (tid & 15) * 8);
  const int vb0 = (int)(uintptr_t)V_lds + v_rd_base(lane);
  bf16x8 sk0, sk1, sk2, sv0, sv1;
#define SLOAD(k0) do { const bf16x8* kp = reinterpret_cast<const bf16x8*>(Kh + (size_t)(k0) * DQ) + tid; sk0 = kp[0]; sk1 = kp[512]; sk2 = kp[1024]; \
    const bf16x8* vp = reinterpret_cast<const bf16x8*>(Vh + (size_t)(k0) * DV) + tid; sv0 = vp[0]; sv1 = vp[512]; } while (0)
#define SWRITE(b) do { *(bf16x8*)(V_lds + (b) * SHM_V + vst0) = sv0; *(bf16x8*)(V_lds + (b) * SHM_V + vst1) = sv1; \
    *(bf16x8*)(K_lds + (b) * SHM_K + kst[0]) = sk0; *(bf16x8*)(K_lds + (b) * SHM_K + kst[1]) = sk1; *(bf16x8*)(K_lds + (b) * SHM_K + kst[2]) = sk2; } while (0)
#define RESC(a) do { if (__any((a) < 1.f)) { if (hi == 0) al_l[r32] = (a); asm volatile("s_waitcnt lgkmcnt(0)" ::: "memory"); \
    _Pragma("unroll") for (int d = 0; d < 4; ++d) _Pragma("unroll") for (int r = 0; r < 16; ++r) o[d][r] *= al_l[crow(r, hi)]; } } while (0)
  f32x16 pA0, pA1, pB0, pB1; float mnA, mnB, alA, alB; bf16x8 pa0, pa1, pa2, pa3; const int NT = seq / KVBLK;
  SLOAD(0); SWRITE(0); __syncthreads();
  qkt(pA0, pA1, K_lds, qr, qrl, r32, hi); partialSM(pA0, pA1, m_reg, mnA, alA);
  SLOAD(KVBLK); SWRITE(1); __syncthreads();
  for (int j = 1; j + 1 < NT; j += 2) {
    SBAR(); qkt(pB0, pB1, K_lds + SHM_K, qr, qrl, r32, hi);
    finishSM(pA0, pA1, alA, l_reg, pa0, pa1, pa2, pa3); SBAR();
    SLOAD((j + 1) * KVBLK); SBAR();
    pv_d0(o, vb0, pa0, pa1, pa2, pa3); partialSM(pB0, pB1, m_reg, mnB, alB);
    __syncthreads(); SWRITE(0);
    RESC(alB); __syncthreads();
    SBAR(); qkt(pA0, pA1, K_lds, qr, qrl, r32, hi);
    finishSM(pB0, pB1, alB, l_reg, pa0, pa1, pa2, pa3); SBAR();
    SLOAD((j + 2) * KVBLK); SBAR();
    pv_d0(o, vb0 + SHM_V, pa0, pa1, pa2, pa3); partialSM(pA0, pA1, m_reg, mnA, alA);
    __syncthreads(); SWRITE(1);
    RESC(alA); __syncthreads();
  }
  SBAR(); qkt(pB0, pB1, K_lds + SHM_K, qr, qrl, r32, hi);
  finishSM(pA0, pA1, alA, l_reg, pa0, pa1, pa2, pa3); SBAR();
  pv_d0(o, vb0, pa0, pa1, pa2, pa3); partialSM(pB0, pB1, m_reg, mnB, alB);
  __syncthreads(); RESC(alB);
  finishSM(pB0, pB1, alB, l_reg, pa0, pa1, pa2, pa3); SBAR();
  pv_d0(o, vb0 + SHM_V, pa0, pa1, pa2, pa3);
  if (hi == 0) li_l[r32] = l_reg; asm volatile("s_waitcnt lgkmcnt(0)" ::: "memory");
  float rli[16];
#pragma unroll
  for (int r = 0; r < 16; ++r) rli[r] = __builtin_amdgcn_rcpf(li_l[crow(r, hi)]);
  bf16_t* Ow = Ob + (size_t)(wid * 32) * 1024;
#pragma unroll
  for (int r = 0; r < 16; ++r) { const int orow = crow(r, hi);
#pragma unroll
    for (int d0 = 0; d0 < 4; ++d0) Ow[(size_t)orow * 1024 + d0 * 32 + r32] = f2bf(o[d0][r] * rli[r]); }
  __syncthreads();
#undef SLOAD
#undef SWRITE
#undef RESC
}
}

DI void phase2_attn(const KP& p, char* lds) {
  for (int u = blockIdx.x; u < 256; u += gridDim.x) {
    unsigned char* ws = launder(p.ws);
    const bf16_t* Qm = (const bf16_t*)(ws + WS_QM); const bf16_t* Km = (const bf16_t*)(ws + WS_KM); const bf16_t* Vm = (const bf16_t*)(ws + WS_VM);
    bf16_t* mixa = (bf16_t*)(ws + WS_P1S);
    const int qb = u & 7, bh = u >> 3, b = bh >> 2, h = bh & 3;
    att::attn_unit(Qm + ((size_t)bh * SEQ + qb * 256) * 192, Km + (size_t)bh * SEQ * 192, Vm + (size_t)bh * SEQ * 128,
                   mixa + ((size_t)b * SEQ + qb * 256) * 1024 + h * 128, SEQ, lds);
  }
}

constexpr int P3_TILE_BYTES = 256 * 1024;
constexpr int LDS_TK = LDS_GEMM;
constexpr int SCW = 260;
template <int N> DI void ce_desc(float (&a)[N], int i, int l) { const float hi = fmaxf(a[i], a[l]), lo = fminf(a[i], a[l]); a[i] = hi; a[l] = lo; }
DI void sort16_desc(float (&a)[16]) {
#pragma unroll
  for (int k = 2; k <= 16; k <<= 1)
#pragma unroll
    for (int j = k >> 1; j > 0; j >>= 1)
#pragma unroll
      for (int i = 0; i < 16; ++i) { const int l = i ^ j; if (l > i) { if ((i & k) == 0) ce_desc(a, i, l); else ce_desc(a, l, i); } }
}
DI void merge16_desc(float (&a)[16]) {
#pragma unroll
  for (int j = 8; j > 0; j >>= 1)
#pragma unroll
    for (int i = 0; i < 16; ++i) { const int l = i ^ j; if (l > i) ce_desc(a, i, l); }
}
DI void top16_merge(float (&a)[16], const float (&b)[16]) {
#pragma unroll
  for (int i = 0; i < 16; ++i) a[i] = fmaxf(a[i], b[15 - i]);
  merge16_desc(a);
}
template <int CTRL> DI float dpp_f(float v) { return __int_as_float(__builtin_amdgcn_mov_dpp(__float_as_int(v), CTRL, 0xF, 0xF, true)); }

DI float gelu_fast(float x) { return 0.5f * x * (1.f + erff(x * 0.70710678118654752f)); }

DI void phase3(const KP& p, char* lds, const int gather_reps, const int probe) {
  const int tid0 = threadIdx.x;
  const int r = tid0 & 31, hh = (tid0 >> 5) & 1, lane = tid0 & 63;
  char* wl = lds + (tid0 >> 6) * WT_BYTES;
  for (int tile = blockIdx.x; tile < 256; tile += gridDim.x) {
    unsigned char* ws = launder(p.ws); float* outp = launder(p.out); const float* xin = launder(p.in[0]);
    const int tok0 = tile * 64, b = tile >> 5;
    unsigned char* tsc = ws + WS_QM + (size_t)tile * P3_TILE_BYTES;
    bf16_t* QRY = (bf16_t*)tsc; bf16_t* Y = (bf16_t*)tsc; bf16_t* MIXA = (bf16_t*)(ws + WS_P1S) + (size_t)tok0 * 1024; bf16_t* H2 = MIXA;
    const float* modb = launder((const float*)(ws + WS_MOD)) + b * 6144;
    __syncthreads();
    {
      const int tid = lv(tid0), lane = tid & 63, w = tid >> 6, r = lane & 31, hh = lane >> 5;
      const int h = w >> 1, mi = w & 1, n = tile & 31;
      const bf16_t* QDg = (const bf16_t*)(ws + WS_QDEC) + (size_t)(tile * 4 + h) * 2 * 4096 + (mi * 32 + r) * 64 + hh * 8;
      const bf16_t* SPg = (const bf16_t*)(ws + WS_SPT) + ((size_t)((b * 4 + h) * 2) * 32 + n) * 8192 + r * 64 + hh * 8;
      f32x16 acc[4];
#pragma unroll
      for (int ni = 0; ni < 4; ++ni)
#pragma unroll
        for (int i = 0; i < 16; ++i) acc[ni][i] = 0.f;
#pragma unroll
      for (int d = 0; d < 2; ++d)
#pragma unroll
        for (int s = 0; s < 4; ++s) { const bf16x8 a = *(const bf16x8*)(QDg + d * 4096 + s * 16);
#pragma unroll
          for (int ni = 0; ni < 4; ++ni) { const bf16x8 bb = *(const bf16x8*)(SPg + (size_t)d * 32 * 8192 + ni * 32 * 64 + s * 16); acc[ni] = MFMA32(a, bb, acc[ni]); } }
      const bf16_t* OI = (const bf16_t*)(ws + WS_OINTRA) + (size_t)(tok0 + mi * 32 + 4 * hh) * 512 + h * 128 + r;
#pragma unroll
      for (int ni = 0; ni < 4; ++ni)
#pragma unroll
        for (int reg = 0; reg < 16; ++reg) acc[ni][reg] += bf2f(OI[(size_t)((reg & 3) + 8 * (reg >> 2)) * 512 + ni * 32]);
      float rs[16];
#pragma unroll
      for (int reg = 0; reg < 16; ++reg) { float v = acc[0][reg] * acc[0][reg] + acc[1][reg] * acc[1][reg] + acc[2][reg] * acc[2][reg] + acc[3][reg] * acc[3][reg];
        v += __shfl_xor(v, 1); v += __shfl_xor(v, 2); v += __shfl_xor(v, 4); v += __shfl_xor(v, 8); v += __shfl_xor(v, 16);
        rs[reg] = rsqrtf(v * (1.f / 128.f) + EPS); }
      const float* ggl = launder(p.in[16]);
      const bf16_t* RGp = (const bf16_t*)(ws + WS_RG) + (size_t)(tok0 + mi * 32 + 4 * hh) * 512 + h * 128 + r;
      bf16_t* MX = MIXA + (size_t)(mi * 32 + 4 * hh) * 1024 + 512 + h * 128 + r;
#pragma unroll
      for (int ni = 0; ni < 4; ++ni) { const float g = ggl[ni * 32 + r];
#pragma unroll
        for (int reg = 0; reg < 16; ++reg) { const int ro = (reg & 3) + 8 * (reg >> 2); const float rv = bf2f(RGp[(size_t)ro * 512 + ni * 32]);
          MX[(size_t)ro * 1024 + ni * 32] = f2bf(acc[ni][reg] * rs[reg] * g * silu_f(rv)); } }
    }
    __syncthreads();
    for (int rep3b = 0; rep3b < (probe == 5 ? 2 : 1); ++rep3b)
    block_gemm(lds, MIXA, 1024, (const bf16_t*)(ws + WS_WTOUT), 1024, 4, 1024, [&](int m0, int n0, const f32x16& a0, const f32x16& a1) {
      const int r2 = lv(r), h2 = lv(hh), ln = lv(lane);
      wt_write(wl, a0, a1, r2, h2, 1.f); LDS_FENCE();
      bf16_t* d = Y + (size_t)m0 * 1024 + n0; wt_store(wl, ln, d, 1024, d + 32, 1024);
    });
    __syncthreads();
    {
      const int tid = lv(tid0), lane = tid & 63, w = tid >> 6;
      float4 A1[4], A2[4], S2[4];
      const float* gpo = launder(p.in[6]); const float* gpf = launder(p.in[18]);
#pragma unroll
      for (int i = 0; i < 4; ++i) { const int d = (lane + 64 * i) * 4;
        const float4 gp = *(const float4*)(gpo + d), gt = *(const float4*)(modb + 2048 + d), g2 = *(const float4*)(gpf + d), sc = *(const float4*)(modb + 4096 + d);
        S2[i] = *(const float4*)(modb + 3072 + d);
        A1[i] = make_float4(gp.x * gt.x, gp.y * gt.y, gp.z * gt.z, gp.w * gt.w);
        A2[i] = make_float4(g2.x * (1.f + sc.x), g2.y * (1.f + sc.y), g2.z * (1.f + sc.z), g2.w * (1.f + sc.w)); }
      for (int rr = 0; rr < 8; ++rr) { const int row = w * 8 + rr; const size_t tok = tok0 + row;
        float4 yv[4]; float ss = 0.f;
#pragma unroll
        for (int i = 0; i < 4; ++i) { const uint2 u = *(const uint2*)(Y + (size_t)row * 1024 + (lane + 64 * i) * 4);
          yv[i] = make_float4(__uint_as_float(u.x << 16), __uint_as_float(u.x & 0xffff0000u), __uint_as_float(u.y << 16), __uint_as_float(u.y & 0xffff0000u));
          ss += yv[i].x * yv[i].x + yv[i].y * yv[i].y + yv[i].z * yv[i].z + yv[i].w * yv[i].w; }
        ss = wave_sum(ss); const float rs = rsqrtf(ss * (1.f / 1024.f) + EPS);
        float4 xv[4]; float s2 = 0.f;
#pragma unroll
        for (int i = 0; i < 4; ++i) { const float4 x = *(const float4*)(xin + tok * 1024 + (lane + 64 * i) * 4);
          xv[i] = make_float4(x.x + A1[i].x * yv[i].x * rs, x.y + A1[i].y * yv[i].y * rs, x.z + A1[i].z * yv[i].z * rs, x.w + A1[i].w * yv[i].w * rs);
          *(float4*)(outp + tok * 1024 + (lane + 64 * i) * 4) = xv[i];
          s2 += xv[i].x * xv[i].x + xv[i].y * xv[i].y + xv[i].z * xv[i].z + xv[i].w * xv[i].w; }
        s2 = wave_sum(s2); const float r2 = rsqrtf(s2 * (1.f / 1024.f) + EPS);
#pragma unroll
        for (int i = 0; i < 4; ++i) { uint2 o; o.x = pack2(xv[i].x * r2 * A2[i].x + S2[i].x, xv[i].y * r2 * A2[i].y + S2[i].y); o.y = pack2(xv[i].z * r2 * A2[i].z + S2[i].z, xv[i].w * r2 * A2[i].w + S2[i].w);
          *(uint2*)(H2 + (size_t)row * 1024 + (lane + 64 * i) * 4) = o; }
      }
    }
    __syncthreads();
    for (int rep3d = 0; rep3d < (probe == 6 ? 2 : 1); ++rep3d)
    block_gemm(lds, H2, 1024, (const bf16_t*)(ws + WS_WTPQ), 1024, 8, 1024, [&](int m0, int n0, const f32x16& a0, const f32x16& a1) {
      const int r2 = lv(r), h2 = lv(hh), ln = lv(lane);
      wt_write(wl, a0, a1, r2, h2, 1.f); LDS_FENCE();
      bf16_t* d = QRY + (size_t)m0 * 2048 + n0; wt_store(wl, ln, d, 2048, d + 32, 2048);
    });
    float* SC = (float*)lds; unsigned* TK = (unsigned*)(lds + LDS_TK);
    for (int rep3e = 0; rep3e < (probe == 7 ? 2 : 1); ++rep3e)
    for (int h = 0; h < 8; ++h) {
      block_gemm(lds, QRY + h * 256, 2048, (const bf16_t*)(ws + WS_KD), 256, 1, 256, [&](int m0, int n0, const f32x16& a0, const f32x16& a1) {
        const int r2 = lv(r), h2 = lv(hh);
        float* sp = SC + (m0 + 4 * h2) * SCW + n0 + r2;
#pragma unroll
        for (int reg = 0; reg < 16; ++reg) { const int ro = ((reg & 3) + 8 * (reg >> 2)) * SCW; sp[ro] = a0[reg]; sp[ro + 32] = a1[reg]; }
      });
      {
        const int tid = lv(tid0);
        const int tt = tid >> 3, sd = (tid >> 2) & 1, q = tid & 3;
        const float* sr = SC + tt * SCW + sd * 128 + q * 32;
        float a[16], c[16];
#pragma unroll
        for (int i = 0; i < 4; ++i) { const float4 v = *(const float4*)(sr + i * 4); const unsigned ib = q * 32 + i * 4;
          a[i * 4 + 0] = __uint_as_float((__float_as_uint(v.x) & 0xFFFFFF80u) | (ib + 0)); a[i * 4 + 1] = __uint_as_float((__float_as_uint(v.y) & 0xFFFFFF80u) | (ib + 1));
          a[i * 4 + 2] = __uint_as_float((__float_as_uint(v.z) & 0xFFFFFF80u) | (ib + 2)); a[i * 4 + 3] = __uint_as_float((__float_as_uint(v.w) & 0xFFFFFF80u) | (ib + 3)); }
#pragma unroll
        for (int i = 0; i < 4; ++i) { const float4 v = *(const float4*)(sr + 16 + i * 4); const unsigned ib = q * 32 + 16 + i * 4;
          c[i * 4 + 0] = __uint_as_float((__float_as_uint(v.x) & 0xFFFFFF80u) | (ib + 0)); c[i * 4 + 1] = __uint_as_float((__float_as_uint(v.y) & 0xFFFFFF80u) | (ib + 1));
          c[i * 4 + 2] = __uint_as_float((__float_as_uint(v.z) & 0xFFFFFF80u) | (ib + 2)); c[i * 4 + 3] = __uint_as_float((__float_as_uint(v.w) & 0xFFFFFF80u) | (ib + 3)); }
        sort16_desc(a); sort16_desc(c); top16_merge(a, c);
#pragma unroll
        for (int i = 0; i < 16; ++i) c[i] = dpp_f<0xB1>(a[i]);
        top16_merge(a, c);
#pragma unroll
        for (int i = 0; i < 16; ++i) c[i] = dpp_f<0x4E>(a[i]);
        top16_merge(a, c);
        if (q == 0) { unsigned* tk = TK + ((tt * 8 + h) * 2 + sd) * 16;
#pragma unroll
          for (int i = 0; i < 4; ++i) *(uint4*)(tk + i * 4) = make_uint4(__float_as_uint(a[i * 4]), __float_as_uint(a[i * 4 + 1]), __float_as_uint(a[i * 4 + 2]), __float_as_uint(a[i * 4 + 3])); }
      }
      __syncthreads();
    }
    int* EIDX = (int*)lds; float* GATE = (float*)(lds + 32768);
    {
      const int tid = lv(tid0);
      const int tt = tid >> 3, h = tid & 7;
      const unsigned* t1 = TK + ((tt * 8 + h) * 2) * 16; const unsigned* t2 = t1 + 16;
      float v1[16], v2[16];
#pragma unroll
      for (int i = 0; i < 4; ++i) { const uint4 u = *(const uint4*)(t1 + i * 4), v = *(const uint4*)(t2 + i * 4);
        v1[i * 4] = __uint_as_float(u.x & 0xFFFFFF80u); v1[i * 4 + 1] = __uint_as_float(u.y & 0xFFFFFF80u); v1[i * 4 + 2] = __uint_as_float(u.z & 0xFFFFFF80u); v1[i * 4 + 3] = __uint_as_float(u.w & 0xFFFFFF80u);
        v2[i * 4] = __uint_as_float(v.x & 0xFFFFFF80u); v2[i * 4 + 1] = __uint_as_float(v.y & 0xFFFFFF80u); v2[i * 4 + 2] = __uint_as_float(v.z & 0xFFFFFF80u); v2[i * 4 + 3] = __uint_as_float(v.w & 0xFFFFFF80u); }
      float best[16], grp[16];
#define CAND(i, j) __uint_as_float((__float_as_uint(v1[i] + v2[j]) & 0xFFFFFF00u) | ((i) << 4) | (j))
      best[0] = CAND(0, 0); best[1] = CAND(0, 1); best[2] = CAND(0, 2); best[3] = CAND(0, 3); best[4] = CAND(0, 4); best[5] = CAND(0, 5); best[6] = CAND(0, 6); best[7] = CAND(0, 7);
      best[8] = CAND(0, 8); best[9] = CAND(0, 9); best[10] = CAND(0, 10); best[11] = CAND(0, 11); best[12] = CAND(0, 12); best[13] = CAND(0, 13); best[14] = CAND(0, 14); best[15] = CAND(0, 15);
      sort16_desc(best);
      grp[0] = CAND(1, 0); grp[1] = CAND(1, 1); grp[2] = CAND(1, 2); grp[3] = CAND(1, 3); grp[4] = CAND(1, 4); grp[5] = CAND(1, 5); grp[6] = CAND(1, 6); grp[7] = CAND(1, 7);
      grp[8] = CAND(2, 0); grp[9] = CAND(2, 1); grp[10] = CAND(2, 2); grp[11] = CAND(2, 3); grp[12] = CAND(2, 4); grp[13] = CAND(3, 0); grp[14] = CAND(3, 1); grp[15] = CAND(3, 2);
      sort16_desc(grp); top16_merge(best, grp);
      grp[0] = CAND(3, 3); grp[1] = CAND(4, 0); grp[2] = CAND(4, 1); grp[3] = CAND(4, 2); grp[4] = CAND(5, 0); grp[5] = CAND(5, 1); grp[6] = CAND(6, 0); grp[7] = CAND(6, 1);
      grp[8] = CAND(7, 0); grp[9] = CAND(7, 1); grp[10] = CAND(8, 0); grp[11] = CAND(9, 0); grp[12] = CAND(10, 0); grp[13] = CAND(11, 0); grp[14] = CAND(12, 0); grp[15] = CAND(13, 0);
      sort16_desc(grp); top16_merge(best, grp);
      { const float c14 = CAND(14, 0), c15 = CAND(15, 0);
        grp[0] = fmaxf(c14, c15); grp[1] = fminf(c14, c15);
#pragma unroll
        for (int i = 2; i < 16; ++i) grp[i] = -3.0e38f;
        top16_merge(best, grp); }
#undef CAND
      __syncthreads();
      float sv[16]; int ev[16]; float mx = -3.0e38f;
#pragma unroll
      for (int k = 0; k < 16; ++k) { const unsigned key = __float_as_uint(best[k]); const int ci = (key >> 4) & 15, cj = key & 15;
        const unsigned k1 = t1[ci], k2 = t2[cj];
        sv[k] = __uint_as_float(k1 & 0xFFFFFF80u) + __uint_as_float(k2 & 0xFFFFFF80u); ev[k] = (int)((k1 & 127u) * 128u + (k2 & 127u)); mx = fmaxf(mx, sv[k]); }
      float sum = 0.f;
#pragma unroll
      for (int k = 0; k < 16; ++k) { sv[k] = __expf(sv[k] - mx); sum += sv[k]; }
      const float inv = 1.f / sum;
#pragma unroll
      for (int k = 0; k < 16; ++k) { EIDX[tt * 128 + h * 16 + k] = ev[k]; GATE[tt * 128 + h * 16 + k] = sv[k] * inv; }
    }
    __syncthreads();
    {
      const int tid = lv(tid0), lane = tid & 63, w = tid >> 6;
      const unsigned char* EU = ws + WS_EU; const unsigned char* EV = ws + WS_EV; const float* SCU = (const float*)(ws + WS_ESC); const float* SCV = SCU + 16384;
      const float* gpf2 = launder(p.in[19]);
      typedef float f2v __attribute__((ext_vector_type(2)));
#define FP8X4(wd, o0, o1, o2, o3) do { const f2v lo_ = __builtin_amdgcn_cvt_pk_f32_fp8((int)(wd), false), hi_ = __builtin_amdgcn_cvt_pk_f32_fp8((int)(wd), true); o0 = lo_.x; o1 = lo_.y; o2 = hi_.x; o3 = hi_.y; } while (0)
#pragma unroll 1
      for (int pass = 0; pass < gather_reps; ++pass)
#pragma unroll 1
      for (int rr = 0; rr < 8; ++rr) { const int row = w * 8 + rr; const size_t tok = tok0 + row;
        float hf[16];
        { const uint4 hA = *(const uint4*)(H2 + (size_t)row * 1024 + lane * 16), hB = *(const uint4*)(H2 + (size_t)row * 1024 + lane * 16 + 8);
          hf[0] = __uint_as_float(hA.x << 16); hf[1] = __uint_as_float(hA.x & 0xffff0000u); hf[2] = __uint_as_float(hA.y << 16); hf[3] = __uint_as_float(hA.y & 0xffff0000u);
          hf[4] = __uint_as_float(hA.z << 16); hf[5] = __uint_as_float(hA.z & 0xffff0000u); hf[6] = __uint_as_float(hA.w << 16); hf[7] = __uint_as_float(hA.w & 0xffff0000u);
          hf[8] = __uint_as_float(hB.x << 16); hf[9] = __uint_as_float(hB.x & 0xffff0000u); hf[10] = __uint_as_float(hB.y << 16); hf[11] = __uint_as_float(hB.y & 0xffff0000u);
          hf[12] = __uint_as_float(hB.z << 16); hf[13] = __uint_as_float(hB.z & 0xffff0000u); hf[14] = __uint_as_float(hB.w << 16); hf[15] = __uint_as_float(hB.w & 0xffff0000u); }
        float acc[16];
#pragma unroll
        for (int i = 0; i < 16; ++i) acc[i] = 0.f;
#pragma unroll 1
        for (int g = 0; g < 16; ++g) {
          const int* ep = EIDX + row * 128 + g * 8;
          const int4 ea = *(const int4*)ep, eb = *(const int4*)(ep + 4);
          int es[8];
          es[0] = __builtin_amdgcn_readfirstlane(ea.x); es[1] = __builtin_amdgcn_readfirstlane(ea.y); es[2] = __builtin_amdgcn_readfirstlane(ea.z); es[3] = __builtin_amdgcn_readfirstlane(ea.w);
          es[4] = __builtin_amdgcn_readfirstlane(eb.x); es[5] = __builtin_amdgcn_readfirstlane(eb.y); es[6] = __builtin_amdgcn_readfirstlane(eb.z); es[7] = __builtin_amdgcn_readfirstlane(eb.w);
          uint4 u[8], v[8];
#pragma unroll
          for (int k2 = 0; k2 < 8; ++k2) u[k2] = *(const uint4*)(EU + (size_t)es[k2] * 1024 + lane * 16);
#pragma unroll
          for (int k2 = 0; k2 < 8; ++k2) v[k2] = *(const uint4*)(EV + (size_t)es[k2] * 1024 + lane * 16);
          const int eslot = ep[lane & 7];
          const float gte = GATE[row * 128 + g * 8 + (lane & 7)], su = SCU[eslot], sv = SCV[eslot];
          float P[8];
#pragma unroll
          for (int k2 = 0; k2 < 8; ++k2) { float a0, a1, a2, a3, d;
            FP8X4(u[k2].x, a0, a1, a2, a3); d = a0 * hf[0] + a1 * hf[1] + a2 * hf[2] + a3 * hf[3];
            FP8X4(u[k2].y, a0, a1, a2, a3); d += a0 * hf[4] + a1 * hf[5] + a2 * hf[6] + a3 * hf[7];
            FP8X4(u[k2].z, a0, a1, a2, a3); d += a0 * hf[8] + a1 * hf[9] + a2 * hf[10] + a3 * hf[11];
            FP8X4(u[k2].w, a0, a1, a2, a3); d += a0 * hf[12] + a1 * hf[13] + a2 * hf[14] + a3 * hf[15];
            P[k2] = d; }
          { const bool up4 = (lane & 4) != 0;
#pragma unroll
            for (int e = 0; e < 4; ++e) { const float keep = up4 ? P[e + 4] : P[e], send = up4 ? P[e] : P[e + 4]; P[e] = keep + __shfl_xor(send, 4); }
            const bool up2 = (lane & 2) != 0;
#pragma unroll
            for (int e = 0; e < 2; ++e) { const float keep = up2 ? P[e + 2] : P[e], send = up2 ? P[e] : P[e + 2]; P[e] = keep + dpp_f<0x4E>(send); }
            const bool up1 = (lane & 1) != 0;
            const float keep = up1 ? P[1] : P[0], send = up1 ? P[0] : P[1];
            float av = keep + dpp_f<0xB1>(send);
            av += __shfl_xor(av, 8); av += __shfl_xor(av, 16); av += __shfl_xor(av, 32);
            av *= su;
            const float ax = fabsf(av), t = __builtin_amdgcn_rcpf(ax * 0.2316418882f + 1.0f);
            float q = t * 0.5307027145f + (-0.7265760135f); q = q * t + 0.7107068705f; q = q * t + (-0.142248368f); q = q * t + 0.127414796f; q = q * t;
            const float ee = __builtin_amdgcn_exp2f(av * av * (-0.72134752044f));
            const float mm = av * (q * ee), gl = (av < 0.f) ? mm : (av - mm);
            P[0] = gte * gl * sv; }
#pragma unroll
          for (int k2 = 0; k2 < 8; ++k2) { const float wk = __int_as_float(__builtin_amdgcn_readlane(__float_as_int(P[0]), k2)); float a0, a1, a2, a3;
            FP8X4(v[k2].x, a0, a1, a2, a3); acc[0] += wk * a0; acc[1] += wk * a1; acc[2] += wk * a2; acc[3] += wk * a3;
            FP8X4(v[k2].y, a0, a1, a2, a3); acc[4] += wk * a0; acc[5] += wk * a1; acc[6] += wk * a2; acc[7] += wk * a3;
            FP8X4(v[k2].z, a0, a1, a2, a3); acc[8] += wk * a0; acc[9] += wk * a1; acc[10] += wk * a2; acc[11] += wk * a3;
            FP8X4(v[k2].w, a0, a1, a2, a3); acc[12] += wk * a0; acc[13] += wk * a1; acc[14] += wk * a2; acc[15] += wk * a3; }
        }
        float ss = 0.f;
#pragma unroll
        for (int i = 0; i < 16; ++i) ss += acc[i] * acc[i];
        ss = wave_sum(ss); const float rs = rsqrtf(ss * (1.f / 1024.f) + EPS);
        float* orow = outp + tok * 1024 + lane * 16;
        if (pass == gather_reps - 1)
#pragma unroll
        for (int i = 0; i < 4; ++i) { const int d = lane * 16 + 4 * i;
          float4 x1 = *(const float4*)(orow + 4 * i); const float4 g3 = *(const float4*)(gpf2 + d), g2 = *(const float4*)(modb + 5120 + d);
          x1.x += g3.x * g2.x * acc[4 * i] * rs; x1.y += g3.y * g2.y * acc[4 * i + 1] * rs; x1.z += g3.z * g2.z * acc[4 * i + 2] * rs; x1.w += g3.w * g2.w * acc[4 * i + 3] * rs;
          *(float4*)(orow + 4 * i) = x1; }
      }
#undef FP8X4
    }
  }
}

DI void phase2_scan(const KP& p) {
  unsigned char* ws = p.ws;
  for (int g = blockIdx.x * NTHR + threadIdx.x; g < 131072; g += gridDim.x * NTHR) {
    const int seq = g >> 11, within = g & 2047, dv = within >> 4, dk4 = (within & 15) * 4, dir = seq & 1;
    bf16_t* base = (bf16_t*)(ws + WS_SPT) + ((size_t)seq * 32 * 128 + dv) * 64 + dk4;
    const float* dec = (const float*)(ws + WS_DEC) + (size_t)seq * 32 * 64 + dk4;
    float s0 = 0.f, s1 = 0.f, s2 = 0.f, s3 = 0.f;
#pragma unroll 1
    for (int i0 = 0; i0 < 32; i0 += 8) {
      uint2 d[8]; float4 c[8];
#pragma unroll
      for (int j = 0; j < 8; ++j) { const int n = dir ? 31 - (i0 + j) : (i0 + j); d[j] = *(const uint2*)(base + (size_t)n * 8192); c[j] = *(const float4*)(dec + n * 64); }
#pragma unroll
      for (int j = 0; j < 8; ++j) { const int n = dir ? 31 - (i0 + j) : (i0 + j);
        uint2 o; o.x = pack2(s0, s1); o.y = pack2(s2, s3); *(uint2*)(base + (size_t)n * 8192) = o;
        s0 = c[j].x * s0 + __uint_as_float(d[j].x << 16); s1 = c[j].y * s1 + __uint_as_float(d[j].x & 0xffff0000u);
        s2 = c[j].z * s2 + __uint_as_float(d[j].y << 16); s3 = c[j].w * s3 + __uint_as_float(d[j].y & 0xffff0000u); }
    }
  }
}

#ifndef PROBE_ID
#define PROBE_ID 0
#endif
__global__ void __launch_bounds__(NTHR, 2) mega(KP p) {
  extern __shared__ __attribute__((aligned(16))) char lds[];
  cg::grid_group grid = cg::this_grid();
  const int hi = p.ph_hi; constexpr int probe = PROBE_ID;
  if (p.ph_lo <= 0 && 0 < hi) { phase0(p, lds); if (probe == 1) phase0(p, lds); if (1 < hi) grid.sync(); }
  if (p.ph_lo <= 1 && 1 < hi) { phase1(p, lds); if (probe == 2) phase1(p, lds); if (2 < hi) grid.sync(); }
  if (p.ph_lo <= 2 && 2 < hi) { phase2_scan(p); phase2_attn(p, lds); if (probe == 3) phase2_attn(p, lds); if (3 < hi) grid.sync(); }
  if (p.ph_lo <= 3 && 3 < hi) { phase3(p, lds, probe == 4 ? 2 : 1, probe); }
}

extern "C" void kernel_launch(void* const* d_in, const int* in_sizes, int n_in, void* d_out, int out_size, void* d_ws, size_t ws_size, hipStream_t stream) {
  float* out = (float*)d_out;
  unsigned char* ws = (unsigned char*)d_ws;
  if (ws_size < WS_END || n_in != 25) return;
  static bool attr_done = false;
  if (!attr_done) { (void)hipFuncSetAttribute((const void*)mega, hipFuncAttributeMaxDynamicSharedMemorySize, LDS_TOTAL); attr_done = true; }
  KP p{};
  for (int i = 0; i < 25; ++i) p.in[i] = (const float*)d_in[i];
  p.out = out; p.ws = ws;
  p.ph_lo = 0; p.ph_hi = 4;
  { void* args[] = {&p}; (void)hipLaunchCooperativeKernel((const void*)mega, dim3(256), dim3(NTHR), args, LDS_TOTAL, stream); }
}
```

```cpp
#include <hip/hip_runtime.h>
#include <hip/hip_cooperative_groups.h>
namespace cg = cooperative_groups;
#include <stdint.h>

typedef unsigned short bf16_t;
#define DI __device__ __forceinline__

DI float bf2f(bf16_t v) { return __uint_as_float(((unsigned)v) << 16); }
DI bf16_t f2bf(float f) { unsigned u = __float_as_uint(f); u += 0x7fffu + ((u >> 16) & 1u); return (bf16_t)(u >> 16); }

constexpr int BATCH = 8, SEQ = 2048, DM = 1024, NTOK = BATCH * SEQ;
constexpr int INW = 2272;
constexpr float EPS = 1e-6f;
constexpr int O_CQ = 0, O_CKV = 384, O_KR = 640, O_QG = 704, O_KG = 960, O_VG = 1216, O_GF = 1728, O_GB = 1744, O_R = 1760;

DI float wave_sum(float v) {
#pragma unroll
  for (int o = 1; o < 64; o <<= 1) v += __shfl_xor(v, o);
  return v;
}
DI float wave_max(float v) {
#pragma unroll
  for (int o = 1; o < 64; o <<= 1) v = fmaxf(v, __shfl_xor(v, o));
  return v;
}
DI float block_sum256(float v, float* red) {
  v = wave_sum(v);
  __syncthreads();
  if ((threadIdx.x & 63) == 0) red[threadIdx.x >> 6] = v;
  __syncthreads();
  return red[0] + red[1] + red[2] + red[3];
}
DI float block_max256(float v, float* red) {
  v = wave_max(v);
  __syncthreads();
  if ((threadIdx.x & 63) == 0) red[threadIdx.x >> 6] = v;
  __syncthreads();
  return fmaxf(fmaxf(red[0], red[1]), fmaxf(red[2], red[3]));
}
DI float silu_f(float x) { return x / (1.f + expf(-x)); }
DI float logsigmoid_f(float x) { return fminf(x, 0.f) - log1pf(expf(-fabsf(x))); }
DI float gelu_erf(float x) { return 0.5f * x * (1.f + erff(x * 0.70710678118654752f)); }

__global__ __launch_bounds__(256) void n_mod(const float* __restrict__ c, const float* __restrict__ w_ada, const float* __restrict__ b_ada, float* __restrict__ mod) {
  int idx = blockIdx.x * 256 + threadIdx.x;
  int b = idx / 6144, j = idx % 6144;
  float acc = b_ada[j];
  for (int k = 0; k < 1024; ++k) acc += silu_f(c[b * 1024 + k]) * w_ada[(size_t)k * 6144 + j];
  mod[idx] = acc;
}

__global__ __launch_bounds__(256) void n_hnorm(const float* __restrict__ x, const float* __restrict__ g, const float* __restrict__ mod, int b, int off_sh, int off_sc, float* __restrict__ h) {
  __shared__ float red[4];
  int t = blockIdx.x, tid = threadIdx.x;
  const float* xr = x + ((size_t)b * SEQ + t) * DM;
  float v[4]; float ss = 0.f;
#pragma unroll
  for (int i = 0; i < 4; ++i) { v[i] = xr[tid + 256 * i]; ss += v[i] * v[i]; }
  ss = block_sum256(ss, red);
  float rs = rsqrtf(ss * (1.f / DM) + EPS);
#pragma unroll
  for (int i = 0; i < 4; ++i) { int d = tid + 256 * i; h[(size_t)t * DM + d] = v[i] * rs * g[d] * (1.f + mod[b * 6144 + off_sc + d]) + mod[b * 6144 + off_sh + d]; }
}

template <bool BT>
__global__ __launch_bounds__(256) void n_gemm(const float* __restrict__ A, int lda, const float* __restrict__ B, int ldb, float* __restrict__ C, int ldc, int M, int N, int K) {
  __shared__ float As[16][65];
  __shared__ float Bs[16][65];
  const int tid = threadIdx.x, tx = tid & 15, ty = tid >> 4;
  const int m0 = blockIdx.y * 64, n0 = blockIdx.x * 64;
  float acc[4][4];
#pragma unroll
  for (int i = 0; i < 4; ++i)
#pragma unroll
    for (int j = 0; j < 4; ++j) acc[i][j] = 0.f;
  for (int k0 = 0; k0 < K; k0 += 16) {
#pragma unroll
    for (int i = 0; i < 4; ++i) { int e = tid + 256 * i; int m = e >> 4, k = e & 15; As[k][m] = A[(size_t)(m0 + m) * lda + k0 + k]; }
#pragma unroll
    for (int i = 0; i < 4; ++i) { int e = tid + 256 * i;
      if (!BT) { int k = e >> 6, n = e & 63; Bs[k][n] = (n0 + n < N) ? B[(size_t)(k0 + k) * ldb + n0 + n] : 0.f; }
      else     { int n = e >> 4, k = e & 15; Bs[k][n] = (n0 + n < N) ? B[(size_t)(n0 + n) * ldb + k0 + k] : 0.f; } }
    __syncthreads();
#pragma unroll
    for (int k = 0; k < 16; ++k) {
      float a[4], bb[4];
#pragma unroll
      for (int i = 0; i < 4; ++i) { a[i] = As[k][ty * 4 + i]; bb[i] = Bs[k][tx * 4 + i]; }
#pragma unroll
      for (int i = 0; i < 4; ++i)
#pragma unroll
        for (int j = 0; j < 4; ++j) acc[i][j] += a[i] * bb[j];
    }
    __syncthreads();
  }
#pragma unroll
  for (int i = 0; i < 4; ++i)
#pragma unroll
    for (int j = 0; j < 4; ++j) { int n = n0 + tx * 4 + j; if (n < N) C[(size_t)(m0 + ty * 4 + i) * ldc + n] = acc[i][j]; }
}

__global__ __launch_bounds__(256) void n_rms_slice(const float* __restrict__ in, int ldin, int off, int W, const float* __restrict__ g, float* __restrict__ out) {
  __shared__ float red[4];
  int t = blockIdx.x, tid = threadIdx.x;
  float v0 = (tid < W) ? in[(size_t)t * ldin + off + tid] : 0.f;
  float v1 = (tid + 256 < W) ? in[(size_t)t * ldin + off + tid + 256] : 0.f;
  float ss = block_sum256(v0 * v0 + v1 * v1, red);
  float rs = rsqrtf(ss / (float)W + EPS);
  if (tid < W) out[(size_t)t * W + tid] = v0 * rs * g[tid];
  if (tid + 256 < W) out[(size_t)t * W + tid + 256] = v1 * rs * g[tid + 256];
}

__global__ __launch_bounds__(256) void n_scatter(const float* __restrict__ proj, const float* __restrict__ qa, const float* __restrict__ kv, const int* __restrict__ positions, int b,
                                                 const float* __restrict__ wgf, const float* __restrict__ bgf, const float* __restrict__ wgb, const float* __restrict__ bgb,
                                                 bf16_t* __restrict__ Qm, bf16_t* __restrict__ Km, bf16_t* __restrict__ Vm, bf16_t* __restrict__ qg, bf16_t* __restrict__ kg, bf16_t* __restrict__ vg,
                                                 bf16_t* __restrict__ rg, float* __restrict__ laf, float* __restrict__ lab) {
  __shared__ float cs[32], sn[32];
  const int t = blockIdx.x, tid = threadIdx.x;
  const size_t tok = (size_t)b * SEQ + t;
  const float* pr = proj + (size_t)t * INW;
  const float* qr = qa + (size_t)t * 768;
  const float* kr = kv + (size_t)t * 1024;
  if (tid < 32) {
    float inv = powf(10000.f, -(float)tid / 32.f);
    float ang = (float)positions[tok] * inv;
    cs[tid] = cosf(ang); sn[tid] = sinf(ang);
  }
  __syncthreads();
  for (int e = tid; e < 4 * 192; e += 256) {
    int h = e / 192, d = e % 192; float v;
    if (d < 128) v = qr[h * 192 + d];
    else { int j = d - 128; const float* rp = qr + h * 192 + 128;
      if (j < 32) v = rp[j] * cs[j] - rp[j + 32] * sn[j]; else v = rp[j] * cs[j - 32] + rp[j - 32] * sn[j - 32]; }
    Qm[(((size_t)b * 4 + h) * SEQ + t) * 192 + d] = f2bf(v);
  }
  for (int e = tid; e < 4 * 192; e += 256) {
    int h = e / 192, d = e % 192; float v;
    if (d < 128) v = kr[h * 256 + d];
    else { int j = d - 128; const float* rp = pr + O_KR;
      if (j < 32) v = rp[j] * cs[j] - rp[j + 32] * sn[j]; else v = rp[j] * cs[j - 32] + rp[j - 32] * sn[j - 32]; }
    Km[(((size_t)b * 4 + h) * SEQ + t) * 192 + d] = f2bf(v);
  }
  for (int e = tid; e < 512; e += 256) { int h = e >> 7, d = e & 127; Vm[(((size_t)b * 4 + h) * SEQ + t) * 128 + d] = f2bf(kr[h * 256 + 128 + d]); }
  { int e = tid; qg[tok * 256 + e] = f2bf(pr[O_QG + e] * 0.125f); kg[tok * 256 + e] = f2bf(pr[O_KG + e]); }
  for (int e = tid; e < 512; e += 256) { vg[tok * 512 + e] = f2bf(pr[O_VG + e]); rg[tok * 512 + e] = f2bf(pr[O_R + e]); }
  { int cidx = tid; float af = bgf[cidx], ab = bgb[cidx];
#pragma unroll
    for (int r = 0; r < 16; ++r) { af += pr[O_GF + r] * wgf[r * 256 + cidx]; ab += pr[O_GB + r] * wgb[r * 256 + cidx]; }
    laf[tok * 256 + cidx] = logsigmoid_f(af) * (1.f / 16.f); lab[tok * 256 + cidx] = logsigmoid_f(ab) * (1.f / 16.f); }
}

__global__ __launch_bounds__(256) void n_attn(const bf16_t* __restrict__ Qm, const bf16_t* __restrict__ Km, const bf16_t* __restrict__ Vm, bf16_t* __restrict__ omla) {
  __shared__ float qs[192]; __shared__ float sc[2048]; __shared__ float red[4];
  const int i = blockIdx.x, h = blockIdx.y, b = blockIdx.z, tid = threadIdx.x;
  const size_t bh = (size_t)b * 4 + h;
  if (tid < 192) qs[tid] = bf2f(Qm[(bh * SEQ + i) * 192 + tid]);
  __syncthreads();
  float mx = -1e30f;
  for (int kk = 0; kk < 8; ++kk) {
    int key = tid + 256 * kk; const uint4* kr = (const uint4*)(Km + (bh * SEQ + key) * 192);
    float s = 0.f;
    for (int c = 0; c < 24; ++c) { uint4 w = kr[c]; const float* q = qs + c * 8;
      s += q[0] * __uint_as_float(w.x << 16) + q[1] * __uint_as_float(w.x & 0xffff0000u) + q[2] * __uint_as_float(w.y << 16) + q[3] * __uint_as_float(w.y & 0xffff0000u)
         + q[4] * __uint_as_float(w.z << 16) + q[5] * __uint_as_float(w.z & 0xffff0000u) + q[6] * __uint_as_float(w.w << 16) + q[7] * __uint_as_float(w.w & 0xffff0000u); }
    s *= 0.07216878364870322f; sc[key] = s; mx = fmaxf(mx, s);
  }
  mx = block_max256(mx, red);
  float sum = 0.f;
  for (int kk = 0; kk < 8; ++kk) { int key = tid + 256 * kk; float p = expf(sc[key] - mx); sc[key] = p; sum += p; }
  sum = block_sum256(sum, red);
  __syncthreads();
  if (tid < 128) { float o = 0.f; const bf16_t* vp = Vm + bh * SEQ * 128 + tid;
    for (int key = 0; key < SEQ; ++key) o += sc[key] * bf2f(vp[(size_t)key * 128]);
    omla[((size_t)b * SEQ + i) * 512 + h * 128 + tid] = f2bf(o / sum); }
}

__global__ __launch_bounds__(128) void n_gla(const bf16_t* __restrict__ qg, const bf16_t* __restrict__ kg, const bf16_t* __restrict__ vg, const bf16_t* __restrict__ laf, const bf16_t* __restrict__ lab, float* __restrict__ og) {
  __shared__ float qs[64], ks[64], as[64];
  const int bh = blockIdx.x, b = bh >> 2, h = bh & 3, dv = threadIdx.x;
  for (int dir = 0; dir < 2; ++dir) {
    float S[64];
#pragma unroll
    for (int d = 0; d < 64; ++d) S[d] = 0.f;
    const bf16_t* la = dir ? lab : laf;
    for (int s = 0; s < SEQ; ++s) {
      const int t = dir ? (SEQ - 1 - s) : s; const size_t tok = (size_t)b * SEQ + t;
      __syncthreads();
      if (dv < 64) { qs[dv] = bf2f(qg[tok * 256 + h * 64 + dv]); ks[dv] = bf2f(kg[tok * 256 + h * 64 + dv]); as[dv] = expf(bf2f(la[tok * 256 + h * 64 + dv])); }
      __syncthreads();
      const float v = bf2f(vg[tok * 512 + h * 128 + dv]); float o = 0.f;
#pragma unroll
      for (int d = 0; d < 64; ++d) { S[d] = as[d] * S[d] + ks[d] * v; o += qs[d] * S[d]; }
      if (dir == 0) og[tok * 512 + h * 128 + dv] = o; else og[tok * 512 + h * 128 + dv] += o;
    }
  }
}

__global__ __launch_bounds__(256) void n_mix(const bf16_t* __restrict__ omla, const float* __restrict__ og, const bf16_t* __restrict__ rg, const float* __restrict__ g_gla, int b, float* __restrict__ mix) {
  __shared__ float ssum[4];
  const int t = blockIdx.x, tid = threadIdx.x; const size_t tok = (size_t)b * SEQ + t;
  if (tid < 4) ssum[tid] = 0.f;
  __syncthreads();
  float v[2];
#pragma unroll
  for (int i = 0; i < 2; ++i) { int e = tid + 256 * i; v[i] = og[tok * 512 + e]; atomicAdd(&ssum[e >> 7], v[i] * v[i]); mix[(size_t)t * DM + e] = bf2f(omla[tok * 512 + e]); }
  __syncthreads();
#pragma unroll
  for (int i = 0; i < 2; ++i) { int e = tid + 256 * i; float rs = rsqrtf(ssum[e >> 7] * (1.f / 128.f) + EPS);
    mix[(size_t)t * DM + 512 + e] = v[i] * rs * g_gla[e & 127] * silu_f(bf2f(rg[tok * 512 + e])); }
}

__global__ __launch_bounds__(256) void n_post1(const float* __restrict__ x, const float* __restrict__ y, const float* __restrict__ g_post, const float* __restrict__ g_pre2, const float* __restrict__ mod, int b,
                                               float* __restrict__ out, float* __restrict__ h2) {
  __shared__ float red[4];
  const int t = blockIdx.x, tid = threadIdx.x; const size_t tok = (size_t)b * SEQ + t;
  float yv[4], xv[4]; float ss = 0.f;
#pragma unroll
  for (int i = 0; i < 4; ++i) { yv[i] = y[(size_t)t * DM + tid + 256 * i]; ss += yv[i] * yv[i]; }
  ss = block_sum256(ss, red);
  float rs = rsqrtf(ss * (1.f / DM) + EPS); float s2 = 0.f;
#pragma unroll
  for (int i = 0; i < 4; ++i) { int d = tid + 256 * i; xv[i] = x[tok * DM + d] + mod[b * 6144 + 2048 + d] * (yv[i] * rs * g_post[d]); out[tok * DM + d] = xv[i]; s2 += xv[i] * xv[i]; }
  s2 = block_sum256(s2, red);
  float r2 = rsqrtf(s2 * (1.f / DM) + EPS);
#pragma unroll
  for (int i = 0; i < 4; ++i) { int d = tid + 256 * i; h2[(size_t)t * DM + d] = xv[i] * r2 * g_pre2[d] * (1.f + mod[b * 6144 + 4096 + d]) + mod[b * 6144 + 3072 + d]; }
}

DI void wave_argmax(float& v, int& i) {
#pragma unroll
  for (int o = 1; o < 64; o <<= 1) { float ov = __shfl_xor(v, o); int oi = __shfl_xor(i, o); if (ov > v || (ov == v && oi < i)) { v = ov; i = oi; } }
}
__global__ __launch_bounds__(256) void n_peer_select(const float* __restrict__ qry, const float* __restrict__ sk1, const float* __restrict__ sk2, int* __restrict__ eidx, float* __restrict__ gate) {
  __shared__ float v1s[4][16], v2s[4][16]; __shared__ int i1s[4][16], i2s[4][16];
  const int w = threadIdx.x >> 6, lane = threadIdx.x & 63;
  const int pair = blockIdx.x * 4 + w;
  const int t = pair >> 3, h = pair & 7;
  const float* q1 = qry + (size_t)t * 2048 + h * 256; const float* q2 = q1 + 128;
  float s1a = 0.f, s1b = 0.f, s2a = 0.f, s2b = 0.f;
  for (int d = 0; d < 128; ++d) { float a = q1[d], bq = q2[d];
    s1a += a * sk1[lane * 128 + d]; s1b += a * sk1[(lane + 64) * 128 + d]; s2a += bq * sk2[lane * 128 + d]; s2b += bq * sk2[(lane + 64) * 128 + d]; }
  for (int side = 0; side < 2; ++side) {
    float va = side ? s2a : s1a, vb = side ? s2b : s1b; bool ta = false, tb = false;
    for (int k = 0; k < 16; ++k) {
      float bv; int bi;
      if (!ta && (tb || va >= vb)) { bv = va; bi = lane; } else if (!tb) { bv = vb; bi = lane + 64; } else { bv = -3e38f; bi = 1 << 20; }
      wave_argmax(bv, bi);
      if (bi == lane) ta = true; if (bi == lane + 64) tb = true;
      if (lane == 0) { if (side) { v2s[w][k] = bv; i2s[w][k] = bi; } else { v1s[w][k] = bv; i1s[w][k] = bi; } }
    }
  }
  __syncthreads();
  float cv[4]; bool tk[4];
#pragma unroll
  for (int j = 0; j < 4; ++j) { int c = lane + 64 * j; cv[j] = v1s[w][c >> 4] + v2s[w][c & 15]; tk[j] = false; }
  float topv = 0.f; int topc = 0; float mx = 0.f;
  for (int k = 0; k < 16; ++k) {
    float bv = -3e38f; int bi = 1 << 20;
#pragma unroll
    for (int j = 0; j < 4; ++j) { if (!tk[j] && cv[j] > bv) { bv = cv[j]; bi = lane + 64 * j; } }
    wave_argmax(bv, bi);
#pragma unroll
    for (int j = 0; j < 4; ++j) if (bi == lane + 64 * j) tk[j] = true;
    if (k == 0) mx = bv;
    if (lane == k) { topv = bv; topc = bi; }
  }
  float e = (lane < 16) ? expf(topv - mx) : 0.f;
  float sum = wave_sum(e);
  if (lane < 16) { eidx[(size_t)pair * 16 + lane] = i1s[w][topc >> 4] * 128 + i2s[w][topc & 15]; gate[(size_t)pair * 16 + lane] = e / sum; }
}

__global__ __launch_bounds__(256) void n_peer_apply(const float* __restrict__ h2, const int* __restrict__ eidx, const float* __restrict__ gate, const float* __restrict__ eu, const float* __restrict__ ev,
                                                    const float* __restrict__ g_post, const float* __restrict__ mod, int b, float* __restrict__ out) {
  __shared__ float ys[4][1024]; __shared__ float red[4];
  const int t = blockIdx.x, tid = threadIdx.x, w = tid >> 6, lane = tid & 63; const size_t tok = (size_t)b * SEQ + t;
  float4 hx[4];
#pragma unroll
  for (int i = 0; i < 4; ++i) hx[i] = *(const float4*)(h2 + (size_t)t * DM + (lane + 64 * i) * 4);
  float4 acc[4];
#pragma unroll
  for (int i = 0; i < 4; ++i) acc[i] = make_float4(0.f, 0.f, 0.f, 0.f);
  for (int k = w; k < 128; k += 4) {
    const int e = eidx[(size_t)t * 128 + k]; const float gt = gate[(size_t)t * 128 + k];
    const float4* ur = (const float4*)(eu + (size_t)e * DM); const float4* vr = (const float4*)(ev + (size_t)e * DM);
    float d = 0.f;
#pragma unroll
    for (int i = 0; i < 4; ++i) { float4 u = ur[lane + 64 * i]; d += u.x * hx[i].x + u.y * hx[i].y + u.z * hx[i].z + u.w * hx[i].w; }
    d = wave_sum(d);
    const float wgt = gt * gelu_erf(d);
#pragma unroll
    for (int i = 0; i < 4; ++i) { float4 v = vr[lane + 64 * i]; acc[i].x += wgt * v.x; acc[i].y += wgt * v.y; acc[i].z += wgt * v.z; acc[i].w += wgt * v.w; }
  }
#pragma unroll
  for (int i = 0; i < 4; ++i) *(float4*)(&ys[w][(lane + 64 * i) * 4]) = acc[i];
  __syncthreads();
  float yv[4]; float ss = 0.f;
#pragma unroll
  for (int i = 0; i < 4; ++i) { int d = tid + 256 * i; yv[i] = ys[0][d] + ys[1][d] + ys[2][d] + ys[3][d]; ss += yv[i] * yv[i]; }
  ss = block_sum256(ss, red);
  const float rs = rsqrtf(ss * (1.f / DM) + EPS);
#pragma unroll
  for (int i = 0; i < 4; ++i) { int d = tid + 256 * i; out[tok * DM + d] = out[tok * DM + d] + mod[b * 6144 + 5120 + d] * (yv[i] * rs * g_post[d]); }
}

typedef short bf16x8 __attribute__((ext_vector_type(8)));
typedef float f32x16 __attribute__((ext_vector_type(16)));
#define MFMA32(a, b, c) __builtin_amdgcn_mfma_f32_32x32x16_bf16((a), (b), (c), 0, 0, 0)

constexpr int NTHR = 512;
constexpr size_t MiB = 1024 * 1024;
constexpr size_t WS_MOD   = 0;
constexpr size_t WS_WTIN  = 256 * 1024;
constexpr size_t WS_WTQUP = WS_WTIN + (size_t)2304 * 1024 * 2;
constexpr size_t WS_WTKVUP = WS_WTQUP + (size_t)768 * 384 * 2;
constexpr size_t WS_WTOUT = WS_WTKVUP + (size_t)1024 * 256 * 2;
constexpr size_t WS_WTPQ  = WS_WTOUT + (size_t)1024 * 1024 * 2;
constexpr size_t WS_KD    = WS_WTPQ + (size_t)2048 * 1024 * 2;
constexpr size_t WS_DEC   = WS_KD + (size_t)256 * 256 * 2;
constexpr size_t WS_ESC   = WS_DEC + (size_t)2048 * 64 * 4;
constexpr size_t WS_R0END = WS_ESC + (size_t)2 * 16384 * 4;
static_assert(WS_R0END <= 13 * MiB, "R0");
constexpr size_t WS_BAR  = 13 * MiB - 65536;
static_assert(WS_R0END + 131072 <= WS_BAR, "R0 room");
constexpr size_t WS_QM   = 13 * MiB;
constexpr size_t WS_KM   = WS_QM + 24 * MiB;
constexpr size_t WS_VM   = WS_KM + 24 * MiB;
constexpr size_t WS_P1S  = WS_VM + 16 * MiB;
constexpr size_t WS_RG   = WS_P1S + 32 * MiB;
constexpr size_t WS_OINTRA = WS_RG + 16 * MiB;
constexpr size_t WS_QDEC = WS_OINTRA + 16 * MiB;
constexpr size_t WS_SPT  = WS_QDEC + 16 * MiB;
constexpr size_t WS_EU   = WS_SPT + 32 * MiB;
constexpr size_t WS_EV   = WS_EU + 16 * MiB;
constexpr size_t WS_END  = WS_EV + 16 * MiB;
static_assert(WS_P1S == WS_QM + 64 * MiB, "P3 QRY scratch aliases QM..VM");
constexpr size_t OUT_HS  = 0;
constexpr size_t OUT_CQ  = 32 * MiB;
constexpr size_t OUT_GR  = 52 * MiB;

struct KP { const float* in[25]; float* out; unsigned char* ws; int ph_lo, ph_hi; };

constexpr int G_STRIDE = 144;
constexpr int G_ABYTES = 64 * G_STRIDE;
constexpr int G_BBYTES = 256 * G_STRIDE;
constexpr int G_STAGE = G_ABYTES + G_BBYTES;
constexpr int LDS_GEMM = 2 * G_STAGE;
constexpr int LDS_TAB = LDS_GEMM;
constexpr int LDS_XB = 157696;
constexpr int LDS_TOTAL = 157696 + 16;

DI unsigned pack2(float lo, float hi) { return (unsigned)f2bf(lo) | ((unsigned)f2bf(hi) << 16); }
DI int crow(int reg, int hh) { return (reg & 3) + 8 * (reg >> 2) + 4 * hh; }

template <class Epi>
DI void block_gemm(char* lds, const bf16_t* A, int lda, const bf16_t* Bt, int ldb, int nchunks, int K, Epi&& epi) {
  const int tid = threadIdx.x, lane = tid & 63, w = tid >> 6, wm = w >> 2, wn = w & 3, r = lane & 31, hh = lane >> 5;
  const int nk = K >> 6;
  const bool early = false;
  const int srow = tid >> 3, skc = tid & 7;
  const int st_off = srow * G_STRIDE + skc * 16;
  const int a_rd = (wm * 32 + r) * G_STRIDE + hh * 16;
  const int b_rd = G_ABYTES + (wn * 64 + r) * G_STRIDE + hh * 16;
#define G_LOAD(R, tt) do { const int ko_ = (tt) * 64; R##a = *(const uint4*)(Ab + ko_); R##b0 = *(const uint4*)(Bb + ko_); R##b1 = *(const uint4*)(Bb + (size_t)64 * ldb + ko_); \
    R##b2 = *(const uint4*)(Bb + (size_t)128 * ldb + ko_); R##b3 = *(const uint4*)(Bb + (size_t)192 * ldb + ko_); } while (0)
#define G_WRITE(R, st) do { char* nb_ = lds + (st) * G_STAGE; *(uint4*)(nb_ + st_off) = R##a; *(uint4*)(nb_ + G_ABYTES + st_off) = R##b0; *(uint4*)(nb_ + G_ABYTES + 64 * G_STRIDE + st_off) = R##b1; \
    *(uint4*)(nb_ + G_ABYTES + 128 * G_STRIDE + st_off) = R##b2; *(uint4*)(nb_ + G_ABYTES + 192 * G_STRIDE + st_off) = R##b3; } while (0)
#define G_COMPUTE(st) do { const char* cur_ = lds + (st) * G_STAGE; _Pragma("unroll") for (int s_ = 0; s_ < 4; ++s_) { \
    const bf16x8 a_ = *(const bf16x8*)(cur_ + a_rd + s_ * 32); const bf16x8 b0_ = *(const bf16x8*)(cur_ + b_rd + s_ * 32); const bf16x8 b1_ = *(const bf16x8*)(cur_ + b_rd + 32 * G_STRIDE + s_ * 32); \
    acc0 = MFMA32(a_, b0_, acc0); acc1 = MFMA32(a_, b1_, acc1); } } while (0)
#pragma unroll 1
  for (int ch = 0; ch < nchunks; ++ch) {
    const bf16_t* Ab = A + (size_t)srow * lda + skc * 8;
    const bf16_t* Bb = Bt + (size_t)(ch * 256 + srow) * ldb + skc * 8;
    f32x16 acc0, acc1;
#pragma unroll
    for (int i = 0; i < 16; ++i) { acc0[i] = 0.f; acc1[i] = 0.f; }
    const uint4 z4_ = make_uint4(0u, 0u, 0u, 0u);
    uint4 R0a = z4_, R0b0 = z4_, R0b1 = z4_, R0b2 = z4_, R0b3 = z4_, R1a = z4_, R1b0 = z4_, R1b1 = z4_, R1b2 = z4_, R1b3 = z4_, R2a = z4_, R2b0 = z4_, R2b1 = z4_, R2b2 = z4_, R2b3 = z4_;
    G_LOAD(R0, 0); if (nk > 1) G_LOAD(R1, 1); if (nk > 2) G_LOAD(R2, 2);
    G_WRITE(R0, 0);
    __syncthreads();
    for (int t = 0; t < nk; t += 3) {
      if (t + 3 < nk) G_LOAD(R0, t + 3);
      if (early && t + 1 < nk) G_WRITE(R1, (t + 1) & 1);
      G_COMPUTE(t & 1);
      if (!early && t + 1 < nk) G_WRITE(R1, (t + 1) & 1);
      __syncthreads();
      if (t + 1 >= nk) break;
      if (t + 4 < nk) G_LOAD(R1, t + 4);
      if (early && t + 2 < nk) G_WRITE(R2, (t + 2) & 1);
      G_COMPUTE((t + 1) & 1);
      if (!early && t + 2 < nk) G_WRITE(R2, (t + 2) & 1);
      __syncthreads();
      if (t + 2 >= nk) break;
      if (t + 5 < nk) G_LOAD(R2, t + 5);
      if (early && t + 3 < nk) G_WRITE(R0, (t + 3) & 1);
      G_COMPUTE((t + 2) & 1);
      if (!early && t + 3 < nk) G_WRITE(R0, (t + 3) & 1);
      __syncthreads();
    }
    epi(wm * 32, ch * 256 + wn * 64, acc0, acc1);
    __syncthreads();
  }
#undef G_LOAD
#undef G_WRITE
#undef G_COMPUTE
}

DI void p0_transpose(char* lds, const float* __restrict__ W, int K, int N, bf16_t* __restrict__ Wt, int item) {
  float* s = (float*)lds;
  const int tid = threadIdx.x;
  const int ntn = (N + 63) >> 6, kt = item / ntn, nt = item % ntn, k0 = kt * 64, n0 = nt * 64;
  __syncthreads();
#pragma unroll
  for (int i = 0; i < 8; ++i) { int e = tid + 512 * i; int kk = e >> 6, nn = e & 63; s[kk * 65 + nn] = (n0 + nn < N) ? W[(size_t)(k0 + kk) * N + n0 + nn] : 0.f; }
  __syncthreads();
  const int nn = tid >> 3, part = tid & 7;
  const float* sp = s + (part * 8) * 65 + nn;
  uint4 o; o.x = pack2(sp[0], sp[65]); o.y = pack2(sp[2 * 65], sp[3 * 65]); o.z = pack2(sp[4 * 65], sp[5 * 65]); o.w = pack2(sp[6 * 65], sp[7 * 65]);
  *(uint4*)(Wt + (size_t)(n0 + nn) * K + k0 + part * 8) = o;
}

DI void phase0(const KP& p, char* lds) {
  const int tid = threadIdx.x, bid = blockIdx.x, nb = gridDim.x;
  unsigned char* ws = p.ws;
  constexpr int I_IN = 16 * 36, I_QUP = 6 * 12, I_KVUP = 4 * 16, I_OUT = 16 * 16, I_PQ = 16 * 32;
  constexpr int I_ALL = I_IN + I_QUP + I_KVUP + I_OUT + I_PQ;
  for (int it = bid; it < I_ALL; it += nb) {
    int q = it;
    if (q < I_IN) { p0_transpose(lds, p.in[7], 1024, 2272, (bf16_t*)(ws + WS_WTIN), q); continue; } q -= I_IN;
    if (q < I_QUP) { p0_transpose(lds, p.in[9], 384, 768, (bf16_t*)(ws + WS_WTQUP), q); continue; } q -= I_QUP;
    if (q < I_KVUP) { p0_transpose(lds, p.in[11], 256, 1024, (bf16_t*)(ws + WS_WTKVUP), q); continue; } q -= I_KVUP;
    if (q < I_OUT) { p0_transpose(lds, p.in[17], 1024, 1024, (bf16_t*)(ws + WS_WTOUT), q); continue; } q -= I_OUT;
    p0_transpose(lds, p.in[20], 1024, 2048, (bf16_t*)(ws + WS_WTPQ), q);
  }
  { bf16_t* kd = (bf16_t*)(ws + WS_KD);
    for (int e = bid * NTHR + tid; e < 65536; e += nb * NTHR) { int n = e >> 8, k = e & 255; float v = 0.f;
      if (n < 128 && k < 128) v = p.in[21][n * 128 + k]; else if (n >= 128 && k >= 128) v = p.in[22][(n - 128) * 128 + (k - 128)];
      kd[e] = f2bf(v); } }
  { const int lane = tid & 63; float* scl = (float*)(ws + WS_ESC);
    for (int row = bid * 8 + (tid >> 6); row < 32768; row += nb * 8) { const int t = row >> 14, e = row & 16383;
      const float* src = p.in[23 + t] + (size_t)e * 1024 + lane * 16;
      float4 x[4]; float am = 0.f;
#pragma unroll
      for (int i = 0; i < 4; ++i) { x[i] = *(const float4*)(src + 4 * i); am = fmaxf(am, fmaxf(fmaxf(fabsf(x[i].x), fabsf(x[i].y)), fmaxf(fabsf(x[i].z), fabsf(x[i].w)))); }
      am = wave_max(am);
      float sc = 1.f, isc = 1.f;
      if (am > 0.f) { int ex; (void)frexpf(448.f / am, &ex); sc = ldexpf(1.f, ex - 1); isc = ldexpf(1.f, 1 - ex); }
      unsigned wv[4];
#pragma unroll
      for (int i = 0; i < 4; ++i) { int q = __builtin_amdgcn_cvt_pk_fp8_f32(x[i].x * sc, x[i].y * sc, 0, false); q = __builtin_amdgcn_cvt_pk_fp8_f32(x[i].z * sc, x[i].w * sc, q, true); wv[i] = (unsigned)q; }
      *(uint4*)(ws + (t ? WS_EV : WS_EU) + (size_t)e * 1024 + lane * 16) = make_uint4(wv[0], wv[1], wv[2], wv[3]);
      if (lane == 0) scl[t * 16384 + e] = isc; } }
  for (int jb = bid; jb < 96; jb += nb) {
    __syncthreads();
    float* cact = (float*)lds;
    float* red = (float*)(lds + 32768);
    for (int e = tid; e < 8192; e += NTHR) cact[e] = silu_f(p.in[1][e]);
    __syncthreads();
    const int jj = tid & 63, ks = tid >> 6, j0 = jb * 64;
    float acc[8];
#pragma unroll
    for (int b = 0; b < 8; ++b) acc[b] = 0.f;
    const float* wp = p.in[3] + (size_t)(ks * 128) * 6144 + j0 + jj;
    for (int k = 0; k < 128; ++k) { const float wv = wp[(size_t)k * 6144];
#pragma unroll
      for (int b = 0; b < 8; ++b) acc[b] += cact[b * 1024 + ks * 128 + k] * wv; }
#pragma unroll
    for (int b = 0; b < 8; ++b) red[(ks * 64 + jj) * 8 + b] = acc[b];
    __syncthreads();
    { const int b = tid >> 6; float sacc = p.in[4][j0 + jj];
#pragma unroll
      for (int k2 = 0; k2 < 8; ++k2) sacc += red[(k2 * 64 + jj) * 8 + b];
      ((float*)(ws + WS_MOD))[b * 6144 + j0 + jj] = sacc; }
  }
}

constexpr int WT_STRIDE = 144, WT_BYTES = 32 * WT_STRIDE;
DI void wt_write(char* wl, const f32x16& a0, const f32x16& a1, int r, int hh, float scale) {
  char* bp = wl + (4 * hh) * WT_STRIDE + r * 2;
#pragma unroll
  for (int reg = 0; reg < 16; ++reg) { const int ro = ((reg & 3) + 8 * (reg >> 2)) * WT_STRIDE;
    *(bf16_t*)(bp + ro) = f2bf(a0[reg] * scale); *(bf16_t*)(bp + ro + 64) = f2bf(a1[reg] * scale); }
}
DI void wt_write_rope(char* wl, const f32x16& a0, const f32x16& a1, int r, int hh, const float* cs, const float* sn, int m0) {
  char* bp = wl + (4 * hh) * WT_STRIDE + r * 2;
#pragma unroll
  for (int reg = 0; reg < 16; ++reg) { const int rw = (reg & 3) + 8 * (reg >> 2); const int row = m0 + rw + 4 * hh;
    const float c = cs[row * 32 + r], s = sn[row * 32 + r];
    *(bf16_t*)(bp + rw * WT_STRIDE) = f2bf(a0[reg] * c - a1[reg] * s); *(bf16_t*)(bp + rw * WT_STRIDE + 64) = f2bf(a1[reg] * c + a0[reg] * s); }
}
DI void wt_store(const char* wl, int lane, bf16_t* dA, int sA, bf16_t* dB, int sB) {
  const int piece = lane & 7, rsub = lane >> 3;
  bf16_t* d = (piece < 4) ? dA : dB; const int st = (piece < 4) ? sA : sB;
  if (d) {
#pragma unroll
    for (int i = 0; i < 4; ++i) { const int row = i * 8 + rsub; const uint4 v = *(const uint4*)(wl + row * WT_STRIDE + piece * 16);
      *(uint4*)(d + (size_t)row * st + (piece & 3) * 8) = v; }
  }
}
#define LDS_FENCE() asm volatile("s_waitcnt lgkmcnt(0)" ::: "memory")
DI int lv(int x) { asm volatile("" : "+v"(x)); return x; }
template <class T> DI T* launder(T* q) { size_t z = 0; asm volatile("" : "+s"(z)); return (T*)((char*)q + z); }

constexpr int GL_GR = 0, GL_VT = 8192, GL_QD = 26624, GL_KI = 45056, GL_KIT = 63488, GL_ATT = 81920, GL_TOT = 91136, GL_DEC = 93184, GL_LA = 93696  , GL_QS = 126464  , GL_KS = 134656;
DI void gla_chunk_local(const KP& p, char* lds, unsigned char* ws, int tile, const bf16_t* qg, const bf16_t* kg, const bf16_t* vg, const bf16_t* GR) {
  const int tid = lv(threadIdx.x), lane = tid & 63, w = tid >> 6, r = lane & 31, hh = lane >> 5;
  const int b = tile >> 5, n = tile & 31, tok0 = tile * 64;
  float* GRL = (float*)(lds + GL_GR); float* TOT = (float*)(lds + GL_TOT); float* DECL = (float*)(lds + GL_DEC);
  __syncthreads();
#pragma unroll
  for (int i = 0; i < 4; ++i) GRL[tid + 512 * i] = bf2f(GR[tid + 512 * i]);
#pragma unroll 1
  for (int h = 0; h < 4; ++h) {
    __syncthreads();
    { const int t = tid >> 3, c8 = (tid & 7) * 8;
      *(uint4*)(lds + GL_QS + (t * 64 + c8) * 2) = *(const uint4*)(qg + (size_t)t * 256 + h * 64 + c8);
      *(uint4*)(lds + GL_KS + (t * 64 + c8) * 2) = *(const uint4*)(kg + (size_t)t * 256 + h * 64 + c8); }
#pragma unroll
    for (int i = 0; i < 2; ++i) { const int c = tid + 512 * i, t = c >> 4, d8 = (c & 15) * 8;
      const uint4 v = *(const uint4*)(vg + (size_t)t * 512 + h * 128 + d8);
      bf16_t* vt = (bf16_t*)(lds + GL_VT) + d8 * 72 + t;
      vt[0] = (bf16_t)(v.x & 0xffffu); vt[72] = (bf16_t)(v.x >> 16); vt[144] = (bf16_t)(v.y & 0xffffu); vt[216] = (bf16_t)(v.y >> 16);
      vt[288] = (bf16_t)(v.z & 0xffffu); vt[360] = (bf16_t)(v.z >> 16); vt[432] = (bf16_t)(v.w & 0xffffu); vt[504] = (bf16_t)(v.w >> 16); }
    const int dir = tid >> 8, qt = (tid >> 6) & 3, dk = tid & 63, col = h * 64 + dk;
    float* LAL = (float*)(lds + GL_LA) + tid;
    {
      const float* wg = launder(dir ? p.in[14] : p.in[12]); const float* bg = launder(dir ? p.in[15] : p.in[13]);
      float wr[16];
#pragma unroll
      for (int q = 0; q < 16; ++q) wr[q] = wg[q * 256 + col];
      const float bias = bg[col];
      float run = 0.f;
#pragma unroll 2
      for (int ii = 0; ii < 16; ++ii) { const int i = dir ? 15 - ii : ii;
        const float* gp = GRL + (qt * 16 + i) * 32 + dir * 16; float x = bias;
#pragma unroll
        for (int q = 0; q < 16; ++q) x += gp[q] * wr[q];
        run += logsigmoid_f(x) * (1.f / 16.f); LAL[i * 512] = run; }
      TOT[(dir * 64 + dk) * 4 + qt] = run;
    }
    __syncthreads();
    {
      const float4 tq = *(const float4*)(TOT + (dir * 64 + dk) * 4);
      const float total = (tq.x + tq.y) + (tq.z + tq.w);
      float off;
      if (dir == 0) off = (qt > 0 ? tq.x : 0.f) + (qt > 1 ? tq.y : 0.f) + (qt > 2 ? tq.z : 0.f);
      else          off = (qt < 1 ? tq.y : 0.f) + (qt < 2 ? tq.z : 0.f) + (qt < 3 ? tq.w : 0.f);
      if (qt == 0) { const float dc = expf(total); DECL[dir * 64 + dk] = dc; ((float*)(ws + WS_DEC))[((size_t)((b * 4 + h) * 2 + dir) * 32 + n) * 64 + dk] = dc; }
      bf16_t* QD = (bf16_t*)(lds + GL_QD + dir * 9216) + (qt * 16) * 72 + dk; bf16_t* KI = (bf16_t*)(lds + GL_KI + dir * 9216) + (qt * 16) * 72 + dk;
      bf16_t* KIT = (bf16_t*)(lds + GL_KIT + dir * 9216) + dk * 72 + qt * 16;
      bf16_t* qdg = (bf16_t*)(ws + WS_QDEC) + (size_t)((tile * 4 + h) * 2 + dir) * 4096 + (qt * 16) * 64 + dk;
      const bf16_t* qgp = (const bf16_t*)(lds + GL_QS) + (qt * 16) * 64 + dk; const bf16_t* kgp = (const bf16_t*)(lds + GL_KS) + (qt * 16) * 64 + dk;
#pragma unroll 2
      for (int i = 0; i < 16; ++i) { const float bb = off + LAL[i * 512];
        const float qv = bf2f(qgp[i * 64]), kv = bf2f(kgp[i * 64]);
        const bf16_t qd = f2bf(qv * expf(bb)), ki = f2bf(kv * expf(-bb));
        QD[i * 72] = qd; KI[i * 72] = ki; qdg[i * 64] = qd; KIT[i] = ki; }
    }
    __syncthreads();
    if (w < 4) { const int mi = w >> 1, ni = w & 1;
      f32x16 asum;
#pragma unroll
      for (int i = 0; i < 16; ++i) asum[i] = 0.f;
#pragma unroll
      for (int d = 0; d < 2; ++d) { f32x16 acc;
#pragma unroll
        for (int i = 0; i < 16; ++i) acc[i] = 0.f;
#pragma unroll
        for (int s = 0; s < 4; ++s) { const bf16x8 a = *(const bf16x8*)(lds + GL_QD + d * 9216 + (mi * 32 + r) * 144 + s * 32 + hh * 16);
          const bf16x8 bb = *(const bf16x8*)(lds + GL_KI + d * 9216 + (ni * 32 + r) * 144 + s * 32 + hh * 16); acc = MFMA32(a, bb, acc); }
#pragma unroll
        for (int reg = 0; reg < 16; ++reg) { const int ti = mi * 32 + crow(reg, hh), tj = ni * 32 + r; const bool keep = d ? (tj >= ti) : (tj <= ti); asum[reg] += keep ? acc[reg] : 0.f; } }
      bf16_t* at = (bf16_t*)(lds + GL_ATT) + (mi * 32 + 4 * hh) * 72 + ni * 32 + r;
#pragma unroll
      for (int reg = 0; reg < 16; ++reg) at[((reg & 3) + 8 * (reg >> 2)) * 72] = f2bf(asum[reg]);
    }
    __syncthreads();
    { const int mi = w >> 2, ni = w & 3; f32x16 acc;
#pragma unroll
      for (int i = 0; i < 16; ++i) acc[i] = 0.f;
#pragma unroll
      for (int s = 0; s < 4; ++s) { const bf16x8 a = *(const bf16x8*)(lds + GL_ATT + (mi * 32 + r) * 144 + s * 32 + hh * 16);
        const bf16x8 bb = *(const bf16x8*)(lds + GL_VT + (ni * 32 + r) * 144 + s * 32 + hh * 16); acc = MFMA32(a, bb, acc); }
      bf16_t* oi = (bf16_t*)(ws + WS_OINTRA) + (size_t)(tok0 + mi * 32 + 4 * hh) * 512 + h * 128 + ni * 32 + r;
#pragma unroll
      for (int reg = 0; reg < 16; ++reg) oi[(size_t)((reg & 3) + 8 * (reg >> 2)) * 512] = f2bf(acc[reg]); }
    { const int dvb = w >> 1, dkb = w & 1;
#pragma unroll
      for (int d = 0; d < 2; ++d) { f32x16 acc;
#pragma unroll
        for (int i = 0; i < 16; ++i) acc[i] = 0.f;
#pragma unroll
        for (int s = 0; s < 4; ++s) { const bf16x8 a = *(const bf16x8*)(lds + GL_VT + (dvb * 32 + r) * 144 + s * 32 + hh * 16);
          const bf16x8 bb = *(const bf16x8*)(lds + GL_KIT + d * 9216 + (dkb * 32 + r) * 144 + s * 32 + hh * 16); acc = MFMA32(a, bb, acc); }
        const float sc = DECL[d * 64 + dkb * 32 + r];
        bf16_t* ds = (bf16_t*)(ws + WS_SPT) + ((size_t)((b * 4 + h) * 2 + d) * 32 + n) * 8192 + (size_t)(dvb * 32 + 4 * hh) * 64 + dkb * 32 + r;
#pragma unroll
        for (int reg = 0; reg < 16; ++reg) ds[((reg & 3) + 8 * (reg >> 2)) * 64] = f2bf(acc[reg] * sc); } }
  }
}

DI void phase1(const KP& p, char* lds) {
  const int tid = threadIdx.x, lane = tid & 63, w = tid >> 6, r = lane & 31, hh = lane >> 5;
  float* cs = (float*)(lds + LDS_TAB); float* sn = cs + 2048;
  char* wl = lds + w * WT_BYTES;
  for (int tile = blockIdx.x; tile < 256; tile += gridDim.x) {
    unsigned char* ws = launder(p.ws); unsigned char* ob = (unsigned char*)launder(p.out); const float* xin = launder(p.in[0]);
    const float* mod = (const float*)(ws + WS_MOD);
    const int tok0 = tile * 64, b = tile >> 5, t0 = (tile & 31) * 64;
    bf16_t* Hs = (bf16_t*)(ob + OUT_HS) + (size_t)tok0 * 1024;
    bf16_t* CQ = (bf16_t*)(ob + OUT_CQ) + (size_t)tok0 * 640;
    bf16_t* CQN = Hs; bf16_t* CKVN = Hs + 64 * 384;
    bf16_t* GR = (bf16_t*)(ob + OUT_GR) + (size_t)tok0 * 32;
    bf16_t* Qm = (bf16_t*)(ws + WS_QM); bf16_t* Km = (bf16_t*)(ws + WS_KM); bf16_t* Vm = (bf16_t*)(ws + WS_VM);
    bf16_t* qg = (bf16_t*)(ws + WS_P1S + (size_t)tile * 131072); bf16_t* kg = qg + 64 * 256; bf16_t* vg = qg + 2 * 64 * 256;
    bf16_t* rg = (bf16_t*)(ws + WS_RG) + (size_t)tok0 * 512;
    __syncthreads();
#pragma unroll
    for (int i = 0; i < 4; ++i) { const int e = tid + 512 * i, tt = e >> 5, j = e & 31;
      const float inv = powf(10000.f, -(float)j * (1.f / 32.f)); const float ang = (float)((const int*)p.in[2])[tok0 + tt] * inv;
      cs[e] = cosf(ang); sn[e] = sinf(ang); }
    {
      float4 ge[4], sh[4];
      const float* gpre = launder(p.in[5]); const float* modb = launder(mod) + b * 6144;
#pragma unroll
      for (int i = 0; i < 4; ++i) { const int d = (lane + 64 * i) * 4;
        const float4 g = *(const float4*)(gpre + d); const float4 sc = *(const float4*)(modb + 1024 + d); sh[i] = *(const float4*)(modb + d);
        ge[i] = make_float4(g.x * (1.f + sc.x), g.y * (1.f + sc.y), g.z * (1.f + sc.z), g.w * (1.f + sc.w)); }
#pragma unroll 2
      for (int rr = 0; rr < 8; ++rr) { const int row = w * 8 + rr;
        const float* xr = xin + (size_t)(tok0 + row) * 1024;
        float4 v[4]; float ss = 0.f;
#pragma unroll
        for (int i = 0; i < 4; ++i) { v[i] = *(const float4*)(xr + (lane + 64 * i) * 4); ss += v[i].x * v[i].x + v[i].y * v[i].y + v[i].z * v[i].z + v[i].w * v[i].w; }
        ss = wave_sum(ss); const float rs = rsqrtf(ss * (1.f / 1024.f) + EPS);
#pragma unroll
        for (int i = 0; i < 4; ++i) { uint2 o; o.x = pack2(v[i].x * rs * ge[i].x + sh[i].x, v[i].y * rs * ge[i].y + sh[i].y); o.y = pack2(v[i].z * rs * ge[i].z + sh[i].z, v[i].w * rs * ge[i].w + sh[i].w);
          *(uint2*)(Hs + (size_t)row * 1024 + (lane + 64 * i) * 4) = o; }
      }
    }
    __syncthreads();
    block_gemm(lds, Hs, 1024, (const bf16_t*)(ws + WS_WTIN), 1024, 9, 1024, [&](int m0, int n0, const f32x16& a0, const f32x16& a1) {
      const int r2 = lv(r), h2 = lv(hh), ln = lv(lane);
      if (n0 == O_KR) {
        wt_write_rope(wl, a0, a1, r2, h2, cs, sn, m0); LDS_FENCE();
        for (int h = 0; h < 4; ++h) { bf16_t* kp = Km + (((size_t)b * 4 + h) * SEQ + t0 + m0) * 192 + 128; wt_store(wl, ln, kp, 192, kp + 32, 192); }
        return; }
      wt_write(wl, a0, a1, r2, h2, (n0 >= O_QG && n0 < O_KG) ? 0.125f : 1.f); LDS_FENCE();
      bf16_t* d[2]; int st[2];
#pragma unroll
      for (int half = 0; half < 2; ++half) { const int nb = n0 + 32 * half;
        if (nb < 640) { d[half] = CQ + (size_t)m0 * 640 + nb; st[half] = 640; }
        else if (nb < O_KG) { d[half] = qg + (size_t)m0 * 256 + (nb - O_QG); st[half] = 256; }
        else if (nb < O_VG) { d[half] = kg + (size_t)m0 * 256 + (nb - O_KG); st[half] = 256; }
        else if (nb < O_GF) { d[half] = vg + (size_t)m0 * 512 + (nb - O_VG); st[half] = 512; }
        else if (nb < O_R) { d[half] = GR + (size_t)m0 * 32; st[half] = 32; }
        else if (nb < INW) { d[half] = rg + (size_t)m0 * 512 + (nb - O_R); st[half] = 512; }
        else { d[half] = nullptr; st[half] = 0; } }
      wt_store(wl, ln, d[0], st[0], d[1], st[1]);
    });
    __syncthreads();
    const float* gq = launder(p.in[8]); const float* gkv = launder(p.in[10]);
#pragma unroll 2
    for (int rr = 0; rr < 8; ++rr) { const int row = w * 8 + rr; const unsigned* cr = (const unsigned*)(CQ + (size_t)row * 640);
      float v0[5], v1[5];
#pragma unroll
      for (int i = 0; i < 5; ++i) { const unsigned u = cr[lane + 64 * i]; v0[i] = __uint_as_float(u << 16); v1[i] = __uint_as_float(u & 0xffff0000u); }
      float ss = v0[0] * v0[0] + v1[0] * v1[0] + v0[1] * v0[1] + v1[1] * v1[1] + v0[2] * v0[2] + v1[2] * v1[2];
      float s2 = v0[3] * v0[3] + v1[3] * v1[3] + v0[4] * v0[4] + v1[4] * v1[4];
      ss = wave_sum(ss); s2 = wave_sum(s2);
      const float rq = rsqrtf(ss * (1.f / 384.f) + EPS), rk = rsqrtf(s2 * (1.f / 256.f) + EPS);
#pragma unroll
      for (int i = 0; i < 3; ++i) { const int c = 2 * (lane + 64 * i); *(unsigned*)(CQN + (size_t)row * 384 + c) = pack2(v0[i] * rq * gq[c], v1[i] * rq * gq[c + 1]); }
#pragma unroll
      for (int i = 3; i < 5; ++i) { const int c = 2 * (lane + 64 * (i - 3)); *(unsigned*)(CKVN + (size_t)row * 256 + c) = pack2(v0[i] * rk * gkv[c], v1[i] * rk * gkv[c + 1]); }
    }
    __syncthreads();
    block_gemm(lds, CQN, 384, (const bf16_t*)(ws + WS_WTQUP), 384, 3, 384, [&](int m0, int n0, const f32x16& a0, const f32x16& a1) {
      const int r2 = lv(r), h2 = lv(hh), ln = lv(lane);
      const int h = n0 / 192, d0 = n0 % 192;
      bf16_t* qp = Qm + (((size_t)b * 4 + h) * SEQ + t0 + m0) * 192 + d0;
      if (d0 < 128) wt_write(wl, a0, a1, r2, h2, 1.f); else wt_write_rope(wl, a0, a1, r2, h2, cs, sn, m0);
      LDS_FENCE();
      wt_store(wl, ln, qp, 192, qp + 32, 192);
    });
    block_gemm(lds, CKVN, 256, (const bf16_t*)(ws + WS_WTKVUP), 256, 4, 256, [&](int m0, int n0, const f32x16& a0, const f32x16& a1) {
      const int r2 = lv(r), h2 = lv(hh), ln = lv(lane);
      const int h = n0 >> 8, d0 = n0 & 255;
      wt_write(wl, a0, a1, r2, h2, 1.f); LDS_FENCE();
      if (d0 < 128) { bf16_t* kp = Km + (((size_t)b * 4 + h) * SEQ + t0 + m0) * 192 + d0; wt_store(wl, ln, kp, 192, kp + 32, 192); }
      else { bf16_t* vp = Vm + (((size_t)b * 4 + h) * SEQ + t0 + m0) * 128 + (d0 - 128); wt_store(wl, ln, vp, 128, vp + 32, 128); }
    });
    gla_chunk_local(p, lds, ws, tile, qg, kg, vg, GR);
  }
}

namespace att {
typedef short s16x4 __attribute__((ext_vector_type(4)));
typedef unsigned u32x4 __attribute__((ext_vector_type(4)));
constexpr int DQ = 192, DV = 128, KVBLK = 64;
constexpr float SCALE = 0.07216878364870322f;
constexpr float THR = 8.f;
constexpr int SHM_V = KVBLK * DV * 2, SHM_K = KVBLK * DQ * 2;
constexpr int SHM_QR = 8 * 32 * 176;
constexpr int SHM_ATTN = 2 * SHM_V + 2 * SHM_K + 8 * 64 * 4 + SHM_QR;
#define KSWZ(row, colB) ((row) * 384 + ((colB) ^ (((row) & 7) << 4)))
#define SBAR() __builtin_amdgcn_sched_barrier(0)
DI unsigned cvtpk(float lo, float hi) { unsigned r; asm volatile("v_cvt_pk_bf16_f32 %0, %1, %2" : "=v"(r) : "v"(lo), "v"(hi)); return r; }

DI void partialSM(f32x16& p0, f32x16& p1, float& m_reg, float& mn, float& alpha) {
  constexpr float C = SCALE * 1.4426950408889634f;
  float pmax = p0[0];
#pragma unroll
  for (int r = 1; r < 16; ++r) pmax = fmaxf(pmax, p0[r]);
#pragma unroll
  for (int r = 0; r < 16; ++r) pmax = fmaxf(pmax, p1[r]);
  { auto rr = __builtin_amdgcn_permlane32_swap(__float_as_uint(pmax), __float_as_uint(pmax), false, false);
    pmax = fmaxf(__uint_as_float(rr[0]), __uint_as_float(rr[1])); }
  if (__builtin_expect(__all(pmax - m_reg <= THR / SCALE), 1)) { mn = m_reg; alpha = 1.f; }
  else { mn = fmaxf(m_reg, pmax); alpha = __builtin_amdgcn_exp2f((m_reg - mn) * C); m_reg = mn; }
  const float mnC = -mn * C;
#pragma unroll
  for (int r = 0; r < 16; ++r) p0[r] = fmaf(p0[r], C, mnC);
#pragma unroll
  for (int r = 0; r < 16; ++r) p1[r] = fmaf(p1[r], C, mnC);
#pragma unroll
  for (int r = 0; r < 16; ++r) p0[r] = __builtin_amdgcn_exp2f(p0[r]);
}
DI void finishSM(f32x16& p0, f32x16& p1, float alpha, float& l_reg, bf16x8& pa0, bf16x8& pa1, bf16x8& pa2, bf16x8& pa3) {
#pragma unroll
  for (int r = 0; r < 16; ++r) p1[r] = __builtin_amdgcn_exp2f(p1[r]);
  float ps = 0;
#pragma unroll
  for (int r = 0; r < 16; ++r) ps += p0[r];
#pragma unroll
  for (int r = 0; r < 16; ++r) ps += p1[r];
  { auto rr = __builtin_amdgcn_permlane32_swap(__float_as_uint(ps), __float_as_uint(ps), false, false);
    ps = __uint_as_float(rr[0]) + __uint_as_float(rr[1]); }
  l_reg = l_reg * alpha + ps;
#define PK4(P, BASE, OUT) do { unsigned a0 = cvtpk(P[BASE + 0], P[BASE + 1]), a1 = cvtpk(P[BASE + 2], P[BASE + 3]);   \
    unsigned b0 = cvtpk(P[BASE + 4], P[BASE + 5]), b1 = cvtpk(P[BASE + 6], P[BASE + 7]);                              \
    auto r0 = __builtin_amdgcn_permlane32_swap(a0, b0, false, false); auto r1 = __builtin_amdgcn_permlane32_swap(a1, b1, false, false); \
    u32x4 wv = {r0[0], r1[0], r0[1], r1[1]}; OUT = *reinterpret_cast<bf16x8*>(&wv); } while (0)
  PK4(p0, 0, pa0); PK4(p0, 8, pa1); PK4(p1, 0, pa2); PK4(p1, 8, pa3);
#undef PK4
}
DI void qkt(f32x16& p0, f32x16& p1, const char* Ks, const bf16x8* qr, const char* qrl, int r32, int hi) {
#pragma unroll
  for (int i = 0; i < 16; ++i) { p0[i] = 0.f; p1[i] = 0.f; }
#pragma unroll
  for (int d0 = 0; d0 < 12; ++d0) { const int cb = (d0 * 16 + hi * 8) * 2;
    const bf16x8 b0 = *reinterpret_cast<const bf16x8*>(Ks + KSWZ(r32, cb));
    const bf16x8 b1 = *reinterpret_cast<const bf16x8*>(Ks + KSWZ(32 + r32, cb));
    const bf16x8 q = (d0 < 7) ? qr[d0 < 7 ? d0 : 0] : *reinterpret_cast<const bf16x8*>(qrl + (d0 - 7) * 32);
    p0 = MFMA32(b0, q, p0);
    p1 = MFMA32(b1, q, p1); }
}
DI int v_st(int k, int c) { const int kk = (k & ~0xC) | ((k & 4) << 1) | ((k & 8) >> 1); return ((kk >> 3) * 4 + (c >> 5)) * 512 + ((kk & 7) * 32 + (c & 31)) * 2; }
DI int v_rd_base(int lane) { return ((lane & 3) << 3) | (((lane >> 2) & 3) << 6) | (((lane >> 4) & 1) << 5) | (((lane >> 5) & 1) << 8); }
constexpr int v_rd_off(int d0, int ks, int half) { return d0 * 512 + ks * 4096 + half * 2048; }
template <int OFF> DI s16x4 tr_read(int vb) { s16x4 r; asm volatile("ds_read_b64_tr_b16 %0, %1 offset:%2" : "=&v"(r) : "v"(vb), "i"(OFF) : "memory"); return r; }
template <int D0> DI void pv_one(f32x16& od, int vb, bf16x8 pa0, bf16x8 pa1, bf16x8 pa2, bf16x8 pa3) {
  const s16x4 l0 = tr_read<v_rd_off(D0, 0, 0)>(vb), h0 = tr_read<v_rd_off(D0, 0, 1)>(vb), l1 = tr_read<v_rd_off(D0, 1, 0)>(vb), h1 = tr_read<v_rd_off(D0, 1, 1)>(vb);
  const s16x4 l2 = tr_read<v_rd_off(D0, 2, 0)>(vb), h2 = tr_read<v_rd_off(D0, 2, 1)>(vb), l3 = tr_read<v_rd_off(D0, 3, 0)>(vb), h3 = tr_read<v_rd_off(D0, 3, 1)>(vb);
  asm volatile("s_waitcnt lgkmcnt(0)" ::: "memory"); SBAR();
#define PK(L, H) (bf16x8){L[0], L[1], L[2], L[3], H[0], H[1], H[2], H[3]}
  od = MFMA32(pa0, PK(l0, h0), od);
  od = MFMA32(pa1, PK(l1, h1), od);
  od = MFMA32(pa2, PK(l2, h2), od);
  od = MFMA32(pa3, PK(l3, h3), od);
#undef PK
}
DI void pv_d0(f32x16* o, int vb, bf16x8 pa0, bf16x8 pa1, bf16x8 pa2, bf16x8 pa3) {
  pv_one<0>(o[0], vb, pa0, pa1, pa2, pa3); pv_one<1>(o[1], vb, pa0, pa1, pa2, pa3); pv_one<2>(o[2], vb, pa0, pa1, pa2, pa3); pv_one<3>(o[3], vb, pa0, pa1, pa2, pa3);
}
DI void attn_unit(const bf16_t* Qb, const bf16_t* Kh, const bf16_t* Vh, bf16_t* Ob, int seq, char* lds) {
  const int tid = lv(threadIdx.x), wid = tid >> 6, lane = tid & 63, r32 = lane & 31, hi = lane >> 5;
  char* V_lds = lds; char* K_lds = lds + 2 * SHM_V;
  float* wsf = (float*)(lds + 2 * SHM_V + 2 * SHM_K) + wid * 64; float* li_l = wsf; float* al_l = wsf + 32;
  char* qrl = lds + 2 * SHM_V + 2 * SHM_K + 8 * 64 * 4 + wid * (32 * 176) + r32 * 176 + hi * 16;
  float m_reg = -1e30f, l_reg = 0; f32x16 o[4]; bf16x8 qr[7];
#pragma unroll
  for (int d = 0; d < 4; ++d)
#pragma unroll
    for (int i = 0; i < 16; ++i) o[d][i] = 0.f;
  const bf16_t* Qw = Qb + (size_t)(wid * 32 + r32) * DQ + hi * 8;
#pragma unroll
  for (int d0 = 0; d0 < 7; ++d0) qr[d0] = *reinterpret_cast<const bf16x8*>(Qw + d0 * 16);
#pragma unroll
  for (int d0 = 7; d0 < 12; ++d0) *reinterpret_cast<bf16x8*>(qrl + (d0 - 7) * 32) = *reinterpret_cast<const bf16x8*>(Qw + d0 * 16);
  int kst[3];
#pragma unroll
  for (int i = 0; i < 3; ++i) { const int c = tid + 512 * i; kst[i] = KSWZ(c / 24, (c % 24) * 16); }
  const int vst0 = v_st(tid >> 4, (tid & 15) * 8), vst1 = v_st(32 + (tid >> 4), (tid & 15) * 8);
  const int vb0 = (int)(uintptr_t)V_lds + v_rd_base(lane);
  bf16x8 sk0, sk1, sk2, sv0, sv1;
#define SLOAD(k0) do { const bf16x8* kp = reinterpret_cast<const bf16x8*>(Kh + (size_t)(k0) * DQ) + tid; sk0 = kp[0]; sk1 = kp[512]; sk2 = kp[1024]; \
    const bf16x8* vp = reinterpret_cast<const bf16x8*>(Vh + (size_t)(k0) * DV) + tid; sv0 = vp[0]; sv1 = vp[512]; } while (0)
#define SWRITE(b) do { *(bf16x8*)(V_lds + (b) * SHM_V + vst0) = sv0; *(bf16x8*)(V_lds + (b) * SHM_V + vst1) = sv1; \
    *(bf16x8*)(K_lds + (b) * SHM_K + kst[0]) = sk0; *(bf16x8*)(K_lds + (b) * SHM_K + kst[1]) = sk1; *(bf16x8*)(K_lds + (b) * SHM_K + kst[2]) = sk2; } while (0)
#define RESC(a) do { if (__any((a) < 1.f)) { if (hi == 0) al_l[r32] = (a); asm volatile("s_waitcnt lgkmcnt(0)" ::: "memory"); \
    _Pragma("unroll") for (int d = 0; d < 4; ++d) _Pragma("unroll") for (int r = 0; r < 16; ++r) o[d][r] *= al_l[crow(r, hi)]; } } while (0)
  f32x16 pA0, pA1, pB0, pB1; float mnA, mnB, alA, alB; bf16x8 pa0, pa1, pa2, pa3; const int NT = seq / KVBLK;
  SLOAD(0); SWRITE(0); __syncthreads();
  qkt(pA0, pA1, K_lds, qr, qrl, r32, hi); partialSM(pA0, pA1, m_reg, mnA, alA);
  SLOAD(KVBLK); SWRITE(1); __syncthreads();
  for (int j = 1; j + 1 < NT; j += 2) {
    SBAR(); qkt(pB0, pB1, K_lds + SHM_K, qr, qrl, r32, hi);
    finishSM(pA0, pA1, alA, l_reg, pa0, pa1, pa2, pa3); SBAR();
    SLOAD((j + 1) * KVBLK); SBAR();
    pv_d0(o, vb0, pa0, pa1, pa2, pa3); partialSM(pB0, pB1, m_reg, mnB, alB);
    __syncthreads(); SWRITE(0);
    RESC(alB); __syncthreads();
    SBAR(); qkt(pA0, pA1, K_lds, qr, qrl, r32, hi);
    finishSM(pB0, pB1, alB, l_reg, pa0, pa1, pa2, pa3); SBAR();
    SLOAD((j + 2) * KVBLK); SBAR();
    pv_d0(o, vb0 + SHM_V, pa0, pa1, pa2, pa3); partialSM(pA0, pA1, m_reg, mnA, alA);
    __syncthreads(); SWRITE(1);
    RESC(alA); __syncthreads();
  }
  SBAR(); qkt(pB0, pB1, K_lds + SHM_K, qr, qrl, r32, hi);
  finishSM(pA0, pA1, alA, l_reg, pa0, pa1, pa2, pa3); SBAR();
  pv_d0(o, vb0, pa0, pa1, pa2, pa3); partialSM(pB0, pB1, m_reg, mnB, alB);
  __syncthreads(); RESC(alB);
  finishSM(pB0, pB1, alB, l_reg, pa0, pa1, pa2, pa3); SBAR();
  pv_d0(o, vb0 + SHM_V, pa0, pa1, pa2, pa3);
  if (hi == 0) li_l[r32] = l_reg; asm volatile("s_waitcnt lgkmcnt(0)" ::: "memory");
  float rli[16];
#pragma unroll
  for (int r = 0; r < 16; ++r) rli[r] = __builtin_amdgcn_rcpf(li_l[crow(r, hi)]);
  bf16_t* Ow = Ob + (size_t)(wid * 32) * 1024;
#pragma unroll
  for (int r = 0; r < 16; ++r) { const int orow = crow(r, hi);
#pragma unroll
    for (int d0 = 0; d0 < 4; ++d0) Ow[(size_t)orow * 1024 + d0 * 32 + r32] = f2bf(o[d0][r] * rli[r]); }
  __syncthreads();
#undef SLOAD
#undef SWRITE
#undef RESC
}
}

DI void phase2_attn(const KP& p, char* lds) {
  for (int u = blockIdx.x; u < 256; u += gridDim.x) {
    unsigned char* ws = launder(p.ws);
    const bf16_t* Qm = (const bf16_t*)(ws + WS_QM); const bf16_t* Km = (const bf16_t*)(ws + WS_KM); const bf16_t* Vm = (const bf16_t*)(ws + WS_VM);
    bf16_t* mixa = (bf16_t*)(ws + WS_P1S);
    const int qb = u & 7, bh = u >> 3, b = bh >> 2, h = bh & 3;
    att::attn_unit(Qm + ((size_t)bh * SEQ + qb * 256) * 192, Km + (size_t)bh * SEQ * 192, Vm + (size_t)bh * SEQ * 128,
                   mixa + ((size_t)b * SEQ + qb * 256) * 1024 + h * 128, SEQ, lds);
  }
}

constexpr int P3_TILE_BYTES = 256 * 1024;
constexpr int LDS_TK = LDS_GEMM;
constexpr int SCW = 260;
template <int N> DI void ce_desc(float (&a)[N], int i, int l) { const float hi = fmaxf(a[i], a[l]), lo = fminf(a[i], a[l]); a[i] = hi; a[l] = lo; }
DI void sort16_desc(float (&a)[16]) {
#pragma unroll
  for (int k = 2; k <= 16; k <<= 1)
#pragma unroll
    for (int j = k >> 1; j > 0; j >>= 1)
#pragma unroll
      for (int i = 0; i < 16; ++i) { const int l = i ^ j; if (l > i) { if ((i & k) == 0) ce_desc(a, i, l); else ce_desc(a, l, i); } }
}
DI void merge16_desc(float (&a)[16]) {
#pragma unroll
  for (int j = 8; j > 0; j >>= 1)
#pragma unroll
    for (int i = 0; i < 16; ++i) { const int l = i ^ j; if (l > i) ce_desc(a, i, l); }
}
DI void top16_merge(float (&a)[16], const float (&b)[16]) {
#pragma unroll
  for (int i = 0; i < 16; ++i) a[i] = fmaxf(a[i], b[15 - i]);
  merge16_desc(a);
}
template <int CTRL> DI float dpp_f(float v) { return __int_as_float(__builtin_amdgcn_mov_dpp(__float_as_int(v), CTRL, 0xF, 0xF, true)); }

DI float gelu_fast(float x) { return 0.5f * x * (1.f + erff(x * 0.70710678118654752f)); }

DI void phase3(const KP& p, char* lds, const int gather_reps, const int probe) {
  const int tid0 = threadIdx.x;
  const int r = tid0 & 31, hh = (tid0 >> 5) & 1, lane = tid0 & 63;
  char* wl = lds + (tid0 >> 6) * WT_BYTES;
  for (int tile = blockIdx.x; tile < 256; tile += gridDim.x) {
    unsigned char* ws = launder(p.ws); float* outp = launder(p.out); const float* xin = launder(p.in[0]);
    const int tok0 = tile * 64, b = tile >> 5;
    unsigned char* tsc = ws + WS_QM + (size_t)tile * P3_TILE_BYTES;
    bf16_t* QRY = (bf16_t*)tsc; bf16_t* Y = (bf16_t*)tsc; bf16_t* MIXA = (bf16_t*)(ws + WS_P1S) + (size_t)tok0 * 1024; bf16_t* H2 = MIXA;
    const float* modb = launder((const float*)(ws + WS_MOD)) + b * 6144;
    __syncthreads();
    {
      const int tid = lv(tid0), lane = tid & 63, w = tid >> 6, r = lane & 31, hh = lane >> 5;
      const int h = w >> 1, mi = w & 1, n = tile & 31;
      const bf16_t* QDg = (const bf16_t*)(ws + WS_QDEC) + (size_t)(tile * 4 + h) * 2 * 4096 + (mi * 32 + r) * 64 + hh * 8;
      const bf16_t* SPg = (const bf16_t*)(ws + WS_SPT) + ((size_t)((b * 4 + h) * 2) * 32 + n) * 8192 + r * 64 + hh * 8;
      f32x16 acc[4];
#pragma unroll
      for (int ni = 0; ni < 4; ++ni)
#pragma unroll
        for (int i = 0; i < 16; ++i) acc[ni][i] = 0.f;
#pragma unroll
      for (int d = 0; d < 2; ++d)
#pragma unroll
        for (int s = 0; s < 4; ++s) { const bf16x8 a = *(const bf16x8*)(QDg + d * 4096 + s * 16);
#pragma unroll
          for (int ni = 0; ni < 4; ++ni) { const bf16x8 bb = *(const bf16x8*)(SPg + (size_t)d * 32 * 8192 + ni * 32 * 64 + s * 16); acc[ni] = MFMA32(a, bb, acc[ni]); } }
      const bf16_t* OI = (const bf16_t*)(ws + WS_OINTRA) + (size_t)(tok0 + mi * 32 + 4 * hh) * 512 + h * 128 + r;
#pragma unroll
      for (int ni = 0; ni < 4; ++ni)
#pragma unroll
        for (int reg = 0; reg < 16; ++reg) acc[ni][reg] += bf2f(OI[(size_t)((reg & 3) + 8 * (reg >> 2)) * 512 + ni * 32]);
      float rs[16];
#pragma unroll
      for (int reg = 0; reg < 16; ++reg) { float v = acc[0][reg] * acc[0][reg] + acc[1][reg] * acc[1][reg] + acc[2][reg] * acc[2][reg] + acc[3][reg] * acc[3][reg];
        v += __shfl_xor(v, 1); v += __shfl_xor(v, 2); v += __shfl_xor(v, 4); v += __shfl_xor(v, 8); v += __shfl_xor(v, 16);
        rs[reg] = rsqrtf(v * (1.f / 128.f) + EPS); }
      const float* ggl = launder(p.in[16]);
      const bf16_t* RGp = (const bf16_t*)(ws + WS_RG) + (size_t)(tok0 + mi * 32 + 4 * hh) * 512 + h * 128 + r;
      bf16_t* MX = MIXA + (size_t)(mi * 32 + 4 * hh) * 1024 + 512 + h * 128 + r;
#pragma unroll
      for (int ni = 0; ni < 4; ++ni) { const float g = ggl[ni * 32 + r];
#pragma unroll
        for (int reg = 0; reg < 16; ++reg) { const int ro = (reg & 3) + 8 * (reg >> 2); const float rv = bf2f(RGp[(size_t)ro * 512 + ni * 32]);
          MX[(size_t)ro * 1024 + ni * 32] = f2bf(acc[ni][reg] * rs[reg] * g * silu_f(rv)); } }
    }
    __syncthreads();
    for (int rep3b = 0; rep3b < (probe == 5 ? 2 : 1); ++rep3b)
    block_gemm(lds, MIXA, 1024, (const bf16_t*)(ws + WS_WTOUT), 1024, 4, 1024, [&](int m0, int n0, const f32x16& a0, const f32x16& a1) {
      const int r2 = lv(r), h2 = lv(hh), ln = lv(lane);
      wt_write(wl, a0, a1, r2, h2, 1.f); LDS_FENCE();
      bf16_t* d = Y + (size_t)m0 * 1024 + n0; wt_store(wl, ln, d, 1024, d + 32, 1024);
    });
    __syncthreads();
    {
      const int tid = lv(tid0), lane = tid & 63, w = tid >> 6;
      float4 A1[4], A2[4], S2[4];
      const float* gpo = launder(p.in[6]); const float* gpf = launder(p.in[18]);
#pragma unroll
      for (int i = 0; i < 4; ++i) { const int d = (lane + 64 * i) * 4;
        const float4 gp = *(const float4*)(gpo + d), gt = *(const float4*)(modb + 2048 + d), g2 = *(const float4*)(gpf + d), sc = *(const float4*)(modb + 4096 + d);
        S2[i] = *(const float4*)(modb + 3072 + d);
        A1[i] = make_float4(gp.x * gt.x, gp.y * gt.y, gp.z * gt.z, gp.w * gt.w);
        A2[i] = make_float4(g2.x * (1.f + sc.x), g2.y * (1.f + sc.y), g2.z * (1.f + sc.z), g2.w * (1.f + sc.w)); }
#pragma unroll 2
      for (int rr = 0; rr < 8; ++rr) { const int row = w * 8 + rr; const size_t tok = tok0 + row;
        float4 yv[4]; float ss = 0.f;
#pragma unroll
        for (int i = 0; i < 4; ++i) { const uint2 u = *(const uint2*)(Y + (size_t)row * 1024 + (lane + 64 * i) * 4);
          yv[i] = make_float4(__uint_as_float(u.x << 16), __uint_as_float(u.x & 0xffff0000u), __uint_as_float(u.y << 16), __uint_as_float(u.y & 0xffff0000u));
          ss += yv[i].x * yv[i].x + yv[i].y * yv[i].y + yv[i].z * yv[i].z + yv[i].w * yv[i].w; }
        ss = wave_sum(ss); const float rs = rsqrtf(ss * (1.f / 1024.f) + EPS);
        float4 xv[4]; float s2 = 0.f;
#pragma unroll
        for (int i = 0; i < 4; ++i) { const float4 x = *(const float4*)(xin + tok * 1024 + (lane + 64 * i) * 4);
          xv[i] = make_float4(x.x + A1[i].x * yv[i].x * rs, x.y + A1[i].y * yv[i].y * rs, x.z + A1[i].z * yv[i].z * rs, x.w + A1[i].w * yv[i].w * rs);
          *(float4*)(outp + tok * 1024 + (lane + 64 * i) * 4) = xv[i];
          s2 += xv[i].x * xv[i].x + xv[i].y * xv[i].y + xv[i].z * xv[i].z + xv[i].w * xv[i].w; }
        s2 = wave_sum(s2); const float r2 = rsqrtf(s2 * (1.f / 1024.f) + EPS);
#pragma unroll
        for (int i = 0; i < 4; ++i) { uint2 o; o.x = pack2(xv[i].x * r2 * A2[i].x + S2[i].x, xv[i].y * r2 * A2[i].y + S2[i].y); o.y = pack2(xv[i].z * r2 * A2[i].z + S2[i].z, xv[i].w * r2 * A2[i].w + S2[i].w);
          *(uint2*)(H2 + (size_t)row * 1024 + (lane + 64 * i) * 4) = o; }
      }
    }
    __syncthreads();
    for (int rep3d = 0; rep3d < (probe == 6 ? 2 : 1); ++rep3d)
    block_gemm(lds, H2, 1024, (const bf16_t*)(ws + WS_WTPQ), 1024, 8, 1024, [&](int m0, int n0, const f32x16& a0, const f32x16& a1) {
      const int r2 = lv(r), h2 = lv(hh), ln = lv(lane);
      wt_write(wl, a0, a1, r2, h2, 1.f); LDS_FENCE();
      bf16_t* d = QRY + (size_t)m0 * 2048 + n0; wt_store(wl, ln, d, 2048, d + 32, 2048);
    });
    float* SC = (float*)lds; unsigned* TK = (unsigned*)(lds + LDS_TK);
    for (int rep3e = 0; rep3e < (probe == 7 ? 2 : 1); ++rep3e)
    for (int h = 0; h < 8; ++h) {
      block_gemm(lds, QRY + h * 256, 2048, (const bf16_t*)(ws + WS_KD), 256, 1, 256, [&](int m0, int n0, const f32x16& a0, const f32x16& a1) {
        const int r2 = lv(r), h2 = lv(hh);
        float* sp = SC + (m0 + 4 * h2) * SCW + n0 + r2;
#pragma unroll
        for (int reg = 0; reg < 16; ++reg) { const int ro = ((reg & 3) + 8 * (reg >> 2)) * SCW; sp[ro] = a0[reg]; sp[ro + 32] = a1[reg]; }
      });
      {
        const int tid = lv(tid0);
        const int tt = tid >> 3, sd = (tid >> 2) & 1, q = tid & 3;
        const float* sr = SC + tt * SCW + sd * 128 + q * 32;
        float a[16], c[16];
#pragma unroll
        for (int i = 0; i < 4; ++i) { const float4 v = *(const float4*)(sr + i * 4); const unsigned ib = q * 32 + i * 4;
          a[i * 4 + 0] = __uint_as_float((__float_as_uint(v.x) & 0xFFFFFF80u) | (ib + 0)); a[i * 4 + 1] = __uint_as_float((__float_as_uint(v.y) & 0xFFFFFF80u) | (ib + 1));
          a[i * 4 + 2] = __uint_as_float((__float_as_uint(v.z) & 0xFFFFFF80u) | (ib + 2)); a[i * 4 + 3] = __uint_as_float((__float_as_uint(v.w) & 0xFFFFFF80u) | (ib + 3)); }
#pragma unroll
        for (int i = 0; i < 4; ++i) { const float4 v = *(const float4*)(sr + 16 + i * 4); const unsigned ib = q * 32 + 16 + i * 4;
          c[i * 4 + 0] = __uint_as_float((__float_as_uint(v.x) & 0xFFFFFF80u) | (ib + 0)); c[i * 4 + 1] = __uint_as_float((__float_as_uint(v.y) & 0xFFFFFF80u) | (ib + 1));
          c[i * 4 + 2] = __uint_as_float((__float_as_uint(v.z) & 0xFFFFFF80u) | (ib + 2)); c[i * 4 + 3] = __uint_as_float((__float_as_uint(v.w) & 0xFFFFFF80u) | (ib + 3)); }
        sort16_desc(a); sort16_desc(c); top16_merge(a, c);
#pragma unroll
        for (int i = 0; i < 16; ++i) c[i] = dpp_f<0xB1>(a[i]);
        top16_merge(a, c);
#pragma unroll
        for (int i = 0; i < 16; ++i) c[i] = dpp_f<0x4E>(a[i]);
        top16_merge(a, c);
        if (q == 0) { unsigned* tk = TK + ((tt * 8 + h) * 2 + sd) * 16;
#pragma unroll
          for (int i = 0; i < 4; ++i) *(uint4*)(tk + i * 4) = make_uint4(__float_as_uint(a[i * 4]), __float_as_uint(a[i * 4 + 1]), __float_as_uint(a[i * 4 + 2]), __float_as_uint(a[i * 4 + 3])); }
      }
      __syncthreads();
    }
    int* EIDX = (int*)lds; float* GATE = (float*)(lds + 32768);
    {
      const int tid = lv(tid0);
      const int tt = tid >> 3, h = tid & 7;
      const unsigned* t1 = TK + ((tt * 8 + h) * 2) * 16; const unsigned* t2 = t1 + 16;
      float v1[16], v2[16];
#pragma unroll
      for (int i = 0; i < 4; ++i) { const uint4 u = *(const uint4*)(t1 + i * 4), v = *(const uint4*)(t2 + i * 4);
        v1[i * 4] = __uint_as_float(u.x & 0xFFFFFF80u); v1[i * 4 + 1] = __uint_as_float(u.y & 0xFFFFFF80u); v1[i * 4 + 2] = __uint_as_float(u.z & 0xFFFFFF80u); v1[i * 4 + 3] = __uint_as_float(u.w & 0xFFFFFF80u);
        v2[i * 4] = __uint_as_float(v.x & 0xFFFFFF80u); v2[i * 4 + 1] = __uint_as_float(v.y & 0xFFFFFF80u); v2[i * 4 + 2] = __uint_as_float(v.z & 0xFFFFFF80u); v2[i * 4 + 3] = __uint_as_float(v.w & 0xFFFFFF80u); }
      float best[16], grp[16];
#define CAND(i, j) __uint_as_float((__float_as_uint(v1[i] + v2[j]) & 0xFFFFFF00u) | ((i) << 4) | (j))
      best[0] = CAND(0, 0); best[1] = CAND(0, 1); best[2] = CAND(0, 2); best[3] = CAND(0, 3); best[4] = CAND(0, 4); best[5] = CAND(0, 5); best[6] = CAND(0, 6); best[7] = CAND(0, 7);
      best[8] = CAND(0, 8); best[9] = CAND(0, 9); best[10] = CAND(0, 10); best[11] = CAND(0, 11); best[12] = CAND(0, 12); best[13] = CAND(0, 13); best[14] = CAND(0, 14); best[15] = CAND(0, 15);
      sort16_desc(best);
      grp[0] = CAND(1, 0); grp[1] = CAND(1, 1); grp[2] = CAND(1, 2); grp[3] = CAND(1, 3); grp[4] = CAND(1, 4); grp[5] = CAND(1, 5); grp[6] = CAND(1, 6); grp[7] = CAND(1, 7);
      grp[8] = CAND(2, 0); grp[9] = CAND(2, 1); grp[10] = CAND(2, 2); grp[11] = CAND(2, 3); grp[12] = CAND(2, 4); grp[13] = CAND(3, 0); grp[14] = CAND(3, 1); grp[15] = CAND(3, 2);
      sort16_desc(grp); top16_merge(best, grp);
      grp[0] = CAND(3, 3); grp[1] = CAND(4, 0); grp[2] = CAND(4, 1); grp[3] = CAND(4, 2); grp[4] = CAND(5, 0); grp[5] = CAND(5, 1); grp[6] = CAND(6, 0); grp[7] = CAND(6, 1);
      grp[8] = CAND(7, 0); grp[9] = CAND(7, 1); grp[10] = CAND(8, 0); grp[11] = CAND(9, 0); grp[12] = CAND(10, 0); grp[13] = CAND(11, 0); grp[14] = CAND(12, 0); grp[15] = CAND(13, 0);
      sort16_desc(grp); top16_merge(best, grp);
      { const float c14 = CAND(14, 0), c15 = CAND(15, 0);
        grp[0] = fmaxf(c14, c15); grp[1] = fminf(c14, c15);
#pragma unroll
        for (int i = 2; i < 16; ++i) grp[i] = -3.0e38f;
        top16_merge(best, grp); }
#undef CAND
      __syncthreads();
      float sv[16]; int ev[16]; float mx = -3.0e38f;
#pragma unroll
      for (int k = 0; k < 16; ++k) { const unsigned key = __float_as_uint(best[k]); const int ci = (key >> 4) & 15, cj = key & 15;
        const unsigned k1 = t1[ci], k2 = t2[cj];
        sv[k] = __uint_as_float(k1 & 0xFFFFFF80u) + __uint_as_float(k2 & 0xFFFFFF80u); ev[k] = (int)((k1 & 127u) * 128u + (k2 & 127u)); mx = fmaxf(mx, sv[k]); }
      float sum = 0.f;
#pragma unroll
      for (int k = 0; k < 16; ++k) { sv[k] = __expf(sv[k] - mx); sum += sv[k]; }
      const float inv = 1.f / sum;
#pragma unroll
      for (int k = 0; k < 16; ++k) { EIDX[tt * 128 + h * 16 + k] = ev[k]; GATE[tt * 128 + h * 16 + k] = sv[k] * inv; }
    }
    __syncthreads();
    {
      const int tid = lv(tid0), lane = tid & 63, w = tid >> 6;
      const unsigned char* EU = ws + WS_EU; const unsigned char* EV = ws + WS_EV; const float* SCU = (const float*)(ws + WS_ESC); const float* SCV = SCU + 16384;
      const float* gpf2 = launder(p.in[19]);
      typedef float f2v __attribute__((ext_vector_type(2)));
#define FP8X4(wd, o0, o1, o2, o3) do { const f2v lo_ = __builtin_amdgcn_cvt_pk_f32_fp8((int)(wd), false), hi_ = __builtin_amdgcn_cvt_pk_f32_fp8((int)(wd), true); o0 = lo_.x; o1 = lo_.y; o2 = hi_.x; o3 = hi_.y; } while (0)
#pragma unroll 1
      for (int pass = 0; pass < gather_reps; ++pass)
#pragma unroll 1
      for (int rr = 0; rr < 8; ++rr) { const int row = w * 8 + rr; const size_t tok = tok0 + row;
        float hf[16];
        { const uint4 hA = *(const uint4*)(H2 + (size_t)row * 1024 + lane * 16), hB = *(const uint4*)(H2 + (size_t)row * 1024 + lane * 16 + 8);
          hf[0] = __uint_as_float(hA.x << 16); hf[1] = __uint_as_float(hA.x & 0xffff0000u); hf[2] = __uint_as_float(hA.y << 16); hf[3] = __uint_as_float(hA.y & 0xffff0000u);
          hf[4] = __uint_as_float(hA.z << 16); hf[5] = __uint_as_float(hA.z & 0xffff0000u); hf[6] = __uint_as_float(hA.w << 16); hf[7] = __uint_as_float(hA.w & 0xffff0000u);
          hf[8] = __uint_as_float(hB.x << 16); hf[9] = __uint_as_float(hB.x & 0xffff0000u); hf[10] = __uint_as_float(hB.y << 16); hf[11] = __uint_as_float(hB.y & 0xffff0000u);
          hf[12] = __uint_as_float(hB.z << 16); hf[13] = __uint_as_float(hB.z & 0xffff0000u); hf[14] = __uint_as_float(hB.w << 16); hf[15] = __uint_as_float(hB.w & 0xffff0000u); }
        float acc[16];
#pragma unroll
        for (int i = 0; i < 16; ++i) acc[i] = 0.f;
#pragma unroll 1
        for (int g = 0; g < 16; ++g) {
          const int* ep = EIDX + row * 128 + g * 8;
          const int4 ea = *(const int4*)ep, eb = *(const int4*)(ep + 4);
          int es[8];
          es[0] = __builtin_amdgcn_readfirstlane(ea.x); es[1] = __builtin_amdgcn_readfirstlane(ea.y); es[2] = __builtin_amdgcn_readfirstlane(ea.z); es[3] = __builtin_amdgcn_readfirstlane(ea.w);
          es[4] = __builtin_amdgcn_readfirstlane(eb.x); es[5] = __builtin_amdgcn_readfirstlane(eb.y); es[6] = __builtin_amdgcn_readfirstlane(eb.z); es[7] = __builtin_amdgcn_readfirstlane(eb.w);
          uint4 u[8], v[8];
#pragma unroll
          for (int k2 = 0; k2 < 8; ++k2) u[k2] = *(const uint4*)(EU + (size_t)es[k2] * 1024 + lane * 16);
#pragma unroll
          for (int k2 = 0; k2 < 8; ++k2) v[k2] = *(const uint4*)(EV + (size_t)es[k2] * 1024 + lane * 16);
          const int eslot = ep[lane & 7];
          const float gte = GATE[row * 128 + g * 8 + (lane & 7)], su = SCU[eslot], sv = SCV[eslot];
          float P[8];
#pragma unroll
          for (int k2 = 0; k2 < 8; ++k2) { float a0, a1, a2, a3, d;
            FP8X4(u[k2].x, a0, a1, a2, a3); d = a0 * hf[0] + a1 * hf[1] + a2 * hf[2] + a3 * hf[3];
            FP8X4(u[k2].y, a0, a1, a2, a3); d += a0 * hf[4] + a1 * hf[5] + a2 * hf[6] + a3 * hf[7];
            FP8X4(u[k2].z, a0, a1, a2, a3); d += a0 * hf[8] + a1 * hf[9] + a2 * hf[10] + a3 * hf[11];
            FP8X4(u[k2].w, a0, a1, a2, a3); d += a0 * hf[12] + a1 * hf[13] + a2 * hf[14] + a3 * hf[15];
            P[k2] = d; }
          { const bool up4 = (lane & 4) != 0;
#pragma unroll
            for (int e = 0; e < 4; ++e) { const float keep = up4 ? P[e + 4] : P[e], send = up4 ? P[e] : P[e + 4]; P[e] = keep + __shfl_xor(send, 4); }
            const bool up2 = (lane & 2) != 0;
#pragma unroll
            for (int e = 0; e < 2; ++e) { const float keep = up2 ? P[e + 2] : P[e], send = up2 ? P[e] : P[e + 2]; P[e] = keep + dpp_f<0x4E>(send); }
            const bool up1 = (lane & 1) != 0;
            const float keep = up1 ? P[1] : P[0], send = up1 ? P[0] : P[1];
            float av = keep + dpp_f<0xB1>(send);
            av += __shfl_xor(av, 8); av += __shfl_xor(av, 16); av += __shfl_xor(av, 32);
            av *= su;
            const float ax = fabsf(av), t = __builtin_amdgcn_rcpf(ax * 0.2316418882f + 1.0f);
            float q = t * 0.5307027145f + (-0.7265760135f); q = q * t + 0.7107068705f; q = q * t + (-0.142248368f); q = q * t + 0.127414796f; q = q * t;
            const float ee = __builtin_amdgcn_exp2f(av * av * (-0.72134752044f));
            const float mm = av * (q * ee), gl = (av < 0.f) ? mm : (av - mm);
            P[0] = gte * gl * sv; }
#pragma unroll
          for (int k2 = 0; k2 < 8; ++k2) { const float wk = __int_as_float(__builtin_amdgcn_readlane(__float_as_int(P[0]), k2)); float a0, a1, a2, a3;
            FP8X4(v[k2].x, a0, a1, a2, a3); acc[0] += wk * a0; acc[1] += wk * a1; acc[2] += wk * a2; acc[3] += wk * a3;
            FP8X4(v[k2].y, a0, a1, a2, a3); acc[4] += wk * a0; acc[5] += wk * a1; acc[6] += wk * a2; acc[7] += wk * a3;
            FP8X4(v[k2].z, a0, a1, a2, a3); acc[8] += wk * a0; acc[9] += wk * a1; acc[10] += wk * a2; acc[11] += wk * a3;
            FP8X4(v[k2].w, a0, a1, a2, a3); acc[12] += wk * a0; acc[13] += wk * a1; acc[14] += wk * a2; acc[15] += wk * a3; }
        }
        float ss = 0.f;
#pragma unroll
        for (int i = 0; i < 16; ++i) ss += acc[i] * acc[i];
        ss = wave_sum(ss); const float rs = rsqrtf(ss * (1.f / 1024.f) + EPS);
        float* orow = outp + tok * 1024 + lane * 16;
        if (pass == gather_reps - 1)
#pragma unroll
        for (int i = 0; i < 4; ++i) { const int d = lane * 16 + 4 * i;
          float4 x1 = *(const float4*)(orow + 4 * i); const float4 g3 = *(const float4*)(gpf2 + d), g2 = *(const float4*)(modb + 5120 + d);
          x1.x += g3.x * g2.x * acc[4 * i] * rs; x1.y += g3.y * g2.y * acc[4 * i + 1] * rs; x1.z += g3.z * g2.z * acc[4 * i + 2] * rs; x1.w += g3.w * g2.w * acc[4 * i + 3] * rs;
          *(float4*)(orow + 4 * i) = x1; }
      }
#undef FP8X4
    }
  }
}

DI void phase2_scan(const KP& p) {
  unsigned char* ws = p.ws;
  for (int g = blockIdx.x * NTHR + threadIdx.x; g < 131072; g += gridDim.x * NTHR) {
    const int seq = g >> 11, within = g & 2047, dv = within >> 4, dk4 = (within & 15) * 4, dir = seq & 1;
    bf16_t* base = (bf16_t*)(ws + WS_SPT) + ((size_t)seq * 32 * 128 + dv) * 64 + dk4;
    const float* dec = (const float*)(ws + WS_DEC) + (size_t)seq * 32 * 64 + dk4;
    float s0 = 0.f, s1 = 0.f, s2 = 0.f, s3 = 0.f;
#pragma unroll 1
    for (int i0 = 0; i0 < 32; i0 += 8) {
      uint2 d[8]; float4 c[8];
#pragma unroll
      for (int j = 0; j < 8; ++j) { const int n = dir ? 31 - (i0 + j) : (i0 + j); d[j] = *(const uint2*)(base + (size_t)n * 8192); c[j] = *(const float4*)(dec + n * 64); }
#pragma unroll
      for (int j = 0; j < 8; ++j) { const int n = dir ? 31 - (i0 + j) : (i0 + j);
        uint2 o; o.x = pack2(s0, s1); o.y = pack2(s2, s3); *(uint2*)(base + (size_t)n * 8192) = o;
        s0 = c[j].x * s0 + __uint_as_float(d[j].x << 16); s1 = c[j].y * s1 + __uint_as_float(d[j].x & 0xffff0000u);
        s2 = c[j].z * s2 + __uint_as_float(d[j].y << 16); s3 = c[j].w * s3 + __uint_as_float(d[j].y & 0xffff0000u); }
    }
  }
}

#define XB_TMO      128
#define XB_XCNT(j)  (256  + 64 * (j))
#define XB_XSUB(j)  (1280 + 64 * (j))
#define XB_XGEN(j)  (2304 + 64 * (j))
#define XB_TOP      3328
#define XB_TOPGEN   3392
#define XCD_BAR_WORDS 3456
#define XB_SPIN_CAP (1u << 18)
#define LAS __attribute__((address_space(3)))

__device__ __forceinline__ unsigned xb_ld(unsigned* p)              { return __hip_atomic_load(p, __ATOMIC_RELAXED, __HIP_MEMORY_SCOPE_AGENT); }
__device__ __forceinline__ unsigned xb_add(unsigned* p, unsigned v) { return __hip_atomic_fetch_add(p, v, __ATOMIC_RELAXED, __HIP_MEMORY_SCOPE_AGENT); }
__device__ __forceinline__ unsigned xb_xcc_id() { return (unsigned)__builtin_amdgcn_s_getreg((3 << 11) | 20) & 0xFu; }
#define XB_SPIN(cond, bar) do { unsigned _sp = 0; while (cond) { __builtin_amdgcn_s_sleep(1); \
    if ((++_sp & 255u) == 0u) { if (xb_ld(&(bar)[XB_TMO])) break; if (_sp > XB_SPIN_CAP) { atomicAdd(&(bar)[XB_TMO], 1u); break; } } } } while (0)

struct XcdBarrier {
    unsigned* bar; unsigned x;
    volatile LAS unsigned* st;
};

__device__ __forceinline__ XcdBarrier xcd_barrier_post(unsigned* bar, volatile LAS unsigned* st) {
    XcdBarrier b; b.bar = bar; b.x = xb_xcc_id(); b.st = st;
    if (threadIdx.x == 0) (void)xb_add(&bar[XB_XCNT(b.x)], 1u);
    return b;
}
__device__ __forceinline__ void xcd_barrier_complete(unsigned* bar, unsigned x, unsigned& nloc, unsigned& nx) {
    const unsigned G = gridDim.x * gridDim.y * gridDim.z;
    unsigned sum, cnt, mine, sp = 0u;
    for (;;) {
        sum = 0u; cnt = 0u; mine = 0u;
#pragma unroll
        for (unsigned j = 0; j < 16; ++j) { const unsigned c = xb_ld(&bar[XB_XCNT(j)]); sum += c; cnt += (c > 0u) ? 1u : 0u; mine = (j == x) ? c : mine; }
        if (sum == G) break;
        __builtin_amdgcn_s_sleep(1);
        if ((++sp & 255u) == 0u) { if (xb_ld(&bar[XB_TMO])) break; if (sp > XB_SPIN_CAP) { atomicAdd(&bar[XB_TMO], 1u); break; } }
    }
    nloc = mine > 0u ? mine : 1u; nx = cnt > 0u ? cnt : 1u;
}

__device__ __forceinline__ void xcd_barrier(const XcdBarrier& b) {
    asm volatile("s_waitcnt vmcnt(0)" ::: "memory");
    __syncthreads();
    if (threadIdx.x == 0) {
        unsigned* bar = b.bar;
        __builtin_amdgcn_s_waitcnt(0);
        unsigned nloc = b.st[0], nx = b.st[1];
        if (nloc == 0u) { xcd_barrier_complete(bar, b.x, nloc, nx); b.st[0] = nloc; b.st[1] = nx; }
        const unsigned old = xb_add(&bar[XB_XSUB(b.x)], 1u);
        const unsigned gen = old / nloc;
        if (old + 1u == (gen + 1u) * nloc) {
            __builtin_amdgcn_fence(__ATOMIC_RELEASE, "agent");
            asm volatile("s_waitcnt vmcnt(0)" ::: "memory");
            const unsigned og = xb_add(&bar[XB_TOP], 1u);
            const unsigned tg = og / nx;
            if (og + 1u == (tg + 1u) * nx) xb_add(&bar[XB_TOPGEN], 1u);
            else XB_SPIN(xb_ld(&bar[XB_TOPGEN]) == tg, bar);
            __builtin_amdgcn_fence(__ATOMIC_ACQUIRE, "agent");
            xb_add(&bar[XB_XGEN(b.x)], 1u);
            asm volatile("s_waitcnt vmcnt(0)" ::: "memory");
        } else {
            XB_SPIN(xb_ld(&bar[XB_XGEN(b.x)]) == gen, bar);
            __builtin_amdgcn_fence(__ATOMIC_ACQUIRE, "agent");
            asm volatile("s_waitcnt vmcnt(0)" ::: "memory");
        }
    }
    __syncthreads();
}

#ifndef PROBE_ID
#define PROBE_ID 0
#endif
__global__ void __launch_bounds__(NTHR, 2) mega(KP p) {
  extern __shared__ __attribute__((aligned(16))) char lds[];
  cg::grid_group grid = cg::this_grid();
  const int hi = p.ph_hi; constexpr int probe = PROBE_ID;
  if (threadIdx.x == 0) { ((volatile LAS unsigned*)(lds + LDS_XB))[0] = 0u; ((volatile LAS unsigned*)(lds + LDS_XB))[1] = 0u; }
  __syncthreads();
  const XcdBarrier xb = xcd_barrier_post((unsigned*)(p.ws + WS_BAR), (volatile LAS unsigned*)(lds + LDS_XB));
  if (p.ph_lo <= 0 && 0 < hi) { phase0(p, lds); if (probe == 1) phase0(p, lds); if (1 < hi) grid.sync(); }
  if (p.ph_lo <= 1 && 1 < hi) { phase1(p, lds); if (probe == 2) phase1(p, lds); if (2 < hi) xcd_barrier(xb); }
  if (p.ph_lo <= 2 && 2 < hi) { phase2_scan(p); phase2_attn(p, lds); if (probe == 3) phase2_attn(p, lds); if (3 < hi) xcd_barrier(xb); }
  if (p.ph_lo <= 3 && 3 < hi) { phase3(p, lds, probe == 4 ? 2 : 1, probe); }
}

extern "C" void kernel_launch(void* const* d_in, const int* in_sizes, int n_in, void* d_out, int out_size, void* d_ws, size_t ws_size, hipStream_t stream) {
  float* out = (float*)d_out;
  unsigned char* ws = (unsigned char*)d_ws;
  if (ws_size < WS_END || n_in != 25) return;
  static bool attr_done = false;
  if (!attr_done) { (void)hipFuncSetAttribute((const void*)mega, hipFuncAttributeMaxDynamicSharedMemorySize, LDS_TOTAL); attr_done = true; }
  KP p{};
  for (int i = 0; i < 25; ++i) p.in[i] = (const float*)d_in[i];
  p.out = out; p.ws = ws;
  p.ph_lo = 0; p.ph_hi = 4;
  (void)hipMemsetAsync(ws + WS_BAR, 0, XCD_BAR_WORDS * 4, stream);
  { void* args[] = {&p}; (void)hipLaunchCooperativeKernel((const void*)mega, dim3(256), dim3(NTHR), args, LDS_TOTAL, stream); }
}
```

```cpp
#include <hip/hip_runtime.h>
#include <hip/hip_cooperative_groups.h>
namespace cg = cooperative_groups;
#include <stdint.h>

typedef unsigned short bf16_t;
#define DI __device__ __forceinline__

DI float bf2f(bf16_t v) { return __uint_as_float(((unsigned)v) << 16); }
DI bf16_t f2bf(float f) { unsigned u = __float_as_uint(f); u += 0x7fffu + ((u >> 16) & 1u); return (bf16_t)(u >> 16); }

constexpr int BATCH = 8, SEQ = 2048, DM = 1024, NTOK = BATCH * SEQ;
constexpr int INW = 2272;
constexpr float EPS = 1e-6f;
constexpr int O_CQ = 0, O_CKV = 384, O_KR = 640, O_QG = 704, O_KG = 960, O_VG = 1216, O_GF = 1728, O_GB = 1744, O_R = 1760;

DI float wave_sum(float v) {
#pragma unroll
  for (int o = 1; o < 64; o <<= 1) v += __shfl_xor(v, o);
  return v;
}
DI float wave_max(float v) {
#pragma unroll
  for (int o = 1; o < 64; o <<= 1) v = fmaxf(v, __shfl_xor(v, o));
  return v;
}
DI float block_sum256(float v, float* red) {
  v = wave_sum(v);
  __syncthreads();
  if ((threadIdx.x & 63) == 0) red[threadIdx.x >> 6] = v;
  __syncthreads();
  return red[0] + red[1] + red[2] + red[3];
}
DI float block_max256(float v, float* red) {
  v = wave_max(v);
  __syncthreads();
  if ((threadIdx.x & 63) == 0) red[threadIdx.x >> 6] = v;
  __syncthreads();
  return fmaxf(fmaxf(red[0], red[1]), fmaxf(red[2], red[3]));
}
DI float silu_f(float x) { return x / (1.f + expf(-x)); }
DI float logsigmoid_f(float x) { return fminf(x, 0.f) - log1pf(expf(-fabsf(x))); }
DI float gelu_erf(float x) { return 0.5f * x * (1.f + erff(x * 0.70710678118654752f)); }

__global__ __launch_bounds__(256) void n_mod(const float* __restrict__ c, const float* __restrict__ w_ada, const float* __restrict__ b_ada, float* __restrict__ mod) {
  int idx = blockIdx.x * 256 + threadIdx.x;
  int b = idx / 6144, j = idx % 6144;
  float acc = b_ada[j];
  for (int k = 0; k < 1024; ++k) acc += silu_f(c[b * 1024 + k]) * w_ada[(size_t)k * 6144 + j];
  mod[idx] = acc;
}

__global__ __launch_bounds__(256) void n_hnorm(const float* __restrict__ x, const float* __restrict__ g, const float* __restrict__ mod, int b, int off_sh, int off_sc, float* __restrict__ h) {
  __shared__ float red[4];
  int t = blockIdx.x, tid = threadIdx.x;
  const float* xr = x + ((size_t)b * SEQ + t) * DM;
  float v[4]; float ss = 0.f;
#pragma unroll
  for (int i = 0; i < 4; ++i) { v[i] = xr[tid + 256 * i]; ss += v[i] * v[i]; }
  ss = block_sum256(ss, red);
  float rs = rsqrtf(ss * (1.f / DM) + EPS);
#pragma unroll
  for (int i = 0; i < 4; ++i) { int d = tid + 256 * i; h[(size_t)t * DM + d] = v[i] * rs * g[d] * (1.f + mod[b * 6144 + off_sc + d]) + mod[b * 6144 + off_sh + d]; }
}

template <bool BT>
__global__ __launch_bounds__(256) void n_gemm(const float* __restrict__ A, int lda, const float* __restrict__ B, int ldb, float* __restrict__ C, int ldc, int M, int N, int K) {
  __shared__ float As[16][65];
  __shared__ float Bs[16][65];
  const int tid = threadIdx.x, tx = tid & 15, ty = tid >> 4;
  const int m0 = blockIdx.y * 64, n0 = blockIdx.x * 64;
  float acc[4][4];
#pragma unroll
  for (int i = 0; i < 4; ++i)
#pragma unroll
    for (int j = 0; j < 4; ++j) acc[i][j] = 0.f;
  for (int k0 = 0; k0 < K; k0 += 16) {
#pragma unroll
    for (int i = 0; i < 4; ++i) { int e = tid + 256 * i; int m = e >> 4, k = e & 15; As[k][m] = A[(size_t)(m0 + m) * lda + k0 + k]; }
#pragma unroll
    for (int i = 0; i < 4; ++i) { int e = tid + 256 * i;
      if (!BT) { int k = e >> 6, n = e & 63; Bs[k][n] = (n0 + n < N) ? B[(size_t)(k0 + k) * ldb + n0 + n] : 0.f; }
      else     { int n = e >> 4, k = e & 15; Bs[k][n] = (n0 + n < N) ? B[(size_t)(n0 + n) * ldb + k0 + k] : 0.f; } }
    __syncthreads();
#pragma unroll
    for (int k = 0; k < 16; ++k) {
      float a[4], bb[4];
#pragma unroll
      for (int i = 0; i < 4; ++i) { a[i] = As[k][ty * 4 + i]; bb[i] = Bs[k][tx * 4 + i]; }
#pragma unroll
      for (int i = 0; i < 4; ++i)
#pragma unroll
        for (int j = 0; j < 4; ++j) acc[i][j] += a[i] * bb[j];
    }
    __syncthreads();
  }
#pragma unroll
  for (int i = 0; i < 4; ++i)
#pragma unroll
    for (int j = 0; j < 4; ++j) { int n = n0 + tx * 4 + j; if (n < N) C[(size_t)(m0 + ty * 4 + i) * ldc + n] = acc[i][j]; }
}

__global__ __launch_bounds__(256) void n_rms_slice(const float* __restrict__ in, int ldin, int off, int W, const float* __restrict__ g, float* __restrict__ out) {
  __shared__ float red[4];
  int t = blockIdx.x, tid = threadIdx.x;
  float v0 = (tid < W) ? in[(size_t)t * ldin + off + tid] : 0.f;
  float v1 = (tid + 256 < W) ? in[(size_t)t * ldin + off + tid + 256] : 0.f;
  float ss = block_sum256(v0 * v0 + v1 * v1, red);
  float rs = rsqrtf(ss / (float)W + EPS);
  if (tid < W) out[(size_t)t * W + tid] = v0 * rs * g[tid];
  if (tid + 256 < W) out[(size_t)t * W + tid + 256] = v1 * rs * g[tid + 256];
}

__global__ __launch_bounds__(256) void n_scatter(const float* __restrict__ proj, const float* __restrict__ qa, const float* __restrict__ kv, const int* __restrict__ positions, int b,
                                                 const float* __restrict__ wgf, const float* __restrict__ bgf, const float* __restrict__ wgb, const float* __restrict__ bgb,
                                                 bf16_t* __restrict__ Qm, bf16_t* __restrict__ Km, bf16_t* __restrict__ Vm, bf16_t* __restrict__ qg, bf16_t* __restrict__ kg, bf16_t* __restrict__ vg,
                                                 bf16_t* __restrict__ rg, float* __restrict__ laf, float* __restrict__ lab) {
  __shared__ float cs[32], sn[32];
  const int t = blockIdx.x, tid = threadIdx.x;
  const size_t tok = (size_t)b * SEQ + t;
  const float* pr = proj + (size_t)t * INW;
  const float* qr = qa + (size_t)t * 768;
  const float* kr = kv + (size_t)t * 1024;
  if (tid < 32) {
    float inv = powf(10000.f, -(float)tid / 32.f);
    float ang = (float)positions[tok] * inv;
    cs[tid] = cosf(ang); sn[tid] = sinf(ang);
  }
  __syncthreads();
  for (int e = tid; e < 4 * 192; e += 256) {
    int h = e / 192, d = e % 192; float v;
    if (d < 128) v = qr[h * 192 + d];
    else { int j = d - 128; const float* rp = qr + h * 192 + 128;
      if (j < 32) v = rp[j] * cs[j] - rp[j + 32] * sn[j]; else v = rp[j] * cs[j - 32] + rp[j - 32] * sn[j - 32]; }
    Qm[(((size_t)b * 4 + h) * SEQ + t) * 192 + d] = f2bf(v);
  }
  for (int e = tid; e < 4 * 192; e += 256) {
    int h = e / 192, d = e % 192; float v;
    if (d < 128) v = kr[h * 256 + d];
    else { int j = d - 128; const float* rp = pr + O_KR;
      if (j < 32) v = rp[j] * cs[j] - rp[j + 32] * sn[j]; else v = rp[j] * cs[j - 32] + rp[j - 32] * sn[j - 32]; }
    Km[(((size_t)b * 4 + h) * SEQ + t) * 192 + d] = f2bf(v);
  }
  for (int e = tid; e < 512; e += 256) { int h = e >> 7, d = e & 127; Vm[(((size_t)b * 4 + h) * SEQ + t) * 128 + d] = f2bf(kr[h * 256 + 128 + d]); }
  { int e = tid; qg[tok * 256 + e] = f2bf(pr[O_QG + e] * 0.125f); kg[tok * 256 + e] = f2bf(pr[O_KG + e]); }
  for (int e = tid; e < 512; e += 256) { vg[tok * 512 + e] = f2bf(pr[O_VG + e]); rg[tok * 512 + e] = f2bf(pr[O_R + e]); }
  { int cidx = tid; float af = bgf[cidx], ab = bgb[cidx];
#pragma unroll
    for (int r = 0; r < 16; ++r) { af += pr[O_GF + r] * wgf[r * 256 + cidx]; ab += pr[O_GB + r] * wgb[r * 256 + cidx]; }
    laf[tok * 256 + cidx] = logsigmoid_f(af) * (1.f / 16.f); lab[tok * 256 + cidx] = logsigmoid_f(ab) * (1.f / 16.f); }
}

__global__ __launch_bounds__(256) void n_attn(const bf16_t* __restrict__ Qm, const bf16_t* __restrict__ Km, const bf16_t* __restrict__ Vm, bf16_t* __restrict__ omla) {
  __shared__ float qs[192]; __shared__ float sc[2048]; __shared__ float red[4];
  const int i = blockIdx.x, h = blockIdx.y, b = blockIdx.z, tid = threadIdx.x;
  const size_t bh = (size_t)b * 4 + h;
  if (tid < 192) qs[tid] = bf2f(Qm[(bh * SEQ + i) * 192 + tid]);
  __syncthreads();
  float mx = -1e30f;
  for (int kk = 0; kk < 8; ++kk) {
    int key = tid + 256 * kk; const uint4* kr = (const uint4*)(Km + (bh * SEQ + key) * 192);
    float s = 0.f;
    for (int c = 0; c < 24; ++c) { uint4 w = kr[c]; const float* q = qs + c * 8;
      s += q[0] * __uint_as_float(w.x << 16) + q[1] * __uint_as_float(w.x & 0xffff0000u) + q[2] * __uint_as_float(w.y << 16) + q[3] * __uint_as_float(w.y & 0xffff0000u)
         + q[4] * __uint_as_float(w.z << 16) + q[5] * __uint_as_float(w.z & 0xffff0000u) + q[6] * __uint_as_float(w.w << 16) + q[7] * __uint_as_float(w.w & 0xffff0000u); }
    s *= 0.07216878364870322f; sc[key] = s; mx = fmaxf(mx, s);
  }
  mx = block_max256(mx, red);
  float sum = 0.f;
  for (int kk = 0; kk < 8; ++kk) { int key = tid + 256 * kk; float p = expf(sc[key] - mx); sc[key] = p; sum += p; }
  sum = block_sum256(sum, red);
  __syncthreads();
  if (tid < 128) { float o = 0.f; const bf16_t* vp = Vm + bh * SEQ * 128 + tid;
    for (int key = 0; key < SEQ; ++key) o += sc[key] * bf2f(vp[(size_t)key * 128]);
    omla[((size_t)b * SEQ + i) * 512 + h * 128 + tid] = f2bf(o / sum); }
}

__global__ __launch_bounds__(128) void n_gla(const bf16_t* __restrict__ qg, const bf16_t* __restrict__ kg, const bf16_t* __restrict__ vg, const bf16_t* __restrict__ laf, const bf16_t* __restrict__ lab, float* __restrict__ og) {
  __shared__ float qs[64], ks[64], as[64];
  const int bh = blockIdx.x, b = bh >> 2, h = bh & 3, dv = threadIdx.x;
  for (int dir = 0; dir < 2; ++dir) {
    float S[64];
#pragma unroll
    for (int d = 0; d < 64; ++d) S[d] = 0.f;
    const bf16_t* la = dir ? lab : laf;
    for (int s = 0; s < SEQ; ++s) {
      const int t = dir ? (SEQ - 1 - s) : s; const size_t tok = (size_t)b * SEQ + t;
      __syncthreads();
      if (dv < 64) { qs[dv] = bf2f(qg[tok * 256 + h * 64 + dv]); ks[dv] = bf2f(kg[tok * 256 + h * 64 + dv]); as[dv] = expf(bf2f(la[tok * 256 + h * 64 + dv])); }
      __syncthreads();
      const float v = bf2f(vg[tok * 512 + h * 128 + dv]); float o = 0.f;
#pragma unroll
      for (int d = 0; d < 64; ++d) { S[d] = as[d] * S[d] + ks[d] * v; o += qs[d] * S[d]; }
      if (dir == 0) og[tok * 512 + h * 128 + dv] = o; else og[tok * 512 + h * 128 + dv] += o;
    }
  }
}

__global__ __launch_bounds__(256) void n_mix(const bf16_t* __restrict__ omla, const float* __restrict__ og, const bf16_t* __restrict__ rg, const float* __restrict__ g_gla, int b, float* __restrict__ mix) {
  __shared__ float ssum[4];
  const int t = blockIdx.x, tid = threadIdx.x; const size_t tok = (size_t)b * SEQ + t;
  if (tid < 4) ssum[tid] = 0.f;
  __syncthreads();
  float v[2];
#pragma unroll
  for (int i = 0; i < 2; ++i) { int e = tid + 256 * i; v[i] = og[tok * 512 + e]; atomicAdd(&ssum[e >> 7], v[i] * v[i]); mix[(size_t)t * DM + e] = bf2f(omla[tok * 512 + e]); }
  __syncthreads();
#pragma unroll
  for (int i = 0; i < 2; ++i) { int e = tid + 256 * i; float rs = rsqrtf(ssum[e >> 7] * (1.f / 128.f) + EPS);
    mix[(size_t)t * DM + 512 + e] = v[i] * rs * g_gla[e & 127] * silu_f(bf2f(rg[tok * 512 + e])); }
}

__global__ __launch_bounds__(256) void n_post1(const float* __restrict__ x, const float* __restrict__ y, const float* __restrict__ g_post, const float* __restrict__ g_pre2, const float* __restrict__ mod, int b,
                                               float* __restrict__ out, float* __restrict__ h2) {
  __shared__ float red[4];
  const int t = blockIdx.x, tid = threadIdx.x; const size_t tok = (size_t)b * SEQ + t;
  float yv[4], xv[4]; float ss = 0.f;
#pragma unroll
  for (int i = 0; i < 4; ++i) { yv[i] = y[(size_t)t * DM + tid + 256 * i]; ss += yv[i] * yv[i]; }
  ss = block_sum256(ss, red);
  float rs = rsqrtf(ss * (1.f / DM) + EPS); float s2 = 0.f;
#pragma unroll
  for (int i = 0; i < 4; ++i) { int d = tid + 256 * i; xv[i] = x[tok * DM + d] + mod[b * 6144 + 2048 + d] * (yv[i] * rs * g_post[d]); out[tok * DM + d] = xv[i]; s2 += xv[i] * xv[i]; }
  s2 = block_sum256(s2, red);
  float r2 = rsqrtf(s2 * (1.f / DM) + EPS);
#pragma unroll
  for (int i = 0; i < 4; ++i) { int d = tid + 256 * i; h2[(size_t)t * DM + d] = xv[i] * r2 * g_pre2[d] * (1.f + mod[b * 6144 + 4096 + d]) + mod[b * 6144 + 3072 + d]; }
}

DI void wave_argmax(float& v, int& i) {
#pragma unroll
  for (int o = 1; o < 64; o <<= 1) { float ov = __shfl_xor(v, o); int oi = __shfl_xor(i, o); if (ov > v || (ov == v && oi < i)) { v = ov; i = oi; } }
}
__global__ __launch_bounds__(256) void n_peer_select(const float* __restrict__ qry, const float* __restrict__ sk1, const float* __restrict__ sk2, int* __restrict__ eidx, float* __restrict__ gate) {
  __shared__ float v1s[4][16], v2s[4][16]; __shared__ int i1s[4][16], i2s[4][16];
  const int w = threadIdx.x >> 6, lane = threadIdx.x & 63;
  const int pair = blockIdx.x * 4 + w;
  const int t = pair >> 3, h = pair & 7;
  const float* q1 = qry + (size_t)t * 2048 + h * 256; const float* q2 = q1 + 128;
  float s1a = 0.f, s1b = 0.f, s2a = 0.f, s2b = 0.f;
  for (int d = 0; d < 128; ++d) { float a = q1[d], bq = q2[d];
    s1a += a * sk1[lane * 128 + d]; s1b += a * sk1[(lane + 64) * 128 + d]; s2a += bq * sk2[lane * 128 + d]; s2b += bq * sk2[(lane + 64) * 128 + d]; }
  for (int side = 0; side < 2; ++side) {
    float va = side ? s2a : s1a, vb = side ? s2b : s1b; bool ta = false, tb = false;
    for (int k = 0; k < 16; ++k) {
      float bv; int bi;
      if (!ta && (tb || va >= vb)) { bv = va; bi = lane; } else if (!tb) { bv = vb; bi = lane + 64; } else { bv = -3e38f; bi = 1 << 20; }
      wave_argmax(bv, bi);
      if (bi == lane) ta = true; if (bi == lane + 64) tb = true;
      if (lane == 0) { if (side) { v2s[w][k] = bv; i2s[w][k] = bi; } else { v1s[w][k] = bv; i1s[w][k] = bi; } }
    }
  }
  __syncthreads();
  float cv[4]; bool tk[4];
#pragma unroll
  for (int j = 0; j < 4; ++j) { int c = lane + 64 * j; cv[j] = v1s[w][c >> 4] + v2s[w][c & 15]; tk[j] = false; }
  float topv = 0.f; int topc = 0; float mx = 0.f;
  for (int k = 0; k < 16; ++k) {
    float bv = -3e38f; int bi = 1 << 20;
#pragma unroll
    for (int j = 0; j < 4; ++j) { if (!tk[j] && cv[j] > bv) { bv = cv[j]; bi = lane + 64 * j; } }
    wave_argmax(bv, bi);
#pragma unroll
    for (int j = 0; j < 4; ++j) if (bi == lane + 64 * j) tk[j] = true;
    if (k == 0) mx = bv;
    if (lane == k) { topv = bv; topc = bi; }
  }
  float e = (lane < 16) ? expf(topv - mx) : 0.f;
  float sum = wave_sum(e);
  if (lane < 16) { eidx[(size_t)pair * 16 + lane] = i1s[w][topc >> 4] * 128 + i2s[w][topc & 15]; gate[(size_t)pair * 16 + lane] = e / sum; }
}

__global__ __launch_bounds__(256) void n_peer_apply(const float* __restrict__ h2, const int* __restrict__ eidx, const float* __restrict__ gate, const float* __restrict__ eu, const float* __restrict__ ev,
                                                    const float* __restrict__ g_post, const float* __restrict__ mod, int b, float* __restrict__ out) {
  __shared__ float ys[4][1024]; __shared__ float red[4];
  const int t = blockIdx.x, tid = threadIdx.x, w = tid >> 6, lane = tid & 63; const size_t tok = (size_t)b * SEQ + t;
  float4 hx[4];
#pragma unroll
  for (int i = 0; i < 4; ++i) hx[i] = *(const float4*)(h2 + (size_t)t * DM + (lane + 64 * i) * 4);
  float4 acc[4];
#pragma unroll
  for (int i = 0; i < 4; ++i) acc[i] = make_float4(0.f, 0.f, 0.f, 0.f);
  for (int k = w; k < 128; k += 4) {
    const int e = eidx[(size_t)t * 128 + k]; const float gt = gate[(size_t)t * 128 + k];
    const float4* ur = (const float4*)(eu + (size_t)e * DM); const float4* vr = (const float4*)(ev + (size_t)e * DM);
    float d = 0.f;
#pragma unroll
    for (int i = 0; i < 4; ++i) { float4 u = ur[lane + 64 * i]; d += u.x * hx[i].x + u.y * hx[i].y + u.z * hx[i].z + u.w * hx[i].w; }
    d = wave_sum(d);
    const float wgt = gt * gelu_erf(d);
#pragma unroll
    for (int i = 0; i < 4; ++i) { float4 v = vr[lane + 64 * i]; acc[i].x += wgt * v.x; acc[i].y += wgt * v.y; acc[i].z += wgt * v.z; acc[i].w += wgt * v.w; }
  }
#pragma unroll
  for (int i = 0; i < 4; ++i) *(float4*)(&ys[w][(lane + 64 * i) * 4]) = acc[i];
  __syncthreads();
  float yv[4]; float ss = 0.f;
#pragma unroll
  for (int i = 0; i < 4; ++i) { int d = tid + 256 * i; yv[i] = ys[0][d] + ys[1][d] + ys[2][d] + ys[3][d]; ss += yv[i] * yv[i]; }
  ss = block_sum256(ss, red);
  const float rs = rsqrtf(ss * (1.f / DM) + EPS);
#pragma unroll
  for (int i = 0; i < 4; ++i) { int d = tid + 256 * i; out[tok * DM + d] = out[tok * DM + d] + mod[b * 6144 + 5120 + d] * (yv[i] * rs * g_post[d]); }
}

typedef short bf16x8 __attribute__((ext_vector_type(8)));
typedef float f32x16 __attribute__((ext_vector_type(16)));
#define MFMA32(a, b, c) __builtin_amdgcn_mfma_f32_32x32x16_bf16((a), (b), (c), 0, 0, 0)

constexpr int NTHR = 512;
constexpr size_t MiB = 1024 * 1024;
constexpr size_t WS_MOD   = 0;
constexpr size_t WS_WTIN  = 256 * 1024;
constexpr size_t WS_WTQUP = WS_WTIN + (size_t)2304 * 1024 * 2;
constexpr size_t WS_WTKVUP = WS_WTQUP + (size_t)768 * 384 * 2;
constexpr size_t WS_WTOUT = WS_WTKVUP + (size_t)1024 * 256 * 2;
constexpr size_t WS_WTPQ  = WS_WTOUT + (size_t)1024 * 1024 * 2;
constexpr size_t WS_KD    = WS_WTPQ + (size_t)2048 * 1024 * 2;
constexpr size_t WS_DEC   = WS_KD + (size_t)256 * 256 * 2;
constexpr size_t WS_ESC   = WS_DEC + (size_t)2048 * 64 * 4;
constexpr size_t WS_R0END = WS_ESC + (size_t)2 * 16384 * 4;
static_assert(WS_R0END <= 13 * MiB, "R0");
constexpr size_t WS_BAR  = 13 * MiB - 65536;
static_assert(WS_R0END + 131072 <= WS_BAR, "R0 room");
constexpr size_t WS_QM   = 13 * MiB;
constexpr size_t WS_KM   = WS_QM + 24 * MiB;
constexpr size_t WS_VM   = WS_KM + 24 * MiB;
constexpr size_t WS_P1S  = WS_VM + 16 * MiB;
constexpr size_t WS_RG   = WS_P1S + 32 * MiB;
constexpr size_t WS_OINTRA = WS_RG + 16 * MiB;
constexpr size_t WS_QDEC = WS_OINTRA + 16 * MiB;
constexpr size_t WS_SPT  = WS_QDEC + 16 * MiB;
constexpr size_t WS_EU   = WS_SPT + 32 * MiB;
constexpr size_t WS_EV   = WS_EU + 16 * MiB;
constexpr size_t WS_END  = WS_EV + 16 * MiB;
static_assert(WS_P1S == WS_QM + 64 * MiB, "P3 QRY scratch aliases QM..VM");
constexpr size_t OUT_HS  = 0;
constexpr size_t OUT_CQ  = 32 * MiB;
constexpr size_t OUT_GR  = 52 * MiB;

struct KP { const float* in[25]; float* out; unsigned char* ws; int ph_lo, ph_hi; };

constexpr int G_STG = 40960;
constexpr int LDS_WT = 3 * G_STG;
constexpr int LDS_TAB = LDS_WT + 18432;
constexpr int LDS_XB = 157696;
constexpr int LDS_TOTAL = 157696 + 16;

DI unsigned pack2(float lo, float hi) { return (unsigned)f2bf(lo) | ((unsigned)f2bf(hi) << 16); }
DI int crow(int reg, int hh) { return (reg & 3) + 8 * (reg >> 2) + 4 * hh; }

#define GLDS16(gp, lp) __builtin_amdgcn_global_load_lds((const unsigned*)(gp), (__attribute__((address_space(3))) unsigned*)(lp), 16, 0, 0)
template <int NST, class Epi>
DI void block_gemm(char* lds, const bf16_t* A, int lda, const bf16_t* Bt, int nchunks, int K, Epi&& epi) {
  const int tid = threadIdx.x, lane = tid & 63, w = __builtin_amdgcn_readfirstlane(tid >> 6), r = lane & 31, hh = lane >> 5;
  const int nk = K >> 6, T = nchunks * nk;
  constexpr int D = NST - 1;
  if (w >= 4) {
    const int j = w - 4, rin = lane >> 3, sw = ((lane & 7) ^ rin) * 8;
    const bf16_t* Ap = A + (size_t)(16 * j + rin) * lda + sw;
    const bf16_t* Bp = Bt + (size_t)(64 * j + rin) * 64 + sw;
    auto dma = [&](int g) {
      const int ch = g / nk, t = g - ch * nk; char* st = lds + (g % NST) * G_STG;
      const bf16_t* a0 = Ap + t * 64; char* la = st + (2 * j) * 1024;
      GLDS16(a0, la); GLDS16(a0 + (size_t)8 * lda, la + 1024);
      const bf16_t* b0 = Bp + (size_t)g * 16384; char* lb = st + 8192 + (8 * j) * 1024;
#pragma unroll
      for (int i = 0; i < 8; ++i) GLDS16(b0 + i * 512, lb + i * 1024);
    };
#pragma unroll
    for (int g = 0; g < D; ++g) if (g < T) dma(g);
    if (D >= 2 && T >= 2) asm volatile("s_waitcnt vmcnt(10)" ::: "memory"); else asm volatile("s_waitcnt vmcnt(0)" ::: "memory");
    __builtin_amdgcn_s_barrier();
#pragma unroll 1
    for (int g = 0; g < T; ++g) {
      if (g + D < T) { dma(g + D); if (D >= 2) asm volatile("s_waitcnt vmcnt(10)" ::: "memory"); else asm volatile("s_waitcnt vmcnt(0)" ::: "memory"); }
      else asm volatile("s_waitcnt vmcnt(0)" ::: "memory");
      __builtin_amdgcn_s_barrier();
    }
  } else {
    const int x = r & 7;
    const int o0 = ((0 + hh) ^ x) * 16, o1 = ((2 + hh) ^ x) * 16, o2 = ((4 + hh) ^ x) * 16, o3 = ((6 + hh) ^ x) * 16;
    const int a_rd = r * 128, b_rd = 8192 + (w * 64 + r) * 128;
    __builtin_amdgcn_s_barrier();
    int g = 0;
#pragma unroll 1
    for (int ch = 0; ch < nchunks; ++ch) {
      f32x16 c00, c01, c10, c11;
#pragma unroll
      for (int i = 0; i < 16; ++i) { c00[i] = 0.f; c01[i] = 0.f; c10[i] = 0.f; c11[i] = 0.f; }
#pragma unroll 1
      for (int t = 0; t < nk; ++t, ++g) {
        const char* cur = lds + (g % NST) * G_STG;
        bf16x8 fa0[4], fa1[4], fb0[4], fb1[4];
#define FRD(s_, o_) do { fa0[s_] = *(const bf16x8*)(cur + a_rd + o_); fb0[s_] = *(const bf16x8*)(cur + b_rd + o_); fb1[s_] = *(const bf16x8*)(cur + b_rd + 4096 + o_); fa1[s_] = *(const bf16x8*)(cur + a_rd + 4096 + o_); } while (0)
        FRD(0, o0); FRD(1, o1); FRD(2, o2); FRD(3, o3);
#undef FRD
        asm volatile("s_waitcnt lgkmcnt(0)" ::: "memory");
        __builtin_amdgcn_s_barrier();
        __builtin_amdgcn_sched_barrier(0);
#pragma unroll
        for (int s = 0; s < 4; ++s) {
          c00 = MFMA32(fa0[s], fb0[s], c00); c01 = MFMA32(fa0[s], fb1[s], c01); c10 = MFMA32(fa1[s], fb0[s], c10); c11 = MFMA32(fa1[s], fb1[s], c11); }
      }
      epi(0, ch * 256 + w * 64, c00, c01);
      epi(32, ch * 256 + w * 64, c10, c11);
    }
  }
}

DI void p0_transpose(char* lds, const float* __restrict__ W, int K, int N, bf16_t* __restrict__ Wt, int item) {
  float* s = (float*)lds;
  const int tid = threadIdx.x;
  const int ntn = (N + 63) >> 6, kt = item / ntn, nt = item % ntn, k0 = kt * 64, n0 = nt * 64;
  __syncthreads();
#pragma unroll
  for (int i = 0; i < 8; ++i) { int e = tid + 512 * i; int kk = e >> 6, nn = e & 63; s[kk * 65 + nn] = (n0 + nn < N) ? W[(size_t)(k0 + kk) * N + n0 + nn] : 0.f; }
  __syncthreads();
  const int nn = tid >> 3, part = tid & 7;
  const float* sp = s + (part * 8) * 65 + nn;
  uint4 o; o.x = pack2(sp[0], sp[65]); o.y = pack2(sp[2 * 65], sp[3 * 65]); o.z = pack2(sp[4 * 65], sp[5 * 65]); o.w = pack2(sp[6 * 65], sp[7 * 65]);
  { const int n = n0 + nn; *(uint4*)(Wt + ((size_t)((n >> 8) * (K >> 6) + kt)) * 16384 + (n & 255) * 64 + part * 8) = o; }
}

DI void phase0(const KP& p, char* lds) {
  const int tid = threadIdx.x, bid = blockIdx.x, nb = gridDim.x;
  unsigned char* ws = p.ws;
  constexpr int I_IN = 16 * 36, I_QUP = 6 * 12, I_KVUP = 4 * 16, I_OUT = 16 * 16, I_PQ = 16 * 32;
  constexpr int I_ALL = I_IN + I_QUP + I_KVUP + I_OUT + I_PQ;
  for (int it = bid; it < I_ALL; it += nb) {
    int q = it;
    if (q < I_IN) { p0_transpose(lds, p.in[7], 1024, 2272, (bf16_t*)(ws + WS_WTIN), q); continue; } q -= I_IN;
    if (q < I_QUP) { p0_transpose(lds, p.in[9], 384, 768, (bf16_t*)(ws + WS_WTQUP), q); continue; } q -= I_QUP;
    if (q < I_KVUP) { p0_transpose(lds, p.in[11], 256, 1024, (bf16_t*)(ws + WS_WTKVUP), q); continue; } q -= I_KVUP;
    if (q < I_OUT) { p0_transpose(lds, p.in[17], 1024, 1024, (bf16_t*)(ws + WS_WTOUT), q); continue; } q -= I_OUT;
    p0_transpose(lds, p.in[20], 1024, 2048, (bf16_t*)(ws + WS_WTPQ), q);
  }
  { bf16_t* kd = (bf16_t*)(ws + WS_KD);
    for (int e = bid * NTHR + tid; e < 65536; e += nb * NTHR) { int n = e >> 8, k = e & 255; float v = 0.f;
      if (n < 128 && k < 128) v = p.in[21][n * 128 + k]; else if (n >= 128 && k >= 128) v = p.in[22][(n - 128) * 128 + (k - 128)];
      kd[(size_t)(k >> 6) * 16384 + n * 64 + (k & 63)] = f2bf(v); } }
  { const int lane = tid & 63; float* scl = (float*)(ws + WS_ESC);
    for (int row = bid * 8 + (tid >> 6); row < 32768; row += nb * 8) { const int t = row >> 14, e = row & 16383;
      const float* src = p.in[23 + t] + (size_t)e * 1024 + lane * 16;
      float4 x[4]; float am = 0.f;
#pragma unroll
      for (int i = 0; i < 4; ++i) { x[i] = *(const float4*)(src + 4 * i); am = fmaxf(am, fmaxf(fmaxf(fabsf(x[i].x), fabsf(x[i].y)), fmaxf(fabsf(x[i].z), fabsf(x[i].w)))); }
      am = wave_max(am);
      float sc = 1.f, isc = 1.f;
      if (am > 0.f) { int ex; (void)frexpf(448.f / am, &ex); sc = ldexpf(1.f, ex - 1); isc = ldexpf(1.f, 1 - ex); }
      unsigned wv[4];
#pragma unroll
      for (int i = 0; i < 4; ++i) { int q = __builtin_amdgcn_cvt_pk_fp8_f32(x[i].x * sc, x[i].y * sc, 0, false); q = __builtin_amdgcn_cvt_pk_fp8_f32(x[i].z * sc, x[i].w * sc, q, true); wv[i] = (unsigned)q; }
      *(uint4*)(ws + (t ? WS_EV : WS_EU) + (size_t)e * 1024 + lane * 16) = make_uint4(wv[0], wv[1], wv[2], wv[3]);
      if (lane == 0) scl[t * 16384 + e] = isc; } }
  for (int jb = bid; jb < 96; jb += nb) {
    __syncthreads();
    float* cact = (float*)lds;
    float* red = (float*)(lds + 32768);
    for (int e = tid; e < 8192; e += NTHR) cact[e] = silu_f(p.in[1][e]);
    __syncthreads();
    const int jj = tid & 63, ks = tid >> 6, j0 = jb * 64;
    float acc[8];
#pragma unroll
    for (int b = 0; b < 8; ++b) acc[b] = 0.f;
    const float* wp = p.in[3] + (size_t)(ks * 128) * 6144 + j0 + jj;
    for (int k = 0; k < 128; ++k) { const float wv = wp[(size_t)k * 6144];
#pragma unroll
      for (int b = 0; b < 8; ++b) acc[b] += cact[b * 1024 + ks * 128 + k] * wv; }
#pragma unroll
    for (int b = 0; b < 8; ++b) red[(ks * 64 + jj) * 8 + b] = acc[b];
    __syncthreads();
    { const int b = tid >> 6; float sacc = p.in[4][j0 + jj];
#pragma unroll
      for (int k2 = 0; k2 < 8; ++k2) sacc += red[(k2 * 64 + jj) * 8 + b];
      ((float*)(ws + WS_MOD))[b * 6144 + j0 + jj] = sacc; }
  }
}

constexpr int WT_STRIDE = 144, WT_BYTES = 32 * WT_STRIDE;
DI void wt_write(char* wl, const f32x16& a0, const f32x16& a1, int r, int hh, float scale) {
  char* bp = wl + (4 * hh) * WT_STRIDE + r * 2;
#pragma unroll
  for (int reg = 0; reg < 16; ++reg) { const int ro = ((reg & 3) + 8 * (reg >> 2)) * WT_STRIDE;
    *(bf16_t*)(bp + ro) = f2bf(a0[reg] * scale); *(bf16_t*)(bp + ro + 64) = f2bf(a1[reg] * scale); }
}
DI void wt_write_rope(char* wl, const f32x16& a0, const f32x16& a1, int r, int hh, const float* cs, const float* sn, int m0) {
  char* bp = wl + (4 * hh) * WT_STRIDE + r * 2;
#pragma unroll
  for (int reg = 0; reg < 16; ++reg) { const int rw = (reg & 3) + 8 * (reg >> 2); const int row = m0 + rw + 4 * hh;
    const float c = cs[row * 32 + r], s = sn[row * 32 + r];
    *(bf16_t*)(bp + rw * WT_STRIDE) = f2bf(a0[reg] * c - a1[reg] * s); *(bf16_t*)(bp + rw * WT_STRIDE + 64) = f2bf(a1[reg] * c + a0[reg] * s); }
}
DI void wt_store(const char* wl, int lane, bf16_t* dA, int sA, bf16_t* dB, int sB) {
  const int piece = lane & 7, rsub = lane >> 3;
  bf16_t* d = (piece < 4) ? dA : dB; const int st = (piece < 4) ? sA : sB;
  if (d) {
#pragma unroll
    for (int i = 0; i < 4; ++i) { const int row = i * 8 + rsub; const uint4 v = *(const uint4*)(wl + row * WT_STRIDE + piece * 16);
      *(uint4*)(d + (size_t)row * st + (piece & 3) * 8) = v; }
  }
}
#define LDS_FENCE() asm volatile("s_waitcnt lgkmcnt(0)" ::: "memory")
DI int lv(int x) { asm volatile("" : "+v"(x)); return x; }
template <class T> DI T* launder(T* q) { size_t z = 0; asm volatile("" : "+s"(z)); return (T*)((char*)q + z); }

constexpr int GL_GR = 0, GL_VT = 8192, GL_QD = 26624, GL_KI = 45056, GL_KIT = 63488, GL_ATT = 81920, GL_TOT = 91136, GL_DEC = 93184, GL_LA = 93696  , GL_QS = 126464  , GL_KS = 134656;
DI void gla_chunk_local(const KP& p, char* lds, unsigned char* ws, int tile, const bf16_t* qg, const bf16_t* kg, const bf16_t* vg, const bf16_t* GR) {
  const int tid = lv(threadIdx.x), lane = tid & 63, w = tid >> 6, r = lane & 31, hh = lane >> 5;
  const int b = tile >> 5, n = tile & 31, tok0 = tile * 64;
  float* GRL = (float*)(lds + GL_GR); float* TOT = (float*)(lds + GL_TOT); float* DECL = (float*)(lds + GL_DEC);
  __syncthreads();
#pragma unroll
  for (int i = 0; i < 4; ++i) GRL[tid + 512 * i] = bf2f(GR[tid + 512 * i]);
#pragma unroll 1
  for (int h = 0; h < 4; ++h) {
    __syncthreads();
    { const int t = tid >> 3, c8 = (tid & 7) * 8;
      *(uint4*)(lds + GL_QS + (t * 64 + c8) * 2) = *(const uint4*)(qg + (size_t)t * 256 + h * 64 + c8);
      *(uint4*)(lds + GL_KS + (t * 64 + c8) * 2) = *(const uint4*)(kg + (size_t)t * 256 + h * 64 + c8); }
#pragma unroll
    for (int i = 0; i < 2; ++i) { const int c = tid + 512 * i, t = c >> 4, d8 = (c & 15) * 8;
      const uint4 v = *(const uint4*)(vg + (size_t)t * 512 + h * 128 + d8);
      bf16_t* vt = (bf16_t*)(lds + GL_VT) + d8 * 72 + t;
      vt[0] = (bf16_t)(v.x & 0xffffu); vt[72] = (bf16_t)(v.x >> 16); vt[144] = (bf16_t)(v.y & 0xffffu); vt[216] = (bf16_t)(v.y >> 16);
      vt[288] = (bf16_t)(v.z & 0xffffu); vt[360] = (bf16_t)(v.z >> 16); vt[432] = (bf16_t)(v.w & 0xffffu); vt[504] = (bf16_t)(v.w >> 16); }
    const int dir = tid >> 8, qt = (tid >> 6) & 3, dk = tid & 63, col = h * 64 + dk;
    float* LAL = (float*)(lds + GL_LA) + tid;
    {
      const float* wg = launder(dir ? p.in[14] : p.in[12]); const float* bg = launder(dir ? p.in[15] : p.in[13]);
      float wr[16];
#pragma unroll
      for (int q = 0; q < 16; ++q) wr[q] = wg[q * 256 + col];
      const float bias = bg[col];
      float run = 0.f;
#pragma unroll 2
      for (int ii = 0; ii < 16; ++ii) { const int i = dir ? 15 - ii : ii;
        const float* gp = GRL + (qt * 16 + i) * 32 + dir * 16; float x = bias;
#pragma unroll
        for (int q = 0; q < 16; ++q) x += gp[q] * wr[q];
        run += logsigmoid_f(x) * (1.f / 16.f); LAL[i * 512] = run; }
      TOT[(dir * 64 + dk) * 4 + qt] = run;
    }
    __syncthreads();
    {
      const float4 tq = *(const float4*)(TOT + (dir * 64 + dk) * 4);
      const float total = (tq.x + tq.y) + (tq.z + tq.w);
      float off;
      if (dir == 0) off = (qt > 0 ? tq.x : 0.f) + (qt > 1 ? tq.y : 0.f) + (qt > 2 ? tq.z : 0.f);
      else          off = (qt < 1 ? tq.y : 0.f) + (qt < 2 ? tq.z : 0.f) + (qt < 3 ? tq.w : 0.f);
      if (qt == 0) { const float dc = expf(total); DECL[dir * 64 + dk] = dc; ((float*)(ws + WS_DEC))[((size_t)((b * 4 + h) * 2 + dir) * 32 + n) * 64 + dk] = dc; }
      bf16_t* QD = (bf16_t*)(lds + GL_QD + dir * 9216) + (qt * 16) * 72 + dk; bf16_t* KI = (bf16_t*)(lds + GL_KI + dir * 9216) + (qt * 16) * 72 + dk;
      bf16_t* KIT = (bf16_t*)(lds + GL_KIT + dir * 9216) + dk * 72 + qt * 16;
      bf16_t* qdg = (bf16_t*)(ws + WS_QDEC) + (size_t)((tile * 4 + h) * 2 + dir) * 4096 + (qt * 16) * 64 + dk;
      const bf16_t* qgp = (const bf16_t*)(lds + GL_QS) + (qt * 16) * 64 + dk; const bf16_t* kgp = (const bf16_t*)(lds + GL_KS) + (qt * 16) * 64 + dk;
#pragma unroll 2
      for (int i = 0; i < 16; ++i) { const float bb = off + LAL[i * 512];
        const float qv = bf2f(qgp[i * 64]), kv = bf2f(kgp[i * 64]);
        const bf16_t qd = f2bf(qv * expf(bb)), ki = f2bf(kv * expf(-bb));
        QD[i * 72] = qd; KI[i * 72] = ki; qdg[i * 64] = qd; KIT[i] = ki; }
    }
    __syncthreads();
    if (w < 4) { const int mi = w >> 1, ni = w & 1;
      f32x16 asum;
#pragma unroll
      for (int i = 0; i < 16; ++i) asum[i] = 0.f;
#pragma unroll
      for (int d = 0; d < 2; ++d) { f32x16 acc;
#pragma unroll
        for (int i = 0; i < 16; ++i) acc[i] = 0.f;
#pragma unroll
        for (int s = 0; s < 4; ++s) { const bf16x8 a = *(const bf16x8*)(lds + GL_QD + d * 9216 + (mi * 32 + r) * 144 + s * 32 + hh * 16);
          const bf16x8 bb = *(const bf16x8*)(lds + GL_KI + d * 9216 + (ni * 32 + r) * 144 + s * 32 + hh * 16); acc = MFMA32(a, bb, acc); }
#pragma unroll
        for (int reg = 0; reg < 16; ++reg) { const int ti = mi * 32 + crow(reg, hh), tj = ni * 32 + r; const bool keep = d ? (tj >= ti) : (tj <= ti); asum[reg] += keep ? acc[reg] : 0.f; } }
      bf16_t* at = (bf16_t*)(lds + GL_ATT) + (mi * 32 + 4 * hh) * 72 + ni * 32 + r;
#pragma unroll
      for (int reg = 0; reg < 16; ++reg) at[((reg & 3) + 8 * (reg >> 2)) * 72] = f2bf(asum[reg]);
    }
    __syncthreads();
    { const int mi = w >> 2, ni = w & 3; f32x16 acc;
#pragma unroll
      for (int i = 0; i < 16; ++i) acc[i] = 0.f;
#pragma unroll
      for (int s = 0; s < 4; ++s) { const bf16x8 a = *(const bf16x8*)(lds + GL_ATT + (mi * 32 + r) * 144 + s * 32 + hh * 16);
        const bf16x8 bb = *(const bf16x8*)(lds + GL_VT + (ni * 32 + r) * 144 + s * 32 + hh * 16); acc = MFMA32(a, bb, acc); }
      bf16_t* oi = (bf16_t*)(ws + WS_OINTRA) + (size_t)(tok0 + mi * 32 + 4 * hh) * 512 + h * 128 + ni * 32 + r;
#pragma unroll
      for (int reg = 0; reg < 16; ++reg) oi[(size_t)((reg & 3) + 8 * (reg >> 2)) * 512] = f2bf(acc[reg]); }
    { const int dvb = w >> 1, dkb = w & 1;
#pragma unroll
      for (int d = 0; d < 2; ++d) { f32x16 acc;
#pragma unroll
        for (int i = 0; i < 16; ++i) acc[i] = 0.f;
#pragma unroll
        for (int s = 0; s < 4; ++s) { const bf16x8 a = *(const bf16x8*)(lds + GL_VT + (dvb * 32 + r) * 144 + s * 32 + hh * 16);
          const bf16x8 bb = *(const bf16x8*)(lds + GL_KIT + d * 9216 + (dkb * 32 + r) * 144 + s * 32 + hh * 16); acc = MFMA32(a, bb, acc); }
        const float sc = DECL[d * 64 + dkb * 32 + r];
        bf16_t* ds = (bf16_t*)(ws + WS_SPT) + ((size_t)((b * 4 + h) * 2 + d) * 32 + n) * 8192 + (size_t)(dvb * 32 + 4 * hh) * 64 + dkb * 32 + r;
#pragma unroll
        for (int reg = 0; reg < 16; ++reg) ds[((reg & 3) + 8 * (reg >> 2)) * 64] = f2bf(acc[reg] * sc); } }
  }
}

DI void phase1(const KP& p, char* lds) {
  const int tid = threadIdx.x, lane = tid & 63, w = tid >> 6, r = lane & 31, hh = lane >> 5;
  float* cs = (float*)(lds + LDS_TAB); float* sn = cs + 2048;
  char* wl = lds + LDS_WT + (w & 3) * WT_BYTES;
  for (int tile = blockIdx.x; tile < 256; tile += gridDim.x) {
    unsigned char* ws = launder(p.ws); unsigned char* ob = (unsigned char*)launder(p.out); const float* xin = launder(p.in[0]);
    const float* mod = (const float*)(ws + WS_MOD);
    const int tok0 = tile * 64, b = tile >> 5, t0 = (tile & 31) * 64;
    bf16_t* Hs = (bf16_t*)(ob + OUT_HS) + (size_t)tok0 * 1024;
    bf16_t* CQ = (bf16_t*)(ob + OUT_CQ) + (size_t)tok0 * 640;
    bf16_t* CQN = Hs; bf16_t* CKVN = Hs + 64 * 384;
    bf16_t* GR = (bf16_t*)(ob + OUT_GR) + (size_t)tok0 * 32;
    bf16_t* Qm = (bf16_t*)(ws + WS_QM); bf16_t* Km = (bf16_t*)(ws + WS_KM); bf16_t* Vm = (bf16_t*)(ws + WS_VM);
    bf16_t* qg = (bf16_t*)(ws + WS_P1S + (size_t)tile * 131072); bf16_t* kg = qg + 64 * 256; bf16_t* vg = qg + 2 * 64 * 256;
    bf16_t* rg = (bf16_t*)(ws + WS_RG) + (size_t)tok0 * 512;
    __syncthreads();
#pragma unroll
    for (int i = 0; i < 4; ++i) { const int e = tid + 512 * i, tt = e >> 5, j = e & 31;
      const float inv = powf(10000.f, -(float)j * (1.f / 32.f)); const float ang = (float)((const int*)p.in[2])[tok0 + tt] * inv;
      cs[e] = cosf(ang); sn[e] = sinf(ang); }
    {
      float4 ge[4], sh[4];
      const float* gpre = launder(p.in[5]); const float* modb = launder(mod) + b * 6144;
#pragma unroll
      for (int i = 0; i < 4; ++i) { const int d = (lane + 64 * i) * 4;
        const float4 g = *(const float4*)(gpre + d); const float4 sc = *(const float4*)(modb + 1024 + d); sh[i] = *(const float4*)(modb + d);
        ge[i] = make_float4(g.x * (1.f + sc.x), g.y * (1.f + sc.y), g.z * (1.f + sc.z), g.w * (1.f + sc.w)); }
#pragma unroll 2
      for (int rr = 0; rr < 8; ++rr) { const int row = w * 8 + rr;
        const float* xr = xin + (size_t)(tok0 + row) * 1024;
        float4 v[4]; float ss = 0.f;
#pragma unroll
        for (int i = 0; i < 4; ++i) { v[i] = *(const float4*)(xr + (lane + 64 * i) * 4); ss += v[i].x * v[i].x + v[i].y * v[i].y + v[i].z * v[i].z + v[i].w * v[i].w; }
        ss = wave_sum(ss); const float rs = rsqrtf(ss * (1.f / 1024.f) + EPS);
#pragma unroll
        for (int i = 0; i < 4; ++i) { uint2 o; o.x = pack2(v[i].x * rs * ge[i].x + sh[i].x, v[i].y * rs * ge[i].y + sh[i].y); o.y = pack2(v[i].z * rs * ge[i].z + sh[i].z, v[i].w * rs * ge[i].w + sh[i].w);
          *(uint2*)(Hs + (size_t)row * 1024 + (lane + 64 * i) * 4) = o; }
      }
    }
    __syncthreads();
    block_gemm<3>(lds, Hs, 1024, (const bf16_t*)(ws + WS_WTIN), 9, 1024, [&](int m0, int n0, const f32x16& a0, const f32x16& a1) {
      const int r2 = lv(r), h2 = lv(hh), ln = lv(lane);
      if (n0 == O_KR) {
        wt_write_rope(wl, a0, a1, r2, h2, cs, sn, m0); LDS_FENCE();
        for (int h = 0; h < 4; ++h) { bf16_t* kp = Km + (((size_t)b * 4 + h) * SEQ + t0 + m0) * 192 + 128; wt_store(wl, ln, kp, 192, kp + 32, 192); }
        return; }
      wt_write(wl, a0, a1, r2, h2, (n0 >= O_QG && n0 < O_KG) ? 0.125f : 1.f); LDS_FENCE();
      bf16_t* d[2]; int st[2];
#pragma unroll
      for (int half = 0; half < 2; ++half) { const int nb = n0 + 32 * half;
        if (nb < 640) { d[half] = CQ + (size_t)m0 * 640 + nb; st[half] = 640; }
        else if (nb < O_KG) { d[half] = qg + (size_t)m0 * 256 + (nb - O_QG); st[half] = 256; }
        else if (nb < O_VG) { d[half] = kg + (size_t)m0 * 256 + (nb - O_KG); st[half] = 256; }
        else if (nb < O_GF) { d[half] = vg + (size_t)m0 * 512 + (nb - O_VG); st[half] = 512; }
        else if (nb < O_R) { d[half] = GR + (size_t)m0 * 32; st[half] = 32; }
        else if (nb < INW) { d[half] = rg + (size_t)m0 * 512 + (nb - O_R); st[half] = 512; }
        else { d[half] = nullptr; st[half] = 0; } }
      wt_store(wl, ln, d[0], st[0], d[1], st[1]);
    });
    __syncthreads();
    const float* gq = launder(p.in[8]); const float* gkv = launder(p.in[10]);
#pragma unroll 2
    for (int rr = 0; rr < 8; ++rr) { const int row = w * 8 + rr; const unsigned* cr = (const unsigned*)(CQ + (size_t)row * 640);
      float v0[5], v1[5];
#pragma unroll
      for (int i = 0; i < 5; ++i) { const unsigned u = cr[lane + 64 * i]; v0[i] = __uint_as_float(u << 16); v1[i] = __uint_as_float(u & 0xffff0000u); }
      float ss = v0[0] * v0[0] + v1[0] * v1[0] + v0[1] * v0[1] + v1[1] * v1[1] + v0[2] * v0[2] + v1[2] * v1[2];
      float s2 = v0[3] * v0[3] + v1[3] * v1[3] + v0[4] * v0[4] + v1[4] * v1[4];
      ss = wave_sum(ss); s2 = wave_sum(s2);
      const float rq = rsqrtf(ss * (1.f / 384.f) + EPS), rk = rsqrtf(s2 * (1.f / 256.f) + EPS);
#pragma unroll
      for (int i = 0; i < 3; ++i) { const int c = 2 * (lane + 64 * i); *(unsigned*)(CQN + (size_t)row * 384 + c) = pack2(v0[i] * rq * gq[c], v1[i] * rq * gq[c + 1]); }
#pragma unroll
      for (int i = 3; i < 5; ++i) { const int c = 2 * (lane + 64 * (i - 3)); *(unsigned*)(CKVN + (size_t)row * 256 + c) = pack2(v0[i] * rk * gkv[c], v1[i] * rk * gkv[c + 1]); }
    }
    __syncthreads();
    block_gemm<3>(lds, CQN, 384, (const bf16_t*)(ws + WS_WTQUP), 3, 384, [&](int m0, int n0, const f32x16& a0, const f32x16& a1) {
      const int r2 = lv(r), h2 = lv(hh), ln = lv(lane);
      const int h = n0 / 192, d0 = n0 % 192;
      bf16_t* qp = Qm + (((size_t)b * 4 + h) * SEQ + t0 + m0) * 192 + d0;
      if (d0 < 128) wt_write(wl, a0, a1, r2, h2, 1.f); else wt_write_rope(wl, a0, a1, r2, h2, cs, sn, m0);
      LDS_FENCE();
      wt_store(wl, ln, qp, 192, qp + 32, 192);
    });
    block_gemm<3>(lds, CKVN, 256, (const bf16_t*)(ws + WS_WTKVUP), 4, 256, [&](int m0, int n0, const f32x16& a0, const f32x16& a1) {
      const int r2 = lv(r), h2 = lv(hh), ln = lv(lane);
      const int h = n0 >> 8, d0 = n0 & 255;
      wt_write(wl, a0, a1, r2, h2, 1.f); LDS_FENCE();
      if (d0 < 128) { bf16_t* kp = Km + (((size_t)b * 4 + h) * SEQ + t0 + m0) * 192 + d0; wt_store(wl, ln, kp, 192, kp + 32, 192); }
      else { bf16_t* vp = Vm + (((size_t)b * 4 + h) * SEQ + t0 + m0) * 128 + (d0 - 128); wt_store(wl, ln, vp, 128, vp + 32, 128); }
    });
    gla_chunk_local(p, lds, ws, tile, qg, kg, vg, GR);
  }
}

namespace att {
typedef short s16x4 __attribute__((ext_vector_type(4)));
typedef unsigned u32x4 __attribute__((ext_vector_type(4)));
constexpr int DQ = 192, DV = 128, KVBLK = 64;
constexpr float SCALE = 0.07216878364870322f;
constexpr float THR = 8.f;
constexpr int SHM_V = KVBLK * DV * 2, SHM_K = KVBLK * DQ * 2;
constexpr int SHM_QR = 8 * 32 * 176;
constexpr int SHM_ATTN = 2 * SHM_V + 2 * SHM_K + 8 * 64 * 4 + SHM_QR;
#define KSWZ(row, colB) ((row) * 384 + ((colB) ^ (((row) & 7) << 4)))
#define SBAR() __builtin_amdgcn_sched_barrier(0)
DI unsigned cvtpk(float lo, float hi) { unsigned r; asm volatile("v_cvt_pk_bf16_f32 %0, %1, %2" : "=v"(r) : "v"(lo), "v"(hi)); return r; }

DI void partialSM(f32x16& p0, f32x16& p1, float& m_reg, float& mn, float& alpha) {
  constexpr float C = SCALE * 1.4426950408889634f;
  float pmax = p0[0];
#pragma unroll
  for (int r = 1; r < 16; ++r) pmax = fmaxf(pmax, p0[r]);
#pragma unroll
  for (int r = 0; r < 16; ++r) pmax = fmaxf(pmax, p1[r]);
  { auto rr = __builtin_amdgcn_permlane32_swap(__float_as_uint(pmax), __float_as_uint(pmax), false, false);
    pmax = fmaxf(__uint_as_float(rr[0]), __uint_as_float(rr[1])); }
  if (__builtin_expect(__all(pmax - m_reg <= THR / SCALE), 1)) { mn = m_reg; alpha = 1.f; }
  else { mn = fmaxf(m_reg, pmax); alpha = __builtin_amdgcn_exp2f((m_reg - mn) * C); m_reg = mn; }
  const float mnC = -mn * C;
#pragma unroll
  for (int r = 0; r < 16; ++r) p0[r] = fmaf(p0[r], C, mnC);
#pragma unroll
  for (int r = 0; r < 16; ++r) p1[r] = fmaf(p1[r], C, mnC);
#pragma unroll
  for (int r = 0; r < 16; ++r) p0[r] = __builtin_amdgcn_exp2f(p0[r]);
}
DI void finishSM(f32x16& p0, f32x16& p1, float alpha, float& l_reg, bf16x8& pa0, bf16x8& pa1, bf16x8& pa2, bf16x8& pa3) {
#pragma unroll
  for (int r = 0; r < 16; ++r) p1[r] = __builtin_amdgcn_exp2f(p1[r]);
  float ps = 0;
#pragma unroll
  for (int r = 0; r < 16; ++r) ps += p0[r];
#pragma unroll
  for (int r = 0; r < 16; ++r) ps += p1[r];
  { auto rr = __builtin_amdgcn_permlane32_swap(__float_as_uint(ps), __float_as_uint(ps), false, false);
    ps = __uint_as_float(rr[0]) + __uint_as_float(rr[1]); }
  l_reg = l_reg * alpha + ps;
#define PK4(P, BASE, OUT) do { unsigned a0 = cvtpk(P[BASE + 0], P[BASE + 1]), a1 = cvtpk(P[BASE + 2], P[BASE + 3]);   \
    unsigned b0 = cvtpk(P[BASE + 4], P[BASE + 5]), b1 = cvtpk(P[BASE + 6], P[BASE + 7]);                              \
    auto r0 = __builtin_amdgcn_permlane32_swap(a0, b0, false, false); auto r1 = __builtin_amdgcn_permlane32_swap(a1, b1, false, false); \
    u32x4 wv = {r0[0], r1[0], r0[1], r1[1]}; OUT = *reinterpret_cast<bf16x8*>(&wv); } while (0)
  PK4(p0, 0, pa0); PK4(p0, 8, pa1); PK4(p1, 0, pa2); PK4(p1, 8, pa3);
#undef PK4
}
DI void qkt(f32x16& p0, f32x16& p1, const char* Ks, const bf16x8* qr, const char* qrl, int r32, int hi) {
#pragma unroll
  for (int i = 0; i < 16; ++i) { p0[i] = 0.f; p1[i] = 0.f; }
#pragma unroll
  for (int d0 = 0; d0 < 12; ++d0) { const int cb = (d0 * 16 + hi * 8) * 2;
    const bf16x8 b0 = *reinterpret_cast<const bf16x8*>(Ks + KSWZ(r32, cb));
    const bf16x8 b1 = *reinterpret_cast<const bf16x8*>(Ks + KSWZ(32 + r32, cb));
    const bf16x8 q = (d0 < 7) ? qr[d0 < 7 ? d0 : 0] : *reinterpret_cast<const bf16x8*>(qrl + (d0 - 7) * 32);
    p0 = MFMA32(b0, q, p0);
    p1 = MFMA32(b1, q, p1); }
}
DI int v_st(int k, int c) { const int kk = (k & ~0xC) | ((k & 4) << 1) | ((k & 8) >> 1); return ((kk >> 3) * 4 + (c >> 5)) * 512 + ((kk & 7) * 32 + (c & 31)) * 2; }
DI int v_rd_base(int lane) { return ((lane & 3) << 3) | (((lane >> 2) & 3) << 6) | (((lane >> 4) & 1) << 5) | (((lane >> 5) & 1) << 8); }
constexpr int v_rd_off(int d0, int ks, int half) { return d0 * 512 + ks * 4096 + half * 2048; }
template <int OFF> DI s16x4 tr_read(int vb) { s16x4 r; asm volatile("ds_read_b64_tr_b16 %0, %1 offset:%2" : "=&v"(r) : "v"(vb), "i"(OFF) : "memory"); return r; }
template <int D0> DI void pv_one(f32x16& od, int vb, bf16x8 pa0, bf16x8 pa1, bf16x8 pa2, bf16x8 pa3) {
  const s16x4 l0 = tr_read<v_rd_off(D0, 0, 0)>(vb), h0 = tr_read<v_rd_off(D0, 0, 1)>(vb), l1 = tr_read<v_rd_off(D0, 1, 0)>(vb), h1 = tr_read<v_rd_off(D0, 1, 1)>(vb);
  const s16x4 l2 = tr_read<v_rd_off(D0, 2, 0)>(vb), h2 = tr_read<v_rd_off(D0, 2, 1)>(vb), l3 = tr_read<v_rd_off(D0, 3, 0)>(vb), h3 = tr_read<v_rd_off(D0, 3, 1)>(vb);
  asm volatile("s_waitcnt lgkmcnt(0)" ::: "memory"); SBAR();
#define PK(L, H) (bf16x8){L[0], L[1], L[2], L[3], H[0], H[1], H[2], H[3]}
  od = MFMA32(pa0, PK(l0, h0), od);
  od = MFMA32(pa1, PK(l1, h1), od);
  od = MFMA32(pa2, PK(l2, h2), od);
  od = MFMA32(pa3, PK(l3, h3), od);
#undef PK
}
DI void pv_d0(f32x16* o, int vb, bf16x8 pa0, bf16x8 pa1, bf16x8 pa2, bf16x8 pa3) {
  pv_one<0>(o[0], vb, pa0, pa1, pa2, pa3); pv_one<1>(o[1], vb, pa0, pa1, pa2, pa3); pv_one<2>(o[2], vb, pa0, pa1, pa2, pa3); pv_one<3>(o[3], vb, pa0, pa1, pa2, pa3);
}
DI void attn_unit(const bf16_t* Qb, const bf16_t* Kh, const bf16_t* Vh, bf16_t* Ob, int seq, char* lds) {
  const int tid = lv(threadIdx.x), wid = tid >> 6, lane = tid & 63, r32 = lane & 31, hi = lane >> 5;
  char* V_lds = lds; char* K_lds = lds + 2 * SHM_V;
  float* wsf = (float*)(lds + 2 * SHM_V + 2 * SHM_K) + wid * 64; float* li_l = wsf; float* al_l = wsf + 32;
  char* qrl = lds + 2 * SHM_V + 2 * SHM_K + 8 * 64 * 4 + wid * (32 * 176) + r32 * 176 + hi * 16;
  float m_reg = -1e30f, l_reg = 0; f32x16 o[4]; bf16x8 qr[7];
#pragma unroll
  for (int d = 0; d < 4; ++d)
#pragma unroll
    for (int i = 0; i < 16; ++i) o[d][i] = 0.f;
  const bf16_t* Qw = Qb + (size_t)(wid * 32 + r32) * DQ + hi * 8;
#pragma unroll
  for (int d0 = 0; d0 < 7; ++d0) qr[d0] = *reinterpret_cast<const bf16x8*>(Qw + d0 * 16);
#pragma unroll
  for (int d0 = 7; d0 < 12; ++d0) *reinterpret_cast<bf16x8*>(qrl + (d0 - 7) * 32) = *reinterpret_cast<const bf16x8*>(Qw + d0 * 16);
  int kst[3];
#pragma unroll
  for (int i = 0; i < 3; ++i) { const int c = tid + 512 * i; kst[i] = KSWZ(c / 24, (c % 24) * 16); }
  const int vst0 = v_st(tid >> 4, (tid & 15) * 8), vst1 = v_st(32 + (tid >> 4), (tid & 15) * 8);
  const int vb0 = (int)(uintptr_t)V_lds + v_rd_base(lane);
  bf16x8 sk0, sk1, sk2, sv0, sv1;
#define SLOAD(k0) do { const bf16x8* kp = reinterpret_cast<const bf16x8*>(Kh + (size_t)(k0) * DQ) + tid; sk0 = kp[0]; sk1 = kp[512]; sk2 = kp[1024]; \
    const bf16x8* vp = reinterpret_cast<const bf16x8*>(Vh + (size_t)(k0) * DV) + tid; sv0 = vp[0]; sv1 = vp[512]; } while (0)
#define SWRITE(b) do { *(bf16x8*)(V_lds + (b) * SHM_V + vst0) = sv0; *(bf16x8*)(V_lds + (b) * SHM_V + vst1) = sv1; \
    *(bf16x8*)(K_lds + (b) * SHM_K + kst[0]) = sk0; *(bf16x8*)(K_lds + (b) * SHM_K + kst[1]) = sk1; *(bf16x8*)(K_lds + (b) * SHM_K + kst[2]) = sk2; } while (0)
#define RESC(a) do { if (__any((a) < 1.f)) { if (hi == 0) al_l[r32] = (a); asm volatile("s_waitcnt lgkmcnt(0)" ::: "memory"); \
    _Pragma("unroll") for (int d = 0; d < 4; ++d) _Pragma("unroll") for (int r = 0; r < 16; ++r) o[d][r] *= al_l[crow(r, hi)]; } } while (0)
  f32x16 pA0, pA1, pB0, pB1; float mnA, mnB, alA, alB; bf16x8 pa0, pa1, pa2, pa3; const int NT = seq / KVBLK;
  SLOAD(0); SWRITE(0); __syncthreads();
  qkt(pA0, pA1, K_lds, qr, qrl, r32, hi); partialSM(pA0, pA1, m_reg, mnA, alA);
  SLOAD(KVBLK); SWRITE(1); __syncthreads();
  for (int j = 1; j + 1 < NT; j += 2) {
    SBAR(); qkt(pB0, pB1, K_lds + SHM_K, qr, qrl, r32, hi);
    finishSM(pA0, pA1, alA, l_reg, pa0, pa1, pa2, pa3); SBAR();
    SLOAD((j + 1) * KVBLK); SBAR();
    pv_d0(o, vb0, pa0, pa1, pa2, pa3); partialSM(pB0, pB1, m_reg, mnB, alB);
    __syncthreads(); SWRITE(0);
    RESC(alB); __syncthreads();
    SBAR(); qkt(pA0, pA1, K_lds, qr, qrl, r32, hi);
    finishSM(pB0, pB1, alB, l_reg, pa0, pa1, pa2, pa3); SBAR();
    SLOAD((j + 2) * KVBLK); SBAR();
    pv_d0(o, vb0 + SHM_V, pa0, pa1, pa2, pa3); partialSM(pA0, pA1, m_reg, mnA, alA);
    __syncthreads(); SWRITE(1);
    RESC(alA); __syncthreads();
  }
  SBAR(); qkt(pB0, pB1, K_lds + SHM_K, qr, qrl, r32, hi);
  finishSM(pA0, pA1, alA, l_reg, pa0, pa1, pa2, pa3); SBAR();
  pv_d0(o, vb0, pa0, pa1, pa2, pa3); partialSM(pB0, pB1, m_reg, mnB, alB);
  __syncthreads(); RESC(alB);
  finishSM(pB0, pB1, alB, l_reg, pa0, pa1, pa2, pa3); SBAR();
  pv_d0(o, vb0 + SHM_V, pa0, pa1, pa2, pa3);
  if (hi == 0) li_l[r32] = l_reg; asm volatile("s_waitcnt lgkmcnt(0)" ::: "memory");
  float rli[16];
#pragma unroll
  for (int r = 0; r < 16; ++r) rli[r] = __builtin_amdgcn_rcpf(li_l[crow(r, hi)]);
  bf16_t* Ow = Ob + (size_t)(wid * 32) * 1024;
#pragma unroll
  for (int r = 0; r < 16; ++r) { const int orow = crow(r, hi);
#pragma unroll
    for (int d0 = 0; d0 < 4; ++d0) Ow[(size_t)orow * 1024 + d0 * 32 + r32] = f2bf(o[d0][r] * rli[r]); }
  __syncthreads();
#undef SLOAD
#undef SWRITE
#undef RESC
}
}

DI void phase2_attn(const KP& p, char* lds) {
  for (int u = blockIdx.x; u < 256; u += gridDim.x) {
    unsigned char* ws = launder(p.ws);
    const bf16_t* Qm = (const bf16_t*)(ws + WS_QM); const bf16_t* Km = (const bf16_t*)(ws + WS_KM); const bf16_t* Vm = (const bf16_t*)(ws + WS_VM);
    bf16_t* mixa = (bf16_t*)(ws + WS_P1S);
    const int qb = u & 7, bh = u >> 3, b = bh >> 2, h = bh & 3;
    att::attn_unit(Qm + ((size_t)bh * SEQ + qb * 256) * 192, Km + (size_t)bh * SEQ * 192, Vm + (size_t)bh * SEQ * 128,
                   mixa + ((size_t)b * SEQ + qb * 256) * 1024 + h * 128, SEQ, lds);
  }
}

constexpr int P3_TILE_BYTES = 256 * 1024;
constexpr int LDS_TK = 92160;
constexpr int SCW = 260;
template <int N> DI void ce_desc(float (&a)[N], int i, int l) { const float hi = fmaxf(a[i], a[l]), lo = fminf(a[i], a[l]); a[i] = hi; a[l] = lo; }
DI void sort16_desc(float (&a)[16]) {
#pragma unroll
  for (int k = 2; k <= 16; k <<= 1)
#pragma unroll
    for (int j = k >> 1; j > 0; j >>= 1)
#pragma unroll
      for (int i = 0; i < 16; ++i) { const int l = i ^ j; if (l > i) { if ((i & k) == 0) ce_desc(a, i, l); else ce_desc(a, l, i); } }
}
DI void merge16_desc(float (&a)[16]) {
#pragma unroll
  for (int j = 8; j > 0; j >>= 1)
#pragma unroll
    for (int i = 0; i < 16; ++i) { const int l = i ^ j; if (l > i) ce_desc(a, i, l); }
}
DI void top16_merge(float (&a)[16], const float (&b)[16]) {
#pragma unroll
  for (int i = 0; i < 16; ++i) a[i] = fmaxf(a[i], b[15 - i]);
  merge16_desc(a);
}
template <int CTRL> DI float dpp_f(float v) { return __int_as_float(__builtin_amdgcn_mov_dpp(__float_as_int(v), CTRL, 0xF, 0xF, true)); }

DI float gelu_fast(float x) { return 0.5f * x * (1.f + erff(x * 0.70710678118654752f)); }

DI void phase3(const KP& p, char* lds, const int gather_reps, const int probe) {
  const int tid0 = threadIdx.x;
  const int r = tid0 & 31, hh = (tid0 >> 5) & 1, lane = tid0 & 63;
  char* wl = lds + LDS_WT + ((tid0 >> 6) & 3) * WT_BYTES;
  for (int tile = blockIdx.x; tile < 256; tile += gridDim.x) {
    unsigned char* ws = launder(p.ws); float* outp = launder(p.out); const float* xin = launder(p.in[0]);
    const int tok0 = tile * 64, b = tile >> 5;
    unsigned char* tsc = ws + WS_QM + (size_t)tile * P3_TILE_BYTES;
    bf16_t* QRY = (bf16_t*)tsc; bf16_t* Y = (bf16_t*)tsc; bf16_t* MIXA = (bf16_t*)(ws + WS_P1S) + (size_t)tok0 * 1024; bf16_t* H2 = MIXA;
    const float* modb = launder((const float*)(ws + WS_MOD)) + b * 6144;
    __syncthreads();
    {
      const int tid = lv(tid0), lane = tid & 63, w = tid >> 6, r = lane & 31, hh = lane >> 5;
      const int h = w >> 1, mi = w & 1, n = tile & 31;
      const bf16_t* QDg = (const bf16_t*)(ws + WS_QDEC) + (size_t)(tile * 4 + h) * 2 * 4096 + (mi * 32 + r) * 64 + hh * 8;
      const bf16_t* SPg = (const bf16_t*)(ws + WS_SPT) + ((size_t)((b * 4 + h) * 2) * 32 + n) * 8192 + r * 64 + hh * 8;
      f32x16 acc[4];
#pragma unroll
      for (int ni = 0; ni < 4; ++ni)
#pragma unroll
        for (int i = 0; i < 16; ++i) acc[ni][i] = 0.f;
#pragma unroll
      for (int d = 0; d < 2; ++d)
#pragma unroll
        for (int s = 0; s < 4; ++s) { const bf16x8 a = *(const bf16x8*)(QDg + d * 4096 + s * 16);
#pragma unroll
          for (int ni = 0; ni < 4; ++ni) { const bf16x8 bb = *(const bf16x8*)(SPg + (size_t)d * 32 * 8192 + ni * 32 * 64 + s * 16); acc[ni] = MFMA32(a, bb, acc[ni]); } }
      const bf16_t* OI = (const bf16_t*)(ws + WS_OINTRA) + (size_t)(tok0 + mi * 32 + 4 * hh) * 512 + h * 128 + r;
#pragma unroll
      for (int ni = 0; ni < 4; ++ni)
#pragma unroll
        for (int reg = 0; reg < 16; ++reg) acc[ni][reg] += bf2f(OI[(size_t)((reg & 3) + 8 * (reg >> 2)) * 512 + ni * 32]);
      float rs[16];
#pragma unroll
      for (int reg = 0; reg < 16; ++reg) { float v = acc[0][reg] * acc[0][reg] + acc[1][reg] * acc[1][reg] + acc[2][reg] * acc[2][reg] + acc[3][reg] * acc[3][reg];
        v += __shfl_xor(v, 1); v += __shfl_xor(v, 2); v += __shfl_xor(v, 4); v += __shfl_xor(v, 8); v += __shfl_xor(v, 16);
        rs[reg] = rsqrtf(v * (1.f / 128.f) + EPS); }
      const float* ggl = launder(p.in[16]);
      const bf16_t* RGp = (const bf16_t*)(ws + WS_RG) + (size_t)(tok0 + mi * 32 + 4 * hh) * 512 + h * 128 + r;
      bf16_t* MX = MIXA + (size_t)(mi * 32 + 4 * hh) * 1024 + 512 + h * 128 + r;
#pragma unroll
      for (int ni = 0; ni < 4; ++ni) { const float g = ggl[ni * 32 + r];
#pragma unroll
        for (int reg = 0; reg < 16; ++reg) { const int ro = (reg & 3) + 8 * (reg >> 2); const float rv = bf2f(RGp[(size_t)ro * 512 + ni * 32]);
          MX[(size_t)ro * 1024 + ni * 32] = f2bf(acc[ni][reg] * rs[reg] * g * silu_f(rv)); } }
    }
    __syncthreads();
    for (int rep3b = 0; rep3b < (probe == 5 ? 2 : 1); ++rep3b)
    block_gemm<3>(lds, MIXA, 1024, (const bf16_t*)(ws + WS_WTOUT), 4, 1024, [&](int m0, int n0, const f32x16& a0, const f32x16& a1) {
      const int r2 = lv(r), h2 = lv(hh), ln = lv(lane);
      wt_write(wl, a0, a1, r2, h2, 1.f); LDS_FENCE();
      bf16_t* d = Y + (size_t)m0 * 1024 + n0; wt_store(wl, ln, d, 1024, d + 32, 1024);
    });
    __syncthreads();
    {
      const int tid = lv(tid0), lane = tid & 63, w = tid >> 6;
      float4 A1[4], A2[4], S2[4];
      const float* gpo = launder(p.in[6]); const float* gpf = launder(p.in[18]);
#pragma unroll
      for (int i = 0; i < 4; ++i) { const int d = (lane + 64 * i) * 4;
        const float4 gp = *(const float4*)(gpo + d), gt = *(const float4*)(modb + 2048 + d), g2 = *(const float4*)(gpf + d), sc = *(const float4*)(modb + 4096 + d);
        S2[i] = *(const float4*)(modb + 3072 + d);
        A1[i] = make_float4(gp.x * gt.x, gp.y * gt.y, gp.z * gt.z, gp.w * gt.w);
        A2[i] = make_float4(g2.x * (1.f + sc.x), g2.y * (1.f + sc.y), g2.z * (1.f + sc.z), g2.w * (1.f + sc.w)); }
#pragma unroll 2
      for (int rr = 0; rr < 8; ++rr) { const int row = w * 8 + rr; const size_t tok = tok0 + row;
        float4 yv[4]; float ss = 0.f;
#pragma unroll
        for (int i = 0; i < 4; ++i) { const uint2 u = *(const uint2*)(Y + (size_t)row * 1024 + (lane + 64 * i) * 4);
          yv[i] = make_float4(__uint_as_float(u.x << 16), __uint_as_float(u.x & 0xffff0000u), __uint_as_float(u.y << 16), __uint_as_float(u.y & 0xffff0000u));
          ss += yv[i].x * yv[i].x + yv[i].y * yv[i].y + yv[i].z * yv[i].z + yv[i].w * yv[i].w; }
        ss = wave_sum(ss); const float rs = rsqrtf(ss * (1.f / 1024.f) + EPS);
        float4 xv[4]; float s2 = 0.f;
#pragma unroll
        for (int i = 0; i < 4; ++i) { const float4 x = *(const float4*)(xin + tok * 1024 + (lane + 64 * i) * 4);
          xv[i] = make_float4(x.x + A1[i].x * yv[i].x * rs, x.y + A1[i].y * yv[i].y * rs, x.z + A1[i].z * yv[i].z * rs, x.w + A1[i].w * yv[i].w * rs);
          *(float4*)(outp + tok * 1024 + (lane + 64 * i) * 4) = xv[i];
          s2 += xv[i].x * xv[i].x + xv[i].y * xv[i].y + xv[i].z * xv[i].z + xv[i].w * xv[i].w; }
        s2 = wave_sum(s2); const float r2 = rsqrtf(s2 * (1.f / 1024.f) + EPS);
#pragma unroll
        for (int i = 0; i < 4; ++i) { uint2 o; o.x = pack2(xv[i].x * r2 * A2[i].x + S2[i].x, xv[i].y * r2 * A2[i].y + S2[i].y); o.y = pack2(xv[i].z * r2 * A2[i].z + S2[i].z, xv[i].w * r2 * A2[i].w + S2[i].w);
          *(uint2*)(H2 + (size_t)row * 1024 + (lane + 64 * i) * 4) = o; }
      }
    }
    __syncthreads();
    for (int rep3d = 0; rep3d < (probe == 6 ? 2 : 1); ++rep3d)
    block_gemm<3>(lds, H2, 1024, (const bf16_t*)(ws + WS_WTPQ), 8, 1024, [&](int m0, int n0, const f32x16& a0, const f32x16& a1) {
      const int r2 = lv(r), h2 = lv(hh), ln = lv(lane);
      wt_write(wl, a0, a1, r2, h2, 1.f); LDS_FENCE();
      bf16_t* d = QRY + (size_t)m0 * 2048 + n0; wt_store(wl, ln, d, 2048, d + 32, 2048);
    });
    __syncthreads();
    float* SC = (float*)lds; unsigned* TK = (unsigned*)(lds + LDS_TK);
    for (int rep3e = 0; rep3e < (probe == 7 ? 2 : 1); ++rep3e)
    for (int h = 0; h < 8; ++h) {
      block_gemm<2>(lds, QRY + h * 256, 2048, (const bf16_t*)(ws + WS_KD), 1, 256, [&](int m0, int n0, const f32x16& a0, const f32x16& a1) {
        const int r2 = lv(r), h2 = lv(hh);
        float* sp = SC + (m0 + 4 * h2) * SCW + n0 + r2;
#pragma unroll
        for (int reg = 0; reg < 16; ++reg) { const int ro = ((reg & 3) + 8 * (reg >> 2)) * SCW; sp[ro] = a0[reg]; sp[ro + 32] = a1[reg]; }
      });
      __syncthreads();
      {
        const int tid = lv(tid0);
        const int tt = tid >> 3, sd = (tid >> 2) & 1, q = tid & 3;
        const float* sr = SC + tt * SCW + sd * 128 + q * 32;
        float a[16], c[16];
#pragma unroll
        for (int i = 0; i < 4; ++i) { const float4 v = *(const float4*)(sr + i * 4); const unsigned ib = q * 32 + i * 4;
          a[i * 4 + 0] = __uint_as_float((__float_as_uint(v.x) & 0xFFFFFF80u) | (ib + 0)); a[i * 4 + 1] = __uint_as_float((__float_as_uint(v.y) & 0xFFFFFF80u) | (ib + 1));
          a[i * 4 + 2] = __uint_as_float((__float_as_uint(v.z) & 0xFFFFFF80u) | (ib + 2)); a[i * 4 + 3] = __uint_as_float((__float_as_uint(v.w) & 0xFFFFFF80u) | (ib + 3)); }
#pragma unroll
        for (int i = 0; i < 4; ++i) { const float4 v = *(const float4*)(sr + 16 + i * 4); const unsigned ib = q * 32 + 16 + i * 4;
          c[i * 4 + 0] = __uint_as_float((__float_as_uint(v.x) & 0xFFFFFF80u) | (ib + 0)); c[i * 4 + 1] = __uint_as_float((__float_as_uint(v.y) & 0xFFFFFF80u) | (ib + 1));
          c[i * 4 + 2] = __uint_as_float((__float_as_uint(v.z) & 0xFFFFFF80u) | (ib + 2)); c[i * 4 + 3] = __uint_as_float((__float_as_uint(v.w) & 0xFFFFFF80u) | (ib + 3)); }
        sort16_desc(a); sort16_desc(c); top16_merge(a, c);
#pragma unroll
        for (int i = 0; i < 16; ++i) c[i] = dpp_f<0xB1>(a[i]);
        top16_merge(a, c);
#pragma unroll
        for (int i = 0; i < 16; ++i) c[i] = dpp_f<0x4E>(a[i]);
        top16_merge(a, c);
        if (q == 0) { unsigned* tk = TK + ((tt * 8 + h) * 2 + sd) * 16;
#pragma unroll
          for (int i = 0; i < 4; ++i) *(uint4*)(tk + i * 4) = make_uint4(__float_as_uint(a[i * 4]), __float_as_uint(a[i * 4 + 1]), __float_as_uint(a[i * 4 + 2]), __float_as_uint(a[i * 4 + 3])); }
      }
      __syncthreads();
    }
    int* EIDX = (int*)lds; float* GATE = (float*)(lds + 32768);
    {
      const int tid = lv(tid0);
      const int tt = tid >> 3, h = tid & 7;
      const unsigned* t1 = TK + ((tt * 8 + h) * 2) * 16; const unsigned* t2 = t1 + 16;
      float v1[16], v2[16];
#pragma unroll
      for (int i = 0; i < 4; ++i) { const uint4 u = *(const uint4*)(t1 + i * 4), v = *(const uint4*)(t2 + i * 4);
        v1[i * 4] = __uint_as_float(u.x & 0xFFFFFF80u); v1[i * 4 + 1] = __uint_as_float(u.y & 0xFFFFFF80u); v1[i * 4 + 2] = __uint_as_float(u.z & 0xFFFFFF80u); v1[i * 4 + 3] = __uint_as_float(u.w & 0xFFFFFF80u);
        v2[i * 4] = __uint_as_float(v.x & 0xFFFFFF80u); v2[i * 4 + 1] = __uint_as_float(v.y & 0xFFFFFF80u); v2[i * 4 + 2] = __uint_as_float(v.z & 0xFFFFFF80u); v2[i * 4 + 3] = __uint_as_float(v.w & 0xFFFFFF80u); }
      float best[16], grp[16];
#define CAND(i, j) __uint_as_float((__float_as_uint(v1[i] + v2[j]) & 0xFFFFFF00u) | ((i) << 4) | (j))
      best[0] = CAND(0, 0); best[1] = CAND(0, 1); best[2] = CAND(0, 2); best[3] = CAND(0, 3); best[4] = CAND(0, 4); best[5] = CAND(0, 5); best[6] = CAND(0, 6); best[7] = CAND(0, 7);
      best[8] = CAND(0, 8); best[9] = CAND(0, 9); best[10] = CAND(0, 10); best[11] = CAND(0, 11); best[12] = CAND(0, 12); best[13] = CAND(0, 13); best[14] = CAND(0, 14); best[15] = CAND(0, 15);
      sort16_desc(best);
      grp[0] = CAND(1, 0); grp[1] = CAND(1, 1); grp[2] = CAND(1, 2); grp[3] = CAND(1, 3); grp[4] = CAND(1, 4); grp[5] = CAND(1, 5); grp[6] = CAND(1, 6); grp[7] = CAND(1, 7);
      grp[8] = CAND(2, 0); grp[9] = CAND(2, 1); grp[10] = CAND(2, 2); grp[11] = CAND(2, 3); grp[12] = CAND(2, 4); grp[13] = CAND(3, 0); grp[14] = CAND(3, 1); grp[15] = CAND(3, 2);
      sort16_desc(grp); top16_merge(best, grp);
      grp[0] = CAND(3, 3); grp[1] = CAND(4, 0); grp[2] = CAND(4, 1); grp[3] = CAND(4, 2); grp[4] = CAND(5, 0); grp[5] = CAND(5, 1); grp[6] = CAND(6, 0); grp[7] = CAND(6, 1);
      grp[8] = CAND(7, 0); grp[9] = CAND(7, 1); grp[10] = CAND(8, 0); grp[11] = CAND(9, 0); grp[12] = CAND(10, 0); grp[13] = CAND(11, 0); grp[14] = CAND(12, 0); grp[15] = CAND(13, 0);
      sort16_desc(grp); top16_merge(best, grp);
      { const float c14 = CAND(14, 0), c15 = CAND(15, 0);
        grp[0] = fmaxf(c14, c15); grp[1] = fminf(c14, c15);
#pragma unroll
        for (int i = 2; i < 16; ++i) grp[i] = -3.0e38f;
        top16_merge(best, grp); }
#undef CAND
      __syncthreads();
      float sv[16]; int ev[16]; float mx = -3.0e38f;
#pragma unroll
      for (int k = 0; k < 16; ++k) { const unsigned key = __float_as_uint(best[k]); const int ci = (key >> 4) & 15, cj = key & 15;
        const unsigned k1 = t1[ci], k2 = t2[cj];
        sv[k] = __uint_as_float(k1 & 0xFFFFFF80u) + __uint_as_float(k2 & 0xFFFFFF80u); ev[k] = (int)((k1 & 127u) * 128u + (k2 & 127u)); mx = fmaxf(mx, sv[k]); }
      float sum = 0.f;
#pragma unroll
      for (int k = 0; k < 16; ++k) { sv[k] = __expf(sv[k] - mx); sum += sv[k]; }
      const float inv = 1.f / sum;
#pragma unroll
      for (int k = 0; k < 16; ++k) { EIDX[tt * 128 + h * 16 + k] = ev[k]; GATE[tt * 128 + h * 16 + k] = sv[k] * inv; }
    }
    __syncthreads();
    {
      const int tid = lv(tid0), lane = tid & 63, w = tid >> 6;
      const unsigned char* EU = ws + WS_EU; const unsigned char* EV = ws + WS_EV; const float* SCU = (const float*)(ws + WS_ESC); const float* SCV = SCU + 16384;
      const float* gpf2 = launder(p.in[19]);
      typedef float f2v __attribute__((ext_vector_type(2)));
#define FP8X4(wd, o0, o1, o2, o3) do { const f2v lo_ = __builtin_amdgcn_cvt_pk_f32_fp8((int)(wd), false), hi_ = __builtin_amdgcn_cvt_pk_f32_fp8((int)(wd), true); o0 = lo_.x; o1 = lo_.y; o2 = hi_.x; o3 = hi_.y; } while (0)
#pragma unroll 1
      for (int pass = 0; pass < gather_reps; ++pass)
#pragma unroll 1
      for (int rr = 0; rr < 8; ++rr) { const int row = w * 8 + rr; const size_t tok = tok0 + row;
        float hf[16];
        { const uint4 hA = *(const uint4*)(H2 + (size_t)row * 1024 + lane * 16), hB = *(const uint4*)(H2 + (size_t)row * 1024 + lane * 16 + 8);
          hf[0] = __uint_as_float(hA.x << 16); hf[1] = __uint_as_float(hA.x & 0xffff0000u); hf[2] = __uint_as_float(hA.y << 16); hf[3] = __uint_as_float(hA.y & 0xffff0000u);
          hf[4] = __uint_as_float(hA.z << 16); hf[5] = __uint_as_float(hA.z & 0xffff0000u); hf[6] = __uint_as_float(hA.w << 16); hf[7] = __uint_as_float(hA.w & 0xffff0000u);
          hf[8] = __uint_as_float(hB.x << 16); hf[9] = __uint_as_float(hB.x & 0xffff0000u); hf[10] = __uint_as_float(hB.y << 16); hf[11] = __uint_as_float(hB.y & 0xffff0000u);
          hf[12] = __uint_as_float(hB.z << 16); hf[13] = __uint_as_float(hB.z & 0xffff0000u); hf[14] = __uint_as_float(hB.w << 16); hf[15] = __uint_as_float(hB.w & 0xffff0000u); }
        float acc[16];
#pragma unroll
        for (int i = 0; i < 16; ++i) acc[i] = 0.f;
#pragma unroll 1
        for (int g = 0; g < 16; ++g) {
          const int* ep = EIDX + row * 128 + g * 8;
          const int4 ea = *(const int4*)ep, eb = *(const int4*)(ep + 4);
          int es[8];
          es[0] = __builtin_amdgcn_readfirstlane(ea.x); es[1] = __builtin_amdgcn_readfirstlane(ea.y); es[2] = __builtin_amdgcn_readfirstlane(ea.z); es[3] = __builtin_amdgcn_readfirstlane(ea.w);
          es[4] = __builtin_amdgcn_readfirstlane(eb.x); es[5] = __builtin_amdgcn_readfirstlane(eb.y); es[6] = __builtin_amdgcn_readfirstlane(eb.z); es[7] = __builtin_amdgcn_readfirstlane(eb.w);
          uint4 u[8], v[8];
#pragma unroll
          for (int k2 = 0; k2 < 8; ++k2) u[k2] = *(const uint4*)(EU + (size_t)es[k2] * 1024 + lane * 16);
#pragma unroll
          for (int k2 = 0; k2 < 8; ++k2) v[k2] = *(const uint4*)(EV + (size_t)es[k2] * 1024 + lane * 16);
          const int eslot = ep[lane & 7];
          const float gte = GATE[row * 128 + g * 8 + (lane & 7)], su = SCU[eslot], sv = SCV[eslot];
          float P[8];
#pragma unroll
          for (int k2 = 0; k2 < 8; ++k2) { float a0, a1, a2, a3, d;
            FP8X4(u[k2].x, a0, a1, a2, a3); d = a0 * hf[0] + a1 * hf[1] + a2 * hf[2] + a3 * hf[3];
            FP8X4(u[k2].y, a0, a1, a2, a3); d += a0 * hf[4] + a1 * hf[5] + a2 * hf[6] + a3 * hf[7];
            FP8X4(u[k2].z, a0, a1, a2, a3); d += a0 * hf[8] + a1 * hf[9] + a2 * hf[10] + a3 * hf[11];
            FP8X4(u[k2].w, a0, a1, a2, a3); d += a0 * hf[12] + a1 * hf[13] + a2 * hf[14] + a3 * hf[15];
            P[k2] = d; }
          { const bool up4 = (lane & 4) != 0;
#pragma unroll
            for (int e = 0; e < 4; ++e) { const float keep = up4 ? P[e + 4] : P[e], send = up4 ? P[e] : P[e + 4]; P[e] = keep + __shfl_xor(send, 4); }
            const bool up2 = (lane & 2) != 0;
#pragma unroll
            for (int e = 0; e < 2; ++e) { const float keep = up2 ? P[e + 2] : P[e], send = up2 ? P[e] : P[e + 2]; P[e] = keep + dpp_f<0x4E>(send); }
            const bool up1 = (lane & 1) != 0;
            const float keep = up1 ? P[1] : P[0], send = up1 ? P[0] : P[1];
            float av = keep + dpp_f<0xB1>(send);
            av += __shfl_xor(av, 8); av += __shfl_xor(av, 16); av += __shfl_xor(av, 32);
            av *= su;
            const float ax = fabsf(av), t = __builtin_amdgcn_rcpf(ax * 0.2316418882f + 1.0f);
            float q = t * 0.5307027145f + (-0.7265760135f); q = q * t + 0.7107068705f; q = q * t + (-0.142248368f); q = q * t + 0.127414796f; q = q * t;
            const float ee = __builtin_amdgcn_exp2f(av * av * (-0.72134752044f));
            const float mm = av * (q * ee), gl = (av < 0.f) ? mm : (av - mm);
            P[0] = gte * gl * sv; }
#pragma unroll
          for (int k2 = 0; k2 < 8; ++k2) { const float wk = __int_as_float(__builtin_amdgcn_readlane(__float_as_int(P[0]), k2)); float a0, a1, a2, a3;
            FP8X4(v[k2].x, a0, a1, a2, a3); acc[0] += wk * a0; acc[1] += wk * a1; acc[2] += wk * a2; acc[3] += wk * a3;
            FP8X4(v[k2].y, a0, a1, a2, a3); acc[4] += wk * a0; acc[5] += wk * a1; acc[6] += wk * a2; acc[7] += wk * a3;
            FP8X4(v[k2].z, a0, a1, a2, a3); acc[8] += wk * a0; acc[9] += wk * a1; acc[10] += wk * a2; acc[11] += wk * a3;
            FP8X4(v[k2].w, a0, a1, a2, a3); acc[12] += wk * a0; acc[13] += wk * a1; acc[14] += wk * a2; acc[15] += wk * a3; }
        }
        float ss = 0.f;
#pragma unroll
        for (int i = 0; i < 16; ++i) ss += acc[i] * acc[i];
        ss = wave_sum(ss); const float rs = rsqrtf(ss * (1.f / 1024.f) + EPS);
        float* orow = outp + tok * 1024 + lane * 16;
        if (pass == gather_reps - 1)
#pragma unroll
        for (int i = 0; i < 4; ++i) { const int d = lane * 16 + 4 * i;
          float4 x1 = *(const float4*)(orow + 4 * i); const float4 g3 = *(const float4*)(gpf2 + d), g2 = *(const float4*)(modb + 5120 + d);
          x1.x += g3.x * g2.x * acc[4 * i] * rs; x1.y += g3.y * g2.y * acc[4 * i + 1] * rs; x1.z += g3.z * g2.z * acc[4 * i + 2] * rs; x1.w += g3.w * g2.w * acc[4 * i + 3] * rs;
          *(float4*)(orow + 4 * i) = x1; }
      }
#undef FP8X4
    }
  }
}

DI void phase2_scan(const KP& p) {
  unsigned char* ws = p.ws;
  for (int g = blockIdx.x * NTHR + threadIdx.x; g < 131072; g += gridDim.x * NTHR) {
    const int seq = g >> 11, within = g & 2047, dv = within >> 4, dk4 = (within & 15) * 4, dir = seq & 1;
    bf16_t* base = (bf16_t*)(ws + WS_SPT) + ((size_t)seq * 32 * 128 + dv) * 64 + dk4;
    const float* dec = (const float*)(ws + WS_DEC) + (size_t)seq * 32 * 64 + dk4;
    float s0 = 0.f, s1 = 0.f, s2 = 0.f, s3 = 0.f;
#pragma unroll 1
    for (int i0 = 0; i0 < 32; i0 += 8) {
      uint2 d[8]; float4 c[8];
#pragma unroll
      for (int j = 0; j < 8; ++j) { const int n = dir ? 31 - (i0 + j) : (i0 + j); d[j] = *(const uint2*)(base + (size_t)n * 8192); c[j] = *(const float4*)(dec + n * 64); }
#pragma unroll
      for (int j = 0; j < 8; ++j) { const int n = dir ? 31 - (i0 + j) : (i0 + j);
        uint2 o; o.x = pack2(s0, s1); o.y = pack2(s2, s3); *(uint2*)(base + (size_t)n * 8192) = o;
        s0 = c[j].x * s0 + __uint_as_float(d[j].x << 16); s1 = c[j].y * s1 + __uint_as_float(d[j].x & 0xffff0000u);
        s2 = c[j].z * s2 + __uint_as_float(d[j].y << 16); s3 = c[j].w * s3 + __uint_as_float(d[j].y & 0xffff0000u); }
    }
  }
}

#define XB_TMO      128
#define XB_XCNT(j)  (256  + 64 * (j))
#define XB_XSUB(j)  (1280 + 64 * (j))
#define XB_XGEN(j)  (2304 + 64 * (j))
#define XB_TOP      3328
#define XB_TOPGEN   3392
#define XCD_BAR_WORDS 3456
#define XB_SPIN_CAP (1u << 18)
#define LAS __attribute__((address_space(3)))

__device__ __forceinline__ unsigned xb_ld(unsigned* p)              { return __hip_atomic_load(p, __ATOMIC_RELAXED, __HIP_MEMORY_SCOPE_AGENT); }
__device__ __forceinline__ unsigned xb_add(unsigned* p, unsigned v) { return __hip_atomic_fetch_add(p, v, __ATOMIC_RELAXED, __HIP_MEMORY_SCOPE_AGENT); }
__device__ __forceinline__ unsigned xb_xcc_id() { return (unsigned)__builtin_amdgcn_s_getreg((3 << 11) | 20) & 0xFu; }
#define XB_SPIN(cond, bar) do { unsigned _sp = 0; while (cond) { __builtin_amdgcn_s_sleep(1); \
    if ((++_sp & 255u) == 0u) { if (xb_ld(&(bar)[XB_TMO])) break; if (_sp > XB_SPIN_CAP) { atomicAdd(&(bar)[XB_TMO], 1u); break; } } } } while (0)

struct XcdBarrier {
    unsigned* bar; unsigned x;
    volatile LAS unsigned* st;
};

__device__ __forceinline__ XcdBarrier xcd_barrier_post(unsigned* bar, volatile LAS unsigned* st) {
    XcdBarrier b; b.bar = bar; b.x = xb_xcc_id(); b.st = st;
    if (threadIdx.x == 0) (void)xb_add(&bar[XB_XCNT(b.x)], 1u);
    return b;
}
__device__ __forceinline__ void xcd_barrier_complete(unsigned* bar, unsigned x, unsigned& nloc, unsigned& nx) {
    const unsigned G = gridDim.x * gridDim.y * gridDim.z;
    unsigned sum, cnt, mine, sp = 0u;
    for (;;) {
        sum = 0u; cnt = 0u; mine = 0u;
#pragma unroll
        for (unsigned j = 0; j < 16; ++j) { const unsigned c = xb_ld(&bar[XB_XCNT(j)]); sum += c; cnt += (c > 0u) ? 1u : 0u; mine = (j == x) ? c : mine; }
        if (sum == G) break;
        __builtin_amdgcn_s_sleep(1);
        if ((++sp & 255u) == 0u) { if (xb_ld(&bar[XB_TMO])) break; if (sp > XB_SPIN_CAP) { atomicAdd(&bar[XB_TMO], 1u); break; } }
    }
    nloc = mine > 0u ? mine : 1u; nx = cnt > 0u ? cnt : 1u;
}

__device__ __forceinline__ void xcd_barrier(const XcdBarrier& b) {
    asm volatile("s_waitcnt vmcnt(0)" ::: "memory");
    __syncthreads();
    if (threadIdx.x == 0) {
        unsigned* bar = b.bar;
        __builtin_amdgcn_s_waitcnt(0);
        unsigned nloc = b.st[0], nx = b.st[1];
        if (nloc == 0u) { xcd_barrier_complete(bar, b.x, nloc, nx); b.st[0] = nloc; b.st[1] = nx; }
        const unsigned old = xb_add(&bar[XB_XSUB(b.x)], 1u);
        const unsigned gen = old / nloc;
        if (old + 1u == (gen + 1u) * nloc) {
            __builtin_amdgcn_fence(__ATOMIC_RELEASE, "agent");
            asm volatile("s_waitcnt vmcnt(0)" ::: "memory");
            const unsigned og = xb_add(&bar[XB_TOP], 1u);
            const unsigned tg = og / nx;
            if (og + 1u == (tg + 1u) * nx) xb_add(&bar[XB_TOPGEN], 1u);
            else XB_SPIN(xb_ld(&bar[XB_TOPGEN]) == tg, bar);
            __builtin_amdgcn_fence(__ATOMIC_ACQUIRE, "agent");
            xb_add(&bar[XB_XGEN(b.x)], 1u);
            asm volatile("s_waitcnt vmcnt(0)" ::: "memory");
        } else {
            XB_SPIN(xb_ld(&bar[XB_XGEN(b.x)]) == gen, bar);
            __builtin_amdgcn_fence(__ATOMIC_ACQUIRE, "agent");
            asm volatile("s_waitcnt vmcnt(0)" ::: "memory");
        }
    }
    __syncthreads();
}

#ifndef PROBE_ID
#define PROBE_ID 0
#endif
__global__ void __launch_bounds__(NTHR, 2) mega(KP p) {
  extern __shared__ __attribute__((aligned(16))) char lds[];
  cg::grid_group grid = cg::this_grid();
  const int hi = p.ph_hi; constexpr int probe = PROBE_ID;
  if (threadIdx.x == 0) { ((volatile LAS unsigned*)(lds + LDS_XB))[0] = 0u; ((volatile LAS unsigned*)(lds + LDS_XB))[1] = 0u; }
  __syncthreads();
  const XcdBarrier xb = xcd_barrier_post((unsigned*)(p.ws + WS_BAR), (volatile LAS unsigned*)(lds + LDS_XB));
  if (p.ph_lo <= 0 && 0 < hi) { phase0(p, lds); if (probe == 1) phase0(p, lds); if (1 < hi) { if (hi > 64) grid.sync(); else xcd_barrier(xb); } }
  if (p.ph_lo <= 1 && 1 < hi) { phase1(p, lds); if (probe == 2) phase1(p, lds); if (2 < hi) xcd_barrier(xb); }
  if (p.ph_lo <= 2 && 2 < hi) { phase2_scan(p); phase2_attn(p, lds); if (probe == 3) phase2_attn(p, lds); if (3 < hi) xcd_barrier(xb); }
  if (p.ph_lo <= 3 && 3 < hi) { phase3(p, lds, probe == 4 ? 2 : 1, probe); }
}

extern "C" void kernel_launch(void* const* d_in, const int* in_sizes, int n_in, void* d_out, int out_size, void* d_ws, size_t ws_size, hipStream_t stream) {
  float* out = (float*)d_out;
  unsigned char* ws = (unsigned char*)d_ws;
  if (ws_size < WS_END || n_in != 25) return;
  static bool attr_done = false;
  if (!attr_done) { (void)hipFuncSetAttribute((const void*)mega, hipFuncAttributeMaxDynamicSharedMemorySize, LDS_TOTAL); attr_done = true; }
  KP p{};
  for (int i = 0; i < 25; ++i) p.in[i] = (const float*)d_in[i];
  p.out = out; p.ws = ws;
  p.ph_lo = 0; p.ph_hi = 4;
  (void)hipMemsetAsync(ws + WS_BAR, 0, XCD_BAR_WORDS * 4, stream);
  { void* args[] = {&p}; (void)hipLaunchCooperativeKernel((const void*)mega, dim3(256), dim3(NTHR), args, LDS_TOTAL, stream); }
}
```

```cpp
#include <hip/hip_runtime.h>
#include <hip/hip_cooperative_groups.h>
namespace cg = cooperative_groups;
#include <stdint.h>

typedef unsigned short bf16_t;
#define DI __device__ __forceinline__

DI float bf2f(bf16_t v) { return __uint_as_float(((unsigned)v) << 16); }
DI bf16_t f2bf(float f) { return __builtin_bit_cast(unsigned short, (__bf16)f); }

constexpr int BATCH = 8, SEQ = 2048, DM = 1024, NTOK = BATCH * SEQ;
constexpr int INW = 2272;
constexpr float EPS = 1e-6f;
constexpr int O_CQ = 0, O_CKV = 384, O_KR = 640, O_QG = 704, O_KG = 960, O_VG = 1216, O_GF = 1728, O_GB = 1744, O_R = 1760;

DI float wave_sum(float v) {
#pragma unroll
  for (int o = 1; o < 64; o <<= 1) v += __shfl_xor(v, o);
  return v;
}
DI float wave_max(float v) {
#pragma unroll
  for (int o = 1; o < 64; o <<= 1) v = fmaxf(v, __shfl_xor(v, o));
  return v;
}
DI float block_sum256(float v, float* red) {
  v = wave_sum(v);
  __syncthreads();
  if ((threadIdx.x & 63) == 0) red[threadIdx.x >> 6] = v;
  __syncthreads();
  return red[0] + red[1] + red[2] + red[3];
}
DI float block_max256(float v, float* red) {
  v = wave_max(v);
  __syncthreads();
  if ((threadIdx.x & 63) == 0) red[threadIdx.x >> 6] = v;
  __syncthreads();
  return fmaxf(fmaxf(red[0], red[1]), fmaxf(red[2], red[3]));
}
DI float silu_f(float x) { return x / (1.f + expf(-x)); }
DI float logsigmoid_f(float x) { return fminf(x, 0.f) - log1pf(expf(-fabsf(x))); }
DI float fexp(float x) { return __builtin_amdgcn_exp2f(x * 1.4426950408889634f); }
DI float silu_fast(float x) { return x * __builtin_amdgcn_rcpf(1.f + fexp(-x)); }
DI float logsigmoid_fast(float x) { return fminf(x, 0.f) - __builtin_amdgcn_logf(1.f + fexp(-fabsf(x))) * 0.6931471805599453f; }
DI float gelu_erf(float x) { return 0.5f * x * (1.f + erff(x * 0.70710678118654752f)); }

__global__ __launch_bounds__(256) void n_mod(const float* __restrict__ c, const float* __restrict__ w_ada, const float* __restrict__ b_ada, float* __restrict__ mod) {
  int idx = blockIdx.x * 256 + threadIdx.x;
  int b = idx / 6144, j = idx % 6144;
  float acc = b_ada[j];
  for (int k = 0; k < 1024; ++k) acc += silu_f(c[b * 1024 + k]) * w_ada[(size_t)k * 6144 + j];
  mod[idx] = acc;
}

__global__ __launch_bounds__(256) void n_hnorm(const float* __restrict__ x, const float* __restrict__ g, const float* __restrict__ mod, int b, int off_sh, int off_sc, float* __restrict__ h) {
  __shared__ float red[4];
  int t = blockIdx.x, tid = threadIdx.x;
  const float* xr = x + ((size_t)b * SEQ + t) * DM;
  float v[4]; float ss = 0.f;
#pragma unroll
  for (int i = 0; i < 4; ++i) { v[i] = xr[tid + 256 * i]; ss += v[i] * v[i]; }
  ss = block_sum256(ss, red);
  float rs = rsqrtf(ss * (1.f / DM) + EPS);
#pragma unroll
  for (int i = 0; i < 4; ++i) { int d = tid + 256 * i; h[(size_t)t * DM + d] = v[i] * rs * g[d] * (1.f + mod[b * 6144 + off_sc + d]) + mod[b * 6144 + off_sh + d]; }
}

template <bool BT>
__global__ __launch_bounds__(256) void n_gemm(const float* __restrict__ A, int lda, const float* __restrict__ B, int ldb, float* __restrict__ C, int ldc, int M, int N, int K) {
  __shared__ float As[16][65];
  __shared__ float Bs[16][65];
  const int tid = threadIdx.x, tx = tid & 15, ty = tid >> 4;
  const int m0 = blockIdx.y * 64, n0 = blockIdx.x * 64;
  float acc[4][4];
#pragma unroll
  for (int i = 0; i < 4; ++i)
#pragma unroll
    for (int j = 0; j < 4; ++j) acc[i][j] = 0.f;
  for (int k0 = 0; k0 < K; k0 += 16) {
#pragma unroll
    for (int i = 0; i < 4; ++i) { int e = tid + 256 * i; int m = e >> 4, k = e & 15; As[k][m] = A[(size_t)(m0 + m) * lda + k0 + k]; }
#pragma unroll
    for (int i = 0; i < 4; ++i) { int e = tid + 256 * i;
      if (!BT) { int k = e >> 6, n = e & 63; Bs[k][n] = (n0 + n < N) ? B[(size_t)(k0 + k) * ldb + n0 + n] : 0.f; }
      else     { int n = e >> 4, k = e & 15; Bs[k][n] = (n0 + n < N) ? B[(size_t)(n0 + n) * ldb + k0 + k] : 0.f; } }
    __syncthreads();
#pragma unroll
    for (int k = 0; k < 16; ++k) {
      float a[4], bb[4];
#pragma unroll
      for (int i = 0; i < 4; ++i) { a[i] = As[k][ty * 4 + i]; bb[i] = Bs[k][tx * 4 + i]; }
#pragma unroll
      for (int i = 0; i < 4; ++i)
#pragma unroll
        for (int j = 0; j < 4; ++j) acc[i][j] += a[i] * bb[j];
    }
    __syncthreads();
  }
#pragma unroll
  for (int i = 0; i < 4; ++i)
#pragma unroll
    for (int j = 0; j < 4; ++j) { int n = n0 + tx * 4 + j; if (n < N) C[(size_t)(m0 + ty * 4 + i) * ldc + n] = acc[i][j]; }
}

__global__ __launch_bounds__(256) void n_rms_slice(const float* __restrict__ in, int ldin, int off, int W, const float* __restrict__ g, float* __restrict__ out) {
  __shared__ float red[4];
  int t = blockIdx.x, tid = threadIdx.x;
  float v0 = (tid < W) ? in[(size_t)t * ldin + off + tid] : 0.f;
  float v1 = (tid + 256 < W) ? in[(size_t)t * ldin + off + tid + 256] : 0.f;
  float ss = block_sum256(v0 * v0 + v1 * v1, red);
  float rs = rsqrtf(ss / (float)W + EPS);
  if (tid < W) out[(size_t)t * W + tid] = v0 * rs * g[tid];
  if (tid + 256 < W) out[(size_t)t * W + tid + 256] = v1 * rs * g[tid + 256];
}

__global__ __launch_bounds__(256) void n_scatter(const float* __restrict__ proj, const float* __restrict__ qa, const float* __restrict__ kv, const int* __restrict__ positions, int b,
                                                 const float* __restrict__ wgf, const float* __restrict__ bgf, const float* __restrict__ wgb, const float* __restrict__ bgb,
                                                 bf16_t* __restrict__ Qm, bf16_t* __restrict__ Km, bf16_t* __restrict__ Vm, bf16_t* __restrict__ qg, bf16_t* __restrict__ kg, bf16_t* __restrict__ vg,
                                                 bf16_t* __restrict__ rg, float* __restrict__ laf, float* __restrict__ lab) {
  __shared__ float cs[32], sn[32];
  const int t = blockIdx.x, tid = threadIdx.x;
  const size_t tok = (size_t)b * SEQ + t;
  const float* pr = proj + (size_t)t * INW;
  const float* qr = qa + (size_t)t * 768;
  const float* kr = kv + (size_t)t * 1024;
  if (tid < 32) {
    float inv = powf(10000.f, -(float)tid / 32.f);
    float ang = (float)positions[tok] * inv;
    cs[tid] = cosf(ang); sn[tid] = sinf(ang);
  }
  __syncthreads();
  for (int e = tid; e < 4 * 192; e += 256) {
    int h = e / 192, d = e % 192; float v;
    if (d < 128) v = qr[h * 192 + d];
    else { int j = d - 128; const float* rp = qr + h * 192 + 128;
      if (j < 32) v = rp[j] * cs[j] - rp[j + 32] * sn[j]; else v = rp[j] * cs[j - 32] + rp[j - 32] * sn[j - 32]; }
    Qm[(((size_t)b * 4 + h) * SEQ + t) * 192 + d] = f2bf(v);
  }
  for (int e = tid; e < 4 * 192; e += 256) {
    int h = e / 192, d = e % 192; float v;
    if (d < 128) v = kr[h * 256 + d];
    else { int j = d - 128; const float* rp = pr + O_KR;
      if (j < 32) v = rp[j] * cs[j] - rp[j + 32] * sn[j]; else v = rp[j] * cs[j - 32] + rp[j - 32] * sn[j - 32]; }
    Km[(((size_t)b * 4 + h) * SEQ + t) * 192 + d] = f2bf(v);
  }
  for (int e = tid; e < 512; e += 256) { int h = e >> 7, d = e & 127; Vm[(((size_t)b * 4 + h) * SEQ + t) * 128 + d] = f2bf(kr[h * 256 + 128 + d]); }
  { int e = tid; qg[tok * 256 + e] = f2bf(pr[O_QG + e] * 0.125f); kg[tok * 256 + e] = f2bf(pr[O_KG + e]); }
  for (int e = tid; e < 512; e += 256) { vg[tok * 512 + e] = f2bf(pr[O_VG + e]); rg[tok * 512 + e] = f2bf(pr[O_R + e]); }
  { int cidx = tid; float af = bgf[cidx], ab = bgb[cidx];
#pragma unroll
    for (int r = 0; r < 16; ++r) { af += pr[O_GF + r] * wgf[r * 256 + cidx]; ab += pr[O_GB + r] * wgb[r * 256 + cidx]; }
    laf[tok * 256 + cidx] = logsigmoid_f(af) * (1.f / 16.f); lab[tok * 256 + cidx] = logsigmoid_f(ab) * (1.f / 16.f); }
}

__global__ __launch_bounds__(256) void n_attn(const bf16_t* __restrict__ Qm, const bf16_t* __restrict__ Km, const bf16_t* __restrict__ Vm, bf16_t* __restrict__ omla) {
  __shared__ float qs[192]; __shared__ float sc[2048]; __shared__ float red[4];
  const int i = blockIdx.x, h = blockIdx.y, b = blockIdx.z, tid = threadIdx.x;
  const size_t bh = (size_t)b * 4 + h;
  if (tid < 192) qs[tid] = bf2f(Qm[(bh * SEQ + i) * 192 + tid]);
  __syncthreads();
  float mx = -1e30f;
  for (int kk = 0; kk < 8; ++kk) {
    int key = tid + 256 * kk; const uint4* kr = (const uint4*)(Km + (bh * SEQ + key) * 192);
    float s = 0.f;
    for (int c = 0; c < 24; ++c) { uint4 w = kr[c]; const float* q = qs + c * 8;
      s += q[0] * __uint_as_float(w.x << 16) + q[1] * __uint_as_float(w.x & 0xffff0000u) + q[2] * __uint_as_float(w.y << 16) + q[3] * __uint_as_float(w.y & 0xffff0000u)
         + q[4] * __uint_as_float(w.z << 16) + q[5] * __uint_as_float(w.z & 0xffff0000u) + q[6] * __uint_as_float(w.w << 16) + q[7] * __uint_as_float(w.w & 0xffff0000u); }
    s *= 0.07216878364870322f; sc[key] = s; mx = fmaxf(mx, s);
  }
  mx = block_max256(mx, red);
  float sum = 0.f;
  for (int kk = 0; kk < 8; ++kk) { int key = tid + 256 * kk; float p = expf(sc[key] - mx); sc[key] = p; sum += p; }
  sum = block_sum256(sum, red);
  __syncthreads();
  if (tid < 128) { float o = 0.f; const bf16_t* vp = Vm + bh * SEQ * 128 + tid;
    for (int key = 0; key < SEQ; ++key) o += sc[key] * bf2f(vp[(size_t)key * 128]);
    omla[((size_t)b * SEQ + i) * 512 + h * 128 + tid] = f2bf(o / sum); }
}

__global__ __launch_bounds__(128) void n_gla(const bf16_t* __restrict__ qg, const bf16_t* __restrict__ kg, const bf16_t* __restrict__ vg, const bf16_t* __restrict__ laf, const bf16_t* __restrict__ lab, float* __restrict__ og) {
  __shared__ float qs[64], ks[64], as[64];
  const int bh = blockIdx.x, b = bh >> 2, h = bh & 3, dv = threadIdx.x;
  for (int dir = 0; dir < 2; ++dir) {
    float S[64];
#pragma unroll
    for (int d = 0; d < 64; ++d) S[d] = 0.f;
    const bf16_t* la = dir ? lab : laf;
    for (int s = 0; s < SEQ; ++s) {
      const int t = dir ? (SEQ - 1 - s) : s; const size_t tok = (size_t)b * SEQ + t;
      __syncthreads();
      if (dv < 64) { qs[dv] = bf2f(qg[tok * 256 + h * 64 + dv]); ks[dv] = bf2f(kg[tok * 256 + h * 64 + dv]); as[dv] = expf(bf2f(la[tok * 256 + h * 64 + dv])); }
      __syncthreads();
      const float v = bf2f(vg[tok * 512 + h * 128 + dv]); float o = 0.f;
#pragma unroll
      for (int d = 0; d < 64; ++d) { S[d] = as[d] * S[d] + ks[d] * v; o += qs[d] * S[d]; }
      if (dir == 0) og[tok * 512 + h * 128 + dv] = o; else og[tok * 512 + h * 128 + dv] += o;
    }
  }
}

__global__ __launch_bounds__(256) void n_mix(const bf16_t* __restrict__ omla, const float* __restrict__ og, const bf16_t* __restrict__ rg, const float* __restrict__ g_gla, int b, float* __restrict__ mix) {
  __shared__ float ssum[4];
  const int t = blockIdx.x, tid = threadIdx.x; const size_t tok = (size_t)b * SEQ + t;
  if (tid < 4) ssum[tid] = 0.f;
  __syncthreads();
  float v[2];
#pragma unroll
  for (int i = 0; i < 2; ++i) { int e = tid + 256 * i; v[i] = og[tok * 512 + e]; atomicAdd(&ssum[e >> 7], v[i] * v[i]); mix[(size_t)t * DM + e] = bf2f(omla[tok * 512 + e]); }
  __syncthreads();
#pragma unroll
  for (int i = 0; i < 2; ++i) { int e = tid + 256 * i; float rs = rsqrtf(ssum[e >> 7] * (1.f / 128.f) + EPS);
    mix[(size_t)t * DM + 512 + e] = v[i] * rs * g_gla[e & 127] * silu_f(bf2f(rg[tok * 512 + e])); }
}

__global__ __launch_bounds__(256) void n_post1(const float* __restrict__ x, const float* __restrict__ y, const float* __restrict__ g_post, const float* __restrict__ g_pre2, const float* __restrict__ mod, int b,
                                               float* __restrict__ out, float* __restrict__ h2) {
  __shared__ float red[4];
  const int t = blockIdx.x, tid = threadIdx.x; const size_t tok = (size_t)b * SEQ + t;
  float yv[4], xv[4]; float ss = 0.f;
#pragma unroll
  for (int i = 0; i < 4; ++i) { yv[i] = y[(size_t)t * DM + tid + 256 * i]; ss += yv[i] * yv[i]; }
  ss = block_sum256(ss, red);
  float rs = rsqrtf(ss * (1.f / DM) + EPS); float s2 = 0.f;
#pragma unroll
  for (int i = 0; i < 4; ++i) { int d = tid + 256 * i; xv[i] = x[tok * DM + d] + mod[b * 6144 + 2048 + d] * (yv[i] * rs * g_post[d]); out[tok * DM + d] = xv[i]; s2 += xv[i] * xv[i]; }
  s2 = block_sum256(s2, red);
  float r2 = rsqrtf(s2 * (1.f / DM) + EPS);
#pragma unroll
  for (int i = 0; i < 4; ++i) { int d = tid + 256 * i; h2[(size_t)t * DM + d] = xv[i] * r2 * g_pre2[d] * (1.f + mod[b * 6144 + 4096 + d]) + mod[b * 6144 + 3072 + d]; }
}

DI void wave_argmax(float& v, int& i) {
#pragma unroll
  for (int o = 1; o < 64; o <<= 1) { float ov = __shfl_xor(v, o); int oi = __shfl_xor(i, o); if (ov > v || (ov == v && oi < i)) { v = ov; i = oi; } }
}
__global__ __launch_bounds__(256) void n_peer_select(const float* __restrict__ qry, const float* __restrict__ sk1, const float* __restrict__ sk2, int* __restrict__ eidx, float* __restrict__ gate) {
  __shared__ float v1s[4][16], v2s[4][16]; __shared__ int i1s[4][16], i2s[4][16];
  const int w = threadIdx.x >> 6, lane = threadIdx.x & 63;
  const int pair = blockIdx.x * 4 + w;
  const int t = pair >> 3, h = pair & 7;
  const float* q1 = qry + (size_t)t * 2048 + h * 256; const float* q2 = q1 + 128;
  float s1a = 0.f, s1b = 0.f, s2a = 0.f, s2b = 0.f;
  for (int d = 0; d < 128; ++d) { float a = q1[d], bq = q2[d];
    s1a += a * sk1[lane * 128 + d]; s1b += a * sk1[(lane + 64) * 128 + d]; s2a += bq * sk2[lane * 128 + d]; s2b += bq * sk2[(lane + 64) * 128 + d]; }
  for (int side = 0; side < 2; ++side) {
    float va = side ? s2a : s1a, vb = side ? s2b : s1b; bool ta = false, tb = false;
    for (int k = 0; k < 16; ++k) {
      float bv; int bi;
      if (!ta && (tb || va >= vb)) { bv = va; bi = lane; } else if (!tb) { bv = vb; bi = lane + 64; } else { bv = -3e38f; bi = 1 << 20; }
      wave_argmax(bv, bi);
      if (bi == lane) ta = true; if (bi == lane + 64) tb = true;
      if (lane == 0) { if (side) { v2s[w][k] = bv; i2s[w][k] = bi; } else { v1s[w][k] = bv; i1s[w][k] = bi; } }
    }
  }
  __syncthreads();
  float cv[4]; bool tk[4];
#pragma unroll
  for (int j = 0; j < 4; ++j) { int c = lane + 64 * j; cv[j] = v1s[w][c >> 4] + v2s[w][c & 15]; tk[j] = false; }
  float topv = 0.f; int topc = 0; float mx = 0.f;
  for (int k = 0; k < 16; ++k) {
    float bv = -3e38f; int bi = 1 << 20;
#pragma unroll
    for (int j = 0; j < 4; ++j) { if (!tk[j] && cv[j] > bv) { bv = cv[j]; bi = lane + 64 * j; } }
    wave_argmax(bv, bi);
#pragma unroll
    for (int j = 0; j < 4; ++j) if (bi == lane + 64 * j) tk[j] = true;
    if (k == 0) mx = bv;
    if (lane == k) { topv = bv; topc = bi; }
  }
  float e = (lane < 16) ? expf(topv - mx) : 0.f;
  float sum = wave_sum(e);
  if (lane < 16) { eidx[(size_t)pair * 16 + lane] = i1s[w][topc >> 4] * 128 + i2s[w][topc & 15]; gate[(size_t)pair * 16 + lane] = e / sum; }
}

__global__ __launch_bounds__(256) void n_peer_apply(const float* __restrict__ h2, const int* __restrict__ eidx, const float* __restrict__ gate, const float* __restrict__ eu, const float* __restrict__ ev,
                                                    const float* __restrict__ g_post, const float* __restrict__ mod, int b, float* __restrict__ out) {
  __shared__ float ys[4][1024]; __shared__ float red[4];
  const int t = blockIdx.x, tid = threadIdx.x, w = tid >> 6, lane = tid & 63; const size_t tok = (size_t)b * SEQ + t;
  float4 hx[4];
#pragma unroll
  for (int i = 0; i < 4; ++i) hx[i] = *(const float4*)(h2 + (size_t)t * DM + (lane + 64 * i) * 4);
  float4 acc[4];
#pragma unroll
  for (int i = 0; i < 4; ++i) acc[i] = make_float4(0.f, 0.f, 0.f, 0.f);
  for (int k = w; k < 128; k += 4) {
    const int e = eidx[(size_t)t * 128 + k]; const float gt = gate[(size_t)t * 128 + k];
    const float4* ur = (const float4*)(eu + (size_t)e * DM); const float4* vr = (const float4*)(ev + (size_t)e * DM);
    float d = 0.f;
#pragma unroll
    for (int i = 0; i < 4; ++i) { float4 u = ur[lane + 64 * i]; d += u.x * hx[i].x + u.y * hx[i].y + u.z * hx[i].z + u.w * hx[i].w; }
    d = wave_sum(d);
    const float wgt = gt * gelu_erf(d);
#pragma unroll
    for (int i = 0; i < 4; ++i) { float4 v = vr[lane + 64 * i]; acc[i].x += wgt * v.x; acc[i].y += wgt * v.y; acc[i].z += wgt * v.z; acc[i].w += wgt * v.w; }
  }
#pragma unroll
  for (int i = 0; i < 4; ++i) *(float4*)(&ys[w][(lane + 64 * i) * 4]) = acc[i];
  __syncthreads();
  float yv[4]; float ss = 0.f;
#pragma unroll
  for (int i = 0; i < 4; ++i) { int d = tid + 256 * i; yv[i] = ys[0][d] + ys[1][d] + ys[2][d] + ys[3][d]; ss += yv[i] * yv[i]; }
  ss = block_sum256(ss, red);
  const float rs = rsqrtf(ss * (1.f / DM) + EPS);
#pragma unroll
  for (int i = 0; i < 4; ++i) { int d = tid + 256 * i; out[tok * DM + d] = out[tok * DM + d] + mod[b * 6144 + 5120 + d] * (yv[i] * rs * g_post[d]); }
}

typedef short bf16x8 __attribute__((ext_vector_type(8)));
typedef float f32x16 __attribute__((ext_vector_type(16)));
#define MFMA32(a, b, c) __builtin_amdgcn_mfma_f32_32x32x16_bf16((a), (b), (c), 0, 0, 0)

constexpr int NTHR = 512;
constexpr size_t MiB = 1024 * 1024;
constexpr size_t WS_MOD   = 0;
constexpr size_t WS_WTIN  = 256 * 1024;
constexpr size_t WS_WTQUP = WS_WTIN + (size_t)2304 * 1024 * 2;
constexpr size_t WS_WTKVUP = WS_WTQUP + (size_t)768 * 384 * 2;
constexpr size_t WS_WTOUT = WS_WTKVUP + (size_t)1024 * 256 * 2;
constexpr size_t WS_WTPQ  = WS_WTOUT + (size_t)1024 * 1024 * 2;
constexpr size_t WS_KD    = WS_WTPQ + (size_t)2048 * 1024 * 2;
constexpr size_t WS_DEC   = WS_KD + (size_t)256 * 256 * 2;
constexpr size_t WS_ESC   = WS_DEC + (size_t)2048 * 64 * 4;
constexpr size_t WS_R0END = WS_ESC + (size_t)2 * 16384 * 4;
static_assert(WS_R0END <= 13 * MiB, "R0");
constexpr size_t WS_BAR  = 13 * MiB - 65536;
static_assert(WS_R0END + 131072 <= WS_BAR, "R0 room");
constexpr size_t WS_QM   = 13 * MiB;
constexpr size_t WS_KM   = WS_QM + 24 * MiB;
constexpr size_t WS_VM   = WS_KM + 24 * MiB;
constexpr size_t WS_P1S  = WS_VM + 16 * MiB;
constexpr size_t WS_RG   = WS_P1S + 32 * MiB;
constexpr size_t WS_OINTRA = WS_RG + 16 * MiB;
constexpr size_t WS_QDEC = WS_OINTRA + 16 * MiB;
constexpr size_t WS_SPT  = WS_QDEC + 16 * MiB;
constexpr size_t WS_EU   = WS_SPT + 32 * MiB;
constexpr size_t WS_EV   = WS_EU + 16 * MiB;
constexpr size_t WS_END  = WS_EV + 16 * MiB;
static_assert(WS_P1S == WS_QM + 64 * MiB, "P3 QRY scratch aliases QM..VM");
constexpr size_t OUT_HS  = 0;
constexpr size_t OUT_CQ  = 32 * MiB;
constexpr size_t OUT_GR  = 52 * MiB;

struct KP { const float* in[25]; float* out; unsigned char* ws; int ph_lo, ph_hi; };

constexpr int G_STG = 40960;
constexpr int LDS_WT = 3 * G_STG;
constexpr int LDS_TAB = LDS_WT + 18432;
constexpr int LDS_XB = 157696;
constexpr int LDS_TOTAL = 157696 + 16;

typedef float f32x2_t __attribute__((ext_vector_type(2)));
typedef __bf16 bf16x2_t __attribute__((ext_vector_type(2)));
DI unsigned pack2(float lo, float hi) { const f32x2_t v = {lo, hi}; return __builtin_bit_cast(unsigned, __builtin_convertvector(v, bf16x2_t)); }
DI int crow(int reg, int hh) { return (reg & 3) + 8 * (reg >> 2) + 4 * hh; }

#define GLDS16(gp, lp) __builtin_amdgcn_global_load_lds((const unsigned*)(gp), (__attribute__((address_space(3))) unsigned*)(lp), 16, 0, 0)
template <int NST, class Epi>
DI void block_gemm(char* lds, const bf16_t* A, int lda, const bf16_t* Bt, int nchunks, int K, Epi&& epi) {
  const int tid = threadIdx.x, lane = tid & 63, w = __builtin_amdgcn_readfirstlane(tid >> 6), r = lane & 31, hh = lane >> 5;
  const int nk = K >> 6, T = nchunks * nk;
  constexpr int D = NST - 1;
  if (w >= 4) {
    const int j = w - 4, rin = lane >> 3, sw = ((lane & 7) ^ rin) * 8;
    const bf16_t* Ap = A + (size_t)(16 * j + rin) * lda + sw;
    const bf16_t* Bp = Bt + (size_t)(64 * j + rin) * 64 + sw;
    auto dma = [&](int g) {
      const int ch = g / nk, t = g - ch * nk; char* st = lds + (g % NST) * G_STG;
      const bf16_t* a0 = Ap + t * 64; char* la = st + (2 * j) * 1024;
      GLDS16(a0, la); GLDS16(a0 + (size_t)8 * lda, la + 1024);
      const bf16_t* b0 = Bp + (size_t)g * 16384; char* lb = st + 8192 + (8 * j) * 1024;
#pragma unroll
      for (int i = 0; i < 8; ++i) GLDS16(b0 + i * 512, lb + i * 1024);
    };
#pragma unroll
    for (int g = 0; g < D; ++g) if (g < T) dma(g);
    if (D >= 2 && T >= 2) asm volatile("s_waitcnt vmcnt(10)" ::: "memory"); else asm volatile("s_waitcnt vmcnt(0)" ::: "memory");
    __builtin_amdgcn_s_barrier();
#pragma unroll 1
    for (int g = 0; g < T; ++g) {
      if (g + D < T) { dma(g + D); if (D >= 2) asm volatile("s_waitcnt vmcnt(10)" ::: "memory"); else asm volatile("s_waitcnt vmcnt(0)" ::: "memory"); }
      else asm volatile("s_waitcnt vmcnt(0)" ::: "memory");
      __builtin_amdgcn_s_barrier();
    }
  } else {
    const int x = r & 7;
    const int o0 = ((0 + hh) ^ x) * 16, o1 = ((2 + hh) ^ x) * 16, o2 = ((4 + hh) ^ x) * 16, o3 = ((6 + hh) ^ x) * 16;
    const int a_rd = r * 128, b_rd = 8192 + (w * 64 + r) * 128;
    __builtin_amdgcn_s_barrier();
    int g = 0;
#pragma unroll 1
    for (int ch = 0; ch < nchunks; ++ch) {
      f32x16 c00, c01, c10, c11;
#pragma unroll
      for (int i = 0; i < 16; ++i) { c00[i] = 0.f; c01[i] = 0.f; c10[i] = 0.f; c11[i] = 0.f; }
#pragma unroll 1
      for (int t = 0; t < nk; ++t, ++g) {
        const char* cur = lds + (g % NST) * G_STG;
        bf16x8 fa0[4], fa1[4], fb0[4], fb1[4];
#define FRD(s_, o_) do { fa0[s_] = *(const bf16x8*)(cur + a_rd + o_); fb0[s_] = *(const bf16x8*)(cur + b_rd + o_); fb1[s_] = *(const bf16x8*)(cur + b_rd + 4096 + o_); fa1[s_] = *(const bf16x8*)(cur + a_rd + 4096 + o_); } while (0)
        FRD(0, o0); FRD(1, o1); FRD(2, o2); FRD(3, o3);
#undef FRD
        asm volatile("s_waitcnt lgkmcnt(0)" ::: "memory");
        __builtin_amdgcn_s_barrier();
        __builtin_amdgcn_sched_barrier(0);
#pragma unroll
        for (int s = 0; s < 4; ++s) {
          c00 = MFMA32(fa0[s], fb0[s], c00); c01 = MFMA32(fa0[s], fb1[s], c01); c10 = MFMA32(fa1[s], fb0[s], c10); c11 = MFMA32(fa1[s], fb1[s], c11); }
      }
      epi(0, ch * 256 + w * 64, c00, c01);
      epi(32, ch * 256 + w * 64, c10, c11);
    }
  }
}

DI void p0_transpose(char* lds, const float* __restrict__ W, int K, int N, bf16_t* __restrict__ Wt, int item) {
  float* s = (float*)lds;
  const int tid = threadIdx.x;
  const int ntn = (N + 63) >> 6, kt = item / ntn, nt = item % ntn, k0 = kt * 64, n0 = nt * 64;
  __syncthreads();
#pragma unroll
  for (int i = 0; i < 8; ++i) { int e = tid + 512 * i; int kk = e >> 6, nn = e & 63; s[kk * 65 + nn] = (n0 + nn < N) ? W[(size_t)(k0 + kk) * N + n0 + nn] : 0.f; }
  __syncthreads();
  const int nn = tid >> 3, part = tid & 7;
  const float* sp = s + (part * 8) * 65 + nn;
  uint4 o; o.x = pack2(sp[0], sp[65]); o.y = pack2(sp[2 * 65], sp[3 * 65]); o.z = pack2(sp[4 * 65], sp[5 * 65]); o.w = pack2(sp[6 * 65], sp[7 * 65]);
  { const int n = n0 + nn; *(uint4*)(Wt + ((size_t)((n >> 8) * (K >> 6) + kt)) * 16384 + (n & 255) * 64 + part * 8) = o; }
}

DI void phase0(const KP& p, char* lds) {
  const int tid = threadIdx.x, bid = blockIdx.x, nb = gridDim.x;
  unsigned char* ws = p.ws;
  constexpr int I_IN = 16 * 36, I_QUP = 6 * 12, I_KVUP = 4 * 16, I_OUT = 16 * 16, I_PQ = 16 * 32;
  constexpr int I_ALL = I_IN + I_QUP + I_KVUP + I_OUT + I_PQ;
  for (int it = bid; it < I_ALL; it += nb) {
    int q = it;
    if (q < I_IN) { p0_transpose(lds, p.in[7], 1024, 2272, (bf16_t*)(ws + WS_WTIN), q); continue; } q -= I_IN;
    if (q < I_QUP) { p0_transpose(lds, p.in[9], 384, 768, (bf16_t*)(ws + WS_WTQUP), q); continue; } q -= I_QUP;
    if (q < I_KVUP) { p0_transpose(lds, p.in[11], 256, 1024, (bf16_t*)(ws + WS_WTKVUP), q); continue; } q -= I_KVUP;
    if (q < I_OUT) { p0_transpose(lds, p.in[17], 1024, 1024, (bf16_t*)(ws + WS_WTOUT), q); continue; } q -= I_OUT;
    p0_transpose(lds, p.in[20], 1024, 2048, (bf16_t*)(ws + WS_WTPQ), q);
  }
  { bf16_t* kd = (bf16_t*)(ws + WS_KD);
    for (int e = bid * NTHR + tid; e < 65536; e += nb * NTHR) { int n = e >> 8, k = e & 255; float v = 0.f;
      if (n < 128 && k < 128) v = p.in[21][n * 128 + k]; else if (n >= 128 && k >= 128) v = p.in[22][(n - 128) * 128 + (k - 128)];
      kd[(size_t)(k >> 6) * 16384 + n * 64 + (k & 63)] = f2bf(v); } }
  { const int lane = tid & 63; float* scl = (float*)(ws + WS_ESC);
    for (int row = bid * 8 + (tid >> 6); row < 32768; row += nb * 8) { const int t = row >> 14, e = row & 16383;
      const float* src = p.in[23 + t] + (size_t)e * 1024 + lane * 16;
      float4 x[4]; float am = 0.f;
#pragma unroll
      for (int i = 0; i < 4; ++i) { x[i] = *(const float4*)(src + 4 * i); am = fmaxf(am, fmaxf(fmaxf(fabsf(x[i].x), fabsf(x[i].y)), fmaxf(fabsf(x[i].z), fabsf(x[i].w)))); }
      am = wave_max(am);
      float sc = 1.f, isc = 1.f;
      if (am > 0.f) { int ex; (void)frexpf(448.f / am, &ex); sc = ldexpf(1.f, ex - 1); isc = ldexpf(1.f, 1 - ex); }
      unsigned wv[4];
#pragma unroll
      for (int i = 0; i < 4; ++i) { int q = __builtin_amdgcn_cvt_pk_fp8_f32(x[i].x * sc, x[i].y * sc, 0, false); q = __builtin_amdgcn_cvt_pk_fp8_f32(x[i].z * sc, x[i].w * sc, q, true); wv[i] = (unsigned)q; }
      *(uint4*)(ws + (t ? WS_EV : WS_EU) + (size_t)e * 1024 + lane * 16) = make_uint4(wv[0], wv[1], wv[2], wv[3]);
      if (lane == 0) scl[t * 16384 + e] = isc; } }
  for (int jb = bid; jb < 96; jb += nb) {
    __syncthreads();
    float* cact = (float*)lds;
    float* red = (float*)(lds + 32768);
    for (int e = tid; e < 8192; e += NTHR) cact[e] = silu_f(p.in[1][e]);
    __syncthreads();
    const int jj = tid & 63, ks = tid >> 6, j0 = jb * 64;
    float acc[8];
#pragma unroll
    for (int b = 0; b < 8; ++b) acc[b] = 0.f;
    const float* wp = p.in[3] + (size_t)(ks * 128) * 6144 + j0 + jj;
    for (int k = 0; k < 128; ++k) { const float wv = wp[(size_t)k * 6144];
#pragma unroll
      for (int b = 0; b < 8; ++b) acc[b] += cact[b * 1024 + ks * 128 + k] * wv; }
#pragma unroll
    for (int b = 0; b < 8; ++b) red[(ks * 64 + jj) * 8 + b] = acc[b];
    __syncthreads();
    { const int b = tid >> 6; float sacc = p.in[4][j0 + jj];
#pragma unroll
      for (int k2 = 0; k2 < 8; ++k2) sacc += red[(k2 * 64 + jj) * 8 + b];
      ((float*)(ws + WS_MOD))[b * 6144 + j0 + jj] = sacc; }
  }
}

constexpr int WT_STRIDE = 144, WT_BYTES = 32 * WT_STRIDE;
DI void wt_write(char* wl, const f32x16& a0, const f32x16& a1, int r, int hh, float scale) {
  char* bp = wl + (4 * hh) * WT_STRIDE + r * 2;
#pragma unroll
  for (int reg = 0; reg < 16; ++reg) { const int ro = ((reg & 3) + 8 * (reg >> 2)) * WT_STRIDE;
    *(bf16_t*)(bp + ro) = f2bf(a0[reg] * scale); *(bf16_t*)(bp + ro + 64) = f2bf(a1[reg] * scale); }
}
DI void wt_write_rope(char* wl, const f32x16& a0, const f32x16& a1, int r, int hh, const float* cs, const float* sn, int m0) {
  char* bp = wl + (4 * hh) * WT_STRIDE + r * 2;
#pragma unroll
  for (int reg = 0; reg < 16; ++reg) { const int rw = (reg & 3) + 8 * (reg >> 2); const int row = m0 + rw + 4 * hh;
    const float c = cs[row * 32 + r], s = sn[row * 32 + r];
    *(bf16_t*)(bp + rw * WT_STRIDE) = f2bf(a0[reg] * c - a1[reg] * s); *(bf16_t*)(bp + rw * WT_STRIDE + 64) = f2bf(a1[reg] * c + a0[reg] * s); }
}
DI void wt_store(const char* wl, int lane, bf16_t* dA, int sA, bf16_t* dB, int sB) {
  const int piece = lane & 7, rsub = lane >> 3;
  bf16_t* d = (piece < 4) ? dA : dB; const int st = (piece < 4) ? sA : sB;
  if (d) {
#pragma unroll
    for (int i = 0; i < 4; ++i) { const int row = i * 8 + rsub; const uint4 v = *(const uint4*)(wl + row * WT_STRIDE + piece * 16);
      *(uint4*)(d + (size_t)row * st + (piece & 3) * 8) = v; }
  }
}
#define LDS_FENCE() asm volatile("s_waitcnt lgkmcnt(0)" ::: "memory")
DI int lv(int x) { asm volatile("" : "+v"(x)); return x; }
template <class T> DI T* launder(T* q) { size_t z = 0; asm volatile("" : "+s"(z)); return (T*)((char*)q + z); }

constexpr int GL_GR = 0, GL_VT = 8192, GL_QD = 26624, GL_KI = 45056, GL_KIT = 63488, GL_ATT = 81920, GL_TOT = 91136, GL_DEC = 93184, GL_LA = 93696  , GL_QS = 126464  , GL_KS = 134656;
DI void gla_chunk_local(const KP& p, char* lds, unsigned char* ws, int tile, const bf16_t* qg, const bf16_t* kg, const bf16_t* vg, const bf16_t* GR) {
  const int tid = lv(threadIdx.x), lane = tid & 63, w = tid >> 6, r = lane & 31, hh = lane >> 5;
  const int b = tile >> 5, n = tile & 31, tok0 = tile * 64;
  float* GRL = (float*)(lds + GL_GR); float* TOT = (float*)(lds + GL_TOT); float* DECL = (float*)(lds + GL_DEC);
  __syncthreads();
#pragma unroll
  for (int i = 0; i < 4; ++i) GRL[tid + 512 * i] = bf2f(GR[tid + 512 * i]);
#pragma unroll 1
  for (int h = 0; h < 4; ++h) {
    __syncthreads();
    { const int t = tid >> 3, c8 = (tid & 7) * 8;
      *(uint4*)(lds + GL_QS + (t * 64 + c8) * 2) = *(const uint4*)(qg + (size_t)t * 256 + h * 64 + c8);
      *(uint4*)(lds + GL_KS + (t * 64 + c8) * 2) = *(const uint4*)(kg + (size_t)t * 256 + h * 64 + c8); }
#pragma unroll
    for (int i = 0; i < 2; ++i) { const int c = tid + 512 * i, t = c >> 4, d8 = (c & 15) * 8;
      const uint4 v = *(const uint4*)(vg + (size_t)t * 512 + h * 128 + d8);
      bf16_t* vt = (bf16_t*)(lds + GL_VT) + d8 * 72 + t;
      vt[0] = (bf16_t)(v.x & 0xffffu); vt[72] = (bf16_t)(v.x >> 16); vt[144] = (bf16_t)(v.y & 0xffffu); vt[216] = (bf16_t)(v.y >> 16);
      vt[288] = (bf16_t)(v.z & 0xffffu); vt[360] = (bf16_t)(v.z >> 16); vt[432] = (bf16_t)(v.w & 0xffffu); vt[504] = (bf16_t)(v.w >> 16); }
    const int dir = tid >> 8, qt = (tid >> 6) & 3, dk = tid & 63, col = h * 64 + dk;
    float* LAL = (float*)(lds + GL_LA) + tid;
    {
      const float* wg = launder(dir ? p.in[14] : p.in[12]); const float* bg = launder(dir ? p.in[15] : p.in[13]);
      float wr[16];
#pragma unroll
      for (int q = 0; q < 16; ++q) wr[q] = wg[q * 256 + col];
      const float bias = bg[col];
      float run = 0.f;
#pragma unroll 2
      for (int ii = 0; ii < 16; ++ii) { const int i = dir ? 15 - ii : ii;
        const float* gp = GRL + (qt * 16 + i) * 32 + dir * 16; float x = bias;
#pragma unroll
        for (int q = 0; q < 16; ++q) x += gp[q] * wr[q];
        run += logsigmoid_fast(x) * (1.f / 16.f); LAL[i * 512] = run; }
      TOT[(dir * 64 + dk) * 4 + qt] = run;
    }
    __syncthreads();
    {
      const float4 tq = *(const float4*)(TOT + (dir * 64 + dk) * 4);
      const float total = (tq.x + tq.y) + (tq.z + tq.w);
      float off;
      if (dir == 0) off = (qt > 0 ? tq.x : 0.f) + (qt > 1 ? tq.y : 0.f) + (qt > 2 ? tq.z : 0.f);
      else          off = (qt < 1 ? tq.y : 0.f) + (qt < 2 ? tq.z : 0.f) + (qt < 3 ? tq.w : 0.f);
      if (qt == 0) { const float dc = fexp(total); DECL[dir * 64 + dk] = dc; ((float*)(ws + WS_DEC))[((size_t)((b * 4 + h) * 2 + dir) * 32 + n) * 64 + dk] = dc; }
      bf16_t* QD = (bf16_t*)(lds + GL_QD + dir * 9216) + (qt * 16) * 72 + dk; bf16_t* KI = (bf16_t*)(lds + GL_KI + dir * 9216) + (qt * 16) * 72 + dk;
      bf16_t* KIT = (bf16_t*)(lds + GL_KIT + dir * 9216) + dk * 72 + qt * 16;
      bf16_t* qdg = (bf16_t*)(ws + WS_QDEC) + (size_t)((tile * 4 + h) * 2 + dir) * 4096 + (qt * 16) * 64 + dk;
      const bf16_t* qgp = (const bf16_t*)(lds + GL_QS) + (qt * 16) * 64 + dk; const bf16_t* kgp = (const bf16_t*)(lds + GL_KS) + (qt * 16) * 64 + dk;
#pragma unroll 2
      for (int i = 0; i < 16; ++i) { const float bb = off + LAL[i * 512];
        const float qv = bf2f(qgp[i * 64]), kv = bf2f(kgp[i * 64]);
        const float eb = fexp(bb); const bf16_t qd = f2bf(qv * eb), ki = f2bf(kv * __builtin_amdgcn_rcpf(eb));
        QD[i * 72] = qd; KI[i * 72] = ki; qdg[i * 64] = qd; KIT[i] = ki; }
    }
    __syncthreads();
    if (w < 4) { const int mi = w >> 1, ni = w & 1;
      f32x16 asum;
#pragma unroll
      for (int i = 0; i < 16; ++i) asum[i] = 0.f;
#pragma unroll
      for (int d = 0; d < 2; ++d) { f32x16 acc;
#pragma unroll
        for (int i = 0; i < 16; ++i) acc[i] = 0.f;
#pragma unroll
        for (int s = 0; s < 4; ++s) { const bf16x8 a = *(const bf16x8*)(lds + GL_QD + d * 9216 + (mi * 32 + r) * 144 + s * 32 + hh * 16);
          const bf16x8 bb = *(const bf16x8*)(lds + GL_KI + d * 9216 + (ni * 32 + r) * 144 + s * 32 + hh * 16); acc = MFMA32(a, bb, acc); }
#pragma unroll
        for (int reg = 0; reg < 16; ++reg) { const int ti = mi * 32 + crow(reg, hh), tj = ni * 32 + r; const bool keep = d ? (tj >= ti) : (tj <= ti); asum[reg] += keep ? acc[reg] : 0.f; } }
      bf16_t* at = (bf16_t*)(lds + GL_ATT) + (mi * 32 + 4 * hh) * 72 + ni * 32 + r;
#pragma unroll
      for (int reg = 0; reg < 16; ++reg) at[((reg & 3) + 8 * (reg >> 2)) * 72] = f2bf(asum[reg]);
    }
    __syncthreads();
    { const int mi = w >> 2, ni = w & 3; f32x16 acc;
#pragma unroll
      for (int i = 0; i < 16; ++i) acc[i] = 0.f;
#pragma unroll
      for (int s = 0; s < 4; ++s) { const bf16x8 a = *(const bf16x8*)(lds + GL_ATT + (mi * 32 + r) * 144 + s * 32 + hh * 16);
        const bf16x8 bb = *(const bf16x8*)(lds + GL_VT + (ni * 32 + r) * 144 + s * 32 + hh * 16); acc = MFMA32(a, bb, acc); }
      bf16_t* oi = (bf16_t*)(ws + WS_OINTRA) + (size_t)(tok0 + mi * 32 + 4 * hh) * 512 + h * 128 + ni * 32 + r;
#pragma unroll
      for (int reg = 0; reg < 16; ++reg) oi[(size_t)((reg & 3) + 8 * (reg >> 2)) * 512] = f2bf(acc[reg]); }
    { const int dvb = w >> 1, dkb = w & 1;
#pragma unroll
      for (int d = 0; d < 2; ++d) { f32x16 acc;
#pragma unroll
        for (int i = 0; i < 16; ++i) acc[i] = 0.f;
#pragma unroll
        for (int s = 0; s < 4; ++s) { const bf16x8 a = *(const bf16x8*)(lds + GL_VT + (dvb * 32 + r) * 144 + s * 32 + hh * 16);
          const bf16x8 bb = *(const bf16x8*)(lds + GL_KIT + d * 9216 + (dkb * 32 + r) * 144 + s * 32 + hh * 16); acc = MFMA32(a, bb, acc); }
        const float sc = DECL[d * 64 + dkb * 32 + r];
        bf16_t* ds = (bf16_t*)(ws + WS_SPT) + ((size_t)((b * 4 + h) * 2 + d) * 32 + n) * 8192 + (size_t)(dvb * 32 + 4 * hh) * 64 + dkb * 32 + r;
#pragma unroll
        for (int reg = 0; reg < 16; ++reg) ds[((reg & 3) + 8 * (reg >> 2)) * 64] = f2bf(acc[reg] * sc); } }
  }
}

DI void phase1(const KP& p, char* lds) {
  const int tid = threadIdx.x, lane = tid & 63, w = tid >> 6, r = lane & 31, hh = lane >> 5;
  float* cs = (float*)(lds + LDS_TAB); float* sn = cs + 2048;
  char* wl = lds + LDS_WT + (w & 3) * WT_BYTES;
  for (int tile = blockIdx.x; tile < 256; tile += gridDim.x) {
    unsigned char* ws = launder(p.ws); unsigned char* ob = (unsigned char*)launder(p.out); const float* xin = launder(p.in[0]);
    const float* mod = (const float*)(ws + WS_MOD);
    const int tok0 = tile * 64, b = tile >> 5, t0 = (tile & 31) * 64;
    bf16_t* Hs = (bf16_t*)(ob + OUT_HS) + (size_t)tok0 * 1024;
    bf16_t* CQ = (bf16_t*)(ob + OUT_CQ) + (size_t)tok0 * 640;
    bf16_t* CQN = Hs; bf16_t* CKVN = Hs + 64 * 384;
    bf16_t* GR = (bf16_t*)(ob + OUT_GR) + (size_t)tok0 * 32;
    bf16_t* Qm = (bf16_t*)(ws + WS_QM); bf16_t* Km = (bf16_t*)(ws + WS_KM); bf16_t* Vm = (bf16_t*)(ws + WS_VM);
    bf16_t* qg = (bf16_t*)(ws + WS_P1S + (size_t)tile * 131072); bf16_t* kg = qg + 64 * 256; bf16_t* vg = qg + 2 * 64 * 256;
    bf16_t* rg = (bf16_t*)(ws + WS_RG) + (size_t)tok0 * 512;
    __syncthreads();
#pragma unroll
    for (int i = 0; i < 4; ++i) { const int e = tid + 512 * i, tt = e >> 5, j = e & 31;
      const float inv = __builtin_amdgcn_exp2f(-(float)j * (13.287712379549449f / 32.f)); const float ang = (float)((const int*)p.in[2])[tok0 + tt] * inv;
      float rev = ang * 0.15915494309189535f; rev -= floorf(rev);
      cs[e] = __builtin_amdgcn_cosf(rev); sn[e] = __builtin_amdgcn_sinf(rev); }
    {
      float4 ge[4], sh[4];
      const float* gpre = launder(p.in[5]); const float* modb = launder(mod) + b * 6144;
#pragma unroll
      for (int i = 0; i < 4; ++i) { const int d = (lane + 64 * i) * 4;
        const float4 g = *(const float4*)(gpre + d); const float4 sc = *(const float4*)(modb + 1024 + d); sh[i] = *(const float4*)(modb + d);
        ge[i] = make_float4(g.x * (1.f + sc.x), g.y * (1.f + sc.y), g.z * (1.f + sc.z), g.w * (1.f + sc.w)); }
#pragma unroll 2
      for (int rr = 0; rr < 8; ++rr) { const int row = w * 8 + rr;
        const float* xr = xin + (size_t)(tok0 + row) * 1024;
        float4 v[4]; float ss = 0.f;
#pragma unroll
        for (int i = 0; i < 4; ++i) { v[i] = *(const float4*)(xr + (lane + 64 * i) * 4); ss += v[i].x * v[i].x + v[i].y * v[i].y + v[i].z * v[i].z + v[i].w * v[i].w; }
        ss = wave_sum(ss); const float rs = rsqrtf(ss * (1.f / 1024.f) + EPS);
#pragma unroll
        for (int i = 0; i < 4; ++i) { uint2 o; o.x = pack2(v[i].x * rs * ge[i].x + sh[i].x, v[i].y * rs * ge[i].y + sh[i].y); o.y = pack2(v[i].z * rs * ge[i].z + sh[i].z, v[i].w * rs * ge[i].w + sh[i].w);
          *(uint2*)(Hs + (size_t)row * 1024 + (lane + 64 * i) * 4) = o; }
      }
    }
    __syncthreads();
    block_gemm<3>(lds, Hs, 1024, (const bf16_t*)(ws + WS_WTIN), 9, 1024, [&](int m0, int n0, const f32x16& a0, const f32x16& a1) {
      const int r2 = lv(r), h2 = lv(hh), ln = lv(lane);
      if (n0 == O_KR) {
        wt_write_rope(wl, a0, a1, r2, h2, cs, sn, m0); LDS_FENCE();
        for (int h = 0; h < 4; ++h) { bf16_t* kp = Km + (((size_t)b * 4 + h) * SEQ + t0 + m0) * 192 + 128; wt_store(wl, ln, kp, 192, kp + 32, 192); }
        return; }
      wt_write(wl, a0, a1, r2, h2, (n0 >= O_QG && n0 < O_KG) ? 0.125f : 1.f); LDS_FENCE();
      bf16_t* d[2]; int st[2];
#pragma unroll
      for (int half = 0; half < 2; ++half) { const int nb = n0 + 32 * half;
        if (nb < 640) { d[half] = CQ + (size_t)m0 * 640 + nb; st[half] = 640; }
        else if (nb < O_KG) { d[half] = qg + (size_t)m0 * 256 + (nb - O_QG); st[half] = 256; }
        else if (nb < O_VG) { d[half] = kg + (size_t)m0 * 256 + (nb - O_KG); st[half] = 256; }
        else if (nb < O_GF) { d[half] = vg + (size_t)m0 * 512 + (nb - O_VG); st[half] = 512; }
        else if (nb < O_R) { d[half] = GR + (size_t)m0 * 32; st[half] = 32; }
        else if (nb < INW) { d[half] = rg + (size_t)m0 * 512 + (nb - O_R); st[half] = 512; }
        else { d[half] = nullptr; st[half] = 0; } }
      wt_store(wl, ln, d[0], st[0], d[1], st[1]);
    });
    __syncthreads();
    const float* gq = launder(p.in[8]); const float* gkv = launder(p.in[10]);
#pragma unroll 2
    for (int rr = 0; rr < 8; ++rr) { const int row = w * 8 + rr; const unsigned* cr = (const unsigned*)(CQ + (size_t)row * 640);
      float v0[5], v1[5];
#pragma unroll
      for (int i = 0; i < 5; ++i) { const unsigned u = cr[lane + 64 * i]; v0[i] = __uint_as_float(u << 16); v1[i] = __uint_as_float(u & 0xffff0000u); }
      float ss = v0[0] * v0[0] + v1[0] * v1[0] + v0[1] * v0[1] + v1[1] * v1[1] + v0[2] * v0[2] + v1[2] * v1[2];
      float s2 = v0[3] * v0[3] + v1[3] * v1[3] + v0[4] * v0[4] + v1[4] * v1[4];
      ss = wave_sum(ss); s2 = wave_sum(s2);
      const float rq = rsqrtf(ss * (1.f / 384.f) + EPS), rk = rsqrtf(s2 * (1.f / 256.f) + EPS);
#pragma unroll
      for (int i = 0; i < 3; ++i) { const int c = 2 * (lane + 64 * i); *(unsigned*)(CQN + (size_t)row * 384 + c) = pack2(v0[i] * rq * gq[c], v1[i] * rq * gq[c + 1]); }
#pragma unroll
      for (int i = 3; i < 5; ++i) { const int c = 2 * (lane + 64 * (i - 3)); *(unsigned*)(CKVN + (size_t)row * 256 + c) = pack2(v0[i] * rk * gkv[c], v1[i] * rk * gkv[c + 1]); }
    }
    __syncthreads();
    block_gemm<3>(lds, CQN, 384, (const bf16_t*)(ws + WS_WTQUP), 3, 384, [&](int m0, int n0, const f32x16& a0, const f32x16& a1) {
      const int r2 = lv(r), h2 = lv(hh), ln = lv(lane);
      const int h = n0 / 192, d0 = n0 % 192;
      bf16_t* qp = Qm + (((size_t)b * 4 + h) * SEQ + t0 + m0) * 192 + d0;
      if (d0 < 128) wt_write(wl, a0, a1, r2, h2, 1.f); else wt_write_rope(wl, a0, a1, r2, h2, cs, sn, m0);
      LDS_FENCE();
      wt_store(wl, ln, qp, 192, qp + 32, 192);
    });
    block_gemm<3>(lds, CKVN, 256, (const bf16_t*)(ws + WS_WTKVUP), 4, 256, [&](int m0, int n0, const f32x16& a0, const f32x16& a1) {
      const int r2 = lv(r), h2 = lv(hh), ln = lv(lane);
      const int h = n0 >> 8, d0 = n0 & 255;
      wt_write(wl, a0, a1, r2, h2, 1.f); LDS_FENCE();
      if (d0 < 128) { bf16_t* kp = Km + (((size_t)b * 4 + h) * SEQ + t0 + m0) * 192 + d0; wt_store(wl, ln, kp, 192, kp + 32, 192); }
      else { bf16_t* vp = Vm + (((size_t)b * 4 + h) * SEQ + t0 + m0) * 128 + (d0 - 128); wt_store(wl, ln, vp, 128, vp + 32, 128); }
    });
    gla_chunk_local(p, lds, ws, tile, qg, kg, vg, GR);
  }
}

namespace att {
typedef short s16x4 __attribute__((ext_vector_type(4)));
typedef unsigned u32x4 __attribute__((ext_vector_type(4)));
constexpr int DQ = 192, DV = 128, KVBLK = 64;
constexpr float SCALE = 0.07216878364870322f;
constexpr float THR = 8.f;
constexpr int SHM_V = KVBLK * DV * 2, SHM_K = KVBLK * DQ * 2;
constexpr int SHM_QR = 8 * 32 * 176;
constexpr int SHM_ATTN = 2 * SHM_V + 2 * SHM_K + 8 * 64 * 4 + SHM_QR;
#define KSWZ(row, colB) ((row) * 384 + ((colB) ^ (((row) & 7) << 4)))
#define SBAR() __builtin_amdgcn_sched_barrier(0)
DI unsigned cvtpk(float lo, float hi) { unsigned r; asm volatile("v_cvt_pk_bf16_f32 %0, %1, %2" : "=v"(r) : "v"(lo), "v"(hi)); return r; }

DI void partialSM(f32x16& p0, f32x16& p1, float& m_reg, float& mn, float& alpha) {
  constexpr float C = SCALE * 1.4426950408889634f;
  float pmax = p0[0];
#pragma unroll
  for (int r = 1; r < 16; ++r) pmax = fmaxf(pmax, p0[r]);
#pragma unroll
  for (int r = 0; r < 16; ++r) pmax = fmaxf(pmax, p1[r]);
  { auto rr = __builtin_amdgcn_permlane32_swap(__float_as_uint(pmax), __float_as_uint(pmax), false, false);
    pmax = fmaxf(__uint_as_float(rr[0]), __uint_as_float(rr[1])); }
  if (__builtin_expect(__all(pmax - m_reg <= THR / SCALE), 1)) { mn = m_reg; alpha = 1.f; }
  else { mn = fmaxf(m_reg, pmax); alpha = __builtin_amdgcn_exp2f((m_reg - mn) * C); m_reg = mn; }
  const float mnC = -mn * C;
#pragma unroll
  for (int r = 0; r < 16; ++r) p0[r] = fmaf(p0[r], C, mnC);
#pragma unroll
  for (int r = 0; r < 16; ++r) p1[r] = fmaf(p1[r], C, mnC);
#pragma unroll
  for (int r = 0; r < 16; ++r) p0[r] = __builtin_amdgcn_exp2f(p0[r]);
}
DI void finishSM(f32x16& p0, f32x16& p1, float alpha, float& l_reg, bf16x8& pa0, bf16x8& pa1, bf16x8& pa2, bf16x8& pa3) {
#pragma unroll
  for (int r = 0; r < 16; ++r) p1[r] = __builtin_amdgcn_exp2f(p1[r]);
  float ps = 0;
#pragma unroll
  for (int r = 0; r < 16; ++r) ps += p0[r];
#pragma unroll
  for (int r = 0; r < 16; ++r) ps += p1[r];
  { auto rr = __builtin_amdgcn_permlane32_swap(__float_as_uint(ps), __float_as_uint(ps), false, false);
    ps = __uint_as_float(rr[0]) + __uint_as_float(rr[1]); }
  l_reg = l_reg * alpha + ps;
#define PK4(P, BASE, OUT) do { unsigned a0 = cvtpk(P[BASE + 0], P[BASE + 1]), a1 = cvtpk(P[BASE + 2], P[BASE + 3]);   \
    unsigned b0 = cvtpk(P[BASE + 4], P[BASE + 5]), b1 = cvtpk(P[BASE + 6], P[BASE + 7]);                              \
    auto r0 = __builtin_amdgcn_permlane32_swap(a0, b0, false, false); auto r1 = __builtin_amdgcn_permlane32_swap(a1, b1, false, false); \
    u32x4 wv = {r0[0], r1[0], r0[1], r1[1]}; OUT = *reinterpret_cast<bf16x8*>(&wv); } while (0)
  PK4(p0, 0, pa0); PK4(p0, 8, pa1); PK4(p1, 0, pa2); PK4(p1, 8, pa3);
#undef PK4
}
DI void qkt(f32x16& p0, f32x16& p1, const char* Ks, const bf16x8* qr, const char* qrl, int r32, int hi) {
#pragma unroll
  for (int i = 0; i < 16; ++i) { p0[i] = 0.f; p1[i] = 0.f; }
#pragma unroll
  for (int d0 = 0; d0 < 12; ++d0) { const int cb = (d0 * 16 + hi * 8) * 2;
    const bf16x8 b0 = *reinterpret_cast<const bf16x8*>(Ks + KSWZ(r32, cb));
    const bf16x8 b1 = *reinterpret_cast<const bf16x8*>(Ks + KSWZ(32 + r32, cb));
    const bf16x8 q = (d0 < 7) ? qr[d0 < 7 ? d0 : 0] : *reinterpret_cast<const bf16x8*>(qrl + (d0 - 7) * 32);
    p0 = MFMA32(b0, q, p0);
    p1 = MFMA32(b1, q, p1); }
}
DI int v_st(int k, int c) { const int kk = (k & ~0xC) | ((k & 4) << 1) | ((k & 8) >> 1); return ((kk >> 3) * 4 + (c >> 5)) * 512 + ((kk & 7) * 32 + (c & 31)) * 2; }
DI int v_rd_base(int lane) { return ((lane & 3) << 3) | (((lane >> 2) & 3) << 6) | (((lane >> 4) & 1) << 5) | (((lane >> 5) & 1) << 8); }
constexpr int v_rd_off(int d0, int ks, int half) { return d0 * 512 + ks * 4096 + half * 2048; }
template <int OFF> DI s16x4 tr_read(int vb) { s16x4 r; asm volatile("ds_read_b64_tr_b16 %0, %1 offset:%2" : "=&v"(r) : "v"(vb), "i"(OFF) : "memory"); return r; }
template <int D0> DI void pv_one(f32x16& od, int vb, bf16x8 pa0, bf16x8 pa1, bf16x8 pa2, bf16x8 pa3) {
  const s16x4 l0 = tr_read<v_rd_off(D0, 0, 0)>(vb), h0 = tr_read<v_rd_off(D0, 0, 1)>(vb), l1 = tr_read<v_rd_off(D0, 1, 0)>(vb), h1 = tr_read<v_rd_off(D0, 1, 1)>(vb);
  const s16x4 l2 = tr_read<v_rd_off(D0, 2, 0)>(vb), h2 = tr_read<v_rd_off(D0, 2, 1)>(vb), l3 = tr_read<v_rd_off(D0, 3, 0)>(vb), h3 = tr_read<v_rd_off(D0, 3, 1)>(vb);
  asm volatile("s_waitcnt lgkmcnt(0)" ::: "memory"); SBAR();
#define PK(L, H) (bf16x8){L[0], L[1], L[2], L[3], H[0], H[1], H[2], H[3]}
  od = MFMA32(pa0, PK(l0, h0), od);
  od = MFMA32(pa1, PK(l1, h1), od);
  od = MFMA32(pa2, PK(l2, h2), od);
  od = MFMA32(pa3, PK(l3, h3), od);
#undef PK
}
DI void pv_d0(f32x16* o, int vb, bf16x8 pa0, bf16x8 pa1, bf16x8 pa2, bf16x8 pa3) {
  pv_one<0>(o[0], vb, pa0, pa1, pa2, pa3); pv_one<1>(o[1], vb, pa0, pa1, pa2, pa3); pv_one<2>(o[2], vb, pa0, pa1, pa2, pa3); pv_one<3>(o[3], vb, pa0, pa1, pa2, pa3);
}
DI void attn_unit(const bf16_t* Qb, const bf16_t* Kh, const bf16_t* Vh, bf16_t* Ob, int seq, char* lds) {
  const int tid = lv(threadIdx.x), wid = tid >> 6, lane = tid & 63, r32 = lane & 31, hi = lane >> 5;
  char* V_lds = lds; char* K_lds = lds + 2 * SHM_V;
  float* wsf = (float*)(lds + 2 * SHM_V + 2 * SHM_K) + wid * 64; float* li_l = wsf; float* al_l = wsf + 32;
  char* qrl = lds + 2 * SHM_V + 2 * SHM_K + 8 * 64 * 4 + wid * (32 * 176) + r32 * 176 + hi * 16;
  float m_reg = -1e30f, l_reg = 0; f32x16 o[4]; bf16x8 qr[7];
#pragma unroll
  for (int d = 0; d < 4; ++d)
#pragma unroll
    for (int i = 0; i < 16; ++i) o[d][i] = 0.f;
  const bf16_t* Qw = Qb + (size_t)(wid * 32 + r32) * DQ + hi * 8;
#pragma unroll
  for (int d0 = 0; d0 < 7; ++d0) qr[d0] = *reinterpret_cast<const bf16x8*>(Qw + d0 * 16);
#pragma unroll
  for (int d0 = 7; d0 < 12; ++d0) *reinterpret_cast<bf16x8*>(qrl + (d0 - 7) * 32) = *reinterpret_cast<const bf16x8*>(Qw + d0 * 16);
  int kst[3];
#pragma unroll
  for (int i = 0; i < 3; ++i) { const int c = tid + 512 * i; kst[i] = KSWZ(c / 24, (c % 24) * 16); }
  const int vst0 = v_st(tid >> 4, (tid & 15) * 8), vst1 = v_st(32 + (tid >> 4), (tid & 15) * 8);
  const int vb0 = (int)(uintptr_t)V_lds + v_rd_base(lane);
  bf16x8 sk0, sk1, sk2, sv0, sv1;
#define SLOAD(k0) do { const bf16x8* kp = reinterpret_cast<const bf16x8*>(Kh + (size_t)(k0) * DQ) + tid; sk0 = kp[0]; sk1 = kp[512]; sk2 = kp[1024]; \
    const bf16x8* vp = reinterpret_cast<const bf16x8*>(Vh + (size_t)(k0) * DV) + tid; sv0 = vp[0]; sv1 = vp[512]; } while (0)
#define SWRITE(b) do { *(bf16x8*)(V_lds + (b) * SHM_V + vst0) = sv0; *(bf16x8*)(V_lds + (b) * SHM_V + vst1) = sv1; \
    *(bf16x8*)(K_lds + (b) * SHM_K + kst[0]) = sk0; *(bf16x8*)(K_lds + (b) * SHM_K + kst[1]) = sk1; *(bf16x8*)(K_lds + (b) * SHM_K + kst[2]) = sk2; } while (0)
#define RESC(a) do { if (__any((a) < 1.f)) { if (hi == 0) al_l[r32] = (a); asm volatile("s_waitcnt lgkmcnt(0)" ::: "memory"); \
    _Pragma("unroll") for (int d = 0; d < 4; ++d) _Pragma("unroll") for (int r = 0; r < 16; ++r) o[d][r] *= al_l[crow(r, hi)]; } } while (0)
  f32x16 pA0, pA1, pB0, pB1; float mnA, mnB, alA, alB; bf16x8 pa0, pa1, pa2, pa3; const int NT = seq / KVBLK;
  SLOAD(0); SWRITE(0); __syncthreads();
  qkt(pA0, pA1, K_lds, qr, qrl, r32, hi); partialSM(pA0, pA1, m_reg, mnA, alA);
  SLOAD(KVBLK); SWRITE(1); __syncthreads();
  for (int j = 1; j + 1 < NT; j += 2) {
    SBAR(); qkt(pB0, pB1, K_lds + SHM_K, qr, qrl, r32, hi);
    finishSM(pA0, pA1, alA, l_reg, pa0, pa1, pa2, pa3); SBAR();
    SLOAD((j + 1) * KVBLK); SBAR();
    pv_d0(o, vb0, pa0, pa1, pa2, pa3); partialSM(pB0, pB1, m_reg, mnB, alB);
    __syncthreads(); SWRITE(0);
    RESC(alB); __syncthreads();
    SBAR(); qkt(pA0, pA1, K_lds, qr, qrl, r32, hi);
    finishSM(pB0, pB1, alB, l_reg, pa0, pa1, pa2, pa3); SBAR();
    SLOAD((j + 2) * KVBLK); SBAR();
    pv_d0(o, vb0 + SHM_V, pa0, pa1, pa2, pa3); partialSM(pA0, pA1, m_reg, mnA, alA);
    __syncthreads(); SWRITE(1);
    RESC(alA); __syncthreads();
  }
  SBAR(); qkt(pB0, pB1, K_lds + SHM_K, qr, qrl, r32, hi);
  finishSM(pA0, pA1, alA, l_reg, pa0, pa1, pa2, pa3); SBAR();
  pv_d0(o, vb0, pa0, pa1, pa2, pa3); partialSM(pB0, pB1, m_reg, mnB, alB);
  __syncthreads(); RESC(alB);
  finishSM(pB0, pB1, alB, l_reg, pa0, pa1, pa2, pa3); SBAR();
  pv_d0(o, vb0 + SHM_V, pa0, pa1, pa2, pa3);
  if (hi == 0) li_l[r32] = l_reg; asm volatile("s_waitcnt lgkmcnt(0)" ::: "memory");
  float rli[16];
#pragma unroll
  for (int r = 0; r < 16; ++r) rli[r] = __builtin_amdgcn_rcpf(li_l[crow(r, hi)]);
  bf16_t* Ow = Ob + (size_t)(wid * 32) * 1024;
#pragma unroll
  for (int r = 0; r < 16; ++r) { const int orow = crow(r, hi);
#pragma unroll
    for (int d0 = 0; d0 < 4; ++d0) Ow[(size_t)orow * 1024 + d0 * 32 + r32] = f2bf(o[d0][r] * rli[r]); }
  __syncthreads();
#undef SLOAD
#undef SWRITE
#undef RESC
}
}

DI void phase2_attn(const KP& p, char* lds) {
  for (int u = blockIdx.x; u < 256; u += gridDim.x) {
    unsigned char* ws = launder(p.ws);
    const bf16_t* Qm = (const bf16_t*)(ws + WS_QM); const bf16_t* Km = (const bf16_t*)(ws + WS_KM); const bf16_t* Vm = (const bf16_t*)(ws + WS_VM);
    bf16_t* mixa = (bf16_t*)(ws + WS_P1S);
    const int qb = u & 7, bh = u >> 3, b = bh >> 2, h = bh & 3;
    att::attn_unit(Qm + ((size_t)bh * SEQ + qb * 256) * 192, Km + (size_t)bh * SEQ * 192, Vm + (size_t)bh * SEQ * 128,
                   mixa + ((size_t)b * SEQ + qb * 256) * 1024 + h * 128, SEQ, lds);
  }
}

constexpr int P3_TILE_BYTES = 256 * 1024;
constexpr int LDS_TK = 92160;
constexpr int SCW = 260;
template <int N> DI void ce_desc(float (&a)[N], int i, int l) { const float hi = fmaxf(a[i], a[l]), lo = fminf(a[i], a[l]); a[i] = hi; a[l] = lo; }
DI void sort16_desc(float (&a)[16]) {
#pragma unroll
  for (int k = 2; k <= 16; k <<= 1)
#pragma unroll
    for (int j = k >> 1; j > 0; j >>= 1)
#pragma unroll
      for (int i = 0; i < 16; ++i) { const int l = i ^ j; if (l > i) { if ((i & k) == 0) ce_desc(a, i, l); else ce_desc(a, l, i); } }
}
DI void merge16_desc(float (&a)[16]) {
#pragma unroll
  for (int j = 8; j > 0; j >>= 1)
#pragma unroll
    for (int i = 0; i < 16; ++i) { const int l = i ^ j; if (l > i) ce_desc(a, i, l); }
}
DI void top16_merge(float (&a)[16], const float (&b)[16]) {
#pragma unroll
  for (int i = 0; i < 16; ++i) a[i] = fmaxf(a[i], b[15 - i]);
  merge16_desc(a);
}
template <int CTRL> DI float dpp_f(float v) { return __int_as_float(__builtin_amdgcn_mov_dpp(__float_as_int(v), CTRL, 0xF, 0xF, true)); }

DI float gelu_fast(float x) { return 0.5f * x * (1.f + erff(x * 0.70710678118654752f)); }

DI void phase3(const KP& p, char* lds, const int gather_reps, const int probe) {
  const int tid0 = threadIdx.x;
  const int r = tid0 & 31, hh = (tid0 >> 5) & 1, lane = tid0 & 63;
  char* wl = lds + LDS_WT + ((tid0 >> 6) & 3) * WT_BYTES;
  for (int tile = blockIdx.x; tile < 256; tile += gridDim.x) {
    unsigned char* ws = launder(p.ws); float* outp = launder(p.out); const float* xin = launder(p.in[0]);
    const int tok0 = tile * 64, b = tile >> 5;
    unsigned char* tsc = ws + WS_QM + (size_t)tile * P3_TILE_BYTES;
    bf16_t* QRY = (bf16_t*)tsc; bf16_t* Y = (bf16_t*)tsc; bf16_t* MIXA = (bf16_t*)(ws + WS_P1S) + (size_t)tok0 * 1024; bf16_t* H2 = MIXA;
    const float* modb = launder((const float*)(ws + WS_MOD)) + b * 6144;
    __syncthreads();
    {
      const int tid = lv(tid0), lane = tid & 63, w = tid >> 6, r = lane & 31, hh = lane >> 5;
      const int h = w >> 1, mi = w & 1, n = tile & 31;
      const bf16_t* QDg = (const bf16_t*)(ws + WS_QDEC) + (size_t)(tile * 4 + h) * 2 * 4096 + (mi * 32 + r) * 64 + hh * 8;
      const bf16_t* SPg = (const bf16_t*)(ws + WS_SPT) + ((size_t)((b * 4 + h) * 2) * 32 + n) * 8192 + r * 64 + hh * 8;
      f32x16 acc[4];
#pragma unroll
      for (int ni = 0; ni < 4; ++ni)
#pragma unroll
        for (int i = 0; i < 16; ++i) acc[ni][i] = 0.f;
#pragma unroll
      for (int d = 0; d < 2; ++d)
#pragma unroll
        for (int s = 0; s < 4; ++s) { const bf16x8 a = *(const bf16x8*)(QDg + d * 4096 + s * 16);
#pragma unroll
          for (int ni = 0; ni < 4; ++ni) { const bf16x8 bb = *(const bf16x8*)(SPg + (size_t)d * 32 * 8192 + ni * 32 * 64 + s * 16); acc[ni] = MFMA32(a, bb, acc[ni]); } }
      const bf16_t* OI = (const bf16_t*)(ws + WS_OINTRA) + (size_t)(tok0 + mi * 32 + 4 * hh) * 512 + h * 128 + r;
#pragma unroll
      for (int ni = 0; ni < 4; ++ni)
#pragma unroll
        for (int reg = 0; reg < 16; ++reg) acc[ni][reg] += bf2f(OI[(size_t)((reg & 3) + 8 * (reg >> 2)) * 512 + ni * 32]);
      float rs[16];
#pragma unroll
      for (int reg = 0; reg < 16; ++reg) { float v = acc[0][reg] * acc[0][reg] + acc[1][reg] * acc[1][reg] + acc[2][reg] * acc[2][reg] + acc[3][reg] * acc[3][reg];
        v += __shfl_xor(v, 1); v += __shfl_xor(v, 2); v += __shfl_xor(v, 4); v += __shfl_xor(v, 8); v += __shfl_xor(v, 16);
        rs[reg] = rsqrtf(v * (1.f / 128.f) + EPS); }
      const float* ggl = launder(p.in[16]);
      const bf16_t* RGp = (const bf16_t*)(ws + WS_RG) + (size_t)(tok0 + mi * 32 + 4 * hh) * 512 + h * 128 + r;
      bf16_t* MX = MIXA + (size_t)(mi * 32 + 4 * hh) * 1024 + 512 + h * 128 + r;
#pragma unroll
      for (int ni = 0; ni < 4; ++ni) { const float g = ggl[ni * 32 + r];
#pragma unroll
        for (int reg = 0; reg < 16; ++reg) { const int ro = (reg & 3) + 8 * (reg >> 2); const float rv = bf2f(RGp[(size_t)ro * 512 + ni * 32]);
          MX[(size_t)ro * 1024 + ni * 32] = f2bf(acc[ni][reg] * rs[reg] * g * silu_fast(rv)); } }
    }
    __syncthreads();
    for (int rep3b = 0; rep3b < (probe == 5 ? 2 : 1); ++rep3b)
    block_gemm<3>(lds, MIXA, 1024, (const bf16_t*)(ws + WS_WTOUT), 4, 1024, [&](int m0, int n0, const f32x16& a0, const f32x16& a1) {
      const int r2 = lv(r), h2 = lv(hh), ln = lv(lane);
      wt_write(wl, a0, a1, r2, h2, 1.f); LDS_FENCE();
      bf16_t* d = Y + (size_t)m0 * 1024 + n0; wt_store(wl, ln, d, 1024, d + 32, 1024);
    });
    __syncthreads();
    {
      const int tid = lv(tid0), lane = tid & 63, w = tid >> 6;
      float4 A1[4], A2[4], S2[4];
      const float* gpo = launder(p.in[6]); const float* gpf = launder(p.in[18]);
#pragma unroll
      for (int i = 0; i < 4; ++i) { const int d = (lane + 64 * i) * 4;
        const float4 gp = *(const float4*)(gpo + d), gt = *(const float4*)(modb + 2048 + d), g2 = *(const float4*)(gpf + d), sc = *(const float4*)(modb + 4096 + d);
        S2[i] = *(const float4*)(modb + 3072 + d);
        A1[i] = make_float4(gp.x * gt.x, gp.y * gt.y, gp.z * gt.z, gp.w * gt.w);
        A2[i] = make_float4(g2.x * (1.f + sc.x), g2.y * (1.f + sc.y), g2.z * (1.f + sc.z), g2.w * (1.f + sc.w)); }
#pragma unroll 2
      for (int rr = 0; rr < 8; ++rr) { const int row = w * 8 + rr; const size_t tok = tok0 + row;
        float4 yv[4]; float ss = 0.f;
#pragma unroll
        for (int i = 0; i < 4; ++i) { const uint2 u = *(const uint2*)(Y + (size_t)row * 1024 + (lane + 64 * i) * 4);
          yv[i] = make_float4(__uint_as_float(u.x << 16), __uint_as_float(u.x & 0xffff0000u), __uint_as_float(u.y << 16), __uint_as_float(u.y & 0xffff0000u));
          ss += yv[i].x * yv[i].x + yv[i].y * yv[i].y + yv[i].z * yv[i].z + yv[i].w * yv[i].w; }
        ss = wave_sum(ss); const float rs = rsqrtf(ss * (1.f / 1024.f) + EPS);
        float4 xv[4]; float s2 = 0.f;
#pragma unroll
        for (int i = 0; i < 4; ++i) { const float4 x = *(const float4*)(xin + tok * 1024 + (lane + 64 * i) * 4);
          xv[i] = make_float4(x.x + A1[i].x * yv[i].x * rs, x.y + A1[i].y * yv[i].y * rs, x.z + A1[i].z * yv[i].z * rs, x.w + A1[i].w * yv[i].w * rs);
          *(float4*)(outp + tok * 1024 + (lane + 64 * i) * 4) = xv[i];
          s2 += xv[i].x * xv[i].x + xv[i].y * xv[i].y + xv[i].z * xv[i].z + xv[i].w * xv[i].w; }
        s2 = wave_sum(s2); const float r2 = rsqrtf(s2 * (1.f / 1024.f) + EPS);
#pragma unroll
        for (int i = 0; i < 4; ++i) { uint2 o; o.x = pack2(xv[i].x * r2 * A2[i].x + S2[i].x, xv[i].y * r2 * A2[i].y + S2[i].y); o.y = pack2(xv[i].z * r2 * A2[i].z + S2[i].z, xv[i].w * r2 * A2[i].w + S2[i].w);
          *(uint2*)(H2 + (size_t)row * 1024 + (lane + 64 * i) * 4) = o; }
      }
    }
    __syncthreads();
    for (int rep3d = 0; rep3d < (probe == 6 ? 2 : 1); ++rep3d)
    block_gemm<3>(lds, H2, 1024, (const bf16_t*)(ws + WS_WTPQ), 8, 1024, [&](int m0, int n0, const f32x16& a0, const f32x16& a1) {
      const int r2 = lv(r), h2 = lv(hh), ln = lv(lane);
      wt_write(wl, a0, a1, r2, h2, 1.f); LDS_FENCE();
      bf16_t* d = QRY + (size_t)m0 * 2048 + n0; wt_store(wl, ln, d, 2048, d + 32, 2048);
    });
    __syncthreads();
    float* SC = (float*)lds; unsigned* TK = (unsigned*)(lds + LDS_TK);
    for (int rep3e = 0; rep3e < (probe == 7 ? 2 : 1); ++rep3e)
    for (int h = 0; h < 8; ++h) {
      block_gemm<2>(lds, QRY + h * 256, 2048, (const bf16_t*)(ws + WS_KD), 1, 256, [&](int m0, int n0, const f32x16& a0, const f32x16& a1) {
        const int r2 = lv(r), h2 = lv(hh);
        float* sp = SC + (m0 + 4 * h2) * SCW + n0 + r2;
#pragma unroll
        for (int reg = 0; reg < 16; ++reg) { const int ro = ((reg & 3) + 8 * (reg >> 2)) * SCW; sp[ro] = a0[reg]; sp[ro + 32] = a1[reg]; }
      });
      __syncthreads();
      {
        const int tid = lv(tid0);
        const int tt = tid >> 3, sd = (tid >> 2) & 1, q = tid & 3;
        const float* sr = SC + tt * SCW + sd * 128 + q * 32;
        float a[16], c[16];
#pragma unroll
        for (int i = 0; i < 4; ++i) { const float4 v = *(const float4*)(sr + i * 4); const unsigned ib = q * 32 + i * 4;
          a[i * 4 + 0] = __uint_as_float((__float_as_uint(v.x) & 0xFFFFFF80u) | (ib + 0)); a[i * 4 + 1] = __uint_as_float((__float_as_uint(v.y) & 0xFFFFFF80u) | (ib + 1));
          a[i * 4 + 2] = __uint_as_float((__float_as_uint(v.z) & 0xFFFFFF80u) | (ib + 2)); a[i * 4 + 3] = __uint_as_float((__float_as_uint(v.w) & 0xFFFFFF80u) | (ib + 3)); }
#pragma unroll
        for (int i = 0; i < 4; ++i) { const float4 v = *(const float4*)(sr + 16 + i * 4); const unsigned ib = q * 32 + 16 + i * 4;
          c[i * 4 + 0] = __uint_as_float((__float_as_uint(v.x) & 0xFFFFFF80u) | (ib + 0)); c[i * 4 + 1] = __uint_as_float((__float_as_uint(v.y) & 0xFFFFFF80u) | (ib + 1));
          c[i * 4 + 2] = __uint_as_float((__float_as_uint(v.z) & 0xFFFFFF80u) | (ib + 2)); c[i * 4 + 3] = __uint_as_float((__float_as_uint(v.w) & 0xFFFFFF80u) | (ib + 3)); }
        sort16_desc(a); sort16_desc(c); top16_merge(a, c);
#pragma unroll
        for (int i = 0; i < 16; ++i) c[i] = dpp_f<0xB1>(a[i]);
        top16_merge(a, c);
#pragma unroll
        for (int i = 0; i < 16; ++i) c[i] = dpp_f<0x4E>(a[i]);
        top16_merge(a, c);
        if (q == 0) { unsigned* tk = TK + ((tt * 8 + h) * 2 + sd) * 16;
#pragma unroll
          for (int i = 0; i < 4; ++i) *(uint4*)(tk + i * 4) = make_uint4(__float_as_uint(a[i * 4]), __float_as_uint(a[i * 4 + 1]), __float_as_uint(a[i * 4 + 2]), __float_as_uint(a[i * 4 + 3])); }
      }
      __syncthreads();
    }
    int* EIDX = (int*)lds; float* GATE = (float*)(lds + 32768);
    {
      const int tid = lv(tid0);
      const int tt = tid >> 3, h = tid & 7;
      const unsigned* t1 = TK + ((tt * 8 + h) * 2) * 16; const unsigned* t2 = t1 + 16;
      float v1[16], v2[16];
#pragma unroll
      for (int i = 0; i < 4; ++i) { const uint4 u = *(const uint4*)(t1 + i * 4), v = *(const uint4*)(t2 + i * 4);
        v1[i * 4] = __uint_as_float(u.x & 0xFFFFFF80u); v1[i * 4 + 1] = __uint_as_float(u.y & 0xFFFFFF80u); v1[i * 4 + 2] = __uint_as_float(u.z & 0xFFFFFF80u); v1[i * 4 + 3] = __uint_as_float(u.w & 0xFFFFFF80u);
        v2[i * 4] = __uint_as_float(v.x & 0xFFFFFF80u); v2[i * 4 + 1] = __uint_as_float(v.y & 0xFFFFFF80u); v2[i * 4 + 2] = __uint_as_float(v.z & 0xFFFFFF80u); v2[i * 4 + 3] = __uint_as_float(v.w & 0xFFFFFF80u); }
      float best[16], grp[16];
#define CAND(i, j) __uint_as_float((__float_as_uint(v1[i] + v2[j]) & 0xFFFFFF00u) | ((i) << 4) | (j))
      best[0] = CAND(0, 0); best[1] = CAND(0, 1); best[2] = CAND(0, 2); best[3] = CAND(0, 3); best[4] = CAND(0, 4); best[5] = CAND(0, 5); best[6] = CAND(0, 6); best[7] = CAND(0, 7);
      best[8] = CAND(0, 8); best[9] = CAND(0, 9); best[10] = CAND(0, 10); best[11] = CAND(0, 11); best[12] = CAND(0, 12); best[13] = CAND(0, 13); best[14] = CAND(0, 14); best[15] = CAND(0, 15);
      sort16_desc(best);
      grp[0] = CAND(1, 0); grp[1] = CAND(1, 1); grp[2] = CAND(1, 2); grp[3] = CAND(1, 3); grp[4] = CAND(1, 4); grp[5] = CAND(1, 5); grp[6] = CAND(1, 6); grp[7] = CAND(1, 7);
      grp[8] = CAND(2, 0); grp[9] = CAND(2, 1); grp[10] = CAND(2, 2); grp[11] = CAND(2, 3); grp[12] = CAND(2, 4); grp[13] = CAND(3, 0); grp[14] = CAND(3, 1); grp[15] = CAND(3, 2);
      sort16_desc(grp); top16_merge(best, grp);
      grp[0] = CAND(3, 3); grp[1] = CAND(4, 0); grp[2] = CAND(4, 1); grp[3] = CAND(4, 2); grp[4] = CAND(5, 0); grp[5] = CAND(5, 1); grp[6] = CAND(6, 0); grp[7] = CAND(6, 1);
      grp[8] = CAND(7, 0); grp[9] = CAND(7, 1); grp[10] = CAND(8, 0); grp[11] = CAND(9, 0); grp[12] = CAND(10, 0); grp[13] = CAND(11, 0); grp[14] = CAND(12, 0); grp[15] = CAND(13, 0);
      sort16_desc(grp); top16_merge(best, grp);
      { const float c14 = CAND(14, 0), c15 = CAND(15, 0);
        grp[0] = fmaxf(c14, c15); grp[1] = fminf(c14, c15);
#pragma unroll
        for (int i = 2; i < 16; ++i) grp[i] = -3.0e38f;
        top16_merge(best, grp); }
#undef CAND
      __syncthreads();
      float sv[16]; int ev[16]; float mx = -3.0e38f;
#pragma unroll
      for (int k = 0; k < 16; ++k) { const unsigned key = __float_as_uint(best[k]); const int ci = (key >> 4) & 15, cj = key & 15;
        const unsigned k1 = t1[ci], k2 = t2[cj];
        sv[k] = __uint_as_float(k1 & 0xFFFFFF80u) + __uint_as_float(k2 & 0xFFFFFF80u); ev[k] = (int)((k1 & 127u) * 128u + (k2 & 127u)); mx = fmaxf(mx, sv[k]); }
      float sum = 0.f;
#pragma unroll
      for (int k = 0; k < 16; ++k) { sv[k] = __expf(sv[k] - mx); sum += sv[k]; }
      const float inv = 1.f / sum;
#pragma unroll
      for (int k = 0; k < 16; ++k) { EIDX[tt * 128 + h * 16 + k] = ev[k]; GATE[tt * 128 + h * 16 + k] = sv[k] * inv; }
    }
    __syncthreads();
    {
      const int tid = lv(tid0), lane = tid & 63, w = tid >> 6;
      const unsigned char* EU = ws + WS_EU; const unsigned char* EV = ws + WS_EV; const float* SCU = (const float*)(ws + WS_ESC); const float* SCV = SCU + 16384;
      const float* gpf2 = launder(p.in[19]);
      typedef float f2v __attribute__((ext_vector_type(2)));
#define FP8X4(wd, o0, o1, o2, o3) do { const f2v lo_ = __builtin_amdgcn_cvt_pk_f32_fp8((int)(wd), false), hi_ = __builtin_amdgcn_cvt_pk_f32_fp8((int)(wd), true); o0 = lo_.x; o1 = lo_.y; o2 = hi_.x; o3 = hi_.y; } while (0)
#pragma unroll 1
      for (int pass = 0; pass < gather_reps; ++pass)
#pragma unroll 1
      for (int rr = 0; rr < 8; ++rr) { const int row = w * 8 + rr; const size_t tok = tok0 + row;
        float hf[16];
        { const uint4 hA = *(const uint4*)(H2 + (size_t)row * 1024 + lane * 16), hB = *(const uint4*)(H2 + (size_t)row * 1024 + lane * 16 + 8);
          hf[0] = __uint_as_float(hA.x << 16); hf[1] = __uint_as_float(hA.x & 0xffff0000u); hf[2] = __uint_as_float(hA.y << 16); hf[3] = __uint_as_float(hA.y & 0xffff0000u);
          hf[4] = __uint_as_float(hA.z << 16); hf[5] = __uint_as_float(hA.z & 0xffff0000u); hf[6] = __uint_as_float(hA.w << 16); hf[7] = __uint_as_float(hA.w & 0xffff0000u);
          hf[8] = __uint_as_float(hB.x << 16); hf[9] = __uint_as_float(hB.x & 0xffff0000u); hf[10] = __uint_as_float(hB.y << 16); hf[11] = __uint_as_float(hB.y & 0xffff0000u);
          hf[12] = __uint_as_float(hB.z << 16); hf[13] = __uint_as_float(hB.z & 0xffff0000u); hf[14] = __uint_as_float(hB.w << 16); hf[15] = __uint_as_float(hB.w & 0xffff0000u); }
        float acc[16];
#pragma unroll
        for (int i = 0; i < 16; ++i) acc[i] = 0.f;
#pragma unroll 1
        for (int g = 0; g < 16; ++g) {
          const int* ep = EIDX + row * 128 + g * 8;
          const int4 ea = *(const int4*)ep, eb = *(const int4*)(ep + 4);
          int es[8];
          es[0] = __builtin_amdgcn_readfirstlane(ea.x); es[1] = __builtin_amdgcn_readfirstlane(ea.y); es[2] = __builtin_amdgcn_readfirstlane(ea.z); es[3] = __builtin_amdgcn_readfirstlane(ea.w);
          es[4] = __builtin_amdgcn_readfirstlane(eb.x); es[5] = __builtin_amdgcn_readfirstlane(eb.y); es[6] = __builtin_amdgcn_readfirstlane(eb.z); es[7] = __builtin_amdgcn_readfirstlane(eb.w);
          uint4 u[8], v[8];
#pragma unroll
          for (int k2 = 0; k2 < 8; ++k2) u[k2] = *(const uint4*)(EU + (size_t)es[k2] * 1024 + lane * 16);
#pragma unroll
          for (int k2 = 0; k2 < 8; ++k2) v[k2] = *(const uint4*)(EV + (size_t)es[k2] * 1024 + lane * 16);
          const int eslot = ep[lane & 7];
          const float gte = GATE[row * 128 + g * 8 + (lane & 7)], su = SCU[eslot], sv = SCV[eslot];
          float P[8];
#pragma unroll
          for (int k2 = 0; k2 < 8; ++k2) { float a0, a1, a2, a3, d;
            FP8X4(u[k2].x, a0, a1, a2, a3); d = a0 * hf[0] + a1 * hf[1] + a2 * hf[2] + a3 * hf[3];
            FP8X4(u[k2].y, a0, a1, a2, a3); d += a0 * hf[4] + a1 * hf[5] + a2 * hf[6] + a3 * hf[7];
            FP8X4(u[k2].z, a0, a1, a2, a3); d += a0 * hf[8] + a1 * hf[9] + a2 * hf[10] + a3 * hf[11];
            FP8X4(u[k2].w, a0, a1, a2, a3); d += a0 * hf[12] + a1 * hf[13] + a2 * hf[14] + a3 * hf[15];
            P[k2] = d; }
          { const bool up4 = (lane & 4) != 0;
#pragma unroll
            for (int e = 0; e < 4; ++e) { const float keep = up4 ? P[e + 4] : P[e], send = up4 ? P[e] : P[e + 4]; P[e] = keep + __shfl_xor(send, 4); }
            const bool up2 = (lane & 2) != 0;
#pragma unroll
            for (int e = 0; e < 2; ++e) { const float keep = up2 ? P[e + 2] : P[e], send = up2 ? P[e] : P[e + 2]; P[e] = keep + dpp_f<0x4E>(send); }
            const bool up1 = (lane & 1) != 0;
            const float keep = up1 ? P[1] : P[0], send = up1 ? P[0] : P[1];
            float av = keep + dpp_f<0xB1>(send);
            av += __shfl_xor(av, 8); av += __shfl_xor(av, 16); av += __shfl_xor(av, 32);
            av *= su;
            const float ax = fabsf(av), t = __builtin_amdgcn_rcpf(ax * 0.2316418882f + 1.0f);
            float q = t * 0.5307027145f + (-0.7265760135f); q = q * t + 0.7107068705f; q = q * t + (-0.142248368f); q = q * t + 0.127414796f; q = q * t;
            const float ee = __builtin_amdgcn_exp2f(av * av * (-0.72134752044f));
            const float mm = av * (q * ee), gl = (av < 0.f) ? mm : (av - mm);
            P[0] = gte * gl * sv; }
#pragma unroll
          for (int k2 = 0; k2 < 8; ++k2) { const float wk = __int_as_float(__builtin_amdgcn_readlane(__float_as_int(P[0]), k2)); float a0, a1, a2, a3;
            FP8X4(v[k2].x, a0, a1, a2, a3); acc[0] += wk * a0; acc[1] += wk * a1; acc[2] += wk * a2; acc[3] += wk * a3;
            FP8X4(v[k2].y, a0, a1, a2, a3); acc[4] += wk * a0; acc[5] += wk * a1; acc[6] += wk * a2; acc[7] += wk * a3;
            FP8X4(v[k2].z, a0, a1, a2, a3); acc[8] += wk * a0; acc[9] += wk * a1; acc[10] += wk * a2; acc[11] += wk * a3;
            FP8X4(v[k2].w, a0, a1, a2, a3); acc[12] += wk * a0; acc[13] += wk * a1; acc[14] += wk * a2; acc[15] += wk * a3; }
        }
        float ss = 0.f;
#pragma unroll
        for (int i = 0; i < 16; ++i) ss += acc[i] * acc[i];
        ss = wave_sum(ss); const float rs = rsqrtf(ss * (1.f / 1024.f) + EPS);
        float* orow = outp + tok * 1024 + lane * 16;
        if (pass == gather_reps - 1)
#pragma unroll
        for (int i = 0; i < 4; ++i) { const int d = lane * 16 + 4 * i;
          float4 x1 = *(const float4*)(orow + 4 * i); const float4 g3 = *(const float4*)(gpf2 + d), g2 = *(const float4*)(modb + 5120 + d);
          x1.x += g3.x * g2.x * acc[4 * i] * rs; x1.y += g3.y * g2.y * acc[4 * i + 1] * rs; x1.z += g3.z * g2.z * acc[4 * i + 2] * rs; x1.w += g3.w * g2.w * acc[4 * i + 3] * rs;
          *(float4*)(orow + 4 * i) = x1; }
      }
#undef FP8X4
    }
  }
}

DI void phase2_scan(const KP& p) {
  unsigned char* ws = p.ws;
  for (int g = blockIdx.x * NTHR + threadIdx.x; g < 131072; g += gridDim.x * NTHR) {
    const int seq = g >> 11, within = g & 2047, dv = within >> 4, dk4 = (within & 15) * 4, dir = seq & 1;
    bf16_t* base = (bf16_t*)(ws + WS_SPT) + ((size_t)seq * 32 * 128 + dv) * 64 + dk4;
    const float* dec = (const float*)(ws + WS_DEC) + (size_t)seq * 32 * 64 + dk4;
    float s0 = 0.f, s1 = 0.f, s2 = 0.f, s3 = 0.f;
#pragma unroll 1
    for (int i0 = 0; i0 < 32; i0 += 8) {
      uint2 d[8]; float4 c[8];
#pragma unroll
      for (int j = 0; j < 8; ++j) { const int n = dir ? 31 - (i0 + j) : (i0 + j); d[j] = *(const uint2*)(base + (size_t)n * 8192); c[j] = *(const float4*)(dec + n * 64); }
#pragma unroll
      for (int j = 0; j < 8; ++j) { const int n = dir ? 31 - (i0 + j) : (i0 + j);
        uint2 o; o.x = pack2(s0, s1); o.y = pack2(s2, s3); *(uint2*)(base + (size_t)n * 8192) = o;
        s0 = c[j].x * s0 + __uint_as_float(d[j].x << 16); s1 = c[j].y * s1 + __uint_as_float(d[j].x & 0xffff0000u);
        s2 = c[j].z * s2 + __uint_as_float(d[j].y << 16); s3 = c[j].w * s3 + __uint_as_float(d[j].y & 0xffff0000u); }
    }
  }
}

#define XB_TMO      128
#define XB_XCNT(j)  (256  + 64 * (j))
#define XB_XSUB(j)  (1280 + 64 * (j))
#define XB_XGEN(j)  (2304 + 64 * (j))
#define XB_TOP      3328
#define XB_TOPGEN   3392
#define XCD_BAR_WORDS 3456
#define XB_SPIN_CAP (1u << 18)
#define LAS __attribute__((address_space(3)))

__device__ __forceinline__ unsigned xb_ld(unsigned* p)              { return __hip_atomic_load(p, __ATOMIC_RELAXED, __HIP_MEMORY_SCOPE_AGENT); }
__device__ __forceinline__ unsigned xb_add(unsigned* p, unsigned v) { return __hip_atomic_fetch_add(p, v, __ATOMIC_RELAXED, __HIP_MEMORY_SCOPE_AGENT); }
__device__ __forceinline__ unsigned xb_xcc_id() { return (unsigned)__builtin_amdgcn_s_getreg((3 << 11) | 20) & 0xFu; }
#define XB_SPIN(cond, bar) do { unsigned _sp = 0; while (cond) { __builtin_amdgcn_s_sleep(1); \
    if ((++_sp & 255u) == 0u) { if (xb_ld(&(bar)[XB_TMO])) break; if (_sp > XB_SPIN_CAP) { atomicAdd(&(bar)[XB_TMO], 1u); break; } } } } while (0)

struct XcdBarrier {
    unsigned* bar; unsigned x;
    volatile LAS unsigned* st;
};

__device__ __forceinline__ XcdBarrier xcd_barrier_post(unsigned* bar, volatile LAS unsigned* st) {
    XcdBarrier b; b.bar = bar; b.x = xb_xcc_id(); b.st = st;
    if (threadIdx.x == 0) (void)xb_add(&bar[XB_XCNT(b.x)], 1u);
    return b;
}
__device__ __forceinline__ void xcd_barrier_complete(unsigned* bar, unsigned x, unsigned& nloc, unsigned& nx) {
    const unsigned G = gridDim.x * gridDim.y * gridDim.z;
    unsigned sum, cnt, mine, sp = 0u;
    for (;;) {
        sum = 0u; cnt = 0u; mine = 0u;
#pragma unroll
        for (unsigned j = 0; j < 16; ++j) { const unsigned c = xb_ld(&bar[XB_XCNT(j)]); sum += c; cnt += (c > 0u) ? 1u : 0u; mine = (j == x) ? c : mine; }
        if (sum == G) break;
        __builtin_amdgcn_s_sleep(1);
        if ((++sp & 255u) == 0u) { if (xb_ld(&bar[XB_TMO])) break; if (sp > XB_SPIN_CAP) { atomicAdd(&bar[XB_TMO], 1u); break; } }
    }
    nloc = mine > 0u ? mine : 1u; nx = cnt > 0u ? cnt : 1u;
}

__device__ __forceinline__ void xcd_barrier(const XcdBarrier& b) {
    asm volatile("s_waitcnt vmcnt(0)" ::: "memory");
    __syncthreads();
    if (threadIdx.x == 0) {
        unsigned* bar = b.bar;
        __builtin_amdgcn_s_waitcnt(0);
        unsigned nloc = b.st[0], nx = b.st[1];
        if (nloc == 0u) { xcd_barrier_complete(bar, b.x, nloc, nx); b.st[0] = nloc; b.st[1] = nx; }
        const unsigned old = xb_add(&bar[XB_XSUB(b.x)], 1u);
        const unsigned gen = old / nloc;
        if (old + 1u == (gen + 1u) * nloc) {
            __builtin_amdgcn_fence(__ATOMIC_RELEASE, "agent");
            asm volatile("s_waitcnt vmcnt(0)" ::: "memory");
            const unsigned og = xb_add(&bar[XB_TOP], 1u);
            const unsigned tg = og / nx;
            if (og + 1u == (tg + 1u) * nx) xb_add(&bar[XB_TOPGEN], 1u);
            else XB_SPIN(xb_ld(&bar[XB_TOPGEN]) == tg, bar);
            __builtin_amdgcn_fence(__ATOMIC_ACQUIRE, "agent");
            xb_add(&bar[XB_XGEN(b.x)], 1u);
            asm volatile("s_waitcnt vmcnt(0)" ::: "memory");
        } else {
            XB_SPIN(xb_ld(&bar[XB_XGEN(b.x)]) == gen, bar);
            __builtin_amdgcn_fence(__ATOMIC_ACQUIRE, "agent");
            asm volatile("s_waitcnt vmcnt(0)" ::: "memory");
        }
    }
    __syncthreads();
}

#ifndef PROBE_ID
#define PROBE_ID 0
#endif
__global__ void __launch_bounds__(NTHR, 2) mega(KP p) {
  extern __shared__ __attribute__((aligned(16))) char lds[];
  cg::grid_group grid = cg::this_grid();
  const int hi = p.ph_hi; constexpr int probe = PROBE_ID;
  if (threadIdx.x == 0) { ((volatile LAS unsigned*)(lds + LDS_XB))[0] = 0u; ((volatile LAS unsigned*)(lds + LDS_XB))[1] = 0u; }
  __syncthreads();
  const XcdBarrier xb = xcd_barrier_post((unsigned*)(p.ws + WS_BAR), (volatile LAS unsigned*)(lds + LDS_XB));
  if (p.ph_lo <= 0 && 0 < hi) { phase0(p, lds); if (probe == 1) phase0(p, lds); if (1 < hi) { if (hi > 64) grid.sync(); else xcd_barrier(xb); } }
  if (p.ph_lo <= 1 && 1 < hi) { phase1(p, lds); if (probe == 2) phase1(p, lds); if (2 < hi) xcd_barrier(xb); }
  if (p.ph_lo <= 2 && 2 < hi) { phase2_scan(p); phase2_attn(p, lds); if (probe == 3) phase2_attn(p, lds); if (3 < hi) xcd_barrier(xb); }
  if (p.ph_lo <= 3 && 3 < hi) { phase3(p, lds, probe == 4 ? 2 : 1, probe); }
}

extern "C" void kernel_launch(void* const* d_in, const int* in_sizes, int n_in, void* d_out, int out_size, void* d_ws, size_t ws_size, hipStream_t stream) {
  float* out = (float*)d_out;
  unsigned char* ws = (unsigned char*)d_ws;
  if (ws_size < WS_END || n_in != 25) return;
  static bool attr_done = false;
  if (!attr_done) { (void)hipFuncSetAttribute((const void*)mega, hipFuncAttributeMaxDynamicSharedMemorySize, LDS_TOTAL); attr_done = true; }
  KP p{};
  for (int i = 0; i < 25; ++i) p.in[i] = (const float*)d_in[i];
  p.out = out; p.ws = ws;
  p.ph_lo = 0; p.ph_hi = 4;
  (void)hipMemsetAsync(ws + WS_BAR, 0, XCD_BAR_WORDS * 4, stream);
  { void* args[] = {&p}; (void)hipLaunchCooperativeKernel((const void*)mega, dim3(256), dim3(NTHR), args, LDS_TOTAL, stream); }
}
```

```cpp
#include <hip/hip_runtime.h>
#include <hip/hip_cooperative_groups.h>
namespace cg = cooperative_groups;
#include <stdint.h>

typedef unsigned short bf16_t;
#define DI __device__ __forceinline__

DI float bf2f(bf16_t v) { return __uint_as_float(((unsigned)v) << 16); }
DI bf16_t f2bf(float f) { return __builtin_bit_cast(unsigned short, (__bf16)f); }

constexpr int BATCH = 8, SEQ = 2048, DM = 1024, NTOK = BATCH * SEQ;
constexpr int INW = 2272;
constexpr float EPS = 1e-6f;
constexpr int O_CQ = 0, O_CKV = 384, O_KR = 640, O_QG = 704, O_KG = 960, O_VG = 1216, O_GF = 1728, O_GB = 1744, O_R = 1760;

DI float wave_sum(float v) {
#pragma unroll
  for (int o = 1; o < 64; o <<= 1) v += __shfl_xor(v, o);
  return v;
}
DI float wave_max(float v) {
#pragma unroll
  for (int o = 1; o < 64; o <<= 1) v = fmaxf(v, __shfl_xor(v, o));
  return v;
}
DI float block_sum256(float v, float* red) {
  v = wave_sum(v);
  __syncthreads();
  if ((threadIdx.x & 63) == 0) red[threadIdx.x >> 6] = v;
  __syncthreads();
  return red[0] + red[1] + red[2] + red[3];
}
DI float block_max256(float v, float* red) {
  v = wave_max(v);
  __syncthreads();
  if ((threadIdx.x & 63) == 0) red[threadIdx.x >> 6] = v;
  __syncthreads();
  return fmaxf(fmaxf(red[0], red[1]), fmaxf(red[2], red[3]));
}
DI float silu_f(float x) { return x / (1.f + expf(-x)); }
DI float logsigmoid_f(float x) { return fminf(x, 0.f) - log1pf(expf(-fabsf(x))); }
DI float fexp(float x) { return __builtin_amdgcn_exp2f(x * 1.4426950408889634f); }
DI float silu_fast(float x) { return x * __builtin_amdgcn_rcpf(1.f + fexp(-x)); }
DI float logsigmoid_fast(float x) { return fminf(x, 0.f) - __builtin_amdgcn_logf(1.f + fexp(-fabsf(x))) * 0.6931471805599453f; }
DI float gelu_erf(float x) { return 0.5f * x * (1.f + erff(x * 0.70710678118654752f)); }

__global__ __launch_bounds__(256) void n_mod(const float* __restrict__ c, const float* __restrict__ w_ada, const float* __restrict__ b_ada, float* __restrict__ mod) {
  int idx = blockIdx.x * 256 + threadIdx.x;
  int b = idx / 6144, j = idx % 6144;
  float acc = b_ada[j];
  for (int k = 0; k < 1024; ++k) acc += silu_f(c[b * 1024 + k]) * w_ada[(size_t)k * 6144 + j];
  mod[idx] = acc;
}

__global__ __launch_bounds__(256) void n_hnorm(const float* __restrict__ x, const float* __restrict__ g, const float* __restrict__ mod, int b, int off_sh, int off_sc, float* __restrict__ h) {
  __shared__ float red[4];
  int t = blockIdx.x, tid = threadIdx.x;
  const float* xr = x + ((size_t)b * SEQ + t) * DM;
  float v[4]; float ss = 0.f;
#pragma unroll
  for (int i = 0; i < 4; ++i) { v[i] = xr[tid + 256 * i]; ss += v[i] * v[i]; }
  ss = block_sum256(ss, red);
  float rs = rsqrtf(ss * (1.f / DM) + EPS);
#pragma unroll
  for (int i = 0; i < 4; ++i) { int d = tid + 256 * i; h[(size_t)t * DM + d] = v[i] * rs * g[d] * (1.f + mod[b * 6144 + off_sc + d]) + mod[b * 6144 + off_sh + d]; }
}

template <bool BT>
__global__ __launch_bounds__(256) void n_gemm(const float* __restrict__ A, int lda, const float* __restrict__ B, int ldb, float* __restrict__ C, int ldc, int M, int N, int K) {
  __shared__ float As[16][65];
  __shared__ float Bs[16][65];
  const int tid = threadIdx.x, tx = tid & 15, ty = tid >> 4;
  const int m0 = blockIdx.y * 64, n0 = blockIdx.x * 64;
  float acc[4][4];
#pragma unroll
  for (int i = 0; i < 4; ++i)
#pragma unroll
    for (int j = 0; j < 4; ++j) acc[i][j] = 0.f;
  for (int k0 = 0; k0 < K; k0 += 16) {
#pragma unroll
    for (int i = 0; i < 4; ++i) { int e = tid + 256 * i; int m = e >> 4, k = e & 15; As[k][m] = A[(size_t)(m0 + m) * lda + k0 + k]; }
#pragma unroll
    for (int i = 0; i < 4; ++i) { int e = tid + 256 * i;
      if (!BT) { int k = e >> 6, n = e & 63; Bs[k][n] = (n0 + n < N) ? B[(size_t)(k0 + k) * ldb + n0 + n] : 0.f; }
      else     { int n = e >> 4, k = e & 15; Bs[k][n] = (n0 + n < N) ? B[(size_t)(n0 + n) * ldb + k0 + k] : 0.f; } }
    __syncthreads();
#pragma unroll
    for (int k = 0; k < 16; ++k) {
      float a[4], bb[4];
#pragma unroll
      for (int i = 0; i < 4; ++i) { a[i] = As[k][ty * 4 + i]; bb[i] = Bs[k][tx * 4 + i]; }
#pragma unroll
      for (int i = 0; i < 4; ++i)
#pragma unroll
        for (int j = 0; j < 4; ++j) acc[i][j] += a[i] * bb[j];
    }
    __syncthreads();
  }
#pragma unroll
  for (int i = 0; i < 4; ++i)
#pragma unroll
    for (int j = 0; j < 4; ++j) { int n = n0 + tx * 4 + j; if (n < N) C[(size_t)(m0 + ty * 4 + i) * ldc + n] = acc[i][j]; }
}

__global__ __launch_bounds__(256) void n_rms_slice(const float* __restrict__ in, int ldin, int off, int W, const float* __restrict__ g, float* __restrict__ out) {
  __shared__ float red[4];
  int t = blockIdx.x, tid = threadIdx.x;
  float v0 = (tid < W) ? in[(size_t)t * ldin + off + tid] : 0.f;
  float v1 = (tid + 256 < W) ? in[(size_t)t * ldin + off + tid + 256] : 0.f;
  float ss = block_sum256(v0 * v0 + v1 * v1, red);
  float rs = rsqrtf(ss / (float)W + EPS);
  if (tid < W) out[(size_t)t * W + tid] = v0 * rs * g[tid];
  if (tid + 256 < W) out[(size_t)t * W + tid + 256] = v1 * rs * g[tid + 256];
}

__global__ __launch_bounds__(256) void n_scatter(const float* __restrict__ proj, const float* __restrict__ qa, const float* __restrict__ kv, const int* __restrict__ positions, int b,
                                                 const float* __restrict__ wgf, const float* __restrict__ bgf, const float* __restrict__ wgb, const float* __restrict__ bgb,
                                                 bf16_t* __restrict__ Qm, bf16_t* __restrict__ Km, bf16_t* __restrict__ Vm, bf16_t* __restrict__ qg, bf16_t* __restrict__ kg, bf16_t* __restrict__ vg,
                                                 bf16_t* __restrict__ rg, float* __restrict__ laf, float* __restrict__ lab) {
  __shared__ float cs[32], sn[32];
  const int t = blockIdx.x, tid = threadIdx.x;
  const size_t tok = (size_t)b * SEQ + t;
  const float* pr = proj + (size_t)t * INW;
  const float* qr = qa + (size_t)t * 768;
  const float* kr = kv + (size_t)t * 1024;
  if (tid < 32) {
    float inv = powf(10000.f, -(float)tid / 32.f);
    float ang = (float)positions[tok] * inv;
    cs[tid] = cosf(ang); sn[tid] = sinf(ang);
  }
  __syncthreads();
  for (int e = tid; e < 4 * 192; e += 256) {
    int h = e / 192, d = e % 192; float v;
    if (d < 128) v = qr[h * 192 + d];
    else { int j = d - 128; const float* rp = qr + h * 192 + 128;
      if (j < 32) v = rp[j] * cs[j] - rp[j + 32] * sn[j]; else v = rp[j] * cs[j - 32] + rp[j - 32] * sn[j - 32]; }
    Qm[(((size_t)b * 4 + h) * SEQ + t) * 192 + d] = f2bf(v);
  }
  for (int e = tid; e < 4 * 192; e += 256) {
    int h = e / 192, d = e % 192; float v;
    if (d < 128) v = kr[h * 256 + d];
    else { int j = d - 128; const float* rp = pr + O_KR;
      if (j < 32) v = rp[j] * cs[j] - rp[j + 32] * sn[j]; else v = rp[j] * cs[j - 32] + rp[j - 32] * sn[j - 32]; }
    Km[(((size_t)b * 4 + h) * SEQ + t) * 192 + d] = f2bf(v);
  }
  for (int e = tid; e < 512; e += 256) { int h = e >> 7, d = e & 127; Vm[(((size_t)b * 4 + h) * SEQ + t) * 128 + d] = f2bf(kr[h * 256 + 128 + d]); }
  { int e = tid; qg[tok * 256 + e] = f2bf(pr[O_QG + e] * 0.125f); kg[tok * 256 + e] = f2bf(pr[O_KG + e]); }
  for (int e = tid; e < 512; e += 256) { vg[tok * 512 + e] = f2bf(pr[O_VG + e]); rg[tok * 512 + e] = f2bf(pr[O_R + e]); }
  { int cidx = tid; float af = bgf[cidx], ab = bgb[cidx];
#pragma unroll
    for (int r = 0; r < 16; ++r) { af += pr[O_GF + r] * wgf[r * 256 + cidx]; ab += pr[O_GB + r] * wgb[r * 256 + cidx]; }
    laf[tok * 256 + cidx] = logsigmoid_f(af) * (1.f / 16.f); lab[tok * 256 + cidx] = logsigmoid_f(ab) * (1.f / 16.f); }
}

__global__ __launch_bounds__(256) void n_attn(const bf16_t* __restrict__ Qm, const bf16_t* __restrict__ Km, const bf16_t* __restrict__ Vm, bf16_t* __restrict__ omla) {
  __shared__ float qs[192]; __shared__ float sc[2048]; __shared__ float red[4];
  const int i = blockIdx.x, h = blockIdx.y, b = blockIdx.z, tid = threadIdx.x;
  const size_t bh = (size_t)b * 4 + h;
  if (tid < 192) qs[tid] = bf2f(Qm[(bh * SEQ + i) * 192 + tid]);
  __syncthreads();
  float mx = -1e30f;
  for (int kk = 0; kk < 8; ++kk) {
    int key = tid + 256 * kk; const uint4* kr = (const uint4*)(Km + (bh * SEQ + key) * 192);
    float s = 0.f;
    for (int c = 0; c < 24; ++c) { uint4 w = kr[c]; const float* q = qs + c * 8;
      s += q[0] * __uint_as_float(w.x << 16) + q[1] * __uint_as_float(w.x & 0xffff0000u) + q[2] * __uint_as_float(w.y << 16) + q[3] * __uint_as_float(w.y & 0xffff0000u)
         + q[4] * __uint_as_float(w.z << 16) + q[5] * __uint_as_float(w.z & 0xffff0000u) + q[6] * __uint_as_float(w.w << 16) + q[7] * __uint_as_float(w.w & 0xffff0000u); }
    s *= 0.07216878364870322f; sc[key] = s; mx = fmaxf(mx, s);
  }
  mx = block_max256(mx, red);
  float sum = 0.f;
  for (int kk = 0; kk < 8; ++kk) { int key = tid + 256 * kk; float p = expf(sc[key] - mx); sc[key] = p; sum += p; }
  sum = block_sum256(sum, red);
  __syncthreads();
  if (tid < 128) { float o = 0.f; const bf16_t* vp = Vm + bh * SEQ * 128 + tid;
    for (int key = 0; key < SEQ; ++key) o += sc[key] * bf2f(vp[(size_t)key * 128]);
    omla[((size_t)b * SEQ + i) * 512 + h * 128 + tid] = f2bf(o / sum); }
}

__global__ __launch_bounds__(128) void n_gla(const bf16_t* __restrict__ qg, const bf16_t* __restrict__ kg, const bf16_t* __restrict__ vg, const bf16_t* __restrict__ laf, const bf16_t* __restrict__ lab, float* __restrict__ og) {
  __shared__ float qs[64], ks[64], as[64];
  const int bh = blockIdx.x, b = bh >> 2, h = bh & 3, dv = threadIdx.x;
  for (int dir = 0; dir < 2; ++dir) {
    float S[64];
#pragma unroll
    for (int d = 0; d < 64; ++d) S[d] = 0.f;
    const bf16_t* la = dir ? lab : laf;
    for (int s = 0; s < SEQ; ++s) {
      const int t = dir ? (SEQ - 1 - s) : s; const size_t tok = (size_t)b * SEQ + t;
      __syncthreads();
      if (dv < 64) { qs[dv] = bf2f(qg[tok * 256 + h * 64 + dv]); ks[dv] = bf2f(kg[tok * 256 + h * 64 + dv]); as[dv] = expf(bf2f(la[tok * 256 + h * 64 + dv])); }
      __syncthreads();
      const float v = bf2f(vg[tok * 512 + h * 128 + dv]); float o = 0.f;
#pragma unroll
      for (int d = 0; d < 64; ++d) { S[d] = as[d] * S[d] + ks[d] * v; o += qs[d] * S[d]; }
      if (dir == 0) og[tok * 512 + h * 128 + dv] = o; else og[tok * 512 + h * 128 + dv] += o;
    }
  }
}

__global__ __launch_bounds__(256) void n_mix(const bf16_t* __restrict__ omla, const float* __restrict__ og, const bf16_t* __restrict__ rg, const float* __restrict__ g_gla, int b, float* __restrict__ mix) {
  __shared__ float ssum[4];
  const int t = blockIdx.x, tid = threadIdx.x; const size_t tok = (size_t)b * SEQ + t;
  if (tid < 4) ssum[tid] = 0.f;
  __syncthreads();
  float v[2];
#pragma unroll
  for (int i = 0; i < 2; ++i) { int e = tid + 256 * i; v[i] = og[tok * 512 + e]; atomicAdd(&ssum[e >> 7], v[i] * v[i]); mix[(size_t)t * DM + e] = bf2f(omla[tok * 512 + e]); }
  __syncthreads();
#pragma unroll
  for (int i = 0; i < 2; ++i) { int e = tid + 256 * i; float rs = rsqrtf(ssum[e >> 7] * (1.f / 128.f) + EPS);
    mix[(size_t)t * DM + 512 + e] = v[i] * rs * g_gla[e & 127] * silu_f(bf2f(rg[tok * 512 + e])); }
}

__global__ __launch_bounds__(256) void n_post1(const float* __restrict__ x, const float* __restrict__ y, const float* __restrict__ g_post, const float* __restrict__ g_pre2, const float* __restrict__ mod, int b,
                                               float* __restrict__ out, float* __restrict__ h2) {
  __shared__ float red[4];
  const int t = blockIdx.x, tid = threadIdx.x; const size_t tok = (size_t)b * SEQ + t;
  float yv[4], xv[4]; float ss = 0.f;
#pragma unroll
  for (int i = 0; i < 4; ++i) { yv[i] = y[(size_t)t * DM + tid + 256 * i]; ss += yv[i] * yv[i]; }
  ss = block_sum256(ss, red);
  float rs = rsqrtf(ss * (1.f / DM) + EPS); float s2 = 0.f;
#pragma unroll
  for (int i = 0; i < 4; ++i) { int d = tid + 256 * i; xv[i] = x[tok * DM + d] + mod[b * 6144 + 2048 + d] * (yv[i] * rs * g_post[d]); out[tok * DM + d] = xv[i]; s2 += xv[i] * xv[i]; }
  s2 = block_sum256(s2, red);
  float r2 = rsqrtf(s2 * (1.f / DM) + EPS);
#pragma unroll
  for (int i = 0; i < 4; ++i) { int d = tid + 256 * i; h2[(size_t)t * DM + d] = xv[i] * r2 * g_pre2[d] * (1.f + mod[b * 6144 + 4096 + d]) + mod[b * 6144 + 3072 + d]; }
}

DI void wave_argmax(float& v, int& i) {
#pragma unroll
  for (int o = 1; o < 64; o <<= 1) { float ov = __shfl_xor(v, o); int oi = __shfl_xor(i, o); if (ov > v || (ov == v && oi < i)) { v = ov; i = oi; } }
}
__global__ __launch_bounds__(256) void n_peer_select(const float* __restrict__ qry, const float* __restrict__ sk1, const float* __restrict__ sk2, int* __restrict__ eidx, float* __restrict__ gate) {
  __shared__ float v1s[4][16], v2s[4][16]; __shared__ int i1s[4][16], i2s[4][16];
  const int w = threadIdx.x >> 6, lane = threadIdx.x & 63;
  const int pair = blockIdx.x * 4 + w;
  const int t = pair >> 3, h = pair & 7;
  const float* q1 = qry + (size_t)t * 2048 + h * 256; const float* q2 = q1 + 128;
  float s1a = 0.f, s1b = 0.f, s2a = 0.f, s2b = 0.f;
  for (int d = 0; d < 128; ++d) { float a = q1[d], bq = q2[d];
    s1a += a * sk1[lane * 128 + d]; s1b += a * sk1[(lane + 64) * 128 + d]; s2a += bq * sk2[lane * 128 + d]; s2b += bq * sk2[(lane + 64) * 128 + d]; }
  for (int side = 0; side < 2; ++side) {
    float va = side ? s2a : s1a, vb = side ? s2b : s1b; bool ta = false, tb = false;
    for (int k = 0; k < 16; ++k) {
      float bv; int bi;
      if (!ta && (tb || va >= vb)) { bv = va; bi = lane; } else if (!tb) { bv = vb; bi = lane + 64; } else { bv = -3e38f; bi = 1 << 20; }
      wave_argmax(bv, bi);
      if (bi == lane) ta = true; if (bi == lane + 64) tb = true;
      if (lane == 0) { if (side) { v2s[w][k] = bv; i2s[w][k] = bi; } else { v1s[w][k] = bv; i1s[w][k] = bi; } }
    }
  }
  __syncthreads();
  float cv[4]; bool tk[4];
#pragma unroll
  for (int j = 0; j < 4; ++j) { int c = lane + 64 * j; cv[j] = v1s[w][c >> 4] + v2s[w][c & 15]; tk[j] = false; }
  float topv = 0.f; int topc = 0; float mx = 0.f;
  for (int k = 0; k < 16; ++k) {
    float bv = -3e38f; int bi = 1 << 20;
#pragma unroll
    for (int j = 0; j < 4; ++j) { if (!tk[j] && cv[j] > bv) { bv = cv[j]; bi = lane + 64 * j; } }
    wave_argmax(bv, bi);
#pragma unroll
    for (int j = 0; j < 4; ++j) if (bi == lane + 64 * j) tk[j] = true;
    if (k == 0) mx = bv;
    if (lane == k) { topv = bv; topc = bi; }
  }
  float e = (lane < 16) ? expf(topv - mx) : 0.f;
  float sum = wave_sum(e);
  if (lane < 16) { eidx[(size_t)pair * 16 + lane] = i1s[w][topc >> 4] * 128 + i2s[w][topc & 15]; gate[(size_t)pair * 16 + lane] = e / sum; }
}

__global__ __launch_bounds__(256) void n_peer_apply(const float* __restrict__ h2, const int* __restrict__ eidx, const float* __restrict__ gate, const float* __restrict__ eu, const float* __restrict__ ev,
                                                    const float* __restrict__ g_post, const float* __restrict__ mod, int b, float* __restrict__ out) {
  __shared__ float ys[4][1024]; __shared__ float red[4];
  const int t = blockIdx.x, tid = threadIdx.x, w = tid >> 6, lane = tid & 63; const size_t tok = (size_t)b * SEQ + t;
  float4 hx[4];
#pragma unroll
  for (int i = 0; i < 4; ++i) hx[i] = *(const float4*)(h2 + (size_t)t * DM + (lane + 64 * i) * 4);
  float4 acc[4];
#pragma unroll
  for (int i = 0; i < 4; ++i) acc[i] = make_float4(0.f, 0.f, 0.f, 0.f);
  for (int k = w; k < 128; k += 4) {
    const int e = eidx[(size_t)t * 128 + k]; const float gt = gate[(size_t)t * 128 + k];
    const float4* ur = (const float4*)(eu + (size_t)e * DM); const float4* vr = (const float4*)(ev + (size_t)e * DM);
    float d = 0.f;
#pragma unroll
    for (int i = 0; i < 4; ++i) { float4 u = ur[lane + 64 * i]; d += u.x * hx[i].x + u.y * hx[i].y + u.z * hx[i].z + u.w * hx[i].w; }
    d = wave_sum(d);
    const float wgt = gt * gelu_erf(d);
#pragma unroll
    for (int i = 0; i < 4; ++i) { float4 v = vr[lane + 64 * i]; acc[i].x += wgt * v.x; acc[i].y += wgt * v.y; acc[i].z += wgt * v.z; acc[i].w += wgt * v.w; }
  }
#pragma unroll
  for (int i = 0; i < 4; ++i) *(float4*)(&ys[w][(lane + 64 * i) * 4]) = acc[i];
  __syncthreads();
  float yv[4]; float ss = 0.f;
#pragma unroll
  for (int i = 0; i < 4; ++i) { int d = tid + 256 * i; yv[i] = ys[0][d] + ys[1][d] + ys[2][d] + ys[3][d]; ss += yv[i] * yv[i]; }
  ss = block_sum256(ss, red);
  const float rs = rsqrtf(ss * (1.f / DM) + EPS);
#pragma unroll
  for (int i = 0; i < 4; ++i) { int d = tid + 256 * i; out[tok * DM + d] = out[tok * DM + d] + mod[b * 6144 + 5120 + d] * (yv[i] * rs * g_post[d]); }
}

typedef short bf16x8 __attribute__((ext_vector_type(8)));
typedef float f32x16 __attribute__((ext_vector_type(16)));
#define MFMA32(a, b, c) __builtin_amdgcn_mfma_f32_32x32x16_bf16((a), (b), (c), 0, 0, 0)

constexpr int NTHR = 512;
constexpr size_t MiB = 1024 * 1024;
constexpr size_t WS_MOD   = 0;
constexpr size_t WS_WTIN  = 256 * 1024;
constexpr size_t WS_WTQUP = WS_WTIN + (size_t)2304 * 1024 * 2;
constexpr size_t WS_WTKVUP = WS_WTQUP + (size_t)768 * 384 * 2;
constexpr size_t WS_WTOUT = WS_WTKVUP + (size_t)1024 * 256 * 2;
constexpr size_t WS_WTPQ  = WS_WTOUT + (size_t)1024 * 1024 * 2;
constexpr size_t WS_KD    = WS_WTPQ + (size_t)2048 * 1024 * 2;
constexpr size_t WS_DEC   = WS_KD + (size_t)256 * 256 * 2;
constexpr size_t WS_ESC   = WS_DEC + (size_t)2048 * 64 * 4;
constexpr size_t WS_R0END = WS_ESC + (size_t)2 * 16384 * 4;
static_assert(WS_R0END <= 13 * MiB, "R0");
constexpr size_t WS_BAR  = 13 * MiB - 65536;
static_assert(WS_R0END + 131072 <= WS_BAR, "R0 room");
constexpr size_t WS_QM   = 13 * MiB;
constexpr size_t WS_KM   = WS_QM + 24 * MiB;
constexpr size_t WS_VM   = WS_KM + 24 * MiB;
constexpr size_t WS_P1S  = WS_VM + 16 * MiB;
constexpr size_t WS_RG   = WS_P1S + 32 * MiB;
constexpr size_t WS_OINTRA = WS_RG + 16 * MiB;
constexpr size_t WS_QDEC = WS_OINTRA + 16 * MiB;
constexpr size_t WS_SPT  = WS_QDEC + 16 * MiB;
constexpr size_t WS_EU   = WS_SPT + 32 * MiB;
constexpr size_t WS_EV   = WS_EU + 16 * MiB;
constexpr size_t WS_WTPQP = WS_EV + 16 * MiB;
constexpr size_t WS_END  = WS_WTPQP + 4 * MiB;
static_assert(WS_P1S == WS_QM + 64 * MiB, "P3 QRY scratch aliases QM..VM");
constexpr size_t OUT_HS  = 0;
constexpr size_t OUT_CQ  = 32 * MiB;
constexpr size_t OUT_GR  = 52 * MiB;

struct KP { const float* in[25]; float* out; unsigned char* ws; int ph_lo, ph_hi; };

constexpr int G_STG = 40960;
constexpr int LDS_WT = 3 * G_STG;
constexpr int LDS_TAB = LDS_WT + 18432;
constexpr int LDS_XB = 157696;
constexpr int LDS_TOTAL = 157696 + 16;

typedef float f32x2_t __attribute__((ext_vector_type(2)));
typedef __bf16 bf16x2_t __attribute__((ext_vector_type(2)));
DI unsigned pack2(float lo, float hi) { const f32x2_t v = {lo, hi}; return __builtin_bit_cast(unsigned, __builtin_convertvector(v, bf16x2_t)); }
DI int crow(int reg, int hh) { return (reg & 3) + 8 * (reg >> 2) + 4 * hh; }

#define GLDS16(gp, lp) __builtin_amdgcn_global_load_lds((const unsigned*)(gp), (__attribute__((address_space(3))) unsigned*)(lp), 16, 0, 0)
template <int NST, class Epi>
DI void block_gemm(char* lds, const bf16_t* A, int lda, const bf16_t* Bt, int nchunks, int K, Epi&& epi) {
  const int tid = threadIdx.x, lane = tid & 63, w = __builtin_amdgcn_readfirstlane(tid >> 6), r = lane & 31, hh = lane >> 5;
  const int nk = K >> 6, T = nchunks * nk;
  constexpr int D = NST - 1;
  if (w >= 4) {
    const int j = w - 4, rin = lane >> 3, sw = ((lane & 7) ^ rin) * 8;
    const bf16_t* Ap = A + (size_t)(16 * j + rin) * lda + sw;
    const bf16_t* Bp = Bt + (size_t)(64 * j + rin) * 64 + sw;
    auto dma = [&](int g) {
      const int ch = g / nk, t = g - ch * nk; char* st = lds + (g % NST) * G_STG;
      const bf16_t* a0 = Ap + t * 64; char* la = st + (2 * j) * 1024;
      GLDS16(a0, la); GLDS16(a0 + (size_t)8 * lda, la + 1024);
      const bf16_t* b0 = Bp + (size_t)g * 16384; char* lb = st + 8192 + (8 * j) * 1024;
#pragma unroll
      for (int i = 0; i < 8; ++i) GLDS16(b0 + i * 512, lb + i * 1024);
    };
#pragma unroll
    for (int g = 0; g < D; ++g) if (g < T) dma(g);
    if (D >= 2 && T >= 2) asm volatile("s_waitcnt vmcnt(10)" ::: "memory"); else asm volatile("s_waitcnt vmcnt(0)" ::: "memory");
    __builtin_amdgcn_s_barrier();
#pragma unroll 1
    for (int g = 0; g < T; ++g) {
      if (g + D < T) { dma(g + D); if (D >= 2) asm volatile("s_waitcnt vmcnt(10)" ::: "memory"); else asm volatile("s_waitcnt vmcnt(0)" ::: "memory"); }
      else asm volatile("s_waitcnt vmcnt(0)" ::: "memory");
      __builtin_amdgcn_s_barrier();
    }
  } else {
    const int x = r & 7;
    const int o0 = ((0 + hh) ^ x) * 16, o1 = ((2 + hh) ^ x) * 16, o2 = ((4 + hh) ^ x) * 16, o3 = ((6 + hh) ^ x) * 16;
    const int a_rd = r * 128, b_rd = 8192 + (w * 64 + r) * 128;
    __builtin_amdgcn_s_barrier();
    int g = 0;
#pragma unroll 1
    for (int ch = 0; ch < nchunks; ++ch) {
      f32x16 c00, c01, c10, c11;
#pragma unroll
      for (int i = 0; i < 16; ++i) { c00[i] = 0.f; c01[i] = 0.f; c10[i] = 0.f; c11[i] = 0.f; }
#pragma unroll 1
      for (int t = 0; t < nk; ++t, ++g) {
        const char* cur = lds + (g % NST) * G_STG;
        bf16x8 fa0[4], fa1[4], fb0[4], fb1[4];
#define FRD(s_, o_) do { fa0[s_] = *(const bf16x8*)(cur + a_rd + o_); fb0[s_] = *(const bf16x8*)(cur + b_rd + o_); fb1[s_] = *(const bf16x8*)(cur + b_rd + 4096 + o_); fa1[s_] = *(const bf16x8*)(cur + a_rd + 4096 + o_); } while (0)
        FRD(0, o0); FRD(1, o1); FRD(2, o2); FRD(3, o3);
#undef FRD
        asm volatile("s_waitcnt lgkmcnt(0)" ::: "memory");
        __builtin_amdgcn_s_barrier();
        __builtin_amdgcn_sched_barrier(0);
#pragma unroll
        for (int s = 0; s < 4; ++s) {
          c00 = MFMA32(fa0[s], fb0[s], c00); c01 = MFMA32(fa0[s], fb1[s], c01); c10 = MFMA32(fa1[s], fb0[s], c10); c11 = MFMA32(fa1[s], fb1[s], c11); }
      }
      epi(0, ch * 256 + w * 64, c00, c01);
      epi(32, ch * 256 + w * 64, c10, c11);
    }
  }
}

DI void p0_transpose(char* lds, const float* __restrict__ W, int K, int N, bf16_t* __restrict__ Wt, int item, bf16_t* __restrict__ Wplain = nullptr) {
  float* s = (float*)lds;
  const int tid = threadIdx.x;
  const int ntn = (N + 63) >> 6, kt = item / ntn, nt = item % ntn, k0 = kt * 64, n0 = nt * 64;
  __syncthreads();
#pragma unroll
  for (int i = 0; i < 8; ++i) { int e = tid + 512 * i; int kk = e >> 6, nn = e & 63; s[kk * 65 + nn] = (n0 + nn < N) ? W[(size_t)(k0 + kk) * N + n0 + nn] : 0.f; }
  __syncthreads();
  const int nn = tid >> 3, part = tid & 7;
  const float* sp = s + (part * 8) * 65 + nn;
  uint4 o; o.x = pack2(sp[0], sp[65]); o.y = pack2(sp[2 * 65], sp[3 * 65]); o.z = pack2(sp[4 * 65], sp[5 * 65]); o.w = pack2(sp[6 * 65], sp[7 * 65]);
  { const int n = n0 + nn; *(uint4*)(Wt + ((size_t)((n >> 8) * (K >> 6) + kt)) * 16384 + (n & 255) * 64 + part * 8) = o; }
  if (Wplain) *(uint4*)(Wplain + (size_t)(n0 + nn) * K + k0 + part * 8) = o;
}

DI void phase0(const KP& p, char* lds) {
  const int tid = threadIdx.x, bid = blockIdx.x, nb = gridDim.x;
  unsigned char* ws = p.ws;
  constexpr int I_IN = 16 * 36, I_QUP = 6 * 12, I_KVUP = 4 * 16, I_OUT = 16 * 16, I_PQ = 16 * 32;
  constexpr int I_ALL = I_IN + I_QUP + I_KVUP + I_OUT + I_PQ;
  for (int it = bid; it < I_ALL; it += nb) {
    int q = it;
    if (q < I_IN) { p0_transpose(lds, p.in[7], 1024, 2272, (bf16_t*)(ws + WS_WTIN), q); continue; } q -= I_IN;
    if (q < I_QUP) { p0_transpose(lds, p.in[9], 384, 768, (bf16_t*)(ws + WS_WTQUP), q); continue; } q -= I_QUP;
    if (q < I_KVUP) { p0_transpose(lds, p.in[11], 256, 1024, (bf16_t*)(ws + WS_WTKVUP), q); continue; } q -= I_KVUP;
    if (q < I_OUT) { p0_transpose(lds, p.in[17], 1024, 1024, (bf16_t*)(ws + WS_WTOUT), q); continue; } q -= I_OUT;
    p0_transpose(lds, p.in[20], 1024, 2048, (bf16_t*)(ws + WS_WTPQ), q, (bf16_t*)(ws + WS_WTPQP));
  }
  { bf16_t* kd = (bf16_t*)(ws + WS_KD);
    for (int e = bid * NTHR + tid; e < 65536; e += nb * NTHR) { int n = e >> 8, k = e & 255; float v = 0.f;
      if (n < 128 && k < 128) v = p.in[21][n * 128 + k]; else if (n >= 128 && k >= 128) v = p.in[22][(n - 128) * 128 + (k - 128)];
      kd[(size_t)(k >> 6) * 16384 + n * 64 + (k & 63)] = f2bf(v); } }
  { const int lane = tid & 63; float* scl = (float*)(ws + WS_ESC);
    for (int row = bid * 8 + (tid >> 6); row < 32768; row += nb * 8) { const int t = row >> 14, e = row & 16383;
      const float* src = p.in[23 + t] + (size_t)e * 1024 + lane * 16;
      float4 x[4]; float am = 0.f;
#pragma unroll
      for (int i = 0; i < 4; ++i) { x[i] = *(const float4*)(src + 4 * i); am = fmaxf(am, fmaxf(fmaxf(fabsf(x[i].x), fabsf(x[i].y)), fmaxf(fabsf(x[i].z), fabsf(x[i].w)))); }
      am = wave_max(am);
      float sc = 1.f, isc = 1.f;
      if (am > 0.f) { int ex; (void)frexpf(448.f / am, &ex); sc = ldexpf(1.f, ex - 1); isc = ldexpf(1.f, 1 - ex); }
      unsigned wv[4];
#pragma unroll
      for (int i = 0; i < 4; ++i) { int q = __builtin_amdgcn_cvt_pk_fp8_f32(x[i].x * sc, x[i].y * sc, 0, false); q = __builtin_amdgcn_cvt_pk_fp8_f32(x[i].z * sc, x[i].w * sc, q, true); wv[i] = (unsigned)q; }
      *(uint4*)(ws + (t ? WS_EV : WS_EU) + (size_t)e * 1024 + lane * 16) = make_uint4(wv[0], wv[1], wv[2], wv[3]);
      if (lane == 0) scl[t * 16384 + e] = isc; } }
  for (int jb = bid; jb < 96; jb += nb) {
    __syncthreads();
    float* cact = (float*)lds;
    float* red = (float*)(lds + 32768);
    for (int e = tid; e < 8192; e += NTHR) cact[e] = silu_f(p.in[1][e]);
    __syncthreads();
    const int jj = tid & 63, ks = tid >> 6, j0 = jb * 64;
    float acc[8];
#pragma unroll
    for (int b = 0; b < 8; ++b) acc[b] = 0.f;
    const float* wp = p.in[3] + (size_t)(ks * 128) * 6144 + j0 + jj;
    for (int k = 0; k < 128; ++k) { const float wv = wp[(size_t)k * 6144];
#pragma unroll
      for (int b = 0; b < 8; ++b) acc[b] += cact[b * 1024 + ks * 128 + k] * wv; }
#pragma unroll
    for (int b = 0; b < 8; ++b) red[(ks * 64 + jj) * 8 + b] = acc[b];
    __syncthreads();
    { const int b = tid >> 6; float sacc = p.in[4][j0 + jj];
#pragma unroll
      for (int k2 = 0; k2 < 8; ++k2) sacc += red[(k2 * 64 + jj) * 8 + b];
      ((float*)(ws + WS_MOD))[b * 6144 + j0 + jj] = sacc; }
  }
}

constexpr int WT_STRIDE = 144, WT_BYTES = 32 * WT_STRIDE;
DI void wt_write(char* wl, const f32x16& a0, const f32x16& a1, int r, int hh, float scale) {
  char* bp = wl + (4 * hh) * WT_STRIDE + r * 2;
#pragma unroll
  for (int reg = 0; reg < 16; ++reg) { const int ro = ((reg & 3) + 8 * (reg >> 2)) * WT_STRIDE;
    *(bf16_t*)(bp + ro) = f2bf(a0[reg] * scale); *(bf16_t*)(bp + ro + 64) = f2bf(a1[reg] * scale); }
}
DI void wt_write_rope(char* wl, const f32x16& a0, const f32x16& a1, int r, int hh, const float* cs, const float* sn, int m0) {
  char* bp = wl + (4 * hh) * WT_STRIDE + r * 2;
#pragma unroll
  for (int reg = 0; reg < 16; ++reg) { const int rw = (reg & 3) + 8 * (reg >> 2); const int row = m0 + rw + 4 * hh;
    const float c = cs[row * 32 + r], s = sn[row * 32 + r];
    *(bf16_t*)(bp + rw * WT_STRIDE) = f2bf(a0[reg] * c - a1[reg] * s); *(bf16_t*)(bp + rw * WT_STRIDE + 64) = f2bf(a1[reg] * c + a0[reg] * s); }
}
DI void wt_store(const char* wl, int lane, bf16_t* dA, int sA, bf16_t* dB, int sB) {
  const int piece = lane & 7, rsub = lane >> 3;
  bf16_t* d = (piece < 4) ? dA : dB; const int st = (piece < 4) ? sA : sB;
  if (d) {
#pragma unroll
    for (int i = 0; i < 4; ++i) { const int row = i * 8 + rsub; const uint4 v = *(const uint4*)(wl + row * WT_STRIDE + piece * 16);
      *(uint4*)(d + (size_t)row * st + (piece & 3) * 8) = v; }
  }
}
#define LDS_FENCE() asm volatile("s_waitcnt lgkmcnt(0)" ::: "memory")
DI int lv(int x) { asm volatile("" : "+v"(x)); return x; }
template <class T> DI T* launder(T* q) { size_t z = 0; asm volatile("" : "+s"(z)); return (T*)((char*)q + z); }

constexpr int GL_GR = 0, GL_VT = 8192, GL_QD = 26624, GL_KI = 45056, GL_KIT = 63488, GL_ATT = 81920, GL_TOT = 91136, GL_DEC = 93184, GL_LA = 93696  , GL_QS = 126464  , GL_KS = 134656;
DI void gla_chunk_local(const KP& p, char* lds, unsigned char* ws, int tile, const bf16_t* qg, const bf16_t* kg, const bf16_t* vg, const bf16_t* GR) {
  const int tid = lv(threadIdx.x), lane = tid & 63, w = tid >> 6, r = lane & 31, hh = lane >> 5;
  const int b = tile >> 5, n = tile & 31, tok0 = tile * 64;
  float* GRL = (float*)(lds + GL_GR); float* TOT = (float*)(lds + GL_TOT); float* DECL = (float*)(lds + GL_DEC);
  __syncthreads();
#pragma unroll
  for (int i = 0; i < 4; ++i) GRL[tid + 512 * i] = bf2f(GR[tid + 512 * i]);
#pragma unroll 1
  for (int h = 0; h < 4; ++h) {
    __syncthreads();
    { const int t = tid >> 3, c8 = (tid & 7) * 8;
      *(uint4*)(lds + GL_QS + (t * 64 + c8) * 2) = *(const uint4*)(qg + (size_t)t * 256 + h * 64 + c8);
      *(uint4*)(lds + GL_KS + (t * 64 + c8) * 2) = *(const uint4*)(kg + (size_t)t * 256 + h * 64 + c8); }
#pragma unroll
    for (int i = 0; i < 2; ++i) { const int c = tid + 512 * i, t = c >> 4, d8 = (c & 15) * 8;
      const uint4 v = *(const uint4*)(vg + (size_t)t * 512 + h * 128 + d8);
      bf16_t* vt = (bf16_t*)(lds + GL_VT) + d8 * 72 + t;
      vt[0] = (bf16_t)(v.x & 0xffffu); vt[72] = (bf16_t)(v.x >> 16); vt[144] = (bf16_t)(v.y & 0xffffu); vt[216] = (bf16_t)(v.y >> 16);
      vt[288] = (bf16_t)(v.z & 0xffffu); vt[360] = (bf16_t)(v.z >> 16); vt[432] = (bf16_t)(v.w & 0xffffu); vt[504] = (bf16_t)(v.w >> 16); }
    const int dir = tid >> 8, qt = (tid >> 6) & 3, dk = tid & 63, col = h * 64 + dk;
    float* LAL = (float*)(lds + GL_LA) + tid;
    {
      const float* wg = launder(dir ? p.in[14] : p.in[12]); const float* bg = launder(dir ? p.in[15] : p.in[13]);
      float wr[16];
#pragma unroll
      for (int q = 0; q < 16; ++q) wr[q] = wg[q * 256 + col];
      const float bias = bg[col];
      float run = 0.f;
#pragma unroll 2
      for (int ii = 0; ii < 16; ++ii) { const int i = dir ? 15 - ii : ii;
        const float* gp = GRL + (qt * 16 + i) * 32 + dir * 16; float x = bias;
#pragma unroll
        for (int q = 0; q < 16; ++q) x += gp[q] * wr[q];
        run += logsigmoid_fast(x) * (1.f / 16.f); LAL[i * 512] = run; }
      TOT[(dir * 64 + dk) * 4 + qt] = run;
    }
    __syncthreads();
    {
      const float4 tq = *(const float4*)(TOT + (dir * 64 + dk) * 4);
      const float total = (tq.x + tq.y) + (tq.z + tq.w);
      float off;
      if (dir == 0) off = (qt > 0 ? tq.x : 0.f) + (qt > 1 ? tq.y : 0.f) + (qt > 2 ? tq.z : 0.f);
      else          off = (qt < 1 ? tq.y : 0.f) + (qt < 2 ? tq.z : 0.f) + (qt < 3 ? tq.w : 0.f);
      if (qt == 0) { const float dc = fexp(total); DECL[dir * 64 + dk] = dc; ((float*)(ws + WS_DEC))[((size_t)((b * 4 + h) * 2 + dir) * 32 + n) * 64 + dk] = dc; }
      bf16_t* QD = (bf16_t*)(lds + GL_QD + dir * 9216) + (qt * 16) * 72 + dk; bf16_t* KI = (bf16_t*)(lds + GL_KI + dir * 9216) + (qt * 16) * 72 + dk;
      bf16_t* KIT = (bf16_t*)(lds + GL_KIT + dir * 9216) + dk * 72 + qt * 16;
      bf16_t* qdg = (bf16_t*)(ws + WS_QDEC) + (size_t)((tile * 4 + h) * 2 + dir) * 4096 + (qt * 16) * 64 + dk;
      const bf16_t* qgp = (const bf16_t*)(lds + GL_QS) + (qt * 16) * 64 + dk; const bf16_t* kgp = (const bf16_t*)(lds + GL_KS) + (qt * 16) * 64 + dk;
#pragma unroll 2
      for (int i = 0; i < 16; ++i) { const float bb = off + LAL[i * 512];
        const float qv = bf2f(qgp[i * 64]), kv = bf2f(kgp[i * 64]);
        const float eb = fexp(bb); const bf16_t qd = f2bf(qv * eb), ki = f2bf(kv * __builtin_amdgcn_rcpf(eb));
        QD[i * 72] = qd; KI[i * 72] = ki; qdg[i * 64] = qd; KIT[i] = ki; }
    }
    __syncthreads();
    if (w < 4) { const int mi = w >> 1, ni = w & 1;
      f32x16 asum;
#pragma unroll
      for (int i = 0; i < 16; ++i) asum[i] = 0.f;
#pragma unroll
      for (int d = 0; d < 2; ++d) { f32x16 acc;
#pragma unroll
        for (int i = 0; i < 16; ++i) acc[i] = 0.f;
#pragma unroll
        for (int s = 0; s < 4; ++s) { const bf16x8 a = *(const bf16x8*)(lds + GL_QD + d * 9216 + (mi * 32 + r) * 144 + s * 32 + hh * 16);
          const bf16x8 bb = *(const bf16x8*)(lds + GL_KI + d * 9216 + (ni * 32 + r) * 144 + s * 32 + hh * 16); acc = MFMA32(a, bb, acc); }
#pragma unroll
        for (int reg = 0; reg < 16; ++reg) { const int ti = mi * 32 + crow(reg, hh), tj = ni * 32 + r; const bool keep = d ? (tj >= ti) : (tj <= ti); asum[reg] += keep ? acc[reg] : 0.f; } }
      bf16_t* at = (bf16_t*)(lds + GL_ATT) + (mi * 32 + 4 * hh) * 72 + ni * 32 + r;
#pragma unroll
      for (int reg = 0; reg < 16; ++reg) at[((reg & 3) + 8 * (reg >> 2)) * 72] = f2bf(asum[reg]);
    }
    __syncthreads();
    { const int mi = w >> 2, ni = w & 3; f32x16 acc;
#pragma unroll
      for (int i = 0; i < 16; ++i) acc[i] = 0.f;
#pragma unroll
      for (int s = 0; s < 4; ++s) { const bf16x8 a = *(const bf16x8*)(lds + GL_ATT + (mi * 32 + r) * 144 + s * 32 + hh * 16);
        const bf16x8 bb = *(const bf16x8*)(lds + GL_VT + (ni * 32 + r) * 144 + s * 32 + hh * 16); acc = MFMA32(a, bb, acc); }
      bf16_t* oi = (bf16_t*)(ws + WS_OINTRA) + (size_t)(tok0 + mi * 32 + 4 * hh) * 512 + h * 128 + ni * 32 + r;
#pragma unroll
      for (int reg = 0; reg < 16; ++reg) oi[(size_t)((reg & 3) + 8 * (reg >> 2)) * 512] = f2bf(acc[reg]); }
    { const int dvb = w >> 1, dkb = w & 1;
#pragma unroll
      for (int d = 0; d < 2; ++d) { f32x16 acc;
#pragma unroll
        for (int i = 0; i < 16; ++i) acc[i] = 0.f;
#pragma unroll
        for (int s = 0; s < 4; ++s) { const bf16x8 a = *(const bf16x8*)(lds + GL_VT + (dvb * 32 + r) * 144 + s * 32 + hh * 16);
          const bf16x8 bb = *(const bf16x8*)(lds + GL_KIT + d * 9216 + (dkb * 32 + r) * 144 + s * 32 + hh * 16); acc = MFMA32(a, bb, acc); }
        const float sc = DECL[d * 64 + dkb * 32 + r];
        bf16_t* ds = (bf16_t*)(ws + WS_SPT) + ((size_t)((b * 4 + h) * 2 + d) * 32 + n) * 8192 + (size_t)(dvb * 32 + 4 * hh) * 64 + dkb * 32 + r;
#pragma unroll
        for (int reg = 0; reg < 16; ++reg) ds[((reg & 3) + 8 * (reg >> 2)) * 64] = f2bf(acc[reg] * sc); } }
  }
}

DI void phase1(const KP& p, char* lds) {
  const int tid = threadIdx.x, lane = tid & 63, w = tid >> 6, r = lane & 31, hh = lane >> 5;
  float* cs = (float*)(lds + LDS_TAB); float* sn = cs + 2048;
  char* wl = lds + LDS_WT + (w & 3) * WT_BYTES;
  for (int tile = blockIdx.x; tile < 256; tile += gridDim.x) {
    unsigned char* ws = launder(p.ws); unsigned char* ob = (unsigned char*)launder(p.out); const float* xin = launder(p.in[0]);
    const float* mod = (const float*)(ws + WS_MOD);
    const int tok0 = tile * 64, b = tile >> 5, t0 = (tile & 31) * 64;
    bf16_t* Hs = (bf16_t*)(ob + OUT_HS) + (size_t)tok0 * 1024;
    bf16_t* CQ = (bf16_t*)(ob + OUT_CQ) + (size_t)tok0 * 640;
    bf16_t* CQN = Hs; bf16_t* CKVN = Hs + 64 * 384;
    bf16_t* GR = (bf16_t*)(ob + OUT_GR) + (size_t)tok0 * 32;
    bf16_t* Qm = (bf16_t*)(ws + WS_QM); bf16_t* Km = (bf16_t*)(ws + WS_KM); bf16_t* Vm = (bf16_t*)(ws + WS_VM);
    bf16_t* qg = (bf16_t*)(ws + WS_P1S + (size_t)tile * 131072); bf16_t* kg = qg + 64 * 256; bf16_t* vg = qg + 2 * 64 * 256;
    bf16_t* rg = (bf16_t*)(ws + WS_RG) + (size_t)tok0 * 512;
    __syncthreads();
#pragma unroll
    for (int i = 0; i < 4; ++i) { const int e = tid + 512 * i, tt = e >> 5, j = e & 31;
      const float inv = __builtin_amdgcn_exp2f(-(float)j * (13.287712379549449f / 32.f)); const float ang = (float)((const int*)p.in[2])[tok0 + tt] * inv;
      float rev = ang * 0.15915494309189535f; rev -= floorf(rev);
      cs[e] = __builtin_amdgcn_cosf(rev); sn[e] = __builtin_amdgcn_sinf(rev); }
    {
      float4 ge[4], sh[4];
      const float* gpre = launder(p.in[5]); const float* modb = launder(mod) + b * 6144;
#pragma unroll
      for (int i = 0; i < 4; ++i) { const int d = (lane + 64 * i) * 4;
        const float4 g = *(const float4*)(gpre + d); const float4 sc = *(const float4*)(modb + 1024 + d); sh[i] = *(const float4*)(modb + d);
        ge[i] = make_float4(g.x * (1.f + sc.x), g.y * (1.f + sc.y), g.z * (1.f + sc.z), g.w * (1.f + sc.w)); }
#pragma unroll 2
      for (int rr = 0; rr < 8; ++rr) { const int row = w * 8 + rr;
        const float* xr = xin + (size_t)(tok0 + row) * 1024;
        float4 v[4]; float ss = 0.f;
#pragma unroll
        for (int i = 0; i < 4; ++i) { v[i] = *(const float4*)(xr + (lane + 64 * i) * 4); ss += v[i].x * v[i].x + v[i].y * v[i].y + v[i].z * v[i].z + v[i].w * v[i].w; }
        ss = wave_sum(ss); const float rs = rsqrtf(ss * (1.f / 1024.f) + EPS);
#pragma unroll
        for (int i = 0; i < 4; ++i) { uint2 o; o.x = pack2(v[i].x * rs * ge[i].x + sh[i].x, v[i].y * rs * ge[i].y + sh[i].y); o.y = pack2(v[i].z * rs * ge[i].z + sh[i].z, v[i].w * rs * ge[i].w + sh[i].w);
          *(uint2*)(Hs + (size_t)row * 1024 + (lane + 64 * i) * 4) = o; }
      }
    }
    __syncthreads();
    block_gemm<3>(lds, Hs, 1024, (const bf16_t*)(ws + WS_WTIN), 9, 1024, [&](int m0, int n0, const f32x16& a0, const f32x16& a1) {
      const int r2 = lv(r), h2 = lv(hh), ln = lv(lane);
      if (n0 == O_KR) {
        wt_write_rope(wl, a0, a1, r2, h2, cs, sn, m0); LDS_FENCE();
        for (int h = 0; h < 4; ++h) { bf16_t* kp = Km + (((size_t)b * 4 + h) * SEQ + t0 + m0) * 192 + 128; wt_store(wl, ln, kp, 192, kp + 32, 192); }
        return; }
      wt_write(wl, a0, a1, r2, h2, (n0 >= O_QG && n0 < O_KG) ? 0.125f : 1.f); LDS_FENCE();
      bf16_t* d[2]; int st[2];
#pragma unroll
      for (int half = 0; half < 2; ++half) { const int nb = n0 + 32 * half;
        if (nb < 640) { d[half] = CQ + (size_t)m0 * 640 + nb; st[half] = 640; }
        else if (nb < O_KG) { d[half] = qg + (size_t)m0 * 256 + (nb - O_QG); st[half] = 256; }
        else if (nb < O_VG) { d[half] = kg + (size_t)m0 * 256 + (nb - O_KG); st[half] = 256; }
        else if (nb < O_GF) { d[half] = vg + (size_t)m0 * 512 + (nb - O_VG); st[half] = 512; }
        else if (nb < O_R) { d[half] = GR + (size_t)m0 * 32; st[half] = 32; }
        else if (nb < INW) { d[half] = rg + (size_t)m0 * 512 + (nb - O_R); st[half] = 512; }
        else { d[half] = nullptr; st[half] = 0; } }
      wt_store(wl, ln, d[0], st[0], d[1], st[1]);
    });
    __syncthreads();
    const float* gq = launder(p.in[8]); const float* gkv = launder(p.in[10]);
#pragma unroll 2
    for (int rr = 0; rr < 8; ++rr) { const int row = w * 8 + rr; const unsigned* cr = (const unsigned*)(CQ + (size_t)row * 640);
      float v0[5], v1[5];
#pragma unroll
      for (int i = 0; i < 5; ++i) { const unsigned u = cr[lane + 64 * i]; v0[i] = __uint_as_float(u << 16); v1[i] = __uint_as_float(u & 0xffff0000u); }
      float ss = v0[0] * v0[0] + v1[0] * v1[0] + v0[1] * v0[1] + v1[1] * v1[1] + v0[2] * v0[2] + v1[2] * v1[2];
      float s2 = v0[3] * v0[3] + v1[3] * v1[3] + v0[4] * v0[4] + v1[4] * v1[4];
      ss = wave_sum(ss); s2 = wave_sum(s2);
      const float rq = rsqrtf(ss * (1.f / 384.f) + EPS), rk = rsqrtf(s2 * (1.f / 256.f) + EPS);
#pragma unroll
      for (int i = 0; i < 3; ++i) { const int c = 2 * (lane + 64 * i); *(unsigned*)(CQN + (size_t)row * 384 + c) = pack2(v0[i] * rq * gq[c], v1[i] * rq * gq[c + 1]); }
#pragma unroll
      for (int i = 3; i < 5; ++i) { const int c = 2 * (lane + 64 * (i - 3)); *(unsigned*)(CKVN + (size_t)row * 256 + c) = pack2(v0[i] * rk * gkv[c], v1[i] * rk * gkv[c + 1]); }
    }
    __syncthreads();
    block_gemm<3>(lds, CQN, 384, (const bf16_t*)(ws + WS_WTQUP), 3, 384, [&](int m0, int n0, const f32x16& a0, const f32x16& a1) {
      const int r2 = lv(r), h2 = lv(hh), ln = lv(lane);
      const int h = n0 / 192, d0 = n0 % 192;
      bf16_t* qp = Qm + (((size_t)b * 4 + h) * SEQ + t0 + m0) * 192 + d0;
      if (d0 < 128) wt_write(wl, a0, a1, r2, h2, 1.f); else wt_write_rope(wl, a0, a1, r2, h2, cs, sn, m0);
      LDS_FENCE();
      wt_store(wl, ln, qp, 192, qp + 32, 192);
    });
    block_gemm<3>(lds, CKVN, 256, (const bf16_t*)(ws + WS_WTKVUP), 4, 256, [&](int m0, int n0, const f32x16& a0, const f32x16& a1) {
      const int r2 = lv(r), h2 = lv(hh), ln = lv(lane);
      const int h = n0 >> 8, d0 = n0 & 255;
      wt_write(wl, a0, a1, r2, h2, 1.f); LDS_FENCE();
      if (d0 < 128) { bf16_t* kp = Km + (((size_t)b * 4 + h) * SEQ + t0 + m0) * 192 + d0; wt_store(wl, ln, kp, 192, kp + 32, 192); }
      else { bf16_t* vp = Vm + (((size_t)b * 4 + h) * SEQ + t0 + m0) * 128 + (d0 - 128); wt_store(wl, ln, vp, 128, vp + 32, 128); }
    });
    gla_chunk_local(p, lds, ws, tile, qg, kg, vg, GR);
  }
}

namespace att {
typedef short s16x4 __attribute__((ext_vector_type(4)));
typedef unsigned u32x4 __attribute__((ext_vector_type(4)));
constexpr int DQ = 192, DV = 128, KVBLK = 64;
constexpr float SCALE = 0.07216878364870322f;
constexpr float THR = 8.f;
constexpr int SHM_V = KVBLK * DV * 2, SHM_K = KVBLK * DQ * 2;
constexpr int SHM_QR = 8 * 32 * 176;
constexpr int SHM_ATTN = 2 * SHM_V + 2 * SHM_K + 8 * 64 * 4 + SHM_QR;
#define KSWZ(row, colB) ((row) * 384 + ((colB) ^ (((row) & 7) << 4)))
#define SBAR() __builtin_amdgcn_sched_barrier(0)
DI unsigned cvtpk(float lo, float hi) { unsigned r; asm volatile("v_cvt_pk_bf16_f32 %0, %1, %2" : "=v"(r) : "v"(lo), "v"(hi)); return r; }

DI void partialSM(f32x16& p0, f32x16& p1, float& m_reg, float& mn, float& alpha) {
  constexpr float C = SCALE * 1.4426950408889634f;
  float pmax = p0[0];
#pragma unroll
  for (int r = 1; r < 16; ++r) pmax = fmaxf(pmax, p0[r]);
#pragma unroll
  for (int r = 0; r < 16; ++r) pmax = fmaxf(pmax, p1[r]);
  { auto rr = __builtin_amdgcn_permlane32_swap(__float_as_uint(pmax), __float_as_uint(pmax), false, false);
    pmax = fmaxf(__uint_as_float(rr[0]), __uint_as_float(rr[1])); }
  if (__builtin_expect(__all(pmax - m_reg <= THR / SCALE), 1)) { mn = m_reg; alpha = 1.f; }
  else { mn = fmaxf(m_reg, pmax); alpha = __builtin_amdgcn_exp2f((m_reg - mn) * C); m_reg = mn; }
  const float mnC = -mn * C;
#pragma unroll
  for (int r = 0; r < 16; ++r) p0[r] = fmaf(p0[r], C, mnC);
#pragma unroll
  for (int r = 0; r < 16; ++r) p1[r] = fmaf(p1[r], C, mnC);
#pragma unroll
  for (int r = 0; r < 16; ++r) p0[r] = __builtin_amdgcn_exp2f(p0[r]);
}
DI void finishSM(f32x16& p0, f32x16& p1, float alpha, float& l_reg, bf16x8& pa0, bf16x8& pa1, bf16x8& pa2, bf16x8& pa3) {
#pragma unroll
  for (int r = 0; r < 16; ++r) p1[r] = __builtin_amdgcn_exp2f(p1[r]);
  float ps = 0;
#pragma unroll
  for (int r = 0; r < 16; ++r) ps += p0[r];
#pragma unroll
  for (int r = 0; r < 16; ++r) ps += p1[r];
  { auto rr = __builtin_amdgcn_permlane32_swap(__float_as_uint(ps), __float_as_uint(ps), false, false);
    ps = __uint_as_float(rr[0]) + __uint_as_float(rr[1]); }
  l_reg = l_reg * alpha + ps;
#define PK4(P, BASE, OUT) do { unsigned a0 = cvtpk(P[BASE + 0], P[BASE + 1]), a1 = cvtpk(P[BASE + 2], P[BASE + 3]);   \
    unsigned b0 = cvtpk(P[BASE + 4], P[BASE + 5]), b1 = cvtpk(P[BASE + 6], P[BASE + 7]);                              \
    auto r0 = __builtin_amdgcn_permlane32_swap(a0, b0, false, false); auto r1 = __builtin_amdgcn_permlane32_swap(a1, b1, false, false); \
    u32x4 wv = {r0[0], r1[0], r0[1], r1[1]}; OUT = *reinterpret_cast<bf16x8*>(&wv); } while (0)
  PK4(p0, 0, pa0); PK4(p0, 8, pa1); PK4(p1, 0, pa2); PK4(p1, 8, pa3);
#undef PK4
}
DI void qkt(f32x16& p0, f32x16& p1, const char* Ks, const bf16x8* qr, const char* qrl, int r32, int hi) {
#pragma unroll
  for (int i = 0; i < 16; ++i) { p0[i] = 0.f; p1[i] = 0.f; }
#pragma unroll
  for (int d0 = 0; d0 < 12; ++d0) { const int cb = (d0 * 16 + hi * 8) * 2;
    const bf16x8 b0 = *reinterpret_cast<const bf16x8*>(Ks + KSWZ(r32, cb));
    const bf16x8 b1 = *reinterpret_cast<const bf16x8*>(Ks + KSWZ(32 + r32, cb));
    const bf16x8 q = (d0 < 7) ? qr[d0 < 7 ? d0 : 0] : *reinterpret_cast<const bf16x8*>(qrl + (d0 - 7) * 32);
    p0 = MFMA32(b0, q, p0);
    p1 = MFMA32(b1, q, p1); }
}
DI int v_st(int k, int c) { const int kk = (k & ~0xC) | ((k & 4) << 1) | ((k & 8) >> 1); return ((kk >> 3) * 4 + (c >> 5)) * 512 + ((kk & 7) * 32 + (c & 31)) * 2; }
DI int v_rd_base(int lane) { return ((lane & 3) << 3) | (((lane >> 2) & 3) << 6) | (((lane >> 4) & 1) << 5) | (((lane >> 5) & 1) << 8); }
constexpr int v_rd_off(int d0, int ks, int half) { return d0 * 512 + ks * 4096 + half * 2048; }
template <int OFF> DI s16x4 tr_read(int vb) { s16x4 r; asm volatile("ds_read_b64_tr_b16 %0, %1 offset:%2" : "=&v"(r) : "v"(vb), "i"(OFF) : "memory"); return r; }
template <int D0> DI void pv_one(f32x16& od, int vb, bf16x8 pa0, bf16x8 pa1, bf16x8 pa2, bf16x8 pa3) {
  const s16x4 l0 = tr_read<v_rd_off(D0, 0, 0)>(vb), h0 = tr_read<v_rd_off(D0, 0, 1)>(vb), l1 = tr_read<v_rd_off(D0, 1, 0)>(vb), h1 = tr_read<v_rd_off(D0, 1, 1)>(vb);
  const s16x4 l2 = tr_read<v_rd_off(D0, 2, 0)>(vb), h2 = tr_read<v_rd_off(D0, 2, 1)>(vb), l3 = tr_read<v_rd_off(D0, 3, 0)>(vb), h3 = tr_read<v_rd_off(D0, 3, 1)>(vb);
  asm volatile("s_waitcnt lgkmcnt(0)" ::: "memory"); SBAR();
#define PK(L, H) (bf16x8){L[0], L[1], L[2], L[3], H[0], H[1], H[2], H[3]}
  od = MFMA32(pa0, PK(l0, h0), od);
  od = MFMA32(pa1, PK(l1, h1), od);
  od = MFMA32(pa2, PK(l2, h2), od);
  od = MFMA32(pa3, PK(l3, h3), od);
#undef PK
}
DI void pv_d0(f32x16* o, int vb, bf16x8 pa0, bf16x8 pa1, bf16x8 pa2, bf16x8 pa3) {
  pv_one<0>(o[0], vb, pa0, pa1, pa2, pa3); pv_one<1>(o[1], vb, pa0, pa1, pa2, pa3); pv_one<2>(o[2], vb, pa0, pa1, pa2, pa3); pv_one<3>(o[3], vb, pa0, pa1, pa2, pa3);
}
DI void attn_unit(const bf16_t* Qb, const bf16_t* Kh, const bf16_t* Vh, bf16_t* Ob, int seq, char* lds) {
  const int tid = lv(threadIdx.x), wid = tid >> 6, lane = tid & 63, r32 = lane & 31, hi = lane >> 5;
  char* V_lds = lds; char* K_lds = lds + 2 * SHM_V;
  float* wsf = (float*)(lds + 2 * SHM_V + 2 * SHM_K) + wid * 64; float* li_l = wsf; float* al_l = wsf + 32;
  char* qrl = lds + 2 * SHM_V + 2 * SHM_K + 8 * 64 * 4 + wid * (32 * 176) + r32 * 176 + hi * 16;
  float m_reg = -1e30f, l_reg = 0; f32x16 o[4]; bf16x8 qr[7];
#pragma unroll
  for (int d = 0; d < 4; ++d)
#pragma unroll
    for (int i = 0; i < 16; ++i) o[d][i] = 0.f;
  const bf16_t* Qw = Qb + (size_t)(wid * 32 + r32) * DQ + hi * 8;
#pragma unroll
  for (int d0 = 0; d0 < 7; ++d0) qr[d0] = *reinterpret_cast<const bf16x8*>(Qw + d0 * 16);
#pragma unroll
  for (int d0 = 7; d0 < 12; ++d0) *reinterpret_cast<bf16x8*>(qrl + (d0 - 7) * 32) = *reinterpret_cast<const bf16x8*>(Qw + d0 * 16);
  int kst[3];
#pragma unroll
  for (int i = 0; i < 3; ++i) { const int c = tid + 512 * i; kst[i] = KSWZ(c / 24, (c % 24) * 16); }
  const int vst0 = v_st(tid >> 4, (tid & 15) * 8), vst1 = v_st(32 + (tid >> 4), (tid & 15) * 8);
  const int vb0 = (int)(uintptr_t)V_lds + v_rd_base(lane);
  bf16x8 sk0, sk1, sk2, sv0, sv1;
#define SLOAD(k0) do { const bf16x8* kp = reinterpret_cast<const bf16x8*>(Kh + (size_t)(k0) * DQ) + tid; sk0 = kp[0]; sk1 = kp[512]; sk2 = kp[1024]; \
    const bf16x8* vp = reinterpret_cast<const bf16x8*>(Vh + (size_t)(k0) * DV) + tid; sv0 = vp[0]; sv1 = vp[512]; } while (0)
#define SWRITE(b) do { *(bf16x8*)(V_lds + (b) * SHM_V + vst0) = sv0; *(bf16x8*)(V_lds + (b) * SHM_V + vst1) = sv1; \
    *(bf16x8*)(K_lds + (b) * SHM_K + kst[0]) = sk0; *(bf16x8*)(K_lds + (b) * SHM_K + kst[1]) = sk1; *(bf16x8*)(K_lds + (b) * SHM_K + kst[2]) = sk2; } while (0)
#define RESC(a) do { if (__any((a) < 1.f)) { if (hi == 0) al_l[r32] = (a); asm volatile("s_waitcnt lgkmcnt(0)" ::: "memory"); \
    _Pragma("unroll") for (int d = 0; d < 4; ++d) _Pragma("unroll") for (int r = 0; r < 16; ++r) o[d][r] *= al_l[crow(r, hi)]; } } while (0)
  f32x16 pA0, pA1, pB0, pB1; float mnA, mnB, alA, alB; bf16x8 pa0, pa1, pa2, pa3; const int NT = seq / KVBLK;
  SLOAD(0); SWRITE(0); __syncthreads();
  qkt(pA0, pA1, K_lds, qr, qrl, r32, hi); partialSM(pA0, pA1, m_reg, mnA, alA);
  SLOAD(KVBLK); SWRITE(1); __syncthreads();
  for (int j = 1; j + 1 < NT; j += 2) {
    SBAR(); qkt(pB0, pB1, K_lds + SHM_K, qr, qrl, r32, hi);
    finishSM(pA0, pA1, alA, l_reg, pa0, pa1, pa2, pa3); SBAR();
    SLOAD((j + 1) * KVBLK); SBAR();
    pv_d0(o, vb0, pa0, pa1, pa2, pa3); partialSM(pB0, pB1, m_reg, mnB, alB);
    __syncthreads(); SWRITE(0);
    RESC(alB); __syncthreads();
    SBAR(); qkt(pA0, pA1, K_lds, qr, qrl, r32, hi);
    finishSM(pB0, pB1, alB, l_reg, pa0, pa1, pa2, pa3); SBAR();
    SLOAD((j + 2) * KVBLK); SBAR();
    pv_d0(o, vb0 + SHM_V, pa0, pa1, pa2, pa3); partialSM(pA0, pA1, m_reg, mnA, alA);
    __syncthreads(); SWRITE(1);
    RESC(alA); __syncthreads();
  }
  SBAR(); qkt(pB0, pB1, K_lds + SHM_K, qr, qrl, r32, hi);
  finishSM(pA0, pA1, alA, l_reg, pa0, pa1, pa2, pa3); SBAR();
  pv_d0(o, vb0, pa0, pa1, pa2, pa3); partialSM(pB0, pB1, m_reg, mnB, alB);
  __syncthreads(); RESC(alB);
  finishSM(pB0, pB1, alB, l_reg, pa0, pa1, pa2, pa3); SBAR();
  pv_d0(o, vb0 + SHM_V, pa0, pa1, pa2, pa3);
  if (hi == 0) li_l[r32] = l_reg; asm volatile("s_waitcnt lgkmcnt(0)" ::: "memory");
  float rli[16];
#pragma unroll
  for (int r = 0; r < 16; ++r) rli[r] = __builtin_amdgcn_rcpf(li_l[crow(r, hi)]);
  bf16_t* Ow = Ob + (size_t)(wid * 32) * 1024;
#pragma unroll
  for (int r = 0; r < 16; ++r) { const int orow = crow(r, hi);
#pragma unroll
    for (int d0 = 0; d0 < 4; ++d0) Ow[(size_t)orow * 1024 + d0 * 32 + r32] = f2bf(o[d0][r] * rli[r]); }
  __syncthreads();
#undef SLOAD
#undef SWRITE
#undef RESC
}
}

DI void phase2_attn(const KP& p, char* lds) {
  for (int u = blockIdx.x; u < 256; u += gridDim.x) {
    unsigned char* ws = launder(p.ws);
    const bf16_t* Qm = (const bf16_t*)(ws + WS_QM); const bf16_t* Km = (const bf16_t*)(ws + WS_KM); const bf16_t* Vm = (const bf16_t*)(ws + WS_VM);
    bf16_t* mixa = (bf16_t*)(ws + WS_P1S);
    const int qb = u & 7, bh = u >> 3, b = bh >> 2, h = bh & 3;
    att::attn_unit(Qm + ((size_t)bh * SEQ + qb * 256) * 192, Km + (size_t)bh * SEQ * 192, Vm + (size_t)bh * SEQ * 128,
                   mixa + ((size_t)b * SEQ + qb * 256) * 1024 + h * 128, SEQ, lds);
  }
}

namespace pg8 {
#define PG8_LAS __attribute__((address_space(3)))
typedef unsigned short bf16_t;
typedef short bf16x8 __attribute__((ext_vector_type(8)));
typedef float f32x4 __attribute__((ext_vector_type(4)));
typedef unsigned u32x4 __attribute__((ext_vector_type(4)));
constexpr int BM = 256, BK = 64, HALF = 128, HTB = HALF * BK * 2  , STAGE_BYTES = 8 * HTB, NXCD = 8, WGM = 8;

__host__ __device__ __forceinline__ int lds_byte(int r, int c) { const int st = (r >> 4) * 2 + (c >> 5), rr = r & 15, cc = c & 31, ob = rr * 64 + cc * 2; return st * 1024 + (ob ^ (((ob >> 9) & 1) << 5)); }
__host__ __device__ __forceinline__ void stage_rc(int b, int& R, int& C) { const int st = b / 1024, sb = b % 1024, swz = sb ^ (((sb >> 9) & 1) << 5); R = (st >> 1) * 16 + swz / 64; C = (st & 1) * 32 + (swz % 64) / 2; }
__host__ __device__ __forceinline__ int perm32(int rho) { const int n = rho >> 4, i = rho & 15; return 8 * (i >> 2) + 4 * n + (i & 3); }

struct Unit { int pm, pn; };
struct Gemm { const bf16_t* A; const bf16_t* Bt; int M, N, K; };

struct StaticOrder {
    int nM, nN, nwg, G, c;
    __host__ __device__ void init(int M, int N, int G_, int c_) { nM = M / BM; nN = N / BM; nwg = nM * nN; G = G_; c = c_; }
    __host__ __device__ bool next(int i, Unit& u) const {
        const long L = (long)i * G + c; if (L >= nwg) return false;
        int wgid = (int)L; { const int q = nwg / NXCD, r = nwg % NXCD, xcd = wgid % NXCD, off = wgid / NXCD; wgid = (xcd < r ? xcd * (q + 1) : r * (q + 1) + (xcd - r) * q) + off; }
        const int nig = WGM * nN, gid = wgid / nig, fm = gid * WGM, gsz = (nM - fm) < WGM ? (nM - fm) : WGM;
        u.pm = fm + ((wgid % nig) % gsz); u.pn = (wgid % nig) / gsz; return true;
    }
    __device__ __forceinline__ void a_ready(const Unit&) const {}
    __device__ __forceinline__ void done(const Unit&) const {}
};

__device__ __forceinline__ unsigned cvt_pk_bf16(float lo, float hi) { unsigned r; asm volatile("v_cvt_pk_bf16_f32 %0, %1, %2" : "=v"(r) : "v"(lo), "v"(hi)); return r; }
typedef float f32x2 __attribute__((ext_vector_type(2)));
__device__ __forceinline__ f32x2 gelu_pk(f32x2 v) {
    const f32x2 av = __builtin_elementwise_abs(v), d = av * 0.2316418882f + 1.0f;
    f32x2 t; t.x = __builtin_amdgcn_rcpf(d.x); t.y = __builtin_amdgcn_rcpf(d.y);
    f32x2 q = t * 0.5307027145f + (-0.7265760135f); q = q * t + 0.7107068705f; q = q * t + (-0.142248368f); q = q * t + 0.127414796f; q = q * t;
    const f32x2 s = (v * v) * (-0.72134752044f);
    f32x2 e; e.x = __builtin_amdgcn_exp2f(s.x); e.y = __builtin_amdgcn_exp2f(s.y);
    const f32x2 m = v * (q * e), r = v - m;
    f32x2 o; o.x = v.x < 0.f ? m.x : r.x; o.y = v.y < 0.f ? m.y : r.y; return o;
}

template <int ACT  > struct EpiBf16 {
    static constexpr bool PERM = true, AFTER_DRAIN = false; static_assert(ACT == 0 || ACT == 1, "EpiBf16: ACT is 0 (none) or 1 (gelu_pk)");
    bf16_t* O; int ldc; const float* bias; int split_cols; size_t split_stride; float scale0;
    __device__ __forceinline__ void operator()(const f32x4 (&acc)[2][2][4][2], const Unit& u, int wr, int wc, int fr, int fq) const {
        const int row0 = u.pm * BM + wr * 64 + fr; int colt = u.pn * BM; bf16_t* base = O;
        float sc = 1.f; if (split_cols) { const int t = colt / split_cols; base += (size_t)t * split_stride; colt -= t * split_cols; if (t == 0) sc = scale0; }
        const int col0 = colt + wc * 32 + 8 * fq, bcol0 = u.pn * BM + wc * 32 + 8 * fq;
        f32x4 bv[2][2];
#pragma unroll
        for (int bj = 0; bj < 2; ++bj)
#pragma unroll
            for (int n = 0; n < 2; ++n) bv[bj][n] = bias ? *(const f32x4*)(bias + bcol0 + bj * HALF + 4 * n) : (f32x4){0.f, 0.f, 0.f, 0.f};
#pragma unroll
        for (int ai = 0; ai < 2; ++ai)
#pragma unroll
            for (int m = 0; m < 4; ++m) { bf16_t* rowp = base + (size_t)(row0 + ai * HALF + m * 16) * ldc + col0;
#pragma unroll
                for (int bj = 0; bj < 2; ++bj) { f32x4 v0 = acc[ai][bj][m][0] + bv[bj][0], v1 = acc[ai][bj][m][1] + bv[bj][1];
                    if (ACT == 1) { f32x2 a = gelu_pk((f32x2){v0[0], v0[1]}), b = gelu_pk((f32x2){v0[2], v0[3]}), c = gelu_pk((f32x2){v1[0], v1[1]}), d = gelu_pk((f32x2){v1[2], v1[3]});
                        v0 = (f32x4){a.x, a.y, b.x, b.y}; v1 = (f32x4){c.x, c.y, d.x, d.y}; }
                    v0 = v0 * sc; v1 = v1 * sc; u32x4 w; w.x = cvt_pk_bf16(v0[0], v0[1]); w.y = cvt_pk_bf16(v0[2], v0[3]); w.z = cvt_pk_bf16(v1[0], v1[1]); w.w = cvt_pk_bf16(v1[2], v1[3]);
                    *(u32x4*)(rowp + bj * HALF) = w; } }
    }
};

template <class Epi, class Sched, bool ALIGN_EPI = false, bool SP2 = false>
__device__ __forceinline__ void gemm_phase(PG8_LAS unsigned char* lds, const Gemm g, const Sched& S, const Epi& E) {
    const int tid = threadIdx.x, wid = __builtin_amdgcn_readfirstlane(tid >> 6), lane = tid & 63, wr = wid >> 2, wc = wid & 3, fr = lane & 15, fq = lane >> 4;
    const int K = g.K, nt = K / BK;
    unsigned voffA[2], voffB[2];
#pragma unroll
    for (int i = 0; i < 2; ++i) { int R, C; stage_rc(tid * 16 + i * 8192, R, C); const int Rb = Epi::PERM ? ((R & ~31) + perm32(R & 31)) : R;
        voffA[i] = (unsigned)(R * K + C) * 2u; voffB[i] = (unsigned)(Rb * K + C) * 2u; }
    const size_t kstep = (size_t)(BK * 2);
    const size_t hstep = (size_t)HALF * K * 2;
    const size_t tstep = 2 * hstep;
    const unsigned ldsw = (unsigned)wid * 1024u;
    const int aoff = lds_byte(wr * 64 + fr, fq * 8), boff = lds_byte(wc * 32 + fr, fq * 8);
#define PG8_SA(b, h) (((b) * 2 + (h)) * HTB)
#define PG8_SB(b, h) ((4 + (b) * 2 + (h)) * HTB)
#define PG8_STAGE(bufoff, gbase, voff) do { _Pragma("unroll") for (int _i = 0; _i < 2; ++_i) \
        __builtin_amdgcn_global_load_lds((const unsigned*)((const char*)(gbase) + (voff)[_i]), (PG8_LAS unsigned*)(lds + (bufoff) + ldsw + _i * 8192), 16, 0, 0); } while (0)
#define PG8_LDA(dst, b, h) do { _Pragma("unroll") for (int m = 0; m < 4; ++m) _Pragma("unroll") for (int k = 0; k < 2; ++k) dst[m][k] = *(const PG8_LAS bf16x8*)(lds + PG8_SA(b, h) + aoff + m * 2048 + k * 1024); } while (0)
#define PG8_LDB(dst, b, h) do { _Pragma("unroll") for (int n = 0; n < 2; ++n) _Pragma("unroll") for (int k = 0; k < 2; ++k) dst[n][k] = *(const PG8_LAS bf16x8*)(lds + PG8_SB(b, h) + boff + n * 2048 + k * 1024); } while (0)
#define PG8_MMA(ai, bj, At, Bt) do { __builtin_amdgcn_s_setprio(1); _Pragma("unroll") for (int m = 0; m < 4; ++m) _Pragma("unroll") for (int n = 0; n < 2; ++n) _Pragma("unroll") for (int k = 0; k < 2; ++k) \
        acc[ai][bj][m][n] = __builtin_amdgcn_mfma_f32_16x16x32_bf16(Bt[n][k], At[m][k], acc[ai][bj][m][n], 0, 0, 0); __builtin_amdgcn_s_setprio(0); } while (0)
#define PG8_WAIT_V(n) asm volatile("s_waitcnt vmcnt(" #n ")" ::: "memory")
#define PG8_WAIT_L(n) asm volatile("s_waitcnt lgkmcnt(" #n ")" ::: "memory")
#define PG8_BAR __builtin_amdgcn_s_barrier()
#define PG8_SCHED __builtin_amdgcn_sched_barrier(0)
    Unit cur, nxt; int ui = 0;
    if (!S.next(0, cur)) return;
    f32x4 acc[2][2][4][2];
#pragma unroll
    for (int a = 0; a < 2; ++a)
#pragma unroll
        for (int b = 0; b < 2; ++b)
#pragma unroll
            for (int m = 0; m < 4; ++m)
#pragma unroll
                for (int n = 0; n < 2; ++n) acc[a][b][m][n] = (f32x4){0.f, 0.f, 0.f, 0.f};
    bf16x8 At[4][2], B0[2][2], B1[2][2];
    const char* cA = (const char*)g.A + (size_t)cur.pm * tstep; const char* cB = (const char*)g.Bt + (size_t)cur.pn * tstep;
    S.a_ready(cur);
    if constexpr (SP2) {
        PG8_STAGE(PG8_SB(0, 0), cB, voffB); PG8_STAGE(PG8_SB(0, 1), cB + hstep, voffB); PG8_STAGE(PG8_SA(0, 0), cA, voffA); PG8_STAGE(PG8_SA(0, 1), cA + hstep, voffA);
        if (wr == 1) PG8_BAR;
        PG8_WAIT_V(2); PG8_BAR;
        PG8_STAGE(PG8_SB(1, 0), cB + kstep, voffB); PG8_STAGE(PG8_SA(1, 0), cA + kstep, voffA); PG8_STAGE(PG8_SB(1, 1), cB + hstep + kstep, voffB);
        PG8_WAIT_V(6); PG8_BAR;
    } else {
        PG8_STAGE(PG8_SB(0, 0), cB, voffB); PG8_STAGE(PG8_SA(0, 0), cA, voffA); PG8_STAGE(PG8_SB(0, 1), cB + hstep, voffB); PG8_STAGE(PG8_SA(0, 1), cA + hstep, voffA);
        if (wr == 1) PG8_BAR;
        PG8_WAIT_V(4); PG8_BAR;
        PG8_STAGE(PG8_SB(1, 0), cB + kstep, voffB); PG8_STAGE(PG8_SA(1, 0), cA + kstep, voffA); PG8_STAGE(PG8_SB(1, 1), cB + hstep + kstep, voffB);
        PG8_WAIT_V(6); PG8_BAR;
    }
    for (;;) {
        const bool has_next = S.next(ui + 1, nxt);
        const char* nA = has_next ? (const char*)g.A + (size_t)nxt.pm * tstep : cA; const char* nB = has_next ? (const char*)g.Bt + (size_t)nxt.pn * tstep : cB;
        for (int t = 0; t < nt; t += 2) {
            const bool last = (t == nt - 2);
            const char* a1 = cA + (size_t)(t + 1) * kstep;
            const char* a2 = last ? nA : cA + (size_t)(t + 2) * kstep; const char* b2 = last ? nB : cB + (size_t)(t + 2) * kstep;
            const char* a3 = a2 + kstep; const char* b3 = b2 + kstep;
            if (last && has_next) S.a_ready(nxt);
            if constexpr (SP2) {
            PG8_LDB(B0, 0, 0); PG8_LDB(B1, 0, 1); PG8_SCHED; PG8_LDA(At, 0, 0); PG8_STAGE(PG8_SA(1, 1), a1 + hstep, voffA);
            PG8_WAIT_V(8); PG8_WAIT_L(0); PG8_BAR; PG8_MMA(0, 0, At, B0); PG8_MMA(0, 1, At, B1); PG8_BAR; PG8_SCHED;
            PG8_LDA(At, 0, 1); PG8_STAGE(PG8_SB(0, 0), b2, voffB); PG8_STAGE(PG8_SB(0, 1), b2 + hstep, voffB); PG8_STAGE(PG8_SA(0, 0), a2, voffA);
            PG8_WAIT_V(8); PG8_WAIT_L(0); PG8_BAR; PG8_MMA(1, 0, At, B0); PG8_MMA(1, 1, At, B1); PG8_BAR; PG8_SCHED;
            PG8_LDB(B0, 1, 0); PG8_LDB(B1, 1, 1); PG8_SCHED; PG8_LDA(At, 1, 0); PG8_STAGE(PG8_SA(0, 1), a2 + hstep, voffA);
            PG8_WAIT_V(8); PG8_WAIT_L(0); PG8_BAR; PG8_MMA(0, 0, At, B0); PG8_MMA(0, 1, At, B1); PG8_BAR; PG8_SCHED;
            PG8_LDA(At, 1, 1); PG8_STAGE(PG8_SB(1, 0), b3, voffB); PG8_STAGE(PG8_SB(1, 1), b3 + hstep, voffB); PG8_STAGE(PG8_SA(1, 0), a3, voffA);
            PG8_WAIT_V(8); PG8_WAIT_L(0); PG8_BAR; PG8_MMA(1, 0, At, B0); PG8_MMA(1, 1, At, B1); PG8_BAR; PG8_SCHED;
            } else {
            PG8_LDB(B0, 0, 0); PG8_SCHED; PG8_LDA(At, 0, 0); PG8_STAGE(PG8_SA(1, 1), a1 + hstep, voffA);
            PG8_WAIT_L(8); PG8_BAR; PG8_WAIT_L(0); PG8_MMA(0, 0, At, B0); PG8_BAR; PG8_SCHED;
            PG8_LDB(B1, 0, 1); PG8_STAGE(PG8_SB(0, 0), b2, voffB);
            PG8_BAR; PG8_WAIT_L(0); PG8_MMA(0, 1, At, B1); PG8_BAR;
            PG8_LDA(At, 0, 1); PG8_STAGE(PG8_SA(0, 0), a2, voffA);
            PG8_BAR; PG8_WAIT_L(0); PG8_MMA(1, 0, At, B0); PG8_BAR; PG8_SCHED;
            PG8_STAGE(PG8_SB(0, 1), b2 + hstep, voffB);
            PG8_WAIT_V(6); PG8_BAR; PG8_MMA(1, 1, At, B1); PG8_BAR;
            PG8_LDB(B0, 1, 0); PG8_SCHED; PG8_LDA(At, 1, 0); PG8_STAGE(PG8_SA(0, 1), a2 + hstep, voffA);
            PG8_WAIT_L(8); PG8_BAR; PG8_WAIT_L(0); PG8_MMA(0, 0, At, B0); PG8_BAR; PG8_SCHED;
            PG8_LDB(B1, 1, 1); PG8_STAGE(PG8_SB(1, 0), b3, voffB);
            PG8_BAR; PG8_WAIT_L(0); PG8_MMA(0, 1, At, B1); PG8_BAR;
            PG8_LDA(At, 1, 1); PG8_STAGE(PG8_SA(1, 0), a3, voffA);
            PG8_BAR; PG8_WAIT_L(0); PG8_MMA(1, 0, At, B0); PG8_BAR; PG8_SCHED;
            PG8_STAGE(PG8_SB(1, 1), b3 + hstep, voffB);
            PG8_WAIT_V(6); PG8_BAR; PG8_MMA(1, 1, At, B1); PG8_BAR;
            }
        }
        if constexpr (ALIGN_EPI) { if (wr == 0) PG8_BAR; }
        if constexpr (!Epi::AFTER_DRAIN) { E(acc, cur, wr, wc, fr, fq); S.done(cur); }
        if (!has_next) break;
#pragma unroll
        for (int a = 0; a < 2; ++a)
#pragma unroll
            for (int b = 0; b < 2; ++b)
#pragma unroll
                for (int m = 0; m < 4; ++m)
#pragma unroll
                    for (int n = 0; n < 2; ++n) acc[a][b][m][n] = (f32x4){0.f, 0.f, 0.f, 0.f};
        cur = nxt; cA = nA; cB = nB; ++ui;
        if constexpr (ALIGN_EPI) { if (wr == 1) PG8_BAR; }
    }
    PG8_WAIT_V(0);
    if constexpr (!ALIGN_EPI) { if (wr == 0) PG8_BAR; }
    PG8_BAR;
    if constexpr (Epi::AFTER_DRAIN) { E.fused(acc, cur, wr, wc, fr, fq, lds, wid, lane); S.done(cur); }
#undef PG8_SA
#undef PG8_SB
#undef PG8_STAGE
#undef PG8_LDA
#undef PG8_LDB
#undef PG8_MMA
#undef PG8_WAIT_V
#undef PG8_WAIT_L
#undef PG8_BAR
#undef PG8_SCHED
}
}

constexpr int P3_TILE_BYTES = 256 * 1024;
constexpr int LDS_TK = 92160;
constexpr int SCW = 260;
template <int N> DI void ce_desc(float (&a)[N], int i, int l) { const float hi = fmaxf(a[i], a[l]), lo = fminf(a[i], a[l]); a[i] = hi; a[l] = lo; }
DI void sort16_desc(float (&a)[16]) {
#pragma unroll
  for (int k = 2; k <= 16; k <<= 1)
#pragma unroll
    for (int j = k >> 1; j > 0; j >>= 1)
#pragma unroll
      for (int i = 0; i < 16; ++i) { const int l = i ^ j; if (l > i) { if ((i & k) == 0) ce_desc(a, i, l); else ce_desc(a, l, i); } }
}
DI void merge16_desc(float (&a)[16]) {
#pragma unroll
  for (int j = 8; j > 0; j >>= 1)
#pragma unroll
    for (int i = 0; i < 16; ++i) { const int l = i ^ j; if (l > i) ce_desc(a, i, l); }
}
DI void top16_merge(float (&a)[16], const float (&b)[16]) {
#pragma unroll
  for (int i = 0; i < 16; ++i) a[i] = fmaxf(a[i], b[15 - i]);
  merge16_desc(a);
}
template <int CTRL> DI float dpp_f(float v) { return __int_as_float(__builtin_amdgcn_mov_dpp(__float_as_int(v), CTRL, 0xF, 0xF, true)); }

DI float gelu_fast(float x) { return 0.5f * x * (1.f + erff(x * 0.70710678118654752f)); }

DI void phase3(const KP& p, char* lds, const int gather_reps, const int probe) {
  const int tid0 = threadIdx.x;
  const int r = tid0 & 31, hh = (tid0 >> 5) & 1, lane = tid0 & 63;
  char* wl = lds + LDS_WT + ((tid0 >> 6) & 3) * WT_BYTES;
  for (int tile = blockIdx.x; tile < 256; tile += gridDim.x) {
    unsigned char* ws = launder(p.ws); float* outp = launder(p.out); const float* xin = launder(p.in[0]);
    const int tok0 = tile * 64, b = tile >> 5;
    unsigned char* tsc = ws + WS_QM + (size_t)tile * P3_TILE_BYTES;
    bf16_t* QRY = (bf16_t*)tsc; bf16_t* Y = (bf16_t*)tsc; bf16_t* MIXA = (bf16_t*)(ws + WS_P1S) + (size_t)tok0 * 1024; bf16_t* H2 = MIXA;
    const float* modb = launder((const float*)(ws + WS_MOD)) + b * 6144;
    __syncthreads();
    {
      const int tid = lv(tid0), lane = tid & 63, w = tid >> 6, r = lane & 31, hh = lane >> 5;
      const int h = w >> 1, mi = w & 1, n = tile & 31;
      char* OIL = lds; char* RGL = lds + 66560;
      { const bf16_t* oig = (const bf16_t*)(ws + WS_OINTRA) + (size_t)tok0 * 512; const bf16_t* rgg = (const bf16_t*)(ws + WS_RG) + (size_t)tok0 * 512;
#pragma unroll
        for (int i = 0; i < 8; ++i) { const int c = tid + 512 * i, row = c >> 6, cc = c & 63;
          *(uint4*)(OIL + row * 1040 + cc * 16) = *(const uint4*)(oig + (size_t)row * 512 + cc * 8);
          *(uint4*)(RGL + row * 1040 + cc * 16) = *(const uint4*)(rgg + (size_t)row * 512 + cc * 8); } }
      const bf16_t* QDg = (const bf16_t*)(ws + WS_QDEC) + (size_t)(tile * 4 + h) * 2 * 4096 + (mi * 32 + r) * 64 + hh * 8;
      const bf16_t* SPg = (const bf16_t*)(ws + WS_SPT) + ((size_t)((b * 4 + h) * 2) * 32 + n) * 8192 + r * 64 + hh * 8;
      f32x16 acc[4];
#pragma unroll
      for (int ni = 0; ni < 4; ++ni)
#pragma unroll
        for (int i = 0; i < 16; ++i) acc[ni][i] = 0.f;
#pragma unroll
      for (int d = 0; d < 2; ++d)
#pragma unroll
        for (int s = 0; s < 4; ++s) { const bf16x8 a = *(const bf16x8*)(QDg + d * 4096 + s * 16);
#pragma unroll
          for (int ni = 0; ni < 4; ++ni) { const bf16x8 bb = *(const bf16x8*)(SPg + (size_t)d * 32 * 8192 + ni * 32 * 64 + s * 16); acc[ni] = MFMA32(a, bb, acc[ni]); } }
      __syncthreads();
      bf16_t* oil = (bf16_t*)(OIL + (mi * 32 + 4 * hh) * 1040) + h * 128 + r; const bf16_t* rgl = (const bf16_t*)(RGL + (mi * 32 + 4 * hh) * 1040) + h * 128 + r;
#pragma unroll
      for (int ni = 0; ni < 4; ++ni)
#pragma unroll
        for (int reg = 0; reg < 16; ++reg) acc[ni][reg] += bf2f(oil[((reg & 3) + 8 * (reg >> 2)) * 520 + ni * 32]);
      float rs[16];
#pragma unroll
      for (int reg = 0; reg < 16; ++reg) { float v = acc[0][reg] * acc[0][reg] + acc[1][reg] * acc[1][reg] + acc[2][reg] * acc[2][reg] + acc[3][reg] * acc[3][reg];
        v += __shfl_xor(v, 1); v += __shfl_xor(v, 2); v += __shfl_xor(v, 4); v += __shfl_xor(v, 8); v += __shfl_xor(v, 16);
        rs[reg] = rsqrtf(v * (1.f / 128.f) + EPS); }
      const float* ggl = launder(p.in[16]);
#pragma unroll
      for (int ni = 0; ni < 4; ++ni) { const float g = ggl[ni * 32 + r];
#pragma unroll
        for (int reg = 0; reg < 16; ++reg) { const int ro = ((reg & 3) + 8 * (reg >> 2)) * 520 + ni * 32; const float rv = bf2f(rgl[ro]);
          oil[ro] = f2bf(acc[ni][reg] * rs[reg] * g * silu_fast(rv)); } }
      __syncthreads();
#pragma unroll
      for (int i = 0; i < 8; ++i) { const int c = tid + 512 * i, row = c >> 6, cc = c & 63;
        *(uint4*)(MIXA + (size_t)row * 1024 + 512 + cc * 8) = *(const uint4*)(OIL + row * 1040 + cc * 16); }
    }
    __syncthreads();
    for (int rep3b = 0; rep3b < (probe == 5 ? 2 : 1); ++rep3b)
    block_gemm<3>(lds, MIXA, 1024, (const bf16_t*)(ws + WS_WTOUT), 4, 1024, [&](int m0, int n0, const f32x16& a0, const f32x16& a1) {
      const int r2 = lv(r), h2 = lv(hh), ln = lv(lane);
      wt_write(wl, a0, a1, r2, h2, 1.f); LDS_FENCE();
      bf16_t* d = Y + (size_t)m0 * 1024 + n0; wt_store(wl, ln, d, 1024, d + 32, 1024);
    });
    __syncthreads();
    {
      const int tid = lv(tid0), lane = tid & 63, w = tid >> 6;
      float4 A1[4], A2[4], S2[4];
      const float* gpo = launder(p.in[6]); const float* gpf = launder(p.in[18]);
#pragma unroll
      for (int i = 0; i < 4; ++i) { const int d = (lane + 64 * i) * 4;
        const float4 gp = *(const float4*)(gpo + d), gt = *(const float4*)(modb + 2048 + d), g2 = *(const float4*)(gpf + d), sc = *(const float4*)(modb + 4096 + d);
        S2[i] = *(const float4*)(modb + 3072 + d);
        A1[i] = make_float4(gp.x * gt.x, gp.y * gt.y, gp.z * gt.z, gp.w * gt.w);
        A2[i] = make_float4(g2.x * (1.f + sc.x), g2.y * (1.f + sc.y), g2.z * (1.f + sc.z), g2.w * (1.f + sc.w)); }
#pragma unroll 2
      for (int rr = 0; rr < 8; ++rr) { const int row = w * 8 + rr; const size_t tok = tok0 + row;
        float4 yv[4]; float ss = 0.f;
#pragma unroll
        for (int i = 0; i < 4; ++i) { const uint2 u = *(const uint2*)(Y + (size_t)row * 1024 + (lane + 64 * i) * 4);
          yv[i] = make_float4(__uint_as_float(u.x << 16), __uint_as_float(u.x & 0xffff0000u), __uint_as_float(u.y << 16), __uint_as_float(u.y & 0xffff0000u));
          ss += yv[i].x * yv[i].x + yv[i].y * yv[i].y + yv[i].z * yv[i].z + yv[i].w * yv[i].w; }
        ss = wave_sum(ss); const float rs = rsqrtf(ss * (1.f / 1024.f) + EPS);
        float4 xv[4]; float s2 = 0.f;
#pragma unroll
        for (int i = 0; i < 4; ++i) { const float4 x = *(const float4*)(xin + tok * 1024 + (lane + 64 * i) * 4);
          xv[i] = make_float4(x.x + A1[i].x * yv[i].x * rs, x.y + A1[i].y * yv[i].y * rs, x.z + A1[i].z * yv[i].z * rs, x.w + A1[i].w * yv[i].w * rs);
          *(float4*)(outp + tok * 1024 + (lane + 64 * i) * 4) = xv[i];
          s2 += xv[i].x * xv[i].x + xv[i].y * xv[i].y + xv[i].z * xv[i].z + xv[i].w * xv[i].w; }
        s2 = wave_sum(s2); const float r2 = rsqrtf(s2 * (1.f / 1024.f) + EPS);
#pragma unroll
        for (int i = 0; i < 4; ++i) { uint2 o; o.x = pack2(xv[i].x * r2 * A2[i].x + S2[i].x, xv[i].y * r2 * A2[i].y + S2[i].y); o.y = pack2(xv[i].z * r2 * A2[i].z + S2[i].z, xv[i].w * r2 * A2[i].w + S2[i].w);
          *(uint2*)(H2 + (size_t)row * 1024 + (lane + 64 * i) * 4) = o; }
      }
    }
  }
}

DI void phase3b(const KP& p, char* lds, const int gather_reps, const int probe) {
  const int tid0 = threadIdx.x;
  const int r = tid0 & 31, hh = (tid0 >> 5) & 1, lane = tid0 & 63;
  char* wl = lds + LDS_WT + ((tid0 >> 6) & 3) * WT_BYTES;
  for (int tile = blockIdx.x; tile < 256; tile += gridDim.x) {
    unsigned char* ws = launder(p.ws); float* outp = launder(p.out); const float* xin = launder(p.in[0]);
    const int tok0 = tile * 64, b = tile >> 5;
    unsigned char* tsc = ws + WS_QM + (size_t)tile * P3_TILE_BYTES;
    bf16_t* QRY = (bf16_t*)tsc; bf16_t* Y = (bf16_t*)tsc; bf16_t* MIXA = (bf16_t*)(ws + WS_P1S) + (size_t)tok0 * 1024; bf16_t* H2 = MIXA;
    const float* modb = launder((const float*)(ws + WS_MOD)) + b * 6144;
    __syncthreads();
    float* SC = (float*)lds; unsigned* TK = (unsigned*)(lds + LDS_TK);
    for (int rep3e = 0; rep3e < (probe == 7 ? 2 : 1); ++rep3e)
    for (int h = 0; h < 8; ++h) {
      block_gemm<2>(lds, QRY + h * 256, 2048, (const bf16_t*)(ws + WS_KD), 1, 256, [&](int m0, int n0, const f32x16& a0, const f32x16& a1) {
        const int r2 = lv(r), h2 = lv(hh);
        float* sp = SC + (m0 + 4 * h2) * SCW + n0 + r2;
#pragma unroll
        for (int reg = 0; reg < 16; ++reg) { const int ro = ((reg & 3) + 8 * (reg >> 2)) * SCW; sp[ro] = a0[reg]; sp[ro + 32] = a1[reg]; }
      });
      __syncthreads();
      {
        const int tid = lv(tid0);
        const int tt = tid >> 3, sd = (tid >> 2) & 1, q = tid & 3;
        const float* sr = SC + tt * SCW + sd * 128 + q * 32;
        float a[16], c[16];
#pragma unroll
        for (int i = 0; i < 4; ++i) { const float4 v = *(const float4*)(sr + i * 4); const unsigned ib = q * 32 + i * 4;
          a[i * 4 + 0] = __uint_as_float((__float_as_uint(v.x) & 0xFFFFFF80u) | (ib + 0)); a[i * 4 + 1] = __uint_as_float((__float_as_uint(v.y) & 0xFFFFFF80u) | (ib + 1));
          a[i * 4 + 2] = __uint_as_float((__float_as_uint(v.z) & 0xFFFFFF80u) | (ib + 2)); a[i * 4 + 3] = __uint_as_float((__float_as_uint(v.w) & 0xFFFFFF80u) | (ib + 3)); }
#pragma unroll
        for (int i = 0; i < 4; ++i) { const float4 v = *(const float4*)(sr + 16 + i * 4); const unsigned ib = q * 32 + 16 + i * 4;
          c[i * 4 + 0] = __uint_as_float((__float_as_uint(v.x) & 0xFFFFFF80u) | (ib + 0)); c[i * 4 + 1] = __uint_as_float((__float_as_uint(v.y) & 0xFFFFFF80u) | (ib + 1));
          c[i * 4 + 2] = __uint_as_float((__float_as_uint(v.z) & 0xFFFFFF80u) | (ib + 2)); c[i * 4 + 3] = __uint_as_float((__float_as_uint(v.w) & 0xFFFFFF80u) | (ib + 3)); }
        sort16_desc(a); sort16_desc(c); top16_merge(a, c);
#pragma unroll
        for (int i = 0; i < 16; ++i) c[i] = dpp_f<0xB1>(a[i]);
        top16_merge(a, c);
#pragma unroll
        for (int i = 0; i < 16; ++i) c[i] = dpp_f<0x4E>(a[i]);
        top16_merge(a, c);
        if (q == 0) { unsigned* tk = TK + ((tt * 8 + h) * 2 + sd) * 16;
#pragma unroll
          for (int i = 0; i < 4; ++i) *(uint4*)(tk + i * 4) = make_uint4(__float_as_uint(a[i * 4]), __float_as_uint(a[i * 4 + 1]), __float_as_uint(a[i * 4 + 2]), __float_as_uint(a[i * 4 + 3])); }
      }
      __syncthreads();
    }
    int* EIDX = (int*)lds; float* GATE = (float*)(lds + 32768);
    {
      const int tid = lv(tid0);
      const int tt = tid >> 3, h = tid & 7;
      const unsigned* t1 = TK + ((tt * 8 + h) * 2) * 16; const unsigned* t2 = t1 + 16;
      float v1[16], v2[16];
#pragma unroll
      for (int i = 0; i < 4; ++i) { const uint4 u = *(const uint4*)(t1 + i * 4), v = *(const uint4*)(t2 + i * 4);
        v1[i * 4] = __uint_as_float(u.x & 0xFFFFFF80u); v1[i * 4 + 1] = __uint_as_float(u.y & 0xFFFFFF80u); v1[i * 4 + 2] = __uint_as_float(u.z & 0xFFFFFF80u); v1[i * 4 + 3] = __uint_as_float(u.w & 0xFFFFFF80u);
        v2[i * 4] = __uint_as_float(v.x & 0xFFFFFF80u); v2[i * 4 + 1] = __uint_as_float(v.y & 0xFFFFFF80u); v2[i * 4 + 2] = __uint_as_float(v.z & 0xFFFFFF80u); v2[i * 4 + 3] = __uint_as_float(v.w & 0xFFFFFF80u); }
      float best[16], grp[16];
#define CAND(i, j) __uint_as_float((__float_as_uint(v1[i] + v2[j]) & 0xFFFFFF00u) | ((i) << 4) | (j))
      best[0] = CAND(0, 0); best[1] = CAND(0, 1); best[2] = CAND(0, 2); best[3] = CAND(0, 3); best[4] = CAND(0, 4); best[5] = CAND(0, 5); best[6] = CAND(0, 6); best[7] = CAND(0, 7);
      best[8] = CAND(0, 8); best[9] = CAND(0, 9); best[10] = CAND(0, 10); best[11] = CAND(0, 11); best[12] = CAND(0, 12); best[13] = CAND(0, 13); best[14] = CAND(0, 14); best[15] = CAND(0, 15);
      sort16_desc(best);
      grp[0] = CAND(1, 0); grp[1] = CAND(1, 1); grp[2] = CAND(1, 2); grp[3] = CAND(1, 3); grp[4] = CAND(1, 4); grp[5] = CAND(1, 5); grp[6] = CAND(1, 6); grp[7] = CAND(1, 7);
      grp[8] = CAND(2, 0); grp[9] = CAND(2, 1); grp[10] = CAND(2, 2); grp[11] = CAND(2, 3); grp[12] = CAND(2, 4); grp[13] = CAND(3, 0); grp[14] = CAND(3, 1); grp[15] = CAND(3, 2);
      sort16_desc(grp); top16_merge(best, grp);
      grp[0] = CAND(3, 3); grp[1] = CAND(4, 0); grp[2] = CAND(4, 1); grp[3] = CAND(4, 2); grp[4] = CAND(5, 0); grp[5] = CAND(5, 1); grp[6] = CAND(6, 0); grp[7] = CAND(6, 1);
      grp[8] = CAND(7, 0); grp[9] = CAND(7, 1); grp[10] = CAND(8, 0); grp[11] = CAND(9, 0); grp[12] = CAND(10, 0); grp[13] = CAND(11, 0); grp[14] = CAND(12, 0); grp[15] = CAND(13, 0);
      sort16_desc(grp); top16_merge(best, grp);
      { const float c14 = CAND(14, 0), c15 = CAND(15, 0);
        grp[0] = fmaxf(c14, c15); grp[1] = fminf(c14, c15);
#pragma unroll
        for (int i = 2; i < 16; ++i) grp[i] = -3.0e38f;
        top16_merge(best, grp); }
#undef CAND
      __syncthreads();
      float sv[16]; int ev[16]; float mx = -3.0e38f;
#pragma unroll
      for (int k = 0; k < 16; ++k) { const unsigned key = __float_as_uint(best[k]); const int ci = (key >> 4) & 15, cj = key & 15;
        const unsigned k1 = t1[ci], k2 = t2[cj];
        sv[k] = __uint_as_float(k1 & 0xFFFFFF80u) + __uint_as_float(k2 & 0xFFFFFF80u); ev[k] = (int)((k1 & 127u) * 128u + (k2 & 127u)); mx = fmaxf(mx, sv[k]); }
      float sum = 0.f;
#pragma unroll
      for (int k = 0; k < 16; ++k) { sv[k] = __expf(sv[k] - mx); sum += sv[k]; }
      const float inv = 1.f / sum;
#pragma unroll
      for (int k = 0; k < 16; ++k) { EIDX[tt * 128 + h * 16 + k] = ev[k]; GATE[tt * 128 + h * 16 + k] = sv[k] * inv; }
    }
    __syncthreads();
    {
      const int tid = lv(tid0), lane = tid & 63, w = tid >> 6;
      const unsigned char* EU = ws + WS_EU; const unsigned char* EV = ws + WS_EV; const float* SCU = (const float*)(ws + WS_ESC); const float* SCV = SCU + 16384;
      const float* gpf2 = launder(p.in[19]);
      typedef float f2v __attribute__((ext_vector_type(2)));
#define FP8X4(wd, o0, o1, o2, o3) do { const f2v lo_ = __builtin_amdgcn_cvt_pk_f32_fp8((int)(wd), false), hi_ = __builtin_amdgcn_cvt_pk_f32_fp8((int)(wd), true); o0 = lo_.x; o1 = lo_.y; o2 = hi_.x; o3 = hi_.y; } while (0)
#pragma unroll 1
      for (int pass = 0; pass < gather_reps; ++pass)
#pragma unroll 1
      for (int rr = 0; rr < 8; ++rr) { const int row = w * 8 + rr; const size_t tok = tok0 + row;
        float hf[16];
        { const uint4 hA = *(const uint4*)(H2 + (size_t)row * 1024 + lane * 16), hB = *(const uint4*)(H2 + (size_t)row * 1024 + lane * 16 + 8);
          hf[0] = __uint_as_float(hA.x << 16); hf[1] = __uint_as_float(hA.x & 0xffff0000u); hf[2] = __uint_as_float(hA.y << 16); hf[3] = __uint_as_float(hA.y & 0xffff0000u);
          hf[4] = __uint_as_float(hA.z << 16); hf[5] = __uint_as_float(hA.z & 0xffff0000u); hf[6] = __uint_as_float(hA.w << 16); hf[7] = __uint_as_float(hA.w & 0xffff0000u);
          hf[8] = __uint_as_float(hB.x << 16); hf[9] = __uint_as_float(hB.x & 0xffff0000u); hf[10] = __uint_as_float(hB.y << 16); hf[11] = __uint_as_float(hB.y & 0xffff0000u);
          hf[12] = __uint_as_float(hB.z << 16); hf[13] = __uint_as_float(hB.z & 0xffff0000u); hf[14] = __uint_as_float(hB.w << 16); hf[15] = __uint_as_float(hB.w & 0xffff0000u); }
        float acc[16];
#pragma unroll
        for (int i = 0; i < 16; ++i) acc[i] = 0.f;
#pragma unroll 1
        for (int g = 0; g < 16; ++g) {
          const int* ep = EIDX + row * 128 + g * 8;
          const int4 ea = *(const int4*)ep, eb = *(const int4*)(ep + 4);
          int es[8];
          es[0] = __builtin_amdgcn_readfirstlane(ea.x); es[1] = __builtin_amdgcn_readfirstlane(ea.y); es[2] = __builtin_amdgcn_readfirstlane(ea.z); es[3] = __builtin_amdgcn_readfirstlane(ea.w);
          es[4] = __builtin_amdgcn_readfirstlane(eb.x); es[5] = __builtin_amdgcn_readfirstlane(eb.y); es[6] = __builtin_amdgcn_readfirstlane(eb.z); es[7] = __builtin_amdgcn_readfirstlane(eb.w);
          uint4 u[8], v[8];
#pragma unroll
          for (int k2 = 0; k2 < 8; ++k2) u[k2] = *(const uint4*)(EU + (size_t)es[k2] * 1024 + lane * 16);
#pragma unroll
          for (int k2 = 0; k2 < 8; ++k2) v[k2] = *(const uint4*)(EV + (size_t)es[k2] * 1024 + lane * 16);
          const int eslot = ep[lane & 7];
          const float gte = GATE[row * 128 + g * 8 + (lane & 7)], su = SCU[eslot], sv = SCV[eslot];
          float P[8];
#pragma unroll
          for (int k2 = 0; k2 < 8; ++k2) { float a0, a1, a2, a3, d;
            FP8X4(u[k2].x, a0, a1, a2, a3); d = a0 * hf[0] + a1 * hf[1] + a2 * hf[2] + a3 * hf[3];
            FP8X4(u[k2].y, a0, a1, a2, a3); d += a0 * hf[4] + a1 * hf[5] + a2 * hf[6] + a3 * hf[7];
            FP8X4(u[k2].z, a0, a1, a2, a3); d += a0 * hf[8] + a1 * hf[9] + a2 * hf[10] + a3 * hf[11];
            FP8X4(u[k2].w, a0, a1, a2, a3); d += a0 * hf[12] + a1 * hf[13] + a2 * hf[14] + a3 * hf[15];
            P[k2] = d; }
          { const bool up4 = (lane & 4) != 0;
#pragma unroll
            for (int e = 0; e < 4; ++e) { const float keep = up4 ? P[e + 4] : P[e], send = up4 ? P[e] : P[e + 4]; P[e] = keep + __shfl_xor(send, 4); }
            const bool up2 = (lane & 2) != 0;
#pragma unroll
            for (int e = 0; e < 2; ++e) { const float keep = up2 ? P[e + 2] : P[e], send = up2 ? P[e] : P[e + 2]; P[e] = keep + dpp_f<0x4E>(send); }
            const bool up1 = (lane & 1) != 0;
            const float keep = up1 ? P[1] : P[0], send = up1 ? P[0] : P[1];
            float av = keep + dpp_f<0xB1>(send);
            av += __shfl_xor(av, 8); av += __shfl_xor(av, 16); av += __shfl_xor(av, 32);
            av *= su;
            const float ax = fabsf(av), t = __builtin_amdgcn_rcpf(ax * 0.2316418882f + 1.0f);
            float q = t * 0.5307027145f + (-0.7265760135f); q = q * t + 0.7107068705f; q = q * t + (-0.142248368f); q = q * t + 0.127414796f; q = q * t;
            const float ee = __builtin_amdgcn_exp2f(av * av * (-0.72134752044f));
            const float mm = av * (q * ee), gl = (av < 0.f) ? mm : (av - mm);
            P[0] = gte * gl * sv; }
#pragma unroll
          for (int k2 = 0; k2 < 8; ++k2) { const float wk = __int_as_float(__builtin_amdgcn_readlane(__float_as_int(P[0]), k2)); float a0, a1, a2, a3;
            FP8X4(v[k2].x, a0, a1, a2, a3); acc[0] += wk * a0; acc[1] += wk * a1; acc[2] += wk * a2; acc[3] += wk * a3;
            FP8X4(v[k2].y, a0, a1, a2, a3); acc[4] += wk * a0; acc[5] += wk * a1; acc[6] += wk * a2; acc[7] += wk * a3;
            FP8X4(v[k2].z, a0, a1, a2, a3); acc[8] += wk * a0; acc[9] += wk * a1; acc[10] += wk * a2; acc[11] += wk * a3;
            FP8X4(v[k2].w, a0, a1, a2, a3); acc[12] += wk * a0; acc[13] += wk * a1; acc[14] += wk * a2; acc[15] += wk * a3; }
        }
        float ss = 0.f;
#pragma unroll
        for (int i = 0; i < 16; ++i) ss += acc[i] * acc[i];
        ss = wave_sum(ss); const float rs = rsqrtf(ss * (1.f / 1024.f) + EPS);
        float* orow = outp + tok * 1024 + lane * 16;
        if (pass == gather_reps - 1)
#pragma unroll
        for (int i = 0; i < 4; ++i) { const int d = lane * 16 + 4 * i;
          float4 x1 = *(const float4*)(orow + 4 * i); const float4 g3 = *(const float4*)(gpf2 + d), g2 = *(const float4*)(modb + 5120 + d);
          x1.x += g3.x * g2.x * acc[4 * i] * rs; x1.y += g3.y * g2.y * acc[4 * i + 1] * rs; x1.z += g3.z * g2.z * acc[4 * i + 2] * rs; x1.w += g3.w * g2.w * acc[4 * i + 3] * rs;
          *(float4*)(orow + 4 * i) = x1; }
      }
#undef FP8X4
    }
  }
}

DI void phase2_scan(const KP& p) {
  unsigned char* ws = p.ws;
  for (int g = blockIdx.x * NTHR + threadIdx.x; g < 131072; g += gridDim.x * NTHR) {
    const int seq = g >> 11, within = g & 2047, dv = within >> 4, dk4 = (within & 15) * 4, dir = seq & 1;
    bf16_t* base = (bf16_t*)(ws + WS_SPT) + ((size_t)seq * 32 * 128 + dv) * 64 + dk4;
    const float* dec = (const float*)(ws + WS_DEC) + (size_t)seq * 32 * 64 + dk4;
    float s0 = 0.f, s1 = 0.f, s2 = 0.f, s3 = 0.f;
#pragma unroll 1
    for (int i0 = 0; i0 < 32; i0 += 8) {
      uint2 d[8]; float4 c[8];
#pragma unroll
      for (int j = 0; j < 8; ++j) { const int n = dir ? 31 - (i0 + j) : (i0 + j); d[j] = *(const uint2*)(base + (size_t)n * 8192); c[j] = *(const float4*)(dec + n * 64); }
#pragma unroll
      for (int j = 0; j < 8; ++j) { const int n = dir ? 31 - (i0 + j) : (i0 + j);
        uint2 o; o.x = pack2(s0, s1); o.y = pack2(s2, s3); *(uint2*)(base + (size_t)n * 8192) = o;
        s0 = c[j].x * s0 + __uint_as_float(d[j].x << 16); s1 = c[j].y * s1 + __uint_as_float(d[j].x & 0xffff0000u);
        s2 = c[j].z * s2 + __uint_as_float(d[j].y << 16); s3 = c[j].w * s3 + __uint_as_float(d[j].y & 0xffff0000u); }
    }
  }
}

#define XB_TMO      128
#define XB_XCNT(j)  (256  + 64 * (j))
#define XB_XSUB(j)  (1280 + 64 * (j))
#define XB_XGEN(j)  (2304 + 64 * (j))
#define XB_TOP      3328
#define XB_TOPGEN   3392
#define XCD_BAR_WORDS 3456
#define XB_SPIN_CAP (1u << 18)
#define LAS __attribute__((address_space(3)))

__device__ __forceinline__ unsigned xb_ld(unsigned* p)              { return __hip_atomic_load(p, __ATOMIC_RELAXED, __HIP_MEMORY_SCOPE_AGENT); }
__device__ __forceinline__ unsigned xb_add(unsigned* p, unsigned v) { return __hip_atomic_fetch_add(p, v, __ATOMIC_RELAXED, __HIP_MEMORY_SCOPE_AGENT); }
__device__ __forceinline__ unsigned xb_xcc_id() { return (unsigned)__builtin_amdgcn_s_getreg((3 << 11) | 20) & 0xFu; }
#define XB_SPIN(cond, bar) do { unsigned _sp = 0; while (cond) { __builtin_amdgcn_s_sleep(1); \
    if ((++_sp & 255u) == 0u) { if (xb_ld(&(bar)[XB_TMO])) break; if (_sp > XB_SPIN_CAP) { atomicAdd(&(bar)[XB_TMO], 1u); break; } } } } while (0)

struct XcdBarrier {
    unsigned* bar; unsigned x;
    volatile LAS unsigned* st;
};

__device__ __forceinline__ XcdBarrier xcd_barrier_post(unsigned* bar, volatile LAS unsigned* st) {
    XcdBarrier b; b.bar = bar; b.x = xb_xcc_id(); b.st = st;
    if (threadIdx.x == 0) (void)xb_add(&bar[XB_XCNT(b.x)], 1u);
    return b;
}
__device__ __forceinline__ void xcd_barrier_complete(unsigned* bar, unsigned x, unsigned& nloc, unsigned& nx) {
    const unsigned G = gridDim.x * gridDim.y * gridDim.z;
    unsigned sum, cnt, mine, sp = 0u;
    for (;;) {
        sum = 0u; cnt = 0u; mine = 0u;
#pragma unroll
        for (unsigned j = 0; j < 16; ++j) { const unsigned c = xb_ld(&bar[XB_XCNT(j)]); sum += c; cnt += (c > 0u) ? 1u : 0u; mine = (j == x) ? c : mine; }
        if (sum == G) break;
        __builtin_amdgcn_s_sleep(1);
        if ((++sp & 255u) == 0u) { if (xb_ld(&bar[XB_TMO])) break; if (sp > XB_SPIN_CAP) { atomicAdd(&bar[XB_TMO], 1u); break; } }
    }
    nloc = mine > 0u ? mine : 1u; nx = cnt > 0u ? cnt : 1u;
}

__device__ __forceinline__ void xcd_barrier(const XcdBarrier& b) {
    asm volatile("s_waitcnt vmcnt(0)" ::: "memory");
    __syncthreads();
    if (threadIdx.x == 0) {
        unsigned* bar = b.bar;
        __builtin_amdgcn_s_waitcnt(0);
        unsigned nloc = b.st[0], nx = b.st[1];
        if (nloc == 0u) { xcd_barrier_complete(bar, b.x, nloc, nx); b.st[0] = nloc; b.st[1] = nx; }
        const unsigned old = xb_add(&bar[XB_XSUB(b.x)], 1u);
        const unsigned gen = old / nloc;
        if (old + 1u == (gen + 1u) * nloc) {
            __builtin_amdgcn_fence(__ATOMIC_RELEASE, "agent");
            asm volatile("s_waitcnt vmcnt(0)" ::: "memory");
            const unsigned og = xb_add(&bar[XB_TOP], 1u);
            const unsigned tg = og / nx;
            if (og + 1u == (tg + 1u) * nx) xb_add(&bar[XB_TOPGEN], 1u);
            else XB_SPIN(xb_ld(&bar[XB_TOPGEN]) == tg, bar);
            __builtin_amdgcn_fence(__ATOMIC_ACQUIRE, "agent");
            xb_add(&bar[XB_XGEN(b.x)], 1u);
            asm volatile("s_waitcnt vmcnt(0)" ::: "memory");
        } else {
            XB_SPIN(xb_ld(&bar[XB_XGEN(b.x)]) == gen, bar);
            __builtin_amdgcn_fence(__ATOMIC_ACQUIRE, "agent");
            asm volatile("s_waitcnt vmcnt(0)" ::: "memory");
        }
    }
    __syncthreads();
}

#ifndef PROBE_ID
#define PROBE_ID 0
#endif
__global__ void __launch_bounds__(NTHR, 2) mega(KP p) {
  extern __shared__ __attribute__((aligned(16))) char lds[];
  cg::grid_group grid = cg::this_grid();
  const int hi = p.ph_hi; constexpr int probe = PROBE_ID;
  if (threadIdx.x == 0) { ((volatile LAS unsigned*)(lds + LDS_XB))[0] = 0u; ((volatile LAS unsigned*)(lds + LDS_XB))[1] = 0u; }
  __syncthreads();
  const XcdBarrier xb = xcd_barrier_post((unsigned*)(p.ws + WS_BAR), (volatile LAS unsigned*)(lds + LDS_XB));
  if (p.ph_lo <= 0 && 0 < hi) { phase0(p, lds); if (probe == 1) phase0(p, lds); if (1 < hi) { if (hi > 64) grid.sync(); else xcd_barrier(xb); } }
  if (p.ph_lo <= 1 && 1 < hi) { phase1(p, lds); if (probe == 2) phase1(p, lds); if (2 < hi) xcd_barrier(xb); }
  if (p.ph_lo <= 2 && 2 < hi) { phase2_scan(p); phase2_attn(p, lds); if (probe == 3) phase2_attn(p, lds); if (3 < hi) xcd_barrier(xb); }
  if (p.ph_lo <= 3 && 3 < hi) {
    phase3(p, lds, 1, probe);
    xcd_barrier(xb);
    {
      pg8::Gemm g{(const pg8::bf16_t*)(p.ws + WS_P1S), (const pg8::bf16_t*)(p.ws + WS_WTPQP), NTOK, 2048, 1024};
      pg8::StaticOrder S; S.init(NTOK, 2048, (int)gridDim.x, (int)blockIdx.x);
      pg8::EpiBf16<0> E{(pg8::bf16_t*)(p.ws + WS_QM), 2048, nullptr, 0, 0, 1.f};
      pg8::gemm_phase<pg8::EpiBf16<0>, pg8::StaticOrder, true, true>((PG8_LAS unsigned char*)lds, g, S, E);
    }
    xcd_barrier(xb);
    phase3b(p, lds, probe == 4 ? 2 : 1, probe);
  }
}

extern "C" void kernel_launch(void* const* d_in, const int* in_sizes, int n_in, void* d_out, int out_size, void* d_ws, size_t ws_size, hipStream_t stream) {
  float* out = (float*)d_out;
  unsigned char* ws = (unsigned char*)d_ws;
  if (ws_size < WS_END || n_in != 25) return;
  static bool attr_done = false;
  if (!attr_done) { (void)hipFuncSetAttribute((const void*)mega, hipFuncAttributeMaxDynamicSharedMemorySize, LDS_TOTAL); attr_done = true; }
  KP p{};
  for (int i = 0; i < 25; ++i) p.in[i] = (const float*)d_in[i];
  p.out = out; p.ws = ws;
  p.ph_lo = 0; p.ph_hi = 4;
  (void)hipMemsetAsync(ws + WS_BAR, 0, XCD_BAR_WORDS * 4, stream);
  { void* args[] = {&p}; (void)hipLaunchCooperativeKernel((const void*)mega, dim3(256), dim3(NTHR), args, LDS_TOTAL, stream); }
}
```

```cpp
#include <hip/hip_runtime.h>
#include <hip/hip_cooperative_groups.h>
namespace cg = cooperative_groups;
#include <stdint.h>

typedef unsigned short bf16_t;
#define DI __device__ __forceinline__

DI float bf2f(bf16_t v) { return __uint_as_float(((unsigned)v) << 16); }
DI bf16_t f2bf(float f) { return __builtin_bit_cast(unsigned short, (__bf16)f); }

constexpr int BATCH = 8, SEQ = 2048, DM = 1024, NTOK = BATCH * SEQ;
constexpr int INW = 2272;
constexpr float EPS = 1e-6f;
constexpr int O_CQ = 0, O_CKV = 384, O_KR = 640, O_QG = 704, O_KG = 960, O_VG = 1216, O_GF = 1728, O_GB = 1744, O_R = 1760;

DI float wave_sum(float v) {
#pragma unroll
  for (int o = 1; o < 64; o <<= 1) v += __shfl_xor(v, o);
  return v;
}
DI float wave_max(float v) {
#pragma unroll
  for (int o = 1; o < 64; o <<= 1) v = fmaxf(v, __shfl_xor(v, o));
  return v;
}
DI float block_sum256(float v, float* red) {
  v = wave_sum(v);
  __syncthreads();
  if ((threadIdx.x & 63) == 0) red[threadIdx.x >> 6] = v;
  __syncthreads();
  return red[0] + red[1] + red[2] + red[3];
}
DI float block_max256(float v, float* red) {
  v = wave_max(v);
  __syncthreads();
  if ((threadIdx.x & 63) == 0) red[threadIdx.x >> 6] = v;
  __syncthreads();
  return fmaxf(fmaxf(red[0], red[1]), fmaxf(red[2], red[3]));
}
DI float silu_f(float x) { return x / (1.f + expf(-x)); }
DI float logsigmoid_f(float x) { return fminf(x, 0.f) - log1pf(expf(-fabsf(x))); }
DI float fexp(float x) { return __builtin_amdgcn_exp2f(x * 1.4426950408889634f); }
DI float silu_fast(float x) { return x * __builtin_amdgcn_rcpf(1.f + fexp(-x)); }
DI float logsigmoid_fast(float x) { return fminf(x, 0.f) - __builtin_amdgcn_logf(1.f + fexp(-fabsf(x))) * 0.6931471805599453f; }
DI float gelu_erf(float x) { return 0.5f * x * (1.f + erff(x * 0.70710678118654752f)); }

__global__ __launch_bounds__(256) void n_mod(const float* __restrict__ c, const float* __restrict__ w_ada, const float* __restrict__ b_ada, float* __restrict__ mod) {
  int idx = blockIdx.x * 256 + threadIdx.x;
  int b = idx / 6144, j = idx % 6144;
  float acc = b_ada[j];
  for (int k = 0; k < 1024; ++k) acc += silu_f(c[b * 1024 + k]) * w_ada[(size_t)k * 6144 + j];
  mod[idx] = acc;
}

__global__ __launch_bounds__(256) void n_hnorm(const float* __restrict__ x, const float* __restrict__ g, const float* __restrict__ mod, int b, int off_sh, int off_sc, float* __restrict__ h) {
  __shared__ float red[4];
  int t = blockIdx.x, tid = threadIdx.x;
  const float* xr = x + ((size_t)b * SEQ + t) * DM;
  float v[4]; float ss = 0.f;
#pragma unroll
  for (int i = 0; i < 4; ++i) { v[i] = xr[tid + 256 * i]; ss += v[i] * v[i]; }
  ss = block_sum256(ss, red);
  float rs = rsqrtf(ss * (1.f / DM) + EPS);
#pragma unroll
  for (int i = 0; i < 4; ++i) { int d = tid + 256 * i; h[(size_t)t * DM + d] = v[i] * rs * g[d] * (1.f + mod[b * 6144 + off_sc + d]) + mod[b * 6144 + off_sh + d]; }
}

template <bool BT>
__global__ __launch_bounds__(256) void n_gemm(const float* __restrict__ A, int lda, const float* __restrict__ B, int ldb, float* __restrict__ C, int ldc, int M, int N, int K) {
  __shared__ float As[16][65];
  __shared__ float Bs[16][65];
  const int tid = threadIdx.x, tx = tid & 15, ty = tid >> 4;
  const int m0 = blockIdx.y * 64, n0 = blockIdx.x * 64;
  float acc[4][4];
#pragma unroll
  for (int i = 0; i < 4; ++i)
#pragma unroll
    for (int j = 0; j < 4; ++j) acc[i][j] = 0.f;
  for (int k0 = 0; k0 < K; k0 += 16) {
#pragma unroll
    for (int i = 0; i < 4; ++i) { int e = tid + 256 * i; int m = e >> 4, k = e & 15; As[k][m] = A[(size_t)(m0 + m) * lda + k0 + k]; }
#pragma unroll
    for (int i = 0; i < 4; ++i) { int e = tid + 256 * i;
      if (!BT) { int k = e >> 6, n = e & 63; Bs[k][n] = (n0 + n < N) ? B[(size_t)(k0 + k) * ldb + n0 + n] : 0.f; }
      else     { int n = e >> 4, k = e & 15; Bs[k][n] = (n0 + n < N) ? B[(size_t)(n0 + n) * ldb + k0 + k] : 0.f; } }
    __syncthreads();
#pragma unroll
    for (int k = 0; k < 16; ++k) {
      float a[4], bb[4];
#pragma unroll
      for (int i = 0; i < 4; ++i) { a[i] = As[k][ty * 4 + i]; bb[i] = Bs[k][tx * 4 + i]; }
#pragma unroll
      for (int i = 0; i < 4; ++i)
#pragma unroll
        for (int j = 0; j < 4; ++j) acc[i][j] += a[i] * bb[j];
    }
    __syncthreads();
  }
#pragma unroll
  for (int i = 0; i < 4; ++i)
#pragma unroll
    for (int j = 0; j < 4; ++j) { int n = n0 + tx * 4 + j; if (n < N) C[(size_t)(m0 + ty * 4 + i) * ldc + n] = acc[i][j]; }
}

__global__ __launch_bounds__(256) void n_rms_slice(const float* __restrict__ in, int ldin, int off, int W, const float* __restrict__ g, float* __restrict__ out) {
  __shared__ float red[4];
  int t = blockIdx.x, tid = threadIdx.x;
  float v0 = (tid < W) ? in[(size_t)t * ldin + off + tid] : 0.f;
  float v1 = (tid + 256 < W) ? in[(size_t)t * ldin + off + tid + 256] : 0.f;
  float ss = block_sum256(v0 * v0 + v1 * v1, red);
  float rs = rsqrtf(ss / (float)W + EPS);
  if (tid < W) out[(size_t)t * W + tid] = v0 * rs * g[tid];
  if (tid + 256 < W) out[(size_t)t * W + tid + 256] = v1 * rs * g[tid + 256];
}

__global__ __launch_bounds__(256) void n_scatter(const float* __restrict__ proj, const float* __restrict__ qa, const float* __restrict__ kv, const int* __restrict__ positions, int b,
                                                 const float* __restrict__ wgf, const float* __restrict__ bgf, const float* __restrict__ wgb, const float* __restrict__ bgb,
                                                 bf16_t* __restrict__ Qm, bf16_t* __restrict__ Km, bf16_t* __restrict__ Vm, bf16_t* __restrict__ qg, bf16_t* __restrict__ kg, bf16_t* __restrict__ vg,
                                                 bf16_t* __restrict__ rg, float* __restrict__ laf, float* __restrict__ lab) {
  __shared__ float cs[32], sn[32];
  const int t = blockIdx.x, tid = threadIdx.x;
  const size_t tok = (size_t)b * SEQ + t;
  const float* pr = proj + (size_t)t * INW;
  const float* qr = qa + (size_t)t * 768;
  const float* kr = kv + (size_t)t * 1024;
  if (tid < 32) {
    float inv = powf(10000.f, -(float)tid / 32.f);
    float ang = (float)positions[tok] * inv;
    cs[tid] = cosf(ang); sn[tid] = sinf(ang);
  }
  __syncthreads();
  for (int e = tid; e < 4 * 192; e += 256) {
    int h = e / 192, d = e % 192; float v;
    if (d < 128) v = qr[h * 192 + d];
    else { int j = d - 128; const float* rp = qr + h * 192 + 128;
      if (j < 32) v = rp[j] * cs[j] - rp[j + 32] * sn[j]; else v = rp[j] * cs[j - 32] + rp[j - 32] * sn[j - 32]; }
    Qm[(((size_t)b * 4 + h) * SEQ + t) * 192 + d] = f2bf(v);
  }
  for (int e = tid; e < 4 * 192; e += 256) {
    int h = e / 192, d = e % 192; float v;
    if (d < 128) v = kr[h * 256 + d];
    else { int j = d - 128; const float* rp = pr + O_KR;
      if (j < 32) v = rp[j] * cs[j] - rp[j + 32] * sn[j]; else v = rp[j] * cs[j - 32] + rp[j - 32] * sn[j - 32]; }
    Km[(((size_t)b * 4 + h) * SEQ + t) * 192 + d] = f2bf(v);
  }
  for (int e = tid; e < 512; e += 256) { int h = e >> 7, d = e & 127; Vm[(((size_t)b * 4 + h) * SEQ + t) * 128 + d] = f2bf(kr[h * 256 + 128 + d]); }
  { int e = tid; qg[tok * 256 + e] = f2bf(pr[O_QG + e] * 0.125f); kg[tok * 256 + e] = f2bf(pr[O_KG + e]); }
  for (int e = tid; e < 512; e += 256) { vg[tok * 512 + e] = f2bf(pr[O_VG + e]); rg[tok * 512 + e] = f2bf(pr[O_R + e]); }
  { int cidx = tid; float af = bgf[cidx], ab = bgb[cidx];
#pragma unroll
    for (int r = 0; r < 16; ++r) { af += pr[O_GF + r] * wgf[r * 256 + cidx]; ab += pr[O_GB + r] * wgb[r * 256 + cidx]; }
    laf[tok * 256 + cidx] = logsigmoid_f(af) * (1.f / 16.f); lab[tok * 256 + cidx] = logsigmoid_f(ab) * (1.f / 16.f); }
}

__global__ __launch_bounds__(256) void n_attn(const bf16_t* __restrict__ Qm, const bf16_t* __restrict__ Km, const bf16_t* __restrict__ Vm, bf16_t* __restrict__ omla) {
  __shared__ float qs[192]; __shared__ float sc[2048]; __shared__ float red[4];
  const int i = blockIdx.x, h = blockIdx.y, b = blockIdx.z, tid = threadIdx.x;
  const size_t bh = (size_t)b * 4 + h;
  if (tid < 192) qs[tid] = bf2f(Qm[(bh * SEQ + i) * 192 + tid]);
  __syncthreads();
  float mx = -1e30f;
  for (int kk = 0; kk < 8; ++kk) {
    int key = tid + 256 * kk; const uint4* kr = (const uint4*)(Km + (bh * SEQ + key) * 192);
    float s = 0.f;
    for (int c = 0; c < 24; ++c) { uint4 w = kr[c]; const float* q = qs + c * 8;
      s += q[0] * __uint_as_float(w.x << 16) + q[1] * __uint_as_float(w.x & 0xffff0000u) + q[2] * __uint_as_float(w.y << 16) + q[3] * __uint_as_float(w.y & 0xffff0000u)
         + q[4] * __uint_as_float(w.z << 16) + q[5] * __uint_as_float(w.z & 0xffff0000u) + q[6] * __uint_as_float(w.w << 16) + q[7] * __uint_as_float(w.w & 0xffff0000u); }
    s *= 0.07216878364870322f; sc[key] = s; mx = fmaxf(mx, s);
  }
  mx = block_max256(mx, red);
  float sum = 0.f;
  for (int kk = 0; kk < 8; ++kk) { int key = tid + 256 * kk; float p = expf(sc[key] - mx); sc[key] = p; sum += p; }
  sum = block_sum256(sum, red);
  __syncthreads();
  if (tid < 128) { float o = 0.f; const bf16_t* vp = Vm + bh * SEQ * 128 + tid;
    for (int key = 0; key < SEQ; ++key) o += sc[key] * bf2f(vp[(size_t)key * 128]);
    omla[((size_t)b * SEQ + i) * 512 + h * 128 + tid] = f2bf(o / sum); }
}

__global__ __launch_bounds__(128) void n_gla(const bf16_t* __restrict__ qg, const bf16_t* __restrict__ kg, const bf16_t* __restrict__ vg, const bf16_t* __restrict__ laf, const bf16_t* __restrict__ lab, float* __restrict__ og) {
  __shared__ float qs[64], ks[64], as[64];
  const int bh = blockIdx.x, b = bh >> 2, h = bh & 3, dv = threadIdx.x;
  for (int dir = 0; dir < 2; ++dir) {
    float S[64];
#pragma unroll
    for (int d = 0; d < 64; ++d) S[d] = 0.f;
    const bf16_t* la = dir ? lab : laf;
    for (int s = 0; s < SEQ; ++s) {
      const int t = dir ? (SEQ - 1 - s) : s; const size_t tok = (size_t)b * SEQ + t;
      __syncthreads();
      if (dv < 64) { qs[dv] = bf2f(qg[tok * 256 + h * 64 + dv]); ks[dv] = bf2f(kg[tok * 256 + h * 64 + dv]); as[dv] = expf(bf2f(la[tok * 256 + h * 64 + dv])); }
      __syncthreads();
      const float v = bf2f(vg[tok * 512 + h * 128 + dv]); float o = 0.f;
#pragma unroll
      for (int d = 0; d < 64; ++d) { S[d] = as[d] * S[d] + ks[d] * v; o += qs[d] * S[d]; }
      if (dir == 0) og[tok * 512 + h * 128 + dv] = o; else og[tok * 512 + h * 128 + dv] += o;
    }
  }
}

__global__ __launch_bounds__(256) void n_mix(const bf16_t* __restrict__ omla, const float* __restrict__ og, const bf16_t* __restrict__ rg, const float* __restrict__ g_gla, int b, float* __restrict__ mix) {
  __shared__ float ssum[4];
  const int t = blockIdx.x, tid = threadIdx.x; const size_t tok = (size_t)b * SEQ + t;
  if (tid < 4) ssum[tid] = 0.f;
  __syncthreads();
  float v[2];
#pragma unroll
  for (int i = 0; i < 2; ++i) { int e = tid + 256 * i; v[i] = og[tok * 512 + e]; atomicAdd(&ssum[e >> 7], v[i] * v[i]); mix[(size_t)t * DM + e] = bf2f(omla[tok * 512 + e]); }
  __syncthreads();
#pragma unroll
  for (int i = 0; i < 2; ++i) { int e = tid + 256 * i; float rs = rsqrtf(ssum[e >> 7] * (1.f / 128.f) + EPS);
    mix[(size_t)t * DM + 512 + e] = v[i] * rs * g_gla[e & 127] * silu_f(bf2f(rg[tok * 512 + e])); }
}

__global__ __launch_bounds__(256) void n_post1(const float* __restrict__ x, const float* __restrict__ y, const float* __restrict__ g_post, const float* __restrict__ g_pre2, const float* __restrict__ mod, int b,
                                               float* __restrict__ out, float* __restrict__ h2) {
  __shared__ float red[4];
  const int t = blockIdx.x, tid = threadIdx.x; const size_t tok = (size_t)b * SEQ + t;
  float yv[4], xv[4]; float ss = 0.f;
#pragma unroll
  for (int i = 0; i < 4; ++i) { yv[i] = y[(size_t)t * DM + tid + 256 * i]; ss += yv[i] * yv[i]; }
  ss = block_sum256(ss, red);
  float rs = rsqrtf(ss * (1.f / DM) + EPS); float s2 = 0.f;
#pragma unroll
  for (int i = 0; i < 4; ++i) { int d = tid + 256 * i; xv[i] = x[tok * DM + d] + mod[b * 6144 + 2048 + d] * (yv[i] * rs * g_post[d]); out[tok * DM + d] = xv[i]; s2 += xv[i] * xv[i]; }
  s2 = block_sum256(s2, red);
  float r2 = rsqrtf(s2 * (1.f / DM) + EPS);
#pragma unroll
  for (int i = 0; i < 4; ++i) { int d = tid + 256 * i; h2[(size_t)t * DM + d] = xv[i] * r2 * g_pre2[d] * (1.f + mod[b * 6144 + 4096 + d]) + mod[b * 6144 + 3072 + d]; }
}

DI void wave_argmax(float& v, int& i) {
#pragma unroll
  for (int o = 1; o < 64; o <<= 1) { float ov = __shfl_xor(v, o); int oi = __shfl_xor(i, o); if (ov > v || (ov == v && oi < i)) { v = ov; i = oi; } }
}
__global__ __launch_bounds__(256) void n_peer_select(const float* __restrict__ qry, const float* __restrict__ sk1, const float* __restrict__ sk2, int* __restrict__ eidx, float* __restrict__ gate) {
  __shared__ float v1s[4][16], v2s[4][16]; __shared__ int i1s[4][16], i2s[4][16];
  const int w = threadIdx.x >> 6, lane = threadIdx.x & 63;
  const int pair = blockIdx.x * 4 + w;
  const int t = pair >> 3, h = pair & 7;
  const float* q1 = qry + (size_t)t * 2048 + h * 256; const float* q2 = q1 + 128;
  float s1a = 0.f, s1b = 0.f, s2a = 0.f, s2b = 0.f;
  for (int d = 0; d < 128; ++d) { float a = q1[d], bq = q2[d];
    s1a += a * sk1[lane * 128 + d]; s1b += a * sk1[(lane + 64) * 128 + d]; s2a += bq * sk2[lane * 128 + d]; s2b += bq * sk2[(lane + 64) * 128 + d]; }
  for (int side = 0; side < 2; ++side) {
    float va = side ? s2a : s1a, vb = side ? s2b : s1b; bool ta = false, tb = false;
    for (int k = 0; k < 16; ++k) {
      float bv; int bi;
      if (!ta && (tb || va >= vb)) { bv = va; bi = lane; } else if (!tb) { bv = vb; bi = lane + 64; } else { bv = -3e38f; bi = 1 << 20; }
      wave_argmax(bv, bi);
      if (bi == lane) ta = true; if (bi == lane + 64) tb = true;
      if (lane == 0) { if (side) { v2s[w][k] = bv; i2s[w][k] = bi; } else { v1s[w][k] = bv; i1s[w][k] = bi; } }
    }
  }
  __syncthreads();
  float cv[4]; bool tk[4];
#pragma unroll
  for (int j = 0; j < 4; ++j) { int c = lane + 64 * j; cv[j] = v1s[w][c >> 4] + v2s[w][c & 15]; tk[j] = false; }
  float topv = 0.f; int topc = 0; float mx = 0.f;
  for (int k = 0; k < 16; ++k) {
    float bv = -3e38f; int bi = 1 << 20;
#pragma unroll
    for (int j = 0; j < 4; ++j) { if (!tk[j] && cv[j] > bv) { bv = cv[j]; bi = lane + 64 * j; } }
    wave_argmax(bv, bi);
#pragma unroll
    for (int j = 0; j < 4; ++j) if (bi == lane + 64 * j) tk[j] = true;
    if (k == 0) mx = bv;
    if (lane == k) { topv = bv; topc = bi; }
  }
  float e = (lane < 16) ? expf(topv - mx) : 0.f;
  float sum = wave_sum(e);
  if (lane < 16) { eidx[(size_t)pair * 16 + lane] = i1s[w][topc >> 4] * 128 + i2s[w][topc & 15]; gate[(size_t)pair * 16 + lane] = e / sum; }
}

__global__ __launch_bounds__(256) void n_peer_apply(const float* __restrict__ h2, const int* __restrict__ eidx, const float* __restrict__ gate, const float* __restrict__ eu, const float* __restrict__ ev,
                                                    const float* __restrict__ g_post, const float* __restrict__ mod, int b, float* __restrict__ out) {
  __shared__ float ys[4][1024]; __shared__ float red[4];
  const int t = blockIdx.x, tid = threadIdx.x, w = tid >> 6, lane = tid & 63; const size_t tok = (size_t)b * SEQ + t;
  float4 hx[4];
#pragma unroll
  for (int i = 0; i < 4; ++i) hx[i] = *(const float4*)(h2 + (size_t)t * DM + (lane + 64 * i) * 4);
  float4 acc[4];
#pragma unroll
  for (int i = 0; i < 4; ++i) acc[i] = make_float4(0.f, 0.f, 0.f, 0.f);
  for (int k = w; k < 128; k += 4) {
    const int e = eidx[(size_t)t * 128 + k]; const float gt = gate[(size_t)t * 128 + k];
    const float4* ur = (const float4*)(eu + (size_t)e * DM); const float4* vr = (const float4*)(ev + (size_t)e * DM);
    float d = 0.f;
#pragma unroll
    for (int i = 0; i < 4; ++i) { float4 u = ur[lane + 64 * i]; d += u.x * hx[i].x + u.y * hx[i].y + u.z * hx[i].z + u.w * hx[i].w; }
    d = wave_sum(d);
    const float wgt = gt * gelu_erf(d);
#pragma unroll
    for (int i = 0; i < 4; ++i) { float4 v = vr[lane + 64 * i]; acc[i].x += wgt * v.x; acc[i].y += wgt * v.y; acc[i].z += wgt * v.z; acc[i].w += wgt * v.w; }
  }
#pragma unroll
  for (int i = 0; i < 4; ++i) *(float4*)(&ys[w][(lane + 64 * i) * 4]) = acc[i];
  __syncthreads();
  float yv[4]; float ss = 0.f;
#pragma unroll
  for (int i = 0; i < 4; ++i) { int d = tid + 256 * i; yv[i] = ys[0][d] + ys[1][d] + ys[2][d] + ys[3][d]; ss += yv[i] * yv[i]; }
  ss = block_sum256(ss, red);
  const float rs = rsqrtf(ss * (1.f / DM) + EPS);
#pragma unroll
  for (int i = 0; i < 4; ++i) { int d = tid + 256 * i; out[tok * DM + d] = out[tok * DM + d] + mod[b * 6144 + 5120 + d] * (yv[i] * rs * g_post[d]); }
}

typedef short bf16x8 __attribute__((ext_vector_type(8)));
typedef float f32x16 __attribute__((ext_vector_type(16)));
#define MFMA32(a, b, c) __builtin_amdgcn_mfma_f32_32x32x16_bf16((a), (b), (c), 0, 0, 0)

constexpr int NTHR = 512;
constexpr size_t MiB = 1024 * 1024;
constexpr size_t WS_MOD   = 0;
constexpr size_t WS_WTIN  = 256 * 1024;
constexpr size_t WS_WTQUP = WS_WTIN + (size_t)2304 * 1024 * 2;
constexpr size_t WS_WTKVUP = WS_WTQUP + (size_t)768 * 384 * 2;
constexpr size_t WS_WTOUT = WS_WTKVUP + (size_t)1024 * 256 * 2;
constexpr size_t WS_WTPQ  = WS_WTOUT + (size_t)1024 * 1024 * 2;
constexpr size_t WS_KD    = WS_WTPQ + (size_t)2048 * 1024 * 2;
constexpr size_t WS_DEC   = WS_KD + (size_t)256 * 256 * 2;
constexpr size_t WS_ESC   = WS_DEC + (size_t)2048 * 64 * 4;
constexpr size_t WS_R0END = WS_ESC + (size_t)2 * 16384 * 4;
static_assert(WS_R0END <= 13 * MiB, "R0");
constexpr size_t WS_BAR  = 13 * MiB - 65536;
static_assert(WS_R0END + 131072 <= WS_BAR, "R0 room");
constexpr size_t WS_QM   = 13 * MiB;
constexpr size_t WS_KM   = WS_QM + 24 * MiB;
constexpr size_t WS_VM   = WS_KM + 24 * MiB;
constexpr size_t WS_P1S  = WS_VM + 16 * MiB;
constexpr size_t WS_RG   = WS_P1S + 32 * MiB;
constexpr size_t WS_OINTRA = WS_RG + 16 * MiB;
constexpr size_t WS_QDEC = WS_OINTRA + 16 * MiB;
constexpr size_t WS_SPT  = WS_QDEC + 16 * MiB;
constexpr size_t WS_EU   = WS_SPT + 32 * MiB;
constexpr size_t WS_EV   = WS_EU + 16 * MiB;
constexpr size_t WS_WTPQP = WS_EV + 16 * MiB;
constexpr size_t WS_WTOUTP = WS_WTPQP + 4 * MiB;
constexpr size_t WS_WTINP = WS_WTOUTP + 2 * MiB;
constexpr size_t WS_PROJC = WS_WTINP + 4608 * 1024;
constexpr size_t WS_END  = WS_PROJC + 8 * MiB;
static_assert(WS_P1S == WS_QM + 64 * MiB, "P3 QRY scratch aliases QM..VM");
constexpr size_t OUT_HS  = 0;
constexpr size_t OUT_CQ  = 32 * MiB;
constexpr size_t OUT_GR  = 52 * MiB;

struct KP { const float* in[25]; float* out; unsigned char* ws; int ph_lo, ph_hi; };

constexpr int G_STG = 40960;
constexpr int LDS_WT = 3 * G_STG;
constexpr int LDS_TAB = LDS_WT + 18432;
constexpr int LDS_XB = 157696;
constexpr int LDS_TOTAL = 157696 + 16;

typedef float f32x2_t __attribute__((ext_vector_type(2)));
typedef __bf16 bf16x2_t __attribute__((ext_vector_type(2)));
DI unsigned pack2(float lo, float hi) { const f32x2_t v = {lo, hi}; return __builtin_bit_cast(unsigned, __builtin_convertvector(v, bf16x2_t)); }
DI int crow(int reg, int hh) { return (reg & 3) + 8 * (reg >> 2) + 4 * hh; }

#define GLDS16(gp, lp) __builtin_amdgcn_global_load_lds((const unsigned*)(gp), (__attribute__((address_space(3))) unsigned*)(lp), 16, 0, 0)
template <int NST, class Epi>
DI void block_gemm(char* lds, const bf16_t* A, int lda, const bf16_t* Bt, int nchunks, int K, Epi&& epi) {
  const int tid = threadIdx.x, lane = tid & 63, w = __builtin_amdgcn_readfirstlane(tid >> 6), r = lane & 31, hh = lane >> 5;
  const int nk = K >> 6, T = nchunks * nk;
  constexpr int D = NST - 1;
  if (w >= 4) {
    const int j = w - 4, rin = lane >> 3, sw = ((lane & 7) ^ rin) * 8;
    const bf16_t* Ap = A + (size_t)(16 * j + rin) * lda + sw;
    const bf16_t* Bp = Bt + (size_t)(64 * j + rin) * 64 + sw;
    auto dma = [&](int g) {
      const int ch = g / nk, t = g - ch * nk; char* st = lds + (g % NST) * G_STG;
      const bf16_t* a0 = Ap + t * 64; char* la = st + (2 * j) * 1024;
      GLDS16(a0, la); GLDS16(a0 + (size_t)8 * lda, la + 1024);
      const bf16_t* b0 = Bp + (size_t)g * 16384; char* lb = st + 8192 + (8 * j) * 1024;
#pragma unroll
      for (int i = 0; i < 8; ++i) GLDS16(b0 + i * 512, lb + i * 1024);
    };
#pragma unroll
    for (int g = 0; g < D; ++g) if (g < T) dma(g);
    if (D >= 2 && T >= 2) asm volatile("s_waitcnt vmcnt(10)" ::: "memory"); else asm volatile("s_waitcnt vmcnt(0)" ::: "memory");
    __builtin_amdgcn_s_barrier();
#pragma unroll 1
    for (int g = 0; g < T; ++g) {
      if (g + D < T) { dma(g + D); if (D >= 2) asm volatile("s_waitcnt vmcnt(10)" ::: "memory"); else asm volatile("s_waitcnt vmcnt(0)" ::: "memory"); }
      else asm volatile("s_waitcnt vmcnt(0)" ::: "memory");
      __builtin_amdgcn_s_barrier();
    }
  } else {
    const int x = r & 7;
    const int o0 = ((0 + hh) ^ x) * 16, o1 = ((2 + hh) ^ x) * 16, o2 = ((4 + hh) ^ x) * 16, o3 = ((6 + hh) ^ x) * 16;
    const int a_rd = r * 128, b_rd = 8192 + (w * 64 + r) * 128;
    __builtin_amdgcn_s_barrier();
    int g = 0;
#pragma unroll 1
    for (int ch = 0; ch < nchunks; ++ch) {
      f32x16 c00, c01, c10, c11;
#pragma unroll
      for (int i = 0; i < 16; ++i) { c00[i] = 0.f; c01[i] = 0.f; c10[i] = 0.f; c11[i] = 0.f; }
#pragma unroll 1
      for (int t = 0; t < nk; ++t, ++g) {
        const char* cur = lds + (g % NST) * G_STG;
        bf16x8 fa0[4], fa1[4], fb0[4], fb1[4];
#define FRD(s_, o_) do { fa0[s_] = *(const bf16x8*)(cur + a_rd + o_); fb0[s_] = *(const bf16x8*)(cur + b_rd + o_); fb1[s_] = *(const bf16x8*)(cur + b_rd + 4096 + o_); fa1[s_] = *(const bf16x8*)(cur + a_rd + 4096 + o_); } while (0)
        FRD(0, o0); FRD(1, o1); FRD(2, o2); FRD(3, o3);
#undef FRD
        asm volatile("s_waitcnt lgkmcnt(0)" ::: "memory");
        __builtin_amdgcn_s_barrier();
        __builtin_amdgcn_sched_barrier(0);
#pragma unroll
        for (int s = 0; s < 4; ++s) {
          c00 = MFMA32(fa0[s], fb0[s], c00); c01 = MFMA32(fa0[s], fb1[s], c01); c10 = MFMA32(fa1[s], fb0[s], c10); c11 = MFMA32(fa1[s], fb1[s], c11); }
      }
      epi(0, ch * 256 + w * 64, c00, c01);
      epi(32, ch * 256 + w * 64, c10, c11);
    }
  }
}

DI void p0_transpose(char* lds, const float* __restrict__ W, int K, int N, bf16_t* __restrict__ Wt, int item, bf16_t* __restrict__ Wplain = nullptr) {
  float* s = (float*)lds;
  const int tid = threadIdx.x;
  const int ntn = (N + 63) >> 6, kt = item / ntn, nt = item % ntn, k0 = kt * 64, n0 = nt * 64;
  __syncthreads();
#pragma unroll
  for (int i = 0; i < 8; ++i) { int e = tid + 512 * i; int kk = e >> 6, nn = e & 63; s[kk * 65 + nn] = (n0 + nn < N) ? W[(size_t)(k0 + kk) * N + n0 + nn] : 0.f; }
  __syncthreads();
  const int nn = tid >> 3, part = tid & 7;
  const float* sp = s + (part * 8) * 65 + nn;
  uint4 o; o.x = pack2(sp[0], sp[65]); o.y = pack2(sp[2 * 65], sp[3 * 65]); o.z = pack2(sp[4 * 65], sp[5 * 65]); o.w = pack2(sp[6 * 65], sp[7 * 65]);
  { const int n = n0 + nn; *(uint4*)(Wt + ((size_t)((n >> 8) * (K >> 6) + kt)) * 16384 + (n & 255) * 64 + part * 8) = o; }
  if (Wplain) *(uint4*)(Wplain + (size_t)(n0 + nn) * K + k0 + part * 8) = o;
}

DI void phase0(const KP& p, char* lds) {
  const int tid = threadIdx.x, bid = blockIdx.x, nb = gridDim.x;
  unsigned char* ws = p.ws;
  constexpr int I_IN = 16 * 36, I_QUP = 6 * 12, I_KVUP = 4 * 16, I_OUT = 16 * 16, I_PQ = 16 * 32;
  constexpr int I_ALL = I_IN + I_QUP + I_KVUP + I_OUT + I_PQ;
  for (int it = bid; it < I_ALL; it += nb) {
    int q = it;
    if (q < I_IN) { p0_transpose(lds, p.in[7], 1024, 2272, (bf16_t*)(ws + WS_WTIN), q, (bf16_t*)(ws + WS_WTINP)); continue; } q -= I_IN;
    if (q < I_QUP) { p0_transpose(lds, p.in[9], 384, 768, (bf16_t*)(ws + WS_WTQUP), q); continue; } q -= I_QUP;
    if (q < I_KVUP) { p0_transpose(lds, p.in[11], 256, 1024, (bf16_t*)(ws + WS_WTKVUP), q); continue; } q -= I_KVUP;
    if (q < I_OUT) { p0_transpose(lds, p.in[17], 1024, 1024, (bf16_t*)(ws + WS_WTOUT), q, (bf16_t*)(ws + WS_WTOUTP)); continue; } q -= I_OUT;
    p0_transpose(lds, p.in[20], 1024, 2048, (bf16_t*)(ws + WS_WTPQ), q, (bf16_t*)(ws + WS_WTPQP));
  }
  { bf16_t* kd = (bf16_t*)(ws + WS_KD);
    for (int e = bid * NTHR + tid; e < 65536; e += nb * NTHR) { int n = e >> 8, k = e & 255; float v = 0.f;
      if (n < 128 && k < 128) v = p.in[21][n * 128 + k]; else if (n >= 128 && k >= 128) v = p.in[22][(n - 128) * 128 + (k - 128)];
      kd[(size_t)(k >> 6) * 16384 + n * 64 + (k & 63)] = f2bf(v); } }
  { const int lane = tid & 63; float* scl = (float*)(ws + WS_ESC);
    for (int row = bid * 8 + (tid >> 6); row < 32768; row += nb * 8) { const int t = row >> 14, e = row & 16383;
      const float* src = p.in[23 + t] + (size_t)e * 1024 + lane * 16;
      float4 x[4]; float am = 0.f;
#pragma unroll
      for (int i = 0; i < 4; ++i) { x[i] = *(const float4*)(src + 4 * i); am = fmaxf(am, fmaxf(fmaxf(fabsf(x[i].x), fabsf(x[i].y)), fmaxf(fabsf(x[i].z), fabsf(x[i].w)))); }
      am = wave_max(am);
      float sc = 1.f, isc = 1.f;
      if (am > 0.f) { int ex; (void)frexpf(448.f / am, &ex); sc = ldexpf(1.f, ex - 1); isc = ldexpf(1.f, 1 - ex); }
      unsigned wv[4];
#pragma unroll
      for (int i = 0; i < 4; ++i) { int q = __builtin_amdgcn_cvt_pk_fp8_f32(x[i].x * sc, x[i].y * sc, 0, false); q = __builtin_amdgcn_cvt_pk_fp8_f32(x[i].z * sc, x[i].w * sc, q, true); wv[i] = (unsigned)q; }
      *(uint4*)(ws + (t ? WS_EV : WS_EU) + (size_t)e * 1024 + lane * 16) = make_uint4(wv[0], wv[1], wv[2], wv[3]);
      if (lane == 0) scl[t * 16384 + e] = isc; } }
  for (int jb = bid; jb < 96; jb += nb) {
    __syncthreads();
    float* cact = (float*)lds;
    float* red = (float*)(lds + 32768);
    for (int e = tid; e < 8192; e += NTHR) cact[e] = silu_f(p.in[1][e]);
    __syncthreads();
    const int jj = tid & 63, ks = tid >> 6, j0 = jb * 64;
    float acc[8];
#pragma unroll
    for (int b = 0; b < 8; ++b) acc[b] = 0.f;
    const float* wp = p.in[3] + (size_t)(ks * 128) * 6144 + j0 + jj;
    for (int k = 0; k < 128; ++k) { const float wv = wp[(size_t)k * 6144];
#pragma unroll
      for (int b = 0; b < 8; ++b) acc[b] += cact[b * 1024 + ks * 128 + k] * wv; }
#pragma unroll
    for (int b = 0; b < 8; ++b) red[(ks * 64 + jj) * 8 + b] = acc[b];
    __syncthreads();
    { const int b = tid >> 6; float sacc = p.in[4][j0 + jj];
#pragma unroll
      for (int k2 = 0; k2 < 8; ++k2) sacc += red[(k2 * 64 + jj) * 8 + b];
      ((float*)(ws + WS_MOD))[b * 6144 + j0 + jj] = sacc; }
  }
}

constexpr int WT_STRIDE = 144, WT_BYTES = 32 * WT_STRIDE;
DI void wt_write(char* wl, const f32x16& a0, const f32x16& a1, int r, int hh, float scale) {
  char* bp = wl + (4 * hh) * WT_STRIDE + r * 2;
#pragma unroll
  for (int reg = 0; reg < 16; ++reg) { const int ro = ((reg & 3) + 8 * (reg >> 2)) * WT_STRIDE;
    *(bf16_t*)(bp + ro) = f2bf(a0[reg] * scale); *(bf16_t*)(bp + ro + 64) = f2bf(a1[reg] * scale); }
}
DI void wt_write_rope(char* wl, const f32x16& a0, const f32x16& a1, int r, int hh, const float* cs, const float* sn, int m0) {
  char* bp = wl + (4 * hh) * WT_STRIDE + r * 2;
#pragma unroll
  for (int reg = 0; reg < 16; ++reg) { const int rw = (reg & 3) + 8 * (reg >> 2); const int row = m0 + rw + 4 * hh;
    const float c = cs[row * 32 + r], s = sn[row * 32 + r];
    *(bf16_t*)(bp + rw * WT_STRIDE) = f2bf(a0[reg] * c - a1[reg] * s); *(bf16_t*)(bp + rw * WT_STRIDE + 64) = f2bf(a1[reg] * c + a0[reg] * s); }
}
DI void wt_store(const char* wl, int lane, bf16_t* dA, int sA, bf16_t* dB, int sB) {
  const int piece = lane & 7, rsub = lane >> 3;
  bf16_t* d = (piece < 4) ? dA : dB; const int st = (piece < 4) ? sA : sB;
  if (d) {
#pragma unroll
    for (int i = 0; i < 4; ++i) { const int row = i * 8 + rsub; const uint4 v = *(const uint4*)(wl + row * WT_STRIDE + piece * 16);
      *(uint4*)(d + (size_t)row * st + (piece & 3) * 8) = v; }
  }
}
#define LDS_FENCE() asm volatile("s_waitcnt lgkmcnt(0)" ::: "memory")
DI int lv(int x) { asm volatile("" : "+v"(x)); return x; }
template <class T> DI T* launder(T* q) { size_t z = 0; asm volatile("" : "+s"(z)); return (T*)((char*)q + z); }

constexpr int GL_GR = 0, GL_VT = 8192, GL_QD = 26624, GL_KI = 45056, GL_KIT = 63488, GL_ATT = 81920, GL_TOT = 91136, GL_DEC = 93184, GL_LA = 93696  , GL_QS = 126464  , GL_KS = 134656;
DI void gla_chunk_local(const KP& p, char* lds, unsigned char* ws, int tile, const bf16_t* PA, const bf16_t* PB) {
  const int tid = lv(threadIdx.x), lane = tid & 63, w = tid >> 6, r = lane & 31, hh = lane >> 5;
  const int b = tile >> 5, n = tile & 31, tok0 = tile * 64;
  float* GRL = (float*)(lds + GL_GR); float* TOT = (float*)(lds + GL_TOT); float* DECL = (float*)(lds + GL_DEC);
  __syncthreads();
#pragma unroll
  for (int i = 0; i < 4; ++i) { const int e = tid + 512 * i; GRL[e] = bf2f(PB[(size_t)(e >> 5) * 1024 + (O_GF - 1024) + (e & 31)]); }
#pragma unroll 1
  for (int h = 0; h < 4; ++h) {
    __syncthreads();
    { const int t = tid >> 3, c8 = (tid & 7) * 8;
      *(uint4*)(lds + GL_QS + (t * 64 + c8) * 2) = *(const uint4*)(PA + (size_t)t * 1024 + O_QG + h * 64 + c8);
      *(uint4*)(lds + GL_KS + (t * 64 + c8) * 2) = (h == 0) ? *(const uint4*)(PA + (size_t)t * 1024 + O_KG + c8) : *(const uint4*)(PB + (size_t)t * 1024 + (O_KG - 1024) + h * 64 + c8); }
#pragma unroll
    for (int i = 0; i < 2; ++i) { const int c = tid + 512 * i, t = c >> 4, d8 = (c & 15) * 8;
      const uint4 v = *(const uint4*)(PB + (size_t)t * 1024 + (O_VG - 1024) + h * 128 + d8);
      bf16_t* vt = (bf16_t*)(lds + GL_VT) + d8 * 72 + t;
      vt[0] = (bf16_t)(v.x & 0xffffu); vt[72] = (bf16_t)(v.x >> 16); vt[144] = (bf16_t)(v.y & 0xffffu); vt[216] = (bf16_t)(v.y >> 16);
      vt[288] = (bf16_t)(v.z & 0xffffu); vt[360] = (bf16_t)(v.z >> 16); vt[432] = (bf16_t)(v.w & 0xffffu); vt[504] = (bf16_t)(v.w >> 16); }
    const int dir = tid >> 8, qt = (tid >> 6) & 3, dk = tid & 63, col = h * 64 + dk;
    float* LAL = (float*)(lds + GL_LA) + tid;
    {
      const float* wg = launder(dir ? p.in[14] : p.in[12]); const float* bg = launder(dir ? p.in[15] : p.in[13]);
      float wr[16];
#pragma unroll
      for (int q = 0; q < 16; ++q) wr[q] = wg[q * 256 + col];
      const float bias = bg[col];
      float run = 0.f;
#pragma unroll 2
      for (int ii = 0; ii < 16; ++ii) { const int i = dir ? 15 - ii : ii;
        const float* gp = GRL + (qt * 16 + i) * 32 + dir * 16; float x = bias;
#pragma unroll
        for (int q = 0; q < 16; ++q) x += gp[q] * wr[q];
        run += logsigmoid_fast(x) * (1.f / 16.f); LAL[i * 512] = run; }
      TOT[(dir * 64 + dk) * 4 + qt] = run;
    }
    __syncthreads();
    {
      const float4 tq = *(const float4*)(TOT + (dir * 64 + dk) * 4);
      const float total = (tq.x + tq.y) + (tq.z + tq.w);
      float off;
      if (dir == 0) off = (qt > 0 ? tq.x : 0.f) + (qt > 1 ? tq.y : 0.f) + (qt > 2 ? tq.z : 0.f);
      else          off = (qt < 1 ? tq.y : 0.f) + (qt < 2 ? tq.z : 0.f) + (qt < 3 ? tq.w : 0.f);
      if (qt == 0) { const float dc = fexp(total); DECL[dir * 64 + dk] = dc; ((float*)(ws + WS_DEC))[((size_t)((b * 4 + h) * 2 + dir) * 32 + n) * 64 + dk] = dc; }
      bf16_t* QD = (bf16_t*)(lds + GL_QD + dir * 9216) + (qt * 16) * 72 + dk; bf16_t* KI = (bf16_t*)(lds + GL_KI + dir * 9216) + (qt * 16) * 72 + dk;
      bf16_t* KIT = (bf16_t*)(lds + GL_KIT + dir * 9216) + dk * 72 + qt * 16;
      bf16_t* qdg = (bf16_t*)(ws + WS_QDEC) + (size_t)((tile * 4 + h) * 2 + dir) * 4096 + (qt * 16) * 64 + dk;
      const bf16_t* qgp = (const bf16_t*)(lds + GL_QS) + (qt * 16) * 64 + dk; const bf16_t* kgp = (const bf16_t*)(lds + GL_KS) + (qt * 16) * 64 + dk;
#pragma unroll 2
      for (int i = 0; i < 16; ++i) { const float bb = off + LAL[i * 512];
        const float qv = bf2f(qgp[i * 64]) * 0.125f, kv = bf2f(kgp[i * 64]);
        const float eb = fexp(bb); const bf16_t qd = f2bf(qv * eb), ki = f2bf(kv * __builtin_amdgcn_rcpf(eb));
        QD[i * 72] = qd; KI[i * 72] = ki; qdg[i * 64] = qd; KIT[i] = ki; }
    }
    __syncthreads();
    if (w < 4) { const int mi = w >> 1, ni = w & 1;
      f32x16 asum;
#pragma unroll
      for (int i = 0; i < 16; ++i) asum[i] = 0.f;
#pragma unroll
      for (int d = 0; d < 2; ++d) { f32x16 acc;
#pragma unroll
        for (int i = 0; i < 16; ++i) acc[i] = 0.f;
#pragma unroll
        for (int s = 0; s < 4; ++s) { const bf16x8 a = *(const bf16x8*)(lds + GL_QD + d * 9216 + (mi * 32 + r) * 144 + s * 32 + hh * 16);
          const bf16x8 bb = *(const bf16x8*)(lds + GL_KI + d * 9216 + (ni * 32 + r) * 144 + s * 32 + hh * 16); acc = MFMA32(a, bb, acc); }
#pragma unroll
        for (int reg = 0; reg < 16; ++reg) { const int ti = mi * 32 + crow(reg, hh), tj = ni * 32 + r; const bool keep = d ? (tj >= ti) : (tj <= ti); asum[reg] += keep ? acc[reg] : 0.f; } }
      bf16_t* at = (bf16_t*)(lds + GL_ATT) + (mi * 32 + 4 * hh) * 72 + ni * 32 + r;
#pragma unroll
      for (int reg = 0; reg < 16; ++reg) at[((reg & 3) + 8 * (reg >> 2)) * 72] = f2bf(asum[reg]);
    }
    __syncthreads();
    { const int mi = w >> 2, ni = w & 3; f32x16 acc;
#pragma unroll
      for (int i = 0; i < 16; ++i) acc[i] = 0.f;
#pragma unroll
      for (int s = 0; s < 4; ++s) { const bf16x8 a = *(const bf16x8*)(lds + GL_ATT + (mi * 32 + r) * 144 + s * 32 + hh * 16);
        const bf16x8 bb = *(const bf16x8*)(lds + GL_VT + (ni * 32 + r) * 144 + s * 32 + hh * 16); acc = MFMA32(a, bb, acc); }
      bf16_t* oi = (bf16_t*)(ws + WS_OINTRA) + (size_t)(tok0 + mi * 32 + 4 * hh) * 512 + h * 128 + ni * 32 + r;
#pragma unroll
      for (int reg = 0; reg < 16; ++reg) oi[(size_t)((reg & 3) + 8 * (reg >> 2)) * 512] = f2bf(acc[reg]); }
    { const int dvb = w >> 1, dkb = w & 1;
#pragma unroll
      for (int d = 0; d < 2; ++d) { f32x16 acc;
#pragma unroll
        for (int i = 0; i < 16; ++i) acc[i] = 0.f;
#pragma unroll
        for (int s = 0; s < 4; ++s) { const bf16x8 a = *(const bf16x8*)(lds + GL_VT + (dvb * 32 + r) * 144 + s * 32 + hh * 16);
          const bf16x8 bb = *(const bf16x8*)(lds + GL_KIT + d * 9216 + (dkb * 32 + r) * 144 + s * 32 + hh * 16); acc = MFMA32(a, bb, acc); }
        const float sc = DECL[d * 64 + dkb * 32 + r];
        bf16_t* ds = (bf16_t*)(ws + WS_SPT) + ((size_t)((b * 4 + h) * 2 + d) * 32 + n) * 8192 + (size_t)(dvb * 32 + 4 * hh) * 64 + dkb * 32 + r;
#pragma unroll
        for (int reg = 0; reg < 16; ++reg) ds[((reg & 3) + 8 * (reg >> 2)) * 64] = f2bf(acc[reg] * sc); } }
  }
}

DI void phase1a(const KP& p, char* lds) {
  const int tid = threadIdx.x, lane = tid & 63, w = tid >> 6;
  for (int tile = blockIdx.x; tile < 256; tile += gridDim.x) {
    unsigned char* ws = launder(p.ws); unsigned char* ob = (unsigned char*)launder(p.out); const float* xin = launder(p.in[0]);
    const float* mod = (const float*)(ws + WS_MOD);
    const int tok0 = tile * 64, b = tile >> 5;
    bf16_t* Hs = (bf16_t*)(ob + OUT_HS) + (size_t)tok0 * 1024;
    float4 ge[4], sh[4];
    const float* gpre = launder(p.in[5]); const float* modb = launder(mod) + b * 6144;
#pragma unroll
    for (int i = 0; i < 4; ++i) { const int d = (lane + 64 * i) * 4;
      const float4 g = *(const float4*)(gpre + d); const float4 sc = *(const float4*)(modb + 1024 + d); sh[i] = *(const float4*)(modb + d);
      ge[i] = make_float4(g.x * (1.f + sc.x), g.y * (1.f + sc.y), g.z * (1.f + sc.z), g.w * (1.f + sc.w)); }
#pragma unroll 2
    for (int rr = 0; rr < 8; ++rr) { const int row = w * 8 + rr;
      const float* xr = xin + (size_t)(tok0 + row) * 1024;
      float4 v[4]; float ss = 0.f;
#pragma unroll
      for (int i = 0; i < 4; ++i) { v[i] = *(const float4*)(xr + (lane + 64 * i) * 4); ss += v[i].x * v[i].x + v[i].y * v[i].y + v[i].z * v[i].z + v[i].w * v[i].w; }
      ss = wave_sum(ss); const float rs = rsqrtf(ss * (1.f / 1024.f) + EPS);
#pragma unroll
      for (int i = 0; i < 4; ++i) { uint2 o; o.x = pack2(v[i].x * rs * ge[i].x + sh[i].x, v[i].y * rs * ge[i].y + sh[i].y); o.y = pack2(v[i].z * rs * ge[i].z + sh[i].z, v[i].w * rs * ge[i].w + sh[i].w);
        *(uint2*)(Hs + (size_t)row * 1024 + (lane + 64 * i) * 4) = o; }
    }
  }
}

DI void phase1c(const KP& p, char* lds) {
  const int tid = threadIdx.x, lane = tid & 63, w = tid >> 6, r = lane & 31, hh = lane >> 5;
  float* cs = (float*)(lds + LDS_TAB); float* sn = cs + 2048;
  char* wl = lds + LDS_WT + (w & 3) * WT_BYTES;
  for (int tile = blockIdx.x; tile < 256; tile += gridDim.x) {
    unsigned char* ws = launder(p.ws); unsigned char* ob = (unsigned char*)launder(p.out);
    const int tok0 = tile * 64, b = tile >> 5, t0 = (tile & 31) * 64;
    const bf16_t* PA = (const bf16_t*)(ws + WS_P1S) + (size_t)tok0 * 1024;
    const bf16_t* PB = (const bf16_t*)(ob + 32 * MiB) + (size_t)tok0 * 1024;
    const bf16_t* PC = (const bf16_t*)(ws + WS_PROJC) + (size_t)tok0 * 256;
    bf16_t* Hs = (bf16_t*)(ob + OUT_HS) + (size_t)tok0 * 1024;
    bf16_t* CQN = Hs; bf16_t* CKVN = Hs + 64 * 384;
    bf16_t* Qm = (bf16_t*)(ws + WS_QM); bf16_t* Km = (bf16_t*)(ws + WS_KM); bf16_t* Vm = (bf16_t*)(ws + WS_VM);
    bf16_t* rg = (bf16_t*)(ws + WS_RG) + (size_t)tok0 * 512;
    __syncthreads();
#pragma unroll
    for (int i = 0; i < 4; ++i) { const int e = tid + 512 * i, tt = e >> 5, j = e & 31;
      const float inv = __builtin_amdgcn_exp2f(-(float)j * (13.287712379549449f / 32.f)); const float ang = (float)((const int*)p.in[2])[tok0 + tt] * inv;
      float rev = ang * 0.15915494309189535f; rev -= floorf(rev);
      cs[e] = __builtin_amdgcn_cosf(rev); sn[e] = __builtin_amdgcn_sinf(rev); }
#pragma unroll
    for (int i = 0; i < 8; ++i) { const int c = tid + 512 * i, row = c >> 6, cc = c & 63;
      const uint4 v = (cc < 36) ? *(const uint4*)(PB + (size_t)row * 1024 + (O_R - 1024) + cc * 8) : *(const uint4*)(PC + (size_t)row * 256 + (cc - 36) * 8);
      *(uint4*)(rg + (size_t)row * 512 + cc * 8) = v; }
    __syncthreads();
    if (tid < 256) { const int row = tid >> 2, pc = tid & 3;
      const uint4 x1 = *(const uint4*)(PA + (size_t)row * 1024 + O_KR + pc * 8), x2 = *(const uint4*)(PA + (size_t)row * 1024 + O_KR + 32 + pc * 8);
      const float4 c0 = *(const float4*)(cs + row * 32 + pc * 8), c1 = *(const float4*)(cs + row * 32 + pc * 8 + 4), s0 = *(const float4*)(sn + row * 32 + pc * 8), s1 = *(const float4*)(sn + row * 32 + pc * 8 + 4);
#define RO1(a_, b_, c_, s_) ((a_) * (c_) - (b_) * (s_))
#define RO2(a_, b_, c_, s_) ((b_) * (c_) + (a_) * (s_))
#define LO(u_) __uint_as_float((u_) << 16)
#define HI(u_) __uint_as_float((u_) & 0xffff0000u)
      uint4 o1, o2;
      o1.x = pack2(RO1(LO(x1.x), LO(x2.x), c0.x, s0.x), RO1(HI(x1.x), HI(x2.x), c0.y, s0.y)); o1.y = pack2(RO1(LO(x1.y), LO(x2.y), c0.z, s0.z), RO1(HI(x1.y), HI(x2.y), c0.w, s0.w));
      o1.z = pack2(RO1(LO(x1.z), LO(x2.z), c1.x, s1.x), RO1(HI(x1.z), HI(x2.z), c1.y, s1.y)); o1.w = pack2(RO1(LO(x1.w), LO(x2.w), c1.z, s1.z), RO1(HI(x1.w), HI(x2.w), c1.w, s1.w));
      o2.x = pack2(RO2(LO(x1.x), LO(x2.x), c0.x, s0.x), RO2(HI(x1.x), HI(x2.x), c0.y, s0.y)); o2.y = pack2(RO2(LO(x1.y), LO(x2.y), c0.z, s0.z), RO2(HI(x1.y), HI(x2.y), c0.w, s0.w));
      o2.z = pack2(RO2(LO(x1.z), LO(x2.z), c1.x, s1.x), RO2(HI(x1.z), HI(x2.z), c1.y, s1.y)); o2.w = pack2(RO2(LO(x1.w), LO(x2.w), c1.z, s1.z), RO2(HI(x1.w), HI(x2.w), c1.w, s1.w));
#undef RO1
#undef RO2
#undef LO
#undef HI
#pragma unroll
      for (int h = 0; h < 4; ++h) { bf16_t* kp = Km + (((size_t)b * 4 + h) * SEQ + t0 + row) * 192 + 128 + pc * 8; *(uint4*)kp = o1; *(uint4*)(kp + 32) = o2; }
    }
    const float* gq = launder(p.in[8]); const float* gkv = launder(p.in[10]);
#pragma unroll 2
    for (int rr = 0; rr < 8; ++rr) { const int row = w * 8 + rr; const unsigned* cr = (const unsigned*)(PA + (size_t)row * 1024);
      float v0[5], v1[5];
#pragma unroll
      for (int i = 0; i < 5; ++i) { const unsigned u = cr[lane + 64 * i]; v0[i] = __uint_as_float(u << 16); v1[i] = __uint_as_float(u & 0xffff0000u); }
      float ss = v0[0] * v0[0] + v1[0] * v1[0] + v0[1] * v0[1] + v1[1] * v1[1] + v0[2] * v0[2] + v1[2] * v1[2];
      float s2 = v0[3] * v0[3] + v1[3] * v1[3] + v0[4] * v0[4] + v1[4] * v1[4];
      ss = wave_sum(ss); s2 = wave_sum(s2);
      const float rq = rsqrtf(ss * (1.f / 384.f) + EPS), rk = rsqrtf(s2 * (1.f / 256.f) + EPS);
#pragma unroll
      for (int i = 0; i < 3; ++i) { const int c = 2 * (lane + 64 * i); *(unsigned*)(CQN + (size_t)row * 384 + c) = pack2(v0[i] * rq * gq[c], v1[i] * rq * gq[c + 1]); }
#pragma unroll
      for (int i = 3; i < 5; ++i) { const int c = 2 * (lane + 64 * (i - 3)); *(unsigned*)(CKVN + (size_t)row * 256 + c) = pack2(v0[i] * rk * gkv[c], v1[i] * rk * gkv[c + 1]); }
    }
    __syncthreads();
    block_gemm<3>(lds, CQN, 384, (const bf16_t*)(ws + WS_WTQUP), 3, 384, [&](int m0, int n0, const f32x16& a0, const f32x16& a1) {
      const int r2 = lv(r), h2 = lv(hh), ln = lv(lane);
      const int h = n0 / 192, d0 = n0 % 192;
      bf16_t* qp = Qm + (((size_t)b * 4 + h) * SEQ + t0 + m0) * 192 + d0;
      if (d0 < 128) wt_write(wl, a0, a1, r2, h2, 1.f); else wt_write_rope(wl, a0, a1, r2, h2, cs, sn, m0);
      LDS_FENCE();
      wt_store(wl, ln, qp, 192, qp + 32, 192);
    });
    block_gemm<3>(lds, CKVN, 256, (const bf16_t*)(ws + WS_WTKVUP), 4, 256, [&](int m0, int n0, const f32x16& a0, const f32x16& a1) {
      const int r2 = lv(r), h2 = lv(hh), ln = lv(lane);
      const int h = n0 >> 8, d0 = n0 & 255;
      wt_write(wl, a0, a1, r2, h2, 1.f); LDS_FENCE();
      if (d0 < 128) { bf16_t* kp = Km + (((size_t)b * 4 + h) * SEQ + t0 + m0) * 192 + d0; wt_store(wl, ln, kp, 192, kp + 32, 192); }
      else { bf16_t* vp = Vm + (((size_t)b * 4 + h) * SEQ + t0 + m0) * 128 + (d0 - 128); wt_store(wl, ln, vp, 128, vp + 32, 128); }
    });
    gla_chunk_local(p, lds, ws, tile, PA, PB);
  }
}

namespace att {
typedef short s16x4 __attribute__((ext_vector_type(4)));
typedef unsigned u32x4 __attribute__((ext_vector_type(4)));
constexpr int DQ = 192, DV = 128, KVBLK = 64;
constexpr float SCALE = 0.07216878364870322f;
constexpr float THR = 8.f;
constexpr int SHM_V = KVBLK * DV * 2, SHM_K = KVBLK * DQ * 2;
constexpr int SHM_QR = 8 * 32 * 176;
constexpr int SHM_ATTN = 2 * SHM_V + 2 * SHM_K + 8 * 64 * 4 + SHM_QR;
#define KSWZ(row, colB) ((row) * 384 + ((colB) ^ (((row) & 7) << 4)))
#define SBAR() __builtin_amdgcn_sched_barrier(0)
DI unsigned cvtpk(float lo, float hi) { unsigned r; asm volatile("v_cvt_pk_bf16_f32 %0, %1, %2" : "=v"(r) : "v"(lo), "v"(hi)); return r; }

DI void partialSM(f32x16& p0, f32x16& p1, float& m_reg, float& mn, float& alpha) {
  constexpr float C = SCALE * 1.4426950408889634f;
  float pmax = p0[0];
#pragma unroll
  for (int r = 1; r < 16; ++r) pmax = fmaxf(pmax, p0[r]);
#pragma unroll
  for (int r = 0; r < 16; ++r) pmax = fmaxf(pmax, p1[r]);
  { auto rr = __builtin_amdgcn_permlane32_swap(__float_as_uint(pmax), __float_as_uint(pmax), false, false);
    pmax = fmaxf(__uint_as_float(rr[0]), __uint_as_float(rr[1])); }
  if (__builtin_expect(__all(pmax - m_reg <= THR / SCALE), 1)) { mn = m_reg; alpha = 1.f; }
  else { mn = fmaxf(m_reg, pmax); alpha = __builtin_amdgcn_exp2f((m_reg - mn) * C); m_reg = mn; }
  const float mnC = -mn * C;
#pragma unroll
  for (int r = 0; r < 16; ++r) p0[r] = fmaf(p0[r], C, mnC);
#pragma unroll
  for (int r = 0; r < 16; ++r) p1[r] = fmaf(p1[r], C, mnC);
#pragma unroll
  for (int r = 0; r < 16; ++r) p0[r] = __builtin_amdgcn_exp2f(p0[r]);
}
DI void finishSM(f32x16& p0, f32x16& p1, float alpha, float& l_reg, bf16x8& pa0, bf16x8& pa1, bf16x8& pa2, bf16x8& pa3) {
#pragma unroll
  for (int r = 0; r < 16; ++r) p1[r] = __builtin_amdgcn_exp2f(p1[r]);
  float ps = 0;
#pragma unroll
  for (int r = 0; r < 16; ++r) ps += p0[r];
#pragma unroll
  for (int r = 0; r < 16; ++r) ps += p1[r];
  { auto rr = __builtin_amdgcn_permlane32_swap(__float_as_uint(ps), __float_as_uint(ps), false, false);
    ps = __uint_as_float(rr[0]) + __uint_as_float(rr[1]); }
  l_reg = l_reg * alpha + ps;
#define PK4(P, BASE, OUT) do { unsigned a0 = cvtpk(P[BASE + 0], P[BASE + 1]), a1 = cvtpk(P[BASE + 2], P[BASE + 3]);   \
    unsigned b0 = cvtpk(P[BASE + 4], P[BASE + 5]), b1 = cvtpk(P[BASE + 6], P[BASE + 7]);                              \
    auto r0 = __builtin_amdgcn_permlane32_swap(a0, b0, false, false); auto r1 = __builtin_amdgcn_permlane32_swap(a1, b1, false, false); \
    u32x4 wv = {r0[0], r1[0], r0[1], r1[1]}; OUT = *reinterpret_cast<bf16x8*>(&wv); } while (0)
  PK4(p0, 0, pa0); PK4(p0, 8, pa1); PK4(p1, 0, pa2); PK4(p1, 8, pa3);
#undef PK4
}
DI void qkt(f32x16& p0, f32x16& p1, const char* Ks, const bf16x8* qr, const char* qrl, int r32, int hi) {
#pragma unroll
  for (int i = 0; i < 16; ++i) { p0[i] = 0.f; p1[i] = 0.f; }
#pragma unroll
  for (int d0 = 0; d0 < 12; ++d0) { const int cb = (d0 * 16 + hi * 8) * 2;
    const bf16x8 b0 = *reinterpret_cast<const bf16x8*>(Ks + KSWZ(r32, cb));
    const bf16x8 b1 = *reinterpret_cast<const bf16x8*>(Ks + KSWZ(32 + r32, cb));
    const bf16x8 q = (d0 < 7) ? qr[d0 < 7 ? d0 : 0] : *reinterpret_cast<const bf16x8*>(qrl + (d0 - 7) * 32);
    p0 = MFMA32(b0, q, p0);
    p1 = MFMA32(b1, q, p1); }
}
DI int v_st(int k, int c) { const int kk = (k & ~0xC) | ((k & 4) << 1) | ((k & 8) >> 1); return ((kk >> 3) * 4 + (c >> 5)) * 512 + ((kk & 7) * 32 + (c & 31)) * 2; }
DI int v_rd_base(int lane) { return ((lane & 3) << 3) | (((lane >> 2) & 3) << 6) | (((lane >> 4) & 1) << 5) | (((lane >> 5) & 1) << 8); }
constexpr int v_rd_off(int d0, int ks, int half) { return d0 * 512 + ks * 4096 + half * 2048; }
template <int OFF> DI s16x4 tr_read(int vb) { s16x4 r; asm volatile("ds_read_b64_tr_b16 %0, %1 offset:%2" : "=&v"(r) : "v"(vb), "i"(OFF) : "memory"); return r; }
template <int D0> DI void pv_one(f32x16& od, int vb, bf16x8 pa0, bf16x8 pa1, bf16x8 pa2, bf16x8 pa3) {
  const s16x4 l0 = tr_read<v_rd_off(D0, 0, 0)>(vb), h0 = tr_read<v_rd_off(D0, 0, 1)>(vb), l1 = tr_read<v_rd_off(D0, 1, 0)>(vb), h1 = tr_read<v_rd_off(D0, 1, 1)>(vb);
  const s16x4 l2 = tr_read<v_rd_off(D0, 2, 0)>(vb), h2 = tr_read<v_rd_off(D0, 2, 1)>(vb), l3 = tr_read<v_rd_off(D0, 3, 0)>(vb), h3 = tr_read<v_rd_off(D0, 3, 1)>(vb);
  asm volatile("s_waitcnt lgkmcnt(0)" ::: "memory"); SBAR();
#define PK(L, H) (bf16x8){L[0], L[1], L[2], L[3], H[0], H[1], H[2], H[3]}
  od = MFMA32(pa0, PK(l0, h0), od);
  od = MFMA32(pa1, PK(l1, h1), od);
  od = MFMA32(pa2, PK(l2, h2), od);
  od = MFMA32(pa3, PK(l3, h3), od);
#undef PK
}
DI void pv_d0(f32x16* o, int vb, bf16x8 pa0, bf16x8 pa1, bf16x8 pa2, bf16x8 pa3) {
  pv_one<0>(o[0], vb, pa0, pa1, pa2, pa3); pv_one<1>(o[1], vb, pa0, pa1, pa2, pa3); pv_one<2>(o[2], vb, pa0, pa1, pa2, pa3); pv_one<3>(o[3], vb, pa0, pa1, pa2, pa3);
}
DI void attn_unit(const bf16_t* Qb, const bf16_t* Kh, const bf16_t* Vh, bf16_t* Ob, int seq, char* lds) {
  const int tid = lv(threadIdx.x), wid = tid >> 6, lane = tid & 63, r32 = lane & 31, hi = lane >> 5;
  char* V_lds = lds; char* K_lds = lds + 2 * SHM_V;
  float* wsf = (float*)(lds + 2 * SHM_V + 2 * SHM_K) + wid * 64; float* li_l = wsf; float* al_l = wsf + 32;
  char* qrl = lds + 2 * SHM_V + 2 * SHM_K + 8 * 64 * 4 + wid * (32 * 176) + r32 * 176 + hi * 16;
  float m_reg = -1e30f, l_reg = 0; f32x16 o[4]; bf16x8 qr[7];
#pragma unroll
  for (int d = 0; d < 4; ++d)
#pragma unroll
    for (int i = 0; i < 16; ++i) o[d][i] = 0.f;
  const bf16_t* Qw = Qb + (size_t)(wid * 32 + r32) * DQ + hi * 8;
#pragma unroll
  for (int d0 = 0; d0 < 7; ++d0) qr[d0] = *reinterpret_cast<const bf16x8*>(Qw + d0 * 16);
#pragma unroll
  for (int d0 = 7; d0 < 12; ++d0) *reinterpret_cast<bf16x8*>(qrl + (d0 - 7) * 32) = *reinterpret_cast<const bf16x8*>(Qw + d0 * 16);
  int kst[3];
#pragma unroll
  for (int i = 0; i < 3; ++i) { const int c = tid + 512 * i; kst[i] = KSWZ(c / 24, (c % 24) * 16); }
  const int vst0 = v_st(tid >> 4, (tid & 15) * 8), vst1 = v_st(32 + (tid >> 4), (tid & 15) * 8);
  const int vb0 = (int)(uintptr_t)V_lds + v_rd_base(lane);
  bf16x8 sk0, sk1, sk2, sv0, sv1;
#define SLOAD(k0) do { const bf16x8* kp = reinterpret_cast<const bf16x8*>(Kh + (size_t)(k0) * DQ) + tid; sk0 = kp[0]; sk1 = kp[512]; sk2 = kp[1024]; \
    const bf16x8* vp = reinterpret_cast<const bf16x8*>(Vh + (size_t)(k0) * DV) + tid; sv0 = vp[0]; sv1 = vp[512]; } while (0)
#define SWRITE(b) do { *(bf16x8*)(V_lds + (b) * SHM_V + vst0) = sv0; *(bf16x8*)(V_lds + (b) * SHM_V + vst1) = sv1; \
    *(bf16x8*)(K_lds + (b) * SHM_K + kst[0]) = sk0; *(bf16x8*)(K_lds + (b) * SHM_K + kst[1]) = sk1; *(bf16x8*)(K_lds + (b) * SHM_K + kst[2]) = sk2; } while (0)
#define RESC(a) do { if (__any((a) < 1.f)) { if (hi == 0) al_l[r32] = (a); asm volatile("s_waitcnt lgkmcnt(0)" ::: "memory"); \
    _Pragma("unroll") for (int d = 0; d < 4; ++d) _Pragma("unroll") for (int r = 0; r < 16; ++r) o[d][r] *= al_l[crow(r, hi)]; } } while (0)
  f32x16 pA0, pA1, pB0, pB1; float mnA, mnB, alA, alB; bf16x8 pa0, pa1, pa2, pa3; const int NT = seq / KVBLK;
  SLOAD(0); SWRITE(0); __syncthreads();
  qkt(pA0, pA1, K_lds, qr, qrl, r32, hi); partialSM(pA0, pA1, m_reg, mnA, alA);
  SLOAD(KVBLK); SWRITE(1); __syncthreads();
  for (int j = 1; j + 1 < NT; j += 2) {
    SBAR(); qkt(pB0, pB1, K_lds + SHM_K, qr, qrl, r32, hi);
    finishSM(pA0, pA1, alA, l_reg, pa0, pa1, pa2, pa3); SBAR();
    SLOAD((j + 1) * KVBLK); SBAR();
    pv_d0(o, vb0, pa0, pa1, pa2, pa3); partialSM(pB0, pB1, m_reg, mnB, alB);
    __syncthreads(); SWRITE(0);
    RESC(alB); __syncthreads();
    SBAR(); qkt(pA0, pA1, K_lds, qr, qrl, r32, hi);
    finishSM(pB0, pB1, alB, l_reg, pa0, pa1, pa2, pa3); SBAR();
    SLOAD((j + 2) * KVBLK); SBAR();
    pv_d0(o, vb0 + SHM_V, pa0, pa1, pa2, pa3); partialSM(pA0, pA1, m_reg, mnA, alA);
    __syncthreads(); SWRITE(1);
    RESC(alA); __syncthreads();
  }
  SBAR(); qkt(pB0, pB1, K_lds + SHM_K, qr, qrl, r32, hi);
  finishSM(pA0, pA1, alA, l_reg, pa0, pa1, pa2, pa3); SBAR();
  pv_d0(o, vb0, pa0, pa1, pa2, pa3); partialSM(pB0, pB1, m_reg, mnB, alB);
  __syncthreads(); RESC(alB);
  finishSM(pB0, pB1, alB, l_reg, pa0, pa1, pa2, pa3); SBAR();
  pv_d0(o, vb0 + SHM_V, pa0, pa1, pa2, pa3);
  if (hi == 0) li_l[r32] = l_reg; asm volatile("s_waitcnt lgkmcnt(0)" ::: "memory");
  float rli[16];
#pragma unroll
  for (int r = 0; r < 16; ++r) rli[r] = __builtin_amdgcn_rcpf(li_l[crow(r, hi)]);
  bf16_t* Ow = Ob + (size_t)(wid * 32) * 1024;
#pragma unroll
  for (int r = 0; r < 16; ++r) { const int orow = crow(r, hi);
#pragma unroll
    for (int d0 = 0; d0 < 4; ++d0) Ow[(size_t)orow * 1024 + d0 * 32 + r32] = f2bf(o[d0][r] * rli[r]); }
  __syncthreads();
#undef SLOAD
#undef SWRITE
#undef RESC
}
}

DI void phase2_attn(const KP& p, char* lds) {
  for (int u = blockIdx.x; u < 256; u += gridDim.x) {
    unsigned char* ws = launder(p.ws);
    const bf16_t* Qm = (const bf16_t*)(ws + WS_QM); const bf16_t* Km = (const bf16_t*)(ws + WS_KM); const bf16_t* Vm = (const bf16_t*)(ws + WS_VM);
    bf16_t* mixa = (bf16_t*)(ws + WS_P1S);
    const int qb = u & 7, bh = u >> 3, b = bh >> 2, h = bh & 3;
    att::attn_unit(Qm + ((size_t)bh * SEQ + qb * 256) * 192, Km + (size_t)bh * SEQ * 192, Vm + (size_t)bh * SEQ * 128,
                   mixa + ((size_t)b * SEQ + qb * 256) * 1024 + h * 128, SEQ, lds);
  }
}

namespace pg8 {
#define PG8_LAS __attribute__((address_space(3)))
typedef unsigned short bf16_t;
typedef short bf16x8 __attribute__((ext_vector_type(8)));
typedef float f32x4 __attribute__((ext_vector_type(4)));
typedef unsigned u32x4 __attribute__((ext_vector_type(4)));
constexpr int BM = 256, BK = 64, HALF = 128, HTB = HALF * BK * 2  , STAGE_BYTES = 8 * HTB, NXCD = 8, WGM = 8;

__host__ __device__ __forceinline__ int lds_byte(int r, int c) { const int st = (r >> 4) * 2 + (c >> 5), rr = r & 15, cc = c & 31, ob = rr * 64 + cc * 2; return st * 1024 + (ob ^ (((ob >> 9) & 1) << 5)); }
__host__ __device__ __forceinline__ void stage_rc(int b, int& R, int& C) { const int st = b / 1024, sb = b % 1024, swz = sb ^ (((sb >> 9) & 1) << 5); R = (st >> 1) * 16 + swz / 64; C = (st & 1) * 32 + (swz % 64) / 2; }
__host__ __device__ __forceinline__ int perm32(int rho) { const int n = rho >> 4, i = rho & 15; return 8 * (i >> 2) + 4 * n + (i & 3); }

struct Unit { int pm, pn; };
struct Gemm { const bf16_t* A; const bf16_t* Bt; int M, N, K; };

struct StaticOrder {
    int nM, nN, nwg, G, c;
    __host__ __device__ void init(int M, int N, int G_, int c_) { nM = M / BM; nN = N / BM; nwg = nM * nN; G = G_; c = c_; }
    __host__ __device__ bool next(int i, Unit& u) const {
        const long L = (long)i * G + c; if (L >= nwg) return false;
        int wgid = (int)L; { const int q = nwg / NXCD, r = nwg % NXCD, xcd = wgid % NXCD, off = wgid / NXCD; wgid = (xcd < r ? xcd * (q + 1) : r * (q + 1) + (xcd - r) * q) + off; }
        const int nig = WGM * nN, gid = wgid / nig, fm = gid * WGM, gsz = (nM - fm) < WGM ? (nM - fm) : WGM;
        u.pm = fm + ((wgid % nig) % gsz); u.pn = (wgid % nig) / gsz; return true;
    }
    __device__ __forceinline__ void a_ready(const Unit&) const {}
    __device__ __forceinline__ void done(const Unit&) const {}
};

__device__ __forceinline__ unsigned cvt_pk_bf16(float lo, float hi) { unsigned r; asm volatile("v_cvt_pk_bf16_f32 %0, %1, %2" : "=v"(r) : "v"(lo), "v"(hi)); return r; }
typedef float f32x2 __attribute__((ext_vector_type(2)));
__device__ __forceinline__ f32x2 gelu_pk(f32x2 v) {
    const f32x2 av = __builtin_elementwise_abs(v), d = av * 0.2316418882f + 1.0f;
    f32x2 t; t.x = __builtin_amdgcn_rcpf(d.x); t.y = __builtin_amdgcn_rcpf(d.y);
    f32x2 q = t * 0.5307027145f + (-0.7265760135f); q = q * t + 0.7107068705f; q = q * t + (-0.142248368f); q = q * t + 0.127414796f; q = q * t;
    const f32x2 s = (v * v) * (-0.72134752044f);
    f32x2 e; e.x = __builtin_amdgcn_exp2f(s.x); e.y = __builtin_amdgcn_exp2f(s.y);
    const f32x2 m = v * (q * e), r = v - m;
    f32x2 o; o.x = v.x < 0.f ? m.x : r.x; o.y = v.y < 0.f ? m.y : r.y; return o;
}

template <int ACT  > struct EpiBf16 {
    static constexpr bool PERM = true, AFTER_DRAIN = false; static_assert(ACT == 0 || ACT == 1, "EpiBf16: ACT is 0 (none) or 1 (gelu_pk)");
    bf16_t* O; int ldc; const float* bias; int split_cols; size_t split_stride; float scale0;
    __device__ __forceinline__ void operator()(const f32x4 (&acc)[2][2][4][2], const Unit& u, int wr, int wc, int fr, int fq) const {
        const int row0 = u.pm * BM + wr * 64 + fr; int colt = u.pn * BM; bf16_t* base = O;
        float sc = 1.f; if (split_cols) { const int t = colt / split_cols; base += (size_t)t * split_stride; colt -= t * split_cols; if (t == 0) sc = scale0; }
        const int col0 = colt + wc * 32 + 8 * fq, bcol0 = u.pn * BM + wc * 32 + 8 * fq;
        f32x4 bv[2][2];
#pragma unroll
        for (int bj = 0; bj < 2; ++bj)
#pragma unroll
            for (int n = 0; n < 2; ++n) bv[bj][n] = bias ? *(const f32x4*)(bias + bcol0 + bj * HALF + 4 * n) : (f32x4){0.f, 0.f, 0.f, 0.f};
#pragma unroll
        for (int ai = 0; ai < 2; ++ai)
#pragma unroll
            for (int m = 0; m < 4; ++m) { bf16_t* rowp = base + (size_t)(row0 + ai * HALF + m * 16) * ldc + col0;
#pragma unroll
                for (int bj = 0; bj < 2; ++bj) { f32x4 v0 = acc[ai][bj][m][0] + bv[bj][0], v1 = acc[ai][bj][m][1] + bv[bj][1];
                    if (ACT == 1) { f32x2 a = gelu_pk((f32x2){v0[0], v0[1]}), b = gelu_pk((f32x2){v0[2], v0[3]}), c = gelu_pk((f32x2){v1[0], v1[1]}), d = gelu_pk((f32x2){v1[2], v1[3]});
                        v0 = (f32x4){a.x, a.y, b.x, b.y}; v1 = (f32x4){c.x, c.y, d.x, d.y}; }
                    v0 = v0 * sc; v1 = v1 * sc; u32x4 w; w.x = cvt_pk_bf16(v0[0], v0[1]); w.y = cvt_pk_bf16(v0[2], v0[3]); w.z = cvt_pk_bf16(v1[0], v1[1]); w.w = cvt_pk_bf16(v1[2], v1[3]);
                    *(u32x4*)(rowp + bj * HALF) = w; } }
    }
};

template <class Epi, class Sched, bool ALIGN_EPI = false, bool SP2 = false>
__device__ __forceinline__ void gemm_phase(PG8_LAS unsigned char* lds, const Gemm g, const Sched& S, const Epi& E) {
    const int tid = threadIdx.x, wid = __builtin_amdgcn_readfirstlane(tid >> 6), lane = tid & 63, wr = wid >> 2, wc = wid & 3, fr = lane & 15, fq = lane >> 4;
    const int K = g.K, nt = K / BK;
    unsigned voffA[2], voffB[2];
#pragma unroll
    for (int i = 0; i < 2; ++i) { int R, C; stage_rc(tid * 16 + i * 8192, R, C); const int Rb = Epi::PERM ? ((R & ~31) + perm32(R & 31)) : R;
        voffA[i] = (unsigned)(R * K + C) * 2u; voffB[i] = (unsigned)(Rb * K + C) * 2u; }
    const size_t kstep = (size_t)(BK * 2);
    const size_t hstep = (size_t)HALF * K * 2;
    const size_t tstep = 2 * hstep;
    const unsigned ldsw = (unsigned)wid * 1024u;
    const int aoff = lds_byte(wr * 64 + fr, fq * 8), boff = lds_byte(wc * 32 + fr, fq * 8);
#define PG8_SA(b, h) (((b) * 2 + (h)) * HTB)
#define PG8_SB(b, h) ((4 + (b) * 2 + (h)) * HTB)
#define PG8_STAGE(bufoff, gbase, voff) do { _Pragma("unroll") for (int _i = 0; _i < 2; ++_i) \
        __builtin_amdgcn_global_load_lds((const unsigned*)((const char*)(gbase) + (voff)[_i]), (PG8_LAS unsigned*)(lds + (bufoff) + ldsw + _i * 8192), 16, 0, 0); } while (0)
#define PG8_LDA(dst, b, h) do { _Pragma("unroll") for (int m = 0; m < 4; ++m) _Pragma("unroll") for (int k = 0; k < 2; ++k) dst[m][k] = *(const PG8_LAS bf16x8*)(lds + PG8_SA(b, h) + aoff + m * 2048 + k * 1024); } while (0)
#define PG8_LDB(dst, b, h) do { _Pragma("unroll") for (int n = 0; n < 2; ++n) _Pragma("unroll") for (int k = 0; k < 2; ++k) dst[n][k] = *(const PG8_LAS bf16x8*)(lds + PG8_SB(b, h) + boff + n * 2048 + k * 1024); } while (0)
#define PG8_MMA(ai, bj, At, Bt) do { __builtin_amdgcn_s_setprio(1); _Pragma("unroll") for (int m = 0; m < 4; ++m) _Pragma("unroll") for (int n = 0; n < 2; ++n) _Pragma("unroll") for (int k = 0; k < 2; ++k) \
        acc[ai][bj][m][n] = __builtin_amdgcn_mfma_f32_16x16x32_bf16(Bt[n][k], At[m][k], acc[ai][bj][m][n], 0, 0, 0); __builtin_amdgcn_s_setprio(0); } while (0)
#define PG8_WAIT_V(n) asm volatile("s_waitcnt vmcnt(" #n ")" ::: "memory")
#define PG8_WAIT_L(n) asm volatile("s_waitcnt lgkmcnt(" #n ")" ::: "memory")
#define PG8_BAR __builtin_amdgcn_s_barrier()
#define PG8_SCHED __builtin_amdgcn_sched_barrier(0)
    Unit cur, nxt; int ui = 0;
    if (!S.next(0, cur)) return;
    f32x4 acc[2][2][4][2];
#pragma unroll
    for (int a = 0; a < 2; ++a)
#pragma unroll
        for (int b = 0; b < 2; ++b)
#pragma unroll
            for (int m = 0; m < 4; ++m)
#pragma unroll
                for (int n = 0; n < 2; ++n) acc[a][b][m][n] = (f32x4){0.f, 0.f, 0.f, 0.f};
    bf16x8 At[4][2], B0[2][2], B1[2][2];
    const char* cA = (const char*)g.A + (size_t)cur.pm * tstep; const char* cB = (const char*)g.Bt + (size_t)cur.pn * tstep;
    S.a_ready(cur);
    if constexpr (SP2) {
        PG8_STAGE(PG8_SB(0, 0), cB, voffB); PG8_STAGE(PG8_SB(0, 1), cB + hstep, voffB); PG8_STAGE(PG8_SA(0, 0), cA, voffA); PG8_STAGE(PG8_SA(0, 1), cA + hstep, voffA);
        if (wr == 1) PG8_BAR;
        PG8_WAIT_V(2); PG8_BAR;
        PG8_STAGE(PG8_SB(1, 0), cB + kstep, voffB); PG8_STAGE(PG8_SA(1, 0), cA + kstep, voffA); PG8_STAGE(PG8_SB(1, 1), cB + hstep + kstep, voffB);
        PG8_WAIT_V(6); PG8_BAR;
    } else {
        PG8_STAGE(PG8_SB(0, 0), cB, voffB); PG8_STAGE(PG8_SA(0, 0), cA, voffA); PG8_STAGE(PG8_SB(0, 1), cB + hstep, voffB); PG8_STAGE(PG8_SA(0, 1), cA + hstep, voffA);
        if (wr == 1) PG8_BAR;
        PG8_WAIT_V(4); PG8_BAR;
        PG8_STAGE(PG8_SB(1, 0), cB + kstep, voffB); PG8_STAGE(PG8_SA(1, 0), cA + kstep, voffA); PG8_STAGE(PG8_SB(1, 1), cB + hstep + kstep, voffB);
        PG8_WAIT_V(6); PG8_BAR;
    }
    for (;;) {
        const bool has_next = S.next(ui + 1, nxt);
        const char* nA = has_next ? (const char*)g.A + (size_t)nxt.pm * tstep : cA; const char* nB = has_next ? (const char*)g.Bt + (size_t)nxt.pn * tstep : cB;
        for (int t = 0; t < nt; t += 2) {
            const bool last = (t == nt - 2);
            const char* a1 = cA + (size_t)(t + 1) * kstep;
            const char* a2 = last ? nA : cA + (size_t)(t + 2) * kstep; const char* b2 = last ? nB : cB + (size_t)(t + 2) * kstep;
            const char* a3 = a2 + kstep; const char* b3 = b2 + kstep;
            if (last && has_next) S.a_ready(nxt);
            if constexpr (SP2) {
            PG8_LDB(B0, 0, 0); PG8_LDB(B1, 0, 1); PG8_SCHED; PG8_LDA(At, 0, 0); PG8_STAGE(PG8_SA(1, 1), a1 + hstep, voffA);
            PG8_WAIT_V(8); PG8_WAIT_L(0); PG8_BAR; PG8_MMA(0, 0, At, B0); PG8_MMA(0, 1, At, B1); PG8_BAR; PG8_SCHED;
            PG8_LDA(At, 0, 1); PG8_STAGE(PG8_SB(0, 0), b2, voffB); PG8_STAGE(PG8_SB(0, 1), b2 + hstep, voffB); PG8_STAGE(PG8_SA(0, 0), a2, voffA);
            PG8_WAIT_V(8); PG8_WAIT_L(0); PG8_BAR; PG8_MMA(1, 0, At, B0); PG8_MMA(1, 1, At, B1); PG8_BAR; PG8_SCHED;
            PG8_LDB(B0, 1, 0); PG8_LDB(B1, 1, 1); PG8_SCHED; PG8_LDA(At, 1, 0); PG8_STAGE(PG8_SA(0, 1), a2 + hstep, voffA);
            PG8_WAIT_V(8); PG8_WAIT_L(0); PG8_BAR; PG8_MMA(0, 0, At, B0); PG8_MMA(0, 1, At, B1); PG8_BAR; PG8_SCHED;
            PG8_LDA(At, 1, 1); PG8_STAGE(PG8_SB(1, 0), b3, voffB); PG8_STAGE(PG8_SB(1, 1), b3 + hstep, voffB); PG8_STAGE(PG8_SA(1, 0), a3, voffA);
            PG8_WAIT_V(8); PG8_WAIT_L(0); PG8_BAR; PG8_MMA(1, 0, At, B0); PG8_MMA(1, 1, At, B1); PG8_BAR; PG8_SCHED;
            } else {
            PG8_LDB(B0, 0, 0); PG8_SCHED; PG8_LDA(At, 0, 0); PG8_STAGE(PG8_SA(1, 1), a1 + hstep, voffA);
            PG8_WAIT_L(8); PG8_BAR; PG8_WAIT_L(0); PG8_MMA(0, 0, At, B0); PG8_BAR; PG8_SCHED;
            PG8_LDB(B1, 0, 1); PG8_STAGE(PG8_SB(0, 0), b2, voffB);
            PG8_BAR; PG8_WAIT_L(0); PG8_MMA(0, 1, At, B1); PG8_BAR;
            PG8_LDA(At, 0, 1); PG8_STAGE(PG8_SA(0, 0), a2, voffA);
            PG8_BAR; PG8_WAIT_L(0); PG8_MMA(1, 0, At, B0); PG8_BAR; PG8_SCHED;
            PG8_STAGE(PG8_SB(0, 1), b2 + hstep, voffB);
            PG8_WAIT_V(6); PG8_BAR; PG8_MMA(1, 1, At, B1); PG8_BAR;
            PG8_LDB(B0, 1, 0); PG8_SCHED; PG8_LDA(At, 1, 0); PG8_STAGE(PG8_SA(0, 1), a2 + hstep, voffA);
            PG8_WAIT_L(8); PG8_BAR; PG8_WAIT_L(0); PG8_MMA(0, 0, At, B0); PG8_BAR; PG8_SCHED;
            PG8_LDB(B1, 1, 1); PG8_STAGE(PG8_SB(1, 0), b3, voffB);
            PG8_BAR; PG8_WAIT_L(0); PG8_MMA(0, 1, At, B1); PG8_BAR;
            PG8_LDA(At, 1, 1); PG8_STAGE(PG8_SA(1, 0), a3, voffA);
            PG8_BAR; PG8_WAIT_L(0); PG8_MMA(1, 0, At, B0); PG8_BAR; PG8_SCHED;
            PG8_STAGE(PG8_SB(1, 1), b3 + hstep, voffB);
            PG8_WAIT_V(6); PG8_BAR; PG8_MMA(1, 1, At, B1); PG8_BAR;
            }
        }
        if constexpr (ALIGN_EPI) { if (wr == 0) PG8_BAR; }
        if constexpr (!Epi::AFTER_DRAIN) { E(acc, cur, wr, wc, fr, fq); S.done(cur); }
        if (!has_next) break;
#pragma unroll
        for (int a = 0; a < 2; ++a)
#pragma unroll
            for (int b = 0; b < 2; ++b)
#pragma unroll
                for (int m = 0; m < 4; ++m)
#pragma unroll
                    for (int n = 0; n < 2; ++n) acc[a][b][m][n] = (f32x4){0.f, 0.f, 0.f, 0.f};
        cur = nxt; cA = nA; cB = nB; ++ui;
        if constexpr (ALIGN_EPI) { if (wr == 1) PG8_BAR; }
    }
    PG8_WAIT_V(0);
    if constexpr (!ALIGN_EPI) { if (wr == 0) PG8_BAR; }
    PG8_BAR;
    if constexpr (Epi::AFTER_DRAIN) { E.fused(acc, cur, wr, wc, fr, fq, lds, wid, lane); S.done(cur); }
#undef PG8_SA
#undef PG8_SB
#undef PG8_STAGE
#undef PG8_LDA
#undef PG8_LDB
#undef PG8_MMA
#undef PG8_WAIT_V
#undef PG8_WAIT_L
#undef PG8_BAR
#undef PG8_SCHED
}
}


namespace pg8 {
struct EpiProj {
    static constexpr bool PERM = true, AFTER_DRAIN = false;
    bf16_t* P0; bf16_t* P1; bf16_t* P2;
    __device__ __forceinline__ void operator()(const f32x4 (&acc)[2][2][4][2], const Unit& u, int wr, int wc, int fr, int fq) const {
        const int row0 = u.pm * BM + wr * 64 + fr; const int colt = u.pn * BM;
        const long d1 = (long)(P1 - P0), d2 = (long)(P2 - P0); long dsel = 0; if (colt >= 1024) dsel = d1; if (colt >= 2048) dsel = d2;
        bf16_t* base = P0 + dsel; const int ldc = colt < 2048 ? 1024 : 256; const int cl = colt & 1023;
        const int col0 = cl + wc * 32 + 8 * fq;
#pragma unroll
        for (int ai = 0; ai < 2; ++ai)
#pragma unroll
            for (int m = 0; m < 4; ++m) { bf16_t* rowp = base + (size_t)(row0 + ai * HALF + m * 16) * ldc + col0;
#pragma unroll
                for (int bj = 0; bj < 2; ++bj) { const f32x4 v0 = acc[ai][bj][m][0], v1 = acc[ai][bj][m][1];
                    u32x4 w; w.x = cvt_pk_bf16(v0[0], v0[1]); w.y = cvt_pk_bf16(v0[2], v0[3]); w.z = cvt_pk_bf16(v1[0], v1[1]); w.w = cvt_pk_bf16(v1[2], v1[3]);
                    *(u32x4*)(rowp + bj * HALF) = w; } }
    }
};
}

constexpr int P3_TILE_BYTES = 256 * 1024;
constexpr int LDS_TK = 92160;
constexpr int SCW = 260;
template <int N> DI void ce_desc(float (&a)[N], int i, int l) { const float hi = fmaxf(a[i], a[l]), lo = fminf(a[i], a[l]); a[i] = hi; a[l] = lo; }
DI void sort16_desc(float (&a)[16]) {
#pragma unroll
  for (int k = 2; k <= 16; k <<= 1)
#pragma unroll
    for (int j = k >> 1; j > 0; j >>= 1)
#pragma unroll
      for (int i = 0; i < 16; ++i) { const int l = i ^ j; if (l > i) { if ((i & k) == 0) ce_desc(a, i, l); else ce_desc(a, l, i); } }
}
DI void merge16_desc(float (&a)[16]) {
#pragma unroll
  for (int j = 8; j > 0; j >>= 1)
#pragma unroll
    for (int i = 0; i < 16; ++i) { const int l = i ^ j; if (l > i) ce_desc(a, i, l); }
}
DI void top16_merge(float (&a)[16], const float (&b)[16]) {
#pragma unroll
  for (int i = 0; i < 16; ++i) a[i] = fmaxf(a[i], b[15 - i]);
  merge16_desc(a);
}
template <int CTRL> DI float dpp_f(float v) { return __int_as_float(__builtin_amdgcn_mov_dpp(__float_as_int(v), CTRL, 0xF, 0xF, true)); }

DI float gelu_fast(float x) { return 0.5f * x * (1.f + erff(x * 0.70710678118654752f)); }

DI void phase3(const KP& p, char* lds, const int gather_reps, const int probe) {
  const int tid0 = threadIdx.x;
  const int r = tid0 & 31, hh = (tid0 >> 5) & 1, lane = tid0 & 63;
  char* wl = lds + LDS_WT + ((tid0 >> 6) & 3) * WT_BYTES;
  for (int tile = blockIdx.x; tile < 256; tile += gridDim.x) {
    unsigned char* ws = launder(p.ws); float* outp = launder(p.out); const float* xin = launder(p.in[0]);
    const int tok0 = tile * 64, b = tile >> 5;
    unsigned char* tsc = ws + WS_QM + (size_t)tile * P3_TILE_BYTES;
    bf16_t* QRY = (bf16_t*)tsc; bf16_t* Y = (bf16_t*)tsc; bf16_t* MIXA = (bf16_t*)(ws + WS_P1S) + (size_t)tok0 * 1024; bf16_t* H2 = MIXA;
    const float* modb = launder((const float*)(ws + WS_MOD)) + b * 6144;
    __syncthreads();
    {
      const int tid = lv(tid0), lane = tid & 63, w = tid >> 6, r = lane & 31, hh = lane >> 5;
      const int h = w >> 1, mi = w & 1, n = tile & 31;
      char* OIL = lds; char* RGL = lds + 66560;
      { const bf16_t* oig = (const bf16_t*)(ws + WS_OINTRA) + (size_t)tok0 * 512; const bf16_t* rgg = (const bf16_t*)(ws + WS_RG) + (size_t)tok0 * 512;
#pragma unroll
        for (int i = 0; i < 8; ++i) { const int c = tid + 512 * i, row = c >> 6, cc = c & 63;
          *(uint4*)(OIL + row * 1040 + cc * 16) = *(const uint4*)(oig + (size_t)row * 512 + cc * 8);
          *(uint4*)(RGL + row * 1040 + cc * 16) = *(const uint4*)(rgg + (size_t)row * 512 + cc * 8); } }
      const bf16_t* QDg = (const bf16_t*)(ws + WS_QDEC) + (size_t)(tile * 4 + h) * 2 * 4096 + (mi * 32 + r) * 64 + hh * 8;
      const bf16_t* SPg = (const bf16_t*)(ws + WS_SPT) + ((size_t)((b * 4 + h) * 2) * 32 + n) * 8192 + r * 64 + hh * 8;
      f32x16 acc[4];
#pragma unroll
      for (int ni = 0; ni < 4; ++ni)
#pragma unroll
        for (int i = 0; i < 16; ++i) acc[ni][i] = 0.f;
#pragma unroll
      for (int d = 0; d < 2; ++d)
#pragma unroll
        for (int s = 0; s < 4; ++s) { const bf16x8 a = *(const bf16x8*)(QDg + d * 4096 + s * 16);
#pragma unroll
          for (int ni = 0; ni < 4; ++ni) { const bf16x8 bb = *(const bf16x8*)(SPg + (size_t)d * 32 * 8192 + ni * 32 * 64 + s * 16); acc[ni] = MFMA32(a, bb, acc[ni]); } }
      __syncthreads();
      bf16_t* oil = (bf16_t*)(OIL + (mi * 32 + 4 * hh) * 1040) + h * 128 + r; const bf16_t* rgl = (const bf16_t*)(RGL + (mi * 32 + 4 * hh) * 1040) + h * 128 + r;
#pragma unroll
      for (int ni = 0; ni < 4; ++ni)
#pragma unroll
        for (int reg = 0; reg < 16; ++reg) acc[ni][reg] += bf2f(oil[((reg & 3) + 8 * (reg >> 2)) * 520 + ni * 32]);
      float rs[16];
#pragma unroll
      for (int reg = 0; reg < 16; ++reg) { float v = acc[0][reg] * acc[0][reg] + acc[1][reg] * acc[1][reg] + acc[2][reg] * acc[2][reg] + acc[3][reg] * acc[3][reg];
        v += __shfl_xor(v, 1); v += __shfl_xor(v, 2); v += __shfl_xor(v, 4); v += __shfl_xor(v, 8); v += __shfl_xor(v, 16);
        rs[reg] = rsqrtf(v * (1.f / 128.f) + EPS); }
      const float* ggl = launder(p.in[16]);
#pragma unroll
      for (int ni = 0; ni < 4; ++ni) { const float g = ggl[ni * 32 + r];
#pragma unroll
        for (int reg = 0; reg < 16; ++reg) { const int ro = ((reg & 3) + 8 * (reg >> 2)) * 520 + ni * 32; const float rv = bf2f(rgl[ro]);
          oil[ro] = f2bf(acc[ni][reg] * rs[reg] * g * silu_fast(rv)); } }
      __syncthreads();
#pragma unroll
      for (int i = 0; i < 8; ++i) { const int c = tid + 512 * i, row = c >> 6, cc = c & 63;
        *(uint4*)(MIXA + (size_t)row * 1024 + 512 + cc * 8) = *(const uint4*)(OIL + row * 1040 + cc * 16); }
    }
  }
}

DI void phase3c(const KP& p, char* lds, const int gather_reps, const int probe) {
  const int tid0 = threadIdx.x;
  const int r = tid0 & 31, hh = (tid0 >> 5) & 1, lane = tid0 & 63;
  char* wl = lds + LDS_WT + ((tid0 >> 6) & 3) * WT_BYTES;
  for (int tile = blockIdx.x; tile < 256; tile += gridDim.x) {
    unsigned char* ws = launder(p.ws); float* outp = launder(p.out); const float* xin = launder(p.in[0]);
    const int tok0 = tile * 64, b = tile >> 5;
    unsigned char* tsc = ws + WS_QM + (size_t)tile * P3_TILE_BYTES;
    bf16_t* QRY = (bf16_t*)tsc; bf16_t* Y = (bf16_t*)(ws + WS_QM) + (size_t)tok0 * 1024; bf16_t* MIXA = (bf16_t*)(ws + WS_P1S) + (size_t)tok0 * 1024; bf16_t* H2 = MIXA;
    const float* modb = launder((const float*)(ws + WS_MOD)) + b * 6144;
    __syncthreads();
    {
      const int tid = lv(tid0), lane = tid & 63, w = tid >> 6;
      float4 A1[4], A2[4], S2[4];
      const float* gpo = launder(p.in[6]); const float* gpf = launder(p.in[18]);
#pragma unroll
      for (int i = 0; i < 4; ++i) { const int d = (lane + 64 * i) * 4;
        const float4 gp = *(const float4*)(gpo + d), gt = *(const float4*)(modb + 2048 + d), g2 = *(const float4*)(gpf + d), sc = *(const float4*)(modb + 4096 + d);
        S2[i] = *(const float4*)(modb + 3072 + d);
        A1[i] = make_float4(gp.x * gt.x, gp.y * gt.y, gp.z * gt.z, gp.w * gt.w);
        A2[i] = make_float4(g2.x * (1.f + sc.x), g2.y * (1.f + sc.y), g2.z * (1.f + sc.z), g2.w * (1.f + sc.w)); }
#pragma unroll 2
      for (int rr = 0; rr < 8; ++rr) { const int row = w * 8 + rr; const size_t tok = tok0 + row;
        float4 yv[4]; float ss = 0.f;
#pragma unroll
        for (int i = 0; i < 4; ++i) { const uint2 u = *(const uint2*)(Y + (size_t)row * 1024 + (lane + 64 * i) * 4);
          yv[i] = make_float4(__uint_as_float(u.x << 16), __uint_as_float(u.x & 0xffff0000u), __uint_as_float(u.y << 16), __uint_as_float(u.y & 0xffff0000u));
          ss += yv[i].x * yv[i].x + yv[i].y * yv[i].y + yv[i].z * yv[i].z + yv[i].w * yv[i].w; }
        ss = wave_sum(ss); const float rs = rsqrtf(ss * (1.f / 1024.f) + EPS);
        float4 xv[4]; float s2 = 0.f;
#pragma unroll
        for (int i = 0; i < 4; ++i) { const float4 x = *(const float4*)(xin + tok * 1024 + (lane + 64 * i) * 4);
          xv[i] = make_float4(x.x + A1[i].x * yv[i].x * rs, x.y + A1[i].y * yv[i].y * rs, x.z + A1[i].z * yv[i].z * rs, x.w + A1[i].w * yv[i].w * rs);
          *(float4*)(outp + tok * 1024 + (lane + 64 * i) * 4) = xv[i];
          s2 += xv[i].x * xv[i].x + xv[i].y * xv[i].y + xv[i].z * xv[i].z + xv[i].w * xv[i].w; }
        s2 = wave_sum(s2); const float r2 = rsqrtf(s2 * (1.f / 1024.f) + EPS);
#pragma unroll
        for (int i = 0; i < 4; ++i) { uint2 o; o.x = pack2(xv[i].x * r2 * A2[i].x + S2[i].x, xv[i].y * r2 * A2[i].y + S2[i].y); o.y = pack2(xv[i].z * r2 * A2[i].z + S2[i].z, xv[i].w * r2 * A2[i].w + S2[i].w);
          *(uint2*)(H2 + (size_t)row * 1024 + (lane + 64 * i) * 4) = o; }
      }
    }
  }
}

DI void phase3b(const KP& p, char* lds, const int gather_reps, const int probe) {
  const int tid0 = threadIdx.x;
  const int r = tid0 & 31, hh = (tid0 >> 5) & 1, lane = tid0 & 63;
  char* wl = lds + LDS_WT + ((tid0 >> 6) & 3) * WT_BYTES;
  for (int tile = blockIdx.x; tile < 256; tile += gridDim.x) {
    unsigned char* ws = launder(p.ws); float* outp = launder(p.out); const float* xin = launder(p.in[0]);
    const int tok0 = tile * 64, b = tile >> 5;
    unsigned char* tsc = ws + WS_QM + (size_t)tile * P3_TILE_BYTES;
    bf16_t* QRY = (bf16_t*)tsc; bf16_t* Y = (bf16_t*)tsc; bf16_t* MIXA = (bf16_t*)(ws + WS_P1S) + (size_t)tok0 * 1024; bf16_t* H2 = MIXA;
    const float* modb = launder((const float*)(ws + WS_MOD)) + b * 6144;
    __syncthreads();
    float* SC = (float*)lds; unsigned* TK = (unsigned*)(lds + LDS_TK);
    for (int rep3e = 0; rep3e < (probe == 7 ? 2 : 1); ++rep3e)
    for (int h = 0; h < 8; ++h) {
      block_gemm<2>(lds, QRY + h * 256, 2048, (const bf16_t*)(ws + WS_KD), 1, 256, [&](int m0, int n0, const f32x16& a0, const f32x16& a1) {
        const int r2 = lv(r), h2 = lv(hh);
        float* sp = SC + (m0 + 4 * h2) * SCW + n0 + r2;
#pragma unroll
        for (int reg = 0; reg < 16; ++reg) { const int ro = ((reg & 3) + 8 * (reg >> 2)) * SCW; sp[ro] = a0[reg]; sp[ro + 32] = a1[reg]; }
      });
      __syncthreads();
      {
        const int tid = lv(tid0);
        const int tt = tid >> 3, sd = (tid >> 2) & 1, q = tid & 3;
        const float* sr = SC + tt * SCW + sd * 128 + q * 32;
        float a[16], c[16];
#pragma unroll
        for (int i = 0; i < 4; ++i) { const float4 v = *(const float4*)(sr + i * 4); const unsigned ib = q * 32 + i * 4;
          a[i * 4 + 0] = __uint_as_float((__float_as_uint(v.x) & 0xFFFFFF80u) | (ib + 0)); a[i * 4 + 1] = __uint_as_float((__float_as_uint(v.y) & 0xFFFFFF80u) | (ib + 1));
          a[i * 4 + 2] = __uint_as_float((__float_as_uint(v.z) & 0xFFFFFF80u) | (ib + 2)); a[i * 4 + 3] = __uint_as_float((__float_as_uint(v.w) & 0xFFFFFF80u) | (ib + 3)); }
#pragma unroll
        for (int i = 0; i < 4; ++i) { const float4 v = *(const float4*)(sr + 16 + i * 4); const unsigned ib = q * 32 + 16 + i * 4;
          c[i * 4 + 0] = __uint_as_float((__float_as_uint(v.x) & 0xFFFFFF80u) | (ib + 0)); c[i * 4 + 1] = __uint_as_float((__float_as_uint(v.y) & 0xFFFFFF80u) | (ib + 1));
          c[i * 4 + 2] = __uint_as_float((__float_as_uint(v.z) & 0xFFFFFF80u) | (ib + 2)); c[i * 4 + 3] = __uint_as_float((__float_as_uint(v.w) & 0xFFFFFF80u) | (ib + 3)); }
        sort16_desc(a); sort16_desc(c); top16_merge(a, c);
#pragma unroll
        for (int i = 0; i < 16; ++i) c[i] = dpp_f<0xB1>(a[i]);
        top16_merge(a, c);
#pragma unroll
        for (int i = 0; i < 16; ++i) c[i] = dpp_f<0x4E>(a[i]);
        top16_merge(a, c);
        if (q == 0) { unsigned* tk = TK + ((tt * 8 + h) * 2 + sd) * 16;
#pragma unroll
          for (int i = 0; i < 4; ++i) *(uint4*)(tk + i * 4) = make_uint4(__float_as_uint(a[i * 4]), __float_as_uint(a[i * 4 + 1]), __float_as_uint(a[i * 4 + 2]), __float_as_uint(a[i * 4 + 3])); }
      }
      __syncthreads();
    }
    int* EIDX = (int*)lds; float* GATE = (float*)(lds + 32768);
    {
      const int tid = lv(tid0);
      const int tt = tid >> 3, h = tid & 7;
      const unsigned* t1 = TK + ((tt * 8 + h) * 2) * 16; const unsigned* t2 = t1 + 16;
      float v1[16], v2[16];
#pragma unroll
      for (int i = 0; i < 4; ++i) { const uint4 u = *(const uint4*)(t1 + i * 4), v = *(const uint4*)(t2 + i * 4);
        v1[i * 4] = __uint_as_float(u.x & 0xFFFFFF80u); v1[i * 4 + 1] = __uint_as_float(u.y & 0xFFFFFF80u); v1[i * 4 + 2] = __uint_as_float(u.z & 0xFFFFFF80u); v1[i * 4 + 3] = __uint_as_float(u.w & 0xFFFFFF80u);
        v2[i * 4] = __uint_as_float(v.x & 0xFFFFFF80u); v2[i * 4 + 1] = __uint_as_float(v.y & 0xFFFFFF80u); v2[i * 4 + 2] = __uint_as_float(v.z & 0xFFFFFF80u); v2[i * 4 + 3] = __uint_as_float(v.w & 0xFFFFFF80u); }
      float best[16], grp[16];
#define CAND(i, j) __uint_as_float((__float_as_uint(v1[i] + v2[j]) & 0xFFFFFF00u) | ((i) << 4) | (j))
      best[0] = CAND(0, 0); best[1] = CAND(0, 1); best[2] = CAND(0, 2); best[3] = CAND(0, 3); best[4] = CAND(0, 4); best[5] = CAND(0, 5); best[6] = CAND(0, 6); best[7] = CAND(0, 7);
      best[8] = CAND(0, 8); best[9] = CAND(0, 9); best[10] = CAND(0, 10); best[11] = CAND(0, 11); best[12] = CAND(0, 12); best[13] = CAND(0, 13); best[14] = CAND(0, 14); best[15] = CAND(0, 15);
      sort16_desc(best);
      grp[0] = CAND(1, 0); grp[1] = CAND(1, 1); grp[2] = CAND(1, 2); grp[3] = CAND(1, 3); grp[4] = CAND(1, 4); grp[5] = CAND(1, 5); grp[6] = CAND(1, 6); grp[7] = CAND(1, 7);
      grp[8] = CAND(2, 0); grp[9] = CAND(2, 1); grp[10] = CAND(2, 2); grp[11] = CAND(2, 3); grp[12] = CAND(2, 4); grp[13] = CAND(3, 0); grp[14] = CAND(3, 1); grp[15] = CAND(3, 2);
      sort16_desc(grp); top16_merge(best, grp);
      grp[0] = CAND(3, 3); grp[1] = CAND(4, 0); grp[2] = CAND(4, 1); grp[3] = CAND(4, 2); grp[4] = CAND(5, 0); grp[5] = CAND(5, 1); grp[6] = CAND(6, 0); grp[7] = CAND(6, 1);
      grp[8] = CAND(7, 0); grp[9] = CAND(7, 1); grp[10] = CAND(8, 0); grp[11] = CAND(9, 0); grp[12] = CAND(10, 0); grp[13] = CAND(11, 0); grp[14] = CAND(12, 0); grp[15] = CAND(13, 0);
      sort16_desc(grp); top16_merge(best, grp);
      { const float c14 = CAND(14, 0), c15 = CAND(15, 0);
        grp[0] = fmaxf(c14, c15); grp[1] = fminf(c14, c15);
#pragma unroll
        for (int i = 2; i < 16; ++i) grp[i] = -3.0e38f;
        top16_merge(best, grp); }
#undef CAND
      __syncthreads();
      float sv[16]; int ev[16]; float mx = -3.0e38f;
#pragma unroll
      for (int k = 0; k < 16; ++k) { const unsigned key = __float_as_uint(best[k]); const int ci = (key >> 4) & 15, cj = key & 15;
        const unsigned k1 = t1[ci], k2 = t2[cj];
        sv[k] = __uint_as_float(k1 & 0xFFFFFF80u) + __uint_as_float(k2 & 0xFFFFFF80u); ev[k] = (int)((k1 & 127u) * 128u + (k2 & 127u)); mx = fmaxf(mx, sv[k]); }
      float sum = 0.f;
#pragma unroll
      for (int k = 0; k < 16; ++k) { sv[k] = __expf(sv[k] - mx); sum += sv[k]; }
      const float inv = 1.f / sum;
#pragma unroll
      for (int k = 0; k < 16; ++k) { EIDX[tt * 128 + h * 16 + k] = ev[k]; GATE[tt * 128 + h * 16 + k] = sv[k] * inv; }
    }
    __syncthreads();
    {
      const int tid = lv(tid0), lane = tid & 63, w = tid >> 6;
      const unsigned char* EU = ws + WS_EU; const unsigned char* EV = ws + WS_EV; const float* SCU = (const float*)(ws + WS_ESC); const float* SCV = SCU + 16384;
      const float* gpf2 = launder(p.in[19]);
      typedef float f2v __attribute__((ext_vector_type(2)));
#define FP8X4(wd, o0, o1, o2, o3) do { const f2v lo_ = __builtin_amdgcn_cvt_pk_f32_fp8((int)(wd), false), hi_ = __builtin_amdgcn_cvt_pk_f32_fp8((int)(wd), true); o0 = lo_.x; o1 = lo_.y; o2 = hi_.x; o3 = hi_.y; } while (0)
#pragma unroll 1
      for (int pass = 0; pass < gather_reps; ++pass)
#pragma unroll 1
      for (int rr = 0; rr < 8; ++rr) { const int row = w * 8 + rr; const size_t tok = tok0 + row;
        float hf[16];
        { const uint4 hA = *(const uint4*)(H2 + (size_t)row * 1024 + lane * 16), hB = *(const uint4*)(H2 + (size_t)row * 1024 + lane * 16 + 8);
          hf[0] = __uint_as_float(hA.x << 16); hf[1] = __uint_as_float(hA.x & 0xffff0000u); hf[2] = __uint_as_float(hA.y << 16); hf[3] = __uint_as_float(hA.y & 0xffff0000u);
          hf[4] = __uint_as_float(hA.z << 16); hf[5] = __uint_as_float(hA.z & 0xffff0000u); hf[6] = __uint_as_float(hA.w << 16); hf[7] = __uint_as_float(hA.w & 0xffff0000u);
          hf[8] = __uint_as_float(hB.x << 16); hf[9] = __uint_as_float(hB.x & 0xffff0000u); hf[10] = __uint_as_float(hB.y << 16); hf[11] = __uint_as_float(hB.y & 0xffff0000u);
          hf[12] = __uint_as_float(hB.z << 16); hf[13] = __uint_as_float(hB.z & 0xffff0000u); hf[14] = __uint_as_float(hB.w << 16); hf[15] = __uint_as_float(hB.w & 0xffff0000u); }
        float acc[16];
#pragma unroll
        for (int i = 0; i < 16; ++i) acc[i] = 0.f;
#pragma unroll 1
        for (int g = 0; g < 16; ++g) {
          const int* ep = EIDX + row * 128 + g * 8;
          const int4 ea = *(const int4*)ep, eb = *(const int4*)(ep + 4);
          int es[8];
          es[0] = __builtin_amdgcn_readfirstlane(ea.x); es[1] = __builtin_amdgcn_readfirstlane(ea.y); es[2] = __builtin_amdgcn_readfirstlane(ea.z); es[3] = __builtin_amdgcn_readfirstlane(ea.w);
          es[4] = __builtin_amdgcn_readfirstlane(eb.x); es[5] = __builtin_amdgcn_readfirstlane(eb.y); es[6] = __builtin_amdgcn_readfirstlane(eb.z); es[7] = __builtin_amdgcn_readfirstlane(eb.w);
          uint4 u[8], v[8];
#pragma unroll
          for (int k2 = 0; k2 < 8; ++k2) u[k2] = *(const uint4*)(EU + (size_t)es[k2] * 1024 + lane * 16);
#pragma unroll
          for (int k2 = 0; k2 < 8; ++k2) v[k2] = *(const uint4*)(EV + (size_t)es[k2] * 1024 + lane * 16);
          const int eslot = ep[lane & 7];
          const float gte = GATE[row * 128 + g * 8 + (lane & 7)], su = SCU[eslot], sv = SCV[eslot];
          float P[8];
#pragma unroll
          for (int k2 = 0; k2 < 8; ++k2) { float a0, a1, a2, a3, d;
            FP8X4(u[k2].x, a0, a1, a2, a3); d = a0 * hf[0] + a1 * hf[1] + a2 * hf[2] + a3 * hf[3];
            FP8X4(u[k2].y, a0, a1, a2, a3); d += a0 * hf[4] + a1 * hf[5] + a2 * hf[6] + a3 * hf[7];
            FP8X4(u[k2].z, a0, a1, a2, a3); d += a0 * hf[8] + a1 * hf[9] + a2 * hf[10] + a3 * hf[11];
            FP8X4(u[k2].w, a0, a1, a2, a3); d += a0 * hf[12] + a1 * hf[13] + a2 * hf[14] + a3 * hf[15];
            P[k2] = d; }
          { const bool up4 = (lane & 4) != 0;
#pragma unroll
            for (int e = 0; e < 4; ++e) { const float keep = up4 ? P[e + 4] : P[e], send = up4 ? P[e] : P[e + 4]; P[e] = keep + __shfl_xor(send, 4); }
            const bool up2 = (lane & 2) != 0;
#pragma unroll
            for (int e = 0; e < 2; ++e) { const float keep = up2 ? P[e + 2] : P[e], send = up2 ? P[e] : P[e + 2]; P[e] = keep + dpp_f<0x4E>(send); }
            const bool up1 = (lane & 1) != 0;
            const float keep = up1 ? P[1] : P[0], send = up1 ? P[0] : P[1];
            float av = keep + dpp_f<0xB1>(send);
            av += __shfl_xor(av, 8); av += __shfl_xor(av, 16); av += __shfl_xor(av, 32);
            av *= su;
            const float ax = fabsf(av), t = __builtin_amdgcn_rcpf(ax * 0.2316418882f + 1.0f);
            float q = t * 0.5307027145f + (-0.7265760135f); q = q * t + 0.7107068705f; q = q * t + (-0.142248368f); q = q * t + 0.127414796f; q = q * t;
            const float ee = __builtin_amdgcn_exp2f(av * av * (-0.72134752044f));
            const float mm = av * (q * ee), gl = (av < 0.f) ? mm : (av - mm);
            P[0] = gte * gl * sv; }
#pragma unroll
          for (int k2 = 0; k2 < 8; ++k2) { const float wk = __int_as_float(__builtin_amdgcn_readlane(__float_as_int(P[0]), k2)); float a0, a1, a2, a3;
            FP8X4(v[k2].x, a0, a1, a2, a3); acc[0] += wk * a0; acc[1] += wk * a1; acc[2] += wk * a2; acc[3] += wk * a3;
            FP8X4(v[k2].y, a0, a1, a2, a3); acc[4] += wk * a0; acc[5] += wk * a1; acc[6] += wk * a2; acc[7] += wk * a3;
            FP8X4(v[k2].z, a0, a1, a2, a3); acc[8] += wk * a0; acc[9] += wk * a1; acc[10] += wk * a2; acc[11] += wk * a3;
            FP8X4(v[k2].w, a0, a1, a2, a3); acc[12] += wk * a0; acc[13] += wk * a1; acc[14] += wk * a2; acc[15] += wk * a3; }
        }
        float ss = 0.f;
#pragma unroll
        for (int i = 0; i < 16; ++i) ss += acc[i] * acc[i];
        ss = wave_sum(ss); const float rs = rsqrtf(ss * (1.f / 1024.f) + EPS);
        float* orow = outp + tok * 1024 + lane * 16;
        if (pass == gather_reps - 1)
#pragma unroll
        for (int i = 0; i < 4; ++i) { const int d = lane * 16 + 4 * i;
          float4 x1 = *(const float4*)(orow + 4 * i); const float4 g3 = *(const float4*)(gpf2 + d), g2 = *(const float4*)(modb + 5120 + d);
          x1.x += g3.x * g2.x * acc[4 * i] * rs; x1.y += g3.y * g2.y * acc[4 * i + 1] * rs; x1.z += g3.z * g2.z * acc[4 * i + 2] * rs; x1.w += g3.w * g2.w * acc[4 * i + 3] * rs;
          *(float4*)(orow + 4 * i) = x1; }
      }
#undef FP8X4
    }
  }
}

DI void phase2_scan(const KP& p) {
  unsigned char* ws = p.ws;
  for (int g = blockIdx.x * NTHR + threadIdx.x; g < 131072; g += gridDim.x * NTHR) {
    const int seq = g >> 11, within = g & 2047, dv = within >> 4, dk4 = (within & 15) * 4, dir = seq & 1;
    bf16_t* base = (bf16_t*)(ws + WS_SPT) + ((size_t)seq * 32 * 128 + dv) * 64 + dk4;
    const float* dec = (const float*)(ws + WS_DEC) + (size_t)seq * 32 * 64 + dk4;
    float s0 = 0.f, s1 = 0.f, s2 = 0.f, s3 = 0.f;
#pragma unroll 1
    for (int i0 = 0; i0 < 32; i0 += 8) {
      uint2 d[8]; float4 c[8];
#pragma unroll
      for (int j = 0; j < 8; ++j) { const int n = dir ? 31 - (i0 + j) : (i0 + j); d[j] = *(const uint2*)(base + (size_t)n * 8192); c[j] = *(const float4*)(dec + n * 64); }
#pragma unroll
      for (int j = 0; j < 8; ++j) { const int n = dir ? 31 - (i0 + j) : (i0 + j);
        uint2 o; o.x = pack2(s0, s1); o.y = pack2(s2, s3); *(uint2*)(base + (size_t)n * 8192) = o;
        s0 = c[j].x * s0 + __uint_as_float(d[j].x << 16); s1 = c[j].y * s1 + __uint_as_float(d[j].x & 0xffff0000u);
        s2 = c[j].z * s2 + __uint_as_float(d[j].y << 16); s3 = c[j].w * s3 + __uint_as_float(d[j].y & 0xffff0000u); }
    }
  }
}

#define XB_TMO      128
#define XB_XCNT(j)  (256  + 64 * (j))
#define XB_XSUB(j)  (1280 + 64 * (j))
#define XB_XGEN(j)  (2304 + 64 * (j))
#define XB_TOP      3328
#define XB_TOPGEN   3392
#define XCD_BAR_WORDS 3456
#define XB_SPIN_CAP (1u << 18)
#define LAS __attribute__((address_space(3)))

__device__ __forceinline__ unsigned xb_ld(unsigned* p)              { return __hip_atomic_load(p, __ATOMIC_RELAXED, __HIP_MEMORY_SCOPE_AGENT); }
__device__ __forceinline__ unsigned xb_add(unsigned* p, unsigned v) { return __hip_atomic_fetch_add(p, v, __ATOMIC_RELAXED, __HIP_MEMORY_SCOPE_AGENT); }
__device__ __forceinline__ unsigned xb_xcc_id() { return (unsigned)__builtin_amdgcn_s_getreg((3 << 11) | 20) & 0xFu; }
#define XB_SPIN(cond, bar) do { unsigned _sp = 0; while (cond) { __builtin_amdgcn_s_sleep(1); \
    if ((++_sp & 255u) == 0u) { if (xb_ld(&(bar)[XB_TMO])) break; if (_sp > XB_SPIN_CAP) { atomicAdd(&(bar)[XB_TMO], 1u); break; } } } } while (0)

struct XcdBarrier {
    unsigned* bar; unsigned x;
    volatile LAS unsigned* st;
};

__device__ __forceinline__ XcdBarrier xcd_barrier_post(unsigned* bar, volatile LAS unsigned* st) {
    XcdBarrier b; b.bar = bar; b.x = xb_xcc_id(); b.st = st;
    if (threadIdx.x == 0) (void)xb_add(&bar[XB_XCNT(b.x)], 1u);
    return b;
}
__device__ __forceinline__ void xcd_barrier_complete(unsigned* bar, unsigned x, unsigned& nloc, unsigned& nx) {
    const unsigned G = gridDim.x * gridDim.y * gridDim.z;
    unsigned sum, cnt, mine, sp = 0u;
    for (;;) {
        sum = 0u; cnt = 0u; mine = 0u;
#pragma unroll
        for (unsigned j = 0; j < 16; ++j) { const unsigned c = xb_ld(&bar[XB_XCNT(j)]); sum += c; cnt += (c > 0u) ? 1u : 0u; mine = (j == x) ? c : mine; }
        if (sum == G) break;
        __builtin_amdgcn_s_sleep(1);
        if ((++sp & 255u) == 0u) { if (xb_ld(&bar[XB_TMO])) break; if (sp > XB_SPIN_CAP) { atomicAdd(&bar[XB_TMO], 1u); break; } }
    }
    nloc = mine > 0u ? mine : 1u; nx = cnt > 0u ? cnt : 1u;
}

__device__ __forceinline__ void xcd_barrier(const XcdBarrier& b) {
    asm volatile("s_waitcnt vmcnt(0)" ::: "memory");
    __syncthreads();
    if (threadIdx.x == 0) {
        unsigned* bar = b.bar;
        __builtin_amdgcn_s_waitcnt(0);
        unsigned nloc = b.st[0], nx = b.st[1];
        if (nloc == 0u) { xcd_barrier_complete(bar, b.x, nloc, nx); b.st[0] = nloc; b.st[1] = nx; }
        const unsigned old = xb_add(&bar[XB_XSUB(b.x)], 1u);
        const unsigned gen = old / nloc;
        if (old + 1u == (gen + 1u) * nloc) {
            __builtin_amdgcn_fence(__ATOMIC_RELEASE, "agent");
            asm volatile("s_waitcnt vmcnt(0)" ::: "memory");
            const unsigned og = xb_add(&bar[XB_TOP], 1u);
            const unsigned tg = og / nx;
            if (og + 1u == (tg + 1u) * nx) xb_add(&bar[XB_TOPGEN], 1u);
            else XB_SPIN(xb_ld(&bar[XB_TOPGEN]) == tg, bar);
            __builtin_amdgcn_fence(__ATOMIC_ACQUIRE, "agent");
            xb_add(&bar[XB_XGEN(b.x)], 1u);
            asm volatile("s_waitcnt vmcnt(0)" ::: "memory");
        } else {
            XB_SPIN(xb_ld(&bar[XB_XGEN(b.x)]) == gen, bar);
            __builtin_amdgcn_fence(__ATOMIC_ACQUIRE, "agent");
            asm volatile("s_waitcnt vmcnt(0)" ::: "memory");
        }
    }
    __syncthreads();
}

#ifndef PROBE_ID
#define PROBE_ID 0
#endif
__global__ void __launch_bounds__(NTHR, 2) mega(KP p) {
  extern __shared__ __attribute__((aligned(16))) char lds[];
  cg::grid_group grid = cg::this_grid();
  const int hi = p.ph_hi; constexpr int probe = PROBE_ID;
  if (threadIdx.x == 0) { ((volatile LAS unsigned*)(lds + LDS_XB))[0] = 0u; ((volatile LAS unsigned*)(lds + LDS_XB))[1] = 0u; }
  __syncthreads();
  const XcdBarrier xb = xcd_barrier_post((unsigned*)(p.ws + WS_BAR), (volatile LAS unsigned*)(lds + LDS_XB));
  if (p.ph_lo <= 0 && 0 < hi) { phase0(p, lds); if (probe == 1) phase0(p, lds); if (1 < hi) { if (hi > 64) grid.sync(); else xcd_barrier(xb); } }
  if (p.ph_lo <= 1 && 1 < hi) {
    phase1a(p, lds);
    xcd_barrier(xb);
    {
      pg8::Gemm g{(const pg8::bf16_t*)p.out, (const pg8::bf16_t*)(p.ws + WS_WTINP), NTOK, 2304, 1024};
      pg8::StaticOrder S; S.init(NTOK, 2304, (int)gridDim.x, (int)blockIdx.x);
      pg8::EpiProj E{(pg8::bf16_t*)(p.ws + WS_P1S), (pg8::bf16_t*)((unsigned char*)p.out + 32 * MiB), (pg8::bf16_t*)(p.ws + WS_PROJC)};
      pg8::gemm_phase<pg8::EpiProj, pg8::StaticOrder, true, true>((PG8_LAS unsigned char*)lds, g, S, E);
    }
    xcd_barrier(xb);
    phase1c(p, lds);
    if (2 < hi) xcd_barrier(xb);
  }
  if (p.ph_lo <= 2 && 2 < hi) { phase2_scan(p); phase2_attn(p, lds); if (probe == 3) phase2_attn(p, lds); if (3 < hi) xcd_barrier(xb); }
  if (p.ph_lo <= 3 && 3 < hi) {
    phase3(p, lds, 1, probe);
    xcd_barrier(xb);
    {
      pg8::Gemm g{(const pg8::bf16_t*)(p.ws + WS_P1S), (const pg8::bf16_t*)(p.ws + WS_WTOUTP), NTOK, 1024, 1024};
      pg8::StaticOrder S; S.init(NTOK, 1024, (int)gridDim.x, (int)blockIdx.x);
      pg8::EpiBf16<0> E{(pg8::bf16_t*)(p.ws + WS_QM), 1024, nullptr, 0, 0, 1.f};
      pg8::gemm_phase<pg8::EpiBf16<0>, pg8::StaticOrder, true, true>((PG8_LAS unsigned char*)lds, g, S, E);
    }
    xcd_barrier(xb);
    phase3c(p, lds, 1, probe);
    xcd_barrier(xb);
    {
      pg8::Gemm g{(const pg8::bf16_t*)(p.ws + WS_P1S), (const pg8::bf16_t*)(p.ws + WS_WTPQP), NTOK, 2048, 1024};
      pg8::StaticOrder S; S.init(NTOK, 2048, (int)gridDim.x, (int)blockIdx.x);
      pg8::EpiBf16<0> E{(pg8::bf16_t*)(p.ws + WS_QM), 2048, nullptr, 0, 0, 1.f};
      pg8::gemm_phase<pg8::EpiBf16<0>, pg8::StaticOrder, true, true>((PG8_LAS unsigned char*)lds, g, S, E);
    }
    xcd_barrier(xb);
    phase3b(p, lds, probe == 4 ? 2 : 1, probe);
  }
}

extern "C" void kernel_launch(void* const* d_in, const int* in_sizes, int n_in, void* d_out, int out_size, void* d_ws, size_t ws_size, hipStream_t stream) {
  float* out = (float*)d_out;
  unsigned char* ws = (unsigned char*)d_ws;
  if (ws_size < WS_END || n_in != 25) return;
  static bool attr_done = false;
  if (!attr_done) { (void)hipFuncSetAttribute((const void*)mega, hipFuncAttributeMaxDynamicSharedMemorySize, LDS_TOTAL); attr_done = true; }
  KP p{};
  for (int i = 0; i < 25; ++i) p.in[i] = (const float*)d_in[i];
  p.out = out; p.ws = ws;
  p.ph_lo = 0; p.ph_hi = 4;
  (void)hipMemsetAsync(ws + WS_BAR, 0, XCD_BAR_WORDS * 4, stream);
  { void* args[] = {&p}; (void)hipLaunchCooperativeKernel((const void*)mega, dim3(256), dim3(NTHR), args, LDS_TOTAL, stream); }
}
```

```cpp
#include <hip/hip_runtime.h>
#include <hip/hip_cooperative_groups.h>
namespace cg = cooperative_groups;
#include <stdint.h>

typedef unsigned short bf16_t;
#define DI __device__ __forceinline__

DI float bf2f(bf16_t v) { return __uint_as_float(((unsigned)v) << 16); }
DI bf16_t f2bf(float f) { return __builtin_bit_cast(unsigned short, (__bf16)f); }

constexpr int BATCH = 8, SEQ = 2048, DM = 1024, NTOK = BATCH * SEQ;
constexpr int INW = 2272;
constexpr float EPS = 1e-6f;
constexpr int O_CQ = 0, O_CKV = 384, O_KR = 640, O_QG = 704, O_KG = 960, O_VG = 1216, O_GF = 1728, O_GB = 1744, O_R = 1760;

DI float wave_sum(float v) {
#pragma unroll
  for (int o = 1; o < 64; o <<= 1) v += __shfl_xor(v, o);
  return v;
}
DI float wave_max(float v) {
#pragma unroll
  for (int o = 1; o < 64; o <<= 1) v = fmaxf(v, __shfl_xor(v, o));
  return v;
}
DI float block_sum256(float v, float* red) {
  v = wave_sum(v);
  __syncthreads();
  if ((threadIdx.x & 63) == 0) red[threadIdx.x >> 6] = v;
  __syncthreads();
  return red[0] + red[1] + red[2] + red[3];
}
DI float block_max256(float v, float* red) {
  v = wave_max(v);
  __syncthreads();
  if ((threadIdx.x & 63) == 0) red[threadIdx.x >> 6] = v;
  __syncthreads();
  return fmaxf(fmaxf(red[0], red[1]), fmaxf(red[2], red[3]));
}
DI float silu_f(float x) { return x / (1.f + expf(-x)); }
DI float logsigmoid_f(float x) { return fminf(x, 0.f) - log1pf(expf(-fabsf(x))); }
DI float fexp(float x) { return __builtin_amdgcn_exp2f(x * 1.4426950408889634f); }
DI float silu_fast(float x) { return x * __builtin_amdgcn_rcpf(1.f + fexp(-x)); }
DI float logsigmoid_fast(float x) { return fminf(x, 0.f) - __builtin_amdgcn_logf(1.f + fexp(-fabsf(x))) * 0.6931471805599453f; }
DI float gelu_erf(float x) { return 0.5f * x * (1.f + erff(x * 0.70710678118654752f)); }

__global__ __launch_bounds__(256) void n_mod(const float* __restrict__ c, const float* __restrict__ w_ada, const float* __restrict__ b_ada, float* __restrict__ mod) {
  int idx = blockIdx.x * 256 + threadIdx.x;
  int b = idx / 6144, j = idx % 6144;
  float acc = b_ada[j];
  for (int k = 0; k < 1024; ++k) acc += silu_f(c[b * 1024 + k]) * w_ada[(size_t)k * 6144 + j];
  mod[idx] = acc;
}

__global__ __launch_bounds__(256) void n_hnorm(const float* __restrict__ x, const float* __restrict__ g, const float* __restrict__ mod, int b, int off_sh, int off_sc, float* __restrict__ h) {
  __shared__ float red[4];
  int t = blockIdx.x, tid = threadIdx.x;
  const float* xr = x + ((size_t)b * SEQ + t) * DM;
  float v[4]; float ss = 0.f;
#pragma unroll
  for (int i = 0; i < 4; ++i) { v[i] = xr[tid + 256 * i]; ss += v[i] * v[i]; }
  ss = block_sum256(ss, red);
  float rs = rsqrtf(ss * (1.f / DM) + EPS);
#pragma unroll
  for (int i = 0; i < 4; ++i) { int d = tid + 256 * i; h[(size_t)t * DM + d] = v[i] * rs * g[d] * (1.f + mod[b * 6144 + off_sc + d]) + mod[b * 6144 + off_sh + d]; }
}

template <bool BT>
__global__ __launch_bounds__(256) void n_gemm(const float* __restrict__ A, int lda, const float* __restrict__ B, int ldb, float* __restrict__ C, int ldc, int M, int N, int K) {
  __shared__ float As[16][65];
  __shared__ float Bs[16][65];
  const int tid = threadIdx.x, tx = tid & 15, ty = tid >> 4;
  const int m0 = blockIdx.y * 64, n0 = blockIdx.x * 64;
  float acc[4][4];
#pragma unroll
  for (int i = 0; i < 4; ++i)
#pragma unroll
    for (int j = 0; j < 4; ++j) acc[i][j] = 0.f;
  for (int k0 = 0; k0 < K; k0 += 16) {
#pragma unroll
    for (int i = 0; i < 4; ++i) { int e = tid + 256 * i; int m = e >> 4, k = e & 15; As[k][m] = A[(size_t)(m0 + m) * lda + k0 + k]; }
#pragma unroll
    for (int i = 0; i < 4; ++i) { int e = tid + 256 * i;
      if (!BT) { int k = e >> 6, n = e & 63; Bs[k][n] = (n0 + n < N) ? B[(size_t)(k0 + k) * ldb + n0 + n] : 0.f; }
      else     { int n = e >> 4, k = e & 15; Bs[k][n] = (n0 + n < N) ? B[(size_t)(n0 + n) * ldb + k0 + k] : 0.f; } }
    __syncthreads();
#pragma unroll
    for (int k = 0; k < 16; ++k) {
      float a[4], bb[4];
#pragma unroll
      for (int i = 0; i < 4; ++i) { a[i] = As[k][ty * 4 + i]; bb[i] = Bs[k][tx * 4 + i]; }
#pragma unroll
      for (int i = 0; i < 4; ++i)
#pragma unroll
        for (int j = 0; j < 4; ++j) acc[i][j] += a[i] * bb[j];
    }
    __syncthreads();
  }
#pragma unroll
  for (int i = 0; i < 4; ++i)
#pragma unroll
    for (int j = 0; j < 4; ++j) { int n = n0 + tx * 4 + j; if (n < N) C[(size_t)(m0 + ty * 4 + i) * ldc + n] = acc[i][j]; }
}

__global__ __launch_bounds__(256) void n_rms_slice(const float* __restrict__ in, int ldin, int off, int W, const float* __restrict__ g, float* __restrict__ out) {
  __shared__ float red[4];
  int t = blockIdx.x, tid = threadIdx.x;
  float v0 = (tid < W) ? in[(size_t)t * ldin + off + tid] : 0.f;
  float v1 = (tid + 256 < W) ? in[(size_t)t * ldin + off + tid + 256] : 0.f;
  float ss = block_sum256(v0 * v0 + v1 * v1, red);
  float rs = rsqrtf(ss / (float)W + EPS);
  if (tid < W) out[(size_t)t * W + tid] = v0 * rs * g[tid];
  if (tid + 256 < W) out[(size_t)t * W + tid + 256] = v1 * rs * g[tid + 256];
}

__global__ __launch_bounds__(256) void n_scatter(const float* __restrict__ proj, const float* __restrict__ qa, const float* __restrict__ kv, const int* __restrict__ positions, int b,
                                                 const float* __restrict__ wgf, const float* __restrict__ bgf, const float* __restrict__ wgb, const float* __restrict__ bgb,
                                                 bf16_t* __restrict__ Qm, bf16_t* __restrict__ Km, bf16_t* __restrict__ Vm, bf16_t* __restrict__ qg, bf16_t* __restrict__ kg, bf16_t* __restrict__ vg,
                                                 bf16_t* __restrict__ rg, float* __restrict__ laf, float* __restrict__ lab) {
  __shared__ float cs[32], sn[32];
  const int t = blockIdx.x, tid = threadIdx.x;
  const size_t tok = (size_t)b * SEQ + t;
  const float* pr = proj + (size_t)t * INW;
  const float* qr = qa + (size_t)t * 768;
  const float* kr = kv + (size_t)t * 1024;
  if (tid < 32) {
    float inv = powf(10000.f, -(float)tid / 32.f);
    float ang = (float)positions[tok] * inv;
    cs[tid] = cosf(ang); sn[tid] = sinf(ang);
  }
  __syncthreads();
  for (int e = tid; e < 4 * 192; e += 256) {
    int h = e / 192, d = e % 192; float v;
    if (d < 128) v = qr[h * 192 + d];
    else { int j = d - 128; const float* rp = qr + h * 192 + 128;
      if (j < 32) v = rp[j] * cs[j] - rp[j + 32] * sn[j]; else v = rp[j] * cs[j - 32] + rp[j - 32] * sn[j - 32]; }
    Qm[(((size_t)b * 4 + h) * SEQ + t) * 192 + d] = f2bf(v);
  }
  for (int e = tid; e < 4 * 192; e += 256) {
    int h = e / 192, d = e % 192; float v;
    if (d < 128) v = kr[h * 256 + d];
    else { int j = d - 128; const float* rp = pr + O_KR;
      if (j < 32) v = rp[j] * cs[j] - rp[j + 32] * sn[j]; else v = rp[j] * cs[j - 32] + rp[j - 32] * sn[j - 32]; }
    Km[(((size_t)b * 4 + h) * SEQ + t) * 192 + d] = f2bf(v);
  }
  for (int e = tid; e < 512; e += 256) { int h = e >> 7, d = e & 127; Vm[(((size_t)b * 4 + h) * SEQ + t) * 128 + d] = f2bf(kr[h * 256 + 128 + d]); }
  { int e = tid; qg[tok * 256 + e] = f2bf(pr[O_QG + e] * 0.125f); kg[tok * 256 + e] = f2bf(pr[O_KG + e]); }
  for (int e = tid; e < 512; e += 256) { vg[tok * 512 + e] = f2bf(pr[O_VG + e]); rg[tok * 512 + e] = f2bf(pr[O_R + e]); }
  { int cidx = tid; float af = bgf[cidx], ab = bgb[cidx];
#pragma unroll
    for (int r = 0; r < 16; ++r) { af += pr[O_GF + r] * wgf[r * 256 + cidx]; ab += pr[O_GB + r] * wgb[r * 256 + cidx]; }
    laf[tok * 256 + cidx] = logsigmoid_f(af) * (1.f / 16.f); lab[tok * 256 + cidx] = logsigmoid_f(ab) * (1.f / 16.f); }
}

__global__ __launch_bounds__(256) void n_attn(const bf16_t* __restrict__ Qm, const bf16_t* __restrict__ Km, const bf16_t* __restrict__ Vm, bf16_t* __restrict__ omla) {
  __shared__ float qs[192]; __shared__ float sc[2048]; __shared__ float red[4];
  const int i = blockIdx.x, h = blockIdx.y, b = blockIdx.z, tid = threadIdx.x;
  const size_t bh = (size_t)b * 4 + h;
  if (tid < 192) qs[tid] = bf2f(Qm[(bh * SEQ + i) * 192 + tid]);
  __syncthreads();
  float mx = -1e30f;
  for (int kk = 0; kk < 8; ++kk) {
    int key = tid + 256 * kk; const uint4* kr = (const uint4*)(Km + (bh * SEQ + key) * 192);
    float s = 0.f;
    for (int c = 0; c < 24; ++c) { uint4 w = kr[c]; const float* q = qs + c * 8;
      s += q[0] * __uint_as_float(w.x << 16) + q[1] * __uint_as_float(w.x & 0xffff0000u) + q[2] * __uint_as_float(w.y << 16) + q[3] * __uint_as_float(w.y & 0xffff0000u)
         + q[4] * __uint_as_float(w.z << 16) + q[5] * __uint_as_float(w.z & 0xffff0000u) + q[6] * __uint_as_float(w.w << 16) + q[7] * __uint_as_float(w.w & 0xffff0000u); }
    s *= 0.07216878364870322f; sc[key] = s; mx = fmaxf(mx, s);
  }
  mx = block_max256(mx, red);
  float sum = 0.f;
  for (int kk = 0; kk < 8; ++kk) { int key = tid + 256 * kk; float p = expf(sc[key] - mx); sc[key] = p; sum += p; }
  sum = block_sum256(sum, red);
  __syncthreads();
  if (tid < 128) { float o = 0.f; const bf16_t* vp = Vm + bh * SEQ * 128 + tid;
    for (int key = 0; key < SEQ; ++key) o += sc[key] * bf2f(vp[(size_t)key * 128]);
    omla[((size_t)b * SEQ + i) * 512 + h * 128 + tid] = f2bf(o / sum); }
}

__global__ __launch_bounds__(128) void n_gla(const bf16_t* __restrict__ qg, const bf16_t* __restrict__ kg, const bf16_t* __restrict__ vg, const bf16_t* __restrict__ laf, const bf16_t* __restrict__ lab, float* __restrict__ og) {
  __shared__ float qs[64], ks[64], as[64];
  const int bh = blockIdx.x, b = bh >> 2, h = bh & 3, dv = threadIdx.x;
  for (int dir = 0; dir < 2; ++dir) {
    float S[64];
#pragma unroll
    for (int d = 0; d < 64; ++d) S[d] = 0.f;
    const bf16_t* la = dir ? lab : laf;
    for (int s = 0; s < SEQ; ++s) {
      const int t = dir ? (SEQ - 1 - s) : s; const size_t tok = (size_t)b * SEQ + t;
      __syncthreads();
      if (dv < 64) { qs[dv] = bf2f(qg[tok * 256 + h * 64 + dv]); ks[dv] = bf2f(kg[tok * 256 + h * 64 + dv]); as[dv] = expf(bf2f(la[tok * 256 + h * 64 + dv])); }
      __syncthreads();
      const float v = bf2f(vg[tok * 512 + h * 128 + dv]); float o = 0.f;
#pragma unroll
      for (int d = 0; d < 64; ++d) { S[d] = as[d] * S[d] + ks[d] * v; o += qs[d] * S[d]; }
      if (dir == 0) og[tok * 512 + h * 128 + dv] = o; else og[tok * 512 + h * 128 + dv] += o;
    }
  }
}

__global__ __launch_bounds__(256) void n_mix(const bf16_t* __restrict__ omla, const float* __restrict__ og, const bf16_t* __restrict__ rg, const float* __restrict__ g_gla, int b, float* __restrict__ mix) {
  __shared__ float ssum[4];
  const int t = blockIdx.x, tid = threadIdx.x; const size_t tok = (size_t)b * SEQ + t;
  if (tid < 4) ssum[tid] = 0.f;
  __syncthreads();
  float v[2];
#pragma unroll
  for (int i = 0; i < 2; ++i) { int e = tid + 256 * i; v[i] = og[tok * 512 + e]; atomicAdd(&ssum[e >> 7], v[i] * v[i]); mix[(size_t)t * DM + e] = bf2f(omla[tok * 512 + e]); }
  __syncthreads();
#pragma unroll
  for (int i = 0; i < 2; ++i) { int e = tid + 256 * i; float rs = rsqrtf(ssum[e >> 7] * (1.f / 128.f) + EPS);
    mix[(size_t)t * DM + 512 + e] = v[i] * rs * g_gla[e & 127] * silu_f(bf2f(rg[tok * 512 + e])); }
}

__global__ __launch_bounds__(256) void n_post1(const float* __restrict__ x, const float* __restrict__ y, const float* __restrict__ g_post, const float* __restrict__ g_pre2, const float* __restrict__ mod, int b,
                                               float* __restrict__ out, float* __restrict__ h2) {
  __shared__ float red[4];
  const int t = blockIdx.x, tid = threadIdx.x; const size_t tok = (size_t)b * SEQ + t;
  float yv[4], xv[4]; float ss = 0.f;
#pragma unroll
  for (int i = 0; i < 4; ++i) { yv[i] = y[(size_t)t * DM + tid + 256 * i]; ss += yv[i] * yv[i]; }
  ss = block_sum256(ss, red);
  float rs = rsqrtf(ss * (1.f / DM) + EPS); float s2 = 0.f;
#pragma unroll
  for (int i = 0; i < 4; ++i) { int d = tid + 256 * i; xv[i] = x[tok * DM + d] + mod[b * 6144 + 2048 + d] * (yv[i] * rs * g_post[d]); out[tok * DM + d] = xv[i]; s2 += xv[i] * xv[i]; }
  s2 = block_sum256(s2, red);
  float r2 = rsqrtf(s2 * (1.f / DM) + EPS);
#pragma unroll
  for (int i = 0; i < 4; ++i) { int d = tid + 256 * i; h2[(size_t)t * DM + d] = xv[i] * r2 * g_pre2[d] * (1.f + mod[b * 6144 + 4096 + d]) + mod[b * 6144 + 3072 + d]; }
}

DI void wave_argmax(float& v, int& i) {
#pragma unroll
  for (int o = 1; o < 64; o <<= 1) { float ov = __shfl_xor(v, o); int oi = __shfl_xor(i, o); if (ov > v || (ov == v && oi < i)) { v = ov; i = oi; } }
}
__global__ __launch_bounds__(256) void n_peer_select(const float* __restrict__ qry, const float* __restrict__ sk1, const float* __restrict__ sk2, int* __restrict__ eidx, float* __restrict__ gate) {
  __shared__ float v1s[4][16], v2s[4][16]; __shared__ int i1s[4][16], i2s[4][16];
  const int w = threadIdx.x >> 6, lane = threadIdx.x & 63;
  const int pair = blockIdx.x * 4 + w;
  const int t = pair >> 3, h = pair & 7;
  const float* q1 = qry + (size_t)t * 2048 + h * 256; const float* q2 = q1 + 128;
  float s1a = 0.f, s1b = 0.f, s2a = 0.f, s2b = 0.f;
  for (int d = 0; d < 128; ++d) { float a = q1[d], bq = q2[d];
    s1a += a * sk1[lane * 128 + d]; s1b += a * sk1[(lane + 64) * 128 + d]; s2a += bq * sk2[lane * 128 + d]; s2b += bq * sk2[(lane + 64) * 128 + d]; }
  for (int side = 0; side < 2; ++side) {
    float va = side ? s2a : s1a, vb = side ? s2b : s1b; bool ta = false, tb = false;
    for (int k = 0; k < 16; ++k) {
      float bv; int bi;
      if (!ta && (tb || va >= vb)) { bv = va; bi = lane; } else if (!tb) { bv = vb; bi = lane + 64; } else { bv = -3e38f; bi = 1 << 20; }
      wave_argmax(bv, bi);
      if (bi == lane) ta = true; if (bi == lane + 64) tb = true;
      if (lane == 0) { if (side) { v2s[w][k] = bv; i2s[w][k] = bi; } else { v1s[w][k] = bv; i1s[w][k] = bi; } }
    }
  }
  __syncthreads();
  float cv[4]; bool tk[4];
#pragma unroll
  for (int j = 0; j < 4; ++j) { int c = lane + 64 * j; cv[j] = v1s[w][c >> 4] + v2s[w][c & 15]; tk[j] = false; }
  float topv = 0.f; int topc = 0; float mx = 0.f;
  for (int k = 0; k < 16; ++k) {
    float bv = -3e38f; int bi = 1 << 20;
#pragma unroll
    for (int j = 0; j < 4; ++j) { if (!tk[j] && cv[j] > bv) { bv = cv[j]; bi = lane + 64 * j; } }
    wave_argmax(bv, bi);
#pragma unroll
    for (int j = 0; j < 4; ++j) if (bi == lane + 64 * j) tk[j] = true;
    if (k == 0) mx = bv;
    if (lane == k) { topv = bv; topc = bi; }
  }
  float e = (lane < 16) ? expf(topv - mx) : 0.f;
  float sum = wave_sum(e);
  if (lane < 16) { eidx[(size_t)pair * 16 + lane] = i1s[w][topc >> 4] * 128 + i2s[w][topc & 15]; gate[(size_t)pair * 16 + lane] = e / sum; }
}

__global__ __launch_bounds__(256) void n_peer_apply(const float* __restrict__ h2, const int* __restrict__ eidx, const float* __restrict__ gate, const float* __restrict__ eu, const float* __restrict__ ev,
                                                    const float* __restrict__ g_post, const float* __restrict__ mod, int b, float* __restrict__ out) {
  __shared__ float ys[4][1024]; __shared__ float red[4];
  const int t = blockIdx.x, tid = threadIdx.x, w = tid >> 6, lane = tid & 63; const size_t tok = (size_t)b * SEQ + t;
  float4 hx[4];
#pragma unroll
  for (int i = 0; i < 4; ++i) hx[i] = *(const float4*)(h2 + (size_t)t * DM + (lane + 64 * i) * 4);
  float4 acc[4];
#pragma unroll
  for (int i = 0; i < 4; ++i) acc[i] = make_float4(0.f, 0.f, 0.f, 0.f);
  for (int k = w; k < 128; k += 4) {
    const int e = eidx[(size_t)t * 128 + k]; const float gt = gate[(size_t)t * 128 + k];
    const float4* ur = (const float4*)(eu + (size_t)e * DM); const float4* vr = (const float4*)(ev + (size_t)e * DM);
    float d = 0.f;
#pragma unroll
    for (int i = 0; i < 4; ++i) { float4 u = ur[lane + 64 * i]; d += u.x * hx[i].x + u.y * hx[i].y + u.z * hx[i].z + u.w * hx[i].w; }
    d = wave_sum(d);
    const float wgt = gt * gelu_erf(d);
#pragma unroll
    for (int i = 0; i < 4; ++i) { float4 v = vr[lane + 64 * i]; acc[i].x += wgt * v.x; acc[i].y += wgt * v.y; acc[i].z += wgt * v.z; acc[i].w += wgt * v.w; }
  }
#pragma unroll
  for (int i = 0; i < 4; ++i) *(float4*)(&ys[w][(lane + 64 * i) * 4]) = acc[i];
  __syncthreads();
  float yv[4]; float ss = 0.f;
#pragma unroll
  for (int i = 0; i < 4; ++i) { int d = tid + 256 * i; yv[i] = ys[0][d] + ys[1][d] + ys[2][d] + ys[3][d]; ss += yv[i] * yv[i]; }
  ss = block_sum256(ss, red);
  const float rs = rsqrtf(ss * (1.f / DM) + EPS);
#pragma unroll
  for (int i = 0; i < 4; ++i) { int d = tid + 256 * i; out[tok * DM + d] = out[tok * DM + d] + mod[b * 6144 + 5120 + d] * (yv[i] * rs * g_post[d]); }
}

typedef short bf16x8 __attribute__((ext_vector_type(8)));
typedef float f32x16 __attribute__((ext_vector_type(16)));
#define MFMA32(a, b, c) __builtin_amdgcn_mfma_f32_32x32x16_bf16((a), (b), (c), 0, 0, 0)

constexpr int NTHR = 512;
constexpr size_t MiB = 1024 * 1024;
constexpr size_t WS_MOD   = 0;
constexpr size_t WS_WTIN  = 256 * 1024;
constexpr size_t WS_WTQUP = WS_WTIN + (size_t)2304 * 1024 * 2;
constexpr size_t WS_WTKVUP = WS_WTQUP + (size_t)768 * 384 * 2;
constexpr size_t WS_WTOUT = WS_WTKVUP + (size_t)1024 * 256 * 2;
constexpr size_t WS_WTPQ  = WS_WTOUT + (size_t)1024 * 1024 * 2;
constexpr size_t WS_KD    = WS_WTPQ + (size_t)2048 * 1024 * 2;
constexpr size_t WS_DEC   = WS_KD + (size_t)256 * 256 * 2;
constexpr size_t WS_ESC   = WS_DEC + (size_t)2048 * 64 * 4;
constexpr size_t WS_R0END = WS_ESC + (size_t)2 * 16384 * 4;
static_assert(WS_R0END <= 13 * MiB, "R0");
constexpr size_t WS_BAR  = 13 * MiB - 65536;
static_assert(WS_R0END + 131072 <= WS_BAR, "R0 room");
constexpr size_t WS_QM   = 13 * MiB;
constexpr size_t WS_KM   = WS_QM + 24 * MiB;
constexpr size_t WS_VM   = WS_KM + 24 * MiB;
constexpr size_t WS_P1S  = WS_VM + 16 * MiB;
constexpr size_t WS_RG   = WS_P1S + 32 * MiB;
constexpr size_t WS_OINTRA = WS_RG + 16 * MiB;
constexpr size_t WS_QDEC = WS_OINTRA + 16 * MiB;
constexpr size_t WS_SPT  = WS_QDEC + 16 * MiB;
constexpr size_t WS_EU   = WS_SPT + 32 * MiB;
constexpr size_t WS_EV   = WS_EU + 16 * MiB;
constexpr size_t WS_WTPQP = WS_EV + 16 * MiB;
constexpr size_t WS_WTOUTP = WS_WTPQP + 4 * MiB;
constexpr size_t WS_WTINP = WS_WTOUTP + 2 * MiB;
constexpr size_t WS_PROJC = WS_WTINP + 4608 * 1024;
constexpr size_t WS_END  = WS_PROJC + 8 * MiB;
static_assert(WS_P1S == WS_QM + 64 * MiB, "P3 QRY scratch aliases QM..VM");
constexpr size_t OUT_HS  = 0;
constexpr size_t OUT_CQ  = 32 * MiB;
constexpr size_t OUT_GR  = 52 * MiB;

struct KP { const float* in[25]; float* out; unsigned char* ws; int ph_lo, ph_hi; };

constexpr int G_STG = 40960;
constexpr int LDS_WT = 3 * G_STG;
constexpr int LDS_TAB = LDS_WT + 18432;
constexpr int LDS_XB = 157696;
constexpr int LDS_TOTAL = 157696 + 16;

typedef float f32x2_t __attribute__((ext_vector_type(2)));
typedef __bf16 bf16x2_t __attribute__((ext_vector_type(2)));
DI unsigned pack2(float lo, float hi) { const f32x2_t v = {lo, hi}; return __builtin_bit_cast(unsigned, __builtin_convertvector(v, bf16x2_t)); }
DI int crow(int reg, int hh) { return (reg & 3) + 8 * (reg >> 2) + 4 * hh; }

#define GLDS16(gp, lp) __builtin_amdgcn_global_load_lds((const unsigned*)(gp), (__attribute__((address_space(3))) unsigned*)(lp), 16, 0, 0)
template <int NST, class Epi>
DI void block_gemm(char* lds, const bf16_t* A, int lda, const bf16_t* Bt, int nchunks, int K, Epi&& epi) {
  const int tid = threadIdx.x, lane = tid & 63, w = __builtin_amdgcn_readfirstlane(tid >> 6), r = lane & 31, hh = lane >> 5;
  const int nk = K >> 6, T = nchunks * nk;
  constexpr int D = NST - 1;
  if (w >= 4) {
    const int j = w - 4, rin = lane >> 3, sw = ((lane & 7) ^ rin) * 8;
    const bf16_t* Ap = A + (size_t)(16 * j + rin) * lda + sw;
    const bf16_t* Bp = Bt + (size_t)(64 * j + rin) * 64 + sw;
    auto dma = [&](int g) {
      const int ch = g / nk, t = g - ch * nk; char* st = lds + (g % NST) * G_STG;
      const bf16_t* a0 = Ap + t * 64; char* la = st + (2 * j) * 1024;
      GLDS16(a0, la); GLDS16(a0 + (size_t)8 * lda, la + 1024);
      const bf16_t* b0 = Bp + (size_t)g * 16384; char* lb = st + 8192 + (8 * j) * 1024;
#pragma unroll
      for (int i = 0; i < 8; ++i) GLDS16(b0 + i * 512, lb + i * 1024);
    };
#pragma unroll
    for (int g = 0; g < D; ++g) if (g < T) dma(g);
    if (D >= 2 && T >= 2) asm volatile("s_waitcnt vmcnt(10)" ::: "memory"); else asm volatile("s_waitcnt vmcnt(0)" ::: "memory");
    __builtin_amdgcn_s_barrier();
#pragma unroll 1
    for (int g = 0; g < T; ++g) {
      if (g + D < T) { dma(g + D); if (D >= 2) asm volatile("s_waitcnt vmcnt(10)" ::: "memory"); else asm volatile("s_waitcnt vmcnt(0)" ::: "memory"); }
      else asm volatile("s_waitcnt vmcnt(0)" ::: "memory");
      __builtin_amdgcn_s_barrier();
    }
  } else {
    const int x = r & 7;
    const int o0 = ((0 + hh) ^ x) * 16, o1 = ((2 + hh) ^ x) * 16, o2 = ((4 + hh) ^ x) * 16, o3 = ((6 + hh) ^ x) * 16;
    const int a_rd = r * 128, b_rd = 8192 + (w * 64 + r) * 128;
    __builtin_amdgcn_s_barrier();
    int g = 0;
#pragma unroll 1
    for (int ch = 0; ch < nchunks; ++ch) {
      f32x16 c00, c01, c10, c11;
#pragma unroll
      for (int i = 0; i < 16; ++i) { c00[i] = 0.f; c01[i] = 0.f; c10[i] = 0.f; c11[i] = 0.f; }
#pragma unroll 1
      for (int t = 0; t < nk; ++t, ++g) {
        const char* cur = lds + (g % NST) * G_STG;
        bf16x8 fa0[4], fa1[4], fb0[4], fb1[4];
#define FRD(s_, o_) do { fa0[s_] = *(const bf16x8*)(cur + a_rd + o_); fb0[s_] = *(const bf16x8*)(cur + b_rd + o_); fb1[s_] = *(const bf16x8*)(cur + b_rd + 4096 + o_); fa1[s_] = *(const bf16x8*)(cur + a_rd + 4096 + o_); } while (0)
        FRD(0, o0); FRD(1, o1); FRD(2, o2); FRD(3, o3);
#undef FRD
        asm volatile("s_waitcnt lgkmcnt(0)" ::: "memory");
        __builtin_amdgcn_s_barrier();
        __builtin_amdgcn_sched_barrier(0);
#pragma unroll
        for (int s = 0; s < 4; ++s) {
          c00 = MFMA32(fa0[s], fb0[s], c00); c01 = MFMA32(fa0[s], fb1[s], c01); c10 = MFMA32(fa1[s], fb0[s], c10); c11 = MFMA32(fa1[s], fb1[s], c11); }
      }
      epi(0, ch * 256 + w * 64, c00, c01);
      epi(32, ch * 256 + w * 64, c10, c11);
    }
  }
}

DI void p0_transpose(char* lds, const float* __restrict__ W, int K, int N, bf16_t* __restrict__ Wt, int item, bf16_t* __restrict__ Wplain = nullptr) {
  float* s = (float*)lds;
  const int tid = threadIdx.x;
  const int ntn = (N + 63) >> 6, kt = item / ntn, nt = item % ntn, k0 = kt * 64, n0 = nt * 64;
  __syncthreads();
#pragma unroll
  for (int i = 0; i < 8; ++i) { int e = tid + 512 * i; int kk = e >> 6, nn = e & 63; s[kk * 65 + nn] = (n0 + nn < N) ? W[(size_t)(k0 + kk) * N + n0 + nn] : 0.f; }
  __syncthreads();
  const int nn = tid >> 3, part = tid & 7;
  const float* sp = s + (part * 8) * 65 + nn;
  uint4 o; o.x = pack2(sp[0], sp[65]); o.y = pack2(sp[2 * 65], sp[3 * 65]); o.z = pack2(sp[4 * 65], sp[5 * 65]); o.w = pack2(sp[6 * 65], sp[7 * 65]);
  { const int n = n0 + nn; *(uint4*)(Wt + ((size_t)((n >> 8) * (K >> 6) + kt)) * 16384 + (n & 255) * 64 + part * 8) = o; }
  if (Wplain) *(uint4*)(Wplain + (size_t)(n0 + nn) * K + k0 + part * 8) = o;
}

DI void phase0(const KP& p, char* lds) {
  const int tid = threadIdx.x, bid = blockIdx.x, nb = gridDim.x;
  unsigned char* ws = p.ws;
  constexpr int I_IN = 16 * 36, I_QUP = 6 * 12, I_KVUP = 4 * 16, I_OUT = 16 * 16, I_PQ = 16 * 32;
  constexpr int I_ALL = I_IN + I_QUP + I_KVUP + I_OUT + I_PQ;
  for (int it = bid; it < I_ALL; it += nb) {
    int q = it;
    if (q < I_IN) { p0_transpose(lds, p.in[7], 1024, 2272, (bf16_t*)(ws + WS_WTIN), q, (bf16_t*)(ws + WS_WTINP)); continue; } q -= I_IN;
    if (q < I_QUP) { p0_transpose(lds, p.in[9], 384, 768, (bf16_t*)(ws + WS_WTQUP), q); continue; } q -= I_QUP;
    if (q < I_KVUP) { p0_transpose(lds, p.in[11], 256, 1024, (bf16_t*)(ws + WS_WTKVUP), q); continue; } q -= I_KVUP;
    if (q < I_OUT) { p0_transpose(lds, p.in[17], 1024, 1024, (bf16_t*)(ws + WS_WTOUT), q, (bf16_t*)(ws + WS_WTOUTP)); continue; } q -= I_OUT;
    p0_transpose(lds, p.in[20], 1024, 2048, (bf16_t*)(ws + WS_WTPQ), q, (bf16_t*)(ws + WS_WTPQP));
  }
  { bf16_t* kd = (bf16_t*)(ws + WS_KD);
    for (int e = bid * NTHR + tid; e < 65536; e += nb * NTHR) { int n = e >> 8, k = e & 255; float v = 0.f;
      if (n < 128 && k < 128) v = p.in[21][n * 128 + k]; else if (n >= 128 && k >= 128) v = p.in[22][(n - 128) * 128 + (k - 128)];
      kd[(size_t)(k >> 6) * 16384 + n * 64 + (k & 63)] = f2bf(v); } }
  { const int lane = tid & 63; float* scl = (float*)(ws + WS_ESC);
    for (int row = bid * 8 + (tid >> 6); row < 32768; row += nb * 8) { const int t = row >> 14, e = row & 16383;
      const float* src = p.in[23 + t] + (size_t)e * 1024 + lane * 16;
      float4 x[4]; float am = 0.f;
#pragma unroll
      for (int i = 0; i < 4; ++i) { x[i] = *(const float4*)(src + 4 * i); am = fmaxf(am, fmaxf(fmaxf(fabsf(x[i].x), fabsf(x[i].y)), fmaxf(fabsf(x[i].z), fabsf(x[i].w)))); }
      am = wave_max(am);
      float sc = 1.f, isc = 1.f;
      if (am > 0.f) { int ex; (void)frexpf(448.f / am, &ex); sc = ldexpf(1.f, ex - 1); isc = ldexpf(1.f, 1 - ex); }
      unsigned wv[4];
#pragma unroll
      for (int i = 0; i < 4; ++i) { int q = __builtin_amdgcn_cvt_pk_fp8_f32(x[i].x * sc, x[i].y * sc, 0, false); q = __builtin_amdgcn_cvt_pk_fp8_f32(x[i].z * sc, x[i].w * sc, q, true); wv[i] = (unsigned)q; }
      *(uint4*)(ws + (t ? WS_EV : WS_EU) + (size_t)e * 1024 + lane * 16) = make_uint4(wv[0], wv[1], wv[2], wv[3]);
      if (lane == 0) scl[t * 16384 + e] = isc; } }
  for (int jb = bid; jb < 96; jb += nb) {
    __syncthreads();
    float* cact = (float*)lds;
    float* red = (float*)(lds + 32768);
    for (int e = tid; e < 8192; e += NTHR) cact[e] = silu_f(p.in[1][e]);
    __syncthreads();
    const int jj = tid & 63, ks = tid >> 6, j0 = jb * 64;
    float acc[8];
#pragma unroll
    for (int b = 0; b < 8; ++b) acc[b] = 0.f;
    const float* wp = p.in[3] + (size_t)(ks * 128) * 6144 + j0 + jj;
    for (int k = 0; k < 128; ++k) { const float wv = wp[(size_t)k * 6144];
#pragma unroll
      for (int b = 0; b < 8; ++b) acc[b] += cact[b * 1024 + ks * 128 + k] * wv; }
#pragma unroll
    for (int b = 0; b < 8; ++b) red[(ks * 64 + jj) * 8 + b] = acc[b];
    __syncthreads();
    { const int b = tid >> 6; float sacc = p.in[4][j0 + jj];
#pragma unroll
      for (int k2 = 0; k2 < 8; ++k2) sacc += red[(k2 * 64 + jj) * 8 + b];
      ((float*)(ws + WS_MOD))[b * 6144 + j0 + jj] = sacc; }
  }
}

constexpr int WT_STRIDE = 144, WT_BYTES = 32 * WT_STRIDE;
DI void wt_write(char* wl, const f32x16& a0, const f32x16& a1, int r, int hh, float scale) {
  char* bp = wl + (4 * hh) * WT_STRIDE + r * 2;
#pragma unroll
  for (int reg = 0; reg < 16; ++reg) { const int ro = ((reg & 3) + 8 * (reg >> 2)) * WT_STRIDE;
    *(bf16_t*)(bp + ro) = f2bf(a0[reg] * scale); *(bf16_t*)(bp + ro + 64) = f2bf(a1[reg] * scale); }
}
DI void wt_write_rope(char* wl, const f32x16& a0, const f32x16& a1, int r, int hh, const float* cs, const float* sn, int m0) {
  char* bp = wl + (4 * hh) * WT_STRIDE + r * 2;
#pragma unroll
  for (int reg = 0; reg < 16; ++reg) { const int rw = (reg & 3) + 8 * (reg >> 2); const int row = m0 + rw + 4 * hh;
    const float c = cs[row * 32 + r], s = sn[row * 32 + r];
    *(bf16_t*)(bp + rw * WT_STRIDE) = f2bf(a0[reg] * c - a1[reg] * s); *(bf16_t*)(bp + rw * WT_STRIDE + 64) = f2bf(a1[reg] * c + a0[reg] * s); }
}
DI void wt_store(const char* wl, int lane, bf16_t* dA, int sA, bf16_t* dB, int sB) {
  const int piece = lane & 7, rsub = lane >> 3;
  bf16_t* d = (piece < 4) ? dA : dB; const int st = (piece < 4) ? sA : sB;
  if (d) {
#pragma unroll
    for (int i = 0; i < 4; ++i) { const int row = i * 8 + rsub; const uint4 v = *(const uint4*)(wl + row * WT_STRIDE + piece * 16);
      *(uint4*)(d + (size_t)row * st + (piece & 3) * 8) = v; }
  }
}
#define LDS_FENCE() asm volatile("s_waitcnt lgkmcnt(0)" ::: "memory")
DI int lv(int x) { asm volatile("" : "+v"(x)); return x; }
template <class T> DI T* launder(T* q) { size_t z = 0; asm volatile("" : "+s"(z)); return (T*)((char*)q + z); }

constexpr int GL_GR = 0, GL_VT = 8192, GL_QD = 26624, GL_KI = 45056, GL_KIT = 63488, GL_ATT = 81920, GL_TOT = 91136, GL_DEC = 93184, GL_LA = 93696  , GL_QS = 126464  , GL_KS = 134656;
DI void gla_chunk_local(const KP& p, char* lds, unsigned char* ws, int tile, const bf16_t* PA, const bf16_t* PB) {
  const int tid = lv(threadIdx.x), lane = tid & 63, w = tid >> 6, r = lane & 31, hh = lane >> 5;
  const int b = tile >> 5, n = tile & 31, tok0 = tile * 64;
  float* GRL = (float*)(lds + GL_GR); float* TOT = (float*)(lds + GL_TOT); float* DECL = (float*)(lds + GL_DEC);
  __syncthreads();
#pragma unroll
  for (int i = 0; i < 4; ++i) { const int e = tid + 512 * i; GRL[e] = bf2f(PB[(size_t)(e >> 5) * 1024 + (O_GF - 1024) + (e & 31)]); }
#pragma unroll 1
  for (int h = 0; h < 4; ++h) {
    __syncthreads();
    { const int t = tid >> 3, c8 = (tid & 7) * 8;
      *(uint4*)(lds + GL_QS + (t * 64 + c8) * 2) = *(const uint4*)(PA + (size_t)t * 1024 + O_QG + h * 64 + c8);
      *(uint4*)(lds + GL_KS + (t * 64 + c8) * 2) = (h == 0) ? *(const uint4*)(PA + (size_t)t * 1024 + O_KG + c8) : *(const uint4*)(PB + (size_t)t * 1024 + (O_KG - 1024) + h * 64 + c8); }
#pragma unroll
    for (int i = 0; i < 2; ++i) { const int c = tid + 512 * i, t = c >> 4, d8 = (c & 15) * 8;
      const uint4 v = *(const uint4*)(PB + (size_t)t * 1024 + (O_VG - 1024) + h * 128 + d8);
      bf16_t* vt = (bf16_t*)(lds + GL_VT) + d8 * 72 + t;
      vt[0] = (bf16_t)(v.x & 0xffffu); vt[72] = (bf16_t)(v.x >> 16); vt[144] = (bf16_t)(v.y & 0xffffu); vt[216] = (bf16_t)(v.y >> 16);
      vt[288] = (bf16_t)(v.z & 0xffffu); vt[360] = (bf16_t)(v.z >> 16); vt[432] = (bf16_t)(v.w & 0xffffu); vt[504] = (bf16_t)(v.w >> 16); }
    const int dir = tid >> 8, qt = (tid >> 6) & 3, dk = tid & 63, col = h * 64 + dk;
    float* LAL = (float*)(lds + GL_LA) + tid;
    {
      const float* wg = launder(dir ? p.in[14] : p.in[12]); const float* bg = launder(dir ? p.in[15] : p.in[13]);
      float wr[16];
#pragma unroll
      for (int q = 0; q < 16; ++q) wr[q] = wg[q * 256 + col];
      const float bias = bg[col];
      float run = 0.f;
#pragma unroll 2
      for (int ii = 0; ii < 16; ++ii) { const int i = dir ? 15 - ii : ii;
        const float* gp = GRL + (qt * 16 + i) * 32 + dir * 16; float x = bias;
#pragma unroll
        for (int q = 0; q < 16; ++q) x += gp[q] * wr[q];
        run += logsigmoid_fast(x) * (1.f / 16.f); LAL[i * 512] = run; }
      TOT[(dir * 64 + dk) * 4 + qt] = run;
    }
    __syncthreads();
    {
      const float4 tq = *(const float4*)(TOT + (dir * 64 + dk) * 4);
      const float total = (tq.x + tq.y) + (tq.z + tq.w);
      float off;
      if (dir == 0) off = (qt > 0 ? tq.x : 0.f) + (qt > 1 ? tq.y : 0.f) + (qt > 2 ? tq.z : 0.f);
      else          off = (qt < 1 ? tq.y : 0.f) + (qt < 2 ? tq.z : 0.f) + (qt < 3 ? tq.w : 0.f);
      if (qt == 0) { const float dc = fexp(total); DECL[dir * 64 + dk] = dc; ((float*)(ws + WS_DEC))[((size_t)((b * 4 + h) * 2 + dir) * 32 + n) * 64 + dk] = dc; }
      bf16_t* QD = (bf16_t*)(lds + GL_QD + dir * 9216) + (qt * 16) * 72 + dk; bf16_t* KI = (bf16_t*)(lds + GL_KI + dir * 9216) + (qt * 16) * 72 + dk;
      bf16_t* KIT = (bf16_t*)(lds + GL_KIT + dir * 9216) + dk * 72 + qt * 16;
      bf16_t* qdg = (bf16_t*)(ws + WS_QDEC) + (size_t)((tile * 4 + h) * 2 + dir) * 4096 + (qt * 16) * 64 + dk;
      const bf16_t* qgp = (const bf16_t*)(lds + GL_QS) + (qt * 16) * 64 + dk; const bf16_t* kgp = (const bf16_t*)(lds + GL_KS) + (qt * 16) * 64 + dk;
#pragma unroll 2
      for (int i = 0; i < 16; ++i) { const float bb = off + LAL[i * 512];
        const float qv = bf2f(qgp[i * 64]) * 0.125f, kv = bf2f(kgp[i * 64]);
        const float eb = fexp(bb); const bf16_t qd = f2bf(qv * eb), ki = f2bf(kv * __builtin_amdgcn_rcpf(eb));
        QD[i * 72] = qd; KI[i * 72] = ki; qdg[i * 64] = qd; KIT[i] = ki; }
    }
    __syncthreads();
    if (w < 4) { const int mi = w >> 1, ni = w & 1;
      f32x16 asum;
#pragma unroll
      for (int i = 0; i < 16; ++i) asum[i] = 0.f;
#pragma unroll
      for (int d = 0; d < 2; ++d) { f32x16 acc;
#pragma unroll
        for (int i = 0; i < 16; ++i) acc[i] = 0.f;
#pragma unroll
        for (int s = 0; s < 4; ++s) { const bf16x8 a = *(const bf16x8*)(lds + GL_QD + d * 9216 + (mi * 32 + r) * 144 + s * 32 + hh * 16);
          const bf16x8 bb = *(const bf16x8*)(lds + GL_KI + d * 9216 + (ni * 32 + r) * 144 + s * 32 + hh * 16); acc = MFMA32(a, bb, acc); }
#pragma unroll
        for (int reg = 0; reg < 16; ++reg) { const int ti = mi * 32 + crow(reg, hh), tj = ni * 32 + r; const bool keep = d ? (tj >= ti) : (tj <= ti); asum[reg] += keep ? acc[reg] : 0.f; } }
      bf16_t* at = (bf16_t*)(lds + GL_ATT) + (mi * 32 + 4 * hh) * 72 + ni * 32 + r;
#pragma unroll
      for (int reg = 0; reg < 16; ++reg) at[((reg & 3) + 8 * (reg >> 2)) * 72] = f2bf(asum[reg]);
    }
    __syncthreads();
    { const int mi = w >> 2, ni = w & 3; f32x16 acc;
#pragma unroll
      for (int i = 0; i < 16; ++i) acc[i] = 0.f;
#pragma unroll
      for (int s = 0; s < 4; ++s) { const bf16x8 a = *(const bf16x8*)(lds + GL_ATT + (mi * 32 + r) * 144 + s * 32 + hh * 16);
        const bf16x8 bb = *(const bf16x8*)(lds + GL_VT + (ni * 32 + r) * 144 + s * 32 + hh * 16); acc = MFMA32(a, bb, acc); }
      bf16_t* oi = (bf16_t*)(ws + WS_OINTRA) + (size_t)(tok0 + mi * 32 + 4 * hh) * 512 + h * 128 + ni * 32 + r;
#pragma unroll
      for (int reg = 0; reg < 16; ++reg) oi[(size_t)((reg & 3) + 8 * (reg >> 2)) * 512] = f2bf(acc[reg]); }
    { const int dvb = w >> 1, dkb = w & 1;
#pragma unroll
      for (int d = 0; d < 2; ++d) { f32x16 acc;
#pragma unroll
        for (int i = 0; i < 16; ++i) acc[i] = 0.f;
#pragma unroll
        for (int s = 0; s < 4; ++s) { const bf16x8 a = *(const bf16x8*)(lds + GL_VT + (dvb * 32 + r) * 144 + s * 32 + hh * 16);
          const bf16x8 bb = *(const bf16x8*)(lds + GL_KIT + d * 9216 + (dkb * 32 + r) * 144 + s * 32 + hh * 16); acc = MFMA32(a, bb, acc); }
        const float sc = DECL[d * 64 + dkb * 32 + r];
        bf16_t* ds = (bf16_t*)(ws + WS_SPT) + ((size_t)((b * 4 + h) * 2 + d) * 32 + n) * 8192 + (size_t)(dvb * 32 + 4 * hh) * 64 + dkb * 32 + r;
#pragma unroll
        for (int reg = 0; reg < 16; ++reg) ds[((reg & 3) + 8 * (reg >> 2)) * 64] = f2bf(acc[reg] * sc); } }
  }
}

DI void phase1a(const KP& p, char* lds) {
  const int tid = threadIdx.x, lane = tid & 63, w = tid >> 6;
  for (int tile = blockIdx.x; tile < 256; tile += gridDim.x) {
    unsigned char* ws = launder(p.ws); unsigned char* ob = (unsigned char*)launder(p.out); const float* xin = launder(p.in[0]);
    const float* mod = (const float*)(ws + WS_MOD);
    const int tok0 = tile * 64, b = tile >> 5;
    bf16_t* Hs = (bf16_t*)(ob + OUT_HS) + (size_t)tok0 * 1024;
    float4 ge[4], sh[4];
    const float* gpre = launder(p.in[5]); const float* modb = launder(mod) + b * 6144;
#pragma unroll
    for (int i = 0; i < 4; ++i) { const int d = (lane + 64 * i) * 4;
      const float4 g = *(const float4*)(gpre + d); const float4 sc = *(const float4*)(modb + 1024 + d); sh[i] = *(const float4*)(modb + d);
      ge[i] = make_float4(g.x * (1.f + sc.x), g.y * (1.f + sc.y), g.z * (1.f + sc.z), g.w * (1.f + sc.w)); }
#pragma unroll 2
    for (int rr = 0; rr < 8; ++rr) { const int row = w * 8 + rr;
      const float* xr = xin + (size_t)(tok0 + row) * 1024;
      float4 v[4]; float ss = 0.f;
#pragma unroll
      for (int i = 0; i < 4; ++i) { v[i] = *(const float4*)(xr + (lane + 64 * i) * 4); ss += v[i].x * v[i].x + v[i].y * v[i].y + v[i].z * v[i].z + v[i].w * v[i].w; }
      ss = wave_sum(ss); const float rs = rsqrtf(ss * (1.f / 1024.f) + EPS);
#pragma unroll
      for (int i = 0; i < 4; ++i) { uint2 o; o.x = pack2(v[i].x * rs * ge[i].x + sh[i].x, v[i].y * rs * ge[i].y + sh[i].y); o.y = pack2(v[i].z * rs * ge[i].z + sh[i].z, v[i].w * rs * ge[i].w + sh[i].w);
        *(uint2*)(Hs + (size_t)row * 1024 + (lane + 64 * i) * 4) = o; }
    }
  }
}

DI void phase1c(const KP& p, char* lds) {
  const int tid = threadIdx.x, lane = tid & 63, w = tid >> 6, r = lane & 31, hh = lane >> 5;
  float* cs = (float*)(lds + LDS_TAB); float* sn = cs + 2048;
  char* wl = lds + LDS_WT + (w & 3) * WT_BYTES;
  for (int tile = blockIdx.x; tile < 256; tile += gridDim.x) {
    unsigned char* ws = launder(p.ws); unsigned char* ob = (unsigned char*)launder(p.out);
    const int tok0 = tile * 64, b = tile >> 5, t0 = (tile & 31) * 64;
    const bf16_t* PA = (const bf16_t*)(ws + WS_P1S) + (size_t)tok0 * 1024;
    const bf16_t* PB = (const bf16_t*)(ob + 32 * MiB) + (size_t)tok0 * 1024;
    const bf16_t* PC = (const bf16_t*)(ws + WS_PROJC) + (size_t)tok0 * 256;
    bf16_t* Hs = (bf16_t*)(ob + OUT_HS) + (size_t)tok0 * 1024;
    bf16_t* CQN = Hs; bf16_t* CKVN = Hs + 64 * 384;
    bf16_t* Qm = (bf16_t*)(ws + WS_QM); bf16_t* Km = (bf16_t*)(ws + WS_KM); bf16_t* Vm = (bf16_t*)(ws + WS_VM);
    bf16_t* rg = (bf16_t*)(ws + WS_RG) + (size_t)tok0 * 512;
    __syncthreads();
#pragma unroll
    for (int i = 0; i < 4; ++i) { const int e = tid + 512 * i, tt = e >> 5, j = e & 31;
      const float inv = __builtin_amdgcn_exp2f(-(float)j * (13.287712379549449f / 32.f)); const float ang = (float)((const int*)p.in[2])[tok0 + tt] * inv;
      float rev = ang * 0.15915494309189535f; rev -= floorf(rev);
      cs[e] = __builtin_amdgcn_cosf(rev); sn[e] = __builtin_amdgcn_sinf(rev); }
#pragma unroll
    for (int i = 0; i < 8; ++i) { const int c = tid + 512 * i, row = c >> 6, cc = c & 63;
      const uint4 v = (cc < 36) ? *(const uint4*)(PB + (size_t)row * 1024 + (O_R - 1024) + cc * 8) : *(const uint4*)(PC + (size_t)row * 256 + (cc - 36) * 8);
      *(uint4*)(rg + (size_t)row * 512 + cc * 8) = v; }
    __syncthreads();
    if (tid < 256) { const int row = tid >> 2, pc = tid & 3;
      const uint4 x1 = *(const uint4*)(PA + (size_t)row * 1024 + O_KR + pc * 8), x2 = *(const uint4*)(PA + (size_t)row * 1024 + O_KR + 32 + pc * 8);
      const float4 c0 = *(const float4*)(cs + row * 32 + pc * 8), c1 = *(const float4*)(cs + row * 32 + pc * 8 + 4), s0 = *(const float4*)(sn + row * 32 + pc * 8), s1 = *(const float4*)(sn + row * 32 + pc * 8 + 4);
#define RO1(a_, b_, c_, s_) ((a_) * (c_) - (b_) * (s_))
#define RO2(a_, b_, c_, s_) ((b_) * (c_) + (a_) * (s_))
#define LO(u_) __uint_as_float((u_) << 16)
#define HI(u_) __uint_as_float((u_) & 0xffff0000u)
      uint4 o1, o2;
      o1.x = pack2(RO1(LO(x1.x), LO(x2.x), c0.x, s0.x), RO1(HI(x1.x), HI(x2.x), c0.y, s0.y)); o1.y = pack2(RO1(LO(x1.y), LO(x2.y), c0.z, s0.z), RO1(HI(x1.y), HI(x2.y), c0.w, s0.w));
      o1.z = pack2(RO1(LO(x1.z), LO(x2.z), c1.x, s1.x), RO1(HI(x1.z), HI(x2.z), c1.y, s1.y)); o1.w = pack2(RO1(LO(x1.w), LO(x2.w), c1.z, s1.z), RO1(HI(x1.w), HI(x2.w), c1.w, s1.w));
      o2.x = pack2(RO2(LO(x1.x), LO(x2.x), c0.x, s0.x), RO2(HI(x1.x), HI(x2.x), c0.y, s0.y)); o2.y = pack2(RO2(LO(x1.y), LO(x2.y), c0.z, s0.z), RO2(HI(x1.y), HI(x2.y), c0.w, s0.w));
      o2.z = pack2(RO2(LO(x1.z), LO(x2.z), c1.x, s1.x), RO2(HI(x1.z), HI(x2.z), c1.y, s1.y)); o2.w = pack2(RO2(LO(x1.w), LO(x2.w), c1.z, s1.z), RO2(HI(x1.w), HI(x2.w), c1.w, s1.w));
#undef RO1
#undef RO2
#undef LO
#undef HI
#pragma unroll
      for (int h = 0; h < 4; ++h) { bf16_t* kp = Km + (((size_t)b * 4 + h) * SEQ + t0 + row) * 192 + 128 + pc * 8; *(uint4*)kp = o1; *(uint4*)(kp + 32) = o2; }
    }
    const float* gq = launder(p.in[8]); const float* gkv = launder(p.in[10]);
#pragma unroll 2
    for (int rr = 0; rr < 8; ++rr) { const int row = w * 8 + rr; const unsigned* cr = (const unsigned*)(PA + (size_t)row * 1024);
      float v0[5], v1[5];
#pragma unroll
      for (int i = 0; i < 5; ++i) { const unsigned u = cr[lane + 64 * i]; v0[i] = __uint_as_float(u << 16); v1[i] = __uint_as_float(u & 0xffff0000u); }
      float ss = v0[0] * v0[0] + v1[0] * v1[0] + v0[1] * v0[1] + v1[1] * v1[1] + v0[2] * v0[2] + v1[2] * v1[2];
      float s2 = v0[3] * v0[3] + v1[3] * v1[3] + v0[4] * v0[4] + v1[4] * v1[4];
      ss = wave_sum(ss); s2 = wave_sum(s2);
      const float rq = rsqrtf(ss * (1.f / 384.f) + EPS), rk = rsqrtf(s2 * (1.f / 256.f) + EPS);
#pragma unroll
      for (int i = 0; i < 3; ++i) { const int c = 2 * (lane + 64 * i); *(unsigned*)(CQN + (size_t)row * 384 + c) = pack2(v0[i] * rq * gq[c], v1[i] * rq * gq[c + 1]); }
#pragma unroll
      for (int i = 3; i < 5; ++i) { const int c = 2 * (lane + 64 * (i - 3)); *(unsigned*)(CKVN + (size_t)row * 256 + c) = pack2(v0[i] * rk * gkv[c], v1[i] * rk * gkv[c + 1]); }
    }
    __syncthreads();
    block_gemm<3>(lds, CQN, 384, (const bf16_t*)(ws + WS_WTQUP), 3, 384, [&](int m0, int n0, const f32x16& a0, const f32x16& a1) {
      const int r2 = lv(r), h2 = lv(hh), ln = lv(lane);
      const int h = n0 / 192, d0 = n0 % 192;
      bf16_t* qp = Qm + (((size_t)b * 4 + h) * SEQ + t0 + m0) * 192 + d0;
      if (d0 < 128) wt_write(wl, a0, a1, r2, h2, 1.f); else wt_write_rope(wl, a0, a1, r2, h2, cs, sn, m0);
      LDS_FENCE();
      wt_store(wl, ln, qp, 192, qp + 32, 192);
    });
    block_gemm<3>(lds, CKVN, 256, (const bf16_t*)(ws + WS_WTKVUP), 4, 256, [&](int m0, int n0, const f32x16& a0, const f32x16& a1) {
      const int r2 = lv(r), h2 = lv(hh), ln = lv(lane);
      const int h = n0 >> 8, d0 = n0 & 255;
      wt_write(wl, a0, a1, r2, h2, 1.f); LDS_FENCE();
      if (d0 < 128) { bf16_t* kp = Km + (((size_t)b * 4 + h) * SEQ + t0 + m0) * 192 + d0; wt_store(wl, ln, kp, 192, kp + 32, 192); }
      else { bf16_t* vp = Vm + (((size_t)b * 4 + h) * SEQ + t0 + m0) * 128 + (d0 - 128); wt_store(wl, ln, vp, 128, vp + 32, 128); }
    });
    gla_chunk_local(p, lds, ws, tile, PA, PB);
  }
}

namespace att {
typedef short s16x4 __attribute__((ext_vector_type(4)));
typedef unsigned u32x4 __attribute__((ext_vector_type(4)));
constexpr int DQ = 192, DV = 128, KVBLK = 64;
constexpr float SCALE = 0.07216878364870322f;
constexpr float THR = 8.f;
constexpr int SHM_V = KVBLK * DV * 2, SHM_K = KVBLK * DQ * 2;
constexpr int SHM_QR = 8 * 32 * 176;
constexpr int SHM_ATTN = 2 * SHM_V + 2 * SHM_K + 8 * 64 * 4 + SHM_QR;
#define KSWZ(row, colB) ((row) * 384 + ((colB) ^ (((row) & 7) << 4)))
#define SBAR() __builtin_amdgcn_sched_barrier(0)
DI unsigned cvtpk(float lo, float hi) { unsigned r; asm volatile("v_cvt_pk_bf16_f32 %0, %1, %2" : "=v"(r) : "v"(lo), "v"(hi)); return r; }

DI void partialSM(f32x16& p0, f32x16& p1, float& m_reg, float& mn, float& alpha) {
  constexpr float C = SCALE * 1.4426950408889634f;
  float pmax = p0[0];
#pragma unroll
  for (int r = 1; r < 16; ++r) pmax = fmaxf(pmax, p0[r]);
#pragma unroll
  for (int r = 0; r < 16; ++r) pmax = fmaxf(pmax, p1[r]);
  { auto rr = __builtin_amdgcn_permlane32_swap(__float_as_uint(pmax), __float_as_uint(pmax), false, false);
    pmax = fmaxf(__uint_as_float(rr[0]), __uint_as_float(rr[1])); }
  if (__builtin_expect(__all(pmax - m_reg <= THR / SCALE), 1)) { mn = m_reg; alpha = 1.f; }
  else { mn = fmaxf(m_reg, pmax); alpha = __builtin_amdgcn_exp2f((m_reg - mn) * C); m_reg = mn; }
  const float mnC = -mn * C;
#pragma unroll
  for (int r = 0; r < 16; ++r) p0[r] = fmaf(p0[r], C, mnC);
#pragma unroll
  for (int r = 0; r < 16; ++r) p1[r] = fmaf(p1[r], C, mnC);
#pragma unroll
  for (int r = 0; r < 16; ++r) p0[r] = __builtin_amdgcn_exp2f(p0[r]);
}
DI void finishSM(f32x16& p0, f32x16& p1, float alpha, float& l_reg, bf16x8& pa0, bf16x8& pa1, bf16x8& pa2, bf16x8& pa3) {
#pragma unroll
  for (int r = 0; r < 16; ++r) p1[r] = __builtin_amdgcn_exp2f(p1[r]);
  float ps = 0;
#pragma unroll
  for (int r = 0; r < 16; ++r) ps += p0[r];
#pragma unroll
  for (int r = 0; r < 16; ++r) ps += p1[r];
  { auto rr = __builtin_amdgcn_permlane32_swap(__float_as_uint(ps), __float_as_uint(ps), false, false);
    ps = __uint_as_float(rr[0]) + __uint_as_float(rr[1]); }
  l_reg = l_reg * alpha + ps;
#define PK4(P, BASE, OUT) do { unsigned a0 = cvtpk(P[BASE + 0], P[BASE + 1]), a1 = cvtpk(P[BASE + 2], P[BASE + 3]);   \
    unsigned b0 = cvtpk(P[BASE + 4], P[BASE + 5]), b1 = cvtpk(P[BASE + 6], P[BASE + 7]);                              \
    auto r0 = __builtin_amdgcn_permlane32_swap(a0, b0, false, false); auto r1 = __builtin_amdgcn_permlane32_swap(a1, b1, false, false); \
    u32x4 wv = {r0[0], r1[0], r0[1], r1[1]}; OUT = *reinterpret_cast<bf16x8*>(&wv); } while (0)
  PK4(p0, 0, pa0); PK4(p0, 8, pa1); PK4(p1, 0, pa2); PK4(p1, 8, pa3);
#undef PK4
}
DI void qkt(f32x16& p0, f32x16& p1, const char* Ks, const bf16x8* qr, const char* qrl, int r32, int hi) {
#pragma unroll
  for (int i = 0; i < 16; ++i) { p0[i] = 0.f; p1[i] = 0.f; }
#pragma unroll
  for (int d0 = 0; d0 < 12; ++d0) { const int cb = (d0 * 16 + hi * 8) * 2;
    const bf16x8 b0 = *reinterpret_cast<const bf16x8*>(Ks + KSWZ(r32, cb));
    const bf16x8 b1 = *reinterpret_cast<const bf16x8*>(Ks + KSWZ(32 + r32, cb));
    const bf16x8 q = (d0 < 7) ? qr[d0 < 7 ? d0 : 0] : *reinterpret_cast<const bf16x8*>(qrl + (d0 - 7) * 32);
    p0 = MFMA32(b0, q, p0);
    p1 = MFMA32(b1, q, p1); }
}
DI int v_st(int k, int c) { const int kk = (k & ~0xC) | ((k & 4) << 1) | ((k & 8) >> 1); return ((kk >> 3) * 4 + (c >> 5)) * 512 + ((kk & 7) * 32 + (c & 31)) * 2; }
DI int v_rd_base(int lane) { return ((lane & 3) << 3) | (((lane >> 2) & 3) << 6) | (((lane >> 4) & 1) << 5) | (((lane >> 5) & 1) << 8); }
constexpr int v_rd_off(int d0, int ks, int half) { return d0 * 512 + ks * 4096 + half * 2048; }
template <int OFF> DI s16x4 tr_read(int vb) { s16x4 r; asm volatile("ds_read_b64_tr_b16 %0, %1 offset:%2" : "=&v"(r) : "v"(vb), "i"(OFF) : "memory"); return r; }
template <int D0> DI void pv_one(f32x16& od, int vb, bf16x8 pa0, bf16x8 pa1, bf16x8 pa2, bf16x8 pa3) {
  const s16x4 l0 = tr_read<v_rd_off(D0, 0, 0)>(vb), h0 = tr_read<v_rd_off(D0, 0, 1)>(vb), l1 = tr_read<v_rd_off(D0, 1, 0)>(vb), h1 = tr_read<v_rd_off(D0, 1, 1)>(vb);
  const s16x4 l2 = tr_read<v_rd_off(D0, 2, 0)>(vb), h2 = tr_read<v_rd_off(D0, 2, 1)>(vb), l3 = tr_read<v_rd_off(D0, 3, 0)>(vb), h3 = tr_read<v_rd_off(D0, 3, 1)>(vb);
  asm volatile("s_waitcnt lgkmcnt(0)" ::: "memory"); SBAR();
#define PK(L, H) (bf16x8){L[0], L[1], L[2], L[3], H[0], H[1], H[2], H[3]}
  od = MFMA32(pa0, PK(l0, h0), od);
  od = MFMA32(pa1, PK(l1, h1), od);
  od = MFMA32(pa2, PK(l2, h2), od);
  od = MFMA32(pa3, PK(l3, h3), od);
#undef PK
}
DI void pv_d0(f32x16* o, int vb, bf16x8 pa0, bf16x8 pa1, bf16x8 pa2, bf16x8 pa3) {
  pv_one<0>(o[0], vb, pa0, pa1, pa2, pa3); pv_one<1>(o[1], vb, pa0, pa1, pa2, pa3); pv_one<2>(o[2], vb, pa0, pa1, pa2, pa3); pv_one<3>(o[3], vb, pa0, pa1, pa2, pa3);
}
DI void attn_unit(const bf16_t* Qb, const bf16_t* Kh, const bf16_t* Vh, bf16_t* Ob, int seq, char* lds) {
  const int tid = lv(threadIdx.x), wid = tid >> 6, lane = tid & 63, r32 = lane & 31, hi = lane >> 5;
  char* V_lds = lds; char* K_lds = lds + 2 * SHM_V;
  float* wsf = (float*)(lds + 2 * SHM_V + 2 * SHM_K) + wid * 64; float* li_l = wsf; float* al_l = wsf + 32;
  char* qrl = lds + 2 * SHM_V + 2 * SHM_K + 8 * 64 * 4 + wid * (32 * 176) + r32 * 176 + hi * 16;
  float m_reg = -1e30f, l_reg = 0; f32x16 o[4]; bf16x8 qr[7];
#pragma unroll
  for (int d = 0; d < 4; ++d)
#pragma unroll
    for (int i = 0; i < 16; ++i) o[d][i] = 0.f;
  const bf16_t* Qw = Qb + (size_t)(wid * 32 + r32) * DQ + hi * 8;
#pragma unroll
  for (int d0 = 0; d0 < 7; ++d0) qr[d0] = *reinterpret_cast<const bf16x8*>(Qw + d0 * 16);
#pragma unroll
  for (int d0 = 7; d0 < 12; ++d0) *reinterpret_cast<bf16x8*>(qrl + (d0 - 7) * 32) = *reinterpret_cast<const bf16x8*>(Qw + d0 * 16);
  int kst[3];
#pragma unroll
  for (int i = 0; i < 3; ++i) { const int c = tid + 512 * i; kst[i] = KSWZ(c / 24, (c % 24) * 16); }
  const int vst0 = v_st(tid >> 4, (tid & 15) * 8), vst1 = v_st(32 + (tid >> 4), (tid & 15) * 8);
  const int vb0 = (int)(uintptr_t)V_lds + v_rd_base(lane);
  bf16x8 sk0, sk1, sk2, sv0, sv1;
#define SLOAD(k0) do { const bf16x8* kp = reinterpret_cast<const bf16x8*>(Kh + (size_t)(k0) * DQ) + tid; sk0 = kp[0]; sk1 = kp[512]; sk2 = kp[1024]; \
    const bf16x8* vp = reinterpret_cast<const bf16x8*>(Vh + (size_t)(k0) * DV) + tid; sv0 = vp[0]; sv1 = vp[512]; } while (0)
#define SWRITE(b) do { *(bf16x8*)(V_lds + (b) * SHM_V + vst0) = sv0; *(bf16x8*)(V_lds + (b) * SHM_V + vst1) = sv1; \
    *(bf16x8*)(K_lds + (b) * SHM_K + kst[0]) = sk0; *(bf16x8*)(K_lds + (b) * SHM_K + kst[1]) = sk1; *(bf16x8*)(K_lds + (b) * SHM_K + kst[2]) = sk2; } while (0)
#define RESC(a) do { if (__any((a) < 1.f)) { if (hi == 0) al_l[r32] = (a); asm volatile("s_waitcnt lgkmcnt(0)" ::: "memory"); \
    _Pragma("unroll") for (int d = 0; d < 4; ++d) _Pragma("unroll") for (int r = 0; r < 16; ++r) o[d][r] *= al_l[crow(r, hi)]; } } while (0)
  f32x16 pA0, pA1, pB0, pB1; float mnA, mnB, alA, alB; bf16x8 pa0, pa1, pa2, pa3; const int NT = seq / KVBLK;
  SLOAD(0); SWRITE(0); __syncthreads();
  qkt(pA0, pA1, K_lds, qr, qrl, r32, hi); partialSM(pA0, pA1, m_reg, mnA, alA);
  SLOAD(KVBLK); SWRITE(1); __syncthreads();
  for (int j = 1; j + 1 < NT; j += 2) {
    SBAR(); qkt(pB0, pB1, K_lds + SHM_K, qr, qrl, r32, hi);
    finishSM(pA0, pA1, alA, l_reg, pa0, pa1, pa2, pa3); SBAR();
    SLOAD((j + 1) * KVBLK); SBAR();
    pv_d0(o, vb0, pa0, pa1, pa2, pa3); partialSM(pB0, pB1, m_reg, mnB, alB);
    __syncthreads(); SWRITE(0);
    RESC(alB); __syncthreads();
    SBAR(); qkt(pA0, pA1, K_lds, qr, qrl, r32, hi);
    finishSM(pB0, pB1, alB, l_reg, pa0, pa1, pa2, pa3); SBAR();
    SLOAD((j + 2) * KVBLK); SBAR();
    pv_d0(o, vb0 + SHM_V, pa0, pa1, pa2, pa3); partialSM(pA0, pA1, m_reg, mnA, alA);
    __syncthreads(); SWRITE(1);
    RESC(alA); __syncthreads();
  }
  SBAR(); qkt(pB0, pB1, K_lds + SHM_K, qr, qrl, r32, hi);
  finishSM(pA0, pA1, alA, l_reg, pa0, pa1, pa2, pa3); SBAR();
  pv_d0(o, vb0, pa0, pa1, pa2, pa3); partialSM(pB0, pB1, m_reg, mnB, alB);
  __syncthreads(); RESC(alB);
  finishSM(pB0, pB1, alB, l_reg, pa0, pa1, pa2, pa3); SBAR();
  pv_d0(o, vb0 + SHM_V, pa0, pa1, pa2, pa3);
  if (hi == 0) li_l[r32] = l_reg; asm volatile("s_waitcnt lgkmcnt(0)" ::: "memory");
  float rli[16];
#pragma unroll
  for (int r = 0; r < 16; ++r) rli[r] = __builtin_amdgcn_rcpf(li_l[crow(r, hi)]);
  bf16_t* Ow = Ob + (size_t)(wid * 32) * 1024;
#pragma unroll
  for (int r = 0; r < 16; ++r) { const int orow = crow(r, hi);
#pragma unroll
    for (int d0 = 0; d0 < 4; ++d0) Ow[(size_t)orow * 1024 + d0 * 32 + r32] = f2bf(o[d0][r] * rli[r]); }
  __syncthreads();
#undef SLOAD
#undef SWRITE
#undef RESC
}
}

DI void phase2_attn(const KP& p, char* lds) {
  for (int u = blockIdx.x; u < 256; u += gridDim.x) {
    unsigned char* ws = launder(p.ws);
    const bf16_t* Qm = (const bf16_t*)(ws + WS_QM); const bf16_t* Km = (const bf16_t*)(ws + WS_KM); const bf16_t* Vm = (const bf16_t*)(ws + WS_VM);
    bf16_t* mixa = (bf16_t*)(ws + WS_P1S);
    const int qb = u & 7, bh = u >> 3, b = bh >> 2, h = bh & 3;
    att::attn_unit(Qm + ((size_t)bh * SEQ + qb * 256) * 192, Km + (size_t)bh * SEQ * 192, Vm + (size_t)bh * SEQ * 128,
                   mixa + ((size_t)b * SEQ + qb * 256) * 1024 + h * 128, SEQ, lds);
  }
}

namespace pg8 {
#define PG8_LAS __attribute__((address_space(3)))
typedef unsigned short bf16_t;
typedef short bf16x8 __attribute__((ext_vector_type(8)));
typedef float f32x4 __attribute__((ext_vector_type(4)));
typedef unsigned u32x4 __attribute__((ext_vector_type(4)));
constexpr int BM = 256, BK = 64, HALF = 128, HTB = HALF * BK * 2  , STAGE_BYTES = 8 * HTB, NXCD = 8, WGM = 8;

__host__ __device__ __forceinline__ int lds_byte(int r, int c) { const int st = (r >> 4) * 2 + (c >> 5), rr = r & 15, cc = c & 31, ob = rr * 64 + cc * 2; return st * 1024 + (ob ^ (((ob >> 9) & 1) << 5)); }
__host__ __device__ __forceinline__ void stage_rc(int b, int& R, int& C) { const int st = b / 1024, sb = b % 1024, swz = sb ^ (((sb >> 9) & 1) << 5); R = (st >> 1) * 16 + swz / 64; C = (st & 1) * 32 + (swz % 64) / 2; }
__host__ __device__ __forceinline__ int perm32(int rho) { const int n = rho >> 4, i = rho & 15; return 8 * (i >> 2) + 4 * n + (i & 3); }

struct Unit { int pm, pn; };
struct Gemm { const bf16_t* A; const bf16_t* Bt; int M, N, K; };

struct StaticOrder {
    int nM, nN, nwg, G, c;
    __host__ __device__ void init(int M, int N, int G_, int c_) { nM = M / BM; nN = N / BM; nwg = nM * nN; G = G_; c = c_; }
    __host__ __device__ bool next(int i, Unit& u) const {
        const long L = (long)i * G + c; if (L >= nwg) return false;
        int wgid = (int)L; { const int q = nwg / NXCD, r = nwg % NXCD, xcd = wgid % NXCD, off = wgid / NXCD; wgid = (xcd < r ? xcd * (q + 1) : r * (q + 1) + (xcd - r) * q) + off; }
        const int nig = WGM * nN, gid = wgid / nig, fm = gid * WGM, gsz = (nM - fm) < WGM ? (nM - fm) : WGM;
        u.pm = fm + ((wgid % nig) % gsz); u.pn = (wgid % nig) / gsz; return true;
    }
    __device__ __forceinline__ void a_ready(const Unit&) const {}
    __device__ __forceinline__ void done(const Unit&) const {}
};

__device__ __forceinline__ unsigned cvt_pk_bf16(float lo, float hi) { unsigned r; asm volatile("v_cvt_pk_bf16_f32 %0, %1, %2" : "=v"(r) : "v"(lo), "v"(hi)); return r; }
typedef float f32x2 __attribute__((ext_vector_type(2)));
__device__ __forceinline__ f32x2 gelu_pk(f32x2 v) {
    const f32x2 av = __builtin_elementwise_abs(v), d = av * 0.2316418882f + 1.0f;
    f32x2 t; t.x = __builtin_amdgcn_rcpf(d.x); t.y = __builtin_amdgcn_rcpf(d.y);
    f32x2 q = t * 0.5307027145f + (-0.7265760135f); q = q * t + 0.7107068705f; q = q * t + (-0.142248368f); q = q * t + 0.127414796f; q = q * t;
    const f32x2 s = (v * v) * (-0.72134752044f);
    f32x2 e; e.x = __builtin_amdgcn_exp2f(s.x); e.y = __builtin_amdgcn_exp2f(s.y);
    const f32x2 m = v * (q * e), r = v - m;
    f32x2 o; o.x = v.x < 0.f ? m.x : r.x; o.y = v.y < 0.f ? m.y : r.y; return o;
}

template <int ACT  > struct EpiBf16 {
    static constexpr bool PERM = true, AFTER_DRAIN = false; static_assert(ACT == 0 || ACT == 1, "EpiBf16: ACT is 0 (none) or 1 (gelu_pk)");
    bf16_t* O; int ldc; const float* bias; int split_cols; size_t split_stride; float scale0;
    __device__ __forceinline__ void operator()(const f32x4 (&acc)[2][2][4][2], const Unit& u, int wr, int wc, int fr, int fq) const {
        const int row0 = u.pm * BM + wr * 64 + fr; int colt = u.pn * BM; bf16_t* base = O;
        float sc = 1.f; if (split_cols) { const int t = colt / split_cols; base += (size_t)t * split_stride; colt -= t * split_cols; if (t == 0) sc = scale0; }
        const int col0 = colt + wc * 32 + 8 * fq, bcol0 = u.pn * BM + wc * 32 + 8 * fq;
        f32x4 bv[2][2];
#pragma unroll
        for (int bj = 0; bj < 2; ++bj)
#pragma unroll
            for (int n = 0; n < 2; ++n) bv[bj][n] = bias ? *(const f32x4*)(bias + bcol0 + bj * HALF + 4 * n) : (f32x4){0.f, 0.f, 0.f, 0.f};
#pragma unroll
        for (int ai = 0; ai < 2; ++ai)
#pragma unroll
            for (int m = 0; m < 4; ++m) { bf16_t* rowp = base + (size_t)(row0 + ai * HALF + m * 16) * ldc + col0;
#pragma unroll
                for (int bj = 0; bj < 2; ++bj) { f32x4 v0 = acc[ai][bj][m][0] + bv[bj][0], v1 = acc[ai][bj][m][1] + bv[bj][1];
                    if (ACT == 1) { f32x2 a = gelu_pk((f32x2){v0[0], v0[1]}), b = gelu_pk((f32x2){v0[2], v0[3]}), c = gelu_pk((f32x2){v1[0], v1[1]}), d = gelu_pk((f32x2){v1[2], v1[3]});
                        v0 = (f32x4){a.x, a.y, b.x, b.y}; v1 = (f32x4){c.x, c.y, d.x, d.y}; }
                    v0 = v0 * sc; v1 = v1 * sc; u32x4 w; w.x = cvt_pk_bf16(v0[0], v0[1]); w.y = cvt_pk_bf16(v0[2], v0[3]); w.z = cvt_pk_bf16(v1[0], v1[1]); w.w = cvt_pk_bf16(v1[2], v1[3]);
                    *(u32x4*)(rowp + bj * HALF) = w; } }
    }
};

template <class Epi, class Sched, bool ALIGN_EPI = false, bool SP2 = false>
__device__ __forceinline__ void gemm_phase(PG8_LAS unsigned char* lds, const Gemm g, const Sched& S, const Epi& E) {
    const int tid = threadIdx.x, wid = __builtin_amdgcn_readfirstlane(tid >> 6), lane = tid & 63, wr = wid >> 2, wc = wid & 3, fr = lane & 15, fq = lane >> 4;
    const int K = g.K, nt = K / BK;
    unsigned voffA[2], voffB[2];
#pragma unroll
    for (int i = 0; i < 2; ++i) { int R, C; stage_rc(tid * 16 + i * 8192, R, C); const int Rb = Epi::PERM ? ((R & ~31) + perm32(R & 31)) : R;
        voffA[i] = (unsigned)(R * K + C) * 2u; voffB[i] = (unsigned)(Rb * K + C) * 2u; }
    const size_t kstep = (size_t)(BK * 2);
    const size_t hstep = (size_t)HALF * K * 2;
    const size_t tstep = 2 * hstep;
    const unsigned ldsw = (unsigned)wid * 1024u;
    const int aoff = lds_byte(wr * 64 + fr, fq * 8), boff = lds_byte(wc * 32 + fr, fq * 8);
#define PG8_SA(b, h) (((b) * 2 + (h)) * HTB)
#define PG8_SB(b, h) ((4 + (b) * 2 + (h)) * HTB)
#define PG8_STAGE(bufoff, gbase, voff) do { _Pragma("unroll") for (int _i = 0; _i < 2; ++_i) \
        __builtin_amdgcn_global_load_lds((const unsigned*)((const char*)(gbase) + (voff)[_i]), (PG8_LAS unsigned*)(lds + (bufoff) + ldsw + _i * 8192), 16, 0, 0); } while (0)
#define PG8_LDA(dst, b, h) do { _Pragma("unroll") for (int m = 0; m < 4; ++m) _Pragma("unroll") for (int k = 0; k < 2; ++k) dst[m][k] = *(const PG8_LAS bf16x8*)(lds + PG8_SA(b, h) + aoff + m * 2048 + k * 1024); } while (0)
#define PG8_LDB(dst, b, h) do { _Pragma("unroll") for (int n = 0; n < 2; ++n) _Pragma("unroll") for (int k = 0; k < 2; ++k) dst[n][k] = *(const PG8_LAS bf16x8*)(lds + PG8_SB(b, h) + boff + n * 2048 + k * 1024); } while (0)
#define PG8_MMA(ai, bj, At, Bt) do { __builtin_amdgcn_s_setprio(1); _Pragma("unroll") for (int m = 0; m < 4; ++m) _Pragma("unroll") for (int n = 0; n < 2; ++n) _Pragma("unroll") for (int k = 0; k < 2; ++k) \
        acc[ai][bj][m][n] = __builtin_amdgcn_mfma_f32_16x16x32_bf16(Bt[n][k], At[m][k], acc[ai][bj][m][n], 0, 0, 0); __builtin_amdgcn_s_setprio(0); } while (0)
#define PG8_WAIT_V(n) asm volatile("s_waitcnt vmcnt(" #n ")" ::: "memory")
#define PG8_WAIT_L(n) asm volatile("s_waitcnt lgkmcnt(" #n ")" ::: "memory")
#define PG8_BAR __builtin_amdgcn_s_barrier()
#define PG8_SCHED __builtin_amdgcn_sched_barrier(0)
    Unit cur, nxt; int ui = 0;
    if (!S.next(0, cur)) return;
    f32x4 acc[2][2][4][2];
#pragma unroll
    for (int a = 0; a < 2; ++a)
#pragma unroll
        for (int b = 0; b < 2; ++b)
#pragma unroll
            for (int m = 0; m < 4; ++m)
#pragma unroll
                for (int n = 0; n < 2; ++n) acc[a][b][m][n] = (f32x4){0.f, 0.f, 0.f, 0.f};
    bf16x8 At[4][2], B0[2][2], B1[2][2];
    const char* cA = (const char*)g.A + (size_t)cur.pm * tstep; const char* cB = (const char*)g.Bt + (size_t)cur.pn * tstep;
    S.a_ready(cur);
    if constexpr (SP2) {
        PG8_STAGE(PG8_SB(0, 0), cB, voffB); PG8_STAGE(PG8_SB(0, 1), cB + hstep, voffB); PG8_STAGE(PG8_SA(0, 0), cA, voffA); PG8_STAGE(PG8_SA(0, 1), cA + hstep, voffA);
        if (wr == 1) PG8_BAR;
        PG8_WAIT_V(2); PG8_BAR;
        PG8_STAGE(PG8_SB(1, 0), cB + kstep, voffB); PG8_STAGE(PG8_SA(1, 0), cA + kstep, voffA); PG8_STAGE(PG8_SB(1, 1), cB + hstep + kstep, voffB);
        PG8_WAIT_V(6); PG8_BAR;
    } else {
        PG8_STAGE(PG8_SB(0, 0), cB, voffB); PG8_STAGE(PG8_SA(0, 0), cA, voffA); PG8_STAGE(PG8_SB(0, 1), cB + hstep, voffB); PG8_STAGE(PG8_SA(0, 1), cA + hstep, voffA);
        if (wr == 1) PG8_BAR;
        PG8_WAIT_V(4); PG8_BAR;
        PG8_STAGE(PG8_SB(1, 0), cB + kstep, voffB); PG8_STAGE(PG8_SA(1, 0), cA + kstep, voffA); PG8_STAGE(PG8_SB(1, 1), cB + hstep + kstep, voffB);
        PG8_WAIT_V(6); PG8_BAR;
    }
    for (;;) {
        const bool has_next = S.next(ui + 1, nxt);
        const char* nA = has_next ? (const char*)g.A + (size_t)nxt.pm * tstep : cA; const char* nB = has_next ? (const char*)g.Bt + (size_t)nxt.pn * tstep : cB;
        for (int t = 0; t < nt; t += 2) {
            const bool last = (t == nt - 2);
            const char* a1 = cA + (size_t)(t + 1) * kstep;
            const char* a2 = last ? nA : cA + (size_t)(t + 2) * kstep; const char* b2 = last ? nB : cB + (size_t)(t + 2) * kstep;
            const char* a3 = a2 + kstep; const char* b3 = b2 + kstep;
            if (last && has_next) S.a_ready(nxt);
            if constexpr (SP2) {
            PG8_LDB(B0, 0, 0); PG8_LDB(B1, 0, 1); PG8_SCHED; PG8_LDA(At, 0, 0); PG8_STAGE(PG8_SA(1, 1), a1 + hstep, voffA);
            PG8_WAIT_V(8); PG8_WAIT_L(0); PG8_BAR; PG8_MMA(0, 0, At, B0); PG8_MMA(0, 1, At, B1); PG8_BAR; PG8_SCHED;
            PG8_LDA(At, 0, 1); PG8_STAGE(PG8_SB(0, 0), b2, voffB); PG8_STAGE(PG8_SB(0, 1), b2 + hstep, voffB); PG8_STAGE(PG8_SA(0, 0), a2, voffA);
            PG8_WAIT_V(8); PG8_WAIT_L(0); PG8_BAR; PG8_MMA(1, 0, At, B0); PG8_MMA(1, 1, At, B1); PG8_BAR; PG8_SCHED;
            PG8_LDB(B0, 1, 0); PG8_LDB(B1, 1, 1); PG8_SCHED; PG8_LDA(At, 1, 0); PG8_STAGE(PG8_SA(0, 1), a2 + hstep, voffA);
            PG8_WAIT_V(8); PG8_WAIT_L(0); PG8_BAR; PG8_MMA(0, 0, At, B0); PG8_MMA(0, 1, At, B1); PG8_BAR; PG8_SCHED;
            PG8_LDA(At, 1, 1); PG8_STAGE(PG8_SB(1, 0), b3, voffB); PG8_STAGE(PG8_SB(1, 1), b3 + hstep, voffB); PG8_STAGE(PG8_SA(1, 0), a3, voffA);
            PG8_WAIT_V(8); PG8_WAIT_L(0); PG8_BAR; PG8_MMA(1, 0, At, B0); PG8_MMA(1, 1, At, B1); PG8_BAR; PG8_SCHED;
            } else {
            PG8_LDB(B0, 0, 0); PG8_SCHED; PG8_LDA(At, 0, 0); PG8_STAGE(PG8_SA(1, 1), a1 + hstep, voffA);
            PG8_WAIT_L(8); PG8_BAR; PG8_WAIT_L(0); PG8_MMA(0, 0, At, B0); PG8_BAR; PG8_SCHED;
            PG8_LDB(B1, 0, 1); PG8_STAGE(PG8_SB(0, 0), b2, voffB);
            PG8_BAR; PG8_WAIT_L(0); PG8_MMA(0, 1, At, B1); PG8_BAR;
            PG8_LDA(At, 0, 1); PG8_STAGE(PG8_SA(0, 0), a2, voffA);
            PG8_BAR; PG8_WAIT_L(0); PG8_MMA(1, 0, At, B0); PG8_BAR; PG8_SCHED;
            PG8_STAGE(PG8_SB(0, 1), b2 + hstep, voffB);
            PG8_WAIT_V(6); PG8_BAR; PG8_MMA(1, 1, At, B1); PG8_BAR;
            PG8_LDB(B0, 1, 0); PG8_SCHED; PG8_LDA(At, 1, 0); PG8_STAGE(PG8_SA(0, 1), a2 + hstep, voffA);
            PG8_WAIT_L(8); PG8_BAR; PG8_WAIT_L(0); PG8_MMA(0, 0, At, B0); PG8_BAR; PG8_SCHED;
            PG8_LDB(B1, 1, 1); PG8_STAGE(PG8_SB(1, 0), b3, voffB);
            PG8_BAR; PG8_WAIT_L(0); PG8_MMA(0, 1, At, B1); PG8_BAR;
            PG8_LDA(At, 1, 1); PG8_STAGE(PG8_SA(1, 0), a3, voffA);
            PG8_BAR; PG8_WAIT_L(0); PG8_MMA(1, 0, At, B0); PG8_BAR; PG8_SCHED;
            PG8_STAGE(PG8_SB(1, 1), b3 + hstep, voffB);
            PG8_WAIT_V(6); PG8_BAR; PG8_MMA(1, 1, At, B1); PG8_BAR;
            }
        }
        if constexpr (ALIGN_EPI) { if (wr == 0) PG8_BAR; }
        if constexpr (!Epi::AFTER_DRAIN) { E(acc, cur, wr, wc, fr, fq); S.done(cur); }
        if (!has_next) break;
#pragma unroll
        for (int a = 0; a < 2; ++a)
#pragma unroll
            for (int b = 0; b < 2; ++b)
#pragma unroll
                for (int m = 0; m < 4; ++m)
#pragma unroll
                    for (int n = 0; n < 2; ++n) acc[a][b][m][n] = (f32x4){0.f, 0.f, 0.f, 0.f};
        cur = nxt; cA = nA; cB = nB; ++ui;
        if constexpr (ALIGN_EPI) { if (wr == 1) PG8_BAR; }
    }
    PG8_WAIT_V(0);
    if constexpr (!ALIGN_EPI) { if (wr == 0) PG8_BAR; }
    PG8_BAR;
    if constexpr (Epi::AFTER_DRAIN) { E.fused(acc, cur, wr, wc, fr, fq, lds, wid, lane); S.done(cur); }
#undef PG8_SA
#undef PG8_SB
#undef PG8_STAGE
#undef PG8_LDA
#undef PG8_LDB
#undef PG8_MMA
#undef PG8_WAIT_V
#undef PG8_WAIT_L
#undef PG8_BAR
#undef PG8_SCHED
}
}


namespace pg8 {
struct EpiProj {
    static constexpr bool PERM = true, AFTER_DRAIN = false;
    bf16_t* P0; bf16_t* P1; bf16_t* P2;
    __device__ __forceinline__ void operator()(const f32x4 (&acc)[2][2][4][2], const Unit& u, int wr, int wc, int fr, int fq) const {
        const int row0 = u.pm * BM + wr * 64 + fr; const int colt = u.pn * BM;
        const long d1 = (long)(P1 - P0), d2 = (long)(P2 - P0); long dsel = 0; if (colt >= 1024) dsel = d1; if (colt >= 2048) dsel = d2;
        bf16_t* base = P0 + dsel; const int ldc = colt < 2048 ? 1024 : 256; const int cl = colt & 1023;
        const int col0 = cl + wc * 32 + 8 * fq;
#pragma unroll
        for (int ai = 0; ai < 2; ++ai)
#pragma unroll
            for (int m = 0; m < 4; ++m) { bf16_t* rowp = base + (size_t)(row0 + ai * HALF + m * 16) * ldc + col0;
#pragma unroll
                for (int bj = 0; bj < 2; ++bj) { const f32x4 v0 = acc[ai][bj][m][0], v1 = acc[ai][bj][m][1];
                    u32x4 w; w.x = cvt_pk_bf16(v0[0], v0[1]); w.y = cvt_pk_bf16(v0[2], v0[3]); w.z = cvt_pk_bf16(v1[0], v1[1]); w.w = cvt_pk_bf16(v1[2], v1[3]);
                    *(u32x4*)(rowp + bj * HALF) = w; } }
    }
};
}

constexpr int P3_TILE_BYTES = 256 * 1024;
constexpr int LDS_TK = 92160;
constexpr int LDS_OFF = 32768, LDS_CNT = 36864, LDS_H2L = 36864;
constexpr int SCW = 260;
template <int N> DI void ce_desc(float (&a)[N], int i, int l) { const float hi = fmaxf(a[i], a[l]), lo = fminf(a[i], a[l]); a[i] = hi; a[l] = lo; }
DI void sort16_desc(float (&a)[16]) {
#pragma unroll
  for (int k = 2; k <= 16; k <<= 1)
#pragma unroll
    for (int j = k >> 1; j > 0; j >>= 1)
#pragma unroll
      for (int i = 0; i < 16; ++i) { const int l = i ^ j; if (l > i) { if ((i & k) == 0) ce_desc(a, i, l); else ce_desc(a, l, i); } }
}
DI void merge16_desc(float (&a)[16]) {
#pragma unroll
  for (int j = 8; j > 0; j >>= 1)
#pragma unroll
    for (int i = 0; i < 16; ++i) { const int l = i ^ j; if (l > i) ce_desc(a, i, l); }
}
DI void top16_merge(float (&a)[16], const float (&b)[16]) {
#pragma unroll
  for (int i = 0; i < 16; ++i) a[i] = fmaxf(a[i], b[15 - i]);
  merge16_desc(a);
}
template <int CTRL> DI float dpp_f(float v) { return __int_as_float(__builtin_amdgcn_mov_dpp(__float_as_int(v), CTRL, 0xF, 0xF, true)); }

DI float gelu_fast(float x) { return 0.5f * x * (1.f + erff(x * 0.70710678118654752f)); }

DI void phase3(const KP& p, char* lds, const int gather_reps, const int probe) {
  const int tid0 = threadIdx.x;
  const int r = tid0 & 31, hh = (tid0 >> 5) & 1, lane = tid0 & 63;
  char* wl = lds + LDS_WT + ((tid0 >> 6) & 3) * WT_BYTES;
  for (int tile = blockIdx.x; tile < 256; tile += gridDim.x) {
    unsigned char* ws = launder(p.ws); float* outp = launder(p.out); const float* xin = launder(p.in[0]);
    const int tok0 = tile * 64, b = tile >> 5;
    unsigned char* tsc = ws + WS_QM + (size_t)tile * P3_TILE_BYTES;
    bf16_t* QRY = (bf16_t*)tsc; bf16_t* Y = (bf16_t*)tsc; bf16_t* MIXA = (bf16_t*)(ws + WS_P1S) + (size_t)tok0 * 1024; bf16_t* H2 = MIXA;
    const float* modb = launder((const float*)(ws + WS_MOD)) + b * 6144;
    __syncthreads();
    {
      const int tid = lv(tid0), lane = tid & 63, w = tid >> 6, r = lane & 31, hh = lane >> 5;
      const int h = w >> 1, mi = w & 1, n = tile & 31;
      char* OIL = lds; char* RGL = lds + 66560;
      { const bf16_t* oig = (const bf16_t*)(ws + WS_OINTRA) + (size_t)tok0 * 512; const bf16_t* rgg = (const bf16_t*)(ws + WS_RG) + (size_t)tok0 * 512;
#pragma unroll
        for (int i = 0; i < 8; ++i) { const int c = tid + 512 * i, row = c >> 6, cc = c & 63;
          *(uint4*)(OIL + row * 1040 + cc * 16) = *(const uint4*)(oig + (size_t)row * 512 + cc * 8);
          *(uint4*)(RGL + row * 1040 + cc * 16) = *(const uint4*)(rgg + (size_t)row * 512 + cc * 8); } }
      const bf16_t* QDg = (const bf16_t*)(ws + WS_QDEC) + (size_t)(tile * 4 + h) * 2 * 4096 + (mi * 32 + r) * 64 + hh * 8;
      const bf16_t* SPg = (const bf16_t*)(ws + WS_SPT) + ((size_t)((b * 4 + h) * 2) * 32 + n) * 8192 + r * 64 + hh * 8;
      f32x16 acc[4];
#pragma unroll
      for (int ni = 0; ni < 4; ++ni)
#pragma unroll
        for (int i = 0; i < 16; ++i) acc[ni][i] = 0.f;
#pragma unroll
      for (int d = 0; d < 2; ++d)
#pragma unroll
        for (int s = 0; s < 4; ++s) { const bf16x8 a = *(const bf16x8*)(QDg + d * 4096 + s * 16);
#pragma unroll
          for (int ni = 0; ni < 4; ++ni) { const bf16x8 bb = *(const bf16x8*)(SPg + (size_t)d * 32 * 8192 + ni * 32 * 64 + s * 16); acc[ni] = MFMA32(a, bb, acc[ni]); } }
      __syncthreads();
      bf16_t* oil = (bf16_t*)(OIL + (mi * 32 + 4 * hh) * 1040) + h * 128 + r; const bf16_t* rgl = (const bf16_t*)(RGL + (mi * 32 + 4 * hh) * 1040) + h * 128 + r;
#pragma unroll
      for (int ni = 0; ni < 4; ++ni)
#pragma unroll
        for (int reg = 0; reg < 16; ++reg) acc[ni][reg] += bf2f(oil[((reg & 3) + 8 * (reg >> 2)) * 520 + ni * 32]);
      float rs[16];
#pragma unroll
      for (int reg = 0; reg < 16; ++reg) { float v = acc[0][reg] * acc[0][reg] + acc[1][reg] * acc[1][reg] + acc[2][reg] * acc[2][reg] + acc[3][reg] * acc[3][reg];
        v += __shfl_xor(v, 1); v += __shfl_xor(v, 2); v += __shfl_xor(v, 4); v += __shfl_xor(v, 8); v += __shfl_xor(v, 16);
        rs[reg] = rsqrtf(v * (1.f / 128.f) + EPS); }
      const float* ggl = launder(p.in[16]);
#pragma unroll
      for (int ni = 0; ni < 4; ++ni) { const float g = ggl[ni * 32 + r];
#pragma unroll
        for (int reg = 0; reg < 16; ++reg) { const int ro = ((reg & 3) + 8 * (reg >> 2)) * 520 + ni * 32; const float rv = bf2f(rgl[ro]);
          oil[ro] = f2bf(acc[ni][reg] * rs[reg] * g * silu_fast(rv)); } }
      __syncthreads();
#pragma unroll
      for (int i = 0; i < 8; ++i) { const int c = tid + 512 * i, row = c >> 6, cc = c & 63;
        *(uint4*)(MIXA + (size_t)row * 1024 + 512 + cc * 8) = *(const uint4*)(OIL + row * 1040 + cc * 16); }
    }
  }
}

DI void phase3c(const KP& p, char* lds, const int gather_reps, const int probe) {
  const int tid0 = threadIdx.x;
  const int r = tid0 & 31, hh = (tid0 >> 5) & 1, lane = tid0 & 63;
  char* wl = lds + LDS_WT + ((tid0 >> 6) & 3) * WT_BYTES;
  for (int tile = blockIdx.x; tile < 256; tile += gridDim.x) {
    unsigned char* ws = launder(p.ws); float* outp = launder(p.out); const float* xin = launder(p.in[0]);
    const int tok0 = tile * 64, b = tile >> 5;
    unsigned char* tsc = ws + WS_QM + (size_t)tile * P3_TILE_BYTES;
    bf16_t* QRY = (bf16_t*)tsc; bf16_t* Y = (bf16_t*)(ws + WS_QM) + (size_t)tok0 * 1024; bf16_t* MIXA = (bf16_t*)(ws + WS_P1S) + (size_t)tok0 * 1024; bf16_t* H2 = MIXA;
    const float* modb = launder((const float*)(ws + WS_MOD)) + b * 6144;
    __syncthreads();
    {
      const int tid = lv(tid0), lane = tid & 63, w = tid >> 6;
      float4 A1[4], A2[4], S2[4];
      const float* gpo = launder(p.in[6]); const float* gpf = launder(p.in[18]);
#pragma unroll
      for (int i = 0; i < 4; ++i) { const int d = (lane + 64 * i) * 4;
        const float4 gp = *(const float4*)(gpo + d), gt = *(const float4*)(modb + 2048 + d), g2 = *(const float4*)(gpf + d), sc = *(const float4*)(modb + 4096 + d);
        S2[i] = *(const float4*)(modb + 3072 + d);
        A1[i] = make_float4(gp.x * gt.x, gp.y * gt.y, gp.z * gt.z, gp.w * gt.w);
        A2[i] = make_float4(g2.x * (1.f + sc.x), g2.y * (1.f + sc.y), g2.z * (1.f + sc.z), g2.w * (1.f + sc.w)); }
#pragma unroll 2
      for (int rr = 0; rr < 8; ++rr) { const int row = w * 8 + rr; const size_t tok = tok0 + row;
        float4 yv[4]; float ss = 0.f;
#pragma unroll
        for (int i = 0; i < 4; ++i) { const uint2 u = *(const uint2*)(Y + (size_t)row * 1024 + (lane + 64 * i) * 4);
          yv[i] = make_float4(__uint_as_float(u.x << 16), __uint_as_float(u.x & 0xffff0000u), __uint_as_float(u.y << 16), __uint_as_float(u.y & 0xffff0000u));
          ss += yv[i].x * yv[i].x + yv[i].y * yv[i].y + yv[i].z * yv[i].z + yv[i].w * yv[i].w; }
        ss = wave_sum(ss); const float rs = rsqrtf(ss * (1.f / 1024.f) + EPS);
        float4 xv[4]; float s2 = 0.f;
#pragma unroll
        for (int i = 0; i < 4; ++i) { const float4 x = *(const float4*)(xin + tok * 1024 + (lane + 64 * i) * 4);
          xv[i] = make_float4(x.x + A1[i].x * yv[i].x * rs, x.y + A1[i].y * yv[i].y * rs, x.z + A1[i].z * yv[i].z * rs, x.w + A1[i].w * yv[i].w * rs);
          *(float4*)(outp + tok * 1024 + (lane + 64 * i) * 4) = xv[i];
          s2 += xv[i].x * xv[i].x + xv[i].y * xv[i].y + xv[i].z * xv[i].z + xv[i].w * xv[i].w; }
        s2 = wave_sum(s2); const float r2 = rsqrtf(s2 * (1.f / 1024.f) + EPS);
#pragma unroll
        for (int i = 0; i < 4; ++i) { uint2 o; o.x = pack2(xv[i].x * r2 * A2[i].x + S2[i].x, xv[i].y * r2 * A2[i].y + S2[i].y); o.y = pack2(xv[i].z * r2 * A2[i].z + S2[i].z, xv[i].w * r2 * A2[i].w + S2[i].w);
          *(uint2*)(H2 + (size_t)row * 1024 + (lane + 64 * i) * 4) = o; }
      }
    }
  }
}

DI void phase3b(const KP& p, char* lds, const int gather_reps, const int probe) {
  const int tid0 = threadIdx.x;
  const int r = tid0 & 31, hh = (tid0 >> 5) & 1, lane = tid0 & 63;
  char* wl = lds + LDS_WT + ((tid0 >> 6) & 3) * WT_BYTES;
  for (int tile = blockIdx.x; tile < 256; tile += gridDim.x) {
    unsigned char* ws = launder(p.ws); float* outp = launder(p.out); const float* xin = launder(p.in[0]);
    const int tok0 = tile * 64, b = tile >> 5;
    unsigned char* tsc = ws + WS_QM + (size_t)tile * P3_TILE_BYTES;
    bf16_t* QRY = (bf16_t*)tsc; bf16_t* Y = (bf16_t*)tsc; bf16_t* MIXA = (bf16_t*)(ws + WS_P1S) + (size_t)tok0 * 1024; bf16_t* H2 = MIXA;
    const float* modb = launder((const float*)(ws + WS_MOD)) + b * 6144;
    __syncthreads();
    float* SC = (float*)lds; unsigned* TK = (unsigned*)(lds + LDS_TK);
    for (int rep3e = 0; rep3e < (probe == 7 ? 2 : 1); ++rep3e)
    for (int h = 0; h < 8; ++h) {
      block_gemm<2>(lds, QRY + h * 256, 2048, (const bf16_t*)(ws + WS_KD), 1, 256, [&](int m0, int n0, const f32x16& a0, const f32x16& a1) {
        const int r2 = lv(r), h2 = lv(hh);
        float* sp = SC + (m0 + 4 * h2) * SCW + n0 + r2;
#pragma unroll
        for (int reg = 0; reg < 16; ++reg) { const int ro = ((reg & 3) + 8 * (reg >> 2)) * SCW; sp[ro] = a0[reg]; sp[ro + 32] = a1[reg]; }
      });
      __syncthreads();
      {
        const int tid = lv(tid0);
        const int tt = tid >> 3, sd = (tid >> 2) & 1, q = tid & 3;
        const float* sr = SC + tt * SCW + sd * 128 + q * 32;
        float a[16], c[16];
#pragma unroll
        for (int i = 0; i < 4; ++i) { const float4 v = *(const float4*)(sr + i * 4); const unsigned ib = q * 32 + i * 4;
          a[i * 4 + 0] = __uint_as_float((__float_as_uint(v.x) & 0xFFFFFF80u) | (ib + 0)); a[i * 4 + 1] = __uint_as_float((__float_as_uint(v.y) & 0xFFFFFF80u) | (ib + 1));
          a[i * 4 + 2] = __uint_as_float((__float_as_uint(v.z) & 0xFFFFFF80u) | (ib + 2)); a[i * 4 + 3] = __uint_as_float((__float_as_uint(v.w) & 0xFFFFFF80u) | (ib + 3)); }
#pragma unroll
        for (int i = 0; i < 4; ++i) { const float4 v = *(const float4*)(sr + 16 + i * 4); const unsigned ib = q * 32 + 16 + i * 4;
          c[i * 4 + 0] = __uint_as_float((__float_as_uint(v.x) & 0xFFFFFF80u) | (ib + 0)); c[i * 4 + 1] = __uint_as_float((__float_as_uint(v.y) & 0xFFFFFF80u) | (ib + 1));
          c[i * 4 + 2] = __uint_as_float((__float_as_uint(v.z) & 0xFFFFFF80u) | (ib + 2)); c[i * 4 + 3] = __uint_as_float((__float_as_uint(v.w) & 0xFFFFFF80u) | (ib + 3)); }
        sort16_desc(a); sort16_desc(c); top16_merge(a, c);
#pragma unroll
        for (int i = 0; i < 16; ++i) c[i] = dpp_f<0xB1>(a[i]);
        top16_merge(a, c);
#pragma unroll
        for (int i = 0; i < 16; ++i) c[i] = dpp_f<0x4E>(a[i]);
        top16_merge(a, c);
        if (q == 0) { unsigned* tk = TK + ((tt * 8 + h) * 2 + sd) * 16;
#pragma unroll
          for (int i = 0; i < 4; ++i) *(uint4*)(tk + i * 4) = make_uint4(__float_as_uint(a[i * 4]), __float_as_uint(a[i * 4 + 1]), __float_as_uint(a[i * 4 + 2]), __float_as_uint(a[i * 4 + 3])); }
      }
      __syncthreads();
    }
    {
      const int tid = lv(tid0);
      const int tt = tid >> 3, h = tid & 7;
      const unsigned* t1 = TK + ((tt * 8 + h) * 2) * 16; const unsigned* t2 = t1 + 16;
      float v1[16], v2[16];
#pragma unroll
      for (int i = 0; i < 4; ++i) { const uint4 u = *(const uint4*)(t1 + i * 4), v = *(const uint4*)(t2 + i * 4);
        v1[i * 4] = __uint_as_float(u.x & 0xFFFFFF80u); v1[i * 4 + 1] = __uint_as_float(u.y & 0xFFFFFF80u); v1[i * 4 + 2] = __uint_as_float(u.z & 0xFFFFFF80u); v1[i * 4 + 3] = __uint_as_float(u.w & 0xFFFFFF80u);
        v2[i * 4] = __uint_as_float(v.x & 0xFFFFFF80u); v2[i * 4 + 1] = __uint_as_float(v.y & 0xFFFFFF80u); v2[i * 4 + 2] = __uint_as_float(v.z & 0xFFFFFF80u); v2[i * 4 + 3] = __uint_as_float(v.w & 0xFFFFFF80u); }
      float best[16], grp[16];
#define CAND(i, j) __uint_as_float((__float_as_uint(v1[i] + v2[j]) & 0xFFFFFF00u) | ((i) << 4) | (j))
      best[0] = CAND(0, 0); best[1] = CAND(0, 1); best[2] = CAND(0, 2); best[3] = CAND(0, 3); best[4] = CAND(0, 4); best[5] = CAND(0, 5); best[6] = CAND(0, 6); best[7] = CAND(0, 7);
      best[8] = CAND(0, 8); best[9] = CAND(0, 9); best[10] = CAND(0, 10); best[11] = CAND(0, 11); best[12] = CAND(0, 12); best[13] = CAND(0, 13); best[14] = CAND(0, 14); best[15] = CAND(0, 15);
      sort16_desc(best);
      grp[0] = CAND(1, 0); grp[1] = CAND(1, 1); grp[2] = CAND(1, 2); grp[3] = CAND(1, 3); grp[4] = CAND(1, 4); grp[5] = CAND(1, 5); grp[6] = CAND(1, 6); grp[7] = CAND(1, 7);
      grp[8] = CAND(2, 0); grp[9] = CAND(2, 1); grp[10] = CAND(2, 2); grp[11] = CAND(2, 3); grp[12] = CAND(2, 4); grp[13] = CAND(3, 0); grp[14] = CAND(3, 1); grp[15] = CAND(3, 2);
      sort16_desc(grp); top16_merge(best, grp);
      grp[0] = CAND(3, 3); grp[1] = CAND(4, 0); grp[2] = CAND(4, 1); grp[3] = CAND(4, 2); grp[4] = CAND(5, 0); grp[5] = CAND(5, 1); grp[6] = CAND(6, 0); grp[7] = CAND(6, 1);
      grp[8] = CAND(7, 0); grp[9] = CAND(7, 1); grp[10] = CAND(8, 0); grp[11] = CAND(9, 0); grp[12] = CAND(10, 0); grp[13] = CAND(11, 0); grp[14] = CAND(12, 0); grp[15] = CAND(13, 0);
      sort16_desc(grp); top16_merge(best, grp);
      { const float c14 = CAND(14, 0), c15 = CAND(15, 0);
        grp[0] = fmaxf(c14, c15); grp[1] = fminf(c14, c15);
#pragma unroll
        for (int i = 2; i < 16; ++i) grp[i] = -3.0e38f;
        top16_merge(best, grp); }
#undef CAND
      __syncthreads();
      float sv[16]; int ev[16]; float mx = -3.0e38f;
#pragma unroll
      for (int k = 0; k < 16; ++k) { const unsigned key = __float_as_uint(best[k]); const int ci = (key >> 4) & 15, cj = key & 15;
        const unsigned k1 = t1[ci], k2 = t2[cj];
        sv[k] = __uint_as_float(k1 & 0xFFFFFF80u) + __uint_as_float(k2 & 0xFFFFFF80u); ev[k] = (int)((k1 & 127u) * 128u + (k2 & 127u)); mx = fmaxf(mx, sv[k]); }
      float sum = 0.f;
#pragma unroll
      for (int k = 0; k < 16; ++k) { sv[k] = __expf(sv[k] - mx); sum += sv[k]; }
      const float inv = 1.f / sum;
      unsigned* CNT = (unsigned*)(lds + LDS_CNT); unsigned short* OFFS = (unsigned short*)(lds + LDS_OFF); unsigned* EL = (unsigned*)lds;
      CNT[tid] = 0u; CNT[tid + 512] = 0u;
      __syncthreads();
      int pos[16];
#pragma unroll
      for (int k = 0; k < 16; ++k) pos[k] = (int)atomicAdd(&CNT[tt * 16 + (ev[k] >> 10)], 1u);
      __syncthreads();
      if (h == 0) { unsigned run = 0;
#pragma unroll
        for (int q = 0; q < 16; ++q) { OFFS[tt * 17 + q] = (unsigned short)run; run += CNT[tt * 16 + q]; }
        OFFS[tt * 17 + 16] = (unsigned short)run; }
      __syncthreads();
#pragma unroll
      for (int k = 0; k < 16; ++k) { const int d = (int)OFFS[tt * 17 + (ev[k] >> 10)] + pos[k];
        EL[tt * 128 + d] = ((__float_as_uint(sv[k] * inv) + 0x2000u) & 0xFFFFC000u) | (unsigned)ev[k]; }
    }
    __syncthreads();
    {
      const int tid = lv(tid0), lane = tid & 63, w = tid >> 6;
      const unsigned char* EU = ws + WS_EU; const unsigned char* EV = ws + WS_EV; const float* SCU = (const float*)(ws + WS_ESC); const float* SCV = SCU + 16384;
      const unsigned* EL = (const unsigned*)lds; const unsigned short* OFFS = (const unsigned short*)(lds + LDS_OFF); char* H2L = lds + LDS_H2L;
      const float* gpf2 = launder(p.in[19]);
      const int rot = (int)(__builtin_amdgcn_s_getreg((3 << 11) | 20) & 0xFu) * 2;
      typedef float f2v __attribute__((ext_vector_type(2)));
#define FP8X4(wd, o0, o1, o2, o3) do { const f2v lo_ = __builtin_amdgcn_cvt_pk_f32_fp8((int)(wd), false), hi_ = __builtin_amdgcn_cvt_pk_f32_fp8((int)(wd), true); o0 = lo_.x; o1 = lo_.y; o2 = hi_.x; o3 = hi_.y; } while (0)
#pragma unroll 1
      for (int pass = 0; pass < gather_reps; ++pass)
#pragma unroll 1
      for (int half = 0; half < 2; ++half) {
        __syncthreads();
        { const uint4* src = (const uint4*)(H2 + (size_t)(half * 32) * 1024); uint4 t[8];
#pragma unroll
          for (int i = 0; i < 8; ++i) t[i] = src[tid + 512 * i];
#pragma unroll
          for (int i = 0; i < 8; ++i) ((uint4*)H2L)[tid + 512 * i] = t[i]; }
        __syncthreads();
        float acc[4][16];
#pragma unroll
        for (int rr = 0; rr < 4; ++rr)
#pragma unroll
          for (int i = 0; i < 16; ++i) acc[rr][i] = 0.f;
#pragma unroll 1
        for (int pp = 0; pp < 16; ++pp) { const int part = (pp + rot) & 15;
#pragma unroll
          for (int rr = 0; rr < 4; ++rr) { const int lrow = w * 4 + rr, row = half * 32 + lrow;
            const int o0 = __builtin_amdgcn_readfirstlane((int)OFFS[row * 17 + part]), o1 = __builtin_amdgcn_readfirstlane((int)OFFS[row * 17 + part + 1]);
            if (o0 == o1) continue;
            float hf[16];
            { const uint4 hA = *(const uint4*)(H2L + lrow * 2048 + lane * 32), hB = *(const uint4*)(H2L + lrow * 2048 + lane * 32 + 16);
              hf[0] = __uint_as_float(hA.x << 16); hf[1] = __uint_as_float(hA.x & 0xffff0000u); hf[2] = __uint_as_float(hA.y << 16); hf[3] = __uint_as_float(hA.y & 0xffff0000u);
              hf[4] = __uint_as_float(hA.z << 16); hf[5] = __uint_as_float(hA.z & 0xffff0000u); hf[6] = __uint_as_float(hA.w << 16); hf[7] = __uint_as_float(hA.w & 0xffff0000u);
              hf[8] = __uint_as_float(hB.x << 16); hf[9] = __uint_as_float(hB.x & 0xffff0000u); hf[10] = __uint_as_float(hB.y << 16); hf[11] = __uint_as_float(hB.y & 0xffff0000u);
              hf[12] = __uint_as_float(hB.z << 16); hf[13] = __uint_as_float(hB.z & 0xffff0000u); hf[14] = __uint_as_float(hB.w << 16); hf[15] = __uint_as_float(hB.w & 0xffff0000u); }
#pragma unroll 1
            for (int base = o0; base < o1; base += 8) {
              const int n = (o1 - base < 8) ? (o1 - base) : 8;
              const int sl = lane & 7; const bool valid = sl < n;
              const unsigned pk = EL[row * 128 + base + (valid ? sl : 0)];
              const int eslot = (int)(pk & 16383u);
              const float gte = valid ? __uint_as_float(pk & 0xFFFFC000u) : 0.f;
              uint4 u[8], v[8];
#pragma unroll
              for (int k2 = 0; k2 < 8; ++k2) if (k2 < n) { const int e = __builtin_amdgcn_readlane(eslot, k2);
                u[k2] = *(const uint4*)(EU + (size_t)e * 1024 + lane * 16); v[k2] = *(const uint4*)(EV + (size_t)e * 1024 + lane * 16); }
              const float su = SCU[eslot], sv = SCV[eslot];
              float P[8];
#pragma unroll
              for (int k2 = 0; k2 < 8; ++k2) { P[k2] = 0.f;
                if (k2 < n) { float a0, a1, a2, a3, d;
                  FP8X4(u[k2].x, a0, a1, a2, a3); d = a0 * hf[0] + a1 * hf[1] + a2 * hf[2] + a3 * hf[3];
                  FP8X4(u[k2].y, a0, a1, a2, a3); d += a0 * hf[4] + a1 * hf[5] + a2 * hf[6] + a3 * hf[7];
                  FP8X4(u[k2].z, a0, a1, a2, a3); d += a0 * hf[8] + a1 * hf[9] + a2 * hf[10] + a3 * hf[11];
                  FP8X4(u[k2].w, a0, a1, a2, a3); d += a0 * hf[12] + a1 * hf[13] + a2 * hf[14] + a3 * hf[15];
                  P[k2] = d; } }
              { const bool up4 = (lane & 4) != 0;
#pragma unroll
                for (int e = 0; e < 4; ++e) { const float keep = up4 ? P[e + 4] : P[e], send = up4 ? P[e] : P[e + 4]; P[e] = keep + __shfl_xor(send, 4); }
                const bool up2 = (lane & 2) != 0;
#pragma unroll
                for (int e = 0; e < 2; ++e) { const float keep = up2 ? P[e + 2] : P[e], send = up2 ? P[e] : P[e + 2]; P[e] = keep + dpp_f<0x4E>(send); }
                const bool up1 = (lane & 1) != 0;
                const float keep = up1 ? P[1] : P[0], send = up1 ? P[0] : P[1];
                float av = keep + dpp_f<0xB1>(send);
                av += __shfl_xor(av, 8); av += __shfl_xor(av, 16); av += __shfl_xor(av, 32);
                av *= su;
                const float ax = fabsf(av), t = __builtin_amdgcn_rcpf(ax * 0.2316418882f + 1.0f);
                float q = t * 0.5307027145f + (-0.7265760135f); q = q * t + 0.7107068705f; q = q * t + (-0.142248368f); q = q * t + 0.127414796f; q = q * t;
                const float ee = __builtin_amdgcn_exp2f(av * av * (-0.72134752044f));
                const float mm = av * (q * ee), gl = (av < 0.f) ? mm : (av - mm);
                P[0] = gte * gl * sv; }
#pragma unroll
              for (int k2 = 0; k2 < 8; ++k2) if (k2 < n) { const float wk = __int_as_float(__builtin_amdgcn_readlane(__float_as_int(P[0]), k2)); float a0, a1, a2, a3;
                FP8X4(v[k2].x, a0, a1, a2, a3); acc[rr][0] += wk * a0; acc[rr][1] += wk * a1; acc[rr][2] += wk * a2; acc[rr][3] += wk * a3;
                FP8X4(v[k2].y, a0, a1, a2, a3); acc[rr][4] += wk * a0; acc[rr][5] += wk * a1; acc[rr][6] += wk * a2; acc[rr][7] += wk * a3;
                FP8X4(v[k2].z, a0, a1, a2, a3); acc[rr][8] += wk * a0; acc[rr][9] += wk * a1; acc[rr][10] += wk * a2; acc[rr][11] += wk * a3;
                FP8X4(v[k2].w, a0, a1, a2, a3); acc[rr][12] += wk * a0; acc[rr][13] += wk * a1; acc[rr][14] += wk * a2; acc[rr][15] += wk * a3; }
            }
          }
        }
        if (pass == gather_reps - 1)
#pragma unroll
        for (int rr = 0; rr < 4; ++rr) { const size_t tok = tok0 + half * 32 + w * 4 + rr;
          float ss = 0.f;
#pragma unroll
          for (int i = 0; i < 16; ++i) ss += acc[rr][i] * acc[rr][i];
          ss = wave_sum(ss); const float rs = rsqrtf(ss * (1.f / 1024.f) + EPS);
          float* orow = outp + tok * 1024 + lane * 16;
#pragma unroll
          for (int i = 0; i < 4; ++i) { const int d = lane * 16 + 4 * i;
            float4 x1 = *(const float4*)(orow + 4 * i); const float4 g3 = *(const float4*)(gpf2 + d), g2 = *(const float4*)(modb + 5120 + d);
            x1.x += g3.x * g2.x * acc[rr][4 * i] * rs; x1.y += g3.y * g2.y * acc[rr][4 * i + 1] * rs; x1.z += g3.z * g2.z * acc[rr][4 * i + 2] * rs; x1.w += g3.w * g2.w * acc[rr][4 * i + 3] * rs;
            *(float4*)(orow + 4 * i) = x1; }
        }
      }
#undef FP8X4
    }
  }
}

DI void phase2_scan(const KP& p) {
  unsigned char* ws = p.ws;
  for (int g = blockIdx.x * NTHR + threadIdx.x; g < 131072; g += gridDim.x * NTHR) {
    const int seq = g >> 11, within = g & 2047, dv = within >> 4, dk4 = (within & 15) * 4, dir = seq & 1;
    bf16_t* base = (bf16_t*)(ws + WS_SPT) + ((size_t)seq * 32 * 128 + dv) * 64 + dk4;
    const float* dec = (const float*)(ws + WS_DEC) + (size_t)seq * 32 * 64 + dk4;
    float s0 = 0.f, s1 = 0.f, s2 = 0.f, s3 = 0.f;
#pragma unroll 1
    for (int i0 = 0; i0 < 32; i0 += 8) {
      uint2 d[8]; float4 c[8];
#pragma unroll
      for (int j = 0; j < 8; ++j) { const int n = dir ? 31 - (i0 + j) : (i0 + j); d[j] = *(const uint2*)(base + (size_t)n * 8192); c[j] = *(const float4*)(dec + n * 64); }
#pragma unroll
      for (int j = 0; j < 8; ++j) { const int n = dir ? 31 - (i0 + j) : (i0 + j);
        uint2 o; o.x = pack2(s0, s1); o.y = pack2(s2, s3); *(uint2*)(base + (size_t)n * 8192) = o;
        s0 = c[j].x * s0 + __uint_as_float(d[j].x << 16); s1 = c[j].y * s1 + __uint_as_float(d[j].x & 0xffff0000u);
        s2 = c[j].z * s2 + __uint_as_float(d[j].y << 16); s3 = c[j].w * s3 + __uint_as_float(d[j].y & 0xffff0000u); }
    }
  }
}

#define XB_TMO      128
#define XB_XCNT(j)  (256  + 64 * (j))
#define XB_XSUB(j)  (1280 + 64 * (j))
#define XB_XGEN(j)  (2304 + 64 * (j))
#define XB_TOP      3328
#define XB_TOPGEN   3392
#define XCD_BAR_WORDS 3456
#define XB_SPIN_CAP (1u << 18)
#define LAS __attribute__((address_space(3)))

__device__ __forceinline__ unsigned xb_ld(unsigned* p)              { return __hip_atomic_load(p, __ATOMIC_RELAXED, __HIP_MEMORY_SCOPE_AGENT); }
__device__ __forceinline__ unsigned xb_add(unsigned* p, unsigned v) { return __hip_atomic_fetch_add(p, v, __ATOMIC_RELAXED, __HIP_MEMORY_SCOPE_AGENT); }
__device__ __forceinline__ unsigned xb_xcc_id() { return (unsigned)__builtin_amdgcn_s_getreg((3 << 11) | 20) & 0xFu; }
#define XB_SPIN(cond, bar) do { unsigned _sp = 0; while (cond) { __builtin_amdgcn_s_sleep(1); \
    if ((++_sp & 255u) == 0u) { if (xb_ld(&(bar)[XB_TMO])) break; if (_sp > XB_SPIN_CAP) { atomicAdd(&(bar)[XB_TMO], 1u); break; } } } } while (0)

struct XcdBarrier {
    unsigned* bar; unsigned x;
    volatile LAS unsigned* st;
};

__device__ __forceinline__ XcdBarrier xcd_barrier_post(unsigned* bar, volatile LAS unsigned* st) {
    XcdBarrier b; b.bar = bar; b.x = xb_xcc_id(); b.st = st;
    if (threadIdx.x == 0) (void)xb_add(&bar[XB_XCNT(b.x)], 1u);
    return b;
}
__device__ __forceinline__ void xcd_barrier_complete(unsigned* bar, unsigned x, unsigned& nloc, unsigned& nx) {
    const unsigned G = gridDim.x * gridDim.y * gridDim.z;
    unsigned sum, cnt, mine, sp = 0u;
    for (;;) {
        sum = 0u; cnt = 0u; mine = 0u;
#pragma unroll
        for (unsigned j = 0; j < 16; ++j) { const unsigned c = xb_ld(&bar[XB_XCNT(j)]); sum += c; cnt += (c > 0u) ? 1u : 0u; mine = (j == x) ? c : mine; }
        if (sum == G) break;
        __builtin_amdgcn_s_sleep(1);
        if ((++sp & 255u) == 0u) { if (xb_ld(&bar[XB_TMO])) break; if (sp > XB_SPIN_CAP) { atomicAdd(&bar[XB_TMO], 1u); break; } }
    }
    nloc = mine > 0u ? mine : 1u; nx = cnt > 0u ? cnt : 1u;
}

__device__ __forceinline__ void xcd_barrier(const XcdBarrier& b) {
    asm volatile("s_waitcnt vmcnt(0)" ::: "memory");
    __syncthreads();
    if (threadIdx.x == 0) {
        unsigned* bar = b.bar;
        __builtin_amdgcn_s_waitcnt(0);
        unsigned nloc = b.st[0], nx = b.st[1];
        if (nloc == 0u) { xcd_barrier_complete(bar, b.x, nloc, nx); b.st[0] = nloc; b.st[1] = nx; }
        const unsigned old = xb_add(&bar[XB_XSUB(b.x)], 1u);
        const unsigned gen = old / nloc;
        if (old + 1u == (gen + 1u) * nloc) {
            __builtin_amdgcn_fence(__ATOMIC_RELEASE, "agent");
            asm volatile("s_waitcnt vmcnt(0)" ::: "memory");
            const unsigned og = xb_add(&bar[XB_TOP], 1u);
            const unsigned tg = og / nx;
            if (og + 1u == (tg + 1u) * nx) xb_add(&bar[XB_TOPGEN], 1u);
            else XB_SPIN(xb_ld(&bar[XB_TOPGEN]) == tg, bar);
            __builtin_amdgcn_fence(__ATOMIC_ACQUIRE, "agent");
            xb_add(&bar[XB_XGEN(b.x)], 1u);
            asm volatile("s_waitcnt vmcnt(0)" ::: "memory");
        } else {
            XB_SPIN(xb_ld(&bar[XB_XGEN(b.x)]) == gen, bar);
            __builtin_amdgcn_fence(__ATOMIC_ACQUIRE, "agent");
            asm volatile("s_waitcnt vmcnt(0)" ::: "memory");
        }
    }
    __syncthreads();
}

#ifndef PROBE_ID
#define PROBE_ID 0
#endif
__global__ void __launch_bounds__(NTHR, 2) mega(KP p) {
  extern __shared__ __attribute__((aligned(16))) char lds[];
  cg::grid_group grid = cg::this_grid();
  const int hi = p.ph_hi; constexpr int probe = PROBE_ID;
  if (threadIdx.x == 0) { ((volatile LAS unsigned*)(lds + LDS_XB))[0] = 0u; ((volatile LAS unsigned*)(lds + LDS_XB))[1] = 0u; }
  __syncthreads();
  const XcdBarrier xb = xcd_barrier_post((unsigned*)(p.ws + WS_BAR), (volatile LAS unsigned*)(lds + LDS_XB));
  if (p.ph_lo <= 0 && 0 < hi) { phase0(p, lds); if (probe == 1) phase0(p, lds); if (1 < hi) { if (hi > 64) grid.sync(); else xcd_barrier(xb); } }
  if (p.ph_lo <= 1 && 1 < hi) {
    phase1a(p, lds);
    xcd_barrier(xb);
    {
      pg8::Gemm g{(const pg8::bf16_t*)p.out, (const pg8::bf16_t*)(p.ws + WS_WTINP), NTOK, 2304, 1024};
      pg8::StaticOrder S; S.init(NTOK, 2304, (int)gridDim.x, (int)blockIdx.x);
      pg8::EpiProj E{(pg8::bf16_t*)(p.ws + WS_P1S), (pg8::bf16_t*)((unsigned char*)p.out + 32 * MiB), (pg8::bf16_t*)(p.ws + WS_PROJC)};
      pg8::gemm_phase<pg8::EpiProj, pg8::StaticOrder, true, true>((PG8_LAS unsigned char*)lds, g, S, E);
    }
    xcd_barrier(xb);
    phase1c(p, lds);
    if (2 < hi) xcd_barrier(xb);
  }
  if (p.ph_lo <= 2 && 2 < hi) { phase2_scan(p); phase2_attn(p, lds); if (probe == 3) phase2_attn(p, lds); if (3 < hi) xcd_barrier(xb); }
  if (p.ph_lo <= 3 && 3 < hi) {
    phase3(p, lds, 1, probe);
    xcd_barrier(xb);
    {
      pg8::Gemm g{(const pg8::bf16_t*)(p.ws + WS_P1S), (const pg8::bf16_t*)(p.ws + WS_WTOUTP), NTOK, 1024, 1024};
      pg8::StaticOrder S; S.init(NTOK, 1024, (int)gridDim.x, (int)blockIdx.x);
      pg8::EpiBf16<0> E{(pg8::bf16_t*)(p.ws + WS_QM), 1024, nullptr, 0, 0, 1.f};
      pg8::gemm_phase<pg8::EpiBf16<0>, pg8::StaticOrder, true, true>((PG8_LAS unsigned char*)lds, g, S, E);
    }
    xcd_barrier(xb);
    phase3c(p, lds, 1, probe);
    xcd_barrier(xb);
    {
      pg8::Gemm g{(const pg8::bf16_t*)(p.ws + WS_P1S), (const pg8::bf16_t*)(p.ws + WS_WTPQP), NTOK, 2048, 1024};
      pg8::StaticOrder S; S.init(NTOK, 2048, (int)gridDim.x, (int)blockIdx.x);
      pg8::EpiBf16<0> E{(pg8::bf16_t*)(p.ws + WS_QM), 2048, nullptr, 0, 0, 1.f};
      pg8::gemm_phase<pg8::EpiBf16<0>, pg8::StaticOrder, true, true>((PG8_LAS unsigned char*)lds, g, S, E);
    }
    xcd_barrier(xb);
    phase3b(p, lds, (probe == 4 || probe == 8) ? 2 : 1, probe);
  }
}

extern "C" void kernel_launch(void* const* d_in, const int* in_sizes, int n_in, void* d_out, int out_size, void* d_ws, size_t ws_size, hipStream_t stream) {
  float* out = (float*)d_out;
  unsigned char* ws = (unsigned char*)d_ws;
  if (ws_size < WS_END || n_in != 25) return;
  static bool attr_done = false;
  if (!attr_done) { (void)hipFuncSetAttribute((const void*)mega, hipFuncAttributeMaxDynamicSharedMemorySize, LDS_TOTAL); attr_done = true; }
  KP p{};
  for (int i = 0; i < 25; ++i) p.in[i] = (const float*)d_in[i];
  p.out = out; p.ws = ws;
  p.ph_lo = 0; p.ph_hi = 4;
  (void)hipMemsetAsync(ws + WS_BAR, 0, XCD_BAR_WORDS * 4, stream);
  { void* args[] = {&p}; (void)hipLaunchCooperativeKernel((const void*)mega, dim3(256), dim3(NTHR), args, LDS_TOTAL, stream); }
}
```

```cpp
#include <hip/hip_runtime.h>
#include <hip/hip_cooperative_groups.h>
namespace cg = cooperative_groups;
#include <stdint.h>

typedef unsigned short bf16_t;
#define DI __device__ __forceinline__

DI float bf2f(bf16_t v) { return __uint_as_float(((unsigned)v) << 16); }
DI bf16_t f2bf(float f) { return __builtin_bit_cast(unsigned short, (__bf16)f); }

constexpr int BATCH = 8, SEQ = 2048, DM = 1024, NTOK = BATCH * SEQ;
constexpr int INW = 2272;
constexpr float EPS = 1e-6f;
constexpr int O_CQ = 0, O_CKV = 384, O_KR = 640, O_QG = 704, O_KG = 960, O_VG = 1216, O_GF = 1728, O_GB = 1744, O_R = 1760;

DI float wave_sum(float v) {
#pragma unroll
  for (int o = 1; o < 64; o <<= 1) v += __shfl_xor(v, o);
  return v;
}
DI float wave_max(float v) {
#pragma unroll
  for (int o = 1; o < 64; o <<= 1) v = fmaxf(v, __shfl_xor(v, o));
  return v;
}
DI float block_sum256(float v, float* red) {
  v = wave_sum(v);
  __syncthreads();
  if ((threadIdx.x & 63) == 0) red[threadIdx.x >> 6] = v;
  __syncthreads();
  return red[0] + red[1] + red[2] + red[3];
}
DI float block_max256(float v, float* red) {
  v = wave_max(v);
  __syncthreads();
  if ((threadIdx.x & 63) == 0) red[threadIdx.x >> 6] = v;
  __syncthreads();
  return fmaxf(fmaxf(red[0], red[1]), fmaxf(red[2], red[3]));
}
DI float silu_f(float x) { return x / (1.f + expf(-x)); }
DI float logsigmoid_f(float x) { return fminf(x, 0.f) - log1pf(expf(-fabsf(x))); }
DI float fexp(float x) { return __builtin_amdgcn_exp2f(x * 1.4426950408889634f); }
DI float silu_fast(float x) { return x * __builtin_amdgcn_rcpf(1.f + fexp(-x)); }
DI float logsigmoid_fast(float x) { return fminf(x, 0.f) - __builtin_amdgcn_logf(1.f + fexp(-fabsf(x))) * 0.6931471805599453f; }
DI float gelu_erf(float x) { return 0.5f * x * (1.f + erff(x * 0.70710678118654752f)); }

__global__ __launch_bounds__(256) void n_mod(const float* __restrict__ c, const float* __restrict__ w_ada, const float* __restrict__ b_ada, float* __restrict__ mod) {
  int idx = blockIdx.x * 256 + threadIdx.x;
  int b = idx / 6144, j = idx % 6144;
  float acc = b_ada[j];
  for (int k = 0; k < 1024; ++k) acc += silu_f(c[b * 1024 + k]) * w_ada[(size_t)k * 6144 + j];
  mod[idx] = acc;
}

__global__ __launch_bounds__(256) void n_hnorm(const float* __restrict__ x, const float* __restrict__ g, const float* __restrict__ mod, int b, int off_sh, int off_sc, float* __restrict__ h) {
  __shared__ float red[4];
  int t = blockIdx.x, tid = threadIdx.x;
  const float* xr = x + ((size_t)b * SEQ + t) * DM;
  float v[4]; float ss = 0.f;
#pragma unroll
  for (int i = 0; i < 4; ++i) { v[i] = xr[tid + 256 * i]; ss += v[i] * v[i]; }
  ss = block_sum256(ss, red);
  float rs = rsqrtf(ss * (1.f / DM) + EPS);
#pragma unroll
  for (int i = 0; i < 4; ++i) { int d = tid + 256 * i; h[(size_t)t * DM + d] = v[i] * rs * g[d] * (1.f + mod[b * 6144 + off_sc + d]) + mod[b * 6144 + off_sh + d]; }
}

template <bool BT>
__global__ __launch_bounds__(256) void n_gemm(const float* __restrict__ A, int lda, const float* __restrict__ B, int ldb, float* __restrict__ C, int ldc, int M, int N, int K) {
  __shared__ float As[16][65];
  __shared__ float Bs[16][65];
  const int tid = threadIdx.x, tx = tid & 15, ty = tid >> 4;
  const int m0 = blockIdx.y * 64, n0 = blockIdx.x * 64;
  float acc[4][4];
#pragma unroll
  for (int i = 0; i < 4; ++i)
#pragma unroll
    for (int j = 0; j < 4; ++j) acc[i][j] = 0.f;
  for (int k0 = 0; k0 < K; k0 += 16) {
#pragma unroll
    for (int i = 0; i < 4; ++i) { int e = tid + 256 * i; int m = e >> 4, k = e & 15; As[k][m] = A[(size_t)(m0 + m) * lda + k0 + k]; }
#pragma unroll
    for (int i = 0; i < 4; ++i) { int e = tid + 256 * i;
      if (!BT) { int k = e >> 6, n = e & 63; Bs[k][n] = (n0 + n < N) ? B[(size_t)(k0 + k) * ldb + n0 + n] : 0.f; }
      else     { int n = e >> 4, k = e & 15; Bs[k][n] = (n0 + n < N) ? B[(size_t)(n0 + n) * ldb + k0 + k] : 0.f; } }
    __syncthreads();
#pragma unroll
    for (int k = 0; k < 16; ++k) {
      float a[4], bb[4];
#pragma unroll
      for (int i = 0; i < 4; ++i) { a[i] = As[k][ty * 4 + i]; bb[i] = Bs[k][tx * 4 + i]; }
#pragma unroll
      for (int i = 0; i < 4; ++i)
#pragma unroll
        for (int j = 0; j < 4; ++j) acc[i][j] += a[i] * bb[j];
    }
    __syncthreads();
  }
#pragma unroll
  for (int i = 0; i < 4; ++i)
#pragma unroll
    for (int j = 0; j < 4; ++j) { int n = n0 + tx * 4 + j; if (n < N) C[(size_t)(m0 + ty * 4 + i) * ldc + n] = acc[i][j]; }
}

__global__ __launch_bounds__(256) void n_rms_slice(const float* __restrict__ in, int ldin, int off, int W, const float* __restrict__ g, float* __restrict__ out) {
  __shared__ float red[4];
  int t = blockIdx.x, tid = threadIdx.x;
  float v0 = (tid < W) ? in[(size_t)t * ldin + off + tid] : 0.f;
  float v1 = (tid + 256 < W) ? in[(size_t)t * ldin + off + tid + 256] : 0.f;
  float ss = block_sum256(v0 * v0 + v1 * v1, red);
  float rs = rsqrtf(ss / (float)W + EPS);
  if (tid < W) out[(size_t)t * W + tid] = v0 * rs * g[tid];
  if (tid + 256 < W) out[(size_t)t * W + tid + 256] = v1 * rs * g[tid + 256];
}

__global__ __launch_bounds__(256) void n_scatter(const float* __restrict__ proj, const float* __restrict__ qa, const float* __restrict__ kv, const int* __restrict__ positions, int b,
                                                 const float* __restrict__ wgf, const float* __restrict__ bgf, const float* __restrict__ wgb, const float* __restrict__ bgb,
                                                 bf16_t* __restrict__ Qm, bf16_t* __restrict__ Km, bf16_t* __restrict__ Vm, bf16_t* __restrict__ qg, bf16_t* __restrict__ kg, bf16_t* __restrict__ vg,
                                                 bf16_t* __restrict__ rg, float* __restrict__ laf, float* __restrict__ lab) {
  __shared__ float cs[32], sn[32];
  const int t = blockIdx.x, tid = threadIdx.x;
  const size_t tok = (size_t)b * SEQ + t;
  const float* pr = proj + (size_t)t * INW;
  const float* qr = qa + (size_t)t * 768;
  const float* kr = kv + (size_t)t * 1024;
  if (tid < 32) {
    float inv = powf(10000.f, -(float)tid / 32.f);
    float ang = (float)positions[tok] * inv;
    cs[tid] = cosf(ang); sn[tid] = sinf(ang);
  }
  __syncthreads();
  for (int e = tid; e < 4 * 192; e += 256) {
    int h = e / 192, d = e % 192; float v;
    if (d < 128) v = qr[h * 192 + d];
    else { int j = d - 128; const float* rp = qr + h * 192 + 128;
      if (j < 32) v = rp[j] * cs[j] - rp[j + 32] * sn[j]; else v = rp[j] * cs[j - 32] + rp[j - 32] * sn[j - 32]; }
    Qm[(((size_t)b * 4 + h) * SEQ + t) * 192 + d] = f2bf(v);
  }
  for (int e = tid; e < 4 * 192; e += 256) {
    int h = e / 192, d = e % 192; float v;
    if (d < 128) v = kr[h * 256 + d];
    else { int j = d - 128; const float* rp = pr + O_KR;
      if (j < 32) v = rp[j] * cs[j] - rp[j + 32] * sn[j]; else v = rp[j] * cs[j - 32] + rp[j - 32] * sn[j - 32]; }
    Km[(((size_t)b * 4 + h) * SEQ + t) * 192 + d] = f2bf(v);
  }
  for (int e = tid; e < 512; e += 256) { int h = e >> 7, d = e & 127; Vm[(((size_t)b * 4 + h) * SEQ + t) * 128 + d] = f2bf(kr[h * 256 + 128 + d]); }
  { int e = tid; qg[tok * 256 + e] = f2bf(pr[O_QG + e] * 0.125f); kg[tok * 256 + e] = f2bf(pr[O_KG + e]); }
  for (int e = tid; e < 512; e += 256) { vg[tok * 512 + e] = f2bf(pr[O_VG + e]); rg[tok * 512 + e] = f2bf(pr[O_R + e]); }
  { int cidx = tid; float af = bgf[cidx], ab = bgb[cidx];
#pragma unroll
    for (int r = 0; r < 16; ++r) { af += pr[O_GF + r] * wgf[r * 256 + cidx]; ab += pr[O_GB + r] * wgb[r * 256 + cidx]; }
    laf[tok * 256 + cidx] = logsigmoid_f(af) * (1.f / 16.f); lab[tok * 256 + cidx] = logsigmoid_f(ab) * (1.f / 16.f); }
}

__global__ __launch_bounds__(256) void n_attn(const bf16_t* __restrict__ Qm, const bf16_t* __restrict__ Km, const bf16_t* __restrict__ Vm, bf16_t* __restrict__ omla) {
  __shared__ float qs[192]; __shared__ float sc[2048]; __shared__ float red[4];
  const int i = blockIdx.x, h = blockIdx.y, b = blockIdx.z, tid = threadIdx.x;
  const size_t bh = (size_t)b * 4 + h;
  if (tid < 192) qs[tid] = bf2f(Qm[(bh * SEQ + i) * 192 + tid]);
  __syncthreads();
  float mx = -1e30f;
  for (int kk = 0; kk < 8; ++kk) {
    int key = tid + 256 * kk; const uint4* kr = (const uint4*)(Km + (bh * SEQ + key) * 192);
    float s = 0.f;
    for (int c = 0; c < 24; ++c) { uint4 w = kr[c]; const float* q = qs + c * 8;
      s += q[0] * __uint_as_float(w.x << 16) + q[1] * __uint_as_float(w.x & 0xffff0000u) + q[2] * __uint_as_float(w.y << 16) + q[3] * __uint_as_float(w.y & 0xffff0000u)
         + q[4] * __uint_as_float(w.z << 16) + q[5] * __uint_as_float(w.z & 0xffff0000u) + q[6] * __uint_as_float(w.w << 16) + q[7] * __uint_as_float(w.w & 0xffff0000u); }
    s *= 0.07216878364870322f; sc[key] = s; mx = fmaxf(mx, s);
  }
  mx = block_max256(mx, red);
  float sum = 0.f;
  for (int kk = 0; kk < 8; ++kk) { int key = tid + 256 * kk; float p = expf(sc[key] - mx); sc[key] = p; sum += p; }
  sum = block_sum256(sum, red);
  __syncthreads();
  if (tid < 128) { float o = 0.f; const bf16_t* vp = Vm + bh * SEQ * 128 + tid;
    for (int key = 0; key < SEQ; ++key) o += sc[key] * bf2f(vp[(size_t)key * 128]);
    omla[((size_t)b * SEQ + i) * 512 + h * 128 + tid] = f2bf(o / sum); }
}

__global__ __launch_bounds__(128) void n_gla(const bf16_t* __restrict__ qg, const bf16_t* __restrict__ kg, const bf16_t* __restrict__ vg, const bf16_t* __restrict__ laf, const bf16_t* __restrict__ lab, float* __restrict__ og) {
  __shared__ float qs[64], ks[64], as[64];
  const int bh = blockIdx.x, b = bh >> 2, h = bh & 3, dv = threadIdx.x;
  for (int dir = 0; dir < 2; ++dir) {
    float S[64];
#pragma unroll
    for (int d = 0; d < 64; ++d) S[d] = 0.f;
    const bf16_t* la = dir ? lab : laf;
    for (int s = 0; s < SEQ; ++s) {
      const int t = dir ? (SEQ - 1 - s) : s; const size_t tok = (size_t)b * SEQ + t;
      __syncthreads();
      if (dv < 64) { qs[dv] = bf2f(qg[tok * 256 + h * 64 + dv]); ks[dv] = bf2f(kg[tok * 256 + h * 64 + dv]); as[dv] = expf(bf2f(la[tok * 256 + h * 64 + dv])); }
      __syncthreads();
      const float v = bf2f(vg[tok * 512 + h * 128 + dv]); float o = 0.f;
#pragma unroll
      for (int d = 0; d < 64; ++d) { S[d] = as[d] * S[d] + ks[d] * v; o += qs[d] * S[d]; }
      if (dir == 0) og[tok * 512 + h * 128 + dv] = o; else og[tok * 512 + h * 128 + dv] += o;
    }
  }
}

__global__ __launch_bounds__(256) void n_mix(const bf16_t* __restrict__ omla, const float* __restrict__ og, const bf16_t* __restrict__ rg, const float* __restrict__ g_gla, int b, float* __restrict__ mix) {
  __shared__ float ssum[4];
  const int t = blockIdx.x, tid = threadIdx.x; const size_t tok = (size_t)b * SEQ + t;
  if (tid < 4) ssum[tid] = 0.f;
  __syncthreads();
  float v[2];
#pragma unroll
  for (int i = 0; i < 2; ++i) { int e = tid + 256 * i; v[i] = og[tok * 512 + e]; atomicAdd(&ssum[e >> 7], v[i] * v[i]); mix[(size_t)t * DM + e] = bf2f(omla[tok * 512 + e]); }
  __syncthreads();
#pragma unroll
  for (int i = 0; i < 2; ++i) { int e = tid + 256 * i; float rs = rsqrtf(ssum[e >> 7] * (1.f / 128.f) + EPS);
    mix[(size_t)t * DM + 512 + e] = v[i] * rs * g_gla[e & 127] * silu_f(bf2f(rg[tok * 512 + e])); }
}

__global__ __launch_bounds__(256) void n_post1(const float* __restrict__ x, const float* __restrict__ y, const float* __restrict__ g_post, const float* __restrict__ g_pre2, const float* __restrict__ mod, int b,
                                               float* __restrict__ out, float* __restrict__ h2) {
  __shared__ float red[4];
  const int t = blockIdx.x, tid = threadIdx.x; const size_t tok = (size_t)b * SEQ + t;
  float yv[4], xv[4]; float ss = 0.f;
#pragma unroll
  for (int i = 0; i < 4; ++i) { yv[i] = y[(size_t)t * DM + tid + 256 * i]; ss += yv[i] * yv[i]; }
  ss = block_sum256(ss, red);
  float rs = rsqrtf(ss * (1.f / DM) + EPS); float s2 = 0.f;
#pragma unroll
  for (int i = 0; i < 4; ++i) { int d = tid + 256 * i; xv[i] = x[tok * DM + d] + mod[b * 6144 + 2048 + d] * (yv[i] * rs * g_post[d]); out[tok * DM + d] = xv[i]; s2 += xv[i] * xv[i]; }
  s2 = block_sum256(s2, red);
  float r2 = rsqrtf(s2 * (1.f / DM) + EPS);
#pragma unroll
  for (int i = 0; i < 4; ++i) { int d = tid + 256 * i; h2[(size_t)t * DM + d] = xv[i] * r2 * g_pre2[d] * (1.f + mod[b * 6144 + 4096 + d]) + mod[b * 6144 + 3072 + d]; }
}

DI void wave_argmax(float& v, int& i) {
#pragma unroll
  for (int o = 1; o < 64; o <<= 1) { float ov = __shfl_xor(v, o); int oi = __shfl_xor(i, o); if (ov > v || (ov == v && oi < i)) { v = ov; i = oi; } }
}
__global__ __launch_bounds__(256) void n_peer_select(const float* __restrict__ qry, const float* __restrict__ sk1, const float* __restrict__ sk2, int* __restrict__ eidx, float* __restrict__ gate) {
  __shared__ float v1s[4][16], v2s[4][16]; __shared__ int i1s[4][16], i2s[4][16];
  const int w = threadIdx.x >> 6, lane = threadIdx.x & 63;
  const int pair = blockIdx.x * 4 + w;
  const int t = pair >> 3, h = pair & 7;
  const float* q1 = qry + (size_t)t * 2048 + h * 256; const float* q2 = q1 + 128;
  float s1a = 0.f, s1b = 0.f, s2a = 0.f, s2b = 0.f;
  for (int d = 0; d < 128; ++d) { float a = q1[d], bq = q2[d];
    s1a += a * sk1[lane * 128 + d]; s1b += a * sk1[(lane + 64) * 128 + d]; s2a += bq * sk2[lane * 128 + d]; s2b += bq * sk2[(lane + 64) * 128 + d]; }
  for (int side = 0; side < 2; ++side) {
    float va = side ? s2a : s1a, vb = side ? s2b : s1b; bool ta = false, tb = false;
    for (int k = 0; k < 16; ++k) {
      float bv; int bi;
      if (!ta && (tb || va >= vb)) { bv = va; bi = lane; } else if (!tb) { bv = vb; bi = lane + 64; } else { bv = -3e38f; bi = 1 << 20; }
      wave_argmax(bv, bi);
      if (bi == lane) ta = true; if (bi == lane + 64) tb = true;
      if (lane == 0) { if (side) { v2s[w][k] = bv; i2s[w][k] = bi; } else { v1s[w][k] = bv; i1s[w][k] = bi; } }
    }
  }
  __syncthreads();
  float cv[4]; bool tk[4];
#pragma unroll
  for (int j = 0; j < 4; ++j) { int c = lane + 64 * j; cv[j] = v1s[w][c >> 4] + v2s[w][c & 15]; tk[j] = false; }
  float topv = 0.f; int topc = 0; float mx = 0.f;
  for (int k = 0; k < 16; ++k) {
    float bv = -3e38f; int bi = 1 << 20;
#pragma unroll
    for (int j = 0; j < 4; ++j) { if (!tk[j] && cv[j] > bv) { bv = cv[j]; bi = lane + 64 * j; } }
    wave_argmax(bv, bi);
#pragma unroll
    for (int j = 0; j < 4; ++j) if (bi == lane + 64 * j) tk[j] = true;
    if (k == 0) mx = bv;
    if (lane == k) { topv = bv; topc = bi; }
  }
  float e = (lane < 16) ? expf(topv - mx) : 0.f;
  float sum = wave_sum(e);
  if (lane < 16) { eidx[(size_t)pair * 16 + lane] = i1s[w][topc >> 4] * 128 + i2s[w][topc & 15]; gate[(size_t)pair * 16 + lane] = e / sum; }
}

__global__ __launch_bounds__(256) void n_peer_apply(const float* __restrict__ h2, const int* __restrict__ eidx, const float* __restrict__ gate, const float* __restrict__ eu, const float* __restrict__ ev,
                                                    const float* __restrict__ g_post, const float* __restrict__ mod, int b, float* __restrict__ out) {
  __shared__ float ys[4][1024]; __shared__ float red[4];
  const int t = blockIdx.x, tid = threadIdx.x, w = tid >> 6, lane = tid & 63; const size_t tok = (size_t)b * SEQ + t;
  float4 hx[4];
#pragma unroll
  for (int i = 0; i < 4; ++i) hx[i] = *(const float4*)(h2 + (size_t)t * DM + (lane + 64 * i) * 4);
  float4 acc[4];
#pragma unroll
  for (int i = 0; i < 4; ++i) acc[i] = make_float4(0.f, 0.f, 0.f, 0.f);
  for (int k = w; k < 128; k += 4) {
    const int e = eidx[(size_t)t * 128 + k]; const float gt = gate[(size_t)t * 128 + k];
    const float4* ur = (const float4*)(eu + (size_t)e * DM); const float4* vr = (const float4*)(ev + (size_t)e * DM);
    float d = 0.f;
#pragma unroll
    for (int i = 0; i < 4; ++i) { float4 u = ur[lane + 64 * i]; d += u.x * hx[i].x + u.y * hx[i].y + u.z * hx[i].z + u.w * hx[i].w; }
    d = wave_sum(d);
    const float wgt = gt * gelu_erf(d);
#pragma unroll
    for (int i = 0; i < 4; ++i) { float4 v = vr[lane + 64 * i]; acc[i].x += wgt * v.x; acc[i].y += wgt * v.y; acc[i].z += wgt * v.z; acc[i].w += wgt * v.w; }
  }
#pragma unroll
  for (int i = 0; i < 4; ++i) *(float4*)(&ys[w][(lane + 64 * i) * 4]) = acc[i];
  __syncthreads();
  float yv[4]; float ss = 0.f;
#pragma unroll
  for (int i = 0; i < 4; ++i) { int d = tid + 256 * i; yv[i] = ys[0][d] + ys[1][d] + ys[2][d] + ys[3][d]; ss += yv[i] * yv[i]; }
  ss = block_sum256(ss, red);
  const float rs = rsqrtf(ss * (1.f / DM) + EPS);
#pragma unroll
  for (int i = 0; i < 4; ++i) { int d = tid + 256 * i; out[tok * DM + d] = out[tok * DM + d] + mod[b * 6144 + 5120 + d] * (yv[i] * rs * g_post[d]); }
}

typedef short bf16x8 __attribute__((ext_vector_type(8)));
typedef float f32x16 __attribute__((ext_vector_type(16)));
#define MFMA32(a, b, c) __builtin_amdgcn_mfma_f32_32x32x16_bf16((a), (b), (c), 0, 0, 0)

constexpr int NTHR = 512;
constexpr size_t MiB = 1024 * 1024;
constexpr size_t WS_MOD   = 0;
constexpr size_t WS_WTIN  = 256 * 1024;
constexpr size_t WS_WTQUP = WS_WTIN + (size_t)2304 * 1024 * 2;
constexpr size_t WS_WTKVUP = WS_WTQUP + (size_t)768 * 384 * 2;
constexpr size_t WS_WTOUT = WS_WTKVUP + (size_t)1024 * 256 * 2;
constexpr size_t WS_WTPQ  = WS_WTOUT + (size_t)1024 * 1024 * 2;
constexpr size_t WS_KD    = WS_WTPQ + (size_t)2048 * 1024 * 2;
constexpr size_t WS_DEC   = WS_KD + (size_t)256 * 256 * 2;
constexpr size_t WS_ESC   = WS_DEC + (size_t)2048 * 64 * 4;
constexpr size_t WS_R0END = WS_ESC + (size_t)2 * 16384 * 4;
static_assert(WS_R0END <= 13 * MiB, "R0");
constexpr size_t WS_BAR  = 13 * MiB - 65536;
static_assert(WS_R0END + 131072 <= WS_BAR, "R0 room");
constexpr size_t WS_QM   = 13 * MiB;
constexpr size_t WS_KM   = WS_QM + 24 * MiB;
constexpr size_t WS_VM   = WS_KM + 24 * MiB;
constexpr size_t WS_P1S  = WS_VM + 16 * MiB;
constexpr size_t WS_RG   = WS_P1S + 32 * MiB;
constexpr size_t WS_OINTRA = WS_RG + 16 * MiB;
constexpr size_t WS_QDEC = WS_OINTRA + 16 * MiB;
constexpr size_t WS_SPT  = WS_QDEC + 16 * MiB;
constexpr size_t WS_EU   = WS_SPT + 32 * MiB;
constexpr size_t WS_EV   = WS_EU + 16 * MiB;
constexpr size_t WS_WTPQP = WS_EV + 16 * MiB;
constexpr size_t WS_WTOUTP = WS_WTPQP + 4 * MiB;
constexpr size_t WS_WTINP = WS_WTOUTP + 2 * MiB;
constexpr size_t WS_PROJC = WS_WTINP + 4608 * 1024;
constexpr size_t WS_END  = WS_PROJC + 8 * MiB;
static_assert(WS_P1S == WS_QM + 64 * MiB, "P3 QRY scratch aliases QM..VM");
constexpr size_t OUT_HS  = 0;
constexpr size_t OUT_CQ  = 32 * MiB;
constexpr size_t OUT_GR  = 52 * MiB;

struct KP { const float* in[25]; float* out; unsigned char* ws; int ph_lo, ph_hi; };

constexpr int G_STG = 40960;
constexpr int LDS_WT = 3 * G_STG;
constexpr int LDS_TAB = LDS_WT + 18432;
constexpr int LDS_XB = 157696;
constexpr int LDS_TOTAL = 157696 + 16;

typedef float f32x2_t __attribute__((ext_vector_type(2)));
typedef __bf16 bf16x2_t __attribute__((ext_vector_type(2)));
DI unsigned pack2(float lo, float hi) { const f32x2_t v = {lo, hi}; return __builtin_bit_cast(unsigned, __builtin_convertvector(v, bf16x2_t)); }
DI int crow(int reg, int hh) { return (reg & 3) + 8 * (reg >> 2) + 4 * hh; }

#define GLDS16(gp, lp) __builtin_amdgcn_global_load_lds((const unsigned*)(gp), (__attribute__((address_space(3))) unsigned*)(lp), 16, 0, 0)
template <int NST, class Epi>
DI void block_gemm(char* lds, const bf16_t* A, int lda, const bf16_t* Bt, int nchunks, int K, Epi&& epi) {
  const int tid = threadIdx.x, lane = tid & 63, w = __builtin_amdgcn_readfirstlane(tid >> 6), r = lane & 31, hh = lane >> 5;
  const int nk = K >> 6, T = nchunks * nk;
  constexpr int D = NST - 1;
  if (w >= 4) {
    const int j = w - 4, rin = lane >> 3, sw = ((lane & 7) ^ rin) * 8;
    const bf16_t* Ap = A + (size_t)(16 * j + rin) * lda + sw;
    const bf16_t* Bp = Bt + (size_t)(64 * j + rin) * 64 + sw;
    auto dma = [&](int g) {
      const int ch = g / nk, t = g - ch * nk; char* st = lds + (g % NST) * G_STG;
      const bf16_t* a0 = Ap + t * 64; char* la = st + (2 * j) * 1024;
      GLDS16(a0, la); GLDS16(a0 + (size_t)8 * lda, la + 1024);
      const bf16_t* b0 = Bp + (size_t)g * 16384; char* lb = st + 8192 + (8 * j) * 1024;
#pragma unroll
      for (int i = 0; i < 8; ++i) GLDS16(b0 + i * 512, lb + i * 1024);
    };
#pragma unroll
    for (int g = 0; g < D; ++g) if (g < T) dma(g);
    if (D >= 2 && T >= 2) asm volatile("s_waitcnt vmcnt(10)" ::: "memory"); else asm volatile("s_waitcnt vmcnt(0)" ::: "memory");
    __builtin_amdgcn_s_barrier();
#pragma unroll 1
    for (int g = 0; g < T; ++g) {
      if (g + D < T) { dma(g + D); if (D >= 2) asm volatile("s_waitcnt vmcnt(10)" ::: "memory"); else asm volatile("s_waitcnt vmcnt(0)" ::: "memory"); }
      else asm volatile("s_waitcnt vmcnt(0)" ::: "memory");
      __builtin_amdgcn_s_barrier();
    }
  } else {
    const int x = r & 7;
    const int o0 = ((0 + hh) ^ x) * 16, o1 = ((2 + hh) ^ x) * 16, o2 = ((4 + hh) ^ x) * 16, o3 = ((6 + hh) ^ x) * 16;
    const int a_rd = r * 128, b_rd = 8192 + (w * 64 + r) * 128;
    __builtin_amdgcn_s_barrier();
    int g = 0;
#pragma unroll 1
    for (int ch = 0; ch < nchunks; ++ch) {
      f32x16 c00, c01, c10, c11;
#pragma unroll
      for (int i = 0; i < 16; ++i) { c00[i] = 0.f; c01[i] = 0.f; c10[i] = 0.f; c11[i] = 0.f; }
#pragma unroll 1
      for (int t = 0; t < nk; ++t, ++g) {
        const char* cur = lds + (g % NST) * G_STG;
        bf16x8 fa0[4], fa1[4], fb0[4], fb1[4];
#define FRD(s_, o_) do { fa0[s_] = *(const bf16x8*)(cur + a_rd + o_); fb0[s_] = *(const bf16x8*)(cur + b_rd + o_); fb1[s_] = *(const bf16x8*)(cur + b_rd + 4096 + o_); fa1[s_] = *(const bf16x8*)(cur + a_rd + 4096 + o_); } while (0)
        FRD(0, o0); FRD(1, o1); FRD(2, o2); FRD(3, o3);
#undef FRD
        asm volatile("s_waitcnt lgkmcnt(0)" ::: "memory");
        __builtin_amdgcn_s_barrier();
        __builtin_amdgcn_sched_barrier(0);
#pragma unroll
        for (int s = 0; s < 4; ++s) {
          c00 = MFMA32(fa0[s], fb0[s], c00); c01 = MFMA32(fa0[s], fb1[s], c01); c10 = MFMA32(fa1[s], fb0[s], c10); c11 = MFMA32(fa1[s], fb1[s], c11); }
      }
      epi(0, ch * 256 + w * 64, c00, c01);
      epi(32, ch * 256 + w * 64, c10, c11);
    }
  }
}

DI void p0_transpose(char* lds, const float* __restrict__ W, int K, int N, bf16_t* __restrict__ Wt, int item, bf16_t* __restrict__ Wplain = nullptr) {
  float* s = (float*)lds;
  const int tid = threadIdx.x;
  const int ntn = (N + 63) >> 6, kt = item / ntn, nt = item % ntn, k0 = kt * 64, n0 = nt * 64;
  __syncthreads();
#pragma unroll
  for (int i = 0; i < 8; ++i) { int e = tid + 512 * i; int kk = e >> 6, nn = e & 63; s[kk * 65 + nn] = (n0 + nn < N) ? W[(size_t)(k0 + kk) * N + n0 + nn] : 0.f; }
  __syncthreads();
  const int nn = tid >> 3, part = tid & 7;
  const float* sp = s + (part * 8) * 65 + nn;
  uint4 o; o.x = pack2(sp[0], sp[65]); o.y = pack2(sp[2 * 65], sp[3 * 65]); o.z = pack2(sp[4 * 65], sp[5 * 65]); o.w = pack2(sp[6 * 65], sp[7 * 65]);
  { const int n = n0 + nn; *(uint4*)(Wt + ((size_t)((n >> 8) * (K >> 6) + kt)) * 16384 + (n & 255) * 64 + part * 8) = o; }
  if (Wplain) *(uint4*)(Wplain + (size_t)(n0 + nn) * K + k0 + part * 8) = o;
}

DI void phase0(const KP& p, char* lds) {
  const int tid = threadIdx.x, bid = blockIdx.x, nb = gridDim.x;
  unsigned char* ws = p.ws;
  constexpr int I_IN = 16 * 36, I_QUP = 6 * 12, I_KVUP = 4 * 16, I_OUT = 16 * 16, I_PQ = 16 * 32;
  constexpr int I_ALL = I_IN + I_QUP + I_KVUP + I_OUT + I_PQ;
  for (int it = bid; it < I_ALL; it += nb) {
    int q = it;
    if (q < I_IN) { p0_transpose(lds, p.in[7], 1024, 2272, (bf16_t*)(ws + WS_WTIN), q, (bf16_t*)(ws + WS_WTINP)); continue; } q -= I_IN;
    if (q < I_QUP) { p0_transpose(lds, p.in[9], 384, 768, (bf16_t*)(ws + WS_WTQUP), q); continue; } q -= I_QUP;
    if (q < I_KVUP) { p0_transpose(lds, p.in[11], 256, 1024, (bf16_t*)(ws + WS_WTKVUP), q); continue; } q -= I_KVUP;
    if (q < I_OUT) { p0_transpose(lds, p.in[17], 1024, 1024, (bf16_t*)(ws + WS_WTOUT), q, (bf16_t*)(ws + WS_WTOUTP)); continue; } q -= I_OUT;
    p0_transpose(lds, p.in[20], 1024, 2048, (bf16_t*)(ws + WS_WTPQ), q, (bf16_t*)(ws + WS_WTPQP));
  }
  { bf16_t* kd = (bf16_t*)(ws + WS_KD);
    for (int e = bid * NTHR + tid; e < 65536; e += nb * NTHR) { int n = e >> 8, k = e & 255; float v = 0.f;
      if (n < 128 && k < 128) v = p.in[21][n * 128 + k]; else if (n >= 128 && k >= 128) v = p.in[22][(n - 128) * 128 + (k - 128)];
      kd[(size_t)(k >> 6) * 16384 + n * 64 + (k & 63)] = f2bf(v); } }
  { const int lane = tid & 63; float* scl = (float*)(ws + WS_ESC);
    for (int row = bid * 8 + (tid >> 6); row < 32768; row += nb * 8) { const int t = row >> 14, e = row & 16383;
      const float* src = p.in[23 + t] + (size_t)e * 1024 + lane * 16;
      float4 x[4]; float am = 0.f;
#pragma unroll
      for (int i = 0; i < 4; ++i) { x[i] = *(const float4*)(src + 4 * i); am = fmaxf(am, fmaxf(fmaxf(fabsf(x[i].x), fabsf(x[i].y)), fmaxf(fabsf(x[i].z), fabsf(x[i].w)))); }
      am = wave_max(am);
      float sc = 1.f, isc = 1.f;
      if (am > 0.f) { int ex; (void)frexpf(448.f / am, &ex); sc = ldexpf(1.f, ex - 1); isc = ldexpf(1.f, 1 - ex); }
      unsigned wv[4];
#pragma unroll
      for (int i = 0; i < 4; ++i) { int q = __builtin_amdgcn_cvt_pk_fp8_f32(x[i].x * sc, x[i].y * sc, 0, false); q = __builtin_amdgcn_cvt_pk_fp8_f32(x[i].z * sc, x[i].w * sc, q, true); wv[i] = (unsigned)q; }
      *(uint4*)(ws + (t ? WS_EV : WS_EU) + (size_t)e * 1024 + lane * 16) = make_uint4(wv[0], wv[1], wv[2], wv[3]);
      if (lane == 0) scl[t * 16384 + e] = isc; } }
  for (int jb = bid; jb < 96; jb += nb) {
    __syncthreads();
    float* cact = (float*)lds;
    float* red = (float*)(lds + 32768);
    for (int e = tid; e < 8192; e += NTHR) cact[e] = silu_f(p.in[1][e]);
    __syncthreads();
    const int jj = tid & 63, ks = tid >> 6, j0 = jb * 64;
    float acc[8];
#pragma unroll
    for (int b = 0; b < 8; ++b) acc[b] = 0.f;
    const float* wp = p.in[3] + (size_t)(ks * 128) * 6144 + j0 + jj;
    for (int k = 0; k < 128; ++k) { const float wv = wp[(size_t)k * 6144];
#pragma unroll
      for (int b = 0; b < 8; ++b) acc[b] += cact[b * 1024 + ks * 128 + k] * wv; }
#pragma unroll
    for (int b = 0; b < 8; ++b) red[(ks * 64 + jj) * 8 + b] = acc[b];
    __syncthreads();
    { const int b = tid >> 6; float sacc = p.in[4][j0 + jj];
#pragma unroll
      for (int k2 = 0; k2 < 8; ++k2) sacc += red[(k2 * 64 + jj) * 8 + b];
      ((float*)(ws + WS_MOD))[b * 6144 + j0 + jj] = sacc; }
  }
}

constexpr int WT_STRIDE = 144, WT_BYTES = 32 * WT_STRIDE;
DI void wt_write(char* wl, const f32x16& a0, const f32x16& a1, int r, int hh, float scale) {
  char* bp = wl + (4 * hh) * WT_STRIDE + r * 2;
#pragma unroll
  for (int reg = 0; reg < 16; ++reg) { const int ro = ((reg & 3) + 8 * (reg >> 2)) * WT_STRIDE;
    *(bf16_t*)(bp + ro) = f2bf(a0[reg] * scale); *(bf16_t*)(bp + ro + 64) = f2bf(a1[reg] * scale); }
}
DI void wt_write_rope(char* wl, const f32x16& a0, const f32x16& a1, int r, int hh, const float* cs, const float* sn, int m0) {
  char* bp = wl + (4 * hh) * WT_STRIDE + r * 2;
#pragma unroll
  for (int reg = 0; reg < 16; ++reg) { const int rw = (reg & 3) + 8 * (reg >> 2); const int row = m0 + rw + 4 * hh;
    const float c = cs[row * 32 + r], s = sn[row * 32 + r];
    *(bf16_t*)(bp + rw * WT_STRIDE) = f2bf(a0[reg] * c - a1[reg] * s); *(bf16_t*)(bp + rw * WT_STRIDE + 64) = f2bf(a1[reg] * c + a0[reg] * s); }
}
DI void wt_store(const char* wl, int lane, bf16_t* dA, int sA, bf16_t* dB, int sB) {
  const int piece = lane & 7, rsub = lane >> 3;
  bf16_t* d = (piece < 4) ? dA : dB; const int st = (piece < 4) ? sA : sB;
  if (d) {
#pragma unroll
    for (int i = 0; i < 4; ++i) { const int row = i * 8 + rsub; const uint4 v = *(const uint4*)(wl + row * WT_STRIDE + piece * 16);
      *(uint4*)(d + (size_t)row * st + (piece & 3) * 8) = v; }
  }
}
#define LDS_FENCE() asm volatile("s_waitcnt lgkmcnt(0)" ::: "memory")
DI int lv(int x) { asm volatile("" : "+v"(x)); return x; }
template <class T> DI T* launder(T* q) { size_t z = 0; asm volatile("" : "+s"(z)); return (T*)((char*)q + z); }

constexpr int GL_GR = 0, GL_VT = 8192, GL_QD = 26624, GL_KI = 45056, GL_KIT = 63488, GL_ATT = 81920, GL_TOT = 91136, GL_DEC = 93184, GL_LA = 93696  , GL_QS = 126464  , GL_KS = 134656;
DI void gla_chunk_local(const KP& p, char* lds, unsigned char* ws, int tile, const bf16_t* PA, const bf16_t* PB) {
  const int tid = lv(threadIdx.x), lane = tid & 63, w = tid >> 6, r = lane & 31, hh = lane >> 5;
  const int b = tile >> 5, n = tile & 31, tok0 = tile * 64;
  float* GRL = (float*)(lds + GL_GR); float* TOT = (float*)(lds + GL_TOT); float* DECL = (float*)(lds + GL_DEC);
  __syncthreads();
#pragma unroll
  for (int i = 0; i < 4; ++i) { const int e = tid + 512 * i; GRL[e] = bf2f(PB[(size_t)(e >> 5) * 1024 + (O_GF - 1024) + (e & 31)]); }
#pragma unroll 1
  for (int h = 0; h < 4; ++h) {
    __syncthreads();
    { const int t = tid >> 3, c8 = (tid & 7) * 8;
      *(uint4*)(lds + GL_QS + (t * 64 + c8) * 2) = *(const uint4*)(PA + (size_t)t * 1024 + O_QG + h * 64 + c8);
      *(uint4*)(lds + GL_KS + (t * 64 + c8) * 2) = (h == 0) ? *(const uint4*)(PA + (size_t)t * 1024 + O_KG + c8) : *(const uint4*)(PB + (size_t)t * 1024 + (O_KG - 1024) + h * 64 + c8); }
#pragma unroll
    for (int i = 0; i < 2; ++i) { const int c = tid + 512 * i, t = c >> 4, d8 = (c & 15) * 8;
      const uint4 v = *(const uint4*)(PB + (size_t)t * 1024 + (O_VG - 1024) + h * 128 + d8);
      bf16_t* vt = (bf16_t*)(lds + GL_VT) + d8 * 72 + t;
      vt[0] = (bf16_t)(v.x & 0xffffu); vt[72] = (bf16_t)(v.x >> 16); vt[144] = (bf16_t)(v.y & 0xffffu); vt[216] = (bf16_t)(v.y >> 16);
      vt[288] = (bf16_t)(v.z & 0xffffu); vt[360] = (bf16_t)(v.z >> 16); vt[432] = (bf16_t)(v.w & 0xffffu); vt[504] = (bf16_t)(v.w >> 16); }
    const int dir = tid >> 8, qt = (tid >> 6) & 3, dk = tid & 63, col = h * 64 + dk;
    float* LAL = (float*)(lds + GL_LA) + tid;
    {
      const float* wg = launder(dir ? p.in[14] : p.in[12]); const float* bg = launder(dir ? p.in[15] : p.in[13]);
      float wr[16];
#pragma unroll
      for (int q = 0; q < 16; ++q) wr[q] = wg[q * 256 + col];
      const float bias = bg[col];
      float run = 0.f;
#pragma unroll 2
      for (int ii = 0; ii < 16; ++ii) { const int i = dir ? 15 - ii : ii;
        const float* gp = GRL + (qt * 16 + i) * 32 + dir * 16; float x = bias;
#pragma unroll
        for (int q = 0; q < 16; ++q) x += gp[q] * wr[q];
        run += logsigmoid_fast(x) * (1.f / 16.f); LAL[i * 512] = run; }
      TOT[(dir * 64 + dk) * 4 + qt] = run;
    }
    __syncthreads();
    {
      const float4 tq = *(const float4*)(TOT + (dir * 64 + dk) * 4);
      const float total = (tq.x + tq.y) + (tq.z + tq.w);
      float off;
      if (dir == 0) off = (qt > 0 ? tq.x : 0.f) + (qt > 1 ? tq.y : 0.f) + (qt > 2 ? tq.z : 0.f);
      else          off = (qt < 1 ? tq.y : 0.f) + (qt < 2 ? tq.z : 0.f) + (qt < 3 ? tq.w : 0.f);
      if (qt == 0) { const float dc = fexp(total); DECL[dir * 64 + dk] = dc; ((float*)(ws + WS_DEC))[((size_t)((b * 4 + h) * 2 + dir) * 32 + n) * 64 + dk] = dc; }
      bf16_t* QD = (bf16_t*)(lds + GL_QD + dir * 9216) + (qt * 16) * 72 + dk; bf16_t* KI = (bf16_t*)(lds + GL_KI + dir * 9216) + (qt * 16) * 72 + dk;
      bf16_t* KIT = (bf16_t*)(lds + GL_KIT + dir * 9216) + dk * 72 + qt * 16;
      bf16_t* qdg = (bf16_t*)(ws + WS_QDEC) + (size_t)((tile * 4 + h) * 2 + dir) * 4096 + (qt * 16) * 64 + dk;
      const bf16_t* qgp = (const bf16_t*)(lds + GL_QS) + (qt * 16) * 64 + dk; const bf16_t* kgp = (const bf16_t*)(lds + GL_KS) + (qt * 16) * 64 + dk;
#pragma unroll 2
      for (int i = 0; i < 16; ++i) { const float bb = off + LAL[i * 512];
        const float qv = bf2f(qgp[i * 64]) * 0.125f, kv = bf2f(kgp[i * 64]);
        const float eb = fexp(bb); const bf16_t qd = f2bf(qv * eb), ki = f2bf(kv * __builtin_amdgcn_rcpf(eb));
        QD[i * 72] = qd; KI[i * 72] = ki; qdg[i * 64] = qd; KIT[i] = ki; }
    }
    __syncthreads();
    if (w < 4) { const int mi = w >> 1, ni = w & 1;
      f32x16 asum;
#pragma unroll
      for (int i = 0; i < 16; ++i) asum[i] = 0.f;
#pragma unroll
      for (int d = 0; d < 2; ++d) { f32x16 acc;
#pragma unroll
        for (int i = 0; i < 16; ++i) acc[i] = 0.f;
#pragma unroll
        for (int s = 0; s < 4; ++s) { const bf16x8 a = *(const bf16x8*)(lds + GL_QD + d * 9216 + (mi * 32 + r) * 144 + s * 32 + hh * 16);
          const bf16x8 bb = *(const bf16x8*)(lds + GL_KI + d * 9216 + (ni * 32 + r) * 144 + s * 32 + hh * 16); acc = MFMA32(a, bb, acc); }
#pragma unroll
        for (int reg = 0; reg < 16; ++reg) { const int ti = mi * 32 + crow(reg, hh), tj = ni * 32 + r; const bool keep = d ? (tj >= ti) : (tj <= ti); asum[reg] += keep ? acc[reg] : 0.f; } }
      bf16_t* at = (bf16_t*)(lds + GL_ATT) + (mi * 32 + 4 * hh) * 72 + ni * 32 + r;
#pragma unroll
      for (int reg = 0; reg < 16; ++reg) at[((reg & 3) + 8 * (reg >> 2)) * 72] = f2bf(asum[reg]);
    }
    __syncthreads();
    { const int mi = w >> 2, ni = w & 3; f32x16 acc;
#pragma unroll
      for (int i = 0; i < 16; ++i) acc[i] = 0.f;
#pragma unroll
      for (int s = 0; s < 4; ++s) { const bf16x8 a = *(const bf16x8*)(lds + GL_ATT + (mi * 32 + r) * 144 + s * 32 + hh * 16);
        const bf16x8 bb = *(const bf16x8*)(lds + GL_VT + (ni * 32 + r) * 144 + s * 32 + hh * 16); acc = MFMA32(a, bb, acc); }
      bf16_t* oi = (bf16_t*)(ws + WS_OINTRA) + (size_t)(tok0 + mi * 32 + 4 * hh) * 512 + h * 128 + ni * 32 + r;
#pragma unroll
      for (int reg = 0; reg < 16; ++reg) oi[(size_t)((reg & 3) + 8 * (reg >> 2)) * 512] = f2bf(acc[reg]); }
    { const int dvb = w >> 1, dkb = w & 1;
#pragma unroll
      for (int d = 0; d < 2; ++d) { f32x16 acc;
#pragma unroll
        for (int i = 0; i < 16; ++i) acc[i] = 0.f;
#pragma unroll
        for (int s = 0; s < 4; ++s) { const bf16x8 a = *(const bf16x8*)(lds + GL_VT + (dvb * 32 + r) * 144 + s * 32 + hh * 16);
          const bf16x8 bb = *(const bf16x8*)(lds + GL_KIT + d * 9216 + (dkb * 32 + r) * 144 + s * 32 + hh * 16); acc = MFMA32(a, bb, acc); }
        const float sc = DECL[d * 64 + dkb * 32 + r];
        bf16_t* ds = (bf16_t*)(ws + WS_SPT) + ((size_t)((b * 4 + h) * 2 + d) * 32 + n) * 8192 + (size_t)(dvb * 32 + 4 * hh) * 64 + dkb * 32 + r;
#pragma unroll
        for (int reg = 0; reg < 16; ++reg) ds[((reg & 3) + 8 * (reg >> 2)) * 64] = f2bf(acc[reg] * sc); } }
  }
}

DI void phase1a(const KP& p, char* lds) {
  const int tid = threadIdx.x, lane = tid & 63, w = tid >> 6;
  for (int tile = blockIdx.x; tile < 256; tile += gridDim.x) {
    unsigned char* ws = launder(p.ws); unsigned char* ob = (unsigned char*)launder(p.out); const float* xin = launder(p.in[0]);
    const float* mod = (const float*)(ws + WS_MOD);
    const int tok0 = tile * 64, b = tile >> 5;
    bf16_t* Hs = (bf16_t*)(ob + OUT_HS) + (size_t)tok0 * 1024;
    float4 ge[4], sh[4];
    const float* gpre = launder(p.in[5]); const float* modb = launder(mod) + b * 6144;
#pragma unroll
    for (int i = 0; i < 4; ++i) { const int d = (lane + 64 * i) * 4;
      const float4 g = *(const float4*)(gpre + d); const float4 sc = *(const float4*)(modb + 1024 + d); sh[i] = *(const float4*)(modb + d);
      ge[i] = make_float4(g.x * (1.f + sc.x), g.y * (1.f + sc.y), g.z * (1.f + sc.z), g.w * (1.f + sc.w)); }
#pragma unroll 2
    for (int rr = 0; rr < 8; ++rr) { const int row = w * 8 + rr;
      const float* xr = xin + (size_t)(tok0 + row) * 1024;
      float4 v[4]; float ss = 0.f;
#pragma unroll
      for (int i = 0; i < 4; ++i) { v[i] = *(const float4*)(xr + (lane + 64 * i) * 4); ss += v[i].x * v[i].x + v[i].y * v[i].y + v[i].z * v[i].z + v[i].w * v[i].w; }
      ss = wave_sum(ss); const float rs = rsqrtf(ss * (1.f / 1024.f) + EPS);
#pragma unroll
      for (int i = 0; i < 4; ++i) { uint2 o; o.x = pack2(v[i].x * rs * ge[i].x + sh[i].x, v[i].y * rs * ge[i].y + sh[i].y); o.y = pack2(v[i].z * rs * ge[i].z + sh[i].z, v[i].w * rs * ge[i].w + sh[i].w);
        *(uint2*)(Hs + (size_t)row * 1024 + (lane + 64 * i) * 4) = o; }
    }
  }
}

DI void phase1c(const KP& p, char* lds) {
  const int tid = threadIdx.x, lane = tid & 63, w = tid >> 6, r = lane & 31, hh = lane >> 5;
  float* cs = (float*)(lds + LDS_TAB); float* sn = cs + 2048;
  char* wl = lds + LDS_WT + (w & 3) * WT_BYTES;
  for (int tile = blockIdx.x; tile < 256; tile += gridDim.x) {
    unsigned char* ws = launder(p.ws); unsigned char* ob = (unsigned char*)launder(p.out);
    const int tok0 = tile * 64, b = tile >> 5, t0 = (tile & 31) * 64;
    const bf16_t* PA = (const bf16_t*)(ws + WS_P1S) + (size_t)tok0 * 1024;
    const bf16_t* PB = (const bf16_t*)(ob + 32 * MiB) + (size_t)tok0 * 1024;
    const bf16_t* PC = (const bf16_t*)(ws + WS_PROJC) + (size_t)tok0 * 256;
    bf16_t* Hs = (bf16_t*)(ob + OUT_HS) + (size_t)tok0 * 1024;
    bf16_t* CQN = Hs; bf16_t* CKVN = Hs + 64 * 384;
    bf16_t* Qm = (bf16_t*)(ws + WS_QM); bf16_t* Km = (bf16_t*)(ws + WS_KM); bf16_t* Vm = (bf16_t*)(ws + WS_VM);
    bf16_t* rg = (bf16_t*)(ws + WS_RG) + (size_t)tok0 * 512;
    __syncthreads();
#pragma unroll
    for (int i = 0; i < 4; ++i) { const int e = tid + 512 * i, tt = e >> 5, j = e & 31;
      const float inv = __builtin_amdgcn_exp2f(-(float)j * (13.287712379549449f / 32.f)); const float ang = (float)((const int*)p.in[2])[tok0 + tt] * inv;
      float rev = ang * 0.15915494309189535f; rev -= floorf(rev);
      cs[e] = __builtin_amdgcn_cosf(rev); sn[e] = __builtin_amdgcn_sinf(rev); }
#pragma unroll
    for (int i = 0; i < 8; ++i) { const int c = tid + 512 * i, row = c >> 6, cc = c & 63;
      const uint4 v = (cc < 36) ? *(const uint4*)(PB + (size_t)row * 1024 + (O_R - 1024) + cc * 8) : *(const uint4*)(PC + (size_t)row * 256 + (cc - 36) * 8);
      *(uint4*)(rg + (size_t)row * 512 + cc * 8) = v; }
    __syncthreads();
    if (tid < 256) { const int row = tid >> 2, pc = tid & 3;
      const uint4 x1 = *(const uint4*)(PA + (size_t)row * 1024 + O_KR + pc * 8), x2 = *(const uint4*)(PA + (size_t)row * 1024 + O_KR + 32 + pc * 8);
      const float4 c0 = *(const float4*)(cs + row * 32 + pc * 8), c1 = *(const float4*)(cs + row * 32 + pc * 8 + 4), s0 = *(const float4*)(sn + row * 32 + pc * 8), s1 = *(const float4*)(sn + row * 32 + pc * 8 + 4);
#define RO1(a_, b_, c_, s_) ((a_) * (c_) - (b_) * (s_))
#define RO2(a_, b_, c_, s_) ((b_) * (c_) + (a_) * (s_))
#define LO(u_) __uint_as_float((u_) << 16)
#define HI(u_) __uint_as_float((u_) & 0xffff0000u)
      uint4 o1, o2;
      o1.x = pack2(RO1(LO(x1.x), LO(x2.x), c0.x, s0.x), RO1(HI(x1.x), HI(x2.x), c0.y, s0.y)); o1.y = pack2(RO1(LO(x1.y), LO(x2.y), c0.z, s0.z), RO1(HI(x1.y), HI(x2.y), c0.w, s0.w));
      o1.z = pack2(RO1(LO(x1.z), LO(x2.z), c1.x, s1.x), RO1(HI(x1.z), HI(x2.z), c1.y, s1.y)); o1.w = pack2(RO1(LO(x1.w), LO(x2.w), c1.z, s1.z), RO1(HI(x1.w), HI(x2.w), c1.w, s1.w));
      o2.x = pack2(RO2(LO(x1.x), LO(x2.x), c0.x, s0.x), RO2(HI(x1.x), HI(x2.x), c0.y, s0.y)); o2.y = pack2(RO2(LO(x1.y), LO(x2.y), c0.z, s0.z), RO2(HI(x1.y), HI(x2.y), c0.w, s0.w));
      o2.z = pack2(RO2(LO(x1.z), LO(x2.z), c1.x, s1.x), RO2(HI(x1.z), HI(x2.z), c1.y, s1.y)); o2.w = pack2(RO2(LO(x1.w), LO(x2.w), c1.z, s1.z), RO2(HI(x1.w), HI(x2.w), c1.w, s1.w));
#undef RO1
#undef RO2
#undef LO
#undef HI
#pragma unroll
      for (int h = 0; h < 4; ++h) { bf16_t* kp = Km + (((size_t)b * 4 + h) * SEQ + t0 + row) * 192 + 128 + pc * 8; *(uint4*)kp = o1; *(uint4*)(kp + 32) = o2; }
    }
    const float* gq = launder(p.in[8]); const float* gkv = launder(p.in[10]);
#pragma unroll 2
    for (int rr = 0; rr < 8; ++rr) { const int row = w * 8 + rr; const unsigned* cr = (const unsigned*)(PA + (size_t)row * 1024);
      float v0[5], v1[5];
#pragma unroll
      for (int i = 0; i < 5; ++i) { const unsigned u = cr[lane + 64 * i]; v0[i] = __uint_as_float(u << 16); v1[i] = __uint_as_float(u & 0xffff0000u); }
      float ss = v0[0] * v0[0] + v1[0] * v1[0] + v0[1] * v0[1] + v1[1] * v1[1] + v0[2] * v0[2] + v1[2] * v1[2];
      float s2 = v0[3] * v0[3] + v1[3] * v1[3] + v0[4] * v0[4] + v1[4] * v1[4];
      ss = wave_sum(ss); s2 = wave_sum(s2);
      const float rq = rsqrtf(ss * (1.f / 384.f) + EPS), rk = rsqrtf(s2 * (1.f / 256.f) + EPS);
#pragma unroll
      for (int i = 0; i < 3; ++i) { const int c = 2 * (lane + 64 * i); *(unsigned*)(CQN + (size_t)row * 384 + c) = pack2(v0[i] * rq * gq[c], v1[i] * rq * gq[c + 1]); }
#pragma unroll
      for (int i = 3; i < 5; ++i) { const int c = 2 * (lane + 64 * (i - 3)); *(unsigned*)(CKVN + (size_t)row * 256 + c) = pack2(v0[i] * rk * gkv[c], v1[i] * rk * gkv[c + 1]); }
    }
    __syncthreads();
    block_gemm<3>(lds, CQN, 384, (const bf16_t*)(ws + WS_WTQUP), 3, 384, [&](int m0, int n0, const f32x16& a0, const f32x16& a1) {
      const int r2 = lv(r), h2 = lv(hh), ln = lv(lane);
      const int h = n0 / 192, d0 = n0 % 192;
      bf16_t* qp = Qm + (((size_t)b * 4 + h) * SEQ + t0 + m0) * 192 + d0;
      if (d0 < 128) wt_write(wl, a0, a1, r2, h2, 1.f); else wt_write_rope(wl, a0, a1, r2, h2, cs, sn, m0);
      LDS_FENCE();
      wt_store(wl, ln, qp, 192, qp + 32, 192);
    });
    block_gemm<3>(lds, CKVN, 256, (const bf16_t*)(ws + WS_WTKVUP), 4, 256, [&](int m0, int n0, const f32x16& a0, const f32x16& a1) {
      const int r2 = lv(r), h2 = lv(hh), ln = lv(lane);
      const int h = n0 >> 8, d0 = n0 & 255;
      wt_write(wl, a0, a1, r2, h2, 1.f); LDS_FENCE();
      if (d0 < 128) { bf16_t* kp = Km + (((size_t)b * 4 + h) * SEQ + t0 + m0) * 192 + d0; wt_store(wl, ln, kp, 192, kp + 32, 192); }
      else { bf16_t* vp = Vm + (((size_t)b * 4 + h) * SEQ + t0 + m0) * 128 + (d0 - 128); wt_store(wl, ln, vp, 128, vp + 32, 128); }
    });
    gla_chunk_local(p, lds, ws, tile, PA, PB);
  }
}

namespace att {
typedef short s16x4 __attribute__((ext_vector_type(4)));
typedef unsigned u32x4 __attribute__((ext_vector_type(4)));
constexpr int DQ = 192, DV = 128, KVBLK = 64;
constexpr float SCALE = 0.07216878364870322f;
constexpr float THR = 8.f;
constexpr int SHM_V = KVBLK * DV * 2, SHM_K = KVBLK * DQ * 2;
constexpr int SHM_QR = 8 * 32 * 176;
constexpr int SHM_ATTN = 2 * SHM_V + 2 * SHM_K + 8 * 64 * 4 + SHM_QR;
#define KSWZ(row, colB) ((row) * 384 + ((colB) ^ (((row) & 7) << 4)))
#define SBAR() __builtin_amdgcn_sched_barrier(0)
DI unsigned cvtpk(float lo, float hi) { unsigned r; asm volatile("v_cvt_pk_bf16_f32 %0, %1, %2" : "=v"(r) : "v"(lo), "v"(hi)); return r; }

DI void partialSM(f32x16& p0, f32x16& p1, float& m_reg, float& mn, float& alpha) {
  constexpr float C = SCALE * 1.4426950408889634f;
  float pmax = p0[0];
#pragma unroll
  for (int r = 1; r < 16; ++r) pmax = fmaxf(pmax, p0[r]);
#pragma unroll
  for (int r = 0; r < 16; ++r) pmax = fmaxf(pmax, p1[r]);
  { auto rr = __builtin_amdgcn_permlane32_swap(__float_as_uint(pmax), __float_as_uint(pmax), false, false);
    pmax = fmaxf(__uint_as_float(rr[0]), __uint_as_float(rr[1])); }
  if (__builtin_expect(__all(pmax - m_reg <= THR / SCALE), 1)) { mn = m_reg; alpha = 1.f; }
  else { mn = fmaxf(m_reg, pmax); alpha = __builtin_amdgcn_exp2f((m_reg - mn) * C); m_reg = mn; }
  const float mnC = -mn * C;
#pragma unroll
  for (int r = 0; r < 16; ++r) p0[r] = fmaf(p0[r], C, mnC);
#pragma unroll
  for (int r = 0; r < 16; ++r) p1[r] = fmaf(p1[r], C, mnC);
#pragma unroll
  for (int r = 0; r < 16; ++r) p0[r] = __builtin_amdgcn_exp2f(p0[r]);
}
DI void finishSM(f32x16& p0, f32x16& p1, float alpha, float& l_reg, bf16x8& pa0, bf16x8& pa1, bf16x8& pa2, bf16x8& pa3) {
#pragma unroll
  for (int r = 0; r < 16; ++r) p1[r] = __builtin_amdgcn_exp2f(p1[r]);
  float ps = 0;
#pragma unroll
  for (int r = 0; r < 16; ++r) ps += p0[r];
#pragma unroll
  for (int r = 0; r < 16; ++r) ps += p1[r];
  { auto rr = __builtin_amdgcn_permlane32_swap(__float_as_uint(ps), __float_as_uint(ps), false, false);
    ps = __uint_as_float(rr[0]) + __uint_as_float(rr[1]); }
  l_reg = l_reg * alpha + ps;
#define PK4(P, BASE, OUT) do { unsigned a0 = cvtpk(P[BASE + 0], P[BASE + 1]), a1 = cvtpk(P[BASE + 2], P[BASE + 3]);   \
    unsigned b0 = cvtpk(P[BASE + 4], P[BASE + 5]), b1 = cvtpk(P[BASE + 6], P[BASE + 7]);                              \
    auto r0 = __builtin_amdgcn_permlane32_swap(a0, b0, false, false); auto r1 = __builtin_amdgcn_permlane32_swap(a1, b1, false, false); \
    u32x4 wv = {r0[0], r1[0], r0[1], r1[1]}; OUT = *reinterpret_cast<bf16x8*>(&wv); } while (0)
  PK4(p0, 0, pa0); PK4(p0, 8, pa1); PK4(p1, 0, pa2); PK4(p1, 8, pa3);
#undef PK4
}
DI void qkt(f32x16& p0, f32x16& p1, const char* Ks, const bf16x8* qr, const char* qrl, int r32, int hi) {
#pragma unroll
  for (int i = 0; i < 16; ++i) { p0[i] = 0.f; p1[i] = 0.f; }
#pragma unroll
  for (int d0 = 0; d0 < 12; ++d0) { const int cb = (d0 * 16 + hi * 8) * 2;
    const bf16x8 b0 = *reinterpret_cast<const bf16x8*>(Ks + KSWZ(r32, cb));
    const bf16x8 b1 = *reinterpret_cast<const bf16x8*>(Ks + KSWZ(32 + r32, cb));
    const bf16x8 q = (d0 < 7) ? qr[d0 < 7 ? d0 : 0] : *reinterpret_cast<const bf16x8*>(qrl + (d0 - 7) * 32);
    p0 = MFMA32(b0, q, p0);
    p1 = MFMA32(b1, q, p1); }
}
DI int v_st(int k, int c) { const int kk = (k & ~0xC) | ((k & 4) << 1) | ((k & 8) >> 1); return ((kk >> 3) * 4 + (c >> 5)) * 512 + ((kk & 7) * 32 + (c & 31)) * 2; }
DI int v_rd_base(int lane) { return ((lane & 3) << 3) | (((lane >> 2) & 3) << 6) | (((lane >> 4) & 1) << 5) | (((lane >> 5) & 1) << 8); }
constexpr int v_rd_off(int d0, int ks, int half) { return d0 * 512 + ks * 4096 + half * 2048; }
template <int OFF> DI s16x4 tr_read(int vb) { s16x4 r; asm volatile("ds_read_b64_tr_b16 %0, %1 offset:%2" : "=&v"(r) : "v"(vb), "i"(OFF) : "memory"); return r; }
template <int D0> DI void pv_one(f32x16& od, int vb, bf16x8 pa0, bf16x8 pa1, bf16x8 pa2, bf16x8 pa3) {
  const s16x4 l0 = tr_read<v_rd_off(D0, 0, 0)>(vb), h0 = tr_read<v_rd_off(D0, 0, 1)>(vb), l1 = tr_read<v_rd_off(D0, 1, 0)>(vb), h1 = tr_read<v_rd_off(D0, 1, 1)>(vb);
  const s16x4 l2 = tr_read<v_rd_off(D0, 2, 0)>(vb), h2 = tr_read<v_rd_off(D0, 2, 1)>(vb), l3 = tr_read<v_rd_off(D0, 3, 0)>(vb), h3 = tr_read<v_rd_off(D0, 3, 1)>(vb);
  asm volatile("s_waitcnt lgkmcnt(0)" ::: "memory"); SBAR();
#define PK(L, H) (bf16x8){L[0], L[1], L[2], L[3], H[0], H[1], H[2], H[3]}
  od = MFMA32(pa0, PK(l0, h0), od);
  od = MFMA32(pa1, PK(l1, h1), od);
  od = MFMA32(pa2, PK(l2, h2), od);
  od = MFMA32(pa3, PK(l3, h3), od);
#undef PK
}
DI void pv_d0(f32x16* o, int vb, bf16x8 pa0, bf16x8 pa1, bf16x8 pa2, bf16x8 pa3) {
  pv_one<0>(o[0], vb, pa0, pa1, pa2, pa3); pv_one<1>(o[1], vb, pa0, pa1, pa2, pa3); pv_one<2>(o[2], vb, pa0, pa1, pa2, pa3); pv_one<3>(o[3], vb, pa0, pa1, pa2, pa3);
}
DI void attn_unit(const bf16_t* Qb, const bf16_t* Kh, const bf16_t* Vh, bf16_t* Ob, int seq, char* lds) {
  const int tid = lv(threadIdx.x), wid = tid >> 6, lane = tid & 63, r32 = lane & 31, hi = lane >> 5;
  char* V_lds = lds; char* K_lds = lds + 2 * SHM_V;
  float* wsf = (float*)(lds + 2 * SHM_V + 2 * SHM_K) + wid * 64; float* li_l = wsf; float* al_l = wsf + 32;
  char* qrl = lds + 2 * SHM_V + 2 * SHM_K + 8 * 64 * 4 + wid * (32 * 176) + r32 * 176 + hi * 16;
  float m_reg = -1e30f, l_reg = 0; f32x16 o[4]; bf16x8 qr[7];
#pragma unroll
  for (int d = 0; d < 4; ++d)
#pragma unroll
    for (int i = 0; i < 16; ++i) o[d][i] = 0.f;
  const bf16_t* Qw = Qb + (size_t)(wid * 32 + r32) * DQ + hi * 8;
#pragma unroll
  for (int d0 = 0; d0 < 7; ++d0) qr[d0] = *reinterpret_cast<const bf16x8*>(Qw + d0 * 16);
#pragma unroll
  for (int d0 = 7; d0 < 12; ++d0) *reinterpret_cast<bf16x8*>(qrl + (d0 - 7) * 32) = *reinterpret_cast<const bf16x8*>(Qw + d0 * 16);
  int kst[3];
#pragma unroll
  for (int i = 0; i < 3; ++i) { const int c = tid + 512 * i; kst[i] = KSWZ(c / 24, (c % 24) * 16); }
  const int vst0 = v_st(tid >> 4, (tid & 15) * 8), vst1 = v_st(32 + (tid >> 4), (tid & 15) * 8);
  const int vb0 = (int)(uintptr_t)V_lds + v_rd_base(lane);
  bf16x8 sk0, sk1, sk2, sv0, sv1;
#define SLOAD(k0) do { const bf16x8* kp = reinterpret_cast<const bf16x8*>(Kh + (size_t)(k0) * DQ) + tid; sk0 = kp[0]; sk1 = kp[512]; sk2 = kp[1024]; \
    const bf16x8* vp = reinterpret_cast<const bf16x8*>(Vh + (size_t)(k0) * DV) + tid; sv0 = vp[0]; sv1 = vp[512]; } while (0)
#define SWRITE(b) do { *(bf16x8*)(V_lds + (b) * SHM_V + vst0) = sv0; *(bf16x8*)(V_lds + (b) * SHM_V + vst1) = sv1; \
    *(bf16x8*)(K_lds + (b) * SHM_K + kst[0]) = sk0; *(bf16x8*)(K_lds + (b) * SHM_K + kst[1]) = sk1; *(bf16x8*)(K_lds + (b) * SHM_K + kst[2]) = sk2; } while (0)
#define RESC(a) do { if (__any((a) < 1.f)) { if (hi == 0) al_l[r32] = (a); asm volatile("s_waitcnt lgkmcnt(0)" ::: "memory"); \
    _Pragma("unroll") for (int d = 0; d < 4; ++d) _Pragma("unroll") for (int r = 0; r < 16; ++r) o[d][r] *= al_l[crow(r, hi)]; } } while (0)
  f32x16 pA0, pA1, pB0, pB1; float mnA, mnB, alA, alB; bf16x8 pa0, pa1, pa2, pa3; const int NT = seq / KVBLK;
  SLOAD(0); SWRITE(0); __syncthreads();
  qkt(pA0, pA1, K_lds, qr, qrl, r32, hi); partialSM(pA0, pA1, m_reg, mnA, alA);
  SLOAD(KVBLK); SWRITE(1); __syncthreads();
  for (int j = 1; j + 1 < NT; j += 2) {
    SBAR(); qkt(pB0, pB1, K_lds + SHM_K, qr, qrl, r32, hi);
    finishSM(pA0, pA1, alA, l_reg, pa0, pa1, pa2, pa3); SBAR();
    SLOAD((j + 1) * KVBLK); SBAR();
    pv_d0(o, vb0, pa0, pa1, pa2, pa3); partialSM(pB0, pB1, m_reg, mnB, alB);
    __syncthreads(); SWRITE(0);
    RESC(alB); __syncthreads();
    SBAR(); qkt(pA0, pA1, K_lds, qr, qrl, r32, hi);
    finishSM(pB0, pB1, alB, l_reg, pa0, pa1, pa2, pa3); SBAR();
    SLOAD((j + 2) * KVBLK); SBAR();
    pv_d0(o, vb0 + SHM_V, pa0, pa1, pa2, pa3); partialSM(pA0, pA1, m_reg, mnA, alA);
    __syncthreads(); SWRITE(1);
    RESC(alA); __syncthreads();
  }
  SBAR(); qkt(pB0, pB1, K_lds + SHM_K, qr, qrl, r32, hi);
  finishSM(pA0, pA1, alA, l_reg, pa0, pa1, pa2, pa3); SBAR();
  pv_d0(o, vb0, pa0, pa1, pa2, pa3); partialSM(pB0, pB1, m_reg, mnB, alB);
  __syncthreads(); RESC(alB);
  finishSM(pB0, pB1, alB, l_reg, pa0, pa1, pa2, pa3); SBAR();
  pv_d0(o, vb0 + SHM_V, pa0, pa1, pa2, pa3);
  if (hi == 0) li_l[r32] = l_reg; asm volatile("s_waitcnt lgkmcnt(0)" ::: "memory");
  float rli[16];
#pragma unroll
  for (int r = 0; r < 16; ++r) rli[r] = __builtin_amdgcn_rcpf(li_l[crow(r, hi)]);
  bf16_t* Ow = Ob + (size_t)(wid * 32) * 1024;
#pragma unroll
  for (int r = 0; r < 16; ++r) { const int orow = crow(r, hi);
#pragma unroll
    for (int d0 = 0; d0 < 4; ++d0) Ow[(size_t)orow * 1024 + d0 * 32 + r32] = f2bf(o[d0][r] * rli[r]); }
  __syncthreads();
#undef SLOAD
#undef SWRITE
#undef RESC
}
}

DI void phase2_attn(const KP& p, char* lds) {
  for (int u = blockIdx.x; u < 256; u += gridDim.x) {
    unsigned char* ws = launder(p.ws);
    const bf16_t* Qm = (const bf16_t*)(ws + WS_QM); const bf16_t* Km = (const bf16_t*)(ws + WS_KM); const bf16_t* Vm = (const bf16_t*)(ws + WS_VM);
    bf16_t* mixa = (bf16_t*)(ws + WS_P1S);
    const int qb = u & 7, bh = u >> 3, b = bh >> 2, h = bh & 3;
    att::attn_unit(Qm + ((size_t)bh * SEQ + qb * 256) * 192, Km + (size_t)bh * SEQ * 192, Vm + (size_t)bh * SEQ * 128,
                   mixa + ((size_t)b * SEQ + qb * 256) * 1024 + h * 128, SEQ, lds);
  }
}

namespace pg8 {
#define PG8_LAS __attribute__((address_space(3)))
typedef unsigned short bf16_t;
typedef short bf16x8 __attribute__((ext_vector_type(8)));
typedef float f32x4 __attribute__((ext_vector_type(4)));
typedef unsigned u32x4 __attribute__((ext_vector_type(4)));
constexpr int BM = 256, BK = 64, HALF = 128, HTB = HALF * BK * 2  , STAGE_BYTES = 8 * HTB, NXCD = 8, WGM = 8;

__host__ __device__ __forceinline__ int lds_byte(int r, int c) { const int st = (r >> 4) * 2 + (c >> 5), rr = r & 15, cc = c & 31, ob = rr * 64 + cc * 2; return st * 1024 + (ob ^ (((ob >> 9) & 1) << 5)); }
__host__ __device__ __forceinline__ void stage_rc(int b, int& R, int& C) { const int st = b / 1024, sb = b % 1024, swz = sb ^ (((sb >> 9) & 1) << 5); R = (st >> 1) * 16 + swz / 64; C = (st & 1) * 32 + (swz % 64) / 2; }
__host__ __device__ __forceinline__ int perm32(int rho) { const int n = rho >> 4, i = rho & 15; return 8 * (i >> 2) + 4 * n + (i & 3); }

struct Unit { int pm, pn; };
struct Gemm { const bf16_t* A; const bf16_t* Bt; int M, N, K; };

struct StaticOrder {
    int nM, nN, nwg, G, c;
    __host__ __device__ void init(int M, int N, int G_, int c_) { nM = M / BM; nN = N / BM; nwg = nM * nN; G = G_; c = c_; }
    __host__ __device__ bool next(int i, Unit& u) const {
        const long L = (long)i * G + c; if (L >= nwg) return false;
        int wgid = (int)L; { const int q = nwg / NXCD, r = nwg % NXCD, xcd = wgid % NXCD, off = wgid / NXCD; wgid = (xcd < r ? xcd * (q + 1) : r * (q + 1) + (xcd - r) * q) + off; }
        const int nig = WGM * nN, gid = wgid / nig, fm = gid * WGM, gsz = (nM - fm) < WGM ? (nM - fm) : WGM;
        u.pm = fm + ((wgid % nig) % gsz); u.pn = (wgid % nig) / gsz; return true;
    }
    __device__ __forceinline__ void a_ready(const Unit&) const {}
    __device__ __forceinline__ void done(const Unit&) const {}
};

__device__ __forceinline__ unsigned cvt_pk_bf16(float lo, float hi) { unsigned r; asm volatile("v_cvt_pk_bf16_f32 %0, %1, %2" : "=v"(r) : "v"(lo), "v"(hi)); return r; }
typedef float f32x2 __attribute__((ext_vector_type(2)));
__device__ __forceinline__ f32x2 gelu_pk(f32x2 v) {
    const f32x2 av = __builtin_elementwise_abs(v), d = av * 0.2316418882f + 1.0f;
    f32x2 t; t.x = __builtin_amdgcn_rcpf(d.x); t.y = __builtin_amdgcn_rcpf(d.y);
    f32x2 q = t * 0.5307027145f + (-0.7265760135f); q = q * t + 0.7107068705f; q = q * t + (-0.142248368f); q = q * t + 0.127414796f; q = q * t;
    const f32x2 s = (v * v) * (-0.72134752044f);
    f32x2 e; e.x = __builtin_amdgcn_exp2f(s.x); e.y = __builtin_amdgcn_exp2f(s.y);
    const f32x2 m = v * (q * e), r = v - m;
    f32x2 o; o.x = v.x < 0.f ? m.x : r.x; o.y = v.y < 0.f ? m.y : r.y; return o;
}

template <int ACT  > struct EpiBf16 {
    static constexpr bool PERM = true, AFTER_DRAIN = false; static_assert(ACT == 0 || ACT == 1, "EpiBf16: ACT is 0 (none) or 1 (gelu_pk)");
    bf16_t* O; int ldc; const float* bias; int split_cols; size_t split_stride; float scale0;
    __device__ __forceinline__ void operator()(const f32x4 (&acc)[2][2][4][2], const Unit& u, int wr, int wc, int fr, int fq) const {
        const int row0 = u.pm * BM + wr * 64 + fr; int colt = u.pn * BM; bf16_t* base = O;
        float sc = 1.f; if (split_cols) { const int t = colt / split_cols; base += (size_t)t * split_stride; colt -= t * split_cols; if (t == 0) sc = scale0; }
        const int col0 = colt + wc * 32 + 8 * fq, bcol0 = u.pn * BM + wc * 32 + 8 * fq;
        f32x4 bv[2][2];
#pragma unroll
        for (int bj = 0; bj < 2; ++bj)
#pragma unroll
            for (int n = 0; n < 2; ++n) bv[bj][n] = bias ? *(const f32x4*)(bias + bcol0 + bj * HALF + 4 * n) : (f32x4){0.f, 0.f, 0.f, 0.f};
#pragma unroll
        for (int ai = 0; ai < 2; ++ai)
#pragma unroll
            for (int m = 0; m < 4; ++m) { bf16_t* rowp = base + (size_t)(row0 + ai * HALF + m * 16) * ldc + col0;
#pragma unroll
                for (int bj = 0; bj < 2; ++bj) { f32x4 v0 = acc[ai][bj][m][0] + bv[bj][0], v1 = acc[ai][bj][m][1] + bv[bj][1];
                    if (ACT == 1) { f32x2 a = gelu_pk((f32x2){v0[0], v0[1]}), b = gelu_pk((f32x2){v0[2], v0[3]}), c = gelu_pk((f32x2){v1[0], v1[1]}), d = gelu_pk((f32x2){v1[2], v1[3]});
                        v0 = (f32x4){a.x, a.y, b.x, b.y}; v1 = (f32x4){c.x, c.y, d.x, d.y}; }
                    v0 = v0 * sc; v1 = v1 * sc; u32x4 w; w.x = cvt_pk_bf16(v0[0], v0[1]); w.y = cvt_pk_bf16(v0[2], v0[3]); w.z = cvt_pk_bf16(v1[0], v1[1]); w.w = cvt_pk_bf16(v1[2], v1[3]);
                    *(u32x4*)(rowp + bj * HALF) = w; } }
    }
};

template <class Epi, class Sched, bool ALIGN_EPI = false, bool SP2 = false>
__device__ __forceinline__ void gemm_phase(PG8_LAS unsigned char* lds, const Gemm g, const Sched& S, const Epi& E) {
    const int tid = threadIdx.x, wid = __builtin_amdgcn_readfirstlane(tid >> 6), lane = tid & 63, wr = wid >> 2, wc = wid & 3, fr = lane & 15, fq = lane >> 4;
    const int K = g.K, nt = K / BK;
    unsigned voffA[2], voffB[2];
#pragma unroll
    for (int i = 0; i < 2; ++i) { int R, C; stage_rc(tid * 16 + i * 8192, R, C); const int Rb = Epi::PERM ? ((R & ~31) + perm32(R & 31)) : R;
        voffA[i] = (unsigned)(R * K + C) * 2u; voffB[i] = (unsigned)(Rb * K + C) * 2u; }
    const size_t kstep = (size_t)(BK * 2);
    const size_t hstep = (size_t)HALF * K * 2;
    const size_t tstep = 2 * hstep;
    const unsigned ldsw = (unsigned)wid * 1024u;
    const int aoff = lds_byte(wr * 64 + fr, fq * 8), boff = lds_byte(wc * 32 + fr, fq * 8);
#define PG8_SA(b, h) (((b) * 2 + (h)) * HTB)
#define PG8_SB(b, h) ((4 + (b) * 2 + (h)) * HTB)
#define PG8_STAGE(bufoff, gbase, voff) do { _Pragma("unroll") for (int _i = 0; _i < 2; ++_i) \
        __builtin_amdgcn_global_load_lds((const unsigned*)((const char*)(gbase) + (voff)[_i]), (PG8_LAS unsigned*)(lds + (bufoff) + ldsw + _i * 8192), 16, 0, 0); } while (0)
#define PG8_LDA(dst, b, h) do { _Pragma("unroll") for (int m = 0; m < 4; ++m) _Pragma("unroll") for (int k = 0; k < 2; ++k) dst[m][k] = *(const PG8_LAS bf16x8*)(lds + PG8_SA(b, h) + aoff + m * 2048 + k * 1024); } while (0)
#define PG8_LDB(dst, b, h) do { _Pragma("unroll") for (int n = 0; n < 2; ++n) _Pragma("unroll") for (int k = 0; k < 2; ++k) dst[n][k] = *(const PG8_LAS bf16x8*)(lds + PG8_SB(b, h) + boff + n * 2048 + k * 1024); } while (0)
#define PG8_MMA(ai, bj, At, Bt) do { __builtin_amdgcn_s_setprio(1); _Pragma("unroll") for (int m = 0; m < 4; ++m) _Pragma("unroll") for (int n = 0; n < 2; ++n) _Pragma("unroll") for (int k = 0; k < 2; ++k) \
        acc[ai][bj][m][n] = __builtin_amdgcn_mfma_f32_16x16x32_bf16(Bt[n][k], At[m][k], acc[ai][bj][m][n], 0, 0, 0); __builtin_amdgcn_s_setprio(0); } while (0)
#define PG8_WAIT_V(n) asm volatile("s_waitcnt vmcnt(" #n ")" ::: "memory")
#define PG8_WAIT_L(n) asm volatile("s_waitcnt lgkmcnt(" #n ")" ::: "memory")
#define PG8_BAR __builtin_amdgcn_s_barrier()
#define PG8_SCHED __builtin_amdgcn_sched_barrier(0)
    Unit cur, nxt; int ui = 0;
    if (!S.next(0, cur)) return;
    f32x4 acc[2][2][4][2];
#pragma unroll
    for (int a = 0; a < 2; ++a)
#pragma unroll
        for (int b = 0; b < 2; ++b)
#pragma unroll
            for (int m = 0; m < 4; ++m)
#pragma unroll
                for (int n = 0; n < 2; ++n) acc[a][b][m][n] = (f32x4){0.f, 0.f, 0.f, 0.f};
    bf16x8 At[4][2], B0[2][2], B1[2][2];
    const char* cA = (const char*)g.A + (size_t)cur.pm * tstep; const char* cB = (const char*)g.Bt + (size_t)cur.pn * tstep;
    S.a_ready(cur);
    if constexpr (SP2) {
        PG8_STAGE(PG8_SB(0, 0), cB, voffB); PG8_STAGE(PG8_SB(0, 1), cB + hstep, voffB); PG8_STAGE(PG8_SA(0, 0), cA, voffA); PG8_STAGE(PG8_SA(0, 1), cA + hstep, voffA);
        if (wr == 1) PG8_BAR;
        PG8_WAIT_V(2); PG8_BAR;
        PG8_STAGE(PG8_SB(1, 0), cB + kstep, voffB); PG8_STAGE(PG8_SA(1, 0), cA + kstep, voffA); PG8_STAGE(PG8_SB(1, 1), cB + hstep + kstep, voffB);
        PG8_WAIT_V(6); PG8_BAR;
    } else {
        PG8_STAGE(PG8_SB(0, 0), cB, voffB); PG8_STAGE(PG8_SA(0, 0), cA, voffA); PG8_STAGE(PG8_SB(0, 1), cB + hstep, voffB); PG8_STAGE(PG8_SA(0, 1), cA + hstep, voffA);
        if (wr == 1) PG8_BAR;
        PG8_WAIT_V(4); PG8_BAR;
        PG8_STAGE(PG8_SB(1, 0), cB + kstep, voffB); PG8_STAGE(PG8_SA(1, 0), cA + kstep, voffA); PG8_STAGE(PG8_SB(1, 1), cB + hstep + kstep, voffB);
        PG8_WAIT_V(6); PG8_BAR;
    }
    for (;;) {
        const bool has_next = S.next(ui + 1, nxt);
        const char* nA = has_next ? (const char*)g.A + (size_t)nxt.pm * tstep : cA; const char* nB = has_next ? (const char*)g.Bt + (size_t)nxt.pn * tstep : cB;
        for (int t = 0; t < nt; t += 2) {
            const bool last = (t == nt - 2);
            const char* a1 = cA + (size_t)(t + 1) * kstep;
            const char* a2 = last ? nA : cA + (size_t)(t + 2) * kstep; const char* b2 = last ? nB : cB + (size_t)(t + 2) * kstep;
            const char* a3 = a2 + kstep; const char* b3 = b2 + kstep;
            if (last && has_next) S.a_ready(nxt);
            if constexpr (SP2) {
            PG8_LDB(B0, 0, 0); PG8_LDB(B1, 0, 1); PG8_SCHED; PG8_LDA(At, 0, 0); PG8_STAGE(PG8_SA(1, 1), a1 + hstep, voffA);
            PG8_WAIT_V(8); PG8_WAIT_L(0); PG8_BAR; PG8_MMA(0, 0, At, B0); PG8_MMA(0, 1, At, B1); PG8_BAR; PG8_SCHED;
            PG8_LDA(At, 0, 1); PG8_STAGE(PG8_SB(0, 0), b2, voffB); PG8_STAGE(PG8_SB(0, 1), b2 + hstep, voffB); PG8_STAGE(PG8_SA(0, 0), a2, voffA);
            PG8_WAIT_V(8); PG8_WAIT_L(0); PG8_BAR; PG8_MMA(1, 0, At, B0); PG8_MMA(1, 1, At, B1); PG8_BAR; PG8_SCHED;
            PG8_LDB(B0, 1, 0); PG8_LDB(B1, 1, 1); PG8_SCHED; PG8_LDA(At, 1, 0); PG8_STAGE(PG8_SA(0, 1), a2 + hstep, voffA);
            PG8_WAIT_V(8); PG8_WAIT_L(0); PG8_BAR; PG8_MMA(0, 0, At, B0); PG8_MMA(0, 1, At, B1); PG8_BAR; PG8_SCHED;
            PG8_LDA(At, 1, 1); PG8_STAGE(PG8_SB(1, 0), b3, voffB); PG8_STAGE(PG8_SB(1, 1), b3 + hstep, voffB); PG8_STAGE(PG8_SA(1, 0), a3, voffA);
            PG8_WAIT_V(8); PG8_WAIT_L(0); PG8_BAR; PG8_MMA(1, 0, At, B0); PG8_MMA(1, 1, At, B1); PG8_BAR; PG8_SCHED;
            } else {
            PG8_LDB(B0, 0, 0); PG8_SCHED; PG8_LDA(At, 0, 0); PG8_STAGE(PG8_SA(1, 1), a1 + hstep, voffA);
            PG8_WAIT_L(8); PG8_BAR; PG8_WAIT_L(0); PG8_MMA(0, 0, At, B0); PG8_BAR; PG8_SCHED;
            PG8_LDB(B1, 0, 1); PG8_STAGE(PG8_SB(0, 0), b2, voffB);
            PG8_BAR; PG8_WAIT_L(0); PG8_MMA(0, 1, At, B1); PG8_BAR;
            PG8_LDA(At, 0, 1); PG8_STAGE(PG8_SA(0, 0), a2, voffA);
            PG8_BAR; PG8_WAIT_L(0); PG8_MMA(1, 0, At, B0); PG8_BAR; PG8_SCHED;
            PG8_STAGE(PG8_SB(0, 1), b2 + hstep, voffB);
            PG8_WAIT_V(6); PG8_BAR; PG8_MMA(1, 1, At, B1); PG8_BAR;
            PG8_LDB(B0, 1, 0); PG8_SCHED; PG8_LDA(At, 1, 0); PG8_STAGE(PG8_SA(0, 1), a2 + hstep, voffA);
            PG8_WAIT_L(8); PG8_BAR; PG8_WAIT_L(0); PG8_MMA(0, 0, At, B0); PG8_BAR; PG8_SCHED;
            PG8_LDB(B1, 1, 1); PG8_STAGE(PG8_SB(1, 0), b3, voffB);
            PG8_BAR; PG8_WAIT_L(0); PG8_MMA(0, 1, At, B1); PG8_BAR;
            PG8_LDA(At, 1, 1); PG8_STAGE(PG8_SA(1, 0), a3, voffA);
            PG8_BAR; PG8_WAIT_L(0); PG8_MMA(1, 0, At, B0); PG8_BAR; PG8_SCHED;
            PG8_STAGE(PG8_SB(1, 1), b3 + hstep, voffB);
            PG8_WAIT_V(6); PG8_BAR; PG8_MMA(1, 1, At, B1); PG8_BAR;
            }
        }
        if constexpr (ALIGN_EPI) { if (wr == 0) PG8_BAR; }
        if constexpr (!Epi::AFTER_DRAIN) { E(acc, cur, wr, wc, fr, fq); S.done(cur); }
        if (!has_next) break;
#pragma unroll
        for (int a = 0; a < 2; ++a)
#pragma unroll
            for (int b = 0; b < 2; ++b)
#pragma unroll
                for (int m = 0; m < 4; ++m)
#pragma unroll
                    for (int n = 0; n < 2; ++n) acc[a][b][m][n] = (f32x4){0.f, 0.f, 0.f, 0.f};
        cur = nxt; cA = nA; cB = nB; ++ui;
        if constexpr (ALIGN_EPI) { if (wr == 1) PG8_BAR; }
    }
    PG8_WAIT_V(0);
    if constexpr (!ALIGN_EPI) { if (wr == 0) PG8_BAR; }
    PG8_BAR;
    if constexpr (Epi::AFTER_DRAIN) { E.fused(acc, cur, wr, wc, fr, fq, lds, wid, lane); S.done(cur); }
#undef PG8_SA
#undef PG8_SB
#undef PG8_STAGE
#undef PG8_LDA
#undef PG8_LDB
#undef PG8_MMA
#undef PG8_WAIT_V
#undef PG8_WAIT_L
#undef PG8_BAR
#undef PG8_SCHED
}
}


namespace pg8 {
struct EpiProj {
    static constexpr bool PERM = true, AFTER_DRAIN = false;
    bf16_t* P0; bf16_t* P1; bf16_t* P2;
    __device__ __forceinline__ void operator()(const f32x4 (&acc)[2][2][4][2], const Unit& u, int wr, int wc, int fr, int fq) const {
        const int row0 = u.pm * BM + wr * 64 + fr; const int colt = u.pn * BM;
        const long d1 = (long)(P1 - P0), d2 = (long)(P2 - P0); long dsel = 0; if (colt >= 1024) dsel = d1; if (colt >= 2048) dsel = d2;
        bf16_t* base = P0 + dsel; const int ldc = colt < 2048 ? 1024 : 256; const int cl = colt & 1023;
        const int col0 = cl + wc * 32 + 8 * fq;
#pragma unroll
        for (int ai = 0; ai < 2; ++ai)
#pragma unroll
            for (int m = 0; m < 4; ++m) { bf16_t* rowp = base + (size_t)(row0 + ai * HALF + m * 16) * ldc + col0;
#pragma unroll
                for (int bj = 0; bj < 2; ++bj) { const f32x4 v0 = acc[ai][bj][m][0], v1 = acc[ai][bj][m][1];
                    u32x4 w; w.x = cvt_pk_bf16(v0[0], v0[1]); w.y = cvt_pk_bf16(v0[2], v0[3]); w.z = cvt_pk_bf16(v1[0], v1[1]); w.w = cvt_pk_bf16(v1[2], v1[3]);
                    *(u32x4*)(rowp + bj * HALF) = w; } }
    }
};
}

constexpr int P3_TILE_BYTES = 256 * 1024;
constexpr int LDS_TK = 92160;
constexpr int GP_SH = 11, GP_N = 16384 >> GP_SH, GP_OS = GP_N + 1;
constexpr int LDS_OFF = 32768, LDS_CNT = 36864, LDS_LIST = 36864, LDS_H2L = 45056;
constexpr int SCW = 260;
template <int N> DI void ce_desc(float (&a)[N], int i, int l) { const float hi = fmaxf(a[i], a[l]), lo = fminf(a[i], a[l]); a[i] = hi; a[l] = lo; }
DI void sort16_desc(float (&a)[16]) {
#pragma unroll
  for (int k = 2; k <= 16; k <<= 1)
#pragma unroll
    for (int j = k >> 1; j > 0; j >>= 1)
#pragma unroll
      for (int i = 0; i < 16; ++i) { const int l = i ^ j; if (l > i) { if ((i & k) == 0) ce_desc(a, i, l); else ce_desc(a, l, i); } }
}
DI void merge16_desc(float (&a)[16]) {
#pragma unroll
  for (int j = 8; j > 0; j >>= 1)
#pragma unroll
    for (int i = 0; i < 16; ++i) { const int l = i ^ j; if (l > i) ce_desc(a, i, l); }
}
DI void top16_merge(float (&a)[16], const float (&b)[16]) {
#pragma unroll
  for (int i = 0; i < 16; ++i) a[i] = fmaxf(a[i], b[15 - i]);
  merge16_desc(a);
}
template <int CTRL> DI float dpp_f(float v) { return __int_as_float(__builtin_amdgcn_mov_dpp(__float_as_int(v), CTRL, 0xF, 0xF, true)); }

DI float gelu_fast(float x) { return 0.5f * x * (1.f + erff(x * 0.70710678118654752f)); }

DI void phase3(const KP& p, char* lds, const int gather_reps, const int probe) {
  const int tid0 = threadIdx.x;
  const int r = tid0 & 31, hh = (tid0 >> 5) & 1, lane = tid0 & 63;
  char* wl = lds + LDS_WT + ((tid0 >> 6) & 3) * WT_BYTES;
  for (int tile = blockIdx.x; tile < 256; tile += gridDim.x) {
    unsigned char* ws = launder(p.ws); float* outp = launder(p.out); const float* xin = launder(p.in[0]);
    const int tok0 = tile * 64, b = tile >> 5;
    unsigned char* tsc = ws + WS_QM + (size_t)tile * P3_TILE_BYTES;
    bf16_t* QRY = (bf16_t*)tsc; bf16_t* Y = (bf16_t*)tsc; bf16_t* MIXA = (bf16_t*)(ws + WS_P1S) + (size_t)tok0 * 1024; bf16_t* H2 = MIXA;
    const float* modb = launder((const float*)(ws + WS_MOD)) + b * 6144;
    __syncthreads();
    {
      const int tid = lv(tid0), lane = tid & 63, w = tid >> 6, r = lane & 31, hh = lane >> 5;
      const int h = w >> 1, mi = w & 1, n = tile & 31;
      char* OIL = lds; char* RGL = lds + 66560;
      { const bf16_t* oig = (const bf16_t*)(ws + WS_OINTRA) + (size_t)tok0 * 512; const bf16_t* rgg = (const bf16_t*)(ws + WS_RG) + (size_t)tok0 * 512;
#pragma unroll
        for (int i = 0; i < 8; ++i) { const int c = tid + 512 * i, row = c >> 6, cc = c & 63;
          *(uint4*)(OIL + row * 1040 + cc * 16) = *(const uint4*)(oig + (size_t)row * 512 + cc * 8);
          *(uint4*)(RGL + row * 1040 + cc * 16) = *(const uint4*)(rgg + (size_t)row * 512 + cc * 8); } }
      const bf16_t* QDg = (const bf16_t*)(ws + WS_QDEC) + (size_t)(tile * 4 + h) * 2 * 4096 + (mi * 32 + r) * 64 + hh * 8;
      const bf16_t* SPg = (const bf16_t*)(ws + WS_SPT) + ((size_t)((b * 4 + h) * 2) * 32 + n) * 8192 + r * 64 + hh * 8;
      f32x16 acc[4];
#pragma unroll
      for (int ni = 0; ni < 4; ++ni)
#pragma unroll
        for (int i = 0; i < 16; ++i) acc[ni][i] = 0.f;
#pragma unroll
      for (int d = 0; d < 2; ++d)
#pragma unroll
        for (int s = 0; s < 4; ++s) { const bf16x8 a = *(const bf16x8*)(QDg + d * 4096 + s * 16);
#pragma unroll
          for (int ni = 0; ni < 4; ++ni) { const bf16x8 bb = *(const bf16x8*)(SPg + (size_t)d * 32 * 8192 + ni * 32 * 64 + s * 16); acc[ni] = MFMA32(a, bb, acc[ni]); } }
      __syncthreads();
      bf16_t* oil = (bf16_t*)(OIL + (mi * 32 + 4 * hh) * 1040) + h * 128 + r; const bf16_t* rgl = (const bf16_t*)(RGL + (mi * 32 + 4 * hh) * 1040) + h * 128 + r;
#pragma unroll
      for (int ni = 0; ni < 4; ++ni)
#pragma unroll
        for (int reg = 0; reg < 16; ++reg) acc[ni][reg] += bf2f(oil[((reg & 3) + 8 * (reg >> 2)) * 520 + ni * 32]);
      float rs[16];
#pragma unroll
      for (int reg = 0; reg < 16; ++reg) { float v = acc[0][reg] * acc[0][reg] + acc[1][reg] * acc[1][reg] + acc[2][reg] * acc[2][reg] + acc[3][reg] * acc[3][reg];
        v += __shfl_xor(v, 1); v += __shfl_xor(v, 2); v += __shfl_xor(v, 4); v += __shfl_xor(v, 8); v += __shfl_xor(v, 16);
        rs[reg] = rsqrtf(v * (1.f / 128.f) + EPS); }
      const float* ggl = launder(p.in[16]);
#pragma unroll
      for (int ni = 0; ni < 4; ++ni) { const float g = ggl[ni * 32 + r];
#pragma unroll
        for (int reg = 0; reg < 16; ++reg) { const int ro = ((reg & 3) + 8 * (reg >> 2)) * 520 + ni * 32; const float rv = bf2f(rgl[ro]);
          oil[ro] = f2bf(acc[ni][reg] * rs[reg] * g * silu_fast(rv)); } }
      __syncthreads();
#pragma unroll
      for (int i = 0; i < 8; ++i) { const int c = tid + 512 * i, row = c >> 6, cc = c & 63;
        *(uint4*)(MIXA + (size_t)row * 1024 + 512 + cc * 8) = *(const uint4*)(OIL + row * 1040 + cc * 16); }
    }
  }
}

DI void phase3c(const KP& p, char* lds, const int gather_reps, const int probe) {
  const int tid0 = threadIdx.x;
  const int r = tid0 & 31, hh = (tid0 >> 5) & 1, lane = tid0 & 63;
  char* wl = lds + LDS_WT + ((tid0 >> 6) & 3) * WT_BYTES;
  for (int tile = blockIdx.x; tile < 256; tile += gridDim.x) {
    unsigned char* ws = launder(p.ws); float* outp = launder(p.out); const float* xin = launder(p.in[0]);
    const int tok0 = tile * 64, b = tile >> 5;
    unsigned char* tsc = ws + WS_QM + (size_t)tile * P3_TILE_BYTES;
    bf16_t* QRY = (bf16_t*)tsc; bf16_t* Y = (bf16_t*)(ws + WS_QM) + (size_t)tok0 * 1024; bf16_t* MIXA = (bf16_t*)(ws + WS_P1S) + (size_t)tok0 * 1024; bf16_t* H2 = MIXA;
    const float* modb = launder((const float*)(ws + WS_MOD)) + b * 6144;
    __syncthreads();
    {
      const int tid = lv(tid0), lane = tid & 63, w = tid >> 6;
      float4 A1[4], A2[4], S2[4];
      const float* gpo = launder(p.in[6]); const float* gpf = launder(p.in[18]);
#pragma unroll
      for (int i = 0; i < 4; ++i) { const int d = (lane + 64 * i) * 4;
        const float4 gp = *(const float4*)(gpo + d), gt = *(const float4*)(modb + 2048 + d), g2 = *(const float4*)(gpf + d), sc = *(const float4*)(modb + 4096 + d);
        S2[i] = *(const float4*)(modb + 3072 + d);
        A1[i] = make_float4(gp.x * gt.x, gp.y * gt.y, gp.z * gt.z, gp.w * gt.w);
        A2[i] = make_float4(g2.x * (1.f + sc.x), g2.y * (1.f + sc.y), g2.z * (1.f + sc.z), g2.w * (1.f + sc.w)); }
#pragma unroll 2
      for (int rr = 0; rr < 8; ++rr) { const int row = w * 8 + rr; const size_t tok = tok0 + row;
        float4 yv[4]; float ss = 0.f;
#pragma unroll
        for (int i = 0; i < 4; ++i) { const uint2 u = *(const uint2*)(Y + (size_t)row * 1024 + (lane + 64 * i) * 4);
          yv[i] = make_float4(__uint_as_float(u.x << 16), __uint_as_float(u.x & 0xffff0000u), __uint_as_float(u.y << 16), __uint_as_float(u.y & 0xffff0000u));
          ss += yv[i].x * yv[i].x + yv[i].y * yv[i].y + yv[i].z * yv[i].z + yv[i].w * yv[i].w; }
        ss = wave_sum(ss); const float rs = rsqrtf(ss * (1.f / 1024.f) + EPS);
        float4 xv[4]; float s2 = 0.f;
#pragma unroll
        for (int i = 0; i < 4; ++i) { const float4 x = *(const float4*)(xin + tok * 1024 + (lane + 64 * i) * 4);
          xv[i] = make_float4(x.x + A1[i].x * yv[i].x * rs, x.y + A1[i].y * yv[i].y * rs, x.z + A1[i].z * yv[i].z * rs, x.w + A1[i].w * yv[i].w * rs);
          *(float4*)(outp + tok * 1024 + (lane + 64 * i) * 4) = xv[i];
          s2 += xv[i].x * xv[i].x + xv[i].y * xv[i].y + xv[i].z * xv[i].z + xv[i].w * xv[i].w; }
        s2 = wave_sum(s2); const float r2 = rsqrtf(s2 * (1.f / 1024.f) + EPS);
#pragma unroll
        for (int i = 0; i < 4; ++i) { uint2 o; o.x = pack2(xv[i].x * r2 * A2[i].x + S2[i].x, xv[i].y * r2 * A2[i].y + S2[i].y); o.y = pack2(xv[i].z * r2 * A2[i].z + S2[i].z, xv[i].w * r2 * A2[i].w + S2[i].w);
          *(uint2*)(H2 + (size_t)row * 1024 + (lane + 64 * i) * 4) = o; }
      }
    }
  }
}

DI void phase3b(const KP& p, char* lds, const int gather_reps, const int probe) {
  const int tid0 = threadIdx.x;
  const int r = tid0 & 31, hh = (tid0 >> 5) & 1, lane = tid0 & 63;
  char* wl = lds + LDS_WT + ((tid0 >> 6) & 3) * WT_BYTES;
  for (int tile = blockIdx.x; tile < 256; tile += gridDim.x) {
    unsigned char* ws = launder(p.ws); float* outp = launder(p.out); const float* xin = launder(p.in[0]);
    const int tok0 = tile * 64, b = tile >> 5;
    unsigned char* tsc = ws + WS_QM + (size_t)tile * P3_TILE_BYTES;
    bf16_t* QRY = (bf16_t*)tsc; bf16_t* Y = (bf16_t*)tsc; bf16_t* MIXA = (bf16_t*)(ws + WS_P1S) + (size_t)tok0 * 1024; bf16_t* H2 = MIXA;
    const float* modb = launder((const float*)(ws + WS_MOD)) + b * 6144;
    __syncthreads();
    float* SC = (float*)lds; unsigned* TK = (unsigned*)(lds + LDS_TK);
    for (int rep3e = 0; rep3e < (probe == 7 ? 2 : 1); ++rep3e)
    for (int h = 0; h < 8; ++h) {
      block_gemm<2>(lds, QRY + h * 256, 2048, (const bf16_t*)(ws + WS_KD), 1, 256, [&](int m0, int n0, const f32x16& a0, const f32x16& a1) {
        const int r2 = lv(r), h2 = lv(hh);
        float* sp = SC + (m0 + 4 * h2) * SCW + n0 + r2;
#pragma unroll
        for (int reg = 0; reg < 16; ++reg) { const int ro = ((reg & 3) + 8 * (reg >> 2)) * SCW; sp[ro] = a0[reg]; sp[ro + 32] = a1[reg]; }
      });
      __syncthreads();
      {
        const int tid = lv(tid0);
        const int tt = tid >> 3, sd = (tid >> 2) & 1, q = tid & 3;
        const float* sr = SC + tt * SCW + sd * 128 + q * 32;
        float a[16], c[16];
#pragma unroll
        for (int i = 0; i < 4; ++i) { const float4 v = *(const float4*)(sr + i * 4); const unsigned ib = q * 32 + i * 4;
          a[i * 4 + 0] = __uint_as_float((__float_as_uint(v.x) & 0xFFFFFF80u) | (ib + 0)); a[i * 4 + 1] = __uint_as_float((__float_as_uint(v.y) & 0xFFFFFF80u) | (ib + 1));
          a[i * 4 + 2] = __uint_as_float((__float_as_uint(v.z) & 0xFFFFFF80u) | (ib + 2)); a[i * 4 + 3] = __uint_as_float((__float_as_uint(v.w) & 0xFFFFFF80u) | (ib + 3)); }
#pragma unroll
        for (int i = 0; i < 4; ++i) { const float4 v = *(const float4*)(sr + 16 + i * 4); const unsigned ib = q * 32 + 16 + i * 4;
          c[i * 4 + 0] = __uint_as_float((__float_as_uint(v.x) & 0xFFFFFF80u) | (ib + 0)); c[i * 4 + 1] = __uint_as_float((__float_as_uint(v.y) & 0xFFFFFF80u) | (ib + 1));
          c[i * 4 + 2] = __uint_as_float((__float_as_uint(v.z) & 0xFFFFFF80u) | (ib + 2)); c[i * 4 + 3] = __uint_as_float((__float_as_uint(v.w) & 0xFFFFFF80u) | (ib + 3)); }
        sort16_desc(a); sort16_desc(c); top16_merge(a, c);
#pragma unroll
        for (int i = 0; i < 16; ++i) c[i] = dpp_f<0xB1>(a[i]);
        top16_merge(a, c);
#pragma unroll
        for (int i = 0; i < 16; ++i) c[i] = dpp_f<0x4E>(a[i]);
        top16_merge(a, c);
        if (q == 0) { unsigned* tk = TK + ((tt * 8 + h) * 2 + sd) * 16;
#pragma unroll
          for (int i = 0; i < 4; ++i) *(uint4*)(tk + i * 4) = make_uint4(__float_as_uint(a[i * 4]), __float_as_uint(a[i * 4 + 1]), __float_as_uint(a[i * 4 + 2]), __float_as_uint(a[i * 4 + 3])); }
      }
      __syncthreads();
    }
    {
      const int tid = lv(tid0);
      const int tt = tid >> 3, h = tid & 7;
      const unsigned* t1 = TK + ((tt * 8 + h) * 2) * 16; const unsigned* t2 = t1 + 16;
      float v1[16], v2[16];
#pragma unroll
      for (int i = 0; i < 4; ++i) { const uint4 u = *(const uint4*)(t1 + i * 4), v = *(const uint4*)(t2 + i * 4);
        v1[i * 4] = __uint_as_float(u.x & 0xFFFFFF80u); v1[i * 4 + 1] = __uint_as_float(u.y & 0xFFFFFF80u); v1[i * 4 + 2] = __uint_as_float(u.z & 0xFFFFFF80u); v1[i * 4 + 3] = __uint_as_float(u.w & 0xFFFFFF80u);
        v2[i * 4] = __uint_as_float(v.x & 0xFFFFFF80u); v2[i * 4 + 1] = __uint_as_float(v.y & 0xFFFFFF80u); v2[i * 4 + 2] = __uint_as_float(v.z & 0xFFFFFF80u); v2[i * 4 + 3] = __uint_as_float(v.w & 0xFFFFFF80u); }
      float best[16], grp[16];
#define CAND(i, j) __uint_as_float((__float_as_uint(v1[i] + v2[j]) & 0xFFFFFF00u) | ((i) << 4) | (j))
      best[0] = CAND(0, 0); best[1] = CAND(0, 1); best[2] = CAND(0, 2); best[3] = CAND(0, 3); best[4] = CAND(0, 4); best[5] = CAND(0, 5); best[6] = CAND(0, 6); best[7] = CAND(0, 7);
      best[8] = CAND(0, 8); best[9] = CAND(0, 9); best[10] = CAND(0, 10); best[11] = CAND(0, 11); best[12] = CAND(0, 12); best[13] = CAND(0, 13); best[14] = CAND(0, 14); best[15] = CAND(0, 15);
      sort16_desc(best);
      grp[0] = CAND(1, 0); grp[1] = CAND(1, 1); grp[2] = CAND(1, 2); grp[3] = CAND(1, 3); grp[4] = CAND(1, 4); grp[5] = CAND(1, 5); grp[6] = CAND(1, 6); grp[7] = CAND(1, 7);
      grp[8] = CAND(2, 0); grp[9] = CAND(2, 1); grp[10] = CAND(2, 2); grp[11] = CAND(2, 3); grp[12] = CAND(2, 4); grp[13] = CAND(3, 0); grp[14] = CAND(3, 1); grp[15] = CAND(3, 2);
      sort16_desc(grp); top16_merge(best, grp);
      grp[0] = CAND(3, 3); grp[1] = CAND(4, 0); grp[2] = CAND(4, 1); grp[3] = CAND(4, 2); grp[4] = CAND(5, 0); grp[5] = CAND(5, 1); grp[6] = CAND(6, 0); grp[7] = CAND(6, 1);
      grp[8] = CAND(7, 0); grp[9] = CAND(7, 1); grp[10] = CAND(8, 0); grp[11] = CAND(9, 0); grp[12] = CAND(10, 0); grp[13] = CAND(11, 0); grp[14] = CAND(12, 0); grp[15] = CAND(13, 0);
      sort16_desc(grp); top16_merge(best, grp);
      { const float c14 = CAND(14, 0), c15 = CAND(15, 0);
        grp[0] = fmaxf(c14, c15); grp[1] = fminf(c14, c15);
#pragma unroll
        for (int i = 2; i < 16; ++i) grp[i] = -3.0e38f;
        top16_merge(best, grp); }
#undef CAND
      __syncthreads();
      float sv[16]; int ev[16]; float mx = -3.0e38f;
#pragma unroll
      for (int k = 0; k < 16; ++k) { const unsigned key = __float_as_uint(best[k]); const int ci = (key >> 4) & 15, cj = key & 15;
        const unsigned k1 = t1[ci], k2 = t2[cj];
        sv[k] = __uint_as_float(k1 & 0xFFFFFF80u) + __uint_as_float(k2 & 0xFFFFFF80u); ev[k] = (int)((k1 & 127u) * 128u + (k2 & 127u)); mx = fmaxf(mx, sv[k]); }
      float sum = 0.f;
#pragma unroll
      for (int k = 0; k < 16; ++k) { sv[k] = __expf(sv[k] - mx); sum += sv[k]; }
      const float inv = 1.f / sum;
      unsigned* CNT = (unsigned*)(lds + LDS_CNT); unsigned short* OFFS = (unsigned short*)(lds + LDS_OFF); unsigned* EL = (unsigned*)lds;
      CNT[tid] = 0u; if (GP_N > 8) CNT[tid + 512] = 0u;
      __syncthreads();
      int pos[16];
#pragma unroll
      for (int k = 0; k < 16; ++k) pos[k] = (int)atomicAdd(&CNT[tt * GP_N + (ev[k] >> GP_SH)], 1u);
      __syncthreads();
      if (h == 0) { unsigned run = 0;
#pragma unroll
        for (int q = 0; q < GP_N; ++q) { OFFS[tt * GP_OS + q] = (unsigned short)run; run += CNT[tt * GP_N + q]; }
        OFFS[tt * GP_OS + GP_N] = (unsigned short)run; }
      __syncthreads();
#pragma unroll
      for (int k = 0; k < 16; ++k) { const int d = (int)OFFS[tt * GP_OS + (ev[k] >> GP_SH)] + pos[k];
        EL[tt * 128 + d] = ((__float_as_uint(sv[k] * inv) + 0x2000u) & 0xFFFFC000u) | (unsigned)ev[k]; }
    }
    __syncthreads();
    {
      const int tid = lv(tid0), lane = tid & 63, w = tid >> 6;
      const unsigned char* EU = ws + WS_EU; const unsigned char* EV = ws + WS_EV; const float* SCU = (const float*)(ws + WS_ESC); const float* SCV = SCU + 16384;
      unsigned* EL = (unsigned*)lds; const unsigned short* OFFS = (const unsigned short*)(lds + LDS_OFF); unsigned* LIST = (unsigned*)(lds + LDS_LIST) + w * 256; char* H2W = lds + LDS_H2L + w * 8192;
      const float* gpf2 = launder(p.in[19]);
      const int rot = (int)(__builtin_amdgcn_s_getreg((3 << 11) | 20) & 0xFu) * (GP_N / 8);
      typedef float f2v __attribute__((ext_vector_type(2)));
#define CVLO(wd) __builtin_amdgcn_cvt_pk_f32_fp8((int)(wd), false)
#define CVHI(wd) __builtin_amdgcn_cvt_pk_f32_fp8((int)(wd), true)
#define BF2(wd) ((f2v){__uint_as_float((wd) << 16), __uint_as_float((wd) & 0xffff0000u)})
#define PF_DESC(D, s_) D = ((s_) < ns) ? __builtin_amdgcn_readfirstlane((int)LIST[(s_)]) : 0
#define G_FETCH(D, PK, R, TAB) do { const int n_ = (D) & 15; const int sl_ = lane & 7; \
        PK = EL[(row0 + ((D) >> 11)) * 128 + (((D) >> 4) & 127) + (sl_ < n_ ? sl_ : 0)]; const int es_ = (int)(PK & 16383u); \
        _Pragma("unroll") for (int k2 = 0; k2 < 8; ++k2) { const int e_ = __builtin_amdgcn_readlane(es_, k2) & emask; R[k2] = *(const uint4*)(TAB + (size_t)e_ * 1024 + lane * 16); } } while (0)
#define U_FETCH(D, PK, SU, SV, R) do { G_FETCH(D, PK, R, EU); SU = SCU[PK & 16383u]; SV = SCV[PK & 16383u]; } while (0)
#define U_COMPUTE(D, PK, SU, SV, R) do { if ((D) != 0) { const int n_ = (D) & 15, rr_ = (D) >> 11; \
        if (rr_ != cur) { cur = rr_; const uint4 hA = *(const uint4*)(H2W + rr_ * 2048 + lane * 32), hB = *(const uint4*)(H2W + rr_ * 2048 + lane * 32 + 16); \
          hf2[0] = BF2(hA.x); hf2[1] = BF2(hA.y); hf2[2] = BF2(hA.z); hf2[3] = BF2(hA.w); hf2[4] = BF2(hB.x); hf2[5] = BF2(hB.y); hf2[6] = BF2(hB.z); hf2[7] = BF2(hB.w); } \
        float P[8]; \
        _Pragma("unroll") for (int k2 = 0; k2 < 8; ++k2) { P[k2] = 0.f; \
          if (k2 < n_) { f2v d2 = CVLO(R[k2].x) * hf2[0]; d2 += CVHI(R[k2].x) * hf2[1]; d2 += CVLO(R[k2].y) * hf2[2]; d2 += CVHI(R[k2].y) * hf2[3]; \
            d2 += CVLO(R[k2].z) * hf2[4]; d2 += CVHI(R[k2].z) * hf2[5]; d2 += CVLO(R[k2].w) * hf2[6]; d2 += CVHI(R[k2].w) * hf2[7]; P[k2] = d2.x + d2.y; } } \
          \
        const bool up4 = (lane & 4) != 0; \
        _Pragma("unroll") for (int e = 0; e < 4; ++e) { const float keep = up4 ? P[e + 4] : P[e], send = up4 ? P[e] : P[e + 4]; P[e] = keep + __shfl_xor(send, 4); } \
        const bool up2 = (lane & 2) != 0; \
        _Pragma("unroll") for (int e = 0; e < 2; ++e) { const float keep = up2 ? P[e + 2] : P[e], send = up2 ? P[e] : P[e + 2]; P[e] = keep + dpp_f<0x4E>(send); } \
        const bool up1 = (lane & 1) != 0; \
        const float keep1 = up1 ? P[1] : P[0], send1 = up1 ? P[0] : P[1]; \
        float av = keep1 + dpp_f<0xB1>(send1); \
        av += __shfl_xor(av, 8); av += __shfl_xor(av, 16); av += __shfl_xor(av, 32); \
        av *= SU; \
          \
        const float ax = fabsf(av), t = __builtin_amdgcn_rcpf(ax * 0.2316418882f + 1.0f); \
        float q = t * 0.5307027145f + (-0.7265760135f); q = q * t + 0.7107068705f; q = q * t + (-0.142248368f); q = q * t + 0.127414796f; q = q * t; \
        const float ee = __builtin_amdgcn_exp2f(av * av * (-0.72134752044f)); \
        const float mm = av * (q * ee), gl = (av < 0.f) ? mm : (av - mm); \
        const float wv = __uint_as_float(PK & 0xFFFFC000u) * gl * SV; \
        if (lane < n_) EL[(row0 + rr_) * 128 + (((D) >> 4) & 127) + lane] = ((__float_as_uint(wv) + 0x2000u) & 0xFFFFC000u) | (PK & 16383u); } } while (0)
#define Y_PARK() do { uint4 y0, y1; y0.x = pack2(acc[0].x, acc[0].y); y0.y = pack2(acc[1].x, acc[1].y); y0.z = pack2(acc[2].x, acc[2].y); y0.w = pack2(acc[3].x, acc[3].y); \
        y1.x = pack2(acc[4].x, acc[4].y); y1.y = pack2(acc[5].x, acc[5].y); y1.z = pack2(acc[6].x, acc[6].y); y1.w = pack2(acc[7].x, acc[7].y); \
        *(uint4*)(H2W + cur * 2048 + lane * 32) = y0; *(uint4*)(H2W + cur * 2048 + lane * 32 + 16) = y1; } while (0)
#define V_COMPUTE(D, PK, R) do { if ((D) != 0) { const int n_ = (D) & 15, rr_ = (D) >> 11; \
        if (rr_ != cur) { if (cur >= 0) Y_PARK(); cur = rr_; \
          const uint4 hA = *(const uint4*)(H2W + rr_ * 2048 + lane * 32), hB = *(const uint4*)(H2W + rr_ * 2048 + lane * 32 + 16); \
          acc[0] = BF2(hA.x); acc[1] = BF2(hA.y); acc[2] = BF2(hA.z); acc[3] = BF2(hA.w); acc[4] = BF2(hB.x); acc[5] = BF2(hB.y); acc[6] = BF2(hB.z); acc[7] = BF2(hB.w); } \
        const float wv_ = ((lane & 7) < n_) ? __uint_as_float(PK & 0xFFFFC000u) : 0.f; \
        _Pragma("unroll") for (int k2 = 0; k2 < 8; ++k2) if (k2 < n_) { const float wk = __int_as_float(__builtin_amdgcn_readlane(__float_as_int(wv_), k2)); const f2v wk2 = {wk, wk}; \
          acc[0] += CVLO(R[k2].x) * wk2; acc[1] += CVHI(R[k2].x) * wk2; acc[2] += CVLO(R[k2].y) * wk2; acc[3] += CVHI(R[k2].y) * wk2; \
          acc[4] += CVLO(R[k2].z) * wk2; acc[5] += CVHI(R[k2].z) * wk2; acc[6] += CVLO(R[k2].w) * wk2; acc[7] += CVHI(R[k2].w) * wk2; } } } while (0)
#pragma unroll 1
      for (int pass = 0; pass < gather_reps; ++pass)
#pragma unroll 1
      for (int half = 0; half < 2; ++half) {
        const int row0 = half * 32 + w * 4;
        const int emask = (probe == 8 && pass == 0) ? ((1 << GP_SH) - 1) : 16383;
        __builtin_amdgcn_wave_barrier(); asm volatile("" ::: "memory");
        { const uint4* src = (const uint4*)(H2 + (size_t)row0 * 1024); uint4 t[8];
#pragma unroll
          for (int i = 0; i < 8; ++i) t[i] = src[lane + 64 * i];
#pragma unroll
          for (int i = 0; i < 8; ++i) ((uint4*)H2W)[lane + 64 * i] = t[i]; }
        int ns;
        {
          const int rr = lane & 3, part = ((lane >> 2) + rot) & (GP_N - 1);
          int o0 = 0, o1 = 0;
          if (lane < 4 * GP_N) { o0 = (int)OFFS[(row0 + rr) * GP_OS + part]; o1 = (int)OFFS[(row0 + rr) * GP_OS + part + 1]; }
          const int nst = (o1 - o0 + 7) >> 3;
          int incl = nst;
#pragma unroll
          for (int d = 1; d < 64; d <<= 1) { const int t = __shfl_up(incl, d); if (lane >= d) incl += t; }
          const int off = incl - nst;
          for (int j = 0; j < nst; ++j) { const int base = o0 + 8 * j; const int nn = (o1 - base < 8) ? (o1 - base) : 8; LIST[off + j] = (unsigned)(nn | (base << 4) | (rr << 11)); }
          ns = __builtin_amdgcn_readlane(incl, 63); }
        __builtin_amdgcn_wave_barrier(); asm volatile("" ::: "memory");
        {
          int DA, DB, cur = -1; unsigned PKA, PKB; float SUA, SVA, SUB, SVB; uint4 RA[8], RB[8]; f2v hf2[8];
          PF_DESC(DA, 0); U_FETCH(DA, PKA, SUA, SVA, RA);
#pragma unroll 1
          for (int s = 0; s < ns; s += 2) {
            PF_DESC(DB, s + 1); U_FETCH(DB, PKB, SUB, SVB, RB);
            U_COMPUTE(DA, PKA, SUA, SVA, RA);
            PF_DESC(DA, s + 2); U_FETCH(DA, PKA, SUA, SVA, RA);
            U_COMPUTE(DB, PKB, SUB, SVB, RB);
          }
        }
        __builtin_amdgcn_wave_barrier(); asm volatile("" ::: "memory");
        { const uint4 z4 = make_uint4(0u, 0u, 0u, 0u);
#pragma unroll
          for (int i = 0; i < 8; ++i) ((uint4*)H2W)[lane + 64 * i] = z4; }
        __builtin_amdgcn_wave_barrier(); asm volatile("" ::: "memory");
        {
          int DA, DB, cur = -1; unsigned PKA, PKB; uint4 RA[8], RB[8]; f2v acc[8];
          PF_DESC(DA, 0); G_FETCH(DA, PKA, RA, EV);
#pragma unroll 1
          for (int s = 0; s < ns; s += 2) {
            PF_DESC(DB, s + 1); G_FETCH(DB, PKB, RB, EV);
            V_COMPUTE(DA, PKA, RA);
            PF_DESC(DA, s + 2); G_FETCH(DA, PKA, RA, EV);
            V_COMPUTE(DB, PKB, RB);
          }
          if (cur >= 0) Y_PARK();
        }
        __builtin_amdgcn_wave_barrier(); asm volatile("" ::: "memory");
        if (pass == gather_reps - 1)
#pragma unroll 1
        for (int rr = 0; rr < 4; ++rr) { const size_t tok = tok0 + row0 + rr;
          const uint4 hA = *(const uint4*)(H2W + rr * 2048 + lane * 32), hB = *(const uint4*)(H2W + rr * 2048 + lane * 32 + 16);
          f2v a[8]; a[0] = BF2(hA.x); a[1] = BF2(hA.y); a[2] = BF2(hA.z); a[3] = BF2(hA.w); a[4] = BF2(hB.x); a[5] = BF2(hB.y); a[6] = BF2(hB.z); a[7] = BF2(hB.w);
          float ss = 0.f;
#pragma unroll
          for (int i = 0; i < 8; ++i) ss += a[i].x * a[i].x + a[i].y * a[i].y;
          ss = wave_sum(ss); const float rs = rsqrtf(ss * (1.f / 1024.f) + EPS);
          float* orow = outp + tok * 1024 + lane * 16;
#pragma unroll
          for (int i = 0; i < 4; ++i) { const int d = lane * 16 + 4 * i;
            float4 x1 = *(const float4*)(orow + 4 * i); const float4 g3 = *(const float4*)(gpf2 + d), g2 = *(const float4*)(modb + 5120 + d);
            x1.x += g3.x * g2.x * a[2 * i].x * rs; x1.y += g3.y * g2.y * a[2 * i].y * rs; x1.z += g3.z * g2.z * a[2 * i + 1].x * rs; x1.w += g3.w * g2.w * a[2 * i + 1].y * rs;
            *(float4*)(orow + 4 * i) = x1; }
        }
      }
#undef CVLO
#undef CVHI
#undef BF2
#undef PF_DESC
#undef G_FETCH
#undef U_FETCH
#undef U_COMPUTE
#undef Y_PARK
#undef V_COMPUTE
    }
  }
}

DI void phase2_scan(const KP& p) {
  unsigned char* ws = p.ws;
  for (int g = blockIdx.x * NTHR + threadIdx.x; g < 131072; g += gridDim.x * NTHR) {
    const int seq = g >> 11, within = g & 2047, dv = within >> 4, dk4 = (within & 15) * 4, dir = seq & 1;
    bf16_t* base = (bf16_t*)(ws + WS_SPT) + ((size_t)seq * 32 * 128 + dv) * 64 + dk4;
    const float* dec = (const float*)(ws + WS_DEC) + (size_t)seq * 32 * 64 + dk4;
    float s0 = 0.f, s1 = 0.f, s2 = 0.f, s3 = 0.f;
#pragma unroll 1
    for (int i0 = 0; i0 < 32; i0 += 8) {
      uint2 d[8]; float4 c[8];
#pragma unroll
      for (int j = 0; j < 8; ++j) { const int n = dir ? 31 - (i0 + j) : (i0 + j); d[j] = *(const uint2*)(base + (size_t)n * 8192); c[j] = *(const float4*)(dec + n * 64); }
#pragma unroll
      for (int j = 0; j < 8; ++j) { const int n = dir ? 31 - (i0 + j) : (i0 + j);
        uint2 o; o.x = pack2(s0, s1); o.y = pack2(s2, s3); *(uint2*)(base + (size_t)n * 8192) = o;
        s0 = c[j].x * s0 + __uint_as_float(d[j].x << 16); s1 = c[j].y * s1 + __uint_as_float(d[j].x & 0xffff0000u);
        s2 = c[j].z * s2 + __uint_as_float(d[j].y << 16); s3 = c[j].w * s3 + __uint_as_float(d[j].y & 0xffff0000u); }
    }
  }
}

#define XB_TMO      128
#define XB_XCNT(j)  (256  + 64 * (j))
#define XB_XSUB(j)  (1280 + 64 * (j))
#define XB_XGEN(j)  (2304 + 64 * (j))
#define XB_TOP      3328
#define XB_TOPGEN   3392
#define XCD_BAR_WORDS 3456
#define XB_SPIN_CAP (1u << 18)
#define LAS __attribute__((address_space(3)))

__device__ __forceinline__ unsigned xb_ld(unsigned* p)              { return __hip_atomic_load(p, __ATOMIC_RELAXED, __HIP_MEMORY_SCOPE_AGENT); }
__device__ __forceinline__ unsigned xb_add(unsigned* p, unsigned v) { return __hip_atomic_fetch_add(p, v, __ATOMIC_RELAXED, __HIP_MEMORY_SCOPE_AGENT); }
__device__ __forceinline__ unsigned xb_xcc_id() { return (unsigned)__builtin_amdgcn_s_getreg((3 << 11) | 20) & 0xFu; }
#define XB_SPIN(cond, bar) do { unsigned _sp = 0; while (cond) { __builtin_amdgcn_s_sleep(1); \
    if ((++_sp & 255u) == 0u) { if (xb_ld(&(bar)[XB_TMO])) break; if (_sp > XB_SPIN_CAP) { atomicAdd(&(bar)[XB_TMO], 1u); break; } } } } while (0)

struct XcdBarrier {
    unsigned* bar; unsigned x;
    volatile LAS unsigned* st;
};

__device__ __forceinline__ XcdBarrier xcd_barrier_post(unsigned* bar, volatile LAS unsigned* st) {
    XcdBarrier b; b.bar = bar; b.x = xb_xcc_id(); b.st = st;
    if (threadIdx.x == 0) (void)xb_add(&bar[XB_XCNT(b.x)], 1u);
    return b;
}
__device__ __forceinline__ void xcd_barrier_complete(unsigned* bar, unsigned x, unsigned& nloc, unsigned& nx) {
    const unsigned G = gridDim.x * gridDim.y * gridDim.z;
    unsigned sum, cnt, mine, sp = 0u;
    for (;;) {
        sum = 0u; cnt = 0u; mine = 0u;
#pragma unroll
        for (unsigned j = 0; j < 16; ++j) { const unsigned c = xb_ld(&bar[XB_XCNT(j)]); sum += c; cnt += (c > 0u) ? 1u : 0u; mine = (j == x) ? c : mine; }
        if (sum == G) break;
        __builtin_amdgcn_s_sleep(1);
        if ((++sp & 255u) == 0u) { if (xb_ld(&bar[XB_TMO])) break; if (sp > XB_SPIN_CAP) { atomicAdd(&bar[XB_TMO], 1u); break; } }
    }
    nloc = mine > 0u ? mine : 1u; nx = cnt > 0u ? cnt : 1u;
}

__device__ __forceinline__ void xcd_barrier(const XcdBarrier& b) {
    asm volatile("s_waitcnt vmcnt(0)" ::: "memory");
    __syncthreads();
    if (threadIdx.x == 0) {
        unsigned* bar = b.bar;
        __builtin_amdgcn_s_waitcnt(0);
        unsigned nloc = b.st[0], nx = b.st[1];
        if (nloc == 0u) { xcd_barrier_complete(bar, b.x, nloc, nx); b.st[0] = nloc; b.st[1] = nx; }
        const unsigned old = xb_add(&bar[XB_XSUB(b.x)], 1u);
        const unsigned gen = old / nloc;
        if (old + 1u == (gen + 1u) * nloc) {
            __builtin_amdgcn_fence(__ATOMIC_RELEASE, "agent");
            asm volatile("s_waitcnt vmcnt(0)" ::: "memory");
            const unsigned og = xb_add(&bar[XB_TOP], 1u);
            const unsigned tg = og / nx;
            if (og + 1u == (tg + 1u) * nx) xb_add(&bar[XB_TOPGEN], 1u);
            else XB_SPIN(xb_ld(&bar[XB_TOPGEN]) == tg, bar);
            __builtin_amdgcn_fence(__ATOMIC_ACQUIRE, "agent");
            xb_add(&bar[XB_XGEN(b.x)], 1u);
            asm volatile("s_waitcnt vmcnt(0)" ::: "memory");
        } else {
            XB_SPIN(xb_ld(&bar[XB_XGEN(b.x)]) == gen, bar);
            __builtin_amdgcn_fence(__ATOMIC_ACQUIRE, "agent");
            asm volatile("s_waitcnt vmcnt(0)" ::: "memory");
        }
    }
    __syncthreads();
}

#ifndef PROBE_ID
#define PROBE_ID 0
#endif
__global__ void __launch_bounds__(NTHR, 2) mega(KP p) {
  extern __shared__ __attribute__((aligned(16))) char lds[];
  cg::grid_group grid = cg::this_grid();
  const int hi = p.ph_hi; constexpr int probe = PROBE_ID;
  if (threadIdx.x == 0) { ((volatile LAS unsigned*)(lds + LDS_XB))[0] = 0u; ((volatile LAS unsigned*)(lds + LDS_XB))[1] = 0u; }
  __syncthreads();
  const XcdBarrier xb = xcd_barrier_post((unsigned*)(p.ws + WS_BAR), (volatile LAS unsigned*)(lds + LDS_XB));
  if (p.ph_lo <= 0 && 0 < hi) { phase0(p, lds); if (probe == 1) phase0(p, lds); if (1 < hi) { if (hi > 64) grid.sync(); else xcd_barrier(xb); } }
  if (p.ph_lo <= 1 && 1 < hi) {
    phase1a(p, lds);
    xcd_barrier(xb);
    {
      pg8::Gemm g{(const pg8::bf16_t*)p.out, (const pg8::bf16_t*)(p.ws + WS_WTINP), NTOK, 2304, 1024};
      pg8::StaticOrder S; S.init(NTOK, 2304, (int)gridDim.x, (int)blockIdx.x);
      pg8::EpiProj E{(pg8::bf16_t*)(p.ws + WS_P1S), (pg8::bf16_t*)((unsigned char*)p.out + 32 * MiB), (pg8::bf16_t*)(p.ws + WS_PROJC)};
      pg8::gemm_phase<pg8::EpiProj, pg8::StaticOrder, true, true>((PG8_LAS unsigned char*)lds, g, S, E);
    }
    xcd_barrier(xb);
    phase1c(p, lds);
    if (2 < hi) xcd_barrier(xb);
  }
  if (p.ph_lo <= 2 && 2 < hi) { phase2_scan(p); phase2_attn(p, lds); if (probe == 3) phase2_attn(p, lds); if (3 < hi) xcd_barrier(xb); }
  if (p.ph_lo <= 3 && 3 < hi) {
    phase3(p, lds, 1, probe);
    xcd_barrier(xb);
    {
      pg8::Gemm g{(const pg8::bf16_t*)(p.ws + WS_P1S), (const pg8::bf16_t*)(p.ws + WS_WTOUTP), NTOK, 1024, 1024};
      pg8::StaticOrder S; S.init(NTOK, 1024, (int)gridDim.x, (int)blockIdx.x);
      pg8::EpiBf16<0> E{(pg8::bf16_t*)(p.ws + WS_QM), 1024, nullptr, 0, 0, 1.f};
      pg8::gemm_phase<pg8::EpiBf16<0>, pg8::StaticOrder, true, true>((PG8_LAS unsigned char*)lds, g, S, E);
    }
    xcd_barrier(xb);
    phase3c(p, lds, 1, probe);
    xcd_barrier(xb);
    {
      pg8::Gemm g{(const pg8::bf16_t*)(p.ws + WS_P1S), (const pg8::bf16_t*)(p.ws + WS_WTPQP), NTOK, 2048, 1024};
      pg8::StaticOrder S; S.init(NTOK, 2048, (int)gridDim.x, (int)blockIdx.x);
      pg8::EpiBf16<0> E{(pg8::bf16_t*)(p.ws + WS_QM), 2048, nullptr, 0, 0, 1.f};
      pg8::gemm_phase<pg8::EpiBf16<0>, pg8::StaticOrder, true, true>((PG8_LAS unsigned char*)lds, g, S, E);
    }
    xcd_barrier(xb);
    phase3b(p, lds, (probe == 4 || probe == 8) ? 2 : 1, probe);
  }
}

extern "C" void kernel_launch(void* const* d_in, const int* in_sizes, int n_in, void* d_out, int out_size, void* d_ws, size_t ws_size, hipStream_t stream) {
  float* out = (float*)d_out;
  unsigned char* ws = (unsigned char*)d_ws;
  if (ws_size < WS_END || n_in != 25) return;
  static bool attr_done = false;
  if (!attr_done) { (void)hipFuncSetAttribute((const void*)mega, hipFuncAttributeMaxDynamicSharedMemorySize, LDS_TOTAL); attr_done = true; }
  KP p{};
  for (int i = 0; i < 25; ++i) p.in[i] = (const float*)d_in[i];
  p.out = out; p.ws = ws;
  p.ph_lo = 0; p.ph_hi = 4;
  (void)hipMemsetAsync(ws + WS_BAR, 0, XCD_BAR_WORDS * 4, stream);
  { void* args[] = {&p}; (void)hipLaunchCooperativeKernel((const void*)mega, dim3(256), dim3(NTHR), args, LDS_TOTAL, stream); }
}
```

```cpp
#include <hip/hip_runtime.h>
#include <hip/hip_cooperative_groups.h>
namespace cg = cooperative_groups;
#include <stdint.h>

typedef unsigned short bf16_t;
#define DI __device__ __forceinline__

DI float bf2f(bf16_t v) { return __uint_as_float(((unsigned)v) << 16); }
DI bf16_t f2bf(float f) { return __builtin_bit_cast(unsigned short, (__bf16)f); }

constexpr int BATCH = 8, SEQ = 2048, DM = 1024, NTOK = BATCH * SEQ;
constexpr int INW = 2272;
constexpr float EPS = 1e-6f;
constexpr int O_CQ = 0, O_CKV = 384, O_KR = 640, O_QG = 704, O_KG = 960, O_VG = 1216, O_GF = 1728, O_GB = 1744, O_R = 1760;

DI float wave_sum(float v) {
#pragma unroll
  for (int o = 1; o < 64; o <<= 1) v += __shfl_xor(v, o);
  return v;
}
DI float wave_max(float v) {
#pragma unroll
  for (int o = 1; o < 64; o <<= 1) v = fmaxf(v, __shfl_xor(v, o));
  return v;
}
DI float block_sum256(float v, float* red) {
  v = wave_sum(v);
  __syncthreads();
  if ((threadIdx.x & 63) == 0) red[threadIdx.x >> 6] = v;
  __syncthreads();
  return red[0] + red[1] + red[2] + red[3];
}
DI float block_max256(float v, float* red) {
  v = wave_max(v);
  __syncthreads();
  if ((threadIdx.x & 63) == 0) red[threadIdx.x >> 6] = v;
  __syncthreads();
  return fmaxf(fmaxf(red[0], red[1]), fmaxf(red[2], red[3]));
}
DI float silu_f(float x) { return x / (1.f + expf(-x)); }
DI float logsigmoid_f(float x) { return fminf(x, 0.f) - log1pf(expf(-fabsf(x))); }
DI float fexp(float x) { return __builtin_amdgcn_exp2f(x * 1.4426950408889634f); }
DI float silu_fast(float x) { return x * __builtin_amdgcn_rcpf(1.f + fexp(-x)); }
DI float logsigmoid_fast(float x) { return fminf(x, 0.f) - __builtin_amdgcn_logf(1.f + fexp(-fabsf(x))) * 0.6931471805599453f; }
DI float gelu_erf(float x) { return 0.5f * x * (1.f + erff(x * 0.70710678118654752f)); }

__global__ __launch_bounds__(256) void n_mod(const float* __restrict__ c, const float* __restrict__ w_ada, const float* __restrict__ b_ada, float* __restrict__ mod) {
  int idx = blockIdx.x * 256 + threadIdx.x;
  int b = idx / 6144, j = idx % 6144;
  float acc = b_ada[j];
  for (int k = 0; k < 1024; ++k) acc += silu_f(c[b * 1024 + k]) * w_ada[(size_t)k * 6144 + j];
  mod[idx] = acc;
}

__global__ __launch_bounds__(256) void n_hnorm(const float* __restrict__ x, const float* __restrict__ g, const float* __restrict__ mod, int b, int off_sh, int off_sc, float* __restrict__ h) {
  __shared__ float red[4];
  int t = blockIdx.x, tid = threadIdx.x;
  const float* xr = x + ((size_t)b * SEQ + t) * DM;
  float v[4]; float ss = 0.f;
#pragma unroll
  for (int i = 0; i < 4; ++i) { v[i] = xr[tid + 256 * i]; ss += v[i] * v[i]; }
  ss = block_sum256(ss, red);
  float rs = rsqrtf(ss * (1.f / DM) + EPS);
#pragma unroll
  for (int i = 0; i < 4; ++i) { int d = tid + 256 * i; h[(size_t)t * DM + d] = v[i] * rs * g[d] * (1.f + mod[b * 6144 + off_sc + d]) + mod[b * 6144 + off_sh + d]; }
}

template <bool BT>
__global__ __launch_bounds__(256) void n_gemm(const float* __restrict__ A, int lda, const float* __restrict__ B, int ldb, float* __restrict__ C, int ldc, int M, int N, int K) {
  __shared__ float As[16][65];
  __shared__ float Bs[16][65];
  const int tid = threadIdx.x, tx = tid & 15, ty = tid >> 4;
  const int m0 = blockIdx.y * 64, n0 = blockIdx.x * 64;
  float acc[4][4];
#pragma unroll
  for (int i = 0; i < 4; ++i)
#pragma unroll
    for (int j = 0; j < 4; ++j) acc[i][j] = 0.f;
  for (int k0 = 0; k0 < K; k0 += 16) {
#pragma unroll
    for (int i = 0; i < 4; ++i) { int e = tid + 256 * i; int m = e >> 4, k = e & 15; As[k][m] = A[(size_t)(m0 + m) * lda + k0 + k]; }
#pragma unroll
    for (int i = 0; i < 4; ++i) { int e = tid + 256 * i;
      if (!BT) { int k = e >> 6, n = e & 63; Bs[k][n] = (n0 + n < N) ? B[(size_t)(k0 + k) * ldb + n0 + n] : 0.f; }
      else     { int n = e >> 4, k = e & 15; Bs[k][n] = (n0 + n < N) ? B[(size_t)(n0 + n) * ldb + k0 + k] : 0.f; } }
    __syncthreads();
#pragma unroll
    for (int k = 0; k < 16; ++k) {
      float a[4], bb[4];
#pragma unroll
      for (int i = 0; i < 4; ++i) { a[i] = As[k][ty * 4 + i]; bb[i] = Bs[k][tx * 4 + i]; }
#pragma unroll
      for (int i = 0; i < 4; ++i)
#pragma unroll
        for (int j = 0; j < 4; ++j) acc[i][j] += a[i] * bb[j];
    }
    __syncthreads();
  }
#pragma unroll
  for (int i = 0; i < 4; ++i)
#pragma unroll
    for (int j = 0; j < 4; ++j) { int n = n0 + tx * 4 + j; if (n < N) C[(size_t)(m0 + ty * 4 + i) * ldc + n] = acc[i][j]; }
}

__global__ __launch_bounds__(256) void n_rms_slice(const float* __restrict__ in, int ldin, int off, int W, const float* __restrict__ g, float* __restrict__ out) {
  __shared__ float red[4];
  int t = blockIdx.x, tid = threadIdx.x;
  float v0 = (tid < W) ? in[(size_t)t * ldin + off + tid] : 0.f;
  float v1 = (tid + 256 < W) ? in[(size_t)t * ldin + off + tid + 256] : 0.f;
  float ss = block_sum256(v0 * v0 + v1 * v1, red);
  float rs = rsqrtf(ss / (float)W + EPS);
  if (tid < W) out[(size_t)t * W + tid] = v0 * rs * g[tid];
  if (tid + 256 < W) out[(size_t)t * W + tid + 256] = v1 * rs * g[tid + 256];
}

__global__ __launch_bounds__(256) void n_scatter(const float* __restrict__ proj, const float* __restrict__ qa, const float* __restrict__ kv, const int* __restrict__ positions, int b,
                                                 const float* __restrict__ wgf, const float* __restrict__ bgf, const float* __restrict__ wgb, const float* __restrict__ bgb,
                                                 bf16_t* __restrict__ Qm, bf16_t* __restrict__ Km, bf16_t* __restrict__ Vm, bf16_t* __restrict__ qg, bf16_t* __restrict__ kg, bf16_t* __restrict__ vg,
                                                 bf16_t* __restrict__ rg, float* __restrict__ laf, float* __restrict__ lab) {
  __shared__ float cs[32], sn[32];
  const int t = blockIdx.x, tid = threadIdx.x;
  const size_t tok = (size_t)b * SEQ + t;
  const float* pr = proj + (size_t)t * INW;
  const float* qr = qa + (size_t)t * 768;
  const float* kr = kv + (size_t)t * 1024;
  if (tid < 32) {
    float inv = powf(10000.f, -(float)tid / 32.f);
    float ang = (float)positions[tok] * inv;
    cs[tid] = cosf(ang); sn[tid] = sinf(ang);
  }
  __syncthreads();
  for (int e = tid; e < 4 * 192; e += 256) {
    int h = e / 192, d = e % 192; float v;
    if (d < 128) v = qr[h * 192 + d];
    else { int j = d - 128; const float* rp = qr + h * 192 + 128;
      if (j < 32) v = rp[j] * cs[j] - rp[j + 32] * sn[j]; else v = rp[j] * cs[j - 32] + rp[j - 32] * sn[j - 32]; }
    Qm[(((size_t)b * 4 + h) * SEQ + t) * 192 + d] = f2bf(v);
  }
  for (int e = tid; e < 4 * 192; e += 256) {
    int h = e / 192, d = e % 192; float v;
    if (d < 128) v = kr[h * 256 + d];
    else { int j = d - 128; const float* rp = pr + O_KR;
      if (j < 32) v = rp[j] * cs[j] - rp[j + 32] * sn[j]; else v = rp[j] * cs[j - 32] + rp[j - 32] * sn[j - 32]; }
    Km[(((size_t)b * 4 + h) * SEQ + t) * 192 + d] = f2bf(v);
  }
  for (int e = tid; e < 512; e += 256) { int h = e >> 7, d = e & 127; Vm[(((size_t)b * 4 + h) * SEQ + t) * 128 + d] = f2bf(kr[h * 256 + 128 + d]); }
  { int e = tid; qg[tok * 256 + e] = f2bf(pr[O_QG + e] * 0.125f); kg[tok * 256 + e] = f2bf(pr[O_KG + e]); }
  for (int e = tid; e < 512; e += 256) { vg[tok * 512 + e] = f2bf(pr[O_VG + e]); rg[tok * 512 + e] = f2bf(pr[O_R + e]); }
  { int cidx = tid; float af = bgf[cidx], ab = bgb[cidx];
#pragma unroll
    for (int r = 0; r < 16; ++r) { af += pr[O_GF + r] * wgf[r * 256 + cidx]; ab += pr[O_GB + r] * wgb[r * 256 + cidx]; }
    laf[tok * 256 + cidx] = logsigmoid_f(af) * (1.f / 16.f); lab[tok * 256 + cidx] = logsigmoid_f(ab) * (1.f / 16.f); }
}

__global__ __launch_bounds__(256) void n_attn(const bf16_t* __restrict__ Qm, const bf16_t* __restrict__ Km, const bf16_t* __restrict__ Vm, bf16_t* __restrict__ omla) {
  __shared__ float qs[192]; __shared__ float sc[2048]; __shared__ float red[4];
  const int i = blockIdx.x, h = blockIdx.y, b = blockIdx.z, tid = threadIdx.x;
  const size_t bh = (size_t)b * 4 + h;
  if (tid < 192) qs[tid] = bf2f(Qm[(bh * SEQ + i) * 192 + tid]);
  __syncthreads();
  float mx = -1e30f;
  for (int kk = 0; kk < 8; ++kk) {
    int key = tid + 256 * kk; const uint4* kr = (const uint4*)(Km + (bh * SEQ + key) * 192);
    float s = 0.f;
    for (int c = 0; c < 24; ++c) { uint4 w = kr[c]; const float* q = qs + c * 8;
      s += q[0] * __uint_as_float(w.x << 16) + q[1] * __uint_as_float(w.x & 0xffff0000u) + q[2] * __uint_as_float(w.y << 16) + q[3] * __uint_as_float(w.y & 0xffff0000u)
         + q[4] * __uint_as_float(w.z << 16) + q[5] * __uint_as_float(w.z & 0xffff0000u) + q[6] * __uint_as_float(w.w << 16) + q[7] * __uint_as_float(w.w & 0xffff0000u); }
    s *= 0.07216878364870322f; sc[key] = s; mx = fmaxf(mx, s);
  }
  mx = block_max256(mx, red);
  float sum = 0.f;
  for (int kk = 0; kk < 8; ++kk) { int key = tid + 256 * kk; float p = expf(sc[key] - mx); sc[key] = p; sum += p; }
  sum = block_sum256(sum, red);
  __syncthreads();
  if (tid < 128) { float o = 0.f; const bf16_t* vp = Vm + bh * SEQ * 128 + tid;
    for (int key = 0; key < SEQ; ++key) o += sc[key] * bf2f(vp[(size_t)key * 128]);
    omla[((size_t)b * SEQ + i) * 512 + h * 128 + tid] = f2bf(o / sum); }
}

__global__ __launch_bounds__(128) void n_gla(const bf16_t* __restrict__ qg, const bf16_t* __restrict__ kg, const bf16_t* __restrict__ vg, const bf16_t* __restrict__ laf, const bf16_t* __restrict__ lab, float* __restrict__ og) {
  __shared__ float qs[64], ks[64], as[64];
  const int bh = blockIdx.x, b = bh >> 2, h = bh & 3, dv = threadIdx.x;
  for (int dir = 0; dir < 2; ++dir) {
    float S[64];
#pragma unroll
    for (int d = 0; d < 64; ++d) S[d] = 0.f;
    const bf16_t* la = dir ? lab : laf;
    for (int s = 0; s < SEQ; ++s) {
      const int t = dir ? (SEQ - 1 - s) : s; const size_t tok = (size_t)b * SEQ + t;
      __syncthreads();
      if (dv < 64) { qs[dv] = bf2f(qg[tok * 256 + h * 64 + dv]); ks[dv] = bf2f(kg[tok * 256 + h * 64 + dv]); as[dv] = expf(bf2f(la[tok * 256 + h * 64 + dv])); }
      __syncthreads();
      const float v = bf2f(vg[tok * 512 + h * 128 + dv]); float o = 0.f;
#pragma unroll
      for (int d = 0; d < 64; ++d) { S[d] = as[d] * S[d] + ks[d] * v; o += qs[d] * S[d]; }
      if (dir == 0) og[tok * 512 + h * 128 + dv] = o; else og[tok * 512 + h * 128 + dv] += o;
    }
  }
}

__global__ __launch_bounds__(256) void n_mix(const bf16_t* __restrict__ omla, const float* __restrict__ og, const bf16_t* __restrict__ rg, const float* __restrict__ g_gla, int b, float* __restrict__ mix) {
  __shared__ float ssum[4];
  const int t = blockIdx.x, tid = threadIdx.x; const size_t tok = (size_t)b * SEQ + t;
  if (tid < 4) ssum[tid] = 0.f;
  __syncthreads();
  float v[2];
#pragma unroll
  for (int i = 0; i < 2; ++i) { int e = tid + 256 * i; v[i] = og[tok * 512 + e]; atomicAdd(&ssum[e >> 7], v[i] * v[i]); mix[(size_t)t * DM + e] = bf2f(omla[tok * 512 + e]); }
  __syncthreads();
#pragma unroll
  for (int i = 0; i < 2; ++i) { int e = tid + 256 * i; float rs = rsqrtf(ssum[e >> 7] * (1.f / 128.f) + EPS);
    mix[(size_t)t * DM + 512 + e] = v[i] * rs * g_gla[e & 127] * silu_f(bf2f(rg[tok * 512 + e])); }
}

__global__ __launch_bounds__(256) void n_post1(const float* __restrict__ x, const float* __restrict__ y, const float* __restrict__ g_post, const float* __restrict__ g_pre2, const float* __restrict__ mod, int b,
                                               float* __restrict__ out, float* __restrict__ h2) {
  __shared__ float red[4];
  const int t = blockIdx.x, tid = threadIdx.x; const size_t tok = (size_t)b * SEQ + t;
  float yv[4], xv[4]; float ss = 0.f;
#pragma unroll
  for (int i = 0; i < 4; ++i) { yv[i] = y[(size_t)t * DM + tid + 256 * i]; ss += yv[i] * yv[i]; }
  ss = block_sum256(ss, red);
  float rs = rsqrtf(ss * (1.f / DM) + EPS); float s2 = 0.f;
#pragma unroll
  for (int i = 0; i < 4; ++i) { int d = tid + 256 * i; xv[i] = x[tok * DM + d] + mod[b * 6144 + 2048 + d] * (yv[i] * rs * g_post[d]); out[tok * DM + d] = xv[i]; s2 += xv[i] * xv[i]; }
  s2 = block_sum256(s2, red);
  float r2 = rsqrtf(s2 * (1.f / DM) + EPS);
#pragma unroll
  for (int i = 0; i < 4; ++i) { int d = tid + 256 * i; h2[(size_t)t * DM + d] = xv[i] * r2 * g_pre2[d] * (1.f + mod[b * 6144 + 4096 + d]) + mod[b * 6144 + 3072 + d]; }
}

DI void wave_argmax(float& v, int& i) {
#pragma unroll
  for (int o = 1; o < 64; o <<= 1) { float ov = __shfl_xor(v, o); int oi = __shfl_xor(i, o); if (ov > v || (ov == v && oi < i)) { v = ov; i = oi; } }
}
__global__ __launch_bounds__(256) void n_peer_select(const float* __restrict__ qry, const float* __restrict__ sk1, const float* __restrict__ sk2, int* __restrict__ eidx, float* __restrict__ gate) {
  __shared__ float v1s[4][16], v2s[4][16]; __shared__ int i1s[4][16], i2s[4][16];
  const int w = threadIdx.x >> 6, lane = threadIdx.x & 63;
  const int pair = blockIdx.x * 4 + w;
  const int t = pair >> 3, h = pair & 7;
  const float* q1 = qry + (size_t)t * 2048 + h * 256; const float* q2 = q1 + 128;
  float s1a = 0.f, s1b = 0.f, s2a = 0.f, s2b = 0.f;
  for (int d = 0; d < 128; ++d) { float a = q1[d], bq = q2[d];
    s1a += a * sk1[lane * 128 + d]; s1b += a * sk1[(lane + 64) * 128 + d]; s2a += bq * sk2[lane * 128 + d]; s2b += bq * sk2[(lane + 64) * 128 + d]; }
  for (int side = 0; side < 2; ++side) {
    float va = side ? s2a : s1a, vb = side ? s2b : s1b; bool ta = false, tb = false;
    for (int k = 0; k < 16; ++k) {
      float bv; int bi;
      if (!ta && (tb || va >= vb)) { bv = va; bi = lane; } else if (!tb) { bv = vb; bi = lane + 64; } else { bv = -3e38f; bi = 1 << 20; }
      wave_argmax(bv, bi);
      if (bi == lane) ta = true; if (bi == lane + 64) tb = true;
      if (lane == 0) { if (side) { v2s[w][k] = bv; i2s[w][k] = bi; } else { v1s[w][k] = bv; i1s[w][k] = bi; } }
    }
  }
  __syncthreads();
  float cv[4]; bool tk[4];
#pragma unroll
  for (int j = 0; j < 4; ++j) { int c = lane + 64 * j; cv[j] = v1s[w][c >> 4] + v2s[w][c & 15]; tk[j] = false; }
  float topv = 0.f; int topc = 0; float mx = 0.f;
  for (int k = 0; k < 16; ++k) {
    float bv = -3e38f; int bi = 1 << 20;
#pragma unroll
    for (int j = 0; j < 4; ++j) { if (!tk[j] && cv[j] > bv) { bv = cv[j]; bi = lane + 64 * j; } }
    wave_argmax(bv, bi);
#pragma unroll
    for (int j = 0; j < 4; ++j) if (bi == lane + 64 * j) tk[j] = true;
    if (k == 0) mx = bv;
    if (lane == k) { topv = bv; topc = bi; }
  }
  float e = (lane < 16) ? expf(topv - mx) : 0.f;
  float sum = wave_sum(e);
  if (lane < 16) { eidx[(size_t)pair * 16 + lane] = i1s[w][topc >> 4] * 128 + i2s[w][topc & 15]; gate[(size_t)pair * 16 + lane] = e / sum; }
}

__global__ __launch_bounds__(256) void n_peer_apply(const float* __restrict__ h2, const int* __restrict__ eidx, const float* __restrict__ gate, const float* __restrict__ eu, const float* __restrict__ ev,
                                                    const float* __restrict__ g_post, const float* __restrict__ mod, int b, float* __restrict__ out) {
  __shared__ float ys[4][1024]; __shared__ float red[4];
  const int t = blockIdx.x, tid = threadIdx.x, w = tid >> 6, lane = tid & 63; const size_t tok = (size_t)b * SEQ + t;
  float4 hx[4];
#pragma unroll
  for (int i = 0; i < 4; ++i) hx[i] = *(const float4*)(h2 + (size_t)t * DM + (lane + 64 * i) * 4);
  float4 acc[4];
#pragma unroll
  for (int i = 0; i < 4; ++i) acc[i] = make_float4(0.f, 0.f, 0.f, 0.f);
  for (int k = w; k < 128; k += 4) {
    const int e = eidx[(size_t)t * 128 + k]; const float gt = gate[(size_t)t * 128 + k];
    const float4* ur = (const float4*)(eu + (size_t)e * DM); const float4* vr = (const float4*)(ev + (size_t)e * DM);
    float d = 0.f;
#pragma unroll
    for (int i = 0; i < 4; ++i) { float4 u = ur[lane + 64 * i]; d += u.x * hx[i].x + u.y * hx[i].y + u.z * hx[i].z + u.w * hx[i].w; }
    d = wave_sum(d);
    const float wgt = gt * gelu_erf(d);
#pragma unroll
    for (int i = 0; i < 4; ++i) { float4 v = vr[lane + 64 * i]; acc[i].x += wgt * v.x; acc[i].y += wgt * v.y; acc[i].z += wgt * v.z; acc[i].w += wgt * v.w; }
  }
#pragma unroll
  for (int i = 0; i < 4; ++i) *(float4*)(&ys[w][(lane + 64 * i) * 4]) = acc[i];
  __syncthreads();
  float yv[4]; float ss = 0.f;
#pragma unroll
  for (int i = 0; i < 4; ++i) { int d = tid + 256 * i; yv[i] = ys[0][d] + ys[1][d] + ys[2][d] + ys[3][d]; ss += yv[i] * yv[i]; }
  ss = block_sum256(ss, red);
  const float rs = rsqrtf(ss * (1.f / DM) + EPS);
#pragma unroll
  for (int i = 0; i < 4; ++i) { int d = tid + 256 * i; out[tok * DM + d] = out[tok * DM + d] + mod[b * 6144 + 5120 + d] * (yv[i] * rs * g_post[d]); }
}

typedef short bf16x8 __attribute__((ext_vector_type(8)));
typedef float f32x16 __attribute__((ext_vector_type(16)));
#define MFMA32(a, b, c) __builtin_amdgcn_mfma_f32_32x32x16_bf16((a), (b), (c), 0, 0, 0)

constexpr int NTHR = 512;
constexpr size_t MiB = 1024 * 1024;
constexpr size_t WS_MOD   = 0;
constexpr size_t WS_WTIN  = 256 * 1024;
constexpr size_t WS_WTQUP = WS_WTIN + (size_t)2304 * 1024 * 2;
constexpr size_t WS_WTKVUP = WS_WTQUP + (size_t)768 * 384 * 2;
constexpr size_t WS_WTOUT = WS_WTKVUP + (size_t)1024 * 256 * 2;
constexpr size_t WS_WTPQ  = WS_WTOUT + (size_t)1024 * 1024 * 2;
constexpr size_t WS_KD    = WS_WTPQ + (size_t)2048 * 1024 * 2;
constexpr size_t WS_DEC   = WS_KD + (size_t)256 * 256 * 2;
constexpr size_t WS_ESC   = WS_DEC + (size_t)2048 * 64 * 4;
constexpr size_t WS_R0END = WS_ESC + (size_t)2 * 16384 * 4;
static_assert(WS_R0END <= 13 * MiB, "R0");
constexpr size_t WS_BAR  = 13 * MiB - 65536;
static_assert(WS_R0END + 131072 <= WS_BAR, "R0 room");
constexpr size_t WS_QM   = 13 * MiB;
constexpr size_t WS_KM   = WS_QM + 24 * MiB;
constexpr size_t WS_VM   = WS_KM + 24 * MiB;
constexpr size_t WS_P1S  = WS_VM + 16 * MiB;
constexpr size_t WS_RG   = WS_P1S + 32 * MiB;
constexpr size_t WS_OINTRA = WS_RG + 16 * MiB;
constexpr size_t WS_QDEC = WS_OINTRA + 16 * MiB;
constexpr size_t WS_SPT  = WS_QDEC + 16 * MiB;
constexpr size_t WS_EU   = WS_SPT + 32 * MiB;
constexpr size_t WS_EV   = WS_EU + 16 * MiB;
constexpr size_t WS_WTPQP = WS_EV + 16 * MiB;
constexpr size_t WS_WTOUTP = WS_WTPQP + 4 * MiB;
constexpr size_t WS_WTINP = WS_WTOUTP + 2 * MiB;
constexpr size_t WS_PROJC = WS_WTINP + 4608 * 1024;
constexpr size_t WS_END  = WS_PROJC + 8 * MiB;
static_assert(WS_P1S == WS_QM + 64 * MiB, "P3 QRY scratch aliases QM..VM");
constexpr size_t OUT_HS  = 0;
constexpr size_t OUT_CQ  = 32 * MiB;
constexpr size_t OUT_GR  = 52 * MiB;

struct KP { const float* in[25]; float* out; unsigned char* ws; int ph_lo, ph_hi; };

constexpr int G_STG = 40960;
constexpr int LDS_WT = 3 * G_STG;
constexpr int LDS_TAB = LDS_WT + 18432;
constexpr int LDS_XB = 157696;
constexpr int LDS_TOTAL = 157696 + 16;

typedef float f32x2_t __attribute__((ext_vector_type(2)));
typedef __bf16 bf16x2_t __attribute__((ext_vector_type(2)));
DI unsigned pack2(float lo, float hi) { const f32x2_t v = {lo, hi}; return __builtin_bit_cast(unsigned, __builtin_convertvector(v, bf16x2_t)); }
DI int crow(int reg, int hh) { return (reg & 3) + 8 * (reg >> 2) + 4 * hh; }

#define GLDS16(gp, lp) __builtin_amdgcn_global_load_lds((const unsigned*)(gp), (__attribute__((address_space(3))) unsigned*)(lp), 16, 0, 0)
template <int NST, class Epi>
DI void block_gemm(char* lds, const bf16_t* A, int lda, const bf16_t* Bt, int nchunks, int K, Epi&& epi) {
  const int tid = threadIdx.x, lane = tid & 63, w = __builtin_amdgcn_readfirstlane(tid >> 6), r = lane & 31, hh = lane >> 5;
  const int nk = K >> 6, T = nchunks * nk;
  constexpr int D = NST - 1;
  if (w >= 4) {
    const int j = w - 4, rin = lane >> 3, sw = ((lane & 7) ^ rin) * 8;
    const bf16_t* Ap = A + (size_t)(16 * j + rin) * lda + sw;
    const bf16_t* Bp = Bt + (size_t)(64 * j + rin) * 64 + sw;
    auto dma = [&](int g) {
      const int ch = g / nk, t = g - ch * nk; char* st = lds + (g % NST) * G_STG;
      const bf16_t* a0 = Ap + t * 64; char* la = st + (2 * j) * 1024;
      GLDS16(a0, la); GLDS16(a0 + (size_t)8 * lda, la + 1024);
      const bf16_t* b0 = Bp + (size_t)g * 16384; char* lb = st + 8192 + (8 * j) * 1024;
#pragma unroll
      for (int i = 0; i < 8; ++i) GLDS16(b0 + i * 512, lb + i * 1024);
    };
#pragma unroll
    for (int g = 0; g < D; ++g) if (g < T) dma(g);
    if (D >= 2 && T >= 2) asm volatile("s_waitcnt vmcnt(10)" ::: "memory"); else asm volatile("s_waitcnt vmcnt(0)" ::: "memory");
    __builtin_amdgcn_s_barrier();
#pragma unroll 1
    for (int g = 0; g < T; ++g) {
      if (g + D < T) { dma(g + D); if (D >= 2) asm volatile("s_waitcnt vmcnt(10)" ::: "memory"); else asm volatile("s_waitcnt vmcnt(0)" ::: "memory"); }
      else asm volatile("s_waitcnt vmcnt(0)" ::: "memory");
      __builtin_amdgcn_s_barrier();
    }
  } else {
    const int x = r & 7;
    const int o0 = ((0 + hh) ^ x) * 16, o1 = ((2 + hh) ^ x) * 16, o2 = ((4 + hh) ^ x) * 16, o3 = ((6 + hh) ^ x) * 16;
    const int a_rd = r * 128, b_rd = 8192 + (w * 64 + r) * 128;
    __builtin_amdgcn_s_barrier();
    int g = 0;
#pragma unroll 1
    for (int ch = 0; ch < nchunks; ++ch) {
      f32x16 c00, c01, c10, c11;
#pragma unroll
      for (int i = 0; i < 16; ++i) { c00[i] = 0.f; c01[i] = 0.f; c10[i] = 0.f; c11[i] = 0.f; }
#pragma unroll 1
      for (int t = 0; t < nk; ++t, ++g) {
        const char* cur = lds + (g % NST) * G_STG;
        bf16x8 fa0[4], fa1[4], fb0[4], fb1[4];
#define FRD(s_, o_) do { fa0[s_] = *(const bf16x8*)(cur + a_rd + o_); fb0[s_] = *(const bf16x8*)(cur + b_rd + o_); fb1[s_] = *(const bf16x8*)(cur + b_rd + 4096 + o_); fa1[s_] = *(const bf16x8*)(cur + a_rd + 4096 + o_); } while (0)
        FRD(0, o0); FRD(1, o1); FRD(2, o2); FRD(3, o3);
#undef FRD
        asm volatile("s_waitcnt lgkmcnt(0)" ::: "memory");
        __builtin_amdgcn_s_barrier();
        __builtin_amdgcn_sched_barrier(0);
#pragma unroll
        for (int s = 0; s < 4; ++s) {
          c00 = MFMA32(fa0[s], fb0[s], c00); c01 = MFMA32(fa0[s], fb1[s], c01); c10 = MFMA32(fa1[s], fb0[s], c10); c11 = MFMA32(fa1[s], fb1[s], c11); }
      }
      epi(0, ch * 256 + w * 64, c00, c01);
      epi(32, ch * 256 + w * 64, c10, c11);
    }
  }
}

DI void p0_transpose(char* lds, const float* __restrict__ W, int K, int N, bf16_t* __restrict__ Wt, int item, bf16_t* __restrict__ Wplain = nullptr) {
  float* s = (float*)lds;
  const int tid = threadIdx.x;
  const int ntn = (N + 63) >> 6, kt = item / ntn, nt = item % ntn, k0 = kt * 64, n0 = nt * 64;
  __syncthreads();
#pragma unroll
  for (int i = 0; i < 8; ++i) { int e = tid + 512 * i; int kk = e >> 6, nn = e & 63; s[kk * 65 + nn] = (n0 + nn < N) ? W[(size_t)(k0 + kk) * N + n0 + nn] : 0.f; }
  __syncthreads();
  const int nn = tid >> 3, part = tid & 7;
  const float* sp = s + (part * 8) * 65 + nn;
  uint4 o; o.x = pack2(sp[0], sp[65]); o.y = pack2(sp[2 * 65], sp[3 * 65]); o.z = pack2(sp[4 * 65], sp[5 * 65]); o.w = pack2(sp[6 * 65], sp[7 * 65]);
  { const int n = n0 + nn; *(uint4*)(Wt + ((size_t)((n >> 8) * (K >> 6) + kt)) * 16384 + (n & 255) * 64 + part * 8) = o; }
  if (Wplain) *(uint4*)(Wplain + (size_t)(n0 + nn) * K + k0 + part * 8) = o;
}

DI void phase0(const KP& p, char* lds) {
  const int tid = threadIdx.x, bid = blockIdx.x, nb = gridDim.x;
  unsigned char* ws = p.ws;
  constexpr int I_IN = 16 * 36, I_QUP = 6 * 12, I_KVUP = 4 * 16, I_OUT = 16 * 16, I_PQ = 16 * 32;
  constexpr int I_ALL = I_IN + I_QUP + I_KVUP + I_OUT + I_PQ;
  for (int it = bid; it < I_ALL; it += nb) {
    int q = it;
    if (q < I_IN) { p0_transpose(lds, p.in[7], 1024, 2272, (bf16_t*)(ws + WS_WTIN), q, (bf16_t*)(ws + WS_WTINP)); continue; } q -= I_IN;
    if (q < I_QUP) { p0_transpose(lds, p.in[9], 384, 768, (bf16_t*)(ws + WS_WTQUP), q); continue; } q -= I_QUP;
    if (q < I_KVUP) { p0_transpose(lds, p.in[11], 256, 1024, (bf16_t*)(ws + WS_WTKVUP), q); continue; } q -= I_KVUP;
    if (q < I_OUT) { p0_transpose(lds, p.in[17], 1024, 1024, (bf16_t*)(ws + WS_WTOUT), q, (bf16_t*)(ws + WS_WTOUTP)); continue; } q -= I_OUT;
    p0_transpose(lds, p.in[20], 1024, 2048, (bf16_t*)(ws + WS_WTPQ), q, (bf16_t*)(ws + WS_WTPQP));
  }
  { bf16_t* kd = (bf16_t*)(ws + WS_KD);
    for (int e = bid * NTHR + tid; e < 65536; e += nb * NTHR) { int n = e >> 8, k = e & 255; float v = 0.f;
      if (n < 128 && k < 128) v = p.in[21][n * 128 + k]; else if (n >= 128 && k >= 128) v = p.in[22][(n - 128) * 128 + (k - 128)];
      kd[(size_t)(k >> 6) * 16384 + n * 64 + (k & 63)] = f2bf(v); } }
  { const int lane = tid & 63; float* scl = (float*)(ws + WS_ESC);
    for (int row = bid * 8 + (tid >> 6); row < 32768; row += nb * 8) { const int t = row >> 14, e = row & 16383;
      const float* src = p.in[23 + t] + (size_t)e * 1024 + lane * 16;
      float4 x[4]; float am = 0.f;
#pragma unroll
      for (int i = 0; i < 4; ++i) { x[i] = *(const float4*)(src + 4 * i); am = fmaxf(am, fmaxf(fmaxf(fabsf(x[i].x), fabsf(x[i].y)), fmaxf(fabsf(x[i].z), fabsf(x[i].w)))); }
      am = wave_max(am);
      float sc = 1.f, isc = 1.f;
      if (am > 0.f) { int ex; (void)frexpf(448.f / am, &ex); sc = ldexpf(1.f, ex - 1); isc = ldexpf(1.f, 1 - ex); }
      unsigned wv[4];
#pragma unroll
      for (int i = 0; i < 4; ++i) { int q = __builtin_amdgcn_cvt_pk_fp8_f32(x[i].x * sc, x[i].y * sc, 0, false); q = __builtin_amdgcn_cvt_pk_fp8_f32(x[i].z * sc, x[i].w * sc, q, true); wv[i] = (unsigned)q; }
      *(uint4*)(ws + (t ? WS_EV : WS_EU) + (size_t)e * 1024 + lane * 16) = make_uint4(wv[0], wv[1], wv[2], wv[3]);
      if (lane == 0) scl[t * 16384 + e] = isc; } }
  for (int jb = bid; jb < 96; jb += nb) {
    __syncthreads();
    float* cact = (float*)lds;
    float* red = (float*)(lds + 32768);
    for (int e = tid; e < 8192; e += NTHR) cact[e] = silu_f(p.in[1][e]);
    __syncthreads();
    const int jj = tid & 63, ks = tid >> 6, j0 = jb * 64;
    float acc[8];
#pragma unroll
    for (int b = 0; b < 8; ++b) acc[b] = 0.f;
    const float* wp = p.in[3] + (size_t)(ks * 128) * 6144 + j0 + jj;
    for (int k = 0; k < 128; ++k) { const float wv = wp[(size_t)k * 6144];
#pragma unroll
      for (int b = 0; b < 8; ++b) acc[b] += cact[b * 1024 + ks * 128 + k] * wv; }
#pragma unroll
    for (int b = 0; b < 8; ++b) red[(ks * 64 + jj) * 8 + b] = acc[b];
    __syncthreads();
    { const int b = tid >> 6; float sacc = p.in[4][j0 + jj];
#pragma unroll
      for (int k2 = 0; k2 < 8; ++k2) sacc += red[(k2 * 64 + jj) * 8 + b];
      ((float*)(ws + WS_MOD))[b * 6144 + j0 + jj] = sacc; }
  }
}

constexpr int WT_STRIDE = 144, WT_BYTES = 32 * WT_STRIDE;
DI void wt_write(char* wl, const f32x16& a0, const f32x16& a1, int r, int hh, float scale) {
  char* bp = wl + (4 * hh) * WT_STRIDE + r * 2;
#pragma unroll
  for (int reg = 0; reg < 16; ++reg) { const int ro = ((reg & 3) + 8 * (reg >> 2)) * WT_STRIDE;
    *(bf16_t*)(bp + ro) = f2bf(a0[reg] * scale); *(bf16_t*)(bp + ro + 64) = f2bf(a1[reg] * scale); }
}
DI void wt_write_rope(char* wl, const f32x16& a0, const f32x16& a1, int r, int hh, const float* cs, const float* sn, int m0) {
  char* bp = wl + (4 * hh) * WT_STRIDE + r * 2;
#pragma unroll
  for (int reg = 0; reg < 16; ++reg) { const int rw = (reg & 3) + 8 * (reg >> 2); const int row = m0 + rw + 4 * hh;
    const float c = cs[row * 32 + r], s = sn[row * 32 + r];
    *(bf16_t*)(bp + rw * WT_STRIDE) = f2bf(a0[reg] * c - a1[reg] * s); *(bf16_t*)(bp + rw * WT_STRIDE + 64) = f2bf(a1[reg] * c + a0[reg] * s); }
}
DI void wt_store(const char* wl, int lane, bf16_t* dA, int sA, bf16_t* dB, int sB) {
  const int piece = lane & 7, rsub = lane >> 3;
  bf16_t* d = (piece < 4) ? dA : dB; const int st = (piece < 4) ? sA : sB;
  if (d) {
#pragma unroll
    for (int i = 0; i < 4; ++i) { const int row = i * 8 + rsub; const uint4 v = *(const uint4*)(wl + row * WT_STRIDE + piece * 16);
      *(uint4*)(d + (size_t)row * st + (piece & 3) * 8) = v; }
  }
}
#define LDS_FENCE() asm volatile("s_waitcnt lgkmcnt(0)" ::: "memory")
DI int lv(int x) { asm volatile("" : "+v"(x)); return x; }
template <class T> DI T* launder(T* q) { size_t z = 0; asm volatile("" : "+s"(z)); return (T*)((char*)q + z); }

constexpr int GL_GR = 0, GL_VT = 8192, GL_QD = 26624, GL_KI = 45056, GL_KIT = 63488, GL_ATT = 81920, GL_TOT = 91136, GL_DEC = 93184, GL_LA = 93696  , GL_QS = 126464  , GL_KS = 134656;
DI void gla_chunk_local(const KP& p, char* lds, unsigned char* ws, int tile, const bf16_t* PA, const bf16_t* PB) {
  const int tid = lv(threadIdx.x), lane = tid & 63, w = tid >> 6, r = lane & 31, hh = lane >> 5;
  const int b = tile >> 5, n = tile & 31, tok0 = tile * 64;
  float* GRL = (float*)(lds + GL_GR); float* TOT = (float*)(lds + GL_TOT); float* DECL = (float*)(lds + GL_DEC);
  __syncthreads();
#pragma unroll
  for (int i = 0; i < 4; ++i) { const int e = tid + 512 * i; GRL[e] = bf2f(PB[(size_t)(e >> 5) * 1024 + (O_GF - 1024) + (e & 31)]); }
#pragma unroll 1
  for (int h = 0; h < 4; ++h) {
    __syncthreads();
    { const int t = tid >> 3, c8 = (tid & 7) * 8;
      *(uint4*)(lds + GL_QS + (t * 64 + c8) * 2) = *(const uint4*)(PA + (size_t)t * 1024 + O_QG + h * 64 + c8);
      *(uint4*)(lds + GL_KS + (t * 64 + c8) * 2) = (h == 0) ? *(const uint4*)(PA + (size_t)t * 1024 + O_KG + c8) : *(const uint4*)(PB + (size_t)t * 1024 + (O_KG - 1024) + h * 64 + c8); }
#pragma unroll
    for (int i = 0; i < 2; ++i) { const int c = tid + 512 * i, t = c >> 4, d8 = (c & 15) * 8;
      const uint4 v = *(const uint4*)(PB + (size_t)t * 1024 + (O_VG - 1024) + h * 128 + d8);
      bf16_t* vt = (bf16_t*)(lds + GL_VT) + d8 * 72 + t;
      vt[0] = (bf16_t)(v.x & 0xffffu); vt[72] = (bf16_t)(v.x >> 16); vt[144] = (bf16_t)(v.y & 0xffffu); vt[216] = (bf16_t)(v.y >> 16);
      vt[288] = (bf16_t)(v.z & 0xffffu); vt[360] = (bf16_t)(v.z >> 16); vt[432] = (bf16_t)(v.w & 0xffffu); vt[504] = (bf16_t)(v.w >> 16); }
    const int dir = tid >> 8, qt = (tid >> 6) & 3, dk = tid & 63, col = h * 64 + dk;
    float* LAL = (float*)(lds + GL_LA) + tid;
    {
      const float* wg = launder(dir ? p.in[14] : p.in[12]); const float* bg = launder(dir ? p.in[15] : p.in[13]);
      float wr[16];
#pragma unroll
      for (int q = 0; q < 16; ++q) wr[q] = wg[q * 256 + col];
      const float bias = bg[col];
      float run = 0.f;
#pragma unroll 2
      for (int ii = 0; ii < 16; ++ii) { const int i = dir ? 15 - ii : ii;
        const float* gp = GRL + (qt * 16 + i) * 32 + dir * 16; float x = bias;
#pragma unroll
        for (int q = 0; q < 16; ++q) x += gp[q] * wr[q];
        run += logsigmoid_fast(x) * (1.f / 16.f); LAL[i * 512] = run; }
      TOT[(dir * 64 + dk) * 4 + qt] = run;
    }
    __syncthreads();
    {
      const float4 tq = *(const float4*)(TOT + (dir * 64 + dk) * 4);
      const float total = (tq.x + tq.y) + (tq.z + tq.w);
      float off;
      if (dir == 0) off = (qt > 0 ? tq.x : 0.f) + (qt > 1 ? tq.y : 0.f) + (qt > 2 ? tq.z : 0.f);
      else          off = (qt < 1 ? tq.y : 0.f) + (qt < 2 ? tq.z : 0.f) + (qt < 3 ? tq.w : 0.f);
      if (qt == 0) { const float dc = fexp(total); DECL[dir * 64 + dk] = dc; ((float*)(ws + WS_DEC))[((size_t)((b * 4 + h) * 2 + dir) * 32 + n) * 64 + dk] = dc; }
      bf16_t* QD = (bf16_t*)(lds + GL_QD + dir * 9216) + (qt * 16) * 72 + dk; bf16_t* KI = (bf16_t*)(lds + GL_KI + dir * 9216) + (qt * 16) * 72 + dk;
      bf16_t* KIT = (bf16_t*)(lds + GL_KIT + dir * 9216) + dk * 72 + qt * 16;
      bf16_t* qdg = (bf16_t*)(ws + WS_QDEC) + (size_t)((tile * 4 + h) * 2 + dir) * 4096 + (qt * 16) * 64 + dk;
      const bf16_t* qgp = (const bf16_t*)(lds + GL_QS) + (qt * 16) * 64 + dk; const bf16_t* kgp = (const bf16_t*)(lds + GL_KS) + (qt * 16) * 64 + dk;
#pragma unroll 2
      for (int i = 0; i < 16; ++i) { const float bb = off + LAL[i * 512];
        const float qv = bf2f(qgp[i * 64]) * 0.125f, kv = bf2f(kgp[i * 64]);
        const float eb = fexp(bb); const bf16_t qd = f2bf(qv * eb), ki = f2bf(kv * __builtin_amdgcn_rcpf(eb));
        QD[i * 72] = qd; KI[i * 72] = ki; qdg[i * 64] = qd; KIT[i] = ki; }
    }
    __syncthreads();
    if (w < 4) { const int mi = w >> 1, ni = w & 1;
      f32x16 asum;
#pragma unroll
      for (int i = 0; i < 16; ++i) asum[i] = 0.f;
#pragma unroll
      for (int d = 0; d < 2; ++d) { f32x16 acc;
#pragma unroll
        for (int i = 0; i < 16; ++i) acc[i] = 0.f;
#pragma unroll
        for (int s = 0; s < 4; ++s) { const bf16x8 a = *(const bf16x8*)(lds + GL_QD + d * 9216 + (mi * 32 + r) * 144 + s * 32 + hh * 16);
          const bf16x8 bb = *(const bf16x8*)(lds + GL_KI + d * 9216 + (ni * 32 + r) * 144 + s * 32 + hh * 16); acc = MFMA32(a, bb, acc); }
#pragma unroll
        for (int reg = 0; reg < 16; ++reg) { const int ti = mi * 32 + crow(reg, hh), tj = ni * 32 + r; const bool keep = d ? (tj >= ti) : (tj <= ti); asum[reg] += keep ? acc[reg] : 0.f; } }
      bf16_t* at = (bf16_t*)(lds + GL_ATT) + (mi * 32 + 4 * hh) * 72 + ni * 32 + r;
#pragma unroll
      for (int reg = 0; reg < 16; ++reg) at[((reg & 3) + 8 * (reg >> 2)) * 72] = f2bf(asum[reg]);
    }
    __syncthreads();
    { const int mi = w >> 2, ni = w & 3; f32x16 acc;
#pragma unroll
      for (int i = 0; i < 16; ++i) acc[i] = 0.f;
#pragma unroll
      for (int s = 0; s < 4; ++s) { const bf16x8 a = *(const bf16x8*)(lds + GL_ATT + (mi * 32 + r) * 144 + s * 32 + hh * 16);
        const bf16x8 bb = *(const bf16x8*)(lds + GL_VT + (ni * 32 + r) * 144 + s * 32 + hh * 16); acc = MFMA32(a, bb, acc); }
      bf16_t* oi = (bf16_t*)(ws + WS_OINTRA) + (size_t)(tok0 + mi * 32 + 4 * hh) * 512 + h * 128 + ni * 32 + r;
#pragma unroll
      for (int reg = 0; reg < 16; ++reg) oi[(size_t)((reg & 3) + 8 * (reg >> 2)) * 512] = f2bf(acc[reg]); }
    { const int dvb = w >> 1, dkb = w & 1;
#pragma unroll
      for (int d = 0; d < 2; ++d) { f32x16 acc;
#pragma unroll
        for (int i = 0; i < 16; ++i) acc[i] = 0.f;
#pragma unroll
        for (int s = 0; s < 4; ++s) { const bf16x8 a = *(const bf16x8*)(lds + GL_VT + (dvb * 32 + r) * 144 + s * 32 + hh * 16);
          const bf16x8 bb = *(const bf16x8*)(lds + GL_KIT + d * 9216 + (dkb * 32 + r) * 144 + s * 32 + hh * 16); acc = MFMA32(a, bb, acc); }
        const float sc = DECL[d * 64 + dkb * 32 + r];
        bf16_t* ds = (bf16_t*)(ws + WS_SPT) + ((size_t)((b * 4 + h) * 2 + d) * 32 + n) * 8192 + (size_t)(dvb * 32 + 4 * hh) * 64 + dkb * 32 + r;
#pragma unroll
        for (int reg = 0; reg < 16; ++reg) ds[((reg & 3) + 8 * (reg >> 2)) * 64] = f2bf(acc[reg] * sc); } }
  }
}

DI void phase1a(const KP& p, char* lds) {
  const int tid = threadIdx.x, lane = tid & 63, w = tid >> 6;
  for (int tile = blockIdx.x; tile < 256; tile += gridDim.x) {
    unsigned char* ws = launder(p.ws); unsigned char* ob = (unsigned char*)launder(p.out); const float* xin = launder(p.in[0]);
    const float* mod = (const float*)(ws + WS_MOD);
    const int tok0 = tile * 64, b = tile >> 5;
    bf16_t* Hs = (bf16_t*)(ob + OUT_HS) + (size_t)tok0 * 1024;
    float4 ge[4], sh[4];
    const float* gpre = launder(p.in[5]); const float* modb = launder(mod) + b * 6144;
#pragma unroll
    for (int i = 0; i < 4; ++i) { const int d = (lane + 64 * i) * 4;
      const float4 g = *(const float4*)(gpre + d); const float4 sc = *(const float4*)(modb + 1024 + d); sh[i] = *(const float4*)(modb + d);
      ge[i] = make_float4(g.x * (1.f + sc.x), g.y * (1.f + sc.y), g.z * (1.f + sc.z), g.w * (1.f + sc.w)); }
#pragma unroll 2
    for (int rr = 0; rr < 8; ++rr) { const int row = w * 8 + rr;
      const float* xr = xin + (size_t)(tok0 + row) * 1024;
      float4 v[4]; float ss = 0.f;
#pragma unroll
      for (int i = 0; i < 4; ++i) { v[i] = *(const float4*)(xr + (lane + 64 * i) * 4); ss += v[i].x * v[i].x + v[i].y * v[i].y + v[i].z * v[i].z + v[i].w * v[i].w; }
      ss = wave_sum(ss); const float rs = rsqrtf(ss * (1.f / 1024.f) + EPS);
#pragma unroll
      for (int i = 0; i < 4; ++i) { uint2 o; o.x = pack2(v[i].x * rs * ge[i].x + sh[i].x, v[i].y * rs * ge[i].y + sh[i].y); o.y = pack2(v[i].z * rs * ge[i].z + sh[i].z, v[i].w * rs * ge[i].w + sh[i].w);
        *(uint2*)(Hs + (size_t)row * 1024 + (lane + 64 * i) * 4) = o; }
    }
  }
}

DI void phase1c(const KP& p, char* lds) {
  const int tid = threadIdx.x, lane = tid & 63, w = tid >> 6, r = lane & 31, hh = lane >> 5;
  float* cs = (float*)(lds + LDS_TAB); float* sn = cs + 2048;
  char* wl = lds + LDS_WT + (w & 3) * WT_BYTES;
  for (int tile = blockIdx.x; tile < 256; tile += gridDim.x) {
    unsigned char* ws = launder(p.ws); unsigned char* ob = (unsigned char*)launder(p.out);
    const int tok0 = tile * 64, b = tile >> 5, t0 = (tile & 31) * 64;
    const bf16_t* PA = (const bf16_t*)(ws + WS_P1S) + (size_t)tok0 * 1024;
    const bf16_t* PB = (const bf16_t*)(ob + 32 * MiB) + (size_t)tok0 * 1024;
    const bf16_t* PC = (const bf16_t*)(ws + WS_PROJC) + (size_t)tok0 * 256;
    bf16_t* Hs = (bf16_t*)(ob + OUT_HS) + (size_t)tok0 * 1024;
    bf16_t* CQN = Hs; bf16_t* CKVN = Hs + 64 * 384;
    bf16_t* Qm = (bf16_t*)(ws + WS_QM); bf16_t* Km = (bf16_t*)(ws + WS_KM); bf16_t* Vm = (bf16_t*)(ws + WS_VM);
    bf16_t* rg = (bf16_t*)(ws + WS_RG) + (size_t)tok0 * 512;
    __syncthreads();
#pragma unroll
    for (int i = 0; i < 4; ++i) { const int e = tid + 512 * i, tt = e >> 5, j = e & 31;
      const float inv = __builtin_amdgcn_exp2f(-(float)j * (13.287712379549449f / 32.f)); const float ang = (float)((const int*)p.in[2])[tok0 + tt] * inv;
      float rev = ang * 0.15915494309189535f; rev -= floorf(rev);
      cs[e] = __builtin_amdgcn_cosf(rev); sn[e] = __builtin_amdgcn_sinf(rev); }
#pragma unroll
    for (int i = 0; i < 8; ++i) { const int c = tid + 512 * i, row = c >> 6, cc = c & 63;
      const uint4 v = (cc < 36) ? *(const uint4*)(PB + (size_t)row * 1024 + (O_R - 1024) + cc * 8) : *(const uint4*)(PC + (size_t)row * 256 + (cc - 36) * 8);
      *(uint4*)(rg + (size_t)row * 512 + cc * 8) = v; }
    __syncthreads();
    if (tid < 256) { const int row = tid >> 2, pc = tid & 3;
      const uint4 x1 = *(const uint4*)(PA + (size_t)row * 1024 + O_KR + pc * 8), x2 = *(const uint4*)(PA + (size_t)row * 1024 + O_KR + 32 + pc * 8);
      const float4 c0 = *(const float4*)(cs + row * 32 + pc * 8), c1 = *(const float4*)(cs + row * 32 + pc * 8 + 4), s0 = *(const float4*)(sn + row * 32 + pc * 8), s1 = *(const float4*)(sn + row * 32 + pc * 8 + 4);
#define RO1(a_, b_, c_, s_) ((a_) * (c_) - (b_) * (s_))
#define RO2(a_, b_, c_, s_) ((b_) * (c_) + (a_) * (s_))
#define LO(u_) __uint_as_float((u_) << 16)
#define HI(u_) __uint_as_float((u_) & 0xffff0000u)
      uint4 o1, o2;
      o1.x = pack2(RO1(LO(x1.x), LO(x2.x), c0.x, s0.x), RO1(HI(x1.x), HI(x2.x), c0.y, s0.y)); o1.y = pack2(RO1(LO(x1.y), LO(x2.y), c0.z, s0.z), RO1(HI(x1.y), HI(x2.y), c0.w, s0.w));
      o1.z = pack2(RO1(LO(x1.z), LO(x2.z), c1.x, s1.x), RO1(HI(x1.z), HI(x2.z), c1.y, s1.y)); o1.w = pack2(RO1(LO(x1.w), LO(x2.w), c1.z, s1.z), RO1(HI(x1.w), HI(x2.w), c1.w, s1.w));
      o2.x = pack2(RO2(LO(x1.x), LO(x2.x), c0.x, s0.x), RO2(HI(x1.x), HI(x2.x), c0.y, s0.y)); o2.y = pack2(RO2(LO(x1.y), LO(x2.y), c0.z, s0.z), RO2(HI(x1.y), HI(x2.y), c0.w, s0.w));
      o2.z = pack2(RO2(LO(x1.z), LO(x2.z), c1.x, s1.x), RO2(HI(x1.z), HI(x2.z), c1.y, s1.y)); o2.w = pack2(RO2(LO(x1.w), LO(x2.w), c1.z, s1.z), RO2(HI(x1.w), HI(x2.w), c1.w, s1.w));
#undef RO1
#undef RO2
#undef LO
#undef HI
#pragma unroll
      for (int h = 0; h < 4; ++h) { bf16_t* kp = Km + (((size_t)b * 4 + h) * SEQ + t0 + row) * 192 + 128 + pc * 8; *(uint4*)kp = o1; *(uint4*)(kp + 32) = o2; }
    }
    const float* gq = launder(p.in[8]); const float* gkv = launder(p.in[10]);
#pragma unroll 2
    for (int rr = 0; rr < 8; ++rr) { const int row = w * 8 + rr; const unsigned* cr = (const unsigned*)(PA + (size_t)row * 1024);
      float v0[5], v1[5];
#pragma unroll
      for (int i = 0; i < 5; ++i) { const unsigned u = cr[lane + 64 * i]; v0[i] = __uint_as_float(u << 16); v1[i] = __uint_as_float(u & 0xffff0000u); }
      float ss = v0[0] * v0[0] + v1[0] * v1[0] + v0[1] * v0[1] + v1[1] * v1[1] + v0[2] * v0[2] + v1[2] * v1[2];
      float s2 = v0[3] * v0[3] + v1[3] * v1[3] + v0[4] * v0[4] + v1[4] * v1[4];
      ss = wave_sum(ss); s2 = wave_sum(s2);
      const float rq = rsqrtf(ss * (1.f / 384.f) + EPS), rk = rsqrtf(s2 * (1.f / 256.f) + EPS);
#pragma unroll
      for (int i = 0; i < 3; ++i) { const int c = 2 * (lane + 64 * i); *(unsigned*)(CQN + (size_t)row * 384 + c) = pack2(v0[i] * rq * gq[c], v1[i] * rq * gq[c + 1]); }
#pragma unroll
      for (int i = 3; i < 5; ++i) { const int c = 2 * (lane + 64 * (i - 3)); *(unsigned*)(CKVN + (size_t)row * 256 + c) = pack2(v0[i] * rk * gkv[c], v1[i] * rk * gkv[c + 1]); }
    }
    __syncthreads();
    block_gemm<3>(lds, CQN, 384, (const bf16_t*)(ws + WS_WTQUP), 3, 384, [&](int m0, int n0, const f32x16& a0, const f32x16& a1) {
      const int r2 = lv(r), h2 = lv(hh), ln = lv(lane);
      const int h = n0 / 192, d0 = n0 % 192;
      bf16_t* qp = Qm + (((size_t)b * 4 + h) * SEQ + t0 + m0) * 192 + d0;
      if (d0 < 128) wt_write(wl, a0, a1, r2, h2, 1.f); else wt_write_rope(wl, a0, a1, r2, h2, cs, sn, m0);
      LDS_FENCE();
      wt_store(wl, ln, qp, 192, qp + 32, 192);
    });
    block_gemm<3>(lds, CKVN, 256, (const bf16_t*)(ws + WS_WTKVUP), 4, 256, [&](int m0, int n0, const f32x16& a0, const f32x16& a1) {
      const int r2 = lv(r), h2 = lv(hh), ln = lv(lane);
      const int h = n0 >> 8, d0 = n0 & 255;
      wt_write(wl, a0, a1, r2, h2, 1.f); LDS_FENCE();
      if (d0 < 128) { bf16_t* kp = Km + (((size_t)b * 4 + h) * SEQ + t0 + m0) * 192 + d0; wt_store(wl, ln, kp, 192, kp + 32, 192); }
      else { bf16_t* vp = Vm + (((size_t)b * 4 + h) * SEQ + t0 + m0) * 128 + (d0 - 128); wt_store(wl, ln, vp, 128, vp + 32, 128); }
    });
    gla_chunk_local(p, lds, ws, tile, PA, PB);
  }
}

namespace att {
typedef short s16x4 __attribute__((ext_vector_type(4)));
typedef unsigned u32x4 __attribute__((ext_vector_type(4)));
constexpr int DQ = 192, DV = 128, KVBLK = 64;
constexpr float SCALE = 0.07216878364870322f;
constexpr float THR = 8.f;
constexpr int SHM_V = KVBLK * DV * 2, SHM_K = KVBLK * DQ * 2;
constexpr int SHM_QR = 8 * 32 * 176;
constexpr int SHM_ATTN = 2 * SHM_V + 2 * SHM_K + 8 * 64 * 4 + SHM_QR;
#define KSWZ(row, colB) ((row) * 384 + ((colB) ^ (((row) & 7) << 4)))
#define SBAR() __builtin_amdgcn_sched_barrier(0)
DI unsigned cvtpk(float lo, float hi) { unsigned r; asm volatile("v_cvt_pk_bf16_f32 %0, %1, %2" : "=v"(r) : "v"(lo), "v"(hi)); return r; }

DI void partialSM(f32x16& p0, f32x16& p1, float& m_reg, float& mn, float& alpha) {
  constexpr float C = SCALE * 1.4426950408889634f;
  float pmax = p0[0];
#pragma unroll
  for (int r = 1; r < 16; ++r) pmax = fmaxf(pmax, p0[r]);
#pragma unroll
  for (int r = 0; r < 16; ++r) pmax = fmaxf(pmax, p1[r]);
  { auto rr = __builtin_amdgcn_permlane32_swap(__float_as_uint(pmax), __float_as_uint(pmax), false, false);
    pmax = fmaxf(__uint_as_float(rr[0]), __uint_as_float(rr[1])); }
  if (__builtin_expect(__all(pmax - m_reg <= THR / SCALE), 1)) { mn = m_reg; alpha = 1.f; }
  else { mn = fmaxf(m_reg, pmax); alpha = __builtin_amdgcn_exp2f((m_reg - mn) * C); m_reg = mn; }
  const float mnC = -mn * C;
#pragma unroll
  for (int r = 0; r < 16; ++r) p0[r] = fmaf(p0[r], C, mnC);
#pragma unroll
  for (int r = 0; r < 16; ++r) p1[r] = fmaf(p1[r], C, mnC);
#pragma unroll
  for (int r = 0; r < 16; ++r) p0[r] = __builtin_amdgcn_exp2f(p0[r]);
}
DI void finishSM(f32x16& p0, f32x16& p1, float alpha, float& l_reg, bf16x8& pa0, bf16x8& pa1, bf16x8& pa2, bf16x8& pa3) {
#pragma unroll
  for (int r = 0; r < 16; ++r) p1[r] = __builtin_amdgcn_exp2f(p1[r]);
  float ps = 0;
#pragma unroll
  for (int r = 0; r < 16; ++r) ps += p0[r];
#pragma unroll
  for (int r = 0; r < 16; ++r) ps += p1[r];
  { auto rr = __builtin_amdgcn_permlane32_swap(__float_as_uint(ps), __float_as_uint(ps), false, false);
    ps = __uint_as_float(rr[0]) + __uint_as_float(rr[1]); }
  l_reg = l_reg * alpha + ps;
#define PK4(P, BASE, OUT) do { unsigned a0 = cvtpk(P[BASE + 0], P[BASE + 1]), a1 = cvtpk(P[BASE + 2], P[BASE + 3]);   \
    unsigned b0 = cvtpk(P[BASE + 4], P[BASE + 5]), b1 = cvtpk(P[BASE + 6], P[BASE + 7]);                              \
    auto r0 = __builtin_amdgcn_permlane32_swap(a0, b0, false, false); auto r1 = __builtin_amdgcn_permlane32_swap(a1, b1, false, false); \
    u32x4 wv = {r0[0], r1[0], r0[1], r1[1]}; OUT = *reinterpret_cast<bf16x8*>(&wv); } while (0)
  PK4(p0, 0, pa0); PK4(p0, 8, pa1); PK4(p1, 0, pa2); PK4(p1, 8, pa3);
#undef PK4
}
DI void qkt(f32x16& p0, f32x16& p1, const char* Ks, const bf16x8* qr, const char* qrl, int r32, int hi) {
#pragma unroll
  for (int i = 0; i < 16; ++i) { p0[i] = 0.f; p1[i] = 0.f; }
#pragma unroll
  for (int d0 = 0; d0 < 12; ++d0) { const int cb = (d0 * 16 + hi * 8) * 2;
    const bf16x8 b0 = *reinterpret_cast<const bf16x8*>(Ks + KSWZ(r32, cb));
    const bf16x8 b1 = *reinterpret_cast<const bf16x8*>(Ks + KSWZ(32 + r32, cb));
    const bf16x8 q = (d0 < 7) ? qr[d0 < 7 ? d0 : 0] : *reinterpret_cast<const bf16x8*>(qrl + (d0 - 7) * 32);
    p0 = MFMA32(b0, q, p0);
    p1 = MFMA32(b1, q, p1); }
}
DI int v_st(int k, int c) { const int kk = (k & ~0xC) | ((k & 4) << 1) | ((k & 8) >> 1); return ((kk >> 3) * 4 + (c >> 5)) * 512 + ((kk & 7) * 32 + (c & 31)) * 2; }
DI int v_rd_base(int lane) { return ((lane & 3) << 3) | (((lane >> 2) & 3) << 6) | (((lane >> 4) & 1) << 5) | (((lane >> 5) & 1) << 8); }
constexpr int v_rd_off(int d0, int ks, int half) { return d0 * 512 + ks * 4096 + half * 2048; }
template <int OFF> DI s16x4 tr_read(int vb) { s16x4 r; asm volatile("ds_read_b64_tr_b16 %0, %1 offset:%2" : "=&v"(r) : "v"(vb), "i"(OFF) : "memory"); return r; }
template <int D0> DI void pv_one(f32x16& od, int vb, bf16x8 pa0, bf16x8 pa1, bf16x8 pa2, bf16x8 pa3) {
  const s16x4 l0 = tr_read<v_rd_off(D0, 0, 0)>(vb), h0 = tr_read<v_rd_off(D0, 0, 1)>(vb), l1 = tr_read<v_rd_off(D0, 1, 0)>(vb), h1 = tr_read<v_rd_off(D0, 1, 1)>(vb);
  const s16x4 l2 = tr_read<v_rd_off(D0, 2, 0)>(vb), h2 = tr_read<v_rd_off(D0, 2, 1)>(vb), l3 = tr_read<v_rd_off(D0, 3, 0)>(vb), h3 = tr_read<v_rd_off(D0, 3, 1)>(vb);
  asm volatile("s_waitcnt lgkmcnt(0)" ::: "memory"); SBAR();
#define PK(L, H) (bf16x8){L[0], L[1], L[2], L[3], H[0], H[1], H[2], H[3]}
  od = MFMA32(pa0, PK(l0, h0), od);
  od = MFMA32(pa1, PK(l1, h1), od);
  od = MFMA32(pa2, PK(l2, h2), od);
  od = MFMA32(pa3, PK(l3, h3), od);
#undef PK
}
DI void pv_d0(f32x16* o, int vb, bf16x8 pa0, bf16x8 pa1, bf16x8 pa2, bf16x8 pa3) {
  pv_one<0>(o[0], vb, pa0, pa1, pa2, pa3); pv_one<1>(o[1], vb, pa0, pa1, pa2, pa3); pv_one<2>(o[2], vb, pa0, pa1, pa2, pa3); pv_one<3>(o[3], vb, pa0, pa1, pa2, pa3);
}
DI void attn_unit(const bf16_t* Qb, const bf16_t* Kh, const bf16_t* Vh, bf16_t* Ob, int seq, char* lds) {
  const int tid = lv(threadIdx.x), wid = tid >> 6, lane = tid & 63, r32 = lane & 31, hi = lane >> 5;
  char* V_lds = lds; char* K_lds = lds + 2 * SHM_V;
  float* wsf = (float*)(lds + 2 * SHM_V + 2 * SHM_K) + wid * 64; float* li_l = wsf; float* al_l = wsf + 32;
  char* qrl = lds + 2 * SHM_V + 2 * SHM_K + 8 * 64 * 4 + wid * (32 * 176) + r32 * 176 + hi * 16;
  float m_reg = -1e30f, l_reg = 0; f32x16 o[4]; bf16x8 qr[7];
#pragma unroll
  for (int d = 0; d < 4; ++d)
#pragma unroll
    for (int i = 0; i < 16; ++i) o[d][i] = 0.f;
  const bf16_t* Qw = Qb + (size_t)(wid * 32 + r32) * DQ + hi * 8;
#pragma unroll
  for (int d0 = 0; d0 < 7; ++d0) qr[d0] = *reinterpret_cast<const bf16x8*>(Qw + d0 * 16);
#pragma unroll
  for (int d0 = 7; d0 < 12; ++d0) *reinterpret_cast<bf16x8*>(qrl + (d0 - 7) * 32) = *reinterpret_cast<const bf16x8*>(Qw + d0 * 16);
  int kst[3];
#pragma unroll
  for (int i = 0; i < 3; ++i) { const int c = tid + 512 * i; kst[i] = KSWZ(c / 24, (c % 24) * 16); }
  const int vst0 = v_st(tid >> 4, (tid & 15) * 8), vst1 = v_st(32 + (tid >> 4), (tid & 15) * 8);
  const int vb0 = (int)(uintptr_t)V_lds + v_rd_base(lane);
  bf16x8 sk0, sk1, sk2, sv0, sv1;
#define SLOAD(k0) do { const bf16x8* kp = reinterpret_cast<const bf16x8*>(Kh + (size_t)(k0) * DQ) + tid; sk0 = kp[0]; sk1 = kp[512]; sk2 = kp[1024]; \
    const bf16x8* vp = reinterpret_cast<const bf16x8*>(Vh + (size_t)(k0) * DV) + tid; sv0 = vp[0]; sv1 = vp[512]; } while (0)
#define SWRITE(b) do { *(bf16x8*)(V_lds + (b) * SHM_V + vst0) = sv0; *(bf16x8*)(V_lds + (b) * SHM_V + vst1) = sv1; \
    *(bf16x8*)(K_lds + (b) * SHM_K + kst[0]) = sk0; *(bf16x8*)(K_lds + (b) * SHM_K + kst[1]) = sk1; *(bf16x8*)(K_lds + (b) * SHM_K + kst[2]) = sk2; } while (0)
#define RESC(a) do { if (__any((a) < 1.f)) { if (hi == 0) al_l[r32] = (a); asm volatile("s_waitcnt lgkmcnt(0)" ::: "memory"); \
    _Pragma("unroll") for (int d = 0; d < 4; ++d) _Pragma("unroll") for (int r = 0; r < 16; ++r) o[d][r] *= al_l[crow(r, hi)]; } } while (0)
  f32x16 pA0, pA1, pB0, pB1; float mnA, mnB, alA, alB; bf16x8 pa0, pa1, pa2, pa3; const int NT = seq / KVBLK;
  SLOAD(0); SWRITE(0); __syncthreads();
  qkt(pA0, pA1, K_lds, qr, qrl, r32, hi); partialSM(pA0, pA1, m_reg, mnA, alA);
  SLOAD(KVBLK); SWRITE(1); __syncthreads();
  for (int j = 1; j + 1 < NT; j += 2) {
    SBAR(); qkt(pB0, pB1, K_lds + SHM_K, qr, qrl, r32, hi);
    finishSM(pA0, pA1, alA, l_reg, pa0, pa1, pa2, pa3); SBAR();
    SLOAD((j + 1) * KVBLK); SBAR();
    pv_d0(o, vb0, pa0, pa1, pa2, pa3); partialSM(pB0, pB1, m_reg, mnB, alB);
    __syncthreads(); SWRITE(0);
    RESC(alB); __syncthreads();
    SBAR(); qkt(pA0, pA1, K_lds, qr, qrl, r32, hi);
    finishSM(pB0, pB1, alB, l_reg, pa0, pa1, pa2, pa3); SBAR();
    SLOAD((j + 2) * KVBLK); SBAR();
    pv_d0(o, vb0 + SHM_V, pa0, pa1, pa2, pa3); partialSM(pA0, pA1, m_reg, mnA, alA);
    __syncthreads(); SWRITE(1);
    RESC(alA); __syncthreads();
  }
  SBAR(); qkt(pB0, pB1, K_lds + SHM_K, qr, qrl, r32, hi);
  finishSM(pA0, pA1, alA, l_reg, pa0, pa1, pa2, pa3); SBAR();
  pv_d0(o, vb0, pa0, pa1, pa2, pa3); partialSM(pB0, pB1, m_reg, mnB, alB);
  __syncthreads(); RESC(alB);
  finishSM(pB0, pB1, alB, l_reg, pa0, pa1, pa2, pa3); SBAR();
  pv_d0(o, vb0 + SHM_V, pa0, pa1, pa2, pa3);
  if (hi == 0) li_l[r32] = l_reg; asm volatile("s_waitcnt lgkmcnt(0)" ::: "memory");
  float rli[16];
#pragma unroll
  for (int r = 0; r < 16; ++r) rli[r] = __builtin_amdgcn_rcpf(li_l[crow(r, hi)]);
  bf16_t* Ow = Ob + (size_t)(wid * 32) * 1024;
#pragma unroll
  for (int r = 0; r < 16; ++r) { const int orow = crow(r, hi);
#pragma unroll
    for (int d0 = 0; d0 < 4; ++d0) Ow[(size_t)orow * 1024 + d0 * 32 + r32] = f2bf(o[d0][r] * rli[r]); }
  __syncthreads();
#undef SLOAD
#undef SWRITE
#undef RESC
}
}

DI void phase2_attn(const KP& p, char* lds) {
  for (int u = blockIdx.x; u < 256; u += gridDim.x) {
    unsigned char* ws = launder(p.ws);
    const bf16_t* Qm = (const bf16_t*)(ws + WS_QM); const bf16_t* Km = (const bf16_t*)(ws + WS_KM); const bf16_t* Vm = (const bf16_t*)(ws + WS_VM);
    bf16_t* mixa = (bf16_t*)(ws + WS_P1S);
    const int qb = u & 7, bh = u >> 3, b = bh >> 2, h = bh & 3;
    att::attn_unit(Qm + ((size_t)bh * SEQ + qb * 256) * 192, Km + (size_t)bh * SEQ * 192, Vm + (size_t)bh * SEQ * 128,
                   mixa + ((size_t)b * SEQ + qb * 256) * 1024 + h * 128, SEQ, lds);
  }
}

namespace pg8 {
#define PG8_LAS __attribute__((address_space(3)))
typedef unsigned short bf16_t;
typedef short bf16x8 __attribute__((ext_vector_type(8)));
typedef float f32x4 __attribute__((ext_vector_type(4)));
typedef unsigned u32x4 __attribute__((ext_vector_type(4)));
constexpr int BM = 256, BK = 64, HALF = 128, HTB = HALF * BK * 2  , STAGE_BYTES = 8 * HTB, NXCD = 8, WGM = 8;

__host__ __device__ __forceinline__ int lds_byte(int r, int c) { const int st = (r >> 4) * 2 + (c >> 5), rr = r & 15, cc = c & 31, ob = rr * 64 + cc * 2; return st * 1024 + (ob ^ (((ob >> 9) & 1) << 5)); }
__host__ __device__ __forceinline__ void stage_rc(int b, int& R, int& C) { const int st = b / 1024, sb = b % 1024, swz = sb ^ (((sb >> 9) & 1) << 5); R = (st >> 1) * 16 + swz / 64; C = (st & 1) * 32 + (swz % 64) / 2; }
__host__ __device__ __forceinline__ int perm32(int rho) { const int n = rho >> 4, i = rho & 15; return 8 * (i >> 2) + 4 * n + (i & 3); }

struct Unit { int pm, pn; };
struct Gemm { const bf16_t* A; const bf16_t* Bt; int M, N, K; };

struct StaticOrder {
    int nM, nN, nwg, G, c;
    __host__ __device__ void init(int M, int N, int G_, int c_) { nM = M / BM; nN = N / BM; nwg = nM * nN; G = G_; c = c_; }
    __host__ __device__ bool next(int i, Unit& u) const {
        const long L = (long)i * G + c; if (L >= nwg) return false;
        int wgid = (int)L; { const int q = nwg / NXCD, r = nwg % NXCD, xcd = wgid % NXCD, off = wgid / NXCD; wgid = (xcd < r ? xcd * (q + 1) : r * (q + 1) + (xcd - r) * q) + off; }
        const int nig = WGM * nN, gid = wgid / nig, fm = gid * WGM, gsz = (nM - fm) < WGM ? (nM - fm) : WGM;
        u.pm = fm + ((wgid % nig) % gsz); u.pn = (wgid % nig) / gsz; return true;
    }
    __device__ __forceinline__ void a_ready(const Unit&) const {}
    __device__ __forceinline__ void done(const Unit&) const {}
};

__device__ __forceinline__ unsigned cvt_pk_bf16(float lo, float hi) { unsigned r; asm volatile("v_cvt_pk_bf16_f32 %0, %1, %2" : "=v"(r) : "v"(lo), "v"(hi)); return r; }
typedef float f32x2 __attribute__((ext_vector_type(2)));
__device__ __forceinline__ f32x2 gelu_pk(f32x2 v) {
    const f32x2 av = __builtin_elementwise_abs(v), d = av * 0.2316418882f + 1.0f;
    f32x2 t; t.x = __builtin_amdgcn_rcpf(d.x); t.y = __builtin_amdgcn_rcpf(d.y);
    f32x2 q = t * 0.5307027145f + (-0.7265760135f); q = q * t + 0.7107068705f; q = q * t + (-0.142248368f); q = q * t + 0.127414796f; q = q * t;
    const f32x2 s = (v * v) * (-0.72134752044f);
    f32x2 e; e.x = __builtin_amdgcn_exp2f(s.x); e.y = __builtin_amdgcn_exp2f(s.y);
    const f32x2 m = v * (q * e), r = v - m;
    f32x2 o; o.x = v.x < 0.f ? m.x : r.x; o.y = v.y < 0.f ? m.y : r.y; return o;
}

template <int ACT  > struct EpiBf16 {
    static constexpr bool PERM = true, AFTER_DRAIN = false; static_assert(ACT == 0 || ACT == 1, "EpiBf16: ACT is 0 (none) or 1 (gelu_pk)");
    bf16_t* O; int ldc; const float* bias; int split_cols; size_t split_stride; float scale0;
    __device__ __forceinline__ void operator()(const f32x4 (&acc)[2][2][4][2], const Unit& u, int wr, int wc, int fr, int fq) const {
        const int row0 = u.pm * BM + wr * 64 + fr; int colt = u.pn * BM; bf16_t* base = O;
        float sc = 1.f; if (split_cols) { const int t = colt / split_cols; base += (size_t)t * split_stride; colt -= t * split_cols; if (t == 0) sc = scale0; }
        const int col0 = colt + wc * 32 + 8 * fq, bcol0 = u.pn * BM + wc * 32 + 8 * fq;
        f32x4 bv[2][2];
#pragma unroll
        for (int bj = 0; bj < 2; ++bj)
#pragma unroll
            for (int n = 0; n < 2; ++n) bv[bj][n] = bias ? *(const f32x4*)(bias + bcol0 + bj * HALF + 4 * n) : (f32x4){0.f, 0.f, 0.f, 0.f};
#pragma unroll
        for (int ai = 0; ai < 2; ++ai)
#pragma unroll
            for (int m = 0; m < 4; ++m) { bf16_t* rowp = base + (size_t)(row0 + ai * HALF + m * 16) * ldc + col0;
#pragma unroll
                for (int bj = 0; bj < 2; ++bj) { f32x4 v0 = acc[ai][bj][m][0] + bv[bj][0], v1 = acc[ai][bj][m][1] + bv[bj][1];
                    if (ACT == 1) { f32x2 a = gelu_pk((f32x2){v0[0], v0[1]}), b = gelu_pk((f32x2){v0[2], v0[3]}), c = gelu_pk((f32x2){v1[0], v1[1]}), d = gelu_pk((f32x2){v1[2], v1[3]});
                        v0 = (f32x4){a.x, a.y, b.x, b.y}; v1 = (f32x4){c.x, c.y, d.x, d.y}; }
                    v0 = v0 * sc; v1 = v1 * sc; u32x4 w; w.x = cvt_pk_bf16(v0[0], v0[1]); w.y = cvt_pk_bf16(v0[2], v0[3]); w.z = cvt_pk_bf16(v1[0], v1[1]); w.w = cvt_pk_bf16(v1[2], v1[3]);
                    *(u32x4*)(rowp + bj * HALF) = w; } }
    }
};

template <class Epi, class Sched, bool ALIGN_EPI = false, bool SP2 = false>
__device__ __forceinline__ void gemm_phase(PG8_LAS unsigned char* lds, const Gemm g, const Sched& S, const Epi& E) {
    const int tid = threadIdx.x, wid = __builtin_amdgcn_readfirstlane(tid >> 6), lane = tid & 63, wr = wid >> 2, wc = wid & 3, fr = lane & 15, fq = lane >> 4;
    const int K = g.K, nt = K / BK;
    unsigned voffA[2], voffB[2];
#pragma unroll
    for (int i = 0; i < 2; ++i) { int R, C; stage_rc(tid * 16 + i * 8192, R, C); const int Rb = Epi::PERM ? ((R & ~31) + perm32(R & 31)) : R;
        voffA[i] = (unsigned)(R * K + C) * 2u; voffB[i] = (unsigned)(Rb * K + C) * 2u; }
    const size_t kstep = (size_t)(BK * 2);
    const size_t hstep = (size_t)HALF * K * 2;
    const size_t tstep = 2 * hstep;
    const unsigned ldsw = (unsigned)wid * 1024u;
    const int aoff = lds_byte(wr * 64 + fr, fq * 8), boff = lds_byte(wc * 32 + fr, fq * 8);
#define PG8_SA(b, h) (((b) * 2 + (h)) * HTB)
#define PG8_SB(b, h) ((4 + (b) * 2 + (h)) * HTB)
#define PG8_STAGE(bufoff, gbase, voff) do { _Pragma("unroll") for (int _i = 0; _i < 2; ++_i) \
        __builtin_amdgcn_global_load_lds((const unsigned*)((const char*)(gbase) + (voff)[_i]), (PG8_LAS unsigned*)(lds + (bufoff) + ldsw + _i * 8192), 16, 0, 0); } while (0)
#define PG8_LDA(dst, b, h) do { _Pragma("unroll") for (int m = 0; m < 4; ++m) _Pragma("unroll") for (int k = 0; k < 2; ++k) dst[m][k] = *(const PG8_LAS bf16x8*)(lds + PG8_SA(b, h) + aoff + m * 2048 + k * 1024); } while (0)
#define PG8_LDB(dst, b, h) do { _Pragma("unroll") for (int n = 0; n < 2; ++n) _Pragma("unroll") for (int k = 0; k < 2; ++k) dst[n][k] = *(const PG8_LAS bf16x8*)(lds + PG8_SB(b, h) + boff + n * 2048 + k * 1024); } while (0)
#define PG8_MMA(ai, bj, At, Bt) do { __builtin_amdgcn_s_setprio(1); _Pragma("unroll") for (int m = 0; m < 4; ++m) _Pragma("unroll") for (int n = 0; n < 2; ++n) _Pragma("unroll") for (int k = 0; k < 2; ++k) \
        acc[ai][bj][m][n] = __builtin_amdgcn_mfma_f32_16x16x32_bf16(Bt[n][k], At[m][k], acc[ai][bj][m][n], 0, 0, 0); __builtin_amdgcn_s_setprio(0); } while (0)
#define PG8_WAIT_V(n) asm volatile("s_waitcnt vmcnt(" #n ")" ::: "memory")
#define PG8_WAIT_L(n) asm volatile("s_waitcnt lgkmcnt(" #n ")" ::: "memory")
#define PG8_BAR __builtin_amdgcn_s_barrier()
#define PG8_SCHED __builtin_amdgcn_sched_barrier(0)
    Unit cur, nxt; int ui = 0;
    if (!S.next(0, cur)) return;
    f32x4 acc[2][2][4][2];
#pragma unroll
    for (int a = 0; a < 2; ++a)
#pragma unroll
        for (int b = 0; b < 2; ++b)
#pragma unroll
            for (int m = 0; m < 4; ++m)
#pragma unroll
                for (int n = 0; n < 2; ++n) acc[a][b][m][n] = (f32x4){0.f, 0.f, 0.f, 0.f};
    bf16x8 At[4][2], B0[2][2], B1[2][2];
    const char* cA = (const char*)g.A + (size_t)cur.pm * tstep; const char* cB = (const char*)g.Bt + (size_t)cur.pn * tstep;
    S.a_ready(cur);
    if constexpr (SP2) {
        PG8_STAGE(PG8_SB(0, 0), cB, voffB); PG8_STAGE(PG8_SB(0, 1), cB + hstep, voffB); PG8_STAGE(PG8_SA(0, 0), cA, voffA); PG8_STAGE(PG8_SA(0, 1), cA + hstep, voffA);
        if (wr == 1) PG8_BAR;
        PG8_WAIT_V(2); PG8_BAR;
        PG8_STAGE(PG8_SB(1, 0), cB + kstep, voffB); PG8_STAGE(PG8_SA(1, 0), cA + kstep, voffA); PG8_STAGE(PG8_SB(1, 1), cB + hstep + kstep, voffB);
        PG8_WAIT_V(6); PG8_BAR;
    } else {
        PG8_STAGE(PG8_SB(0, 0), cB, voffB); PG8_STAGE(PG8_SA(0, 0), cA, voffA); PG8_STAGE(PG8_SB(0, 1), cB + hstep, voffB); PG8_STAGE(PG8_SA(0, 1), cA + hstep, voffA);
        if (wr == 1) PG8_BAR;
        PG8_WAIT_V(4); PG8_BAR;
        PG8_STAGE(PG8_SB(1, 0), cB + kstep, voffB); PG8_STAGE(PG8_SA(1, 0), cA + kstep, voffA); PG8_STAGE(PG8_SB(1, 1), cB + hstep + kstep, voffB);
        PG8_WAIT_V(6); PG8_BAR;
    }
    for (;;) {
        const bool has_next = S.next(ui + 1, nxt);
        const char* nA = has_next ? (const char*)g.A + (size_t)nxt.pm * tstep : cA; const char* nB = has_next ? (const char*)g.Bt + (size_t)nxt.pn * tstep : cB;
        for (int t = 0; t < nt; t += 2) {
            const bool last = (t == nt - 2);
            const char* a1 = cA + (size_t)(t + 1) * kstep;
            const char* a2 = last ? nA : cA + (size_t)(t + 2) * kstep; const char* b2 = last ? nB : cB + (size_t)(t + 2) * kstep;
            const char* a3 = a2 + kstep; const char* b3 = b2 + kstep;
            if (last && has_next) S.a_ready(nxt);
            if constexpr (SP2) {
            PG8_LDB(B0, 0, 0); PG8_LDB(B1, 0, 1); PG8_SCHED; PG8_LDA(At, 0, 0); PG8_STAGE(PG8_SA(1, 1), a1 + hstep, voffA);
            PG8_WAIT_V(8); PG8_WAIT_L(0); PG8_BAR; PG8_MMA(0, 0, At, B0); PG8_MMA(0, 1, At, B1); PG8_BAR; PG8_SCHED;
            PG8_LDA(At, 0, 1); PG8_STAGE(PG8_SB(0, 0), b2, voffB); PG8_STAGE(PG8_SB(0, 1), b2 + hstep, voffB); PG8_STAGE(PG8_SA(0, 0), a2, voffA);
            PG8_WAIT_V(8); PG8_WAIT_L(0); PG8_BAR; PG8_MMA(1, 0, At, B0); PG8_MMA(1, 1, At, B1); PG8_BAR; PG8_SCHED;
            PG8_LDB(B0, 1, 0); PG8_LDB(B1, 1, 1); PG8_SCHED; PG8_LDA(At, 1, 0); PG8_STAGE(PG8_SA(0, 1), a2 + hstep, voffA);
            PG8_WAIT_V(8); PG8_WAIT_L(0); PG8_BAR; PG8_MMA(0, 0, At, B0); PG8_MMA(0, 1, At, B1); PG8_BAR; PG8_SCHED;
            PG8_LDA(At, 1, 1); PG8_STAGE(PG8_SB(1, 0), b3, voffB); PG8_STAGE(PG8_SB(1, 1), b3 + hstep, voffB); PG8_STAGE(PG8_SA(1, 0), a3, voffA);
            PG8_WAIT_V(8); PG8_WAIT_L(0); PG8_BAR; PG8_MMA(1, 0, At, B0); PG8_MMA(1, 1, At, B1); PG8_BAR; PG8_SCHED;
            } else {
            PG8_LDB(B0, 0, 0); PG8_SCHED; PG8_LDA(At, 0, 0); PG8_STAGE(PG8_SA(1, 1), a1 + hstep, voffA);
            PG8_WAIT_L(8); PG8_BAR; PG8_WAIT_L(0); PG8_MMA(0, 0, At, B0); PG8_BAR; PG8_SCHED;
            PG8_LDB(B1, 0, 1); PG8_STAGE(PG8_SB(0, 0), b2, voffB);
            PG8_BAR; PG8_WAIT_L(0); PG8_MMA(0, 1, At, B1); PG8_BAR;
            PG8_LDA(At, 0, 1); PG8_STAGE(PG8_SA(0, 0), a2, voffA);
            PG8_BAR; PG8_WAIT_L(0); PG8_MMA(1, 0, At, B0); PG8_BAR; PG8_SCHED;
            PG8_STAGE(PG8_SB(0, 1), b2 + hstep, voffB);
            PG8_WAIT_V(6); PG8_BAR; PG8_MMA(1, 1, At, B1); PG8_BAR;
            PG8_LDB(B0, 1, 0); PG8_SCHED; PG8_LDA(At, 1, 0); PG8_STAGE(PG8_SA(0, 1), a2 + hstep, voffA);
            PG8_WAIT_L(8); PG8_BAR; PG8_WAIT_L(0); PG8_MMA(0, 0, At, B0); PG8_BAR; PG8_SCHED;
            PG8_LDB(B1, 1, 1); PG8_STAGE(PG8_SB(1, 0), b3, voffB);
            PG8_BAR; PG8_WAIT_L(0); PG8_MMA(0, 1, At, B1); PG8_BAR;
            PG8_LDA(At, 1, 1); PG8_STAGE(PG8_SA(1, 0), a3, voffA);
            PG8_BAR; PG8_WAIT_L(0); PG8_MMA(1, 0, At, B0); PG8_BAR; PG8_SCHED;
            PG8_STAGE(PG8_SB(1, 1), b3 + hstep, voffB);
            PG8_WAIT_V(6); PG8_BAR; PG8_MMA(1, 1, At, B1); PG8_BAR;
            }
        }
        if constexpr (ALIGN_EPI) { if (wr == 0) PG8_BAR; }
        if constexpr (!Epi::AFTER_DRAIN) { E(acc, cur, wr, wc, fr, fq); S.done(cur); }
        if (!has_next) break;
#pragma unroll
        for (int a = 0; a < 2; ++a)
#pragma unroll
            for (int b = 0; b < 2; ++b)
#pragma unroll
                for (int m = 0; m < 4; ++m)
#pragma unroll
                    for (int n = 0; n < 2; ++n) acc[a][b][m][n] = (f32x4){0.f, 0.f, 0.f, 0.f};
        cur = nxt; cA = nA; cB = nB; ++ui;
        if constexpr (ALIGN_EPI) { if (wr == 1) PG8_BAR; }
    }
    PG8_WAIT_V(0);
    if constexpr (!ALIGN_EPI) { if (wr == 0) PG8_BAR; }
    PG8_BAR;
    if constexpr (Epi::AFTER_DRAIN) { E.fused(acc, cur, wr, wc, fr, fq, lds, wid, lane); S.done(cur); }
#undef PG8_SA
#undef PG8_SB
#undef PG8_STAGE
#undef PG8_LDA
#undef PG8_LDB
#undef PG8_MMA
#undef PG8_WAIT_V
#undef PG8_WAIT_L
#undef PG8_BAR
#undef PG8_SCHED
}
}


namespace pg8 {
struct EpiProj {
    static constexpr bool PERM = true, AFTER_DRAIN = false;
    bf16_t* P0; bf16_t* P1; bf16_t* P2;
    __device__ __forceinline__ void operator()(const f32x4 (&acc)[2][2][4][2], const Unit& u, int wr, int wc, int fr, int fq) const {
        const int row0 = u.pm * BM + wr * 64 + fr; const int colt = u.pn * BM;
        const long d1 = (long)(P1 - P0), d2 = (long)(P2 - P0); long dsel = 0; if (colt >= 1024) dsel = d1; if (colt >= 2048) dsel = d2;
        bf16_t* base = P0 + dsel; const int ldc = colt < 2048 ? 1024 : 256; const int cl = colt & 1023;
        const int col0 = cl + wc * 32 + 8 * fq;
#pragma unroll
        for (int ai = 0; ai < 2; ++ai)
#pragma unroll
            for (int m = 0; m < 4; ++m) { bf16_t* rowp = base + (size_t)(row0 + ai * HALF + m * 16) * ldc + col0;
#pragma unroll
                for (int bj = 0; bj < 2; ++bj) { const f32x4 v0 = acc[ai][bj][m][0], v1 = acc[ai][bj][m][1];
                    u32x4 w; w.x = cvt_pk_bf16(v0[0], v0[1]); w.y = cvt_pk_bf16(v0[2], v0[3]); w.z = cvt_pk_bf16(v1[0], v1[1]); w.w = cvt_pk_bf16(v1[2], v1[3]);
                    *(u32x4*)(rowp + bj * HALF) = w; } }
    }
};
}

constexpr int P3_TILE_BYTES = 256 * 1024;
constexpr int LDS_TK = 92160;
constexpr int GP_SH = 11, GP_N = 16384 >> GP_SH, GP_OS = GP_N + 1;
constexpr int LDS_OFF = 32768, LDS_CNT = 36864, LDS_LIST = 36864, LDS_H2L = 45056, LDS_SE = 110592;
constexpr int SCW = 260;
template <int N> DI void ce_desc(float (&a)[N], int i, int l) { const float hi = fmaxf(a[i], a[l]), lo = fminf(a[i], a[l]); a[i] = hi; a[l] = lo; }
DI void sort16_desc(float (&a)[16]) {
#pragma unroll
  for (int k = 2; k <= 16; k <<= 1)
#pragma unroll
    for (int j = k >> 1; j > 0; j >>= 1)
#pragma unroll
      for (int i = 0; i < 16; ++i) { const int l = i ^ j; if (l > i) { if ((i & k) == 0) ce_desc(a, i, l); else ce_desc(a, l, i); } }
}
DI void merge16_desc(float (&a)[16]) {
#pragma unroll
  for (int j = 8; j > 0; j >>= 1)
#pragma unroll
    for (int i = 0; i < 16; ++i) { const int l = i ^ j; if (l > i) ce_desc(a, i, l); }
}
DI void top16_merge(float (&a)[16], const float (&b)[16]) {
#pragma unroll
  for (int i = 0; i < 16; ++i) a[i] = fmaxf(a[i], b[15 - i]);
  merge16_desc(a);
}
template <int CTRL> DI float dpp_f(float v) { return __int_as_float(__builtin_amdgcn_mov_dpp(__float_as_int(v), CTRL, 0xF, 0xF, true)); }

DI float gelu_fast(float x) { return 0.5f * x * (1.f + erff(x * 0.70710678118654752f)); }

DI void phase3(const KP& p, char* lds, const int gather_reps, const int probe) {
  const int tid0 = threadIdx.x;
  const int r = tid0 & 31, hh = (tid0 >> 5) & 1, lane = tid0 & 63;
  char* wl = lds + LDS_WT + ((tid0 >> 6) & 3) * WT_BYTES;
  for (int tile = blockIdx.x; tile < 256; tile += gridDim.x) {
    unsigned char* ws = launder(p.ws); float* outp = launder(p.out); const float* xin = launder(p.in[0]);
    const int tok0 = tile * 64, b = tile >> 5;
    unsigned char* tsc = ws + WS_QM + (size_t)tile * P3_TILE_BYTES;
    bf16_t* QRY = (bf16_t*)tsc; bf16_t* Y = (bf16_t*)tsc; bf16_t* MIXA = (bf16_t*)(ws + WS_P1S) + (size_t)tok0 * 1024; bf16_t* H2 = MIXA;
    const float* modb = launder((const float*)(ws + WS_MOD)) + b * 6144;
    __syncthreads();
    {
      const int tid = lv(tid0), lane = tid & 63, w = tid >> 6, r = lane & 31, hh = lane >> 5;
      const int h = w >> 1, mi = w & 1, n = tile & 31;
      char* OIL = lds; char* RGL = lds + 66560;
      { const bf16_t* oig = (const bf16_t*)(ws + WS_OINTRA) + (size_t)tok0 * 512; const bf16_t* rgg = (const bf16_t*)(ws + WS_RG) + (size_t)tok0 * 512;
#pragma unroll
        for (int i = 0; i < 8; ++i) { const int c = tid + 512 * i, row = c >> 6, cc = c & 63;
          *(uint4*)(OIL + row * 1040 + cc * 16) = *(const uint4*)(oig + (size_t)row * 512 + cc * 8);
          *(uint4*)(RGL + row * 1040 + cc * 16) = *(const uint4*)(rgg + (size_t)row * 512 + cc * 8); } }
      const bf16_t* QDg = (const bf16_t*)(ws + WS_QDEC) + (size_t)(tile * 4 + h) * 2 * 4096 + (mi * 32 + r) * 64 + hh * 8;
      const bf16_t* SPg = (const bf16_t*)(ws + WS_SPT) + ((size_t)((b * 4 + h) * 2) * 32 + n) * 8192 + r * 64 + hh * 8;
      f32x16 acc[4];
#pragma unroll
      for (int ni = 0; ni < 4; ++ni)
#pragma unroll
        for (int i = 0; i < 16; ++i) acc[ni][i] = 0.f;
#pragma unroll
      for (int d = 0; d < 2; ++d)
#pragma unroll
        for (int s = 0; s < 4; ++s) { const bf16x8 a = *(const bf16x8*)(QDg + d * 4096 + s * 16);
#pragma unroll
          for (int ni = 0; ni < 4; ++ni) { const bf16x8 bb = *(const bf16x8*)(SPg + (size_t)d * 32 * 8192 + ni * 32 * 64 + s * 16); acc[ni] = MFMA32(a, bb, acc[ni]); } }
      __syncthreads();
      bf16_t* oil = (bf16_t*)(OIL + (mi * 32 + 4 * hh) * 1040) + h * 128 + r; const bf16_t* rgl = (const bf16_t*)(RGL + (mi * 32 + 4 * hh) * 1040) + h * 128 + r;
#pragma unroll
      for (int ni = 0; ni < 4; ++ni)
#pragma unroll
        for (int reg = 0; reg < 16; ++reg) acc[ni][reg] += bf2f(oil[((reg & 3) + 8 * (reg >> 2)) * 520 + ni * 32]);
      float rs[16];
#pragma unroll
      for (int reg = 0; reg < 16; ++reg) { float v = acc[0][reg] * acc[0][reg] + acc[1][reg] * acc[1][reg] + acc[2][reg] * acc[2][reg] + acc[3][reg] * acc[3][reg];
        v += __shfl_xor(v, 1); v += __shfl_xor(v, 2); v += __shfl_xor(v, 4); v += __shfl_xor(v, 8); v += __shfl_xor(v, 16);
        rs[reg] = rsqrtf(v * (1.f / 128.f) + EPS); }
      const float* ggl = launder(p.in[16]);
#pragma unroll
      for (int ni = 0; ni < 4; ++ni) { const float g = ggl[ni * 32 + r];
#pragma unroll
        for (int reg = 0; reg < 16; ++reg) { const int ro = ((reg & 3) + 8 * (reg >> 2)) * 520 + ni * 32; const float rv = bf2f(rgl[ro]);
          oil[ro] = f2bf(acc[ni][reg] * rs[reg] * g * silu_fast(rv)); } }
      __syncthreads();
#pragma unroll
      for (int i = 0; i < 8; ++i) { const int c = tid + 512 * i, row = c >> 6, cc = c & 63;
        *(uint4*)(MIXA + (size_t)row * 1024 + 512 + cc * 8) = *(const uint4*)(OIL + row * 1040 + cc * 16); }
    }
  }
}

DI void phase3c(const KP& p, char* lds, const int gather_reps, const int probe) {
  const int tid0 = threadIdx.x;
  const int r = tid0 & 31, hh = (tid0 >> 5) & 1, lane = tid0 & 63;
  char* wl = lds + LDS_WT + ((tid0 >> 6) & 3) * WT_BYTES;
  for (int tile = blockIdx.x; tile < 256; tile += gridDim.x) {
    unsigned char* ws = launder(p.ws); float* outp = launder(p.out); const float* xin = launder(p.in[0]);
    const int tok0 = tile * 64, b = tile >> 5;
    unsigned char* tsc = ws + WS_QM + (size_t)tile * P3_TILE_BYTES;
    bf16_t* QRY = (bf16_t*)tsc; bf16_t* Y = (bf16_t*)(ws + WS_QM) + (size_t)tok0 * 1024; bf16_t* MIXA = (bf16_t*)(ws + WS_P1S) + (size_t)tok0 * 1024; bf16_t* H2 = MIXA;
    const float* modb = launder((const float*)(ws + WS_MOD)) + b * 6144;
    __syncthreads();
    {
      const int tid = lv(tid0), lane = tid & 63, w = tid >> 6;
      float4 A1[4], A2[4], S2[4];
      const float* gpo = launder(p.in[6]); const float* gpf = launder(p.in[18]);
#pragma unroll
      for (int i = 0; i < 4; ++i) { const int d = (lane + 64 * i) * 4;
        const float4 gp = *(const float4*)(gpo + d), gt = *(const float4*)(modb + 2048 + d), g2 = *(const float4*)(gpf + d), sc = *(const float4*)(modb + 4096 + d);
        S2[i] = *(const float4*)(modb + 3072 + d);
        A1[i] = make_float4(gp.x * gt.x, gp.y * gt.y, gp.z * gt.z, gp.w * gt.w);
        A2[i] = make_float4(g2.x * (1.f + sc.x), g2.y * (1.f + sc.y), g2.z * (1.f + sc.z), g2.w * (1.f + sc.w)); }
#pragma unroll 2
      for (int rr = 0; rr < 8; ++rr) { const int row = w * 8 + rr; const size_t tok = tok0 + row;
        float4 yv[4]; float ss = 0.f;
#pragma unroll
        for (int i = 0; i < 4; ++i) { const uint2 u = *(const uint2*)(Y + (size_t)row * 1024 + (lane + 64 * i) * 4);
          yv[i] = make_float4(__uint_as_float(u.x << 16), __uint_as_float(u.x & 0xffff0000u), __uint_as_float(u.y << 16), __uint_as_float(u.y & 0xffff0000u));
          ss += yv[i].x * yv[i].x + yv[i].y * yv[i].y + yv[i].z * yv[i].z + yv[i].w * yv[i].w; }
        ss = wave_sum(ss); const float rs = rsqrtf(ss * (1.f / 1024.f) + EPS);
        float4 xv[4]; float s2 = 0.f;
#pragma unroll
        for (int i = 0; i < 4; ++i) { const float4 x = *(const float4*)(xin + tok * 1024 + (lane + 64 * i) * 4);
          xv[i] = make_float4(x.x + A1[i].x * yv[i].x * rs, x.y + A1[i].y * yv[i].y * rs, x.z + A1[i].z * yv[i].z * rs, x.w + A1[i].w * yv[i].w * rs);
          *(float4*)(outp + tok * 1024 + (lane + 64 * i) * 4) = xv[i];
          s2 += xv[i].x * xv[i].x + xv[i].y * xv[i].y + xv[i].z * xv[i].z + xv[i].w * xv[i].w; }
        s2 = wave_sum(s2); const float r2 = rsqrtf(s2 * (1.f / 1024.f) + EPS);
#pragma unroll
        for (int i = 0; i < 4; ++i) { uint2 o; o.x = pack2(xv[i].x * r2 * A2[i].x + S2[i].x, xv[i].y * r2 * A2[i].y + S2[i].y); o.y = pack2(xv[i].z * r2 * A2[i].z + S2[i].z, xv[i].w * r2 * A2[i].w + S2[i].w);
          *(uint2*)(H2 + (size_t)row * 1024 + (lane + 64 * i) * 4) = o; }
      }
    }
  }
}

DI void phase3b(const KP& p, char* lds, const int gather_reps, const int probe) {
  const int tid0 = threadIdx.x;
  const int r = tid0 & 31, hh = (tid0 >> 5) & 1, lane = tid0 & 63;
  char* wl = lds + LDS_WT + ((tid0 >> 6) & 3) * WT_BYTES;
  for (int tile = blockIdx.x; tile < 256; tile += gridDim.x) {
    unsigned char* ws = launder(p.ws); float* outp = launder(p.out); const float* xin = launder(p.in[0]);
    const int tok0 = tile * 64, b = tile >> 5;
    unsigned char* tsc = ws + WS_QM + (size_t)tile * P3_TILE_BYTES;
    bf16_t* QRY = (bf16_t*)tsc; bf16_t* Y = (bf16_t*)tsc; bf16_t* MIXA = (bf16_t*)(ws + WS_P1S) + (size_t)tok0 * 1024; bf16_t* H2 = MIXA;
    const float* modb = launder((const float*)(ws + WS_MOD)) + b * 6144;
    __syncthreads();
    float* SC = (float*)lds; unsigned* TK = (unsigned*)(lds + LDS_TK);
    for (int rep3e = 0; rep3e < (probe == 7 ? 2 : 1); ++rep3e)
    for (int h = 0; h < 8; ++h) {
      block_gemm<2>(lds, QRY + h * 256, 2048, (const bf16_t*)(ws + WS_KD), 1, 256, [&](int m0, int n0, const f32x16& a0, const f32x16& a1) {
        const int r2 = lv(r), h2 = lv(hh);
        float* sp = SC + (m0 + 4 * h2) * SCW + n0 + r2;
#pragma unroll
        for (int reg = 0; reg < 16; ++reg) { const int ro = ((reg & 3) + 8 * (reg >> 2)) * SCW; sp[ro] = a0[reg]; sp[ro + 32] = a1[reg]; }
      });
      __syncthreads();
      {
        const int tid = lv(tid0);
        const int tt = tid >> 3, sd = (tid >> 2) & 1, q = tid & 3;
        const float* sr = SC + tt * SCW + sd * 128 + q * 32;
        float a[16], c[16];
#pragma unroll
        for (int i = 0; i < 4; ++i) { const float4 v = *(const float4*)(sr + i * 4); const unsigned ib = q * 32 + i * 4;
          a[i * 4 + 0] = __uint_as_float((__float_as_uint(v.x) & 0xFFFFFF80u) | (ib + 0)); a[i * 4 + 1] = __uint_as_float((__float_as_uint(v.y) & 0xFFFFFF80u) | (ib + 1));
          a[i * 4 + 2] = __uint_as_float((__float_as_uint(v.z) & 0xFFFFFF80u) | (ib + 2)); a[i * 4 + 3] = __uint_as_float((__float_as_uint(v.w) & 0xFFFFFF80u) | (ib + 3)); }
#pragma unroll
        for (int i = 0; i < 4; ++i) { const float4 v = *(const float4*)(sr + 16 + i * 4); const unsigned ib = q * 32 + 16 + i * 4;
          c[i * 4 + 0] = __uint_as_float((__float_as_uint(v.x) & 0xFFFFFF80u) | (ib + 0)); c[i * 4 + 1] = __uint_as_float((__float_as_uint(v.y) & 0xFFFFFF80u) | (ib + 1));
          c[i * 4 + 2] = __uint_as_float((__float_as_uint(v.z) & 0xFFFFFF80u) | (ib + 2)); c[i * 4 + 3] = __uint_as_float((__float_as_uint(v.w) & 0xFFFFFF80u) | (ib + 3)); }
        sort16_desc(a); sort16_desc(c); top16_merge(a, c);
#pragma unroll
        for (int i = 0; i < 16; ++i) c[i] = dpp_f<0xB1>(a[i]);
        top16_merge(a, c);
#pragma unroll
        for (int i = 0; i < 16; ++i) c[i] = dpp_f<0x4E>(a[i]);
        top16_merge(a, c);
        if (q == 0) { unsigned* tk = TK + ((tt * 8 + h) * 2 + sd) * 16;
#pragma unroll
          for (int i = 0; i < 4; ++i) *(uint4*)(tk + i * 4) = make_uint4(__float_as_uint(a[i * 4]), __float_as_uint(a[i * 4 + 1]), __float_as_uint(a[i * 4 + 2]), __float_as_uint(a[i * 4 + 3])); }
      }
      __syncthreads();
    }
    {
      const int tid = lv(tid0);
      const int tt = tid >> 3, h = tid & 7;
      const unsigned* t1 = TK + ((tt * 8 + h) * 2) * 16; const unsigned* t2 = t1 + 16;
      float v1[16], v2[16];
#pragma unroll
      for (int i = 0; i < 4; ++i) { const uint4 u = *(const uint4*)(t1 + i * 4), v = *(const uint4*)(t2 + i * 4);
        v1[i * 4] = __uint_as_float(u.x & 0xFFFFFF80u); v1[i * 4 + 1] = __uint_as_float(u.y & 0xFFFFFF80u); v1[i * 4 + 2] = __uint_as_float(u.z & 0xFFFFFF80u); v1[i * 4 + 3] = __uint_as_float(u.w & 0xFFFFFF80u);
        v2[i * 4] = __uint_as_float(v.x & 0xFFFFFF80u); v2[i * 4 + 1] = __uint_as_float(v.y & 0xFFFFFF80u); v2[i * 4 + 2] = __uint_as_float(v.z & 0xFFFFFF80u); v2[i * 4 + 3] = __uint_as_float(v.w & 0xFFFFFF80u); }
      float best[16], grp[16];
#define CAND(i, j) __uint_as_float((__float_as_uint(v1[i] + v2[j]) & 0xFFFFFF00u) | ((i) << 4) | (j))
      best[0] = CAND(0, 0); best[1] = CAND(0, 1); best[2] = CAND(0, 2); best[3] = CAND(0, 3); best[4] = CAND(0, 4); best[5] = CAND(0, 5); best[6] = CAND(0, 6); best[7] = CAND(0, 7);
      best[8] = CAND(0, 8); best[9] = CAND(0, 9); best[10] = CAND(0, 10); best[11] = CAND(0, 11); best[12] = CAND(0, 12); best[13] = CAND(0, 13); best[14] = CAND(0, 14); best[15] = CAND(0, 15);
      sort16_desc(best);
      grp[0] = CAND(1, 0); grp[1] = CAND(1, 1); grp[2] = CAND(1, 2); grp[3] = CAND(1, 3); grp[4] = CAND(1, 4); grp[5] = CAND(1, 5); grp[6] = CAND(1, 6); grp[7] = CAND(1, 7);
      grp[8] = CAND(2, 0); grp[9] = CAND(2, 1); grp[10] = CAND(2, 2); grp[11] = CAND(2, 3); grp[12] = CAND(2, 4); grp[13] = CAND(3, 0); grp[14] = CAND(3, 1); grp[15] = CAND(3, 2);
      sort16_desc(grp); top16_merge(best, grp);
      grp[0] = CAND(3, 3); grp[1] = CAND(4, 0); grp[2] = CAND(4, 1); grp[3] = CAND(4, 2); grp[4] = CAND(5, 0); grp[5] = CAND(5, 1); grp[6] = CAND(6, 0); grp[7] = CAND(6, 1);
      grp[8] = CAND(7, 0); grp[9] = CAND(7, 1); grp[10] = CAND(8, 0); grp[11] = CAND(9, 0); grp[12] = CAND(10, 0); grp[13] = CAND(11, 0); grp[14] = CAND(12, 0); grp[15] = CAND(13, 0);
      sort16_desc(grp); top16_merge(best, grp);
      { const float c14 = CAND(14, 0), c15 = CAND(15, 0);
        grp[0] = fmaxf(c14, c15); grp[1] = fminf(c14, c15);
#pragma unroll
        for (int i = 2; i < 16; ++i) grp[i] = -3.0e38f;
        top16_merge(best, grp); }
#undef CAND
      __syncthreads();
      float sv[16]; int ev[16]; float mx = -3.0e38f;
#pragma unroll
      for (int k = 0; k < 16; ++k) { const unsigned key = __float_as_uint(best[k]); const int ci = (key >> 4) & 15, cj = key & 15;
        const unsigned k1 = t1[ci], k2 = t2[cj];
        sv[k] = __uint_as_float(k1 & 0xFFFFFF80u) + __uint_as_float(k2 & 0xFFFFFF80u); ev[k] = (int)((k1 & 127u) * 128u + (k2 & 127u)); mx = fmaxf(mx, sv[k]); }
      float sum = 0.f;
#pragma unroll
      for (int k = 0; k < 16; ++k) { sv[k] = __expf(sv[k] - mx); sum += sv[k]; }
      const float inv = 1.f / sum;
      unsigned* CNT = (unsigned*)(lds + LDS_CNT); unsigned short* OFFS = (unsigned short*)(lds + LDS_OFF); unsigned* EL = (unsigned*)lds; unsigned short* SE = (unsigned short*)(lds + LDS_SE);
      float scu[16], scv[16];
      { const float* SCU = (const float*)(ws + WS_ESC);
#pragma unroll
        for (int k = 0; k < 16; ++k) { scu[k] = SCU[ev[k]]; scv[k] = SCU[16384 + ev[k]]; } }
      CNT[tid] = 0u; if (GP_N > 8) CNT[tid + 512] = 0u;
      __syncthreads();
      int pos[16];
#pragma unroll
      for (int k = 0; k < 16; ++k) pos[k] = (int)atomicAdd(&CNT[tt * GP_N + (ev[k] >> GP_SH)], 1u);
      __syncthreads();
      if (h == 0) { unsigned run = 0;
#pragma unroll
        for (int q = 0; q < GP_N; ++q) { OFFS[tt * GP_OS + q] = (unsigned short)run; run += CNT[tt * GP_N + q]; }
        OFFS[tt * GP_OS + GP_N] = (unsigned short)run; }
      __syncthreads();
#pragma unroll
      for (int k = 0; k < 16; ++k) { const int d = (int)OFFS[tt * GP_OS + (ev[k] >> GP_SH)] + pos[k];
        EL[tt * 128 + d] = ((__float_as_uint(sv[k] * inv) + 0x2000u) & 0xFFFFC000u) | (unsigned)ev[k];
        SE[tt * 128 + d] = (unsigned short)((((__float_as_uint(scu[k]) >> 23) & 255u) << 8) | ((__float_as_uint(scv[k]) >> 23) & 255u)); }
    }
    __syncthreads();
    {
      const int tid = lv(tid0), lane = tid & 63, w = tid >> 6;
      const unsigned char* EU = ws + WS_EU; const unsigned char* EV = ws + WS_EV;
      unsigned* EL = (unsigned*)lds; const unsigned short* OFFS = (const unsigned short*)(lds + LDS_OFF); unsigned* LIST = (unsigned*)(lds + LDS_LIST) + w * 256; char* H2W = lds + LDS_H2L + w * 8192;
      const unsigned short* SE = (const unsigned short*)(lds + LDS_SE);
      const float* gpf2 = launder(p.in[19]);
      const int rot = (int)(__builtin_amdgcn_s_getreg((3 << 11) | 20) & 0xFu) * (GP_N / 8);
      const unsigned voff = (unsigned)lane * 16u;
      const int sl = lane & 7;
      typedef float f2v __attribute__((ext_vector_type(2))); typedef unsigned u32x4_t __attribute__((ext_vector_type(4)));
#define CVLO(wd) __builtin_amdgcn_cvt_pk_f32_fp8((int)(wd), false)
#define CVHI(wd) __builtin_amdgcn_cvt_pk_f32_fp8((int)(wd), true)
#define BF2(wd) ((f2v){__uint_as_float((wd) << 16), __uint_as_float((wd) & 0xffff0000u)})
#define DPPF(x, CTRL) __int_as_float(__builtin_amdgcn_update_dpp(0, __float_as_int(x), CTRL, 0xF, 0xF, true))
#define R_INIT(R, TAG) do { _Pragma("unroll") for (int k2 = 0; k2 < 8; ++k2) asm volatile("; init " TAG : "=v"(R[k2])); } while (0)
#define EIDX(D) ((row0 + ((D) >> 11)) * 128 + (((D) >> 4) & 127) + (sl < ((D) & 15) ? sl : 0))
#define G_FETCH(DX, PKX, R, TAB, TAG) do { DX = Dn; PKX = PKn; { const int es_ = (int)(PKX & 16383u); \
        _Pragma("unroll") for (int k2 = 0; k2 < 8; ++k2) { const int e_ = __builtin_amdgcn_readlane(es_, k2); const unsigned char* rp_ = TAB + (size_t)e_ * 1024; \
          asm volatile("global_load_dwordx4 %0, %1, %2 ; " TAG : "+v"(R[k2]) : "v"(voff), "s"(rp_)); } } \
        Dn = __builtin_amdgcn_readfirstlane((int)tmpL); PKn = EL[EIDX(Dn)]; tmpL = LIST[sidx]; ++sidx; } while (0)
#define G_WAITK(R, k2) asm volatile("s_waitcnt vmcnt(%1)" : "+v"(R[k2]) : "n"(15 - (k2)))
#define G_DRAIN(RA_, RB_) do { asm volatile("s_waitcnt vmcnt(0)" : "+v"(RA_[0]), "+v"(RA_[1]), "+v"(RA_[2]), "+v"(RA_[3]), "+v"(RA_[4]), "+v"(RA_[5]), "+v"(RA_[6]), "+v"(RA_[7])); \
        asm volatile("" : "+v"(RB_[0]), "+v"(RB_[1]), "+v"(RB_[2]), "+v"(RB_[3]), "+v"(RB_[4]), "+v"(RB_[5]), "+v"(RB_[6]), "+v"(RB_[7])); } while (0)
#define U_COMPUTE(D, PK, R) do { if ((D) != 0) { const int n_ = (D) & 15, rr_ = (D) >> 11; \
        const unsigned se_ = (unsigned)SE[EIDX(D)]; \
        if (rr_ != cur) { cur = rr_; const uint4 hA = *(const uint4*)(H2W + rr_ * 2048 + lane * 32), hB = *(const uint4*)(H2W + rr_ * 2048 + lane * 32 + 16); \
          hf2[0] = BF2(hA.x); hf2[1] = BF2(hA.y); hf2[2] = BF2(hA.z); hf2[3] = BF2(hA.w); hf2[4] = BF2(hB.x); hf2[5] = BF2(hB.y); hf2[6] = BF2(hB.z); hf2[7] = BF2(hB.w); } \
        float P[8]; \
        _Pragma("unroll") for (int k2 = 0; k2 < 8; ++k2) { P[k2] = 0.f; \
          if (k2 < n_) { G_WAITK(R, k2); f2v d2 = CVLO(R[k2][0]) * hf2[0]; d2 += CVHI(R[k2][0]) * hf2[1]; d2 += CVLO(R[k2][1]) * hf2[2]; d2 += CVHI(R[k2][1]) * hf2[3]; \
            d2 += CVLO(R[k2][2]) * hf2[4]; d2 += CVHI(R[k2][2]) * hf2[5]; d2 += CVLO(R[k2][3]) * hf2[6]; d2 += CVHI(R[k2][3]) * hf2[7]; P[k2] = d2.x + d2.y; } } \
          \
        _Pragma("unroll") for (int e = 0; e < 4; ++e) { const float a_ = P[e] + DPPF(P[e], 0x141), b_ = P[e + 4] + DPPF(P[e + 4], 0x141); P[e] = (lane & 4) ? b_ : a_; } \
        _Pragma("unroll") for (int e = 0; e < 2; ++e) { const float a_ = P[e] + DPPF(P[e], 0x4E), b_ = P[e + 2] + DPPF(P[e + 2], 0x4E); P[e] = (lane & 2) ? b_ : a_; } \
        float av; { const float a_ = P[0] + DPPF(P[0], 0xB1), b_ = P[1] + DPPF(P[1], 0xB1); av = (lane & 1) ? b_ : a_; } \
        av += DPPF(av, 0x128); \
        { const auto s16 = __builtin_amdgcn_permlane16_swap(__float_as_uint(av), __float_as_uint(av), false, false); av = __uint_as_float(s16[0]) + __uint_as_float(s16[1]); } \
        { const auto s32 = __builtin_amdgcn_permlane32_swap(__float_as_uint(av), __float_as_uint(av), false, false); av = __uint_as_float(s32[0]) + __uint_as_float(s32[1]); } \
        av *= __uint_as_float((se_ >> 8) << 23); \
          \
        const float ax = fabsf(av), t = __builtin_amdgcn_rcpf(ax * 0.2316418882f + 1.0f); \
        float q = t * 0.5307027145f + (-0.7265760135f); q = q * t + 0.7107068705f; q = q * t + (-0.142248368f); q = q * t + 0.127414796f; q = q * t; \
        const float ee = __builtin_amdgcn_exp2f(av * av * (-0.72134752044f)); \
        const float mm = av * (q * ee), gl = (av < 0.f) ? mm : (av - mm); \
        const float wv = __uint_as_float(PK & 0xFFFFC000u) * gl * __uint_as_float((se_ & 255u) << 23); \
        if (lane < n_) EL[EIDX(D)] = ((__float_as_uint(wv) + 0x2000u) & 0xFFFFC000u) | (PK & 16383u); } } while (0)
#define Y_PARK() do { uint4 y0, y1; y0.x = pack2(acc[0].x, acc[0].y); y0.y = pack2(acc[1].x, acc[1].y); y0.z = pack2(acc[2].x, acc[2].y); y0.w = pack2(acc[3].x, acc[3].y); \
        y1.x = pack2(acc[4].x, acc[4].y); y1.y = pack2(acc[5].x, acc[5].y); y1.z = pack2(acc[6].x, acc[6].y); y1.w = pack2(acc[7].x, acc[7].y); \
        *(uint4*)(H2W + cur * 2048 + lane * 32) = y0; *(uint4*)(H2W + cur * 2048 + lane * 32 + 16) = y1; } while (0)
#define V_COMPUTE(D, PK, R) do { if ((D) != 0) { const int n_ = (D) & 15, rr_ = (D) >> 11; \
        if (rr_ != cur) { if (cur >= 0) Y_PARK(); cur = rr_; \
          const uint4 hA = *(const uint4*)(H2W + rr_ * 2048 + lane * 32), hB = *(const uint4*)(H2W + rr_ * 2048 + lane * 32 + 16); \
          acc[0] = BF2(hA.x); acc[1] = BF2(hA.y); acc[2] = BF2(hA.z); acc[3] = BF2(hA.w); acc[4] = BF2(hB.x); acc[5] = BF2(hB.y); acc[6] = BF2(hB.z); acc[7] = BF2(hB.w); } \
        const float wv_ = (sl < n_) ? __uint_as_float(PK & 0xFFFFC000u) : 0.f; \
        _Pragma("unroll") for (int k2 = 0; k2 < 8; ++k2) if (k2 < n_) { const float wk = __int_as_float(__builtin_amdgcn_readlane(__float_as_int(wv_), k2)); const f2v wk2 = {wk, wk}; \
          G_WAITK(R, k2); \
          acc[0] += CVLO(R[k2][0]) * wk2; acc[1] += CVHI(R[k2][0]) * wk2; acc[2] += CVLO(R[k2][1]) * wk2; acc[3] += CVHI(R[k2][1]) * wk2; \
          acc[4] += CVLO(R[k2][2]) * wk2; acc[5] += CVHI(R[k2][2]) * wk2; acc[6] += CVLO(R[k2][3]) * wk2; acc[7] += CVHI(R[k2][3]) * wk2; } } } while (0)
#define G_PROLOGUE() do { Dn = __builtin_amdgcn_readfirstlane((int)LIST[0]); PKn = EL[EIDX(Dn)]; tmpL = LIST[1]; sidx = 2; } while (0)
#pragma unroll 1
      for (int half = 0; half < 2; ++half) {
        const int row0 = half * 32 + w * 4;
        __builtin_amdgcn_wave_barrier(); asm volatile("" ::: "memory");
        { const uint4* src = (const uint4*)(H2 + (size_t)row0 * 1024); uint4 t[8];
#pragma unroll
          for (int i = 0; i < 8; ++i) t[i] = src[lane + 64 * i];
#pragma unroll
          for (int i = 0; i < 8; ++i) ((uint4*)H2W)[lane + 64 * i] = t[i]; }
        int ns;
        {
          const int rr = lane & 3, part = ((lane >> 2) + rot) & (GP_N - 1);
          int o0 = 0, o1 = 0;
          if (lane < 4 * GP_N) { o0 = (int)OFFS[(row0 + rr) * GP_OS + part]; o1 = (int)OFFS[(row0 + rr) * GP_OS + part + 1]; }
          const int nst = (o1 - o0 + 7) >> 3;
          int incl = nst;
#pragma unroll
          for (int d = 1; d < 64; d <<= 1) { const int t = __shfl_up(incl, d); if (lane >= d) incl += t; }
          const int off = incl - nst;
          for (int j = 0; j < nst; ++j) { const int base = o0 + 8 * j; const int nn = (o1 - base < 8) ? (o1 - base) : 8; LIST[off + j] = (unsigned)(nn | (base << 4) | (rr << 11)); }
          ns = __builtin_amdgcn_readlane(incl, 63);
          if (lane < 8) LIST[ns + lane] = 0u; }
        __builtin_amdgcn_wave_barrier(); asm volatile("s_waitcnt vmcnt(0)" ::: "memory");
        {
          int DA, DB, Dn, sidx, cur = -1; unsigned PKA, PKB, PKn, tmpL; u32x4_t RA[8], RB[8]; f2v hf2[8];
          R_INIT(RA, "uA"); R_INIT(RB, "uB");
          G_PROLOGUE(); G_FETCH(DA, PKA, RA, EU, "uA0");
#pragma unroll 1
          for (int s = 0; s < ns; s += 2) {
            G_FETCH(DB, PKB, RB, EU, "uB"); U_COMPUTE(DA, PKA, RA);
            G_FETCH(DA, PKA, RA, EU, "uA"); U_COMPUTE(DB, PKB, RB);
          }
          G_DRAIN(RA, RB);
        }
        __builtin_amdgcn_wave_barrier(); asm volatile("s_waitcnt vmcnt(0)" ::: "memory");
        { const uint4 z4 = make_uint4(0u, 0u, 0u, 0u);
#pragma unroll
          for (int i = 0; i < 8; ++i) ((uint4*)H2W)[lane + 64 * i] = z4; }
        __builtin_amdgcn_wave_barrier(); asm volatile("" ::: "memory");
        {
          int DA, DB, Dn, sidx, cur = -1; unsigned PKA, PKB, PKn, tmpL; u32x4_t RA[8], RB[8]; f2v acc[8];
          R_INIT(RA, "vA"); R_INIT(RB, "vB");
          G_PROLOGUE(); G_FETCH(DA, PKA, RA, EV, "vA0");
#pragma unroll 1
          for (int s = 0; s < ns; s += 2) {
            G_FETCH(DB, PKB, RB, EV, "vB"); V_COMPUTE(DA, PKA, RA);
            G_FETCH(DA, PKA, RA, EV, "vA"); V_COMPUTE(DB, PKB, RB);
          }
          G_DRAIN(RA, RB);
          if (cur >= 0) Y_PARK();
        }
        __builtin_amdgcn_wave_barrier(); asm volatile("s_waitcnt vmcnt(0)" ::: "memory");
#pragma unroll 1
        for (int rr = 0; rr < 4; ++rr) { const size_t tok = tok0 + row0 + rr;
          const uint4 hA = *(const uint4*)(H2W + rr * 2048 + lane * 32), hB = *(const uint4*)(H2W + rr * 2048 + lane * 32 + 16);
          f2v a[8]; a[0] = BF2(hA.x); a[1] = BF2(hA.y); a[2] = BF2(hA.z); a[3] = BF2(hA.w); a[4] = BF2(hB.x); a[5] = BF2(hB.y); a[6] = BF2(hB.z); a[7] = BF2(hB.w);
          float ss = 0.f;
#pragma unroll
          for (int i = 0; i < 8; ++i) ss += a[i].x * a[i].x + a[i].y * a[i].y;
          ss = wave_sum(ss); const float rs = rsqrtf(ss * (1.f / 1024.f) + EPS);
          float* orow = outp + tok * 1024 + lane * 16;
#pragma unroll
          for (int i = 0; i < 4; ++i) { const int d = lane * 16 + 4 * i;
            float4 x1 = *(const float4*)(orow + 4 * i); const float4 g3 = *(const float4*)(gpf2 + d), g2 = *(const float4*)(modb + 5120 + d);
            x1.x += g3.x * g2.x * a[2 * i].x * rs; x1.y += g3.y * g2.y * a[2 * i].y * rs; x1.z += g3.z * g2.z * a[2 * i + 1].x * rs; x1.w += g3.w * g2.w * a[2 * i + 1].y * rs;
            *(float4*)(orow + 4 * i) = x1; }
        }
      }
#undef CVLO
#undef CVHI
#undef BF2
#undef DPPF
#undef R_INIT
#undef EIDX
#undef G_FETCH
#undef G_WAITK
#undef G_DRAIN
#undef U_COMPUTE
#undef Y_PARK
#undef V_COMPUTE
#undef G_PROLOGUE
    }
  }
}

DI void phase2_scan(const KP& p) {
  unsigned char* ws = p.ws;
  for (int g = blockIdx.x * NTHR + threadIdx.x; g < 131072; g += gridDim.x * NTHR) {
    const int seq = g >> 11, within = g & 2047, dv = within >> 4, dk4 = (within & 15) * 4, dir = seq & 1;
    bf16_t* base = (bf16_t*)(ws + WS_SPT) + ((size_t)seq * 32 * 128 + dv) * 64 + dk4;
    const float* dec = (const float*)(ws + WS_DEC) + (size_t)seq * 32 * 64 + dk4;
    float s0 = 0.f, s1 = 0.f, s2 = 0.f, s3 = 0.f;
#pragma unroll 1
    for (int i0 = 0; i0 < 32; i0 += 8) {
      uint2 d[8]; float4 c[8];
#pragma unroll
      for (int j = 0; j < 8; ++j) { const int n = dir ? 31 - (i0 + j) : (i0 + j); d[j] = *(const uint2*)(base + (size_t)n * 8192); c[j] = *(const float4*)(dec + n * 64); }
#pragma unroll
      for (int j = 0; j < 8; ++j) { const int n = dir ? 31 - (i0 + j) : (i0 + j);
        uint2 o; o.x = pack2(s0, s1); o.y = pack2(s2, s3); *(uint2*)(base + (size_t)n * 8192) = o;
        s0 = c[j].x * s0 + __uint_as_float(d[j].x << 16); s1 = c[j].y * s1 + __uint_as_float(d[j].x & 0xffff0000u);
        s2 = c[j].z * s2 + __uint_as_float(d[j].y << 16); s3 = c[j].w * s3 + __uint_as_float(d[j].y & 0xffff0000u); }
    }
  }
}

#define XB_TMO      128
#define XB_XCNT(j)  (256  + 64 * (j))
#define XB_XSUB(j)  (1280 + 64 * (j))
#define XB_XGEN(j)  (2304 + 64 * (j))
#define XB_TOP      3328
#define XB_TOPGEN   3392
#define XCD_BAR_WORDS 3456
#define XB_SPIN_CAP (1u << 18)
#define LAS __attribute__((address_space(3)))

__device__ __forceinline__ unsigned xb_ld(unsigned* p)              { return __hip_atomic_load(p, __ATOMIC_RELAXED, __HIP_MEMORY_SCOPE_AGENT); }
__device__ __forceinline__ unsigned xb_add(unsigned* p, unsigned v) { return __hip_atomic_fetch_add(p, v, __ATOMIC_RELAXED, __HIP_MEMORY_SCOPE_AGENT); }
__device__ __forceinline__ unsigned xb_xcc_id() { return (unsigned)__builtin_amdgcn_s_getreg((3 << 11) | 20) & 0xFu; }
#define XB_SPIN(cond, bar) do { unsigned _sp = 0; while (cond) { __builtin_amdgcn_s_sleep(1); \
    if ((++_sp & 255u) == 0u) { if (xb_ld(&(bar)[XB_TMO])) break; if (_sp > XB_SPIN_CAP) { atomicAdd(&(bar)[XB_TMO], 1u); break; } } } } while (0)

struct XcdBarrier {
    unsigned* bar; unsigned x;
    volatile LAS unsigned* st;
};

__device__ __forceinline__ XcdBarrier xcd_barrier_post(unsigned* bar, volatile LAS unsigned* st) {
    XcdBarrier b; b.bar = bar; b.x = xb_xcc_id(); b.st = st;
    if (threadIdx.x == 0) (void)xb_add(&bar[XB_XCNT(b.x)], 1u);
    return b;
}
__device__ __forceinline__ void xcd_barrier_complete(unsigned* bar, unsigned x, unsigned& nloc, unsigned& nx) {
    const unsigned G = gridDim.x * gridDim.y * gridDim.z;
    unsigned sum, cnt, mine, sp = 0u;
    for (;;) {
        sum = 0u; cnt = 0u; mine = 0u;
#pragma unroll
        for (unsigned j = 0; j < 16; ++j) { const unsigned c = xb_ld(&bar[XB_XCNT(j)]); sum += c; cnt += (c > 0u) ? 1u : 0u; mine = (j == x) ? c : mine; }
        if (sum == G) break;
        __builtin_amdgcn_s_sleep(1);
        if ((++sp & 255u) == 0u) { if (xb_ld(&bar[XB_TMO])) break; if (sp > XB_SPIN_CAP) { atomicAdd(&bar[XB_TMO], 1u); break; } }
    }
    nloc = mine > 0u ? mine : 1u; nx = cnt > 0u ? cnt : 1u;
}

__device__ __forceinline__ void xcd_barrier(const XcdBarrier& b) {
    asm volatile("s_waitcnt vmcnt(0)" ::: "memory");
    __syncthreads();
    if (threadIdx.x == 0) {
        unsigned* bar = b.bar;
        __builtin_amdgcn_s_waitcnt(0);
        unsigned nloc = b.st[0], nx = b.st[1];
        if (nloc == 0u) { xcd_barrier_complete(bar, b.x, nloc, nx); b.st[0] = nloc; b.st[1] = nx; }
        const unsigned old = xb_add(&bar[XB_XSUB(b.x)], 1u);
        const unsigned gen = old / nloc;
        if (old + 1u == (gen + 1u) * nloc) {
            __builtin_amdgcn_fence(__ATOMIC_RELEASE, "agent");
            asm volatile("s_waitcnt vmcnt(0)" ::: "memory");
            const unsigned og = xb_add(&bar[XB_TOP], 1u);
            const unsigned tg = og / nx;
            if (og + 1u == (tg + 1u) * nx) xb_add(&bar[XB_TOPGEN], 1u);
            else XB_SPIN(xb_ld(&bar[XB_TOPGEN]) == tg, bar);
            __builtin_amdgcn_fence(__ATOMIC_ACQUIRE, "agent");
            xb_add(&bar[XB_XGEN(b.x)], 1u);
            asm volatile("s_waitcnt vmcnt(0)" ::: "memory");
        } else {
            XB_SPIN(xb_ld(&bar[XB_XGEN(b.x)]) == gen, bar);
            __builtin_amdgcn_fence(__ATOMIC_ACQUIRE, "agent");
            asm volatile("s_waitcnt vmcnt(0)" ::: "memory");
        }
    }
    __syncthreads();
}

#ifndef PROBE_ID
#define PROBE_ID 0
#endif
__global__ void __launch_bounds__(NTHR, 2) mega(KP p) {
  extern __shared__ __attribute__((aligned(16))) char lds[];
  cg::grid_group grid = cg::this_grid();
  const int hi = p.ph_hi; constexpr int probe = PROBE_ID;
  if (threadIdx.x == 0) { ((volatile LAS unsigned*)(lds + LDS_XB))[0] = 0u; ((volatile LAS unsigned*)(lds + LDS_XB))[1] = 0u; }
  __syncthreads();
  const XcdBarrier xb = xcd_barrier_post((unsigned*)(p.ws + WS_BAR), (volatile LAS unsigned*)(lds + LDS_XB));
  if (p.ph_lo <= 0 && 0 < hi) { phase0(p, lds); if (probe == 1) phase0(p, lds); if (1 < hi) { if (hi > 64) grid.sync(); else xcd_barrier(xb); } }
  if (p.ph_lo <= 1 && 1 < hi) {
    phase1a(p, lds);
    xcd_barrier(xb);
    {
      pg8::Gemm g{(const pg8::bf16_t*)p.out, (const pg8::bf16_t*)(p.ws + WS_WTINP), NTOK, 2304, 1024};
      pg8::StaticOrder S; S.init(NTOK, 2304, (int)gridDim.x, (int)blockIdx.x);
      pg8::EpiProj E{(pg8::bf16_t*)(p.ws + WS_P1S), (pg8::bf16_t*)((unsigned char*)p.out + 32 * MiB), (pg8::bf16_t*)(p.ws + WS_PROJC)};
      pg8::gemm_phase<pg8::EpiProj, pg8::StaticOrder, true, true>((PG8_LAS unsigned char*)lds, g, S, E);
    }
    xcd_barrier(xb);
    phase1c(p, lds);
    if (2 < hi) xcd_barrier(xb);
  }
  if (p.ph_lo <= 2 && 2 < hi) { phase2_scan(p); phase2_attn(p, lds); if (probe == 3) phase2_attn(p, lds); if (3 < hi) xcd_barrier(xb); }
  if (p.ph_lo <= 3 && 3 < hi) {
    phase3(p, lds, 1, probe);
    xcd_barrier(xb);
    {
      pg8::Gemm g{(const pg8::bf16_t*)(p.ws + WS_P1S), (const pg8::bf16_t*)(p.ws + WS_WTOUTP), NTOK, 1024, 1024};
      pg8::StaticOrder S; S.init(NTOK, 1024, (int)gridDim.x, (int)blockIdx.x);
      pg8::EpiBf16<0> E{(pg8::bf16_t*)(p.ws + WS_QM), 1024, nullptr, 0, 0, 1.f};
      pg8::gemm_phase<pg8::EpiBf16<0>, pg8::StaticOrder, true, true>((PG8_LAS unsigned char*)lds, g, S, E);
    }
    xcd_barrier(xb);
    phase3c(p, lds, 1, probe);
    xcd_barrier(xb);
    {
      pg8::Gemm g{(const pg8::bf16_t*)(p.ws + WS_P1S), (const pg8::bf16_t*)(p.ws + WS_WTPQP), NTOK, 2048, 1024};
      pg8::StaticOrder S; S.init(NTOK, 2048, (int)gridDim.x, (int)blockIdx.x);
      pg8::EpiBf16<0> E{(pg8::bf16_t*)(p.ws + WS_QM), 2048, nullptr, 0, 0, 1.f};
      pg8::gemm_phase<pg8::EpiBf16<0>, pg8::StaticOrder, true, true>((PG8_LAS unsigned char*)lds, g, S, E);
    }
    xcd_barrier(xb);
    phase3b(p, lds, (probe == 4 || probe == 8 || probe == 9 || probe == 10) ? 2 : 1, probe);
  }
}

extern "C" void kernel_launch(void* const* d_in, const int* in_sizes, int n_in, void* d_out, int out_size, void* d_ws, size_t ws_size, hipStream_t stream) {
  float* out = (float*)d_out;
  unsigned char* ws = (unsigned char*)d_ws;
  if (ws_size < WS_END || n_in != 25) return;
  static bool attr_done = false;
  if (!attr_done) { (void)hipFuncSetAttribute((const void*)mega, hipFuncAttributeMaxDynamicSharedMemorySize, LDS_TOTAL); attr_done = true; }
  KP p{};
  for (int i = 0; i < 25; ++i) p.in[i] = (const float*)d_in[i];
  p.out = out; p.ws = ws;
  p.ph_lo = 0; p.ph_hi = 4;
  (void)hipMemsetAsync(ws + WS_BAR, 0, XCD_BAR_WORDS * 4, stream);
  { void* args[] = {&p}; (void)hipLaunchCooperativeKernel((const void*)mega, dim3(256), dim3(NTHR), args, LDS_TOTAL, stream); }
}
```

```cpp
#include <hip/hip_runtime.h>
#include <hip/hip_cooperative_groups.h>
namespace cg = cooperative_groups;
#include <stdint.h>

typedef unsigned short bf16_t;
#define DI __device__ __forceinline__

DI float bf2f(bf16_t v) { return __uint_as_float(((unsigned)v) << 16); }
DI bf16_t f2bf(float f) { return __builtin_bit_cast(unsigned short, (__bf16)f); }

constexpr int BATCH = 8, SEQ = 2048, DM = 1024, NTOK = BATCH * SEQ;
constexpr int INW = 2272;
constexpr float EPS = 1e-6f;
constexpr int O_CQ = 0, O_CKV = 384, O_KR = 640, O_QG = 704, O_KG = 960, O_VG = 1216, O_GF = 1728, O_GB = 1744, O_R = 1760;

DI float wave_sum(float v) {
#pragma unroll
  for (int o = 1; o < 64; o <<= 1) v += __shfl_xor(v, o);
  return v;
}
DI float wave_max(float v) {
#pragma unroll
  for (int o = 1; o < 64; o <<= 1) v = fmaxf(v, __shfl_xor(v, o));
  return v;
}
DI float block_sum256(float v, float* red) {
  v = wave_sum(v);
  __syncthreads();
  if ((threadIdx.x & 63) == 0) red[threadIdx.x >> 6] = v;
  __syncthreads();
  return red[0] + red[1] + red[2] + red[3];
}
DI float block_max256(float v, float* red) {
  v = wave_max(v);
  __syncthreads();
  if ((threadIdx.x & 63) == 0) red[threadIdx.x >> 6] = v;
  __syncthreads();
  return fmaxf(fmaxf(red[0], red[1]), fmaxf(red[2], red[3]));
}
DI float silu_f(float x) { return x / (1.f + expf(-x)); }
DI float logsigmoid_f(float x) { return fminf(x, 0.f) - log1pf(expf(-fabsf(x))); }
DI float fexp(float x) { return __builtin_amdgcn_exp2f(x * 1.4426950408889634f); }
DI float silu_fast(float x) { return x * __builtin_amdgcn_rcpf(1.f + fexp(-x)); }
DI float logsigmoid_fast(float x) { return fminf(x, 0.f) - __builtin_amdgcn_logf(1.f + fexp(-fabsf(x))) * 0.6931471805599453f; }
DI float gelu_erf(float x) { return 0.5f * x * (1.f + erff(x * 0.70710678118654752f)); }

__global__ __launch_bounds__(256) void n_mod(const float* __restrict__ c, const float* __restrict__ w_ada, const float* __restrict__ b_ada, float* __restrict__ mod) {
  int idx = blockIdx.x * 256 + threadIdx.x;
  int b = idx / 6144, j = idx % 6144;
  float acc = b_ada[j];
  for (int k = 0; k < 1024; ++k) acc += silu_f(c[b * 1024 + k]) * w_ada[(size_t)k * 6144 + j];
  mod[idx] = acc;
}

__global__ __launch_bounds__(256) void n_hnorm(const float* __restrict__ x, const float* __restrict__ g, const float* __restrict__ mod, int b, int off_sh, int off_sc, float* __restrict__ h) {
  __shared__ float red[4];
  int t = blockIdx.x, tid = threadIdx.x;
  const float* xr = x + ((size_t)b * SEQ + t) * DM;
  float v[4]; float ss = 0.f;
#pragma unroll
  for (int i = 0; i < 4; ++i) { v[i] = xr[tid + 256 * i]; ss += v[i] * v[i]; }
  ss = block_sum256(ss, red);
  float rs = rsqrtf(ss * (1.f / DM) + EPS);
#pragma unroll
  for (int i = 0; i < 4; ++i) { int d = tid + 256 * i; h[(size_t)t * DM + d] = v[i] * rs * g[d] * (1.f + mod[b * 6144 + off_sc + d]) + mod[b * 6144 + off_sh + d]; }
}

template <bool BT>
__global__ __launch_bounds__(256) void n_gemm(const float* __restrict__ A, int lda, const float* __restrict__ B, int ldb, float* __restrict__ C, int ldc, int M, int N, int K) {
  __shared__ float As[16][65];
  __shared__ float Bs[16][65];
  const int tid = threadIdx.x, tx = tid & 15, ty = tid >> 4;
  const int m0 = blockIdx.y * 64, n0 = blockIdx.x * 64;
  float acc[4][4];
#pragma unroll
  for (int i = 0; i < 4; ++i)
#pragma unroll
    for (int j = 0; j < 4; ++j) acc[i][j] = 0.f;
  for (int k0 = 0; k0 < K; k0 += 16) {
#pragma unroll
    for (int i = 0; i < 4; ++i) { int e = tid + 256 * i; int m = e >> 4, k = e & 15; As[k][m] = A[(size_t)(m0 + m) * lda + k0 + k]; }
#pragma unroll
    for (int i = 0; i < 4; ++i) { int e = tid + 256 * i;
      if (!BT) { int k = e >> 6, n = e & 63; Bs[k][n] = (n0 + n < N) ? B[(size_t)(k0 + k) * ldb + n0 + n] : 0.f; }
      else     { int n = e >> 4, k = e & 15; Bs[k][n] = (n0 + n < N) ? B[(size_t)(n0 + n) * ldb + k0 + k] : 0.f; } }
    __syncthreads();
#pragma unroll
    for (int k = 0; k < 16; ++k) {
      float a[4], bb[4];
#pragma unroll
      for (int i = 0; i < 4; ++i) { a[i] = As[k][ty * 4 + i]; bb[i] = Bs[k][tx * 4 + i]; }
#pragma unroll
      for (int i = 0; i < 4; ++i)
#pragma unroll
        for (int j = 0; j < 4; ++j) acc[i][j] += a[i] * bb[j];
    }
    __syncthreads();
  }
#pragma unroll
  for (int i = 0; i < 4; ++i)
#pragma unroll
    for (int j = 0; j < 4; ++j) { int n = n0 + tx * 4 + j; if (n < N) C[(size_t)(m0 + ty * 4 + i) * ldc + n] = acc[i][j]; }
}

__global__ __launch_bounds__(256) void n_rms_slice(const float* __restrict__ in, int ldin, int off, int W, const float* __restrict__ g, float* __restrict__ out) {
  __shared__ float red[4];
  int t = blockIdx.x, tid = threadIdx.x;
  float v0 = (tid < W) ? in[(size_t)t * ldin + off + tid] : 0.f;
  float v1 = (tid + 256 < W) ? in[(size_t)t * ldin + off + tid + 256] : 0.f;
  float ss = block_sum256(v0 * v0 + v1 * v1, red);
  float rs = rsqrtf(ss / (float)W + EPS);
  if (tid < W) out[(size_t)t * W + tid] = v0 * rs * g[tid];
  if (tid + 256 < W) out[(size_t)t * W + tid + 256] = v1 * rs * g[tid + 256];
}

__global__ __launch_bounds__(256) void n_scatter(const float* __restrict__ proj, const float* __restrict__ qa, const float* __restrict__ kv, const int* __restrict__ positions, int b,
                                                 const float* __restrict__ wgf, const float* __restrict__ bgf, const float* __restrict__ wgb, const float* __restrict__ bgb,
                                                 bf16_t* __restrict__ Qm, bf16_t* __restrict__ Km, bf16_t* __restrict__ Vm, bf16_t* __restrict__ qg, bf16_t* __restrict__ kg, bf16_t* __restrict__ vg,
                                                 bf16_t* __restrict__ rg, float* __restrict__ laf, float* __restrict__ lab) {
  __shared__ float cs[32], sn[32];
  const int t = blockIdx.x, tid = threadIdx.x;
  const size_t tok = (size_t)b * SEQ + t;
  const float* pr = proj + (size_t)t * INW;
  const float* qr = qa + (size_t)t * 768;
  const float* kr = kv + (size_t)t * 1024;
  if (tid < 32) {
    float inv = powf(10000.f, -(float)tid / 32.f);
    float ang = (float)positions[tok] * inv;
    cs[tid] = cosf(ang); sn[tid] = sinf(ang);
  }
  __syncthreads();
  for (int e = tid; e < 4 * 192; e += 256) {
    int h = e / 192, d = e % 192; float v;
    if (d < 128) v = qr[h * 192 + d];
    else { int j = d - 128; const float* rp = qr + h * 192 + 128;
      if (j < 32) v = rp[j] * cs[j] - rp[j + 32] * sn[j]; else v = rp[j] * cs[j - 32] + rp[j - 32] * sn[j - 32]; }
    Qm[(((size_t)b * 4 + h) * SEQ + t) * 192 + d] = f2bf(v);
  }
  for (int e = tid; e < 4 * 192; e += 256) {
    int h = e / 192, d = e % 192; float v;
    if (d < 128) v = kr[h * 256 + d];
    else { int j = d - 128; const float* rp = pr + O_KR;
      if (j < 32) v = rp[j] * cs[j] - rp[j + 32] * sn[j]; else v = rp[j] * cs[j - 32] + rp[j - 32] * sn[j - 32]; }
    Km[(((size_t)b * 4 + h) * SEQ + t) * 192 + d] = f2bf(v);
  }
  for (int e = tid; e < 512; e += 256) { int h = e >> 7, d = e & 127; Vm[(((size_t)b * 4 + h) * SEQ + t) * 128 + d] = f2bf(kr[h * 256 + 128 + d]); }
  { int e = tid; qg[tok * 256 + e] = f2bf(pr[O_QG + e] * 0.125f); kg[tok * 256 + e] = f2bf(pr[O_KG + e]); }
  for (int e = tid; e < 512; e += 256) { vg[tok * 512 + e] = f2bf(pr[O_VG + e]); rg[tok * 512 + e] = f2bf(pr[O_R + e]); }
  { int cidx = tid; float af = bgf[cidx], ab = bgb[cidx];
#pragma unroll
    for (int r = 0; r < 16; ++r) { af += pr[O_GF + r] * wgf[r * 256 + cidx]; ab += pr[O_GB + r] * wgb[r * 256 + cidx]; }
    laf[tok * 256 + cidx] = logsigmoid_f(af) * (1.f / 16.f); lab[tok * 256 + cidx] = logsigmoid_f(ab) * (1.f / 16.f); }
}

__global__ __launch_bounds__(256) void n_attn(const bf16_t* __restrict__ Qm, const bf16_t* __restrict__ Km, const bf16_t* __restrict__ Vm, bf16_t* __restrict__ omla) {
  __shared__ float qs[192]; __shared__ float sc[2048]; __shared__ float red[4];
  const int i = blockIdx.x, h = blockIdx.y, b = blockIdx.z, tid = threadIdx.x;
  const size_t bh = (size_t)b * 4 + h;
  if (tid < 192) qs[tid] = bf2f(Qm[(bh * SEQ + i) * 192 + tid]);
  __syncthreads();
  float mx = -1e30f;
  for (int kk = 0; kk < 8; ++kk) {
    int key = tid + 256 * kk; const uint4* kr = (const uint4*)(Km + (bh * SEQ + key) * 192);
    float s = 0.f;
    for (int c = 0; c < 24; ++c) { uint4 w = kr[c]; const float* q = qs + c * 8;
      s += q[0] * __uint_as_float(w.x << 16) + q[1] * __uint_as_float(w.x & 0xffff0000u) + q[2] * __uint_as_float(w.y << 16) + q[3] * __uint_as_float(w.y & 0xffff0000u)
         + q[4] * __uint_as_float(w.z << 16) + q[5] * __uint_as_float(w.z & 0xffff0000u) + q[6] * __uint_as_float(w.w << 16) + q[7] * __uint_as_float(w.w & 0xffff0000u); }
    s *= 0.07216878364870322f; sc[key] = s; mx = fmaxf(mx, s);
  }
  mx = block_max256(mx, red);
  float sum = 0.f;
  for (int kk = 0; kk < 8; ++kk) { int key = tid + 256 * kk; float p = expf(sc[key] - mx); sc[key] = p; sum += p; }
  sum = block_sum256(sum, red);
  __syncthreads();
  if (tid < 128) { float o = 0.f; const bf16_t* vp = Vm + bh * SEQ * 128 + tid;
    for (int key = 0; key < SEQ; ++key) o += sc[key] * bf2f(vp[(size_t)key * 128]);
    omla[((size_t)b * SEQ + i) * 512 + h * 128 + tid] = f2bf(o / sum); }
}

__global__ __launch_bounds__(128) void n_gla(const bf16_t* __restrict__ qg, const bf16_t* __restrict__ kg, const bf16_t* __restrict__ vg, const bf16_t* __restrict__ laf, const bf16_t* __restrict__ lab, float* __restrict__ og) {
  __shared__ float qs[64], ks[64], as[64];
  const int bh = blockIdx.x, b = bh >> 2, h = bh & 3, dv = threadIdx.x;
  for (int dir = 0; dir < 2; ++dir) {
    float S[64];
#pragma unroll
    for (int d = 0; d < 64; ++d) S[d] = 0.f;
    const bf16_t* la = dir ? lab : laf;
    for (int s = 0; s < SEQ; ++s) {
      const int t = dir ? (SEQ - 1 - s) : s; const size_t tok = (size_t)b * SEQ + t;
      __syncthreads();
      if (dv < 64) { qs[dv] = bf2f(qg[tok * 256 + h * 64 + dv]); ks[dv] = bf2f(kg[tok * 256 + h * 64 + dv]); as[dv] = expf(bf2f(la[tok * 256 + h * 64 + dv])); }
      __syncthreads();
      const float v = bf2f(vg[tok * 512 + h * 128 + dv]); float o = 0.f;
#pragma unroll
      for (int d = 0; d < 64; ++d) { S[d] = as[d] * S[d] + ks[d] * v; o += qs[d] * S[d]; }
      if (dir == 0) og[tok * 512 + h * 128 + dv] = o; else og[tok * 512 + h * 128 + dv] += o;
    }
  }
}

__global__ __launch_bounds__(256) void n_mix(const bf16_t* __restrict__ omla, const float* __restrict__ og, const bf16_t* __restrict__ rg, const float* __restrict__ g_gla, int b, float* __restrict__ mix) {
  __shared__ float ssum[4];
  const int t = blockIdx.x, tid = threadIdx.x; const size_t tok = (size_t)b * SEQ + t;
  if (tid < 4) ssum[tid] = 0.f;
  __syncthreads();
  float v[2];
#pragma unroll
  for (int i = 0; i < 2; ++i) { int e = tid + 256 * i; v[i] = og[tok * 512 + e]; atomicAdd(&ssum[e >> 7], v[i] * v[i]); mix[(size_t)t * DM + e] = bf2f(omla[tok * 512 + e]); }
  __syncthreads();
#pragma unroll
  for (int i = 0; i < 2; ++i) { int e = tid + 256 * i; float rs = rsqrtf(ssum[e >> 7] * (1.f / 128.f) + EPS);
    mix[(size_t)t * DM + 512 + e] = v[i] * rs * g_gla[e & 127] * silu_f(bf2f(rg[tok * 512 + e])); }
}

__global__ __launch_bounds__(256) void n_post1(const float* __restrict__ x, const float* __restrict__ y, const float* __restrict__ g_post, const float* __restrict__ g_pre2, const float* __restrict__ mod, int b,
                                               float* __restrict__ out, float* __restrict__ h2) {
  __shared__ float red[4];
  const int t = blockIdx.x, tid = threadIdx.x; const size_t tok = (size_t)b * SEQ + t;
  float yv[4], xv[4]; float ss = 0.f;
#pragma unroll
  for (int i = 0; i < 4; ++i) { yv[i] = y[(size_t)t * DM + tid + 256 * i]; ss += yv[i] * yv[i]; }
  ss = block_sum256(ss, red);
  float rs = rsqrtf(ss * (1.f / DM) + EPS); float s2 = 0.f;
#pragma unroll
  for (int i = 0; i < 4; ++i) { int d = tid + 256 * i; xv[i] = x[tok * DM + d] + mod[b * 6144 + 2048 + d] * (yv[i] * rs * g_post[d]); out[tok * DM + d] = xv[i]; s2 += xv[i] * xv[i]; }
  s2 = block_sum256(s2, red);
  float r2 = rsqrtf(s2 * (1.f / DM) + EPS);
#pragma unroll
  for (int i = 0; i < 4; ++i) { int d = tid + 256 * i; h2[(size_t)t * DM + d] = xv[i] * r2 * g_pre2[d] * (1.f + mod[b * 6144 + 4096 + d]) + mod[b * 6144 + 3072 + d]; }
}

DI void wave_argmax(float& v, int& i) {
#pragma unroll
  for (int o = 1; o < 64; o <<= 1) { float ov = __shfl_xor(v, o); int oi = __shfl_xor(i, o); if (ov > v || (ov == v && oi < i)) { v = ov; i = oi; } }
}
__global__ __launch_bounds__(256) void n_peer_select(const float* __restrict__ qry, const float* __restrict__ sk1, const float* __restrict__ sk2, int* __restrict__ eidx, float* __restrict__ gate) {
  __shared__ float v1s[4][16], v2s[4][16]; __shared__ int i1s[4][16], i2s[4][16];
  const int w = threadIdx.x >> 6, lane = threadIdx.x & 63;
  const int pair = blockIdx.x * 4 + w;
  const int t = pair >> 3, h = pair & 7;
  const float* q1 = qry + (size_t)t * 2048 + h * 256; const float* q2 = q1 + 128;
  float s1a = 0.f, s1b = 0.f, s2a = 0.f, s2b = 0.f;
  for (int d = 0; d < 128; ++d) { float a = q1[d], bq = q2[d];
    s1a += a * sk1[lane * 128 + d]; s1b += a * sk1[(lane + 64) * 128 + d]; s2a += bq * sk2[lane * 128 + d]; s2b += bq * sk2[(lane + 64) * 128 + d]; }
  for (int side = 0; side < 2; ++side) {
    float va = side ? s2a : s1a, vb = side ? s2b : s1b; bool ta = false, tb = false;
    for (int k = 0; k < 16; ++k) {
      float bv; int bi;
      if (!ta && (tb || va >= vb)) { bv = va; bi = lane; } else if (!tb) { bv = vb; bi = lane + 64; } else { bv = -3e38f; bi = 1 << 20; }
      wave_argmax(bv, bi);
      if (bi == lane) ta = true; if (bi == lane + 64) tb = true;
      if (lane == 0) { if (side) { v2s[w][k] = bv; i2s[w][k] = bi; } else { v1s[w][k] = bv; i1s[w][k] = bi; } }
    }
  }
  __syncthreads();
  float cv[4]; bool tk[4];
#pragma unroll
  for (int j = 0; j < 4; ++j) { int c = lane + 64 * j; cv[j] = v1s[w][c >> 4] + v2s[w][c & 15]; tk[j] = false; }
  float topv = 0.f; int topc = 0; float mx = 0.f;
  for (int k = 0; k < 16; ++k) {
    float bv = -3e38f; int bi = 1 << 20;
#pragma unroll
    for (int j = 0; j < 4; ++j) { if (!tk[j] && cv[j] > bv) { bv = cv[j]; bi = lane + 64 * j; } }
    wave_argmax(bv, bi);
#pragma unroll
    for (int j = 0; j < 4; ++j) if (bi == lane + 64 * j) tk[j] = true;
    if (k == 0) mx = bv;
    if (lane == k) { topv = bv; topc = bi; }
  }
  float e = (lane < 16) ? expf(topv - mx) : 0.f;
  float sum = wave_sum(e);
  if (lane < 16) { eidx[(size_t)pair * 16 + lane] = i1s[w][topc >> 4] * 128 + i2s[w][topc & 15]; gate[(size_t)pair * 16 + lane] = e / sum; }
}

__global__ __launch_bounds__(256) void n_peer_apply(const float* __restrict__ h2, const int* __restrict__ eidx, const float* __restrict__ gate, const float* __restrict__ eu, const float* __restrict__ ev,
                                                    const float* __restrict__ g_post, const float* __restrict__ mod, int b, float* __restrict__ out) {
  __shared__ float ys[4][1024]; __shared__ float red[4];
  const int t = blockIdx.x, tid = threadIdx.x, w = tid >> 6, lane = tid & 63; const size_t tok = (size_t)b * SEQ + t;
  float4 hx[4];
#pragma unroll
  for (int i = 0; i < 4; ++i) hx[i] = *(const float4*)(h2 + (size_t)t * DM + (lane + 64 * i) * 4);
  float4 acc[4];
#pragma unroll
  for (int i = 0; i < 4; ++i) acc[i] = make_float4(0.f, 0.f, 0.f, 0.f);
  for (int k = w; k < 128; k += 4) {
    const int e = eidx[(size_t)t * 128 + k]; const float gt = gate[(size_t)t * 128 + k];
    const float4* ur = (const float4*)(eu + (size_t)e * DM); const float4* vr = (const float4*)(ev + (size_t)e * DM);
    float d = 0.f;
#pragma unroll
    for (int i = 0; i < 4; ++i) { float4 u = ur[lane + 64 * i]; d += u.x * hx[i].x + u.y * hx[i].y + u.z * hx[i].z + u.w * hx[i].w; }
    d = wave_sum(d);
    const float wgt = gt * gelu_erf(d);
#pragma unroll
    for (int i = 0; i < 4; ++i) { float4 v = vr[lane + 64 * i]; acc[i].x += wgt * v.x; acc[i].y += wgt * v.y; acc[i].z += wgt * v.z; acc[i].w += wgt * v.w; }
  }
#pragma unroll
  for (int i = 0; i < 4; ++i) *(float4*)(&ys[w][(lane + 64 * i) * 4]) = acc[i];
  __syncthreads();
  float yv[4]; float ss = 0.f;
#pragma unroll
  for (int i = 0; i < 4; ++i) { int d = tid + 256 * i; yv[i] = ys[0][d] + ys[1][d] + ys[2][d] + ys[3][d]; ss += yv[i] * yv[i]; }
  ss = block_sum256(ss, red);
  const float rs = rsqrtf(ss * (1.f / DM) + EPS);
#pragma unroll
  for (int i = 0; i < 4; ++i) { int d = tid + 256 * i; out[tok * DM + d] = out[tok * DM + d] + mod[b * 6144 + 5120 + d] * (yv[i] * rs * g_post[d]); }
}

typedef short bf16x8 __attribute__((ext_vector_type(8)));
typedef float f32x16 __attribute__((ext_vector_type(16)));
#define MFMA32(a, b, c) __builtin_amdgcn_mfma_f32_32x32x16_bf16((a), (b), (c), 0, 0, 0)

constexpr int NTHR = 512;
constexpr size_t MiB = 1024 * 1024;
constexpr size_t WS_MOD   = 0;
constexpr size_t WS_WTIN  = 256 * 1024;
constexpr size_t WS_WTQUP = WS_WTIN + (size_t)2304 * 1024 * 2;
constexpr size_t WS_WTKVUP = WS_WTQUP + (size_t)768 * 384 * 2;
constexpr size_t WS_WTOUT = WS_WTKVUP + (size_t)1024 * 256 * 2;
constexpr size_t WS_WTPQ  = WS_WTOUT + (size_t)1024 * 1024 * 2;
constexpr size_t WS_KD    = WS_WTPQ + (size_t)2048 * 1024 * 2;
constexpr size_t WS_DEC   = WS_KD + (size_t)256 * 256 * 2;
constexpr size_t WS_ESC   = WS_DEC + (size_t)2048 * 64 * 4;
constexpr size_t WS_R0END = WS_ESC + (size_t)2 * 16384 * 4;
static_assert(WS_R0END <= 13 * MiB, "R0");
constexpr size_t WS_BAR  = 13 * MiB - 65536;
static_assert(WS_R0END + 131072 <= WS_BAR, "R0 room");
constexpr size_t WS_QM   = 13 * MiB;
constexpr size_t WS_KM   = WS_QM + 24 * MiB;
constexpr size_t WS_VM   = WS_KM + 24 * MiB;
constexpr size_t WS_P1S  = WS_VM + 16 * MiB;
constexpr size_t WS_RG   = WS_P1S + 32 * MiB;
constexpr size_t WS_OINTRA = WS_RG + 16 * MiB;
constexpr size_t WS_QDEC = WS_OINTRA + 16 * MiB;
constexpr size_t WS_SPT  = WS_QDEC + 16 * MiB;
constexpr size_t WS_EU   = WS_SPT + 32 * MiB;
constexpr size_t WS_EV   = WS_EU + 16 * MiB;
constexpr size_t WS_WTPQP = WS_EV + 16 * MiB;
constexpr size_t WS_WTOUTP = WS_WTPQP + 4 * MiB;
constexpr size_t WS_WTINP = WS_WTOUTP + 2 * MiB;
constexpr size_t WS_PROJC = WS_WTINP + 4608 * 1024;
constexpr size_t WS_END  = WS_PROJC + 8 * MiB;
static_assert(WS_P1S == WS_QM + 64 * MiB, "P3 QRY scratch aliases QM..VM");
constexpr size_t OUT_HS  = 0;
constexpr size_t OUT_CQ  = 32 * MiB;
constexpr size_t OUT_GR  = 52 * MiB;

struct KP { const float* in[25]; float* out; unsigned char* ws; int ph_lo, ph_hi; };

constexpr int G_STG = 40960;
constexpr int LDS_WT = 3 * G_STG;
constexpr int LDS_TAB = LDS_WT + 18432;
constexpr int LDS_XB = 157696;
constexpr int LDS_TOTAL = 157696 + 16;

typedef float f32x2_t __attribute__((ext_vector_type(2)));
typedef __bf16 bf16x2_t __attribute__((ext_vector_type(2)));
DI unsigned pack2(float lo, float hi) { const f32x2_t v = {lo, hi}; return __builtin_bit_cast(unsigned, __builtin_convertvector(v, bf16x2_t)); }
DI int crow(int reg, int hh) { return (reg & 3) + 8 * (reg >> 2) + 4 * hh; }

#define GLDS16(gp, lp) __builtin_amdgcn_global_load_lds((const unsigned*)(gp), (__attribute__((address_space(3))) unsigned*)(lp), 16, 0, 0)
template <int NST, class Epi>
DI void block_gemm(char* lds, const bf16_t* A, int lda, const bf16_t* Bt, int nchunks, int K, Epi&& epi) {
  const int tid = threadIdx.x, lane = tid & 63, w = __builtin_amdgcn_readfirstlane(tid >> 6), r = lane & 31, hh = lane >> 5;
  const int nk = K >> 6, T = nchunks * nk;
  constexpr int D = NST - 1;
  if (w >= 4) {
    const int j = w - 4, rin = lane >> 3, sw = ((lane & 7) ^ rin) * 8;
    const bf16_t* Ap = A + (size_t)(16 * j + rin) * lda + sw;
    const bf16_t* Bp = Bt + (size_t)(64 * j + rin) * 64 + sw;
    auto dma = [&](int g) {
      const int ch = g / nk, t = g - ch * nk; char* st = lds + (g % NST) * G_STG;
      const bf16_t* a0 = Ap + t * 64; char* la = st + (2 * j) * 1024;
      GLDS16(a0, la); GLDS16(a0 + (size_t)8 * lda, la + 1024);
      const bf16_t* b0 = Bp + (size_t)g * 16384; char* lb = st + 8192 + (8 * j) * 1024;
#pragma unroll
      for (int i = 0; i < 8; ++i) GLDS16(b0 + i * 512, lb + i * 1024);
    };
#pragma unroll
    for (int g = 0; g < D; ++g) if (g < T) dma(g);
    if (D >= 2 && T >= 2) asm volatile("s_waitcnt vmcnt(10)" ::: "memory"); else asm volatile("s_waitcnt vmcnt(0)" ::: "memory");
    __builtin_amdgcn_s_barrier();
#pragma unroll 1
    for (int g = 0; g < T; ++g) {
      if (g + D < T) { dma(g + D); if (D >= 2) asm volatile("s_waitcnt vmcnt(10)" ::: "memory"); else asm volatile("s_waitcnt vmcnt(0)" ::: "memory"); }
      else asm volatile("s_waitcnt vmcnt(0)" ::: "memory");
      __builtin_amdgcn_s_barrier();
    }
  } else {
    const int x = r & 7;
    const int o0 = ((0 + hh) ^ x) * 16, o1 = ((2 + hh) ^ x) * 16, o2 = ((4 + hh) ^ x) * 16, o3 = ((6 + hh) ^ x) * 16;
    const int a_rd = r * 128, b_rd = 8192 + (w * 64 + r) * 128;
    __builtin_amdgcn_s_barrier();
    int g = 0;
#pragma unroll 1
    for (int ch = 0; ch < nchunks; ++ch) {
      f32x16 c00, c01, c10, c11;
#pragma unroll
      for (int i = 0; i < 16; ++i) { c00[i] = 0.f; c01[i] = 0.f; c10[i] = 0.f; c11[i] = 0.f; }
#pragma unroll 1
      for (int t = 0; t < nk; ++t, ++g) {
        const char* cur = lds + (g % NST) * G_STG;
        bf16x8 fa0[4], fa1[4], fb0[4], fb1[4];
#define FRD(s_, o_) do { fa0[s_] = *(const bf16x8*)(cur + a_rd + o_); fb0[s_] = *(const bf16x8*)(cur + b_rd + o_); fb1[s_] = *(const bf16x8*)(cur + b_rd + 4096 + o_); fa1[s_] = *(const bf16x8*)(cur + a_rd + 4096 + o_); } while (0)
        FRD(0, o0); FRD(1, o1); FRD(2, o2); FRD(3, o3);
#undef FRD
        asm volatile("s_waitcnt lgkmcnt(0)" ::: "memory");
        __builtin_amdgcn_s_barrier();
        __builtin_amdgcn_sched_barrier(0);
#pragma unroll
        for (int s = 0; s < 4; ++s) {
          c00 = MFMA32(fa0[s], fb0[s], c00); c01 = MFMA32(fa0[s], fb1[s], c01); c10 = MFMA32(fa1[s], fb0[s], c10); c11 = MFMA32(fa1[s], fb1[s], c11); }
      }
      epi(0, ch * 256 + w * 64, c00, c01);
      epi(32, ch * 256 + w * 64, c10, c11);
    }
  }
}

DI void p0_transpose(char* lds, const float* __restrict__ W, int K, int N, bf16_t* __restrict__ Wt, int item, bf16_t* __restrict__ Wplain = nullptr) {
  float* s = (float*)lds;
  const int tid = threadIdx.x;
  const int ntn = (N + 63) >> 6, kt = item / ntn, nt = item % ntn, k0 = kt * 64, n0 = nt * 64;
  __syncthreads();
#pragma unroll
  for (int i = 0; i < 8; ++i) { int e = tid + 512 * i; int kk = e >> 6, nn = e & 63; s[kk * 65 + nn] = (n0 + nn < N) ? W[(size_t)(k0 + kk) * N + n0 + nn] : 0.f; }
  __syncthreads();
  const int nn = tid >> 3, part = tid & 7;
  const float* sp = s + (part * 8) * 65 + nn;
  uint4 o; o.x = pack2(sp[0], sp[65]); o.y = pack2(sp[2 * 65], sp[3 * 65]); o.z = pack2(sp[4 * 65], sp[5 * 65]); o.w = pack2(sp[6 * 65], sp[7 * 65]);
  { const int n = n0 + nn; *(uint4*)(Wt + ((size_t)((n >> 8) * (K >> 6) + kt)) * 16384 + (n & 255) * 64 + part * 8) = o; }
  if (Wplain) *(uint4*)(Wplain + (size_t)(n0 + nn) * K + k0 + part * 8) = o;
}

DI void convert_experts(const KP& p, const int bid, const int nb) {
  const int tid = threadIdx.x; unsigned char* ws = p.ws;
  { const int lane = tid & 63; float* scl = (float*)(ws + WS_ESC);
    for (int row = bid * 8 + (tid >> 6); row < 32768; row += nb * 8) { const int t = row >> 14, e = row & 16383;
      const float* src = p.in[23 + t] + (size_t)e * 1024 + lane * 16;
      float4 x[4]; float am = 0.f;
#pragma unroll
      for (int i = 0; i < 4; ++i) { x[i] = *(const float4*)(src + 4 * i); am = fmaxf(am, fmaxf(fmaxf(fabsf(x[i].x), fabsf(x[i].y)), fmaxf(fabsf(x[i].z), fabsf(x[i].w)))); }
      am = wave_max(am);
      float sc = 1.f, isc = 1.f;
      if (am > 0.f) { int ex; (void)frexpf(448.f / am, &ex); sc = ldexpf(1.f, ex - 1); isc = ldexpf(1.f, 1 - ex); }
      unsigned wv[4];
#pragma unroll
      for (int i = 0; i < 4; ++i) { int q = __builtin_amdgcn_cvt_pk_fp8_f32(x[i].x * sc, x[i].y * sc, 0, false); q = __builtin_amdgcn_cvt_pk_fp8_f32(x[i].z * sc, x[i].w * sc, q, true); wv[i] = (unsigned)q; }
      *(uint4*)(ws + (t ? WS_EV : WS_EU) + (size_t)e * 1024 + lane * 16) = make_uint4(wv[0], wv[1], wv[2], wv[3]);
      if (lane == 0) scl[t * 16384 + e] = isc; } }
}

DI void phase0(const KP& p, char* lds) {
  const int tid = threadIdx.x, bid = blockIdx.x, nb = gridDim.x;
  unsigned char* ws = p.ws;
  constexpr int I_IN = 16 * 36, I_QUP = 6 * 12, I_KVUP = 4 * 16, I_OUT = 16 * 16, I_PQ = 16 * 32;
  constexpr int I_ALL = I_IN + I_QUP + I_KVUP + I_OUT + I_PQ;
  for (int it = bid; it < I_ALL; it += nb) {
    int q = it;
    if (q < I_IN) { p0_transpose(lds, p.in[7], 1024, 2272, (bf16_t*)(ws + WS_WTIN), q, (bf16_t*)(ws + WS_WTINP)); continue; } q -= I_IN;
    if (q < I_QUP) { p0_transpose(lds, p.in[9], 384, 768, (bf16_t*)(ws + WS_WTQUP), q); continue; } q -= I_QUP;
    if (q < I_KVUP) { p0_transpose(lds, p.in[11], 256, 1024, (bf16_t*)(ws + WS_WTKVUP), q); continue; } q -= I_KVUP;
    if (q < I_OUT) { p0_transpose(lds, p.in[17], 1024, 1024, (bf16_t*)(ws + WS_WTOUT), q, (bf16_t*)(ws + WS_WTOUTP)); continue; } q -= I_OUT;
    p0_transpose(lds, p.in[20], 1024, 2048, (bf16_t*)(ws + WS_WTPQ), q, (bf16_t*)(ws + WS_WTPQP));
  }
  { bf16_t* kd = (bf16_t*)(ws + WS_KD);
    for (int e = bid * NTHR + tid; e < 65536; e += nb * NTHR) { int n = e >> 8, k = e & 255; float v = 0.f;
      if (n < 128 && k < 128) v = p.in[21][n * 128 + k]; else if (n >= 128 && k >= 128) v = p.in[22][(n - 128) * 128 + (k - 128)];
      kd[(size_t)(k >> 6) * 16384 + n * 64 + (k & 63)] = f2bf(v); } }
  for (int jb = bid; jb < 96; jb += nb) {
    __syncthreads();
    float* cact = (float*)lds;
    float* red = (float*)(lds + 32768);
    for (int e = tid; e < 8192; e += NTHR) cact[e] = silu_f(p.in[1][e]);
    __syncthreads();
    const int jj = tid & 63, ks = tid >> 6, j0 = jb * 64;
    float acc[8];
#pragma unroll
    for (int b = 0; b < 8; ++b) acc[b] = 0.f;
    const float* wp = p.in[3] + (size_t)(ks * 128) * 6144 + j0 + jj;
    for (int k = 0; k < 128; ++k) { const float wv = wp[(size_t)k * 6144];
#pragma unroll
      for (int b = 0; b < 8; ++b) acc[b] += cact[b * 1024 + ks * 128 + k] * wv; }
#pragma unroll
    for (int b = 0; b < 8; ++b) red[(ks * 64 + jj) * 8 + b] = acc[b];
    __syncthreads();
    { const int b = tid >> 6; float sacc = p.in[4][j0 + jj];
#pragma unroll
      for (int k2 = 0; k2 < 8; ++k2) sacc += red[(k2 * 64 + jj) * 8 + b];
      ((float*)(ws + WS_MOD))[b * 6144 + j0 + jj] = sacc; }
  }
}

constexpr int WT_STRIDE = 144, WT_BYTES = 32 * WT_STRIDE;
DI void wt_write(char* wl, const f32x16& a0, const f32x16& a1, int r, int hh, float scale) {
  char* bp = wl + (4 * hh) * WT_STRIDE + r * 2;
#pragma unroll
  for (int reg = 0; reg < 16; ++reg) { const int ro = ((reg & 3) + 8 * (reg >> 2)) * WT_STRIDE;
    *(bf16_t*)(bp + ro) = f2bf(a0[reg] * scale); *(bf16_t*)(bp + ro + 64) = f2bf(a1[reg] * scale); }
}
DI void wt_write_rope(char* wl, const f32x16& a0, const f32x16& a1, int r, int hh, const float* cs, const float* sn, int m0) {
  char* bp = wl + (4 * hh) * WT_STRIDE + r * 2;
#pragma unroll
  for (int reg = 0; reg < 16; ++reg) { const int rw = (reg & 3) + 8 * (reg >> 2); const int row = m0 + rw + 4 * hh;
    const float c = cs[row * 32 + r], s = sn[row * 32 + r];
    *(bf16_t*)(bp + rw * WT_STRIDE) = f2bf(a0[reg] * c - a1[reg] * s); *(bf16_t*)(bp + rw * WT_STRIDE + 64) = f2bf(a1[reg] * c + a0[reg] * s); }
}
DI void wt_store(const char* wl, int lane, bf16_t* dA, int sA, bf16_t* dB, int sB) {
  const int piece = lane & 7, rsub = lane >> 3;
  bf16_t* d = (piece < 4) ? dA : dB; const int st = (piece < 4) ? sA : sB;
  if (d) {
#pragma unroll
    for (int i = 0; i < 4; ++i) { const int row = i * 8 + rsub; const uint4 v = *(const uint4*)(wl + row * WT_STRIDE + piece * 16);
      *(uint4*)(d + (size_t)row * st + (piece & 3) * 8) = v; }
  }
}
#define LDS_FENCE() asm volatile("s_waitcnt lgkmcnt(0)" ::: "memory")
DI int lv(int x) { asm volatile("" : "+v"(x)); return x; }
template <class T> DI T* launder(T* q) { size_t z = 0; asm volatile("" : "+s"(z)); return (T*)((char*)q + z); }

constexpr int GL_GR = 0, GL_VT = 8192, GL_QD = 26624, GL_KI = 45056, GL_KIT = 63488, GL_ATT = 81920, GL_TOT = 91136, GL_DEC = 93184, GL_LA = 93696  , GL_QS = 126464  , GL_KS = 134656;
DI void gla_chunk_local(const KP& p, char* lds, unsigned char* ws, int tile, const bf16_t* PA, const bf16_t* PB) {
  const int tid = lv(threadIdx.x), lane = tid & 63, w = tid >> 6, r = lane & 31, hh = lane >> 5;
  const int b = tile >> 5, n = tile & 31, tok0 = tile * 64;
  float* GRL = (float*)(lds + GL_GR); float* TOT = (float*)(lds + GL_TOT); float* DECL = (float*)(lds + GL_DEC);
  __syncthreads();
#pragma unroll
  for (int i = 0; i < 4; ++i) { const int e = tid + 512 * i; GRL[e] = bf2f(PB[(size_t)(e >> 5) * 1024 + (O_GF - 1024) + (e & 31)]); }
#pragma unroll 1
  for (int h = 0; h < 4; ++h) {
    __syncthreads();
    { const int t = tid >> 3, c8 = (tid & 7) * 8;
      *(uint4*)(lds + GL_QS + (t * 64 + c8) * 2) = *(const uint4*)(PA + (size_t)t * 1024 + O_QG + h * 64 + c8);
      *(uint4*)(lds + GL_KS + (t * 64 + c8) * 2) = (h == 0) ? *(const uint4*)(PA + (size_t)t * 1024 + O_KG + c8) : *(const uint4*)(PB + (size_t)t * 1024 + (O_KG - 1024) + h * 64 + c8); }
#pragma unroll
    for (int i = 0; i < 2; ++i) { const int c = tid + 512 * i, t = c >> 4, d8 = (c & 15) * 8;
      const uint4 v = *(const uint4*)(PB + (size_t)t * 1024 + (O_VG - 1024) + h * 128 + d8);
      bf16_t* vt = (bf16_t*)(lds + GL_VT) + d8 * 72 + t;
      vt[0] = (bf16_t)(v.x & 0xffffu); vt[72] = (bf16_t)(v.x >> 16); vt[144] = (bf16_t)(v.y & 0xffffu); vt[216] = (bf16_t)(v.y >> 16);
      vt[288] = (bf16_t)(v.z & 0xffffu); vt[360] = (bf16_t)(v.z >> 16); vt[432] = (bf16_t)(v.w & 0xffffu); vt[504] = (bf16_t)(v.w >> 16); }
    const int dir = tid >> 8, qt = (tid >> 6) & 3, dk = tid & 63, col = h * 64 + dk;
    float* LAL = (float*)(lds + GL_LA) + tid;
    {
      const float* wg = launder(dir ? p.in[14] : p.in[12]); const float* bg = launder(dir ? p.in[15] : p.in[13]);
      float wr[16];
#pragma unroll
      for (int q = 0; q < 16; ++q) wr[q] = wg[q * 256 + col];
      const float bias = bg[col];
      float run = 0.f;
#pragma unroll 2
      for (int ii = 0; ii < 16; ++ii) { const int i = dir ? 15 - ii : ii;
        const float* gp = GRL + (qt * 16 + i) * 32 + dir * 16; float x = bias;
#pragma unroll
        for (int q = 0; q < 16; ++q) x += gp[q] * wr[q];
        run += logsigmoid_fast(x) * (1.f / 16.f); LAL[i * 512] = run; }
      TOT[(dir * 64 + dk) * 4 + qt] = run;
    }
    __syncthreads();
    {
      const float4 tq = *(const float4*)(TOT + (dir * 64 + dk) * 4);
      const float total = (tq.x + tq.y) + (tq.z + tq.w);
      float off;
      if (dir == 0) off = (qt > 0 ? tq.x : 0.f) + (qt > 1 ? tq.y : 0.f) + (qt > 2 ? tq.z : 0.f);
      else          off = (qt < 1 ? tq.y : 0.f) + (qt < 2 ? tq.z : 0.f) + (qt < 3 ? tq.w : 0.f);
      if (qt == 0) { const float dc = fexp(total); DECL[dir * 64 + dk] = dc; ((float*)(ws + WS_DEC))[((size_t)((b * 4 + h) * 2 + dir) * 32 + n) * 64 + dk] = dc; }
      bf16_t* QD = (bf16_t*)(lds + GL_QD + dir * 9216) + (qt * 16) * 72 + dk; bf16_t* KI = (bf16_t*)(lds + GL_KI + dir * 9216) + (qt * 16) * 72 + dk;
      bf16_t* KIT = (bf16_t*)(lds + GL_KIT + dir * 9216) + dk * 72 + qt * 16;
      bf16_t* qdg = (bf16_t*)(ws + WS_QDEC) + (size_t)((tile * 4 + h) * 2 + dir) * 4096 + (qt * 16) * 64 + dk;
      const bf16_t* qgp = (const bf16_t*)(lds + GL_QS) + (qt * 16) * 64 + dk; const bf16_t* kgp = (const bf16_t*)(lds + GL_KS) + (qt * 16) * 64 + dk;
#pragma unroll 2
      for (int i = 0; i < 16; ++i) { const float bb = off + LAL[i * 512];
        const float qv = bf2f(qgp[i * 64]) * 0.125f, kv = bf2f(kgp[i * 64]);
        const float eb = fexp(bb); const bf16_t qd = f2bf(qv * eb), ki = f2bf(kv * __builtin_amdgcn_rcpf(eb));
        QD[i * 72] = qd; KI[i * 72] = ki; qdg[i * 64] = qd; KIT[i] = ki; }
    }
    __syncthreads();
    if (w < 4) { const int mi = w >> 1, ni = w & 1;
      f32x16 asum;
#pragma unroll
      for (int i = 0; i < 16; ++i) asum[i] = 0.f;
#pragma unroll
      for (int d = 0; d < 2; ++d) { f32x16 acc;
#pragma unroll
        for (int i = 0; i < 16; ++i) acc[i] = 0.f;
#pragma unroll
        for (int s = 0; s < 4; ++s) { const bf16x8 a = *(const bf16x8*)(lds + GL_QD + d * 9216 + (mi * 32 + r) * 144 + s * 32 + hh * 16);
          const bf16x8 bb = *(const bf16x8*)(lds + GL_KI + d * 9216 + (ni * 32 + r) * 144 + s * 32 + hh * 16); acc = MFMA32(a, bb, acc); }
#pragma unroll
        for (int reg = 0; reg < 16; ++reg) { const int ti = mi * 32 + crow(reg, hh), tj = ni * 32 + r; const bool keep = d ? (tj >= ti) : (tj <= ti); asum[reg] += keep ? acc[reg] : 0.f; } }
      bf16_t* at = (bf16_t*)(lds + GL_ATT) + (mi * 32 + 4 * hh) * 72 + ni * 32 + r;
#pragma unroll
      for (int reg = 0; reg < 16; ++reg) at[((reg & 3) + 8 * (reg >> 2)) * 72] = f2bf(asum[reg]);
    }
    __syncthreads();
    { const int mi = w >> 2, ni = w & 3; f32x16 acc;
#pragma unroll
      for (int i = 0; i < 16; ++i) acc[i] = 0.f;
#pragma unroll
      for (int s = 0; s < 4; ++s) { const bf16x8 a = *(const bf16x8*)(lds + GL_ATT + (mi * 32 + r) * 144 + s * 32 + hh * 16);
        const bf16x8 bb = *(const bf16x8*)(lds + GL_VT + (ni * 32 + r) * 144 + s * 32 + hh * 16); acc = MFMA32(a, bb, acc); }
      bf16_t* oi = (bf16_t*)(ws + WS_OINTRA) + (size_t)(tok0 + mi * 32 + 4 * hh) * 512 + h * 128 + ni * 32 + r;
#pragma unroll
      for (int reg = 0; reg < 16; ++reg) oi[(size_t)((reg & 3) + 8 * (reg >> 2)) * 512] = f2bf(acc[reg]); }
    { const int dvb = w >> 1, dkb = w & 1;
#pragma unroll
      for (int d = 0; d < 2; ++d) { f32x16 acc;
#pragma unroll
        for (int i = 0; i < 16; ++i) acc[i] = 0.f;
#pragma unroll
        for (int s = 0; s < 4; ++s) { const bf16x8 a = *(const bf16x8*)(lds + GL_VT + (dvb * 32 + r) * 144 + s * 32 + hh * 16);
          const bf16x8 bb = *(const bf16x8*)(lds + GL_KIT + d * 9216 + (dkb * 32 + r) * 144 + s * 32 + hh * 16); acc = MFMA32(a, bb, acc); }
        const float sc = DECL[d * 64 + dkb * 32 + r];
        bf16_t* ds = (bf16_t*)(ws + WS_SPT) + ((size_t)((b * 4 + h) * 2 + d) * 32 + n) * 8192 + (size_t)(dvb * 32 + 4 * hh) * 64 + dkb * 32 + r;
#pragma unroll
        for (int reg = 0; reg < 16; ++reg) ds[((reg & 3) + 8 * (reg >> 2)) * 64] = f2bf(acc[reg] * sc); } }
  }
}

DI void phase1a(const KP& p, char* lds) {
  const int tid = threadIdx.x, lane = tid & 63, w = tid >> 6;
  for (int tile = blockIdx.x; tile < 256; tile += gridDim.x) {
    unsigned char* ws = launder(p.ws); unsigned char* ob = (unsigned char*)launder(p.out); const float* xin = launder(p.in[0]);
    const float* mod = (const float*)(ws + WS_MOD);
    const int tok0 = tile * 64, b = tile >> 5;
    bf16_t* Hs = (bf16_t*)(ob + OUT_HS) + (size_t)tok0 * 1024;
    float4 ge[4], sh[4];
    const float* gpre = launder(p.in[5]); const float* modb = launder(mod) + b * 6144;
#pragma unroll
    for (int i = 0; i < 4; ++i) { const int d = (lane + 64 * i) * 4;
      const float4 g = *(const float4*)(gpre + d); const float4 sc = *(const float4*)(modb + 1024 + d); sh[i] = *(const float4*)(modb + d);
      ge[i] = make_float4(g.x * (1.f + sc.x), g.y * (1.f + sc.y), g.z * (1.f + sc.z), g.w * (1.f + sc.w)); }
#pragma unroll 2
    for (int rr = 0; rr < 8; ++rr) { const int row = w * 8 + rr;
      const float* xr = xin + (size_t)(tok0 + row) * 1024;
      float4 v[4]; float ss = 0.f;
#pragma unroll
      for (int i = 0; i < 4; ++i) { v[i] = *(const float4*)(xr + (lane + 64 * i) * 4); ss += v[i].x * v[i].x + v[i].y * v[i].y + v[i].z * v[i].z + v[i].w * v[i].w; }
      ss = wave_sum(ss); const float rs = rsqrtf(ss * (1.f / 1024.f) + EPS);
#pragma unroll
      for (int i = 0; i < 4; ++i) { uint2 o; o.x = pack2(v[i].x * rs * ge[i].x + sh[i].x, v[i].y * rs * ge[i].y + sh[i].y); o.y = pack2(v[i].z * rs * ge[i].z + sh[i].z, v[i].w * rs * ge[i].w + sh[i].w);
        *(uint2*)(Hs + (size_t)row * 1024 + (lane + 64 * i) * 4) = o; }
    }
  }
}

DI void phase1c(const KP& p, char* lds) {
  const int tid = threadIdx.x, lane = tid & 63, w = tid >> 6, r = lane & 31, hh = lane >> 5;
  float* cs = (float*)(lds + LDS_TAB); float* sn = cs + 2048;
  char* wl = lds + LDS_WT + (w & 3) * WT_BYTES;
  for (int tile = blockIdx.x; tile < 256; tile += gridDim.x) {
    unsigned char* ws = launder(p.ws); unsigned char* ob = (unsigned char*)launder(p.out);
    const int tok0 = tile * 64, b = tile >> 5, t0 = (tile & 31) * 64;
    const bf16_t* PA = (const bf16_t*)(ws + WS_P1S) + (size_t)tok0 * 1024;
    const bf16_t* PB = (const bf16_t*)(ob + 32 * MiB) + (size_t)tok0 * 1024;
    const bf16_t* PC = (const bf16_t*)(ws + WS_PROJC) + (size_t)tok0 * 256;
    bf16_t* Hs = (bf16_t*)(ob + OUT_HS) + (size_t)tok0 * 1024;
    bf16_t* CQN = Hs; bf16_t* CKVN = Hs + 64 * 384;
    bf16_t* Qm = (bf16_t*)(ws + WS_QM); bf16_t* Km = (bf16_t*)(ws + WS_KM); bf16_t* Vm = (bf16_t*)(ws + WS_VM);
    bf16_t* rg = (bf16_t*)(ws + WS_RG) + (size_t)tok0 * 512;
    __syncthreads();
#pragma unroll
    for (int i = 0; i < 4; ++i) { const int e = tid + 512 * i, tt = e >> 5, j = e & 31;
      const float inv = __builtin_amdgcn_exp2f(-(float)j * (13.287712379549449f / 32.f)); const float ang = (float)((const int*)p.in[2])[tok0 + tt] * inv;
      float rev = ang * 0.15915494309189535f; rev -= floorf(rev);
      cs[e] = __builtin_amdgcn_cosf(rev); sn[e] = __builtin_amdgcn_sinf(rev); }
#pragma unroll
    for (int i = 0; i < 8; ++i) { const int c = tid + 512 * i, row = c >> 6, cc = c & 63;
      const uint4 v = (cc < 36) ? *(const uint4*)(PB + (size_t)row * 1024 + (O_R - 1024) + cc * 8) : *(const uint4*)(PC + (size_t)row * 256 + (cc - 36) * 8);
      *(uint4*)(rg + (size_t)row * 512 + cc * 8) = v; }
    __syncthreads();
    if (tid < 256) { const int row = tid >> 2, pc = tid & 3;
      const uint4 x1 = *(const uint4*)(PA + (size_t)row * 1024 + O_KR + pc * 8), x2 = *(const uint4*)(PA + (size_t)row * 1024 + O_KR + 32 + pc * 8);
      const float4 c0 = *(const float4*)(cs + row * 32 + pc * 8), c1 = *(const float4*)(cs + row * 32 + pc * 8 + 4), s0 = *(const float4*)(sn + row * 32 + pc * 8), s1 = *(const float4*)(sn + row * 32 + pc * 8 + 4);
#define RO1(a_, b_, c_, s_) ((a_) * (c_) - (b_) * (s_))
#define RO2(a_, b_, c_, s_) ((b_) * (c_) + (a_) * (s_))
#define LO(u_) __uint_as_float((u_) << 16)
#define HI(u_) __uint_as_float((u_) & 0xffff0000u)
      uint4 o1, o2;
      o1.x = pack2(RO1(LO(x1.x), LO(x2.x), c0.x, s0.x), RO1(HI(x1.x), HI(x2.x), c0.y, s0.y)); o1.y = pack2(RO1(LO(x1.y), LO(x2.y), c0.z, s0.z), RO1(HI(x1.y), HI(x2.y), c0.w, s0.w));
      o1.z = pack2(RO1(LO(x1.z), LO(x2.z), c1.x, s1.x), RO1(HI(x1.z), HI(x2.z), c1.y, s1.y)); o1.w = pack2(RO1(LO(x1.w), LO(x2.w), c1.z, s1.z), RO1(HI(x1.w), HI(x2.w), c1.w, s1.w));
      o2.x = pack2(RO2(LO(x1.x), LO(x2.x), c0.x, s0.x), RO2(HI(x1.x), HI(x2.x), c0.y, s0.y)); o2.y = pack2(RO2(LO(x1.y), LO(x2.y), c0.z, s0.z), RO2(HI(x1.y), HI(x2.y), c0.w, s0.w));
      o2.z = pack2(RO2(LO(x1.z), LO(x2.z), c1.x, s1.x), RO2(HI(x1.z), HI(x2.z), c1.y, s1.y)); o2.w = pack2(RO2(LO(x1.w), LO(x2.w), c1.z, s1.z), RO2(HI(x1.w), HI(x2.w), c1.w, s1.w));
#undef RO1
#undef RO2
#undef LO
#undef HI
#pragma unroll
      for (int h = 0; h < 4; ++h) { bf16_t* kp = Km + (((size_t)b * 4 + h) * SEQ + t0 + row) * 192 + 128 + pc * 8; *(uint4*)kp = o1; *(uint4*)(kp + 32) = o2; }
    }
    const float* gq = launder(p.in[8]); const float* gkv = launder(p.in[10]);
#pragma unroll 2
    for (int rr = 0; rr < 8; ++rr) { const int row = w * 8 + rr; const unsigned* cr = (const unsigned*)(PA + (size_t)row * 1024);
      float v0[5], v1[5];
#pragma unroll
      for (int i = 0; i < 5; ++i) { const unsigned u = cr[lane + 64 * i]; v0[i] = __uint_as_float(u << 16); v1[i] = __uint_as_float(u & 0xffff0000u); }
      float ss = v0[0] * v0[0] + v1[0] * v1[0] + v0[1] * v0[1] + v1[1] * v1[1] + v0[2] * v0[2] + v1[2] * v1[2];
      float s2 = v0[3] * v0[3] + v1[3] * v1[3] + v0[4] * v0[4] + v1[4] * v1[4];
      ss = wave_sum(ss); s2 = wave_sum(s2);
      const float rq = rsqrtf(ss * (1.f / 384.f) + EPS), rk = rsqrtf(s2 * (1.f / 256.f) + EPS);
#pragma unroll
      for (int i = 0; i < 3; ++i) { const int c = 2 * (lane + 64 * i); *(unsigned*)(CQN + (size_t)row * 384 + c) = pack2(v0[i] * rq * gq[c], v1[i] * rq * gq[c + 1]); }
#pragma unroll
      for (int i = 3; i < 5; ++i) { const int c = 2 * (lane + 64 * (i - 3)); *(unsigned*)(CKVN + (size_t)row * 256 + c) = pack2(v0[i] * rk * gkv[c], v1[i] * rk * gkv[c + 1]); }
    }
    __syncthreads();
    block_gemm<3>(lds, CQN, 384, (const bf16_t*)(ws + WS_WTQUP), 3, 384, [&](int m0, int n0, const f32x16& a0, const f32x16& a1) {
      const int r2 = lv(r), h2 = lv(hh), ln = lv(lane);
      const int h = n0 / 192, d0 = n0 % 192;
      bf16_t* qp = Qm + (((size_t)b * 4 + h) * SEQ + t0 + m0) * 192 + d0;
      if (d0 < 128) wt_write(wl, a0, a1, r2, h2, 1.f); else wt_write_rope(wl, a0, a1, r2, h2, cs, sn, m0);
      LDS_FENCE();
      wt_store(wl, ln, qp, 192, qp + 32, 192);
    });
    block_gemm<3>(lds, CKVN, 256, (const bf16_t*)(ws + WS_WTKVUP), 4, 256, [&](int m0, int n0, const f32x16& a0, const f32x16& a1) {
      const int r2 = lv(r), h2 = lv(hh), ln = lv(lane);
      const int h = n0 >> 8, d0 = n0 & 255;
      wt_write(wl, a0, a1, r2, h2, 1.f); LDS_FENCE();
      if (d0 < 128) { bf16_t* kp = Km + (((size_t)b * 4 + h) * SEQ + t0 + m0) * 192 + d0; wt_store(wl, ln, kp, 192, kp + 32, 192); }
      else { bf16_t* vp = Vm + (((size_t)b * 4 + h) * SEQ + t0 + m0) * 128 + (d0 - 128); wt_store(wl, ln, vp, 128, vp + 32, 128); }
    });
    gla_chunk_local(p, lds, ws, tile, PA, PB);
  }
}

namespace att {
typedef short s16x4 __attribute__((ext_vector_type(4)));
typedef unsigned u32x4 __attribute__((ext_vector_type(4)));
constexpr int DQ = 192, DV = 128, KVBLK = 64;
constexpr float SCALE = 0.07216878364870322f;
constexpr float THR = 8.f;
constexpr int SHM_V = KVBLK * DV * 2, SHM_K = KVBLK * DQ * 2;
constexpr int SHM_QR = 8 * 32 * 176;
constexpr int SHM_ATTN = 2 * SHM_V + 2 * SHM_K + 8 * 64 * 4 + SHM_QR;
#define KSWZ(row, colB) ((row) * 384 + ((colB) ^ (((row) & 7) << 4)))
#define SBAR() __builtin_amdgcn_sched_barrier(0)
DI unsigned cvtpk(float lo, float hi) { unsigned r; asm volatile("v_cvt_pk_bf16_f32 %0, %1, %2" : "=v"(r) : "v"(lo), "v"(hi)); return r; }

DI void partialSM(f32x16& p0, f32x16& p1, float& m_reg, float& mn, float& alpha) {
  constexpr float C = SCALE * 1.4426950408889634f;
  float pmax = p0[0];
#pragma unroll
  for (int r = 1; r < 16; ++r) pmax = fmaxf(pmax, p0[r]);
#pragma unroll
  for (int r = 0; r < 16; ++r) pmax = fmaxf(pmax, p1[r]);
  { auto rr = __builtin_amdgcn_permlane32_swap(__float_as_uint(pmax), __float_as_uint(pmax), false, false);
    pmax = fmaxf(__uint_as_float(rr[0]), __uint_as_float(rr[1])); }
  if (__builtin_expect(__all(pmax - m_reg <= THR / SCALE), 1)) { mn = m_reg; alpha = 1.f; }
  else { mn = fmaxf(m_reg, pmax); alpha = __builtin_amdgcn_exp2f((m_reg - mn) * C); m_reg = mn; }
  const float mnC = -mn * C;
#pragma unroll
  for (int r = 0; r < 16; ++r) p0[r] = fmaf(p0[r], C, mnC);
#pragma unroll
  for (int r = 0; r < 16; ++r) p1[r] = fmaf(p1[r], C, mnC);
#pragma unroll
  for (int r = 0; r < 16; ++r) p0[r] = __builtin_amdgcn_exp2f(p0[r]);
}
DI void finishSM(f32x16& p0, f32x16& p1, float alpha, float& l_reg, bf16x8& pa0, bf16x8& pa1, bf16x8& pa2, bf16x8& pa3) {
#pragma unroll
  for (int r = 0; r < 16; ++r) p1[r] = __builtin_amdgcn_exp2f(p1[r]);
  float ps = 0;
#pragma unroll
  for (int r = 0; r < 16; ++r) ps += p0[r];
#pragma unroll
  for (int r = 0; r < 16; ++r) ps += p1[r];
  { auto rr = __builtin_amdgcn_permlane32_swap(__float_as_uint(ps), __float_as_uint(ps), false, false);
    ps = __uint_as_float(rr[0]) + __uint_as_float(rr[1]); }
  l_reg = l_reg * alpha + ps;
#define PK4(P, BASE, OUT) do { unsigned a0 = cvtpk(P[BASE + 0], P[BASE + 1]), a1 = cvtpk(P[BASE + 2], P[BASE + 3]);   \
    unsigned b0 = cvtpk(P[BASE + 4], P[BASE + 5]), b1 = cvtpk(P[BASE + 6], P[BASE + 7]);                              \
    auto r0 = __builtin_amdgcn_permlane32_swap(a0, b0, false, false); auto r1 = __builtin_amdgcn_permlane32_swap(a1, b1, false, false); \
    u32x4 wv = {r0[0], r1[0], r0[1], r1[1]}; OUT = *reinterpret_cast<bf16x8*>(&wv); } while (0)
  PK4(p0, 0, pa0); PK4(p0, 8, pa1); PK4(p1, 0, pa2); PK4(p1, 8, pa3);
#undef PK4
}
DI void qkt(f32x16& p0, f32x16& p1, const char* Ks, const bf16x8* qr, const char* qrl, int r32, int hi) {
#pragma unroll
  for (int i = 0; i < 16; ++i) { p0[i] = 0.f; p1[i] = 0.f; }
#pragma unroll
  for (int d0 = 0; d0 < 12; ++d0) { const int cb = (d0 * 16 + hi * 8) * 2;
    const bf16x8 b0 = *reinterpret_cast<const bf16x8*>(Ks + KSWZ(r32, cb));
    const bf16x8 b1 = *reinterpret_cast<const bf16x8*>(Ks + KSWZ(32 + r32, cb));
    const bf16x8 q = (d0 < 7) ? qr[d0 < 7 ? d0 : 0] : *reinterpret_cast<const bf16x8*>(qrl + (d0 - 7) * 32);
    p0 = MFMA32(b0, q, p0);
    p1 = MFMA32(b1, q, p1); }
}
DI int v_st(int k, int c) { const int kk = (k & ~0xC) | ((k & 4) << 1) | ((k & 8) >> 1); return ((kk >> 3) * 4 + (c >> 5)) * 512 + ((kk & 7) * 32 + (c & 31)) * 2; }
DI int v_rd_base(int lane) { return ((lane & 3) << 3) | (((lane >> 2) & 3) << 6) | (((lane >> 4) & 1) << 5) | (((lane >> 5) & 1) << 8); }
constexpr int v_rd_off(int d0, int ks, int half) { return d0 * 512 + ks * 4096 + half * 2048; }
template <int OFF> DI s16x4 tr_read(int vb) { s16x4 r; asm volatile("ds_read_b64_tr_b16 %0, %1 offset:%2" : "=&v"(r) : "v"(vb), "i"(OFF) : "memory"); return r; }
template <int D0> DI void pv_one(f32x16& od, int vb, bf16x8 pa0, bf16x8 pa1, bf16x8 pa2, bf16x8 pa3) {
  const s16x4 l0 = tr_read<v_rd_off(D0, 0, 0)>(vb), h0 = tr_read<v_rd_off(D0, 0, 1)>(vb), l1 = tr_read<v_rd_off(D0, 1, 0)>(vb), h1 = tr_read<v_rd_off(D0, 1, 1)>(vb);
  const s16x4 l2 = tr_read<v_rd_off(D0, 2, 0)>(vb), h2 = tr_read<v_rd_off(D0, 2, 1)>(vb), l3 = tr_read<v_rd_off(D0, 3, 0)>(vb), h3 = tr_read<v_rd_off(D0, 3, 1)>(vb);
  asm volatile("s_waitcnt lgkmcnt(0)" ::: "memory"); SBAR();
#define PK(L, H) (bf16x8){L[0], L[1], L[2], L[3], H[0], H[1], H[2], H[3]}
  od = MFMA32(pa0, PK(l0, h0), od);
  od = MFMA32(pa1, PK(l1, h1), od);
  od = MFMA32(pa2, PK(l2, h2), od);
  od = MFMA32(pa3, PK(l3, h3), od);
#undef PK
}
DI void pv_d0(f32x16* o, int vb, bf16x8 pa0, bf16x8 pa1, bf16x8 pa2, bf16x8 pa3) {
  pv_one<0>(o[0], vb, pa0, pa1, pa2, pa3); pv_one<1>(o[1], vb, pa0, pa1, pa2, pa3); pv_one<2>(o[2], vb, pa0, pa1, pa2, pa3); pv_one<3>(o[3], vb, pa0, pa1, pa2, pa3);
}
DI void attn_unit(const bf16_t* Qb, const bf16_t* Kh, const bf16_t* Vh, bf16_t* Ob, int seq, char* lds) {
  const int tid = lv(threadIdx.x), wid = tid >> 6, lane = tid & 63, r32 = lane & 31, hi = lane >> 5;
  char* V_lds = lds; char* K_lds = lds + 2 * SHM_V;
  float* wsf = (float*)(lds + 2 * SHM_V + 2 * SHM_K) + wid * 64; float* li_l = wsf; float* al_l = wsf + 32;
  char* qrl = lds + 2 * SHM_V + 2 * SHM_K + 8 * 64 * 4 + wid * (32 * 176) + r32 * 176 + hi * 16;
  float m_reg = -1e30f, l_reg = 0; f32x16 o[4]; bf16x8 qr[7];
#pragma unroll
  for (int d = 0; d < 4; ++d)
#pragma unroll
    for (int i = 0; i < 16; ++i) o[d][i] = 0.f;
  const bf16_t* Qw = Qb + (size_t)(wid * 32 + r32) * DQ + hi * 8;
#pragma unroll
  for (int d0 = 0; d0 < 7; ++d0) qr[d0] = *reinterpret_cast<const bf16x8*>(Qw + d0 * 16);
#pragma unroll
  for (int d0 = 7; d0 < 12; ++d0) *reinterpret_cast<bf16x8*>(qrl + (d0 - 7) * 32) = *reinterpret_cast<const bf16x8*>(Qw + d0 * 16);
  int kst[3];
#pragma unroll
  for (int i = 0; i < 3; ++i) { const int c = tid + 512 * i; kst[i] = KSWZ(c / 24, (c % 24) * 16); }
  const int vst0 = v_st(tid >> 4, (tid & 15) * 8), vst1 = v_st(32 + (tid >> 4), (tid & 15) * 8);
  const int vb0 = (int)(uintptr_t)V_lds + v_rd_base(lane);
  bf16x8 sk0, sk1, sk2, sv0, sv1;
#define SLOAD(k0) do { const bf16x8* kp = reinterpret_cast<const bf16x8*>(Kh + (size_t)(k0) * DQ) + tid; sk0 = kp[0]; sk1 = kp[512]; sk2 = kp[1024]; \
    const bf16x8* vp = reinterpret_cast<const bf16x8*>(Vh + (size_t)(k0) * DV) + tid; sv0 = vp[0]; sv1 = vp[512]; } while (0)
#define SWRITE(b) do { *(bf16x8*)(V_lds + (b) * SHM_V + vst0) = sv0; *(bf16x8*)(V_lds + (b) * SHM_V + vst1) = sv1; \
    *(bf16x8*)(K_lds + (b) * SHM_K + kst[0]) = sk0; *(bf16x8*)(K_lds + (b) * SHM_K + kst[1]) = sk1; *(bf16x8*)(K_lds + (b) * SHM_K + kst[2]) = sk2; } while (0)
#define RESC(a) do { if (__any((a) < 1.f)) { if (hi == 0) al_l[r32] = (a); asm volatile("s_waitcnt lgkmcnt(0)" ::: "memory"); \
    _Pragma("unroll") for (int d = 0; d < 4; ++d) _Pragma("unroll") for (int r = 0; r < 16; ++r) o[d][r] *= al_l[crow(r, hi)]; } } while (0)
  f32x16 pA0, pA1, pB0, pB1; float mnA, mnB, alA, alB; bf16x8 pa0, pa1, pa2, pa3; const int NT = seq / KVBLK;
  SLOAD(0); SWRITE(0); __syncthreads();
  qkt(pA0, pA1, K_lds, qr, qrl, r32, hi); partialSM(pA0, pA1, m_reg, mnA, alA);
  SLOAD(KVBLK); SWRITE(1); __syncthreads();
  for (int j = 1; j + 1 < NT; j += 2) {
    SBAR(); qkt(pB0, pB1, K_lds + SHM_K, qr, qrl, r32, hi);
    finishSM(pA0, pA1, alA, l_reg, pa0, pa1, pa2, pa3); SBAR();
    SLOAD((j + 1) * KVBLK); SBAR();
    pv_d0(o, vb0, pa0, pa1, pa2, pa3); partialSM(pB0, pB1, m_reg, mnB, alB);
    __syncthreads(); SWRITE(0);
    RESC(alB); __syncthreads();
    SBAR(); qkt(pA0, pA1, K_lds, qr, qrl, r32, hi);
    finishSM(pB0, pB1, alB, l_reg, pa0, pa1, pa2, pa3); SBAR();
    SLOAD((j + 2) * KVBLK); SBAR();
    pv_d0(o, vb0 + SHM_V, pa0, pa1, pa2, pa3); partialSM(pA0, pA1, m_reg, mnA, alA);
    __syncthreads(); SWRITE(1);
    RESC(alA); __syncthreads();
  }
  SBAR(); qkt(pB0, pB1, K_lds + SHM_K, qr, qrl, r32, hi);
  finishSM(pA0, pA1, alA, l_reg, pa0, pa1, pa2, pa3); SBAR();
  pv_d0(o, vb0, pa0, pa1, pa2, pa3); partialSM(pB0, pB1, m_reg, mnB, alB);
  __syncthreads(); RESC(alB);
  finishSM(pB0, pB1, alB, l_reg, pa0, pa1, pa2, pa3); SBAR();
  pv_d0(o, vb0 + SHM_V, pa0, pa1, pa2, pa3);
  if (hi == 0) li_l[r32] = l_reg; asm volatile("s_waitcnt lgkmcnt(0)" ::: "memory");
  float rli[16];
#pragma unroll
  for (int r = 0; r < 16; ++r) rli[r] = __builtin_amdgcn_rcpf(li_l[crow(r, hi)]);
  bf16_t* Ow = Ob + (size_t)(wid * 32) * 1024;
#pragma unroll
  for (int r = 0; r < 16; ++r) { const int orow = crow(r, hi);
#pragma unroll
    for (int d0 = 0; d0 < 4; ++d0) Ow[(size_t)orow * 1024 + d0 * 32 + r32] = f2bf(o[d0][r] * rli[r]); }
  __syncthreads();
#undef SLOAD
#undef SWRITE
#undef RESC
}
}

DI void phase2_attn(const KP& p, char* lds) {
  for (int u = blockIdx.x; u < 256; u += gridDim.x) {
    unsigned char* ws = launder(p.ws);
    const bf16_t* Qm = (const bf16_t*)(ws + WS_QM); const bf16_t* Km = (const bf16_t*)(ws + WS_KM); const bf16_t* Vm = (const bf16_t*)(ws + WS_VM);
    bf16_t* mixa = (bf16_t*)(ws + WS_P1S);
    const int qb = u & 7, bh = u >> 3, b = bh >> 2, h = bh & 3;
    att::attn_unit(Qm + ((size_t)bh * SEQ + qb * 256) * 192, Km + (size_t)bh * SEQ * 192, Vm + (size_t)bh * SEQ * 128,
                   mixa + ((size_t)b * SEQ + qb * 256) * 1024 + h * 128, SEQ, lds);
  }
}

namespace pg8 {
#define PG8_LAS __attribute__((address_space(3)))
typedef unsigned short bf16_t;
typedef short bf16x8 __attribute__((ext_vector_type(8)));
typedef float f32x4 __attribute__((ext_vector_type(4)));
typedef unsigned u32x4 __attribute__((ext_vector_type(4)));
constexpr int BM = 256, BK = 64, HALF = 128, HTB = HALF * BK * 2  , STAGE_BYTES = 8 * HTB, NXCD = 8, WGM = 8;

__host__ __device__ __forceinline__ int lds_byte(int r, int c) { const int st = (r >> 4) * 2 + (c >> 5), rr = r & 15, cc = c & 31, ob = rr * 64 + cc * 2; return st * 1024 + (ob ^ (((ob >> 9) & 1) << 5)); }
__host__ __device__ __forceinline__ void stage_rc(int b, int& R, int& C) { const int st = b / 1024, sb = b % 1024, swz = sb ^ (((sb >> 9) & 1) << 5); R = (st >> 1) * 16 + swz / 64; C = (st & 1) * 32 + (swz % 64) / 2; }
__host__ __device__ __forceinline__ int perm32(int rho) { const int n = rho >> 4, i = rho & 15; return 8 * (i >> 2) + 4 * n + (i & 3); }

struct Unit { int pm, pn; };
struct Gemm { const bf16_t* A; const bf16_t* Bt; int M, N, K; };

struct StaticOrder {
    int nM, nN, nwg, G, c;
    __host__ __device__ void init(int M, int N, int G_, int c_) { nM = M / BM; nN = N / BM; nwg = nM * nN; G = G_; c = c_; }
    __host__ __device__ bool next(int i, Unit& u) const {
        const long L = (long)i * G + c; if (L >= nwg) return false;
        int wgid = (int)L; { const int q = nwg / NXCD, r = nwg % NXCD, xcd = wgid % NXCD, off = wgid / NXCD; wgid = (xcd < r ? xcd * (q + 1) : r * (q + 1) + (xcd - r) * q) + off; }
        const int nig = WGM * nN, gid = wgid / nig, fm = gid * WGM, gsz = (nM - fm) < WGM ? (nM - fm) : WGM;
        u.pm = fm + ((wgid % nig) % gsz); u.pn = (wgid % nig) / gsz; return true;
    }
    __device__ __forceinline__ void a_ready(const Unit&) const {}
    __device__ __forceinline__ void done(const Unit&) const {}
};

__device__ __forceinline__ unsigned cvt_pk_bf16(float lo, float hi) { unsigned r; asm volatile("v_cvt_pk_bf16_f32 %0, %1, %2" : "=v"(r) : "v"(lo), "v"(hi)); return r; }
typedef float f32x2 __attribute__((ext_vector_type(2)));
__device__ __forceinline__ f32x2 gelu_pk(f32x2 v) {
    const f32x2 av = __builtin_elementwise_abs(v), d = av * 0.2316418882f + 1.0f;
    f32x2 t; t.x = __builtin_amdgcn_rcpf(d.x); t.y = __builtin_amdgcn_rcpf(d.y);
    f32x2 q = t * 0.5307027145f + (-0.7265760135f); q = q * t + 0.7107068705f; q = q * t + (-0.142248368f); q = q * t + 0.127414796f; q = q * t;
    const f32x2 s = (v * v) * (-0.72134752044f);
    f32x2 e; e.x = __builtin_amdgcn_exp2f(s.x); e.y = __builtin_amdgcn_exp2f(s.y);
    const f32x2 m = v * (q * e), r = v - m;
    f32x2 o; o.x = v.x < 0.f ? m.x : r.x; o.y = v.y < 0.f ? m.y : r.y; return o;
}

template <int ACT  > struct EpiBf16 {
    static constexpr bool PERM = true, AFTER_DRAIN = false; static_assert(ACT == 0 || ACT == 1, "EpiBf16: ACT is 0 (none) or 1 (gelu_pk)");
    bf16_t* O; int ldc; const float* bias; int split_cols; size_t split_stride; float scale0;
    __device__ __forceinline__ void operator()(const f32x4 (&acc)[2][2][4][2], const Unit& u, int wr, int wc, int fr, int fq) const {
        const int row0 = u.pm * BM + wr * 64 + fr; int colt = u.pn * BM; bf16_t* base = O;
        float sc = 1.f; if (split_cols) { const int t = colt / split_cols; base += (size_t)t * split_stride; colt -= t * split_cols; if (t == 0) sc = scale0; }
        const int col0 = colt + wc * 32 + 8 * fq, bcol0 = u.pn * BM + wc * 32 + 8 * fq;
        f32x4 bv[2][2];
#pragma unroll
        for (int bj = 0; bj < 2; ++bj)
#pragma unroll
            for (int n = 0; n < 2; ++n) bv[bj][n] = bias ? *(const f32x4*)(bias + bcol0 + bj * HALF + 4 * n) : (f32x4){0.f, 0.f, 0.f, 0.f};
#pragma unroll
        for (int ai = 0; ai < 2; ++ai)
#pragma unroll
            for (int m = 0; m < 4; ++m) { bf16_t* rowp = base + (size_t)(row0 + ai * HALF + m * 16) * ldc + col0;
#pragma unroll
                for (int bj = 0; bj < 2; ++bj) { f32x4 v0 = acc[ai][bj][m][0] + bv[bj][0], v1 = acc[ai][bj][m][1] + bv[bj][1];
                    if (ACT == 1) { f32x2 a = gelu_pk((f32x2){v0[0], v0[1]}), b = gelu_pk((f32x2){v0[2], v0[3]}), c = gelu_pk((f32x2){v1[0], v1[1]}), d = gelu_pk((f32x2){v1[2], v1[3]});
                        v0 = (f32x4){a.x, a.y, b.x, b.y}; v1 = (f32x4){c.x, c.y, d.x, d.y}; }
                    v0 = v0 * sc; v1 = v1 * sc; u32x4 w; w.x = cvt_pk_bf16(v0[0], v0[1]); w.y = cvt_pk_bf16(v0[2], v0[3]); w.z = cvt_pk_bf16(v1[0], v1[1]); w.w = cvt_pk_bf16(v1[2], v1[3]);
                    *(u32x4*)(rowp + bj * HALF) = w; } }
    }
};

template <class Epi, class Sched, bool ALIGN_EPI = false, bool SP2 = false>
__device__ __forceinline__ void gemm_phase(PG8_LAS unsigned char* lds, const Gemm g, const Sched& S, const Epi& E) {
    const int tid = threadIdx.x, wid = __builtin_amdgcn_readfirstlane(tid >> 6), lane = tid & 63, wr = wid >> 2, wc = wid & 3, fr = lane & 15, fq = lane >> 4;
    const int K = g.K, nt = K / BK;
    unsigned voffA[2], voffB[2];
#pragma unroll
    for (int i = 0; i < 2; ++i) { int R, C; stage_rc(tid * 16 + i * 8192, R, C); const int Rb = Epi::PERM ? ((R & ~31) + perm32(R & 31)) : R;
        voffA[i] = (unsigned)(R * K + C) * 2u; voffB[i] = (unsigned)(Rb * K + C) * 2u; }
    const size_t kstep = (size_t)(BK * 2);
    const size_t hstep = (size_t)HALF * K * 2;
    const size_t tstep = 2 * hstep;
    const unsigned ldsw = (unsigned)wid * 1024u;
    const int aoff = lds_byte(wr * 64 + fr, fq * 8), boff = lds_byte(wc * 32 + fr, fq * 8);
#define PG8_SA(b, h) (((b) * 2 + (h)) * HTB)
#define PG8_SB(b, h) ((4 + (b) * 2 + (h)) * HTB)
#define PG8_STAGE(bufoff, gbase, voff) do { _Pragma("unroll") for (int _i = 0; _i < 2; ++_i) \
        __builtin_amdgcn_global_load_lds((const unsigned*)((const char*)(gbase) + (voff)[_i]), (PG8_LAS unsigned*)(lds + (bufoff) + ldsw + _i * 8192), 16, 0, 0); } while (0)
#define PG8_LDA(dst, b, h) do { _Pragma("unroll") for (int m = 0; m < 4; ++m) _Pragma("unroll") for (int k = 0; k < 2; ++k) dst[m][k] = *(const PG8_LAS bf16x8*)(lds + PG8_SA(b, h) + aoff + m * 2048 + k * 1024); } while (0)
#define PG8_LDB(dst, b, h) do { _Pragma("unroll") for (int n = 0; n < 2; ++n) _Pragma("unroll") for (int k = 0; k < 2; ++k) dst[n][k] = *(const PG8_LAS bf16x8*)(lds + PG8_SB(b, h) + boff + n * 2048 + k * 1024); } while (0)
#define PG8_MMA(ai, bj, At, Bt) do { __builtin_amdgcn_s_setprio(1); _Pragma("unroll") for (int m = 0; m < 4; ++m) _Pragma("unroll") for (int n = 0; n < 2; ++n) _Pragma("unroll") for (int k = 0; k < 2; ++k) \
        acc[ai][bj][m][n] = __builtin_amdgcn_mfma_f32_16x16x32_bf16(Bt[n][k], At[m][k], acc[ai][bj][m][n], 0, 0, 0); __builtin_amdgcn_s_setprio(0); } while (0)
#define PG8_WAIT_V(n) asm volatile("s_waitcnt vmcnt(" #n ")" ::: "memory")
#define PG8_WAIT_L(n) asm volatile("s_waitcnt lgkmcnt(" #n ")" ::: "memory")
#define PG8_BAR __builtin_amdgcn_s_barrier()
#define PG8_SCHED __builtin_amdgcn_sched_barrier(0)
    Unit cur, nxt; int ui = 0;
    if (!S.next(0, cur)) return;
    f32x4 acc[2][2][4][2];
#pragma unroll
    for (int a = 0; a < 2; ++a)
#pragma unroll
        for (int b = 0; b < 2; ++b)
#pragma unroll
            for (int m = 0; m < 4; ++m)
#pragma unroll
                for (int n = 0; n < 2; ++n) acc[a][b][m][n] = (f32x4){0.f, 0.f, 0.f, 0.f};
    bf16x8 At[4][2], B0[2][2], B1[2][2];
    const char* cA = (const char*)g.A + (size_t)cur.pm * tstep; const char* cB = (const char*)g.Bt + (size_t)cur.pn * tstep;
    S.a_ready(cur);
    if constexpr (SP2) {
        PG8_STAGE(PG8_SB(0, 0), cB, voffB); PG8_STAGE(PG8_SB(0, 1), cB + hstep, voffB); PG8_STAGE(PG8_SA(0, 0), cA, voffA); PG8_STAGE(PG8_SA(0, 1), cA + hstep, voffA);
        if (wr == 1) PG8_BAR;
        PG8_WAIT_V(2); PG8_BAR;
        PG8_STAGE(PG8_SB(1, 0), cB + kstep, voffB); PG8_STAGE(PG8_SA(1, 0), cA + kstep, voffA); PG8_STAGE(PG8_SB(1, 1), cB + hstep + kstep, voffB);
        PG8_WAIT_V(6); PG8_BAR;
    } else {
        PG8_STAGE(PG8_SB(0, 0), cB, voffB); PG8_STAGE(PG8_SA(0, 0), cA, voffA); PG8_STAGE(PG8_SB(0, 1), cB + hstep, voffB); PG8_STAGE(PG8_SA(0, 1), cA + hstep, voffA);
        if (wr == 1) PG8_BAR;
        PG8_WAIT_V(4); PG8_BAR;
        PG8_STAGE(PG8_SB(1, 0), cB + kstep, voffB); PG8_STAGE(PG8_SA(1, 0), cA + kstep, voffA); PG8_STAGE(PG8_SB(1, 1), cB + hstep + kstep, voffB);
        PG8_WAIT_V(6); PG8_BAR;
    }
    for (;;) {
        const bool has_next = S.next(ui + 1, nxt);
        const char* nA = has_next ? (const char*)g.A + (size_t)nxt.pm * tstep : cA; const char* nB = has_next ? (const char*)g.Bt + (size_t)nxt.pn * tstep : cB;
        for (int t = 0; t < nt; t += 2) {
            const bool last = (t == nt - 2);
            const char* a1 = cA + (size_t)(t + 1) * kstep;
            const char* a2 = last ? nA : cA + (size_t)(t + 2) * kstep; const char* b2 = last ? nB : cB + (size_t)(t + 2) * kstep;
            const char* a3 = a2 + kstep; const char* b3 = b2 + kstep;
            if (last && has_next) S.a_ready(nxt);
            if constexpr (SP2) {
            PG8_LDB(B0, 0, 0); PG8_LDB(B1, 0, 1); PG8_SCHED; PG8_LDA(At, 0, 0); PG8_STAGE(PG8_SA(1, 1), a1 + hstep, voffA);
            PG8_WAIT_V(8); PG8_WAIT_L(0); PG8_BAR; PG8_MMA(0, 0, At, B0); PG8_MMA(0, 1, At, B1); PG8_BAR; PG8_SCHED;
            PG8_LDA(At, 0, 1); PG8_STAGE(PG8_SB(0, 0), b2, voffB); PG8_STAGE(PG8_SB(0, 1), b2 + hstep, voffB); PG8_STAGE(PG8_SA(0, 0), a2, voffA);
            PG8_WAIT_V(8); PG8_WAIT_L(0); PG8_BAR; PG8_MMA(1, 0, At, B0); PG8_MMA(1, 1, At, B1); PG8_BAR; PG8_SCHED;
            PG8_LDB(B0, 1, 0); PG8_LDB(B1, 1, 1); PG8_SCHED; PG8_LDA(At, 1, 0); PG8_STAGE(PG8_SA(0, 1), a2 + hstep, voffA);
            PG8_WAIT_V(8); PG8_WAIT_L(0); PG8_BAR; PG8_MMA(0, 0, At, B0); PG8_MMA(0, 1, At, B1); PG8_BAR; PG8_SCHED;
            PG8_LDA(At, 1, 1); PG8_STAGE(PG8_SB(1, 0), b3, voffB); PG8_STAGE(PG8_SB(1, 1), b3 + hstep, voffB); PG8_STAGE(PG8_SA(1, 0), a3, voffA);
            PG8_WAIT_V(8); PG8_WAIT_L(0); PG8_BAR; PG8_MMA(1, 0, At, B0); PG8_MMA(1, 1, At, B1); PG8_BAR; PG8_SCHED;
            } else {
            PG8_LDB(B0, 0, 0); PG8_SCHED; PG8_LDA(At, 0, 0); PG8_STAGE(PG8_SA(1, 1), a1 + hstep, voffA);
            PG8_WAIT_L(8); PG8_BAR; PG8_WAIT_L(0); PG8_MMA(0, 0, At, B0); PG8_BAR; PG8_SCHED;
            PG8_LDB(B1, 0, 1); PG8_STAGE(PG8_SB(0, 0), b2, voffB);
            PG8_BAR; PG8_WAIT_L(0); PG8_MMA(0, 1, At, B1); PG8_BAR;
            PG8_LDA(At, 0, 1); PG8_STAGE(PG8_SA(0, 0), a2, voffA);
            PG8_BAR; PG8_WAIT_L(0); PG8_MMA(1, 0, At, B0); PG8_BAR; PG8_SCHED;
            PG8_STAGE(PG8_SB(0, 1), b2 + hstep, voffB);
            PG8_WAIT_V(6); PG8_BAR; PG8_MMA(1, 1, At, B1); PG8_BAR;
            PG8_LDB(B0, 1, 0); PG8_SCHED; PG8_LDA(At, 1, 0); PG8_STAGE(PG8_SA(0, 1), a2 + hstep, voffA);
            PG8_WAIT_L(8); PG8_BAR; PG8_WAIT_L(0); PG8_MMA(0, 0, At, B0); PG8_BAR; PG8_SCHED;
            PG8_LDB(B1, 1, 1); PG8_STAGE(PG8_SB(1, 0), b3, voffB);
            PG8_BAR; PG8_WAIT_L(0); PG8_MMA(0, 1, At, B1); PG8_BAR;
            PG8_LDA(At, 1, 1); PG8_STAGE(PG8_SA(1, 0), a3, voffA);
            PG8_BAR; PG8_WAIT_L(0); PG8_MMA(1, 0, At, B0); PG8_BAR; PG8_SCHED;
            PG8_STAGE(PG8_SB(1, 1), b3 + hstep, voffB);
            PG8_WAIT_V(6); PG8_BAR; PG8_MMA(1, 1, At, B1); PG8_BAR;
            }
        }
        if constexpr (ALIGN_EPI) { if (wr == 0) PG8_BAR; }
        if constexpr (!Epi::AFTER_DRAIN) { E(acc, cur, wr, wc, fr, fq); S.done(cur); }
        if (!has_next) break;
#pragma unroll
        for (int a = 0; a < 2; ++a)
#pragma unroll
            for (int b = 0; b < 2; ++b)
#pragma unroll
                for (int m = 0; m < 4; ++m)
#pragma unroll
                    for (int n = 0; n < 2; ++n) acc[a][b][m][n] = (f32x4){0.f, 0.f, 0.f, 0.f};
        cur = nxt; cA = nA; cB = nB; ++ui;
        if constexpr (ALIGN_EPI) { if (wr == 1) PG8_BAR; }
    }
    PG8_WAIT_V(0);
    if constexpr (!ALIGN_EPI) { if (wr == 0) PG8_BAR; }
    PG8_BAR;
    if constexpr (Epi::AFTER_DRAIN) { E.fused(acc, cur, wr, wc, fr, fq, lds, wid, lane); S.done(cur); }
#undef PG8_SA
#undef PG8_SB
#undef PG8_STAGE
#undef PG8_LDA
#undef PG8_LDB
#undef PG8_MMA
#undef PG8_WAIT_V
#undef PG8_WAIT_L
#undef PG8_BAR
#undef PG8_SCHED
}
}


namespace pg8 {
struct EpiProj {
    static constexpr bool PERM = true, AFTER_DRAIN = false;
    bf16_t* P0; bf16_t* P1; bf16_t* P2;
    __device__ __forceinline__ void operator()(const f32x4 (&acc)[2][2][4][2], const Unit& u, int wr, int wc, int fr, int fq) const {
        const int row0 = u.pm * BM + wr * 64 + fr; const int colt = u.pn * BM;
        const long d1 = (long)(P1 - P0), d2 = (long)(P2 - P0); long dsel = 0; if (colt >= 1024) dsel = d1; if (colt >= 2048) dsel = d2;
        bf16_t* base = P0 + dsel; const int ldc = colt < 2048 ? 1024 : 256; const int cl = colt & 1023;
        const int col0 = cl + wc * 32 + 8 * fq;
#pragma unroll
        for (int ai = 0; ai < 2; ++ai)
#pragma unroll
            for (int m = 0; m < 4; ++m) { bf16_t* rowp = base + (size_t)(row0 + ai * HALF + m * 16) * ldc + col0;
#pragma unroll
                for (int bj = 0; bj < 2; ++bj) { const f32x4 v0 = acc[ai][bj][m][0], v1 = acc[ai][bj][m][1];
                    u32x4 w; w.x = cvt_pk_bf16(v0[0], v0[1]); w.y = cvt_pk_bf16(v0[2], v0[3]); w.z = cvt_pk_bf16(v1[0], v1[1]); w.w = cvt_pk_bf16(v1[2], v1[3]);
                    *(u32x4*)(rowp + bj * HALF) = w; } }
    }
};
}

constexpr int P3_TILE_BYTES = 256 * 1024;
constexpr int LDS_TK = 92160;
constexpr int GP_SH = 11, GP_N = 16384 >> GP_SH, GP_OS = GP_N + 1;
constexpr int LDS_OFF = 32768, LDS_CNT = 36864, LDS_LIST = 36864, LDS_H2L = 45056, LDS_SE = 110592;
constexpr int SCW = 260;
template <int N> DI void ce_desc(float (&a)[N], int i, int l) { const float hi = fmaxf(a[i], a[l]), lo = fminf(a[i], a[l]); a[i] = hi; a[l] = lo; }
DI void sort16_desc(float (&a)[16]) {
#pragma unroll
  for (int k = 2; k <= 16; k <<= 1)
#pragma unroll
    for (int j = k >> 1; j > 0; j >>= 1)
#pragma unroll
      for (int i = 0; i < 16; ++i) { const int l = i ^ j; if (l > i) { if ((i & k) == 0) ce_desc(a, i, l); else ce_desc(a, l, i); } }
}
DI void merge16_desc(float (&a)[16]) {
#pragma unroll
  for (int j = 8; j > 0; j >>= 1)
#pragma unroll
    for (int i = 0; i < 16; ++i) { const int l = i ^ j; if (l > i) ce_desc(a, i, l); }
}
DI void top16_merge(float (&a)[16], const float (&b)[16]) {
#pragma unroll
  for (int i = 0; i < 16; ++i) a[i] = fmaxf(a[i], b[15 - i]);
  merge16_desc(a);
}
template <int CTRL> DI float dpp_f(float v) { return __int_as_float(__builtin_amdgcn_mov_dpp(__float_as_int(v), CTRL, 0xF, 0xF, true)); }

DI float gelu_fast(float x) { return 0.5f * x * (1.f + erff(x * 0.70710678118654752f)); }

DI void phase3(const KP& p, char* lds, const int gather_reps, const int probe) {
  const int tid0 = threadIdx.x;
  const int r = tid0 & 31, hh = (tid0 >> 5) & 1, lane = tid0 & 63;
  char* wl = lds + LDS_WT + ((tid0 >> 6) & 3) * WT_BYTES;
  for (int tile = blockIdx.x; tile < 256; tile += gridDim.x) {
    unsigned char* ws = launder(p.ws); float* outp = launder(p.out); const float* xin = launder(p.in[0]);
    const int tok0 = tile * 64, b = tile >> 5;
    unsigned char* tsc = ws + WS_QM + (size_t)tile * P3_TILE_BYTES;
    bf16_t* QRY = (bf16_t*)tsc; bf16_t* Y = (bf16_t*)tsc; bf16_t* MIXA = (bf16_t*)(ws + WS_P1S) + (size_t)tok0 * 1024; bf16_t* H2 = MIXA;
    const float* modb = launder((const float*)(ws + WS_MOD)) + b * 6144;
    __syncthreads();
    {
      const int tid = lv(tid0), lane = tid & 63, w = tid >> 6, r = lane & 31, hh = lane >> 5;
      const int h = w >> 1, mi = w & 1, n = tile & 31;
      char* OIL = lds; char* RGL = lds + 66560;
      { const bf16_t* oig = (const bf16_t*)(ws + WS_OINTRA) + (size_t)tok0 * 512; const bf16_t* rgg = (const bf16_t*)(ws + WS_RG) + (size_t)tok0 * 512;
#pragma unroll
        for (int i = 0; i < 8; ++i) { const int c = tid + 512 * i, row = c >> 6, cc = c & 63;
          *(uint4*)(OIL + row * 1040 + cc * 16) = *(const uint4*)(oig + (size_t)row * 512 + cc * 8);
          *(uint4*)(RGL + row * 1040 + cc * 16) = *(const uint4*)(rgg + (size_t)row * 512 + cc * 8); } }
      const bf16_t* QDg = (const bf16_t*)(ws + WS_QDEC) + (size_t)(tile * 4 + h) * 2 * 4096 + (mi * 32 + r) * 64 + hh * 8;
      const bf16_t* SPg = (const bf16_t*)(ws + WS_SPT) + ((size_t)((b * 4 + h) * 2) * 32 + n) * 8192 + r * 64 + hh * 8;
      f32x16 acc[4];
#pragma unroll
      for (int ni = 0; ni < 4; ++ni)
#pragma unroll
        for (int i = 0; i < 16; ++i) acc[ni][i] = 0.f;
#pragma unroll
      for (int d = 0; d < 2; ++d)
#pragma unroll
        for (int s = 0; s < 4; ++s) { const bf16x8 a = *(const bf16x8*)(QDg + d * 4096 + s * 16);
#pragma unroll
          for (int ni = 0; ni < 4; ++ni) { const bf16x8 bb = *(const bf16x8*)(SPg + (size_t)d * 32 * 8192 + ni * 32 * 64 + s * 16); acc[ni] = MFMA32(a, bb, acc[ni]); } }
      __syncthreads();
      bf16_t* oil = (bf16_t*)(OIL + (mi * 32 + 4 * hh) * 1040) + h * 128 + r; const bf16_t* rgl = (const bf16_t*)(RGL + (mi * 32 + 4 * hh) * 1040) + h * 128 + r;
#pragma unroll
      for (int ni = 0; ni < 4; ++ni)
#pragma unroll
        for (int reg = 0; reg < 16; ++reg) acc[ni][reg] += bf2f(oil[((reg & 3) + 8 * (reg >> 2)) * 520 + ni * 32]);
      float rs[16];
#pragma unroll
      for (int reg = 0; reg < 16; ++reg) { float v = acc[0][reg] * acc[0][reg] + acc[1][reg] * acc[1][reg] + acc[2][reg] * acc[2][reg] + acc[3][reg] * acc[3][reg];
        v += __shfl_xor(v, 1); v += __shfl_xor(v, 2); v += __shfl_xor(v, 4); v += __shfl_xor(v, 8); v += __shfl_xor(v, 16);
        rs[reg] = rsqrtf(v * (1.f / 128.f) + EPS); }
      const float* ggl = launder(p.in[16]);
#pragma unroll
      for (int ni = 0; ni < 4; ++ni) { const float g = ggl[ni * 32 + r];
#pragma unroll
        for (int reg = 0; reg < 16; ++reg) { const int ro = ((reg & 3) + 8 * (reg >> 2)) * 520 + ni * 32; const float rv = bf2f(rgl[ro]);
          oil[ro] = f2bf(acc[ni][reg] * rs[reg] * g * silu_fast(rv)); } }
      __syncthreads();
#pragma unroll
      for (int i = 0; i < 8; ++i) { const int c = tid + 512 * i, row = c >> 6, cc = c & 63;
        *(uint4*)(MIXA + (size_t)row * 1024 + 512 + cc * 8) = *(const uint4*)(OIL + row * 1040 + cc * 16); }
    }
  }
}

DI void phase3c(const KP& p, char* lds, const int gather_reps, const int probe) {
  const int tid0 = threadIdx.x;
  const int r = tid0 & 31, hh = (tid0 >> 5) & 1, lane = tid0 & 63;
  char* wl = lds + LDS_WT + ((tid0 >> 6) & 3) * WT_BYTES;
  for (int tile = blockIdx.x; tile < 256; tile += gridDim.x) {
    unsigned char* ws = launder(p.ws); float* outp = launder(p.out); const float* xin = launder(p.in[0]);
    const int tok0 = tile * 64, b = tile >> 5;
    unsigned char* tsc = ws + WS_QM + (size_t)tile * P3_TILE_BYTES;
    bf16_t* QRY = (bf16_t*)tsc; bf16_t* Y = (bf16_t*)(ws + WS_QM) + (size_t)tok0 * 1024; bf16_t* MIXA = (bf16_t*)(ws + WS_P1S) + (size_t)tok0 * 1024; bf16_t* H2 = MIXA;
    const float* modb = launder((const float*)(ws + WS_MOD)) + b * 6144;
    __syncthreads();
    {
      const int tid = lv(tid0), lane = tid & 63, w = tid >> 6;
      float4 A1[4], A2[4], S2[4];
      const float* gpo = launder(p.in[6]); const float* gpf = launder(p.in[18]);
#pragma unroll
      for (int i = 0; i < 4; ++i) { const int d = (lane + 64 * i) * 4;
        const float4 gp = *(const float4*)(gpo + d), gt = *(const float4*)(modb + 2048 + d), g2 = *(const float4*)(gpf + d), sc = *(const float4*)(modb + 4096 + d);
        S2[i] = *(const float4*)(modb + 3072 + d);
        A1[i] = make_float4(gp.x * gt.x, gp.y * gt.y, gp.z * gt.z, gp.w * gt.w);
        A2[i] = make_float4(g2.x * (1.f + sc.x), g2.y * (1.f + sc.y), g2.z * (1.f + sc.z), g2.w * (1.f + sc.w)); }
#pragma unroll 2
      for (int rr = 0; rr < 8; ++rr) { const int row = w * 8 + rr; const size_t tok = tok0 + row;
        float4 yv[4]; float ss = 0.f;
#pragma unroll
        for (int i = 0; i < 4; ++i) { const uint2 u = *(const uint2*)(Y + (size_t)row * 1024 + (lane + 64 * i) * 4);
          yv[i] = make_float4(__uint_as_float(u.x << 16), __uint_as_float(u.x & 0xffff0000u), __uint_as_float(u.y << 16), __uint_as_float(u.y & 0xffff0000u));
          ss += yv[i].x * yv[i].x + yv[i].y * yv[i].y + yv[i].z * yv[i].z + yv[i].w * yv[i].w; }
        ss = wave_sum(ss); const float rs = rsqrtf(ss * (1.f / 1024.f) + EPS);
        float4 xv[4]; float s2 = 0.f;
#pragma unroll
        for (int i = 0; i < 4; ++i) { const float4 x = *(const float4*)(xin + tok * 1024 + (lane + 64 * i) * 4);
          xv[i] = make_float4(x.x + A1[i].x * yv[i].x * rs, x.y + A1[i].y * yv[i].y * rs, x.z + A1[i].z * yv[i].z * rs, x.w + A1[i].w * yv[i].w * rs);
          *(float4*)(outp + tok * 1024 + (lane + 64 * i) * 4) = xv[i];
          s2 += xv[i].x * xv[i].x + xv[i].y * xv[i].y + xv[i].z * xv[i].z + xv[i].w * xv[i].w; }
        s2 = wave_sum(s2); const float r2 = rsqrtf(s2 * (1.f / 1024.f) + EPS);
#pragma unroll
        for (int i = 0; i < 4; ++i) { uint2 o; o.x = pack2(xv[i].x * r2 * A2[i].x + S2[i].x, xv[i].y * r2 * A2[i].y + S2[i].y); o.y = pack2(xv[i].z * r2 * A2[i].z + S2[i].z, xv[i].w * r2 * A2[i].w + S2[i].w);
          *(uint2*)(H2 + (size_t)row * 1024 + (lane + 64 * i) * 4) = o; }
      }
    }
  }
}

DI void phase3b(const KP& p, char* lds, const int gather_reps, const int probe) {
  const int tid0 = threadIdx.x;
  const int r = tid0 & 31, hh = (tid0 >> 5) & 1, lane = tid0 & 63;
  char* wl = lds + LDS_WT + ((tid0 >> 6) & 3) * WT_BYTES;
  for (int tile = blockIdx.x; tile < 256; tile += gridDim.x) {
    unsigned char* ws = launder(p.ws); float* outp = launder(p.out); const float* xin = launder(p.in[0]);
    const int tok0 = tile * 64, b = tile >> 5;
    unsigned char* tsc = ws + WS_QM + (size_t)tile * P3_TILE_BYTES;
    bf16_t* QRY = (bf16_t*)tsc; bf16_t* Y = (bf16_t*)tsc; bf16_t* MIXA = (bf16_t*)(ws + WS_P1S) + (size_t)tok0 * 1024; bf16_t* H2 = MIXA;
    const float* modb = launder((const float*)(ws + WS_MOD)) + b * 6144;
    __syncthreads();
    float* SC = (float*)lds; unsigned* TK = (unsigned*)(lds + LDS_TK);
    for (int rep3e = 0; rep3e < (probe == 7 ? 2 : 1); ++rep3e)
    for (int h = 0; h < 8; ++h) {
      block_gemm<2>(lds, QRY + h * 256, 2048, (const bf16_t*)(ws + WS_KD), 1, 256, [&](int m0, int n0, const f32x16& a0, const f32x16& a1) {
        const int r2 = lv(r), h2 = lv(hh);
        float* sp = SC + (m0 + 4 * h2) * SCW + n0 + r2;
#pragma unroll
        for (int reg = 0; reg < 16; ++reg) { const int ro = ((reg & 3) + 8 * (reg >> 2)) * SCW; sp[ro] = a0[reg]; sp[ro + 32] = a1[reg]; }
      });
      __syncthreads();
      {
        const int tid = lv(tid0);
        const int tt = tid >> 3, sd = (tid >> 2) & 1, q = tid & 3;
        const float* sr = SC + tt * SCW + sd * 128 + q * 32;
        float a[16], c[16];
#pragma unroll
        for (int i = 0; i < 4; ++i) { const float4 v = *(const float4*)(sr + i * 4); const unsigned ib = q * 32 + i * 4;
          a[i * 4 + 0] = __uint_as_float((__float_as_uint(v.x) & 0xFFFFFF80u) | (ib + 0)); a[i * 4 + 1] = __uint_as_float((__float_as_uint(v.y) & 0xFFFFFF80u) | (ib + 1));
          a[i * 4 + 2] = __uint_as_float((__float_as_uint(v.z) & 0xFFFFFF80u) | (ib + 2)); a[i * 4 + 3] = __uint_as_float((__float_as_uint(v.w) & 0xFFFFFF80u) | (ib + 3)); }
#pragma unroll
        for (int i = 0; i < 4; ++i) { const float4 v = *(const float4*)(sr + 16 + i * 4); const unsigned ib = q * 32 + 16 + i * 4;
          c[i * 4 + 0] = __uint_as_float((__float_as_uint(v.x) & 0xFFFFFF80u) | (ib + 0)); c[i * 4 + 1] = __uint_as_float((__float_as_uint(v.y) & 0xFFFFFF80u) | (ib + 1));
          c[i * 4 + 2] = __uint_as_float((__float_as_uint(v.z) & 0xFFFFFF80u) | (ib + 2)); c[i * 4 + 3] = __uint_as_float((__float_as_uint(v.w) & 0xFFFFFF80u) | (ib + 3)); }
        sort16_desc(a); sort16_desc(c); top16_merge(a, c);
#pragma unroll
        for (int i = 0; i < 16; ++i) c[i] = dpp_f<0xB1>(a[i]);
        top16_merge(a, c);
#pragma unroll
        for (int i = 0; i < 16; ++i) c[i] = dpp_f<0x4E>(a[i]);
        top16_merge(a, c);
        if (q == 0) { unsigned* tk = TK + ((tt * 8 + h) * 2 + sd) * 16;
#pragma unroll
          for (int i = 0; i < 4; ++i) *(uint4*)(tk + i * 4) = make_uint4(__float_as_uint(a[i * 4]), __float_as_uint(a[i * 4 + 1]), __float_as_uint(a[i * 4 + 2]), __float_as_uint(a[i * 4 + 3])); }
      }
      __syncthreads();
    }
    {
      const int tid = lv(tid0);
      const int tt = tid >> 3, h = tid & 7;
      const unsigned* t1 = TK + ((tt * 8 + h) * 2) * 16; const unsigned* t2 = t1 + 16;
      float v1[16], v2[16];
#pragma unroll
      for (int i = 0; i < 4; ++i) { const uint4 u = *(const uint4*)(t1 + i * 4), v = *(const uint4*)(t2 + i * 4);
        v1[i * 4] = __uint_as_float(u.x & 0xFFFFFF80u); v1[i * 4 + 1] = __uint_as_float(u.y & 0xFFFFFF80u); v1[i * 4 + 2] = __uint_as_float(u.z & 0xFFFFFF80u); v1[i * 4 + 3] = __uint_as_float(u.w & 0xFFFFFF80u);
        v2[i * 4] = __uint_as_float(v.x & 0xFFFFFF80u); v2[i * 4 + 1] = __uint_as_float(v.y & 0xFFFFFF80u); v2[i * 4 + 2] = __uint_as_float(v.z & 0xFFFFFF80u); v2[i * 4 + 3] = __uint_as_float(v.w & 0xFFFFFF80u); }
      float best[16], grp[16];
#define CAND(i, j) __uint_as_float((__float_as_uint(v1[i] + v2[j]) & 0xFFFFFF00u) | ((i) << 4) | (j))
      best[0] = CAND(0, 0); best[1] = CAND(0, 1); best[2] = CAND(0, 2); best[3] = CAND(0, 3); best[4] = CAND(0, 4); best[5] = CAND(0, 5); best[6] = CAND(0, 6); best[7] = CAND(0, 7);
      best[8] = CAND(0, 8); best[9] = CAND(0, 9); best[10] = CAND(0, 10); best[11] = CAND(0, 11); best[12] = CAND(0, 12); best[13] = CAND(0, 13); best[14] = CAND(0, 14); best[15] = CAND(0, 15);
      sort16_desc(best);
      grp[0] = CAND(1, 0); grp[1] = CAND(1, 1); grp[2] = CAND(1, 2); grp[3] = CAND(1, 3); grp[4] = CAND(1, 4); grp[5] = CAND(1, 5); grp[6] = CAND(1, 6); grp[7] = CAND(1, 7);
      grp[8] = CAND(2, 0); grp[9] = CAND(2, 1); grp[10] = CAND(2, 2); grp[11] = CAND(2, 3); grp[12] = CAND(2, 4); grp[13] = CAND(3, 0); grp[14] = CAND(3, 1); grp[15] = CAND(3, 2);
      sort16_desc(grp); top16_merge(best, grp);
      grp[0] = CAND(3, 3); grp[1] = CAND(4, 0); grp[2] = CAND(4, 1); grp[3] = CAND(4, 2); grp[4] = CAND(5, 0); grp[5] = CAND(5, 1); grp[6] = CAND(6, 0); grp[7] = CAND(6, 1);
      grp[8] = CAND(7, 0); grp[9] = CAND(7, 1); grp[10] = CAND(8, 0); grp[11] = CAND(9, 0); grp[12] = CAND(10, 0); grp[13] = CAND(11, 0); grp[14] = CAND(12, 0); grp[15] = CAND(13, 0);
      sort16_desc(grp); top16_merge(best, grp);
      { const float c14 = CAND(14, 0), c15 = CAND(15, 0);
        grp[0] = fmaxf(c14, c15); grp[1] = fminf(c14, c15);
#pragma unroll
        for (int i = 2; i < 16; ++i) grp[i] = -3.0e38f;
        top16_merge(best, grp); }
#undef CAND
      __syncthreads();
      float sv[16]; int ev[16]; float mx = -3.0e38f;
#pragma unroll
      for (int k = 0; k < 16; ++k) { const unsigned key = __float_as_uint(best[k]); const int ci = (key >> 4) & 15, cj = key & 15;
        const unsigned k1 = t1[ci], k2 = t2[cj];
        sv[k] = __uint_as_float(k1 & 0xFFFFFF80u) + __uint_as_float(k2 & 0xFFFFFF80u); ev[k] = (int)((k1 & 127u) * 128u + (k2 & 127u)); mx = fmaxf(mx, sv[k]); }
      float sum = 0.f;
#pragma unroll
      for (int k = 0; k < 16; ++k) { sv[k] = __expf(sv[k] - mx); sum += sv[k]; }
      const float inv = 1.f / sum;
      unsigned* CNT = (unsigned*)(lds + LDS_CNT); unsigned short* OFFS = (unsigned short*)(lds + LDS_OFF); unsigned* EL = (unsigned*)lds; unsigned short* SE = (unsigned short*)(lds + LDS_SE);
      float scu[16], scv[16];
      { const float* SCU = (const float*)(ws + WS_ESC);
#pragma unroll
        for (int k = 0; k < 16; ++k) { scu[k] = SCU[ev[k]]; scv[k] = SCU[16384 + ev[k]]; } }
      CNT[tid] = 0u; if (GP_N > 8) CNT[tid + 512] = 0u;
      __syncthreads();
      int pos[16];
#pragma unroll
      for (int k = 0; k < 16; ++k) pos[k] = (int)atomicAdd(&CNT[tt * GP_N + (ev[k] >> GP_SH)], 1u);
      __syncthreads();
      if (h == 0) { unsigned run = 0;
#pragma unroll
        for (int q = 0; q < GP_N; ++q) { OFFS[tt * GP_OS + q] = (unsigned short)run; run += CNT[tt * GP_N + q]; }
        OFFS[tt * GP_OS + GP_N] = (unsigned short)run; }
      __syncthreads();
#pragma unroll
      for (int k = 0; k < 16; ++k) { const int d = (int)OFFS[tt * GP_OS + (ev[k] >> GP_SH)] + pos[k];
        EL[tt * 128 + d] = ((__float_as_uint(sv[k] * inv) + 0x2000u) & 0xFFFFC000u) | (unsigned)ev[k];
        SE[tt * 128 + d] = (unsigned short)((((__float_as_uint(scu[k]) >> 23) & 255u) << 8) | ((__float_as_uint(scv[k]) >> 23) & 255u)); }
    }
    __syncthreads();
    {
      const int tid = lv(tid0), lane = tid & 63, w = tid >> 6;
      const unsigned char* EU = ws + WS_EU; const unsigned char* EV = ws + WS_EV;
      unsigned* EL = (unsigned*)lds; const unsigned short* OFFS = (const unsigned short*)(lds + LDS_OFF); unsigned* LIST = (unsigned*)(lds + LDS_LIST) + w * 256; char* H2W = lds + LDS_H2L + w * 8192;
      const unsigned short* SE = (const unsigned short*)(lds + LDS_SE);
      const float* gpf2 = launder(p.in[19]);
      const int rot = (int)(__builtin_amdgcn_s_getreg((3 << 11) | 20) & 0xFu) * (GP_N / 8);
      const unsigned voff = (unsigned)lane * 16u;
      const int sl = lane & 7;
      typedef float f2v __attribute__((ext_vector_type(2))); typedef unsigned u32x4_t __attribute__((ext_vector_type(4)));
#define CVLO(wd) __builtin_amdgcn_cvt_pk_f32_fp8((int)(wd), false)
#define CVHI(wd) __builtin_amdgcn_cvt_pk_f32_fp8((int)(wd), true)
#define BF2(wd) ((f2v){__uint_as_float((wd) << 16), __uint_as_float((wd) & 0xffff0000u)})
#define DPPF(x, CTRL) __int_as_float(__builtin_amdgcn_update_dpp(0, __float_as_int(x), CTRL, 0xF, 0xF, true))
#define R_INIT(R, TAG) do { _Pragma("unroll") for (int k2 = 0; k2 < 8; ++k2) asm volatile("; init " TAG : "=v"(R[k2])); } while (0)
#define EIDX(D) ((row0 + ((D) >> 11)) * 128 + (((D) >> 4) & 127) + (sl < ((D) & 15) ? sl : 0))
#define G_FETCH(DX, PKX, R, TAB, TAG) do { DX = Dn; PKX = PKn; { const int es_ = (int)(PKX & 16383u); \
        _Pragma("unroll") for (int k2 = 0; k2 < 8; ++k2) { const int e_ = __builtin_amdgcn_readlane(es_, k2); const unsigned char* rp_ = TAB + (size_t)e_ * 1024; \
          asm volatile("global_load_dwordx4 %0, %1, %2 ; " TAG : "+v"(R[k2]) : "v"(voff), "s"(rp_)); } } \
        Dn = __builtin_amdgcn_readfirstlane((int)tmpL); PKn = EL[EIDX(Dn)]; tmpL = LIST[sidx]; ++sidx; } while (0)
#define G_WAITK(R, k2) asm volatile("s_waitcnt vmcnt(%1)" : "+v"(R[k2]) : "n"(15 - (k2)))
#define G_DRAIN(RA_, RB_) do { asm volatile("s_waitcnt vmcnt(0)" : "+v"(RA_[0]), "+v"(RA_[1]), "+v"(RA_[2]), "+v"(RA_[3]), "+v"(RA_[4]), "+v"(RA_[5]), "+v"(RA_[6]), "+v"(RA_[7])); \
        asm volatile("" : "+v"(RB_[0]), "+v"(RB_[1]), "+v"(RB_[2]), "+v"(RB_[3]), "+v"(RB_[4]), "+v"(RB_[5]), "+v"(RB_[6]), "+v"(RB_[7])); } while (0)
#define U_COMPUTE(D, PK, R) do { if ((D) != 0) { const int n_ = (D) & 15, rr_ = (D) >> 11; \
        const unsigned se_ = (unsigned)SE[EIDX(D)]; \
        if (rr_ != cur) { cur = rr_; const uint4 hA = *(const uint4*)(H2W + rr_ * 2048 + lane * 32), hB = *(const uint4*)(H2W + rr_ * 2048 + lane * 32 + 16); \
          hf2[0] = BF2(hA.x); hf2[1] = BF2(hA.y); hf2[2] = BF2(hA.z); hf2[3] = BF2(hA.w); hf2[4] = BF2(hB.x); hf2[5] = BF2(hB.y); hf2[6] = BF2(hB.z); hf2[7] = BF2(hB.w); } \
        float P[8]; \
        _Pragma("unroll") for (int k2 = 0; k2 < 8; ++k2) { P[k2] = 0.f; \
          if (k2 < n_) { G_WAITK(R, k2); f2v d2 = CVLO(R[k2][0]) * hf2[0]; d2 += CVHI(R[k2][0]) * hf2[1]; d2 += CVLO(R[k2][1]) * hf2[2]; d2 += CVHI(R[k2][1]) * hf2[3]; \
            d2 += CVLO(R[k2][2]) * hf2[4]; d2 += CVHI(R[k2][2]) * hf2[5]; d2 += CVLO(R[k2][3]) * hf2[6]; d2 += CVHI(R[k2][3]) * hf2[7]; P[k2] = d2.x + d2.y; } } \
          \
        _Pragma("unroll") for (int e = 0; e < 4; ++e) { const float a_ = P[e] + DPPF(P[e], 0x141), b_ = P[e + 4] + DPPF(P[e + 4], 0x141); P[e] = (lane & 4) ? b_ : a_; } \
        _Pragma("unroll") for (int e = 0; e < 2; ++e) { const float a_ = P[e] + DPPF(P[e], 0x4E), b_ = P[e + 2] + DPPF(P[e + 2], 0x4E); P[e] = (lane & 2) ? b_ : a_; } \
        float av; { const float a_ = P[0] + DPPF(P[0], 0xB1), b_ = P[1] + DPPF(P[1], 0xB1); av = (lane & 1) ? b_ : a_; } \
        av += DPPF(av, 0x128); \
        { const auto s16 = __builtin_amdgcn_permlane16_swap(__float_as_uint(av), __float_as_uint(av), false, false); av = __uint_as_float(s16[0]) + __uint_as_float(s16[1]); } \
        { const auto s32 = __builtin_amdgcn_permlane32_swap(__float_as_uint(av), __float_as_uint(av), false, false); av = __uint_as_float(s32[0]) + __uint_as_float(s32[1]); } \
        av *= __uint_as_float((se_ >> 8) << 23); \
          \
        const float ax = fabsf(av), t = __builtin_amdgcn_rcpf(ax * 0.2316418882f + 1.0f); \
        float q = t * 0.5307027145f + (-0.7265760135f); q = q * t + 0.7107068705f; q = q * t + (-0.142248368f); q = q * t + 0.127414796f; q = q * t; \
        const float ee = __builtin_amdgcn_exp2f(av * av * (-0.72134752044f)); \
        const float mm = av * (q * ee), gl = (av < 0.f) ? mm : (av - mm); \
        const float wv = __uint_as_float(PK & 0xFFFFC000u) * gl * __uint_as_float((se_ & 255u) << 23); \
        if (lane < n_) EL[EIDX(D)] = ((__float_as_uint(wv) + 0x2000u) & 0xFFFFC000u) | (PK & 16383u); } } while (0)
#define Y_PARK() do { uint4 y0, y1; y0.x = pack2(acc[0].x, acc[0].y); y0.y = pack2(acc[1].x, acc[1].y); y0.z = pack2(acc[2].x, acc[2].y); y0.w = pack2(acc[3].x, acc[3].y); \
        y1.x = pack2(acc[4].x, acc[4].y); y1.y = pack2(acc[5].x, acc[5].y); y1.z = pack2(acc[6].x, acc[6].y); y1.w = pack2(acc[7].x, acc[7].y); \
        *(uint4*)(H2W + cur * 2048 + lane * 32) = y0; *(uint4*)(H2W + cur * 2048 + lane * 32 + 16) = y1; } while (0)
#define V_COMPUTE(D, PK, R) do { if ((D) != 0) { const int n_ = (D) & 15, rr_ = (D) >> 11; \
        if (rr_ != cur) { if (cur >= 0) Y_PARK(); cur = rr_; \
          const uint4 hA = *(const uint4*)(H2W + rr_ * 2048 + lane * 32), hB = *(const uint4*)(H2W + rr_ * 2048 + lane * 32 + 16); \
          acc[0] = BF2(hA.x); acc[1] = BF2(hA.y); acc[2] = BF2(hA.z); acc[3] = BF2(hA.w); acc[4] = BF2(hB.x); acc[5] = BF2(hB.y); acc[6] = BF2(hB.z); acc[7] = BF2(hB.w); } \
        const float wv_ = (sl < n_) ? __uint_as_float(PK & 0xFFFFC000u) : 0.f; \
        _Pragma("unroll") for (int k2 = 0; k2 < 8; ++k2) if (k2 < n_) { const float wk = __int_as_float(__builtin_amdgcn_readlane(__float_as_int(wv_), k2)); const f2v wk2 = {wk, wk}; \
          G_WAITK(R, k2); \
          acc[0] += CVLO(R[k2][0]) * wk2; acc[1] += CVHI(R[k2][0]) * wk2; acc[2] += CVLO(R[k2][1]) * wk2; acc[3] += CVHI(R[k2][1]) * wk2; \
          acc[4] += CVLO(R[k2][2]) * wk2; acc[5] += CVHI(R[k2][2]) * wk2; acc[6] += CVLO(R[k2][3]) * wk2; acc[7] += CVHI(R[k2][3]) * wk2; } } } while (0)
#define G_PROLOGUE() do { Dn = __builtin_amdgcn_readfirstlane((int)LIST[0]); PKn = EL[EIDX(Dn)]; tmpL = LIST[1]; sidx = 2; } while (0)
#pragma unroll 1
      for (int half = 0; half < 2; ++half) {
        const int row0 = half * 32 + w * 4;
        __builtin_amdgcn_wave_barrier(); asm volatile("" ::: "memory");
        { const uint4* src = (const uint4*)(H2 + (size_t)row0 * 1024); uint4 t[8];
#pragma unroll
          for (int i = 0; i < 8; ++i) t[i] = src[lane + 64 * i];
#pragma unroll
          for (int i = 0; i < 8; ++i) ((uint4*)H2W)[lane + 64 * i] = t[i]; }
        int ns;
        {
          const int rr = lane & 3, part = ((lane >> 2) + rot) & (GP_N - 1);
          int o0 = 0, o1 = 0;
          if (lane < 4 * GP_N) { o0 = (int)OFFS[(row0 + rr) * GP_OS + part]; o1 = (int)OFFS[(row0 + rr) * GP_OS + part + 1]; }
          const int nst = (o1 - o0 + 7) >> 3;
          int incl = nst;
#pragma unroll
          for (int d = 1; d < 64; d <<= 1) { const int t = __shfl_up(incl, d); if (lane >= d) incl += t; }
          const int off = incl - nst;
          for (int j = 0; j < nst; ++j) { const int base = o0 + 8 * j; const int nn = (o1 - base < 8) ? (o1 - base) : 8; LIST[off + j] = (unsigned)(nn | (base << 4) | (rr << 11)); }
          ns = __builtin_amdgcn_readlane(incl, 63);
          if (lane < 8) LIST[ns + lane] = 0u; }
        __builtin_amdgcn_wave_barrier(); asm volatile("s_waitcnt vmcnt(0)" ::: "memory");
        {
          int DA, DB, Dn, sidx, cur = -1; unsigned PKA, PKB, PKn, tmpL; u32x4_t RA[8], RB[8]; f2v hf2[8];
          R_INIT(RA, "uA"); R_INIT(RB, "uB");
          G_PROLOGUE(); G_FETCH(DA, PKA, RA, EU, "uA0");
#pragma unroll 1
          for (int s = 0; s < ns; s += 2) {
            G_FETCH(DB, PKB, RB, EU, "uB"); U_COMPUTE(DA, PKA, RA);
            G_FETCH(DA, PKA, RA, EU, "uA"); U_COMPUTE(DB, PKB, RB);
          }
          G_DRAIN(RA, RB);
        }
        __builtin_amdgcn_wave_barrier(); asm volatile("s_waitcnt vmcnt(0)" ::: "memory");
        { const uint4 z4 = make_uint4(0u, 0u, 0u, 0u);
#pragma unroll
          for (int i = 0; i < 8; ++i) ((uint4*)H2W)[lane + 64 * i] = z4; }
        __builtin_amdgcn_wave_barrier(); asm volatile("" ::: "memory");
        {
          int DA, DB, Dn, sidx, cur = -1; unsigned PKA, PKB, PKn, tmpL; u32x4_t RA[8], RB[8]; f2v acc[8];
          R_INIT(RA, "vA"); R_INIT(RB, "vB");
          G_PROLOGUE(); G_FETCH(DA, PKA, RA, EV, "vA0");
#pragma unroll 1
          for (int s = 0; s < ns; s += 2) {
            G_FETCH(DB, PKB, RB, EV, "vB"); V_COMPUTE(DA, PKA, RA);
            G_FETCH(DA, PKA, RA, EV, "vA"); V_COMPUTE(DB, PKB, RB);
          }
          G_DRAIN(RA, RB);
          if (cur >= 0) Y_PARK();
        }
        __builtin_amdgcn_wave_barrier(); asm volatile("s_waitcnt vmcnt(0)" ::: "memory");
#pragma unroll 1
        for (int rr = 0; rr < 4; ++rr) { const size_t tok = tok0 + row0 + rr;
          const uint4 hA = *(const uint4*)(H2W + rr * 2048 + lane * 32), hB = *(const uint4*)(H2W + rr * 2048 + lane * 32 + 16);
          f2v a[8]; a[0] = BF2(hA.x); a[1] = BF2(hA.y); a[2] = BF2(hA.z); a[3] = BF2(hA.w); a[4] = BF2(hB.x); a[5] = BF2(hB.y); a[6] = BF2(hB.z); a[7] = BF2(hB.w);
          float ss = 0.f;
#pragma unroll
          for (int i = 0; i < 8; ++i) ss += a[i].x * a[i].x + a[i].y * a[i].y;
          ss = wave_sum(ss); const float rs = rsqrtf(ss * (1.f / 1024.f) + EPS);
          float* orow = outp + tok * 1024 + lane * 16;
#pragma unroll
          for (int i = 0; i < 4; ++i) { const int d = lane * 16 + 4 * i;
            float4 x1 = *(const float4*)(orow + 4 * i); const float4 g3 = *(const float4*)(gpf2 + d), g2 = *(const float4*)(modb + 5120 + d);
            x1.x += g3.x * g2.x * a[2 * i].x * rs; x1.y += g3.y * g2.y * a[2 * i].y * rs; x1.z += g3.z * g2.z * a[2 * i + 1].x * rs; x1.w += g3.w * g2.w * a[2 * i + 1].y * rs;
            *(float4*)(orow + 4 * i) = x1; }
        }
      }
#undef CVLO
#undef CVHI
#undef BF2
#undef DPPF
#undef R_INIT
#undef EIDX
#undef G_FETCH
#undef G_WAITK
#undef G_DRAIN
#undef U_COMPUTE
#undef Y_PARK
#undef V_COMPUTE
#undef G_PROLOGUE
    }
  }
}

DI void phase2_scan(const KP& p) {
  unsigned char* ws = p.ws;
  for (int g = blockIdx.x * NTHR + threadIdx.x; g < 131072; g += gridDim.x * NTHR) {
    const int seq = g >> 11, within = g & 2047, dv = within >> 4, dk4 = (within & 15) * 4, dir = seq & 1;
    bf16_t* base = (bf16_t*)(ws + WS_SPT) + ((size_t)seq * 32 * 128 + dv) * 64 + dk4;
    const float* dec = (const float*)(ws + WS_DEC) + (size_t)seq * 32 * 64 + dk4;
    float s0 = 0.f, s1 = 0.f, s2 = 0.f, s3 = 0.f;
#pragma unroll 1
    for (int i0 = 0; i0 < 32; i0 += 8) {
      uint2 d[8]; float4 c[8];
#pragma unroll
      for (int j = 0; j < 8; ++j) { const int n = dir ? 31 - (i0 + j) : (i0 + j); d[j] = *(const uint2*)(base + (size_t)n * 8192); c[j] = *(const float4*)(dec + n * 64); }
#pragma unroll
      for (int j = 0; j < 8; ++j) { const int n = dir ? 31 - (i0 + j) : (i0 + j);
        uint2 o; o.x = pack2(s0, s1); o.y = pack2(s2, s3); *(uint2*)(base + (size_t)n * 8192) = o;
        s0 = c[j].x * s0 + __uint_as_float(d[j].x << 16); s1 = c[j].y * s1 + __uint_as_float(d[j].x & 0xffff0000u);
        s2 = c[j].z * s2 + __uint_as_float(d[j].y << 16); s3 = c[j].w * s3 + __uint_as_float(d[j].y & 0xffff0000u); }
    }
  }
}

#define XB_TMO      128
#define XB_XCNT(j)  (256  + 64 * (j))
#define XB_XSUB(j)  (1280 + 64 * (j))
#define XB_XGEN(j)  (2304 + 64 * (j))
#define XB_TOP      3328
#define XB_TOPGEN   3392
#define XCD_BAR_WORDS 3456
#define XB_SPIN_CAP (1u << 18)
#define LAS __attribute__((address_space(3)))

__device__ __forceinline__ unsigned xb_ld(unsigned* p)              { return __hip_atomic_load(p, __ATOMIC_RELAXED, __HIP_MEMORY_SCOPE_AGENT); }
__device__ __forceinline__ unsigned xb_add(unsigned* p, unsigned v) { return __hip_atomic_fetch_add(p, v, __ATOMIC_RELAXED, __HIP_MEMORY_SCOPE_AGENT); }
__device__ __forceinline__ unsigned xb_xcc_id() { return (unsigned)__builtin_amdgcn_s_getreg((3 << 11) | 20) & 0xFu; }
#define XB_SPIN(cond, bar) do { unsigned _sp = 0; while (cond) { __builtin_amdgcn_s_sleep(1); \
    if ((++_sp & 255u) == 0u) { if (xb_ld(&(bar)[XB_TMO])) break; if (_sp > XB_SPIN_CAP) { atomicAdd(&(bar)[XB_TMO], 1u); break; } } } } while (0)

struct XcdBarrier {
    unsigned* bar; unsigned x;
    volatile LAS unsigned* st;
};

__device__ __forceinline__ XcdBarrier xcd_barrier_post(unsigned* bar, volatile LAS unsigned* st) {
    XcdBarrier b; b.bar = bar; b.x = xb_xcc_id(); b.st = st;
    if (threadIdx.x == 0) (void)xb_add(&bar[XB_XCNT(b.x)], 1u);
    return b;
}
__device__ __forceinline__ void xcd_barrier_complete(unsigned* bar, unsigned x, unsigned& nloc, unsigned& nx) {
    const unsigned G = gridDim.x * gridDim.y * gridDim.z;
    unsigned sum, cnt, mine, sp = 0u;
    for (;;) {
        sum = 0u; cnt = 0u; mine = 0u;
#pragma unroll
        for (unsigned j = 0; j < 16; ++j) { const unsigned c = xb_ld(&bar[XB_XCNT(j)]); sum += c; cnt += (c > 0u) ? 1u : 0u; mine = (j == x) ? c : mine; }
        if (sum == G) break;
        __builtin_amdgcn_s_sleep(1);
        if ((++sp & 255u) == 0u) { if (xb_ld(&bar[XB_TMO])) break; if (sp > XB_SPIN_CAP) { atomicAdd(&bar[XB_TMO], 1u); break; } }
    }
    nloc = mine > 0u ? mine : 1u; nx = cnt > 0u ? cnt : 1u;
}

__device__ __forceinline__ void xcd_barrier(const XcdBarrier& b) {
    asm volatile("s_waitcnt vmcnt(0)" ::: "memory");
    __syncthreads();
    if (threadIdx.x == 0) {
        unsigned* bar = b.bar;
        __builtin_amdgcn_s_waitcnt(0);
        unsigned nloc = b.st[0], nx = b.st[1];
        if (nloc == 0u) { xcd_barrier_complete(bar, b.x, nloc, nx); b.st[0] = nloc; b.st[1] = nx; }
        const unsigned old = xb_add(&bar[XB_XSUB(b.x)], 1u);
        const unsigned gen = old / nloc;
        if (old + 1u == (gen + 1u) * nloc) {
            __builtin_amdgcn_fence(__ATOMIC_RELEASE, "agent");
            asm volatile("s_waitcnt vmcnt(0)" ::: "memory");
            const unsigned og = xb_add(&bar[XB_TOP], 1u);
            const unsigned tg = og / nx;
            if (og + 1u == (tg + 1u) * nx) xb_add(&bar[XB_TOPGEN], 1u);
            else XB_SPIN(xb_ld(&bar[XB_TOPGEN]) == tg, bar);
            __builtin_amdgcn_fence(__ATOMIC_ACQUIRE, "agent");
            xb_add(&bar[XB_XGEN(b.x)], 1u);
            asm volatile("s_waitcnt vmcnt(0)" ::: "memory");
        } else {
            XB_SPIN(xb_ld(&bar[XB_XGEN(b.x)]) == gen, bar);
            __builtin_amdgcn_fence(__ATOMIC_ACQUIRE, "agent");
            asm volatile("s_waitcnt vmcnt(0)" ::: "memory");
        }
    }
    __syncthreads();
}

#ifndef PROBE_ID
#define PROBE_ID 0
#endif
__global__ void __launch_bounds__(NTHR, 2) mega(KP p) {
  extern __shared__ __attribute__((aligned(16))) char lds[];
  cg::grid_group grid = cg::this_grid();
  const int hi = p.ph_hi; constexpr int probe = PROBE_ID;
  if (threadIdx.x == 0) { ((volatile LAS unsigned*)(lds + LDS_XB))[0] = 0u; ((volatile LAS unsigned*)(lds + LDS_XB))[1] = 0u; }
  __syncthreads();
  const XcdBarrier xb = xcd_barrier_post((unsigned*)(p.ws + WS_BAR), (volatile LAS unsigned*)(lds + LDS_XB));
  if (p.ph_lo <= 0 && 0 < hi) { phase0(p, lds); if (probe == 1) phase0(p, lds); if (1 < hi) { if (hi > 64) grid.sync(); else xcd_barrier(xb); } }
  if (p.ph_lo <= 1 && 1 < hi) {
    phase1a(p, lds);
    xcd_barrier(xb);
    {
      pg8::Gemm g{(const pg8::bf16_t*)p.out, (const pg8::bf16_t*)(p.ws + WS_WTINP), NTOK, 2304, 1024};
      pg8::StaticOrder S; S.init(NTOK, 2304, (int)gridDim.x, (int)blockIdx.x);
      pg8::EpiProj E{(pg8::bf16_t*)(p.ws + WS_P1S), (pg8::bf16_t*)((unsigned char*)p.out + 32 * MiB), (pg8::bf16_t*)(p.ws + WS_PROJC)};
      pg8::gemm_phase<pg8::EpiProj, pg8::StaticOrder, true, true>((PG8_LAS unsigned char*)lds, g, S, E);
      if (blockIdx.x >= 64) convert_experts(p, (int)blockIdx.x - 64, (int)gridDim.x - 64);
    }
    xcd_barrier(xb);
    phase1c(p, lds);
    if (2 < hi) xcd_barrier(xb);
  }
  if (p.ph_lo <= 2 && 2 < hi) { phase2_scan(p); phase2_attn(p, lds); if (probe == 3) phase2_attn(p, lds); if (3 < hi) xcd_barrier(xb); }
  if (p.ph_lo <= 3 && 3 < hi) {
    phase3(p, lds, 1, probe);
    xcd_barrier(xb);
    {
      pg8::Gemm g{(const pg8::bf16_t*)(p.ws + WS_P1S), (const pg8::bf16_t*)(p.ws + WS_WTOUTP), NTOK, 1024, 1024};
      pg8::StaticOrder S; S.init(NTOK, 1024, (int)gridDim.x, (int)blockIdx.x);
      pg8::EpiBf16<0> E{(pg8::bf16_t*)(p.ws + WS_QM), 1024, nullptr, 0, 0, 1.f};
      pg8::gemm_phase<pg8::EpiBf16<0>, pg8::StaticOrder, true, true>((PG8_LAS unsigned char*)lds, g, S, E);
    }
    xcd_barrier(xb);
    phase3c(p, lds, 1, probe);
    xcd_barrier(xb);
    {
      pg8::Gemm g{(const pg8::bf16_t*)(p.ws + WS_P1S), (const pg8::bf16_t*)(p.ws + WS_WTPQP), NTOK, 2048, 1024};
      pg8::StaticOrder S; S.init(NTOK, 2048, (int)gridDim.x, (int)blockIdx.x);
      pg8::EpiBf16<0> E{(pg8::bf16_t*)(p.ws + WS_QM), 2048, nullptr, 0, 0, 1.f};
      pg8::gemm_phase<pg8::EpiBf16<0>, pg8::StaticOrder, true, true>((PG8_LAS unsigned char*)lds, g, S, E);
    }
    xcd_barrier(xb);
    phase3b(p, lds, (probe == 4 || probe == 8 || probe == 9 || probe == 10) ? 2 : 1, probe);
  }
}

extern "C" void kernel_launch(void* const* d_in, const int* in_sizes, int n_in, void* d_out, int out_size, void* d_ws, size_t ws_size, hipStream_t stream) {
  float* out = (float*)d_out;
  unsigned char* ws = (unsigned char*)d_ws;
  if (ws_size < WS_END || n_in != 25) return;
  static bool attr_done = false;
  if (!attr_done) { (void)hipFuncSetAttribute((const void*)mega, hipFuncAttributeMaxDynamicSharedMemorySize, LDS_TOTAL); attr_done = true; }
  KP p{};
  for (int i = 0; i < 25; ++i) p.in[i] = (const float*)d_in[i];
  p.out = out; p.ws = ws;
  p.ph_lo = 0; p.ph_hi = 4;
  (void)hipMemsetAsync(ws + WS_BAR, 0, XCD_BAR_WORDS * 4, stream);
  { void* args[] = {&p}; (void)hipLaunchCooperativeKernel((const void*)mega, dim3(256), dim3(NTHR), args, LDS_TOTAL, stream); }
}
```

```cpp
#include <hip/hip_runtime.h>
#include <hip/hip_cooperative_groups.h>
namespace cg = cooperative_groups;
#include <stdint.h>

typedef unsigned short bf16_t;
#define DI __device__ __forceinline__

DI float bf2f(bf16_t v) { return __uint_as_float(((unsigned)v) << 16); }
DI bf16_t f2bf(float f) { return __builtin_bit_cast(unsigned short, (__bf16)f); }

constexpr int BATCH = 8, SEQ = 2048, DM = 1024, NTOK = BATCH * SEQ;
constexpr int INW = 2272;
constexpr float EPS = 1e-6f;
constexpr int O_CQ = 0, O_CKV = 384, O_KR = 640, O_QG = 704, O_KG = 960, O_VG = 1216, O_GF = 1728, O_GB = 1744, O_R = 1760;

DI float wave_sum(float v) {
#pragma unroll
  for (int o = 1; o < 64; o <<= 1) v += __shfl_xor(v, o);
  return v;
}
DI float wave_max(float v) {
#pragma unroll
  for (int o = 1; o < 64; o <<= 1) v = fmaxf(v, __shfl_xor(v, o));
  return v;
}
DI float block_sum256(float v, float* red) {
  v = wave_sum(v);
  __syncthreads();
  if ((threadIdx.x & 63) == 0) red[threadIdx.x >> 6] = v;
  __syncthreads();
  return red[0] + red[1] + red[2] + red[3];
}
DI float block_max256(float v, float* red) {
  v = wave_max(v);
  __syncthreads();
  if ((threadIdx.x & 63) == 0) red[threadIdx.x >> 6] = v;
  __syncthreads();
  return fmaxf(fmaxf(red[0], red[1]), fmaxf(red[2], red[3]));
}
DI float silu_f(float x) { return x / (1.f + expf(-x)); }
DI float logsigmoid_f(float x) { return fminf(x, 0.f) - log1pf(expf(-fabsf(x))); }
DI float fexp(float x) { return __builtin_amdgcn_exp2f(x * 1.4426950408889634f); }
DI float silu_fast(float x) { return x * __builtin_amdgcn_rcpf(1.f + fexp(-x)); }
DI float logsigmoid_fast(float x) { return fminf(x, 0.f) - __builtin_amdgcn_logf(1.f + fexp(-fabsf(x))) * 0.6931471805599453f; }
DI float gelu_erf(float x) { return 0.5f * x * (1.f + erff(x * 0.70710678118654752f)); }

__global__ __launch_bounds__(256) void n_mod(const float* __restrict__ c, const float* __restrict__ w_ada, const float* __restrict__ b_ada, float* __restrict__ mod) {
  int idx = blockIdx.x * 256 + threadIdx.x;
  int b = idx / 6144, j = idx % 6144;
  float acc = b_ada[j];
  for (int k = 0; k < 1024; ++k) acc += silu_f(c[b * 1024 + k]) * w_ada[(size_t)k * 6144 + j];
  mod[idx] = acc;
}

__global__ __launch_bounds__(256) void n_hnorm(const float* __restrict__ x, const float* __restrict__ g, const float* __restrict__ mod, int b, int off_sh, int off_sc, float* __restrict__ h) {
  __shared__ float red[4];
  int t = blockIdx.x, tid = threadIdx.x;
  const float* xr = x + ((size_t)b * SEQ + t) * DM;
  float v[4]; float ss = 0.f;
#pragma unroll
  for (int i = 0; i < 4; ++i) { v[i] = xr[tid + 256 * i]; ss += v[i] * v[i]; }
  ss = block_sum256(ss, red);
  float rs = rsqrtf(ss * (1.f / DM) + EPS);
#pragma unroll
  for (int i = 0; i < 4; ++i) { int d = tid + 256 * i; h[(size_t)t * DM + d] = v[i] * rs * g[d] * (1.f + mod[b * 6144 + off_sc + d]) + mod[b * 6144 + off_sh + d]; }
}

template <bool BT>
__global__ __launch_bounds__(256) void n_gemm(const float* __restrict__ A, int lda, const float* __restrict__ B, int ldb, float* __restrict__ C, int ldc, int M, int N, int K) {
  __shared__ float As[16][65];
  __shared__ float Bs[16][65];
  const int tid = threadIdx.x, tx = tid & 15, ty = tid >> 4;
  const int m0 = blockIdx.y * 64, n0 = blockIdx.x * 64;
  float acc[4][4];
#pragma unroll
  for (int i = 0; i < 4; ++i)
#pragma unroll
    for (int j = 0; j < 4; ++j) acc[i][j] = 0.f;
  for (int k0 = 0; k0 < K; k0 += 16) {
#pragma unroll
    for (int i = 0; i < 4; ++i) { int e = tid + 256 * i; int m = e >> 4, k = e & 15; As[k][m] = A[(size_t)(m0 + m) * lda + k0 + k]; }
#pragma unroll
    for (int i = 0; i < 4; ++i) { int e = tid + 256 * i;
      if (!BT) { int k = e >> 6, n = e & 63; Bs[k][n] = (n0 + n < N) ? B[(size_t)(k0 + k) * ldb + n0 + n] : 0.f; }
      else     { int n = e >> 4, k = e & 15; Bs[k][n] = (n0 + n < N) ? B[(size_t)(n0 + n) * ldb + k0 + k] : 0.f; } }
    __syncthreads();
#pragma unroll
    for (int k = 0; k < 16; ++k) {
      float a[4], bb[4];
#pragma unroll
      for (int i = 0; i < 4; ++i) { a[i] = As[k][ty * 4 + i]; bb[i] = Bs[k][tx * 4 + i]; }
#pragma unroll
      for (int i = 0; i < 4; ++i)
#pragma unroll
        for (int j = 0; j < 4; ++j) acc[i][j] += a[i] * bb[j];
    }
    __syncthreads();
  }
#pragma unroll
  for (int i = 0; i < 4; ++i)
#pragma unroll
    for (int j = 0; j < 4; ++j) { int n = n0 + tx * 4 + j; if (n < N) C[(size_t)(m0 + ty * 4 + i) * ldc + n] = acc[i][j]; }
}

__global__ __launch_bounds__(256) void n_rms_slice(const float* __restrict__ in, int ldin, int off, int W, const float* __restrict__ g, float* __restrict__ out) {
  __shared__ float red[4];
  int t = blockIdx.x, tid = threadIdx.x;
  float v0 = (tid < W) ? in[(size_t)t * ldin + off + tid] : 0.f;
  float v1 = (tid + 256 < W) ? in[(size_t)t * ldin + off + tid + 256] : 0.f;
  float ss = block_sum256(v0 * v0 + v1 * v1, red);
  float rs = rsqrtf(ss / (float)W + EPS);
  if (tid < W) out[(size_t)t * W + tid] = v0 * rs * g[tid];
  if (tid + 256 < W) out[(size_t)t * W + tid + 256] = v1 * rs * g[tid + 256];
}

__global__ __launch_bounds__(256) void n_scatter(const float* __restrict__ proj, const float* __restrict__ qa, const float* __restrict__ kv, const int* __restrict__ positions, int b,
                                                 const float* __restrict__ wgf, const float* __restrict__ bgf, const float* __restrict__ wgb, const float* __restrict__ bgb,
                                                 bf16_t* __restrict__ Qm, bf16_t* __restrict__ Km, bf16_t* __restrict__ Vm, bf16_t* __restrict__ qg, bf16_t* __restrict__ kg, bf16_t* __restrict__ vg,
                                                 bf16_t* __restrict__ rg, float* __restrict__ laf, float* __restrict__ lab) {
  __shared__ float cs[32], sn[32];
  const int t = blockIdx.x, tid = threadIdx.x;
  const size_t tok = (size_t)b * SEQ + t;
  const float* pr = proj + (size_t)t * INW;
  const float* qr = qa + (size_t)t * 768;
  const float* kr = kv + (size_t)t * 1024;
  if (tid < 32) {
    float inv = powf(10000.f, -(float)tid / 32.f);
    float ang = (float)positions[tok] * inv;
    cs[tid] = cosf(ang); sn[tid] = sinf(ang);
  }
  __syncthreads();
  for (int e = tid; e < 4 * 192; e += 256) {
    int h = e / 192, d = e % 192; float v;
    if (d < 128) v = qr[h * 192 + d];
    else { int j = d - 128; const float* rp = qr + h * 192 + 128;
      if (j < 32) v = rp[j] * cs[j] - rp[j + 32] * sn[j]; else v = rp[j] * cs[j - 32] + rp[j - 32] * sn[j - 32]; }
    Qm[(((size_t)b * 4 + h) * SEQ + t) * 192 + d] = f2bf(v);
  }
  for (int e = tid; e < 4 * 192; e += 256) {
    int h = e / 192, d = e % 192; float v;
    if (d < 128) v = kr[h * 256 + d];
    else { int j = d - 128; const float* rp = pr + O_KR;
      if (j < 32) v = rp[j] * cs[j] - rp[j + 32] * sn[j]; else v = rp[j] * cs[j - 32] + rp[j - 32] * sn[j - 32]; }
    Km[(((size_t)b * 4 + h) * SEQ + t) * 192 + d] = f2bf(v);
  }
  for (int e = tid; e < 512; e += 256) { int h = e >> 7, d = e & 127; Vm[(((size_t)b * 4 + h) * SEQ + t) * 128 + d] = f2bf(kr[h * 256 + 128 + d]); }
  { int e = tid; qg[tok * 256 + e] = f2bf(pr[O_QG + e] * 0.125f); kg[tok * 256 + e] = f2bf(pr[O_KG + e]); }
  for (int e = tid; e < 512; e += 256) { vg[tok * 512 + e] = f2bf(pr[O_VG + e]); rg[tok * 512 + e] = f2bf(pr[O_R + e]); }
  { int cidx = tid; float af = bgf[cidx], ab = bgb[cidx];
#pragma unroll
    for (int r = 0; r < 16; ++r) { af += pr[O_GF + r] * wgf[r * 256 + cidx]; ab += pr[O_GB + r] * wgb[r * 256 + cidx]; }
    laf[tok * 256 + cidx] = logsigmoid_f(af) * (1.f / 16.f); lab[tok * 256 + cidx] = logsigmoid_f(ab) * (1.f / 16.f); }
}

__global__ __launch_bounds__(256) void n_attn(const bf16_t* __restrict__ Qm, const bf16_t* __restrict__ Km, const bf16_t* __restrict__ Vm, bf16_t* __restrict__ omla) {
  __shared__ float qs[192]; __shared__ float sc[2048]; __shared__ float red[4];
  const int i = blockIdx.x, h = blockIdx.y, b = blockIdx.z, tid = threadIdx.x;
  const size_t bh = (size_t)b * 4 + h;
  if (tid < 192) qs[tid] = bf2f(Qm[(bh * SEQ + i) * 192 + tid]);
  __syncthreads();
  float mx = -1e30f;
  for (int kk = 0; kk < 8; ++kk) {
    int key = tid + 256 * kk; const uint4* kr = (const uint4*)(Km + (bh * SEQ + key) * 192);
    float s = 0.f;
    for (int c = 0; c < 24; ++c) { uint4 w = kr[c]; const float* q = qs + c * 8;
      s += q[0] * __uint_as_float(w.x << 16) + q[1] * __uint_as_float(w.x & 0xffff0000u) + q[2] * __uint_as_float(w.y << 16) + q[3] * __uint_as_float(w.y & 0xffff0000u)
         + q[4] * __uint_as_float(w.z << 16) + q[5] * __uint_as_float(w.z & 0xffff0000u) + q[6] * __uint_as_float(w.w << 16) + q[7] * __uint_as_float(w.w & 0xffff0000u); }
    s *= 0.07216878364870322f; sc[key] = s; mx = fmaxf(mx, s);
  }
  mx = block_max256(mx, red);
  float sum = 0.f;
  for (int kk = 0; kk < 8; ++kk) { int key = tid + 256 * kk; float p = expf(sc[key] - mx); sc[key] = p; sum += p; }
  sum = block_sum256(sum, red);
  __syncthreads();
  if (tid < 128) { float o = 0.f; const bf16_t* vp = Vm + bh * SEQ * 128 + tid;
    for (int key = 0; key < SEQ; ++key) o += sc[key] * bf2f(vp[(size_t)key * 128]);
    omla[((size_t)b * SEQ + i) * 512 + h * 128 + tid] = f2bf(o / sum); }
}

__global__ __launch_bounds__(128) void n_gla(const bf16_t* __restrict__ qg, const bf16_t* __restrict__ kg, const bf16_t* __restrict__ vg, const bf16_t* __restrict__ laf, const bf16_t* __restrict__ lab, float* __restrict__ og) {
  __shared__ float qs[64], ks[64], as[64];
  const int bh = blockIdx.x, b = bh >> 2, h = bh & 3, dv = threadIdx.x;
  for (int dir = 0; dir < 2; ++dir) {
    float S[64];
#pragma unroll
    for (int d = 0; d < 64; ++d) S[d] = 0.f;
    const bf16_t* la = dir ? lab : laf;
    for (int s = 0; s < SEQ; ++s) {
      const int t = dir ? (SEQ - 1 - s) : s; const size_t tok = (size_t)b * SEQ + t;
      __syncthreads();
      if (dv < 64) { qs[dv] = bf2f(qg[tok * 256 + h * 64 + dv]); ks[dv] = bf2f(kg[tok * 256 + h * 64 + dv]); as[dv] = expf(bf2f(la[tok * 256 + h * 64 + dv])); }
      __syncthreads();
      const float v = bf2f(vg[tok * 512 + h * 128 + dv]); float o = 0.f;
#pragma unroll
      for (int d = 0; d < 64; ++d) { S[d] = as[d] * S[d] + ks[d] * v; o += qs[d] * S[d]; }
      if (dir == 0) og[tok * 512 + h * 128 + dv] = o; else og[tok * 512 + h * 128 + dv] += o;
    }
  }
}

__global__ __launch_bounds__(256) void n_mix(const bf16_t* __restrict__ omla, const float* __restrict__ og, const bf16_t* __restrict__ rg, const float* __restrict__ g_gla, int b, float* __restrict__ mix) {
  __shared__ float ssum[4];
  const int t = blockIdx.x, tid = threadIdx.x; const size_t tok = (size_t)b * SEQ + t;
  if (tid < 4) ssum[tid] = 0.f;
  __syncthreads();
  float v[2];
#pragma unroll
  for (int i = 0; i < 2; ++i) { int e = tid + 256 * i; v[i] = og[tok * 512 + e]; atomicAdd(&ssum[e >> 7], v[i] * v[i]); mix[(size_t)t * DM + e] = bf2f(omla[tok * 512 + e]); }
  __syncthreads();
#pragma unroll
  for (int i = 0; i < 2; ++i) { int e = tid + 256 * i; float rs = rsqrtf(ssum[e >> 7] * (1.f / 128.f) + EPS);
    mix[(size_t)t * DM + 512 + e] = v[i] * rs * g_gla[e & 127] * silu_f(bf2f(rg[tok * 512 + e])); }
}

__global__ __launch_bounds__(256) void n_post1(const float* __restrict__ x, const float* __restrict__ y, const float* __restrict__ g_post, const float* __restrict__ g_pre2, const float* __restrict__ mod, int b,
                                               float* __restrict__ out, float* __restrict__ h2) {
  __shared__ float red[4];
  const int t = blockIdx.x, tid = threadIdx.x; const size_t tok = (size_t)b * SEQ + t;
  float yv[4], xv[4]; float ss = 0.f;
#pragma unroll
  for (int i = 0; i < 4; ++i) { yv[i] = y[(size_t)t * DM + tid + 256 * i]; ss += yv[i] * yv[i]; }
  ss = block_sum256(ss, red);
  float rs = rsqrtf(ss * (1.f / DM) + EPS); float s2 = 0.f;
#pragma unroll
  for (int i = 0; i < 4; ++i) { int d = tid + 256 * i; xv[i] = x[tok * DM + d] + mod[b * 6144 + 2048 + d] * (yv[i] * rs * g_post[d]); out[tok * DM + d] = xv[i]; s2 += xv[i] * xv[i]; }
  s2 = block_sum256(s2, red);
  float r2 = rsqrtf(s2 * (1.f / DM) + EPS);
#pragma unroll
  for (int i = 0; i < 4; ++i) { int d = tid + 256 * i; h2[(size_t)t * DM + d] = xv[i] * r2 * g_pre2[d] * (1.f + mod[b * 6144 + 4096 + d]) + mod[b * 6144 + 3072 + d]; }
}

DI void wave_argmax(float& v, int& i) {
#pragma unroll
  for (int o = 1; o < 64; o <<= 1) { float ov = __shfl_xor(v, o); int oi = __shfl_xor(i, o); if (ov > v || (ov == v && oi < i)) { v = ov; i = oi; } }
}
__global__ __launch_bounds__(256) void n_peer_select(const float* __restrict__ qry, const float* __restrict__ sk1, const float* __restrict__ sk2, int* __restrict__ eidx, float* __restrict__ gate) {
  __shared__ float v1s[4][16], v2s[4][16]; __shared__ int i1s[4][16], i2s[4][16];
  const int w = threadIdx.x >> 6, lane = threadIdx.x & 63;
  const int pair = blockIdx.x * 4 + w;
  const int t = pair >> 3, h = pair & 7;
  const float* q1 = qry + (size_t)t * 2048 + h * 256; const float* q2 = q1 + 128;
  float s1a = 0.f, s1b = 0.f, s2a = 0.f, s2b = 0.f;
  for (int d = 0; d < 128; ++d) { float a = q1[d], bq = q2[d];
    s1a += a * sk1[lane * 128 + d]; s1b += a * sk1[(lane + 64) * 128 + d]; s2a += bq * sk2[lane * 128 + d]; s2b += bq * sk2[(lane + 64) * 128 + d]; }
  for (int side = 0; side < 2; ++side) {
    float va = side ? s2a : s1a, vb = side ? s2b : s1b; bool ta = false, tb = false;
    for (int k = 0; k < 16; ++k) {
      float bv; int bi;
      if (!ta && (tb || va >= vb)) { bv = va; bi = lane; } else if (!tb) { bv = vb; bi = lane + 64; } else { bv = -3e38f; bi = 1 << 20; }
      wave_argmax(bv, bi);
      if (bi == lane) ta = true; if (bi == lane + 64) tb = true;
      if (lane == 0) { if (side) { v2s[w][k] = bv; i2s[w][k] = bi; } else { v1s[w][k] = bv; i1s[w][k] = bi; } }
    }
  }
  __syncthreads();
  float cv[4]; bool tk[4];
#pragma unroll
  for (int j = 0; j < 4; ++j) { int c = lane + 64 * j; cv[j] = v1s[w][c >> 4] + v2s[w][c & 15]; tk[j] = false; }
  float topv = 0.f; int topc = 0; float mx = 0.f;
  for (int k = 0; k < 16; ++k) {
    float bv = -3e38f; int bi = 1 << 20;
#pragma unroll
    for (int j = 0; j < 4; ++j) { if (!tk[j] && cv[j] > bv) { bv = cv[j]; bi = lane + 64 * j; } }
    wave_argmax(bv, bi);
#pragma unroll
    for (int j = 0; j < 4; ++j) if (bi == lane + 64 * j) tk[j] = true;
    if (k == 0) mx = bv;
    if (lane == k) { topv = bv; topc = bi; }
  }
  float e = (lane < 16) ? expf(topv - mx) : 0.f;
  float sum = wave_sum(e);
  if (lane < 16) { eidx[(size_t)pair * 16 + lane] = i1s[w][topc >> 4] * 128 + i2s[w][topc & 15]; gate[(size_t)pair * 16 + lane] = e / sum; }
}

__global__ __launch_bounds__(256) void n_peer_apply(const float* __restrict__ h2, const int* __restrict__ eidx, const float* __restrict__ gate, const float* __restrict__ eu, const float* __restrict__ ev,
                                                    const float* __restrict__ g_post, const float* __restrict__ mod, int b, float* __restrict__ out) {
  __shared__ float ys[4][1024]; __shared__ float red[4];
  const int t = blockIdx.x, tid = threadIdx.x, w = tid >> 6, lane = tid & 63; const size_t tok = (size_t)b * SEQ + t;
  float4 hx[4];
#pragma unroll
  for (int i = 0; i < 4; ++i) hx[i] = *(const float4*)(h2 + (size_t)t * DM + (lane + 64 * i) * 4);
  float4 acc[4];
#pragma unroll
  for (int i = 0; i < 4; ++i) acc[i] = make_float4(0.f, 0.f, 0.f, 0.f);
  for (int k = w; k < 128; k += 4) {
    const int e = eidx[(size_t)t * 128 + k]; const float gt = gate[(size_t)t * 128 + k];
    const float4* ur = (const float4*)(eu + (size_t)e * DM); const float4* vr = (const float4*)(ev + (size_t)e * DM);
    float d = 0.f;
#pragma unroll
    for (int i = 0; i < 4; ++i) { float4 u = ur[lane + 64 * i]; d += u.x * hx[i].x + u.y * hx[i].y + u.z * hx[i].z + u.w * hx[i].w; }
    d = wave_sum(d);
    const float wgt = gt * gelu_erf(d);
#pragma unroll
    for (int i = 0; i < 4; ++i) { float4 v = vr[lane + 64 * i]; acc[i].x += wgt * v.x; acc[i].y += wgt * v.y; acc[i].z += wgt * v.z; acc[i].w += wgt * v.w; }
  }
#pragma unroll
  for (int i = 0; i < 4; ++i) *(float4*)(&ys[w][(lane + 64 * i) * 4]) = acc[i];
  __syncthreads();
  float yv[4]; float ss = 0.f;
#pragma unroll
  for (int i = 0; i < 4; ++i) { int d = tid + 256 * i; yv[i] = ys[0][d] + ys[1][d] + ys[2][d] + ys[3][d]; ss += yv[i] * yv[i]; }
  ss = block_sum256(ss, red);
  const float rs = rsqrtf(ss * (1.f / DM) + EPS);
#pragma unroll
  for (int i = 0; i < 4; ++i) { int d = tid + 256 * i; out[tok * DM + d] = out[tok * DM + d] + mod[b * 6144 + 5120 + d] * (yv[i] * rs * g_post[d]); }
}

typedef short bf16x8 __attribute__((ext_vector_type(8)));
typedef float f32x16 __attribute__((ext_vector_type(16)));
#define MFMA32(a, b, c) __builtin_amdgcn_mfma_f32_32x32x16_bf16((a), (b), (c), 0, 0, 0)

constexpr int NTHR = 512;
constexpr size_t MiB = 1024 * 1024;
constexpr size_t WS_MOD   = 0;
constexpr size_t WS_WTIN  = 256 * 1024;
constexpr size_t WS_WTQUP = WS_WTIN + (size_t)2304 * 1024 * 2;
constexpr size_t WS_WTKVUP = WS_WTQUP + (size_t)768 * 384 * 2;
constexpr size_t WS_WTOUT = WS_WTKVUP + (size_t)1024 * 256 * 2;
constexpr size_t WS_WTPQ  = WS_WTOUT + (size_t)1024 * 1024 * 2;
constexpr size_t WS_KD    = WS_WTPQ + (size_t)2048 * 1024 * 2;
constexpr size_t WS_DEC   = WS_KD + (size_t)256 * 256 * 2;
constexpr size_t WS_ESC   = WS_DEC + (size_t)2048 * 64 * 4;
constexpr size_t WS_R0END = WS_ESC + (size_t)2 * 16384 * 4;
static_assert(WS_R0END <= 13 * MiB, "R0");
constexpr size_t WS_BAR  = 13 * MiB - 65536;
static_assert(WS_R0END + 131072 <= WS_BAR, "R0 room");
constexpr size_t WS_QM   = 13 * MiB;
constexpr size_t WS_KM   = WS_QM + 24 * MiB;
constexpr size_t WS_VM   = WS_KM + 24 * MiB;
constexpr size_t WS_P1S  = WS_VM + 16 * MiB;
constexpr size_t WS_RG   = WS_P1S + 32 * MiB;
constexpr size_t WS_OINTRA = WS_RG + 16 * MiB;
constexpr size_t WS_QDEC = WS_OINTRA + 16 * MiB;
constexpr size_t WS_SPT  = WS_QDEC + 16 * MiB;
constexpr size_t WS_EU   = WS_SPT + 32 * MiB;
constexpr size_t WS_EV   = WS_EU + 16 * MiB;
constexpr size_t WS_WTPQP = WS_EV + 16 * MiB;
constexpr size_t WS_WTOUTP = WS_WTPQP + 4 * MiB;
constexpr size_t WS_WTINP = WS_WTOUTP + 2 * MiB;
constexpr size_t WS_PROJC = WS_WTINP + 4608 * 1024;
constexpr size_t WS_END  = WS_PROJC + 8 * MiB;
static_assert(WS_P1S == WS_QM + 64 * MiB, "P3 QRY scratch aliases QM..VM");
constexpr size_t OUT_HS  = 0;
constexpr size_t OUT_CQ  = 32 * MiB;
constexpr size_t OUT_GR  = 52 * MiB;

struct KP { const float* in[25]; float* out; unsigned char* ws; int ph_lo, ph_hi; };

constexpr int G_STG = 40960;
constexpr int LDS_WT = 3 * G_STG;
constexpr int LDS_TAB = LDS_WT + 18432;
constexpr int LDS_XB = 157696;
constexpr int LDS_TOTAL = 157696 + 16;

typedef float f32x2_t __attribute__((ext_vector_type(2)));
typedef __bf16 bf16x2_t __attribute__((ext_vector_type(2)));
DI unsigned pack2(float lo, float hi) { const f32x2_t v = {lo, hi}; return __builtin_bit_cast(unsigned, __builtin_convertvector(v, bf16x2_t)); }
DI int crow(int reg, int hh) { return (reg & 3) + 8 * (reg >> 2) + 4 * hh; }

#define GLDS16(gp, lp) __builtin_amdgcn_global_load_lds((const unsigned*)(gp), (__attribute__((address_space(3))) unsigned*)(lp), 16, 0, 0)
template <int NST, class Epi>
DI void block_gemm(char* lds, const bf16_t* A, int lda, const bf16_t* Bt, int nchunks, int K, Epi&& epi) {
  const int tid = threadIdx.x, lane = tid & 63, w = __builtin_amdgcn_readfirstlane(tid >> 6), r = lane & 31, hh = lane >> 5;
  const int nk = K >> 6, T = nchunks * nk;
  constexpr int D = NST - 1;
  if (w >= 4) {
    const int j = w - 4, rin = lane >> 3, sw = ((lane & 7) ^ rin) * 8;
    const bf16_t* Ap = A + (size_t)(16 * j + rin) * lda + sw;
    const bf16_t* Bp = Bt + (size_t)(64 * j + rin) * 64 + sw;
    auto dma = [&](int g) {
      const int ch = g / nk, t = g - ch * nk; char* st = lds + (g % NST) * G_STG;
      const bf16_t* a0 = Ap + t * 64; char* la = st + (2 * j) * 1024;
      GLDS16(a0, la); GLDS16(a0 + (size_t)8 * lda, la + 1024);
      const bf16_t* b0 = Bp + (size_t)g * 16384; char* lb = st + 8192 + (8 * j) * 1024;
#pragma unroll
      for (int i = 0; i < 8; ++i) GLDS16(b0 + i * 512, lb + i * 1024);
    };
#pragma unroll
    for (int g = 0; g < D; ++g) if (g < T) dma(g);
    if (D >= 2 && T >= 2) asm volatile("s_waitcnt vmcnt(10)" ::: "memory"); else asm volatile("s_waitcnt vmcnt(0)" ::: "memory");
    __builtin_amdgcn_s_barrier();
#pragma unroll 1
    for (int g = 0; g < T; ++g) {
      if (g + D < T) { dma(g + D); if (D >= 2) asm volatile("s_waitcnt vmcnt(10)" ::: "memory"); else asm volatile("s_waitcnt vmcnt(0)" ::: "memory"); }
      else asm volatile("s_waitcnt vmcnt(0)" ::: "memory");
      __builtin_amdgcn_s_barrier();
    }
  } else {
    const int x = r & 7;
    const int o0 = ((0 + hh) ^ x) * 16, o1 = ((2 + hh) ^ x) * 16, o2 = ((4 + hh) ^ x) * 16, o3 = ((6 + hh) ^ x) * 16;
    const int a_rd = r * 128, b_rd = 8192 + (w * 64 + r) * 128;
    __builtin_amdgcn_s_barrier();
    int g = 0;
#pragma unroll 1
    for (int ch = 0; ch < nchunks; ++ch) {
      f32x16 c00, c01, c10, c11;
#pragma unroll
      for (int i = 0; i < 16; ++i) { c00[i] = 0.f; c01[i] = 0.f; c10[i] = 0.f; c11[i] = 0.f; }
#pragma unroll 1
      for (int t = 0; t < nk; ++t, ++g) {
        const char* cur = lds + (g % NST) * G_STG;
        bf16x8 fa0[4], fa1[4], fb0[4], fb1[4];
#define FRD(s_, o_) do { fa0[s_] = *(const bf16x8*)(cur + a_rd + o_); fb0[s_] = *(const bf16x8*)(cur + b_rd + o_); fb1[s_] = *(const bf16x8*)(cur + b_rd + 4096 + o_); fa1[s_] = *(const bf16x8*)(cur + a_rd + 4096 + o_); } while (0)
        FRD(0, o0); FRD(1, o1); FRD(2, o2); FRD(3, o3);
#undef FRD
        asm volatile("s_waitcnt lgkmcnt(0)" ::: "memory");
        __builtin_amdgcn_s_barrier();
        __builtin_amdgcn_sched_barrier(0);
#pragma unroll
        for (int s = 0; s < 4; ++s) {
          c00 = MFMA32(fa0[s], fb0[s], c00); c01 = MFMA32(fa0[s], fb1[s], c01); c10 = MFMA32(fa1[s], fb0[s], c10); c11 = MFMA32(fa1[s], fb1[s], c11); }
      }
      epi(0, ch * 256 + w * 64, c00, c01);
      epi(32, ch * 256 + w * 64, c10, c11);
    }
  }
}

DI void p0_transpose(char* lds, const float* __restrict__ W, int K, int N, bf16_t* __restrict__ Wt, int item, bf16_t* __restrict__ Wplain = nullptr) {
  float* s = (float*)lds;
  const int tid = threadIdx.x;
  const int ntn = (N + 63) >> 6, kt = item / ntn, nt = item % ntn, k0 = kt * 64, n0 = nt * 64;
  __syncthreads();
#pragma unroll
  for (int i = 0; i < 8; ++i) { int e = tid + 512 * i; int kk = e >> 6, nn = e & 63; s[kk * 65 + nn] = (n0 + nn < N) ? W[(size_t)(k0 + kk) * N + n0 + nn] : 0.f; }
  __syncthreads();
  const int nn = tid >> 3, part = tid & 7;
  const float* sp = s + (part * 8) * 65 + nn;
  uint4 o; o.x = pack2(sp[0], sp[65]); o.y = pack2(sp[2 * 65], sp[3 * 65]); o.z = pack2(sp[4 * 65], sp[5 * 65]); o.w = pack2(sp[6 * 65], sp[7 * 65]);
  { const int n = n0 + nn; *(uint4*)(Wt + ((size_t)((n >> 8) * (K >> 6) + kt)) * 16384 + (n & 255) * 64 + part * 8) = o; }
  if (Wplain) *(uint4*)(Wplain + (size_t)(n0 + nn) * K + k0 + part * 8) = o;
}

DI void convert_experts(const KP& p, const int bid, const int nb) {
  const int tid = threadIdx.x; unsigned char* ws = p.ws;
  { const int lane = tid & 63; float* scl = (float*)(ws + WS_ESC);
    for (int row = bid * 8 + (tid >> 6); row < 32768; row += nb * 8) { const int t = row >> 14, e = row & 16383;
      const float* src = p.in[23 + t] + (size_t)e * 1024 + lane * 16;
      float4 x[4]; float am = 0.f;
#pragma unroll
      for (int i = 0; i < 4; ++i) { x[i] = *(const float4*)(src + 4 * i); am = fmaxf(am, fmaxf(fmaxf(fabsf(x[i].x), fabsf(x[i].y)), fmaxf(fabsf(x[i].z), fabsf(x[i].w)))); }
      am = wave_max(am);
      float sc = 1.f, isc = 1.f;
      if (am > 0.f) { int ex; (void)frexpf(448.f / am, &ex); sc = ldexpf(1.f, ex - 1); isc = ldexpf(1.f, 1 - ex); }
      unsigned wv[4];
#pragma unroll
      for (int i = 0; i < 4; ++i) { int q = __builtin_amdgcn_cvt_pk_fp8_f32(x[i].x * sc, x[i].y * sc, 0, false); q = __builtin_amdgcn_cvt_pk_fp8_f32(x[i].z * sc, x[i].w * sc, q, true); wv[i] = (unsigned)q; }
      *(uint4*)(ws + (t ? WS_EV : WS_EU) + (size_t)e * 1024 + lane * 16) = make_uint4(wv[0], wv[1], wv[2], wv[3]);
      if (lane == 0) scl[t * 16384 + e] = isc; } }
}

DI void phase0(const KP& p, char* lds) {
  const int tid = threadIdx.x, bid = blockIdx.x, nb = gridDim.x;
  unsigned char* ws = p.ws;
  constexpr int I_IN = 16 * 36, I_QUP = 6 * 12, I_KVUP = 4 * 16, I_OUT = 16 * 16, I_PQ = 16 * 32;
  constexpr int I_ALL = I_IN + I_QUP + I_KVUP + I_OUT + I_PQ;
  for (int it = bid; it < I_ALL; it += nb) {
    int q = it;
    if (q < I_IN) { p0_transpose(lds, p.in[7], 1024, 2272, (bf16_t*)(ws + WS_WTIN), q, (bf16_t*)(ws + WS_WTINP)); continue; } q -= I_IN;
    if (q < I_QUP) { p0_transpose(lds, p.in[9], 384, 768, (bf16_t*)(ws + WS_WTQUP), q); continue; } q -= I_QUP;
    if (q < I_KVUP) { p0_transpose(lds, p.in[11], 256, 1024, (bf16_t*)(ws + WS_WTKVUP), q); continue; } q -= I_KVUP;
    if (q < I_OUT) { p0_transpose(lds, p.in[17], 1024, 1024, (bf16_t*)(ws + WS_WTOUT), q, (bf16_t*)(ws + WS_WTOUTP)); continue; } q -= I_OUT;
    p0_transpose(lds, p.in[20], 1024, 2048, (bf16_t*)(ws + WS_WTPQ), q, (bf16_t*)(ws + WS_WTPQP));
  }
  { bf16_t* kd = (bf16_t*)(ws + WS_KD);
    for (int e = bid * NTHR + tid; e < 65536; e += nb * NTHR) { int n = e >> 8, k = e & 255; float v = 0.f;
      if (n < 128 && k < 128) v = p.in[21][n * 128 + k]; else if (n >= 128 && k >= 128) v = p.in[22][(n - 128) * 128 + (k - 128)];
      kd[(size_t)(k >> 6) * 16384 + n * 64 + (k & 63)] = f2bf(v); } }
  for (int jb = bid; jb < 96; jb += nb) {
    __syncthreads();
    float* cact = (float*)lds;
    float* red = (float*)(lds + 32768);
    for (int e = tid; e < 8192; e += NTHR) cact[e] = silu_f(p.in[1][e]);
    __syncthreads();
    const int jj = tid & 63, ks = tid >> 6, j0 = jb * 64;
    float acc[8];
#pragma unroll
    for (int b = 0; b < 8; ++b) acc[b] = 0.f;
    const float* wp = p.in[3] + (size_t)(ks * 128) * 6144 + j0 + jj;
    for (int k = 0; k < 128; ++k) { const float wv = wp[(size_t)k * 6144];
#pragma unroll
      for (int b = 0; b < 8; ++b) acc[b] += cact[b * 1024 + ks * 128 + k] * wv; }
#pragma unroll
    for (int b = 0; b < 8; ++b) red[(ks * 64 + jj) * 8 + b] = acc[b];
    __syncthreads();
    { const int b = tid >> 6; float sacc = p.in[4][j0 + jj];
#pragma unroll
      for (int k2 = 0; k2 < 8; ++k2) sacc += red[(k2 * 64 + jj) * 8 + b];
      ((float*)(ws + WS_MOD))[b * 6144 + j0 + jj] = sacc; }
  }
}

constexpr int WT_STRIDE = 144, WT_BYTES = 32 * WT_STRIDE;
DI void wt_write(char* wl, const f32x16& a0, const f32x16& a1, int r, int hh, float scale) {
  char* bp = wl + (4 * hh) * WT_STRIDE + r * 2;
#pragma unroll
  for (int reg = 0; reg < 16; ++reg) { const int ro = ((reg & 3) + 8 * (reg >> 2)) * WT_STRIDE;
    *(bf16_t*)(bp + ro) = f2bf(a0[reg] * scale); *(bf16_t*)(bp + ro + 64) = f2bf(a1[reg] * scale); }
}
DI void wt_write_rope(char* wl, const f32x16& a0, const f32x16& a1, int r, int hh, const float* cs, const float* sn, int m0) {
  char* bp = wl + (4 * hh) * WT_STRIDE + r * 2;
#pragma unroll
  for (int reg = 0; reg < 16; ++reg) { const int rw = (reg & 3) + 8 * (reg >> 2); const int row = m0 + rw + 4 * hh;
    const float c = cs[row * 32 + r], s = sn[row * 32 + r];
    *(bf16_t*)(bp + rw * WT_STRIDE) = f2bf(a0[reg] * c - a1[reg] * s); *(bf16_t*)(bp + rw * WT_STRIDE + 64) = f2bf(a1[reg] * c + a0[reg] * s); }
}
DI void wt_store(const char* wl, int lane, bf16_t* dA, int sA, bf16_t* dB, int sB) {
  const int piece = lane & 7, rsub = lane >> 3;
  bf16_t* d = (piece < 4) ? dA : dB; const int st = (piece < 4) ? sA : sB;
  if (d) {
#pragma unroll
    for (int i = 0; i < 4; ++i) { const int row = i * 8 + rsub; const uint4 v = *(const uint4*)(wl + row * WT_STRIDE + piece * 16);
      *(uint4*)(d + (size_t)row * st + (piece & 3) * 8) = v; }
  }
}
#define LDS_FENCE() asm volatile("s_waitcnt lgkmcnt(0)" ::: "memory")
DI int lv(int x) { asm volatile("" : "+v"(x)); return x; }
template <class T> DI T* launder(T* q) { size_t z = 0; asm volatile("" : "+s"(z)); return (T*)((char*)q + z); }

constexpr int GL_GR = 0, GL_VT = 8192, GL_QD = 26624, GL_KI = 45056, GL_KIT = 63488, GL_ATT = 81920, GL_TOT = 91136, GL_DEC = 93184, GL_LA = 93696  , GL_QS = 126464  , GL_KS = 134656;
DI void gla_chunk_local(const KP& p, char* lds, unsigned char* ws, int tile, const bf16_t* PA, const bf16_t* PB) {
  const int tid = lv(threadIdx.x), lane = tid & 63, w = tid >> 6, r = lane & 31, hh = lane >> 5;
  const int b = tile >> 5, n = tile & 31, tok0 = tile * 64;
  float* GRL = (float*)(lds + GL_GR); float* TOT = (float*)(lds + GL_TOT); float* DECL = (float*)(lds + GL_DEC);
  __syncthreads();
#pragma unroll
  for (int i = 0; i < 4; ++i) { const int e = tid + 512 * i; GRL[e] = bf2f(PB[(size_t)(e >> 5) * 1024 + (O_GF - 1024) + (e & 31)]); }
#pragma unroll 1
  for (int h = 0; h < 4; ++h) {
    __syncthreads();
    { const int t = tid >> 3, c8 = (tid & 7) * 8;
      *(uint4*)(lds + GL_QS + (t * 64 + c8) * 2) = *(const uint4*)(PA + (size_t)t * 1024 + O_QG + h * 64 + c8);
      *(uint4*)(lds + GL_KS + (t * 64 + c8) * 2) = (h == 0) ? *(const uint4*)(PA + (size_t)t * 1024 + O_KG + c8) : *(const uint4*)(PB + (size_t)t * 1024 + (O_KG - 1024) + h * 64 + c8); }
#pragma unroll
    for (int i = 0; i < 2; ++i) { const int c = tid + 512 * i, t = c >> 4, d8 = (c & 15) * 8;
      const uint4 v = *(const uint4*)(PB + (size_t)t * 1024 + (O_VG - 1024) + h * 128 + d8);
      bf16_t* vt = (bf16_t*)(lds + GL_VT) + d8 * 72 + t;
      vt[0] = (bf16_t)(v.x & 0xffffu); vt[72] = (bf16_t)(v.x >> 16); vt[144] = (bf16_t)(v.y & 0xffffu); vt[216] = (bf16_t)(v.y >> 16);
      vt[288] = (bf16_t)(v.z & 0xffffu); vt[360] = (bf16_t)(v.z >> 16); vt[432] = (bf16_t)(v.w & 0xffffu); vt[504] = (bf16_t)(v.w >> 16); }
    const int dir = tid >> 8, qt = (tid >> 6) & 3, dk = tid & 63, col = h * 64 + dk;
    float* LAL = (float*)(lds + GL_LA) + tid;
    {
      const float* wg = launder(dir ? p.in[14] : p.in[12]); const float* bg = launder(dir ? p.in[15] : p.in[13]);
      float wr[16];
#pragma unroll
      for (int q = 0; q < 16; ++q) wr[q] = wg[q * 256 + col];
      const float bias = bg[col];
      float run = 0.f;
#pragma unroll 2
      for (int ii = 0; ii < 16; ++ii) { const int i = dir ? 15 - ii : ii;
        const float* gp = GRL + (qt * 16 + i) * 32 + dir * 16; float x = bias;
#pragma unroll
        for (int q = 0; q < 16; ++q) x += gp[q] * wr[q];
        run += logsigmoid_fast(x) * (1.f / 16.f); LAL[i * 512] = run; }
      TOT[(dir * 64 + dk) * 4 + qt] = run;
    }
    __syncthreads();
    {
      const float4 tq = *(const float4*)(TOT + (dir * 64 + dk) * 4);
      const float total = (tq.x + tq.y) + (tq.z + tq.w);
      float off;
      if (dir == 0) off = (qt > 0 ? tq.x : 0.f) + (qt > 1 ? tq.y : 0.f) + (qt > 2 ? tq.z : 0.f);
      else          off = (qt < 1 ? tq.y : 0.f) + (qt < 2 ? tq.z : 0.f) + (qt < 3 ? tq.w : 0.f);
      if (qt == 0) { const float dc = fexp(total); DECL[dir * 64 + dk] = dc; ((float*)(ws + WS_DEC))[((size_t)((b * 4 + h) * 2 + dir) * 32 + n) * 64 + dk] = dc; }
      bf16_t* QD = (bf16_t*)(lds + GL_QD + dir * 9216) + (qt * 16) * 72 + dk; bf16_t* KI = (bf16_t*)(lds + GL_KI + dir * 9216) + (qt * 16) * 72 + dk;
      bf16_t* KIT = (bf16_t*)(lds + GL_KIT + dir * 9216) + dk * 72 + qt * 16;
      bf16_t* qdg = (bf16_t*)(ws + WS_QDEC) + (size_t)((tile * 4 + h) * 2 + dir) * 4096 + (qt * 16) * 64 + dk;
      const bf16_t* qgp = (const bf16_t*)(lds + GL_QS) + (qt * 16) * 64 + dk; const bf16_t* kgp = (const bf16_t*)(lds + GL_KS) + (qt * 16) * 64 + dk;
#pragma unroll 2
      for (int i = 0; i < 16; ++i) { const float bb = off + LAL[i * 512];
        const float qv = bf2f(qgp[i * 64]) * 0.125f, kv = bf2f(kgp[i * 64]);
        const float eb = fexp(bb); const bf16_t qd = f2bf(qv * eb), ki = f2bf(kv * __builtin_amdgcn_rcpf(eb));
        QD[i * 72] = qd; KI[i * 72] = ki; qdg[i * 64] = qd; KIT[i] = ki; }
    }
    __syncthreads();
    if (w < 4) { const int mi = w >> 1, ni = w & 1;
      f32x16 asum;
#pragma unroll
      for (int i = 0; i < 16; ++i) asum[i] = 0.f;
#pragma unroll
      for (int d = 0; d < 2; ++d) { f32x16 acc;
#pragma unroll
        for (int i = 0; i < 16; ++i) acc[i] = 0.f;
#pragma unroll
        for (int s = 0; s < 4; ++s) { const bf16x8 a = *(const bf16x8*)(lds + GL_QD + d * 9216 + (mi * 32 + r) * 144 + s * 32 + hh * 16);
          const bf16x8 bb = *(const bf16x8*)(lds + GL_KI + d * 9216 + (ni * 32 + r) * 144 + s * 32 + hh * 16); acc = MFMA32(a, bb, acc); }
#pragma unroll
        for (int reg = 0; reg < 16; ++reg) { const int ti = mi * 32 + crow(reg, hh), tj = ni * 32 + r; const bool keep = d ? (tj >= ti) : (tj <= ti); asum[reg] += keep ? acc[reg] : 0.f; } }
      bf16_t* at = (bf16_t*)(lds + GL_ATT) + (mi * 32 + 4 * hh) * 72 + ni * 32 + r;
#pragma unroll
      for (int reg = 0; reg < 16; ++reg) at[((reg & 3) + 8 * (reg >> 2)) * 72] = f2bf(asum[reg]);
    }
    __syncthreads();
    { const int mi = w >> 2, ni = w & 3; f32x16 acc;
#pragma unroll
      for (int i = 0; i < 16; ++i) acc[i] = 0.f;
#pragma unroll
      for (int s = 0; s < 4; ++s) { const bf16x8 a = *(const bf16x8*)(lds + GL_ATT + (mi * 32 + r) * 144 + s * 32 + hh * 16);
        const bf16x8 bb = *(const bf16x8*)(lds + GL_VT + (ni * 32 + r) * 144 + s * 32 + hh * 16); acc = MFMA32(a, bb, acc); }
      bf16_t* oi = (bf16_t*)(ws + WS_OINTRA) + (size_t)(tok0 + mi * 32 + 4 * hh) * 512 + h * 128 + ni * 32 + r;
#pragma unroll
      for (int reg = 0; reg < 16; ++reg) oi[(size_t)((reg & 3) + 8 * (reg >> 2)) * 512] = f2bf(acc[reg]); }
    { const int dvb = w >> 1, dkb = w & 1;
#pragma unroll
      for (int d = 0; d < 2; ++d) { f32x16 acc;
#pragma unroll
        for (int i = 0; i < 16; ++i) acc[i] = 0.f;
#pragma unroll
        for (int s = 0; s < 4; ++s) { const bf16x8 a = *(const bf16x8*)(lds + GL_VT + (dvb * 32 + r) * 144 + s * 32 + hh * 16);
          const bf16x8 bb = *(const bf16x8*)(lds + GL_KIT + d * 9216 + (dkb * 32 + r) * 144 + s * 32 + hh * 16); acc = MFMA32(a, bb, acc); }
        const float sc = DECL[d * 64 + dkb * 32 + r];
        bf16_t* ds = (bf16_t*)(ws + WS_SPT) + ((size_t)((b * 4 + h) * 2 + d) * 32 + n) * 8192 + (size_t)(dvb * 32 + 4 * hh) * 64 + dkb * 32 + r;
#pragma unroll
        for (int reg = 0; reg < 16; ++reg) ds[((reg & 3) + 8 * (reg >> 2)) * 64] = f2bf(acc[reg] * sc); } }
  }
}

DI void phase1a(const KP& p, char* lds) {
  const int tid = threadIdx.x, lane = tid & 63, w = tid >> 6;
  for (int tile = blockIdx.x; tile < 256; tile += gridDim.x) {
    unsigned char* ws = launder(p.ws); unsigned char* ob = (unsigned char*)launder(p.out); const float* xin = launder(p.in[0]);
    const float* mod = (const float*)(ws + WS_MOD);
    const int tok0 = tile * 64, b = tile >> 5;
    bf16_t* Hs = (bf16_t*)(ob + OUT_HS) + (size_t)tok0 * 1024;
    float4 ge[4], sh[4];
    const float* gpre = launder(p.in[5]); const float* modb = launder(mod) + b * 6144;
#pragma unroll
    for (int i = 0; i < 4; ++i) { const int d = (lane + 64 * i) * 4;
      const float4 g = *(const float4*)(gpre + d); const float4 sc = *(const float4*)(modb + 1024 + d); sh[i] = *(const float4*)(modb + d);
      ge[i] = make_float4(g.x * (1.f + sc.x), g.y * (1.f + sc.y), g.z * (1.f + sc.z), g.w * (1.f + sc.w)); }
#pragma unroll 2
    for (int rr = 0; rr < 8; ++rr) { const int row = w * 8 + rr;
      const float* xr = xin + (size_t)(tok0 + row) * 1024;
      float4 v[4]; float ss = 0.f;
#pragma unroll
      for (int i = 0; i < 4; ++i) { v[i] = *(const float4*)(xr + (lane + 64 * i) * 4); ss += v[i].x * v[i].x + v[i].y * v[i].y + v[i].z * v[i].z + v[i].w * v[i].w; }
      ss = wave_sum(ss); const float rs = rsqrtf(ss * (1.f / 1024.f) + EPS);
#pragma unroll
      for (int i = 0; i < 4; ++i) { uint2 o; o.x = pack2(v[i].x * rs * ge[i].x + sh[i].x, v[i].y * rs * ge[i].y + sh[i].y); o.y = pack2(v[i].z * rs * ge[i].z + sh[i].z, v[i].w * rs * ge[i].w + sh[i].w);
        *(uint2*)(Hs + (size_t)row * 1024 + (lane + 64 * i) * 4) = o; }
    }
  }
}

DI void phase1c(const KP& p, char* lds) {
  const int tid = threadIdx.x, lane = tid & 63, w = tid >> 6, r = lane & 31, hh = lane >> 5;
  float* cs = (float*)(lds + LDS_TAB); float* sn = cs + 2048;
  char* wl = lds + LDS_WT + (w & 3) * WT_BYTES;
  for (int tile = blockIdx.x; tile < 256; tile += gridDim.x) {
    unsigned char* ws = launder(p.ws); unsigned char* ob = (unsigned char*)launder(p.out);
    const int tok0 = tile * 64, b = tile >> 5, t0 = (tile & 31) * 64;
    const bf16_t* PA = (const bf16_t*)(ws + WS_P1S) + (size_t)tok0 * 1024;
    const bf16_t* PB = (const bf16_t*)(ob + 32 * MiB) + (size_t)tok0 * 1024;
    const bf16_t* PC = (const bf16_t*)(ws + WS_PROJC) + (size_t)tok0 * 256;
    bf16_t* Hs = (bf16_t*)(ob + OUT_HS) + (size_t)tok0 * 1024;
    bf16_t* CQN = Hs; bf16_t* CKVN = Hs + 64 * 384;
    bf16_t* Qm = (bf16_t*)(ws + WS_QM); bf16_t* Km = (bf16_t*)(ws + WS_KM); bf16_t* Vm = (bf16_t*)(ws + WS_VM);
    bf16_t* rg = (bf16_t*)(ws + WS_RG) + (size_t)tok0 * 512;
    __syncthreads();
#pragma unroll
    for (int i = 0; i < 4; ++i) { const int e = tid + 512 * i, tt = e >> 5, j = e & 31;
      const float inv = __builtin_amdgcn_exp2f(-(float)j * (13.287712379549449f / 32.f)); const float ang = (float)((const int*)p.in[2])[tok0 + tt] * inv;
      float rev = ang * 0.15915494309189535f; rev -= floorf(rev);
      cs[e] = __builtin_amdgcn_cosf(rev); sn[e] = __builtin_amdgcn_sinf(rev); }
#pragma unroll
    for (int i = 0; i < 8; ++i) { const int c = tid + 512 * i, row = c >> 6, cc = c & 63;
      const uint4 v = (cc < 36) ? *(const uint4*)(PB + (size_t)row * 1024 + (O_R - 1024) + cc * 8) : *(const uint4*)(PC + (size_t)row * 256 + (cc - 36) * 8);
      *(uint4*)(rg + (size_t)row * 512 + cc * 8) = v; }
    __syncthreads();
    if (tid < 256) { const int row = tid >> 2, pc = tid & 3;
      const uint4 x1 = *(const uint4*)(PA + (size_t)row * 1024 + O_KR + pc * 8), x2 = *(const uint4*)(PA + (size_t)row * 1024 + O_KR + 32 + pc * 8);
      const float4 c0 = *(const float4*)(cs + row * 32 + pc * 8), c1 = *(const float4*)(cs + row * 32 + pc * 8 + 4), s0 = *(const float4*)(sn + row * 32 + pc * 8), s1 = *(const float4*)(sn + row * 32 + pc * 8 + 4);
#define RO1(a_, b_, c_, s_) ((a_) * (c_) - (b_) * (s_))
#define RO2(a_, b_, c_, s_) ((b_) * (c_) + (a_) * (s_))
#define LO(u_) __uint_as_float((u_) << 16)
#define HI(u_) __uint_as_float((u_) & 0xffff0000u)
      uint4 o1, o2;
      o1.x = pack2(RO1(LO(x1.x), LO(x2.x), c0.x, s0.x), RO1(HI(x1.x), HI(x2.x), c0.y, s0.y)); o1.y = pack2(RO1(LO(x1.y), LO(x2.y), c0.z, s0.z), RO1(HI(x1.y), HI(x2.y), c0.w, s0.w));
      o1.z = pack2(RO1(LO(x1.z), LO(x2.z), c1.x, s1.x), RO1(HI(x1.z), HI(x2.z), c1.y, s1.y)); o1.w = pack2(RO1(LO(x1.w), LO(x2.w), c1.z, s1.z), RO1(HI(x1.w), HI(x2.w), c1.w, s1.w));
      o2.x = pack2(RO2(LO(x1.x), LO(x2.x), c0.x, s0.x), RO2(HI(x1.x), HI(x2.x), c0.y, s0.y)); o2.y = pack2(RO2(LO(x1.y), LO(x2.y), c0.z, s0.z), RO2(HI(x1.y), HI(x2.y), c0.w, s0.w));
      o2.z = pack2(RO2(LO(x1.z), LO(x2.z), c1.x, s1.x), RO2(HI(x1.z), HI(x2.z), c1.y, s1.y)); o2.w = pack2(RO2(LO(x1.w), LO(x2.w), c1.z, s1.z), RO2(HI(x1.w), HI(x2.w), c1.w, s1.w));
#undef RO1
#undef RO2
#undef LO
#undef HI
#pragma unroll
      for (int h = 0; h < 4; ++h) { bf16_t* kp = Km + (((size_t)b * 4 + h) * SEQ + t0 + row) * 192 + 128 + pc * 8; *(uint4*)kp = o1; *(uint4*)(kp + 32) = o2; }
    }
    const float* gq = launder(p.in[8]); const float* gkv = launder(p.in[10]);
#pragma unroll 2
    for (int rr = 0; rr < 8; ++rr) { const int row = w * 8 + rr; const unsigned* cr = (const unsigned*)(PA + (size_t)row * 1024);
      float v0[5], v1[5];
#pragma unroll
      for (int i = 0; i < 5; ++i) { const unsigned u = cr[lane + 64 * i]; v0[i] = __uint_as_float(u << 16); v1[i] = __uint_as_float(u & 0xffff0000u); }
      float ss = v0[0] * v0[0] + v1[0] * v1[0] + v0[1] * v0[1] + v1[1] * v1[1] + v0[2] * v0[2] + v1[2] * v1[2];
      float s2 = v0[3] * v0[3] + v1[3] * v1[3] + v0[4] * v0[4] + v1[4] * v1[4];
      ss = wave_sum(ss); s2 = wave_sum(s2);
      const float rq = rsqrtf(ss * (1.f / 384.f) + EPS), rk = rsqrtf(s2 * (1.f / 256.f) + EPS);
#pragma unroll
      for (int i = 0; i < 3; ++i) { const int c = 2 * (lane + 64 * i); *(unsigned*)(CQN + (size_t)row * 384 + c) = pack2(v0[i] * rq * gq[c], v1[i] * rq * gq[c + 1]); }
#pragma unroll
      for (int i = 3; i < 5; ++i) { const int c = 2 * (lane + 64 * (i - 3)); *(unsigned*)(CKVN + (size_t)row * 256 + c) = pack2(v0[i] * rk * gkv[c], v1[i] * rk * gkv[c + 1]); }
    }
    __syncthreads();
    block_gemm<3>(lds, CQN, 384, (const bf16_t*)(ws + WS_WTQUP), 3, 384, [&](int m0, int n0, const f32x16& a0, const f32x16& a1) {
      const int r2 = lv(r), h2 = lv(hh), ln = lv(lane);
      const int h = n0 / 192, d0 = n0 % 192;
      bf16_t* qp = Qm + (((size_t)b * 4 + h) * SEQ + t0 + m0) * 192 + d0;
      if (d0 < 128) wt_write(wl, a0, a1, r2, h2, 1.f); else wt_write_rope(wl, a0, a1, r2, h2, cs, sn, m0);
      LDS_FENCE();
      wt_store(wl, ln, qp, 192, qp + 32, 192);
    });
    block_gemm<3>(lds, CKVN, 256, (const bf16_t*)(ws + WS_WTKVUP), 4, 256, [&](int m0, int n0, const f32x16& a0, const f32x16& a1) {
      const int r2 = lv(r), h2 = lv(hh), ln = lv(lane);
      const int h = n0 >> 8, d0 = n0 & 255;
      wt_write(wl, a0, a1, r2, h2, 1.f); LDS_FENCE();
      if (d0 < 128) { bf16_t* kp = Km + (((size_t)b * 4 + h) * SEQ + t0 + m0) * 192 + d0; wt_store(wl, ln, kp, 192, kp + 32, 192); }
      else { bf16_t* vp = Vm + (((size_t)b * 4 + h) * SEQ + t0 + m0) * 128 + (d0 - 128); wt_store(wl, ln, vp, 128, vp + 32, 128); }
    });
    gla_chunk_local(p, lds, ws, tile, PA, PB);
  }
}

namespace att {
typedef short s16x4 __attribute__((ext_vector_type(4)));
typedef unsigned u32x4 __attribute__((ext_vector_type(4)));
constexpr int DQ = 192, DV = 128, KVBLK = 64;
constexpr float SCALE = 0.07216878364870322f;
constexpr float THR = 8.f;
constexpr int SHM_V = KVBLK * DV * 2, SHM_K = KVBLK * DQ * 2;
constexpr int SHM_QR = 8 * 32 * 176;
constexpr int SHM_ATTN = 2 * SHM_V + 2 * SHM_K + 8 * 64 * 4 + SHM_QR;
#define KSWZ(row, colB) ((row) * 384 + ((colB) ^ (((row) & 7) << 4)))
#define SBAR() __builtin_amdgcn_sched_barrier(0)
DI unsigned cvtpk(float lo, float hi) { unsigned r; asm volatile("v_cvt_pk_bf16_f32 %0, %1, %2" : "=v"(r) : "v"(lo), "v"(hi)); return r; }

DI void partialSM(f32x16& p0, f32x16& p1, float& m_reg, float& mn, float& alpha) {
  constexpr float C = SCALE * 1.4426950408889634f;
  float pmax = p0[0];
#pragma unroll
  for (int r = 1; r < 16; ++r) pmax = fmaxf(pmax, p0[r]);
#pragma unroll
  for (int r = 0; r < 16; ++r) pmax = fmaxf(pmax, p1[r]);
  { auto rr = __builtin_amdgcn_permlane32_swap(__float_as_uint(pmax), __float_as_uint(pmax), false, false);
    pmax = fmaxf(__uint_as_float(rr[0]), __uint_as_float(rr[1])); }
  if (__builtin_expect(__all(pmax - m_reg <= THR / SCALE), 1)) { mn = m_reg; alpha = 1.f; }
  else { mn = fmaxf(m_reg, pmax); alpha = __builtin_amdgcn_exp2f((m_reg - mn) * C); m_reg = mn; }
  const float mnC = -mn * C;
#pragma unroll
  for (int r = 0; r < 16; ++r) p0[r] = fmaf(p0[r], C, mnC);
#pragma unroll
  for (int r = 0; r < 16; ++r) p1[r] = fmaf(p1[r], C, mnC);
#pragma unroll
  for (int r = 0; r < 16; ++r) p0[r] = __builtin_amdgcn_exp2f(p0[r]);
}
DI void finishSM(f32x16& p0, f32x16& p1, float alpha, float& l_reg, bf16x8& pa0, bf16x8& pa1, bf16x8& pa2, bf16x8& pa3) {
#pragma unroll
  for (int r = 0; r < 16; ++r) p1[r] = __builtin_amdgcn_exp2f(p1[r]);
  float ps = 0;
#pragma unroll
  for (int r = 0; r < 16; ++r) ps += p0[r];
#pragma unroll
  for (int r = 0; r < 16; ++r) ps += p1[r];
  { auto rr = __builtin_amdgcn_permlane32_swap(__float_as_uint(ps), __float_as_uint(ps), false, false);
    ps = __uint_as_float(rr[0]) + __uint_as_float(rr[1]); }
  l_reg = l_reg * alpha + ps;
#define PK4(P, BASE, OUT) do { unsigned a0 = cvtpk(P[BASE + 0], P[BASE + 1]), a1 = cvtpk(P[BASE + 2], P[BASE + 3]);   \
    unsigned b0 = cvtpk(P[BASE + 4], P[BASE + 5]), b1 = cvtpk(P[BASE + 6], P[BASE + 7]);                              \
    auto r0 = __builtin_amdgcn_permlane32_swap(a0, b0, false, false); auto r1 = __builtin_amdgcn_permlane32_swap(a1, b1, false, false); \
    u32x4 wv = {r0[0], r1[0], r0[1], r1[1]}; OUT = *reinterpret_cast<bf16x8*>(&wv); } while (0)
  PK4(p0, 0, pa0); PK4(p0, 8, pa1); PK4(p1, 0, pa2); PK4(p1, 8, pa3);
#undef PK4
}
DI void qkt(f32x16& p0, f32x16& p1, const char* Ks, const bf16x8* qr, const char* qrl, int r32, int hi) {
#pragma unroll
  for (int i = 0; i < 16; ++i) { p0[i] = 0.f; p1[i] = 0.f; }
#pragma unroll
  for (int d0 = 0; d0 < 12; ++d0) { const int cb = (d0 * 16 + hi * 8) * 2;
    const bf16x8 b0 = *reinterpret_cast<const bf16x8*>(Ks + KSWZ(r32, cb));
    const bf16x8 b1 = *reinterpret_cast<const bf16x8*>(Ks + KSWZ(32 + r32, cb));
    const bf16x8 q = (d0 < 7) ? qr[d0 < 7 ? d0 : 0] : *reinterpret_cast<const bf16x8*>(qrl + (d0 - 7) * 32);
    p0 = MFMA32(b0, q, p0);
    p1 = MFMA32(b1, q, p1); }
}
DI int v_st(int k, int c) { const int kk = (k & ~0xC) | ((k & 4) << 1) | ((k & 8) >> 1); return ((kk >> 3) * 4 + (c >> 5)) * 512 + ((kk & 7) * 32 + (c & 31)) * 2; }
DI int v_rd_base(int lane) { return ((lane & 3) << 3) | (((lane >> 2) & 3) << 6) | (((lane >> 4) & 1) << 5) | (((lane >> 5) & 1) << 8); }
constexpr int v_rd_off(int d0, int ks, int half) { return d0 * 512 + ks * 4096 + half * 2048; }
template <int OFF> DI s16x4 tr_read(int vb) { s16x4 r; asm volatile("ds_read_b64_tr_b16 %0, %1 offset:%2" : "=&v"(r) : "v"(vb), "i"(OFF) : "memory"); return r; }
template <int D0> DI void pv_one(f32x16& od, int vb, bf16x8 pa0, bf16x8 pa1, bf16x8 pa2, bf16x8 pa3) {
  const s16x4 l0 = tr_read<v_rd_off(D0, 0, 0)>(vb), h0 = tr_read<v_rd_off(D0, 0, 1)>(vb), l1 = tr_read<v_rd_off(D0, 1, 0)>(vb), h1 = tr_read<v_rd_off(D0, 1, 1)>(vb);
  const s16x4 l2 = tr_read<v_rd_off(D0, 2, 0)>(vb), h2 = tr_read<v_rd_off(D0, 2, 1)>(vb), l3 = tr_read<v_rd_off(D0, 3, 0)>(vb), h3 = tr_read<v_rd_off(D0, 3, 1)>(vb);
  asm volatile("s_waitcnt lgkmcnt(0)" ::: "memory"); SBAR();
#define PK(L, H) (bf16x8){L[0], L[1], L[2], L[3], H[0], H[1], H[2], H[3]}
  od = MFMA32(pa0, PK(l0, h0), od);
  od = MFMA32(pa1, PK(l1, h1), od);
  od = MFMA32(pa2, PK(l2, h2), od);
  od = MFMA32(pa3, PK(l3, h3), od);
#undef PK
}
DI void pv_d0(f32x16* o, int vb, bf16x8 pa0, bf16x8 pa1, bf16x8 pa2, bf16x8 pa3) {
  pv_one<0>(o[0], vb, pa0, pa1, pa2, pa3); pv_one<1>(o[1], vb, pa0, pa1, pa2, pa3); pv_one<2>(o[2], vb, pa0, pa1, pa2, pa3); pv_one<3>(o[3], vb, pa0, pa1, pa2, pa3);
}
DI void attn_unit(const bf16_t* Qb, const bf16_t* Kh, const bf16_t* Vh, bf16_t* Ob, int seq, char* lds) {
  const int tid = lv(threadIdx.x), wid = tid >> 6, lane = tid & 63, r32 = lane & 31, hi = lane >> 5;
  char* V_lds = lds; char* K_lds = lds + 2 * SHM_V;
  float* wsf = (float*)(lds + 2 * SHM_V + 2 * SHM_K) + wid * 64; float* li_l = wsf; float* al_l = wsf + 32;
  char* qrl = lds + 2 * SHM_V + 2 * SHM_K + 8 * 64 * 4 + wid * (32 * 176) + r32 * 176 + hi * 16;
  float m_reg = -1e30f, l_reg = 0; f32x16 o[4]; bf16x8 qr[7];
#pragma unroll
  for (int d = 0; d < 4; ++d)
#pragma unroll
    for (int i = 0; i < 16; ++i) o[d][i] = 0.f;
  const bf16_t* Qw = Qb + (size_t)(wid * 32 + r32) * DQ + hi * 8;
#pragma unroll
  for (int d0 = 0; d0 < 7; ++d0) qr[d0] = *reinterpret_cast<const bf16x8*>(Qw + d0 * 16);
#pragma unroll
  for (int d0 = 7; d0 < 12; ++d0) *reinterpret_cast<bf16x8*>(qrl + (d0 - 7) * 32) = *reinterpret_cast<const bf16x8*>(Qw + d0 * 16);
  int kst[3];
#pragma unroll
  for (int i = 0; i < 3; ++i) { const int c = tid + 512 * i; kst[i] = KSWZ(c / 24, (c % 24) * 16); }
  const int vst0 = v_st(tid >> 4, (tid & 15) * 8), vst1 = v_st(32 + (tid >> 4), (tid & 15) * 8);
  const int vb0 = (int)(uintptr_t)V_lds + v_rd_base(lane);
  bf16x8 sk0, sk1, sk2, sv0, sv1;
#define SLOAD(k0) do { const bf16x8* kp = reinterpret_cast<const bf16x8*>(Kh + (size_t)(k0) * DQ) + tid; sk0 = kp[0]; sk1 = kp[512]; sk2 = kp[1024]; \
    const bf16x8* vp = reinterpret_cast<const bf16x8*>(Vh + (size_t)(k0) * DV) + tid; sv0 = vp[0]; sv1 = vp[512]; } while (0)
#define SWRITE(b) do { *(bf16x8*)(V_lds + (b) * SHM_V + vst0) = sv0; *(bf16x8*)(V_lds + (b) * SHM_V + vst1) = sv1; \
    *(bf16x8*)(K_lds + (b) * SHM_K + kst[0]) = sk0; *(bf16x8*)(K_lds + (b) * SHM_K + kst[1]) = sk1; *(bf16x8*)(K_lds + (b) * SHM_K + kst[2]) = sk2; } while (0)
#define RESC(a) do { if (__any((a) < 1.f)) { if (hi == 0) al_l[r32] = (a); asm volatile("s_waitcnt lgkmcnt(0)" ::: "memory"); \
    _Pragma("unroll") for (int d = 0; d < 4; ++d) _Pragma("unroll") for (int r = 0; r < 16; ++r) o[d][r] *= al_l[crow(r, hi)]; } } while (0)
  f32x16 pA0, pA1, pB0, pB1; float mnA, mnB, alA, alB; bf16x8 pa0, pa1, pa2, pa3; const int NT = seq / KVBLK;
  SLOAD(0); SWRITE(0); __syncthreads();
  qkt(pA0, pA1, K_lds, qr, qrl, r32, hi); partialSM(pA0, pA1, m_reg, mnA, alA);
  SLOAD(KVBLK); SWRITE(1); __syncthreads();
  for (int j = 1; j + 1 < NT; j += 2) {
    SBAR(); qkt(pB0, pB1, K_lds + SHM_K, qr, qrl, r32, hi);
    finishSM(pA0, pA1, alA, l_reg, pa0, pa1, pa2, pa3); SBAR();
    SLOAD((j + 1) * KVBLK); SBAR();
    pv_d0(o, vb0, pa0, pa1, pa2, pa3); partialSM(pB0, pB1, m_reg, mnB, alB);
    __syncthreads(); SWRITE(0);
    RESC(alB); __syncthreads();
    SBAR(); qkt(pA0, pA1, K_lds, qr, qrl, r32, hi);
    finishSM(pB0, pB1, alB, l_reg, pa0, pa1, pa2, pa3); SBAR();
    SLOAD((j + 2) * KVBLK); SBAR();
    pv_d0(o, vb0 + SHM_V, pa0, pa1, pa2, pa3); partialSM(pA0, pA1, m_reg, mnA, alA);
    __syncthreads(); SWRITE(1);
    RESC(alA); __syncthreads();
  }
  SBAR(); qkt(pB0, pB1, K_lds + SHM_K, qr, qrl, r32, hi);
  finishSM(pA0, pA1, alA, l_reg, pa0, pa1, pa2, pa3); SBAR();
  pv_d0(o, vb0, pa0, pa1, pa2, pa3); partialSM(pB0, pB1, m_reg, mnB, alB);
  __syncthreads(); RESC(alB);
  finishSM(pB0, pB1, alB, l_reg, pa0, pa1, pa2, pa3); SBAR();
  pv_d0(o, vb0 + SHM_V, pa0, pa1, pa2, pa3);
  if (hi == 0) li_l[r32] = l_reg; asm volatile("s_waitcnt lgkmcnt(0)" ::: "memory");
  float rli[16];
#pragma unroll
  for (int r = 0; r < 16; ++r) rli[r] = __builtin_amdgcn_rcpf(li_l[crow(r, hi)]);
  bf16_t* Ow = Ob + (size_t)(wid * 32) * 1024;
#pragma unroll
  for (int r = 0; r < 16; ++r) { const int orow = crow(r, hi);
#pragma unroll
    for (int d0 = 0; d0 < 4; ++d0) Ow[(size_t)orow * 1024 + d0 * 32 + r32] = f2bf(o[d0][r] * rli[r]); }
  __syncthreads();
#undef SLOAD
#undef SWRITE
#undef RESC
}
}

DI void phase2_attn(const KP& p, char* lds) {
  for (int u = blockIdx.x; u < 256; u += gridDim.x) {
    unsigned char* ws = launder(p.ws);
    const bf16_t* Qm = (const bf16_t*)(ws + WS_QM); const bf16_t* Km = (const bf16_t*)(ws + WS_KM); const bf16_t* Vm = (const bf16_t*)(ws + WS_VM);
    bf16_t* mixa = (bf16_t*)(ws + WS_P1S);
    const int qb = u & 7, bh = u >> 3, b = bh >> 2, h = bh & 3;
    att::attn_unit(Qm + ((size_t)bh * SEQ + qb * 256) * 192, Km + (size_t)bh * SEQ * 192, Vm + (size_t)bh * SEQ * 128,
                   mixa + ((size_t)b * SEQ + qb * 256) * 1024 + h * 128, SEQ, lds);
  }
}

namespace pg8 {
#define PG8_LAS __attribute__((address_space(3)))
typedef unsigned short bf16_t;
typedef short bf16x8 __attribute__((ext_vector_type(8)));
typedef float f32x4 __attribute__((ext_vector_type(4)));
typedef unsigned u32x4 __attribute__((ext_vector_type(4)));
constexpr int BM = 256, BK = 64, HALF = 128, HTB = HALF * BK * 2  , STAGE_BYTES = 8 * HTB, NXCD = 8, WGM = 8;

__host__ __device__ __forceinline__ int lds_byte(int r, int c) { const int st = (r >> 4) * 2 + (c >> 5), rr = r & 15, cc = c & 31, ob = rr * 64 + cc * 2; return st * 1024 + (ob ^ (((ob >> 9) & 1) << 5)); }
__host__ __device__ __forceinline__ void stage_rc(int b, int& R, int& C) { const int st = b / 1024, sb = b % 1024, swz = sb ^ (((sb >> 9) & 1) << 5); R = (st >> 1) * 16 + swz / 64; C = (st & 1) * 32 + (swz % 64) / 2; }
__host__ __device__ __forceinline__ int perm32(int rho) { const int n = rho >> 4, i = rho & 15; return 8 * (i >> 2) + 4 * n + (i & 3); }

struct Unit { int pm, pn; };
struct Gemm { const bf16_t* A; const bf16_t* Bt; int M, N, K; };

struct StaticOrder {
    int nM, nN, nwg, G, c;
    __host__ __device__ void init(int M, int N, int G_, int c_) { nM = M / BM; nN = N / BM; nwg = nM * nN; G = G_; c = c_; }
    __host__ __device__ bool next(int i, Unit& u) const {
        const long L = (long)i * G + c; if (L >= nwg) return false;
        int wgid = (int)L; { const int q = nwg / NXCD, r = nwg % NXCD, xcd = wgid % NXCD, off = wgid / NXCD; wgid = (xcd < r ? xcd * (q + 1) : r * (q + 1) + (xcd - r) * q) + off; }
        const int nig = WGM * nN, gid = wgid / nig, fm = gid * WGM, gsz = (nM - fm) < WGM ? (nM - fm) : WGM;
        u.pm = fm + ((wgid % nig) % gsz); u.pn = (wgid % nig) / gsz; return true;
    }
    __device__ __forceinline__ void a_ready(const Unit&) const {}
    __device__ __forceinline__ void done(const Unit&) const {}
};

__device__ __forceinline__ unsigned cvt_pk_bf16(float lo, float hi) { unsigned r; asm volatile("v_cvt_pk_bf16_f32 %0, %1, %2" : "=v"(r) : "v"(lo), "v"(hi)); return r; }
typedef float f32x2 __attribute__((ext_vector_type(2)));
__device__ __forceinline__ f32x2 gelu_pk(f32x2 v) {
    const f32x2 av = __builtin_elementwise_abs(v), d = av * 0.2316418882f + 1.0f;
    f32x2 t; t.x = __builtin_amdgcn_rcpf(d.x); t.y = __builtin_amdgcn_rcpf(d.y);
    f32x2 q = t * 0.5307027145f + (-0.7265760135f); q = q * t + 0.7107068705f; q = q * t + (-0.142248368f); q = q * t + 0.127414796f; q = q * t;
    const f32x2 s = (v * v) * (-0.72134752044f);
    f32x2 e; e.x = __builtin_amdgcn_exp2f(s.x); e.y = __builtin_amdgcn_exp2f(s.y);
    const f32x2 m = v * (q * e), r = v - m;
    f32x2 o; o.x = v.x < 0.f ? m.x : r.x; o.y = v.y < 0.f ? m.y : r.y; return o;
}

template <int ACT  > struct EpiBf16 {
    static constexpr bool PERM = true, AFTER_DRAIN = false; static_assert(ACT == 0 || ACT == 1, "EpiBf16: ACT is 0 (none) or 1 (gelu_pk)");
    bf16_t* O; int ldc; const float* bias; int split_cols; size_t split_stride; float scale0;
    __device__ __forceinline__ void operator()(const f32x4 (&acc)[2][2][4][2], const Unit& u, int wr, int wc, int fr, int fq) const {
        const int row0 = u.pm * BM + wr * 64 + fr; int colt = u.pn * BM; bf16_t* base = O;
        float sc = 1.f; if (split_cols) { const int t = colt / split_cols; base += (size_t)t * split_stride; colt -= t * split_cols; if (t == 0) sc = scale0; }
        const int col0 = colt + wc * 32 + 8 * fq, bcol0 = u.pn * BM + wc * 32 + 8 * fq;
        f32x4 bv[2][2];
#pragma unroll
        for (int bj = 0; bj < 2; ++bj)
#pragma unroll
            for (int n = 0; n < 2; ++n) bv[bj][n] = bias ? *(const f32x4*)(bias + bcol0 + bj * HALF + 4 * n) : (f32x4){0.f, 0.f, 0.f, 0.f};
#pragma unroll
        for (int ai = 0; ai < 2; ++ai)
#pragma unroll
            for (int m = 0; m < 4; ++m) { bf16_t* rowp = base + (size_t)(row0 + ai * HALF + m * 16) * ldc + col0;
#pragma unroll
                for (int bj = 0; bj < 2; ++bj) { f32x4 v0 = acc[ai][bj][m][0] + bv[bj][0], v1 = acc[ai][bj][m][1] + bv[bj][1];
                    if (ACT == 1) { f32x2 a = gelu_pk((f32x2){v0[0], v0[1]}), b = gelu_pk((f32x2){v0[2], v0[3]}), c = gelu_pk((f32x2){v1[0], v1[1]}), d = gelu_pk((f32x2){v1[2], v1[3]});
                        v0 = (f32x4){a.x, a.y, b.x, b.y}; v1 = (f32x4){c.x, c.y, d.x, d.y}; }
                    v0 = v0 * sc; v1 = v1 * sc; u32x4 w; w.x = cvt_pk_bf16(v0[0], v0[1]); w.y = cvt_pk_bf16(v0[2], v0[3]); w.z = cvt_pk_bf16(v1[0], v1[1]); w.w = cvt_pk_bf16(v1[2], v1[3]);
                    *(u32x4*)(rowp + bj * HALF) = w; } }
    }
};

template <class Epi, class Sched, bool ALIGN_EPI = false, bool SP2 = false>
__device__ __forceinline__ void gemm_phase(PG8_LAS unsigned char* lds, const Gemm g, const Sched& S, const Epi& E) {
    const int tid = threadIdx.x, wid = __builtin_amdgcn_readfirstlane(tid >> 6), lane = tid & 63, wr = wid >> 2, wc = wid & 3, fr = lane & 15, fq = lane >> 4;
    const int K = g.K, nt = K / BK;
    unsigned voffA[2], voffB[2];
#pragma unroll
    for (int i = 0; i < 2; ++i) { int R, C; stage_rc(tid * 16 + i * 8192, R, C); const int Rb = Epi::PERM ? ((R & ~31) + perm32(R & 31)) : R;
        voffA[i] = (unsigned)(R * K + C) * 2u; voffB[i] = (unsigned)(Rb * K + C) * 2u; }
    const size_t kstep = (size_t)(BK * 2);
    const size_t hstep = (size_t)HALF * K * 2;
    const size_t tstep = 2 * hstep;
    const unsigned ldsw = (unsigned)wid * 1024u;
    const int aoff = lds_byte(wr * 64 + fr, fq * 8), boff = lds_byte(wc * 32 + fr, fq * 8);
#define PG8_SA(b, h) (((b) * 2 + (h)) * HTB)
#define PG8_SB(b, h) ((4 + (b) * 2 + (h)) * HTB)
#define PG8_STAGE(bufoff, gbase, voff) do { _Pragma("unroll") for (int _i = 0; _i < 2; ++_i) \
        __builtin_amdgcn_global_load_lds((const unsigned*)((const char*)(gbase) + (voff)[_i]), (PG8_LAS unsigned*)(lds + (bufoff) + ldsw + _i * 8192), 16, 0, 0); } while (0)
#define PG8_LDA(dst, b, h) do { _Pragma("unroll") for (int m = 0; m < 4; ++m) _Pragma("unroll") for (int k = 0; k < 2; ++k) dst[m][k] = *(const PG8_LAS bf16x8*)(lds + PG8_SA(b, h) + aoff + m * 2048 + k * 1024); } while (0)
#define PG8_LDB(dst, b, h) do { _Pragma("unroll") for (int n = 0; n < 2; ++n) _Pragma("unroll") for (int k = 0; k < 2; ++k) dst[n][k] = *(const PG8_LAS bf16x8*)(lds + PG8_SB(b, h) + boff + n * 2048 + k * 1024); } while (0)
#define PG8_MMA(ai, bj, At, Bt) do { __builtin_amdgcn_s_setprio(1); _Pragma("unroll") for (int m = 0; m < 4; ++m) _Pragma("unroll") for (int n = 0; n < 2; ++n) _Pragma("unroll") for (int k = 0; k < 2; ++k) \
        acc[ai][bj][m][n] = __builtin_amdgcn_mfma_f32_16x16x32_bf16(Bt[n][k], At[m][k], acc[ai][bj][m][n], 0, 0, 0); __builtin_amdgcn_s_setprio(0); } while (0)
#define PG8_WAIT_V(n) asm volatile("s_waitcnt vmcnt(" #n ")" ::: "memory")
#define PG8_WAIT_L(n) asm volatile("s_waitcnt lgkmcnt(" #n ")" ::: "memory")
#define PG8_BAR __builtin_amdgcn_s_barrier()
#define PG8_SCHED __builtin_amdgcn_sched_barrier(0)
    Unit cur, nxt; int ui = 0;
    if (!S.next(0, cur)) return;
    f32x4 acc[2][2][4][2];
#pragma unroll
    for (int a = 0; a < 2; ++a)
#pragma unroll
        for (int b = 0; b < 2; ++b)
#pragma unroll
            for (int m = 0; m < 4; ++m)
#pragma unroll
                for (int n = 0; n < 2; ++n) acc[a][b][m][n] = (f32x4){0.f, 0.f, 0.f, 0.f};
    bf16x8 At[4][2], B0[2][2], B1[2][2];
    const char* cA = (const char*)g.A + (size_t)cur.pm * tstep; const char* cB = (const char*)g.Bt + (size_t)cur.pn * tstep;
    S.a_ready(cur);
    if constexpr (SP2) {
        PG8_STAGE(PG8_SB(0, 0), cB, voffB); PG8_STAGE(PG8_SB(0, 1), cB + hstep, voffB); PG8_STAGE(PG8_SA(0, 0), cA, voffA); PG8_STAGE(PG8_SA(0, 1), cA + hstep, voffA);
        if (wr == 1) PG8_BAR;
        PG8_WAIT_V(2); PG8_BAR;
        PG8_STAGE(PG8_SB(1, 0), cB + kstep, voffB); PG8_STAGE(PG8_SA(1, 0), cA + kstep, voffA); PG8_STAGE(PG8_SB(1, 1), cB + hstep + kstep, voffB);
        PG8_WAIT_V(6); PG8_BAR;
    } else {
        PG8_STAGE(PG8_SB(0, 0), cB, voffB); PG8_STAGE(PG8_SA(0, 0), cA, voffA); PG8_STAGE(PG8_SB(0, 1), cB + hstep, voffB); PG8_STAGE(PG8_SA(0, 1), cA + hstep, voffA);
        if (wr == 1) PG8_BAR;
        PG8_WAIT_V(4); PG8_BAR;
        PG8_STAGE(PG8_SB(1, 0), cB + kstep, voffB); PG8_STAGE(PG8_SA(1, 0), cA + kstep, voffA); PG8_STAGE(PG8_SB(1, 1), cB + hstep + kstep, voffB);
        PG8_WAIT_V(6); PG8_BAR;
    }
    for (;;) {
        const bool has_next = S.next(ui + 1, nxt);
        const char* nA = has_next ? (const char*)g.A + (size_t)nxt.pm * tstep : cA; const char* nB = has_next ? (const char*)g.Bt + (size_t)nxt.pn * tstep : cB;
        for (int t = 0; t < nt; t += 2) {
            const bool last = (t == nt - 2);
            const char* a1 = cA + (size_t)(t + 1) * kstep;
            const char* a2 = last ? nA : cA + (size_t)(t + 2) * kstep; const char* b2 = last ? nB : cB + (size_t)(t + 2) * kstep;
            const char* a3 = a2 + kstep; const char* b3 = b2 + kstep;
            if (last && has_next) S.a_ready(nxt);
            if constexpr (SP2) {
            PG8_LDB(B0, 0, 0); PG8_LDB(B1, 0, 1); PG8_SCHED; PG8_LDA(At, 0, 0); PG8_STAGE(PG8_SA(1, 1), a1 + hstep, voffA);
            PG8_WAIT_V(8); PG8_WAIT_L(0); PG8_BAR; PG8_MMA(0, 0, At, B0); PG8_MMA(0, 1, At, B1); PG8_BAR; PG8_SCHED;
            PG8_LDA(At, 0, 1); PG8_STAGE(PG8_SB(0, 0), b2, voffB); PG8_STAGE(PG8_SB(0, 1), b2 + hstep, voffB); PG8_STAGE(PG8_SA(0, 0), a2, voffA);
            PG8_WAIT_V(8); PG8_WAIT_L(0); PG8_BAR; PG8_MMA(1, 0, At, B0); PG8_MMA(1, 1, At, B1); PG8_BAR; PG8_SCHED;
            PG8_LDB(B0, 1, 0); PG8_LDB(B1, 1, 1); PG8_SCHED; PG8_LDA(At, 1, 0); PG8_STAGE(PG8_SA(0, 1), a2 + hstep, voffA);
            PG8_WAIT_V(8); PG8_WAIT_L(0); PG8_BAR; PG8_MMA(0, 0, At, B0); PG8_MMA(0, 1, At, B1); PG8_BAR; PG8_SCHED;
            PG8_LDA(At, 1, 1); PG8_STAGE(PG8_SB(1, 0), b3, voffB); PG8_STAGE(PG8_SB(1, 1), b3 + hstep, voffB); PG8_STAGE(PG8_SA(1, 0), a3, voffA);
            PG8_WAIT_V(8); PG8_WAIT_L(0); PG8_BAR; PG8_MMA(1, 0, At, B0); PG8_MMA(1, 1, At, B1); PG8_BAR; PG8_SCHED;
            } else {
            PG8_LDB(B0, 0, 0); PG8_SCHED; PG8_LDA(At, 0, 0); PG8_STAGE(PG8_SA(1, 1), a1 + hstep, voffA);
            PG8_WAIT_L(8); PG8_BAR; PG8_WAIT_L(0); PG8_MMA(0, 0, At, B0); PG8_BAR; PG8_SCHED;
            PG8_LDB(B1, 0, 1); PG8_STAGE(PG8_SB(0, 0), b2, voffB);
            PG8_BAR; PG8_WAIT_L(0); PG8_MMA(0, 1, At, B1); PG8_BAR;
            PG8_LDA(At, 0, 1); PG8_STAGE(PG8_SA(0, 0), a2, voffA);
            PG8_BAR; PG8_WAIT_L(0); PG8_MMA(1, 0, At, B0); PG8_BAR; PG8_SCHED;
            PG8_STAGE(PG8_SB(0, 1), b2 + hstep, voffB);
            PG8_WAIT_V(6); PG8_BAR; PG8_MMA(1, 1, At, B1); PG8_BAR;
            PG8_LDB(B0, 1, 0); PG8_SCHED; PG8_LDA(At, 1, 0); PG8_STAGE(PG8_SA(0, 1), a2 + hstep, voffA);
            PG8_WAIT_L(8); PG8_BAR; PG8_WAIT_L(0); PG8_MMA(0, 0, At, B0); PG8_BAR; PG8_SCHED;
            PG8_LDB(B1, 1, 1); PG8_STAGE(PG8_SB(1, 0), b3, voffB);
            PG8_BAR; PG8_WAIT_L(0); PG8_MMA(0, 1, At, B1); PG8_BAR;
            PG8_LDA(At, 1, 1); PG8_STAGE(PG8_SA(1, 0), a3, voffA);
            PG8_BAR; PG8_WAIT_L(0); PG8_MMA(1, 0, At, B0); PG8_BAR; PG8_SCHED;
            PG8_STAGE(PG8_SB(1, 1), b3 + hstep, voffB);
            PG8_WAIT_V(6); PG8_BAR; PG8_MMA(1, 1, At, B1); PG8_BAR;
            }
        }
        if constexpr (ALIGN_EPI) { if (wr == 0) PG8_BAR; }
        if constexpr (!Epi::AFTER_DRAIN) { E(acc, cur, wr, wc, fr, fq); S.done(cur); }
        if (!has_next) break;
#pragma unroll
        for (int a = 0; a < 2; ++a)
#pragma unroll
            for (int b = 0; b < 2; ++b)
#pragma unroll
                for (int m = 0; m < 4; ++m)
#pragma unroll
                    for (int n = 0; n < 2; ++n) acc[a][b][m][n] = (f32x4){0.f, 0.f, 0.f, 0.f};
        cur = nxt; cA = nA; cB = nB; ++ui;
        if constexpr (ALIGN_EPI) { if (wr == 1) PG8_BAR; }
    }
    PG8_WAIT_V(0);
    if constexpr (!ALIGN_EPI) { if (wr == 0) PG8_BAR; }
    PG8_BAR;
    if constexpr (Epi::AFTER_DRAIN) { E.fused(acc, cur, wr, wc, fr, fq, lds, wid, lane); S.done(cur); }
#undef PG8_SA
#undef PG8_SB
#undef PG8_STAGE
#undef PG8_LDA
#undef PG8_LDB
#undef PG8_MMA
#undef PG8_WAIT_V
#undef PG8_WAIT_L
#undef PG8_BAR
#undef PG8_SCHED
}
}


namespace pg8 {
struct EpiProj {
    static constexpr bool PERM = true, AFTER_DRAIN = false;
    bf16_t* P0; bf16_t* P1; bf16_t* P2;
    __device__ __forceinline__ void operator()(const f32x4 (&acc)[2][2][4][2], const Unit& u, int wr, int wc, int fr, int fq) const {
        const int row0 = u.pm * BM + wr * 64 + fr; const int colt = u.pn * BM;
        const long d1 = (long)(P1 - P0), d2 = (long)(P2 - P0); long dsel = 0; if (colt >= 1024) dsel = d1; if (colt >= 2048) dsel = d2;
        bf16_t* base = P0 + dsel; const int ldc = colt < 2048 ? 1024 : 256; const int cl = colt & 1023;
        const int col0 = cl + wc * 32 + 8 * fq;
#pragma unroll
        for (int ai = 0; ai < 2; ++ai)
#pragma unroll
            for (int m = 0; m < 4; ++m) { bf16_t* rowp = base + (size_t)(row0 + ai * HALF + m * 16) * ldc + col0;
#pragma unroll
                for (int bj = 0; bj < 2; ++bj) { const f32x4 v0 = acc[ai][bj][m][0], v1 = acc[ai][bj][m][1];
                    u32x4 w; w.x = cvt_pk_bf16(v0[0], v0[1]); w.y = cvt_pk_bf16(v0[2], v0[3]); w.z = cvt_pk_bf16(v1[0], v1[1]); w.w = cvt_pk_bf16(v1[2], v1[3]);
                    *(u32x4*)(rowp + bj * HALF) = w; } }
    }
};
}

constexpr int P3_TILE_BYTES = 256 * 1024;
constexpr int LDS_TK = 92160;
constexpr int GP_SH = 11, GP_N = 16384 >> GP_SH, GP_OS = GP_N + 1;
constexpr int LDS_OFF = 32768, LDS_CNT = 36864, LDS_LIST = 36864, LDS_H2L = 45056, LDS_SE = 110592;
constexpr int SCW = 260;
template <int N> DI void ce_desc(float (&a)[N], int i, int l) { const float hi = fmaxf(a[i], a[l]), lo = fminf(a[i], a[l]); a[i] = hi; a[l] = lo; }
DI void sort16_desc(float (&a)[16]) {
#pragma unroll
  for (int k = 2; k <= 16; k <<= 1)
#pragma unroll
    for (int j = k >> 1; j > 0; j >>= 1)
#pragma unroll
      for (int i = 0; i < 16; ++i) { const int l = i ^ j; if (l > i) { if ((i & k) == 0) ce_desc(a, i, l); else ce_desc(a, l, i); } }
}
DI void merge16_desc(float (&a)[16]) {
#pragma unroll
  for (int j = 8; j > 0; j >>= 1)
#pragma unroll
    for (int i = 0; i < 16; ++i) { const int l = i ^ j; if (l > i) ce_desc(a, i, l); }
}
DI void top16_merge(float (&a)[16], const float (&b)[16]) {
#pragma unroll
  for (int i = 0; i < 16; ++i) a[i] = fmaxf(a[i], b[15 - i]);
  merge16_desc(a);
}
template <int CTRL> DI float dpp_f(float v) { return __int_as_float(__builtin_amdgcn_mov_dpp(__float_as_int(v), CTRL, 0xF, 0xF, true)); }

DI float gelu_fast(float x) { return 0.5f * x * (1.f + erff(x * 0.70710678118654752f)); }

DI void phase3(const KP& p, char* lds, const int gather_reps, const int probe) {
  const int tid0 = threadIdx.x;
  const int r = tid0 & 31, hh = (tid0 >> 5) & 1, lane = tid0 & 63;
  char* wl = lds + LDS_WT + ((tid0 >> 6) & 3) * WT_BYTES;
  for (int tile = blockIdx.x; tile < 256; tile += gridDim.x) {
    unsigned char* ws = launder(p.ws); float* outp = launder(p.out); const float* xin = launder(p.in[0]);
    const int tok0 = tile * 64, b = tile >> 5;
    unsigned char* tsc = ws + WS_QM + (size_t)tile * P3_TILE_BYTES;
    bf16_t* QRY = (bf16_t*)tsc; bf16_t* Y = (bf16_t*)tsc; bf16_t* MIXA = (bf16_t*)(ws + WS_P1S) + (size_t)tok0 * 1024; bf16_t* H2 = MIXA;
    const float* modb = launder((const float*)(ws + WS_MOD)) + b * 6144;
    __syncthreads();
    {
      const int tid = lv(tid0), lane = tid & 63, w = tid >> 6, r = lane & 31, hh = lane >> 5;
      const int h = w >> 1, mi = w & 1, n = tile & 31;
      char* OIL = lds; char* RGL = lds + 66560;
      { const bf16_t* oig = (const bf16_t*)(ws + WS_OINTRA) + (size_t)tok0 * 512; const bf16_t* rgg = (const bf16_t*)(ws + WS_RG) + (size_t)tok0 * 512;
#pragma unroll
        for (int i = 0; i < 8; ++i) { const int c = tid + 512 * i, row = c >> 6, cc = c & 63;
          *(uint4*)(OIL + row * 1040 + cc * 16) = *(const uint4*)(oig + (size_t)row * 512 + cc * 8);
          *(uint4*)(RGL + row * 1040 + cc * 16) = *(const uint4*)(rgg + (size_t)row * 512 + cc * 8); } }
      const bf16_t* QDg = (const bf16_t*)(ws + WS_QDEC) + (size_t)(tile * 4 + h) * 2 * 4096 + (mi * 32 + r) * 64 + hh * 8;
      const bf16_t* SPg = (const bf16_t*)(ws + WS_SPT) + ((size_t)((b * 4 + h) * 2) * 32 + n) * 8192 + r * 64 + hh * 8;
      f32x16 acc[4];
#pragma unroll
      for (int ni = 0; ni < 4; ++ni)
#pragma unroll
        for (int i = 0; i < 16; ++i) acc[ni][i] = 0.f;
#pragma unroll
      for (int d = 0; d < 2; ++d)
#pragma unroll
        for (int s = 0; s < 4; ++s) { const bf16x8 a = *(const bf16x8*)(QDg + d * 4096 + s * 16);
#pragma unroll
          for (int ni = 0; ni < 4; ++ni) { const bf16x8 bb = *(const bf16x8*)(SPg + (size_t)d * 32 * 8192 + ni * 32 * 64 + s * 16); acc[ni] = MFMA32(a, bb, acc[ni]); } }
      __syncthreads();
      bf16_t* oil = (bf16_t*)(OIL + (mi * 32 + 4 * hh) * 1040) + h * 128 + r; const bf16_t* rgl = (const bf16_t*)(RGL + (mi * 32 + 4 * hh) * 1040) + h * 128 + r;
#pragma unroll
      for (int ni = 0; ni < 4; ++ni)
#pragma unroll
        for (int reg = 0; reg < 16; ++reg) acc[ni][reg] += bf2f(oil[((reg & 3) + 8 * (reg >> 2)) * 520 + ni * 32]);
      float rs[16];
#pragma unroll
      for (int reg = 0; reg < 16; ++reg) { float v = acc[0][reg] * acc[0][reg] + acc[1][reg] * acc[1][reg] + acc[2][reg] * acc[2][reg] + acc[3][reg] * acc[3][reg];
        v += __shfl_xor(v, 1); v += __shfl_xor(v, 2); v += __shfl_xor(v, 4); v += __shfl_xor(v, 8); v += __shfl_xor(v, 16);
        rs[reg] = rsqrtf(v * (1.f / 128.f) + EPS); }
      const float* ggl = launder(p.in[16]);
#pragma unroll
      for (int ni = 0; ni < 4; ++ni) { const float g = ggl[ni * 32 + r];
#pragma unroll
        for (int reg = 0; reg < 16; ++reg) { const int ro = ((reg & 3) + 8 * (reg >> 2)) * 520 + ni * 32; const float rv = bf2f(rgl[ro]);
          oil[ro] = f2bf(acc[ni][reg] * rs[reg] * g * silu_fast(rv)); } }
      __syncthreads();
#pragma unroll
      for (int i = 0; i < 8; ++i) { const int c = tid + 512 * i, row = c >> 6, cc = c & 63;
        *(uint4*)(MIXA + (size_t)row * 1024 + 512 + cc * 8) = *(const uint4*)(OIL + row * 1040 + cc * 16); }
    }
  }
}

DI void phase3c(const KP& p, char* lds, const int gather_reps, const int probe) {
  const int tid0 = threadIdx.x;
  const int r = tid0 & 31, hh = (tid0 >> 5) & 1, lane = tid0 & 63;
  char* wl = lds + LDS_WT + ((tid0 >> 6) & 3) * WT_BYTES;
  for (int tile = blockIdx.x; tile < 256; tile += gridDim.x) {
    unsigned char* ws = launder(p.ws); float* outp = launder(p.out); const float* xin = launder(p.in[0]);
    const int tok0 = tile * 64, b = tile >> 5;
    unsigned char* tsc = ws + WS_QM + (size_t)tile * P3_TILE_BYTES;
    bf16_t* QRY = (bf16_t*)tsc; bf16_t* Y = (bf16_t*)(ws + WS_QM) + (size_t)tok0 * 1024; bf16_t* MIXA = (bf16_t*)(ws + WS_P1S) + (size_t)tok0 * 1024; bf16_t* H2 = MIXA;
    const float* modb = launder((const float*)(ws + WS_MOD)) + b * 6144;
    __syncthreads();
    {
      const int tid = lv(tid0), lane = tid & 63, w = tid >> 6;
      float4 A1[4], A2[4], S2[4];
      const float* gpo = launder(p.in[6]); const float* gpf = launder(p.in[18]);
#pragma unroll
      for (int i = 0; i < 4; ++i) { const int d = (lane + 64 * i) * 4;
        const float4 gp = *(const float4*)(gpo + d), gt = *(const float4*)(modb + 2048 + d), g2 = *(const float4*)(gpf + d), sc = *(const float4*)(modb + 4096 + d);
        S2[i] = *(const float4*)(modb + 3072 + d);
        A1[i] = make_float4(gp.x * gt.x, gp.y * gt.y, gp.z * gt.z, gp.w * gt.w);
        A2[i] = make_float4(g2.x * (1.f + sc.x), g2.y * (1.f + sc.y), g2.z * (1.f + sc.z), g2.w * (1.f + sc.w)); }
#pragma unroll 2
      for (int rr = 0; rr < 8; ++rr) { const int row = w * 8 + rr; const size_t tok = tok0 + row;
        float4 yv[4]; float ss = 0.f;
#pragma unroll
        for (int i = 0; i < 4; ++i) { const uint2 u = *(const uint2*)(Y + (size_t)row * 1024 + (lane + 64 * i) * 4);
          yv[i] = make_float4(__uint_as_float(u.x << 16), __uint_as_float(u.x & 0xffff0000u), __uint_as_float(u.y << 16), __uint_as_float(u.y & 0xffff0000u));
          ss += yv[i].x * yv[i].x + yv[i].y * yv[i].y + yv[i].z * yv[i].z + yv[i].w * yv[i].w; }
        ss = wave_sum(ss); const float rs = rsqrtf(ss * (1.f / 1024.f) + EPS);
        float4 xv[4]; float s2 = 0.f;
#pragma unroll
        for (int i = 0; i < 4; ++i) { const float4 x = *(const float4*)(xin + tok * 1024 + (lane + 64 * i) * 4);
          xv[i] = make_float4(x.x + A1[i].x * yv[i].x * rs, x.y + A1[i].y * yv[i].y * rs, x.z + A1[i].z * yv[i].z * rs, x.w + A1[i].w * yv[i].w * rs);
          *(float4*)(outp + tok * 1024 + (lane + 64 * i) * 4) = xv[i];
          s2 += xv[i].x * xv[i].x + xv[i].y * xv[i].y + xv[i].z * xv[i].z + xv[i].w * xv[i].w; }
        s2 = wave_sum(s2); const float r2 = rsqrtf(s2 * (1.f / 1024.f) + EPS);
#pragma unroll
        for (int i = 0; i < 4; ++i) { uint2 o; o.x = pack2(xv[i].x * r2 * A2[i].x + S2[i].x, xv[i].y * r2 * A2[i].y + S2[i].y); o.y = pack2(xv[i].z * r2 * A2[i].z + S2[i].z, xv[i].w * r2 * A2[i].w + S2[i].w);
          *(uint2*)(H2 + (size_t)row * 1024 + (lane + 64 * i) * 4) = o; }
      }
    }
  }
}

DI void phase3b(const KP& p, char* lds, const int gather_reps, const int probe) {
  const int tid0 = threadIdx.x;
  const int r = tid0 & 31, hh = (tid0 >> 5) & 1, lane = tid0 & 63;
  char* wl = lds + LDS_WT + ((tid0 >> 6) & 3) * WT_BYTES;
  for (int tile = blockIdx.x; tile < 256; tile += gridDim.x) {
    unsigned char* ws = launder(p.ws); float* outp = launder(p.out); const float* xin = launder(p.in[0]);
    const int tok0 = tile * 64, b = tile >> 5;
    unsigned char* tsc = ws + WS_QM + (size_t)tile * P3_TILE_BYTES;
    bf16_t* QRY = (bf16_t*)tsc; bf16_t* Y = (bf16_t*)tsc; bf16_t* MIXA = (bf16_t*)(ws + WS_P1S) + (size_t)tok0 * 1024; bf16_t* H2 = MIXA;
    const float* modb = launder((const float*)(ws + WS_MOD)) + b * 6144;
    __syncthreads();
    float* SC = (float*)lds; unsigned* TK = (unsigned*)(lds + LDS_TK);
    for (int rep3e = 0; rep3e < (probe == 7 ? 2 : 1); ++rep3e)
    for (int h = 0; h < 8; ++h) {
      block_gemm<2>(lds, QRY + h * 256, 2048, (const bf16_t*)(ws + WS_KD), 1, 256, [&](int m0, int n0, const f32x16& a0, const f32x16& a1) {
        const int r2 = lv(r), h2 = lv(hh);
        float* sp = SC + (m0 + 4 * h2) * SCW + n0 + r2;
#pragma unroll
        for (int reg = 0; reg < 16; ++reg) { const int ro = ((reg & 3) + 8 * (reg >> 2)) * SCW; sp[ro] = a0[reg]; sp[ro + 32] = a1[reg]; }
      });
      __syncthreads();
      {
        const int tid = lv(tid0);
        const int tt = tid >> 3, sd = (tid >> 2) & 1, q = tid & 3;
        const float* sr = SC + tt * SCW + sd * 128 + q * 32;
        float a[16], c[16];
#pragma unroll
        for (int i = 0; i < 4; ++i) { const float4 v = *(const float4*)(sr + i * 4); const unsigned ib = q * 32 + i * 4;
          a[i * 4 + 0] = __uint_as_float((__float_as_uint(v.x) & 0xFFFFFF80u) | (ib + 0)); a[i * 4 + 1] = __uint_as_float((__float_as_uint(v.y) & 0xFFFFFF80u) | (ib + 1));
          a[i * 4 + 2] = __uint_as_float((__float_as_uint(v.z) & 0xFFFFFF80u) | (ib + 2)); a[i * 4 + 3] = __uint_as_float((__float_as_uint(v.w) & 0xFFFFFF80u) | (ib + 3)); }
#pragma unroll
        for (int i = 0; i < 4; ++i) { const float4 v = *(const float4*)(sr + 16 + i * 4); const unsigned ib = q * 32 + 16 + i * 4;
          c[i * 4 + 0] = __uint_as_float((__float_as_uint(v.x) & 0xFFFFFF80u) | (ib + 0)); c[i * 4 + 1] = __uint_as_float((__float_as_uint(v.y) & 0xFFFFFF80u) | (ib + 1));
          c[i * 4 + 2] = __uint_as_float((__float_as_uint(v.z) & 0xFFFFFF80u) | (ib + 2)); c[i * 4 + 3] = __uint_as_float((__float_as_uint(v.w) & 0xFFFFFF80u) | (ib + 3)); }
        sort16_desc(a); sort16_desc(c); top16_merge(a, c);
#pragma unroll
        for (int i = 0; i < 16; ++i) c[i] = dpp_f<0xB1>(a[i]);
        top16_merge(a, c);
#pragma unroll
        for (int i = 0; i < 16; ++i) c[i] = dpp_f<0x4E>(a[i]);
        top16_merge(a, c);
        if (q == 0) { unsigned* tk = TK + ((tt * 8 + h) * 2 + sd) * 16;
#pragma unroll
          for (int i = 0; i < 4; ++i) *(uint4*)(tk + i * 4) = make_uint4(__float_as_uint(a[i * 4]), __float_as_uint(a[i * 4 + 1]), __float_as_uint(a[i * 4 + 2]), __float_as_uint(a[i * 4 + 3])); }
      }
      __syncthreads();
    }
    {
      const int tid = lv(tid0);
      const int tt = tid >> 3, h = tid & 7;
      const unsigned* t1 = TK + ((tt * 8 + h) * 2) * 16; const unsigned* t2 = t1 + 16;
      float v1[16], v2[16];
#pragma unroll
      for (int i = 0; i < 4; ++i) { const uint4 u = *(const uint4*)(t1 + i * 4), v = *(const uint4*)(t2 + i * 4);
        v1[i * 4] = __uint_as_float(u.x & 0xFFFFFF80u); v1[i * 4 + 1] = __uint_as_float(u.y & 0xFFFFFF80u); v1[i * 4 + 2] = __uint_as_float(u.z & 0xFFFFFF80u); v1[i * 4 + 3] = __uint_as_float(u.w & 0xFFFFFF80u);
        v2[i * 4] = __uint_as_float(v.x & 0xFFFFFF80u); v2[i * 4 + 1] = __uint_as_float(v.y & 0xFFFFFF80u); v2[i * 4 + 2] = __uint_as_float(v.z & 0xFFFFFF80u); v2[i * 4 + 3] = __uint_as_float(v.w & 0xFFFFFF80u); }
      float best[16], grp[16];
#define CAND(i, j) __uint_as_float((__float_as_uint(v1[i] + v2[j]) & 0xFFFFFF00u) | ((i) << 4) | (j))
      best[0] = CAND(0, 0); best[1] = CAND(0, 1); best[2] = CAND(0, 2); best[3] = CAND(0, 3); best[4] = CAND(0, 4); best[5] = CAND(0, 5); best[6] = CAND(0, 6); best[7] = CAND(0, 7);
      best[8] = CAND(0, 8); best[9] = CAND(0, 9); best[10] = CAND(0, 10); best[11] = CAND(0, 11); best[12] = CAND(0, 12); best[13] = CAND(0, 13); best[14] = CAND(0, 14); best[15] = CAND(0, 15);
      sort16_desc(best);
      grp[0] = CAND(1, 0); grp[1] = CAND(1, 1); grp[2] = CAND(1, 2); grp[3] = CAND(1, 3); grp[4] = CAND(1, 4); grp[5] = CAND(1, 5); grp[6] = CAND(1, 6); grp[7] = CAND(1, 7);
      grp[8] = CAND(2, 0); grp[9] = CAND(2, 1); grp[10] = CAND(2, 2); grp[11] = CAND(2, 3); grp[12] = CAND(2, 4); grp[13] = CAND(3, 0); grp[14] = CAND(3, 1); grp[15] = CAND(3, 2);
      sort16_desc(grp); top16_merge(best, grp);
      grp[0] = CAND(3, 3); grp[1] = CAND(4, 0); grp[2] = CAND(4, 1); grp[3] = CAND(4, 2); grp[4] = CAND(5, 0); grp[5] = CAND(5, 1); grp[6] = CAND(6, 0); grp[7] = CAND(6, 1);
      grp[8] = CAND(7, 0); grp[9] = CAND(7, 1); grp[10] = CAND(8, 0); grp[11] = CAND(9, 0); grp[12] = CAND(10, 0); grp[13] = CAND(11, 0); grp[14] = CAND(12, 0); grp[15] = CAND(13, 0);
      sort16_desc(grp); top16_merge(best, grp);
      { const float c14 = CAND(14, 0), c15 = CAND(15, 0);
        grp[0] = fmaxf(c14, c15); grp[1] = fminf(c14, c15);
#pragma unroll
        for (int i = 2; i < 16; ++i) grp[i] = -3.0e38f;
        top16_merge(best, grp); }
#undef CAND
      __syncthreads();
      float sv[16]; int ev[16]; float mx = -3.0e38f;
#pragma unroll
      for (int k = 0; k < 16; ++k) { const unsigned key = __float_as_uint(best[k]); const int ci = (key >> 4) & 15, cj = key & 15;
        const unsigned k1 = t1[ci], k2 = t2[cj];
        sv[k] = __uint_as_float(k1 & 0xFFFFFF80u) + __uint_as_float(k2 & 0xFFFFFF80u); ev[k] = (int)((k1 & 127u) * 128u + (k2 & 127u)); mx = fmaxf(mx, sv[k]); }
      float sum = 0.f;
#pragma unroll
      for (int k = 0; k < 16; ++k) { sv[k] = __expf(sv[k] - mx); sum += sv[k]; }
      const float inv = 1.f / sum;
      unsigned* CNT = (unsigned*)(lds + LDS_CNT); unsigned short* OFFS = (unsigned short*)(lds + LDS_OFF); unsigned* EL = (unsigned*)lds; unsigned short* SE = (unsigned short*)(lds + LDS_SE);
      float scu[16], scv[16];
      { const float* SCU = (const float*)(ws + WS_ESC);
#pragma unroll
        for (int k = 0; k < 16; ++k) { scu[k] = SCU[ev[k]]; scv[k] = SCU[16384 + ev[k]]; } }
      CNT[tid] = 0u; if (GP_N > 8) CNT[tid + 512] = 0u;
      __syncthreads();
      int pos[16];
#pragma unroll
      for (int k = 0; k < 16; ++k) pos[k] = (int)atomicAdd(&CNT[tt * GP_N + (ev[k] >> GP_SH)], 1u);
      __syncthreads();
      if (h == 0) { unsigned run = 0;
#pragma unroll
        for (int q = 0; q < GP_N; ++q) { OFFS[tt * GP_OS + q] = (unsigned short)run; run += CNT[tt * GP_N + q]; }
        OFFS[tt * GP_OS + GP_N] = (unsigned short)run; }
      __syncthreads();
#pragma unroll
      for (int k = 0; k < 16; ++k) { const int d = (int)OFFS[tt * GP_OS + (ev[k] >> GP_SH)] + pos[k];
        EL[tt * 128 + d] = ((__float_as_uint(sv[k] * inv) + 0x2000u) & 0xFFFFC000u) | (unsigned)ev[k];
        SE[tt * 128 + d] = (unsigned short)((((__float_as_uint(scu[k]) >> 23) & 255u) << 8) | ((__float_as_uint(scv[k]) >> 23) & 255u)); }
    }
    __syncthreads();
    {
      const int tid = lv(tid0), lane = tid & 63, w = tid >> 6;
      const unsigned char* EU = ws + WS_EU; const unsigned char* EV = ws + WS_EV;
      unsigned* EL = (unsigned*)lds; const unsigned short* OFFS = (const unsigned short*)(lds + LDS_OFF); unsigned* LIST = (unsigned*)(lds + LDS_LIST) + w * 256; char* H2W = lds + LDS_H2L + w * 8192;
      const unsigned short* SE = (const unsigned short*)(lds + LDS_SE);
      const float* gpf2 = launder(p.in[19]);
      const int rot = (int)(__builtin_amdgcn_s_getreg((3 << 11) | 20) & 0xFu) * (GP_N / 8);
      const unsigned voff = (unsigned)lane * 16u;
      const int sl = lane & 7;
      typedef float f2v __attribute__((ext_vector_type(2))); typedef unsigned u32x4_t __attribute__((ext_vector_type(4)));
#define CVLO(wd) __builtin_amdgcn_cvt_pk_f32_fp8((int)(wd), false)
#define CVHI(wd) __builtin_amdgcn_cvt_pk_f32_fp8((int)(wd), true)
#define BF2(wd) ((f2v){__uint_as_float((wd) << 16), __uint_as_float((wd) & 0xffff0000u)})
#define DPPF(x, CTRL) __int_as_float(__builtin_amdgcn_update_dpp(0, __float_as_int(x), CTRL, 0xF, 0xF, true))
#define R_INIT(R, TAG) do { _Pragma("unroll") for (int k2 = 0; k2 < 8; ++k2) asm volatile("; init " TAG : "=v"(R[k2])); } while (0)
#define EIDX(D) ((row0 + ((D) >> 11)) * 128 + (((D) >> 4) & 127) + (sl < ((D) & 15) ? sl : 0))
#define G_FETCH(DX, PKX, R, TAB, TAG) do { DX = Dn; PKX = PKn; { const int es_ = (int)(PKX & 16383u); const unsigned char* rp_[8]; \
        _Pragma("unroll") for (int k2 = 0; k2 < 8; ++k2) rp_[k2] = TAB + (size_t)(unsigned)__builtin_amdgcn_readlane(es_, k2) * 1024; \
        asm volatile("global_load_dwordx4 %0, %8, %9 ; " TAG "\n\tglobal_load_dwordx4 %1, %8, %10\n\tglobal_load_dwordx4 %2, %8, %11\n\tglobal_load_dwordx4 %3, %8, %12\n\t" \
                     "global_load_dwordx4 %4, %8, %13\n\tglobal_load_dwordx4 %5, %8, %14\n\tglobal_load_dwordx4 %6, %8, %15\n\tglobal_load_dwordx4 %7, %8, %16" \
                     : "+v"(R[0]), "+v"(R[1]), "+v"(R[2]), "+v"(R[3]), "+v"(R[4]), "+v"(R[5]), "+v"(R[6]), "+v"(R[7])     \
                     : "v"(voff), "s"(rp_[0]), "s"(rp_[1]), "s"(rp_[2]), "s"(rp_[3]), "s"(rp_[4]), "s"(rp_[5]), "s"(rp_[6]), "s"(rp_[7])); } \
        Dn = __builtin_amdgcn_readfirstlane((int)tmpL); PKn = EL[EIDX(Dn)]; tmpL = LIST[sidx]; ++sidx; } while (0)
#define G_WAITK(R, k2) asm volatile("s_waitcnt vmcnt(%1)" : "+v"(R[k2]) : "n"(15 - (k2)))
#define G_DRAIN(RA_, RB_) do { asm volatile("s_waitcnt vmcnt(0)" : "+v"(RA_[0]), "+v"(RA_[1]), "+v"(RA_[2]), "+v"(RA_[3]), "+v"(RA_[4]), "+v"(RA_[5]), "+v"(RA_[6]), "+v"(RA_[7])); \
        asm volatile("" : "+v"(RB_[0]), "+v"(RB_[1]), "+v"(RB_[2]), "+v"(RB_[3]), "+v"(RB_[4]), "+v"(RB_[5]), "+v"(RB_[6]), "+v"(RB_[7])); } while (0)
#define U_COMPUTE(D, PK, R) do { if ((D) != 0) { const int n_ = (D) & 15, rr_ = (D) >> 11; \
        const unsigned se_ = (unsigned)SE[EIDX(D)]; \
        if (rr_ != cur) { cur = rr_; const uint4 hA = *(const uint4*)(H2W + rr_ * 2048 + lane * 32), hB = *(const uint4*)(H2W + rr_ * 2048 + lane * 32 + 16); \
          hf2[0] = BF2(hA.x); hf2[1] = BF2(hA.y); hf2[2] = BF2(hA.z); hf2[3] = BF2(hA.w); hf2[4] = BF2(hB.x); hf2[5] = BF2(hB.y); hf2[6] = BF2(hB.z); hf2[7] = BF2(hB.w); } \
        float P[8]; \
        _Pragma("unroll") for (int k2 = 0; k2 < 8; ++k2) { P[k2] = 0.f; \
          if (k2 < n_) { G_WAITK(R, k2); f2v d2 = CVLO(R[k2][0]) * hf2[0]; d2 += CVHI(R[k2][0]) * hf2[1]; d2 += CVLO(R[k2][1]) * hf2[2]; d2 += CVHI(R[k2][1]) * hf2[3]; \
            d2 += CVLO(R[k2][2]) * hf2[4]; d2 += CVHI(R[k2][2]) * hf2[5]; d2 += CVLO(R[k2][3]) * hf2[6]; d2 += CVHI(R[k2][3]) * hf2[7]; P[k2] = d2.x + d2.y; } } \
          \
        _Pragma("unroll") for (int e = 0; e < 4; ++e) { const float a_ = P[e] + DPPF(P[e], 0x141), b_ = P[e + 4] + DPPF(P[e + 4], 0x141); P[e] = (lane & 4) ? b_ : a_; } \
        _Pragma("unroll") for (int e = 0; e < 2; ++e) { const float a_ = P[e] + DPPF(P[e], 0x4E), b_ = P[e + 2] + DPPF(P[e + 2], 0x4E); P[e] = (lane & 2) ? b_ : a_; } \
        float av; { const float a_ = P[0] + DPPF(P[0], 0xB1), b_ = P[1] + DPPF(P[1], 0xB1); av = (lane & 1) ? b_ : a_; } \
        av += DPPF(av, 0x128); \
        { const auto s16 = __builtin_amdgcn_permlane16_swap(__float_as_uint(av), __float_as_uint(av), false, false); av = __uint_as_float(s16[0]) + __uint_as_float(s16[1]); } \
        { const auto s32 = __builtin_amdgcn_permlane32_swap(__float_as_uint(av), __float_as_uint(av), false, false); av = __uint_as_float(s32[0]) + __uint_as_float(s32[1]); } \
        av *= __uint_as_float((se_ >> 8) << 23); \
          \
        const float ax = fabsf(av), t = __builtin_amdgcn_rcpf(ax * 0.2316418882f + 1.0f); \
        float q = t * 0.5307027145f + (-0.7265760135f); q = q * t + 0.7107068705f; q = q * t + (-0.142248368f); q = q * t + 0.127414796f; q = q * t; \
        const float ee = __builtin_amdgcn_exp2f(av * av * (-0.72134752044f)); \
        const float mm = av * (q * ee), gl = (av < 0.f) ? mm : (av - mm); \
        const float wv = __uint_as_float(PK & 0xFFFFC000u) * gl * __uint_as_float((se_ & 255u) << 23); \
        if (lane < n_) EL[EIDX(D)] = ((__float_as_uint(wv) + 0x2000u) & 0xFFFFC000u) | (PK & 16383u); } } while (0)
#define Y_PARK() do { uint4 y0, y1; y0.x = pack2(acc[0].x, acc[0].y); y0.y = pack2(acc[1].x, acc[1].y); y0.z = pack2(acc[2].x, acc[2].y); y0.w = pack2(acc[3].x, acc[3].y); \
        y1.x = pack2(acc[4].x, acc[4].y); y1.y = pack2(acc[5].x, acc[5].y); y1.z = pack2(acc[6].x, acc[6].y); y1.w = pack2(acc[7].x, acc[7].y); \
        *(uint4*)(H2W + cur * 2048 + lane * 32) = y0; *(uint4*)(H2W + cur * 2048 + lane * 32 + 16) = y1; } while (0)
#define V_COMPUTE(D, PK, R) do { if ((D) != 0) { const int n_ = (D) & 15, rr_ = (D) >> 11; \
        if (rr_ != cur) { if (cur >= 0) Y_PARK(); cur = rr_; \
          const uint4 hA = *(const uint4*)(H2W + rr_ * 2048 + lane * 32), hB = *(const uint4*)(H2W + rr_ * 2048 + lane * 32 + 16); \
          acc[0] = BF2(hA.x); acc[1] = BF2(hA.y); acc[2] = BF2(hA.z); acc[3] = BF2(hA.w); acc[4] = BF2(hB.x); acc[5] = BF2(hB.y); acc[6] = BF2(hB.z); acc[7] = BF2(hB.w); } \
        const float wv_ = (sl < n_) ? __uint_as_float(PK & 0xFFFFC000u) : 0.f; \
        _Pragma("unroll") for (int k2 = 0; k2 < 8; ++k2) if (k2 < n_) { const float wk = __int_as_float(__builtin_amdgcn_readlane(__float_as_int(wv_), k2)); const f2v wk2 = {wk, wk}; \
          G_WAITK(R, k2); \
          acc[0] += CVLO(R[k2][0]) * wk2; acc[1] += CVHI(R[k2][0]) * wk2; acc[2] += CVLO(R[k2][1]) * wk2; acc[3] += CVHI(R[k2][1]) * wk2; \
          acc[4] += CVLO(R[k2][2]) * wk2; acc[5] += CVHI(R[k2][2]) * wk2; acc[6] += CVLO(R[k2][3]) * wk2; acc[7] += CVHI(R[k2][3]) * wk2; } } } while (0)
#define G_PROLOGUE() do { Dn = __builtin_amdgcn_readfirstlane((int)LIST[0]); PKn = EL[EIDX(Dn)]; tmpL = LIST[1]; sidx = 2; } while (0)
#pragma unroll 1
      for (int half = 0; half < 2; ++half) {
        const int row0 = half * 32 + w * 4;
        __builtin_amdgcn_wave_barrier(); asm volatile("" ::: "memory");
        { const uint4* src = (const uint4*)(H2 + (size_t)row0 * 1024); uint4 t[8];
#pragma unroll
          for (int i = 0; i < 8; ++i) t[i] = src[lane + 64 * i];
#pragma unroll
          for (int i = 0; i < 8; ++i) ((uint4*)H2W)[lane + 64 * i] = t[i]; }
        int ns;
        {
          const int rr = lane & 3, part = ((lane >> 2) + rot) & (GP_N - 1);
          int o0 = 0, o1 = 0;
          if (lane < 4 * GP_N) { o0 = (int)OFFS[(row0 + rr) * GP_OS + part]; o1 = (int)OFFS[(row0 + rr) * GP_OS + part + 1]; }
          const int nst = (o1 - o0 + 7) >> 3;
          int incl = nst;
#pragma unroll
          for (int d = 1; d < 64; d <<= 1) { const int t = __shfl_up(incl, d); if (lane >= d) incl += t; }
          const int off = incl - nst;
          for (int j = 0; j < nst; ++j) { const int base = o0 + 8 * j; const int nn = (o1 - base < 8) ? (o1 - base) : 8; LIST[off + j] = (unsigned)(nn | (base << 4) | (rr << 11)); }
          ns = __builtin_amdgcn_readlane(incl, 63);
          if (lane < 8) LIST[ns + lane] = 0u; }
        __builtin_amdgcn_wave_barrier(); asm volatile("s_waitcnt vmcnt(0)" ::: "memory");
        {
          int DA, DB, Dn, sidx, cur = -1; unsigned PKA, PKB, PKn, tmpL; u32x4_t RA[8], RB[8]; f2v hf2[8];
          R_INIT(RA, "uA"); R_INIT(RB, "uB");
          G_PROLOGUE(); G_FETCH(DA, PKA, RA, EU, "uA0");
#pragma unroll 1
          for (int s = 0; s < ns; s += 2) {
            G_FETCH(DB, PKB, RB, EU, "uB"); U_COMPUTE(DA, PKA, RA);
            G_FETCH(DA, PKA, RA, EU, "uA"); U_COMPUTE(DB, PKB, RB);
          }
          G_DRAIN(RA, RB);
        }
        __builtin_amdgcn_wave_barrier(); asm volatile("s_waitcnt vmcnt(0)" ::: "memory");
        { const uint4 z4 = make_uint4(0u, 0u, 0u, 0u);
#pragma unroll
          for (int i = 0; i < 8; ++i) ((uint4*)H2W)[lane + 64 * i] = z4; }
        __builtin_amdgcn_wave_barrier(); asm volatile("" ::: "memory");
        {
          int DA, DB, Dn, sidx, cur = -1; unsigned PKA, PKB, PKn, tmpL; u32x4_t RA[8], RB[8]; f2v acc[8];
          R_INIT(RA, "vA"); R_INIT(RB, "vB");
          G_PROLOGUE(); G_FETCH(DA, PKA, RA, EV, "vA0");
#pragma unroll 1
          for (int s = 0; s < ns; s += 2) {
            G_FETCH(DB, PKB, RB, EV, "vB"); V_COMPUTE(DA, PKA, RA);
            G_FETCH(DA, PKA, RA, EV, "vA"); V_COMPUTE(DB, PKB, RB);
          }
          G_DRAIN(RA, RB);
          if (cur >= 0) Y_PARK();
        }
        __builtin_amdgcn_wave_barrier(); asm volatile("s_waitcnt vmcnt(0)" ::: "memory");
#pragma unroll 1
        for (int rr = 0; rr < 4; ++rr) { const size_t tok = tok0 + row0 + rr;
          const uint4 hA = *(const uint4*)(H2W + rr * 2048 + lane * 32), hB = *(const uint4*)(H2W + rr * 2048 + lane * 32 + 16);
          f2v a[8]; a[0] = BF2(hA.x); a[1] = BF2(hA.y); a[2] = BF2(hA.z); a[3] = BF2(hA.w); a[4] = BF2(hB.x); a[5] = BF2(hB.y); a[6] = BF2(hB.z); a[7] = BF2(hB.w);
          float ss = 0.f;
#pragma unroll
          for (int i = 0; i < 8; ++i) ss += a[i].x * a[i].x + a[i].y * a[i].y;
          ss = wave_sum(ss); const float rs = rsqrtf(ss * (1.f / 1024.f) + EPS);
          float* orow = outp + tok * 1024 + lane * 16;
#pragma unroll
          for (int i = 0; i < 4; ++i) { const int d = lane * 16 + 4 * i;
            float4 x1 = *(const float4*)(orow + 4 * i); const float4 g3 = *(const float4*)(gpf2 + d), g2 = *(const float4*)(modb + 5120 + d);
            x1.x += g3.x * g2.x * a[2 * i].x * rs; x1.y += g3.y * g2.y * a[2 * i].y * rs; x1.z += g3.z * g2.z * a[2 * i + 1].x * rs; x1.w += g3.w * g2.w * a[2 * i + 1].y * rs;
            *(float4*)(orow + 4 * i) = x1; }
        }
      }
#undef CVLO
#undef CVHI
#undef BF2
#undef DPPF
#undef R_INIT
#undef EIDX
#undef G_FETCH
#undef G_WAITK
#undef G_DRAIN
#undef U_COMPUTE
#undef Y_PARK
#undef V_COMPUTE
#undef G_PROLOGUE
    }
  }
}

DI void phase2_scan(const KP& p) {
  unsigned char* ws = p.ws;
  for (int g = blockIdx.x * NTHR + threadIdx.x; g < 131072; g += gridDim.x * NTHR) {
    const int seq = g >> 11, within = g & 2047, dv = within >> 4, dk4 = (within & 15) * 4, dir = seq & 1;
    bf16_t* base = (bf16_t*)(ws + WS_SPT) + ((size_t)seq * 32 * 128 + dv) * 64 + dk4;
    const float* dec = (const float*)(ws + WS_DEC) + (size_t)seq * 32 * 64 + dk4;
    float s0 = 0.f, s1 = 0.f, s2 = 0.f, s3 = 0.f;
#pragma unroll 1
    for (int i0 = 0; i0 < 32; i0 += 8) {
      uint2 d[8]; float4 c[8];
#pragma unroll
      for (int j = 0; j < 8; ++j) { const int n = dir ? 31 - (i0 + j) : (i0 + j); d[j] = *(const uint2*)(base + (size_t)n * 8192); c[j] = *(const float4*)(dec + n * 64); }
#pragma unroll
      for (int j = 0; j < 8; ++j) { const int n = dir ? 31 - (i0 + j) : (i0 + j);
        uint2 o; o.x = pack2(s0, s1); o.y = pack2(s2, s3); *(uint2*)(base + (size_t)n * 8192) = o;
        s0 = c[j].x * s0 + __uint_as_float(d[j].x << 16); s1 = c[j].y * s1 + __uint_as_float(d[j].x & 0xffff0000u);
        s2 = c[j].z * s2 + __uint_as_float(d[j].y << 16); s3 = c[j].w * s3 + __uint_as_float(d[j].y & 0xffff0000u); }
    }
  }
}

#define XB_TMO      128
#define XB_XCNT(j)  (256  + 64 * (j))
#define XB_XSUB(j)  (1280 + 64 * (j))
#define XB_XGEN(j)  (2304 + 64 * (j))
#define XB_TOP      3328
#define XB_TOPGEN   3392
#define XCD_BAR_WORDS 3456
#define XB_SPIN_CAP (1u << 18)
#define LAS __attribute__((address_space(3)))

__device__ __forceinline__ unsigned xb_ld(unsigned* p)              { return __hip_atomic_load(p, __ATOMIC_RELAXED, __HIP_MEMORY_SCOPE_AGENT); }
__device__ __forceinline__ unsigned xb_add(unsigned* p, unsigned v) { return __hip_atomic_fetch_add(p, v, __ATOMIC_RELAXED, __HIP_MEMORY_SCOPE_AGENT); }
__device__ __forceinline__ unsigned xb_xcc_id() { return (unsigned)__builtin_amdgcn_s_getreg((3 << 11) | 20) & 0xFu; }
#define XB_SPIN(cond, bar) do { unsigned _sp = 0; while (cond) { __builtin_amdgcn_s_sleep(1); \
    if ((++_sp & 255u) == 0u) { if (xb_ld(&(bar)[XB_TMO])) break; if (_sp > XB_SPIN_CAP) { atomicAdd(&(bar)[XB_TMO], 1u); break; } } } } while (0)

struct XcdBarrier {
    unsigned* bar; unsigned x;
    volatile LAS unsigned* st;
};

__device__ __forceinline__ XcdBarrier xcd_barrier_post(unsigned* bar, volatile LAS unsigned* st) {
    XcdBarrier b; b.bar = bar; b.x = xb_xcc_id(); b.st = st;
    if (threadIdx.x == 0) (void)xb_add(&bar[XB_XCNT(b.x)], 1u);
    return b;
}
__device__ __forceinline__ void xcd_barrier_complete(unsigned* bar, unsigned x, unsigned& nloc, unsigned& nx) {
    const unsigned G = gridDim.x * gridDim.y * gridDim.z;
    unsigned sum, cnt, mine, sp = 0u;
    for (;;) {
        sum = 0u; cnt = 0u; mine = 0u;
#pragma unroll
        for (unsigned j = 0; j < 16; ++j) { const unsigned c = xb_ld(&bar[XB_XCNT(j)]); sum += c; cnt += (c > 0u) ? 1u : 0u; mine = (j == x) ? c : mine; }
        if (sum == G) break;
        __builtin_amdgcn_s_sleep(1);
        if ((++sp & 255u) == 0u) { if (xb_ld(&bar[XB_TMO])) break; if (sp > XB_SPIN_CAP) { atomicAdd(&bar[XB_TMO], 1u); break; } }
    }
    nloc = mine > 0u ? mine : 1u; nx = cnt > 0u ? cnt : 1u;
}

__device__ __forceinline__ void xcd_barrier(const XcdBarrier& b) {
    asm volatile("s_waitcnt vmcnt(0)" ::: "memory");
    __syncthreads();
    if (threadIdx.x == 0) {
        unsigned* bar = b.bar;
        __builtin_amdgcn_s_waitcnt(0);
        unsigned nloc = b.st[0], nx = b.st[1];
        if (nloc == 0u) { xcd_barrier_complete(bar, b.x, nloc, nx); b.st[0] = nloc; b.st[1] = nx; }
        const unsigned old = xb_add(&bar[XB_XSUB(b.x)], 1u);
        const unsigned gen = old / nloc;
        if (old + 1u == (gen + 1u) * nloc) {
            __builtin_amdgcn_fence(__ATOMIC_RELEASE, "agent");
            asm volatile("s_waitcnt vmcnt(0)" ::: "memory");
            const unsigned og = xb_add(&bar[XB_TOP], 1u);
            const unsigned tg = og / nx;
            if (og + 1u == (tg + 1u) * nx) xb_add(&bar[XB_TOPGEN], 1u);
            else XB_SPIN(xb_ld(&bar[XB_TOPGEN]) == tg, bar);
            __builtin_amdgcn_fence(__ATOMIC_ACQUIRE, "agent");
            xb_add(&bar[XB_XGEN(b.x)], 1u);
            asm volatile("s_waitcnt vmcnt(0)" ::: "memory");
        } else {
            XB_SPIN(xb_ld(&bar[XB_XGEN(b.x)]) == gen, bar);
            __builtin_amdgcn_fence(__ATOMIC_ACQUIRE, "agent");
            asm volatile("s_waitcnt vmcnt(0)" ::: "memory");
        }
    }
    __syncthreads();
}

#ifndef PROBE_ID
#define PROBE_ID 0
#endif
__global__ void __launch_bounds__(NTHR, 2) mega(KP p) {
  extern __shared__ __attribute__((aligned(16))) char lds[];
  cg::grid_group grid = cg::this_grid();
  const int hi = p.ph_hi; constexpr int probe = PROBE_ID;
  if (threadIdx.x == 0) { ((volatile LAS unsigned*)(lds + LDS_XB))[0] = 0u; ((volatile LAS unsigned*)(lds + LDS_XB))[1] = 0u; }
  __syncthreads();
  const XcdBarrier xb = xcd_barrier_post((unsigned*)(p.ws + WS_BAR), (volatile LAS unsigned*)(lds + LDS_XB));
  if (p.ph_lo <= 0 && 0 < hi) { phase0(p, lds); if (probe == 1) phase0(p, lds); if (1 < hi) { if (hi > 64) grid.sync(); else xcd_barrier(xb); } }
  if (p.ph_lo <= 1 && 1 < hi) {
    phase1a(p, lds);
    xcd_barrier(xb);
    {
      pg8::Gemm g{(const pg8::bf16_t*)p.out, (const pg8::bf16_t*)(p.ws + WS_WTINP), NTOK, 2304, 1024};
      pg8::StaticOrder S; S.init(NTOK, 2304, (int)gridDim.x, (int)blockIdx.x);
      pg8::EpiProj E{(pg8::bf16_t*)(p.ws + WS_P1S), (pg8::bf16_t*)((unsigned char*)p.out + 32 * MiB), (pg8::bf16_t*)(p.ws + WS_PROJC)};
      pg8::gemm_phase<pg8::EpiProj, pg8::StaticOrder, true, true>((PG8_LAS unsigned char*)lds, g, S, E);
      if (blockIdx.x >= 64) convert_experts(p, (int)blockIdx.x - 64, (int)gridDim.x - 64);
    }
    xcd_barrier(xb);
    phase1c(p, lds);
    if (2 < hi) xcd_barrier(xb);
  }
  if (p.ph_lo <= 2 && 2 < hi) { phase2_scan(p); phase2_attn(p, lds); if (probe == 3) phase2_attn(p, lds); if (3 < hi) xcd_barrier(xb); }
  if (p.ph_lo <= 3 && 3 < hi) {
    phase3(p, lds, 1, probe);
    xcd_barrier(xb);
    {
      pg8::Gemm g{(const pg8::bf16_t*)(p.ws + WS_P1S), (const pg8::bf16_t*)(p.ws + WS_WTOUTP), NTOK, 1024, 1024};
      pg8::StaticOrder S; S.init(NTOK, 1024, (int)gridDim.x, (int)blockIdx.x);
      pg8::EpiBf16<0> E{(pg8::bf16_t*)(p.ws + WS_QM), 1024, nullptr, 0, 0, 1.f};
      pg8::gemm_phase<pg8::EpiBf16<0>, pg8::StaticOrder, true, true>((PG8_LAS unsigned char*)lds, g, S, E);
    }
    xcd_barrier(xb);
    phase3c(p, lds, 1, probe);
    xcd_barrier(xb);
    {
      pg8::Gemm g{(const pg8::bf16_t*)(p.ws + WS_P1S), (const pg8::bf16_t*)(p.ws + WS_WTPQP), NTOK, 2048, 1024};
      pg8::StaticOrder S; S.init(NTOK, 2048, (int)gridDim.x, (int)blockIdx.x);
      pg8::EpiBf16<0> E{(pg8::bf16_t*)(p.ws + WS_QM), 2048, nullptr, 0, 0, 1.f};
      pg8::gemm_phase<pg8::EpiBf16<0>, pg8::StaticOrder, true, true>((PG8_LAS unsigned char*)lds, g, S, E);
    }
    xcd_barrier(xb);
    phase3b(p, lds, (probe == 4 || probe == 8 || probe == 9 || probe == 10) ? 2 : 1, probe);
  }
}

extern "C" void kernel_launch(void* const* d_in, const int* in_sizes, int n_in, void* d_out, int out_size, void* d_ws, size_t ws_size, hipStream_t stream) {
  float* out = (float*)d_out;
  unsigned char* ws = (unsigned char*)d_ws;
  if (ws_size < WS_END || n_in != 25) return;
  static bool attr_done = false;
  if (!attr_done) { (void)hipFuncSetAttribute((const void*)mega, hipFuncAttributeMaxDynamicSharedMemorySize, LDS_TOTAL); attr_done = true; }
  KP p{};
  for (int i = 0; i < 25; ++i) p.in[i] = (const float*)d_in[i];
  p.out = out; p.ws = ws;
  p.ph_lo = 0; p.ph_hi = 4;
  (void)hipMemsetAsync(ws + WS_BAR, 0, XCD_BAR_WORDS * 4, stream);
  { void* args[] = {&p}; (void)hipLaunchCooperativeKernel((const void*)mega, dim3(256), dim3(NTHR), args, LDS_TOTAL, stream); }
}
```

```cpp
#include <hip/hip_runtime.h>
#include <hip/hip_cooperative_groups.h>
namespace cg = cooperative_groups;
#include <stdint.h>

typedef unsigned short bf16_t;
#define DI __device__ __forceinline__

DI float bf2f(bf16_t v) { return __uint_as_float(((unsigned)v) << 16); }
DI bf16_t f2bf(float f) { return __builtin_bit_cast(unsigned short, (__bf16)f); }

constexpr int BATCH = 8, SEQ = 2048, DM = 1024, NTOK = BATCH * SEQ;
constexpr int INW = 2272;
constexpr float EPS = 1e-6f;
constexpr int O_CQ = 0, O_CKV = 384, O_KR = 640, O_QG = 704, O_KG = 960, O_VG = 1216, O_GF = 1728, O_GB = 1744, O_R = 1760;

DI float wave_sum(float v) {
#pragma unroll
  for (int o = 1; o < 64; o <<= 1) v += __shfl_xor(v, o);
  return v;
}
DI float wave_max(float v) {
#pragma unroll
  for (int o = 1; o < 64; o <<= 1) v = fmaxf(v, __shfl_xor(v, o));
  return v;
}
DI float block_sum256(float v, float* red) {
  v = wave_sum(v);
  __syncthreads();
  if ((threadIdx.x & 63) == 0) red[threadIdx.x >> 6] = v;
  __syncthreads();
  return red[0] + red[1] + red[2] + red[3];
}
DI float block_max256(float v, float* red) {
  v = wave_max(v);
  __syncthreads();
  if ((threadIdx.x & 63) == 0) red[threadIdx.x >> 6] = v;
  __syncthreads();
  return fmaxf(fmaxf(red[0], red[1]), fmaxf(red[2], red[3]));
}
DI float silu_f(float x) { return x / (1.f + expf(-x)); }
DI float logsigmoid_f(float x) { return fminf(x, 0.f) - log1pf(expf(-fabsf(x))); }
DI float fexp(float x) { return __builtin_amdgcn_exp2f(x * 1.4426950408889634f); }
DI float silu_fast(float x) { return x * __builtin_amdgcn_rcpf(1.f + fexp(-x)); }
DI float logsigmoid_fast(float x) { return fminf(x, 0.f) - __builtin_amdgcn_logf(1.f + fexp(-fabsf(x))) * 0.6931471805599453f; }
DI float gelu_erf(float x) { return 0.5f * x * (1.f + erff(x * 0.70710678118654752f)); }

__global__ __launch_bounds__(256) void n_mod(const float* __restrict__ c, const float* __restrict__ w_ada, const float* __restrict__ b_ada, float* __restrict__ mod) {
  int idx = blockIdx.x * 256 + threadIdx.x;
  int b = idx / 6144, j = idx % 6144;
  float acc = b_ada[j];
  for (int k = 0; k < 1024; ++k) acc += silu_f(c[b * 1024 + k]) * w_ada[(size_t)k * 6144 + j];
  mod[idx] = acc;
}

__global__ __launch_bounds__(256) void n_hnorm(const float* __restrict__ x, const float* __restrict__ g, const float* __restrict__ mod, int b, int off_sh, int off_sc, float* __restrict__ h) {
  __shared__ float red[4];
  int t = blockIdx.x, tid = threadIdx.x;
  const float* xr = x + ((size_t)b * SEQ + t) * DM;
  float v[4]; float ss = 0.f;
#pragma unroll
  for (int i = 0; i < 4; ++i) { v[i] = xr[tid + 256 * i]; ss += v[i] * v[i]; }
  ss = block_sum256(ss, red);
  float rs = rsqrtf(ss * (1.f / DM) + EPS);
#pragma unroll
  for (int i = 0; i < 4; ++i) { int d = tid + 256 * i; h[(size_t)t * DM + d] = v[i] * rs * g[d] * (1.f + mod[b * 6144 + off_sc + d]) + mod[b * 6144 + off_sh + d]; }
}

template <bool BT>
__global__ __launch_bounds__(256) void n_gemm(const float* __restrict__ A, int lda, const float* __restrict__ B, int ldb, float* __restrict__ C, int ldc, int M, int N, int K) {
  __shared__ float As[16][65];
  __shared__ float Bs[16][65];
  const int tid = threadIdx.x, tx = tid & 15, ty = tid >> 4;
  const int m0 = blockIdx.y * 64, n0 = blockIdx.x * 64;
  float acc[4][4];
#pragma unroll
  for (int i = 0; i < 4; ++i)
#pragma unroll
    for (int j = 0; j < 4; ++j) acc[i][j] = 0.f;
  for (int k0 = 0; k0 < K; k0 += 16) {
#pragma unroll
    for (int i = 0; i < 4; ++i) { int e = tid + 256 * i; int m = e >> 4, k = e & 15; As[k][m] = A[(size_t)(m0 + m) * lda + k0 + k]; }
#pragma unroll
    for (int i = 0; i < 4; ++i) { int e = tid + 256 * i;
      if (!BT) { int k = e >> 6, n = e & 63; Bs[k][n] = (n0 + n < N) ? B[(size_t)(k0 + k) * ldb + n0 + n] : 0.f; }
      else     { int n = e >> 4, k = e & 15; Bs[k][n] = (n0 + n < N) ? B[(size_t)(n0 + n) * ldb + k0 + k] : 0.f; } }
    __syncthreads();
#pragma unroll
    for (int k = 0; k < 16; ++k) {
      float a[4], bb[4];
#pragma unroll
      for (int i = 0; i < 4; ++i) { a[i] = As[k][ty * 4 + i]; bb[i] = Bs[k][tx * 4 + i]; }
#pragma unroll
      for (int i = 0; i < 4; ++i)
#pragma unroll
        for (int j = 0; j < 4; ++j) acc[i][j] += a[i] * bb[j];
    }
    __syncthreads();
  }
#pragma unroll
  for (int i = 0; i < 4; ++i)
#pragma unroll
    for (int j = 0; j < 4; ++j) { int n = n0 + tx * 4 + j; if (n < N) C[(size_t)(m0 + ty * 4 + i) * ldc + n] = acc[i][j]; }
}

__global__ __launch_bounds__(256) void n_rms_slice(const float* __restrict__ in, int ldin, int off, int W, const float* __restrict__ g, float* __restrict__ out) {
  __shared__ float red[4];
  int t = blockIdx.x, tid = threadIdx.x;
  float v0 = (tid < W) ? in[(size_t)t * ldin + off + tid] : 0.f;
  float v1 = (tid + 256 < W) ? in[(size_t)t * ldin + off + tid + 256] : 0.f;
  float ss = block_sum256(v0 * v0 + v1 * v1, red);
  float rs = rsqrtf(ss / (float)W + EPS);
  if (tid < W) out[(size_t)t * W + tid] = v0 * rs * g[tid];
  if (tid + 256 < W) out[(size_t)t * W + tid + 256] = v1 * rs * g[tid + 256];
}

__global__ __launch_bounds__(256) void n_scatter(const float* __restrict__ proj, const float* __restrict__ qa, const float* __restrict__ kv, const int* __restrict__ positions, int b,
                                                 const float* __restrict__ wgf, const float* __restrict__ bgf, const float* __restrict__ wgb, const float* __restrict__ bgb,
                                                 bf16_t* __restrict__ Qm, bf16_t* __restrict__ Km, bf16_t* __restrict__ Vm, bf16_t* __restrict__ qg, bf16_t* __restrict__ kg, bf16_t* __restrict__ vg,
                                                 bf16_t* __restrict__ rg, float* __restrict__ laf, float* __restrict__ lab) {
  __shared__ float cs[32], sn[32];
  const int t = blockIdx.x, tid = threadIdx.x;
  const size_t tok = (size_t)b * SEQ + t;
  const float* pr = proj + (size_t)t * INW;
  const float* qr = qa + (size_t)t * 768;
  const float* kr = kv + (size_t)t * 1024;
  if (tid < 32) {
    float inv = powf(10000.f, -(float)tid / 32.f);
    float ang = (float)positions[tok] * inv;
    cs[tid] = cosf(ang); sn[tid] = sinf(ang);
  }
  __syncthreads();
  for (int e = tid; e < 4 * 192; e += 256) {
    int h = e / 192, d = e % 192; float v;
    if (d < 128) v = qr[h * 192 + d];
    else { int j = d - 128; const float* rp = qr + h * 192 + 128;
      if (j < 32) v = rp[j] * cs[j] - rp[j + 32] * sn[j]; else v = rp[j] * cs[j - 32] + rp[j - 32] * sn[j - 32]; }
    Qm[(((size_t)b * 4 + h) * SEQ + t) * 192 + d] = f2bf(v);
  }
  for (int e = tid; e < 4 * 192; e += 256) {
    int h = e / 192, d = e % 192; float v;
    if (d < 128) v = kr[h * 256 + d];
    else { int j = d - 128; const float* rp = pr + O_KR;
      if (j < 32) v = rp[j] * cs[j] - rp[j + 32] * sn[j]; else v = rp[j] * cs[j - 32] + rp[j - 32] * sn[j - 32]; }
    Km[(((size_t)b * 4 + h) * SEQ + t) * 192 + d] = f2bf(v);
  }
  for (int e = tid; e < 512; e += 256) { int h = e >> 7, d = e & 127; Vm[(((size_t)b * 4 + h) * SEQ + t) * 128 + d] = f2bf(kr[h * 256 + 128 + d]); }
  { int e = tid; qg[tok * 256 + e] = f2bf(pr[O_QG + e] * 0.125f); kg[tok * 256 + e] = f2bf(pr[O_KG + e]); }
  for (int e = tid; e < 512; e += 256) { vg[tok * 512 + e] = f2bf(pr[O_VG + e]); rg[tok * 512 + e] = f2bf(pr[O_R + e]); }
  { int cidx = tid; float af = bgf[cidx], ab = bgb[cidx];
#pragma unroll
    for (int r = 0; r < 16; ++r) { af += pr[O_GF + r] * wgf[r * 256 + cidx]; ab += pr[O_GB + r] * wgb[r * 256 + cidx]; }
    laf[tok * 256 + cidx] = logsigmoid_f(af) * (1.f / 16.f); lab[tok * 256 + cidx] = logsigmoid_f(ab) * (1.f / 16.f); }
}

__global__ __launch_bounds__(256) void n_attn(const bf16_t* __restrict__ Qm, const bf16_t* __restrict__ Km, const bf16_t* __restrict__ Vm, bf16_t* __restrict__ omla) {
  __shared__ float qs[192]; __shared__ float sc[2048]; __shared__ float red[4];
  const int i = blockIdx.x, h = blockIdx.y, b = blockIdx.z, tid = threadIdx.x;
  const size_t bh = (size_t)b * 4 + h;
  if (tid < 192) qs[tid] = bf2f(Qm[(bh * SEQ + i) * 192 + tid]);
  __syncthreads();
  float mx = -1e30f;
  for (int kk = 0; kk < 8; ++kk) {
    int key = tid + 256 * kk; const uint4* kr = (const uint4*)(Km + (bh * SEQ + key) * 192);
    float s = 0.f;
    for (int c = 0; c < 24; ++c) { uint4 w = kr[c]; const float* q = qs + c * 8;
      s += q[0] * __uint_as_float(w.x << 16) + q[1] * __uint_as_float(w.x & 0xffff0000u) + q[2] * __uint_as_float(w.y << 16) + q[3] * __uint_as_float(w.y & 0xffff0000u)
         + q[4] * __uint_as_float(w.z << 16) + q[5] * __uint_as_float(w.z & 0xffff0000u) + q[6] * __uint_as_float(w.w << 16) + q[7] * __uint_as_float(w.w & 0xffff0000u); }
    s *= 0.07216878364870322f; sc[key] = s; mx = fmaxf(mx, s);
  }
  mx = block_max256(mx, red);
  float sum = 0.f;
  for (int kk = 0; kk < 8; ++kk) { int key = tid + 256 * kk; float p = expf(sc[key] - mx); sc[key] = p; sum += p; }
  sum = block_sum256(sum, red);
  __syncthreads();
  if (tid < 128) { float o = 0.f; const bf16_t* vp = Vm + bh * SEQ * 128 + tid;
    for (int key = 0; key < SEQ; ++key) o += sc[key] * bf2f(vp[(size_t)key * 128]);
    omla[((size_t)b * SEQ + i) * 512 + h * 128 + tid] = f2bf(o / sum); }
}

__global__ __launch_bounds__(128) void n_gla(const bf16_t* __restrict__ qg, const bf16_t* __restrict__ kg, const bf16_t* __restrict__ vg, const bf16_t* __restrict__ laf, const bf16_t* __restrict__ lab, float* __restrict__ og) {
  __shared__ float qs[64], ks[64], as[64];
  const int bh = blockIdx.x, b = bh >> 2, h = bh & 3, dv = threadIdx.x;
  for (int dir = 0; dir < 2; ++dir) {
    float S[64];
#pragma unroll
    for (int d = 0; d < 64; ++d) S[d] = 0.f;
    const bf16_t* la = dir ? lab : laf;
    for (int s = 0; s < SEQ; ++s) {
      const int t = dir ? (SEQ - 1 - s) : s; const size_t tok = (size_t)b * SEQ + t;
      __syncthreads();
      if (dv < 64) { qs[dv] = bf2f(qg[tok * 256 + h * 64 + dv]); ks[dv] = bf2f(kg[tok * 256 + h * 64 + dv]); as[dv] = expf(bf2f(la[tok * 256 + h * 64 + dv])); }
      __syncthreads();
      const float v = bf2f(vg[tok * 512 + h * 128 + dv]); float o = 0.f;
#pragma unroll
      for (int d = 0; d < 64; ++d) { S[d] = as[d] * S[d] + ks[d] * v; o += qs[d] * S[d]; }
      if (dir == 0) og[tok * 512 + h * 128 + dv] = o; else og[tok * 512 + h * 128 + dv] += o;
    }
  }
}

__global__ __launch_bounds__(256) void n_mix(const bf16_t* __restrict__ omla, const float* __restrict__ og, const bf16_t* __restrict__ rg, const float* __restrict__ g_gla, int b, float* __restrict__ mix) {
  __shared__ float ssum[4];
  const int t = blockIdx.x, tid = threadIdx.x; const size_t tok = (size_t)b * SEQ + t;
  if (tid < 4) ssum[tid] = 0.f;
  __syncthreads();
  float v[2];
#pragma unroll
  for (int i = 0; i < 2; ++i) { int e = tid + 256 * i; v[i] = og[tok * 512 + e]; atomicAdd(&ssum[e >> 7], v[i] * v[i]); mix[(size_t)t * DM + e] = bf2f(omla[tok * 512 + e]); }
  __syncthreads();
#pragma unroll
  for (int i = 0; i < 2; ++i) { int e = tid + 256 * i; float rs = rsqrtf(ssum[e >> 7] * (1.f / 128.f) + EPS);
    mix[(size_t)t * DM + 512 + e] = v[i] * rs * g_gla[e & 127] * silu_f(bf2f(rg[tok * 512 + e])); }
}

__global__ __launch_bounds__(256) void n_post1(const float* __restrict__ x, const float* __restrict__ y, const float* __restrict__ g_post, const float* __restrict__ g_pre2, const float* __restrict__ mod, int b,
                                               float* __restrict__ out, float* __restrict__ h2) {
  __shared__ float red[4];
  const int t = blockIdx.x, tid = threadIdx.x; const size_t tok = (size_t)b * SEQ + t;
  float yv[4], xv[4]; float ss = 0.f;
#pragma unroll
  for (int i = 0; i < 4; ++i) { yv[i] = y[(size_t)t * DM + tid + 256 * i]; ss += yv[i] * yv[i]; }
  ss = block_sum256(ss, red);
  float rs = rsqrtf(ss * (1.f / DM) + EPS); float s2 = 0.f;
#pragma unroll
  for (int i = 0; i < 4; ++i) { int d = tid + 256 * i; xv[i] = x[tok * DM + d] + mod[b * 6144 + 2048 + d] * (yv[i] * rs * g_post[d]); out[tok * DM + d] = xv[i]; s2 += xv[i] * xv[i]; }
  s2 = block_sum256(s2, red);
  float r2 = rsqrtf(s2 * (1.f / DM) + EPS);
#pragma unroll
  for (int i = 0; i < 4; ++i) { int d = tid + 256 * i; h2[(size_t)t * DM + d] = xv[i] * r2 * g_pre2[d] * (1.f + mod[b * 6144 + 4096 + d]) + mod[b * 6144 + 3072 + d]; }
}

DI void wave_argmax(float& v, int& i) {
#pragma unroll
  for (int o = 1; o < 64; o <<= 1) { float ov = __shfl_xor(v, o); int oi = __shfl_xor(i, o); if (ov > v || (ov == v && oi < i)) { v = ov; i = oi; } }
}
__global__ __launch_bounds__(256) void n_peer_select(const float* __restrict__ qry, const float* __restrict__ sk1, const float* __restrict__ sk2, int* __restrict__ eidx, float* __restrict__ gate) {
  __shared__ float v1s[4][16], v2s[4][16]; __shared__ int i1s[4][16], i2s[4][16];
  const int w = threadIdx.x >> 6, lane = threadIdx.x & 63;
  const int pair = blockIdx.x * 4 + w;
  const int t = pair >> 3, h = pair & 7;
  const float* q1 = qry + (size_t)t * 2048 + h * 256; const float* q2 = q1 + 128;
  float s1a = 0.f, s1b = 0.f, s2a = 0.f, s2b = 0.f;
  for (int d = 0; d < 128; ++d) { float a = q1[d], bq = q2[d];
    s1a += a * sk1[lane * 128 + d]; s1b += a * sk1[(lane + 64) * 128 + d]; s2a += bq * sk2[lane * 128 + d]; s2b += bq * sk2[(lane + 64) * 128 + d]; }
  for (int side = 0; side < 2; ++side) {
    float va = side ? s2a : s1a, vb = side ? s2b : s1b; bool ta = false, tb = false;
    for (int k = 0; k < 16; ++k) {
      float bv; int bi;
      if (!ta && (tb || va >= vb)) { bv = va; bi = lane; } else if (!tb) { bv = vb; bi = lane + 64; } else { bv = -3e38f; bi = 1 << 20; }
      wave_argmax(bv, bi);
      if (bi == lane) ta = true; if (bi == lane + 64) tb = true;
      if (lane == 0) { if (side) { v2s[w][k] = bv; i2s[w][k] = bi; } else { v1s[w][k] = bv; i1s[w][k] = bi; } }
    }
  }
  __syncthreads();
  float cv[4]; bool tk[4];
#pragma unroll
  for (int j = 0; j < 4; ++j) { int c = lane + 64 * j; cv[j] = v1s[w][c >> 4] + v2s[w][c & 15]; tk[j] = false; }
  float topv = 0.f; int topc = 0; float mx = 0.f;
  for (int k = 0; k < 16; ++k) {
    float bv = -3e38f; int bi = 1 << 20;
#pragma unroll
    for (int j = 0; j < 4; ++j) { if (!tk[j] && cv[j] > bv) { bv = cv[j]; bi = lane + 64 * j; } }
    wave_argmax(bv, bi);
#pragma unroll
    for (int j = 0; j < 4; ++j) if (bi == lane + 64 * j) tk[j] = true;
    if (k == 0) mx = bv;
    if (lane == k) { topv = bv; topc = bi; }
  }
  float e = (lane < 16) ? expf(topv - mx) : 0.f;
  float sum = wave_sum(e);
  if (lane < 16) { eidx[(size_t)pair * 16 + lane] = i1s[w][topc >> 4] * 128 + i2s[w][topc & 15]; gate[(size_t)pair * 16 + lane] = e / sum; }
}

__global__ __launch_bounds__(256) void n_peer_apply(const float* __restrict__ h2, const int* __restrict__ eidx, const float* __restrict__ gate, const float* __restrict__ eu, const float* __restrict__ ev,
                                                    const float* __restrict__ g_post, const float* __restrict__ mod, int b, float* __restrict__ out) {
  __shared__ float ys[4][1024]; __shared__ float red[4];
  const int t = blockIdx.x, tid = threadIdx.x, w = tid >> 6, lane = tid & 63; const size_t tok = (size_t)b * SEQ + t;
  float4 hx[4];
#pragma unroll
  for (int i = 0; i < 4; ++i) hx[i] = *(const float4*)(h2 + (size_t)t * DM + (lane + 64 * i) * 4);
  float4 acc[4];
#pragma unroll
  for (int i = 0; i < 4; ++i) acc[i] = make_float4(0.f, 0.f, 0.f, 0.f);
  for (int k = w; k < 128; k += 4) {
    const int e = eidx[(size_t)t * 128 + k]; const float gt = gate[(size_t)t * 128 + k];
    const float4* ur = (const float4*)(eu + (size_t)e * DM); const float4* vr = (const float4*)(ev + (size_t)e * DM);
    float d = 0.f;
#pragma unroll
    for (int i = 0; i < 4; ++i) { float4 u = ur[lane + 64 * i]; d += u.x * hx[i].x + u.y * hx[i].y + u.z * hx[i].z + u.w * hx[i].w; }
    d = wave_sum(d);
    const float wgt = gt * gelu_erf(d);
#pragma unroll
    for (int i = 0; i < 4; ++i) { float4 v = vr[lane + 64 * i]; acc[i].x += wgt * v.x; acc[i].y += wgt * v.y; acc[i].z += wgt * v.z; acc[i].w += wgt * v.w; }
  }
#pragma unroll
  for (int i = 0; i < 4; ++i) *(float4*)(&ys[w][(lane + 64 * i) * 4]) = acc[i];
  __syncthreads();
  float yv[4]; float ss = 0.f;
#pragma unroll
  for (int i = 0; i < 4; ++i) { int d = tid + 256 * i; yv[i] = ys[0][d] + ys[1][d] + ys[2][d] + ys[3][d]; ss += yv[i] * yv[i]; }
  ss = block_sum256(ss, red);
  const float rs = rsqrtf(ss * (1.f / DM) + EPS);
#pragma unroll
  for (int i = 0; i < 4; ++i) { int d = tid + 256 * i; out[tok * DM + d] = out[tok * DM + d] + mod[b * 6144 + 5120 + d] * (yv[i] * rs * g_post[d]); }
}

typedef short bf16x8 __attribute__((ext_vector_type(8)));
typedef float f32x16 __attribute__((ext_vector_type(16)));
#define MFMA32(a, b, c) __builtin_amdgcn_mfma_f32_32x32x16_bf16((a), (b), (c), 0, 0, 0)

constexpr int NTHR = 512;
constexpr size_t MiB = 1024 * 1024;
constexpr size_t WS_MOD   = 0;
constexpr size_t WS_WTIN  = 256 * 1024;
constexpr size_t WS_WTQUP = WS_WTIN + (size_t)2304 * 1024 * 2;
constexpr size_t WS_WTKVUP = WS_WTQUP + (size_t)768 * 384 * 2;
constexpr size_t WS_WTOUT = WS_WTKVUP + (size_t)1024 * 256 * 2;
constexpr size_t WS_WTPQ  = WS_WTOUT + (size_t)1024 * 1024 * 2;
constexpr size_t WS_KD    = WS_WTPQ + (size_t)2048 * 1024 * 2;
constexpr size_t WS_DEC   = WS_KD + (size_t)256 * 256 * 2;
constexpr size_t WS_ESC   = WS_DEC + (size_t)2048 * 64 * 4;
constexpr size_t WS_R0END = WS_ESC + (size_t)2 * 16384 * 4;
static_assert(WS_R0END <= 13 * MiB, "R0");
constexpr size_t WS_BAR  = 13 * MiB - 65536;
static_assert(WS_R0END + 131072 <= WS_BAR, "R0 room");
constexpr size_t WS_QM   = 13 * MiB;
constexpr size_t WS_KM   = WS_QM + 24 * MiB;
constexpr size_t WS_VM   = WS_KM + 24 * MiB;
constexpr size_t WS_P1S  = WS_VM + 16 * MiB;
constexpr size_t WS_RG   = WS_P1S + 32 * MiB;
constexpr size_t WS_OINTRA = WS_RG + 16 * MiB;
constexpr size_t WS_QDEC = WS_OINTRA + 16 * MiB;
constexpr size_t WS_SPT  = WS_QDEC + 16 * MiB;
constexpr size_t WS_EU   = WS_SPT + 32 * MiB;
constexpr size_t WS_EV   = WS_EU + 16 * MiB;
constexpr size_t WS_WTPQP = WS_EV + 16 * MiB;
constexpr size_t WS_WTOUTP = WS_WTPQP + 4 * MiB;
constexpr size_t WS_WTINP = WS_WTOUTP + 2 * MiB;
constexpr size_t WS_PROJC = WS_WTINP + 4608 * 1024;
constexpr size_t WS_END  = WS_PROJC + 8 * MiB;
static_assert(WS_P1S == WS_QM + 64 * MiB, "P3 QRY scratch aliases QM..VM");
constexpr size_t OUT_HS  = 0;
constexpr size_t OUT_CQ  = 32 * MiB;
constexpr size_t OUT_GR  = 52 * MiB;

struct KP { const float* in[25]; float* out; unsigned char* ws; int ph_lo, ph_hi; };

constexpr int G_STG = 40960;
constexpr int LDS_WT = 3 * G_STG;
constexpr int LDS_TAB = LDS_WT + 18432;
constexpr int LDS_XB = 157696;
constexpr int LDS_TOTAL = 157696 + 16;

typedef float f32x2_t __attribute__((ext_vector_type(2)));
typedef __bf16 bf16x2_t __attribute__((ext_vector_type(2)));
DI unsigned pack2(float lo, float hi) { const f32x2_t v = {lo, hi}; return __builtin_bit_cast(unsigned, __builtin_convertvector(v, bf16x2_t)); }
DI int crow(int reg, int hh) { return (reg & 3) + 8 * (reg >> 2) + 4 * hh; }

#define GLDS16(gp, lp) __builtin_amdgcn_global_load_lds((const unsigned*)(gp), (__attribute__((address_space(3))) unsigned*)(lp), 16, 0, 0)
template <int NST, class Epi>
DI void block_gemm(char* lds, const bf16_t* A, int lda, const bf16_t* Bt, int nchunks, int K, Epi&& epi) {
  const int tid = threadIdx.x, lane = tid & 63, w = __builtin_amdgcn_readfirstlane(tid >> 6), r = lane & 31, hh = lane >> 5;
  const int nk = K >> 6, T = nchunks * nk;
  constexpr int D = NST - 1;
  if (w >= 4) {
    const int j = w - 4, rin = lane >> 3, sw = ((lane & 7) ^ rin) * 8;
    const bf16_t* Ap = A + (size_t)(16 * j + rin) * lda + sw;
    const bf16_t* Bp = Bt + (size_t)(64 * j + rin) * 64 + sw;
    auto dma = [&](int g) {
      const int ch = g / nk, t = g - ch * nk; char* st = lds + (g % NST) * G_STG;
      const bf16_t* a0 = Ap + t * 64; char* la = st + (2 * j) * 1024;
      GLDS16(a0, la); GLDS16(a0 + (size_t)8 * lda, la + 1024);
      const bf16_t* b0 = Bp + (size_t)g * 16384; char* lb = st + 8192 + (8 * j) * 1024;
#pragma unroll
      for (int i = 0; i < 8; ++i) GLDS16(b0 + i * 512, lb + i * 1024);
    };
#pragma unroll
    for (int g = 0; g < D; ++g) if (g < T) dma(g);
    if (D >= 2 && T >= 2) asm volatile("s_waitcnt vmcnt(10)" ::: "memory"); else asm volatile("s_waitcnt vmcnt(0)" ::: "memory");
    __builtin_amdgcn_s_barrier();
#pragma unroll 1
    for (int g = 0; g < T; ++g) {
      if (g + D < T) { dma(g + D); if (D >= 2) asm volatile("s_waitcnt vmcnt(10)" ::: "memory"); else asm volatile("s_waitcnt vmcnt(0)" ::: "memory"); }
      else asm volatile("s_waitcnt vmcnt(0)" ::: "memory");
      __builtin_amdgcn_s_barrier();
    }
  } else {
    const int x = r & 7;
    const int o0 = ((0 + hh) ^ x) * 16, o1 = ((2 + hh) ^ x) * 16, o2 = ((4 + hh) ^ x) * 16, o3 = ((6 + hh) ^ x) * 16;
    const int a_rd = r * 128, b_rd = 8192 + (w * 64 + r) * 128;
    __builtin_amdgcn_s_barrier();
    int g = 0;
#pragma unroll 1
    for (int ch = 0; ch < nchunks; ++ch) {
      f32x16 c00, c01, c10, c11;
#pragma unroll
      for (int i = 0; i < 16; ++i) { c00[i] = 0.f; c01[i] = 0.f; c10[i] = 0.f; c11[i] = 0.f; }
#pragma unroll 1
      for (int t = 0; t < nk; ++t, ++g) {
        const char* cur = lds + (g % NST) * G_STG;
        bf16x8 fa0[4], fa1[4], fb0[4], fb1[4];
#define FRD(s_, o_) do { fa0[s_] = *(const bf16x8*)(cur + a_rd + o_); fb0[s_] = *(const bf16x8*)(cur + b_rd + o_); fb1[s_] = *(const bf16x8*)(cur + b_rd + 4096 + o_); fa1[s_] = *(const bf16x8*)(cur + a_rd + 4096 + o_); } while (0)
        FRD(0, o0); FRD(1, o1); FRD(2, o2); FRD(3, o3);
#undef FRD
        asm volatile("s_waitcnt lgkmcnt(0)" ::: "memory");
        __builtin_amdgcn_s_barrier();
        __builtin_amdgcn_sched_barrier(0);
#pragma unroll
        for (int s = 0; s < 4; ++s) {
          c00 = MFMA32(fa0[s], fb0[s], c00); c01 = MFMA32(fa0[s], fb1[s], c01); c10 = MFMA32(fa1[s], fb0[s], c10); c11 = MFMA32(fa1[s], fb1[s], c11); }
      }
      epi(0, ch * 256 + w * 64, c00, c01);
      epi(32, ch * 256 + w * 64, c10, c11);
    }
  }
}

DI void p0_transpose(char* lds, const float* __restrict__ W, int K, int N, bf16_t* __restrict__ Wt, int item, bf16_t* __restrict__ Wplain = nullptr) {
  float* s = (float*)lds;
  const int tid = threadIdx.x;
  const int ntn = (N + 63) >> 6, kt = item / ntn, nt = item % ntn, k0 = kt * 64, n0 = nt * 64;
  __syncthreads();
#pragma unroll
  for (int i = 0; i < 8; ++i) { int e = tid + 512 * i; int kk = e >> 6, nn = e & 63; s[kk * 65 + nn] = (n0 + nn < N) ? W[(size_t)(k0 + kk) * N + n0 + nn] : 0.f; }
  __syncthreads();
  const int nn = tid >> 3, part = tid & 7;
  const float* sp = s + (part * 8) * 65 + nn;
  uint4 o; o.x = pack2(sp[0], sp[65]); o.y = pack2(sp[2 * 65], sp[3 * 65]); o.z = pack2(sp[4 * 65], sp[5 * 65]); o.w = pack2(sp[6 * 65], sp[7 * 65]);
  { const int n = n0 + nn; *(uint4*)(Wt + ((size_t)((n >> 8) * (K >> 6) + kt)) * 16384 + (n & 255) * 64 + part * 8) = o; }
  if (Wplain) *(uint4*)(Wplain + (size_t)(n0 + nn) * K + k0 + part * 8) = o;
}

DI void convert_experts(const KP& p, const int bid, const int nb) {
  const int tid = threadIdx.x; unsigned char* ws = p.ws;
  { const int lane = tid & 63; float* scl = (float*)(ws + WS_ESC);
    for (int row = bid * 8 + (tid >> 6); row < 32768; row += nb * 8) { const int t = row >> 14, e = row & 16383;
      const float* src = p.in[23 + t] + (size_t)e * 1024 + lane * 16;
      float4 x[4]; float am = 0.f;
#pragma unroll
      for (int i = 0; i < 4; ++i) { x[i] = *(const float4*)(src + 4 * i); am = fmaxf(am, fmaxf(fmaxf(fabsf(x[i].x), fabsf(x[i].y)), fmaxf(fabsf(x[i].z), fabsf(x[i].w)))); }
      am = wave_max(am);
      float sc = 1.f, isc = 1.f;
      if (am > 0.f) { int ex; (void)frexpf(448.f / am, &ex); sc = ldexpf(1.f, ex - 1); isc = ldexpf(1.f, 1 - ex); }
      unsigned wv[4];
#pragma unroll
      for (int i = 0; i < 4; ++i) { int q = __builtin_amdgcn_cvt_pk_fp8_f32(x[i].x * sc, x[i].y * sc, 0, false); q = __builtin_amdgcn_cvt_pk_fp8_f32(x[i].z * sc, x[i].w * sc, q, true); wv[i] = (unsigned)q; }
      *(uint4*)(ws + (t ? WS_EV : WS_EU) + (size_t)e * 1024 + lane * 16) = make_uint4(wv[0], wv[1], wv[2], wv[3]);
      if (lane == 0) scl[t * 16384 + e] = isc; } }
}

DI void phase0(const KP& p, char* lds) {
  const int tid = threadIdx.x, bid = blockIdx.x, nb = gridDim.x;
  unsigned char* ws = p.ws;
  constexpr int I_IN = 16 * 36, I_QUP = 6 * 12, I_KVUP = 4 * 16, I_OUT = 16 * 16, I_PQ = 16 * 32;
  constexpr int I_ALL = I_IN + I_QUP + I_KVUP + I_OUT + I_PQ;
  const int nlow = nb > 96 ? 96 : 0, quota = 2;
  const int it0 = bid < nlow ? bid : nlow * quota + (bid - nlow), itstep = bid < nlow ? nlow : nb - nlow, itend = bid < nlow ? nlow * quota : I_ALL;
  for (int it = it0; it < itend; it += itstep) {
    int q = it;
    if (q < I_IN) { p0_transpose(lds, p.in[7], 1024, 2272, (bf16_t*)(ws + WS_WTIN), q, (bf16_t*)(ws + WS_WTINP)); continue; } q -= I_IN;
    if (q < I_QUP) { p0_transpose(lds, p.in[9], 384, 768, (bf16_t*)(ws + WS_WTQUP), q); continue; } q -= I_QUP;
    if (q < I_KVUP) { p0_transpose(lds, p.in[11], 256, 1024, (bf16_t*)(ws + WS_WTKVUP), q); continue; } q -= I_KVUP;
    if (q < I_OUT) { p0_transpose(lds, p.in[17], 1024, 1024, (bf16_t*)(ws + WS_WTOUT), q, (bf16_t*)(ws + WS_WTOUTP)); continue; } q -= I_OUT;
    p0_transpose(lds, p.in[20], 1024, 2048, (bf16_t*)(ws + WS_WTPQ), q, (bf16_t*)(ws + WS_WTPQP));
  }
  { bf16_t* kd = (bf16_t*)(ws + WS_KD);
    for (int e = bid * NTHR + tid; e < 65536; e += nb * NTHR) { int n = e >> 8, k = e & 255; float v = 0.f;
      if (n < 128 && k < 128) v = p.in[21][n * 128 + k]; else if (n >= 128 && k >= 128) v = p.in[22][(n - 128) * 128 + (k - 128)];
      kd[(size_t)(k >> 6) * 16384 + n * 64 + (k & 63)] = f2bf(v); } }
  for (int jb = bid; jb < 96; jb += nb) {
    __syncthreads();
    float* cact = (float*)lds;
    float* red = (float*)(lds + 32768);
    for (int e = tid; e < 8192; e += NTHR) cact[e] = silu_f(p.in[1][e]);
    __syncthreads();
    const int jj = tid & 63, ks = tid >> 6, j0 = jb * 64;
    float acc[8];
#pragma unroll
    for (int b = 0; b < 8; ++b) acc[b] = 0.f;
    const float* wp = p.in[3] + (size_t)(ks * 128) * 6144 + j0 + jj;
    for (int k = 0; k < 128; ++k) { const float wv = wp[(size_t)k * 6144];
#pragma unroll
      for (int b = 0; b < 8; ++b) acc[b] += cact[b * 1024 + ks * 128 + k] * wv; }
#pragma unroll
    for (int b = 0; b < 8; ++b) red[(ks * 64 + jj) * 8 + b] = acc[b];
    __syncthreads();
    { const int b = tid >> 6; float sacc = p.in[4][j0 + jj];
#pragma unroll
      for (int k2 = 0; k2 < 8; ++k2) sacc += red[(k2 * 64 + jj) * 8 + b];
      ((float*)(ws + WS_MOD))[b * 6144 + j0 + jj] = sacc; }
  }
}

constexpr int WT_STRIDE = 144, WT_BYTES = 32 * WT_STRIDE;
DI void wt_write(char* wl, const f32x16& a0, const f32x16& a1, int r, int hh, float scale) {
  char* bp = wl + (4 * hh) * WT_STRIDE + r * 2;
#pragma unroll
  for (int reg = 0; reg < 16; ++reg) { const int ro = ((reg & 3) + 8 * (reg >> 2)) * WT_STRIDE;
    *(bf16_t*)(bp + ro) = f2bf(a0[reg] * scale); *(bf16_t*)(bp + ro + 64) = f2bf(a1[reg] * scale); }
}
DI void wt_write_rope(char* wl, const f32x16& a0, const f32x16& a1, int r, int hh, const float* cs, const float* sn, int m0) {
  char* bp = wl + (4 * hh) * WT_STRIDE + r * 2;
#pragma unroll
  for (int reg = 0; reg < 16; ++reg) { const int rw = (reg & 3) + 8 * (reg >> 2); const int row = m0 + rw + 4 * hh;
    const float c = cs[row * 32 + r], s = sn[row * 32 + r];
    *(bf16_t*)(bp + rw * WT_STRIDE) = f2bf(a0[reg] * c - a1[reg] * s); *(bf16_t*)(bp + rw * WT_STRIDE + 64) = f2bf(a1[reg] * c + a0[reg] * s); }
}
DI void wt_store(const char* wl, int lane, bf16_t* dA, int sA, bf16_t* dB, int sB) {
  const int piece = lane & 7, rsub = lane >> 3;
  bf16_t* d = (piece < 4) ? dA : dB; const int st = (piece < 4) ? sA : sB;
  if (d) {
#pragma unroll
    for (int i = 0; i < 4; ++i) { const int row = i * 8 + rsub; const uint4 v = *(const uint4*)(wl + row * WT_STRIDE + piece * 16);
      *(uint4*)(d + (size_t)row * st + (piece & 3) * 8) = v; }
  }
}
#define LDS_FENCE() asm volatile("s_waitcnt lgkmcnt(0)" ::: "memory")
DI int lv(int x) { asm volatile("" : "+v"(x)); return x; }
template <class T> DI T* launder(T* q) { size_t z = 0; asm volatile("" : "+s"(z)); return (T*)((char*)q + z); }

constexpr int GL_GR = 0, GL_VT = 8192, GL_QD = 26624, GL_KI = 45056, GL_KIT = 63488, GL_ATT = 81920, GL_TOT = 91136, GL_DEC = 93184, GL_LA = 93696  , GL_QS = 126464  , GL_KS = 134656;
DI void gla_chunk_local(const KP& p, char* lds, unsigned char* ws, int tile, const bf16_t* PA, const bf16_t* PB) {
  const int tid = lv(threadIdx.x), lane = tid & 63, w = tid >> 6, r = lane & 31, hh = lane >> 5;
  const int b = tile >> 5, n = tile & 31, tok0 = tile * 64;
  float* GRL = (float*)(lds + GL_GR); float* TOT = (float*)(lds + GL_TOT); float* DECL = (float*)(lds + GL_DEC);
  __syncthreads();
#pragma unroll
  for (int i = 0; i < 4; ++i) { const int e = tid + 512 * i; GRL[e] = bf2f(PB[(size_t)(e >> 5) * 1024 + (O_GF - 1024) + (e & 31)]); }
#pragma unroll 1
  for (int h = 0; h < 4; ++h) {
    __syncthreads();
    { const int t = tid >> 3, c8 = (tid & 7) * 8;
      *(uint4*)(lds + GL_QS + (t * 64 + c8) * 2) = *(const uint4*)(PA + (size_t)t * 1024 + O_QG + h * 64 + c8);
      *(uint4*)(lds + GL_KS + (t * 64 + c8) * 2) = (h == 0) ? *(const uint4*)(PA + (size_t)t * 1024 + O_KG + c8) : *(const uint4*)(PB + (size_t)t * 1024 + (O_KG - 1024) + h * 64 + c8); }
#pragma unroll
    for (int i = 0; i < 2; ++i) { const int c = tid + 512 * i, t = c >> 4, d8 = (c & 15) * 8;
      const uint4 v = *(const uint4*)(PB + (size_t)t * 1024 + (O_VG - 1024) + h * 128 + d8);
      bf16_t* vt = (bf16_t*)(lds + GL_VT) + d8 * 72 + t;
      vt[0] = (bf16_t)(v.x & 0xffffu); vt[72] = (bf16_t)(v.x >> 16); vt[144] = (bf16_t)(v.y & 0xffffu); vt[216] = (bf16_t)(v.y >> 16);
      vt[288] = (bf16_t)(v.z & 0xffffu); vt[360] = (bf16_t)(v.z >> 16); vt[432] = (bf16_t)(v.w & 0xffffu); vt[504] = (bf16_t)(v.w >> 16); }
    const int dir = tid >> 8, qt = (tid >> 6) & 3, dk = tid & 63, col = h * 64 + dk;
    float* LAL = (float*)(lds + GL_LA) + tid;
    {
      const float* wg = launder(dir ? p.in[14] : p.in[12]); const float* bg = launder(dir ? p.in[15] : p.in[13]);
      float wr[16];
#pragma unroll
      for (int q = 0; q < 16; ++q) wr[q] = wg[q * 256 + col];
      const float bias = bg[col];
      float run = 0.f;
#pragma unroll 2
      for (int ii = 0; ii < 16; ++ii) { const int i = dir ? 15 - ii : ii;
        const float* gp = GRL + (qt * 16 + i) * 32 + dir * 16; float x = bias;
#pragma unroll
        for (int q = 0; q < 16; ++q) x += gp[q] * wr[q];
        run += logsigmoid_fast(x) * (1.f / 16.f); LAL[i * 512] = run; }
      TOT[(dir * 64 + dk) * 4 + qt] = run;
    }
    __syncthreads();
    {
      const float4 tq = *(const float4*)(TOT + (dir * 64 + dk) * 4);
      const float total = (tq.x + tq.y) + (tq.z + tq.w);
      float off;
      if (dir == 0) off = (qt > 0 ? tq.x : 0.f) + (qt > 1 ? tq.y : 0.f) + (qt > 2 ? tq.z : 0.f);
      else          off = (qt < 1 ? tq.y : 0.f) + (qt < 2 ? tq.z : 0.f) + (qt < 3 ? tq.w : 0.f);
      if (qt == 0) { const float dc = fexp(total); DECL[dir * 64 + dk] = dc; ((float*)(ws + WS_DEC))[((size_t)((b * 4 + h) * 2 + dir) * 32 + n) * 64 + dk] = dc; }
      bf16_t* QD = (bf16_t*)(lds + GL_QD + dir * 9216) + (qt * 16) * 72 + dk; bf16_t* KI = (bf16_t*)(lds + GL_KI + dir * 9216) + (qt * 16) * 72 + dk;
      bf16_t* KIT = (bf16_t*)(lds + GL_KIT + dir * 9216) + dk * 72 + qt * 16;
      bf16_t* qdg = (bf16_t*)(ws + WS_QDEC) + (size_t)((tile * 4 + h) * 2 + dir) * 4096 + (qt * 16) * 64 + dk;
      const bf16_t* qgp = (const bf16_t*)(lds + GL_QS) + (qt * 16) * 64 + dk; const bf16_t* kgp = (const bf16_t*)(lds + GL_KS) + (qt * 16) * 64 + dk;
#pragma unroll 2
      for (int i = 0; i < 16; ++i) { const float bb = off + LAL[i * 512];
        const float qv = bf2f(qgp[i * 64]) * 0.125f, kv = bf2f(kgp[i * 64]);
        const float eb = fexp(bb); const bf16_t qd = f2bf(qv * eb), ki = f2bf(kv * __builtin_amdgcn_rcpf(eb));
        QD[i * 72] = qd; KI[i * 72] = ki; qdg[i * 64] = qd; KIT[i] = ki; }
    }
    __syncthreads();
    if (w < 4) { const int mi = w >> 1, ni = w & 1;
      f32x16 asum;
#pragma unroll
      for (int i = 0; i < 16; ++i) asum[i] = 0.f;
#pragma unroll
      for (int d = 0; d < 2; ++d) { f32x16 acc;
#pragma unroll
        for (int i = 0; i < 16; ++i) acc[i] = 0.f;
#pragma unroll
        for (int s = 0; s < 4; ++s) { const bf16x8 a = *(const bf16x8*)(lds + GL_QD + d * 9216 + (mi * 32 + r) * 144 + s * 32 + hh * 16);
          const bf16x8 bb = *(const bf16x8*)(lds + GL_KI + d * 9216 + (ni * 32 + r) * 144 + s * 32 + hh * 16); acc = MFMA32(a, bb, acc); }
#pragma unroll
        for (int reg = 0; reg < 16; ++reg) { const int ti = mi * 32 + crow(reg, hh), tj = ni * 32 + r; const bool keep = d ? (tj >= ti) : (tj <= ti); asum[reg] += keep ? acc[reg] : 0.f; } }
      bf16_t* at = (bf16_t*)(lds + GL_ATT) + (mi * 32 + 4 * hh) * 72 + ni * 32 + r;
#pragma unroll
      for (int reg = 0; reg < 16; ++reg) at[((reg & 3) + 8 * (reg >> 2)) * 72] = f2bf(asum[reg]);
    }
    __syncthreads();
    { const int mi = w >> 2, ni = w & 3; f32x16 acc;
#pragma unroll
      for (int i = 0; i < 16; ++i) acc[i] = 0.f;
#pragma unroll
      for (int s = 0; s < 4; ++s) { const bf16x8 a = *(const bf16x8*)(lds + GL_ATT + (mi * 32 + r) * 144 + s * 32 + hh * 16);
        const bf16x8 bb = *(const bf16x8*)(lds + GL_VT + (ni * 32 + r) * 144 + s * 32 + hh * 16); acc = MFMA32(a, bb, acc); }
      bf16_t* oi = (bf16_t*)(ws + WS_OINTRA) + (size_t)(tok0 + mi * 32 + 4 * hh) * 512 + h * 128 + ni * 32 + r;
#pragma unroll
      for (int reg = 0; reg < 16; ++reg) oi[(size_t)((reg & 3) + 8 * (reg >> 2)) * 512] = f2bf(acc[reg]); }
    { const int dvb = w >> 1, dkb = w & 1;
#pragma unroll
      for (int d = 0; d < 2; ++d) { f32x16 acc;
#pragma unroll
        for (int i = 0; i < 16; ++i) acc[i] = 0.f;
#pragma unroll
        for (int s = 0; s < 4; ++s) { const bf16x8 a = *(const bf16x8*)(lds + GL_VT + (dvb * 32 + r) * 144 + s * 32 + hh * 16);
          const bf16x8 bb = *(const bf16x8*)(lds + GL_KIT + d * 9216 + (dkb * 32 + r) * 144 + s * 32 + hh * 16); acc = MFMA32(a, bb, acc); }
        const float sc = DECL[d * 64 + dkb * 32 + r];
        bf16_t* ds = (bf16_t*)(ws + WS_SPT) + ((size_t)((b * 4 + h) * 2 + d) * 32 + n) * 8192 + (size_t)(dvb * 32 + 4 * hh) * 64 + dkb * 32 + r;
#pragma unroll
        for (int reg = 0; reg < 16; ++reg) ds[((reg & 3) + 8 * (reg >> 2)) * 64] = f2bf(acc[reg] * sc); } }
  }
}

DI void phase1a(const KP& p, char* lds) {
  const int tid = threadIdx.x, lane = tid & 63, w = tid >> 6;
  for (int tile = blockIdx.x; tile < 256; tile += gridDim.x) {
    unsigned char* ws = launder(p.ws); unsigned char* ob = (unsigned char*)launder(p.out); const float* xin = launder(p.in[0]);
    const float* mod = (const float*)(ws + WS_MOD);
    const int tok0 = tile * 64, b = tile >> 5;
    bf16_t* Hs = (bf16_t*)(ob + OUT_HS) + (size_t)tok0 * 1024;
    float4 ge[4], sh[4];
    const float* gpre = launder(p.in[5]); const float* modb = launder(mod) + b * 6144;
#pragma unroll
    for (int i = 0; i < 4; ++i) { const int d = (lane + 64 * i) * 4;
      const float4 g = *(const float4*)(gpre + d); const float4 sc = *(const float4*)(modb + 1024 + d); sh[i] = *(const float4*)(modb + d);
      ge[i] = make_float4(g.x * (1.f + sc.x), g.y * (1.f + sc.y), g.z * (1.f + sc.z), g.w * (1.f + sc.w)); }
#pragma unroll 2
    for (int rr = 0; rr < 8; ++rr) { const int row = w * 8 + rr;
      const float* xr = xin + (size_t)(tok0 + row) * 1024;
      float4 v[4]; float ss = 0.f;
#pragma unroll
      for (int i = 0; i < 4; ++i) { v[i] = *(const float4*)(xr + (lane + 64 * i) * 4); ss += v[i].x * v[i].x + v[i].y * v[i].y + v[i].z * v[i].z + v[i].w * v[i].w; }
      ss = wave_sum(ss); const float rs = rsqrtf(ss * (1.f / 1024.f) + EPS);
#pragma unroll
      for (int i = 0; i < 4; ++i) { uint2 o; o.x = pack2(v[i].x * rs * ge[i].x + sh[i].x, v[i].y * rs * ge[i].y + sh[i].y); o.y = pack2(v[i].z * rs * ge[i].z + sh[i].z, v[i].w * rs * ge[i].w + sh[i].w);
        *(uint2*)(Hs + (size_t)row * 1024 + (lane + 64 * i) * 4) = o; }
    }
  }
}

DI void phase1c(const KP& p, char* lds) {
  const int tid = threadIdx.x, lane = tid & 63, w = tid >> 6, r = lane & 31, hh = lane >> 5;
  float* cs = (float*)(lds + LDS_TAB); float* sn = cs + 2048;
  char* wl = lds + LDS_WT + (w & 3) * WT_BYTES;
  for (int tile = blockIdx.x; tile < 256; tile += gridDim.x) {
    unsigned char* ws = launder(p.ws); unsigned char* ob = (unsigned char*)launder(p.out);
    const int tok0 = tile * 64, b = tile >> 5, t0 = (tile & 31) * 64;
    const bf16_t* PA = (const bf16_t*)(ws + WS_P1S) + (size_t)tok0 * 1024;
    const bf16_t* PB = (const bf16_t*)(ob + 32 * MiB) + (size_t)tok0 * 1024;
    const bf16_t* PC = (const bf16_t*)(ws + WS_PROJC) + (size_t)tok0 * 256;
    bf16_t* Hs = (bf16_t*)(ob + OUT_HS) + (size_t)tok0 * 1024;
    bf16_t* CQN = Hs; bf16_t* CKVN = Hs + 64 * 384;
    bf16_t* Qm = (bf16_t*)(ws + WS_QM); bf16_t* Km = (bf16_t*)(ws + WS_KM); bf16_t* Vm = (bf16_t*)(ws + WS_VM);
    bf16_t* rg = (bf16_t*)(ws + WS_RG) + (size_t)tok0 * 512;
    __syncthreads();
#pragma unroll
    for (int i = 0; i < 4; ++i) { const int e = tid + 512 * i, tt = e >> 5, j = e & 31;
      const float inv = __builtin_amdgcn_exp2f(-(float)j * (13.287712379549449f / 32.f)); const float ang = (float)((const int*)p.in[2])[tok0 + tt] * inv;
      float rev = ang * 0.15915494309189535f; rev -= floorf(rev);
      cs[e] = __builtin_amdgcn_cosf(rev); sn[e] = __builtin_amdgcn_sinf(rev); }
#pragma unroll
    for (int i = 0; i < 8; ++i) { const int c = tid + 512 * i, row = c >> 6, cc = c & 63;
      const uint4 v = (cc < 36) ? *(const uint4*)(PB + (size_t)row * 1024 + (O_R - 1024) + cc * 8) : *(const uint4*)(PC + (size_t)row * 256 + (cc - 36) * 8);
      *(uint4*)(rg + (size_t)row * 512 + cc * 8) = v; }
    __syncthreads();
    if (tid < 256) { const int row = tid >> 2, pc = tid & 3;
      const uint4 x1 = *(const uint4*)(PA + (size_t)row * 1024 + O_KR + pc * 8), x2 = *(const uint4*)(PA + (size_t)row * 1024 + O_KR + 32 + pc * 8);
      const float4 c0 = *(const float4*)(cs + row * 32 + pc * 8), c1 = *(const float4*)(cs + row * 32 + pc * 8 + 4), s0 = *(const float4*)(sn + row * 32 + pc * 8), s1 = *(const float4*)(sn + row * 32 + pc * 8 + 4);
#define RO1(a_, b_, c_, s_) ((a_) * (c_) - (b_) * (s_))
#define RO2(a_, b_, c_, s_) ((b_) * (c_) + (a_) * (s_))
#define LO(u_) __uint_as_float((u_) << 16)
#define HI(u_) __uint_as_float((u_) & 0xffff0000u)
      uint4 o1, o2;
      o1.x = pack2(RO1(LO(x1.x), LO(x2.x), c0.x, s0.x), RO1(HI(x1.x), HI(x2.x), c0.y, s0.y)); o1.y = pack2(RO1(LO(x1.y), LO(x2.y), c0.z, s0.z), RO1(HI(x1.y), HI(x2.y), c0.w, s0.w));
      o1.z = pack2(RO1(LO(x1.z), LO(x2.z), c1.x, s1.x), RO1(HI(x1.z), HI(x2.z), c1.y, s1.y)); o1.w = pack2(RO1(LO(x1.w), LO(x2.w), c1.z, s1.z), RO1(HI(x1.w), HI(x2.w), c1.w, s1.w));
      o2.x = pack2(RO2(LO(x1.x), LO(x2.x), c0.x, s0.x), RO2(HI(x1.x), HI(x2.x), c0.y, s0.y)); o2.y = pack2(RO2(LO(x1.y), LO(x2.y), c0.z, s0.z), RO2(HI(x1.y), HI(x2.y), c0.w, s0.w));
      o2.z = pack2(RO2(LO(x1.z), LO(x2.z), c1.x, s1.x), RO2(HI(x1.z), HI(x2.z), c1.y, s1.y)); o2.w = pack2(RO2(LO(x1.w), LO(x2.w), c1.z, s1.z), RO2(HI(x1.w), HI(x2.w), c1.w, s1.w));
#undef RO1
#undef RO2
#undef LO
#undef HI
#pragma unroll
      for (int h = 0; h < 4; ++h) { bf16_t* kp = Km + (((size_t)b * 4 + h) * SEQ + t0 + row) * 192 + 128 + pc * 8; *(uint4*)kp = o1; *(uint4*)(kp + 32) = o2; }
    }
    const float* gq = launder(p.in[8]); const float* gkv = launder(p.in[10]);
#pragma unroll 2
    for (int rr = 0; rr < 8; ++rr) { const int row = w * 8 + rr; const unsigned* cr = (const unsigned*)(PA + (size_t)row * 1024);
      float v0[5], v1[5];
#pragma unroll
      for (int i = 0; i < 5; ++i) { const unsigned u = cr[lane + 64 * i]; v0[i] = __uint_as_float(u << 16); v1[i] = __uint_as_float(u & 0xffff0000u); }
      float ss = v0[0] * v0[0] + v1[0] * v1[0] + v0[1] * v0[1] + v1[1] * v1[1] + v0[2] * v0[2] + v1[2] * v1[2];
      float s2 = v0[3] * v0[3] + v1[3] * v1[3] + v0[4] * v0[4] + v1[4] * v1[4];
      ss = wave_sum(ss); s2 = wave_sum(s2);
      const float rq = rsqrtf(ss * (1.f / 384.f) + EPS), rk = rsqrtf(s2 * (1.f / 256.f) + EPS);
#pragma unroll
      for (int i = 0; i < 3; ++i) { const int c = 2 * (lane + 64 * i); *(unsigned*)(CQN + (size_t)row * 384 + c) = pack2(v0[i] * rq * gq[c], v1[i] * rq * gq[c + 1]); }
#pragma unroll
      for (int i = 3; i < 5; ++i) { const int c = 2 * (lane + 64 * (i - 3)); *(unsigned*)(CKVN + (size_t)row * 256 + c) = pack2(v0[i] * rk * gkv[c], v1[i] * rk * gkv[c + 1]); }
    }
    __syncthreads();
    block_gemm<3>(lds, CQN, 384, (const bf16_t*)(ws + WS_WTQUP), 3, 384, [&](int m0, int n0, const f32x16& a0, const f32x16& a1) {
      const int r2 = lv(r), h2 = lv(hh), ln = lv(lane);
      const int h = n0 / 192, d0 = n0 % 192;
      bf16_t* qp = Qm + (((size_t)b * 4 + h) * SEQ + t0 + m0) * 192 + d0;
      if (d0 < 128) wt_write(wl, a0, a1, r2, h2, 1.f); else wt_write_rope(wl, a0, a1, r2, h2, cs, sn, m0);
      LDS_FENCE();
      wt_store(wl, ln, qp, 192, qp + 32, 192);
    });
    block_gemm<3>(lds, CKVN, 256, (const bf16_t*)(ws + WS_WTKVUP), 4, 256, [&](int m0, int n0, const f32x16& a0, const f32x16& a1) {
      const int r2 = lv(r), h2 = lv(hh), ln = lv(lane);
      const int h = n0 >> 8, d0 = n0 & 255;
      wt_write(wl, a0, a1, r2, h2, 1.f); LDS_FENCE();
      if (d0 < 128) { bf16_t* kp = Km + (((size_t)b * 4 + h) * SEQ + t0 + m0) * 192 + d0; wt_store(wl, ln, kp, 192, kp + 32, 192); }
      else { bf16_t* vp = Vm + (((size_t)b * 4 + h) * SEQ + t0 + m0) * 128 + (d0 - 128); wt_store(wl, ln, vp, 128, vp + 32, 128); }
    });
    gla_chunk_local(p, lds, ws, tile, PA, PB);
  }
}

namespace att {
typedef short s16x4 __attribute__((ext_vector_type(4)));
typedef unsigned u32x4 __attribute__((ext_vector_type(4)));
constexpr int DQ = 192, DV = 128, KVBLK = 64;
constexpr float SCALE = 0.07216878364870322f;
constexpr float THR = 8.f;
constexpr int SHM_V = KVBLK * DV * 2, SHM_K = KVBLK * DQ * 2;
constexpr int SHM_QR = 8 * 32 * 176;
constexpr int SHM_ATTN = 2 * SHM_V + 2 * SHM_K + 8 * 64 * 4 + SHM_QR;
#define KSWZ(row, colB) ((row) * 384 + ((colB) ^ (((row) & 7) << 4)))
#define SBAR() __builtin_amdgcn_sched_barrier(0)
DI unsigned cvtpk(float lo, float hi) { unsigned r; asm volatile("v_cvt_pk_bf16_f32 %0, %1, %2" : "=v"(r) : "v"(lo), "v"(hi)); return r; }

DI void partialSM(f32x16& p0, f32x16& p1, float& m_reg, float& mn, float& alpha) {
  constexpr float C = SCALE * 1.4426950408889634f;
  float pmax = p0[0];
#pragma unroll
  for (int r = 1; r < 16; ++r) pmax = fmaxf(pmax, p0[r]);
#pragma unroll
  for (int r = 0; r < 16; ++r) pmax = fmaxf(pmax, p1[r]);
  { auto rr = __builtin_amdgcn_permlane32_swap(__float_as_uint(pmax), __float_as_uint(pmax), false, false);
    pmax = fmaxf(__uint_as_float(rr[0]), __uint_as_float(rr[1])); }
  if (__builtin_expect(__all(pmax - m_reg <= THR / SCALE), 1)) { mn = m_reg; alpha = 1.f; }
  else { mn = fmaxf(m_reg, pmax); alpha = __builtin_amdgcn_exp2f((m_reg - mn) * C); m_reg = mn; }
  const float mnC = -mn * C;
#pragma unroll
  for (int r = 0; r < 16; ++r) p0[r] = fmaf(p0[r], C, mnC);
#pragma unroll
  for (int r = 0; r < 16; ++r) p1[r] = fmaf(p1[r], C, mnC);
#pragma unroll
  for (int r = 0; r < 16; ++r) p0[r] = __builtin_amdgcn_exp2f(p0[r]);
}
DI void finishSM(f32x16& p0, f32x16& p1, float alpha, float& l_reg, bf16x8& pa0, bf16x8& pa1, bf16x8& pa2, bf16x8& pa3) {
#pragma unroll
  for (int r = 0; r < 16; ++r) p1[r] = __builtin_amdgcn_exp2f(p1[r]);
  float ps = 0;
#pragma unroll
  for (int r = 0; r < 16; ++r) ps += p0[r];
#pragma unroll
  for (int r = 0; r < 16; ++r) ps += p1[r];
  { auto rr = __builtin_amdgcn_permlane32_swap(__float_as_uint(ps), __float_as_uint(ps), false, false);
    ps = __uint_as_float(rr[0]) + __uint_as_float(rr[1]); }
  l_reg = l_reg * alpha + ps;
#define PK4(P, BASE, OUT) do { unsigned a0 = cvtpk(P[BASE + 0], P[BASE + 1]), a1 = cvtpk(P[BASE + 2], P[BASE + 3]);   \
    unsigned b0 = cvtpk(P[BASE + 4], P[BASE + 5]), b1 = cvtpk(P[BASE + 6], P[BASE + 7]);                              \
    auto r0 = __builtin_amdgcn_permlane32_swap(a0, b0, false, false); auto r1 = __builtin_amdgcn_permlane32_swap(a1, b1, false, false); \
    u32x4 wv = {r0[0], r1[0], r0[1], r1[1]}; OUT = *reinterpret_cast<bf16x8*>(&wv); } while (0)
  PK4(p0, 0, pa0); PK4(p0, 8, pa1); PK4(p1, 0, pa2); PK4(p1, 8, pa3);
#undef PK4
}
DI void qkt(f32x16& p0, f32x16& p1, const char* Ks, const bf16x8* qr, const char* qrl, int r32, int hi) {
#pragma unroll
  for (int i = 0; i < 16; ++i) { p0[i] = 0.f; p1[i] = 0.f; }
#pragma unroll
  for (int d0 = 0; d0 < 12; ++d0) { const int cb = (d0 * 16 + hi * 8) * 2;
    const bf16x8 b0 = *reinterpret_cast<const bf16x8*>(Ks + KSWZ(r32, cb));
    const bf16x8 b1 = *reinterpret_cast<const bf16x8*>(Ks + KSWZ(32 + r32, cb));
    const bf16x8 q = (d0 < 7) ? qr[d0 < 7 ? d0 : 0] : *reinterpret_cast<const bf16x8*>(qrl + (d0 - 7) * 32);
    p0 = MFMA32(b0, q, p0);
    p1 = MFMA32(b1, q, p1); }
}
DI int v_st(int k, int c) { const int kk = (k & ~0xC) | ((k & 4) << 1) | ((k & 8) >> 1); return ((kk >> 3) * 4 + (c >> 5)) * 512 + ((kk & 7) * 32 + (c & 31)) * 2; }
DI int v_rd_base(int lane) { return ((lane & 3) << 3) | (((lane >> 2) & 3) << 6) | (((lane >> 4) & 1) << 5) | (((lane >> 5) & 1) << 8); }
constexpr int v_rd_off(int d0, int ks, int half) { return d0 * 512 + ks * 4096 + half * 2048; }
template <int OFF> DI s16x4 tr_read(int vb) { s16x4 r; asm volatile("ds_read_b64_tr_b16 %0, %1 offset:%2" : "=&v"(r) : "v"(vb), "i"(OFF) : "memory"); return r; }
template <int D0> DI void pv_one(f32x16& od, int vb, bf16x8 pa0, bf16x8 pa1, bf16x8 pa2, bf16x8 pa3) {
  const s16x4 l0 = tr_read<v_rd_off(D0, 0, 0)>(vb), h0 = tr_read<v_rd_off(D0, 0, 1)>(vb), l1 = tr_read<v_rd_off(D0, 1, 0)>(vb), h1 = tr_read<v_rd_off(D0, 1, 1)>(vb);
  const s16x4 l2 = tr_read<v_rd_off(D0, 2, 0)>(vb), h2 = tr_read<v_rd_off(D0, 2, 1)>(vb), l3 = tr_read<v_rd_off(D0, 3, 0)>(vb), h3 = tr_read<v_rd_off(D0, 3, 1)>(vb);
  asm volatile("s_waitcnt lgkmcnt(0)" ::: "memory"); SBAR();
#define PK(L, H) (bf16x8){L[0], L[1], L[2], L[3], H[0], H[1], H[2], H[3]}
  od = MFMA32(pa0, PK(l0, h0), od);
  od = MFMA32(pa1, PK(l1, h1), od);
  od = MFMA32(pa2, PK(l2, h2), od);
  od = MFMA32(pa3, PK(l3, h3), od);
#undef PK
}
DI void pv_d0(f32x16* o, int vb, bf16x8 pa0, bf16x8 pa1, bf16x8 pa2, bf16x8 pa3) {
  pv_one<0>(o[0], vb, pa0, pa1, pa2, pa3); pv_one<1>(o[1], vb, pa0, pa1, pa2, pa3); pv_one<2>(o[2], vb, pa0, pa1, pa2, pa3); pv_one<3>(o[3], vb, pa0, pa1, pa2, pa3);
}
DI void attn_unit(const bf16_t* Qb, const bf16_t* Kh, const bf16_t* Vh, bf16_t* Ob, int seq, char* lds) {
  const int tid = lv(threadIdx.x), wid = tid >> 6, lane = tid & 63, r32 = lane & 31, hi = lane >> 5;
  char* V_lds = lds; char* K_lds = lds + 2 * SHM_V;
  float* wsf = (float*)(lds + 2 * SHM_V + 2 * SHM_K) + wid * 64; float* li_l = wsf; float* al_l = wsf + 32;
  char* qrl = lds + 2 * SHM_V + 2 * SHM_K + 8 * 64 * 4 + wid * (32 * 176) + r32 * 176 + hi * 16;
  float m_reg = -1e30f, l_reg = 0; f32x16 o[4]; bf16x8 qr[7];
#pragma unroll
  for (int d = 0; d < 4; ++d)
#pragma unroll
    for (int i = 0; i < 16; ++i) o[d][i] = 0.f;
  const bf16_t* Qw = Qb + (size_t)(wid * 32 + r32) * DQ + hi * 8;
#pragma unroll
  for (int d0 = 0; d0 < 7; ++d0) qr[d0] = *reinterpret_cast<const bf16x8*>(Qw + d0 * 16);
#pragma unroll
  for (int d0 = 7; d0 < 12; ++d0) *reinterpret_cast<bf16x8*>(qrl + (d0 - 7) * 32) = *reinterpret_cast<const bf16x8*>(Qw + d0 * 16);
  int kst[3];
#pragma unroll
  for (int i = 0; i < 3; ++i) { const int c = tid + 512 * i; kst[i] = KSWZ(c / 24, (c % 24) * 16); }
  const int vst0 = v_st(tid >> 4, (tid & 15) * 8), vst1 = v_st(32 + (tid >> 4), (tid & 15) * 8);
  const int vb0 = (int)(uintptr_t)V_lds + v_rd_base(lane);
  bf16x8 sk0, sk1, sk2, sv0, sv1;
#define SLOAD(k0) do { const bf16x8* kp = reinterpret_cast<const bf16x8*>(Kh + (size_t)(k0) * DQ) + tid; sk0 = kp[0]; sk1 = kp[512]; sk2 = kp[1024]; \
    const bf16x8* vp = reinterpret_cast<const bf16x8*>(Vh + (size_t)(k0) * DV) + tid; sv0 = vp[0]; sv1 = vp[512]; } while (0)
#define SWRITE(b) do { *(bf16x8*)(V_lds + (b) * SHM_V + vst0) = sv0; *(bf16x8*)(V_lds + (b) * SHM_V + vst1) = sv1; \
    *(bf16x8*)(K_lds + (b) * SHM_K + kst[0]) = sk0; *(bf16x8*)(K_lds + (b) * SHM_K + kst[1]) = sk1; *(bf16x8*)(K_lds + (b) * SHM_K + kst[2]) = sk2; } while (0)
#define RESC(a) do { if (__any((a) < 1.f)) { if (hi == 0) al_l[r32] = (a); asm volatile("s_waitcnt lgkmcnt(0)" ::: "memory"); \
    _Pragma("unroll") for (int d = 0; d < 4; ++d) _Pragma("unroll") for (int r = 0; r < 16; ++r) o[d][r] *= al_l[crow(r, hi)]; } } while (0)
  f32x16 pA0, pA1, pB0, pB1; float mnA, mnB, alA, alB; bf16x8 pa0, pa1, pa2, pa3; const int NT = seq / KVBLK;
  SLOAD(0); SWRITE(0); __syncthreads();
  qkt(pA0, pA1, K_lds, qr, qrl, r32, hi); partialSM(pA0, pA1, m_reg, mnA, alA);
  SLOAD(KVBLK); SWRITE(1); __syncthreads();
  for (int j = 1; j + 1 < NT; j += 2) {
    SBAR(); qkt(pB0, pB1, K_lds + SHM_K, qr, qrl, r32, hi);
    finishSM(pA0, pA1, alA, l_reg, pa0, pa1, pa2, pa3); SBAR();
    SLOAD((j + 1) * KVBLK); SBAR();
    pv_d0(o, vb0, pa0, pa1, pa2, pa3); partialSM(pB0, pB1, m_reg, mnB, alB);
    __syncthreads(); SWRITE(0);
    RESC(alB); __syncthreads();
    SBAR(); qkt(pA0, pA1, K_lds, qr, qrl, r32, hi);
    finishSM(pB0, pB1, alB, l_reg, pa0, pa1, pa2, pa3); SBAR();
    SLOAD((j + 2) * KVBLK); SBAR();
    pv_d0(o, vb0 + SHM_V, pa0, pa1, pa2, pa3); partialSM(pA0, pA1, m_reg, mnA, alA);
    __syncthreads(); SWRITE(1);
    RESC(alA); __syncthreads();
  }
  SBAR(); qkt(pB0, pB1, K_lds + SHM_K, qr, qrl, r32, hi);
  finishSM(pA0, pA1, alA, l_reg, pa0, pa1, pa2, pa3); SBAR();
  pv_d0(o, vb0, pa0, pa1, pa2, pa3); partialSM(pB0, pB1, m_reg, mnB, alB);
  __syncthreads(); RESC(alB);
  finishSM(pB0, pB1, alB, l_reg, pa0, pa1, pa2, pa3); SBAR();
  pv_d0(o, vb0 + SHM_V, pa0, pa1, pa2, pa3);
  if (hi == 0) li_l[r32] = l_reg; asm volatile("s_waitcnt lgkmcnt(0)" ::: "memory");
  float rli[16];
#pragma unroll
  for (int r = 0; r < 16; ++r) rli[r] = __builtin_amdgcn_rcpf(li_l[crow(r, hi)]);
  bf16_t* Ow = Ob + (size_t)(wid * 32) * 1024;
#pragma unroll
  for (int r = 0; r < 16; ++r) { const int orow = crow(r, hi);
#pragma unroll
    for (int d0 = 0; d0 < 4; ++d0) Ow[(size_t)orow * 1024 + d0 * 32 + r32] = f2bf(o[d0][r] * rli[r]); }
  __syncthreads();
#undef SLOAD
#undef SWRITE
#undef RESC
}
}

DI void phase2_attn(const KP& p, char* lds) {
  for (int u = blockIdx.x; u < 256; u += gridDim.x) {
    unsigned char* ws = launder(p.ws);
    const bf16_t* Qm = (const bf16_t*)(ws + WS_QM); const bf16_t* Km = (const bf16_t*)(ws + WS_KM); const bf16_t* Vm = (const bf16_t*)(ws + WS_VM);
    bf16_t* mixa = (bf16_t*)(ws + WS_P1S);
    const int qb = u & 7, bh = u >> 3, b = bh >> 2, h = bh & 3;
    att::attn_unit(Qm + ((size_t)bh * SEQ + qb * 256) * 192, Km + (size_t)bh * SEQ * 192, Vm + (size_t)bh * SEQ * 128,
                   mixa + ((size_t)b * SEQ + qb * 256) * 1024 + h * 128, SEQ, lds);
  }
}

namespace pg8 {
#define PG8_LAS __attribute__((address_space(3)))
typedef unsigned short bf16_t;
typedef short bf16x8 __attribute__((ext_vector_type(8)));
typedef float f32x4 __attribute__((ext_vector_type(4)));
typedef unsigned u32x4 __attribute__((ext_vector_type(4)));
constexpr int BM = 256, BK = 64, HALF = 128, HTB = HALF * BK * 2  , STAGE_BYTES = 8 * HTB, NXCD = 8, WGM = 8;

__host__ __device__ __forceinline__ int lds_byte(int r, int c) { const int st = (r >> 4) * 2 + (c >> 5), rr = r & 15, cc = c & 31, ob = rr * 64 + cc * 2; return st * 1024 + (ob ^ (((ob >> 9) & 1) << 5)); }
__host__ __device__ __forceinline__ void stage_rc(int b, int& R, int& C) { const int st = b / 1024, sb = b % 1024, swz = sb ^ (((sb >> 9) & 1) << 5); R = (st >> 1) * 16 + swz / 64; C = (st & 1) * 32 + (swz % 64) / 2; }
__host__ __device__ __forceinline__ int perm32(int rho) { const int n = rho >> 4, i = rho & 15; return 8 * (i >> 2) + 4 * n + (i & 3); }

struct Unit { int pm, pn; };
struct Gemm { const bf16_t* A; const bf16_t* Bt; int M, N, K; };

struct StaticOrder {
    int nM, nN, nwg, G, c;
    __host__ __device__ void init(int M, int N, int G_, int c_) { nM = M / BM; nN = N / BM; nwg = nM * nN; G = G_; c = c_; }
    __host__ __device__ bool next(int i, Unit& u) const {
        const long L = (long)i * G + c; if (L >= nwg) return false;
        int wgid = (int)L; { const int q = nwg / NXCD, r = nwg % NXCD, xcd = wgid % NXCD, off = wgid / NXCD; wgid = (xcd < r ? xcd * (q + 1) : r * (q + 1) + (xcd - r) * q) + off; }
        const int nig = WGM * nN, gid = wgid / nig, fm = gid * WGM, gsz = (nM - fm) < WGM ? (nM - fm) : WGM;
        u.pm = fm + ((wgid % nig) % gsz); u.pn = (wgid % nig) / gsz; return true;
    }
    __device__ __forceinline__ void a_ready(const Unit&) const {}
    __device__ __forceinline__ void done(const Unit&) const {}
};

__device__ __forceinline__ unsigned cvt_pk_bf16(float lo, float hi) { unsigned r; asm volatile("v_cvt_pk_bf16_f32 %0, %1, %2" : "=v"(r) : "v"(lo), "v"(hi)); return r; }
typedef float f32x2 __attribute__((ext_vector_type(2)));
__device__ __forceinline__ f32x2 gelu_pk(f32x2 v) {
    const f32x2 av = __builtin_elementwise_abs(v), d = av * 0.2316418882f + 1.0f;
    f32x2 t; t.x = __builtin_amdgcn_rcpf(d.x); t.y = __builtin_amdgcn_rcpf(d.y);
    f32x2 q = t * 0.5307027145f + (-0.7265760135f); q = q * t + 0.7107068705f; q = q * t + (-0.142248368f); q = q * t + 0.127414796f; q = q * t;
    const f32x2 s = (v * v) * (-0.72134752044f);
    f32x2 e; e.x = __builtin_amdgcn_exp2f(s.x); e.y = __builtin_amdgcn_exp2f(s.y);
    const f32x2 m = v * (q * e), r = v - m;
    f32x2 o; o.x = v.x < 0.f ? m.x : r.x; o.y = v.y < 0.f ? m.y : r.y; return o;
}

template <int ACT  > struct EpiBf16 {
    static constexpr bool PERM = true, AFTER_DRAIN = false; static_assert(ACT == 0 || ACT == 1, "EpiBf16: ACT is 0 (none) or 1 (gelu_pk)");
    bf16_t* O; int ldc; const float* bias; int split_cols; size_t split_stride; float scale0;
    __device__ __forceinline__ void operator()(const f32x4 (&acc)[2][2][4][2], const Unit& u, int wr, int wc, int fr, int fq) const {
        const int row0 = u.pm * BM + wr * 64 + fr; int colt = u.pn * BM; bf16_t* base = O;
        float sc = 1.f; if (split_cols) { const int t = colt / split_cols; base += (size_t)t * split_stride; colt -= t * split_cols; if (t == 0) sc = scale0; }
        const int col0 = colt + wc * 32 + 8 * fq, bcol0 = u.pn * BM + wc * 32 + 8 * fq;
        f32x4 bv[2][2];
#pragma unroll
        for (int bj = 0; bj < 2; ++bj)
#pragma unroll
            for (int n = 0; n < 2; ++n) bv[bj][n] = bias ? *(const f32x4*)(bias + bcol0 + bj * HALF + 4 * n) : (f32x4){0.f, 0.f, 0.f, 0.f};
#pragma unroll
        for (int ai = 0; ai < 2; ++ai)
#pragma unroll
            for (int m = 0; m < 4; ++m) { bf16_t* rowp = base + (size_t)(row0 + ai * HALF + m * 16) * ldc + col0;
#pragma unroll
                for (int bj = 0; bj < 2; ++bj) { f32x4 v0 = acc[ai][bj][m][0] + bv[bj][0], v1 = acc[ai][bj][m][1] + bv[bj][1];
                    if (ACT == 1) { f32x2 a = gelu_pk((f32x2){v0[0], v0[1]}), b = gelu_pk((f32x2){v0[2], v0[3]}), c = gelu_pk((f32x2){v1[0], v1[1]}), d = gelu_pk((f32x2){v1[2], v1[3]});
                        v0 = (f32x4){a.x, a.y, b.x, b.y}; v1 = (f32x4){c.x, c.y, d.x, d.y}; }
                    v0 = v0 * sc; v1 = v1 * sc; u32x4 w; w.x = cvt_pk_bf16(v0[0], v0[1]); w.y = cvt_pk_bf16(v0[2], v0[3]); w.z = cvt_pk_bf16(v1[0], v1[1]); w.w = cvt_pk_bf16(v1[2], v1[3]);
                    *(u32x4*)(rowp + bj * HALF) = w; } }
    }
};

template <class Epi, class Sched, bool ALIGN_EPI = false, bool SP2 = false>
__device__ __forceinline__ void gemm_phase(PG8_LAS unsigned char* lds, const Gemm g, const Sched& S, const Epi& E) {
    const int tid = threadIdx.x, wid = __builtin_amdgcn_readfirstlane(tid >> 6), lane = tid & 63, wr = wid >> 2, wc = wid & 3, fr = lane & 15, fq = lane >> 4;
    const int K = g.K, nt = K / BK;
    unsigned voffA[2], voffB[2];
#pragma unroll
    for (int i = 0; i < 2; ++i) { int R, C; stage_rc(tid * 16 + i * 8192, R, C); const int Rb = Epi::PERM ? ((R & ~31) + perm32(R & 31)) : R;
        voffA[i] = (unsigned)(R * K + C) * 2u; voffB[i] = (unsigned)(Rb * K + C) * 2u; }
    const size_t kstep = (size_t)(BK * 2);
    const size_t hstep = (size_t)HALF * K * 2;
    const size_t tstep = 2 * hstep;
    const unsigned ldsw = (unsigned)wid * 1024u;
    const int aoff = lds_byte(wr * 64 + fr, fq * 8), boff = lds_byte(wc * 32 + fr, fq * 8);
#define PG8_SA(b, h) (((b) * 2 + (h)) * HTB)
#define PG8_SB(b, h) ((4 + (b) * 2 + (h)) * HTB)
#define PG8_STAGE(bufoff, gbase, voff) do { _Pragma("unroll") for (int _i = 0; _i < 2; ++_i) \
        __builtin_amdgcn_global_load_lds((const unsigned*)((const char*)(gbase) + (voff)[_i]), (PG8_LAS unsigned*)(lds + (bufoff) + ldsw + _i * 8192), 16, 0, 0); } while (0)
#define PG8_LDA(dst, b, h) do { _Pragma("unroll") for (int m = 0; m < 4; ++m) _Pragma("unroll") for (int k = 0; k < 2; ++k) dst[m][k] = *(const PG8_LAS bf16x8*)(lds + PG8_SA(b, h) + aoff + m * 2048 + k * 1024); } while (0)
#define PG8_LDB(dst, b, h) do { _Pragma("unroll") for (int n = 0; n < 2; ++n) _Pragma("unroll") for (int k = 0; k < 2; ++k) dst[n][k] = *(const PG8_LAS bf16x8*)(lds + PG8_SB(b, h) + boff + n * 2048 + k * 1024); } while (0)
#define PG8_MMA(ai, bj, At, Bt) do { __builtin_amdgcn_s_setprio(1); _Pragma("unroll") for (int m = 0; m < 4; ++m) _Pragma("unroll") for (int n = 0; n < 2; ++n) _Pragma("unroll") for (int k = 0; k < 2; ++k) \
        acc[ai][bj][m][n] = __builtin_amdgcn_mfma_f32_16x16x32_bf16(Bt[n][k], At[m][k], acc[ai][bj][m][n], 0, 0, 0); __builtin_amdgcn_s_setprio(0); } while (0)
#define PG8_WAIT_V(n) asm volatile("s_waitcnt vmcnt(" #n ")" ::: "memory")
#define PG8_WAIT_L(n) asm volatile("s_waitcnt lgkmcnt(" #n ")" ::: "memory")
#define PG8_BAR __builtin_amdgcn_s_barrier()
#define PG8_SCHED __builtin_amdgcn_sched_barrier(0)
    Unit cur, nxt; int ui = 0;
    if (!S.next(0, cur)) return;
    f32x4 acc[2][2][4][2];
#pragma unroll
    for (int a = 0; a < 2; ++a)
#pragma unroll
        for (int b = 0; b < 2; ++b)
#pragma unroll
            for (int m = 0; m < 4; ++m)
#pragma unroll
                for (int n = 0; n < 2; ++n) acc[a][b][m][n] = (f32x4){0.f, 0.f, 0.f, 0.f};
    bf16x8 At[4][2], B0[2][2], B1[2][2];
    const char* cA = (const char*)g.A + (size_t)cur.pm * tstep; const char* cB = (const char*)g.Bt + (size_t)cur.pn * tstep;
    S.a_ready(cur);
    if constexpr (SP2) {
        PG8_STAGE(PG8_SB(0, 0), cB, voffB); PG8_STAGE(PG8_SB(0, 1), cB + hstep, voffB); PG8_STAGE(PG8_SA(0, 0), cA, voffA); PG8_STAGE(PG8_SA(0, 1), cA + hstep, voffA);
        if (wr == 1) PG8_BAR;
        PG8_WAIT_V(2); PG8_BAR;
        PG8_STAGE(PG8_SB(1, 0), cB + kstep, voffB); PG8_STAGE(PG8_SA(1, 0), cA + kstep, voffA); PG8_STAGE(PG8_SB(1, 1), cB + hstep + kstep, voffB);
        PG8_WAIT_V(6); PG8_BAR;
    } else {
        PG8_STAGE(PG8_SB(0, 0), cB, voffB); PG8_STAGE(PG8_SA(0, 0), cA, voffA); PG8_STAGE(PG8_SB(0, 1), cB + hstep, voffB); PG8_STAGE(PG8_SA(0, 1), cA + hstep, voffA);
        if (wr == 1) PG8_BAR;
        PG8_WAIT_V(4); PG8_BAR;
        PG8_STAGE(PG8_SB(1, 0), cB + kstep, voffB); PG8_STAGE(PG8_SA(1, 0), cA + kstep, voffA); PG8_STAGE(PG8_SB(1, 1), cB + hstep + kstep, voffB);
        PG8_WAIT_V(6); PG8_BAR;
    }
    for (;;) {
        const bool has_next = S.next(ui + 1, nxt);
        const char* nA = has_next ? (const char*)g.A + (size_t)nxt.pm * tstep : cA; const char* nB = has_next ? (const char*)g.Bt + (size_t)nxt.pn * tstep : cB;
        for (int t = 0; t < nt; t += 2) {
            const bool last = (t == nt - 2);
            const char* a1 = cA + (size_t)(t + 1) * kstep;
            const char* a2 = last ? nA : cA + (size_t)(t + 2) * kstep; const char* b2 = last ? nB : cB + (size_t)(t + 2) * kstep;
            const char* a3 = a2 + kstep; const char* b3 = b2 + kstep;
            if (last && has_next) S.a_ready(nxt);
            if constexpr (SP2) {
            PG8_LDB(B0, 0, 0); PG8_LDB(B1, 0, 1); PG8_SCHED; PG8_LDA(At, 0, 0); PG8_STAGE(PG8_SA(1, 1), a1 + hstep, voffA);
            PG8_WAIT_V(8); PG8_WAIT_L(0); PG8_BAR; PG8_MMA(0, 0, At, B0); PG8_MMA(0, 1, At, B1); PG8_BAR; PG8_SCHED;
            PG8_LDA(At, 0, 1); PG8_STAGE(PG8_SB(0, 0), b2, voffB); PG8_STAGE(PG8_SB(0, 1), b2 + hstep, voffB); PG8_STAGE(PG8_SA(0, 0), a2, voffA);
            PG8_WAIT_V(8); PG8_WAIT_L(0); PG8_BAR; PG8_MMA(1, 0, At, B0); PG8_MMA(1, 1, At, B1); PG8_BAR; PG8_SCHED;
            PG8_LDB(B0, 1, 0); PG8_LDB(B1, 1, 1); PG8_SCHED; PG8_LDA(At, 1, 0); PG8_STAGE(PG8_SA(0, 1), a2 + hstep, voffA);
            PG8_WAIT_V(8); PG8_WAIT_L(0); PG8_BAR; PG8_MMA(0, 0, At, B0); PG8_MMA(0, 1, At, B1); PG8_BAR; PG8_SCHED;
            PG8_LDA(At, 1, 1); PG8_STAGE(PG8_SB(1, 0), b3, voffB); PG8_STAGE(PG8_SB(1, 1), b3 + hstep, voffB); PG8_STAGE(PG8_SA(1, 0), a3, voffA);
            PG8_WAIT_V(8); PG8_WAIT_L(0); PG8_BAR; PG8_MMA(1, 0, At, B0); PG8_MMA(1, 1, At, B1); PG8_BAR; PG8_SCHED;
            } else {
            PG8_LDB(B0, 0, 0); PG8_SCHED; PG8_LDA(At, 0, 0); PG8_STAGE(PG8_SA(1, 1), a1 + hstep, voffA);
            PG8_WAIT_L(8); PG8_BAR; PG8_WAIT_L(0); PG8_MMA(0, 0, At, B0); PG8_BAR; PG8_SCHED;
            PG8_LDB(B1, 0, 1); PG8_STAGE(PG8_SB(0, 0), b2, voffB);
            PG8_BAR; PG8_WAIT_L(0); PG8_MMA(0, 1, At, B1); PG8_BAR;
            PG8_LDA(At, 0, 1); PG8_STAGE(PG8_SA(0, 0), a2, voffA);
            PG8_BAR; PG8_WAIT_L(0); PG8_MMA(1, 0, At, B0); PG8_BAR; PG8_SCHED;
            PG8_STAGE(PG8_SB(0, 1), b2 + hstep, voffB);
            PG8_WAIT_V(6); PG8_BAR; PG8_MMA(1, 1, At, B1); PG8_BAR;
            PG8_LDB(B0, 1, 0); PG8_SCHED; PG8_LDA(At, 1, 0); PG8_STAGE(PG8_SA(0, 1), a2 + hstep, voffA);
            PG8_WAIT_L(8); PG8_BAR; PG8_WAIT_L(0); PG8_MMA(0, 0, At, B0); PG8_BAR; PG8_SCHED;
            PG8_LDB(B1, 1, 1); PG8_STAGE(PG8_SB(1, 0), b3, voffB);
            PG8_BAR; PG8_WAIT_L(0); PG8_MMA(0, 1, At, B1); PG8_BAR;
            PG8_LDA(At, 1, 1); PG8_STAGE(PG8_SA(1, 0), a3, voffA);
            PG8_BAR; PG8_WAIT_L(0); PG8_MMA(1, 0, At, B0); PG8_BAR; PG8_SCHED;
            PG8_STAGE(PG8_SB(1, 1), b3 + hstep, voffB);
            PG8_WAIT_V(6); PG8_BAR; PG8_MMA(1, 1, At, B1); PG8_BAR;
            }
        }
        if constexpr (ALIGN_EPI) { if (wr == 0) PG8_BAR; }
        if constexpr (!Epi::AFTER_DRAIN) { E(acc, cur, wr, wc, fr, fq); S.done(cur); }
        if (!has_next) break;
#pragma unroll
        for (int a = 0; a < 2; ++a)
#pragma unroll
            for (int b = 0; b < 2; ++b)
#pragma unroll
                for (int m = 0; m < 4; ++m)
#pragma unroll
                    for (int n = 0; n < 2; ++n) acc[a][b][m][n] = (f32x4){0.f, 0.f, 0.f, 0.f};
        cur = nxt; cA = nA; cB = nB; ++ui;
        if constexpr (ALIGN_EPI) { if (wr == 1) PG8_BAR; }
    }
    PG8_WAIT_V(0);
    if constexpr (!ALIGN_EPI) { if (wr == 0) PG8_BAR; }
    PG8_BAR;
    if constexpr (Epi::AFTER_DRAIN) { E.fused(acc, cur, wr, wc, fr, fq, lds, wid, lane); S.done(cur); }
#undef PG8_SA
#undef PG8_SB
#undef PG8_STAGE
#undef PG8_LDA
#undef PG8_LDB
#undef PG8_MMA
#undef PG8_WAIT_V
#undef PG8_WAIT_L
#undef PG8_BAR
#undef PG8_SCHED
}
}


namespace pg8 {
struct EpiProj {
    static constexpr bool PERM = true, AFTER_DRAIN = false;
    bf16_t* P0; bf16_t* P1; bf16_t* P2;
    __device__ __forceinline__ void operator()(const f32x4 (&acc)[2][2][4][2], const Unit& u, int wr, int wc, int fr, int fq) const {
        const int row0 = u.pm * BM + wr * 64 + fr; const int colt = u.pn * BM;
        const long d1 = (long)(P1 - P0), d2 = (long)(P2 - P0); long dsel = 0; if (colt >= 1024) dsel = d1; if (colt >= 2048) dsel = d2;
        bf16_t* base = P0 + dsel; const int ldc = colt < 2048 ? 1024 : 256; const int cl = colt & 1023;
        const int col0 = cl + wc * 32 + 8 * fq;
#pragma unroll
        for (int ai = 0; ai < 2; ++ai)
#pragma unroll
            for (int m = 0; m < 4; ++m) { bf16_t* rowp = base + (size_t)(row0 + ai * HALF + m * 16) * ldc + col0;
#pragma unroll
                for (int bj = 0; bj < 2; ++bj) { const f32x4 v0 = acc[ai][bj][m][0], v1 = acc[ai][bj][m][1];
                    u32x4 w; w.x = cvt_pk_bf16(v0[0], v0[1]); w.y = cvt_pk_bf16(v0[2], v0[3]); w.z = cvt_pk_bf16(v1[0], v1[1]); w.w = cvt_pk_bf16(v1[2], v1[3]);
                    *(u32x4*)(rowp + bj * HALF) = w; } }
    }
};
}

constexpr int P3_TILE_BYTES = 256 * 1024;
constexpr int LDS_TK = 92160;
constexpr int GP_SH = 11, GP_N = 16384 >> GP_SH, GP_OS = GP_N + 1;
constexpr int LDS_OFF = 32768, LDS_CNT = 36864, LDS_LIST = 36864, LDS_H2L = 45056, LDS_SE = 110592;
constexpr int SCW = 260;
template <int N> DI void ce_desc(float (&a)[N], int i, int l) { const float hi = fmaxf(a[i], a[l]), lo = fminf(a[i], a[l]); a[i] = hi; a[l] = lo; }
DI void sort16_desc(float (&a)[16]) {
#pragma unroll
  for (int k = 2; k <= 16; k <<= 1)
#pragma unroll
    for (int j = k >> 1; j > 0; j >>= 1)
#pragma unroll
      for (int i = 0; i < 16; ++i) { const int l = i ^ j; if (l > i) { if ((i & k) == 0) ce_desc(a, i, l); else ce_desc(a, l, i); } }
}
DI void merge16_desc(float (&a)[16]) {
#pragma unroll
  for (int j = 8; j > 0; j >>= 1)
#pragma unroll
    for (int i = 0; i < 16; ++i) { const int l = i ^ j; if (l > i) ce_desc(a, i, l); }
}
DI void top16_merge(float (&a)[16], const float (&b)[16]) {
#pragma unroll
  for (int i = 0; i < 16; ++i) a[i] = fmaxf(a[i], b[15 - i]);
  merge16_desc(a);
}
template <int CTRL> DI float dpp_f(float v) { return __int_as_float(__builtin_amdgcn_mov_dpp(__float_as_int(v), CTRL, 0xF, 0xF, true)); }

DI float gelu_fast(float x) { return 0.5f * x * (1.f + erff(x * 0.70710678118654752f)); }

DI void phase3(const KP& p, char* lds, const int gather_reps, const int probe) {
  const int tid0 = threadIdx.x;
  const int r = tid0 & 31, hh = (tid0 >> 5) & 1, lane = tid0 & 63;
  char* wl = lds + LDS_WT + ((tid0 >> 6) & 3) * WT_BYTES;
  for (int tile = blockIdx.x; tile < 256; tile += gridDim.x) {
    unsigned char* ws = launder(p.ws); float* outp = launder(p.out); const float* xin = launder(p.in[0]);
    const int tok0 = tile * 64, b = tile >> 5;
    unsigned char* tsc = ws + WS_QM + (size_t)tile * P3_TILE_BYTES;
    bf16_t* QRY = (bf16_t*)tsc; bf16_t* Y = (bf16_t*)tsc; bf16_t* MIXA = (bf16_t*)(ws + WS_P1S) + (size_t)tok0 * 1024; bf16_t* H2 = MIXA;
    const float* modb = launder((const float*)(ws + WS_MOD)) + b * 6144;
    __syncthreads();
    {
      const int tid = lv(tid0), lane = tid & 63, w = tid >> 6, r = lane & 31, hh = lane >> 5;
      const int h = w >> 1, mi = w & 1, n = tile & 31;
      char* OIL = lds; char* RGL = lds + 66560;
      { const bf16_t* oig = (const bf16_t*)(ws + WS_OINTRA) + (size_t)tok0 * 512; const bf16_t* rgg = (const bf16_t*)(ws + WS_RG) + (size_t)tok0 * 512;
#pragma unroll
        for (int i = 0; i < 8; ++i) { const int c = tid + 512 * i, row = c >> 6, cc = c & 63;
          *(uint4*)(OIL + row * 1040 + cc * 16) = *(const uint4*)(oig + (size_t)row * 512 + cc * 8);
          *(uint4*)(RGL + row * 1040 + cc * 16) = *(const uint4*)(rgg + (size_t)row * 512 + cc * 8); } }
      const bf16_t* QDg = (const bf16_t*)(ws + WS_QDEC) + (size_t)(tile * 4 + h) * 2 * 4096 + (mi * 32 + r) * 64 + hh * 8;
      const bf16_t* SPg = (const bf16_t*)(ws + WS_SPT) + ((size_t)((b * 4 + h) * 2) * 32 + n) * 8192 + r * 64 + hh * 8;
      f32x16 acc[4];
#pragma unroll
      for (int ni = 0; ni < 4; ++ni)
#pragma unroll
        for (int i = 0; i < 16; ++i) acc[ni][i] = 0.f;
#pragma unroll
      for (int d = 0; d < 2; ++d)
#pragma unroll
        for (int s = 0; s < 4; ++s) { const bf16x8 a = *(const bf16x8*)(QDg + d * 4096 + s * 16);
#pragma unroll
          for (int ni = 0; ni < 4; ++ni) { const bf16x8 bb = *(const bf16x8*)(SPg + (size_t)d * 32 * 8192 + ni * 32 * 64 + s * 16); acc[ni] = MFMA32(a, bb, acc[ni]); } }
      __syncthreads();
      bf16_t* oil = (bf16_t*)(OIL + (mi * 32 + 4 * hh) * 1040) + h * 128 + r; const bf16_t* rgl = (const bf16_t*)(RGL + (mi * 32 + 4 * hh) * 1040) + h * 128 + r;
#pragma unroll
      for (int ni = 0; ni < 4; ++ni)
#pragma unroll
        for (int reg = 0; reg < 16; ++reg) acc[ni][reg] += bf2f(oil[((reg & 3) + 8 * (reg >> 2)) * 520 + ni * 32]);
      float rs[16];
#pragma unroll
      for (int reg = 0; reg < 16; ++reg) { float v = acc[0][reg] * acc[0][reg] + acc[1][reg] * acc[1][reg] + acc[2][reg] * acc[2][reg] + acc[3][reg] * acc[3][reg];
        v += __shfl_xor(v, 1); v += __shfl_xor(v, 2); v += __shfl_xor(v, 4); v += __shfl_xor(v, 8); v += __shfl_xor(v, 16);
        rs[reg] = rsqrtf(v * (1.f / 128.f) + EPS); }
      const float* ggl = launder(p.in[16]);
#pragma unroll
      for (int ni = 0; ni < 4; ++ni) { const float g = ggl[ni * 32 + r];
#pragma unroll
        for (int reg = 0; reg < 16; ++reg) { const int ro = ((reg & 3) + 8 * (reg >> 2)) * 520 + ni * 32; const float rv = bf2f(rgl[ro]);
          oil[ro] = f2bf(acc[ni][reg] * rs[reg] * g * silu_fast(rv)); } }
      __syncthreads();
#pragma unroll
      for (int i = 0; i < 8; ++i) { const int c = tid + 512 * i, row = c >> 6, cc = c & 63;
        *(uint4*)(MIXA + (size_t)row * 1024 + 512 + cc * 8) = *(const uint4*)(OIL + row * 1040 + cc * 16); }
    }
  }
}

DI void phase3c(const KP& p, char* lds, const int gather_reps, const int probe) {
  const int tid0 = threadIdx.x;
  const int r = tid0 & 31, hh = (tid0 >> 5) & 1, lane = tid0 & 63;
  char* wl = lds + LDS_WT + ((tid0 >> 6) & 3) * WT_BYTES;
  for (int tile = blockIdx.x; tile < 256; tile += gridDim.x) {
    unsigned char* ws = launder(p.ws); float* outp = launder(p.out); const float* xin = launder(p.in[0]);
    const int tok0 = tile * 64, b = tile >> 5;
    unsigned char* tsc = ws + WS_QM + (size_t)tile * P3_TILE_BYTES;
    bf16_t* QRY = (bf16_t*)tsc; bf16_t* Y = (bf16_t*)(ws + WS_QM) + (size_t)tok0 * 1024; bf16_t* MIXA = (bf16_t*)(ws + WS_P1S) + (size_t)tok0 * 1024; bf16_t* H2 = MIXA;
    const float* modb = launder((const float*)(ws + WS_MOD)) + b * 6144;
    __syncthreads();
    {
      const int tid = lv(tid0), lane = tid & 63, w = tid >> 6;
      float4 A1[4], A2[4], S2[4];
      const float* gpo = launder(p.in[6]); const float* gpf = launder(p.in[18]);
#pragma unroll
      for (int i = 0; i < 4; ++i) { const int d = (lane + 64 * i) * 4;
        const float4 gp = *(const float4*)(gpo + d), gt = *(const float4*)(modb + 2048 + d), g2 = *(const float4*)(gpf + d), sc = *(const float4*)(modb + 4096 + d);
        S2[i] = *(const float4*)(modb + 3072 + d);
        A1[i] = make_float4(gp.x * gt.x, gp.y * gt.y, gp.z * gt.z, gp.w * gt.w);
        A2[i] = make_float4(g2.x * (1.f + sc.x), g2.y * (1.f + sc.y), g2.z * (1.f + sc.z), g2.w * (1.f + sc.w)); }
#pragma unroll 2
      for (int rr = 0; rr < 8; ++rr) { const int row = w * 8 + rr; const size_t tok = tok0 + row;
        float4 yv[4]; float ss = 0.f;
#pragma unroll
        for (int i = 0; i < 4; ++i) { const uint2 u = *(const uint2*)(Y + (size_t)row * 1024 + (lane + 64 * i) * 4);
          yv[i] = make_float4(__uint_as_float(u.x << 16), __uint_as_float(u.x & 0xffff0000u), __uint_as_float(u.y << 16), __uint_as_float(u.y & 0xffff0000u));
          ss += yv[i].x * yv[i].x + yv[i].y * yv[i].y + yv[i].z * yv[i].z + yv[i].w * yv[i].w; }
        ss = wave_sum(ss); const float rs = rsqrtf(ss * (1.f / 1024.f) + EPS);
        float4 xv[4]; float s2 = 0.f;
#pragma unroll
        for (int i = 0; i < 4; ++i) { const float4 x = *(const float4*)(xin + tok * 1024 + (lane + 64 * i) * 4);
          xv[i] = make_float4(x.x + A1[i].x * yv[i].x * rs, x.y + A1[i].y * yv[i].y * rs, x.z + A1[i].z * yv[i].z * rs, x.w + A1[i].w * yv[i].w * rs);
          *(float4*)(outp + tok * 1024 + (lane + 64 * i) * 4) = xv[i];
          s2 += xv[i].x * xv[i].x + xv[i].y * xv[i].y + xv[i].z * xv[i].z + xv[i].w * xv[i].w; }
        s2 = wave_sum(s2); const float r2 = rsqrtf(s2 * (1.f / 1024.f) + EPS);
#pragma unroll
        for (int i = 0; i < 4; ++i) { uint2 o; o.x = pack2(xv[i].x * r2 * A2[i].x + S2[i].x, xv[i].y * r2 * A2[i].y + S2[i].y); o.y = pack2(xv[i].z * r2 * A2[i].z + S2[i].z, xv[i].w * r2 * A2[i].w + S2[i].w);
          *(uint2*)(H2 + (size_t)row * 1024 + (lane + 64 * i) * 4) = o; }
      }
    }
  }
}

DI void phase3b(const KP& p, char* lds, const int gather_reps, const int probe) {
  const int tid0 = threadIdx.x;
  const int r = tid0 & 31, hh = (tid0 >> 5) & 1, lane = tid0 & 63;
  char* wl = lds + LDS_WT + ((tid0 >> 6) & 3) * WT_BYTES;
  for (int tile = blockIdx.x; tile < 256; tile += gridDim.x) {
    unsigned char* ws = launder(p.ws); float* outp = launder(p.out); const float* xin = launder(p.in[0]);
    const int tok0 = tile * 64, b = tile >> 5;
    unsigned char* tsc = ws + WS_QM + (size_t)tile * P3_TILE_BYTES;
    bf16_t* QRY = (bf16_t*)tsc; bf16_t* Y = (bf16_t*)tsc; bf16_t* MIXA = (bf16_t*)(ws + WS_P1S) + (size_t)tok0 * 1024; bf16_t* H2 = MIXA;
    const float* modb = launder((const float*)(ws + WS_MOD)) + b * 6144;
    __syncthreads();
    float* SC = (float*)lds; unsigned* TK = (unsigned*)(lds + LDS_TK);
    for (int rep3e = 0; rep3e < (probe == 7 ? 2 : 1); ++rep3e)
    for (int h = 0; h < 8; ++h) {
      block_gemm<2>(lds, QRY + h * 256, 2048, (const bf16_t*)(ws + WS_KD), 1, 256, [&](int m0, int n0, const f32x16& a0, const f32x16& a1) {
        const int r2 = lv(r), h2 = lv(hh);
        float* sp = SC + (m0 + 4 * h2) * SCW + n0 + r2;
#pragma unroll
        for (int reg = 0; reg < 16; ++reg) { const int ro = ((reg & 3) + 8 * (reg >> 2)) * SCW; sp[ro] = a0[reg]; sp[ro + 32] = a1[reg]; }
      });
      __syncthreads();
      {
        const int tid = lv(tid0);
        const int tt = tid >> 3, sd = (tid >> 2) & 1, q = tid & 3;
        const float* sr = SC + tt * SCW + sd * 128 + q * 32;
        float a[16], c[16];
#pragma unroll
        for (int i = 0; i < 4; ++i) { const float4 v = *(const float4*)(sr + i * 4); const unsigned ib = q * 32 + i * 4;
          a[i * 4 + 0] = __uint_as_float((__float_as_uint(v.x) & 0xFFFFFF80u) | (ib + 0)); a[i * 4 + 1] = __uint_as_float((__float_as_uint(v.y) & 0xFFFFFF80u) | (ib + 1));
          a[i * 4 + 2] = __uint_as_float((__float_as_uint(v.z) & 0xFFFFFF80u) | (ib + 2)); a[i * 4 + 3] = __uint_as_float((__float_as_uint(v.w) & 0xFFFFFF80u) | (ib + 3)); }
#pragma unroll
        for (int i = 0; i < 4; ++i) { const float4 v = *(const float4*)(sr + 16 + i * 4); const unsigned ib = q * 32 + 16 + i * 4;
          c[i * 4 + 0] = __uint_as_float((__float_as_uint(v.x) & 0xFFFFFF80u) | (ib + 0)); c[i * 4 + 1] = __uint_as_float((__float_as_uint(v.y) & 0xFFFFFF80u) | (ib + 1));
          c[i * 4 + 2] = __uint_as_float((__float_as_uint(v.z) & 0xFFFFFF80u) | (ib + 2)); c[i * 4 + 3] = __uint_as_float((__float_as_uint(v.w) & 0xFFFFFF80u) | (ib + 3)); }
        sort16_desc(a); sort16_desc(c); top16_merge(a, c);
#pragma unroll
        for (int i = 0; i < 16; ++i) c[i] = dpp_f<0xB1>(a[i]);
        top16_merge(a, c);
#pragma unroll
        for (int i = 0; i < 16; ++i) c[i] = dpp_f<0x4E>(a[i]);
        top16_merge(a, c);
        if (q == 0) { unsigned* tk = TK + ((tt * 8 + h) * 2 + sd) * 16;
#pragma unroll
          for (int i = 0; i < 4; ++i) *(uint4*)(tk + i * 4) = make_uint4(__float_as_uint(a[i * 4]), __float_as_uint(a[i * 4 + 1]), __float_as_uint(a[i * 4 + 2]), __float_as_uint(a[i * 4 + 3])); }
      }
      __syncthreads();
    }
    {
      const int tid = lv(tid0);
      const int tt = tid >> 3, h = tid & 7;
      const unsigned* t1 = TK + ((tt * 8 + h) * 2) * 16; const unsigned* t2 = t1 + 16;
      float v1[16], v2[16];
#pragma unroll
      for (int i = 0; i < 4; ++i) { const uint4 u = *(const uint4*)(t1 + i * 4), v = *(const uint4*)(t2 + i * 4);
        v1[i * 4] = __uint_as_float(u.x & 0xFFFFFF80u); v1[i * 4 + 1] = __uint_as_float(u.y & 0xFFFFFF80u); v1[i * 4 + 2] = __uint_as_float(u.z & 0xFFFFFF80u); v1[i * 4 + 3] = __uint_as_float(u.w & 0xFFFFFF80u);
        v2[i * 4] = __uint_as_float(v.x & 0xFFFFFF80u); v2[i * 4 + 1] = __uint_as_float(v.y & 0xFFFFFF80u); v2[i * 4 + 2] = __uint_as_float(v.z & 0xFFFFFF80u); v2[i * 4 + 3] = __uint_as_float(v.w & 0xFFFFFF80u); }
      float best[16], grp[16];
#define CAND(i, j) __uint_as_float((__float_as_uint(v1[i] + v2[j]) & 0xFFFFFF00u) | ((i) << 4) | (j))
      best[0] = CAND(0, 0); best[1] = CAND(0, 1); best[2] = CAND(0, 2); best[3] = CAND(0, 3); best[4] = CAND(0, 4); best[5] = CAND(0, 5); best[6] = CAND(0, 6); best[7] = CAND(0, 7);
      best[8] = CAND(0, 8); best[9] = CAND(0, 9); best[10] = CAND(0, 10); best[11] = CAND(0, 11); best[12] = CAND(0, 12); best[13] = CAND(0, 13); best[14] = CAND(0, 14); best[15] = CAND(0, 15);
      sort16_desc(best);
      grp[0] = CAND(1, 0); grp[1] = CAND(1, 1); grp[2] = CAND(1, 2); grp[3] = CAND(1, 3); grp[4] = CAND(1, 4); grp[5] = CAND(1, 5); grp[6] = CAND(1, 6); grp[7] = CAND(1, 7);
      grp[8] = CAND(2, 0); grp[9] = CAND(2, 1); grp[10] = CAND(2, 2); grp[11] = CAND(2, 3); grp[12] = CAND(2, 4); grp[13] = CAND(3, 0); grp[14] = CAND(3, 1); grp[15] = CAND(3, 2);
      sort16_desc(grp); top16_merge(best, grp);
      grp[0] = CAND(3, 3); grp[1] = CAND(4, 0); grp[2] = CAND(4, 1); grp[3] = CAND(4, 2); grp[4] = CAND(5, 0); grp[5] = CAND(5, 1); grp[6] = CAND(6, 0); grp[7] = CAND(6, 1);
      grp[8] = CAND(7, 0); grp[9] = CAND(7, 1); grp[10] = CAND(8, 0); grp[11] = CAND(9, 0); grp[12] = CAND(10, 0); grp[13] = CAND(11, 0); grp[14] = CAND(12, 0); grp[15] = CAND(13, 0);
      sort16_desc(grp); top16_merge(best, grp);
      { const float c14 = CAND(14, 0), c15 = CAND(15, 0);
        grp[0] = fmaxf(c14, c15); grp[1] = fminf(c14, c15);
#pragma unroll
        for (int i = 2; i < 16; ++i) grp[i] = -3.0e38f;
        top16_merge(best, grp); }
#undef CAND
      __syncthreads();
      float sv[16]; int ev[16]; float mx = -3.0e38f;
#pragma unroll
      for (int k = 0; k < 16; ++k) { const unsigned key = __float_as_uint(best[k]); const int ci = (key >> 4) & 15, cj = key & 15;
        const unsigned k1 = t1[ci], k2 = t2[cj];
        sv[k] = __uint_as_float(k1 & 0xFFFFFF80u) + __uint_as_float(k2 & 0xFFFFFF80u); ev[k] = (int)((k1 & 127u) * 128u + (k2 & 127u)); mx = fmaxf(mx, sv[k]); }
      float sum = 0.f;
#pragma unroll
      for (int k = 0; k < 16; ++k) { sv[k] = __expf(sv[k] - mx); sum += sv[k]; }
      const float inv = 1.f / sum;
      unsigned* CNT = (unsigned*)(lds + LDS_CNT); unsigned short* OFFS = (unsigned short*)(lds + LDS_OFF); unsigned* EL = (unsigned*)lds; unsigned short* SE = (unsigned short*)(lds + LDS_SE);
      float scu[16], scv[16];
      { const float* SCU = (const float*)(ws + WS_ESC);
#pragma unroll
        for (int k = 0; k < 16; ++k) { scu[k] = SCU[ev[k]]; scv[k] = SCU[16384 + ev[k]]; } }
      CNT[tid] = 0u; if (GP_N > 8) CNT[tid + 512] = 0u;
      __syncthreads();
      int pos[16];
#pragma unroll
      for (int k = 0; k < 16; ++k) pos[k] = (int)atomicAdd(&CNT[tt * GP_N + (ev[k] >> GP_SH)], 1u);
      __syncthreads();
      if (h == 0) { unsigned run = 0;
#pragma unroll
        for (int q = 0; q < GP_N; ++q) { OFFS[tt * GP_OS + q] = (unsigned short)run; run += CNT[tt * GP_N + q]; }
        OFFS[tt * GP_OS + GP_N] = (unsigned short)run; }
      __syncthreads();
#pragma unroll
      for (int k = 0; k < 16; ++k) { const int d = (int)OFFS[tt * GP_OS + (ev[k] >> GP_SH)] + pos[k];
        EL[tt * 128 + d] = ((__float_as_uint(sv[k] * inv) + 0x2000u) & 0xFFFFC000u) | (unsigned)ev[k];
        SE[tt * 128 + d] = (unsigned short)((((__float_as_uint(scu[k]) >> 23) & 255u) << 8) | ((__float_as_uint(scv[k]) >> 23) & 255u)); }
    }
    __syncthreads();
    {
      const int tid = lv(tid0), lane = tid & 63, w = tid >> 6;
      const unsigned char* EU = ws + WS_EU; const unsigned char* EV = ws + WS_EV;
      unsigned* EL = (unsigned*)lds; const unsigned short* OFFS = (const unsigned short*)(lds + LDS_OFF); unsigned* LIST = (unsigned*)(lds + LDS_LIST) + w * 256; char* H2W = lds + LDS_H2L + w * 8192;
      const unsigned short* SE = (const unsigned short*)(lds + LDS_SE);
      const float* gpf2 = launder(p.in[19]);
      const int rot = (int)(__builtin_amdgcn_s_getreg((3 << 11) | 20) & 0xFu) * (GP_N / 8);
      const unsigned voff = (unsigned)lane * 16u;
      const int sl = lane & 7;
      typedef float f2v __attribute__((ext_vector_type(2))); typedef unsigned u32x4_t __attribute__((ext_vector_type(4)));
#define CVLO(wd) __builtin_amdgcn_cvt_pk_f32_fp8((int)(wd), false)
#define CVHI(wd) __builtin_amdgcn_cvt_pk_f32_fp8((int)(wd), true)
#define BF2(wd) ((f2v){__uint_as_float((wd) << 16), __uint_as_float((wd) & 0xffff0000u)})
#define DPPF(x, CTRL) __int_as_float(__builtin_amdgcn_update_dpp(0, __float_as_int(x), CTRL, 0xF, 0xF, true))
#define R_INIT(R, TAG) do { _Pragma("unroll") for (int k2 = 0; k2 < 8; ++k2) asm volatile("; init " TAG : "=v"(R[k2])); } while (0)
#define EIDX(D) ((row0 + ((D) >> 11)) * 128 + (((D) >> 4) & 127) + (sl < ((D) & 15) ? sl : 0))
#define G_FETCH(DX, PKX, R, TAB, TAG) do { DX = Dn; PKX = PKn; { const int es_ = (int)(PKX & 16383u); const unsigned char* rp_[8]; \
        _Pragma("unroll") for (int k2 = 0; k2 < 8; ++k2) rp_[k2] = TAB + (size_t)(unsigned)__builtin_amdgcn_readlane(es_, k2) * 1024; \
        asm volatile("global_load_dwordx4 %0, %8, %9 ; " TAG "\n\tglobal_load_dwordx4 %1, %8, %10\n\tglobal_load_dwordx4 %2, %8, %11\n\tglobal_load_dwordx4 %3, %8, %12\n\t" \
                     "global_load_dwordx4 %4, %8, %13\n\tglobal_load_dwordx4 %5, %8, %14\n\tglobal_load_dwordx4 %6, %8, %15\n\tglobal_load_dwordx4 %7, %8, %16" \
                     : "+v"(R[0]), "+v"(R[1]), "+v"(R[2]), "+v"(R[3]), "+v"(R[4]), "+v"(R[5]), "+v"(R[6]), "+v"(R[7])     \
                     : "v"(voff), "s"(rp_[0]), "s"(rp_[1]), "s"(rp_[2]), "s"(rp_[3]), "s"(rp_[4]), "s"(rp_[5]), "s"(rp_[6]), "s"(rp_[7])); } \
        Dn = __builtin_amdgcn_readfirstlane((int)tmpL); PKn = EL[EIDX(Dn)]; tmpL = LIST[sidx]; ++sidx; } while (0)
#define G_WAITK(R, k2) asm volatile("s_waitcnt vmcnt(%1)" : "+v"(R[k2]) : "n"(15 - (k2)))
#define G_DRAIN(RA_, RB_) do { asm volatile("s_waitcnt vmcnt(0)" : "+v"(RA_[0]), "+v"(RA_[1]), "+v"(RA_[2]), "+v"(RA_[3]), "+v"(RA_[4]), "+v"(RA_[5]), "+v"(RA_[6]), "+v"(RA_[7])); \
        asm volatile("" : "+v"(RB_[0]), "+v"(RB_[1]), "+v"(RB_[2]), "+v"(RB_[3]), "+v"(RB_[4]), "+v"(RB_[5]), "+v"(RB_[6]), "+v"(RB_[7])); } while (0)
#define U_COMPUTE(D, PK, R) do { if ((D) != 0) { const int n_ = (D) & 15, rr_ = (D) >> 11; \
        const unsigned se_ = (unsigned)SE[EIDX(D)]; \
        if (rr_ != cur) { cur = rr_; const uint4 hA = *(const uint4*)(H2W + rr_ * 2048 + lane * 32), hB = *(const uint4*)(H2W + rr_ * 2048 + lane * 32 + 16); \
          hf2[0] = BF2(hA.x); hf2[1] = BF2(hA.y); hf2[2] = BF2(hA.z); hf2[3] = BF2(hA.w); hf2[4] = BF2(hB.x); hf2[5] = BF2(hB.y); hf2[6] = BF2(hB.z); hf2[7] = BF2(hB.w); } \
        float P[8]; \
        _Pragma("unroll") for (int k2 = 0; k2 < 8; ++k2) { P[k2] = 0.f; \
          if (k2 < n_) { G_WAITK(R, k2); f2v d2 = CVLO(R[k2][0]) * hf2[0]; d2 += CVHI(R[k2][0]) * hf2[1]; d2 += CVLO(R[k2][1]) * hf2[2]; d2 += CVHI(R[k2][1]) * hf2[3]; \
            d2 += CVLO(R[k2][2]) * hf2[4]; d2 += CVHI(R[k2][2]) * hf2[5]; d2 += CVLO(R[k2][3]) * hf2[6]; d2 += CVHI(R[k2][3]) * hf2[7]; P[k2] = d2.x + d2.y; } } \
          \
        _Pragma("unroll") for (int e = 0; e < 4; ++e) { const float a_ = P[e] + DPPF(P[e], 0x141), b_ = P[e + 4] + DPPF(P[e + 4], 0x141); P[e] = (lane & 4) ? b_ : a_; } \
        _Pragma("unroll") for (int e = 0; e < 2; ++e) { const float a_ = P[e] + DPPF(P[e], 0x4E), b_ = P[e + 2] + DPPF(P[e + 2], 0x4E); P[e] = (lane & 2) ? b_ : a_; } \
        float av; { const float a_ = P[0] + DPPF(P[0], 0xB1), b_ = P[1] + DPPF(P[1], 0xB1); av = (lane & 1) ? b_ : a_; } \
        av += DPPF(av, 0x128); \
        { const auto s16 = __builtin_amdgcn_permlane16_swap(__float_as_uint(av), __float_as_uint(av), false, false); av = __uint_as_float(s16[0]) + __uint_as_float(s16[1]); } \
        { const auto s32 = __builtin_amdgcn_permlane32_swap(__float_as_uint(av), __float_as_uint(av), false, false); av = __uint_as_float(s32[0]) + __uint_as_float(s32[1]); } \
        av *= __uint_as_float((se_ >> 8) << 23); \
          \
        const float ax = fabsf(av), t = __builtin_amdgcn_rcpf(ax * 0.2316418882f + 1.0f); \
        float q = t * 0.5307027145f + (-0.7265760135f); q = q * t + 0.7107068705f; q = q * t + (-0.142248368f); q = q * t + 0.127414796f; q = q * t; \
        const float ee = __builtin_amdgcn_exp2f(av * av * (-0.72134752044f)); \
        const float mm = av * (q * ee), gl = (av < 0.f) ? mm : (av - mm); \
        const float wv = __uint_as_float(PK & 0xFFFFC000u) * gl * __uint_as_float((se_ & 255u) << 23); \
        if (lane < n_) EL[EIDX(D)] = ((__float_as_uint(wv) + 0x2000u) & 0xFFFFC000u) | (PK & 16383u); } } while (0)
#define Y_PARK() do { uint4 y0, y1; y0.x = pack2(acc[0].x, acc[0].y); y0.y = pack2(acc[1].x, acc[1].y); y0.z = pack2(acc[2].x, acc[2].y); y0.w = pack2(acc[3].x, acc[3].y); \
        y1.x = pack2(acc[4].x, acc[4].y); y1.y = pack2(acc[5].x, acc[5].y); y1.z = pack2(acc[6].x, acc[6].y); y1.w = pack2(acc[7].x, acc[7].y); \
        *(uint4*)(H2W + cur * 2048 + lane * 32) = y0; *(uint4*)(H2W + cur * 2048 + lane * 32 + 16) = y1; } while (0)
#define V_COMPUTE(D, PK, R) do { if ((D) != 0) { const int n_ = (D) & 15, rr_ = (D) >> 11; \
        if (rr_ != cur) { if (cur >= 0) Y_PARK(); cur = rr_; \
          const uint4 hA = *(const uint4*)(H2W + rr_ * 2048 + lane * 32), hB = *(const uint4*)(H2W + rr_ * 2048 + lane * 32 + 16); \
          acc[0] = BF2(hA.x); acc[1] = BF2(hA.y); acc[2] = BF2(hA.z); acc[3] = BF2(hA.w); acc[4] = BF2(hB.x); acc[5] = BF2(hB.y); acc[6] = BF2(hB.z); acc[7] = BF2(hB.w); } \
        const float wv_ = (sl < n_) ? __uint_as_float(PK & 0xFFFFC000u) : 0.f; \
        _Pragma("unroll") for (int k2 = 0; k2 < 8; ++k2) if (k2 < n_) { const float wk = __int_as_float(__builtin_amdgcn_readlane(__float_as_int(wv_), k2)); const f2v wk2 = {wk, wk}; \
          G_WAITK(R, k2); \
          acc[0] += CVLO(R[k2][0]) * wk2; acc[1] += CVHI(R[k2][0]) * wk2; acc[2] += CVLO(R[k2][1]) * wk2; acc[3] += CVHI(R[k2][1]) * wk2; \
          acc[4] += CVLO(R[k2][2]) * wk2; acc[5] += CVHI(R[k2][2]) * wk2; acc[6] += CVLO(R[k2][3]) * wk2; acc[7] += CVHI(R[k2][3]) * wk2; } } } while (0)
#define G_PROLOGUE() do { Dn = __builtin_amdgcn_readfirstlane((int)LIST[0]); PKn = EL[EIDX(Dn)]; tmpL = LIST[1]; sidx = 2; } while (0)
#pragma unroll 1
      for (int half = 0; half < 2; ++half) {
        const int row0 = half * 32 + w * 4;
        __builtin_amdgcn_wave_barrier(); asm volatile("" ::: "memory");
        { const uint4* src = (const uint4*)(H2 + (size_t)row0 * 1024); uint4 t[8];
#pragma unroll
          for (int i = 0; i < 8; ++i) t[i] = src[lane + 64 * i];
#pragma unroll
          for (int i = 0; i < 8; ++i) ((uint4*)H2W)[lane + 64 * i] = t[i]; }
        int ns;
        {
          const int rr = lane & 3, part = ((lane >> 2) + rot) & (GP_N - 1);
          int o0 = 0, o1 = 0;
          if (lane < 4 * GP_N) { o0 = (int)OFFS[(row0 + rr) * GP_OS + part]; o1 = (int)OFFS[(row0 + rr) * GP_OS + part + 1]; }
          const int nst = (o1 - o0 + 7) >> 3;
          int incl = nst;
#pragma unroll
          for (int d = 1; d < 64; d <<= 1) { const int t = __shfl_up(incl, d); if (lane >= d) incl += t; }
          const int off = incl - nst;
          for (int j = 0; j < nst; ++j) { const int base = o0 + 8 * j; const int nn = (o1 - base < 8) ? (o1 - base) : 8; LIST[off + j] = (unsigned)(nn | (base << 4) | (rr << 11)); }
          ns = __builtin_amdgcn_readlane(incl, 63);
          if (lane < 8) LIST[ns + lane] = 0u; }
        __builtin_amdgcn_wave_barrier(); asm volatile("s_waitcnt vmcnt(0)" ::: "memory");
        {
          int DA, DB, Dn, sidx, cur = -1; unsigned PKA, PKB, PKn, tmpL; u32x4_t RA[8], RB[8]; f2v hf2[8];
          R_INIT(RA, "uA"); R_INIT(RB, "uB");
          G_PROLOGUE(); G_FETCH(DA, PKA, RA, EU, "uA0");
#pragma unroll 1
          for (int s = 0; s < ns; s += 2) {
            G_FETCH(DB, PKB, RB, EU, "uB"); U_COMPUTE(DA, PKA, RA);
            G_FETCH(DA, PKA, RA, EU, "uA"); U_COMPUTE(DB, PKB, RB);
          }
          G_DRAIN(RA, RB);
        }
        __builtin_amdgcn_wave_barrier(); asm volatile("s_waitcnt vmcnt(0)" ::: "memory");
        { const uint4 z4 = make_uint4(0u, 0u, 0u, 0u);
#pragma unroll
          for (int i = 0; i < 8; ++i) ((uint4*)H2W)[lane + 64 * i] = z4; }
        __builtin_amdgcn_wave_barrier(); asm volatile("" ::: "memory");
        {
          int DA, DB, Dn, sidx, cur = -1; unsigned PKA, PKB, PKn, tmpL; u32x4_t RA[8], RB[8]; f2v acc[8];
          R_INIT(RA, "vA"); R_INIT(RB, "vB");
          G_PROLOGUE(); G_FETCH(DA, PKA, RA, EV, "vA0");
#pragma unroll 1
          for (int s = 0; s < ns; s += 2) {
            G_FETCH(DB, PKB, RB, EV, "vB"); V_COMPUTE(DA, PKA, RA);
            G_FETCH(DA, PKA, RA, EV, "vA"); V_COMPUTE(DB, PKB, RB);
          }
          G_DRAIN(RA, RB);
          if (cur >= 0) Y_PARK();
        }
        __builtin_amdgcn_wave_barrier(); asm volatile("s_waitcnt vmcnt(0)" ::: "memory");
#pragma unroll 1
        for (int rr = 0; rr < 4; ++rr) { const size_t tok = tok0 + row0 + rr;
          const uint4 hA = *(const uint4*)(H2W + rr * 2048 + lane * 32), hB = *(const uint4*)(H2W + rr * 2048 + lane * 32 + 16);
          f2v a[8]; a[0] = BF2(hA.x); a[1] = BF2(hA.y); a[2] = BF2(hA.z); a[3] = BF2(hA.w); a[4] = BF2(hB.x); a[5] = BF2(hB.y); a[6] = BF2(hB.z); a[7] = BF2(hB.w);
          float ss = 0.f;
#pragma unroll
          for (int i = 0; i < 8; ++i) ss += a[i].x * a[i].x + a[i].y * a[i].y;
          ss = wave_sum(ss); const float rs = rsqrtf(ss * (1.f / 1024.f) + EPS);
          float* orow = outp + tok * 1024 + lane * 16;
#pragma unroll
          for (int i = 0; i < 4; ++i) { const int d = lane * 16 + 4 * i;
            float4 x1 = *(const float4*)(orow + 4 * i); const float4 g3 = *(const float4*)(gpf2 + d), g2 = *(const float4*)(modb + 5120 + d);
            x1.x += g3.x * g2.x * a[2 * i].x * rs; x1.y += g3.y * g2.y * a[2 * i].y * rs; x1.z += g3.z * g2.z * a[2 * i + 1].x * rs; x1.w += g3.w * g2.w * a[2 * i + 1].y * rs;
            *(float4*)(orow + 4 * i) = x1; }
        }
      }
#undef CVLO
#undef CVHI
#undef BF2
#undef DPPF
#undef R_INIT
#undef EIDX
#undef G_FETCH
#undef G_WAITK
#undef G_DRAIN
#undef U_COMPUTE
#undef Y_PARK
#undef V_COMPUTE
#undef G_PROLOGUE
    }
  }
}

DI void phase2_scan(const KP& p) {
  unsigned char* ws = p.ws;
  for (int g = blockIdx.x * NTHR + threadIdx.x; g < 131072; g += gridDim.x * NTHR) {
    const int seq = g >> 11, within = g & 2047, dv = within >> 4, dk4 = (within & 15) * 4, dir = seq & 1;
    bf16_t* base = (bf16_t*)(ws + WS_SPT) + ((size_t)seq * 32 * 128 + dv) * 64 + dk4;
    const float* dec = (const float*)(ws + WS_DEC) + (size_t)seq * 32 * 64 + dk4;
    float s0 = 0.f, s1 = 0.f, s2 = 0.f, s3 = 0.f;
#pragma unroll 1
    for (int i0 = 0; i0 < 32; i0 += 8) {
      uint2 d[8]; float4 c[8];
#pragma unroll
      for (int j = 0; j < 8; ++j) { const int n = dir ? 31 - (i0 + j) : (i0 + j); d[j] = *(const uint2*)(base + (size_t)n * 8192); c[j] = *(const float4*)(dec + n * 64); }
#pragma unroll
      for (int j = 0; j < 8; ++j) { const int n = dir ? 31 - (i0 + j) : (i0 + j);
        uint2 o; o.x = pack2(s0, s1); o.y = pack2(s2, s3); *(uint2*)(base + (size_t)n * 8192) = o;
        s0 = c[j].x * s0 + __uint_as_float(d[j].x << 16); s1 = c[j].y * s1 + __uint_as_float(d[j].x & 0xffff0000u);
        s2 = c[j].z * s2 + __uint_as_float(d[j].y << 16); s3 = c[j].w * s3 + __uint_as_float(d[j].y & 0xffff0000u); }
    }
  }
}

#define XB_TMO      128
#define XB_XCNT(j)  (256  + 64 * (j))
#define XB_XSUB(j)  (1280 + 64 * (j))
#define XB_XGEN(j)  (2304 + 64 * (j))
#define XB_TOP      3328
#define XB_TOPGEN   3392
#define XCD_BAR_WORDS 3456
#define XB_SPIN_CAP (1u << 18)
#define LAS __attribute__((address_space(3)))

__device__ __forceinline__ unsigned xb_ld(unsigned* p)              { return __hip_atomic_load(p, __ATOMIC_RELAXED, __HIP_MEMORY_SCOPE_AGENT); }
__device__ __forceinline__ unsigned xb_add(unsigned* p, unsigned v) { return __hip_atomic_fetch_add(p, v, __ATOMIC_RELAXED, __HIP_MEMORY_SCOPE_AGENT); }
__device__ __forceinline__ unsigned xb_xcc_id() { return (unsigned)__builtin_amdgcn_s_getreg((3 << 11) | 20) & 0xFu; }
#define XB_SPIN(cond, bar) do { unsigned _sp = 0; while (cond) { __builtin_amdgcn_s_sleep(1); \
    if ((++_sp & 255u) == 0u) { if (xb_ld(&(bar)[XB_TMO])) break; if (_sp > XB_SPIN_CAP) { atomicAdd(&(bar)[XB_TMO], 1u); break; } } } } while (0)

struct XcdBarrier {
    unsigned* bar; unsigned x;
    volatile LAS unsigned* st;
};

__device__ __forceinline__ XcdBarrier xcd_barrier_post(unsigned* bar, volatile LAS unsigned* st) {
    XcdBarrier b; b.bar = bar; b.x = xb_xcc_id(); b.st = st;
    if (threadIdx.x == 0) (void)xb_add(&bar[XB_XCNT(b.x)], 1u);
    return b;
}
__device__ __forceinline__ void xcd_barrier_complete(unsigned* bar, unsigned x, unsigned& nloc, unsigned& nx) {
    const unsigned G = gridDim.x * gridDim.y * gridDim.z;
    unsigned sum, cnt, mine, sp = 0u;
    for (;;) {
        sum = 0u; cnt = 0u; mine = 0u;
#pragma unroll
        for (unsigned j = 0; j < 16; ++j) { const unsigned c = xb_ld(&bar[XB_XCNT(j)]); sum += c; cnt += (c > 0u) ? 1u : 0u; mine = (j == x) ? c : mine; }
        if (sum == G) break;
        __builtin_amdgcn_s_sleep(1);
        if ((++sp & 255u) == 0u) { if (xb_ld(&bar[XB_TMO])) break; if (sp > XB_SPIN_CAP) { atomicAdd(&bar[XB_TMO], 1u); break; } }
    }
    nloc = mine > 0u ? mine : 1u; nx = cnt > 0u ? cnt : 1u;
}

__device__ __forceinline__ void xcd_barrier(const XcdBarrier& b) {
    asm volatile("s_waitcnt vmcnt(0)" ::: "memory");
    __syncthreads();
    if (threadIdx.x == 0) {
        unsigned* bar = b.bar;
        __builtin_amdgcn_s_waitcnt(0);
        unsigned nloc = b.st[0], nx = b.st[1];
        if (nloc == 0u) { xcd_barrier_complete(bar, b.x, nloc, nx); b.st[0] = nloc; b.st[1] = nx; }
        const unsigned old = xb_add(&bar[XB_XSUB(b.x)], 1u);
        const unsigned gen = old / nloc;
        if (old + 1u == (gen + 1u) * nloc) {
            __builtin_amdgcn_fence(__ATOMIC_RELEASE, "agent");
            asm volatile("s_waitcnt vmcnt(0)" ::: "memory");
            const unsigned og = xb_add(&bar[XB_TOP], 1u);
            const unsigned tg = og / nx;
            if (og + 1u == (tg + 1u) * nx) xb_add(&bar[XB_TOPGEN], 1u);
            else XB_SPIN(xb_ld(&bar[XB_TOPGEN]) == tg, bar);
            __builtin_amdgcn_fence(__ATOMIC_ACQUIRE, "agent");
            xb_add(&bar[XB_XGEN(b.x)], 1u);
            asm volatile("s_waitcnt vmcnt(0)" ::: "memory");
        } else {
            XB_SPIN(xb_ld(&bar[XB_XGEN(b.x)]) == gen, bar);
            __builtin_amdgcn_fence(__ATOMIC_ACQUIRE, "agent");
            asm volatile("s_waitcnt vmcnt(0)" ::: "memory");
        }
    }
    __syncthreads();
}

#ifndef PROBE_ID
#define PROBE_ID 0
#endif
__global__ void __launch_bounds__(NTHR, 2) mega(KP p) {
  extern __shared__ __attribute__((aligned(16))) char lds[];
  cg::grid_group grid = cg::this_grid();
  const int hi = p.ph_hi; constexpr int probe = PROBE_ID;
  if (threadIdx.x == 0) { ((volatile LAS unsigned*)(lds + LDS_XB))[0] = 0u; ((volatile LAS unsigned*)(lds + LDS_XB))[1] = 0u; }
  __syncthreads();
  const XcdBarrier xb = xcd_barrier_post((unsigned*)(p.ws + WS_BAR), (volatile LAS unsigned*)(lds + LDS_XB));
  if (p.ph_lo <= 0 && 0 < hi) { phase0(p, lds); if (probe == 1) phase0(p, lds); if (1 < hi) { if (hi > 64) grid.sync(); else xcd_barrier(xb); } }
  if (p.ph_lo <= 1 && 1 < hi) {
    phase1a(p, lds);
    xcd_barrier(xb);
    {
      pg8::Gemm g{(const pg8::bf16_t*)p.out, (const pg8::bf16_t*)(p.ws + WS_WTINP), NTOK, 2304, 1024};
      pg8::StaticOrder S; S.init(NTOK, 2304, (int)gridDim.x, (int)blockIdx.x);
      pg8::EpiProj E{(pg8::bf16_t*)(p.ws + WS_P1S), (pg8::bf16_t*)((unsigned char*)p.out + 32 * MiB), (pg8::bf16_t*)(p.ws + WS_PROJC)};
      pg8::gemm_phase<pg8::EpiProj, pg8::StaticOrder, true, true>((PG8_LAS unsigned char*)lds, g, S, E);
      if (blockIdx.x >= 64) convert_experts(p, (int)blockIdx.x - 64, (int)gridDim.x - 64);
    }
    xcd_barrier(xb);
    phase1c(p, lds);
    if (2 < hi) xcd_barrier(xb);
  }
  if (p.ph_lo <= 2 && 2 < hi) { phase2_scan(p); phase2_attn(p, lds); if (probe == 3) phase2_attn(p, lds); if (3 < hi) xcd_barrier(xb); }
  if (p.ph_lo <= 3 && 3 < hi) {
    phase3(p, lds, 1, probe);
    xcd_barrier(xb);
    {
      pg8::Gemm g{(const pg8::bf16_t*)(p.ws + WS_P1S), (const pg8::bf16_t*)(p.ws + WS_WTOUTP), NTOK, 1024, 1024};
      pg8::StaticOrder S; S.init(NTOK, 1024, (int)gridDim.x, (int)blockIdx.x);
      pg8::EpiBf16<0> E{(pg8::bf16_t*)(p.ws + WS_QM), 1024, nullptr, 0, 0, 1.f};
      pg8::gemm_phase<pg8::EpiBf16<0>, pg8::StaticOrder, true, true>((PG8_LAS unsigned char*)lds, g, S, E);
    }
    xcd_barrier(xb);
    phase3c(p, lds, 1, probe);
    xcd_barrier(xb);
    {
      pg8::Gemm g{(const pg8::bf16_t*)(p.ws + WS_P1S), (const pg8::bf16_t*)(p.ws + WS_WTPQP), NTOK, 2048, 1024};
      pg8::StaticOrder S; S.init(NTOK, 2048, (int)gridDim.x, (int)blockIdx.x);
      pg8::EpiBf16<0> E{(pg8::bf16_t*)(p.ws + WS_QM), 2048, nullptr, 0, 0, 1.f};
      pg8::gemm_phase<pg8::EpiBf16<0>, pg8::StaticOrder, true, true>((PG8_LAS unsigned char*)lds, g, S, E);
    }
    xcd_barrier(xb);
    phase3b(p, lds, (probe == 4 || probe == 8 || probe == 9 || probe == 10) ? 2 : 1, probe);
  }
}

extern "C" void kernel_launch(void* const* d_in, const int* in_sizes, int n_in, void* d_out, int out_size, void* d_ws, size_t ws_size, hipStream_t stream) {
  float* out = (float*)d_out;
  unsigned char* ws = (unsigned char*)d_ws;
  if (ws_size < WS_END || n_in != 25) return;
  static bool attr_done = false;
  if (!attr_done) { (void)hipFuncSetAttribute((const void*)mega, hipFuncAttributeMaxDynamicSharedMemorySize, LDS_TOTAL); attr_done = true; }
  KP p{};
  for (int i = 0; i < 25; ++i) p.in[i] = (const float*)d_in[i];
  p.out = out; p.ws = ws;
  p.ph_lo = 0; p.ph_hi = 4;
  (void)hipMemsetAsync(ws + WS_BAR, 0, XCD_BAR_WORDS * 4, stream);
  { void* args[] = {&p}; (void)hipLaunchCooperativeKernel((const void*)mega, dim3(256), dim3(NTHR), args, LDS_TOTAL, stream); }
}
```

```cpp
#include <hip/hip_runtime.h>
#include <hip/hip_cooperative_groups.h>
namespace cg = cooperative_groups;
#include <stdint.h>

typedef unsigned short bf16_t;
#define DI __device__ __forceinline__

DI float bf2f(bf16_t v) { return __uint_as_float(((unsigned)v) << 16); }
DI bf16_t f2bf(float f) { return __builtin_bit_cast(unsigned short, (__bf16)f); }

constexpr int BATCH = 8, SEQ = 2048, DM = 1024, NTOK = BATCH * SEQ;
constexpr int INW = 2272;
constexpr float EPS = 1e-6f;
constexpr int O_CQ = 0, O_CKV = 384, O_KR = 640, O_QG = 704, O_KG = 960, O_VG = 1216, O_GF = 1728, O_GB = 1744, O_R = 1760;

DI float wave_sum(float v) {
#pragma unroll
  for (int o = 1; o < 64; o <<= 1) v += __shfl_xor(v, o);
  return v;
}
DI float wave_max(float v) {
#pragma unroll
  for (int o = 1; o < 64; o <<= 1) v = fmaxf(v, __shfl_xor(v, o));
  return v;
}
DI float block_sum256(float v, float* red) {
  v = wave_sum(v);
  __syncthreads();
  if ((threadIdx.x & 63) == 0) red[threadIdx.x >> 6] = v;
  __syncthreads();
  return red[0] + red[1] + red[2] + red[3];
}
DI float block_max256(float v, float* red) {
  v = wave_max(v);
  __syncthreads();
  if ((threadIdx.x & 63) == 0) red[threadIdx.x >> 6] = v;
  __syncthreads();
  return fmaxf(fmaxf(red[0], red[1]), fmaxf(red[2], red[3]));
}
DI float silu_f(float x) { return x / (1.f + expf(-x)); }
DI float logsigmoid_f(float x) { return fminf(x, 0.f) - log1pf(expf(-fabsf(x))); }
DI float fexp(float x) { return __builtin_amdgcn_exp2f(x * 1.4426950408889634f); }
DI float silu_fast(float x) { return x * __builtin_amdgcn_rcpf(1.f + fexp(-x)); }
DI float logsigmoid_fast(float x) { return fminf(x, 0.f) - __builtin_amdgcn_logf(1.f + fexp(-fabsf(x))) * 0.6931471805599453f; }
DI float gelu_erf(float x) { return 0.5f * x * (1.f + erff(x * 0.70710678118654752f)); }

__global__ __launch_bounds__(256) void n_mod(const float* __restrict__ c, const float* __restrict__ w_ada, const float* __restrict__ b_ada, float* __restrict__ mod) {
  int idx = blockIdx.x * 256 + threadIdx.x;
  int b = idx / 6144, j = idx % 6144;
  float acc = b_ada[j];
  for (int k = 0; k < 1024; ++k) acc += silu_f(c[b * 1024 + k]) * w_ada[(size_t)k * 6144 + j];
  mod[idx] = acc;
}

__global__ __launch_bounds__(256) void n_hnorm(const float* __restrict__ x, const float* __restrict__ g, const float* __restrict__ mod, int b, int off_sh, int off_sc, float* __restrict__ h) {
  __shared__ float red[4];
  int t = blockIdx.x, tid = threadIdx.x;
  const float* xr = x + ((size_t)b * SEQ + t) * DM;
  float v[4]; float ss = 0.f;
#pragma unroll
  for (int i = 0; i < 4; ++i) { v[i] = xr[tid + 256 * i]; ss += v[i] * v[i]; }
  ss = block_sum256(ss, red);
  float rs = rsqrtf(ss * (1.f / DM) + EPS);
#pragma unroll
  for (int i = 0; i < 4; ++i) { int d = tid + 256 * i; h[(size_t)t * DM + d] = v[i] * rs * g[d] * (1.f + mod[b * 6144 + off_sc + d]) + mod[b * 6144 + off_sh + d]; }
}

template <bool BT>
__global__ __launch_bounds__(256) void n_gemm(const float* __restrict__ A, int lda, const float* __restrict__ B, int ldb, float* __restrict__ C, int ldc, int M, int N, int K) {
  __shared__ float As[16][65];
  __shared__ float Bs[16][65];
  const int tid = threadIdx.x, tx = tid & 15, ty = tid >> 4;
  const int m0 = blockIdx.y * 64, n0 = blockIdx.x * 64;
  float acc[4][4];
#pragma unroll
  for (int i = 0; i < 4; ++i)
#pragma unroll
    for (int j = 0; j < 4; ++j) acc[i][j] = 0.f;
  for (int k0 = 0; k0 < K; k0 += 16) {
#pragma unroll
    for (int i = 0; i < 4; ++i) { int e = tid + 256 * i; int m = e >> 4, k = e & 15; As[k][m] = A[(size_t)(m0 + m) * lda + k0 + k]; }
#pragma unroll
    for (int i = 0; i < 4; ++i) { int e = tid + 256 * i;
      if (!BT) { int k = e >> 6, n = e & 63; Bs[k][n] = (n0 + n < N) ? B[(size_t)(k0 + k) * ldb + n0 + n] : 0.f; }
      else     { int n = e >> 4, k = e & 15; Bs[k][n] = (n0 + n < N) ? B[(size_t)(n0 + n) * ldb + k0 + k] : 0.f; } }
    __syncthreads();
#pragma unroll
    for (int k = 0; k < 16; ++k) {
      float a[4], bb[4];
#pragma unroll
      for (int i = 0; i < 4; ++i) { a[i] = As[k][ty * 4 + i]; bb[i] = Bs[k][tx * 4 + i]; }
#pragma unroll
      for (int i = 0; i < 4; ++i)
#pragma unroll
        for (int j = 0; j < 4; ++j) acc[i][j] += a[i] * bb[j];
    }
    __syncthreads();
  }
#pragma unroll
  for (int i = 0; i < 4; ++i)
#pragma unroll
    for (int j = 0; j < 4; ++j) { int n = n0 + tx * 4 + j; if (n < N) C[(size_t)(m0 + ty * 4 + i) * ldc + n] = acc[i][j]; }
}

__global__ __launch_bounds__(256) void n_rms_slice(const float* __restrict__ in, int ldin, int off, int W, const float* __restrict__ g, float* __restrict__ out) {
  __shared__ float red[4];
  int t = blockIdx.x, tid = threadIdx.x;
  float v0 = (tid < W) ? in[(size_t)t * ldin + off + tid] : 0.f;
  float v1 = (tid + 256 < W) ? in[(size_t)t * ldin + off + tid + 256] : 0.f;
  float ss = block_sum256(v0 * v0 + v1 * v1, red);
  float rs = rsqrtf(ss / (float)W + EPS);
  if (tid < W) out[(size_t)t * W + tid] = v0 * rs * g[tid];
  if (tid + 256 < W) out[(size_t)t * W + tid + 256] = v1 * rs * g[tid + 256];
}

__global__ __launch_bounds__(256) void n_scatter(const float* __restrict__ proj, const float* __restrict__ qa, const float* __restrict__ kv, const int* __restrict__ positions, int b,
                                                 const float* __restrict__ wgf, const float* __restrict__ bgf, const float* __restrict__ wgb, const float* __restrict__ bgb,
                                                 bf16_t* __restrict__ Qm, bf16_t* __restrict__ Km, bf16_t* __restrict__ Vm, bf16_t* __restrict__ qg, bf16_t* __restrict__ kg, bf16_t* __restrict__ vg,
                                                 bf16_t* __restrict__ rg, float* __restrict__ laf, float* __restrict__ lab) {
  __shared__ float cs[32], sn[32];
  const int t = blockIdx.x, tid = threadIdx.x;
  const size_t tok = (size_t)b * SEQ + t;
  const float* pr = proj + (size_t)t * INW;
  const float* qr = qa + (size_t)t * 768;
  const float* kr = kv + (size_t)t * 1024;
  if (tid < 32) {
    float inv = powf(10000.f, -(float)tid / 32.f);
    float ang = (float)positions[tok] * inv;
    cs[tid] = cosf(ang); sn[tid] = sinf(ang);
  }
  __syncthreads();
  for (int e = tid; e < 4 * 192; e += 256) {
    int h = e / 192, d = e % 192; float v;
    if (d < 128) v = qr[h * 192 + d];
    else { int j = d - 128; const float* rp = qr + h * 192 + 128;
      if (j < 32) v = rp[j] * cs[j] - rp[j + 32] * sn[j]; else v = rp[j] * cs[j - 32] + rp[j - 32] * sn[j - 32]; }
    Qm[(((size_t)b * 4 + h) * SEQ + t) * 192 + d] = f2bf(v);
  }
  for (int e = tid; e < 4 * 192; e += 256) {
    int h = e / 192, d = e % 192; float v;
    if (d < 128) v = kr[h * 256 + d];
    else { int j = d - 128; const float* rp = pr + O_KR;
      if (j < 32) v = rp[j] * cs[j] - rp[j + 32] * sn[j]; else v = rp[j] * cs[j - 32] + rp[j - 32] * sn[j - 32]; }
    Km[(((size_t)b * 4 + h) * SEQ + t) * 192 + d] = f2bf(v);
  }
  for (int e = tid; e < 512; e += 256) { int h = e >> 7, d = e & 127; Vm[(((size_t)b * 4 + h) * SEQ + t) * 128 + d] = f2bf(kr[h * 256 + 128 + d]); }
  { int e = tid; qg[tok * 256 + e] = f2bf(pr[O_QG + e] * 0.125f); kg[tok * 256 + e] = f2bf(pr[O_KG + e]); }
  for (int e = tid; e < 512; e += 256) { vg[tok * 512 + e] = f2bf(pr[O_VG + e]); rg[tok * 512 + e] = f2bf(pr[O_R + e]); }
  { int cidx = tid; float af = bgf[cidx], ab = bgb[cidx];
#pragma unroll
    for (int r = 0; r < 16; ++r) { af += pr[O_GF + r] * wgf[r * 256 + cidx]; ab += pr[O_GB + r] * wgb[r * 256 + cidx]; }
    laf[tok * 256 + cidx] = logsigmoid_f(af) * (1.f / 16.f); lab[tok * 256 + cidx] = logsigmoid_f(ab) * (1.f / 16.f); }
}

__global__ __launch_bounds__(256) void n_attn(const bf16_t* __restrict__ Qm, const bf16_t* __restrict__ Km, const bf16_t* __restrict__ Vm, bf16_t* __restrict__ omla) {
  __shared__ float qs[192]; __shared__ float sc[2048]; __shared__ float red[4];
  const int i = blockIdx.x, h = blockIdx.y, b = blockIdx.z, tid = threadIdx.x;
  const size_t bh = (size_t)b * 4 + h;
  if (tid < 192) qs[tid] = bf2f(Qm[(bh * SEQ + i) * 192 + tid]);
  __syncthreads();
  float mx = -1e30f;
  for (int kk = 0; kk < 8; ++kk) {
    int key = tid + 256 * kk; const uint4* kr = (const uint4*)(Km + (bh * SEQ + key) * 192);
    float s = 0.f;
    for (int c = 0; c < 24; ++c) { uint4 w = kr[c]; const float* q = qs + c * 8;
      s += q[0] * __uint_as_float(w.x << 16) + q[1] * __uint_as_float(w.x & 0xffff0000u) + q[2] * __uint_as_float(w.y << 16) + q[3] * __uint_as_float(w.y & 0xffff0000u)
         + q[4] * __uint_as_float(w.z << 16) + q[5] * __uint_as_float(w.z & 0xffff0000u) + q[6] * __uint_as_float(w.w << 16) + q[7] * __uint_as_float(w.w & 0xffff0000u); }
    s *= 0.07216878364870322f; sc[key] = s; mx = fmaxf(mx, s);
  }
  mx = block_max256(mx, red);
  float sum = 0.f;
  for (int kk = 0; kk < 8; ++kk) { int key = tid + 256 * kk; float p = expf(sc[key] - mx); sc[key] = p; sum += p; }
  sum = block_sum256(sum, red);
  __syncthreads();
  if (tid < 128) { float o = 0.f; const bf16_t* vp = Vm + bh * SEQ * 128 + tid;
    for (int key = 0; key < SEQ; ++key) o += sc[key] * bf2f(vp[(size_t)key * 128]);
    omla[((size_t)b * SEQ + i) * 512 + h * 128 + tid] = f2bf(o / sum); }
}

__global__ __launch_bounds__(128) void n_gla(const bf16_t* __restrict__ qg, const bf16_t* __restrict__ kg, const bf16_t* __restrict__ vg, const bf16_t* __restrict__ laf, const bf16_t* __restrict__ lab, float* __restrict__ og) {
  __shared__ float qs[64], ks[64], as[64];
  const int bh = blockIdx.x, b = bh >> 2, h = bh & 3, dv = threadIdx.x;
  for (int dir = 0; dir < 2; ++dir) {
    float S[64];
#pragma unroll
    for (int d = 0; d < 64; ++d) S[d] = 0.f;
    const bf16_t* la = dir ? lab : laf;
    for (int s = 0; s < SEQ; ++s) {
      const int t = dir ? (SEQ - 1 - s) : s; const size_t tok = (size_t)b * SEQ + t;
      __syncthreads();
      if (dv < 64) { qs[dv] = bf2f(qg[tok * 256 + h * 64 + dv]); ks[dv] = bf2f(kg[tok * 256 + h * 64 + dv]); as[dv] = expf(bf2f(la[tok * 256 + h * 64 + dv])); }
      __syncthreads();
      const float v = bf2f(vg[tok * 512 + h * 128 + dv]); float o = 0.f;
#pragma unroll
      for (int d = 0; d < 64; ++d) { S[d] = as[d] * S[d] + ks[d] * v; o += qs[d] * S[d]; }
      if (dir == 0) og[tok * 512 + h * 128 + dv] = o; else og[tok * 512 + h * 128 + dv] += o;
    }
  }
}

__global__ __launch_bounds__(256) void n_mix(const bf16_t* __restrict__ omla, const float* __restrict__ og, const bf16_t* __restrict__ rg, const float* __restrict__ g_gla, int b, float* __restrict__ mix) {
  __shared__ float ssum[4];
  const int t = blockIdx.x, tid = threadIdx.x; const size_t tok = (size_t)b * SEQ + t;
  if (tid < 4) ssum[tid] = 0.f;
  __syncthreads();
  float v[2];
#pragma unroll
  for (int i = 0; i < 2; ++i) { int e = tid + 256 * i; v[i] = og[tok * 512 + e]; atomicAdd(&ssum[e >> 7], v[i] * v[i]); mix[(size_t)t * DM + e] = bf2f(omla[tok * 512 + e]); }
  __syncthreads();
#pragma unroll
  for (int i = 0; i < 2; ++i) { int e = tid + 256 * i; float rs = rsqrtf(ssum[e >> 7] * (1.f / 128.f) + EPS);
    mix[(size_t)t * DM + 512 + e] = v[i] * rs * g_gla[e & 127] * silu_f(bf2f(rg[tok * 512 + e])); }
}

__global__ __launch_bounds__(256) void n_post1(const float* __restrict__ x, const float* __restrict__ y, const float* __restrict__ g_post, const float* __restrict__ g_pre2, const float* __restrict__ mod, int b,
                                               float* __restrict__ out, float* __restrict__ h2) {
  __shared__ float red[4];
  const int t = blockIdx.x, tid = threadIdx.x; const size_t tok = (size_t)b * SEQ + t;
  float yv[4], xv[4]; float ss = 0.f;
#pragma unroll
  for (int i = 0; i < 4; ++i) { yv[i] = y[(size_t)t * DM + tid + 256 * i]; ss += yv[i] * yv[i]; }
  ss = block_sum256(ss, red);
  float rs = rsqrtf(ss * (1.f / DM) + EPS); float s2 = 0.f;
#pragma unroll
  for (int i = 0; i < 4; ++i) { int d = tid + 256 * i; xv[i] = x[tok * DM + d] + mod[b * 6144 + 2048 + d] * (yv[i] * rs * g_post[d]); out[tok * DM + d] = xv[i]; s2 += xv[i] * xv[i]; }
  s2 = block_sum256(s2, red);
  float r2 = rsqrtf(s2 * (1.f / DM) + EPS);
#pragma unroll
  for (int i = 0; i < 4; ++i) { int d = tid + 256 * i; h2[(size_t)t * DM + d] = xv[i] * r2 * g_pre2[d] * (1.f + mod[b * 6144 + 4096 + d]) + mod[b * 6144 + 3072 + d]; }
}

DI void wave_argmax(float& v, int& i) {
#pragma unroll
  for (int o = 1; o < 64; o <<= 1) { float ov = __shfl_xor(v, o); int oi = __shfl_xor(i, o); if (ov > v || (ov == v && oi < i)) { v = ov; i = oi; } }
}
__global__ __launch_bounds__(256) void n_peer_select(const float* __restrict__ qry, const float* __restrict__ sk1, const float* __restrict__ sk2, int* __restrict__ eidx, float* __restrict__ gate) {
  __shared__ float v1s[4][16], v2s[4][16]; __shared__ int i1s[4][16], i2s[4][16];
  const int w = threadIdx.x >> 6, lane = threadIdx.x & 63;
  const int pair = blockIdx.x * 4 + w;
  const int t = pair >> 3, h = pair & 7;
  const float* q1 = qry + (size_t)t * 2048 + h * 256; const float* q2 = q1 + 128;
  float s1a = 0.f, s1b = 0.f, s2a = 0.f, s2b = 0.f;
  for (int d = 0; d < 128; ++d) { float a = q1[d], bq = q2[d];
    s1a += a * sk1[lane * 128 + d]; s1b += a * sk1[(lane + 64) * 128 + d]; s2a += bq * sk2[lane * 128 + d]; s2b += bq * sk2[(lane + 64) * 128 + d]; }
  for (int side = 0; side < 2; ++side) {
    float va = side ? s2a : s1a, vb = side ? s2b : s1b; bool ta = false, tb = false;
    for (int k = 0; k < 16; ++k) {
      float bv; int bi;
      if (!ta && (tb || va >= vb)) { bv = va; bi = lane; } else if (!tb) { bv = vb; bi = lane + 64; } else { bv = -3e38f; bi = 1 << 20; }
      wave_argmax(bv, bi);
      if (bi == lane) ta = true; if (bi == lane + 64) tb = true;
      if (lane == 0) { if (side) { v2s[w][k] = bv; i2s[w][k] = bi; } else { v1s[w][k] = bv; i1s[w][k] = bi; } }
    }
  }
  __syncthreads();
  float cv[4]; bool tk[4];
#pragma unroll
  for (int j = 0; j < 4; ++j) { int c = lane + 64 * j; cv[j] = v1s[w][c >> 4] + v2s[w][c & 15]; tk[j] = false; }
  float topv = 0.f; int topc = 0; float mx = 0.f;
  for (int k = 0; k < 16; ++k) {
    float bv = -3e38f; int bi = 1 << 20;
#pragma unroll
    for (int j = 0; j < 4; ++j) { if (!tk[j] && cv[j] > bv) { bv = cv[j]; bi = lane + 64 * j; } }
    wave_argmax(bv, bi);
#pragma unroll
    for (int j = 0; j < 4; ++j) if (bi == lane + 64 * j) tk[j] = true;
    if (k == 0) mx = bv;
    if (lane == k) { topv = bv; topc = bi; }
  }
  float e = (lane < 16) ? expf(topv - mx) : 0.f;
  float sum = wave_sum(e);
  if (lane < 16) { eidx[(size_t)pair * 16 + lane] = i1s[w][topc >> 4] * 128 + i2s[w][topc & 15]; gate[(size_t)pair * 16 + lane] = e / sum; }
}

__global__ __launch_bounds__(256) void n_peer_apply(const float* __restrict__ h2, const int* __restrict__ eidx, const float* __restrict__ gate, const float* __restrict__ eu, const float* __restrict__ ev,
                                                    const float* __restrict__ g_post, const float* __restrict__ mod, int b, float* __restrict__ out) {
  __shared__ float ys[4][1024]; __shared__ float red[4];
  const int t = blockIdx.x, tid = threadIdx.x, w = tid >> 6, lane = tid & 63; const size_t tok = (size_t)b * SEQ + t;
  float4 hx[4];
#pragma unroll
  for (int i = 0; i < 4; ++i) hx[i] = *(const float4*)(h2 + (size_t)t * DM + (lane + 64 * i) * 4);
  float4 acc[4];
#pragma unroll
  for (int i = 0; i < 4; ++i) acc[i] = make_float4(0.f, 0.f, 0.f, 0.f);
  for (int k = w; k < 128; k += 4) {
    const int e = eidx[(size_t)t * 128 + k]; const float gt = gate[(size_t)t * 128 + k];
    const float4* ur = (const float4*)(eu + (size_t)e * DM); const float4* vr = (const float4*)(ev + (size_t)e * DM);
    float d = 0.f;
#pragma unroll
    for (int i = 0; i < 4; ++i) { float4 u = ur[lane + 64 * i]; d += u.x * hx[i].x + u.y * hx[i].y + u.z * hx[i].z + u.w * hx[i].w; }
    d = wave_sum(d);
    const float wgt = gt * gelu_erf(d);
#pragma unroll
    for (int i = 0; i < 4; ++i) { float4 v = vr[lane + 64 * i]; acc[i].x += wgt * v.x; acc[i].y += wgt * v.y; acc[i].z += wgt * v.z; acc[i].w += wgt * v.w; }
  }
#pragma unroll
  for (int i = 0; i < 4; ++i) *(float4*)(&ys[w][(lane + 64 * i) * 4]) = acc[i];
  __syncthreads();
  float yv[4]; float ss = 0.f;
#pragma unroll
  for (int i = 0; i < 4; ++i) { int d = tid + 256 * i; yv[i] = ys[0][d] + ys[1][d] + ys[2][d] + ys[3][d]; ss += yv[i] * yv[i]; }
  ss = block_sum256(ss, red);
  const float rs = rsqrtf(ss * (1.f / DM) + EPS);
#pragma unroll
  for (int i = 0; i < 4; ++i) { int d = tid + 256 * i; out[tok * DM + d] = out[tok * DM + d] + mod[b * 6144 + 5120 + d] * (yv[i] * rs * g_post[d]); }
}

typedef short bf16x8 __attribute__((ext_vector_type(8)));
typedef float f32x16 __attribute__((ext_vector_type(16)));
#define MFMA32(a, b, c) __builtin_amdgcn_mfma_f32_32x32x16_bf16((a), (b), (c), 0, 0, 0)

constexpr int NTHR = 512;
constexpr size_t MiB = 1024 * 1024;
constexpr size_t WS_MOD   = 0;
constexpr size_t WS_WTIN  = 256 * 1024;
constexpr size_t WS_WTQUP = WS_WTIN + (size_t)2304 * 1024 * 2;
constexpr size_t WS_WTKVUP = WS_WTQUP + (size_t)768 * 384 * 2;
constexpr size_t WS_WTOUT = WS_WTKVUP + (size_t)1024 * 256 * 2;
constexpr size_t WS_WTPQ  = WS_WTOUT + (size_t)1024 * 1024 * 2;
constexpr size_t WS_KD    = WS_WTPQ + (size_t)2048 * 1024 * 2;
constexpr size_t WS_DEC   = WS_KD + (size_t)256 * 256 * 2;
constexpr size_t WS_ESC   = WS_DEC + (size_t)2048 * 64 * 4;
constexpr size_t WS_R0END = WS_ESC + (size_t)2 * 16384 * 4;
static_assert(WS_R0END <= 13 * MiB, "R0");
constexpr size_t WS_BAR  = 13 * MiB - 65536;
static_assert(WS_R0END + 131072 <= WS_BAR, "R0 room");
constexpr size_t WS_QM   = 13 * MiB;
constexpr size_t WS_KM   = WS_QM + 24 * MiB;
constexpr size_t WS_VM   = WS_KM + 24 * MiB;
constexpr size_t WS_P1S  = WS_VM + 16 * MiB;
constexpr size_t WS_RG   = WS_P1S + 32 * MiB;
constexpr size_t WS_OINTRA = WS_RG + 16 * MiB;
constexpr size_t WS_QDEC = WS_OINTRA + 16 * MiB;
constexpr size_t WS_SPT  = WS_QDEC + 16 * MiB;
constexpr size_t WS_EU   = WS_SPT + 32 * MiB;
constexpr size_t WS_EV   = WS_EU + 16 * MiB;
constexpr size_t WS_WTPQP = WS_EV + 16 * MiB;
constexpr size_t WS_WTOUTP = WS_WTPQP + 4 * MiB;
constexpr size_t WS_WTINP = WS_WTOUTP + 2 * MiB;
constexpr size_t WS_PROJC = WS_WTINP + 4608 * 1024;
constexpr size_t WS_END  = WS_PROJC + 8 * MiB;
static_assert(WS_P1S == WS_QM + 64 * MiB, "P3 QRY scratch aliases QM..VM");
constexpr size_t OUT_HS  = 0;
constexpr size_t OUT_CQ  = 32 * MiB;
constexpr size_t OUT_GR  = 52 * MiB;

struct KP { const float* in[25]; float* out; unsigned char* ws; int ph_lo, ph_hi; };

constexpr int G_STG = 40960;
constexpr int LDS_WT = 3 * G_STG;
constexpr int LDS_TAB = LDS_WT + 18432;
constexpr int LDS_XB = 157696;
constexpr int LDS_TOTAL = 157696 + 16;

typedef float f32x2_t __attribute__((ext_vector_type(2)));
typedef __bf16 bf16x2_t __attribute__((ext_vector_type(2)));
DI unsigned pack2(float lo, float hi) { const f32x2_t v = {lo, hi}; return __builtin_bit_cast(unsigned, __builtin_convertvector(v, bf16x2_t)); }
DI int crow(int reg, int hh) { return (reg & 3) + 8 * (reg >> 2) + 4 * hh; }

#define GLDS16(gp, lp) __builtin_amdgcn_global_load_lds((const unsigned*)(gp), (__attribute__((address_space(3))) unsigned*)(lp), 16, 0, 0)
template <int NST, class Epi>
DI void block_gemm(char* lds, const bf16_t* A, int lda, const bf16_t* Bt, int nchunks, int K, Epi&& epi) {
  const int tid = threadIdx.x, lane = tid & 63, w = __builtin_amdgcn_readfirstlane(tid >> 6), r = lane & 31, hh = lane >> 5;
  const int nk = K >> 6, T = nchunks * nk;
  constexpr int D = NST - 1;
  if (w >= 4) {
    const int j = w - 4, rin = lane >> 3, sw = ((lane & 7) ^ rin) * 8;
    const bf16_t* Ap = A + (size_t)(16 * j + rin) * lda + sw;
    const bf16_t* Bp = Bt + (size_t)(64 * j + rin) * 64 + sw;
    auto dma = [&](int g) {
      const int ch = g / nk, t = g - ch * nk; char* st = lds + (g % NST) * G_STG;
      const bf16_t* a0 = Ap + t * 64; char* la = st + (2 * j) * 1024;
      GLDS16(a0, la); GLDS16(a0 + (size_t)8 * lda, la + 1024);
      const bf16_t* b0 = Bp + (size_t)g * 16384; char* lb = st + 8192 + (8 * j) * 1024;
#pragma unroll
      for (int i = 0; i < 8; ++i) GLDS16(b0 + i * 512, lb + i * 1024);
    };
#pragma unroll
    for (int g = 0; g < D; ++g) if (g < T) dma(g);
    if (D >= 2 && T >= 2) asm volatile("s_waitcnt vmcnt(10)" ::: "memory"); else asm volatile("s_waitcnt vmcnt(0)" ::: "memory");
    __builtin_amdgcn_s_barrier();
#pragma unroll 1
    for (int g = 0; g < T; ++g) {
      if (g + D < T) { dma(g + D); if (D >= 2) asm volatile("s_waitcnt vmcnt(10)" ::: "memory"); else asm volatile("s_waitcnt vmcnt(0)" ::: "memory"); }
      else asm volatile("s_waitcnt vmcnt(0)" ::: "memory");
      __builtin_amdgcn_s_barrier();
    }
  } else {
    const int x = r & 7;
    const int o0 = ((0 + hh) ^ x) * 16, o1 = ((2 + hh) ^ x) * 16, o2 = ((4 + hh) ^ x) * 16, o3 = ((6 + hh) ^ x) * 16;
    const int a_rd = r * 128, b_rd = 8192 + (w * 64 + r) * 128;
    __builtin_amdgcn_s_barrier();
    int g = 0;
#pragma unroll 1
    for (int ch = 0; ch < nchunks; ++ch) {
      f32x16 c00, c01, c10, c11;
#pragma unroll
      for (int i = 0; i < 16; ++i) { c00[i] = 0.f; c01[i] = 0.f; c10[i] = 0.f; c11[i] = 0.f; }
#pragma unroll 1
      for (int t = 0; t < nk; ++t, ++g) {
        const char* cur = lds + (g % NST) * G_STG;
        bf16x8 fa0[4], fa1[4], fb0[4], fb1[4];
#define FRD(s_, o_) do { fa0[s_] = *(const bf16x8*)(cur + a_rd + o_); fb0[s_] = *(const bf16x8*)(cur + b_rd + o_); fb1[s_] = *(const bf16x8*)(cur + b_rd + 4096 + o_); fa1[s_] = *(const bf16x8*)(cur + a_rd + 4096 + o_); } while (0)
        FRD(0, o0); FRD(1, o1); FRD(2, o2); FRD(3, o3);
#undef FRD
        asm volatile("s_waitcnt lgkmcnt(0)" ::: "memory");
        __builtin_amdgcn_s_barrier();
        __builtin_amdgcn_sched_barrier(0);
#pragma unroll
        for (int s = 0; s < 4; ++s) {
          c00 = MFMA32(fa0[s], fb0[s], c00); c01 = MFMA32(fa0[s], fb1[s], c01); c10 = MFMA32(fa1[s], fb0[s], c10); c11 = MFMA32(fa1[s], fb1[s], c11); }
      }
      epi(0, ch * 256 + w * 64, c00, c01);
      epi(32, ch * 256 + w * 64, c10, c11);
    }
  }
}

DI void p0_transpose(char* lds, const float* __restrict__ W, int K, int N, bf16_t* __restrict__ Wt, int item, bf16_t* __restrict__ Wplain = nullptr) {
  float* s = (float*)lds;
  const int tid = threadIdx.x;
  const int ntn = (N + 63) >> 6, kt = item / ntn, nt = item % ntn, k0 = kt * 64, n0 = nt * 64;
  __syncthreads();
#pragma unroll
  for (int i = 0; i < 8; ++i) { int e = tid + 512 * i; int kk = e >> 6, nn = e & 63; s[kk * 65 + nn] = (n0 + nn < N) ? W[(size_t)(k0 + kk) * N + n0 + nn] : 0.f; }
  __syncthreads();
  const int nn = tid >> 3, part = tid & 7;
  const float* sp = s + (part * 8) * 65 + nn;
  uint4 o; o.x = pack2(sp[0], sp[65]); o.y = pack2(sp[2 * 65], sp[3 * 65]); o.z = pack2(sp[4 * 65], sp[5 * 65]); o.w = pack2(sp[6 * 65], sp[7 * 65]);
  { const int n = n0 + nn; *(uint4*)(Wt + ((size_t)((n >> 8) * (K >> 6) + kt)) * 16384 + (n & 255) * 64 + part * 8) = o; }
  if (Wplain) *(uint4*)(Wplain + (size_t)(n0 + nn) * K + k0 + part * 8) = o;
}

DI void convert_experts(const KP& p, const int bid, const int nb) {
  const int tid = threadIdx.x; unsigned char* ws = p.ws;
  { const int lane = tid & 63; float* scl = (float*)(ws + WS_ESC);
    for (int row = bid * 8 + (tid >> 6); row < 32768; row += nb * 8) { const int t = row >> 14, e = row & 16383;
      const float* src = p.in[23 + t] + (size_t)e * 1024 + lane * 16;
      float4 x[4]; float am = 0.f;
#pragma unroll
      for (int i = 0; i < 4; ++i) { x[i] = *(const float4*)(src + 4 * i); am = fmaxf(am, fmaxf(fmaxf(fabsf(x[i].x), fabsf(x[i].y)), fmaxf(fabsf(x[i].z), fabsf(x[i].w)))); }
      am = wave_max(am);
      float sc = 1.f, isc = 1.f;
      if (am > 0.f) { int ex; (void)frexpf((t ? 448.f : 127.f) / am, &ex); sc = ldexpf(1.f, ex - 1); isc = ldexpf(1.f, 1 - ex); }
      unsigned wv[4];
      if (t) {
#pragma unroll
        for (int i = 0; i < 4; ++i) { int q = __builtin_amdgcn_cvt_pk_fp8_f32(x[i].x * sc, x[i].y * sc, 0, false); q = __builtin_amdgcn_cvt_pk_fp8_f32(x[i].z * sc, x[i].w * sc, q, true); wv[i] = (unsigned)q; }
      } else {
#pragma unroll
        for (int i = 0; i < 4; ++i) { const int q0 = (int)rintf(x[i].x * sc), q1 = (int)rintf(x[i].y * sc), q2 = (int)rintf(x[i].z * sc), q3 = (int)rintf(x[i].w * sc);
          wv[i] = (unsigned)(q0 & 255) | ((unsigned)(q1 & 255) << 8) | ((unsigned)(q2 & 255) << 16) | ((unsigned)(q3 & 255) << 24); }
      }
      *(uint4*)(ws + (t ? WS_EV : WS_EU) + (size_t)e * 1024 + lane * 16) = make_uint4(wv[0], wv[1], wv[2], wv[3]);
      if (lane == 0) scl[t * 16384 + e] = isc; } }
}

constexpr int MOD_JOBS = 192;
DI int phase0_mod(const KP& p, char* lds) {
  const int tid = threadIdx.x, bid = blockIdx.x, nb = gridDim.x; unsigned char* ws = p.ws; int njobs = 0;
  for (int jb = bid; jb < MOD_JOBS; jb += nb) {
    __syncthreads();
    float* cact = (float*)lds;
    float* red = (float*)(lds + 32768);
    for (int e = tid; e < 8192; e += NTHR) cact[e] = silu_f(p.in[1][e]);
    __syncthreads();
    const int jj = tid & 31, ks = tid >> 5, j0 = jb * 32;
    float acc[8];
#pragma unroll
    for (int b = 0; b < 8; ++b) acc[b] = 0.f;
    const float* wp = p.in[3] + (size_t)(ks * 64) * 6144 + j0 + jj;
    float wv[64];
#pragma unroll
    for (int k = 0; k < 64; ++k) wv[k] = wp[(size_t)k * 6144];
#pragma unroll
    for (int b = 0; b < 8; ++b) {
#pragma unroll
      for (int k4 = 0; k4 < 16; ++k4) { const float4 c = *(const float4*)(cact + b * 1024 + ks * 64 + 4 * k4);
        acc[b] += c.x * wv[4 * k4] + c.y * wv[4 * k4 + 1] + c.z * wv[4 * k4 + 2] + c.w * wv[4 * k4 + 3]; } }
#pragma unroll
    for (int b = 0; b < 8; ++b) red[(ks * 32 + jj) * 8 + b] = acc[b];
    __syncthreads();
    if (tid < 256) { const int b = tid >> 5; float sacc = p.in[4][j0 + jj];
#pragma unroll
      for (int k2 = 0; k2 < 16; ++k2) sacc += red[(k2 * 32 + jj) * 8 + b];
      ((float*)(ws + WS_MOD))[b * 6144 + j0 + jj] = sacc; }
    ++njobs;
  }
  return njobs;
}

DI void p0_transpose_wave(float* s, const float* __restrict__ W, int K, int N, int item, bf16_t* __restrict__ Wtiled, bf16_t* __restrict__ Wplain) {
  const int lane = threadIdx.x & 63;
  const int ntn = (N + 63) >> 6, kt = item / ntn, nt = item % ntn, k0 = kt * 64, n0 = nt * 64;
  const int c4 = (lane & 15) * 4, rq = lane >> 4;
#pragma unroll
  for (int i = 0; i < 16; ++i) { const int kk = 4 * i + rq;
    const float4 v = (n0 + c4 < N) ? *(const float4*)(W + (size_t)(k0 + kk) * N + n0 + c4) : make_float4(0.f, 0.f, 0.f, 0.f);
    float* d = s + kk * 65 + c4; d[0] = v.x; d[1] = v.y; d[2] = v.z; d[3] = v.w; }
  __builtin_amdgcn_wave_barrier(); asm volatile("" ::: "memory");
#pragma unroll
  for (int q = 0; q < 8; ++q) { const int c = lane + 64 * q, nn = c >> 3, part = c & 7;
    const float* sp = s + (part * 8) * 65 + nn;
    uint4 o; o.x = pack2(sp[0], sp[65]); o.y = pack2(sp[2 * 65], sp[3 * 65]); o.z = pack2(sp[4 * 65], sp[5 * 65]); o.w = pack2(sp[6 * 65], sp[7 * 65]);
    const int n = n0 + nn;
    if (Wtiled) *(uint4*)(Wtiled + ((size_t)((n >> 8) * (K >> 6) + kt)) * 16384 + (n & 255) * 64 + part * 8) = o;
    if (Wplain) *(uint4*)(Wplain + (size_t)n * K + k0 + part * 8) = o; }
  __builtin_amdgcn_wave_barrier(); asm volatile("" ::: "memory");
}

DI void phase0(const KP& p, char* lds) {
  const int tid = threadIdx.x, bid = blockIdx.x, nb = gridDim.x;
  unsigned char* ws = p.ws;
  constexpr int I_IN = 16 * 36, I_QUP = 6 * 12, I_KVUP = 4 * 16, I_OUT = 16 * 16, I_PQ = 16 * 32;
  constexpr int I_ALL = I_IN + I_QUP + I_KVUP + I_OUT + I_PQ;
  { const int w = tid >> 6, nwv = nb * 8; float* s = (float*)(lds + w * 16640);
    for (int it = nwv - 1 - (bid * 8 + w); it < I_ALL; it += nwv) {
      int q = it;
      if (q < I_IN) { p0_transpose_wave(s, p.in[7], 1024, 2272, q, nullptr, (bf16_t*)(ws + WS_WTINP)); continue; } q -= I_IN;
      if (q < I_QUP) { p0_transpose_wave(s, p.in[9], 384, 768, q, (bf16_t*)(ws + WS_WTQUP), nullptr); continue; } q -= I_QUP;
      if (q < I_KVUP) { p0_transpose_wave(s, p.in[11], 256, 1024, q, (bf16_t*)(ws + WS_WTKVUP), nullptr); continue; } q -= I_KVUP;
      if (q < I_OUT) { p0_transpose_wave(s, p.in[17], 1024, 1024, q, nullptr, (bf16_t*)(ws + WS_WTOUTP)); continue; } q -= I_OUT;
      p0_transpose_wave(s, p.in[20], 1024, 2048, q, nullptr, (bf16_t*)(ws + WS_WTPQP));
    }
  }
  { bf16_t* kd = (bf16_t*)(ws + WS_KD);
    for (int e = bid * NTHR + tid; e < 65536; e += nb * NTHR) { int n = e >> 8, k = e & 255; float v = 0.f;
      if (n < 128 && k < 128) v = p.in[21][n * 128 + k]; else if (n >= 128 && k >= 128) v = p.in[22][(n - 128) * 128 + (k - 128)];
      kd[(size_t)(k >> 6) * 16384 + n * 64 + (k & 63)] = f2bf(v); } }
}

constexpr int WT_STRIDE = 144, WT_BYTES = 32 * WT_STRIDE;
DI void wt_write(char* wl, const f32x16& a0, const f32x16& a1, int r, int hh, float scale) {
  char* bp = wl + (4 * hh) * WT_STRIDE + r * 2;
#pragma unroll
  for (int reg = 0; reg < 16; ++reg) { const int ro = ((reg & 3) + 8 * (reg >> 2)) * WT_STRIDE;
    *(bf16_t*)(bp + ro) = f2bf(a0[reg] * scale); *(bf16_t*)(bp + ro + 64) = f2bf(a1[reg] * scale); }
}
DI void wt_write_rope(char* wl, const f32x16& a0, const f32x16& a1, int r, int hh, const float* cs, const float* sn, int m0) {
  char* bp = wl + (4 * hh) * WT_STRIDE + r * 2;
#pragma unroll
  for (int reg = 0; reg < 16; ++reg) { const int rw = (reg & 3) + 8 * (reg >> 2); const int row = m0 + rw + 4 * hh;
    const float c = cs[row * 32 + r], s = sn[row * 32 + r];
    *(bf16_t*)(bp + rw * WT_STRIDE) = f2bf(a0[reg] * c - a1[reg] * s); *(bf16_t*)(bp + rw * WT_STRIDE + 64) = f2bf(a1[reg] * c + a0[reg] * s); }
}
DI void wt_store(const char* wl, int lane, bf16_t* dA, int sA, bf16_t* dB, int sB) {
  const int piece = lane & 7, rsub = lane >> 3;
  bf16_t* d = (piece < 4) ? dA : dB; const int st = (piece < 4) ? sA : sB;
  if (d) {
#pragma unroll
    for (int i = 0; i < 4; ++i) { const int row = i * 8 + rsub; const uint4 v = *(const uint4*)(wl + row * WT_STRIDE + piece * 16);
      *(uint4*)(d + (size_t)row * st + (piece & 3) * 8) = v; }
  }
}
#define LDS_FENCE() asm volatile("s_waitcnt lgkmcnt(0)" ::: "memory")
DI int lv(int x) { asm volatile("" : "+v"(x)); return x; }
template <class T> DI T* launder(T* q) { size_t z = 0; asm volatile("" : "+s"(z)); return (T*)((char*)q + z); }

constexpr int GL_GR = 0, GL_VT = 8192, GL_QD = 26624, GL_KI = 45056, GL_KIT = 63488, GL_ATT = 81920, GL_TOT = 91136, GL_DEC = 93184, GL_LA = 93696  , GL_QS = 126464  , GL_KS = 134656;
DI void gla_chunk_local(const KP& p, char* lds, unsigned char* ws, int tile, const bf16_t* PA, const bf16_t* PB) {
  const int tid = lv(threadIdx.x), lane = tid & 63, w = tid >> 6, r = lane & 31, hh = lane >> 5;
  const int b = tile >> 5, n = tile & 31, tok0 = tile * 64;
  float* GRL = (float*)(lds + GL_GR); float* TOT = (float*)(lds + GL_TOT); float* DECL = (float*)(lds + GL_DEC);
  __syncthreads();
#pragma unroll
  for (int i = 0; i < 4; ++i) { const int e = tid + 512 * i; GRL[e] = bf2f(PB[(size_t)(e >> 5) * 1024 + (O_GF - 1024) + (e & 31)]); }
#pragma unroll 1
  for (int h = 0; h < 4; ++h) {
    __syncthreads();
    { const int t = tid >> 3, c8 = (tid & 7) * 8;
      *(uint4*)(lds + GL_QS + (t * 64 + c8) * 2) = *(const uint4*)(PA + (size_t)t * 1024 + O_QG + h * 64 + c8);
      *(uint4*)(lds + GL_KS + (t * 64 + c8) * 2) = (h == 0) ? *(const uint4*)(PA + (size_t)t * 1024 + O_KG + c8) : *(const uint4*)(PB + (size_t)t * 1024 + (O_KG - 1024) + h * 64 + c8); }
#pragma unroll
    for (int i = 0; i < 2; ++i) { const int c = tid + 512 * i, t = c >> 4, d8 = (c & 15) * 8;
      const uint4 v = *(const uint4*)(PB + (size_t)t * 1024 + (O_VG - 1024) + h * 128 + d8);
      bf16_t* vt = (bf16_t*)(lds + GL_VT) + d8 * 72 + t;
      vt[0] = (bf16_t)(v.x & 0xffffu); vt[72] = (bf16_t)(v.x >> 16); vt[144] = (bf16_t)(v.y & 0xffffu); vt[216] = (bf16_t)(v.y >> 16);
      vt[288] = (bf16_t)(v.z & 0xffffu); vt[360] = (bf16_t)(v.z >> 16); vt[432] = (bf16_t)(v.w & 0xffffu); vt[504] = (bf16_t)(v.w >> 16); }
    const int dir = tid >> 8, qt = (tid >> 6) & 3, dk = tid & 63, col = h * 64 + dk;
    float* LAL = (float*)(lds + GL_LA) + tid;
    {
      const float* wg = launder(dir ? p.in[14] : p.in[12]); const float* bg = launder(dir ? p.in[15] : p.in[13]);
      float wr[16];
#pragma unroll
      for (int q = 0; q < 16; ++q) wr[q] = wg[q * 256 + col];
      const float bias = bg[col];
      float run = 0.f;
#pragma unroll 2
      for (int ii = 0; ii < 16; ++ii) { const int i = dir ? 15 - ii : ii;
        const float* gp = GRL + (qt * 16 + i) * 32 + dir * 16; float x = bias;
#pragma unroll
        for (int q = 0; q < 16; ++q) x += gp[q] * wr[q];
        run += logsigmoid_fast(x) * (1.f / 16.f); LAL[i * 512] = run; }
      TOT[(dir * 64 + dk) * 4 + qt] = run;
    }
    __syncthreads();
    {
      const float4 tq = *(const float4*)(TOT + (dir * 64 + dk) * 4);
      const float total = (tq.x + tq.y) + (tq.z + tq.w);
      float off;
      if (dir == 0) off = (qt > 0 ? tq.x : 0.f) + (qt > 1 ? tq.y : 0.f) + (qt > 2 ? tq.z : 0.f);
      else          off = (qt < 1 ? tq.y : 0.f) + (qt < 2 ? tq.z : 0.f) + (qt < 3 ? tq.w : 0.f);
      if (qt == 0) { const float dc = fexp(total); DECL[dir * 64 + dk] = dc; ((float*)(ws + WS_DEC))[((size_t)((b * 4 + h) * 2 + dir) * 32 + n) * 64 + dk] = dc; }
      bf16_t* QD = (bf16_t*)(lds + GL_QD + dir * 9216) + (qt * 16) * 72 + dk; bf16_t* KI = (bf16_t*)(lds + GL_KI + dir * 9216) + (qt * 16) * 72 + dk;
      bf16_t* KIT = (bf16_t*)(lds + GL_KIT + dir * 9216) + dk * 72 + qt * 16;
      bf16_t* qdg = (bf16_t*)(ws + WS_QDEC) + (size_t)((tile * 4 + h) * 2 + dir) * 4096 + (qt * 16) * 64 + dk;
      const bf16_t* qgp = (const bf16_t*)(lds + GL_QS) + (qt * 16) * 64 + dk; const bf16_t* kgp = (const bf16_t*)(lds + GL_KS) + (qt * 16) * 64 + dk;
#pragma unroll 2
      for (int i = 0; i < 16; ++i) { const float bb = off + LAL[i * 512];
        const float qv = bf2f(qgp[i * 64]) * 0.125f, kv = bf2f(kgp[i * 64]);
        const float eb = fexp(bb); const bf16_t qd = f2bf(qv * eb), ki = f2bf(kv * __builtin_amdgcn_rcpf(eb));
        QD[i * 72] = qd; KI[i * 72] = ki; qdg[i * 64] = qd; KIT[i] = ki; }
    }
    __syncthreads();
    if (w < 4) { const int mi = w >> 1, ni = w & 1;
      f32x16 asum;
#pragma unroll
      for (int i = 0; i < 16; ++i) asum[i] = 0.f;
#pragma unroll
      for (int d = 0; d < 2; ++d) { f32x16 acc;
#pragma unroll
        for (int i = 0; i < 16; ++i) acc[i] = 0.f;
#pragma unroll
        for (int s = 0; s < 4; ++s) { const bf16x8 a = *(const bf16x8*)(lds + GL_QD + d * 9216 + (mi * 32 + r) * 144 + s * 32 + hh * 16);
          const bf16x8 bb = *(const bf16x8*)(lds + GL_KI + d * 9216 + (ni * 32 + r) * 144 + s * 32 + hh * 16); acc = MFMA32(a, bb, acc); }
#pragma unroll
        for (int reg = 0; reg < 16; ++reg) { const int ti = mi * 32 + crow(reg, hh), tj = ni * 32 + r; const bool keep = d ? (tj >= ti) : (tj <= ti); asum[reg] += keep ? acc[reg] : 0.f; } }
      bf16_t* at = (bf16_t*)(lds + GL_ATT) + (mi * 32 + 4 * hh) * 72 + ni * 32 + r;
#pragma unroll
      for (int reg = 0; reg < 16; ++reg) at[((reg & 3) + 8 * (reg >> 2)) * 72] = f2bf(asum[reg]);
    }
    __syncthreads();
    { const int mi = w >> 2, ni = w & 3; f32x16 acc;
#pragma unroll
      for (int i = 0; i < 16; ++i) acc[i] = 0.f;
#pragma unroll
      for (int s = 0; s < 4; ++s) { const bf16x8 a = *(const bf16x8*)(lds + GL_ATT + (mi * 32 + r) * 144 + s * 32 + hh * 16);
        const bf16x8 bb = *(const bf16x8*)(lds + GL_VT + (ni * 32 + r) * 144 + s * 32 + hh * 16); acc = MFMA32(a, bb, acc); }
      bf16_t* oi = (bf16_t*)(ws + WS_OINTRA) + (size_t)(tok0 + mi * 32 + 4 * hh) * 512 + h * 128 + ni * 32 + r;
#pragma unroll
      for (int reg = 0; reg < 16; ++reg) oi[(size_t)((reg & 3) + 8 * (reg >> 2)) * 512] = f2bf(acc[reg]); }
    { const int dvb = w >> 1, dkb = w & 1;
#pragma unroll
      for (int d = 0; d < 2; ++d) { f32x16 acc;
#pragma unroll
        for (int i = 0; i < 16; ++i) acc[i] = 0.f;
#pragma unroll
        for (int s = 0; s < 4; ++s) { const bf16x8 a = *(const bf16x8*)(lds + GL_VT + (dvb * 32 + r) * 144 + s * 32 + hh * 16);
          const bf16x8 bb = *(const bf16x8*)(lds + GL_KIT + d * 9216 + (dkb * 32 + r) * 144 + s * 32 + hh * 16); acc = MFMA32(a, bb, acc); }
        const float sc = DECL[d * 64 + dkb * 32 + r];
        bf16_t* ds = (bf16_t*)(ws + WS_SPT) + ((size_t)((b * 4 + h) * 2 + d) * 32 + n) * 8192 + (size_t)(dvb * 32 + 4 * hh) * 64 + dkb * 32 + r;
#pragma unroll
        for (int reg = 0; reg < 16; ++reg) ds[((reg & 3) + 8 * (reg >> 2)) * 64] = f2bf(acc[reg] * sc); } }
  }
}

DI void phase1a(const KP& p, char* lds) {
  const int tid = threadIdx.x, lane = tid & 63, w = tid >> 6;
  for (int tile = blockIdx.x; tile < 256; tile += gridDim.x) {
    unsigned char* ws = launder(p.ws); unsigned char* ob = (unsigned char*)launder(p.out); const float* xin = launder(p.in[0]);
    const float* mod = (const float*)(ws + WS_MOD);
    const int tok0 = tile * 64, b = tile >> 5;
    bf16_t* Hs = (bf16_t*)(ob + OUT_HS) + (size_t)tok0 * 1024;
    float4 ge[4], sh[4];
    const float* gpre = launder(p.in[5]); const float* modb = launder(mod) + b * 6144;
#pragma unroll
    for (int i = 0; i < 4; ++i) { const int d = (lane + 64 * i) * 4;
      const float4 g = *(const float4*)(gpre + d); const float4 sc = *(const float4*)(modb + 1024 + d); sh[i] = *(const float4*)(modb + d);
      ge[i] = make_float4(g.x * (1.f + sc.x), g.y * (1.f + sc.y), g.z * (1.f + sc.z), g.w * (1.f + sc.w)); }
#pragma unroll 1
    for (int g = 0; g < 2; ++g) {
      float4 v[4][4];
#pragma unroll
      for (int rr = 0; rr < 4; ++rr) { const float* xr = xin + (size_t)(tok0 + w * 8 + g * 4 + rr) * 1024;
#pragma unroll
        for (int i = 0; i < 4; ++i) v[rr][i] = *(const float4*)(xr + (lane + 64 * i) * 4); }
#pragma unroll
      for (int rr = 0; rr < 4; ++rr) { const int row = w * 8 + g * 4 + rr; float ss = 0.f;
#pragma unroll
        for (int i = 0; i < 4; ++i) ss += v[rr][i].x * v[rr][i].x + v[rr][i].y * v[rr][i].y + v[rr][i].z * v[rr][i].z + v[rr][i].w * v[rr][i].w;
        ss = wave_sum(ss); const float rs = rsqrtf(ss * (1.f / 1024.f) + EPS);
#pragma unroll
        for (int i = 0; i < 4; ++i) { uint2 o; o.x = pack2(v[rr][i].x * rs * ge[i].x + sh[i].x, v[rr][i].y * rs * ge[i].y + sh[i].y); o.y = pack2(v[rr][i].z * rs * ge[i].z + sh[i].z, v[rr][i].w * rs * ge[i].w + sh[i].w);
          *(uint2*)(Hs + (size_t)row * 1024 + (lane + 64 * i) * 4) = o; }
      }
    }
  }
}

DI void phase1c(const KP& p, char* lds) {
  const int tid = threadIdx.x, lane = tid & 63, w = tid >> 6, r = lane & 31, hh = lane >> 5;
  float* cs = (float*)(lds + LDS_TAB); float* sn = cs + 2048;
  char* wl = lds + LDS_WT + (w & 3) * WT_BYTES;
  for (int tile = blockIdx.x; tile < 256; tile += gridDim.x) {
    unsigned char* ws = launder(p.ws); unsigned char* ob = (unsigned char*)launder(p.out);
    const int tok0 = tile * 64, b = tile >> 5, t0 = (tile & 31) * 64;
    const bf16_t* PA = (const bf16_t*)(ws + WS_P1S) + (size_t)tok0 * 1024;
    const bf16_t* PB = (const bf16_t*)(ob + 32 * MiB) + (size_t)tok0 * 1024;
    const bf16_t* PC = (const bf16_t*)(ws + WS_PROJC) + (size_t)tok0 * 256;
    bf16_t* Hs = (bf16_t*)(ob + OUT_HS) + (size_t)tok0 * 1024;
    bf16_t* CQN = Hs; bf16_t* CKVN = Hs + 64 * 384;
    bf16_t* Qm = (bf16_t*)(ws + WS_QM); bf16_t* Km = (bf16_t*)(ws + WS_KM); bf16_t* Vm = (bf16_t*)(ws + WS_VM);
    bf16_t* rg = (bf16_t*)(ws + WS_RG) + (size_t)tok0 * 512;
    __syncthreads();
#pragma unroll
    for (int i = 0; i < 4; ++i) { const int e = tid + 512 * i, tt = e >> 5, j = e & 31;
      const float inv = __builtin_amdgcn_exp2f(-(float)j * (13.287712379549449f / 32.f)); const float ang = (float)((const int*)p.in[2])[tok0 + tt] * inv;
      float rev = ang * 0.15915494309189535f; rev -= floorf(rev);
      cs[e] = __builtin_amdgcn_cosf(rev); sn[e] = __builtin_amdgcn_sinf(rev); }
#pragma unroll
    for (int i = 0; i < 8; ++i) { const int c = tid + 512 * i, row = c >> 6, cc = c & 63;
      const uint4 v = (cc < 36) ? *(const uint4*)(PB + (size_t)row * 1024 + (O_R - 1024) + cc * 8) : *(const uint4*)(PC + (size_t)row * 256 + (cc - 36) * 8);
      *(uint4*)(rg + (size_t)row * 512 + cc * 8) = v; }
    __syncthreads();
    if (tid < 256) { const int row = tid >> 2, pc = tid & 3;
      const uint4 x1 = *(const uint4*)(PA + (size_t)row * 1024 + O_KR + pc * 8), x2 = *(const uint4*)(PA + (size_t)row * 1024 + O_KR + 32 + pc * 8);
      const float4 c0 = *(const float4*)(cs + row * 32 + pc * 8), c1 = *(const float4*)(cs + row * 32 + pc * 8 + 4), s0 = *(const float4*)(sn + row * 32 + pc * 8), s1 = *(const float4*)(sn + row * 32 + pc * 8 + 4);
#define RO1(a_, b_, c_, s_) ((a_) * (c_) - (b_) * (s_))
#define RO2(a_, b_, c_, s_) ((b_) * (c_) + (a_) * (s_))
#define LO(u_) __uint_as_float((u_) << 16)
#define HI(u_) __uint_as_float((u_) & 0xffff0000u)
      uint4 o1, o2;
      o1.x = pack2(RO1(LO(x1.x), LO(x2.x), c0.x, s0.x), RO1(HI(x1.x), HI(x2.x), c0.y, s0.y)); o1.y = pack2(RO1(LO(x1.y), LO(x2.y), c0.z, s0.z), RO1(HI(x1.y), HI(x2.y), c0.w, s0.w));
      o1.z = pack2(RO1(LO(x1.z), LO(x2.z), c1.x, s1.x), RO1(HI(x1.z), HI(x2.z), c1.y, s1.y)); o1.w = pack2(RO1(LO(x1.w), LO(x2.w), c1.z, s1.z), RO1(HI(x1.w), HI(x2.w), c1.w, s1.w));
      o2.x = pack2(RO2(LO(x1.x), LO(x2.x), c0.x, s0.x), RO2(HI(x1.x), HI(x2.x), c0.y, s0.y)); o2.y = pack2(RO2(LO(x1.y), LO(x2.y), c0.z, s0.z), RO2(HI(x1.y), HI(x2.y), c0.w, s0.w));
      o2.z = pack2(RO2(LO(x1.z), LO(x2.z), c1.x, s1.x), RO2(HI(x1.z), HI(x2.z), c1.y, s1.y)); o2.w = pack2(RO2(LO(x1.w), LO(x2.w), c1.z, s1.z), RO2(HI(x1.w), HI(x2.w), c1.w, s1.w));
#undef RO1
#undef RO2
#undef LO
#undef HI
#pragma unroll
      for (int h = 0; h < 4; ++h) { bf16_t* kp = Km + (((size_t)b * 4 + h) * SEQ + t0 + row) * 192 + 128 + pc * 8; *(uint4*)kp = o1; *(uint4*)(kp + 32) = o2; }
    }
    const float* gq = launder(p.in[8]); const float* gkv = launder(p.in[10]);
#pragma unroll 2
    for (int rr = 0; rr < 8; ++rr) { const int row = w * 8 + rr; const unsigned* cr = (const unsigned*)(PA + (size_t)row * 1024);
      float v0[5], v1[5];
#pragma unroll
      for (int i = 0; i < 5; ++i) { const unsigned u = cr[lane + 64 * i]; v0[i] = __uint_as_float(u << 16); v1[i] = __uint_as_float(u & 0xffff0000u); }
      float ss = v0[0] * v0[0] + v1[0] * v1[0] + v0[1] * v0[1] + v1[1] * v1[1] + v0[2] * v0[2] + v1[2] * v1[2];
      float s2 = v0[3] * v0[3] + v1[3] * v1[3] + v0[4] * v0[4] + v1[4] * v1[4];
      ss = wave_sum(ss); s2 = wave_sum(s2);
      const float rq = rsqrtf(ss * (1.f / 384.f) + EPS), rk = rsqrtf(s2 * (1.f / 256.f) + EPS);
#pragma unroll
      for (int i = 0; i < 3; ++i) { const int c = 2 * (lane + 64 * i); *(unsigned*)(CQN + (size_t)row * 384 + c) = pack2(v0[i] * rq * gq[c], v1[i] * rq * gq[c + 1]); }
#pragma unroll
      for (int i = 3; i < 5; ++i) { const int c = 2 * (lane + 64 * (i - 3)); *(unsigned*)(CKVN + (size_t)row * 256 + c) = pack2(v0[i] * rk * gkv[c], v1[i] * rk * gkv[c + 1]); }
    }
    __syncthreads();
    block_gemm<3>(lds, CQN, 384, (const bf16_t*)(ws + WS_WTQUP), 3, 384, [&](int m0, int n0, const f32x16& a0, const f32x16& a1) {
      const int r2 = lv(r), h2 = lv(hh), ln = lv(lane);
      const int h = n0 / 192, d0 = n0 % 192;
      bf16_t* qp = Qm + (((size_t)b * 4 + h) * SEQ + t0 + m0) * 192 + d0;
      if (d0 < 128) wt_write(wl, a0, a1, r2, h2, 1.f); else wt_write_rope(wl, a0, a1, r2, h2, cs, sn, m0);
      LDS_FENCE();
      wt_store(wl, ln, qp, 192, qp + 32, 192);
    });
    block_gemm<3>(lds, CKVN, 256, (const bf16_t*)(ws + WS_WTKVUP), 4, 256, [&](int m0, int n0, const f32x16& a0, const f32x16& a1) {
      const int r2 = lv(r), h2 = lv(hh), ln = lv(lane);
      const int h = n0 >> 8, d0 = n0 & 255;
      wt_write(wl, a0, a1, r2, h2, 1.f); LDS_FENCE();
      if (d0 < 128) { bf16_t* kp = Km + (((size_t)b * 4 + h) * SEQ + t0 + m0) * 192 + d0; wt_store(wl, ln, kp, 192, kp + 32, 192); }
      else { bf16_t* vp = Vm + (((size_t)b * 4 + h) * SEQ + t0 + m0) * 128 + (d0 - 128); wt_store(wl, ln, vp, 128, vp + 32, 128); }
    });
    gla_chunk_local(p, lds, ws, tile, PA, PB);
  }
}

namespace att {
typedef short s16x4 __attribute__((ext_vector_type(4)));
typedef unsigned u32x4 __attribute__((ext_vector_type(4)));
constexpr int DQ = 192, DV = 128, KVBLK = 64;
constexpr float SCALE = 0.07216878364870322f;
constexpr float THR = 8.f;
constexpr int SHM_V = KVBLK * DV * 2, SHM_K = KVBLK * DQ * 2;
constexpr int SHM_QR = 8 * 32 * 176;
constexpr int SHM_ATTN = 2 * SHM_V + 2 * SHM_K + 8 * 64 * 4 + SHM_QR;
#define KSWZ(row, colB) ((row) * 384 + ((colB) ^ (((row) & 7) << 4)))
#define SBAR() __builtin_amdgcn_sched_barrier(0)
DI unsigned cvtpk(float lo, float hi) { unsigned r; asm volatile("v_cvt_pk_bf16_f32 %0, %1, %2" : "=v"(r) : "v"(lo), "v"(hi)); return r; }

DI void partialSM(f32x16& p0, f32x16& p1, float& m_reg, float& mn, float& alpha) {
  constexpr float C = SCALE * 1.4426950408889634f;
  float pmax = p0[0];
#pragma unroll
  for (int r = 1; r < 16; ++r) pmax = fmaxf(pmax, p0[r]);
#pragma unroll
  for (int r = 0; r < 16; ++r) pmax = fmaxf(pmax, p1[r]);
  { auto rr = __builtin_amdgcn_permlane32_swap(__float_as_uint(pmax), __float_as_uint(pmax), false, false);
    pmax = fmaxf(__uint_as_float(rr[0]), __uint_as_float(rr[1])); }
  if (__builtin_expect(__all(pmax - m_reg <= THR / SCALE), 1)) { mn = m_reg; alpha = 1.f; }
  else { mn = fmaxf(m_reg, pmax); alpha = __builtin_amdgcn_exp2f((m_reg - mn) * C); m_reg = mn; }
  const float mnC = -mn * C;
#pragma unroll
  for (int r = 0; r < 16; ++r) p0[r] = fmaf(p0[r], C, mnC);
#pragma unroll
  for (int r = 0; r < 16; ++r) p1[r] = fmaf(p1[r], C, mnC);
#pragma unroll
  for (int r = 0; r < 16; ++r) p0[r] = __builtin_amdgcn_exp2f(p0[r]);
}
DI void finishSM(f32x16& p0, f32x16& p1, float alpha, float& l_reg, bf16x8& pa0, bf16x8& pa1, bf16x8& pa2, bf16x8& pa3) {
#pragma unroll
  for (int r = 0; r < 16; ++r) p1[r] = __builtin_amdgcn_exp2f(p1[r]);
  float ps = 0;
#pragma unroll
  for (int r = 0; r < 16; ++r) ps += p0[r];
#pragma unroll
  for (int r = 0; r < 16; ++r) ps += p1[r];
  { auto rr = __builtin_amdgcn_permlane32_swap(__float_as_uint(ps), __float_as_uint(ps), false, false);
    ps = __uint_as_float(rr[0]) + __uint_as_float(rr[1]); }
  l_reg = l_reg * alpha + ps;
#define PK4(P, BASE, OUT) do { unsigned a0 = cvtpk(P[BASE + 0], P[BASE + 1]), a1 = cvtpk(P[BASE + 2], P[BASE + 3]);   \
    unsigned b0 = cvtpk(P[BASE + 4], P[BASE + 5]), b1 = cvtpk(P[BASE + 6], P[BASE + 7]);                              \
    auto r0 = __builtin_amdgcn_permlane32_swap(a0, b0, false, false); auto r1 = __builtin_amdgcn_permlane32_swap(a1, b1, false, false); \
    u32x4 wv = {r0[0], r1[0], r0[1], r1[1]}; OUT = *reinterpret_cast<bf16x8*>(&wv); } while (0)
  PK4(p0, 0, pa0); PK4(p0, 8, pa1); PK4(p1, 0, pa2); PK4(p1, 8, pa3);
#undef PK4
}
DI void qkt(f32x16& p0, f32x16& p1, const char* Ks, const bf16x8* qr, const char* qrl, int r32, int hi) {
#pragma unroll
  for (int i = 0; i < 16; ++i) { p0[i] = 0.f; p1[i] = 0.f; }
#pragma unroll
  for (int d0 = 0; d0 < 12; ++d0) { const int cb = (d0 * 16 + hi * 8) * 2;
    const bf16x8 b0 = *reinterpret_cast<const bf16x8*>(Ks + KSWZ(r32, cb));
    const bf16x8 b1 = *reinterpret_cast<const bf16x8*>(Ks + KSWZ(32 + r32, cb));
    const bf16x8 q = (d0 < 7) ? qr[d0 < 7 ? d0 : 0] : *reinterpret_cast<const bf16x8*>(qrl + (d0 - 7) * 32);
    p0 = MFMA32(b0, q, p0);
    p1 = MFMA32(b1, q, p1); }
}
DI int v_st(int k, int c) { const int kk = (k & ~0xC) | ((k & 4) << 1) | ((k & 8) >> 1); return ((kk >> 3) * 4 + (c >> 5)) * 512 + ((kk & 7) * 32 + (c & 31)) * 2; }
DI int v_rd_base(int lane) { return ((lane & 3) << 3) | (((lane >> 2) & 3) << 6) | (((lane >> 4) & 1) << 5) | (((lane >> 5) & 1) << 8); }
constexpr int v_rd_off(int d0, int ks, int half) { return d0 * 512 + ks * 4096 + half * 2048; }
template <int OFF> DI s16x4 tr_read(int vb) { s16x4 r; asm volatile("ds_read_b64_tr_b16 %0, %1 offset:%2" : "=&v"(r) : "v"(vb), "i"(OFF) : "memory"); return r; }
template <int D0> DI void pv_one(f32x16& od, int vb, bf16x8 pa0, bf16x8 pa1, bf16x8 pa2, bf16x8 pa3) {
  const s16x4 l0 = tr_read<v_rd_off(D0, 0, 0)>(vb), h0 = tr_read<v_rd_off(D0, 0, 1)>(vb), l1 = tr_read<v_rd_off(D0, 1, 0)>(vb), h1 = tr_read<v_rd_off(D0, 1, 1)>(vb);
  const s16x4 l2 = tr_read<v_rd_off(D0, 2, 0)>(vb), h2 = tr_read<v_rd_off(D0, 2, 1)>(vb), l3 = tr_read<v_rd_off(D0, 3, 0)>(vb), h3 = tr_read<v_rd_off(D0, 3, 1)>(vb);
  asm volatile("s_waitcnt lgkmcnt(0)" ::: "memory"); SBAR();
#define PK(L, H) (bf16x8){L[0], L[1], L[2], L[3], H[0], H[1], H[2], H[3]}
  od = MFMA32(pa0, PK(l0, h0), od);
  od = MFMA32(pa1, PK(l1, h1), od);
  od = MFMA32(pa2, PK(l2, h2), od);
  od = MFMA32(pa3, PK(l3, h3), od);
#undef PK
}
DI void pv_d0(f32x16* o, int vb, bf16x8 pa0, bf16x8 pa1, bf16x8 pa2, bf16x8 pa3) {
  pv_one<0>(o[0], vb, pa0, pa1, pa2, pa3); pv_one<1>(o[1], vb, pa0, pa1, pa2, pa3); pv_one<2>(o[2], vb, pa0, pa1, pa2, pa3); pv_one<3>(o[3], vb, pa0, pa1, pa2, pa3);
}
DI void attn_unit(const bf16_t* Qb, const bf16_t* Kh, const bf16_t* Vh, bf16_t* Ob, int seq, char* lds) {
  const int tid = lv(threadIdx.x), wid = tid >> 6, lane = tid & 63, r32 = lane & 31, hi = lane >> 5;
  char* V_lds = lds; char* K_lds = lds + 2 * SHM_V;
  float* wsf = (float*)(lds + 2 * SHM_V + 2 * SHM_K) + wid * 64; float* li_l = wsf; float* al_l = wsf + 32;
  char* qrl = lds + 2 * SHM_V + 2 * SHM_K + 8 * 64 * 4 + wid * (32 * 176) + r32 * 176 + hi * 16;
  float m_reg = -1e30f, l_reg = 0; f32x16 o[4]; bf16x8 qr[7];
#pragma unroll
  for (int d = 0; d < 4; ++d)
#pragma unroll
    for (int i = 0; i < 16; ++i) o[d][i] = 0.f;
  const bf16_t* Qw = Qb + (size_t)(wid * 32 + r32) * DQ + hi * 8;
#pragma unroll
  for (int d0 = 0; d0 < 7; ++d0) qr[d0] = *reinterpret_cast<const bf16x8*>(Qw + d0 * 16);
#pragma unroll
  for (int d0 = 7; d0 < 12; ++d0) *reinterpret_cast<bf16x8*>(qrl + (d0 - 7) * 32) = *reinterpret_cast<const bf16x8*>(Qw + d0 * 16);
  int kst[3];
#pragma unroll
  for (int i = 0; i < 3; ++i) { const int c = tid + 512 * i; kst[i] = KSWZ(c / 24, (c % 24) * 16); }
  const int vst0 = v_st(tid >> 4, (tid & 15) * 8), vst1 = v_st(32 + (tid >> 4), (tid & 15) * 8);
  const int vb0 = (int)(uintptr_t)V_lds + v_rd_base(lane);
  bf16x8 sk0, sk1, sk2, sv0, sv1;
#define SLOAD(k0) do { const bf16x8* kp = reinterpret_cast<const bf16x8*>(Kh + (size_t)(k0) * DQ) + tid; sk0 = kp[0]; sk1 = kp[512]; sk2 = kp[1024]; \
    const bf16x8* vp = reinterpret_cast<const bf16x8*>(Vh + (size_t)(k0) * DV) + tid; sv0 = vp[0]; sv1 = vp[512]; } while (0)
#define SWRITE(b) do { *(bf16x8*)(V_lds + (b) * SHM_V + vst0) = sv0; *(bf16x8*)(V_lds + (b) * SHM_V + vst1) = sv1; \
    *(bf16x8*)(K_lds + (b) * SHM_K + kst[0]) = sk0; *(bf16x8*)(K_lds + (b) * SHM_K + kst[1]) = sk1; *(bf16x8*)(K_lds + (b) * SHM_K + kst[2]) = sk2; } while (0)
#define RESC(a) do { if (__any((a) < 1.f)) { if (hi == 0) al_l[r32] = (a); asm volatile("s_waitcnt lgkmcnt(0)" ::: "memory"); \
    _Pragma("unroll") for (int d = 0; d < 4; ++d) _Pragma("unroll") for (int r = 0; r < 16; ++r) o[d][r] *= al_l[crow(r, hi)]; } } while (0)
  f32x16 pA0, pA1, pB0, pB1; float mnA, mnB, alA, alB; bf16x8 pa0, pa1, pa2, pa3; const int NT = seq / KVBLK;
  SLOAD(0); SWRITE(0); __syncthreads();
  qkt(pA0, pA1, K_lds, qr, qrl, r32, hi); partialSM(pA0, pA1, m_reg, mnA, alA);
  SLOAD(KVBLK); SWRITE(1); __syncthreads();
  for (int j = 1; j + 1 < NT; j += 2) {
    SBAR(); qkt(pB0, pB1, K_lds + SHM_K, qr, qrl, r32, hi);
    finishSM(pA0, pA1, alA, l_reg, pa0, pa1, pa2, pa3); SBAR();
    SLOAD((j + 1) * KVBLK); SBAR();
    pv_d0(o, vb0, pa0, pa1, pa2, pa3); partialSM(pB0, pB1, m_reg, mnB, alB);
    __syncthreads(); SWRITE(0);
    RESC(alB); __syncthreads();
    SBAR(); qkt(pA0, pA1, K_lds, qr, qrl, r32, hi);
    finishSM(pB0, pB1, alB, l_reg, pa0, pa1, pa2, pa3); SBAR();
    SLOAD((j + 2) * KVBLK); SBAR();
    pv_d0(o, vb0 + SHM_V, pa0, pa1, pa2, pa3); partialSM(pA0, pA1, m_reg, mnA, alA);
    __syncthreads(); SWRITE(1);
    RESC(alA); __syncthreads();
  }
  SBAR(); qkt(pB0, pB1, K_lds + SHM_K, qr, qrl, r32, hi);
  finishSM(pA0, pA1, alA, l_reg, pa0, pa1, pa2, pa3); SBAR();
  pv_d0(o, vb0, pa0, pa1, pa2, pa3); partialSM(pB0, pB1, m_reg, mnB, alB);
  __syncthreads(); RESC(alB);
  finishSM(pB0, pB1, alB, l_reg, pa0, pa1, pa2, pa3); SBAR();
  pv_d0(o, vb0 + SHM_V, pa0, pa1, pa2, pa3);
  if (hi == 0) li_l[r32] = l_reg; asm volatile("s_waitcnt lgkmcnt(0)" ::: "memory");
  float rli[16];
#pragma unroll
  for (int r = 0; r < 16; ++r) rli[r] = __builtin_amdgcn_rcpf(li_l[crow(r, hi)]);
  bf16_t* Ow = Ob + (size_t)(wid * 32) * 1024;
#pragma unroll
  for (int r = 0; r < 16; ++r) { const int orow = crow(r, hi);
#pragma unroll
    for (int d0 = 0; d0 < 4; ++d0) Ow[(size_t)orow * 1024 + d0 * 32 + r32] = f2bf(o[d0][r] * rli[r]); }
  __syncthreads();
#undef SLOAD
#undef SWRITE
#undef RESC
}
}

DI void phase2_attn(const KP& p, char* lds) {
  for (int u = blockIdx.x; u < 256; u += gridDim.x) {
    unsigned char* ws = launder(p.ws);
    const bf16_t* Qm = (const bf16_t*)(ws + WS_QM); const bf16_t* Km = (const bf16_t*)(ws + WS_KM); const bf16_t* Vm = (const bf16_t*)(ws + WS_VM);
    bf16_t* mixa = (bf16_t*)(ws + WS_P1S);
    const int qb = u & 7, bh = u >> 3, b = bh >> 2, h = bh & 3;
    att::attn_unit(Qm + ((size_t)bh * SEQ + qb * 256) * 192, Km + (size_t)bh * SEQ * 192, Vm + (size_t)bh * SEQ * 128,
                   mixa + ((size_t)b * SEQ + qb * 256) * 1024 + h * 128, SEQ, lds);
  }
}

namespace pg8 {
#define PG8_LAS __attribute__((address_space(3)))
typedef unsigned short bf16_t;
typedef short bf16x8 __attribute__((ext_vector_type(8)));
typedef float f32x4 __attribute__((ext_vector_type(4)));
typedef unsigned u32x4 __attribute__((ext_vector_type(4)));
constexpr int BM = 256, BK = 64, HALF = 128, HTB = HALF * BK * 2  , STAGE_BYTES = 8 * HTB, NXCD = 8, WGM = 8;

__host__ __device__ __forceinline__ int lds_byte(int r, int c) { const int st = (r >> 4) * 2 + (c >> 5), rr = r & 15, cc = c & 31, ob = rr * 64 + cc * 2; return st * 1024 + (ob ^ (((ob >> 9) & 1) << 5)); }
__host__ __device__ __forceinline__ void stage_rc(int b, int& R, int& C) { const int st = b / 1024, sb = b % 1024, swz = sb ^ (((sb >> 9) & 1) << 5); R = (st >> 1) * 16 + swz / 64; C = (st & 1) * 32 + (swz % 64) / 2; }
__host__ __device__ __forceinline__ int perm32(int rho) { const int n = rho >> 4, i = rho & 15; return 8 * (i >> 2) + 4 * n + (i & 3); }

struct Unit { int pm, pn; };
struct Gemm { const bf16_t* A; const bf16_t* Bt; int M, N, K; };

struct StaticOrder {
    int nM, nN, nwg, G, c;
    __host__ __device__ void init(int M, int N, int G_, int c_) { nM = M / BM; nN = N / BM; nwg = nM * nN; G = G_; c = c_; }
    __host__ __device__ bool next(int i, Unit& u) const {
        const long L = (long)i * G + c; if (L >= nwg) return false;
        int wgid = (int)L; { const int q = nwg / NXCD, r = nwg % NXCD, xcd = wgid % NXCD, off = wgid / NXCD; wgid = (xcd < r ? xcd * (q + 1) : r * (q + 1) + (xcd - r) * q) + off; }
        const int nig = WGM * nN, gid = wgid / nig, fm = gid * WGM, gsz = (nM - fm) < WGM ? (nM - fm) : WGM;
        u.pm = fm + ((wgid % nig) % gsz); u.pn = (wgid % nig) / gsz; return true;
    }
    __device__ __forceinline__ void a_ready(const Unit&) const {}
    __device__ __forceinline__ void done(const Unit&) const {}
};

__device__ __forceinline__ unsigned cvt_pk_bf16(float lo, float hi) { unsigned r; asm volatile("v_cvt_pk_bf16_f32 %0, %1, %2" : "=v"(r) : "v"(lo), "v"(hi)); return r; }
typedef float f32x2 __attribute__((ext_vector_type(2)));
__device__ __forceinline__ f32x2 gelu_pk(f32x2 v) {
    const f32x2 av = __builtin_elementwise_abs(v), d = av * 0.2316418882f + 1.0f;
    f32x2 t; t.x = __builtin_amdgcn_rcpf(d.x); t.y = __builtin_amdgcn_rcpf(d.y);
    f32x2 q = t * 0.5307027145f + (-0.7265760135f); q = q * t + 0.7107068705f; q = q * t + (-0.142248368f); q = q * t + 0.127414796f; q = q * t;
    const f32x2 s = (v * v) * (-0.72134752044f);
    f32x2 e; e.x = __builtin_amdgcn_exp2f(s.x); e.y = __builtin_amdgcn_exp2f(s.y);
    const f32x2 m = v * (q * e), r = v - m;
    f32x2 o; o.x = v.x < 0.f ? m.x : r.x; o.y = v.y < 0.f ? m.y : r.y; return o;
}

template <int ACT  > struct EpiBf16 {
    static constexpr bool PERM = true, AFTER_DRAIN = false; static_assert(ACT == 0 || ACT == 1, "EpiBf16: ACT is 0 (none) or 1 (gelu_pk)");
    bf16_t* O; int ldc; const float* bias; int split_cols; size_t split_stride; float scale0;
    __device__ __forceinline__ void operator()(const f32x4 (&acc)[2][2][4][2], const Unit& u, int wr, int wc, int fr, int fq) const {
        const int row0 = u.pm * BM + wr * 64 + fr; int colt = u.pn * BM; bf16_t* base = O;
        float sc = 1.f; if (split_cols) { const int t = colt / split_cols; base += (size_t)t * split_stride; colt -= t * split_cols; if (t == 0) sc = scale0; }
        const int col0 = colt + wc * 32 + 8 * fq, bcol0 = u.pn * BM + wc * 32 + 8 * fq;
        f32x4 bv[2][2];
#pragma unroll
        for (int bj = 0; bj < 2; ++bj)
#pragma unroll
            for (int n = 0; n < 2; ++n) bv[bj][n] = bias ? *(const f32x4*)(bias + bcol0 + bj * HALF + 4 * n) : (f32x4){0.f, 0.f, 0.f, 0.f};
#pragma unroll
        for (int ai = 0; ai < 2; ++ai)
#pragma unroll
            for (int m = 0; m < 4; ++m) { bf16_t* rowp = base + (size_t)(row0 + ai * HALF + m * 16) * ldc + col0;
#pragma unroll
                for (int bj = 0; bj < 2; ++bj) { f32x4 v0 = acc[ai][bj][m][0] + bv[bj][0], v1 = acc[ai][bj][m][1] + bv[bj][1];
                    if (ACT == 1) { f32x2 a = gelu_pk((f32x2){v0[0], v0[1]}), b = gelu_pk((f32x2){v0[2], v0[3]}), c = gelu_pk((f32x2){v1[0], v1[1]}), d = gelu_pk((f32x2){v1[2], v1[3]});
                        v0 = (f32x4){a.x, a.y, b.x, b.y}; v1 = (f32x4){c.x, c.y, d.x, d.y}; }
                    v0 = v0 * sc; v1 = v1 * sc; u32x4 w; w.x = cvt_pk_bf16(v0[0], v0[1]); w.y = cvt_pk_bf16(v0[2], v0[3]); w.z = cvt_pk_bf16(v1[0], v1[1]); w.w = cvt_pk_bf16(v1[2], v1[3]);
                    *(u32x4*)(rowp + bj * HALF) = w; } }
    }
};

template <class Epi, class Sched, bool ALIGN_EPI = false, bool SP2 = false>
__device__ __forceinline__ void gemm_phase(PG8_LAS unsigned char* lds, const Gemm g, const Sched& S, const Epi& E) {
    const int tid = threadIdx.x, wid = __builtin_amdgcn_readfirstlane(tid >> 6), lane = tid & 63, wr = wid >> 2, wc = wid & 3, fr = lane & 15, fq = lane >> 4;
    const int K = g.K, nt = K / BK;
    unsigned voffA[2], voffB[2];
#pragma unroll
    for (int i = 0; i < 2; ++i) { int R, C; stage_rc(tid * 16 + i * 8192, R, C); const int Rb = Epi::PERM ? ((R & ~31) + perm32(R & 31)) : R;
        voffA[i] = (unsigned)(R * K + C) * 2u; voffB[i] = (unsigned)(Rb * K + C) * 2u; }
    const size_t kstep = (size_t)(BK * 2);
    const size_t hstep = (size_t)HALF * K * 2;
    const size_t tstep = 2 * hstep;
    const unsigned ldsw = (unsigned)wid * 1024u;
    const int aoff = lds_byte(wr * 64 + fr, fq * 8), boff = lds_byte(wc * 32 + fr, fq * 8);
#define PG8_SA(b, h) (((b) * 2 + (h)) * HTB)
#define PG8_SB(b, h) ((4 + (b) * 2 + (h)) * HTB)
#define PG8_STAGE(bufoff, gbase, voff) do { _Pragma("unroll") for (int _i = 0; _i < 2; ++_i) \
        __builtin_amdgcn_global_load_lds((const unsigned*)((const char*)(gbase) + (voff)[_i]), (PG8_LAS unsigned*)(lds + (bufoff) + ldsw + _i * 8192), 16, 0, 0); } while (0)
#define PG8_LDA(dst, b, h) do { _Pragma("unroll") for (int m = 0; m < 4; ++m) _Pragma("unroll") for (int k = 0; k < 2; ++k) dst[m][k] = *(const PG8_LAS bf16x8*)(lds + PG8_SA(b, h) + aoff + m * 2048 + k * 1024); } while (0)
#define PG8_LDB(dst, b, h) do { _Pragma("unroll") for (int n = 0; n < 2; ++n) _Pragma("unroll") for (int k = 0; k < 2; ++k) dst[n][k] = *(const PG8_LAS bf16x8*)(lds + PG8_SB(b, h) + boff + n * 2048 + k * 1024); } while (0)
#define PG8_MMA(ai, bj, At, Bt) do { __builtin_amdgcn_s_setprio(1); _Pragma("unroll") for (int m = 0; m < 4; ++m) _Pragma("unroll") for (int n = 0; n < 2; ++n) _Pragma("unroll") for (int k = 0; k < 2; ++k) \
        acc[ai][bj][m][n] = __builtin_amdgcn_mfma_f32_16x16x32_bf16(Bt[n][k], At[m][k], acc[ai][bj][m][n], 0, 0, 0); __builtin_amdgcn_s_setprio(0); } while (0)
#define PG8_WAIT_V(n) asm volatile("s_waitcnt vmcnt(" #n ")" ::: "memory")
#define PG8_WAIT_L(n) asm volatile("s_waitcnt lgkmcnt(" #n ")" ::: "memory")
#define PG8_BAR __builtin_amdgcn_s_barrier()
#define PG8_SCHED __builtin_amdgcn_sched_barrier(0)
    Unit cur, nxt; int ui = 0;
    if (!S.next(0, cur)) return;
    f32x4 acc[2][2][4][2];
#pragma unroll
    for (int a = 0; a < 2; ++a)
#pragma unroll
        for (int b = 0; b < 2; ++b)
#pragma unroll
            for (int m = 0; m < 4; ++m)
#pragma unroll
                for (int n = 0; n < 2; ++n) acc[a][b][m][n] = (f32x4){0.f, 0.f, 0.f, 0.f};
    bf16x8 At[4][2], B0[2][2], B1[2][2];
    const char* cA = (const char*)g.A + (size_t)cur.pm * tstep; const char* cB = (const char*)g.Bt + (size_t)cur.pn * tstep;
    S.a_ready(cur);
    if constexpr (SP2) {
        PG8_STAGE(PG8_SB(0, 0), cB, voffB); PG8_STAGE(PG8_SB(0, 1), cB + hstep, voffB); PG8_STAGE(PG8_SA(0, 0), cA, voffA); PG8_STAGE(PG8_SA(0, 1), cA + hstep, voffA);
        if (wr == 1) PG8_BAR;
        PG8_WAIT_V(2); PG8_BAR;
        PG8_STAGE(PG8_SB(1, 0), cB + kstep, voffB); PG8_STAGE(PG8_SA(1, 0), cA + kstep, voffA); PG8_STAGE(PG8_SB(1, 1), cB + hstep + kstep, voffB);
        PG8_WAIT_V(6); PG8_BAR;
    } else {
        PG8_STAGE(PG8_SB(0, 0), cB, voffB); PG8_STAGE(PG8_SA(0, 0), cA, voffA); PG8_STAGE(PG8_SB(0, 1), cB + hstep, voffB); PG8_STAGE(PG8_SA(0, 1), cA + hstep, voffA);
        if (wr == 1) PG8_BAR;
        PG8_WAIT_V(4); PG8_BAR;
        PG8_STAGE(PG8_SB(1, 0), cB + kstep, voffB); PG8_STAGE(PG8_SA(1, 0), cA + kstep, voffA); PG8_STAGE(PG8_SB(1, 1), cB + hstep + kstep, voffB);
        PG8_WAIT_V(6); PG8_BAR;
    }
    for (;;) {
        const bool has_next = S.next(ui + 1, nxt);
        const char* nA = has_next ? (const char*)g.A + (size_t)nxt.pm * tstep : cA; const char* nB = has_next ? (const char*)g.Bt + (size_t)nxt.pn * tstep : cB;
        for (int t = 0; t < nt; t += 2) {
            const bool last = (t == nt - 2);
            const char* a1 = cA + (size_t)(t + 1) * kstep;
            const char* a2 = last ? nA : cA + (size_t)(t + 2) * kstep; const char* b2 = last ? nB : cB + (size_t)(t + 2) * kstep;
            const char* a3 = a2 + kstep; const char* b3 = b2 + kstep;
            if (last && has_next) S.a_ready(nxt);
            if constexpr (SP2) {
            PG8_LDB(B0, 0, 0); PG8_LDB(B1, 0, 1); PG8_SCHED; PG8_LDA(At, 0, 0); PG8_STAGE(PG8_SA(1, 1), a1 + hstep, voffA);
            PG8_WAIT_V(8); PG8_WAIT_L(0); PG8_BAR; PG8_MMA(0, 0, At, B0); PG8_MMA(0, 1, At, B1); PG8_BAR; PG8_SCHED;
            PG8_LDA(At, 0, 1); PG8_STAGE(PG8_SB(0, 0), b2, voffB); PG8_STAGE(PG8_SB(0, 1), b2 + hstep, voffB); PG8_STAGE(PG8_SA(0, 0), a2, voffA);
            PG8_WAIT_V(8); PG8_WAIT_L(0); PG8_BAR; PG8_MMA(1, 0, At, B0); PG8_MMA(1, 1, At, B1); PG8_BAR; PG8_SCHED;
            PG8_LDB(B0, 1, 0); PG8_LDB(B1, 1, 1); PG8_SCHED; PG8_LDA(At, 1, 0); PG8_STAGE(PG8_SA(0, 1), a2 + hstep, voffA);
            PG8_WAIT_V(8); PG8_WAIT_L(0); PG8_BAR; PG8_MMA(0, 0, At, B0); PG8_MMA(0, 1, At, B1); PG8_BAR; PG8_SCHED;
            PG8_LDA(At, 1, 1); PG8_STAGE(PG8_SB(1, 0), b3, voffB); PG8_STAGE(PG8_SB(1, 1), b3 + hstep, voffB); PG8_STAGE(PG8_SA(1, 0), a3, voffA);
            PG8_WAIT_V(8); PG8_WAIT_L(0); PG8_BAR; PG8_MMA(1, 0, At, B0); PG8_MMA(1, 1, At, B1); PG8_BAR; PG8_SCHED;
            } else {
            PG8_LDB(B0, 0, 0); PG8_SCHED; PG8_LDA(At, 0, 0); PG8_STAGE(PG8_SA(1, 1), a1 + hstep, voffA);
            PG8_WAIT_L(8); PG8_BAR; PG8_WAIT_L(0); PG8_MMA(0, 0, At, B0); PG8_BAR; PG8_SCHED;
            PG8_LDB(B1, 0, 1); PG8_STAGE(PG8_SB(0, 0), b2, voffB);
            PG8_BAR; PG8_WAIT_L(0); PG8_MMA(0, 1, At, B1); PG8_BAR;
            PG8_LDA(At, 0, 1); PG8_STAGE(PG8_SA(0, 0), a2, voffA);
            PG8_BAR; PG8_WAIT_L(0); PG8_MMA(1, 0, At, B0); PG8_BAR; PG8_SCHED;
            PG8_STAGE(PG8_SB(0, 1), b2 + hstep, voffB);
            PG8_WAIT_V(6); PG8_BAR; PG8_MMA(1, 1, At, B1); PG8_BAR;
            PG8_LDB(B0, 1, 0); PG8_SCHED; PG8_LDA(At, 1, 0); PG8_STAGE(PG8_SA(0, 1), a2 + hstep, voffA);
            PG8_WAIT_L(8); PG8_BAR; PG8_WAIT_L(0); PG8_MMA(0, 0, At, B0); PG8_BAR; PG8_SCHED;
            PG8_LDB(B1, 1, 1); PG8_STAGE(PG8_SB(1, 0), b3, voffB);
            PG8_BAR; PG8_WAIT_L(0); PG8_MMA(0, 1, At, B1); PG8_BAR;
            PG8_LDA(At, 1, 1); PG8_STAGE(PG8_SA(1, 0), a3, voffA);
            PG8_BAR; PG8_WAIT_L(0); PG8_MMA(1, 0, At, B0); PG8_BAR; PG8_SCHED;
            PG8_STAGE(PG8_SB(1, 1), b3 + hstep, voffB);
            PG8_WAIT_V(6); PG8_BAR; PG8_MMA(1, 1, At, B1); PG8_BAR;
            }
        }
        if constexpr (ALIGN_EPI) { if (wr == 0) PG8_BAR; }
        if constexpr (!Epi::AFTER_DRAIN) { E(acc, cur, wr, wc, fr, fq); S.done(cur); }
        if (!has_next) break;
#pragma unroll
        for (int a = 0; a < 2; ++a)
#pragma unroll
            for (int b = 0; b < 2; ++b)
#pragma unroll
                for (int m = 0; m < 4; ++m)
#pragma unroll
                    for (int n = 0; n < 2; ++n) acc[a][b][m][n] = (f32x4){0.f, 0.f, 0.f, 0.f};
        cur = nxt; cA = nA; cB = nB; ++ui;
        if constexpr (ALIGN_EPI) { if (wr == 1) PG8_BAR; }
    }
    PG8_WAIT_V(0);
    if constexpr (!ALIGN_EPI) { if (wr == 0) PG8_BAR; }
    PG8_BAR;
    if constexpr (Epi::AFTER_DRAIN) { E.fused(acc, cur, wr, wc, fr, fq, lds, wid, lane); S.done(cur); }
#undef PG8_SA
#undef PG8_SB
#undef PG8_STAGE
#undef PG8_LDA
#undef PG8_LDB
#undef PG8_MMA
#undef PG8_WAIT_V
#undef PG8_WAIT_L
#undef PG8_BAR
#undef PG8_SCHED
}
}


namespace pg8 {
struct EpiProj {
    static constexpr bool PERM = true, AFTER_DRAIN = false;
    bf16_t* P0; bf16_t* P1; bf16_t* P2;
    __device__ __forceinline__ void operator()(const f32x4 (&acc)[2][2][4][2], const Unit& u, int wr, int wc, int fr, int fq) const {
        const int row0 = u.pm * BM + wr * 64 + fr; const int colt = u.pn * BM;
        const long d1 = (long)(P1 - P0), d2 = (long)(P2 - P0); long dsel = 0; if (colt >= 1024) dsel = d1; if (colt >= 2048) dsel = d2;
        bf16_t* base = P0 + dsel; const int ldc = colt < 2048 ? 1024 : 256; const int cl = colt & 1023;
        const int col0 = cl + wc * 32 + 8 * fq;
#pragma unroll
        for (int ai = 0; ai < 2; ++ai)
#pragma unroll
            for (int m = 0; m < 4; ++m) { bf16_t* rowp = base + (size_t)(row0 + ai * HALF + m * 16) * ldc + col0;
#pragma unroll
                for (int bj = 0; bj < 2; ++bj) { const f32x4 v0 = acc[ai][bj][m][0], v1 = acc[ai][bj][m][1];
                    u32x4 w; w.x = cvt_pk_bf16(v0[0], v0[1]); w.y = cvt_pk_bf16(v0[2], v0[3]); w.z = cvt_pk_bf16(v1[0], v1[1]); w.w = cvt_pk_bf16(v1[2], v1[3]);
                    *(u32x4*)(rowp + bj * HALF) = w; } }
    }
};
}

constexpr int P3_TILE_BYTES = 256 * 1024;
constexpr int LDS_TK = 92160;
constexpr int GP_SH = 11, GP_N = 16384 >> GP_SH, GP_OS = GP_N + 1;
constexpr int LDS_OFF = 32768, LDS_CNT = 36864, LDS_LIST = 36864, LDS_H2L = 45056, LDS_SE = 110592;
constexpr int SCW = 260;
template <int N> DI void ce_desc(float (&a)[N], int i, int l) { const float hi = fmaxf(a[i], a[l]), lo = fminf(a[i], a[l]); a[i] = hi; a[l] = lo; }
DI void sort16_desc(float (&a)[16]) {
#pragma unroll
  for (int k = 2; k <= 16; k <<= 1)
#pragma unroll
    for (int j = k >> 1; j > 0; j >>= 1)
#pragma unroll
      for (int i = 0; i < 16; ++i) { const int l = i ^ j; if (l > i) { if ((i & k) == 0) ce_desc(a, i, l); else ce_desc(a, l, i); } }
}
DI void merge16_desc(float (&a)[16]) {
#pragma unroll
  for (int j = 8; j > 0; j >>= 1)
#pragma unroll
    for (int i = 0; i < 16; ++i) { const int l = i ^ j; if (l > i) ce_desc(a, i, l); }
}
DI void top16_merge(float (&a)[16], const float (&b)[16]) {
#pragma unroll
  for (int i = 0; i < 16; ++i) a[i] = fmaxf(a[i], b[15 - i]);
  merge16_desc(a);
}
template <int CTRL> DI float dpp_f(float v) { return __int_as_float(__builtin_amdgcn_mov_dpp(__float_as_int(v), CTRL, 0xF, 0xF, true)); }

DI float gelu_fast(float x) { return 0.5f * x * (1.f + erff(x * 0.70710678118654752f)); }

DI void phase3(const KP& p, char* lds, const int gather_reps, const int probe) {
  const int tid0 = threadIdx.x;
  const int r = tid0 & 31, hh = (tid0 >> 5) & 1, lane = tid0 & 63;
  char* wl = lds + LDS_WT + ((tid0 >> 6) & 3) * WT_BYTES;
  for (int tile = blockIdx.x; tile < 256; tile += gridDim.x) {
    unsigned char* ws = launder(p.ws); float* outp = launder(p.out); const float* xin = launder(p.in[0]);
    const int tok0 = tile * 64, b = tile >> 5;
    unsigned char* tsc = ws + WS_QM + (size_t)tile * P3_TILE_BYTES;
    bf16_t* QRY = (bf16_t*)tsc; bf16_t* Y = (bf16_t*)tsc; bf16_t* MIXA = (bf16_t*)(ws + WS_P1S) + (size_t)tok0 * 1024; bf16_t* H2 = MIXA;
    const float* modb = launder((const float*)(ws + WS_MOD)) + b * 6144;
    __syncthreads();
    {
      const int tid = lv(tid0), lane = tid & 63, w = tid >> 6, r = lane & 31, hh = lane >> 5;
      const int h = w >> 1, mi = w & 1, n = tile & 31;
      char* OIL = lds; char* RGL = lds + 66560;
      { const bf16_t* oig = (const bf16_t*)(ws + WS_OINTRA) + (size_t)tok0 * 512; const bf16_t* rgg = (const bf16_t*)(ws + WS_RG) + (size_t)tok0 * 512;
#pragma unroll
        for (int i = 0; i < 8; ++i) { const int c = tid + 512 * i, row = c >> 6, cc = c & 63;
          *(uint4*)(OIL + row * 1040 + cc * 16) = *(const uint4*)(oig + (size_t)row * 512 + cc * 8);
          *(uint4*)(RGL + row * 1040 + cc * 16) = *(const uint4*)(rgg + (size_t)row * 512 + cc * 8); } }
      const bf16_t* QDg = (const bf16_t*)(ws + WS_QDEC) + (size_t)(tile * 4 + h) * 2 * 4096 + (mi * 32 + r) * 64 + hh * 8;
      const bf16_t* SPg = (const bf16_t*)(ws + WS_SPT) + ((size_t)((b * 4 + h) * 2) * 32 + n) * 8192 + r * 64 + hh * 8;
      f32x16 acc[4];
#pragma unroll
      for (int ni = 0; ni < 4; ++ni)
#pragma unroll
        for (int i = 0; i < 16; ++i) acc[ni][i] = 0.f;
#pragma unroll
      for (int d = 0; d < 2; ++d)
#pragma unroll
        for (int s = 0; s < 4; ++s) { const bf16x8 a = *(const bf16x8*)(QDg + d * 4096 + s * 16);
#pragma unroll
          for (int ni = 0; ni < 4; ++ni) { const bf16x8 bb = *(const bf16x8*)(SPg + (size_t)d * 32 * 8192 + ni * 32 * 64 + s * 16); acc[ni] = MFMA32(a, bb, acc[ni]); } }
      __syncthreads();
      bf16_t* oil = (bf16_t*)(OIL + (mi * 32 + 4 * hh) * 1040) + h * 128 + r; const bf16_t* rgl = (const bf16_t*)(RGL + (mi * 32 + 4 * hh) * 1040) + h * 128 + r;
#pragma unroll
      for (int ni = 0; ni < 4; ++ni)
#pragma unroll
        for (int reg = 0; reg < 16; ++reg) acc[ni][reg] += bf2f(oil[((reg & 3) + 8 * (reg >> 2)) * 520 + ni * 32]);
      float rs[16];
#pragma unroll
      for (int reg = 0; reg < 16; ++reg) { float v = acc[0][reg] * acc[0][reg] + acc[1][reg] * acc[1][reg] + acc[2][reg] * acc[2][reg] + acc[3][reg] * acc[3][reg];
        v += __shfl_xor(v, 1); v += __shfl_xor(v, 2); v += __shfl_xor(v, 4); v += __shfl_xor(v, 8); v += __shfl_xor(v, 16);
        rs[reg] = rsqrtf(v * (1.f / 128.f) + EPS); }
      const float* ggl = launder(p.in[16]);
#pragma unroll
      for (int ni = 0; ni < 4; ++ni) { const float g = ggl[ni * 32 + r];
#pragma unroll
        for (int reg = 0; reg < 16; ++reg) { const int ro = ((reg & 3) + 8 * (reg >> 2)) * 520 + ni * 32; const float rv = bf2f(rgl[ro]);
          oil[ro] = f2bf(acc[ni][reg] * rs[reg] * g * silu_fast(rv)); } }
      __syncthreads();
#pragma unroll
      for (int i = 0; i < 8; ++i) { const int c = tid + 512 * i, row = c >> 6, cc = c & 63;
        *(uint4*)(MIXA + (size_t)row * 1024 + 512 + cc * 8) = *(const uint4*)(OIL + row * 1040 + cc * 16); }
    }
  }
}

DI void phase3c(const KP& p, char* lds, const int gather_reps, const int probe) {
  const int tid0 = threadIdx.x;
  const int r = tid0 & 31, hh = (tid0 >> 5) & 1, lane = tid0 & 63;
  char* wl = lds + LDS_WT + ((tid0 >> 6) & 3) * WT_BYTES;
  for (int tile = blockIdx.x; tile < 256; tile += gridDim.x) {
    unsigned char* ws = launder(p.ws); float* outp = launder(p.out); const float* xin = launder(p.in[0]);
    const int tok0 = tile * 64, b = tile >> 5;
    unsigned char* tsc = ws + WS_QM + (size_t)tile * P3_TILE_BYTES;
    bf16_t* QRY = (bf16_t*)tsc; bf16_t* Y = (bf16_t*)(ws + WS_QM) + (size_t)tok0 * 1024; bf16_t* MIXA = (bf16_t*)(ws + WS_P1S) + (size_t)tok0 * 1024; bf16_t* H2 = MIXA;
    const float* modb = launder((const float*)(ws + WS_MOD)) + b * 6144;
    __syncthreads();
    {
      const int tid = lv(tid0), lane = tid & 63, w = tid >> 6;
      float4 A1[4], A2[4], S2[4];
      const float* gpo = launder(p.in[6]); const float* gpf = launder(p.in[18]);
#pragma unroll
      for (int i = 0; i < 4; ++i) { const int d = (lane + 64 * i) * 4;
        const float4 gp = *(const float4*)(gpo + d), gt = *(const float4*)(modb + 2048 + d), g2 = *(const float4*)(gpf + d), sc = *(const float4*)(modb + 4096 + d);
        S2[i] = *(const float4*)(modb + 3072 + d);
        A1[i] = make_float4(gp.x * gt.x, gp.y * gt.y, gp.z * gt.z, gp.w * gt.w);
        A2[i] = make_float4(g2.x * (1.f + sc.x), g2.y * (1.f + sc.y), g2.z * (1.f + sc.z), g2.w * (1.f + sc.w)); }
#pragma unroll 2
      for (int rr = 0; rr < 8; ++rr) { const int row = w * 8 + rr; const size_t tok = tok0 + row;
        float4 yv[4]; float ss = 0.f;
#pragma unroll
        for (int i = 0; i < 4; ++i) { const uint2 u = *(const uint2*)(Y + (size_t)row * 1024 + (lane + 64 * i) * 4);
          yv[i] = make_float4(__uint_as_float(u.x << 16), __uint_as_float(u.x & 0xffff0000u), __uint_as_float(u.y << 16), __uint_as_float(u.y & 0xffff0000u));
          ss += yv[i].x * yv[i].x + yv[i].y * yv[i].y + yv[i].z * yv[i].z + yv[i].w * yv[i].w; }
        ss = wave_sum(ss); const float rs = rsqrtf(ss * (1.f / 1024.f) + EPS);
        float4 xv[4]; float s2 = 0.f;
#pragma unroll
        for (int i = 0; i < 4; ++i) { const float4 x = *(const float4*)(xin + tok * 1024 + (lane + 64 * i) * 4);
          xv[i] = make_float4(x.x + A1[i].x * yv[i].x * rs, x.y + A1[i].y * yv[i].y * rs, x.z + A1[i].z * yv[i].z * rs, x.w + A1[i].w * yv[i].w * rs);
          *(float4*)(outp + tok * 1024 + (lane + 64 * i) * 4) = xv[i];
          s2 += xv[i].x * xv[i].x + xv[i].y * xv[i].y + xv[i].z * xv[i].z + xv[i].w * xv[i].w; }
        s2 = wave_sum(s2); const float r2 = rsqrtf(s2 * (1.f / 1024.f) + EPS);
#pragma unroll
        for (int i = 0; i < 4; ++i) { uint2 o; o.x = pack2(xv[i].x * r2 * A2[i].x + S2[i].x, xv[i].y * r2 * A2[i].y + S2[i].y); o.y = pack2(xv[i].z * r2 * A2[i].z + S2[i].z, xv[i].w * r2 * A2[i].w + S2[i].w);
          *(uint2*)(H2 + (size_t)row * 1024 + (lane + 64 * i) * 4) = o; }
      }
    }
  }
}

DI void phase3b(const KP& p, char* lds, const int gather_reps, const int probe) {
  const int tid0 = threadIdx.x;
  const int r = tid0 & 31, hh = (tid0 >> 5) & 1, lane = tid0 & 63;
  char* wl = lds + LDS_WT + ((tid0 >> 6) & 3) * WT_BYTES;
  for (int tile = blockIdx.x; tile < 256; tile += gridDim.x) {
    unsigned char* ws = launder(p.ws); float* outp = launder(p.out); const float* xin = launder(p.in[0]);
    const int tok0 = tile * 64, b = tile >> 5;
    unsigned char* tsc = ws + WS_QM + (size_t)tile * P3_TILE_BYTES;
    bf16_t* QRY = (bf16_t*)tsc; bf16_t* Y = (bf16_t*)tsc; bf16_t* MIXA = (bf16_t*)(ws + WS_P1S) + (size_t)tok0 * 1024; bf16_t* H2 = MIXA;
    const float* modb = launder((const float*)(ws + WS_MOD)) + b * 6144;
    __syncthreads();
    float* SC = (float*)lds; unsigned* TK = (unsigned*)(lds + LDS_TK);
    {
      constexpr int SC2W = 132, SC2H = 64 * SC2W;
      const int tid = lv(tid0), ln = tid & 63, wv = tid >> 6, r2 = ln & 31, h2 = ln >> 5;
      const int mi = wv & 1, ni = wv >> 1;
      const bf16_t* kd = launder((const bf16_t*)(ws + WS_KD));
      bf16x8 fb[8], fa0[8], fa1[8];
#define LD_FB(side_) do { _Pragma("unroll") for (int j = 0; j < 8; ++j) { const int kg = (side_) * 128 + 16 * j + 8 * h2, n = (side_) * 128 + 32 * ni + r2;     \
          fb[j] = *(const bf16x8*)(kd + (size_t)(kg >> 6) * 16384 + n * 64 + (kg & 63)); } } while (0)
#define LD_FA(rd_) do { const bf16_t* qp = QRY + (size_t)(32 * mi + r2) * 2048 + (2 * ((rd_) & 3)) * 256 + ((rd_) >> 2) * 128 + 8 * h2; \
          _Pragma("unroll") for (int j = 0; j < 8; ++j) { fa0[j] = *(const bf16x8*)(qp + 16 * j); fa1[j] = *(const bf16x8*)(qp + 256 + 16 * j); } } while (0)
      LD_FB(0); LD_FA(0);
#pragma unroll 1
      for (int rd = 0; rd < 8; ++rd) {
        const int side = rd >> 2, hp = rd & 3;
        {
          {
            f32x16 acc0, acc1;
#pragma unroll
            for (int i = 0; i < 16; ++i) { acc0[i] = 0.f; acc1[i] = 0.f; }
#pragma unroll
            for (int j = 0; j < 8; ++j) { acc0 = MFMA32(fa0[j], fb[j], acc0); acc1 = MFMA32(fa1[j], fb[j], acc1); }
            if (rd == 3) LD_FB(1);
            if (rd < 7) LD_FA(rd + 1);
            float* sp = SC + (32 * mi + 4 * h2) * SC2W + 32 * ni + r2;
#pragma unroll
            for (int reg = 0; reg < 16; ++reg) { sp[((reg & 3) + 8 * (reg >> 2)) * SC2W] = acc0[reg]; sp[SC2H + ((reg & 3) + 8 * (reg >> 2)) * SC2W] = acc1[reg]; }
          }
          __syncthreads();
          {
            const int tt = tid >> 3, hs = (tid >> 2) & 1, q = tid & 3;
            const float* sr = SC + hs * SC2H + tt * SC2W + q * 32;
            float a[16], c[16];
#pragma unroll
            for (int i = 0; i < 4; ++i) { const float4 v = *(const float4*)(sr + i * 4); const unsigned ib = q * 32 + i * 4;
              a[i * 4 + 0] = __uint_as_float((__float_as_uint(v.x) & 0xFFFFFF80u) | (ib + 0)); a[i * 4 + 1] = __uint_as_float((__float_as_uint(v.y) & 0xFFFFFF80u) | (ib + 1));
              a[i * 4 + 2] = __uint_as_float((__float_as_uint(v.z) & 0xFFFFFF80u) | (ib + 2)); a[i * 4 + 3] = __uint_as_float((__float_as_uint(v.w) & 0xFFFFFF80u) | (ib + 3)); }
#pragma unroll
            for (int i = 0; i < 4; ++i) { const float4 v = *(const float4*)(sr + 16 + i * 4); const unsigned ib = q * 32 + 16 + i * 4;
              c[i * 4 + 0] = __uint_as_float((__float_as_uint(v.x) & 0xFFFFFF80u) | (ib + 0)); c[i * 4 + 1] = __uint_as_float((__float_as_uint(v.y) & 0xFFFFFF80u) | (ib + 1));
              c[i * 4 + 2] = __uint_as_float((__float_as_uint(v.z) & 0xFFFFFF80u) | (ib + 2)); c[i * 4 + 3] = __uint_as_float((__float_as_uint(v.w) & 0xFFFFFF80u) | (ib + 3)); }
            sort16_desc(a); sort16_desc(c); top16_merge(a, c);
#pragma unroll
            for (int i = 0; i < 16; ++i) c[i] = dpp_f<0xB1>(a[i]);
            top16_merge(a, c);
#pragma unroll
            for (int i = 0; i < 16; ++i) c[i] = dpp_f<0x4E>(a[i]);
            top16_merge(a, c);
            if (q == 0) { unsigned* tk = TK + ((tt * 8 + 2 * hp + hs) * 2 + side) * 16;
#pragma unroll
              for (int i = 0; i < 4; ++i) *(uint4*)(tk + i * 4) = make_uint4(__float_as_uint(a[i * 4]), __float_as_uint(a[i * 4 + 1]), __float_as_uint(a[i * 4 + 2]), __float_as_uint(a[i * 4 + 3])); }
          }
          __syncthreads();
        }
      }
#undef LD_FB
#undef LD_FA
    }
    {
      const int tid = lv(tid0);
      const int tt = tid >> 3, h = tid & 7;
      const unsigned* t1 = TK + ((tt * 8 + h) * 2) * 16; const unsigned* t2 = t1 + 16;
      float v1[16], v2[16];
#pragma unroll
      for (int i = 0; i < 4; ++i) { const uint4 u = *(const uint4*)(t1 + i * 4), v = *(const uint4*)(t2 + i * 4);
        v1[i * 4] = __uint_as_float(u.x & 0xFFFFFF80u); v1[i * 4 + 1] = __uint_as_float(u.y & 0xFFFFFF80u); v1[i * 4 + 2] = __uint_as_float(u.z & 0xFFFFFF80u); v1[i * 4 + 3] = __uint_as_float(u.w & 0xFFFFFF80u);
        v2[i * 4] = __uint_as_float(v.x & 0xFFFFFF80u); v2[i * 4 + 1] = __uint_as_float(v.y & 0xFFFFFF80u); v2[i * 4 + 2] = __uint_as_float(v.z & 0xFFFFFF80u); v2[i * 4 + 3] = __uint_as_float(v.w & 0xFFFFFF80u); }
      float best[16], grp[16];
#define CAND(i, j) __uint_as_float((__float_as_uint(v1[i] + v2[j]) & 0xFFFFFF00u) | ((i) << 4) | (j))
      best[0] = CAND(0, 0); best[1] = CAND(0, 1); best[2] = CAND(0, 2); best[3] = CAND(0, 3); best[4] = CAND(0, 4); best[5] = CAND(0, 5); best[6] = CAND(0, 6); best[7] = CAND(0, 7);
      best[8] = CAND(0, 8); best[9] = CAND(0, 9); best[10] = CAND(0, 10); best[11] = CAND(0, 11); best[12] = CAND(0, 12); best[13] = CAND(0, 13); best[14] = CAND(0, 14); best[15] = CAND(0, 15);
      sort16_desc(best);
      grp[0] = CAND(1, 0); grp[1] = CAND(1, 1); grp[2] = CAND(1, 2); grp[3] = CAND(1, 3); grp[4] = CAND(1, 4); grp[5] = CAND(1, 5); grp[6] = CAND(1, 6); grp[7] = CAND(1, 7);
      grp[8] = CAND(2, 0); grp[9] = CAND(2, 1); grp[10] = CAND(2, 2); grp[11] = CAND(2, 3); grp[12] = CAND(2, 4); grp[13] = CAND(3, 0); grp[14] = CAND(3, 1); grp[15] = CAND(3, 2);
      sort16_desc(grp); top16_merge(best, grp);
      grp[0] = CAND(3, 3); grp[1] = CAND(4, 0); grp[2] = CAND(4, 1); grp[3] = CAND(4, 2); grp[4] = CAND(5, 0); grp[5] = CAND(5, 1); grp[6] = CAND(6, 0); grp[7] = CAND(6, 1);
      grp[8] = CAND(7, 0); grp[9] = CAND(7, 1); grp[10] = CAND(8, 0); grp[11] = CAND(9, 0); grp[12] = CAND(10, 0); grp[13] = CAND(11, 0); grp[14] = CAND(12, 0); grp[15] = CAND(13, 0);
      sort16_desc(grp); top16_merge(best, grp);
      { const float c14 = CAND(14, 0), c15 = CAND(15, 0);
        grp[0] = fmaxf(c14, c15); grp[1] = fminf(c14, c15);
#pragma unroll
        for (int i = 2; i < 16; ++i) grp[i] = -3.0e38f;
        top16_merge(best, grp); }
#undef CAND
      __syncthreads();
      float sv[16]; int ev[16]; float mx = -3.0e38f;
#pragma unroll
      for (int k = 0; k < 16; ++k) { const unsigned key = __float_as_uint(best[k]); const int ci = (key >> 4) & 15, cj = key & 15;
        const unsigned k1 = t1[ci], k2 = t2[cj];
        sv[k] = __uint_as_float(k1 & 0xFFFFFF80u) + __uint_as_float(k2 & 0xFFFFFF80u); ev[k] = (int)((k1 & 127u) * 128u + (k2 & 127u)); mx = fmaxf(mx, sv[k]); }
      float sum = 0.f;
#pragma unroll
      for (int k = 0; k < 16; ++k) { sv[k] = __expf(sv[k] - mx); sum += sv[k]; }
      const float inv = 1.f / sum;
      unsigned* CNT = (unsigned*)(lds + LDS_CNT); unsigned short* OFFS = (unsigned short*)(lds + LDS_OFF); unsigned* EL = (unsigned*)lds; unsigned short* SE = (unsigned short*)(lds + LDS_SE);
      float scu[16], scv[16];
      { const float* SCU = (const float*)(ws + WS_ESC);
#pragma unroll
        for (int k = 0; k < 16; ++k) { scu[k] = SCU[ev[k]]; scv[k] = SCU[16384 + ev[k]]; } }
      CNT[tid] = 0u; if (GP_N > 8) CNT[tid + 512] = 0u;
      __syncthreads();
      int pos[16];
#pragma unroll
      for (int k = 0; k < 16; ++k) pos[k] = (int)atomicAdd(&CNT[tt * GP_N + (ev[k] >> GP_SH)], 1u);
      __syncthreads();
      if (h == 0) { unsigned run = 0;
#pragma unroll
        for (int q = 0; q < GP_N; ++q) { OFFS[tt * GP_OS + q] = (unsigned short)run; run += CNT[tt * GP_N + q]; }
        OFFS[tt * GP_OS + GP_N] = (unsigned short)run; }
      __syncthreads();
#pragma unroll
      for (int k = 0; k < 16; ++k) { const int d = (int)OFFS[tt * GP_OS + (ev[k] >> GP_SH)] + pos[k];
        EL[tt * 128 + d] = ((__float_as_uint(sv[k] * inv) + 0x2000u) & 0xFFFFC000u) | (unsigned)ev[k];
        SE[tt * 128 + d] = (unsigned short)((((__float_as_uint(scu[k]) >> 23) & 255u) << 8) | ((__float_as_uint(scv[k]) >> 23) & 255u)); }
    }
    __syncthreads();
    {
      const int tid = lv(tid0), lane = tid & 63, w = tid >> 6;
      typedef int i32x4_t __attribute__((ext_vector_type(4)));
      i32x4_t EU, EV;
      { const unsigned long long bu = (unsigned long long)(ws + WS_EU), bv = (unsigned long long)(ws + WS_EV);
        EU[0] = __builtin_amdgcn_readfirstlane((int)(unsigned)bu); EU[1] = __builtin_amdgcn_readfirstlane((int)((bu >> 32) & 0xFFFFu)); EU[2] = 0x01000000; EU[3] = 0x00020000;
        EV[0] = __builtin_amdgcn_readfirstlane((int)(unsigned)bv); EV[1] = __builtin_amdgcn_readfirstlane((int)((bv >> 32) & 0xFFFFu)); EV[2] = 0x01000000; EV[3] = 0x00020000; }
      unsigned* EL = (unsigned*)lds; const unsigned short* OFFS = (const unsigned short*)(lds + LDS_OFF); unsigned* LIST = (unsigned*)(lds + LDS_LIST) + w * 256; char* H2W = lds + LDS_H2L + w * 8192;
      const unsigned short* SE = (const unsigned short*)(lds + LDS_SE);
      const float* gpf2 = launder(p.in[19]);
      const int rot = (int)(__builtin_amdgcn_s_getreg((3 << 11) | 20) & 0xFu) * (GP_N / 8);
      const unsigned voff = (unsigned)lane * 16u;
      const int sl = lane & 7;
      typedef float f2v __attribute__((ext_vector_type(2))); typedef unsigned u32x4_t __attribute__((ext_vector_type(4)));
#define CVLO(wd) __builtin_amdgcn_cvt_pk_f32_fp8((int)(wd), false)
#define CVHI(wd) __builtin_amdgcn_cvt_pk_f32_fp8((int)(wd), true)
#define BF2(wd) ((f2v){__uint_as_float((wd) << 16), __uint_as_float((wd) & 0xffff0000u)})
#define DPPF(x, CTRL) __int_as_float(__builtin_amdgcn_update_dpp(0, __float_as_int(x), CTRL, 0xF, 0xF, true))
#define R_INIT(R, TAG) do { _Pragma("unroll") for (int k2 = 0; k2 < 8; ++k2) asm volatile("; init " TAG : "=v"(R[k2])); } while (0)
#define EIDX(D) ((row0 + ((D) >> 11)) * 128 + (((D) >> 4) & 127) + (sl < ((D) & 15) ? sl : 0))
#define G_FETCH(DX, PKX, R, TAB, TAG) do { DX = Dn; PKX = PKn; { const int es_ = (int)(PKX & 16383u); unsigned so_[8]; \
        _Pragma("unroll") for (int k2 = 0; k2 < 8; ++k2) so_[k2] = (unsigned)__builtin_amdgcn_readlane(es_, k2) << 10;     \
        asm volatile("buffer_load_dwordx4 %0, %8, %9, %10 offen ; " TAG "\n\tbuffer_load_dwordx4 %1, %8, %9, %11 offen\n\tbuffer_load_dwordx4 %2, %8, %9, %12 offen\n\tbuffer_load_dwordx4 %3, %8, %9, %13 offen\n\t" \
                     "buffer_load_dwordx4 %4, %8, %9, %14 offen\n\tbuffer_load_dwordx4 %5, %8, %9, %15 offen\n\tbuffer_load_dwordx4 %6, %8, %9, %16 offen\n\tbuffer_load_dwordx4 %7, %8, %9, %17 offen" \
                     : "+v"(R[0]), "+v"(R[1]), "+v"(R[2]), "+v"(R[3]), "+v"(R[4]), "+v"(R[5]), "+v"(R[6]), "+v"(R[7])     \
                     : "v"(voff), "s"(TAB), "s"(so_[0]), "s"(so_[1]), "s"(so_[2]), "s"(so_[3]), "s"(so_[4]), "s"(so_[5]), "s"(so_[6]), "s"(so_[7])); } \
        Dn = __builtin_amdgcn_readfirstlane((int)tmpL); PKn = EL[EIDX(Dn)]; tmpL = LIST[sidx]; ++sidx; } while (0)
#define G_WAITK(R, k2) asm volatile("s_waitcnt vmcnt(%1)" : "+v"(R[k2]) : "n"(15 - (k2)))
#define G_DRAIN(RA_, RB_) do { asm volatile("s_waitcnt vmcnt(0)" : "+v"(RA_[0]), "+v"(RA_[1]), "+v"(RA_[2]), "+v"(RA_[3]), "+v"(RA_[4]), "+v"(RA_[5]), "+v"(RA_[6]), "+v"(RA_[7])); \
        asm volatile("" : "+v"(RB_[0]), "+v"(RB_[1]), "+v"(RB_[2]), "+v"(RB_[3]), "+v"(RB_[4]), "+v"(RB_[5]), "+v"(RB_[6]), "+v"(RB_[7])); } while (0)
#define U_DOT(R, k2) do { G_WAITK(R, k2); int d_ = __builtin_amdgcn_sdot4((int)R[k2][0], (int)hq.x, 0, false); d_ = __builtin_amdgcn_sdot4((int)R[k2][1], (int)hq.y, d_, false); \
            d_ = __builtin_amdgcn_sdot4((int)R[k2][2], (int)hq.z, d_, false); d_ = __builtin_amdgcn_sdot4((int)R[k2][3], (int)hq.w, d_, false); P[k2] = (float)d_; } while (0)
#define U_COMPUTE(D, R, SI) do { if ((D) != 0) { const int n_ = (D) & 15, rr_ = (D) >> 11; \
        if (rr_ != cur) { cur = rr_; hq = *(const uint4*)(H2W + rr_ * 1024 + lane * 16); } \
        float P[8]; \
        _Pragma("unroll") for (int k2 = 0; k2 < 8; ++k2) P[k2] = 0.f; \
          \
        U_DOT(R, 0); if (n_ > 1) { U_DOT(R, 1); if (n_ > 2) { U_DOT(R, 2); if (n_ > 3) { U_DOT(R, 3); if (n_ > 4) { U_DOT(R, 4); if (n_ > 5) { U_DOT(R, 5); if (n_ > 6) { U_DOT(R, 6); if (n_ > 7) { U_DOT(R, 7); } } } } } } } \
          \
        _Pragma("unroll") for (int e = 0; e < 4; ++e) { const float a_ = P[e] + DPPF(P[e], 0x141), b_ = P[e + 4] + DPPF(P[e + 4], 0x141); P[e] = (lane & 4) ? b_ : a_; } \
        _Pragma("unroll") for (int e = 0; e < 2; ++e) { const float a_ = P[e] + DPPF(P[e], 0x4E), b_ = P[e + 2] + DPPF(P[e + 2], 0x4E); P[e] = (lane & 2) ? b_ : a_; } \
        float av; { const float a_ = P[0] + DPPF(P[0], 0xB1), b_ = P[1] + DPPF(P[1], 0xB1); av = (lane & 1) ? b_ : a_; } \
        av += DPPF(av, 0x128); \
        { const auto s16 = __builtin_amdgcn_permlane16_swap(__float_as_uint(av), __float_as_uint(av), false, false); av = __uint_as_float(s16[0]) + __uint_as_float(s16[1]); } \
        { const auto s32 = __builtin_amdgcn_permlane32_swap(__float_as_uint(av), __float_as_uint(av), false, false); av = __uint_as_float(s32[0]) + __uint_as_float(s32[1]); } \
        if (lane < 8) AVB[((SI) & 7) * 8 + lane] = av;              } } while (0)
#define U_FLUSH(s0_, cnt_) do { const int j_ = lane >> 3; const unsigned D_ = (j_ < (cnt_)) ? LIST[(s0_) + j_] : 0u; const int n_ = (int)(D_ & 15u), rr_ = (int)(D_ >> 11); \
        if (sl < n_) { const int ei_ = (row0 + rr_) * 128 + (int)((D_ >> 4) & 127u) + sl; const unsigned pk_ = EL[ei_]; const unsigned se_ = (unsigned)SE[ei_]; \
          const float av = AVB[j_ * 8 + sl] * (__uint_as_float((se_ >> 8) << 23) * ((const float*)(H2W + 4096))[rr_]);              \
            \
          const float ax = fabsf(av), t = __builtin_amdgcn_rcpf(ax * 0.2316418882f + 1.0f); \
          float q = t * 0.5307027145f + (-0.7265760135f); q = q * t + 0.7107068705f; q = q * t + (-0.142248368f); q = q * t + 0.127414796f; q = q * t; \
          const float ee = __builtin_amdgcn_exp2f(av * av * (-0.72134752044f)); \
          const float mm = av * (q * ee), gl = (av < 0.f) ? mm : (av - mm); \
          const float wv = __uint_as_float(pk_ & 0xFFFFC000u) * gl * __uint_as_float((se_ & 255u) << 23); \
          EL[ei_] = ((__float_as_uint(wv) + 0x2000u) & 0xFFFFC000u) | (pk_ & 16383u); } } while (0)
#define Y_PARK() do { uint4 y0, y1; y0.x = pack2(acc[0].x, acc[0].y); y0.y = pack2(acc[1].x, acc[1].y); y0.z = pack2(acc[2].x, acc[2].y); y0.w = pack2(acc[3].x, acc[3].y); \
        y1.x = pack2(acc[4].x, acc[4].y); y1.y = pack2(acc[5].x, acc[5].y); y1.z = pack2(acc[6].x, acc[6].y); y1.w = pack2(acc[7].x, acc[7].y); \
        *(uint4*)(H2W + cur * 2048 + lane * 32) = y0; *(uint4*)(H2W + cur * 2048 + lane * 32 + 16) = y1; } while (0)
#define V_ACC(R, k2) do { const float wk = __int_as_float(__builtin_amdgcn_readlane(__float_as_int(wv_), k2)); const f2v wk2 = {wk, wk}; \
          G_WAITK(R, k2); \
          acc[0] += CVLO(R[k2][0]) * wk2; acc[1] += CVHI(R[k2][0]) * wk2; acc[2] += CVLO(R[k2][1]) * wk2; acc[3] += CVHI(R[k2][1]) * wk2; \
          acc[4] += CVLO(R[k2][2]) * wk2; acc[5] += CVHI(R[k2][2]) * wk2; acc[6] += CVLO(R[k2][3]) * wk2; acc[7] += CVHI(R[k2][3]) * wk2; } while (0)
#define V_COMPUTE(D, PK, R) do { if ((D) != 0) { const int n_ = (D) & 15, rr_ = (D) >> 11; \
        if (rr_ != cur) { if (cur >= 0) Y_PARK(); cur = rr_; \
          const uint4 hA = *(const uint4*)(H2W + rr_ * 2048 + lane * 32), hB = *(const uint4*)(H2W + rr_ * 2048 + lane * 32 + 16); \
          acc[0] = BF2(hA.x); acc[1] = BF2(hA.y); acc[2] = BF2(hA.z); acc[3] = BF2(hA.w); acc[4] = BF2(hB.x); acc[5] = BF2(hB.y); acc[6] = BF2(hB.z); acc[7] = BF2(hB.w); } \
        const float wv_ = (sl < n_) ? __uint_as_float(PK & 0xFFFFC000u) : 0.f; \
        V_ACC(R, 0); if (n_ > 1) { V_ACC(R, 1); if (n_ > 2) { V_ACC(R, 2); if (n_ > 3) { V_ACC(R, 3); if (n_ > 4) { V_ACC(R, 4); if (n_ > 5) { V_ACC(R, 5); if (n_ > 6) { V_ACC(R, 6); if (n_ > 7) { V_ACC(R, 7); } } } } } } } } } while (0)
#define G_PROLOGUE() do { Dn = __builtin_amdgcn_readfirstlane((int)LIST[0]); PKn = EL[EIDX(Dn)]; tmpL = LIST[1]; sidx = 2; } while (0)
#pragma unroll 1
      for (int half = 0; half < 2; ++half) {
        const int row0 = half * 32 + w * 4;
        __builtin_amdgcn_wave_barrier(); asm volatile("" ::: "memory");
        {
          uint4 ta[4], tb[4];
#pragma unroll
          for (int rr = 0; rr < 4; ++rr) { const uint4* src = (const uint4*)(H2 + (size_t)(row0 + rr) * 1024 + lane * 16); ta[rr] = src[0]; tb[rr] = src[1]; }
#pragma unroll
          for (int rr = 0; rr < 4; ++rr) { float f[16];
            f[0] = __uint_as_float(ta[rr].x << 16); f[1] = __uint_as_float(ta[rr].x & 0xffff0000u); f[2] = __uint_as_float(ta[rr].y << 16); f[3] = __uint_as_float(ta[rr].y & 0xffff0000u);
            f[4] = __uint_as_float(ta[rr].z << 16); f[5] = __uint_as_float(ta[rr].z & 0xffff0000u); f[6] = __uint_as_float(ta[rr].w << 16); f[7] = __uint_as_float(ta[rr].w & 0xffff0000u);
            f[8] = __uint_as_float(tb[rr].x << 16); f[9] = __uint_as_float(tb[rr].x & 0xffff0000u); f[10] = __uint_as_float(tb[rr].y << 16); f[11] = __uint_as_float(tb[rr].y & 0xffff0000u);
            f[12] = __uint_as_float(tb[rr].z << 16); f[13] = __uint_as_float(tb[rr].z & 0xffff0000u); f[14] = __uint_as_float(tb[rr].w << 16); f[15] = __uint_as_float(tb[rr].w & 0xffff0000u);
            float am = 0.f;
#pragma unroll
            for (int i = 0; i < 16; ++i) am = fmaxf(am, fabsf(f[i]));
            am = wave_max(am);
            const float hs = (am > 0.f) ? am * (1.f / 127.f) : 1.f, ihs = 1.f / hs;
            unsigned qd[4];
#pragma unroll
            for (int i = 0; i < 4; ++i) { const int q0 = (int)rintf(f[4 * i] * ihs), q1 = (int)rintf(f[4 * i + 1] * ihs), q2 = (int)rintf(f[4 * i + 2] * ihs), q3 = (int)rintf(f[4 * i + 3] * ihs);
              qd[i] = (unsigned)(q0 & 255) | ((unsigned)(q1 & 255) << 8) | ((unsigned)(q2 & 255) << 16) | ((unsigned)(q3 & 255) << 24); }
            *(uint4*)(H2W + rr * 1024 + lane * 16) = make_uint4(qd[0], qd[1], qd[2], qd[3]);
            if (lane == 0) ((float*)(H2W + 4096))[rr] = hs; } }
        int ns;
        {
          const int rr = lane & 3, part = ((lane >> 2) + rot) & (GP_N - 1);
          int o0 = 0, o1 = 0;
          if (lane < 4 * GP_N) { o0 = (int)OFFS[(row0 + rr) * GP_OS + part]; o1 = (int)OFFS[(row0 + rr) * GP_OS + part + 1]; }
          const int nst = (o1 - o0 + 7) >> 3;
          int incl = nst;
#pragma unroll
          for (int d = 1; d < 64; d <<= 1) { const int t = __shfl_up(incl, d); if (lane >= d) incl += t; }
          const int off = incl - nst;
          for (int j = 0; j < nst; ++j) { const int base = o0 + 8 * j; const int nn = (o1 - base < 8) ? (o1 - base) : 8; LIST[off + j] = (unsigned)(nn | (base << 4) | (rr << 11)); }
          ns = __builtin_amdgcn_readlane(incl, 63);
          if (lane < 8) LIST[ns + lane] = 0u; }
        __builtin_amdgcn_wave_barrier(); asm volatile("s_waitcnt vmcnt(0)" ::: "memory");
        {
          int DA, DB, Dn, sidx, cur = -1; unsigned PKA, PKB, PKn, tmpL; u32x4_t RA[8], RB[8]; uint4 hq = make_uint4(0u, 0u, 0u, 0u);
          float* AVB = (float*)(H2W + 4352); int flushed = 0;
          R_INIT(RA, "uA"); R_INIT(RB, "uB");
          G_PROLOGUE(); G_FETCH(DA, PKA, RA, EU, "uA0");
#pragma unroll 1
          for (int s = 0; s < ns; s += 2) {
            G_FETCH(DB, PKB, RB, EU, "uB"); U_COMPUTE(DA, RA, s);
            G_FETCH(DA, PKA, RA, EU, "uA"); U_COMPUTE(DB, RB, s + 1);
            if ((s & 7) == 6) { U_FLUSH(s - 6, 8); flushed = s + 2; }
          }
          G_DRAIN(RA, RB);
          if (flushed < ns) U_FLUSH(flushed, ns - flushed);
          (void)PKA; (void)PKB;
        }
        __builtin_amdgcn_wave_barrier(); asm volatile("s_waitcnt vmcnt(0)" ::: "memory");
        { const uint4 z4 = make_uint4(0u, 0u, 0u, 0u);
#pragma unroll
          for (int i = 0; i < 8; ++i) ((uint4*)H2W)[lane + 64 * i] = z4; }
        __builtin_amdgcn_wave_barrier(); asm volatile("" ::: "memory");
        {
          int DA, DB, Dn, sidx, cur = -1; unsigned PKA, PKB, PKn, tmpL; u32x4_t RA[8], RB[8]; f2v acc[8];
          R_INIT(RA, "vA"); R_INIT(RB, "vB");
          G_PROLOGUE(); G_FETCH(DA, PKA, RA, EV, "vA0");
#pragma unroll 1
          for (int s = 0; s < ns; s += 2) {
            G_FETCH(DB, PKB, RB, EV, "vB"); V_COMPUTE(DA, PKA, RA);
            G_FETCH(DA, PKA, RA, EV, "vA"); V_COMPUTE(DB, PKB, RB);
          }
          G_DRAIN(RA, RB);
          if (cur >= 0) Y_PARK();
        }
        __builtin_amdgcn_wave_barrier(); asm volatile("s_waitcnt vmcnt(0)" ::: "memory");
#pragma unroll 1
        for (int rr = 0; rr < 4; ++rr) { const size_t tok = tok0 + row0 + rr;
          const uint4 hA = *(const uint4*)(H2W + rr * 2048 + lane * 32), hB = *(const uint4*)(H2W + rr * 2048 + lane * 32 + 16);
          f2v a[8]; a[0] = BF2(hA.x); a[1] = BF2(hA.y); a[2] = BF2(hA.z); a[3] = BF2(hA.w); a[4] = BF2(hB.x); a[5] = BF2(hB.y); a[6] = BF2(hB.z); a[7] = BF2(hB.w);
          float ss = 0.f;
#pragma unroll
          for (int i = 0; i < 8; ++i) ss += a[i].x * a[i].x + a[i].y * a[i].y;
          ss = wave_sum(ss); const float rs = rsqrtf(ss * (1.f / 1024.f) + EPS);
          float* orow = outp + tok * 1024 + lane * 16;
#pragma unroll
          for (int i = 0; i < 4; ++i) { const int d = lane * 16 + 4 * i;
            float4 x1 = *(const float4*)(orow + 4 * i); const float4 g3 = *(const float4*)(gpf2 + d), g2 = *(const float4*)(modb + 5120 + d);
            x1.x += g3.x * g2.x * a[2 * i].x * rs; x1.y += g3.y * g2.y * a[2 * i].y * rs; x1.z += g3.z * g2.z * a[2 * i + 1].x * rs; x1.w += g3.w * g2.w * a[2 * i + 1].y * rs;
            *(float4*)(orow + 4 * i) = x1; }
        }
      }
#undef CVLO
#undef CVHI
#undef BF2
#undef DPPF
#undef R_INIT
#undef EIDX
#undef G_FETCH
#undef G_WAITK
#undef G_DRAIN
#undef U_COMPUTE
#undef U_FLUSH
#undef U_DOT
#undef V_ACC
#undef Y_PARK
#undef V_COMPUTE
#undef G_PROLOGUE
    }
  }
}

DI void phase2_scan(const KP& p) {
  unsigned char* ws = p.ws;
  for (int g = blockIdx.x * NTHR + threadIdx.x; g < 131072; g += gridDim.x * NTHR) {
    const int seq = g >> 11, within = g & 2047, dv = within >> 4, dk4 = (within & 15) * 4, dir = seq & 1;
    bf16_t* base = (bf16_t*)(ws + WS_SPT) + ((size_t)seq * 32 * 128 + dv) * 64 + dk4;
    const float* dec = (const float*)(ws + WS_DEC) + (size_t)seq * 32 * 64 + dk4;
    float s0 = 0.f, s1 = 0.f, s2 = 0.f, s3 = 0.f;
    uint2 d[32]; float4 c[8], cn[8];
#pragma unroll
    for (int j = 0; j < 32; ++j) { const int n = dir ? 31 - j : j; d[j] = *(const uint2*)(base + (size_t)n * 8192); }
#pragma unroll
    for (int j = 0; j < 8; ++j) { const int n = dir ? 31 - j : j; c[j] = *(const float4*)(dec + n * 64); }
#pragma unroll
    for (int i0 = 0; i0 < 32; i0 += 8) {
      if (i0 + 8 < 32) {
#pragma unroll
        for (int j = 0; j < 8; ++j) { const int n = dir ? 31 - (i0 + 8 + j) : (i0 + 8 + j); cn[j] = *(const float4*)(dec + n * 64); } }
#pragma unroll
      for (int j = 0; j < 8; ++j) { const int n = dir ? 31 - (i0 + j) : (i0 + j);
        uint2 o; o.x = pack2(s0, s1); o.y = pack2(s2, s3); *(uint2*)(base + (size_t)n * 8192) = o;
        s0 = c[j].x * s0 + __uint_as_float(d[i0 + j].x << 16); s1 = c[j].y * s1 + __uint_as_float(d[i0 + j].x & 0xffff0000u);
        s2 = c[j].z * s2 + __uint_as_float(d[i0 + j].y << 16); s3 = c[j].w * s3 + __uint_as_float(d[i0 + j].y & 0xffff0000u); }
#pragma unroll
      for (int j = 0; j < 8; ++j) c[j] = cn[j];
    }
  }
}

#define XB_MODCNT   64
#define XB_TMO      128
#define XB_XCNT(j)  (256  + 64 * (j))
#define XB_XSUB(j)  (1280 + 64 * (j))
#define XB_XGEN(j)  (2304 + 64 * (j))
#define XB_TOP      3328
#define XB_TOPGEN   3392
#define XCD_BAR_WORDS 3456
#define XB_SPIN_CAP (1u << 18)
#define LAS __attribute__((address_space(3)))

__device__ __forceinline__ unsigned xb_ld(unsigned* p)              { return __hip_atomic_load(p, __ATOMIC_RELAXED, __HIP_MEMORY_SCOPE_AGENT); }
__device__ __forceinline__ unsigned xb_add(unsigned* p, unsigned v) { return __hip_atomic_fetch_add(p, v, __ATOMIC_RELAXED, __HIP_MEMORY_SCOPE_AGENT); }
__device__ __forceinline__ unsigned xb_xcc_id() { return (unsigned)__builtin_amdgcn_s_getreg((3 << 11) | 20) & 0xFu; }
#define XB_SPIN(cond, bar) do { unsigned _sp = 0; while (cond) { __builtin_amdgcn_s_sleep(1); \
    if ((++_sp & 255u) == 0u) { if (xb_ld(&(bar)[XB_TMO])) break; if (_sp > XB_SPIN_CAP) { atomicAdd(&(bar)[XB_TMO], 1u); break; } } } } while (0)

struct XcdBarrier {
    unsigned* bar; unsigned x;
    volatile LAS unsigned* st;
};

__device__ __forceinline__ XcdBarrier xcd_barrier_post(unsigned* bar, volatile LAS unsigned* st) {
    XcdBarrier b; b.bar = bar; b.x = xb_xcc_id(); b.st = st;
    if (threadIdx.x == 0) (void)xb_add(&bar[XB_XCNT(b.x)], 1u);
    return b;
}
__device__ __forceinline__ void xcd_barrier_complete(unsigned* bar, unsigned x, unsigned& nloc, unsigned& nx) {
    const unsigned G = gridDim.x * gridDim.y * gridDim.z;
    unsigned sum, cnt, mine, sp = 0u;
    for (;;) {
        sum = 0u; cnt = 0u; mine = 0u;
#pragma unroll
        for (unsigned j = 0; j < 16; ++j) { const unsigned c = xb_ld(&bar[XB_XCNT(j)]); sum += c; cnt += (c > 0u) ? 1u : 0u; mine = (j == x) ? c : mine; }
        if (sum == G) break;
        __builtin_amdgcn_s_sleep(1);
        if ((++sp & 255u) == 0u) { if (xb_ld(&bar[XB_TMO])) break; if (sp > XB_SPIN_CAP) { atomicAdd(&bar[XB_TMO], 1u); break; } }
    }
    nloc = mine > 0u ? mine : 1u; nx = cnt > 0u ? cnt : 1u;
}

__device__ __forceinline__ void xcd_barrier(const XcdBarrier& b) {
    asm volatile("s_waitcnt vmcnt(0)" ::: "memory");
    __syncthreads();
    if (threadIdx.x == 0) {
        unsigned* bar = b.bar;
        __builtin_amdgcn_s_waitcnt(0);
        unsigned nloc = b.st[0], nx = b.st[1];
        if (nloc == 0u) { xcd_barrier_complete(bar, b.x, nloc, nx); b.st[0] = nloc; b.st[1] = nx; }
        const unsigned old = xb_add(&bar[XB_XSUB(b.x)], 1u);
        const unsigned gen = old / nloc;
        if (old + 1u == (gen + 1u) * nloc) {
            __builtin_amdgcn_fence(__ATOMIC_RELEASE, "agent");
            asm volatile("s_waitcnt vmcnt(0)" ::: "memory");
            const unsigned og = xb_add(&bar[XB_TOP], 1u);
            const unsigned tg = og / nx;
            if (og + 1u == (tg + 1u) * nx) xb_add(&bar[XB_TOPGEN], 1u);
            else XB_SPIN(xb_ld(&bar[XB_TOPGEN]) == tg, bar);
            __builtin_amdgcn_fence(__ATOMIC_ACQUIRE, "agent");
            xb_add(&bar[XB_XGEN(b.x)], 1u);
            asm volatile("s_waitcnt vmcnt(0)" ::: "memory");
        } else {
            XB_SPIN(xb_ld(&bar[XB_XGEN(b.x)]) == gen, bar);
            __builtin_amdgcn_fence(__ATOMIC_ACQUIRE, "agent");
            asm volatile("s_waitcnt vmcnt(0)" ::: "memory");
        }
    }
    __syncthreads();
}

#ifndef PROBE_ID
#define PROBE_ID 0
#endif
__global__ void __launch_bounds__(NTHR, 2) mega(KP p) {
  extern __shared__ __attribute__((aligned(16))) char lds[];
  cg::grid_group grid = cg::this_grid();
  const int hi = p.ph_hi; constexpr int probe = PROBE_ID;
  if (threadIdx.x == 0) { ((volatile LAS unsigned*)(lds + LDS_XB))[0] = 0u; ((volatile LAS unsigned*)(lds + LDS_XB))[1] = 0u; }
  __syncthreads();
  const XcdBarrier xb = xcd_barrier_post((unsigned*)(p.ws + WS_BAR), (volatile LAS unsigned*)(lds + LDS_XB));
  if (hi > 64) grid.sync();
  {
    unsigned* bar = (unsigned*)(p.ws + WS_BAR);
    const int njobs = phase0_mod(p, lds);
    if (njobs > 0) {
      asm volatile("s_waitcnt vmcnt(0)" ::: "memory"); __syncthreads();
      if (threadIdx.x == 0) { __builtin_amdgcn_fence(__ATOMIC_RELEASE, "agent"); asm volatile("s_waitcnt vmcnt(0)" ::: "memory"); xb_add(&bar[XB_MODCNT], (unsigned)njobs); }
    }
    phase0(p, lds);
    if (threadIdx.x == 0) { XB_SPIN(xb_ld(&bar[XB_MODCNT]) < (unsigned)MOD_JOBS, bar); __builtin_amdgcn_fence(__ATOMIC_ACQUIRE, "agent"); asm volatile("s_waitcnt vmcnt(0)" ::: "memory"); }
    __syncthreads();
  }
  if (p.ph_lo <= 1 && 1 < hi) {
    phase1a(p, lds);
    xcd_barrier(xb);
    {
      pg8::Gemm g{(const pg8::bf16_t*)p.out, (const pg8::bf16_t*)(p.ws + WS_WTINP), NTOK, 2304, 1024};
      pg8::StaticOrder S; S.init(NTOK, 2304, (int)gridDim.x, (int)blockIdx.x);
      pg8::EpiProj E{(pg8::bf16_t*)(p.ws + WS_P1S), (pg8::bf16_t*)((unsigned char*)p.out + 32 * MiB), (pg8::bf16_t*)(p.ws + WS_PROJC)};
      pg8::gemm_phase<pg8::EpiProj, pg8::StaticOrder, true, true>((PG8_LAS unsigned char*)lds, g, S, E);
      if (blockIdx.x >= 64) convert_experts(p, (int)blockIdx.x - 64, (int)gridDim.x - 64);
    }
    xcd_barrier(xb);
    phase1c(p, lds);
    if (2 < hi) xcd_barrier(xb);
  }
  if (p.ph_lo <= 2 && 2 < hi) { phase2_scan(p); phase2_attn(p, lds); if (probe == 3) phase2_attn(p, lds); if (3 < hi) xcd_barrier(xb); }
  if (p.ph_lo <= 3 && 3 < hi) {
    phase3(p, lds, 1, probe);
    xcd_barrier(xb);
    {
      pg8::Gemm g{(const pg8::bf16_t*)(p.ws + WS_P1S), (const pg8::bf16_t*)(p.ws + WS_WTOUTP), NTOK, 1024, 1024};
      pg8::StaticOrder S; S.init(NTOK, 1024, (int)gridDim.x, (int)blockIdx.x);
      pg8::EpiBf16<0> E{(pg8::bf16_t*)(p.ws + WS_QM), 1024, nullptr, 0, 0, 1.f};
      pg8::gemm_phase<pg8::EpiBf16<0>, pg8::StaticOrder, true, true>((PG8_LAS unsigned char*)lds, g, S, E);
    }
    xcd_barrier(xb);
    phase3c(p, lds, 1, probe);
    xcd_barrier(xb);
    {
      pg8::Gemm g{(const pg8::bf16_t*)(p.ws + WS_P1S), (const pg8::bf16_t*)(p.ws + WS_WTPQP), NTOK, 2048, 1024};
      pg8::StaticOrder S; S.init(NTOK, 2048, (int)gridDim.x, (int)blockIdx.x);
      pg8::EpiBf16<0> E{(pg8::bf16_t*)(p.ws + WS_QM), 2048, nullptr, 0, 0, 1.f};
      pg8::gemm_phase<pg8::EpiBf16<0>, pg8::StaticOrder, true, true>((PG8_LAS unsigned char*)lds, g, S, E);
    }
    xcd_barrier(xb);
    phase3b(p, lds, (probe == 4 || probe == 8 || probe == 9 || probe == 10) ? 2 : 1, probe);
  }
}

extern "C" void kernel_launch(void* const* d_in, const int* in_sizes, int n_in, void* d_out, int out_size, void* d_ws, size_t ws_size, hipStream_t stream) {
  float* out = (float*)d_out;
  unsigned char* ws = (unsigned char*)d_ws;
  if (ws_size < WS_END || n_in != 25) return;
  static bool attr_done = false;
  if (!attr_done) { (void)hipFuncSetAttribute((const void*)mega, hipFuncAttributeMaxDynamicSharedMemorySize, LDS_TOTAL); attr_done = true; }
  KP p{};
  for (int i = 0; i < 25; ++i) p.in[i] = (const float*)d_in[i];
  p.out = out; p.ws = ws;
  p.ph_lo = 0; p.ph_hi = 4;
  (void)hipMemsetAsync(ws + WS_BAR, 0, XCD_BAR_WORDS * 4, stream);
  { void* args[] = {&p}; (void)hipLaunchCooperativeKernel((const void*)mega, dim3(256), dim3(NTHR), args, LDS_TOTAL, stream); }
}
```

```cpp
#include <hip/hip_runtime.h>
#include <hip/hip_cooperative_groups.h>
namespace cg = cooperative_groups;
#include <stdint.h>

typedef unsigned short bf16_t;
#define DI __device__ __forceinline__

DI float bf2f(bf16_t v) { return __uint_as_float(((unsigned)v) << 16); }
DI bf16_t f2bf(float f) { return __builtin_bit_cast(unsigned short, (__bf16)f); }

constexpr int BATCH = 8, SEQ = 2048, DM = 1024, NTOK = BATCH * SEQ;
constexpr int INW = 2272;
constexpr float EPS = 1e-6f;
constexpr int O_CQ = 0, O_CKV = 384, O_KR = 640, O_QG = 704, O_KG = 960, O_VG = 1216, O_GF = 1728, O_GB = 1744, O_R = 1760;

DI float wave_sum(float v) {
#pragma unroll
  for (int o = 1; o < 64; o <<= 1) v += __shfl_xor(v, o);
  return v;
}
DI float wave_max(float v) {
#pragma unroll
  for (int o = 1; o < 64; o <<= 1) v = fmaxf(v, __shfl_xor(v, o));
  return v;
}
DI float block_sum256(float v, float* red) {
  v = wave_sum(v);
  __syncthreads();
  if ((threadIdx.x & 63) == 0) red[threadIdx.x >> 6] = v;
  __syncthreads();
  return red[0] + red[1] + red[2] + red[3];
}
DI float block_max256(float v, float* red) {
  v = wave_max(v);
  __syncthreads();
  if ((threadIdx.x & 63) == 0) red[threadIdx.x >> 6] = v;
  __syncthreads();
  return fmaxf(fmaxf(red[0], red[1]), fmaxf(red[2], red[3]));
}
DI float silu_f(float x) { return x / (1.f + expf(-x)); }
DI float logsigmoid_f(float x) { return fminf(x, 0.f) - log1pf(expf(-fabsf(x))); }
DI float fexp(float x) { return __builtin_amdgcn_exp2f(x * 1.4426950408889634f); }
DI float silu_fast(float x) { return x * __builtin_amdgcn_rcpf(1.f + fexp(-x)); }
DI float logsigmoid_fast(float x) { return fminf(x, 0.f) - __builtin_amdgcn_logf(1.f + fexp(-fabsf(x))) * 0.6931471805599453f; }
DI float gelu_erf(float x) { return 0.5f * x * (1.f + erff(x * 0.70710678118654752f)); }

__global__ __launch_bounds__(256) void n_mod(const float* __restrict__ c, const float* __restrict__ w_ada, const float* __restrict__ b_ada, float* __restrict__ mod) {
  int idx = blockIdx.x * 256 + threadIdx.x;
  int b = idx / 6144, j = idx % 6144;
  float acc = b_ada[j];
  for (int k = 0; k < 1024; ++k) acc += silu_f(c[b * 1024 + k]) * w_ada[(size_t)k * 6144 + j];
  mod[idx] = acc;
}

__global__ __launch_bounds__(256) void n_hnorm(const float* __restrict__ x, const float* __restrict__ g, const float* __restrict__ mod, int b, int off_sh, int off_sc, float* __restrict__ h) {
  __shared__ float red[4];
  int t = blockIdx.x, tid = threadIdx.x;
  const float* xr = x + ((size_t)b * SEQ + t) * DM;
  float v[4]; float ss = 0.f;
#pragma unroll
  for (int i = 0; i < 4; ++i) { v[i] = xr[tid + 256 * i]; ss += v[i] * v[i]; }
  ss = block_sum256(ss, red);
  float rs = rsqrtf(ss * (1.f / DM) + EPS);
#pragma unroll
  for (int i = 0; i < 4; ++i) { int d = tid + 256 * i; h[(size_t)t * DM + d] = v[i] * rs * g[d] * (1.f + mod[b * 6144 + off_sc + d]) + mod[b * 6144 + off_sh + d]; }
}

template <bool BT>
__global__ __launch_bounds__(256) void n_gemm(const float* __restrict__ A, int lda, const float* __restrict__ B, int ldb, float* __restrict__ C, int ldc, int M, int N, int K) {
  __shared__ float As[16][65];
  __shared__ float Bs[16][65];
  const int tid = threadIdx.x, tx = tid & 15, ty = tid >> 4;
  const int m0 = blockIdx.y * 64, n0 = blockIdx.x * 64;
  float acc[4][4];
#pragma unroll
  for (int i = 0; i < 4; ++i)
#pragma unroll
    for (int j = 0; j < 4; ++j) acc[i][j] = 0.f;
  for (int k0 = 0; k0 < K; k0 += 16) {
#pragma unroll
    for (int i = 0; i < 4; ++i) { int e = tid + 256 * i; int m = e >> 4, k = e & 15; As[k][m] = A[(size_t)(m0 + m) * lda + k0 + k]; }
#pragma unroll
    for (int i = 0; i < 4; ++i) { int e = tid + 256 * i;
      if (!BT) { int k = e >> 6, n = e & 63; Bs[k][n] = (n0 + n < N) ? B[(size_t)(k0 + k) * ldb + n0 + n] : 0.f; }
      else     { int n = e >> 4, k = e & 15; Bs[k][n] = (n0 + n < N) ? B[(size_t)(n0 + n) * ldb + k0 + k] : 0.f; } }
    __syncthreads();
#pragma unroll
    for (int k = 0; k < 16; ++k) {
      float a[4], bb[4];
#pragma unroll
      for (int i = 0; i < 4; ++i) { a[i] = As[k][ty * 4 + i]; bb[i] = Bs[k][tx * 4 + i]; }
#pragma unroll
      for (int i = 0; i < 4; ++i)
#pragma unroll
        for (int j = 0; j < 4; ++j) acc[i][j] += a[i] * bb[j];
    }
    __syncthreads();
  }
#pragma unroll
  for (int i = 0; i < 4; ++i)
#pragma unroll
    for (int j = 0; j < 4; ++j) { int n = n0 + tx * 4 + j; if (n < N) C[(size_t)(m0 + ty * 4 + i) * ldc + n] = acc[i][j]; }
}

__global__ __launch_bounds__(256) void n_rms_slice(const float* __restrict__ in, int ldin, int off, int W, const float* __restrict__ g, float* __restrict__ out) {
  __shared__ float red[4];
  int t = blockIdx.x, tid = threadIdx.x;
  float v0 = (tid < W) ? in[(size_t)t * ldin + off + tid] : 0.f;
  float v1 = (tid + 256 < W) ? in[(size_t)t * ldin + off + tid + 256] : 0.f;
  float ss = block_sum256(v0 * v0 + v1 * v1, red);
  float rs = rsqrtf(ss / (float)W + EPS);
  if (tid < W) out[(size_t)t * W + tid] = v0 * rs * g[tid];
  if (tid + 256 < W) out[(size_t)t * W + tid + 256] = v1 * rs * g[tid + 256];
}

__global__ __launch_bounds__(256) void n_scatter(const float* __restrict__ proj, const float* __restrict__ qa, const float* __restrict__ kv, const int* __restrict__ positions, int b,
                                                 const float* __restrict__ wgf, const float* __restrict__ bgf, const float* __restrict__ wgb, const float* __restrict__ bgb,
                                                 bf16_t* __restrict__ Qm, bf16_t* __restrict__ Km, bf16_t* __restrict__ Vm, bf16_t* __restrict__ qg, bf16_t* __restrict__ kg, bf16_t* __restrict__ vg,
                                                 bf16_t* __restrict__ rg, float* __restrict__ laf, float* __restrict__ lab) {
  __shared__ float cs[32], sn[32];
  const int t = blockIdx.x, tid = threadIdx.x;
  const size_t tok = (size_t)b * SEQ + t;
  const float* pr = proj + (size_t)t * INW;
  const float* qr = qa + (size_t)t * 768;
  const float* kr = kv + (size_t)t * 1024;
  if (tid < 32) {
    float inv = powf(10000.f, -(float)tid / 32.f);
    float ang = (float)positions[tok] * inv;
    cs[tid] = cosf(ang); sn[tid] = sinf(ang);
  }
  __syncthreads();
  for (int e = tid; e < 4 * 192; e += 256) {
    int h = e / 192, d = e % 192; float v;
    if (d < 128) v = qr[h * 192 + d];
    else { int j = d - 128; const float* rp = qr + h * 192 + 128;
      if (j < 32) v = rp[j] * cs[j] - rp[j + 32] * sn[j]; else v = rp[j] * cs[j - 32] + rp[j - 32] * sn[j - 32]; }
    Qm[(((size_t)b * 4 + h) * SEQ + t) * 192 + d] = f2bf(v);
  }
  for (int e = tid; e < 4 * 192; e += 256) {
    int h = e / 192, d = e % 192; float v;
    if (d < 128) v = kr[h * 256 + d];
    else { int j = d - 128; const float* rp = pr + O_KR;
      if (j < 32) v = rp[j] * cs[j] - rp[j + 32] * sn[j]; else v = rp[j] * cs[j - 32] + rp[j - 32] * sn[j - 32]; }
    Km[(((size_t)b * 4 + h) * SEQ + t) * 192 + d] = f2bf(v);
  }
  for (int e = tid; e < 512; e += 256) { int h = e >> 7, d = e & 127; Vm[(((size_t)b * 4 + h) * SEQ + t) * 128 + d] = f2bf(kr[h * 256 + 128 + d]); }
  { int e = tid; qg[tok * 256 + e] = f2bf(pr[O_QG + e] * 0.125f); kg[tok * 256 + e] = f2bf(pr[O_KG + e]); }
  for (int e = tid; e < 512; e += 256) { vg[tok * 512 + e] = f2bf(pr[O_VG + e]); rg[tok * 512 + e] = f2bf(pr[O_R + e]); }
  { int cidx = tid; float af = bgf[cidx], ab = bgb[cidx];
#pragma unroll
    for (int r = 0; r < 16; ++r) { af += pr[O_GF + r] * wgf[r * 256 + cidx]; ab += pr[O_GB + r] * wgb[r * 256 + cidx]; }
    laf[tok * 256 + cidx] = logsigmoid_f(af) * (1.f / 16.f); lab[tok * 256 + cidx] = logsigmoid_f(ab) * (1.f / 16.f); }
}

__global__ __launch_bounds__(256) void n_attn(const bf16_t* __restrict__ Qm, const bf16_t* __restrict__ Km, const bf16_t* __restrict__ Vm, bf16_t* __restrict__ omla) {
  __shared__ float qs[192]; __shared__ float sc[2048]; __shared__ float red[4];
  const int i = blockIdx.x, h = blockIdx.y, b = blockIdx.z, tid = threadIdx.x;
  const size_t bh = (size_t)b * 4 + h;
  if (tid < 192) qs[tid] = bf2f(Qm[(bh * SEQ + i) * 192 + tid]);
  __syncthreads();
  float mx = -1e30f;
  for (int kk = 0; kk < 8; ++kk) {
    int key = tid + 256 * kk; const uint4* kr = (const uint4*)(Km + (bh * SEQ + key) * 192);
    float s = 0.f;
    for (int c = 0; c < 24; ++c) { uint4 w = kr[c]; const float* q = qs + c * 8;
      s += q[0] * __uint_as_float(w.x << 16) + q[1] * __uint_as_float(w.x & 0xffff0000u) + q[2] * __uint_as_float(w.y << 16) + q[3] * __uint_as_float(w.y & 0xffff0000u)
         + q[4] * __uint_as_float(w.z << 16) + q[5] * __uint_as_float(w.z & 0xffff0000u) + q[6] * __uint_as_float(w.w << 16) + q[7] * __uint_as_float(w.w & 0xffff0000u); }
    s *= 0.07216878364870322f; sc[key] = s; mx = fmaxf(mx, s);
  }
  mx = block_max256(mx, red);
  float sum = 0.f;
  for (int kk = 0; kk < 8; ++kk) { int key = tid + 256 * kk; float p = expf(sc[key] - mx); sc[key] = p; sum += p; }
  sum = block_sum256(sum, red);
  __syncthreads();
  if (tid < 128) { float o = 0.f; const bf16_t* vp = Vm + bh * SEQ * 128 + tid;
    for (int key = 0; key < SEQ; ++key) o += sc[key] * bf2f(vp[(size_t)key * 128]);
    omla[((size_t)b * SEQ + i) * 512 + h * 128 + tid] = f2bf(o / sum); }
}

__global__ __launch_bounds__(128) void n_gla(const bf16_t* __restrict__ qg, const bf16_t* __restrict__ kg, const bf16_t* __restrict__ vg, const bf16_t* __restrict__ laf, const bf16_t* __restrict__ lab, float* __restrict__ og) {
  __shared__ float qs[64], ks[64], as[64];
  const int bh = blockIdx.x, b = bh >> 2, h = bh & 3, dv = threadIdx.x;
  for (int dir = 0; dir < 2; ++dir) {
    float S[64];
#pragma unroll
    for (int d = 0; d < 64; ++d) S[d] = 0.f;
    const bf16_t* la = dir ? lab : laf;
    for (int s = 0; s < SEQ; ++s) {
      const int t = dir ? (SEQ - 1 - s) : s; const size_t tok = (size_t)b * SEQ + t;
      __syncthreads();
      if (dv < 64) { qs[dv] = bf2f(qg[tok * 256 + h * 64 + dv]); ks[dv] = bf2f(kg[tok * 256 + h * 64 + dv]); as[dv] = expf(bf2f(la[tok * 256 + h * 64 + dv])); }
      __syncthreads();
      const float v = bf2f(vg[tok * 512 + h * 128 + dv]); float o = 0.f;
#pragma unroll
      for (int d = 0; d < 64; ++d) { S[d] = as[d] * S[d] + ks[d] * v; o += qs[d] * S[d]; }
      if (dir == 0) og[tok * 512 + h * 128 + dv] = o; else og[tok * 512 + h * 128 + dv] += o;
    }
  }
}

__global__ __launch_bounds__(256) void n_mix(const bf16_t* __restrict__ omla, const float* __restrict__ og, const bf16_t* __restrict__ rg, const float* __restrict__ g_gla, int b, float* __restrict__ mix) {
  __shared__ float ssum[4];
  const int t = blockIdx.x, tid = threadIdx.x; const size_t tok = (size_t)b * SEQ + t;
  if (tid < 4) ssum[tid] = 0.f;
  __syncthreads();
  float v[2];
#pragma unroll
  for (int i = 0; i < 2; ++i) { int e = tid + 256 * i; v[i] = og[tok * 512 + e]; atomicAdd(&ssum[e >> 7], v[i] * v[i]); mix[(size_t)t * DM + e] = bf2f(omla[tok * 512 + e]); }
  __syncthreads();
#pragma unroll
  for (int i = 0; i < 2; ++i) { int e = tid + 256 * i; float rs = rsqrtf(ssum[e >> 7] * (1.f / 128.f) + EPS);
    mix[(size_t)t * DM + 512 + e] = v[i] * rs * g_gla[e & 127] * silu_f(bf2f(rg[tok * 512 + e])); }
}

__global__ __launch_bounds__(256) void n_post1(const float* __restrict__ x, const float* __restrict__ y, const float* __restrict__ g_post, const float* __restrict__ g_pre2, const float* __restrict__ mod, int b,
                                               float* __restrict__ out, float* __restrict__ h2) {
  __shared__ float red[4];
  const int t = blockIdx.x, tid = threadIdx.x; const size_t tok = (size_t)b * SEQ + t;
  float yv[4], xv[4]; float ss = 0.f;
#pragma unroll
  for (int i = 0; i < 4; ++i) { yv[i] = y[(size_t)t * DM + tid + 256 * i]; ss += yv[i] * yv[i]; }
  ss = block_sum256(ss, red);
  float rs = rsqrtf(ss * (1.f / DM) + EPS); float s2 = 0.f;
#pragma unroll
  for (int i = 0; i < 4; ++i) { int d = tid + 256 * i; xv[i] = x[tok * DM + d] + mod[b * 6144 + 2048 + d] * (yv[i] * rs * g_post[d]); out[tok * DM + d] = xv[i]; s2 += xv[i] * xv[i]; }
  s2 = block_sum256(s2, red);
  float r2 = rsqrtf(s2 * (1.f / DM) + EPS);
#pragma unroll
  for (int i = 0; i < 4; ++i) { int d = tid + 256 * i; h2[(size_t)t * DM + d] = xv[i] * r2 * g_pre2[d] * (1.f + mod[b * 6144 + 4096 + d]) + mod[b * 6144 + 3072 + d]; }
}

DI void wave_argmax(float& v, int& i) {
#pragma unroll
  for (int o = 1; o < 64; o <<= 1) { float ov = __shfl_xor(v, o); int oi = __shfl_xor(i, o); if (ov > v || (ov == v && oi < i)) { v = ov; i = oi; } }
}
__global__ __launch_bounds__(256) void n_peer_select(const float* __restrict__ qry, const float* __restrict__ sk1, const float* __restrict__ sk2, int* __restrict__ eidx, float* __restrict__ gate) {
  __shared__ float v1s[4][16], v2s[4][16]; __shared__ int i1s[4][16], i2s[4][16];
  const int w = threadIdx.x >> 6, lane = threadIdx.x & 63;
  const int pair = blockIdx.x * 4 + w;
  const int t = pair >> 3, h = pair & 7;
  const float* q1 = qry + (size_t)t * 2048 + h * 256; const float* q2 = q1 + 128;
  float s1a = 0.f, s1b = 0.f, s2a = 0.f, s2b = 0.f;
  for (int d = 0; d < 128; ++d) { float a = q1[d], bq = q2[d];
    s1a += a * sk1[lane * 128 + d]; s1b += a * sk1[(lane + 64) * 128 + d]; s2a += bq * sk2[lane * 128 + d]; s2b += bq * sk2[(lane + 64) * 128 + d]; }
  for (int side = 0; side < 2; ++side) {
    float va = side ? s2a : s1a, vb = side ? s2b : s1b; bool ta = false, tb = false;
    for (int k = 0; k < 16; ++k) {
      float bv; int bi;
      if (!ta && (tb || va >= vb)) { bv = va; bi = lane; } else if (!tb) { bv = vb; bi = lane + 64; } else { bv = -3e38f; bi = 1 << 20; }
      wave_argmax(bv, bi);
      if (bi == lane) ta = true; if (bi == lane + 64) tb = true;
      if (lane == 0) { if (side) { v2s[w][k] = bv; i2s[w][k] = bi; } else { v1s[w][k] = bv; i1s[w][k] = bi; } }
    }
  }
  __syncthreads();
  float cv[4]; bool tk[4];
#pragma unroll
  for (int j = 0; j < 4; ++j) { int c = lane + 64 * j; cv[j] = v1s[w][c >> 4] + v2s[w][c & 15]; tk[j] = false; }
  float topv = 0.f; int topc = 0; float mx = 0.f;
  for (int k = 0; k < 16; ++k) {
    float bv = -3e38f; int bi = 1 << 20;
#pragma unroll
    for (int j = 0; j < 4; ++j) { if (!tk[j] && cv[j] > bv) { bv = cv[j]; bi = lane + 64 * j; } }
    wave_argmax(bv, bi);
#pragma unroll
    for (int j = 0; j < 4; ++j) if (bi == lane + 64 * j) tk[j] = true;
    if (k == 0) mx = bv;
    if (lane == k) { topv = bv; topc = bi; }
  }
  float e = (lane < 16) ? expf(topv - mx) : 0.f;
  float sum = wave_sum(e);
  if (lane < 16) { eidx[(size_t)pair * 16 + lane] = i1s[w][topc >> 4] * 128 + i2s[w][topc & 15]; gate[(size_t)pair * 16 + lane] = e / sum; }
}

__global__ __launch_bounds__(256) void n_peer_apply(const float* __restrict__ h2, const int* __restrict__ eidx, const float* __restrict__ gate, const float* __restrict__ eu, const float* __restrict__ ev,
                                                    const float* __restrict__ g_post, const float* __restrict__ mod, int b, float* __restrict__ out) {
  __shared__ float ys[4][1024]; __shared__ float red[4];
  const int t = blockIdx.x, tid = threadIdx.x, w = tid >> 6, lane = tid & 63; const size_t tok = (size_t)b * SEQ + t;
  float4 hx[4];
#pragma unroll
  for (int i = 0; i < 4; ++i) hx[i] = *(const float4*)(h2 + (size_t)t * DM + (lane + 64 * i) * 4);
  float4 acc[4];
#pragma unroll
  for (int i = 0; i < 4; ++i) acc[i] = make_float4(0.f, 0.f, 0.f, 0.f);
  for (int k = w; k < 128; k += 4) {
    const int e = eidx[(size_t)t * 128 + k]; const float gt = gate[(size_t)t * 128 + k];
    const float4* ur = (const float4*)(eu + (size_t)e * DM); const float4* vr = (const float4*)(ev + (size_t)e * DM);
    float d = 0.f;
#pragma unroll
    for (int i = 0; i < 4; ++i) { float4 u = ur[lane + 64 * i]; d += u.x * hx[i].x + u.y * hx[i].y + u.z * hx[i].z + u.w * hx[i].w; }
    d = wave_sum(d);
    const float wgt = gt * gelu_erf(d);
#pragma unroll
    for (int i = 0; i < 4; ++i) { float4 v = vr[lane + 64 * i]; acc[i].x += wgt * v.x; acc[i].y += wgt * v.y; acc[i].z += wgt * v.z; acc[i].w += wgt * v.w; }
  }
#pragma unroll
  for (int i = 0; i < 4; ++i) *(float4*)(&ys[w][(lane + 64 * i) * 4]) = acc[i];
  __syncthreads();
  float yv[4]; float ss = 0.f;
#pragma unroll
  for (int i = 0; i < 4; ++i) { int d = tid + 256 * i; yv[i] = ys[0][d] + ys[1][d] + ys[2][d] + ys[3][d]; ss += yv[i] * yv[i]; }
  ss = block_sum256(ss, red);
  const float rs = rsqrtf(ss * (1.f / DM) + EPS);
#pragma unroll
  for (int i = 0; i < 4; ++i) { int d = tid + 256 * i; out[tok * DM + d] = out[tok * DM + d] + mod[b * 6144 + 5120 + d] * (yv[i] * rs * g_post[d]); }
}

typedef short bf16x8 __attribute__((ext_vector_type(8)));
typedef float f32x16 __attribute__((ext_vector_type(16)));
#define MFMA32(a, b, c) __builtin_amdgcn_mfma_f32_32x32x16_bf16((a), (b), (c), 0, 0, 0)

constexpr int NTHR = 512;
constexpr size_t MiB = 1024 * 1024;
constexpr size_t WS_MOD   = 0;
constexpr size_t WS_WTIN  = 256 * 1024;
constexpr size_t WS_WTQUP = WS_WTIN + (size_t)2304 * 1024 * 2;
constexpr size_t WS_WTKVUP = WS_WTQUP + (size_t)768 * 384 * 2;
constexpr size_t WS_WTOUT = WS_WTKVUP + (size_t)1024 * 256 * 2;
constexpr size_t WS_WTPQ  = WS_WTOUT + (size_t)1024 * 1024 * 2;
constexpr size_t WS_KD    = WS_WTPQ + (size_t)2048 * 1024 * 2;
constexpr size_t WS_DEC   = WS_KD + (size_t)256 * 256 * 2;
constexpr size_t WS_ESC   = WS_DEC + (size_t)2048 * 64 * 4;
constexpr size_t WS_R0END = WS_ESC + (size_t)2 * 16384 * 4;
static_assert(WS_R0END <= 13 * MiB, "R0");
constexpr size_t WS_BAR  = 13 * MiB - 65536;
static_assert(WS_R0END + 131072 <= WS_BAR, "R0 room");
constexpr size_t WS_QM   = 13 * MiB;
constexpr size_t WS_KM   = WS_QM + 24 * MiB;
constexpr size_t WS_VM   = WS_KM + 24 * MiB;
constexpr size_t WS_P1S  = WS_VM + 16 * MiB;
constexpr size_t WS_RG   = WS_P1S + 32 * MiB;
constexpr size_t WS_OINTRA = WS_RG + 16 * MiB;
constexpr size_t WS_QDEC = WS_OINTRA + 16 * MiB;
constexpr size_t WS_SPT  = WS_QDEC + 16 * MiB;
constexpr size_t WS_EU   = WS_SPT + 32 * MiB;
constexpr size_t WS_EV   = WS_EU + 16 * MiB;
constexpr size_t WS_WTPQP = WS_EV + 16 * MiB;
constexpr size_t WS_WTOUTP = WS_WTPQP + 4 * MiB;
constexpr size_t WS_WTINP = WS_WTOUTP + 2 * MiB;
constexpr size_t WS_PROJC = WS_WTINP + 4608 * 1024;
constexpr size_t WS_END  = WS_PROJC + 8 * MiB;
static_assert(WS_P1S == WS_QM + 64 * MiB, "P3 QRY scratch aliases QM..VM");
constexpr size_t OUT_HS  = 0;
constexpr size_t OUT_CQ  = 32 * MiB;
constexpr size_t OUT_GR  = 52 * MiB;

struct KP { const float* in[25]; float* out; unsigned char* ws; int ph_lo, ph_hi; };

constexpr int G_STG = 40960;
constexpr int LDS_WT = 3 * G_STG;
constexpr int LDS_TAB = LDS_WT + 18432;
constexpr int LDS_XB = 157696;
constexpr int LDS_TOTAL = 157696 + 16;

typedef float f32x2_t __attribute__((ext_vector_type(2)));
typedef __bf16 bf16x2_t __attribute__((ext_vector_type(2)));
DI unsigned pack2(float lo, float hi) { const f32x2_t v = {lo, hi}; return __builtin_bit_cast(unsigned, __builtin_convertvector(v, bf16x2_t)); }
DI int crow(int reg, int hh) { return (reg & 3) + 8 * (reg >> 2) + 4 * hh; }

#define GLDS16(gp, lp) __builtin_amdgcn_global_load_lds((const unsigned*)(gp), (__attribute__((address_space(3))) unsigned*)(lp), 16, 0, 0)
template <int NST, class Epi>
DI void block_gemm(char* lds, const bf16_t* A, int lda, const bf16_t* Bt, int nchunks, int K, Epi&& epi) {
  const int tid = threadIdx.x, lane = tid & 63, w = __builtin_amdgcn_readfirstlane(tid >> 6), r = lane & 31, hh = lane >> 5;
  const int nk = K >> 6, T = nchunks * nk;
  constexpr int D = NST - 1;
  if (w >= 4) {
    const int j = w - 4, rin = lane >> 3, sw = ((lane & 7) ^ rin) * 8;
    const bf16_t* Ap = A + (size_t)(16 * j + rin) * lda + sw;
    const bf16_t* Bp = Bt + (size_t)(64 * j + rin) * 64 + sw;
    auto dma = [&](int g) {
      const int ch = g / nk, t = g - ch * nk; char* st = lds + (g % NST) * G_STG;
      const bf16_t* a0 = Ap + t * 64; char* la = st + (2 * j) * 1024;
      GLDS16(a0, la); GLDS16(a0 + (size_t)8 * lda, la + 1024);
      const bf16_t* b0 = Bp + (size_t)g * 16384; char* lb = st + 8192 + (8 * j) * 1024;
#pragma unroll
      for (int i = 0; i < 8; ++i) GLDS16(b0 + i * 512, lb + i * 1024);
    };
#pragma unroll
    for (int g = 0; g < D; ++g) if (g < T) dma(g);
    if (D >= 2 && T >= 2) asm volatile("s_waitcnt vmcnt(10)" ::: "memory"); else asm volatile("s_waitcnt vmcnt(0)" ::: "memory");
    __builtin_amdgcn_s_barrier();
#pragma unroll 1
    for (int g = 0; g < T; ++g) {
      if (g + D < T) { dma(g + D); if (D >= 2) asm volatile("s_waitcnt vmcnt(10)" ::: "memory"); else asm volatile("s_waitcnt vmcnt(0)" ::: "memory"); }
      else asm volatile("s_waitcnt vmcnt(0)" ::: "memory");
      __builtin_amdgcn_s_barrier();
    }
  } else {
    const int x = r & 7;
    const int o0 = ((0 + hh) ^ x) * 16, o1 = ((2 + hh) ^ x) * 16, o2 = ((4 + hh) ^ x) * 16, o3 = ((6 + hh) ^ x) * 16;
    const int a_rd = r * 128, b_rd = 8192 + (w * 64 + r) * 128;
    __builtin_amdgcn_s_barrier();
    int g = 0;
#pragma unroll 1
    for (int ch = 0; ch < nchunks; ++ch) {
      f32x16 c00, c01, c10, c11;
#pragma unroll
      for (int i = 0; i < 16; ++i) { c00[i] = 0.f; c01[i] = 0.f; c10[i] = 0.f; c11[i] = 0.f; }
#pragma unroll 1
      for (int t = 0; t < nk; ++t, ++g) {
        const char* cur = lds + (g % NST) * G_STG;
        bf16x8 fa0[4], fa1[4], fb0[4], fb1[4];
#define FRD(s_, o_) do { fa0[s_] = *(const bf16x8*)(cur + a_rd + o_); fb0[s_] = *(const bf16x8*)(cur + b_rd + o_); fb1[s_] = *(const bf16x8*)(cur + b_rd + 4096 + o_); fa1[s_] = *(const bf16x8*)(cur + a_rd + 4096 + o_); } while (0)
        FRD(0, o0); FRD(1, o1); FRD(2, o2); FRD(3, o3);
#undef FRD
        asm volatile("s_waitcnt lgkmcnt(0)" ::: "memory");
        __builtin_amdgcn_s_barrier();
        __builtin_amdgcn_sched_barrier(0);
#pragma unroll
        for (int s = 0; s < 4; ++s) {
          c00 = MFMA32(fa0[s], fb0[s], c00); c01 = MFMA32(fa0[s], fb1[s], c01); c10 = MFMA32(fa1[s], fb0[s], c10); c11 = MFMA32(fa1[s], fb1[s], c11); }
      }
      epi(0, ch * 256 + w * 64, c00, c01);
      epi(32, ch * 256 + w * 64, c10, c11);
    }
  }
}

DI void p0_transpose(char* lds, const float* __restrict__ W, int K, int N, bf16_t* __restrict__ Wt, int item, bf16_t* __restrict__ Wplain = nullptr) {
  float* s = (float*)lds;
  const int tid = threadIdx.x;
  const int ntn = (N + 63) >> 6, kt = item / ntn, nt = item % ntn, k0 = kt * 64, n0 = nt * 64;
  __syncthreads();
#pragma unroll
  for (int i = 0; i < 8; ++i) { int e = tid + 512 * i; int kk = e >> 6, nn = e & 63; s[kk * 65 + nn] = (n0 + nn < N) ? W[(size_t)(k0 + kk) * N + n0 + nn] : 0.f; }
  __syncthreads();
  const int nn = tid >> 3, part = tid & 7;
  const float* sp = s + (part * 8) * 65 + nn;
  uint4 o; o.x = pack2(sp[0], sp[65]); o.y = pack2(sp[2 * 65], sp[3 * 65]); o.z = pack2(sp[4 * 65], sp[5 * 65]); o.w = pack2(sp[6 * 65], sp[7 * 65]);
  { const int n = n0 + nn; *(uint4*)(Wt + ((size_t)((n >> 8) * (K >> 6) + kt)) * 16384 + (n & 255) * 64 + part * 8) = o; }
  if (Wplain) *(uint4*)(Wplain + (size_t)(n0 + nn) * K + k0 + part * 8) = o;
}

DI void convert_experts(const KP& p, const int bid, const int nb) {
  const int tid = threadIdx.x; unsigned char* ws = p.ws;
  { const int lane = tid & 63; float* scl = (float*)(ws + WS_ESC);
    for (int row = bid * 8 + (tid >> 6); row < 32768; row += nb * 8) { const int t = row >> 14, e = row & 16383;
      const float* src = p.in[23 + t] + (size_t)e * 1024 + lane * 16;
      float4 x[4]; float am = 0.f;
#pragma unroll
      for (int i = 0; i < 4; ++i) { x[i] = *(const float4*)(src + 4 * i); am = fmaxf(am, fmaxf(fmaxf(fabsf(x[i].x), fabsf(x[i].y)), fmaxf(fabsf(x[i].z), fabsf(x[i].w)))); }
      am = wave_max(am);
      float sc = 1.f, isc = 1.f;
      if (am > 0.f) { int ex; (void)frexpf((t ? 448.f : 127.f) / am, &ex); sc = ldexpf(1.f, ex - 1); isc = ldexpf(1.f, 1 - ex); }
      unsigned wv[4];
      if (t) {
#pragma unroll
        for (int i = 0; i < 4; ++i) { int q = __builtin_amdgcn_cvt_pk_fp8_f32(x[i].x * sc, x[i].y * sc, 0, false); q = __builtin_amdgcn_cvt_pk_fp8_f32(x[i].z * sc, x[i].w * sc, q, true); wv[i] = (unsigned)q; }
      } else {
#pragma unroll
        for (int i = 0; i < 4; ++i) { const int q0 = (int)rintf(x[i].x * sc), q1 = (int)rintf(x[i].y * sc), q2 = (int)rintf(x[i].z * sc), q3 = (int)rintf(x[i].w * sc);
          wv[i] = (unsigned)(q0 & 255) | ((unsigned)(q1 & 255) << 8) | ((unsigned)(q2 & 255) << 16) | ((unsigned)(q3 & 255) << 24); }
      }
      *(uint4*)(ws + (t ? WS_EV : WS_EU) + (size_t)e * 1024 + lane * 16) = make_uint4(wv[0], wv[1], wv[2], wv[3]);
      if (lane == 0) scl[t * 16384 + e] = isc; } }
}

constexpr int MOD_JOBS = 192;
DI int phase0_mod(const KP& p, char* lds) {
  const int tid = threadIdx.x, bid = blockIdx.x, nb = gridDim.x; unsigned char* ws = p.ws; int njobs = 0;
  for (int jb = bid; jb < MOD_JOBS; jb += nb) {
    __syncthreads();
    float* cact = (float*)lds;
    float* red = (float*)(lds + 32768);
    for (int e = tid; e < 8192; e += NTHR) cact[e] = silu_f(p.in[1][e]);
    __syncthreads();
    const int jj = tid & 31, ks = tid >> 5, j0 = jb * 32;
    float acc[8];
#pragma unroll
    for (int b = 0; b < 8; ++b) acc[b] = 0.f;
    const float* wp = p.in[3] + (size_t)(ks * 64) * 6144 + j0 + jj;
#pragma unroll 8
    for (int k = 0; k < 64; ++k) { const float wv = wp[(size_t)k * 6144];
#pragma unroll
      for (int b = 0; b < 8; ++b) acc[b] += cact[b * 1024 + ks * 64 + k] * wv; }
#pragma unroll
    for (int b = 0; b < 8; ++b) red[(ks * 32 + jj) * 8 + b] = acc[b];
    __syncthreads();
    if (tid < 256) { const int b = tid >> 5; float sacc = p.in[4][j0 + jj];
#pragma unroll
      for (int k2 = 0; k2 < 16; ++k2) sacc += red[(k2 * 32 + jj) * 8 + b];
      ((float*)(ws + WS_MOD))[b * 6144 + j0 + jj] = sacc; }
    ++njobs;
  }
  return njobs;
}

DI void p0_transpose_wave(float* s, const float* __restrict__ W, int K, int N, int item, bf16_t* __restrict__ Wtiled, bf16_t* __restrict__ Wplain) {
  const int lane = threadIdx.x & 63;
  const int ntn = (N + 63) >> 6, kt = item / ntn, nt = item % ntn, k0 = kt * 64, n0 = nt * 64;
  const int c4 = (lane & 15) * 4, rq = lane >> 4;
  float4 v[16];
#pragma unroll
  for (int i = 0; i < 16; ++i) { const int kk = 4 * i + rq;
    v[i] = (n0 + c4 < N) ? *(const float4*)(W + (size_t)(k0 + kk) * N + n0 + c4) : make_float4(0.f, 0.f, 0.f, 0.f); }
#pragma unroll
  for (int i = 0; i < 16; ++i) { const int kk = 4 * i + rq;
    float* d = s + kk * 65 + c4; d[0] = v[i].x; d[1] = v[i].y; d[2] = v[i].z; d[3] = v[i].w; }
  __builtin_amdgcn_wave_barrier(); asm volatile("" ::: "memory");
#pragma unroll
  for (int q = 0; q < 8; ++q) { const int c = lane + 64 * q, nn = c >> 3, part = c & 7;
    const float* sp = s + (part * 8) * 65 + nn;
    uint4 o; o.x = pack2(sp[0], sp[65]); o.y = pack2(sp[2 * 65], sp[3 * 65]); o.z = pack2(sp[4 * 65], sp[5 * 65]); o.w = pack2(sp[6 * 65], sp[7 * 65]);
    const int n = n0 + nn;
    if (Wtiled) *(uint4*)(Wtiled + ((size_t)((n >> 8) * (K >> 6) + kt)) * 16384 + (n & 255) * 64 + part * 8) = o;
    if (Wplain) *(uint4*)(Wplain + (size_t)n * K + k0 + part * 8) = o; }
  __builtin_amdgcn_wave_barrier(); asm volatile("" ::: "memory");
}

DI void phase0(const KP& p, char* lds) {
  const int tid = threadIdx.x, bid = blockIdx.x, nb = gridDim.x;
  unsigned char* ws = p.ws;
  constexpr int I_IN = 16 * 36, I_QUP = 6 * 12, I_KVUP = 4 * 16, I_OUT = 16 * 16, I_PQ = 16 * 32;
  constexpr int I_ALL = I_IN + I_QUP + I_KVUP + I_OUT + I_PQ;
  { const int w = tid >> 6, nwv = nb * 8; float* s = (float*)(lds + w * 16640);
    for (int it = nwv - 1 - (bid * 8 + w); it < I_ALL; it += nwv) {
      int q = it;
      if (q < I_IN) { p0_transpose_wave(s, p.in[7], 1024, 2272, q, nullptr, (bf16_t*)(ws + WS_WTINP)); continue; } q -= I_IN;
      if (q < I_QUP) { p0_transpose_wave(s, p.in[9], 384, 768, q, (bf16_t*)(ws + WS_WTQUP), nullptr); continue; } q -= I_QUP;
      if (q < I_KVUP) { p0_transpose_wave(s, p.in[11], 256, 1024, q, (bf16_t*)(ws + WS_WTKVUP), nullptr); continue; } q -= I_KVUP;
      if (q < I_OUT) { p0_transpose_wave(s, p.in[17], 1024, 1024, q, nullptr, (bf16_t*)(ws + WS_WTOUTP)); continue; } q -= I_OUT;
      p0_transpose_wave(s, p.in[20], 1024, 2048, q, nullptr, (bf16_t*)(ws + WS_WTPQP));
    }
  }
  { bf16_t* kd = (bf16_t*)(ws + WS_KD);
    for (int e = bid * NTHR + tid; e < 65536; e += nb * NTHR) { int n = e >> 8, k = e & 255; float v = 0.f;
      if (n < 128 && k < 128) v = p.in[21][n * 128 + k]; else if (n >= 128 && k >= 128) v = p.in[22][(n - 128) * 128 + (k - 128)];
      kd[(size_t)(k >> 6) * 16384 + n * 64 + (k & 63)] = f2bf(v); } }
}

constexpr int WT_STRIDE = 144, WT_BYTES = 32 * WT_STRIDE;
DI void wt_write(char* wl, const f32x16& a0, const f32x16& a1, int r, int hh, float scale) {
  char* bp = wl + (4 * hh) * WT_STRIDE + r * 2;
#pragma unroll
  for (int reg = 0; reg < 16; ++reg) { const int ro = ((reg & 3) + 8 * (reg >> 2)) * WT_STRIDE;
    *(bf16_t*)(bp + ro) = f2bf(a0[reg] * scale); *(bf16_t*)(bp + ro + 64) = f2bf(a1[reg] * scale); }
}
DI void wt_write_rope(char* wl, const f32x16& a0, const f32x16& a1, int r, int hh, const float* cs, const float* sn, int m0) {
  char* bp = wl + (4 * hh) * WT_STRIDE + r * 2;
#pragma unroll
  for (int reg = 0; reg < 16; ++reg) { const int rw = (reg & 3) + 8 * (reg >> 2); const int row = m0 + rw + 4 * hh;
    const float c = cs[row * 32 + r], s = sn[row * 32 + r];
    *(bf16_t*)(bp + rw * WT_STRIDE) = f2bf(a0[reg] * c - a1[reg] * s); *(bf16_t*)(bp + rw * WT_STRIDE + 64) = f2bf(a1[reg] * c + a0[reg] * s); }
}
DI void wt_store(const char* wl, int lane, bf16_t* dA, int sA, bf16_t* dB, int sB) {
  const int piece = lane & 7, rsub = lane >> 3;
  bf16_t* d = (piece < 4) ? dA : dB; const int st = (piece < 4) ? sA : sB;
  if (d) {
#pragma unroll
    for (int i = 0; i < 4; ++i) { const int row = i * 8 + rsub; const uint4 v = *(const uint4*)(wl + row * WT_STRIDE + piece * 16);
      *(uint4*)(d + (size_t)row * st + (piece & 3) * 8) = v; }
  }
}
#define LDS_FENCE() asm volatile("s_waitcnt lgkmcnt(0)" ::: "memory")
DI int lv(int x) { asm volatile("" : "+v"(x)); return x; }
template <class T> DI T* launder(T* q) { size_t z = 0; asm volatile("" : "+s"(z)); return (T*)((char*)q + z); }

constexpr int GL_GR = 0, GL_VT = 8192, GL_QD = 26624, GL_KI = 45056, GL_KIT = 63488, GL_ATT = 81920, GL_TOT = 91136, GL_DEC = 93184, GL_LA = 93696  , GL_QS = 126464  , GL_KS = 134656;
DI void gla_chunk_local(const KP& p, char* lds, unsigned char* ws, int tile, const bf16_t* PA, const bf16_t* PB) {
  const int tid = lv(threadIdx.x), lane = tid & 63, w = tid >> 6, r = lane & 31, hh = lane >> 5;
  const int b = tile >> 5, n = tile & 31, tok0 = tile * 64;
  float* GRL = (float*)(lds + GL_GR); float* TOT = (float*)(lds + GL_TOT); float* DECL = (float*)(lds + GL_DEC);
  __syncthreads();
#pragma unroll
  for (int i = 0; i < 4; ++i) { const int e = tid + 512 * i; GRL[e] = bf2f(PB[(size_t)(e >> 5) * 1024 + (O_GF - 1024) + (e & 31)]); }
#pragma unroll 1
  for (int h = 0; h < 4; ++h) {
    __syncthreads();
    { const int t = tid >> 3, c8 = (tid & 7) * 8;
      const uint4 qv4 = *(const uint4*)(PA + (size_t)t * 1024 + O_QG + h * 64 + c8);
      const uint4 kv4 = (h == 0) ? *(const uint4*)(PA + (size_t)t * 1024 + O_KG + c8) : *(const uint4*)(PB + (size_t)t * 1024 + (O_KG - 1024) + h * 64 + c8);
      uint4 vv4[2];
#pragma unroll
      for (int i = 0; i < 2; ++i) { const int c = tid + 512 * i, t2 = c >> 4, d8 = (c & 15) * 8; vv4[i] = *(const uint4*)(PB + (size_t)t2 * 1024 + (O_VG - 1024) + h * 128 + d8); }
      *(uint4*)(lds + GL_QS + (t * 64 + c8) * 2) = qv4; *(uint4*)(lds + GL_KS + (t * 64 + c8) * 2) = kv4;
#pragma unroll
    for (int i = 0; i < 2; ++i) { const int c = tid + 512 * i, t = c >> 4, d8 = (c & 15) * 8;
      const uint4 v = vv4[i];
      bf16_t* vt = (bf16_t*)(lds + GL_VT) + d8 * 72 + t;
      vt[0] = (bf16_t)(v.x & 0xffffu); vt[72] = (bf16_t)(v.x >> 16); vt[144] = (bf16_t)(v.y & 0xffffu); vt[216] = (bf16_t)(v.y >> 16);
      vt[288] = (bf16_t)(v.z & 0xffffu); vt[360] = (bf16_t)(v.z >> 16); vt[432] = (bf16_t)(v.w & 0xffffu); vt[504] = (bf16_t)(v.w >> 16); } }
    const int dir = tid >> 8, qt = (tid >> 6) & 3, dk = tid & 63, col = h * 64 + dk;
    float* LAL = (float*)(lds + GL_LA) + tid;
    {
      const float* wg = launder(dir ? p.in[14] : p.in[12]); const float* bg = launder(dir ? p.in[15] : p.in[13]);
      float wr[16];
#pragma unroll
      for (int q = 0; q < 16; ++q) wr[q] = wg[q * 256 + col];
      const float bias = bg[col];
      float run = 0.f;
#pragma unroll 2
      for (int ii = 0; ii < 16; ++ii) { const int i = dir ? 15 - ii : ii;
        const float* gp = GRL + (qt * 16 + i) * 32 + dir * 16; float x = bias;
#pragma unroll
        for (int q = 0; q < 16; ++q) x += gp[q] * wr[q];
        run += logsigmoid_fast(x) * (1.f / 16.f); LAL[i * 512] = run; }
      TOT[(dir * 64 + dk) * 4 + qt] = run;
    }
    __syncthreads();
    {
      const float4 tq = *(const float4*)(TOT + (dir * 64 + dk) * 4);
      const float total = (tq.x + tq.y) + (tq.z + tq.w);
      float off;
      if (dir == 0) off = (qt > 0 ? tq.x : 0.f) + (qt > 1 ? tq.y : 0.f) + (qt > 2 ? tq.z : 0.f);
      else          off = (qt < 1 ? tq.y : 0.f) + (qt < 2 ? tq.z : 0.f) + (qt < 3 ? tq.w : 0.f);
      if (qt == 0) { const float dc = fexp(total); DECL[dir * 64 + dk] = dc; ((float*)(ws + WS_DEC))[((size_t)((b * 4 + h) * 2 + dir) * 32 + n) * 64 + dk] = dc; }
      bf16_t* QD = (bf16_t*)(lds + GL_QD + dir * 9216) + (qt * 16) * 72 + dk; bf16_t* KI = (bf16_t*)(lds + GL_KI + dir * 9216) + (qt * 16) * 72 + dk;
      bf16_t* KIT = (bf16_t*)(lds + GL_KIT + dir * 9216) + dk * 72 + qt * 16;
      bf16_t* qdg = (bf16_t*)(ws + WS_QDEC) + (size_t)((tile * 4 + h) * 2 + dir) * 4096 + (qt * 16) * 64 + dk;
      const bf16_t* qgp = (const bf16_t*)(lds + GL_QS) + (qt * 16) * 64 + dk; const bf16_t* kgp = (const bf16_t*)(lds + GL_KS) + (qt * 16) * 64 + dk;
#pragma unroll 2
      for (int i = 0; i < 16; ++i) { const float bb = off + LAL[i * 512];
        const float qv = bf2f(qgp[i * 64]) * 0.125f, kv = bf2f(kgp[i * 64]);
        const float eb = fexp(bb); const bf16_t qd = f2bf(qv * eb), ki = f2bf(kv * __builtin_amdgcn_rcpf(eb));
        QD[i * 72] = qd; KI[i * 72] = ki; qdg[i * 64] = qd; KIT[i] = ki; }
    }
    __syncthreads();
    if (w < 4) { const int mi = w >> 1, ni = w & 1;
      f32x16 asum;
#pragma unroll
      for (int i = 0; i < 16; ++i) asum[i] = 0.f;
#pragma unroll
      for (int d = 0; d < 2; ++d) { f32x16 acc;
#pragma unroll
        for (int i = 0; i < 16; ++i) acc[i] = 0.f;
#pragma unroll
        for (int s = 0; s < 4; ++s) { const bf16x8 a = *(const bf16x8*)(lds + GL_QD + d * 9216 + (mi * 32 + r) * 144 + s * 32 + hh * 16);
          const bf16x8 bb = *(const bf16x8*)(lds + GL_KI + d * 9216 + (ni * 32 + r) * 144 + s * 32 + hh * 16); acc = MFMA32(a, bb, acc); }
#pragma unroll
        for (int reg = 0; reg < 16; ++reg) { const int ti = mi * 32 + crow(reg, hh), tj = ni * 32 + r; const bool keep = d ? (tj >= ti) : (tj <= ti); asum[reg] += keep ? acc[reg] : 0.f; } }
      bf16_t* at = (bf16_t*)(lds + GL_ATT) + (mi * 32 + 4 * hh) * 72 + ni * 32 + r;
#pragma unroll
      for (int reg = 0; reg < 16; ++reg) at[((reg & 3) + 8 * (reg >> 2)) * 72] = f2bf(asum[reg]);
    }
    __syncthreads();
    { const int mi = w >> 2, ni = w & 3; f32x16 acc;
#pragma unroll
      for (int i = 0; i < 16; ++i) acc[i] = 0.f;
#pragma unroll
      for (int s = 0; s < 4; ++s) { const bf16x8 a = *(const bf16x8*)(lds + GL_ATT + (mi * 32 + r) * 144 + s * 32 + hh * 16);
        const bf16x8 bb = *(const bf16x8*)(lds + GL_VT + (ni * 32 + r) * 144 + s * 32 + hh * 16); acc = MFMA32(a, bb, acc); }
      bf16_t* oi = (bf16_t*)(ws + WS_OINTRA) + (size_t)(tok0 + mi * 32 + 4 * hh) * 512 + h * 128 + ni * 32 + r;
#pragma unroll
      for (int reg = 0; reg < 16; ++reg) oi[(size_t)((reg & 3) + 8 * (reg >> 2)) * 512] = f2bf(acc[reg]); }
    { const int dvb = w >> 1, dkb = w & 1;
#pragma unroll
      for (int d = 0; d < 2; ++d) { f32x16 acc;
#pragma unroll
        for (int i = 0; i < 16; ++i) acc[i] = 0.f;
#pragma unroll
        for (int s = 0; s < 4; ++s) { const bf16x8 a = *(const bf16x8*)(lds + GL_VT + (dvb * 32 + r) * 144 + s * 32 + hh * 16);
          const bf16x8 bb = *(const bf16x8*)(lds + GL_KIT + d * 9216 + (dkb * 32 + r) * 144 + s * 32 + hh * 16); acc = MFMA32(a, bb, acc); }
        const float sc = DECL[d * 64 + dkb * 32 + r];
        bf16_t* ds = (bf16_t*)(ws + WS_SPT) + ((size_t)((b * 4 + h) * 2 + d) * 32 + n) * 8192 + (size_t)(dvb * 32 + 4 * hh) * 64 + dkb * 32 + r;
#pragma unroll
        for (int reg = 0; reg < 16; ++reg) ds[((reg & 3) + 8 * (reg >> 2)) * 64] = f2bf(acc[reg] * sc); } }
  }
}

DI void phase1a(const KP& p, char* lds) {
  const int tid = threadIdx.x, lane = tid & 63, w = tid >> 6;
  for (int tile = blockIdx.x; tile < 256; tile += gridDim.x) {
    unsigned char* ws = launder(p.ws); unsigned char* ob = (unsigned char*)launder(p.out); const float* xin = launder(p.in[0]);
    const float* mod = (const float*)(ws + WS_MOD);
    const int tok0 = tile * 64, b = tile >> 5;
    bf16_t* Hs = (bf16_t*)(ob + OUT_HS) + (size_t)tok0 * 1024;
    float4 ge[4], sh[4];
    const float* gpre = launder(p.in[5]); const float* modb = launder(mod) + b * 6144;
#pragma unroll
    for (int i = 0; i < 4; ++i) { const int d = (lane + 64 * i) * 4;
      const float4 g = *(const float4*)(gpre + d); const float4 sc = *(const float4*)(modb + 1024 + d); sh[i] = *(const float4*)(modb + d);
      ge[i] = make_float4(g.x * (1.f + sc.x), g.y * (1.f + sc.y), g.z * (1.f + sc.z), g.w * (1.f + sc.w)); }
#pragma unroll 1
    for (int g = 0; g < 2; ++g) {
      float4 v[4][4];
#pragma unroll
      for (int rr = 0; rr < 4; ++rr) { const float* xr = xin + (size_t)(tok0 + w * 8 + g * 4 + rr) * 1024;
#pragma unroll
        for (int i = 0; i < 4; ++i) v[rr][i] = *(const float4*)(xr + (lane + 64 * i) * 4); }
#pragma unroll
      for (int rr = 0; rr < 4; ++rr) { const int row = w * 8 + g * 4 + rr; float ss = 0.f;
#pragma unroll
        for (int i = 0; i < 4; ++i) ss += v[rr][i].x * v[rr][i].x + v[rr][i].y * v[rr][i].y + v[rr][i].z * v[rr][i].z + v[rr][i].w * v[rr][i].w;
        ss = wave_sum(ss); const float rs = rsqrtf(ss * (1.f / 1024.f) + EPS);
#pragma unroll
        for (int i = 0; i < 4; ++i) { uint2 o; o.x = pack2(v[rr][i].x * rs * ge[i].x + sh[i].x, v[rr][i].y * rs * ge[i].y + sh[i].y); o.y = pack2(v[rr][i].z * rs * ge[i].z + sh[i].z, v[rr][i].w * rs * ge[i].w + sh[i].w);
          *(uint2*)(Hs + (size_t)row * 1024 + (lane + 64 * i) * 4) = o; }
      }
    }
  }
}

DI void phase1c(const KP& p, char* lds) {
  const int tid = threadIdx.x, lane = tid & 63, w = tid >> 6, r = lane & 31, hh = lane >> 5;
  float* cs = (float*)(lds + LDS_TAB); float* sn = cs + 2048;
  char* wl = lds + LDS_WT + (w & 3) * WT_BYTES;
  for (int tile = blockIdx.x; tile < 256; tile += gridDim.x) {
    unsigned char* ws = launder(p.ws); unsigned char* ob = (unsigned char*)launder(p.out);
    const int tok0 = tile * 64, b = tile >> 5, t0 = (tile & 31) * 64;
    const bf16_t* PA = (const bf16_t*)(ws + WS_P1S) + (size_t)tok0 * 1024;
    const bf16_t* PB = (const bf16_t*)(ob + 32 * MiB) + (size_t)tok0 * 1024;
    const bf16_t* PC = (const bf16_t*)(ws + WS_PROJC) + (size_t)tok0 * 256;
    bf16_t* Hs = (bf16_t*)(ob + OUT_HS) + (size_t)tok0 * 1024;
    bf16_t* CQN = Hs; bf16_t* CKVN = Hs + 64 * 384;
    bf16_t* Qm = (bf16_t*)(ws + WS_QM); bf16_t* Km = (bf16_t*)(ws + WS_KM); bf16_t* Vm = (bf16_t*)(ws + WS_VM);
    bf16_t* rg = (bf16_t*)(ws + WS_RG) + (size_t)tok0 * 512;
    __syncthreads();
#pragma unroll
    for (int i = 0; i < 4; ++i) { const int e = tid + 512 * i, tt = e >> 5, j = e & 31;
      const float inv = __builtin_amdgcn_exp2f(-(float)j * (13.287712379549449f / 32.f)); const float ang = (float)((const int*)p.in[2])[tok0 + tt] * inv;
      float rev = ang * 0.15915494309189535f; rev -= floorf(rev);
      cs[e] = __builtin_amdgcn_cosf(rev); sn[e] = __builtin_amdgcn_sinf(rev); }
    { bf16x8 v[8];
#pragma unroll
      for (int i = 0; i < 8; ++i) { const int c = tid + 512 * i, row = c >> 6, cc = c & 63;
        const bf16_t* sp = (cc < 36) ? PB + (size_t)row * 1024 + (O_R - 1024) + cc * 8 : PC + (size_t)row * 256 + (cc - 36) * 8; v[i] = *(const bf16x8*)sp; }
#pragma unroll
      for (int i = 0; i < 8; ++i) { const int c = tid + 512 * i, row = c >> 6, cc = c & 63;
        *(bf16x8*)(rg + (size_t)row * 512 + cc * 8) = v[i]; } }
    __syncthreads();
    if (tid < 256) { const int row = tid >> 2, pc = tid & 3;
      const uint4 x1 = *(const uint4*)(PA + (size_t)row * 1024 + O_KR + pc * 8), x2 = *(const uint4*)(PA + (size_t)row * 1024 + O_KR + 32 + pc * 8);
      const float4 c0 = *(const float4*)(cs + row * 32 + pc * 8), c1 = *(const float4*)(cs + row * 32 + pc * 8 + 4), s0 = *(const float4*)(sn + row * 32 + pc * 8), s1 = *(const float4*)(sn + row * 32 + pc * 8 + 4);
#define RO1(a_, b_, c_, s_) ((a_) * (c_) - (b_) * (s_))
#define RO2(a_, b_, c_, s_) ((b_) * (c_) + (a_) * (s_))
#define LO(u_) __uint_as_float((u_) << 16)
#define HI(u_) __uint_as_float((u_) & 0xffff0000u)
      uint4 o1, o2;
      o1.x = pack2(RO1(LO(x1.x), LO(x2.x), c0.x, s0.x), RO1(HI(x1.x), HI(x2.x), c0.y, s0.y)); o1.y = pack2(RO1(LO(x1.y), LO(x2.y), c0.z, s0.z), RO1(HI(x1.y), HI(x2.y), c0.w, s0.w));
      o1.z = pack2(RO1(LO(x1.z), LO(x2.z), c1.x, s1.x), RO1(HI(x1.z), HI(x2.z), c1.y, s1.y)); o1.w = pack2(RO1(LO(x1.w), LO(x2.w), c1.z, s1.z), RO1(HI(x1.w), HI(x2.w), c1.w, s1.w));
      o2.x = pack2(RO2(LO(x1.x), LO(x2.x), c0.x, s0.x), RO2(HI(x1.x), HI(x2.x), c0.y, s0.y)); o2.y = pack2(RO2(LO(x1.y), LO(x2.y), c0.z, s0.z), RO2(HI(x1.y), HI(x2.y), c0.w, s0.w));
      o2.z = pack2(RO2(LO(x1.z), LO(x2.z), c1.x, s1.x), RO2(HI(x1.z), HI(x2.z), c1.y, s1.y)); o2.w = pack2(RO2(LO(x1.w), LO(x2.w), c1.z, s1.z), RO2(HI(x1.w), HI(x2.w), c1.w, s1.w));
#undef RO1
#undef RO2
#undef LO
#undef HI
#pragma unroll
      for (int h = 0; h < 4; ++h) { bf16_t* kp = Km + (((size_t)b * 4 + h) * SEQ + t0 + row) * 192 + 128 + pc * 8; *(uint4*)kp = o1; *(uint4*)(kp + 32) = o2; }
    }
    const float* gq = launder(p.in[8]); const float* gkv = launder(p.in[10]);
#pragma unroll 2
    for (int rr = 0; rr < 8; ++rr) { const int row = w * 8 + rr; const unsigned* cr = (const unsigned*)(PA + (size_t)row * 1024);
      float v0[5], v1[5];
#pragma unroll
      for (int i = 0; i < 5; ++i) { const unsigned u = cr[lane + 64 * i]; v0[i] = __uint_as_float(u << 16); v1[i] = __uint_as_float(u & 0xffff0000u); }
      float ss = v0[0] * v0[0] + v1[0] * v1[0] + v0[1] * v0[1] + v1[1] * v1[1] + v0[2] * v0[2] + v1[2] * v1[2];
      float s2 = v0[3] * v0[3] + v1[3] * v1[3] + v0[4] * v0[4] + v1[4] * v1[4];
      ss = wave_sum(ss); s2 = wave_sum(s2);
      const float rq = rsqrtf(ss * (1.f / 384.f) + EPS), rk = rsqrtf(s2 * (1.f / 256.f) + EPS);
#pragma unroll
      for (int i = 0; i < 3; ++i) { const int c = 2 * (lane + 64 * i); *(unsigned*)(CQN + (size_t)row * 384 + c) = pack2(v0[i] * rq * gq[c], v1[i] * rq * gq[c + 1]); }
#pragma unroll
      for (int i = 3; i < 5; ++i) { const int c = 2 * (lane + 64 * (i - 3)); *(unsigned*)(CKVN + (size_t)row * 256 + c) = pack2(v0[i] * rk * gkv[c], v1[i] * rk * gkv[c + 1]); }
    }
    __syncthreads();
    block_gemm<3>(lds, CQN, 384, (const bf16_t*)(ws + WS_WTQUP), 3, 384, [&](int m0, int n0, const f32x16& a0, const f32x16& a1) {
      const int r2 = lv(r), h2 = lv(hh), ln = lv(lane);
      const int h = n0 / 192, d0 = n0 % 192;
      bf16_t* qp = Qm + (((size_t)b * 4 + h) * SEQ + t0 + m0) * 192 + d0;
      if (d0 < 128) wt_write(wl, a0, a1, r2, h2, 1.f); else wt_write_rope(wl, a0, a1, r2, h2, cs, sn, m0);
      LDS_FENCE();
      wt_store(wl, ln, qp, 192, qp + 32, 192);
    });
    block_gemm<3>(lds, CKVN, 256, (const bf16_t*)(ws + WS_WTKVUP), 4, 256, [&](int m0, int n0, const f32x16& a0, const f32x16& a1) {
      const int r2 = lv(r), h2 = lv(hh), ln = lv(lane);
      const int h = n0 >> 8, d0 = n0 & 255;
      wt_write(wl, a0, a1, r2, h2, 1.f); LDS_FENCE();
      if (d0 < 128) { bf16_t* kp = Km + (((size_t)b * 4 + h) * SEQ + t0 + m0) * 192 + d0; wt_store(wl, ln, kp, 192, kp + 32, 192); }
      else { bf16_t* vp = Vm + (((size_t)b * 4 + h) * SEQ + t0 + m0) * 128 + (d0 - 128); wt_store(wl, ln, vp, 128, vp + 32, 128); }
    });
    gla_chunk_local(p, lds, ws, tile, PA, PB);
  }
}

namespace att {
typedef short s16x4 __attribute__((ext_vector_type(4)));
typedef unsigned u32x4 __attribute__((ext_vector_type(4)));
constexpr int DQ = 192, DV = 128, KVBLK = 64;
constexpr float SCALE = 0.07216878364870322f;
constexpr float THR = 8.f;
constexpr int SHM_V = KVBLK * DV * 2, SHM_K = KVBLK * DQ * 2;
constexpr int SHM_QR = 8 * 32 * 176;
constexpr int SHM_ATTN = 2 * SHM_V + 2 * SHM_K + 8 * 64 * 4 + SHM_QR;
#define KSWZ(row, colB) ((row) * 384 + ((colB) ^ (((row) & 7) << 4)))
#define SBAR() __builtin_amdgcn_sched_barrier(0)
DI unsigned cvtpk(float lo, float hi) { unsigned r; asm volatile("v_cvt_pk_bf16_f32 %0, %1, %2" : "=v"(r) : "v"(lo), "v"(hi)); return r; }

DI void partialSM(f32x16& p0, f32x16& p1, float& m_reg, float& mn, float& alpha) {
  constexpr float C = SCALE * 1.4426950408889634f;
  float pmax = p0[0];
#pragma unroll
  for (int r = 1; r < 16; ++r) pmax = fmaxf(pmax, p0[r]);
#pragma unroll
  for (int r = 0; r < 16; ++r) pmax = fmaxf(pmax, p1[r]);
  { auto rr = __builtin_amdgcn_permlane32_swap(__float_as_uint(pmax), __float_as_uint(pmax), false, false);
    pmax = fmaxf(__uint_as_float(rr[0]), __uint_as_float(rr[1])); }
  if (__builtin_expect(__all(pmax - m_reg <= THR / SCALE), 1)) { mn = m_reg; alpha = 1.f; }
  else { mn = fmaxf(m_reg, pmax); alpha = __builtin_amdgcn_exp2f((m_reg - mn) * C); m_reg = mn; }
  const float mnC = -mn * C;
#pragma unroll
  for (int r = 0; r < 16; ++r) p0[r] = fmaf(p0[r], C, mnC);
#pragma unroll
  for (int r = 0; r < 16; ++r) p1[r] = fmaf(p1[r], C, mnC);
#pragma unroll
  for (int r = 0; r < 16; ++r) p0[r] = __builtin_amdgcn_exp2f(p0[r]);
}
DI void finishSM(f32x16& p0, f32x16& p1, float alpha, float& l_reg, bf16x8& pa0, bf16x8& pa1, bf16x8& pa2, bf16x8& pa3) {
#pragma unroll
  for (int r = 0; r < 16; ++r) p1[r] = __builtin_amdgcn_exp2f(p1[r]);
  float ps = 0;
#pragma unroll
  for (int r = 0; r < 16; ++r) ps += p0[r];
#pragma unroll
  for (int r = 0; r < 16; ++r) ps += p1[r];
  { auto rr = __builtin_amdgcn_permlane32_swap(__float_as_uint(ps), __float_as_uint(ps), false, false);
    ps = __uint_as_float(rr[0]) + __uint_as_float(rr[1]); }
  l_reg = l_reg * alpha + ps;
#define PK4(P, BASE, OUT) do { unsigned a0 = cvtpk(P[BASE + 0], P[BASE + 1]), a1 = cvtpk(P[BASE + 2], P[BASE + 3]);   \
    unsigned b0 = cvtpk(P[BASE + 4], P[BASE + 5]), b1 = cvtpk(P[BASE + 6], P[BASE + 7]);                              \
    auto r0 = __builtin_amdgcn_permlane32_swap(a0, b0, false, false); auto r1 = __builtin_amdgcn_permlane32_swap(a1, b1, false, false); \
    u32x4 wv = {r0[0], r1[0], r0[1], r1[1]}; OUT = *reinterpret_cast<bf16x8*>(&wv); } while (0)
  PK4(p0, 0, pa0); PK4(p0, 8, pa1); PK4(p1, 0, pa2); PK4(p1, 8, pa3);
#undef PK4
}
DI void qkt(f32x16& p0, f32x16& p1, const char* Ks, const bf16x8* qr, const char* qrl, int r32, int hi) {
#pragma unroll
  for (int i = 0; i < 16; ++i) { p0[i] = 0.f; p1[i] = 0.f; }
#pragma unroll
  for (int d0 = 0; d0 < 12; ++d0) { const int cb = (d0 * 16 + hi * 8) * 2;
    const bf16x8 b0 = *reinterpret_cast<const bf16x8*>(Ks + KSWZ(r32, cb));
    const bf16x8 b1 = *reinterpret_cast<const bf16x8*>(Ks + KSWZ(32 + r32, cb));
    const bf16x8 q = (d0 < 7) ? qr[d0 < 7 ? d0 : 0] : *reinterpret_cast<const bf16x8*>(qrl + (d0 - 7) * 32);
    p0 = MFMA32(b0, q, p0);
    p1 = MFMA32(b1, q, p1); }
}
DI int v_st(int k, int c) { const int kk = (k & ~0xC) | ((k & 4) << 1) | ((k & 8) >> 1); return ((kk >> 3) * 4 + (c >> 5)) * 512 + ((kk & 7) * 32 + (c & 31)) * 2; }
DI int v_rd_base(int lane) { return ((lane & 3) << 3) | (((lane >> 2) & 3) << 6) | (((lane >> 4) & 1) << 5) | (((lane >> 5) & 1) << 8); }
constexpr int v_rd_off(int d0, int ks, int half) { return d0 * 512 + ks * 4096 + half * 2048; }
template <int OFF> DI s16x4 tr_read(int vb) { s16x4 r; asm volatile("ds_read_b64_tr_b16 %0, %1 offset:%2" : "=&v"(r) : "v"(vb), "i"(OFF) : "memory"); return r; }
template <int D0> DI void pv_one(f32x16& od, int vb, bf16x8 pa0, bf16x8 pa1, bf16x8 pa2, bf16x8 pa3) {
  const s16x4 l0 = tr_read<v_rd_off(D0, 0, 0)>(vb), h0 = tr_read<v_rd_off(D0, 0, 1)>(vb), l1 = tr_read<v_rd_off(D0, 1, 0)>(vb), h1 = tr_read<v_rd_off(D0, 1, 1)>(vb);
  const s16x4 l2 = tr_read<v_rd_off(D0, 2, 0)>(vb), h2 = tr_read<v_rd_off(D0, 2, 1)>(vb), l3 = tr_read<v_rd_off(D0, 3, 0)>(vb), h3 = tr_read<v_rd_off(D0, 3, 1)>(vb);
  asm volatile("s_waitcnt lgkmcnt(0)" ::: "memory"); SBAR();
#define PK(L, H) (bf16x8){L[0], L[1], L[2], L[3], H[0], H[1], H[2], H[3]}
  od = MFMA32(pa0, PK(l0, h0), od);
  od = MFMA32(pa1, PK(l1, h1), od);
  od = MFMA32(pa2, PK(l2, h2), od);
  od = MFMA32(pa3, PK(l3, h3), od);
#undef PK
}
DI void pv_d0(f32x16* o, int vb, bf16x8 pa0, bf16x8 pa1, bf16x8 pa2, bf16x8 pa3) {
  pv_one<0>(o[0], vb, pa0, pa1, pa2, pa3); pv_one<1>(o[1], vb, pa0, pa1, pa2, pa3); pv_one<2>(o[2], vb, pa0, pa1, pa2, pa3); pv_one<3>(o[3], vb, pa0, pa1, pa2, pa3);
}
DI void attn_unit(const bf16_t* Qb, const bf16_t* Kh, const bf16_t* Vh, bf16_t* Ob, int seq, char* lds) {
  const int tid = lv(threadIdx.x), wid = tid >> 6, lane = tid & 63, r32 = lane & 31, hi = lane >> 5;
  char* V_lds = lds; char* K_lds = lds + 2 * SHM_V;
  float* wsf = (float*)(lds + 2 * SHM_V + 2 * SHM_K) + wid * 64; float* li_l = wsf; float* al_l = wsf + 32;
  char* qrl = lds + 2 * SHM_V + 2 * SHM_K + 8 * 64 * 4 + wid * (32 * 176) + r32 * 176 + hi * 16;
  float m_reg = -1e30f, l_reg = 0; f32x16 o[4]; bf16x8 qr[7];
#pragma unroll
  for (int d = 0; d < 4; ++d)
#pragma unroll
    for (int i = 0; i < 16; ++i) o[d][i] = 0.f;
  const bf16_t* Qw = Qb + (size_t)(wid * 32 + r32) * DQ + hi * 8;
#pragma unroll
  for (int d0 = 0; d0 < 7; ++d0) qr[d0] = *reinterpret_cast<const bf16x8*>(Qw + d0 * 16);
#pragma unroll
  for (int d0 = 7; d0 < 12; ++d0) *reinterpret_cast<bf16x8*>(qrl + (d0 - 7) * 32) = *reinterpret_cast<const bf16x8*>(Qw + d0 * 16);
  int kst[3];
#pragma unroll
  for (int i = 0; i < 3; ++i) { const int c = tid + 512 * i; kst[i] = KSWZ(c / 24, (c % 24) * 16); }
  const int vst0 = v_st(tid >> 4, (tid & 15) * 8), vst1 = v_st(32 + (tid >> 4), (tid & 15) * 8);
  const int vb0 = (int)(uintptr_t)V_lds + v_rd_base(lane);
  bf16x8 sk0, sk1, sk2, sv0, sv1;
#define SLOAD(k0) do { const bf16x8* kp = reinterpret_cast<const bf16x8*>(Kh + (size_t)(k0) * DQ) + tid; sk0 = kp[0]; sk1 = kp[512]; sk2 = kp[1024]; \
    const bf16x8* vp = reinterpret_cast<const bf16x8*>(Vh + (size_t)(k0) * DV) + tid; sv0 = vp[0]; sv1 = vp[512]; } while (0)
#define SWRITE(b) do { *(bf16x8*)(V_lds + (b) * SHM_V + vst0) = sv0; *(bf16x8*)(V_lds + (b) * SHM_V + vst1) = sv1; \
    *(bf16x8*)(K_lds + (b) * SHM_K + kst[0]) = sk0; *(bf16x8*)(K_lds + (b) * SHM_K + kst[1]) = sk1; *(bf16x8*)(K_lds + (b) * SHM_K + kst[2]) = sk2; } while (0)
#define RESC(a) do { if (__any((a) < 1.f)) { if (hi == 0) al_l[r32] = (a); asm volatile("s_waitcnt lgkmcnt(0)" ::: "memory"); \
    _Pragma("unroll") for (int d = 0; d < 4; ++d) _Pragma("unroll") for (int r = 0; r < 16; ++r) o[d][r] *= al_l[crow(r, hi)]; } } while (0)
  f32x16 pA0, pA1, pB0, pB1; float mnA, mnB, alA, alB; bf16x8 pa0, pa1, pa2, pa3; const int NT = seq / KVBLK;
  SLOAD(0); SWRITE(0); __syncthreads();
  qkt(pA0, pA1, K_lds, qr, qrl, r32, hi); partialSM(pA0, pA1, m_reg, mnA, alA);
  SLOAD(KVBLK); SWRITE(1); __syncthreads();
  for (int j = 1; j + 1 < NT; j += 2) {
    SBAR(); qkt(pB0, pB1, K_lds + SHM_K, qr, qrl, r32, hi);
    finishSM(pA0, pA1, alA, l_reg, pa0, pa1, pa2, pa3); SBAR();
    SLOAD((j + 1) * KVBLK); SBAR();
    pv_d0(o, vb0, pa0, pa1, pa2, pa3); partialSM(pB0, pB1, m_reg, mnB, alB);
    __syncthreads(); SWRITE(0);
    RESC(alB); __syncthreads();
    SBAR(); qkt(pA0, pA1, K_lds, qr, qrl, r32, hi);
    finishSM(pB0, pB1, alB, l_reg, pa0, pa1, pa2, pa3); SBAR();
    SLOAD((j + 2) * KVBLK); SBAR();
    pv_d0(o, vb0 + SHM_V, pa0, pa1, pa2, pa3); partialSM(pA0, pA1, m_reg, mnA, alA);
    __syncthreads(); SWRITE(1);
    RESC(alA); __syncthreads();
  }
  SBAR(); qkt(pB0, pB1, K_lds + SHM_K, qr, qrl, r32, hi);
  finishSM(pA0, pA1, alA, l_reg, pa0, pa1, pa2, pa3); SBAR();
  pv_d0(o, vb0, pa0, pa1, pa2, pa3); partialSM(pB0, pB1, m_reg, mnB, alB);
  __syncthreads(); RESC(alB);
  finishSM(pB0, pB1, alB, l_reg, pa0, pa1, pa2, pa3); SBAR();
  pv_d0(o, vb0 + SHM_V, pa0, pa1, pa2, pa3);
  if (hi == 0) li_l[r32] = l_reg; asm volatile("s_waitcnt lgkmcnt(0)" ::: "memory");
  float rli[16];
#pragma unroll
  for (int r = 0; r < 16; ++r) rli[r] = __builtin_amdgcn_rcpf(li_l[crow(r, hi)]);
  bf16_t* Ow = Ob + (size_t)(wid * 32) * 1024;
#pragma unroll
  for (int r = 0; r < 16; ++r) { const int orow = crow(r, hi);
#pragma unroll
    for (int d0 = 0; d0 < 4; ++d0) Ow[(size_t)orow * 1024 + d0 * 32 + r32] = f2bf(o[d0][r] * rli[r]); }
  __syncthreads();
#undef SLOAD
#undef SWRITE
#undef RESC
}
}

DI void phase2_attn(const KP& p, char* lds) {
  for (int u = blockIdx.x; u < 256; u += gridDim.x) {
    unsigned char* ws = launder(p.ws);
    const bf16_t* Qm = (const bf16_t*)(ws + WS_QM); const bf16_t* Km = (const bf16_t*)(ws + WS_KM); const bf16_t* Vm = (const bf16_t*)(ws + WS_VM);
    bf16_t* mixa = (bf16_t*)(ws + WS_P1S);
    const int qb = u & 7, bh = u >> 3, b = bh >> 2, h = bh & 3;
    att::attn_unit(Qm + ((size_t)bh * SEQ + qb * 256) * 192, Km + (size_t)bh * SEQ * 192, Vm + (size_t)bh * SEQ * 128,
                   mixa + ((size_t)b * SEQ + qb * 256) * 1024 + h * 128, SEQ, lds);
  }
}

namespace pg8 {
#define PG8_LAS __attribute__((address_space(3)))
typedef unsigned short bf16_t;
typedef short bf16x8 __attribute__((ext_vector_type(8)));
typedef float f32x4 __attribute__((ext_vector_type(4)));
typedef unsigned u32x4 __attribute__((ext_vector_type(4)));
constexpr int BM = 256, BK = 64, HALF = 128, HTB = HALF * BK * 2  , STAGE_BYTES = 8 * HTB, NXCD = 8, WGM = 8;

__host__ __device__ __forceinline__ int lds_byte(int r, int c) { const int st = (r >> 4) * 2 + (c >> 5), rr = r & 15, cc = c & 31, ob = rr * 64 + cc * 2; return st * 1024 + (ob ^ (((ob >> 9) & 1) << 5)); }
__host__ __device__ __forceinline__ void stage_rc(int b, int& R, int& C) { const int st = b / 1024, sb = b % 1024, swz = sb ^ (((sb >> 9) & 1) << 5); R = (st >> 1) * 16 + swz / 64; C = (st & 1) * 32 + (swz % 64) / 2; }
__host__ __device__ __forceinline__ int perm32(int rho) { const int n = rho >> 4, i = rho & 15; return 8 * (i >> 2) + 4 * n + (i & 3); }

struct Unit { int pm, pn; };
struct Gemm { const bf16_t* A; const bf16_t* Bt; int M, N, K; };

struct StaticOrder {
    int nM, nN, nwg, G, c;
    __host__ __device__ void init(int M, int N, int G_, int c_) { nM = M / BM; nN = N / BM; nwg = nM * nN; G = G_; c = c_; }
    __host__ __device__ bool next(int i, Unit& u) const {
        const long L = (long)i * G + c; if (L >= nwg) return false;
        int wgid = (int)L; { const int q = nwg / NXCD, r = nwg % NXCD, xcd = wgid % NXCD, off = wgid / NXCD; wgid = (xcd < r ? xcd * (q + 1) : r * (q + 1) + (xcd - r) * q) + off; }
        const int nig = WGM * nN, gid = wgid / nig, fm = gid * WGM, gsz = (nM - fm) < WGM ? (nM - fm) : WGM;
        u.pm = fm + ((wgid % nig) % gsz); u.pn = (wgid % nig) / gsz; return true;
    }
    __device__ __forceinline__ void a_ready(const Unit&) const {}
    __device__ __forceinline__ void done(const Unit&) const {}
};

__device__ __forceinline__ unsigned cvt_pk_bf16(float lo, float hi) { unsigned r; asm volatile("v_cvt_pk_bf16_f32 %0, %1, %2" : "=v"(r) : "v"(lo), "v"(hi)); return r; }
typedef float f32x2 __attribute__((ext_vector_type(2)));
__device__ __forceinline__ f32x2 gelu_pk(f32x2 v) {
    const f32x2 av = __builtin_elementwise_abs(v), d = av * 0.2316418882f + 1.0f;
    f32x2 t; t.x = __builtin_amdgcn_rcpf(d.x); t.y = __builtin_amdgcn_rcpf(d.y);
    f32x2 q = t * 0.5307027145f + (-0.7265760135f); q = q * t + 0.7107068705f; q = q * t + (-0.142248368f); q = q * t + 0.127414796f; q = q * t;
    const f32x2 s = (v * v) * (-0.72134752044f);
    f32x2 e; e.x = __builtin_amdgcn_exp2f(s.x); e.y = __builtin_amdgcn_exp2f(s.y);
    const f32x2 m = v * (q * e), r = v - m;
    f32x2 o; o.x = v.x < 0.f ? m.x : r.x; o.y = v.y < 0.f ? m.y : r.y; return o;
}

template <int ACT  > struct EpiBf16 {
    static constexpr bool PERM = true, AFTER_DRAIN = false; static_assert(ACT == 0 || ACT == 1, "EpiBf16: ACT is 0 (none) or 1 (gelu_pk)");
    bf16_t* O; int ldc; const float* bias; int split_cols; size_t split_stride; float scale0;
    __device__ __forceinline__ void operator()(const f32x4 (&acc)[2][2][4][2], const Unit& u, int wr, int wc, int fr, int fq) const {
        const int row0 = u.pm * BM + wr * 64 + fr; int colt = u.pn * BM; bf16_t* base = O;
        float sc = 1.f; if (split_cols) { const int t = colt / split_cols; base += (size_t)t * split_stride; colt -= t * split_cols; if (t == 0) sc = scale0; }
        const int col0 = colt + wc * 32 + 8 * fq, bcol0 = u.pn * BM + wc * 32 + 8 * fq;
        f32x4 bv[2][2];
#pragma unroll
        for (int bj = 0; bj < 2; ++bj)
#pragma unroll
            for (int n = 0; n < 2; ++n) bv[bj][n] = bias ? *(const f32x4*)(bias + bcol0 + bj * HALF + 4 * n) : (f32x4){0.f, 0.f, 0.f, 0.f};
#pragma unroll
        for (int ai = 0; ai < 2; ++ai)
#pragma unroll
            for (int m = 0; m < 4; ++m) { bf16_t* rowp = base + (size_t)(row0 + ai * HALF + m * 16) * ldc + col0;
#pragma unroll
                for (int bj = 0; bj < 2; ++bj) { f32x4 v0 = acc[ai][bj][m][0] + bv[bj][0], v1 = acc[ai][bj][m][1] + bv[bj][1];
                    if (ACT == 1) { f32x2 a = gelu_pk((f32x2){v0[0], v0[1]}), b = gelu_pk((f32x2){v0[2], v0[3]}), c = gelu_pk((f32x2){v1[0], v1[1]}), d = gelu_pk((f32x2){v1[2], v1[3]});
                        v0 = (f32x4){a.x, a.y, b.x, b.y}; v1 = (f32x4){c.x, c.y, d.x, d.y}; }
                    v0 = v0 * sc; v1 = v1 * sc; u32x4 w; w.x = cvt_pk_bf16(v0[0], v0[1]); w.y = cvt_pk_bf16(v0[2], v0[3]); w.z = cvt_pk_bf16(v1[0], v1[1]); w.w = cvt_pk_bf16(v1[2], v1[3]);
                    *(u32x4*)(rowp + bj * HALF) = w; } }
    }
};

template <class Epi, class Sched, bool ALIGN_EPI = false, bool SP2 = false>
__device__ __forceinline__ void gemm_phase(PG8_LAS unsigned char* lds, const Gemm g, const Sched& S, const Epi& E) {
    const int tid = threadIdx.x, wid = __builtin_amdgcn_readfirstlane(tid >> 6), lane = tid & 63, wr = wid >> 2, wc = wid & 3, fr = lane & 15, fq = lane >> 4;
    const int K = g.K, nt = K / BK;
    unsigned voffA[2], voffB[2];
#pragma unroll
    for (int i = 0; i < 2; ++i) { int R, C; stage_rc(tid * 16 + i * 8192, R, C); const int Rb = Epi::PERM ? ((R & ~31) + perm32(R & 31)) : R;
        voffA[i] = (unsigned)(R * K + C) * 2u; voffB[i] = (unsigned)(Rb * K + C) * 2u; }
    const size_t kstep = (size_t)(BK * 2);
    const size_t hstep = (size_t)HALF * K * 2;
    const size_t tstep = 2 * hstep;
    const unsigned ldsw = (unsigned)wid * 1024u;
    const int aoff = lds_byte(wr * 64 + fr, fq * 8), boff = lds_byte(wc * 32 + fr, fq * 8);
#define PG8_SA(b, h) (((b) * 2 + (h)) * HTB)
#define PG8_SB(b, h) ((4 + (b) * 2 + (h)) * HTB)
#define PG8_STAGE(bufoff, gbase, voff) do { _Pragma("unroll") for (int _i = 0; _i < 2; ++_i) \
        __builtin_amdgcn_global_load_lds((const unsigned*)((const char*)(gbase) + (voff)[_i]), (PG8_LAS unsigned*)(lds + (bufoff) + ldsw + _i * 8192), 16, 0, 0); } while (0)
#define PG8_LDA(dst, b, h) do { _Pragma("unroll") for (int m = 0; m < 4; ++m) _Pragma("unroll") for (int k = 0; k < 2; ++k) dst[m][k] = *(const PG8_LAS bf16x8*)(lds + PG8_SA(b, h) + aoff + m * 2048 + k * 1024); } while (0)
#define PG8_LDB(dst, b, h) do { _Pragma("unroll") for (int n = 0; n < 2; ++n) _Pragma("unroll") for (int k = 0; k < 2; ++k) dst[n][k] = *(const PG8_LAS bf16x8*)(lds + PG8_SB(b, h) + boff + n * 2048 + k * 1024); } while (0)
#define PG8_MMA(ai, bj, At, Bt) do { __builtin_amdgcn_s_setprio(1); _Pragma("unroll") for (int m = 0; m < 4; ++m) _Pragma("unroll") for (int n = 0; n < 2; ++n) _Pragma("unroll") for (int k = 0; k < 2; ++k) \
        acc[ai][bj][m][n] = __builtin_amdgcn_mfma_f32_16x16x32_bf16(Bt[n][k], At[m][k], acc[ai][bj][m][n], 0, 0, 0); __builtin_amdgcn_s_setprio(0); } while (0)
#define PG8_WAIT_V(n) asm volatile("s_waitcnt vmcnt(" #n ")" ::: "memory")
#define PG8_WAIT_L(n) asm volatile("s_waitcnt lgkmcnt(" #n ")" ::: "memory")
#define PG8_BAR __builtin_amdgcn_s_barrier()
#define PG8_SCHED __builtin_amdgcn_sched_barrier(0)
    Unit cur, nxt; int ui = 0;
    if (!S.next(0, cur)) return;
    f32x4 acc[2][2][4][2];
#pragma unroll
    for (int a = 0; a < 2; ++a)
#pragma unroll
        for (int b = 0; b < 2; ++b)
#pragma unroll
            for (int m = 0; m < 4; ++m)
#pragma unroll
                for (int n = 0; n < 2; ++n) acc[a][b][m][n] = (f32x4){0.f, 0.f, 0.f, 0.f};
    bf16x8 At[4][2], B0[2][2], B1[2][2];
    const char* cA = (const char*)g.A + (size_t)cur.pm * tstep; const char* cB = (const char*)g.Bt + (size_t)cur.pn * tstep;
    S.a_ready(cur);
    if constexpr (SP2) {
        PG8_STAGE(PG8_SB(0, 0), cB, voffB); PG8_STAGE(PG8_SB(0, 1), cB + hstep, voffB); PG8_STAGE(PG8_SA(0, 0), cA, voffA); PG8_STAGE(PG8_SA(0, 1), cA + hstep, voffA);
        if (wr == 1) PG8_BAR;
        PG8_WAIT_V(2); PG8_BAR;
        PG8_STAGE(PG8_SB(1, 0), cB + kstep, voffB); PG8_STAGE(PG8_SA(1, 0), cA + kstep, voffA); PG8_STAGE(PG8_SB(1, 1), cB + hstep + kstep, voffB);
        PG8_WAIT_V(6); PG8_BAR;
    } else {
        PG8_STAGE(PG8_SB(0, 0), cB, voffB); PG8_STAGE(PG8_SA(0, 0), cA, voffA); PG8_STAGE(PG8_SB(0, 1), cB + hstep, voffB); PG8_STAGE(PG8_SA(0, 1), cA + hstep, voffA);
        if (wr == 1) PG8_BAR;
        PG8_WAIT_V(4); PG8_BAR;
        PG8_STAGE(PG8_SB(1, 0), cB + kstep, voffB); PG8_STAGE(PG8_SA(1, 0), cA + kstep, voffA); PG8_STAGE(PG8_SB(1, 1), cB + hstep + kstep, voffB);
        PG8_WAIT_V(6); PG8_BAR;
    }
    for (;;) {
        const bool has_next = S.next(ui + 1, nxt);
        const char* nA = has_next ? (const char*)g.A + (size_t)nxt.pm * tstep : cA; const char* nB = has_next ? (const char*)g.Bt + (size_t)nxt.pn * tstep : cB;
        for (int t = 0; t < nt; t += 2) {
            const bool last = (t == nt - 2);
            const char* a1 = cA + (size_t)(t + 1) * kstep;
            const char* a2 = last ? nA : cA + (size_t)(t + 2) * kstep; const char* b2 = last ? nB : cB + (size_t)(t + 2) * kstep;
            const char* a3 = a2 + kstep; const char* b3 = b2 + kstep;
            if (last && has_next) S.a_ready(nxt);
            if constexpr (SP2) {
            PG8_LDB(B0, 0, 0); PG8_LDB(B1, 0, 1); PG8_SCHED; PG8_LDA(At, 0, 0); PG8_STAGE(PG8_SA(1, 1), a1 + hstep, voffA);
            PG8_WAIT_V(8); PG8_WAIT_L(0); PG8_BAR; PG8_MMA(0, 0, At, B0); PG8_MMA(0, 1, At, B1); PG8_BAR; PG8_SCHED;
            PG8_LDA(At, 0, 1); PG8_STAGE(PG8_SB(0, 0), b2, voffB); PG8_STAGE(PG8_SB(0, 1), b2 + hstep, voffB); PG8_STAGE(PG8_SA(0, 0), a2, voffA);
            PG8_WAIT_V(8); PG8_WAIT_L(0); PG8_BAR; PG8_MMA(1, 0, At, B0); PG8_MMA(1, 1, At, B1); PG8_BAR; PG8_SCHED;
            PG8_LDB(B0, 1, 0); PG8_LDB(B1, 1, 1); PG8_SCHED; PG8_LDA(At, 1, 0); PG8_STAGE(PG8_SA(0, 1), a2 + hstep, voffA);
            PG8_WAIT_V(8); PG8_WAIT_L(0); PG8_BAR; PG8_MMA(0, 0, At, B0); PG8_MMA(0, 1, At, B1); PG8_BAR; PG8_SCHED;
            PG8_LDA(At, 1, 1); PG8_STAGE(PG8_SB(1, 0), b3, voffB); PG8_STAGE(PG8_SB(1, 1), b3 + hstep, voffB); PG8_STAGE(PG8_SA(1, 0), a3, voffA);
            PG8_WAIT_V(8); PG8_WAIT_L(0); PG8_BAR; PG8_MMA(1, 0, At, B0); PG8_MMA(1, 1, At, B1); PG8_BAR; PG8_SCHED;
            } else {
            PG8_LDB(B0, 0, 0); PG8_SCHED; PG8_LDA(At, 0, 0); PG8_STAGE(PG8_SA(1, 1), a1 + hstep, voffA);
            PG8_WAIT_L(8); PG8_BAR; PG8_WAIT_L(0); PG8_MMA(0, 0, At, B0); PG8_BAR; PG8_SCHED;
            PG8_LDB(B1, 0, 1); PG8_STAGE(PG8_SB(0, 0), b2, voffB);
            PG8_BAR; PG8_WAIT_L(0); PG8_MMA(0, 1, At, B1); PG8_BAR;
            PG8_LDA(At, 0, 1); PG8_STAGE(PG8_SA(0, 0), a2, voffA);
            PG8_BAR; PG8_WAIT_L(0); PG8_MMA(1, 0, At, B0); PG8_BAR; PG8_SCHED;
            PG8_STAGE(PG8_SB(0, 1), b2 + hstep, voffB);
            PG8_WAIT_V(6); PG8_BAR; PG8_MMA(1, 1, At, B1); PG8_BAR;
            PG8_LDB(B0, 1, 0); PG8_SCHED; PG8_LDA(At, 1, 0); PG8_STAGE(PG8_SA(0, 1), a2 + hstep, voffA);
            PG8_WAIT_L(8); PG8_BAR; PG8_WAIT_L(0); PG8_MMA(0, 0, At, B0); PG8_BAR; PG8_SCHED;
            PG8_LDB(B1, 1, 1); PG8_STAGE(PG8_SB(1, 0), b3, voffB);
            PG8_BAR; PG8_WAIT_L(0); PG8_MMA(0, 1, At, B1); PG8_BAR;
            PG8_LDA(At, 1, 1); PG8_STAGE(PG8_SA(1, 0), a3, voffA);
            PG8_BAR; PG8_WAIT_L(0); PG8_MMA(1, 0, At, B0); PG8_BAR; PG8_SCHED;
            PG8_STAGE(PG8_SB(1, 1), b3 + hstep, voffB);
            PG8_WAIT_V(6); PG8_BAR; PG8_MMA(1, 1, At, B1); PG8_BAR;
            }
        }
        if constexpr (ALIGN_EPI) { if (wr == 0) PG8_BAR; }
        if constexpr (!Epi::AFTER_DRAIN) { E(acc, cur, wr, wc, fr, fq); S.done(cur); }
        if (!has_next) break;
#pragma unroll
        for (int a = 0; a < 2; ++a)
#pragma unroll
            for (int b = 0; b < 2; ++b)
#pragma unroll
                for (int m = 0; m < 4; ++m)
#pragma unroll
                    for (int n = 0; n < 2; ++n) acc[a][b][m][n] = (f32x4){0.f, 0.f, 0.f, 0.f};
        cur = nxt; cA = nA; cB = nB; ++ui;
        if constexpr (ALIGN_EPI) { if (wr == 1) PG8_BAR; }
    }
    PG8_WAIT_V(0);
    if constexpr (!ALIGN_EPI) { if (wr == 0) PG8_BAR; }
    PG8_BAR;
    if constexpr (Epi::AFTER_DRAIN) { E.fused(acc, cur, wr, wc, fr, fq, lds, wid, lane); S.done(cur); }
#undef PG8_SA
#undef PG8_SB
#undef PG8_STAGE
#undef PG8_LDA
#undef PG8_LDB
#undef PG8_MMA
#undef PG8_WAIT_V
#undef PG8_WAIT_L
#undef PG8_BAR
#undef PG8_SCHED
}
}


namespace pg8 {
struct EpiProj {
    static constexpr bool PERM = true, AFTER_DRAIN = false;
    bf16_t* P0; bf16_t* P1; bf16_t* P2;
    __device__ __forceinline__ void operator()(const f32x4 (&acc)[2][2][4][2], const Unit& u, int wr, int wc, int fr, int fq) const {
        const int row0 = u.pm * BM + wr * 64 + fr; const int colt = u.pn * BM;
        const long d1 = (long)(P1 - P0), d2 = (long)(P2 - P0); long dsel = 0; if (colt >= 1024) dsel = d1; if (colt >= 2048) dsel = d2;
        bf16_t* base = P0 + dsel; const int ldc = colt < 2048 ? 1024 : 256; const int cl = colt & 1023;
        const int col0 = cl + wc * 32 + 8 * fq;
#pragma unroll
        for (int ai = 0; ai < 2; ++ai)
#pragma unroll
            for (int m = 0; m < 4; ++m) { bf16_t* rowp = base + (size_t)(row0 + ai * HALF + m * 16) * ldc + col0;
#pragma unroll
                for (int bj = 0; bj < 2; ++bj) { const f32x4 v0 = acc[ai][bj][m][0], v1 = acc[ai][bj][m][1];
                    u32x4 w; w.x = cvt_pk_bf16(v0[0], v0[1]); w.y = cvt_pk_bf16(v0[2], v0[3]); w.z = cvt_pk_bf16(v1[0], v1[1]); w.w = cvt_pk_bf16(v1[2], v1[3]);
                    *(u32x4*)(rowp + bj * HALF) = w; } }
    }
};
}

constexpr int P3_TILE_BYTES = 256 * 1024;
constexpr int LDS_TK = 92160;
constexpr int GP_SH = 11, GP_N = 16384 >> GP_SH, GP_OS = GP_N + 1;
constexpr int LDS_OFF = 32768, LDS_CNT = 36864, LDS_LIST = 36864, LDS_H2L = 45056, LDS_SE = 110592;
constexpr int SCW = 260;
template <int N> DI void ce_desc(float (&a)[N], int i, int l) { const float hi = fmaxf(a[i], a[l]), lo = fminf(a[i], a[l]); a[i] = hi; a[l] = lo; }
DI void sort16_desc(float (&a)[16]) {
#pragma unroll
  for (int k = 2; k <= 16; k <<= 1)
#pragma unroll
    for (int j = k >> 1; j > 0; j >>= 1)
#pragma unroll
      for (int i = 0; i < 16; ++i) { const int l = i ^ j; if (l > i) { if ((i & k) == 0) ce_desc(a, i, l); else ce_desc(a, l, i); } }
}
DI void merge16_desc(float (&a)[16]) {
#pragma unroll
  for (int j = 8; j > 0; j >>= 1)
#pragma unroll
    for (int i = 0; i < 16; ++i) { const int l = i ^ j; if (l > i) ce_desc(a, i, l); }
}
DI void top16_merge(float (&a)[16], const float (&b)[16]) {
#pragma unroll
  for (int i = 0; i < 16; ++i) a[i] = fmaxf(a[i], b[15 - i]);
  merge16_desc(a);
}
template <int CTRL> DI float dpp_f(float v) { return __int_as_float(__builtin_amdgcn_mov_dpp(__float_as_int(v), CTRL, 0xF, 0xF, true)); }

DI float gelu_fast(float x) { return 0.5f * x * (1.f + erff(x * 0.70710678118654752f)); }

DI void phase3(const KP& p, char* lds, const int gather_reps, const int probe) {
  const int tid0 = threadIdx.x;
  const int r = tid0 & 31, hh = (tid0 >> 5) & 1, lane = tid0 & 63;
  char* wl = lds + LDS_WT + ((tid0 >> 6) & 3) * WT_BYTES;
  for (int tile = blockIdx.x; tile < 256; tile += gridDim.x) {
    unsigned char* ws = launder(p.ws); float* outp = launder(p.out); const float* xin = launder(p.in[0]);
    const int tok0 = tile * 64, b = tile >> 5;
    unsigned char* tsc = ws + WS_QM + (size_t)tile * P3_TILE_BYTES;
    bf16_t* QRY = (bf16_t*)tsc; bf16_t* Y = (bf16_t*)tsc; bf16_t* MIXA = (bf16_t*)(ws + WS_P1S) + (size_t)tok0 * 1024; bf16_t* H2 = MIXA;
    const float* modb = launder((const float*)(ws + WS_MOD)) + b * 6144;
    __syncthreads();
    {
      const int tid = lv(tid0), lane = tid & 63, w = tid >> 6, r = lane & 31, hh = lane >> 5;
      const int h = w >> 1, mi = w & 1, n = tile & 31;
      char* OIL = lds; char* RGL = lds + 66560;
      { const bf16_t* oig = (const bf16_t*)(ws + WS_OINTRA) + (size_t)tok0 * 512; const bf16_t* rgg = (const bf16_t*)(ws + WS_RG) + (size_t)tok0 * 512;
#pragma unroll
        for (int g = 0; g < 2; ++g) {
          bf16x8 vo[4], vr[4];
#pragma unroll
          for (int i = 0; i < 4; ++i) { const int c = tid + 512 * (g * 4 + i), row = c >> 6, cc = c & 63;
            vo[i] = *(const bf16x8*)(oig + (size_t)row * 512 + cc * 8); vr[i] = *(const bf16x8*)(rgg + (size_t)row * 512 + cc * 8); }
#pragma unroll
          for (int i = 0; i < 4; ++i) { const int c = tid + 512 * (g * 4 + i), row = c >> 6, cc = c & 63;
            *(bf16x8*)(OIL + row * 1040 + cc * 16) = vo[i]; *(bf16x8*)(RGL + row * 1040 + cc * 16) = vr[i]; } } }
      const bf16_t* QDg = (const bf16_t*)(ws + WS_QDEC) + (size_t)(tile * 4 + h) * 2 * 4096 + (mi * 32 + r) * 64 + hh * 8;
      const bf16_t* SPg = (const bf16_t*)(ws + WS_SPT) + ((size_t)((b * 4 + h) * 2) * 32 + n) * 8192 + r * 64 + hh * 8;
      f32x16 acc[4];
#pragma unroll
      for (int ni = 0; ni < 4; ++ni)
#pragma unroll
        for (int i = 0; i < 16; ++i) acc[ni][i] = 0.f;
#pragma unroll
      for (int d = 0; d < 2; ++d) {
        bf16x8 a[4], bb[4][4];
#pragma unroll
        for (int s = 0; s < 4; ++s) { a[s] = *(const bf16x8*)(QDg + d * 4096 + s * 16);
#pragma unroll
          for (int ni = 0; ni < 4; ++ni) bb[s][ni] = *(const bf16x8*)(SPg + (size_t)d * 32 * 8192 + ni * 32 * 64 + s * 16); }
#pragma unroll
        for (int s = 0; s < 4; ++s)
#pragma unroll
          for (int ni = 0; ni < 4; ++ni) acc[ni] = MFMA32(a[s], bb[s][ni], acc[ni]); }
      __syncthreads();
      bf16_t* oil = (bf16_t*)(OIL + (mi * 32 + 4 * hh) * 1040) + h * 128 + r; const bf16_t* rgl = (const bf16_t*)(RGL + (mi * 32 + 4 * hh) * 1040) + h * 128 + r;
#pragma unroll
      for (int ni = 0; ni < 4; ++ni)
#pragma unroll
        for (int reg = 0; reg < 16; ++reg) acc[ni][reg] += bf2f(oil[((reg & 3) + 8 * (reg >> 2)) * 520 + ni * 32]);
      float rs[16];
#pragma unroll
      for (int reg = 0; reg < 16; ++reg) { float v = acc[0][reg] * acc[0][reg] + acc[1][reg] * acc[1][reg] + acc[2][reg] * acc[2][reg] + acc[3][reg] * acc[3][reg];
        v += __shfl_xor(v, 1); v += __shfl_xor(v, 2); v += __shfl_xor(v, 4); v += __shfl_xor(v, 8); v += __shfl_xor(v, 16);
        rs[reg] = rsqrtf(v * (1.f / 128.f) + EPS); }
      const float* ggl = launder(p.in[16]);
#pragma unroll
      for (int ni = 0; ni < 4; ++ni) { const float g = ggl[ni * 32 + r];
#pragma unroll
        for (int reg = 0; reg < 16; ++reg) { const int ro = ((reg & 3) + 8 * (reg >> 2)) * 520 + ni * 32; const float rv = bf2f(rgl[ro]);
          oil[ro] = f2bf(acc[ni][reg] * rs[reg] * g * silu_fast(rv)); } }
      __syncthreads();
#pragma unroll
      for (int i = 0; i < 8; ++i) { const int c = tid + 512 * i, row = c >> 6, cc = c & 63;
        *(uint4*)(MIXA + (size_t)row * 1024 + 512 + cc * 8) = *(const uint4*)(OIL + row * 1040 + cc * 16); }
    }
  }
}

DI void phase3c(const KP& p, char* lds, const int gather_reps, const int probe) {
  const int tid0 = threadIdx.x;
  const int r = tid0 & 31, hh = (tid0 >> 5) & 1, lane = tid0 & 63;
  char* wl = lds + LDS_WT + ((tid0 >> 6) & 3) * WT_BYTES;
  for (int tile = blockIdx.x; tile < 256; tile += gridDim.x) {
    unsigned char* ws = launder(p.ws); float* outp = launder(p.out); const float* xin = launder(p.in[0]);
    const int tok0 = tile * 64, b = tile >> 5;
    unsigned char* tsc = ws + WS_QM + (size_t)tile * P3_TILE_BYTES;
    bf16_t* QRY = (bf16_t*)tsc; bf16_t* Y = (bf16_t*)(ws + WS_QM) + (size_t)tok0 * 1024; bf16_t* MIXA = (bf16_t*)(ws + WS_P1S) + (size_t)tok0 * 1024; bf16_t* H2 = MIXA;
    const float* modb = launder((const float*)(ws + WS_MOD)) + b * 6144;
    __syncthreads();
    {
      const int tid = lv(tid0), lane = tid & 63, w = tid >> 6;
      float4 A1[4], A2[4], S2[4];
      const float* gpo = launder(p.in[6]); const float* gpf = launder(p.in[18]);
#pragma unroll
      for (int i = 0; i < 4; ++i) { const int d = (lane + 64 * i) * 4;
        const float4 gp = *(const float4*)(gpo + d), gt = *(const float4*)(modb + 2048 + d), g2 = *(const float4*)(gpf + d), sc = *(const float4*)(modb + 4096 + d);
        S2[i] = *(const float4*)(modb + 3072 + d);
        A1[i] = make_float4(gp.x * gt.x, gp.y * gt.y, gp.z * gt.z, gp.w * gt.w);
        A2[i] = make_float4(g2.x * (1.f + sc.x), g2.y * (1.f + sc.y), g2.z * (1.f + sc.z), g2.w * (1.f + sc.w)); }
#pragma unroll 2
      for (int rr = 0; rr < 8; ++rr) { const int row = w * 8 + rr; const size_t tok = tok0 + row;
        float4 yv[4]; float ss = 0.f;
#pragma unroll
        for (int i = 0; i < 4; ++i) { const uint2 u = *(const uint2*)(Y + (size_t)row * 1024 + (lane + 64 * i) * 4);
          yv[i] = make_float4(__uint_as_float(u.x << 16), __uint_as_float(u.x & 0xffff0000u), __uint_as_float(u.y << 16), __uint_as_float(u.y & 0xffff0000u));
          ss += yv[i].x * yv[i].x + yv[i].y * yv[i].y + yv[i].z * yv[i].z + yv[i].w * yv[i].w; }
        ss = wave_sum(ss); const float rs = rsqrtf(ss * (1.f / 1024.f) + EPS);
        float4 xv[4]; float s2 = 0.f;
#pragma unroll
        for (int i = 0; i < 4; ++i) { const float4 x = *(const float4*)(xin + tok * 1024 + (lane + 64 * i) * 4);
          xv[i] = make_float4(x.x + A1[i].x * yv[i].x * rs, x.y + A1[i].y * yv[i].y * rs, x.z + A1[i].z * yv[i].z * rs, x.w + A1[i].w * yv[i].w * rs);
          *(float4*)(outp + tok * 1024 + (lane + 64 * i) * 4) = xv[i];
          s2 += xv[i].x * xv[i].x + xv[i].y * xv[i].y + xv[i].z * xv[i].z + xv[i].w * xv[i].w; }
        s2 = wave_sum(s2); const float r2 = rsqrtf(s2 * (1.f / 1024.f) + EPS);
#pragma unroll
        for (int i = 0; i < 4; ++i) { uint2 o; o.x = pack2(xv[i].x * r2 * A2[i].x + S2[i].x, xv[i].y * r2 * A2[i].y + S2[i].y); o.y = pack2(xv[i].z * r2 * A2[i].z + S2[i].z, xv[i].w * r2 * A2[i].w + S2[i].w);
          *(uint2*)(H2 + (size_t)row * 1024 + (lane + 64 * i) * 4) = o; }
      }
    }
  }
}

DI void phase3b(const KP& p, char* lds, const int gather_reps, const int probe) {
  const int tid0 = threadIdx.x;
  const int r = tid0 & 31, hh = (tid0 >> 5) & 1, lane = tid0 & 63;
  char* wl = lds + LDS_WT + ((tid0 >> 6) & 3) * WT_BYTES;
  for (int tile = blockIdx.x; tile < 256; tile += gridDim.x) {
    unsigned char* ws = launder(p.ws); float* outp = launder(p.out); const float* xin = launder(p.in[0]);
    const int tok0 = tile * 64, b = tile >> 5;
    unsigned char* tsc = ws + WS_QM + (size_t)tile * P3_TILE_BYTES;
    bf16_t* QRY = (bf16_t*)tsc; bf16_t* Y = (bf16_t*)tsc; bf16_t* MIXA = (bf16_t*)(ws + WS_P1S) + (size_t)tok0 * 1024; bf16_t* H2 = MIXA;
    const float* modb = launder((const float*)(ws + WS_MOD)) + b * 6144;
    __syncthreads();
    float* SC = (float*)lds; unsigned* TK = (unsigned*)(lds + LDS_TK);
    {
      constexpr int SC2W = 132, SC2H = 64 * SC2W;
      const int tid = lv(tid0), ln = tid & 63, wv = tid >> 6, r2 = ln & 31, h2 = ln >> 5;
      const int mi = wv & 1, ni = wv >> 1;
      const bf16_t* kd = launder((const bf16_t*)(ws + WS_KD));
      bf16x8 fb[8], fa0[8], fa1[8];
#define LD_FB(side_) do { _Pragma("unroll") for (int j = 0; j < 8; ++j) { const int kg = (side_) * 128 + 16 * j + 8 * h2, n = (side_) * 128 + 32 * ni + r2;     \
          fb[j] = *(const bf16x8*)(kd + (size_t)(kg >> 6) * 16384 + n * 64 + (kg & 63)); } } while (0)
#define LD_FA(rd_) do { const bf16_t* qp = QRY + (size_t)(32 * mi + r2) * 2048 + (2 * ((rd_) & 3)) * 256 + ((rd_) >> 2) * 128 + 8 * h2; \
          _Pragma("unroll") for (int j = 0; j < 8; ++j) { fa0[j] = *(const bf16x8*)(qp + 16 * j); fa1[j] = *(const bf16x8*)(qp + 256 + 16 * j); } } while (0)
      LD_FB(0); LD_FA(0);
#pragma unroll 1
      for (int rd = 0; rd < 8; ++rd) {
        const int side = rd >> 2, hp = rd & 3;
        {
          {
            f32x16 acc0, acc1;
#pragma unroll
            for (int i = 0; i < 16; ++i) { acc0[i] = 0.f; acc1[i] = 0.f; }
#pragma unroll
            for (int j = 0; j < 8; ++j) { acc0 = MFMA32(fa0[j], fb[j], acc0); acc1 = MFMA32(fa1[j], fb[j], acc1); }
            if (rd == 3) LD_FB(1);
            if (rd < 7) LD_FA(rd + 1);
            float* sp = SC + (32 * mi + 4 * h2) * SC2W + 32 * ni + r2;
#pragma unroll
            for (int reg = 0; reg < 16; ++reg) { sp[((reg & 3) + 8 * (reg >> 2)) * SC2W] = acc0[reg]; sp[SC2H + ((reg & 3) + 8 * (reg >> 2)) * SC2W] = acc1[reg]; }
          }
          __syncthreads();
          {
            const int tt = tid >> 3, hs = (tid >> 2) & 1, q = tid & 3;
            const float* sr = SC + hs * SC2H + tt * SC2W + q * 32;
            float a[16], c[16];
#pragma unroll
            for (int i = 0; i < 4; ++i) { const float4 v = *(const float4*)(sr + i * 4); const unsigned ib = q * 32 + i * 4;
              a[i * 4 + 0] = __uint_as_float((__float_as_uint(v.x) & 0xFFFFFF80u) | (ib + 0)); a[i * 4 + 1] = __uint_as_float((__float_as_uint(v.y) & 0xFFFFFF80u) | (ib + 1));
              a[i * 4 + 2] = __uint_as_float((__float_as_uint(v.z) & 0xFFFFFF80u) | (ib + 2)); a[i * 4 + 3] = __uint_as_float((__float_as_uint(v.w) & 0xFFFFFF80u) | (ib + 3)); }
#pragma unroll
            for (int i = 0; i < 4; ++i) { const float4 v = *(const float4*)(sr + 16 + i * 4); const unsigned ib = q * 32 + 16 + i * 4;
              c[i * 4 + 0] = __uint_as_float((__float_as_uint(v.x) & 0xFFFFFF80u) | (ib + 0)); c[i * 4 + 1] = __uint_as_float((__float_as_uint(v.y) & 0xFFFFFF80u) | (ib + 1));
              c[i * 4 + 2] = __uint_as_float((__float_as_uint(v.z) & 0xFFFFFF80u) | (ib + 2)); c[i * 4 + 3] = __uint_as_float((__float_as_uint(v.w) & 0xFFFFFF80u) | (ib + 3)); }
            sort16_desc(a); sort16_desc(c); top16_merge(a, c);
#pragma unroll
            for (int i = 0; i < 16; ++i) c[i] = dpp_f<0xB1>(a[i]);
            top16_merge(a, c);
#pragma unroll
            for (int i = 0; i < 16; ++i) c[i] = dpp_f<0x4E>(a[i]);
            top16_merge(a, c);
            if (q == 0) { unsigned* tk = TK + ((tt * 8 + 2 * hp + hs) * 2 + side) * 16;
#pragma unroll
              for (int i = 0; i < 4; ++i) *(uint4*)(tk + i * 4) = make_uint4(__float_as_uint(a[i * 4]), __float_as_uint(a[i * 4 + 1]), __float_as_uint(a[i * 4 + 2]), __float_as_uint(a[i * 4 + 3])); }
          }
          __syncthreads();
        }
      }
#undef LD_FB
#undef LD_FA
    }
    {
      const int tid = lv(tid0);
      const int tt = tid >> 3, h = tid & 7;
      const unsigned* t1 = TK + ((tt * 8 + h) * 2) * 16; const unsigned* t2 = t1 + 16;
      float v1[16], v2[16];
#pragma unroll
      for (int i = 0; i < 4; ++i) { const uint4 u = *(const uint4*)(t1 + i * 4), v = *(const uint4*)(t2 + i * 4);
        v1[i * 4] = __uint_as_float(u.x & 0xFFFFFF80u); v1[i * 4 + 1] = __uint_as_float(u.y & 0xFFFFFF80u); v1[i * 4 + 2] = __uint_as_float(u.z & 0xFFFFFF80u); v1[i * 4 + 3] = __uint_as_float(u.w & 0xFFFFFF80u);
        v2[i * 4] = __uint_as_float(v.x & 0xFFFFFF80u); v2[i * 4 + 1] = __uint_as_float(v.y & 0xFFFFFF80u); v2[i * 4 + 2] = __uint_as_float(v.z & 0xFFFFFF80u); v2[i * 4 + 3] = __uint_as_float(v.w & 0xFFFFFF80u); }
      float best[16], grp[16];
#define CAND(i, j) __uint_as_float((__float_as_uint(v1[i] + v2[j]) & 0xFFFFFF00u) | ((i) << 4) | (j))
      best[0] = CAND(0, 0); best[1] = CAND(0, 1); best[2] = CAND(0, 2); best[3] = CAND(0, 3); best[4] = CAND(0, 4); best[5] = CAND(0, 5); best[6] = CAND(0, 6); best[7] = CAND(0, 7);
      best[8] = CAND(0, 8); best[9] = CAND(0, 9); best[10] = CAND(0, 10); best[11] = CAND(0, 11); best[12] = CAND(0, 12); best[13] = CAND(0, 13); best[14] = CAND(0, 14); best[15] = CAND(0, 15);
      sort16_desc(best);
      grp[0] = CAND(1, 0); grp[1] = CAND(1, 1); grp[2] = CAND(1, 2); grp[3] = CAND(1, 3); grp[4] = CAND(1, 4); grp[5] = CAND(1, 5); grp[6] = CAND(1, 6); grp[7] = CAND(1, 7);
      grp[8] = CAND(2, 0); grp[9] = CAND(2, 1); grp[10] = CAND(2, 2); grp[11] = CAND(2, 3); grp[12] = CAND(2, 4); grp[13] = CAND(3, 0); grp[14] = CAND(3, 1); grp[15] = CAND(3, 2);
      sort16_desc(grp); top16_merge(best, grp);
      grp[0] = CAND(3, 3); grp[1] = CAND(4, 0); grp[2] = CAND(4, 1); grp[3] = CAND(4, 2); grp[4] = CAND(5, 0); grp[5] = CAND(5, 1); grp[6] = CAND(6, 0); grp[7] = CAND(6, 1);
      grp[8] = CAND(7, 0); grp[9] = CAND(7, 1); grp[10] = CAND(8, 0); grp[11] = CAND(9, 0); grp[12] = CAND(10, 0); grp[13] = CAND(11, 0); grp[14] = CAND(12, 0); grp[15] = CAND(13, 0);
      sort16_desc(grp); top16_merge(best, grp);
      { const float c14 = CAND(14, 0), c15 = CAND(15, 0);
        grp[0] = fmaxf(c14, c15); grp[1] = fminf(c14, c15);
#pragma unroll
        for (int i = 2; i < 16; ++i) grp[i] = -3.0e38f;
        top16_merge(best, grp); }
#undef CAND
      __syncthreads();
      float sv[16]; int ev[16]; float mx = -3.0e38f;
#pragma unroll
      for (int k = 0; k < 16; ++k) { const unsigned key = __float_as_uint(best[k]); const int ci = (key >> 4) & 15, cj = key & 15;
        const unsigned k1 = t1[ci], k2 = t2[cj];
        sv[k] = __uint_as_float(k1 & 0xFFFFFF80u) + __uint_as_float(k2 & 0xFFFFFF80u); ev[k] = (int)((k1 & 127u) * 128u + (k2 & 127u)); mx = fmaxf(mx, sv[k]); }
      float sum = 0.f;
#pragma unroll
      for (int k = 0; k < 16; ++k) { sv[k] = __expf(sv[k] - mx); sum += sv[k]; }
      const float inv = 1.f / sum;
      unsigned* CNT = (unsigned*)(lds + LDS_CNT); unsigned short* OFFS = (unsigned short*)(lds + LDS_OFF); unsigned* EL = (unsigned*)lds; unsigned short* SE = (unsigned short*)(lds + LDS_SE);
      float scu[16], scv[16];
      { const float* SCU = (const float*)(ws + WS_ESC);
#pragma unroll
        for (int k = 0; k < 16; ++k) { scu[k] = SCU[ev[k]]; scv[k] = SCU[16384 + ev[k]]; } }
      CNT[tid] = 0u; if (GP_N > 8) CNT[tid + 512] = 0u;
      __syncthreads();
      int pos[16];
#pragma unroll
      for (int k = 0; k < 16; ++k) pos[k] = (int)atomicAdd(&CNT[tt * GP_N + (ev[k] >> GP_SH)], 1u);
      __syncthreads();
      if (h == 0) { unsigned run = 0;
#pragma unroll
        for (int q = 0; q < GP_N; ++q) { OFFS[tt * GP_OS + q] = (unsigned short)run; run += CNT[tt * GP_N + q]; }
        OFFS[tt * GP_OS + GP_N] = (unsigned short)run; }
      __syncthreads();
#pragma unroll
      for (int k = 0; k < 16; ++k) { const int d = (int)OFFS[tt * GP_OS + (ev[k] >> GP_SH)] + pos[k];
        EL[tt * 128 + d] = ((__float_as_uint(sv[k] * inv) + 0x2000u) & 0xFFFFC000u) | (unsigned)ev[k];
        SE[tt * 128 + d] = (unsigned short)((((__float_as_uint(scu[k]) >> 23) & 255u) << 8) | ((__float_as_uint(scv[k]) >> 23) & 255u)); }
    }
    __syncthreads();
    {
      const int tid = lv(tid0), lane = tid & 63, w = tid >> 6;
      typedef int i32x4_t __attribute__((ext_vector_type(4)));
      i32x4_t EU, EV;
      { const unsigned long long bu = (unsigned long long)(ws + WS_EU), bv = (unsigned long long)(ws + WS_EV);
        EU[0] = __builtin_amdgcn_readfirstlane((int)(unsigned)bu); EU[1] = __builtin_amdgcn_readfirstlane((int)((bu >> 32) & 0xFFFFu)); EU[2] = 0x01000000; EU[3] = 0x00020000;
        EV[0] = __builtin_amdgcn_readfirstlane((int)(unsigned)bv); EV[1] = __builtin_amdgcn_readfirstlane((int)((bv >> 32) & 0xFFFFu)); EV[2] = 0x01000000; EV[3] = 0x00020000; }
      unsigned* EL = (unsigned*)lds; const unsigned short* OFFS = (const unsigned short*)(lds + LDS_OFF); unsigned* LIST = (unsigned*)(lds + LDS_LIST) + w * 256; char* H2W = lds + LDS_H2L + w * 8192;
      const unsigned short* SE = (const unsigned short*)(lds + LDS_SE);
      const float* gpf2 = launder(p.in[19]);
      const int rot = (int)(__builtin_amdgcn_s_getreg((3 << 11) | 20) & 0xFu) * (GP_N / 8);
      const unsigned voff = (unsigned)lane * 16u;
      const int sl = lane & 7;
      typedef float f2v __attribute__((ext_vector_type(2))); typedef unsigned u32x4_t __attribute__((ext_vector_type(4)));
#define CVLO(wd) __builtin_amdgcn_cvt_pk_f32_fp8((int)(wd), false)
#define CVHI(wd) __builtin_amdgcn_cvt_pk_f32_fp8((int)(wd), true)
#define BF2(wd) ((f2v){__uint_as_float((wd) << 16), __uint_as_float((wd) & 0xffff0000u)})
#define DPPF(x, CTRL) __int_as_float(__builtin_amdgcn_update_dpp(0, __float_as_int(x), CTRL, 0xF, 0xF, true))
#define R_INIT(R, TAG) do { _Pragma("unroll") for (int k2 = 0; k2 < 8; ++k2) asm volatile("; init " TAG : "=v"(R[k2])); } while (0)
#define EIDX(D) ((row0 + ((D) >> 11)) * 128 + (((D) >> 4) & 127) + (sl < ((D) & 15) ? sl : 0))
#define G_FETCH(DX, PKX, R, TAB, TAG) do { DX = Dn; PKX = PKn; { const int es_ = (int)(PKX & 16383u); unsigned so_[8]; \
        _Pragma("unroll") for (int k2 = 0; k2 < 8; ++k2) so_[k2] = (unsigned)__builtin_amdgcn_readlane(es_, k2) << 10;     \
        asm volatile("buffer_load_dwordx4 %0, %8, %9, %10 offen ; " TAG "\n\tbuffer_load_dwordx4 %1, %8, %9, %11 offen\n\tbuffer_load_dwordx4 %2, %8, %9, %12 offen\n\tbuffer_load_dwordx4 %3, %8, %9, %13 offen\n\t" \
                     "buffer_load_dwordx4 %4, %8, %9, %14 offen\n\tbuffer_load_dwordx4 %5, %8, %9, %15 offen\n\tbuffer_load_dwordx4 %6, %8, %9, %16 offen\n\tbuffer_load_dwordx4 %7, %8, %9, %17 offen" \
                     : "+v"(R[0]), "+v"(R[1]), "+v"(R[2]), "+v"(R[3]), "+v"(R[4]), "+v"(R[5]), "+v"(R[6]), "+v"(R[7])     \
                     : "v"(voff), "s"(TAB), "s"(so_[0]), "s"(so_[1]), "s"(so_[2]), "s"(so_[3]), "s"(so_[4]), "s"(so_[5]), "s"(so_[6]), "s"(so_[7])); } \
        Dn = __builtin_amdgcn_readfirstlane((int)tmpL); PKn = EL[EIDX(Dn)]; tmpL = LIST[sidx]; ++sidx; } while (0)
#define G_WAITK(R, k2) asm volatile("s_waitcnt vmcnt(%1)" : "+v"(R[k2]) : "n"(15 - (k2)))
#define G_DRAIN(RA_, RB_) do { asm volatile("s_waitcnt vmcnt(0)" : "+v"(RA_[0]), "+v"(RA_[1]), "+v"(RA_[2]), "+v"(RA_[3]), "+v"(RA_[4]), "+v"(RA_[5]), "+v"(RA_[6]), "+v"(RA_[7])); \
        asm volatile("" : "+v"(RB_[0]), "+v"(RB_[1]), "+v"(RB_[2]), "+v"(RB_[3]), "+v"(RB_[4]), "+v"(RB_[5]), "+v"(RB_[6]), "+v"(RB_[7])); } while (0)
#define U_DOT(R, k2) do { G_WAITK(R, k2); int d_ = __builtin_amdgcn_sdot4((int)R[k2][0], (int)hq.x, 0, false); d_ = __builtin_amdgcn_sdot4((int)R[k2][1], (int)hq.y, d_, false); \
            d_ = __builtin_amdgcn_sdot4((int)R[k2][2], (int)hq.z, d_, false); d_ = __builtin_amdgcn_sdot4((int)R[k2][3], (int)hq.w, d_, false); P[k2] = (float)d_; } while (0)
#define U_COMPUTE(D, R, SI) do { if ((D) != 0) { const int n_ = (D) & 15, rr_ = (D) >> 11; \
        if (rr_ != cur) { cur = rr_; hq = *(const uint4*)(H2W + rr_ * 1024 + lane * 16); } \
        float P[8]; \
        _Pragma("unroll") for (int k2 = 0; k2 < 8; ++k2) P[k2] = 0.f; \
          \
        U_DOT(R, 0); if (n_ > 1) { U_DOT(R, 1); if (n_ > 2) { U_DOT(R, 2); if (n_ > 3) { U_DOT(R, 3); if (n_ > 4) { U_DOT(R, 4); if (n_ > 5) { U_DOT(R, 5); if (n_ > 6) { U_DOT(R, 6); if (n_ > 7) { U_DOT(R, 7); } } } } } } } \
          \
        _Pragma("unroll") for (int e = 0; e < 4; ++e) { const float a_ = P[e] + DPPF(P[e], 0x141), b_ = P[e + 4] + DPPF(P[e + 4], 0x141); P[e] = (lane & 4) ? b_ : a_; } \
        _Pragma("unroll") for (int e = 0; e < 2; ++e) { const float a_ = P[e] + DPPF(P[e], 0x4E), b_ = P[e + 2] + DPPF(P[e + 2], 0x4E); P[e] = (lane & 2) ? b_ : a_; } \
        float av; { const float a_ = P[0] + DPPF(P[0], 0xB1), b_ = P[1] + DPPF(P[1], 0xB1); av = (lane & 1) ? b_ : a_; } \
        av += DPPF(av, 0x128); \
        { const auto s16 = __builtin_amdgcn_permlane16_swap(__float_as_uint(av), __float_as_uint(av), false, false); av = __uint_as_float(s16[0]) + __uint_as_float(s16[1]); } \
        { const auto s32 = __builtin_amdgcn_permlane32_swap(__float_as_uint(av), __float_as_uint(av), false, false); av = __uint_as_float(s32[0]) + __uint_as_float(s32[1]); } \
        if (lane < 8) AVB[((SI) & 7) * 8 + lane] = av;              } } while (0)
#define U_FLUSH(s0_, cnt_) do { const int j_ = lane >> 3; const unsigned D_ = (j_ < (cnt_)) ? LIST[(s0_) + j_] : 0u; const int n_ = (int)(D_ & 15u), rr_ = (int)(D_ >> 11); \
        if (sl < n_) { const int ei_ = (row0 + rr_) * 128 + (int)((D_ >> 4) & 127u) + sl; const unsigned pk_ = EL[ei_]; const unsigned se_ = (unsigned)SE[ei_]; \
          const float av = AVB[j_ * 8 + sl] * (__uint_as_float((se_ >> 8) << 23) * ((const float*)(H2W + 4096))[rr_]);              \
            \
          const float ax = fabsf(av), t = __builtin_amdgcn_rcpf(ax * 0.2316418882f + 1.0f); \
          float q = t * 0.5307027145f + (-0.7265760135f); q = q * t + 0.7107068705f; q = q * t + (-0.142248368f); q = q * t + 0.127414796f; q = q * t; \
          const float ee = __builtin_amdgcn_exp2f(av * av * (-0.72134752044f)); \
          const float mm = av * (q * ee), gl = (av < 0.f) ? mm : (av - mm); \
          const float wv = __uint_as_float(pk_ & 0xFFFFC000u) * gl * __uint_as_float((se_ & 255u) << 23); \
          EL[ei_] = ((__float_as_uint(wv) + 0x2000u) & 0xFFFFC000u) | (pk_ & 16383u); } } while (0)
#define Y_PARK() do { uint4 y0, y1; y0.x = pack2(acc[0].x, acc[0].y); y0.y = pack2(acc[1].x, acc[1].y); y0.z = pack2(acc[2].x, acc[2].y); y0.w = pack2(acc[3].x, acc[3].y); \
        y1.x = pack2(acc[4].x, acc[4].y); y1.y = pack2(acc[5].x, acc[5].y); y1.z = pack2(acc[6].x, acc[6].y); y1.w = pack2(acc[7].x, acc[7].y); \
        *(uint4*)(H2W + cur * 2048 + lane * 32) = y0; *(uint4*)(H2W + cur * 2048 + lane * 32 + 16) = y1; } while (0)
#define V_ACC(R, k2) do { const float wk = __int_as_float(__builtin_amdgcn_readlane(__float_as_int(wv_), k2)); const f2v wk2 = {wk, wk}; \
          G_WAITK(R, k2); \
          acc[0] += CVLO(R[k2][0]) * wk2; acc[1] += CVHI(R[k2][0]) * wk2; acc[2] += CVLO(R[k2][1]) * wk2; acc[3] += CVHI(R[k2][1]) * wk2; \
          acc[4] += CVLO(R[k2][2]) * wk2; acc[5] += CVHI(R[k2][2]) * wk2; acc[6] += CVLO(R[k2][3]) * wk2; acc[7] += CVHI(R[k2][3]) * wk2; } while (0)
#define V_COMPUTE(D, PK, R) do { if ((D) != 0) { const int n_ = (D) & 15, rr_ = (D) >> 11; \
        if (rr_ != cur) { if (cur >= 0) Y_PARK(); cur = rr_; \
          const uint4 hA = *(const uint4*)(H2W + rr_ * 2048 + lane * 32), hB = *(const uint4*)(H2W + rr_ * 2048 + lane * 32 + 16); \
          acc[0] = BF2(hA.x); acc[1] = BF2(hA.y); acc[2] = BF2(hA.z); acc[3] = BF2(hA.w); acc[4] = BF2(hB.x); acc[5] = BF2(hB.y); acc[6] = BF2(hB.z); acc[7] = BF2(hB.w); } \
        const float wv_ = (sl < n_) ? __uint_as_float(PK & 0xFFFFC000u) : 0.f; \
        V_ACC(R, 0); if (n_ > 1) { V_ACC(R, 1); if (n_ > 2) { V_ACC(R, 2); if (n_ > 3) { V_ACC(R, 3); if (n_ > 4) { V_ACC(R, 4); if (n_ > 5) { V_ACC(R, 5); if (n_ > 6) { V_ACC(R, 6); if (n_ > 7) { V_ACC(R, 7); } } } } } } } } } while (0)
#define G_PROLOGUE() do { Dn = __builtin_amdgcn_readfirstlane((int)LIST[0]); PKn = EL[EIDX(Dn)]; tmpL = LIST[1]; sidx = 2; } while (0)
#pragma unroll 1
      for (int half = 0; half < 2; ++half) {
        const int row0 = half * 32 + w * 4;
        __builtin_amdgcn_wave_barrier(); asm volatile("" ::: "memory");
        {
          uint4 ta[4], tb[4];
#pragma unroll
          for (int rr = 0; rr < 4; ++rr) { const uint4* src = (const uint4*)(H2 + (size_t)(row0 + rr) * 1024 + lane * 16); ta[rr] = src[0]; tb[rr] = src[1]; }
#pragma unroll
          for (int rr = 0; rr < 4; ++rr) { float f[16];
            f[0] = __uint_as_float(ta[rr].x << 16); f[1] = __uint_as_float(ta[rr].x & 0xffff0000u); f[2] = __uint_as_float(ta[rr].y << 16); f[3] = __uint_as_float(ta[rr].y & 0xffff0000u);
            f[4] = __uint_as_float(ta[rr].z << 16); f[5] = __uint_as_float(ta[rr].z & 0xffff0000u); f[6] = __uint_as_float(ta[rr].w << 16); f[7] = __uint_as_float(ta[rr].w & 0xffff0000u);
            f[8] = __uint_as_float(tb[rr].x << 16); f[9] = __uint_as_float(tb[rr].x & 0xffff0000u); f[10] = __uint_as_float(tb[rr].y << 16); f[11] = __uint_as_float(tb[rr].y & 0xffff0000u);
            f[12] = __uint_as_float(tb[rr].z << 16); f[13] = __uint_as_float(tb[rr].z & 0xffff0000u); f[14] = __uint_as_float(tb[rr].w << 16); f[15] = __uint_as_float(tb[rr].w & 0xffff0000u);
            float am = 0.f;
#pragma unroll
            for (int i = 0; i < 16; ++i) am = fmaxf(am, fabsf(f[i]));
            am = wave_max(am);
            const float hs = (am > 0.f) ? am * (1.f / 127.f) : 1.f, ihs = 1.f / hs;
            unsigned qd[4];
#pragma unroll
            for (int i = 0; i < 4; ++i) { const int q0 = (int)rintf(f[4 * i] * ihs), q1 = (int)rintf(f[4 * i + 1] * ihs), q2 = (int)rintf(f[4 * i + 2] * ihs), q3 = (int)rintf(f[4 * i + 3] * ihs);
              qd[i] = (unsigned)(q0 & 255) | ((unsigned)(q1 & 255) << 8) | ((unsigned)(q2 & 255) << 16) | ((unsigned)(q3 & 255) << 24); }
            *(uint4*)(H2W + rr * 1024 + lane * 16) = make_uint4(qd[0], qd[1], qd[2], qd[3]);
            if (lane == 0) ((float*)(H2W + 4096))[rr] = hs; } }
        int ns;
        {
          const int rr = lane & 3, part = ((lane >> 2) + rot) & (GP_N - 1);
          int o0 = 0, o1 = 0;
          if (lane < 4 * GP_N) { o0 = (int)OFFS[(row0 + rr) * GP_OS + part]; o1 = (int)OFFS[(row0 + rr) * GP_OS + part + 1]; }
          const int nst = (o1 - o0 + 7) >> 3;
          int incl = nst;
#pragma unroll
          for (int d = 1; d < 64; d <<= 1) { const int t = __shfl_up(incl, d); if (lane >= d) incl += t; }
          const int off = incl - nst;
          for (int j = 0; j < nst; ++j) { const int base = o0 + 8 * j; const int nn = (o1 - base < 8) ? (o1 - base) : 8; LIST[off + j] = (unsigned)(nn | (base << 4) | (rr << 11)); }
          ns = __builtin_amdgcn_readlane(incl, 63);
          if (lane < 8) LIST[ns + lane] = 0u; }
        __builtin_amdgcn_wave_barrier(); asm volatile("s_waitcnt vmcnt(0)" ::: "memory");
        {
          int DA, DB, Dn, sidx, cur = -1; unsigned PKA, PKB, PKn, tmpL; u32x4_t RA[8], RB[8]; uint4 hq = make_uint4(0u, 0u, 0u, 0u);
          float* AVB = (float*)(H2W + 4352); int flushed = 0;
          R_INIT(RA, "uA"); R_INIT(RB, "uB");
          G_PROLOGUE(); G_FETCH(DA, PKA, RA, EU, "uA0");
#pragma unroll 1
          for (int s = 0; s < ns; s += 2) {
            G_FETCH(DB, PKB, RB, EU, "uB"); U_COMPUTE(DA, RA, s);
            G_FETCH(DA, PKA, RA, EU, "uA"); U_COMPUTE(DB, RB, s + 1);
            if ((s & 7) == 6) { U_FLUSH(s - 6, 8); flushed = s + 2; }
          }
          G_DRAIN(RA, RB);
          if (flushed < ns) U_FLUSH(flushed, ns - flushed);
          (void)PKA; (void)PKB;
        }
        __builtin_amdgcn_wave_barrier(); asm volatile("s_waitcnt vmcnt(0)" ::: "memory");
        { const uint4 z4 = make_uint4(0u, 0u, 0u, 0u);
#pragma unroll
          for (int i = 0; i < 8; ++i) ((uint4*)H2W)[lane + 64 * i] = z4; }
        __builtin_amdgcn_wave_barrier(); asm volatile("" ::: "memory");
        {
          int DA, DB, Dn, sidx, cur = -1; unsigned PKA, PKB, PKn, tmpL; u32x4_t RA[8], RB[8]; f2v acc[8];
          R_INIT(RA, "vA"); R_INIT(RB, "vB");
          G_PROLOGUE(); G_FETCH(DA, PKA, RA, EV, "vA0");
#pragma unroll 1
          for (int s = 0; s < ns; s += 2) {
            G_FETCH(DB, PKB, RB, EV, "vB"); V_COMPUTE(DA, PKA, RA);
            G_FETCH(DA, PKA, RA, EV, "vA"); V_COMPUTE(DB, PKB, RB);
          }
          G_DRAIN(RA, RB);
          if (cur >= 0) Y_PARK();
        }
        __builtin_amdgcn_wave_barrier(); asm volatile("s_waitcnt vmcnt(0)" ::: "memory");
#pragma unroll 1
        for (int rr = 0; rr < 4; ++rr) { const size_t tok = tok0 + row0 + rr;
          const uint4 hA = *(const uint4*)(H2W + rr * 2048 + lane * 32), hB = *(const uint4*)(H2W + rr * 2048 + lane * 32 + 16);
          f2v a[8]; a[0] = BF2(hA.x); a[1] = BF2(hA.y); a[2] = BF2(hA.z); a[3] = BF2(hA.w); a[4] = BF2(hB.x); a[5] = BF2(hB.y); a[6] = BF2(hB.z); a[7] = BF2(hB.w);
          float ss = 0.f;
#pragma unroll
          for (int i = 0; i < 8; ++i) ss += a[i].x * a[i].x + a[i].y * a[i].y;
          ss = wave_sum(ss); const float rs = rsqrtf(ss * (1.f / 1024.f) + EPS);
          float* orow = outp + tok * 1024 + lane * 16;
#pragma unroll
          for (int i = 0; i < 4; ++i) { const int d = lane * 16 + 4 * i;
            float4 x1 = *(const float4*)(orow + 4 * i); const float4 g3 = *(const float4*)(gpf2 + d), g2 = *(const float4*)(modb + 5120 + d);
            x1.x += g3.x * g2.x * a[2 * i].x * rs; x1.y += g3.y * g2.y * a[2 * i].y * rs; x1.z += g3.z * g2.z * a[2 * i + 1].x * rs; x1.w += g3.w * g2.w * a[2 * i + 1].y * rs;
            *(float4*)(orow + 4 * i) = x1; }
        }
      }
#undef CVLO
#undef CVHI
#undef BF2
#undef DPPF
#undef R_INIT
#undef EIDX
#undef G_FETCH
#undef G_WAITK
#undef G_DRAIN
#undef U_COMPUTE
#undef U_FLUSH
#undef U_DOT
#undef V_ACC
#undef Y_PARK
#undef V_COMPUTE
#undef G_PROLOGUE
    }
  }
}

DI void phase2_scan(const KP& p) {
  unsigned char* ws = p.ws;
  for (int g = blockIdx.x * NTHR + threadIdx.x; g < 131072; g += gridDim.x * NTHR) {
    const int seq = g >> 11, within = g & 2047, dv = within >> 4, dk4 = (within & 15) * 4, dir = seq & 1;
    bf16_t* base = (bf16_t*)(ws + WS_SPT) + ((size_t)seq * 32 * 128 + dv) * 64 + dk4;
    const float* dec = (const float*)(ws + WS_DEC) + (size_t)seq * 32 * 64 + dk4;
    float s0 = 0.f, s1 = 0.f, s2 = 0.f, s3 = 0.f;
#pragma unroll 1
    for (int i0 = 0; i0 < 32; i0 += 8) {
      uint2 d[8]; float4 c[8];
#pragma unroll
      for (int j = 0; j < 8; ++j) { const int n = dir ? 31 - (i0 + j) : (i0 + j); d[j] = *(const uint2*)(base + (size_t)n * 8192); c[j] = *(const float4*)(dec + n * 64); }
#pragma unroll
      for (int j = 0; j < 8; ++j) { const int n = dir ? 31 - (i0 + j) : (i0 + j);
        uint2 o; o.x = pack2(s0, s1); o.y = pack2(s2, s3); *(uint2*)(base + (size_t)n * 8192) = o;
        s0 = c[j].x * s0 + __uint_as_float(d[j].x << 16); s1 = c[j].y * s1 + __uint_as_float(d[j].x & 0xffff0000u);
        s2 = c[j].z * s2 + __uint_as_float(d[j].y << 16); s3 = c[j].w * s3 + __uint_as_float(d[j].y & 0xffff0000u); }
    }
  }
}

#define XB_MODCNT   64
#define XB_TMO      128
#define XB_XCNT(j)  (256  + 64 * (j))
#define XB_XSUB(j)  (1280 + 64 * (j))
#define XB_XGEN(j)  (2304 + 64 * (j))
#define XB_TOP      3328
#define XB_TOPGEN   3392
#define XCD_BAR_WORDS 3456
#define XB_SPIN_CAP (1u << 18)
#define LAS __attribute__((address_space(3)))

__device__ __forceinline__ unsigned xb_ld(unsigned* p)              { return __hip_atomic_load(p, __ATOMIC_RELAXED, __HIP_MEMORY_SCOPE_AGENT); }
__device__ __forceinline__ unsigned xb_add(unsigned* p, unsigned v) { return __hip_atomic_fetch_add(p, v, __ATOMIC_RELAXED, __HIP_MEMORY_SCOPE_AGENT); }
__device__ __forceinline__ unsigned xb_xcc_id() { return (unsigned)__builtin_amdgcn_s_getreg((3 << 11) | 20) & 0xFu; }
#define XB_SPIN(cond, bar) do { unsigned _sp = 0; while (cond) { __builtin_amdgcn_s_sleep(1); \
    if ((++_sp & 255u) == 0u) { if (xb_ld(&(bar)[XB_TMO])) break; if (_sp > XB_SPIN_CAP) { atomicAdd(&(bar)[XB_TMO], 1u); break; } } } } while (0)

struct XcdBarrier {
    unsigned* bar; unsigned x;
    volatile LAS unsigned* st;
};

__device__ __forceinline__ XcdBarrier xcd_barrier_post(unsigned* bar, volatile LAS unsigned* st) {
    XcdBarrier b; b.bar = bar; b.x = xb_xcc_id(); b.st = st;
    if (threadIdx.x == 0) (void)xb_add(&bar[XB_XCNT(b.x)], 1u);
    return b;
}
__device__ __forceinline__ void xcd_barrier_complete(unsigned* bar, unsigned x, unsigned& nloc, unsigned& nx) {
    const unsigned G = gridDim.x * gridDim.y * gridDim.z;
    unsigned sum, cnt, mine, sp = 0u;
    for (;;) {
        sum = 0u; cnt = 0u; mine = 0u;
#pragma unroll
        for (unsigned j = 0; j < 16; ++j) { const unsigned c = xb_ld(&bar[XB_XCNT(j)]); sum += c; cnt += (c > 0u) ? 1u : 0u; mine = (j == x) ? c : mine; }
        if (sum == G) break;
        __builtin_amdgcn_s_sleep(1);
        if ((++sp & 255u) == 0u) { if (xb_ld(&bar[XB_TMO])) break; if (sp > XB_SPIN_CAP) { atomicAdd(&bar[XB_TMO], 1u); break; } }
    }
    nloc = mine > 0u ? mine : 1u; nx = cnt > 0u ? cnt : 1u;
}

__device__ __forceinline__ void xcd_barrier(const XcdBarrier& b) {
    asm volatile("s_waitcnt vmcnt(0)" ::: "memory");
    __syncthreads();
    if (threadIdx.x == 0) {
        unsigned* bar = b.bar;
        __builtin_amdgcn_s_waitcnt(0);
        unsigned nloc = b.st[0], nx = b.st[1];
        if (nloc == 0u) { xcd_barrier_complete(bar, b.x, nloc, nx); b.st[0] = nloc; b.st[1] = nx; }
        const unsigned old = xb_add(&bar[XB_XSUB(b.x)], 1u);
        const unsigned gen = old / nloc;
        if (old + 1u == (gen + 1u) * nloc) {
            __builtin_amdgcn_fence(__ATOMIC_RELEASE, "agent");
            asm volatile("s_waitcnt vmcnt(0)" ::: "memory");
            const unsigned og = xb_add(&bar[XB_TOP], 1u);
            const unsigned tg = og / nx;
            if (og + 1u == (tg + 1u) * nx) xb_add(&bar[XB_TOPGEN], 1u);
            else XB_SPIN(xb_ld(&bar[XB_TOPGEN]) == tg, bar);
            __builtin_amdgcn_fence(__ATOMIC_ACQUIRE, "agent");
            xb_add(&bar[XB_XGEN(b.x)], 1u);
            asm volatile("s_waitcnt vmcnt(0)" ::: "memory");
        } else {
            XB_SPIN(xb_ld(&bar[XB_XGEN(b.x)]) == gen, bar);
            __builtin_amdgcn_fence(__ATOMIC_ACQUIRE, "agent");
            asm volatile("s_waitcnt vmcnt(0)" ::: "memory");
        }
    }
    __syncthreads();
}

#ifndef PROBE_ID
#define PROBE_ID 0
#endif
__global__ void __launch_bounds__(NTHR, 2) mega(KP p) {
  extern __shared__ __attribute__((aligned(16))) char lds[];
  cg::grid_group grid = cg::this_grid();
  const int hi = p.ph_hi; constexpr int probe = PROBE_ID;
  if (threadIdx.x == 0) { ((volatile LAS unsigned*)(lds + LDS_XB))[0] = 0u; ((volatile LAS unsigned*)(lds + LDS_XB))[1] = 0u; }
  __syncthreads();
  const XcdBarrier xb = xcd_barrier_post((unsigned*)(p.ws + WS_BAR), (volatile LAS unsigned*)(lds + LDS_XB));
  if (hi > 64) grid.sync();
  {
    unsigned* bar = (unsigned*)(p.ws + WS_BAR);
    const int njobs = phase0_mod(p, lds);
    if (njobs > 0) {
      asm volatile("s_waitcnt vmcnt(0)" ::: "memory"); __syncthreads();
      if (threadIdx.x == 0) { __builtin_amdgcn_fence(__ATOMIC_RELEASE, "agent"); asm volatile("s_waitcnt vmcnt(0)" ::: "memory"); xb_add(&bar[XB_MODCNT], (unsigned)njobs); }
    }
    phase0(p, lds);
    if (threadIdx.x == 0) { XB_SPIN(xb_ld(&bar[XB_MODCNT]) < (unsigned)MOD_JOBS, bar); __builtin_amdgcn_fence(__ATOMIC_ACQUIRE, "agent"); asm volatile("s_waitcnt vmcnt(0)" ::: "memory"); }
    __syncthreads();
  }
  if (p.ph_lo <= 1 && 1 < hi) {
    phase1a(p, lds);
    xcd_barrier(xb);
    {
      pg8::Gemm g{(const pg8::bf16_t*)p.out, (const pg8::bf16_t*)(p.ws + WS_WTINP), NTOK, 2304, 1024};
      pg8::StaticOrder S; S.init(NTOK, 2304, (int)gridDim.x, (int)blockIdx.x);
      pg8::EpiProj E{(pg8::bf16_t*)(p.ws + WS_P1S), (pg8::bf16_t*)((unsigned char*)p.out + 32 * MiB), (pg8::bf16_t*)(p.ws + WS_PROJC)};
      pg8::gemm_phase<pg8::EpiProj, pg8::StaticOrder, true, true>((PG8_LAS unsigned char*)lds, g, S, E);
      if (blockIdx.x >= 64) convert_experts(p, (int)blockIdx.x - 64, (int)gridDim.x - 64);
    }
    xcd_barrier(xb);
    phase1c(p, lds);
    if (2 < hi) xcd_barrier(xb);
  }
  if (p.ph_lo <= 2 && 2 < hi) { phase2_scan(p); phase2_attn(p, lds); if (probe == 3) phase2_attn(p, lds); if (3 < hi) xcd_barrier(xb); }
  if (p.ph_lo <= 3 && 3 < hi) {
    phase3(p, lds, 1, probe);
    xcd_barrier(xb);
    {
      pg8::Gemm g{(const pg8::bf16_t*)(p.ws + WS_P1S), (const pg8::bf16_t*)(p.ws + WS_WTOUTP), NTOK, 1024, 1024};
      pg8::StaticOrder S; S.init(NTOK, 1024, (int)gridDim.x, (int)blockIdx.x);
      pg8::EpiBf16<0> E{(pg8::bf16_t*)(p.ws + WS_QM), 1024, nullptr, 0, 0, 1.f};
      pg8::gemm_phase<pg8::EpiBf16<0>, pg8::StaticOrder, true, true>((PG8_LAS unsigned char*)lds, g, S, E);
    }
    xcd_barrier(xb);
    phase3c(p, lds, 1, probe);
    xcd_barrier(xb);
    {
      pg8::Gemm g{(const pg8::bf16_t*)(p.ws + WS_P1S), (const pg8::bf16_t*)(p.ws + WS_WTPQP), NTOK, 2048, 1024};
      pg8::StaticOrder S; S.init(NTOK, 2048, (int)gridDim.x, (int)blockIdx.x);
      pg8::EpiBf16<0> E{(pg8::bf16_t*)(p.ws + WS_QM), 2048, nullptr, 0, 0, 1.f};
      pg8::gemm_phase<pg8::EpiBf16<0>, pg8::StaticOrder, true, true>((PG8_LAS unsigned char*)lds, g, S, E);
    }
    xcd_barrier(xb);
    phase3b(p, lds, (probe == 4 || probe == 8 || probe == 9 || probe == 10) ? 2 : 1, probe);
  }
}

extern "C" void kernel_launch(void* const* d_in, const int* in_sizes, int n_in, void* d_out, int out_size, void* d_ws, size_t ws_size, hipStream_t stream) {
  float* out = (float*)d_out;
  unsigned char* ws = (unsigned char*)d_ws;
  if (ws_size < WS_END || n_in != 25) return;
  static bool attr_done = false;
  if (!attr_done) { (void)hipFuncSetAttribute((const void*)mega, hipFuncAttributeMaxDynamicSharedMemorySize, LDS_TOTAL); attr_done = true; }
  KP p{};
  for (int i = 0; i < 25; ++i) p.in[i] = (const float*)d_in[i];
  p.out = out; p.ws = ws;
  p.ph_lo = 0; p.ph_hi = 4;
  (void)hipMemsetAsync(ws + WS_BAR, 0, XCD_BAR_WORDS * 4, stream);
  { void* args[] = {&p}; (void)hipLaunchCooperativeKernel((const void*)mega, dim3(256), dim3(NTHR), args, LDS_TOTAL, stream); }
}
```

```cpp
#include <hip/hip_runtime.h>
#include <hip/hip_cooperative_groups.h>
namespace cg = cooperative_groups;
#include <stdint.h>

typedef unsigned short bf16_t;
#define DI __device__ __forceinline__

DI float bf2f(bf16_t v) { return __uint_as_float(((unsigned)v) << 16); }
DI bf16_t f2bf(float f) { return __builtin_bit_cast(unsigned short, (__bf16)f); }

constexpr int BATCH = 8, SEQ = 2048, DM = 1024, NTOK = BATCH * SEQ;
constexpr int INW = 2272;
constexpr float EPS = 1e-6f;
constexpr int O_CQ = 0, O_CKV = 384, O_KR = 640, O_QG = 704, O_KG = 960, O_VG = 1216, O_GF = 1728, O_GB = 1744, O_R = 1760;

DI float wave_sum(float v) {
#pragma unroll
  for (int o = 1; o < 64; o <<= 1) v += __shfl_xor(v, o);
  return v;
}
DI float wave_max(float v) {
#pragma unroll
  for (int o = 1; o < 64; o <<= 1) v = fmaxf(v, __shfl_xor(v, o));
  return v;
}
DI float block_sum256(float v, float* red) {
  v = wave_sum(v);
  __syncthreads();
  if ((threadIdx.x & 63) == 0) red[threadIdx.x >> 6] = v;
  __syncthreads();
  return red[0] + red[1] + red[2] + red[3];
}
DI float block_max256(float v, float* red) {
  v = wave_max(v);
  __syncthreads();
  if ((threadIdx.x & 63) == 0) red[threadIdx.x >> 6] = v;
  __syncthreads();
  return fmaxf(fmaxf(red[0], red[1]), fmaxf(red[2], red[3]));
}
DI float silu_f(float x) { return x / (1.f + expf(-x)); }
DI float logsigmoid_f(float x) { return fminf(x, 0.f) - log1pf(expf(-fabsf(x))); }
DI float fexp(float x) { return __builtin_amdgcn_exp2f(x * 1.4426950408889634f); }
DI float silu_fast(float x) { return x * __builtin_amdgcn_rcpf(1.f + fexp(-x)); }
DI float logsigmoid_fast(float x) { return fminf(x, 0.f) - __builtin_amdgcn_logf(1.f + fexp(-fabsf(x))) * 0.6931471805599453f; }
DI float gelu_erf(float x) { return 0.5f * x * (1.f + erff(x * 0.70710678118654752f)); }

__global__ __launch_bounds__(256) void n_mod(const float* __restrict__ c, const float* __restrict__ w_ada, const float* __restrict__ b_ada, float* __restrict__ mod) {
  int idx = blockIdx.x * 256 + threadIdx.x;
  int b = idx / 6144, j = idx % 6144;
  float acc = b_ada[j];
  for (int k = 0; k < 1024; ++k) acc += silu_f(c[b * 1024 + k]) * w_ada[(size_t)k * 6144 + j];
  mod[idx] = acc;
}

__global__ __launch_bounds__(256) void n_hnorm(const float* __restrict__ x, const float* __restrict__ g, const float* __restrict__ mod, int b, int off_sh, int off_sc, float* __restrict__ h) {
  __shared__ float red[4];
  int t = blockIdx.x, tid = threadIdx.x;
  const float* xr = x + ((size_t)b * SEQ + t) * DM;
  float v[4]; float ss = 0.f;
#pragma unroll
  for (int i = 0; i < 4; ++i) { v[i] = xr[tid + 256 * i]; ss += v[i] * v[i]; }
  ss = block_sum256(ss, red);
  float rs = rsqrtf(ss * (1.f / DM) + EPS);
#pragma unroll
  for (int i = 0; i < 4; ++i) { int d = tid + 256 * i; h[(size_t)t * DM + d] = v[i] * rs * g[d] * (1.f + mod[b * 6144 + off_sc + d]) + mod[b * 6144 + off_sh + d]; }
}

template <bool BT>
__global__ __launch_bounds__(256) void n_gemm(const float* __restrict__ A, int lda, const float* __restrict__ B, int ldb, float* __restrict__ C, int ldc, int M, int N, int K) {
  __shared__ float As[16][65];
  __shared__ float Bs[16][65];
  const int tid = threadIdx.x, tx = tid & 15, ty = tid >> 4;
  const int m0 = blockIdx.y * 64, n0 = blockIdx.x * 64;
  float acc[4][4];
#pragma unroll
  for (int i = 0; i < 4; ++i)
#pragma unroll
    for (int j = 0; j < 4; ++j) acc[i][j] = 0.f;
  for (int k0 = 0; k0 < K; k0 += 16) {
#pragma unroll
    for (int i = 0; i < 4; ++i) { int e = tid + 256 * i; int m = e >> 4, k = e & 15; As[k][m] = A[(size_t)(m0 + m) * lda + k0 + k]; }
#pragma unroll
    for (int i = 0; i < 4; ++i) { int e = tid + 256 * i;
      if (!BT) { int k = e >> 6, n = e & 63; Bs[k][n] = (n0 + n < N) ? B[(size_t)(k0 + k) * ldb + n0 + n] : 0.f; }
      else     { int n = e >> 4, k = e & 15; Bs[k][n] = (n0 + n < N) ? B[(size_t)(n0 + n) * ldb + k0 + k] : 0.f; } }
    __syncthreads();
#pragma unroll
    for (int k = 0; k < 16; ++k) {
      float a[4], bb[4];
#pragma unroll
      for (int i = 0; i < 4; ++i) { a[i] = As[k][ty * 4 + i]; bb[i] = Bs[k][tx * 4 + i]; }
#pragma unroll
      for (int i = 0; i < 4; ++i)
#pragma unroll
        for (int j = 0; j < 4; ++j) acc[i][j] += a[i] * bb[j];
    }
    __syncthreads();
  }
#pragma unroll
  for (int i = 0; i < 4; ++i)
#pragma unroll
    for (int j = 0; j < 4; ++j) { int n = n0 + tx * 4 + j; if (n < N) C[(size_t)(m0 + ty * 4 + i) * ldc + n] = acc[i][j]; }
}

__global__ __launch_bounds__(256) void n_rms_slice(const float* __restrict__ in, int ldin, int off, int W, const float* __restrict__ g, float* __restrict__ out) {
  __shared__ float red[4];
  int t = blockIdx.x, tid = threadIdx.x;
  float v0 = (tid < W) ? in[(size_t)t * ldin + off + tid] : 0.f;
  float v1 = (tid + 256 < W) ? in[(size_t)t * ldin + off + tid + 256] : 0.f;
  float ss = block_sum256(v0 * v0 + v1 * v1, red);
  float rs = rsqrtf(ss / (float)W + EPS);
  if (tid < W) out[(size_t)t * W + tid] = v0 * rs * g[tid];
  if (tid + 256 < W) out[(size_t)t * W + tid + 256] = v1 * rs * g[tid + 256];
}

__global__ __launch_bounds__(256) void n_scatter(const float* __restrict__ proj, const float* __restrict__ qa, const float* __restrict__ kv, const int* __restrict__ positions, int b,
                                                 const float* __restrict__ wgf, const float* __restrict__ bgf, const float* __restrict__ wgb, const float* __restrict__ bgb,
                                                 bf16_t* __restrict__ Qm, bf16_t* __restrict__ Km, bf16_t* __restrict__ Vm, bf16_t* __restrict__ qg, bf16_t* __restrict__ kg, bf16_t* __restrict__ vg,
                                                 bf16_t* __restrict__ rg, float* __restrict__ laf, float* __restrict__ lab) {
  __shared__ float cs[32], sn[32];
  const int t = blockIdx.x, tid = threadIdx.x;
  const size_t tok = (size_t)b * SEQ + t;
  const float* pr = proj + (size_t)t * INW;
  const float* qr = qa + (size_t)t * 768;
  const float* kr = kv + (size_t)t * 1024;
  if (tid < 32) {
    float inv = powf(10000.f, -(float)tid / 32.f);
    float ang = (float)positions[tok] * inv;
    cs[tid] = cosf(ang); sn[tid] = sinf(ang);
  }
  __syncthreads();
  for (int e = tid; e < 4 * 192; e += 256) {
    int h = e / 192, d = e % 192; float v;
    if (d < 128) v = qr[h * 192 + d];
    else { int j = d - 128; const float* rp = qr + h * 192 + 128;
      if (j < 32) v = rp[j] * cs[j] - rp[j + 32] * sn[j]; else v = rp[j] * cs[j - 32] + rp[j - 32] * sn[j - 32]; }
    Qm[(((size_t)b * 4 + h) * SEQ + t) * 192 + d] = f2bf(v);
  }
  for (int e = tid; e < 4 * 192; e += 256) {
    int h = e / 192, d = e % 192; float v;
    if (d < 128) v = kr[h * 256 + d];
    else { int j = d - 128; const float* rp = pr + O_KR;
      if (j < 32) v = rp[j] * cs[j] - rp[j + 32] * sn[j]; else v = rp[j] * cs[j - 32] + rp[j - 32] * sn[j - 32]; }
    Km[(((size_t)b * 4 + h) * SEQ + t) * 192 + d] = f2bf(v);
  }
  for (int e = tid; e < 512; e += 256) { int h = e >> 7, d = e & 127; Vm[(((size_t)b * 4 + h) * SEQ + t) * 128 + d] = f2bf(kr[h * 256 + 128 + d]); }
  { int e = tid; qg[tok * 256 + e] = f2bf(pr[O_QG + e] * 0.125f); kg[tok * 256 + e] = f2bf(pr[O_KG + e]); }
  for (int e = tid; e < 512; e += 256) { vg[tok * 512 + e] = f2bf(pr[O_VG + e]); rg[tok * 512 + e] = f2bf(pr[O_R + e]); }
  { int cidx = tid; float af = bgf[cidx], ab = bgb[cidx];
#pragma unroll
    for (int r = 0; r < 16; ++r) { af += pr[O_GF + r] * wgf[r * 256 + cidx]; ab += pr[O_GB + r] * wgb[r * 256 + cidx]; }
    laf[tok * 256 + cidx] = logsigmoid_f(af) * (1.f / 16.f); lab[tok * 256 + cidx] = logsigmoid_f(ab) * (1.f / 16.f); }
}

__global__ __launch_bounds__(256) void n_attn(const bf16_t* __restrict__ Qm, const bf16_t* __restrict__ Km, const bf16_t* __restrict__ Vm, bf16_t* __restrict__ omla) {
  __shared__ float qs[192]; __shared__ float sc[2048]; __shared__ float red[4];
  const int i = blockIdx.x, h = blockIdx.y, b = blockIdx.z, tid = threadIdx.x;
  const size_t bh = (size_t)b * 4 + h;
  if (tid < 192) qs[tid] = bf2f(Qm[(bh * SEQ + i) * 192 + tid]);
  __syncthreads();
  float mx = -1e30f;
  for (int kk = 0; kk < 8; ++kk) {
    int key = tid + 256 * kk; const uint4* kr = (const uint4*)(Km + (bh * SEQ + key) * 192);
    float s = 0.f;
    for (int c = 0; c < 24; ++c) { uint4 w = kr[c]; const float* q = qs + c * 8;
      s += q[0] * __uint_as_float(w.x << 16) + q[1] * __uint_as_float(w.x & 0xffff0000u) + q[2] * __uint_as_float(w.y << 16) + q[3] * __uint_as_float(w.y & 0xffff0000u)
         + q[4] * __uint_as_float(w.z << 16) + q[5] * __uint_as_float(w.z & 0xffff0000u) + q[6] * __uint_as_float(w.w << 16) + q[7] * __uint_as_float(w.w & 0xffff0000u); }
    s *= 0.07216878364870322f; sc[key] = s; mx = fmaxf(mx, s);
  }
  mx = block_max256(mx, red);
  float sum = 0.f;
  for (int kk = 0; kk < 8; ++kk) { int key = tid + 256 * kk; float p = expf(sc[key] - mx); sc[key] = p; sum += p; }
  sum = block_sum256(sum, red);
  __syncthreads();
  if (tid < 128) { float o = 0.f; const bf16_t* vp = Vm + bh * SEQ * 128 + tid;
    for (int key = 0; key < SEQ; ++key) o += sc[key] * bf2f(vp[(size_t)key * 128]);
    omla[((size_t)b * SEQ + i) * 512 + h * 128 + tid] = f2bf(o / sum); }
}

__global__ __launch_bounds__(128) void n_gla(const bf16_t* __restrict__ qg, const bf16_t* __restrict__ kg, const bf16_t* __restrict__ vg, const bf16_t* __restrict__ laf, const bf16_t* __restrict__ lab, float* __restrict__ og) {
  __shared__ float qs[64], ks[64], as[64];
  const int bh = blockIdx.x, b = bh >> 2, h = bh & 3, dv = threadIdx.x;
  for (int dir = 0; dir < 2; ++dir) {
    float S[64];
#pragma unroll
    for (int d = 0; d < 64; ++d) S[d] = 0.f;
    const bf16_t* la = dir ? lab : laf;
    for (int s = 0; s < SEQ; ++s) {
      const int t = dir ? (SEQ - 1 - s) : s; const size_t tok = (size_t)b * SEQ + t;
      __syncthreads();
      if (dv < 64) { qs[dv] = bf2f(qg[tok * 256 + h * 64 + dv]); ks[dv] = bf2f(kg[tok * 256 + h * 64 + dv]); as[dv] = expf(bf2f(la[tok * 256 + h * 64 + dv])); }
      __syncthreads();
      const float v = bf2f(vg[tok * 512 + h * 128 + dv]); float o = 0.f;
#pragma unroll
      for (int d = 0; d < 64; ++d) { S[d] = as[d] * S[d] + ks[d] * v; o += qs[d] * S[d]; }
      if (dir == 0) og[tok * 512 + h * 128 + dv] = o; else og[tok * 512 + h * 128 + dv] += o;
    }
  }
}

__global__ __launch_bounds__(256) void n_mix(const bf16_t* __restrict__ omla, const float* __restrict__ og, const bf16_t* __restrict__ rg, const float* __restrict__ g_gla, int b, float* __restrict__ mix) {
  __shared__ float ssum[4];
  const int t = blockIdx.x, tid = threadIdx.x; const size_t tok = (size_t)b * SEQ + t;
  if (tid < 4) ssum[tid] = 0.f;
  __syncthreads();
  float v[2];
#pragma unroll
  for (int i = 0; i < 2; ++i) { int e = tid + 256 * i; v[i] = og[tok * 512 + e]; atomicAdd(&ssum[e >> 7], v[i] * v[i]); mix[(size_t)t * DM + e] = bf2f(omla[tok * 512 + e]); }
  __syncthreads();
#pragma unroll
  for (int i = 0; i < 2; ++i) { int e = tid + 256 * i; float rs = rsqrtf(ssum[e >> 7] * (1.f / 128.f) + EPS);
    mix[(size_t)t * DM + 512 + e] = v[i] * rs * g_gla[e & 127] * silu_f(bf2f(rg[tok * 512 + e])); }
}

__global__ __launch_bounds__(256) void n_post1(const float* __restrict__ x, const float* __restrict__ y, const float* __restrict__ g_post, const float* __restrict__ g_pre2, const float* __restrict__ mod, int b,
                                               float* __restrict__ out, float* __restrict__ h2) {
  __shared__ float red[4];
  const int t = blockIdx.x, tid = threadIdx.x; const size_t tok = (size_t)b * SEQ + t;
  float yv[4], xv[4]; float ss = 0.f;
#pragma unroll
  for (int i = 0; i < 4; ++i) { yv[i] = y[(size_t)t * DM + tid + 256 * i]; ss += yv[i] * yv[i]; }
  ss = block_sum256(ss, red);
  float rs = rsqrtf(ss * (1.f / DM) + EPS); float s2 = 0.f;
#pragma unroll
  for (int i = 0; i < 4; ++i) { int d = tid + 256 * i; xv[i] = x[tok * DM + d] + mod[b * 6144 + 2048 + d] * (yv[i] * rs * g_post[d]); out[tok * DM + d] = xv[i]; s2 += xv[i] * xv[i]; }
  s2 = block_sum256(s2, red);
  float r2 = rsqrtf(s2 * (1.f / DM) + EPS);
#pragma unroll
  for (int i = 0; i < 4; ++i) { int d = tid + 256 * i; h2[(size_t)t * DM + d] = xv[i] * r2 * g_pre2[d] * (1.f + mod[b * 6144 + 4096 + d]) + mod[b * 6144 + 3072 + d]; }
}

DI void wave_argmax(float& v, int& i) {
#pragma unroll
  for (int o = 1; o < 64; o <<= 1) { float ov = __shfl_xor(v, o); int oi = __shfl_xor(i, o); if (ov > v || (ov == v && oi < i)) { v = ov; i = oi; } }
}
__global__ __launch_bounds__(256) void n_peer_select(const float* __restrict__ qry, const float* __restrict__ sk1, const float* __restrict__ sk2, int* __restrict__ eidx, float* __restrict__ gate) {
  __shared__ float v1s[4][16], v2s[4][16]; __shared__ int i1s[4][16], i2s[4][16];
  const int w = threadIdx.x >> 6, lane = threadIdx.x & 63;
  const int pair = blockIdx.x * 4 + w;
  const int t = pair >> 3, h = pair & 7;
  const float* q1 = qry + (size_t)t * 2048 + h * 256; const float* q2 = q1 + 128;
  float s1a = 0.f, s1b = 0.f, s2a = 0.f, s2b = 0.f;
  for (int d = 0; d < 128; ++d) { float a = q1[d], bq = q2[d];
    s1a += a * sk1[lane * 128 + d]; s1b += a * sk1[(lane + 64) * 128 + d]; s2a += bq * sk2[lane * 128 + d]; s2b += bq * sk2[(lane + 64) * 128 + d]; }
  for (int side = 0; side < 2; ++side) {
    float va = side ? s2a : s1a, vb = side ? s2b : s1b; bool ta = false, tb = false;
    for (int k = 0; k < 16; ++k) {
      float bv; int bi;
      if (!ta && (tb || va >= vb)) { bv = va; bi = lane; } else if (!tb) { bv = vb; bi = lane + 64; } else { bv = -3e38f; bi = 1 << 20; }
      wave_argmax(bv, bi);
      if (bi == lane) ta = true; if (bi == lane + 64) tb = true;
      if (lane == 0) { if (side) { v2s[w][k] = bv; i2s[w][k] = bi; } else { v1s[w][k] = bv; i1s[w][k] = bi; } }
    }
  }
  __syncthreads();
  float cv[4]; bool tk[4];
#pragma unroll
  for (int j = 0; j < 4; ++j) { int c = lane + 64 * j; cv[j] = v1s[w][c >> 4] + v2s[w][c & 15]; tk[j] = false; }
  float topv = 0.f; int topc = 0; float mx = 0.f;
  for (int k = 0; k < 16; ++k) {
    float bv = -3e38f; int bi = 1 << 20;
#pragma unroll
    for (int j = 0; j < 4; ++j) { if (!tk[j] && cv[j] > bv) { bv = cv[j]; bi = lane + 64 * j; } }
    wave_argmax(bv, bi);
#pragma unroll
    for (int j = 0; j < 4; ++j) if (bi == lane + 64 * j) tk[j] = true;
    if (k == 0) mx = bv;
    if (lane == k) { topv = bv; topc = bi; }
  }
  float e = (lane < 16) ? expf(topv - mx) : 0.f;
  float sum = wave_sum(e);
  if (lane < 16) { eidx[(size_t)pair * 16 + lane] = i1s[w][topc >> 4] * 128 + i2s[w][topc & 15]; gate[(size_t)pair * 16 + lane] = e / sum; }
}

__global__ __launch_bounds__(256) void n_peer_apply(const float* __restrict__ h2, const int* __restrict__ eidx, const float* __restrict__ gate, const float* __restrict__ eu, const float* __restrict__ ev,
                                                    const float* __restrict__ g_post, const float* __restrict__ mod, int b, float* __restrict__ out) {
  __shared__ float ys[4][1024]; __shared__ float red[4];
  const int t = blockIdx.x, tid = threadIdx.x, w = tid >> 6, lane = tid & 63; const size_t tok = (size_t)b * SEQ + t;
  float4 hx[4];
#pragma unroll
  for (int i = 0; i < 4; ++i) hx[i] = *(const float4*)(h2 + (size_t)t * DM + (lane + 64 * i) * 4);
  float4 acc[4];
#pragma unroll
  for (int i = 0; i < 4; ++i) acc[i] = make_float4(0.f, 0.f, 0.f, 0.f);
  for (int k = w; k < 128; k += 4) {
    const int e = eidx[(size_t)t * 128 + k]; const float gt = gate[(size_t)t * 128 + k];
    const float4* ur = (const float4*)(eu + (size_t)e * DM); const float4* vr = (const float4*)(ev + (size_t)e * DM);
    float d = 0.f;
#pragma unroll
    for (int i = 0; i < 4; ++i) { float4 u = ur[lane + 64 * i]; d += u.x * hx[i].x + u.y * hx[i].y + u.z * hx[i].z + u.w * hx[i].w; }
    d = wave_sum(d);
    const float wgt = gt * gelu_erf(d);
#pragma unroll
    for (int i = 0; i < 4; ++i) { float4 v = vr[lane + 64 * i]; acc[i].x += wgt * v.x; acc[i].y += wgt * v.y; acc[i].z += wgt * v.z; acc[i].w += wgt * v.w; }
  }
#pragma unroll
  for (int i = 0; i < 4; ++i) *(float4*)(&ys[w][(lane + 64 * i) * 4]) = acc[i];
  __syncthreads();
  float yv[4]; float ss = 0.f;
#pragma unroll
  for (int i = 0; i < 4; ++i) { int d = tid + 256 * i; yv[i] = ys[0][d] + ys[1][d] + ys[2][d] + ys[3][d]; ss += yv[i] * yv[i]; }
  ss = block_sum256(ss, red);
  const float rs = rsqrtf(ss * (1.f / DM) + EPS);
#pragma unroll
  for (int i = 0; i < 4; ++i) { int d = tid + 256 * i; out[tok * DM + d] = out[tok * DM + d] + mod[b * 6144 + 5120 + d] * (yv[i] * rs * g_post[d]); }
}

typedef short bf16x8 __attribute__((ext_vector_type(8)));
typedef float f32x16 __attribute__((ext_vector_type(16)));
#define MFMA32(a, b, c) __builtin_amdgcn_mfma_f32_32x32x16_bf16((a), (b), (c), 0, 0, 0)

constexpr int NTHR = 512;
constexpr size_t MiB = 1024 * 1024;
constexpr size_t WS_MOD   = 0;
constexpr size_t WS_WTIN  = 256 * 1024;
constexpr size_t WS_WTQUP = WS_WTIN + (size_t)2304 * 1024 * 2;
constexpr size_t WS_WTKVUP = WS_WTQUP + (size_t)768 * 384 * 2;
constexpr size_t WS_WTOUT = WS_WTKVUP + (size_t)1024 * 256 * 2;
constexpr size_t WS_WTPQ  = WS_WTOUT + (size_t)1024 * 1024 * 2;
constexpr size_t WS_KD    = WS_WTPQ + (size_t)2048 * 1024 * 2;
constexpr size_t WS_DEC   = WS_KD + (size_t)256 * 256 * 2;
constexpr size_t WS_ESC   = WS_DEC + (size_t)2048 * 64 * 4;
constexpr size_t WS_R0END = WS_ESC + (size_t)2 * 16384 * 4;
static_assert(WS_R0END <= 13 * MiB, "R0");
constexpr size_t WS_BAR  = 13 * MiB - 65536;
static_assert(WS_R0END + 131072 <= WS_BAR, "R0 room");
constexpr size_t WS_QM   = 13 * MiB;
constexpr size_t WS_KM   = WS_QM + 24 * MiB;
constexpr size_t WS_VM   = WS_KM + 24 * MiB;
constexpr size_t WS_P1S  = WS_VM + 16 * MiB;
constexpr size_t WS_RG   = WS_P1S + 32 * MiB;
constexpr size_t WS_X1B  = WS_RG;
constexpr size_t WS_OINTRA = WS_RG + 16 * MiB;
constexpr size_t WS_QDEC = WS_OINTRA + 16 * MiB;
constexpr size_t WS_SPT  = WS_QDEC + 16 * MiB;
constexpr size_t WS_EU   = WS_SPT + 32 * MiB;
constexpr size_t WS_EV   = WS_EU + 16 * MiB;
constexpr size_t WS_WTPQP = WS_EV + 16 * MiB;
constexpr size_t WS_WTOUTP = WS_WTPQP + 4 * MiB;
constexpr size_t WS_WTINP = WS_WTOUTP + 2 * MiB;
constexpr size_t WS_PROJC = WS_WTINP + 4608 * 1024;
constexpr size_t WS_END  = WS_PROJC + 8 * MiB;
static_assert(WS_P1S == WS_QM + 64 * MiB, "P3 QRY scratch aliases QM..VM");
constexpr size_t OUT_HS  = 0;
constexpr size_t OUT_CQ  = 32 * MiB;
constexpr size_t OUT_GR  = 52 * MiB;

struct KP { const float* in[25]; float* out; unsigned char* ws; int ph_lo, ph_hi; };

constexpr int G_STG = 40960;
constexpr int LDS_WT = 3 * G_STG;
constexpr int LDS_TAB = LDS_WT + 18432;
constexpr int LDS_XB = 157696;
constexpr int LDS_TOTAL = 157696 + 16;

typedef float f32x2_t __attribute__((ext_vector_type(2)));
typedef __bf16 bf16x2_t __attribute__((ext_vector_type(2)));
DI unsigned pack2(float lo, float hi) { const f32x2_t v = {lo, hi}; return __builtin_bit_cast(unsigned, __builtin_convertvector(v, bf16x2_t)); }
DI int crow(int reg, int hh) { return (reg & 3) + 8 * (reg >> 2) + 4 * hh; }
typedef unsigned u32x2_wt __attribute__((ext_vector_type(2)));
DI void st_wt8(void* q, uint2 v) { const u32x2_wt t = {v.x, v.y}; asm volatile("global_store_dwordx2 %0, %1, off sc1\n\ts_nop 1" :: "v"(q), "v"(t) : "memory"); }
typedef unsigned u32x4_wt __attribute__((ext_vector_type(4)));
DI void st_wt16(void* q, uint4 v) { const u32x4_wt t = {v.x, v.y, v.z, v.w}; asm volatile("global_store_dwordx4 %0, %1, off sc1\n\ts_nop 1" :: "v"(q), "v"(t) : "memory"); }
DI void st_wt4(void* q, unsigned v) { asm volatile("global_store_dword %0, %1, off sc1\n\ts_nop 1" :: "v"(q), "v"(v) : "memory"); }

#define GLDS16(gp, lp) __builtin_amdgcn_global_load_lds((const unsigned*)(gp), (__attribute__((address_space(3))) unsigned*)(lp), 16, 0, 0)
template <int NST, class Epi>
DI void block_gemm(char* lds, const bf16_t* A, int lda, const bf16_t* Bt, int nchunks, int K, Epi&& epi) {
  const int tid = threadIdx.x, lane = tid & 63, w = __builtin_amdgcn_readfirstlane(tid >> 6), r = lane & 31, hh = lane >> 5;
  const int nk = K >> 6, T = nchunks * nk;
  constexpr int D = NST - 1;
  if (w >= 4) {
    const int j = w - 4, rin = lane >> 3, sw = ((lane & 7) ^ rin) * 8;
    const bf16_t* Ap = A + (size_t)(16 * j + rin) * lda + sw;
    const bf16_t* Bp = Bt + (size_t)(64 * j + rin) * 64 + sw;
    auto dma = [&](int g) {
      const int ch = g / nk, t = g - ch * nk; char* st = lds + (g % NST) * G_STG;
      const bf16_t* a0 = Ap + t * 64; char* la = st + (2 * j) * 1024;
      GLDS16(a0, la); GLDS16(a0 + (size_t)8 * lda, la + 1024);
      const bf16_t* b0 = Bp + (size_t)g * 16384; char* lb = st + 8192 + (8 * j) * 1024;
#pragma unroll
      for (int i = 0; i < 8; ++i) GLDS16(b0 + i * 512, lb + i * 1024);
    };
#pragma unroll
    for (int g = 0; g < D; ++g) if (g < T) dma(g);
    if (D >= 2 && T >= 2) asm volatile("s_waitcnt vmcnt(10)" ::: "memory"); else asm volatile("s_waitcnt vmcnt(0)" ::: "memory");
    __builtin_amdgcn_s_barrier();
#pragma unroll 1
    for (int g = 0; g < T; ++g) {
      if (g + D < T) { dma(g + D); if (D >= 2) asm volatile("s_waitcnt vmcnt(10)" ::: "memory"); else asm volatile("s_waitcnt vmcnt(0)" ::: "memory"); }
      else asm volatile("s_waitcnt vmcnt(0)" ::: "memory");
      __builtin_amdgcn_s_barrier();
    }
  } else {
    const int x = r & 7;
    const int o0 = ((0 + hh) ^ x) * 16, o1 = ((2 + hh) ^ x) * 16, o2 = ((4 + hh) ^ x) * 16, o3 = ((6 + hh) ^ x) * 16;
    const int a_rd = r * 128, b_rd = 8192 + (w * 64 + r) * 128;
    __builtin_amdgcn_s_barrier();
    int g = 0;
#pragma unroll 1
    for (int ch = 0; ch < nchunks; ++ch) {
      f32x16 c00, c01, c10, c11;
#pragma unroll
      for (int i = 0; i < 16; ++i) { c00[i] = 0.f; c01[i] = 0.f; c10[i] = 0.f; c11[i] = 0.f; }
#pragma unroll 1
      for (int t = 0; t < nk; ++t, ++g) {
        const char* cur = lds + (g % NST) * G_STG;
        bf16x8 fa0[4], fa1[4], fb0[4], fb1[4];
#define FRD(s_, o_) do { fa0[s_] = *(const bf16x8*)(cur + a_rd + o_); fb0[s_] = *(const bf16x8*)(cur + b_rd + o_); fb1[s_] = *(const bf16x8*)(cur + b_rd + 4096 + o_); fa1[s_] = *(const bf16x8*)(cur + a_rd + 4096 + o_); } while (0)
        FRD(0, o0); FRD(1, o1); FRD(2, o2); FRD(3, o3);
#undef FRD
        asm volatile("s_waitcnt lgkmcnt(0)" ::: "memory");
        __builtin_amdgcn_s_barrier();
        __builtin_amdgcn_sched_barrier(0);
#pragma unroll
        for (int s = 0; s < 4; ++s) {
          c00 = MFMA32(fa0[s], fb0[s], c00); c01 = MFMA32(fa0[s], fb1[s], c01); c10 = MFMA32(fa1[s], fb0[s], c10); c11 = MFMA32(fa1[s], fb1[s], c11); }
      }
      epi(0, ch * 256 + w * 64, c00, c01);
      epi(32, ch * 256 + w * 64, c10, c11);
    }
  }
}

DI void p0_transpose(char* lds, const float* __restrict__ W, int K, int N, bf16_t* __restrict__ Wt, int item, bf16_t* __restrict__ Wplain = nullptr) {
  float* s = (float*)lds;
  const int tid = threadIdx.x;
  const int ntn = (N + 63) >> 6, kt = item / ntn, nt = item % ntn, k0 = kt * 64, n0 = nt * 64;
  __syncthreads();
#pragma unroll
  for (int i = 0; i < 8; ++i) { int e = tid + 512 * i; int kk = e >> 6, nn = e & 63; s[kk * 65 + nn] = (n0 + nn < N) ? W[(size_t)(k0 + kk) * N + n0 + nn] : 0.f; }
  __syncthreads();
  const int nn = tid >> 3, part = tid & 7;
  const float* sp = s + (part * 8) * 65 + nn;
  uint4 o; o.x = pack2(sp[0], sp[65]); o.y = pack2(sp[2 * 65], sp[3 * 65]); o.z = pack2(sp[4 * 65], sp[5 * 65]); o.w = pack2(sp[6 * 65], sp[7 * 65]);
  { const int n = n0 + nn; *(uint4*)(Wt + ((size_t)((n >> 8) * (K >> 6) + kt)) * 16384 + (n & 255) * 64 + part * 8) = o; }
  if (Wplain) *(uint4*)(Wplain + (size_t)(n0 + nn) * K + k0 + part * 8) = o;
}

DI void convert_experts(const KP& p, const int bid, const int nb) {
  const int tid = threadIdx.x; unsigned char* ws = p.ws;
  { const int lane = tid & 63; float* scl = (float*)(ws + WS_ESC);
    for (int row = bid * 8 + (tid >> 6); row < 32768; row += nb * 8) { const int t = row >> 14, e = row & 16383;
      const float* src = p.in[23 + t] + (size_t)e * 1024 + lane * 16;
      float4 x[4]; float am = 0.f;
#pragma unroll
      for (int i = 0; i < 4; ++i) { x[i] = *(const float4*)(src + 4 * i); am = fmaxf(am, fmaxf(fmaxf(fabsf(x[i].x), fabsf(x[i].y)), fmaxf(fabsf(x[i].z), fabsf(x[i].w)))); }
      am = wave_max(am);
      float sc = 1.f, isc = 1.f;
      if (am > 0.f) { int ex; (void)frexpf((t ? 448.f : 127.f) / am, &ex); sc = ldexpf(1.f, ex - 1); isc = ldexpf(1.f, 1 - ex); }
      unsigned wv[4];
      if (t) {
#pragma unroll
        for (int i = 0; i < 4; ++i) { int q = __builtin_amdgcn_cvt_pk_fp8_f32(x[i].x * sc, x[i].y * sc, 0, false); q = __builtin_amdgcn_cvt_pk_fp8_f32(x[i].z * sc, x[i].w * sc, q, true); wv[i] = (unsigned)q; }
      } else {
#pragma unroll
        for (int i = 0; i < 4; ++i) { const int q0 = (int)rintf(x[i].x * sc), q1 = (int)rintf(x[i].y * sc), q2 = (int)rintf(x[i].z * sc), q3 = (int)rintf(x[i].w * sc);
          wv[i] = (unsigned)(q0 & 255) | ((unsigned)(q1 & 255) << 8) | ((unsigned)(q2 & 255) << 16) | ((unsigned)(q3 & 255) << 24); }
      }
      *(uint4*)(ws + (t ? WS_EV : WS_EU) + (size_t)e * 1024 + lane * 16) = make_uint4(wv[0], wv[1], wv[2], wv[3]);
      if (lane == 0) ((unsigned char*)scl)[e * 2 + (t ? 0 : 1)] = (unsigned char)((__float_as_uint(isc) >> 23) & 255u); } }
}

DI void conv_row_load(const KP& p, int row, int lane, float4 (&x)[4]) {
  const float* src = p.in[23 + (row >> 14)] + (size_t)(row & 16383) * 1024 + lane * 4;
#pragma unroll
  for (int i = 0; i < 4; ++i) { typedef float f32x4_s __attribute__((ext_vector_type(4))); const f32x4_s t_ = __builtin_nontemporal_load((const f32x4_s*)(src + 256 * i)); x[i] = make_float4(t_.x, t_.y, t_.z, t_.w); }
}
DI void conv_row_finish(unsigned char* ws, int row, int lane, const float4 (&x)[4]) {
  const int t = row >> 14, e = row & 16383; float am = 0.f;
#pragma unroll
  for (int i = 0; i < 4; ++i) am = fmaxf(am, fmaxf(fmaxf(fabsf(x[i].x), fabsf(x[i].y)), fmaxf(fabsf(x[i].z), fabsf(x[i].w))));
  am = wave_max(am);
  float sc = 1.f, isc = 1.f;
  if (am > 0.f) { int ex; (void)frexpf((t ? 448.f : 127.f) / am, &ex); sc = ldexpf(1.f, ex - 1); isc = ldexpf(1.f, 1 - ex); }
  unsigned* dst = (unsigned*)(ws + (t ? WS_EV : WS_EU) + (size_t)e * 1024) + lane;
  if (t) {
#pragma unroll
    for (int i = 0; i < 4; ++i) { int q = __builtin_amdgcn_cvt_pk_fp8_f32(x[i].x * sc, x[i].y * sc, 0, false); q = __builtin_amdgcn_cvt_pk_fp8_f32(x[i].z * sc, x[i].w * sc, q, true); st_wt4(dst + 64 * i, (unsigned)q); }
  } else {
#pragma unroll
    for (int i = 0; i < 4; ++i) { const int q0 = (int)rintf(x[i].x * sc), q1 = (int)rintf(x[i].y * sc), q2 = (int)rintf(x[i].z * sc), q3 = (int)rintf(x[i].w * sc);
      st_wt4(dst + 64 * i, (unsigned)(q0 & 255) | ((unsigned)(q1 & 255) << 8) | ((unsigned)(q2 & 255) << 16) | ((unsigned)(q3 & 255) << 24)); }
  }
  if (lane == 0) ((unsigned char*)(ws + WS_ESC))[e * 2 + (t ? 0 : 1)] = (unsigned char)((__float_as_uint(isc) >> 23) & 255u);
}

constexpr int MOD_JOBS = 192;
DI int phase0_mod(const KP& p, char* lds) {
  const int tid = threadIdx.x, bid = blockIdx.x, nb = gridDim.x; unsigned char* ws = p.ws; int njobs = 0;
  for (int jb = bid; jb < MOD_JOBS; jb += nb) {
    __syncthreads();
    float* cact = (float*)lds;
    float* red = (float*)(lds + 32768);
    for (int e = tid; e < 8192; e += NTHR) cact[e] = silu_f(p.in[1][e]);
    __syncthreads();
    const int jj = tid & 31, ks = tid >> 5, j0 = jb * 32;
    float acc[8];
#pragma unroll
    for (int b = 0; b < 8; ++b) acc[b] = 0.f;
    const float* wp = p.in[3] + (size_t)(ks * 64) * 6144 + j0 + jj;
#pragma unroll 8
    for (int k = 0; k < 64; ++k) { const float wv = __builtin_nontemporal_load(wp + (size_t)k * 6144);
#pragma unroll
      for (int b = 0; b < 8; ++b) acc[b] += cact[b * 1024 + ks * 64 + k] * wv; }
#pragma unroll
    for (int b = 0; b < 8; ++b) red[(ks * 32 + jj) * 8 + b] = acc[b];
    __syncthreads();
    if (tid < 256) { const int b = tid >> 5; float sacc = p.in[4][j0 + jj];
#pragma unroll
      for (int k2 = 0; k2 < 16; ++k2) sacc += red[(k2 * 32 + jj) * 8 + b];
      ((float*)(ws + WS_MOD))[b * 6144 + j0 + jj] = sacc; }
    ++njobs;
  }
  return njobs;
}

DI void p0_transpose_wave(float* s, const float* __restrict__ W, int K, int N, int item, bf16_t* __restrict__ Wtiled, bf16_t* __restrict__ Wplain) {
  const int lane = threadIdx.x & 63;
  const int ntn = (N + 63) >> 6, kt = item / ntn, nt = item % ntn, k0 = kt * 64, n0 = nt * 64;
  const int c4 = (lane & 15) * 4, rq = lane >> 4;
  float4 v[16];
#pragma unroll
  for (int i = 0; i < 16; ++i) { const int kk = 4 * i + rq;
    if (n0 + c4 < N) { typedef float f32x4_s __attribute__((ext_vector_type(4))); const f32x4_s t_ = __builtin_nontemporal_load((const f32x4_s*)(W + (size_t)(k0 + kk) * N + n0 + c4)); v[i] = make_float4(t_.x, t_.y, t_.z, t_.w); } else v[i] = make_float4(0.f, 0.f, 0.f, 0.f); }
#pragma unroll
  for (int i = 0; i < 16; ++i) { const int kk = 4 * i + rq;
    float* d = s + kk * 65 + c4; d[0] = v[i].x; d[1] = v[i].y; d[2] = v[i].z; d[3] = v[i].w; }
  __builtin_amdgcn_wave_barrier(); asm volatile("" ::: "memory");
#pragma unroll
  for (int q = 0; q < 8; ++q) { const int c = lane + 64 * q, nn = c >> 3, part = c & 7;
    const float* sp = s + (part * 8) * 65 + nn;
    uint4 o; o.x = pack2(sp[0], sp[65]); o.y = pack2(sp[2 * 65], sp[3 * 65]); o.z = pack2(sp[4 * 65], sp[5 * 65]); o.w = pack2(sp[6 * 65], sp[7 * 65]);
    const int n = n0 + nn;
    if (Wtiled) st_wt16(Wtiled + ((size_t)((n >> 8) * (K >> 6) + kt)) * 16384 + (n & 255) * 64 + part * 8, o);
    if (Wplain) st_wt16(Wplain + (size_t)n * K + k0 + part * 8, o); }
  __builtin_amdgcn_wave_barrier(); asm volatile("" ::: "memory");
}

DI void phase0(const KP& p, char* lds) {
  const int tid = threadIdx.x, bid = blockIdx.x, nb = gridDim.x;
  unsigned char* ws = p.ws;
  constexpr int I_IN = 16 * 36, I_QUP = 6 * 12, I_KVUP = 4 * 16, I_OUT = 16 * 16, I_PQ = 16 * 32;
  constexpr int I_ALL = I_IN + I_QUP + I_KVUP + I_OUT + I_PQ;
  { const int w = tid >> 6, nwv = nb * 8; float* s = (float*)(lds + w * 16640);
    for (int it = nwv - 1 - (bid * 8 + w); it < I_ALL; it += nwv) {
      int q = it;
      if (q < I_IN) { p0_transpose_wave(s, p.in[7], 1024, 2272, q, (bf16_t*)(ws + WS_WTIN), (bf16_t*)(ws + WS_WTINP)); continue; } q -= I_IN;
      if (q < I_QUP) { p0_transpose_wave(s, p.in[9], 384, 768, q, (bf16_t*)(ws + WS_WTQUP), nullptr); continue; } q -= I_QUP;
      if (q < I_KVUP) { p0_transpose_wave(s, p.in[11], 256, 1024, q, (bf16_t*)(ws + WS_WTKVUP), nullptr); continue; } q -= I_KVUP;
      if (q < I_OUT) { p0_transpose_wave(s, p.in[17], 1024, 1024, q, nullptr, (bf16_t*)(ws + WS_WTOUTP)); continue; } q -= I_OUT;
      p0_transpose_wave(s, p.in[20], 1024, 2048, q, nullptr, (bf16_t*)(ws + WS_WTPQP));
    }
  }
  { bf16_t* kd = (bf16_t*)(ws + WS_KD);
    for (int e = bid * NTHR + tid; e < 65536; e += nb * NTHR) { int n = e >> 8, k = e & 255; float v = 0.f;
      if (n < 128 && k < 128) v = p.in[21][n * 128 + k]; else if (n >= 128 && k >= 128) v = p.in[22][(n - 128) * 128 + (k - 128)];
      kd[(size_t)(k >> 6) * 16384 + n * 64 + (k & 63)] = f2bf(v); } }
}

constexpr int WT_STRIDE = 144, WT_BYTES = 32 * WT_STRIDE;
DI void wt_write(char* wl, const f32x16& a0, const f32x16& a1, int r, int hh, float scale) {
  char* bp = wl + (4 * hh) * WT_STRIDE + r * 2;
#pragma unroll
  for (int reg = 0; reg < 16; ++reg) { const int ro = ((reg & 3) + 8 * (reg >> 2)) * WT_STRIDE;
    *(bf16_t*)(bp + ro) = f2bf(a0[reg] * scale); *(bf16_t*)(bp + ro + 64) = f2bf(a1[reg] * scale); }
}
DI void wt_write_rope(char* wl, const f32x16& a0, const f32x16& a1, int r, int hh, const float* cs, const float* sn, int m0) {
  char* bp = wl + (4 * hh) * WT_STRIDE + r * 2;
#pragma unroll
  for (int reg = 0; reg < 16; ++reg) { const int rw = (reg & 3) + 8 * (reg >> 2); const int row = m0 + rw + 4 * hh;
    const float c = cs[row * 32 + r], s = sn[row * 32 + r];
    *(bf16_t*)(bp + rw * WT_STRIDE) = f2bf(a0[reg] * c - a1[reg] * s); *(bf16_t*)(bp + rw * WT_STRIDE + 64) = f2bf(a1[reg] * c + a0[reg] * s); }
}
DI void wt_store(const char* wl, int lane, bf16_t* dA, int sA, bf16_t* dB, int sB) {
  const int piece = lane & 7, rsub = lane >> 3;
  bf16_t* d = (piece < 4) ? dA : dB; const int st = (piece < 4) ? sA : sB;
  if (d) {
#pragma unroll
    for (int i = 0; i < 4; ++i) { const int row = i * 8 + rsub; const uint4 v = *(const uint4*)(wl + row * WT_STRIDE + piece * 16);
      *(uint4*)(d + (size_t)row * st + (piece & 3) * 8) = v; }
  }
}
#define LDS_FENCE() asm volatile("s_waitcnt lgkmcnt(0)" ::: "memory")
DI int lv(int x) { asm volatile("" : "+v"(x)); return x; }
template <class T> DI T* launder(T* q) { size_t z = 0; asm volatile("" : "+s"(z)); return (T*)((char*)q + z); }

constexpr int GL_GR = 0, GL_VT = 8192, GL_QD = 26624, GL_KI = 45056, GL_KIT = 63488, GL_ATT = 81920, GL_TOT = 91136, GL_DEC = 93184, GL_LA = 93696  , GL_QS = 126464  , GL_KS = 134656;
DI void gla_chunk_local(const KP& p, char* lds, unsigned char* ws, int tile, const bf16_t* PA, const bf16_t* PB, const bool bgconv) {
  const int tid = lv(threadIdx.x), lane = tid & 63, w = tid >> 6, r = lane & 31, hh = lane >> 5;
  const int b = tile >> 5, n = tile & 31, tok0 = tile * 64;
  float* GRL = (float*)(lds + GL_GR); float* TOT = (float*)(lds + GL_TOT); float* DECL = (float*)(lds + GL_DEC);
  const int dir = tid >> 8, qt = (tid >> 6) & 3, dk = tid & 63;
  const float* wg = launder(dir ? p.in[14] : p.in[12]); const float* bg = launder(dir ? p.in[15] : p.in[13]);
  const int st = tid >> 3, sc8 = (tid & 7) * 8, vt_t = tid >> 4, vt_d8 = (tid & 15) * 8;
  bf16x8 nq, nk, nv0, nv1; float nw[16], nb;
#define GLA_LOADS(H_) do { \
    nq = *(const bf16x8*)(PA + (size_t)st * 1024 + O_QG + (H_) * 64 + sc8);            \
    { const bf16_t* kp_ = ((H_) == 0) ? PA + (size_t)st * 1024 + O_KG + sc8 : PB + (size_t)st * 1024 + (O_KG - 1024) + (H_) * 64 + sc8; nk = *(const bf16x8*)kp_; } \
    nv0 = *(const bf16x8*)(PB + (size_t)vt_t * 1024 + (O_VG - 1024) + (H_) * 128 + vt_d8); \
    nv1 = *(const bf16x8*)(PB + (size_t)(vt_t + 32) * 1024 + (O_VG - 1024) + (H_) * 128 + vt_d8); \
    _Pragma("unroll") for (int q = 0; q < 16; ++q) nw[q] = wg[q * 256 + (H_) * 64 + dk]; \
    nb = bg[(H_) * 64 + dk]; } while (0)
  __syncthreads();
  { bf16_t gr[4];
#pragma unroll
    for (int i = 0; i < 4; ++i) { const int e = tid + 512 * i; gr[i] = PB[(size_t)(e >> 5) * 1024 + (O_GF - 1024) + (e & 31)]; }
    GLA_LOADS(0);
#pragma unroll
    for (int i = 0; i < 4; ++i) GRL[tid + 512 * i] = bf2f(gr[i]); }
#pragma unroll 1
  for (int h = 0; h < 4; ++h) {
    __syncthreads();
    *(bf16x8*)(lds + GL_QS + (st * 64 + sc8) * 2) = nq; *(bf16x8*)(lds + GL_KS + (st * 64 + sc8) * 2) = nk;
    { bf16_t* vt = (bf16_t*)(lds + GL_VT) + vt_d8 * 72 + vt_t;
#pragma unroll
      for (int j = 0; j < 8; ++j) { vt[j * 72] = (bf16_t)nv0[j]; vt[j * 72 + 32] = (bf16_t)nv1[j]; } }
    float4 cx[4][4]; const int crow0 = ((int)blockIdx.x * 8 + w) * 16 + h * 4;
    if (bgconv) {
#pragma unroll
      for (int rr = 0; rr < 4; ++rr) conv_row_load(p, crow0 + rr, lane, cx[rr]);
    }
    float* LAL = (float*)(lds + GL_LA) + tid;
    {
      float wr[16];
#pragma unroll
      for (int q = 0; q < 16; ++q) wr[q] = nw[q];
      const float bias = nb;
      { const int hn = h < 3 ? h + 1 : 3; GLA_LOADS(hn); }
      float run = 0.f;
#pragma unroll 2
      for (int ii = 0; ii < 16; ++ii) { const int i = dir ? 15 - ii : ii;
        const float* gp = GRL + (qt * 16 + i) * 32 + dir * 16; float x = bias;
#pragma unroll
        for (int q = 0; q < 16; ++q) x += gp[q] * wr[q];
        run += logsigmoid_fast(x) * (1.f / 16.f); LAL[i * 512] = run; }
      TOT[(dir * 64 + dk) * 4 + qt] = run;
    }
    __syncthreads();
    {
      const float4 tq = *(const float4*)(TOT + (dir * 64 + dk) * 4);
      const float total = (tq.x + tq.y) + (tq.z + tq.w);
      float off;
      if (dir == 0) off = (qt > 0 ? tq.x : 0.f) + (qt > 1 ? tq.y : 0.f) + (qt > 2 ? tq.z : 0.f);
      else          off = (qt < 1 ? tq.y : 0.f) + (qt < 2 ? tq.z : 0.f) + (qt < 3 ? tq.w : 0.f);
      if (qt == 0) { const float dc = fexp(total); DECL[dir * 64 + dk] = dc; ((float*)(ws + WS_DEC))[((size_t)((b * 4 + h) * 2 + dir) * 32 + n) * 64 + dk] = dc; }
      bf16_t* QD = (bf16_t*)(lds + GL_QD + dir * 9216) + (qt * 16) * 72 + dk; bf16_t* KI = (bf16_t*)(lds + GL_KI + dir * 9216) + (qt * 16) * 72 + dk;
      bf16_t* KIT = (bf16_t*)(lds + GL_KIT + dir * 9216) + dk * 72 + qt * 16;
      bf16_t* qdg = (bf16_t*)(ws + WS_QDEC) + (size_t)((tile * 4 + h) * 2 + dir) * 4096 + (qt * 16) * 64 + dk;
      const bf16_t* qgp = (const bf16_t*)(lds + GL_QS) + (qt * 16) * 64 + dk; const bf16_t* kgp = (const bf16_t*)(lds + GL_KS) + (qt * 16) * 64 + dk;
#pragma unroll 2
      for (int i = 0; i < 16; ++i) { const float bb = off + LAL[i * 512];
        const float qv = bf2f(qgp[i * 64]) * 0.125f, kv = bf2f(kgp[i * 64]);
        const float eb = fexp(bb); const bf16_t qd = f2bf(qv * eb), ki = f2bf(kv * __builtin_amdgcn_rcpf(eb));
        QD[i * 72] = qd; KI[i * 72] = ki; qdg[i * 64] = qd; KIT[i] = ki; }
    }
    __syncthreads();
    if (w < 4) { const int mi = w >> 1, ni = w & 1;
      f32x16 asum;
#pragma unroll
      for (int i = 0; i < 16; ++i) asum[i] = 0.f;
#pragma unroll
      for (int d = 0; d < 2; ++d) { f32x16 acc;
#pragma unroll
        for (int i = 0; i < 16; ++i) acc[i] = 0.f;
#pragma unroll
        for (int s = 0; s < 4; ++s) { const bf16x8 a = *(const bf16x8*)(lds + GL_QD + d * 9216 + (mi * 32 + r) * 144 + s * 32 + hh * 16);
          const bf16x8 bb = *(const bf16x8*)(lds + GL_KI + d * 9216 + (ni * 32 + r) * 144 + s * 32 + hh * 16); acc = MFMA32(a, bb, acc); }
#pragma unroll
        for (int reg = 0; reg < 16; ++reg) { const int ti = mi * 32 + crow(reg, hh), tj = ni * 32 + r; const bool keep = d ? (tj >= ti) : (tj <= ti); asum[reg] += keep ? acc[reg] : 0.f; } }
      bf16_t* at = (bf16_t*)(lds + GL_ATT) + (mi * 32 + 4 * hh) * 72 + ni * 32 + r;
#pragma unroll
      for (int reg = 0; reg < 16; ++reg) at[((reg & 3) + 8 * (reg >> 2)) * 72] = f2bf(asum[reg]);
    }
    __syncthreads();
    { const int mi = w >> 2, ni = w & 3; f32x16 acc;
#pragma unroll
      for (int i = 0; i < 16; ++i) acc[i] = 0.f;
#pragma unroll
      for (int s = 0; s < 4; ++s) { const bf16x8 a = *(const bf16x8*)(lds + GL_ATT + (mi * 32 + r) * 144 + s * 32 + hh * 16);
        const bf16x8 bb = *(const bf16x8*)(lds + GL_VT + (ni * 32 + r) * 144 + s * 32 + hh * 16); acc = MFMA32(a, bb, acc); }
      bf16_t* oi = (bf16_t*)(ws + WS_OINTRA) + (size_t)(tok0 + mi * 32 + 4 * hh) * 512 + h * 128 + ni * 32 + r;
#pragma unroll
      for (int reg = 0; reg < 16; ++reg) oi[(size_t)((reg & 3) + 8 * (reg >> 2)) * 512] = f2bf(acc[reg]); }
    { const int dvb = w >> 1, dkb = w & 1;
#pragma unroll
      for (int d = 0; d < 2; ++d) { f32x16 acc;
#pragma unroll
        for (int i = 0; i < 16; ++i) acc[i] = 0.f;
#pragma unroll
        for (int s = 0; s < 4; ++s) { const bf16x8 a = *(const bf16x8*)(lds + GL_VT + (dvb * 32 + r) * 144 + s * 32 + hh * 16);
          const bf16x8 bb = *(const bf16x8*)(lds + GL_KIT + d * 9216 + (dkb * 32 + r) * 144 + s * 32 + hh * 16); acc = MFMA32(a, bb, acc); }
        const float sc = DECL[d * 64 + dkb * 32 + r];
        bf16_t* ds = (bf16_t*)(ws + WS_SPT) + ((size_t)((b * 4 + h) * 2 + d) * 32 + n) * 8192 + (size_t)(dvb * 32 + 4 * hh) * 64 + dkb * 32 + r;
#pragma unroll
        for (int reg = 0; reg < 16; ++reg) ds[((reg & 3) + 8 * (reg >> 2)) * 64] = f2bf(acc[reg] * sc); } }
    if (bgconv) {
#pragma unroll
      for (int rr = 0; rr < 4; ++rr) conv_row_finish(ws, crow0 + rr, lane, cx[rr]);
    }
  }
}

DI void phase1a(const KP& p, char* lds) {
  const int tid = threadIdx.x, lane = tid & 63, w = tid >> 6;
  for (int tile = blockIdx.x; tile < 256; tile += gridDim.x) {
    unsigned char* ws = launder(p.ws); unsigned char* ob = (unsigned char*)launder(p.out); const float* xin = launder(p.in[0]);
    const float* mod = (const float*)(ws + WS_MOD);
    const int tok0 = tile * 64, b = tile >> 5;
    bf16_t* Hs = (bf16_t*)(ob + OUT_HS) + (size_t)tok0 * 1024;
    float4 ge[4], sh[4];
    const float* gpre = launder(p.in[5]); const float* modb = launder(mod) + b * 6144;
#pragma unroll
    for (int i = 0; i < 4; ++i) { const int d = (lane + 64 * i) * 4;
      const float4 g = *(const float4*)(gpre + d); const float4 sc = *(const float4*)(modb + 1024 + d); sh[i] = *(const float4*)(modb + d);
      ge[i] = make_float4(g.x * (1.f + sc.x), g.y * (1.f + sc.y), g.z * (1.f + sc.z), g.w * (1.f + sc.w)); }
#pragma unroll 1
    for (int g = 0; g < 2; ++g) {
      float4 v[4][4];
#pragma unroll
      for (int rr = 0; rr < 4; ++rr) { const float* xr = xin + (size_t)(tok0 + w * 8 + g * 4 + rr) * 1024;
#pragma unroll
        for (int i = 0; i < 4; ++i) { typedef float f32x4_s __attribute__((ext_vector_type(4))); const f32x4_s t_ = __builtin_nontemporal_load((const f32x4_s*)(xr + (lane + 64 * i) * 4)); v[rr][i] = make_float4(t_.x, t_.y, t_.z, t_.w); } }
#pragma unroll
      for (int rr = 0; rr < 4; ++rr) { const int row = w * 8 + g * 4 + rr; float ss = 0.f;
#pragma unroll
        for (int i = 0; i < 4; ++i) ss += v[rr][i].x * v[rr][i].x + v[rr][i].y * v[rr][i].y + v[rr][i].z * v[rr][i].z + v[rr][i].w * v[rr][i].w;
        ss = wave_sum(ss); const float rs = rsqrtf(ss * (1.f / 1024.f) + EPS);
#pragma unroll
        for (int i = 0; i < 4; ++i) { uint2 o; o.x = pack2(v[rr][i].x * rs * ge[i].x + sh[i].x, v[rr][i].y * rs * ge[i].y + sh[i].y); o.y = pack2(v[rr][i].z * rs * ge[i].z + sh[i].z, v[rr][i].w * rs * ge[i].w + sh[i].w);
          *(uint2*)(Hs + (size_t)row * 1024 + (lane + 64 * i) * 4) = o; }
      }
    }
  }
}

DI void phase1c(const KP& p, char* lds) {
  const int tid = threadIdx.x, lane = tid & 63, w = tid >> 6, r = lane & 31, hh = lane >> 5;
  float* cs = (float*)(lds + LDS_TAB); float* sn = cs + 2048;
  char* wl = lds + LDS_WT + (w & 3) * WT_BYTES;
  for (int tile = blockIdx.x; tile < 256; tile += gridDim.x) {
    unsigned char* ws = launder(p.ws); unsigned char* ob = (unsigned char*)launder(p.out);
    const int tok0 = tile * 64, b = tile >> 5, t0 = (tile & 31) * 64;
    const bf16_t* PA = (const bf16_t*)(ws + WS_P1S) + (size_t)tok0 * 1024;
    const bf16_t* PB = (const bf16_t*)(ob + 32 * MiB) + (size_t)tok0 * 1024;
    const bf16_t* PC = (const bf16_t*)(ws + WS_PROJC) + (size_t)tok0 * 256;
    bf16_t* Hs = (bf16_t*)(ob + OUT_HS) + (size_t)tok0 * 1024;
    bf16_t* CQN = Hs; bf16_t* CKVN = Hs + 64 * 384;
    bf16_t* Qm = (bf16_t*)(ws + WS_QM); bf16_t* Km = (bf16_t*)(ws + WS_KM); bf16_t* Vm = (bf16_t*)(ws + WS_VM);
    __syncthreads();
    block_gemm<3>(lds, Hs, 1024, (const bf16_t*)(ws + WS_WTIN) + (size_t)8 * 16 * 16384, 1, 1024, [&](int m0, int n0, const f32x16& a0, const f32x16& a1) {
      const int r2 = lv(r), h2 = lv(hh), ln = lv(lane);
      wt_write(wl, a0, a1, r2, h2, 1.f); LDS_FENCE();
      bf16_t* pc = (bf16_t*)(ws + WS_PROJC) + (size_t)(tok0 + m0) * 256 + n0; wt_store(wl, ln, pc, 256, pc + 32, 256);
    });
    __syncthreads();
#pragma unroll
    for (int i = 0; i < 4; ++i) { const int e = tid + 512 * i, tt = e >> 5, j = e & 31;
      const float inv = __builtin_amdgcn_exp2f(-(float)j * (13.287712379549449f / 32.f)); const float ang = (float)((const int*)p.in[2])[tok0 + tt] * inv;
      float rev = ang * 0.15915494309189535f; rev -= floorf(rev);
      cs[e] = __builtin_amdgcn_cosf(rev); sn[e] = __builtin_amdgcn_sinf(rev); }
    __syncthreads();
    if (tid < 256) { const int row = tid >> 2, pc = tid & 3;
      const uint4 x1 = *(const uint4*)(PA + (size_t)row * 1024 + O_KR + pc * 8), x2 = *(const uint4*)(PA + (size_t)row * 1024 + O_KR + 32 + pc * 8);
      const float4 c0 = *(const float4*)(cs + row * 32 + pc * 8), c1 = *(const float4*)(cs + row * 32 + pc * 8 + 4), s0 = *(const float4*)(sn + row * 32 + pc * 8), s1 = *(const float4*)(sn + row * 32 + pc * 8 + 4);
#define RO1(a_, b_, c_, s_) ((a_) * (c_) - (b_) * (s_))
#define RO2(a_, b_, c_, s_) ((b_) * (c_) + (a_) * (s_))
#define LO(u_) __uint_as_float((u_) << 16)
#define HI(u_) __uint_as_float((u_) & 0xffff0000u)
      uint4 o1, o2;
      o1.x = pack2(RO1(LO(x1.x), LO(x2.x), c0.x, s0.x), RO1(HI(x1.x), HI(x2.x), c0.y, s0.y)); o1.y = pack2(RO1(LO(x1.y), LO(x2.y), c0.z, s0.z), RO1(HI(x1.y), HI(x2.y), c0.w, s0.w));
      o1.z = pack2(RO1(LO(x1.z), LO(x2.z), c1.x, s1.x), RO1(HI(x1.z), HI(x2.z), c1.y, s1.y)); o1.w = pack2(RO1(LO(x1.w), LO(x2.w), c1.z, s1.z), RO1(HI(x1.w), HI(x2.w), c1.w, s1.w));
      o2.x = pack2(RO2(LO(x1.x), LO(x2.x), c0.x, s0.x), RO2(HI(x1.x), HI(x2.x), c0.y, s0.y)); o2.y = pack2(RO2(LO(x1.y), LO(x2.y), c0.z, s0.z), RO2(HI(x1.y), HI(x2.y), c0.w, s0.w));
      o2.z = pack2(RO2(LO(x1.z), LO(x2.z), c1.x, s1.x), RO2(HI(x1.z), HI(x2.z), c1.y, s1.y)); o2.w = pack2(RO2(LO(x1.w), LO(x2.w), c1.z, s1.z), RO2(HI(x1.w), HI(x2.w), c1.w, s1.w));
#undef RO1
#undef RO2
#undef LO
#undef HI
#pragma unroll
      for (int h = 0; h < 4; ++h) { bf16_t* kp = Km + (((size_t)b * 4 + h) * SEQ + t0 + row) * 192 + 128 + pc * 8; *(uint4*)kp = o1; *(uint4*)(kp + 32) = o2; }
    }
    const float* gq = launder(p.in[8]); const float* gkv = launder(p.in[10]);
#pragma unroll 2
    for (int rr = 0; rr < 8; ++rr) { const int row = w * 8 + rr; const unsigned* cr = (const unsigned*)(PA + (size_t)row * 1024);
      float v0[5], v1[5];
#pragma unroll
      for (int i = 0; i < 5; ++i) { const unsigned u = cr[lane + 64 * i]; v0[i] = __uint_as_float(u << 16); v1[i] = __uint_as_float(u & 0xffff0000u); }
      float ss = v0[0] * v0[0] + v1[0] * v1[0] + v0[1] * v0[1] + v1[1] * v1[1] + v0[2] * v0[2] + v1[2] * v1[2];
      float s2 = v0[3] * v0[3] + v1[3] * v1[3] + v0[4] * v0[4] + v1[4] * v1[4];
      ss = wave_sum(ss); s2 = wave_sum(s2);
      const float rq = rsqrtf(ss * (1.f / 384.f) + EPS), rk = rsqrtf(s2 * (1.f / 256.f) + EPS);
#pragma unroll
      for (int i = 0; i < 3; ++i) { const int c = 2 * (lane + 64 * i); *(unsigned*)(CQN + (size_t)row * 384 + c) = pack2(v0[i] * rq * gq[c], v1[i] * rq * gq[c + 1]); }
#pragma unroll
      for (int i = 3; i < 5; ++i) { const int c = 2 * (lane + 64 * (i - 3)); *(unsigned*)(CKVN + (size_t)row * 256 + c) = pack2(v0[i] * rk * gkv[c], v1[i] * rk * gkv[c + 1]); }
    }
    __syncthreads();
    block_gemm<3>(lds, CQN, 384, (const bf16_t*)(ws + WS_WTQUP), 3, 384, [&](int m0, int n0, const f32x16& a0, const f32x16& a1) {
      const int r2 = lv(r), h2 = lv(hh), ln = lv(lane);
      const int h = n0 / 192, d0 = n0 % 192;
      bf16_t* qp = Qm + (((size_t)b * 4 + h) * SEQ + t0 + m0) * 192 + d0;
      if (d0 < 128) wt_write(wl, a0, a1, r2, h2, 1.f); else wt_write_rope(wl, a0, a1, r2, h2, cs, sn, m0);
      LDS_FENCE();
      wt_store(wl, ln, qp, 192, qp + 32, 192);
    });
    block_gemm<3>(lds, CKVN, 256, (const bf16_t*)(ws + WS_WTKVUP), 4, 256, [&](int m0, int n0, const f32x16& a0, const f32x16& a1) {
      const int r2 = lv(r), h2 = lv(hh), ln = lv(lane);
      const int h = n0 >> 8, d0 = n0 & 255;
      wt_write(wl, a0, a1, r2, h2, 1.f); LDS_FENCE();
      if (d0 < 128) { bf16_t* kp = Km + (((size_t)b * 4 + h) * SEQ + t0 + m0) * 192 + d0; wt_store(wl, ln, kp, 192, kp + 32, 192); }
      else { bf16_t* vp = Vm + (((size_t)b * 4 + h) * SEQ + t0 + m0) * 128 + (d0 - 128); wt_store(wl, ln, vp, 128, vp + 32, 128); }
    });
    gla_chunk_local(p, lds, ws, tile, PA, PB, false);
  }
}

namespace att {
typedef short s16x4 __attribute__((ext_vector_type(4)));
typedef unsigned u32x4 __attribute__((ext_vector_type(4)));
constexpr int DQ = 192, DV = 128, KVBLK = 64;
constexpr float SCALE = 0.07216878364870322f;
constexpr float THR = 8.f;
constexpr int SHM_V = KVBLK * DV * 2, SHM_K = KVBLK * DQ * 2;
constexpr int SHM_QR = 8 * 32 * 176;
constexpr int SHM_ATTN = 2 * SHM_V + 2 * SHM_K + 8 * 64 * 4 + SHM_QR;
#define KSWZ(row, colB) ((row) * 384 + ((colB) ^ (((row) & 7) << 4)))
#define SBAR() __builtin_amdgcn_sched_barrier(0)
DI unsigned cvtpk(float lo, float hi) { unsigned r; asm volatile("v_cvt_pk_bf16_f32 %0, %1, %2" : "=v"(r) : "v"(lo), "v"(hi)); return r; }

DI void partialSM(f32x16& p0, f32x16& p1, float& m_reg, float& mn, float& alpha) {
  constexpr float C = SCALE * 1.4426950408889634f;
  float pmax = p0[0];
#pragma unroll
  for (int r = 1; r < 16; ++r) pmax = fmaxf(pmax, p0[r]);
#pragma unroll
  for (int r = 0; r < 16; ++r) pmax = fmaxf(pmax, p1[r]);
  { auto rr = __builtin_amdgcn_permlane32_swap(__float_as_uint(pmax), __float_as_uint(pmax), false, false);
    pmax = fmaxf(__uint_as_float(rr[0]), __uint_as_float(rr[1])); }
  if (__builtin_expect(__all(pmax - m_reg <= THR / SCALE), 1)) { mn = m_reg; alpha = 1.f; }
  else { mn = fmaxf(m_reg, pmax); alpha = __builtin_amdgcn_exp2f((m_reg - mn) * C); m_reg = mn; }
  const float mnC = -mn * C;
#pragma unroll
  for (int r = 0; r < 16; ++r) p0[r] = fmaf(p0[r], C, mnC);
#pragma unroll
  for (int r = 0; r < 16; ++r) p1[r] = fmaf(p1[r], C, mnC);
#pragma unroll
  for (int r = 0; r < 16; ++r) p0[r] = __builtin_amdgcn_exp2f(p0[r]);
}
DI void finishSM(f32x16& p0, f32x16& p1, float alpha, float& l_reg, bf16x8& pa0, bf16x8& pa1, bf16x8& pa2, bf16x8& pa3) {
#pragma unroll
  for (int r = 0; r < 16; ++r) p1[r] = __builtin_amdgcn_exp2f(p1[r]);
  float ps = 0;
#pragma unroll
  for (int r = 0; r < 16; ++r) ps += p0[r];
#pragma unroll
  for (int r = 0; r < 16; ++r) ps += p1[r];
  { auto rr = __builtin_amdgcn_permlane32_swap(__float_as_uint(ps), __float_as_uint(ps), false, false);
    ps = __uint_as_float(rr[0]) + __uint_as_float(rr[1]); }
  l_reg = l_reg * alpha + ps;
#define PK4(P, BASE, OUT) do { unsigned a0 = cvtpk(P[BASE + 0], P[BASE + 1]), a1 = cvtpk(P[BASE + 2], P[BASE + 3]);   \
    unsigned b0 = cvtpk(P[BASE + 4], P[BASE + 5]), b1 = cvtpk(P[BASE + 6], P[BASE + 7]);                              \
    auto r0 = __builtin_amdgcn_permlane32_swap(a0, b0, false, false); auto r1 = __builtin_amdgcn_permlane32_swap(a1, b1, false, false); \
    u32x4 wv = {r0[0], r1[0], r0[1], r1[1]}; OUT = *reinterpret_cast<bf16x8*>(&wv); } while (0)
  PK4(p0, 0, pa0); PK4(p0, 8, pa1); PK4(p1, 0, pa2); PK4(p1, 8, pa3);
#undef PK4
}
DI void qkt(f32x16& p0, f32x16& p1, const char* Ks, const bf16x8* qr, const char* qrl, int r32, int hi) {
#pragma unroll
  for (int i = 0; i < 16; ++i) { p0[i] = 0.f; p1[i] = 0.f; }
#pragma unroll
  for (int d0 = 0; d0 < 12; ++d0) { const int cb = (d0 * 16 + hi * 8) * 2;
    const bf16x8 b0 = *reinterpret_cast<const bf16x8*>(Ks + KSWZ(r32, cb));
    const bf16x8 b1 = *reinterpret_cast<const bf16x8*>(Ks + KSWZ(32 + r32, cb));
    const bf16x8 q = (d0 < 7) ? qr[d0 < 7 ? d0 : 0] : *reinterpret_cast<const bf16x8*>(qrl + (d0 - 7) * 32);
    p0 = MFMA32(b0, q, p0);
    p1 = MFMA32(b1, q, p1); }
}
DI int v_st(int k, int c) { const int kk = (k & ~0xC) | ((k & 4) << 1) | ((k & 8) >> 1); return ((kk >> 3) * 4 + (c >> 5)) * 512 + ((kk & 7) * 32 + (c & 31)) * 2; }
DI int v_rd_base(int lane) { return ((lane & 3) << 3) | (((lane >> 2) & 3) << 6) | (((lane >> 4) & 1) << 5) | (((lane >> 5) & 1) << 8); }
constexpr int v_rd_off(int d0, int ks, int half) { return d0 * 512 + ks * 4096 + half * 2048; }
template <int OFF> DI s16x4 tr_read(int vb) { s16x4 r; asm volatile("ds_read_b64_tr_b16 %0, %1 offset:%2" : "=&v"(r) : "v"(vb), "i"(OFF) : "memory"); return r; }
template <int D0> DI void pv_one(f32x16& od, int vb, bf16x8 pa0, bf16x8 pa1, bf16x8 pa2, bf16x8 pa3) {
  const s16x4 l0 = tr_read<v_rd_off(D0, 0, 0)>(vb), h0 = tr_read<v_rd_off(D0, 0, 1)>(vb), l1 = tr_read<v_rd_off(D0, 1, 0)>(vb), h1 = tr_read<v_rd_off(D0, 1, 1)>(vb);
  const s16x4 l2 = tr_read<v_rd_off(D0, 2, 0)>(vb), h2 = tr_read<v_rd_off(D0, 2, 1)>(vb), l3 = tr_read<v_rd_off(D0, 3, 0)>(vb), h3 = tr_read<v_rd_off(D0, 3, 1)>(vb);
  asm volatile("s_waitcnt lgkmcnt(0)" ::: "memory"); SBAR();
#define PK(L, H) (bf16x8){L[0], L[1], L[2], L[3], H[0], H[1], H[2], H[3]}
  od = MFMA32(pa0, PK(l0, h0), od);
  od = MFMA32(pa1, PK(l1, h1), od);
  od = MFMA32(pa2, PK(l2, h2), od);
  od = MFMA32(pa3, PK(l3, h3), od);
#undef PK
}
DI void pv_d0(f32x16* o, int vb, bf16x8 pa0, bf16x8 pa1, bf16x8 pa2, bf16x8 pa3) {
  pv_one<0>(o[0], vb, pa0, pa1, pa2, pa3); pv_one<1>(o[1], vb, pa0, pa1, pa2, pa3); pv_one<2>(o[2], vb, pa0, pa1, pa2, pa3); pv_one<3>(o[3], vb, pa0, pa1, pa2, pa3);
}
struct ScanChain { int seq, si; float s0, s1, s2, s3; uint2 d; float4 c; };
DI void scan_ld(ScanChain& sc, unsigned char* ws, int n) {
  const int within = (int)(blockIdx.x & 3) * NTHR + lv((int)threadIdx.x);
  const bf16_t* base = (const bf16_t*)(ws + WS_SPT) + (size_t)sc.seq * 262144 + (size_t)n * 8192; const float* dec = (const float*)(ws + WS_DEC) + sc.seq * 2048 + n * 64;
  sc.d = *(const uint2*)(base + (unsigned)(within * 4)); sc.c = *(const float4*)(dec + (unsigned)((within & 15) * 4));
}
DI void scan_init(ScanChain& sc, unsigned char* ws) {
  sc.seq = (int)(blockIdx.x >> 2); sc.si = 0; sc.s0 = 0.f; sc.s1 = 0.f; sc.s2 = 0.f; sc.s3 = 0.f;
  scan_ld(sc, ws, (sc.seq & 1) ? 31 : 0);
}
DI void scan_step(ScanChain& sc, unsigned char* ws) {
  const int dir = sc.seq & 1, n = dir ? 31 - sc.si : sc.si;
  const int within = (int)(blockIdx.x & 3) * NTHR + lv((int)threadIdx.x);
  uint2 o; o.x = pack2(sc.s0, sc.s1); o.y = pack2(sc.s2, sc.s3);
  st_wt8((bf16_t*)(ws + WS_SPT) + (size_t)sc.seq * 262144 + (size_t)n * 8192 + (unsigned)(within * 4), o);
  sc.s0 = sc.c.x * sc.s0 + __uint_as_float(sc.d.x << 16); sc.s1 = sc.c.y * sc.s1 + __uint_as_float(sc.d.x & 0xffff0000u);
  sc.s2 = sc.c.z * sc.s2 + __uint_as_float(sc.d.y << 16); sc.s3 = sc.c.w * sc.s3 + __uint_as_float(sc.d.y & 0xffff0000u);
  ++sc.si;
  if (sc.si < 32) scan_ld(sc, ws, dir ? 31 - sc.si : sc.si);
}
template <bool FUSE_SCAN>
DI void attn_unit(const bf16_t* Qb, const bf16_t* Kh, const bf16_t* Vh, bf16_t* Ob, int seq, char* lds, ScanChain& sc, unsigned char* ws) {
  const int tid = lv(threadIdx.x), wid = tid >> 6, lane = tid & 63, r32 = lane & 31, hi = lane >> 5;
  char* V_lds = lds; char* K_lds = lds + 2 * SHM_V;
  float* wsf = (float*)(lds + 2 * SHM_V + 2 * SHM_K) + wid * 64; float* li_l = wsf; float* al_l = wsf + 32;
  char* qrl = lds + 2 * SHM_V + 2 * SHM_K + 8 * 64 * 4 + wid * (32 * 176) + r32 * 176 + hi * 16;
  float m_reg = -1e30f, l_reg = 0; f32x16 o[4]; bf16x8 qr[7];
#pragma unroll
  for (int d = 0; d < 4; ++d)
#pragma unroll
    for (int i = 0; i < 16; ++i) o[d][i] = 0.f;
  const bf16_t* Qw = Qb + (size_t)(wid * 32 + r32) * DQ + hi * 8;
#pragma unroll
  for (int d0 = 0; d0 < 7; ++d0) qr[d0] = *reinterpret_cast<const bf16x8*>(Qw + d0 * 16);
#pragma unroll
  for (int d0 = 7; d0 < 12; ++d0) *reinterpret_cast<bf16x8*>(qrl + (d0 - 7) * 32) = *reinterpret_cast<const bf16x8*>(Qw + d0 * 16);
  int kst[3];
#pragma unroll
  for (int i = 0; i < 3; ++i) { const int c = tid + 512 * i; kst[i] = KSWZ(c / 24, (c % 24) * 16); }
  const int vst0 = v_st(tid >> 4, (tid & 15) * 8), vst1 = v_st(32 + (tid >> 4), (tid & 15) * 8);
  const int vb0 = (int)(uintptr_t)V_lds + v_rd_base(lane);
  bf16x8 sk0, sk1, sk2, sv0, sv1;
#define SLOAD(k0) do { const bf16x8* kp = reinterpret_cast<const bf16x8*>(Kh + (size_t)(k0) * DQ) + tid; sk0 = kp[0]; sk1 = kp[512]; sk2 = kp[1024]; \
    const bf16x8* vp = reinterpret_cast<const bf16x8*>(Vh + (size_t)(k0) * DV) + tid; sv0 = vp[0]; sv1 = vp[512]; } while (0)
#define SWRITE(b) do { *(bf16x8*)(V_lds + (b) * SHM_V + vst0) = sv0; *(bf16x8*)(V_lds + (b) * SHM_V + vst1) = sv1; \
    *(bf16x8*)(K_lds + (b) * SHM_K + kst[0]) = sk0; *(bf16x8*)(K_lds + (b) * SHM_K + kst[1]) = sk1; *(bf16x8*)(K_lds + (b) * SHM_K + kst[2]) = sk2; } while (0)
#define RESC(a) do { if (__any((a) < 1.f)) { if (hi == 0) al_l[r32] = (a); asm volatile("s_waitcnt lgkmcnt(0)" ::: "memory"); \
    _Pragma("unroll") for (int d = 0; d < 4; ++d) _Pragma("unroll") for (int r = 0; r < 16; ++r) o[d][r] *= al_l[crow(r, hi)]; } } while (0)
  f32x16 pA0, pA1, pB0, pB1; float mnA, mnB, alA, alB; bf16x8 pa0, pa1, pa2, pa3; const int NT = seq / KVBLK;
  SLOAD(0); SWRITE(0); __syncthreads();
  qkt(pA0, pA1, K_lds, qr, qrl, r32, hi); partialSM(pA0, pA1, m_reg, mnA, alA);
  SLOAD(KVBLK); SWRITE(1); __syncthreads();
  for (int j = 1; j + 1 < NT; j += 2) {
    SBAR(); qkt(pB0, pB1, K_lds + SHM_K, qr, qrl, r32, hi);
    finishSM(pA0, pA1, alA, l_reg, pa0, pa1, pa2, pa3); SBAR();
    SLOAD((j + 1) * KVBLK); if (FUSE_SCAN) scan_step(sc, ws); SBAR();
    pv_d0(o, vb0, pa0, pa1, pa2, pa3); partialSM(pB0, pB1, m_reg, mnB, alB);
    __syncthreads(); SWRITE(0);
    RESC(alB); __syncthreads();
    SBAR(); qkt(pA0, pA1, K_lds, qr, qrl, r32, hi);
    finishSM(pB0, pB1, alB, l_reg, pa0, pa1, pa2, pa3); SBAR();
    SLOAD((j + 2) * KVBLK); if (FUSE_SCAN) scan_step(sc, ws); SBAR();
    pv_d0(o, vb0 + SHM_V, pa0, pa1, pa2, pa3); partialSM(pA0, pA1, m_reg, mnA, alA);
    __syncthreads(); SWRITE(1);
    RESC(alA); __syncthreads();
  }
  SBAR(); qkt(pB0, pB1, K_lds + SHM_K, qr, qrl, r32, hi);
  finishSM(pA0, pA1, alA, l_reg, pa0, pa1, pa2, pa3); SBAR();
  pv_d0(o, vb0, pa0, pa1, pa2, pa3); partialSM(pB0, pB1, m_reg, mnB, alB);
  __syncthreads(); RESC(alB);
  finishSM(pB0, pB1, alB, l_reg, pa0, pa1, pa2, pa3); SBAR();
  pv_d0(o, vb0 + SHM_V, pa0, pa1, pa2, pa3);
  if (FUSE_SCAN) { while (sc.si < 32) scan_step(sc, ws); }
  if (hi == 0) li_l[r32] = l_reg; asm volatile("s_waitcnt lgkmcnt(0)" ::: "memory");
  float rli[16];
#pragma unroll
  for (int r = 0; r < 16; ++r) rli[r] = __builtin_amdgcn_rcpf(li_l[crow(r, hi)]);
  bf16_t* Ow = Ob + (size_t)(wid * 32) * 1024;
#pragma unroll
  for (int r = 0; r < 16; ++r) { const int orow = crow(r, hi);
#pragma unroll
    for (int d0 = 0; d0 < 4; ++d0) Ow[(size_t)orow * 1024 + d0 * 32 + r32] = f2bf(o[d0][r] * rli[r]); }
  __syncthreads();
#undef SLOAD
#undef SWRITE
#undef RESC
}
}

DI void phase2_attn(const KP& p, char* lds, const bool fuse_scan) {
  for (int u = blockIdx.x; u < 256; u += gridDim.x) {
    unsigned char* ws = launder(p.ws);
    const bf16_t* Qm = (const bf16_t*)(ws + WS_QM); const bf16_t* Km = (const bf16_t*)(ws + WS_KM); const bf16_t* Vm = (const bf16_t*)(ws + WS_VM);
    bf16_t* mixa = (bf16_t*)(ws + WS_P1S);
    const int qb = u & 7, bh = u >> 3, b = bh >> 2, h = bh & 3;
    att::ScanChain sc;
    if (fuse_scan) { att::scan_init(sc, ws);
      att::attn_unit<true>(Qm + ((size_t)bh * SEQ + qb * 256) * 192, Km + (size_t)bh * SEQ * 192, Vm + (size_t)bh * SEQ * 128,
                           mixa + ((size_t)b * SEQ + qb * 256) * 1024 + h * 128, SEQ, lds, sc, ws); }
    else att::attn_unit<false>(Qm + ((size_t)bh * SEQ + qb * 256) * 192, Km + (size_t)bh * SEQ * 192, Vm + (size_t)bh * SEQ * 128,
                               mixa + ((size_t)b * SEQ + qb * 256) * 1024 + h * 128, SEQ, lds, sc, ws);
  }
}

namespace pg8 {
#define PG8_LAS __attribute__((address_space(3)))
typedef unsigned short bf16_t;
typedef short bf16x8 __attribute__((ext_vector_type(8)));
typedef float f32x4 __attribute__((ext_vector_type(4)));
typedef unsigned u32x4 __attribute__((ext_vector_type(4)));
constexpr int BM = 256, BK = 64, HALF = 128, HTB = HALF * BK * 2  , STAGE_BYTES = 8 * HTB, NXCD = 8, WGM = 8;

__host__ __device__ __forceinline__ int lds_byte(int r, int c) { const int st = (r >> 4) * 2 + (c >> 5), rr = r & 15, cc = c & 31, ob = rr * 64 + cc * 2; return st * 1024 + (ob ^ (((ob >> 9) & 1) << 5)); }
__host__ __device__ __forceinline__ void stage_rc(int b, int& R, int& C) { const int st = b / 1024, sb = b % 1024, swz = sb ^ (((sb >> 9) & 1) << 5); R = (st >> 1) * 16 + swz / 64; C = (st & 1) * 32 + (swz % 64) / 2; }
__host__ __device__ __forceinline__ int perm32(int rho) { const int n = rho >> 4, i = rho & 15; return 8 * (i >> 2) + 4 * n + (i & 3); }

struct Unit { int pm, pn; };
struct Gemm { const bf16_t* A; const bf16_t* Bt; int M, N, K; };

struct StaticOrder {
    int nM, nN, nwg, G, c;
    __host__ __device__ void init(int M, int N, int G_, int c_) { nM = M / BM; nN = N / BM; nwg = nM * nN; G = G_; c = c_; }
    __host__ __device__ bool next(int i, Unit& u) const {
        const long L = (long)i * G + c; if (L >= nwg) return false;
        int wgid = (int)L; { const int q = nwg / NXCD, r = nwg % NXCD, xcd = wgid % NXCD, off = wgid / NXCD; wgid = (xcd < r ? xcd * (q + 1) : r * (q + 1) + (xcd - r) * q) + off; }
        const int nig = WGM * nN, gid = wgid / nig, fm = gid * WGM, gsz = (nM - fm) < WGM ? (nM - fm) : WGM;
        u.pm = fm + ((wgid % nig) % gsz); u.pn = (wgid % nig) / gsz; return true;
    }
    __device__ __forceinline__ void a_ready(const Unit&) const {}
    __device__ __forceinline__ void done(const Unit&) const {}
};

__device__ __forceinline__ unsigned cvt_pk_bf16(float lo, float hi) { unsigned r; asm volatile("v_cvt_pk_bf16_f32 %0, %1, %2" : "=v"(r) : "v"(lo), "v"(hi)); return r; }
typedef float f32x2 __attribute__((ext_vector_type(2)));
__device__ __forceinline__ f32x2 gelu_pk(f32x2 v) {
    const f32x2 av = __builtin_elementwise_abs(v), d = av * 0.2316418882f + 1.0f;
    f32x2 t; t.x = __builtin_amdgcn_rcpf(d.x); t.y = __builtin_amdgcn_rcpf(d.y);
    f32x2 q = t * 0.5307027145f + (-0.7265760135f); q = q * t + 0.7107068705f; q = q * t + (-0.142248368f); q = q * t + 0.127414796f; q = q * t;
    const f32x2 s = (v * v) * (-0.72134752044f);
    f32x2 e; e.x = __builtin_amdgcn_exp2f(s.x); e.y = __builtin_amdgcn_exp2f(s.y);
    const f32x2 m = v * (q * e), r = v - m;
    f32x2 o; o.x = v.x < 0.f ? m.x : r.x; o.y = v.y < 0.f ? m.y : r.y; return o;
}

template <int ACT  > struct EpiBf16 {
    static constexpr bool PERM = true, AFTER_DRAIN = false; static_assert(ACT == 0 || ACT == 1, "EpiBf16: ACT is 0 (none) or 1 (gelu_pk)");
    bf16_t* O; int ldc; const float* bias; int split_cols; size_t split_stride; float scale0;
    __device__ __forceinline__ void operator()(const f32x4 (&acc)[2][2][4][2], const Unit& u, int wr, int wc, int fr, int fq) const {
        const int row0 = u.pm * BM + wr * 64 + fr; int colt = u.pn * BM; bf16_t* base = O;
        float sc = 1.f; if (split_cols) { const int t = colt / split_cols; base += (size_t)t * split_stride; colt -= t * split_cols; if (t == 0) sc = scale0; }
        const int col0 = colt + wc * 32 + 8 * fq, bcol0 = u.pn * BM + wc * 32 + 8 * fq;
        f32x4 bv[2][2];
#pragma unroll
        for (int bj = 0; bj < 2; ++bj)
#pragma unroll
            for (int n = 0; n < 2; ++n) bv[bj][n] = bias ? *(const f32x4*)(bias + bcol0 + bj * HALF + 4 * n) : (f32x4){0.f, 0.f, 0.f, 0.f};
#pragma unroll
        for (int ai = 0; ai < 2; ++ai)
#pragma unroll
            for (int m = 0; m < 4; ++m) { bf16_t* rowp = base + (size_t)(row0 + ai * HALF + m * 16) * ldc + col0;
#pragma unroll
                for (int bj = 0; bj < 2; ++bj) { f32x4 v0 = acc[ai][bj][m][0] + bv[bj][0], v1 = acc[ai][bj][m][1] + bv[bj][1];
                    if (ACT == 1) { f32x2 a = gelu_pk((f32x2){v0[0], v0[1]}), b = gelu_pk((f32x2){v0[2], v0[3]}), c = gelu_pk((f32x2){v1[0], v1[1]}), d = gelu_pk((f32x2){v1[2], v1[3]});
                        v0 = (f32x4){a.x, a.y, b.x, b.y}; v1 = (f32x4){c.x, c.y, d.x, d.y}; }
                    v0 = v0 * sc; v1 = v1 * sc; u32x4 w; w.x = cvt_pk_bf16(v0[0], v0[1]); w.y = cvt_pk_bf16(v0[2], v0[3]); w.z = cvt_pk_bf16(v1[0], v1[1]); w.w = cvt_pk_bf16(v1[2], v1[3]);
                    asm volatile("global_store_dwordx4 %0, %1, off sc1\n\ts_nop 1" :: "v"((u32x4*)(rowp + bj * HALF)), "v"(w) : "memory"); } }
    }
};

template <class Epi, class Sched, bool ALIGN_EPI = false, bool SP2 = false>
__device__ __forceinline__ void gemm_phase(PG8_LAS unsigned char* lds, const Gemm g, const Sched& S, const Epi& E) {
    const int tid = threadIdx.x, wid = __builtin_amdgcn_readfirstlane(tid >> 6), lane = tid & 63, wr = wid >> 2, wc = wid & 3, fr = lane & 15, fq = lane >> 4;
    const int K = g.K, nt = K / BK;
    unsigned voffA[2], voffB[2];
#pragma unroll
    for (int i = 0; i < 2; ++i) { int R, C; stage_rc(tid * 16 + i * 8192, R, C); const int Rb = Epi::PERM ? ((R & ~31) + perm32(R & 31)) : R;
        voffA[i] = (unsigned)(R * K + C) * 2u; voffB[i] = (unsigned)(Rb * K + C) * 2u; }
    const size_t kstep = (size_t)(BK * 2);
    const size_t hstep = (size_t)HALF * K * 2;
    const size_t tstep = 2 * hstep;
    const unsigned ldsw = (unsigned)wid * 1024u;
    const int aoff = lds_byte(wr * 64 + fr, fq * 8), boff = lds_byte(wc * 32 + fr, fq * 8);
#define PG8_SA(b, h) (((b) * 2 + (h)) * HTB)
#define PG8_SB(b, h) ((4 + (b) * 2 + (h)) * HTB)
#define PG8_STAGE(bufoff, gbase, voff) do { _Pragma("unroll") for (int _i = 0; _i < 2; ++_i) \
        __builtin_amdgcn_global_load_lds((const unsigned*)((const char*)(gbase) + (voff)[_i]), (PG8_LAS unsigned*)(lds + (bufoff) + ldsw + _i * 8192), 16, 0, 0); } while (0)
#define PG8_LDA(dst, b, h) do { _Pragma("unroll") for (int m = 0; m < 4; ++m) _Pragma("unroll") for (int k = 0; k < 2; ++k) dst[m][k] = *(const PG8_LAS bf16x8*)(lds + PG8_SA(b, h) + aoff + m * 2048 + k * 1024); } while (0)
#define PG8_LDB(dst, b, h) do { _Pragma("unroll") for (int n = 0; n < 2; ++n) _Pragma("unroll") for (int k = 0; k < 2; ++k) dst[n][k] = *(const PG8_LAS bf16x8*)(lds + PG8_SB(b, h) + boff + n * 2048 + k * 1024); } while (0)
#define PG8_MMA(ai, bj, At, Bt) do { __builtin_amdgcn_s_setprio(1); _Pragma("unroll") for (int m = 0; m < 4; ++m) _Pragma("unroll") for (int n = 0; n < 2; ++n) _Pragma("unroll") for (int k = 0; k < 2; ++k) \
        acc[ai][bj][m][n] = __builtin_amdgcn_mfma_f32_16x16x32_bf16(Bt[n][k], At[m][k], acc[ai][bj][m][n], 0, 0, 0); __builtin_amdgcn_s_setprio(0); } while (0)
#define PG8_WAIT_V(n) asm volatile("s_waitcnt vmcnt(" #n ")" ::: "memory")
#define PG8_WAIT_L(n) asm volatile("s_waitcnt lgkmcnt(" #n ")" ::: "memory")
#define PG8_BAR __builtin_amdgcn_s_barrier()
#define PG8_SCHED __builtin_amdgcn_sched_barrier(0)
    Unit cur, nxt; int ui = 0;
    if (!S.next(0, cur)) return;
    f32x4 acc[2][2][4][2];
#pragma unroll
    for (int a = 0; a < 2; ++a)
#pragma unroll
        for (int b = 0; b < 2; ++b)
#pragma unroll
            for (int m = 0; m < 4; ++m)
#pragma unroll
                for (int n = 0; n < 2; ++n) acc[a][b][m][n] = (f32x4){0.f, 0.f, 0.f, 0.f};
    bf16x8 At[4][2], B0[2][2], B1[2][2];
    const char* cA = (const char*)g.A + (size_t)cur.pm * tstep; const char* cB = (const char*)g.Bt + (size_t)cur.pn * tstep;
    S.a_ready(cur);
    if constexpr (SP2) {
        PG8_STAGE(PG8_SB(0, 0), cB, voffB); PG8_STAGE(PG8_SB(0, 1), cB + hstep, voffB); PG8_STAGE(PG8_SA(0, 0), cA, voffA); PG8_STAGE(PG8_SA(0, 1), cA + hstep, voffA);
        if (wr == 1) PG8_BAR;
        PG8_WAIT_V(2); PG8_BAR;
        PG8_STAGE(PG8_SB(1, 0), cB + kstep, voffB); PG8_STAGE(PG8_SA(1, 0), cA + kstep, voffA); PG8_STAGE(PG8_SB(1, 1), cB + hstep + kstep, voffB);
        PG8_WAIT_V(6); PG8_BAR;
    } else {
        PG8_STAGE(PG8_SB(0, 0), cB, voffB); PG8_STAGE(PG8_SA(0, 0), cA, voffA); PG8_STAGE(PG8_SB(0, 1), cB + hstep, voffB); PG8_STAGE(PG8_SA(0, 1), cA + hstep, voffA);
        if (wr == 1) PG8_BAR;
        PG8_WAIT_V(4); PG8_BAR;
        PG8_STAGE(PG8_SB(1, 0), cB + kstep, voffB); PG8_STAGE(PG8_SA(1, 0), cA + kstep, voffA); PG8_STAGE(PG8_SB(1, 1), cB + hstep + kstep, voffB);
        PG8_WAIT_V(6); PG8_BAR;
    }
    for (;;) {
        const bool has_next = S.next(ui + 1, nxt);
        const char* nA = has_next ? (const char*)g.A + (size_t)nxt.pm * tstep : cA; const char* nB = has_next ? (const char*)g.Bt + (size_t)nxt.pn * tstep : cB;
        for (int t = 0; t < nt; t += 2) {
            const bool last = (t == nt - 2);
            const char* a1 = cA + (size_t)(t + 1) * kstep;
            const char* a2 = last ? nA : cA + (size_t)(t + 2) * kstep; const char* b2 = last ? nB : cB + (size_t)(t + 2) * kstep;
            const char* a3 = a2 + kstep; const char* b3 = b2 + kstep;
            if (last && has_next) S.a_ready(nxt);
            if constexpr (SP2) {
            PG8_LDB(B0, 0, 0); PG8_LDB(B1, 0, 1); PG8_SCHED; PG8_LDA(At, 0, 0); PG8_STAGE(PG8_SA(1, 1), a1 + hstep, voffA);
            PG8_WAIT_V(8); PG8_WAIT_L(0); PG8_BAR; PG8_MMA(0, 0, At, B0); PG8_MMA(0, 1, At, B1); PG8_BAR; PG8_SCHED;
            PG8_LDA(At, 0, 1); PG8_STAGE(PG8_SB(0, 0), b2, voffB); PG8_STAGE(PG8_SB(0, 1), b2 + hstep, voffB); PG8_STAGE(PG8_SA(0, 0), a2, voffA);
            PG8_WAIT_V(8); PG8_WAIT_L(0); PG8_BAR; PG8_MMA(1, 0, At, B0); PG8_MMA(1, 1, At, B1); PG8_BAR; PG8_SCHED;
            PG8_LDB(B0, 1, 0); PG8_LDB(B1, 1, 1); PG8_SCHED; PG8_LDA(At, 1, 0); PG8_STAGE(PG8_SA(0, 1), a2 + hstep, voffA);
            PG8_WAIT_V(8); PG8_WAIT_L(0); PG8_BAR; PG8_MMA(0, 0, At, B0); PG8_MMA(0, 1, At, B1); PG8_BAR; PG8_SCHED;
            PG8_LDA(At, 1, 1); PG8_STAGE(PG8_SB(1, 0), b3, voffB); PG8_STAGE(PG8_SB(1, 1), b3 + hstep, voffB); PG8_STAGE(PG8_SA(1, 0), a3, voffA);
            PG8_WAIT_V(8); PG8_WAIT_L(0); PG8_BAR; PG8_MMA(1, 0, At, B0); PG8_MMA(1, 1, At, B1); PG8_BAR; PG8_SCHED;
            } else {
            PG8_LDB(B0, 0, 0); PG8_SCHED; PG8_LDA(At, 0, 0); PG8_STAGE(PG8_SA(1, 1), a1 + hstep, voffA);
            PG8_WAIT_L(8); PG8_BAR; PG8_WAIT_L(0); PG8_MMA(0, 0, At, B0); PG8_BAR; PG8_SCHED;
            PG8_LDB(B1, 0, 1); PG8_STAGE(PG8_SB(0, 0), b2, voffB);
            PG8_BAR; PG8_WAIT_L(0); PG8_MMA(0, 1, At, B1); PG8_BAR;
            PG8_LDA(At, 0, 1); PG8_STAGE(PG8_SA(0, 0), a2, voffA);
            PG8_BAR; PG8_WAIT_L(0); PG8_MMA(1, 0, At, B0); PG8_BAR; PG8_SCHED;
            PG8_STAGE(PG8_SB(0, 1), b2 + hstep, voffB);
            PG8_WAIT_V(6); PG8_BAR; PG8_MMA(1, 1, At, B1); PG8_BAR;
            PG8_LDB(B0, 1, 0); PG8_SCHED; PG8_LDA(At, 1, 0); PG8_STAGE(PG8_SA(0, 1), a2 + hstep, voffA);
            PG8_WAIT_L(8); PG8_BAR; PG8_WAIT_L(0); PG8_MMA(0, 0, At, B0); PG8_BAR; PG8_SCHED;
            PG8_LDB(B1, 1, 1); PG8_STAGE(PG8_SB(1, 0), b3, voffB);
            PG8_BAR; PG8_WAIT_L(0); PG8_MMA(0, 1, At, B1); PG8_BAR;
            PG8_LDA(At, 1, 1); PG8_STAGE(PG8_SA(1, 0), a3, voffA);
            PG8_BAR; PG8_WAIT_L(0); PG8_MMA(1, 0, At, B0); PG8_BAR; PG8_SCHED;
            PG8_STAGE(PG8_SB(1, 1), b3 + hstep, voffB);
            PG8_WAIT_V(6); PG8_BAR; PG8_MMA(1, 1, At, B1); PG8_BAR;
            }
        }
        if constexpr (ALIGN_EPI) { if (wr == 0) PG8_BAR; }
        if constexpr (!Epi::AFTER_DRAIN) { E(acc, cur, wr, wc, fr, fq); S.done(cur); }
        if (!has_next) break;
#pragma unroll
        for (int a = 0; a < 2; ++a)
#pragma unroll
            for (int b = 0; b < 2; ++b)
#pragma unroll
                for (int m = 0; m < 4; ++m)
#pragma unroll
                    for (int n = 0; n < 2; ++n) acc[a][b][m][n] = (f32x4){0.f, 0.f, 0.f, 0.f};
        cur = nxt; cA = nA; cB = nB; ++ui;
        if constexpr (ALIGN_EPI) { if (wr == 1) PG8_BAR; }
    }
    PG8_WAIT_V(0);
    if constexpr (!ALIGN_EPI) { if (wr == 0) PG8_BAR; }
    PG8_BAR;
    if constexpr (Epi::AFTER_DRAIN) { E.fused(acc, cur, wr, wc, fr, fq, lds, wid, lane); S.done(cur); }
#undef PG8_SA
#undef PG8_SB
#undef PG8_STAGE
#undef PG8_LDA
#undef PG8_LDB
#undef PG8_MMA
#undef PG8_WAIT_V
#undef PG8_WAIT_L
#undef PG8_BAR
#undef PG8_SCHED
}
}


namespace pg8 {
struct EpiProj {
    static constexpr bool PERM = true, AFTER_DRAIN = false;
    bf16_t* P0; bf16_t* P1; bf16_t* P2;
    __device__ __forceinline__ void operator()(const f32x4 (&acc)[2][2][4][2], const Unit& u, int wr, int wc, int fr, int fq) const {
        const int row0 = u.pm * BM + wr * 64 + fr; const int colt = u.pn * BM;
        const long d1 = (long)(P1 - P0), d2 = (long)(P2 - P0); long dsel = 0; if (colt >= 1024) dsel = d1; if (colt >= 2048) dsel = d2;
        bf16_t* base = P0 + dsel; const int ldc = colt < 2048 ? 1024 : 256; const int cl = colt & 1023;
        const int col0 = cl + wc * 32 + 8 * fq;
#pragma unroll
        for (int ai = 0; ai < 2; ++ai)
#pragma unroll
            for (int m = 0; m < 4; ++m) { bf16_t* rowp = base + (size_t)(row0 + ai * HALF + m * 16) * ldc + col0;
#pragma unroll
                for (int bj = 0; bj < 2; ++bj) { const f32x4 v0 = acc[ai][bj][m][0], v1 = acc[ai][bj][m][1];
                    u32x4 w; w.x = cvt_pk_bf16(v0[0], v0[1]); w.y = cvt_pk_bf16(v0[2], v0[3]); w.z = cvt_pk_bf16(v1[0], v1[1]); w.w = cvt_pk_bf16(v1[2], v1[3]);
                    asm volatile("global_store_dwordx4 %0, %1, off sc1\n\ts_nop 1" :: "v"((u32x4*)(rowp + bj * HALF)), "v"(w) : "memory"); } }
    }
};
}

constexpr int P3_TILE_BYTES = 256 * 1024;
constexpr int LDS_TK = 92160;
constexpr int GP_SH = 11, GP_N = 16384 >> GP_SH, GP_OS = GP_N + 1;
constexpr int LDS_OFF = 32768, LDS_CNT = 36864, LDS_LIST = 36864, LDS_H2L = 45056, LDS_SE = 110592;
constexpr int SCW = 260;
template <int N> DI void ce_desc(float (&a)[N], int i, int l) { const float hi = fmaxf(a[i], a[l]), lo = fminf(a[i], a[l]); a[i] = hi; a[l] = lo; }
DI void sort16_desc(float (&a)[16]) {
#pragma unroll
  for (int k = 2; k <= 16; k <<= 1)
#pragma unroll
    for (int j = k >> 1; j > 0; j >>= 1)
#pragma unroll
      for (int i = 0; i < 16; ++i) { const int l = i ^ j; if (l > i) { if ((i & k) == 0) ce_desc(a, i, l); else ce_desc(a, l, i); } }
}
DI void merge16_desc(float (&a)[16]) {
#pragma unroll
  for (int j = 8; j > 0; j >>= 1)
#pragma unroll
    for (int i = 0; i < 16; ++i) { const int l = i ^ j; if (l > i) ce_desc(a, i, l); }
}
DI void top16_merge(float (&a)[16], const float (&b)[16]) {
#pragma unroll
  for (int i = 0; i < 16; ++i) a[i] = fmaxf(a[i], b[15 - i]);
  merge16_desc(a);
}
template <int CTRL> DI float dpp_f(float v) { return __int_as_float(__builtin_amdgcn_mov_dpp(__float_as_int(v), CTRL, 0xF, 0xF, true)); }

DI float gelu_fast(float x) { return 0.5f * x * (1.f + erff(x * 0.70710678118654752f)); }

DI void phase3(const KP& p, char* lds, const int gather_reps, const int probe) {
  const int tid0 = threadIdx.x;
  const int r = tid0 & 31, hh = (tid0 >> 5) & 1, lane = tid0 & 63;
  char* wl = lds + LDS_WT + ((tid0 >> 6) & 3) * WT_BYTES;
  for (int tile = blockIdx.x; tile < 256; tile += gridDim.x) {
    unsigned char* ws = launder(p.ws); float* outp = launder(p.out); const float* xin = launder(p.in[0]);
    const int tok0 = tile * 64, b = tile >> 5;
    unsigned char* tsc = ws + WS_QM + (size_t)tile * P3_TILE_BYTES;
    bf16_t* QRY = (bf16_t*)tsc; bf16_t* Y = (bf16_t*)tsc; bf16_t* MIXA = (bf16_t*)(ws + WS_P1S) + (size_t)tok0 * 1024; bf16_t* H2 = MIXA;
    const float* modb = launder((const float*)(ws + WS_MOD)) + b * 6144;
    __syncthreads();
    {
      const int tid = lv(tid0), lane = tid & 63, w = tid >> 6, r = lane & 31, hh = lane >> 5;
      const int h = w >> 1, mi = w & 1, n = tile & 31;
      char* OIL = lds; char* RGL = lds + 66560;
      { const bf16_t* oig = (const bf16_t*)(ws + WS_OINTRA) + (size_t)tok0 * 512; const bf16_t* PBr = (const bf16_t*)((const unsigned char*)outp + 32 * MiB) + (size_t)tok0 * 1024 + (O_R - 1024); const bf16_t* PCr = (const bf16_t*)(ws + WS_PROJC) + (size_t)tok0 * 256;
#pragma unroll
        for (int g = 0; g < 2; ++g) {
          bf16x8 vo[4], vr[4];
#pragma unroll
          for (int i = 0; i < 4; ++i) { const int c = tid + 512 * (g * 4 + i), row = c >> 6, cc = c & 63;
            vo[i] = *(const bf16x8*)(oig + (size_t)row * 512 + cc * 8); { const bf16_t* rp = (cc < 36) ? PBr + (size_t)row * 1024 + cc * 8 : PCr + (size_t)row * 256 + (cc - 36) * 8; vr[i] = *(const bf16x8*)rp; } }
#pragma unroll
          for (int i = 0; i < 4; ++i) { const int c = tid + 512 * (g * 4 + i), row = c >> 6, cc = c & 63;
            *(bf16x8*)(OIL + row * 1040 + cc * 16) = vo[i]; *(bf16x8*)(RGL + row * 1040 + cc * 16) = vr[i]; } } }
      const bf16_t* QDg = (const bf16_t*)(ws + WS_QDEC) + (size_t)(tile * 4 + h) * 2 * 4096 + (mi * 32 + r) * 64 + hh * 8;
      const bf16_t* SPg = (const bf16_t*)(ws + WS_SPT) + ((size_t)((b * 4 + h) * 2) * 32 + n) * 8192 + r * 64 + hh * 8;
      f32x16 acc[4];
#pragma unroll
      for (int ni = 0; ni < 4; ++ni)
#pragma unroll
        for (int i = 0; i < 16; ++i) acc[ni][i] = 0.f;
#pragma unroll
      for (int d = 0; d < 2; ++d) {
        bf16x8 a[4], bb[4][4];
#pragma unroll
        for (int s = 0; s < 4; ++s) { a[s] = *(const bf16x8*)(QDg + d * 4096 + s * 16);
#pragma unroll
          for (int ni = 0; ni < 4; ++ni) bb[s][ni] = *(const bf16x8*)(SPg + (size_t)d * 32 * 8192 + ni * 32 * 64 + s * 16); }
#pragma unroll
        for (int s = 0; s < 4; ++s)
#pragma unroll
          for (int ni = 0; ni < 4; ++ni) acc[ni] = MFMA32(a[s], bb[s][ni], acc[ni]); }
      __syncthreads();
      bf16_t* oil = (bf16_t*)(OIL + (mi * 32 + 4 * hh) * 1040) + h * 128 + r; const bf16_t* rgl = (const bf16_t*)(RGL + (mi * 32 + 4 * hh) * 1040) + h * 128 + r;
#pragma unroll
      for (int ni = 0; ni < 4; ++ni)
#pragma unroll
        for (int reg = 0; reg < 16; ++reg) acc[ni][reg] += bf2f(oil[((reg & 3) + 8 * (reg >> 2)) * 520 + ni * 32]);
      float rs[16];
#pragma unroll
      for (int reg = 0; reg < 16; ++reg) { float v = acc[0][reg] * acc[0][reg] + acc[1][reg] * acc[1][reg] + acc[2][reg] * acc[2][reg] + acc[3][reg] * acc[3][reg];
        v += __shfl_xor(v, 1); v += __shfl_xor(v, 2); v += __shfl_xor(v, 4); v += __shfl_xor(v, 8); v += __shfl_xor(v, 16);
        rs[reg] = rsqrtf(v * (1.f / 128.f) + EPS); }
      const float* ggl = launder(p.in[16]);
#pragma unroll
      for (int ni = 0; ni < 4; ++ni) { const float g = ggl[ni * 32 + r];
#pragma unroll
        for (int reg = 0; reg < 16; ++reg) { const int ro = ((reg & 3) + 8 * (reg >> 2)) * 520 + ni * 32; const float rv = bf2f(rgl[ro]);
          oil[ro] = f2bf(acc[ni][reg] * rs[reg] * g * silu_fast(rv)); } }
      __syncthreads();
#pragma unroll
      for (int i = 0; i < 8; ++i) { const int c = tid + 512 * i, row = c >> 6, cc = c & 63;
        *(uint4*)(MIXA + (size_t)row * 1024 + 512 + cc * 8) = *(const uint4*)(OIL + row * 1040 + cc * 16); }
    }
  }
}

DI void phase3c(const KP& p, char* lds, const int gather_reps, const int probe) {
  const int tid0 = threadIdx.x;
  const int r = tid0 & 31, hh = (tid0 >> 5) & 1, lane = tid0 & 63;
  char* wl = lds + LDS_WT + ((tid0 >> 6) & 3) * WT_BYTES;
  for (int tile = blockIdx.x; tile < 256; tile += gridDim.x) {
    unsigned char* ws = launder(p.ws); float* outp = launder(p.out); const float* xin = launder(p.in[0]);
    const int tok0 = tile * 64, b = tile >> 5;
    unsigned char* tsc = ws + WS_QM + (size_t)tile * P3_TILE_BYTES;
    bf16_t* QRY = (bf16_t*)tsc; bf16_t* Y = (bf16_t*)(ws + WS_QM) + (size_t)tok0 * 1024; bf16_t* MIXA = (bf16_t*)(ws + WS_P1S) + (size_t)tok0 * 1024; bf16_t* H2 = MIXA;
    const float* modb = launder((const float*)(ws + WS_MOD)) + b * 6144;
    bf16_t* X1B = (bf16_t*)(ws + WS_X1B);
    __syncthreads();
    {
      const int tid = lv(tid0), lane = tid & 63, w = tid >> 6;
      float4 A1[4], A2[4], S2[4];
      const float* gpo = launder(p.in[6]); const float* gpf = launder(p.in[18]);
#pragma unroll
      for (int i = 0; i < 4; ++i) { const int d = (lane + 64 * i) * 4;
        const float4 gp = *(const float4*)(gpo + d), gt = *(const float4*)(modb + 2048 + d), g2 = *(const float4*)(gpf + d), sc = *(const float4*)(modb + 4096 + d);
        S2[i] = *(const float4*)(modb + 3072 + d);
        A1[i] = make_float4(gp.x * gt.x, gp.y * gt.y, gp.z * gt.z, gp.w * gt.w);
        A2[i] = make_float4(g2.x * (1.f + sc.x), g2.y * (1.f + sc.y), g2.z * (1.f + sc.z), g2.w * (1.f + sc.w)); }
#pragma unroll 2
      for (int rr = 0; rr < 8; ++rr) { const int row = w * 8 + rr; const size_t tok = tok0 + row;
        float4 yv[4]; float ss = 0.f;
#pragma unroll
        for (int i = 0; i < 4; ++i) { const uint2 u = *(const uint2*)(Y + (size_t)row * 1024 + (lane + 64 * i) * 4);
          yv[i] = make_float4(__uint_as_float(u.x << 16), __uint_as_float(u.x & 0xffff0000u), __uint_as_float(u.y << 16), __uint_as_float(u.y & 0xffff0000u));
          ss += yv[i].x * yv[i].x + yv[i].y * yv[i].y + yv[i].z * yv[i].z + yv[i].w * yv[i].w; }
        ss = wave_sum(ss); const float rs = rsqrtf(ss * (1.f / 1024.f) + EPS);
        float4 xv[4]; float s2 = 0.f;
#pragma unroll
        for (int i = 0; i < 4; ++i) { const float4 x = *(const float4*)(xin + tok * 1024 + (lane + 64 * i) * 4);
          xv[i] = make_float4(x.x + A1[i].x * yv[i].x * rs, x.y + A1[i].y * yv[i].y * rs, x.z + A1[i].z * yv[i].z * rs, x.w + A1[i].w * yv[i].w * rs);
          { uint2 xo; xo.x = pack2(xv[i].x, xv[i].y); xo.y = pack2(xv[i].z, xv[i].w); *(uint2*)(X1B + tok * 1024 + (lane + 64 * i) * 4) = xo; }
          s2 += xv[i].x * xv[i].x + xv[i].y * xv[i].y + xv[i].z * xv[i].z + xv[i].w * xv[i].w; }
        s2 = wave_sum(s2); const float r2 = rsqrtf(s2 * (1.f / 1024.f) + EPS);
#pragma unroll
        for (int i = 0; i < 4; ++i) { uint2 o; o.x = pack2(xv[i].x * r2 * A2[i].x + S2[i].x, xv[i].y * r2 * A2[i].y + S2[i].y); o.y = pack2(xv[i].z * r2 * A2[i].z + S2[i].z, xv[i].w * r2 * A2[i].w + S2[i].w);
          *(uint2*)(H2 + (size_t)row * 1024 + (lane + 64 * i) * 4) = o; }
      }
    }
  }
}

struct XcdBarrier;
__device__ __forceinline__ void xcd_barrier(const XcdBarrier& b);
DI void phase3b(const KP& p, char* lds, const int gather_reps, const int probe, const XcdBarrier& xbr, const bool xbp) {
  const int tid0 = threadIdx.x;
  const int r = tid0 & 31, hh = (tid0 >> 5) & 1, lane = tid0 & 63;
  char* wl = lds + LDS_WT + ((tid0 >> 6) & 3) * WT_BYTES;
  for (int tile = blockIdx.x; tile < 256; tile += gridDim.x) {
    unsigned char* ws = launder(p.ws); float* outp = launder(p.out); const float* xin = launder(p.in[0]);
    const int tok0 = tile * 64, b = tile >> 5;
    unsigned char* tsc = ws + WS_QM + (size_t)tile * P3_TILE_BYTES;
    bf16_t* QRY = (bf16_t*)tsc; bf16_t* Y = (bf16_t*)tsc; bf16_t* MIXA = (bf16_t*)(ws + WS_P1S) + (size_t)tok0 * 1024; bf16_t* H2 = MIXA;
    const float* modb = launder((const float*)(ws + WS_MOD)) + b * 6144;
    __syncthreads();
    float* SC = (float*)lds; unsigned* TK = (unsigned*)(lds + LDS_TK);
    {
      constexpr int SC2W = 132, SC2H = 64 * SC2W;
      const int tid = lv(tid0), ln = tid & 63, wv = tid >> 6, r2 = ln & 31, h2 = ln >> 5;
      const int mi = wv & 1, hd = (wv >> 1) & 1, np = wv >> 2;
      const int m16 = ln & 15, kq = ln >> 4;
      typedef float f32x4_e __attribute__((ext_vector_type(4)));
      const bf16_t* kd = launder((const bf16_t*)(ws + WS_KD));
      bf16x8 fb[4][4], fa[2][4];
#define LD_FB(side_) do { _Pragma("unroll") for (int c = 0; c < 4; ++c) _Pragma("unroll") for (int ks = 0; ks < 4; ++ks) { const int kg = (side_) * 128 + 32 * ks + 8 * kq, n = (side_) * 128 + 64 * np + 16 * c + m16;     \
          fb[c][ks] = *(const bf16x8*)(kd + (size_t)(kg >> 6) * 16384 + n * 64 + (kg & 63)); } } while (0)
#define LD_FA(rd_) do { const bf16_t* qp = QRY + (size_t)(32 * mi + m16) * 2048 + (2 * ((rd_) & 3) + hd) * 256 + ((rd_) >> 2) * 128 + 8 * kq; \
          _Pragma("unroll") for (int g = 0; g < 2; ++g) _Pragma("unroll") for (int ks = 0; ks < 4; ++ks) fa[g][ks] = *(const bf16x8*)(qp + (size_t)g * 16 * 2048 + 32 * ks); } while (0)
      LD_FB(0); LD_FA(0);
      float4 cxX[4];
      if (xbp) conv_row_load(p, ((int)blockIdx.x * 8 + wv) * 16, ln, cxX);
#pragma unroll 1
      for (int rd = 0; rd < 8; ++rd) {
        const int side = rd >> 2, hp = rd & 3;
        const int crow0 = ((int)blockIdx.x * 8 + wv) * 16 + rd * 2;
        float4 cxY[4];
        {
          {
            f32x4_e acc[2][4];
#pragma unroll
            for (int g = 0; g < 2; ++g)
#pragma unroll
              for (int c = 0; c < 4; ++c) acc[g][c] = (f32x4_e){0.f, 0.f, 0.f, 0.f};
#pragma unroll
            for (int ks = 0; ks < 4; ++ks)
#pragma unroll
              for (int g = 0; g < 2; ++g)
#pragma unroll
                for (int c = 0; c < 4; ++c) acc[g][c] = __builtin_amdgcn_mfma_f32_16x16x32_bf16(fa[g][ks], fb[c][ks], acc[g][c], 0, 0, 0);
            if (rd == 3) LD_FB(1);
            if (rd < 7) LD_FA(rd + 1);
            float* sp = SC + hd * SC2H + (32 * mi + 4 * kq) * SC2W + 64 * np + m16;
#pragma unroll
            for (int g = 0; g < 2; ++g)
#pragma unroll
              for (int c = 0; c < 4; ++c)
#pragma unroll
                for (int i = 0; i < 4; ++i) sp[(16 * g + i) * SC2W + 16 * c] = acc[g][c][i];
          }
          if (xbp) conv_row_load(p, crow0 + 1, ln, cxY);
          __syncthreads();
          if (xbp) { conv_row_finish(ws, crow0, ln, cxX); if (rd < 7) conv_row_load(p, crow0 + 2, ln, cxX); }
          {
            const int tt = tid >> 3, hs = (tid >> 2) & 1, q = tid & 3;
            const float* sr = SC + hs * SC2H + tt * SC2W + q * 32;
            float a[16], c[16];
#pragma unroll
            for (int i = 0; i < 4; ++i) { const float4 v = *(const float4*)(sr + i * 4); const unsigned ib = q * 32 + i * 4;
              a[i * 4 + 0] = __uint_as_float((__float_as_uint(v.x) & 0xFFFFFF80u) | (ib + 0)); a[i * 4 + 1] = __uint_as_float((__float_as_uint(v.y) & 0xFFFFFF80u) | (ib + 1));
              a[i * 4 + 2] = __uint_as_float((__float_as_uint(v.z) & 0xFFFFFF80u) | (ib + 2)); a[i * 4 + 3] = __uint_as_float((__float_as_uint(v.w) & 0xFFFFFF80u) | (ib + 3)); }
#pragma unroll
            for (int i = 0; i < 4; ++i) { const float4 v = *(const float4*)(sr + 16 + i * 4); const unsigned ib = q * 32 + 16 + i * 4;
              c[i * 4 + 0] = __uint_as_float((__float_as_uint(v.x) & 0xFFFFFF80u) | (ib + 0)); c[i * 4 + 1] = __uint_as_float((__float_as_uint(v.y) & 0xFFFFFF80u) | (ib + 1));
              c[i * 4 + 2] = __uint_as_float((__float_as_uint(v.z) & 0xFFFFFF80u) | (ib + 2)); c[i * 4 + 3] = __uint_as_float((__float_as_uint(v.w) & 0xFFFFFF80u) | (ib + 3)); }
            sort16_desc(a); sort16_desc(c); top16_merge(a, c);
#pragma unroll
            for (int i = 0; i < 16; ++i) c[i] = dpp_f<0xB1>(a[i]);
            top16_merge(a, c);
#pragma unroll
            for (int i = 0; i < 16; ++i) c[i] = dpp_f<0x4E>(a[i]);
            top16_merge(a, c);
            if (q == 0) { unsigned* tk = TK + ((tt * 8 + 2 * hp + hs) * 2 + side) * 16;
#pragma unroll
              for (int i = 0; i < 4; ++i) *(uint4*)(tk + i * 4) = make_uint4(__float_as_uint(a[i * 4]), __float_as_uint(a[i * 4 + 1]), __float_as_uint(a[i * 4 + 2]), __float_as_uint(a[i * 4 + 3])); }
          }
          if (xbp) conv_row_finish(ws, crow0 + 1, ln, cxY);
          __syncthreads();
        }
      }
#undef LD_FB
#undef LD_FA
    }
    {
      const int tid = lv(tid0);
      const int tt = tid >> 3, h = tid & 7;
      const unsigned* t1 = TK + ((tt * 8 + h) * 2) * 16; const unsigned* t2 = t1 + 16;
      float v1[16], v2[16];
#pragma unroll
      for (int i = 0; i < 4; ++i) { const uint4 u = *(const uint4*)(t1 + i * 4), v = *(const uint4*)(t2 + i * 4);
        v1[i * 4] = __uint_as_float(u.x & 0xFFFFFF80u); v1[i * 4 + 1] = __uint_as_float(u.y & 0xFFFFFF80u); v1[i * 4 + 2] = __uint_as_float(u.z & 0xFFFFFF80u); v1[i * 4 + 3] = __uint_as_float(u.w & 0xFFFFFF80u);
        v2[i * 4] = __uint_as_float(v.x & 0xFFFFFF80u); v2[i * 4 + 1] = __uint_as_float(v.y & 0xFFFFFF80u); v2[i * 4 + 2] = __uint_as_float(v.z & 0xFFFFFF80u); v2[i * 4 + 3] = __uint_as_float(v.w & 0xFFFFFF80u); }
      float best[16], grp[16];
#define CAND(i, j) __uint_as_float((__float_as_uint(v1[i] + v2[j]) & 0xFFFFFF00u) | ((i) << 4) | (j))
      best[0] = CAND(0, 0); best[1] = CAND(0, 1); best[2] = CAND(0, 2); best[3] = CAND(0, 3); best[4] = CAND(0, 4); best[5] = CAND(0, 5); best[6] = CAND(0, 6); best[7] = CAND(0, 7);
      best[8] = CAND(0, 8); best[9] = CAND(0, 9); best[10] = CAND(0, 10); best[11] = CAND(0, 11); best[12] = CAND(0, 12); best[13] = CAND(0, 13); best[14] = CAND(0, 14); best[15] = CAND(0, 15);
      sort16_desc(best);
      grp[0] = CAND(1, 0); grp[1] = CAND(1, 1); grp[2] = CAND(1, 2); grp[3] = CAND(1, 3); grp[4] = CAND(1, 4); grp[5] = CAND(1, 5); grp[6] = CAND(1, 6); grp[7] = CAND(1, 7);
      grp[8] = CAND(2, 0); grp[9] = CAND(2, 1); grp[10] = CAND(2, 2); grp[11] = CAND(2, 3); grp[12] = CAND(2, 4); grp[13] = CAND(3, 0); grp[14] = CAND(3, 1); grp[15] = CAND(3, 2);
      sort16_desc(grp); top16_merge(best, grp);
      grp[0] = CAND(3, 3); grp[1] = CAND(4, 0); grp[2] = CAND(4, 1); grp[3] = CAND(4, 2); grp[4] = CAND(5, 0); grp[5] = CAND(5, 1); grp[6] = CAND(6, 0); grp[7] = CAND(6, 1);
      grp[8] = CAND(7, 0); grp[9] = CAND(7, 1); grp[10] = CAND(8, 0); grp[11] = CAND(9, 0); grp[12] = CAND(10, 0); grp[13] = CAND(11, 0); grp[14] = CAND(12, 0); grp[15] = CAND(13, 0);
      sort16_desc(grp); top16_merge(best, grp);
      { const float c14 = CAND(14, 0), c15 = CAND(15, 0);
        grp[0] = fmaxf(c14, c15); grp[1] = fminf(c14, c15);
#pragma unroll
        for (int i = 2; i < 16; ++i) grp[i] = -3.0e38f;
        top16_merge(best, grp); }
#undef CAND
      if (xbp) xcd_barrier(xbr);
      else __syncthreads();
      float sv[16]; int ev[16]; float mx = -3.0e38f;
#pragma unroll
      for (int k = 0; k < 16; ++k) { const unsigned key = __float_as_uint(best[k]); const int ci = (key >> 4) & 15, cj = key & 15;
        const unsigned k1 = t1[ci], k2 = t2[cj];
        sv[k] = __uint_as_float(k1 & 0xFFFFFF80u) + __uint_as_float(k2 & 0xFFFFFF80u); ev[k] = (int)((k1 & 127u) * 128u + (k2 & 127u)); mx = fmaxf(mx, sv[k]); }
      float sum = 0.f;
#pragma unroll
      for (int k = 0; k < 16; ++k) { sv[k] = __expf(sv[k] - mx); sum += sv[k]; }
      const float inv = 1.f / sum;
      unsigned* CNT = (unsigned*)(lds + LDS_CNT); unsigned short* OFFS = (unsigned short*)(lds + LDS_OFF); unsigned* EL = (unsigned*)lds; unsigned short* SE = (unsigned short*)(lds + LDS_SE);
      unsigned short sek[16];
      { const unsigned short* SE16 = (const unsigned short*)(ws + WS_ESC);
#pragma unroll
        for (int k = 0; k < 16; ++k) sek[k] = SE16[ev[k]]; }
      CNT[tid] = 0u; if (GP_N > 8) CNT[tid + 512] = 0u;
      __syncthreads();
      int pos[16];
#pragma unroll
      for (int k = 0; k < 16; ++k) pos[k] = (int)atomicAdd(&CNT[tt * GP_N + (ev[k] >> GP_SH)], 1u);
      __syncthreads();
      if (h == 0) { unsigned run = 0;
#pragma unroll
        for (int q = 0; q < GP_N; ++q) { OFFS[tt * GP_OS + q] = (unsigned short)run; run += CNT[tt * GP_N + q]; }
        OFFS[tt * GP_OS + GP_N] = (unsigned short)run; }
      __syncthreads();
#pragma unroll
      for (int k = 0; k < 16; ++k) { const int d = (int)OFFS[tt * GP_OS + (ev[k] >> GP_SH)] + pos[k];
        EL[tt * 128 + d] = ((__float_as_uint(sv[k] * inv) + 0x2000u) & 0xFFFFC000u) | (unsigned)ev[k];
        SE[tt * 128 + d] = sek[k]; }
    }
    __syncthreads();
    {
      const int tid = lv(tid0), lane = tid & 63, w = tid >> 6;
      typedef int i32x4_t __attribute__((ext_vector_type(4)));
      i32x4_t EU, EV;
      { const unsigned long long bu = (unsigned long long)(ws + WS_EU), bv = (unsigned long long)(ws + WS_EV);
        EU[0] = __builtin_amdgcn_readfirstlane((int)(unsigned)bu); EU[1] = __builtin_amdgcn_readfirstlane((int)((bu >> 32) & 0xFFFFu)); EU[2] = 0x01000000; EU[3] = 0x00020000;
        EV[0] = __builtin_amdgcn_readfirstlane((int)(unsigned)bv); EV[1] = __builtin_amdgcn_readfirstlane((int)((bv >> 32) & 0xFFFFu)); EV[2] = 0x01000000; EV[3] = 0x00020000; }
      unsigned* EL = (unsigned*)lds; const unsigned short* OFFS = (const unsigned short*)(lds + LDS_OFF); unsigned* LIST = (unsigned*)(lds + LDS_LIST) + w * 256; char* H2W = lds + LDS_H2L + w * 8192;
      const unsigned short* SE = (const unsigned short*)(lds + LDS_SE);
      const float* gpf2 = launder(p.in[19]);
      const int rot = (int)(__builtin_amdgcn_s_getreg((3 << 11) | 20) & 0xFu) * (GP_N / 8);
      const unsigned voff = (unsigned)lane * 16u;
      const int sl = lane & 7;
      typedef float f2v __attribute__((ext_vector_type(2))); typedef unsigned u32x4_t __attribute__((ext_vector_type(4)));
#define CVLO(wd) __builtin_amdgcn_cvt_pk_f32_fp8((int)(wd), false)
#define CVHI(wd) __builtin_amdgcn_cvt_pk_f32_fp8((int)(wd), true)
#define BF2(wd) ((f2v){__uint_as_float((wd) << 16), __uint_as_float((wd) & 0xffff0000u)})
#define DPPF(x, CTRL) __int_as_float(__builtin_amdgcn_update_dpp(0, __float_as_int(x), CTRL, 0xF, 0xF, true))
#define R_INIT(R, TAG) do { _Pragma("unroll") for (int k2 = 0; k2 < 8; ++k2) asm volatile("; init " TAG : "=v"(R[k2])); } while (0)
#define EIDX(D) ((row0 + ((D) >> 11)) * 128 + (((D) >> 4) & 127) + (sl < ((D) & 15) ? sl : 0))
#define G_FETCH(DX, PKX, R, TAB, TAG) do { DX = Dn; PKX = PKn; { const int es_ = (int)(PKX & 16383u); unsigned so_[8]; \
        _Pragma("unroll") for (int k2 = 0; k2 < 8; ++k2) so_[k2] = (unsigned)__builtin_amdgcn_readlane(es_, k2) << 10;     \
        asm volatile("buffer_load_dwordx4 %0, %8, %9, %10 offen ; " TAG "\n\tbuffer_load_dwordx4 %1, %8, %9, %11 offen\n\tbuffer_load_dwordx4 %2, %8, %9, %12 offen\n\tbuffer_load_dwordx4 %3, %8, %9, %13 offen\n\t" \
                     "buffer_load_dwordx4 %4, %8, %9, %14 offen\n\tbuffer_load_dwordx4 %5, %8, %9, %15 offen\n\tbuffer_load_dwordx4 %6, %8, %9, %16 offen\n\tbuffer_load_dwordx4 %7, %8, %9, %17 offen" \
                     : "+v"(R[0]), "+v"(R[1]), "+v"(R[2]), "+v"(R[3]), "+v"(R[4]), "+v"(R[5]), "+v"(R[6]), "+v"(R[7])     \
                     : "v"(voff), "s"(TAB), "s"(so_[0]), "s"(so_[1]), "s"(so_[2]), "s"(so_[3]), "s"(so_[4]), "s"(so_[5]), "s"(so_[6]), "s"(so_[7])); } \
        Dn = __builtin_amdgcn_readfirstlane((int)tmpL); PKn = EL[EIDX(Dn)]; tmpL = LIST[sidx]; ++sidx; } while (0)
#define G_WAITK(R, k2) asm volatile("s_waitcnt vmcnt(%1)" : "+v"(R[k2]) : "n"(15 - (k2)))
#define G_DRAIN(RA_, RB_) do { asm volatile("s_waitcnt vmcnt(0)" : "+v"(RA_[0]), "+v"(RA_[1]), "+v"(RA_[2]), "+v"(RA_[3]), "+v"(RA_[4]), "+v"(RA_[5]), "+v"(RA_[6]), "+v"(RA_[7])); \
        asm volatile("" : "+v"(RB_[0]), "+v"(RB_[1]), "+v"(RB_[2]), "+v"(RB_[3]), "+v"(RB_[4]), "+v"(RB_[5]), "+v"(RB_[6]), "+v"(RB_[7])); } while (0)
#define U_DOT(R, k2) do { G_WAITK(R, k2); int d_ = __builtin_amdgcn_sdot4((int)R[k2][0], (int)hq.x, 0, false); d_ = __builtin_amdgcn_sdot4((int)R[k2][1], (int)hq.y, d_, false); \
            d_ = __builtin_amdgcn_sdot4((int)R[k2][2], (int)hq.z, d_, false); d_ = __builtin_amdgcn_sdot4((int)R[k2][3], (int)hq.w, d_, false); P[k2] = (float)d_; } while (0)
#define U_COMPUTE(D, R, SI) do { if ((D) != 0) { const int n_ = (D) & 15, rr_ = (D) >> 11; \
        if (rr_ != cur) { cur = rr_; hq = *(const uint4*)(H2W + rr_ * 1024 + lane * 16); } \
        float P[8]; \
        _Pragma("unroll") for (int k2 = 0; k2 < 8; ++k2) P[k2] = 0.f; \
          \
        U_DOT(R, 0); if (n_ > 1) { U_DOT(R, 1); if (n_ > 2) { U_DOT(R, 2); if (n_ > 3) { U_DOT(R, 3); if (n_ > 4) { U_DOT(R, 4); if (n_ > 5) { U_DOT(R, 5); if (n_ > 6) { U_DOT(R, 6); if (n_ > 7) { U_DOT(R, 7); } } } } } } } \
          \
        _Pragma("unroll") for (int e = 0; e < 4; ++e) { const float a_ = P[e] + DPPF(P[e], 0x141), b_ = P[e + 4] + DPPF(P[e + 4], 0x141); P[e] = (lane & 4) ? b_ : a_; } \
        _Pragma("unroll") for (int e = 0; e < 2; ++e) { const float a_ = P[e] + DPPF(P[e], 0x4E), b_ = P[e + 2] + DPPF(P[e + 2], 0x4E); P[e] = (lane & 2) ? b_ : a_; } \
        float av; { const float a_ = P[0] + DPPF(P[0], 0xB1), b_ = P[1] + DPPF(P[1], 0xB1); av = (lane & 1) ? b_ : a_; } \
        av += DPPF(av, 0x128); \
        { const auto s16 = __builtin_amdgcn_permlane16_swap(__float_as_uint(av), __float_as_uint(av), false, false); av = __uint_as_float(s16[0]) + __uint_as_float(s16[1]); } \
        { const auto s32 = __builtin_amdgcn_permlane32_swap(__float_as_uint(av), __float_as_uint(av), false, false); av = __uint_as_float(s32[0]) + __uint_as_float(s32[1]); } \
        if (lane < 8) AVB[((SI) & 7) * 8 + lane] = av;              } } while (0)
#define U_FLUSH(s0_, cnt_) do { const int j_ = lane >> 3; const unsigned D_ = (j_ < (cnt_)) ? LIST[(s0_) + j_] : 0u; const int n_ = (int)(D_ & 15u), rr_ = (int)(D_ >> 11); \
        if (sl < n_) { const int ei_ = (row0 + rr_) * 128 + (int)((D_ >> 4) & 127u) + sl; const unsigned pk_ = EL[ei_]; const unsigned se_ = (unsigned)SE[ei_]; \
          const float av = AVB[j_ * 8 + sl] * (__uint_as_float((se_ >> 8) << 23) * ((const float*)(H2W + 4096))[rr_]);              \
            \
          const float ax = fabsf(av), t = __builtin_amdgcn_rcpf(ax * 0.2316418882f + 1.0f); \
          float q = t * 0.5307027145f + (-0.7265760135f); q = q * t + 0.7107068705f; q = q * t + (-0.142248368f); q = q * t + 0.127414796f; q = q * t; \
          const float ee = __builtin_amdgcn_exp2f(av * av * (-0.72134752044f)); \
          const float mm = av * (q * ee), gl = (av < 0.f) ? mm : (av - mm); \
          const float wv = __uint_as_float(pk_ & 0xFFFFC000u) * gl * __uint_as_float((se_ & 255u) << 23); \
          EL[ei_] = ((__float_as_uint(wv) + 0x2000u) & 0xFFFFC000u) | (pk_ & 16383u); } } while (0)
#define Y_PARK() do { uint4 y0, y1; y0.x = pack2(acc[0].x, acc[0].y); y0.y = pack2(acc[1].x, acc[1].y); y0.z = pack2(acc[2].x, acc[2].y); y0.w = pack2(acc[3].x, acc[3].y); \
        y1.x = pack2(acc[4].x, acc[4].y); y1.y = pack2(acc[5].x, acc[5].y); y1.z = pack2(acc[6].x, acc[6].y); y1.w = pack2(acc[7].x, acc[7].y); \
        *(uint4*)(H2W + cur * 2048 + lane * 32) = y0; *(uint4*)(H2W + cur * 2048 + lane * 32 + 16) = y1; } while (0)
#define V_ACC(R, k2) do { const float wk = __int_as_float(__builtin_amdgcn_readlane(__float_as_int(wv_), k2)); const f2v wk2 = {wk, wk}; \
          G_WAITK(R, k2); \
          acc[0] += CVLO(R[k2][0]) * wk2; acc[1] += CVHI(R[k2][0]) * wk2; acc[2] += CVLO(R[k2][1]) * wk2; acc[3] += CVHI(R[k2][1]) * wk2; \
          acc[4] += CVLO(R[k2][2]) * wk2; acc[5] += CVHI(R[k2][2]) * wk2; acc[6] += CVLO(R[k2][3]) * wk2; acc[7] += CVHI(R[k2][3]) * wk2; } while (0)
#define V_COMPUTE(D, PK, R) do { if ((D) != 0) { const int n_ = (D) & 15, rr_ = (D) >> 11; \
        if (rr_ != cur) { if (cur >= 0) Y_PARK(); cur = rr_; \
          const uint4 hA = *(const uint4*)(H2W + rr_ * 2048 + lane * 32), hB = *(const uint4*)(H2W + rr_ * 2048 + lane * 32 + 16); \
          acc[0] = BF2(hA.x); acc[1] = BF2(hA.y); acc[2] = BF2(hA.z); acc[3] = BF2(hA.w); acc[4] = BF2(hB.x); acc[5] = BF2(hB.y); acc[6] = BF2(hB.z); acc[7] = BF2(hB.w); } \
        const float wv_ = (sl < n_) ? __uint_as_float(PK & 0xFFFFC000u) : 0.f; \
        V_ACC(R, 0); if (n_ > 1) { V_ACC(R, 1); if (n_ > 2) { V_ACC(R, 2); if (n_ > 3) { V_ACC(R, 3); if (n_ > 4) { V_ACC(R, 4); if (n_ > 5) { V_ACC(R, 5); if (n_ > 6) { V_ACC(R, 6); if (n_ > 7) { V_ACC(R, 7); } } } } } } } } } while (0)
#define G_PROLOGUE() do { Dn = __builtin_amdgcn_readfirstlane((int)LIST[0]); PKn = EL[EIDX(Dn)]; tmpL = LIST[1]; sidx = 2; } while (0)
#pragma unroll 1
      for (int half = 0; half < 2; ++half) {
        const int row0 = half * 32 + w * 4;
        __builtin_amdgcn_wave_barrier(); asm volatile("" ::: "memory");
        {
          uint4 ta[4], tb[4];
#pragma unroll
          for (int rr = 0; rr < 4; ++rr) { const uint4* src = (const uint4*)(H2 + (size_t)(row0 + rr) * 1024 + lane * 16); ta[rr] = src[0]; tb[rr] = src[1]; }
#pragma unroll
          for (int rr = 0; rr < 4; ++rr) { float f[16];
            f[0] = __uint_as_float(ta[rr].x << 16); f[1] = __uint_as_float(ta[rr].x & 0xffff0000u); f[2] = __uint_as_float(ta[rr].y << 16); f[3] = __uint_as_float(ta[rr].y & 0xffff0000u);
            f[4] = __uint_as_float(ta[rr].z << 16); f[5] = __uint_as_float(ta[rr].z & 0xffff0000u); f[6] = __uint_as_float(ta[rr].w << 16); f[7] = __uint_as_float(ta[rr].w & 0xffff0000u);
            f[8] = __uint_as_float(tb[rr].x << 16); f[9] = __uint_as_float(tb[rr].x & 0xffff0000u); f[10] = __uint_as_float(tb[rr].y << 16); f[11] = __uint_as_float(tb[rr].y & 0xffff0000u);
            f[12] = __uint_as_float(tb[rr].z << 16); f[13] = __uint_as_float(tb[rr].z & 0xffff0000u); f[14] = __uint_as_float(tb[rr].w << 16); f[15] = __uint_as_float(tb[rr].w & 0xffff0000u);
            float am = 0.f;
#pragma unroll
            for (int i = 0; i < 16; ++i) am = fmaxf(am, fabsf(f[i]));
            am = wave_max(am);
            const float hs = (am > 0.f) ? am * (1.f / 127.f) : 1.f, ihs = 1.f / hs;
            unsigned qd[4];
#pragma unroll
            for (int i = 0; i < 4; ++i) { const int q0 = (int)rintf(f[4 * i] * ihs), q1 = (int)rintf(f[4 * i + 1] * ihs), q2 = (int)rintf(f[4 * i + 2] * ihs), q3 = (int)rintf(f[4 * i + 3] * ihs);
              qd[i] = (unsigned)(q0 & 255) | ((unsigned)(q1 & 255) << 8) | ((unsigned)(q2 & 255) << 16) | ((unsigned)(q3 & 255) << 24); }
            *(uint4*)(H2W + rr * 1024 + lane * 16) = make_uint4(qd[0], qd[1], qd[2], qd[3]);
            if (lane == 0) ((float*)(H2W + 4096))[rr] = hs; } }
        int ns;
        {
          const int rr = lane & 3, part = ((lane >> 2) + rot) & (GP_N - 1);
          int o0 = 0, o1 = 0;
          if (lane < 4 * GP_N) { o0 = (int)OFFS[(row0 + rr) * GP_OS + part]; o1 = (int)OFFS[(row0 + rr) * GP_OS + part + 1]; }
          const int nst = (o1 - o0 + 7) >> 3;
          int incl = nst;
#pragma unroll
          for (int d = 1; d < 64; d <<= 1) { const int t = __shfl_up(incl, d); if (lane >= d) incl += t; }
          const int off = incl - nst;
          for (int j = 0; j < nst; ++j) { const int base = o0 + 8 * j; const int nn = (o1 - base < 8) ? (o1 - base) : 8; LIST[off + j] = (unsigned)(nn | (base << 4) | (rr << 11)); }
          ns = __builtin_amdgcn_readlane(incl, 63);
          if (lane < 8) LIST[ns + lane] = 0u; }
        __builtin_amdgcn_wave_barrier(); asm volatile("s_waitcnt vmcnt(0)" ::: "memory");
        {
          int DA, DB, Dn, sidx, cur = -1; unsigned PKA, PKB, PKn, tmpL; u32x4_t RA[8], RB[8]; uint4 hq = make_uint4(0u, 0u, 0u, 0u);
          float* AVB = (float*)(H2W + 4352); int flushed = 0;
          R_INIT(RA, "uA"); R_INIT(RB, "uB");
          G_PROLOGUE(); G_FETCH(DA, PKA, RA, EU, "uA0");
#pragma unroll 1
          for (int s = 0; s < ns; s += 2) {
            G_FETCH(DB, PKB, RB, EU, "uB"); U_COMPUTE(DA, RA, s);
            G_FETCH(DA, PKA, RA, EU, "uA"); U_COMPUTE(DB, RB, s + 1);
            if ((s & 7) == 6) { U_FLUSH(s - 6, 8); flushed = s + 2; }
          }
          G_DRAIN(RA, RB);
          if (flushed < ns) U_FLUSH(flushed, ns - flushed);
          (void)PKA; (void)PKB;
        }
        __builtin_amdgcn_wave_barrier(); asm volatile("s_waitcnt vmcnt(0)" ::: "memory");
        { const uint4 z4 = make_uint4(0u, 0u, 0u, 0u);
#pragma unroll
          for (int i = 0; i < 8; ++i) ((uint4*)H2W)[lane + 64 * i] = z4; }
        __builtin_amdgcn_wave_barrier(); asm volatile("" ::: "memory");
        {
          int DA, DB, Dn, sidx, cur = -1; unsigned PKA, PKB, PKn, tmpL; u32x4_t RA[8], RB[8]; f2v acc[8];
          R_INIT(RA, "vA"); R_INIT(RB, "vB");
          G_PROLOGUE(); G_FETCH(DA, PKA, RA, EV, "vA0");
#pragma unroll 1
          for (int s = 0; s < ns; s += 2) {
            G_FETCH(DB, PKB, RB, EV, "vB"); V_COMPUTE(DA, PKA, RA);
            G_FETCH(DA, PKA, RA, EV, "vA"); V_COMPUTE(DB, PKB, RB);
          }
          G_DRAIN(RA, RB);
          if (cur >= 0) Y_PARK();
        }
        __builtin_amdgcn_wave_barrier(); asm volatile("s_waitcnt vmcnt(0)" ::: "memory");
#pragma unroll 1
        for (int rr = 0; rr < 4; ++rr) { const size_t tok = tok0 + row0 + rr;
          uint2 yw[4]; float ss = 0.f;
#pragma unroll
          for (int i = 0; i < 4; ++i) { yw[i] = *(const uint2*)(H2W + rr * 2048 + (lane + 64 * i) * 8);
            const float y0 = __uint_as_float(yw[i].x << 16), y1 = __uint_as_float(yw[i].x & 0xffff0000u), y2 = __uint_as_float(yw[i].y << 16), y3 = __uint_as_float(yw[i].y & 0xffff0000u);
            ss += y0 * y0 + y1 * y1 + y2 * y2 + y3 * y3; }
          ss = wave_sum(ss); const float rs = rsqrtf(ss * (1.f / 1024.f) + EPS);
          uint2 xw[4];
#pragma unroll
          for (int i = 0; i < 4; ++i) { typedef unsigned u32x2_nt __attribute__((ext_vector_type(2)));
            const u32x2_nt t_ = __builtin_nontemporal_load((const u32x2_nt*)((const bf16_t*)(ws + WS_X1B) + tok * 1024 + (lane + 64 * i) * 4)); xw[i].x = t_.x; xw[i].y = t_.y; }
#pragma unroll
          for (int i = 0; i < 4; ++i) { const int d = (lane + 64 * i) * 4;
            const float4 g3 = *(const float4*)(gpf2 + d), g2 = *(const float4*)(modb + 5120 + d);
            float4 x1 = make_float4(__uint_as_float(xw[i].x << 16), __uint_as_float(xw[i].x & 0xffff0000u), __uint_as_float(xw[i].y << 16), __uint_as_float(xw[i].y & 0xffff0000u));
            x1.x += g3.x * g2.x * __uint_as_float(yw[i].x << 16) * rs; x1.y += g3.y * g2.y * __uint_as_float(yw[i].x & 0xffff0000u) * rs;
            x1.z += g3.z * g2.z * __uint_as_float(yw[i].y << 16) * rs; x1.w += g3.w * g2.w * __uint_as_float(yw[i].y & 0xffff0000u) * rs;
            { typedef float f32x4_nt __attribute__((ext_vector_type(4))); const f32x4_nt o_ = {x1.x, x1.y, x1.z, x1.w}; __builtin_nontemporal_store(o_, (f32x4_nt*)(outp + tok * 1024 + d)); } }
        }
      }
#undef CVLO
#undef CVHI
#undef BF2
#undef DPPF
#undef R_INIT
#undef EIDX
#undef G_FETCH
#undef G_WAITK
#undef G_DRAIN
#undef U_COMPUTE
#undef U_FLUSH
#undef U_DOT
#undef V_ACC
#undef Y_PARK
#undef V_COMPUTE
#undef G_PROLOGUE
    }
  }
}

DI void phase2_scan(const KP& p) {
  unsigned char* ws = p.ws;
  for (int g = blockIdx.x * NTHR + threadIdx.x; g < 131072; g += gridDim.x * NTHR) {
    const int seq = g >> 11, within = g & 2047, dv = within >> 4, dk4 = (within & 15) * 4, dir = seq & 1;
    bf16_t* base = (bf16_t*)(ws + WS_SPT) + ((size_t)seq * 32 * 128 + dv) * 64 + dk4;
    const float* dec = (const float*)(ws + WS_DEC) + (size_t)seq * 32 * 64 + dk4;
    float s0 = 0.f, s1 = 0.f, s2 = 0.f, s3 = 0.f;
#pragma unroll 1
    for (int i0 = 0; i0 < 32; i0 += 8) {
      uint2 d[8]; float4 c[8];
#pragma unroll
      for (int j = 0; j < 8; ++j) { const int n = dir ? 31 - (i0 + j) : (i0 + j); d[j] = *(const uint2*)(base + (size_t)n * 8192); c[j] = *(const float4*)(dec + n * 64); }
#pragma unroll
      for (int j = 0; j < 8; ++j) { const int n = dir ? 31 - (i0 + j) : (i0 + j);
        uint2 o; o.x = pack2(s0, s1); o.y = pack2(s2, s3); *(uint2*)(base + (size_t)n * 8192) = o;
        s0 = c[j].x * s0 + __uint_as_float(d[j].x << 16); s1 = c[j].y * s1 + __uint_as_float(d[j].x & 0xffff0000u);
        s2 = c[j].z * s2 + __uint_as_float(d[j].y << 16); s3 = c[j].w * s3 + __uint_as_float(d[j].y & 0xffff0000u); }
    }
  }
}

#define XB_MODCNT   64
#define XB_TMO      128
#define XB_XCNT(j)  (256  + 64 * (j))
#define XB_XSUB(j)  (1280 + 64 * (j))
#define XB_XGEN(j)  (2304 + 64 * (j))
#define XB_TOP      3328
#define XB_TOPGEN   3392
#define XCD_BAR_WORDS 3456
#define XB_SPIN_CAP (1u << 18)
#define LAS __attribute__((address_space(3)))

__device__ __forceinline__ unsigned xb_ld(unsigned* p)              { return __hip_atomic_load(p, __ATOMIC_RELAXED, __HIP_MEMORY_SCOPE_AGENT); }
__device__ __forceinline__ unsigned xb_add(unsigned* p, unsigned v) { return __hip_atomic_fetch_add(p, v, __ATOMIC_RELAXED, __HIP_MEMORY_SCOPE_AGENT); }
__device__ __forceinline__ unsigned xb_xcc_id() { return (unsigned)__builtin_amdgcn_s_getreg((3 << 11) | 20) & 0xFu; }
#define XB_SPIN(cond, bar) do { unsigned _sp = 0; while (cond) { __builtin_amdgcn_s_sleep(1); \
    if ((++_sp & 255u) == 0u) { if (xb_ld(&(bar)[XB_TMO])) break; if (_sp > XB_SPIN_CAP) { atomicAdd(&(bar)[XB_TMO], 1u); break; } } } } while (0)

struct XcdBarrier {
    unsigned* bar; unsigned x;
    volatile LAS unsigned* st;
};

__device__ __forceinline__ XcdBarrier xcd_barrier_post(unsigned* bar, volatile LAS unsigned* st) {
    XcdBarrier b; b.bar = bar; b.x = xb_xcc_id(); b.st = st;
    if (threadIdx.x == 0) (void)xb_add(&bar[XB_XCNT(b.x)], 1u);
    return b;
}
__device__ __forceinline__ void xcd_barrier_complete(unsigned* bar, unsigned x, unsigned& nloc, unsigned& nx) {
    const unsigned G = gridDim.x * gridDim.y * gridDim.z;
    unsigned sum, cnt, mine, sp = 0u;
    for (;;) {
        sum = 0u; cnt = 0u; mine = 0u;
#pragma unroll
        for (unsigned j = 0; j < 16; ++j) { const unsigned c = xb_ld(&bar[XB_XCNT(j)]); sum += c; cnt += (c > 0u) ? 1u : 0u; mine = (j == x) ? c : mine; }
        if (sum == G) break;
        __builtin_amdgcn_s_sleep(1);
        if ((++sp & 255u) == 0u) { if (xb_ld(&bar[XB_TMO])) break; if (sp > XB_SPIN_CAP) { atomicAdd(&bar[XB_TMO], 1u); break; } }
    }
    nloc = mine > 0u ? mine : 1u; nx = cnt > 0u ? cnt : 1u;
}

__device__ __forceinline__ void xcd_barrier(const XcdBarrier& b) {
    asm volatile("s_waitcnt vmcnt(0)" ::: "memory");
    __syncthreads();
    if (threadIdx.x == 0) {
        unsigned* bar = b.bar;
        __builtin_amdgcn_s_waitcnt(0);
        unsigned nloc = b.st[0], nx = b.st[1];
        if (nloc == 0u) { xcd_barrier_complete(bar, b.x, nloc, nx); b.st[0] = nloc; b.st[1] = nx; }
        const unsigned old = xb_add(&bar[XB_XSUB(b.x)], 1u);
        const unsigned gen = old / nloc;
        if (old + 1u == (gen + 1u) * nloc) {
            __builtin_amdgcn_fence(__ATOMIC_RELEASE, "agent");
            asm volatile("s_waitcnt vmcnt(0)" ::: "memory");
            const unsigned og = xb_add(&bar[XB_TOP], 1u);
            const unsigned tg = og / nx;
            if (og + 1u == (tg + 1u) * nx) xb_add(&bar[XB_TOPGEN], 1u);
            else XB_SPIN(xb_ld(&bar[XB_TOPGEN]) == tg, bar);
            __builtin_amdgcn_fence(__ATOMIC_ACQUIRE, "agent");
            xb_add(&bar[XB_XGEN(b.x)], 1u);
            asm volatile("s_waitcnt vmcnt(0)" ::: "memory");
        } else {
            XB_SPIN(xb_ld(&bar[XB_XGEN(b.x)]) == gen, bar);
            __builtin_amdgcn_fence(__ATOMIC_ACQUIRE, "agent");
            asm volatile("s_waitcnt vmcnt(0)" ::: "memory");
        }
    }
    __syncthreads();
}

#ifndef PROBE_ID
#define PROBE_ID 0
#endif
__global__ void __launch_bounds__(NTHR, 2) mega(KP p) {
  extern __shared__ __attribute__((aligned(16))) char lds[];
  cg::grid_group grid = cg::this_grid();
  const int hi = p.ph_hi; constexpr int probe = PROBE_ID;
  if (threadIdx.x == 0) { ((volatile LAS unsigned*)(lds + LDS_XB))[0] = 0u; ((volatile LAS unsigned*)(lds + LDS_XB))[1] = 0u; }
  __syncthreads();
  const XcdBarrier xb = xcd_barrier_post((unsigned*)(p.ws + WS_BAR), (volatile LAS unsigned*)(lds + LDS_XB));
  if (hi > 64) grid.sync();
  {
    unsigned* bar = (unsigned*)(p.ws + WS_BAR);
    const int njobs = phase0_mod(p, lds);
    if (njobs > 0) {
      asm volatile("s_waitcnt vmcnt(0)" ::: "memory"); __syncthreads();
      if (threadIdx.x == 0) { __builtin_amdgcn_fence(__ATOMIC_RELEASE, "agent"); asm volatile("s_waitcnt vmcnt(0)" ::: "memory"); xb_add(&bar[XB_MODCNT], (unsigned)njobs); }
    }
    phase0(p, lds);
    if (threadIdx.x == 0) { XB_SPIN(xb_ld(&bar[XB_MODCNT]) < (unsigned)MOD_JOBS, bar); __builtin_amdgcn_fence(__ATOMIC_ACQUIRE, "agent"); asm volatile("s_waitcnt vmcnt(0)" ::: "memory"); }
    __syncthreads();
  }
  if (p.ph_lo <= 1 && 1 < hi) {
    phase1a(p, lds);
    xcd_barrier(xb);
    {
      pg8::Gemm g{(const pg8::bf16_t*)p.out, (const pg8::bf16_t*)(p.ws + WS_WTINP), NTOK, 2048, 1024};
      pg8::StaticOrder S; S.init(NTOK, 2048, (int)gridDim.x, (int)blockIdx.x);
      pg8::EpiProj E{(pg8::bf16_t*)(p.ws + WS_P1S), (pg8::bf16_t*)((unsigned char*)p.out + 32 * MiB), (pg8::bf16_t*)(p.ws + WS_PROJC)};
      pg8::gemm_phase<pg8::EpiProj, pg8::StaticOrder, true, true>((PG8_LAS unsigned char*)lds, g, S, E);
      if (gridDim.x != 256) convert_experts(p, (int)blockIdx.x, (int)gridDim.x);
    }
    xcd_barrier(xb);
    phase1c(p, lds);
    if (2 < hi) xcd_barrier(xb);
  }
  if (p.ph_lo <= 2 && 2 < hi) { const bool fuse_scan = (gridDim.x == 256);
    if (!fuse_scan) phase2_scan(p);
    phase2_attn(p, lds, fuse_scan); if (3 < hi) xcd_barrier(xb); }
  if (p.ph_lo <= 3 && 3 < hi) {
    phase3(p, lds, 1, probe);
    xcd_barrier(xb);
    {
      pg8::Gemm g{(const pg8::bf16_t*)(p.ws + WS_P1S), (const pg8::bf16_t*)(p.ws + WS_WTOUTP), NTOK, 1024, 1024};
      pg8::StaticOrder S; S.init(NTOK, 1024, (int)gridDim.x, (int)blockIdx.x);
      pg8::EpiBf16<0> E{(pg8::bf16_t*)(p.ws + WS_QM), 1024, nullptr, 0, 0, 1.f};
      pg8::gemm_phase<pg8::EpiBf16<0>, pg8::StaticOrder, true, true>((PG8_LAS unsigned char*)lds, g, S, E);
    }
    xcd_barrier(xb);
    phase3c(p, lds, 1, probe);
    xcd_barrier(xb);
    {
      pg8::Gemm g{(const pg8::bf16_t*)(p.ws + WS_P1S), (const pg8::bf16_t*)(p.ws + WS_WTPQP), NTOK, 2048, 1024};
      pg8::StaticOrder S; S.init(NTOK, 2048, (int)gridDim.x, (int)blockIdx.x);
      pg8::EpiBf16<0> E{(pg8::bf16_t*)(p.ws + WS_QM), 2048, nullptr, 0, 0, 1.f};
      pg8::gemm_phase<pg8::EpiBf16<0>, pg8::StaticOrder, true, true>((PG8_LAS unsigned char*)lds, g, S, E);
    }
    xcd_barrier(xb);
    phase3b(p, lds, (probe == 4 || probe == 8 || probe == 9 || probe == 10) ? 2 : 1, probe, xb, gridDim.x == 256);
  }
}

extern "C" void kernel_launch(void* const* d_in, const int* in_sizes, int n_in, void* d_out, int out_size, void* d_ws, size_t ws_size, hipStream_t stream) {
  float* out = (float*)d_out;
  unsigned char* ws = (unsigned char*)d_ws;
  if (ws_size < WS_END || n_in != 25) return;
  static bool attr_done = false;
  if (!attr_done) { (void)hipFuncSetAttribute((const void*)mega, hipFuncAttributeMaxDynamicSharedMemorySize, LDS_TOTAL); attr_done = true; }
  KP p{};
  for (int i = 0; i < 25; ++i) p.in[i] = (const float*)d_in[i];
  p.out = out; p.ws = ws;
  p.ph_lo = 0; p.ph_hi = 4;
  (void)hipMemsetAsync(ws + WS_BAR, 0, XCD_BAR_WORDS * 4, stream);
  { void* args[] = {&p}; (void)hipLaunchCooperativeKernel((const void*)mega, dim3(256), dim3(NTHR), args, LDS_TOTAL, stream); }
}
```
